# Optimizing an MI355X kernel written in HIP

```python
import jax, jax.numpy as jnp
from jax import lax
import numpy as np

D_MODEL = 1024
BATCH = 16
SEQ = 2048
DEPTH = 2

D_MIX = D_MODEL
HEAD_DIM = 64
CONV_WIDTH = 256
SB_HEADS = 6
SB_WIDTH = SB_HEADS * HEAD_DIM
RWKV_HEADS = 6
RWKV_WIDTH = RWKV_HEADS * HEAD_DIM
CONV_TAPS = 31
DECAY_LORA = 32
ICLR_LORA = 32
VRES_LORA = 32
BLOCK_Q = 128
RMS_EPS = 1e-6
LN_EPS = 1e-5
GN_EPS = 64e-5
IN_WIDTHS = (CONV_WIDTH, CONV_WIDTH, CONV_WIDTH,
             SB_WIDTH, SB_WIDTH, SB_WIDTH, SB_WIDTH,
             RWKV_WIDTH, RWKV_WIDTH, RWKV_WIDTH,
             DECAY_LORA, ICLR_LORA,
             RWKV_WIDTH)
D_IN = 3 * CONV_WIDTH + 4 * SB_WIDTH + 4 * RWKV_WIDTH + DECAY_LORA + ICLR_LORA
SHIFT_WIDTH = 3 * RWKV_WIDTH + DECAY_LORA + ICLR_LORA

kernel_name = 'hybrid_conformer_stickbreak_rwkv7'


def _split_cols(p, widths):
    idx, acc = [], 0
    for w in widths[:-1]:
        acc += w
        idx.append(acc)
    return jnp.split(p, idx, axis=-1)


def rms_norm(x, g):
    xf = x.astype(jnp.float32)
    y = xf * lax.rsqrt(jnp.mean(xf * xf, axis=-1, keepdims=True) + RMS_EPS)
    return (y * g.astype(jnp.float32)).astype(x.dtype)


def token_shift(f):
    return jnp.pad(f, ((0, 0), (1, 0), (0, 0)))[:, :-1]


def _heads(t, n_heads):
    b, s, _ = t.shape
    return t.reshape(b, s, n_heads, HEAD_DIM).transpose(0, 2, 1, 3)


def conformer_conv(glu_a, glu_b, dw, dw_b, ln_g, ln_b, pw, pw_b):
    u = glu_a * jax.nn.sigmoid(glu_b)
    u = lax.conv_general_dilated(u, dw[:, None, :].astype(u.dtype), window_strides=(1,),
                                 padding=((CONV_TAPS - 1, 0),),
                                 dimension_numbers=('NWC', 'WIO', 'NWC'),
                                 feature_group_count=CONV_WIDTH) + dw_b
    uf = u.astype(jnp.float32)
    mean = jnp.mean(uf, axis=-1, keepdims=True)
    var = jnp.mean(jnp.square(uf - mean), axis=-1, keepdims=True)
    uf = (uf - mean) * lax.rsqrt(var + LN_EPS) * ln_g + ln_b
    uf = jax.nn.silu(uf)
    return uf.astype(glu_a.dtype) @ pw + pw_b


def stick_breaking_attention(q, k, v):
    b, h, t_len, dh = q.shape
    scale = HEAD_DIM ** -0.5
    outs = []
    for blk in range(t_len // BLOCK_Q):
        q0, q1 = blk * BLOCK_Q, (blk + 1) * BLOCK_Q
        z = jnp.einsum('bhqd,bhkd->bhqk', q[:, :, q0:q1], k[:, :, :q1]).astype(jnp.float32) * scale
        causal = jnp.arange(q1)[None, :] < jnp.arange(q0, q1)[:, None]
        log_keep = jnp.where(causal, jax.nn.log_sigmoid(-z), 0.0)
        log_rest = lax.cumsum(log_keep, axis=3, reverse=True) - log_keep
        att = jnp.where(causal, jnp.exp(jax.nn.log_sigmoid(z) + log_rest), 0.0)
        outs.append(jnp.einsum('bhqk,bhkd->bhqd', att.astype(v.dtype), v[:, :, :q1]))
    o = jnp.concatenate(outs, axis=2)
    return o.transpose(0, 2, 1, 3).reshape(b, t_len, h * dh)


def rwkv7_scan(r, w, k, v, a, b):
    bsz, _, h, n = r.shape

    def step(S, inp):
        r_t, w_t, k_t, v_t, a_t, b_t = inp
        sa = jnp.einsum('bhvk,bhk->bhv', S, a_t)
        S = S * w_t[:, :, None, :] + sa[..., None] * b_t[:, :, None, :] + v_t[..., None] * k_t[:, :, None, :]
        return S, jnp.einsum('bhvk,bhk->bhv', S, r_t)

    S0 = jnp.zeros((bsz, h, n, n), jnp.float32)
    xs = tuple(t.transpose(1, 0, 2, 3) for t in (r, w, k, v, a, b))
    _, y = lax.scan(step, S0, xs)
    return y.transpose(1, 0, 2, 3)


def rwkv7_time_mix(r, k, v, w_d, a_d, mu, w0, w2, a0, a2, kk_scale, ka, rk, gn_g, gn_b, v_first, v_res):
    out_dtype = r.dtype
    feats = jnp.concatenate([r, k, v, w_d, a_d], axis=-1)
    feats = feats + (token_shift(feats) - feats) * mu
    r, k, v, w_d, a_d = _split_cols(feats.astype(jnp.float32), (RWKV_WIDTH, RWKV_WIDTH, RWKV_WIDTH, DECAY_LORA, ICLR_LORA))
    w_log = -jax.nn.softplus(-(w0 + jnp.tanh(w_d) @ w2)) - 0.5
    decay = jnp.exp(-jnp.exp(w_log))
    a = jax.nn.sigmoid(a0 + a_d @ a2)
    if v_res is None:
        v_first = v
    else:
        v0, v1, v2 = v_res
        v = v + (v_first - v) * jax.nn.sigmoid(v0 + (v @ v1) @ v2)
    bsz, t_len, _ = r.shape
    hd = lambda t: t.reshape(bsz, t_len, RWKV_HEADS, HEAD_DIM)
    kk = hd(k * kk_scale)
    kk = kk / jnp.maximum(jnp.sqrt(jnp.sum(kk * kk, axis=-1, keepdims=True)), 1e-12)
    k = k * (1.0 + (a - 1.0) * ka)
    rh, kh, vh, ah = hd(r), hd(k), hd(v), hd(a)
    y = rwkv7_scan(rh, hd(decay), kh, vh, -kk, kk * ah)
    mean = jnp.mean(y, axis=-1, keepdims=True)
    var = jnp.mean(jnp.square(y - mean), axis=-1, keepdims=True)
    y = ((y - mean) * lax.rsqrt(var + GN_EPS)).reshape(bsz, t_len, RWKV_WIDTH) * gn_g + gn_b
    y = y + (jnp.sum(rh * kh * rk, axis=-1, keepdims=True) * vh).reshape(bsz, t_len, RWKV_WIDTH)
    return y.astype(out_dtype), v_first


def setup_inputs(seed: int = 0) -> dict:
    key = jax.random.key(seed)
    ks = jax.random.split(key, 24)
    L = DEPTH
    nrm = lambda k, shape, s: jax.random.normal(k, shape, jnp.float32) * s
    return {
        'x': nrm(ks[0], (BATCH, SEQ, D_MODEL), 1.0),
        'pre_norm_g': 1.0 + nrm(ks[1], (L, D_MODEL), 0.02),
        'post_norm_g': 1.0 + nrm(ks[2], (L, D_MODEL), 0.02),
        'w_in': nrm(ks[3], (L, D_MODEL, D_IN), D_MODEL ** -0.5),
        'w_out': nrm(ks[4], (L, D_MIX, D_MODEL), D_MIX ** -0.5),
        'conv_dw': nrm(ks[5], (L, CONV_TAPS, CONV_WIDTH), CONV_TAPS ** -0.5),
        'conv_dw_b': nrm(ks[6], (L, CONV_WIDTH), 0.02),
        'conv_ln_g': 1.0 + nrm(ks[7], (L, CONV_WIDTH), 0.02),
        'conv_ln_b': nrm(ks[8], (L, CONV_WIDTH), 0.02),
        'conv_pw': nrm(ks[9], (L, CONV_WIDTH, CONV_WIDTH), CONV_WIDTH ** -0.5),
        'conv_pw_b': nrm(ks[10], (L, CONV_WIDTH), 0.02),
        'rwkv_mu': jax.random.uniform(ks[11], (L, SHIFT_WIDTH), jnp.float32),
        'rwkv_w0': jax.random.uniform(ks[12], (L, RWKV_WIDTH), jnp.float32, minval=-4.0, maxval=0.0),
        'rwkv_w2': nrm(ks[13], (L, DECAY_LORA, RWKV_WIDTH), 0.1),
        'rwkv_a0': nrm(ks[14], (L, RWKV_WIDTH), 0.1),
        'rwkv_a2': nrm(ks[15], (L, ICLR_LORA, RWKV_WIDTH), 0.1),
        'rwkv_kk_scale': 0.85 + nrm(ks[16], (L, RWKV_WIDTH), 0.05),
        'rwkv_ka': 1.0 + nrm(ks[17], (L, RWKV_WIDTH), 0.05),
        'rwkv_rk': nrm(ks[18], (L, RWKV_HEADS, HEAD_DIM), 0.1),
        'rwkv_gn_g': 1.0 + nrm(ks[19], (L, RWKV_WIDTH), 0.02),
        'rwkv_gn_b': nrm(ks[20], (L, RWKV_WIDTH), 0.02),
        'rwkv_v0': nrm(ks[21], (L - 1, RWKV_WIDTH), 0.1),
        'rwkv_v1': nrm(ks[22], (L - 1, RWKV_WIDTH, VRES_LORA), RWKV_WIDTH ** -0.5),
        'rwkv_v2': nrm(ks[23], (L - 1, VRES_LORA, RWKV_WIDTH), 0.1),
    }


def reference(x, pre_norm_g, post_norm_g, w_in, w_out, conv_dw, conv_dw_b, conv_ln_g, conv_ln_b,
              conv_pw, conv_pw_b, rwkv_mu, rwkv_w0, rwkv_w2, rwkv_a0, rwkv_a2, rwkv_kk_scale, rwkv_ka,
              rwkv_rk, rwkv_gn_g, rwkv_gn_b, rwkv_v0, rwkv_v1, rwkv_v2):
    v_first = None
    for l in range(DEPTH):
        h = rms_norm(x, pre_norm_g[l])
        p = h @ w_in[l]
        (glu_a, glu_b, g_conv, q, k, v, g_sb, r_r, r_k, r_v, w_d, a_d, g_rwkv) = _split_cols(p, IN_WIDTHS)
        y_conv = conformer_conv(glu_a, glu_b, conv_dw[l], conv_dw_b[l], conv_ln_g[l], conv_ln_b[l],
                                conv_pw[l], conv_pw_b[l])
        y_sb = stick_breaking_attention(_heads(q, SB_HEADS), _heads(k, SB_HEADS), _heads(v, SB_HEADS))
        v_res = None if l == 0 else (rwkv_v0[l - 1], rwkv_v1[l - 1], rwkv_v2[l - 1])
        y_rwkv, v_first = rwkv7_time_mix(r_r, r_k, r_v, w_d, a_d, rwkv_mu[l], rwkv_w0[l], rwkv_w2[l],
                                         rwkv_a0[l], rwkv_a2[l], rwkv_kk_scale[l], rwkv_ka[l], rwkv_rk[l],
                                         rwkv_gn_g[l], rwkv_gn_b[l], v_first, v_res)
        mix = jnp.concatenate([y_conv * jax.nn.silu(g_conv),
                               y_sb * jax.nn.silu(g_sb),
                               y_rwkv * jax.nn.silu(g_rwkv)], axis=-1)
        x = x + rms_norm(mix @ w_out[l], post_norm_g[l])
    return x
```

```cpp
#include <hip/hip_runtime.h>
#include <hip/hip_cooperative_groups.h>
#include <cstdio>
#include <cstdint>
namespace cg = cooperative_groups;

#ifndef MK_COOP
#define MK_COOP 0
#endif

constexpr int BATCH = 16, SEQ = 2048, DM = 1024, DEPTH = 2;
constexpr int M = BATCH * SEQ;
constexpr int HD = 64, NH = 6;
constexpr int CW = 256, SBW = 384, RWW = 384, LORA = 32, TAPS = 31;
constexpr int DIN = 3904;
constexpr int NINT = 4096;
constexpr int PC_W = 768, PS_W = 1536, PR_W = 1280, PG_W = 384;
constexpr float RMS_EPS = 1e-6f, LN_EPS = 1e-5f, GN_EPS = 64e-5f;

typedef unsigned short bf16_t;
typedef short bf16x8 __attribute__((ext_vector_type(8)));
typedef float f32x4 __attribute__((ext_vector_type(4)));
typedef unsigned short us4 __attribute__((ext_vector_type(4)));

constexpr size_t MiB = 1u << 20;
constexpr size_t WS_CTL = 0;
constexpr size_t WS_WIN = 1 * MiB;
constexpr size_t WS_WOUT = 17 * MiB;
constexpr size_t WS_XB = 21 * MiB;
constexpr size_t WS_MIX = WS_XB;
constexpr size_t WS_PC = 85 * MiB;
constexpr size_t WS_PS = 133 * MiB;
constexpr size_t WS_Y = WS_PC;
constexpr size_t WS_PR = 229 * MiB;
constexpr size_t WS_PG = 309 * MiB;
constexpr size_t WS_VF = 333 * MiB;
constexpr size_t WS_END = 381 * MiB;

struct Params {
    const float* in[24];
    float* out;
    unsigned char* ws;
    int ph_lo, ph_hi;
};

__device__ __forceinline__ float bf2f(bf16_t v) { return __uint_as_float(((unsigned)v) << 16); }
__device__ __forceinline__ bf16_t f2bf(float f) { unsigned u = __float_as_uint(f); return (bf16_t)((u + 0x7fffu + ((u >> 16) & 1u)) >> 16); }
__device__ __forceinline__ unsigned pk2(float lo, float hi) { return (unsigned)f2bf(lo) | ((unsigned)f2bf(hi) << 16); }
__device__ __forceinline__ float wave_sum(float v) {
#pragma unroll
    for (int o = 1; o < 64; o <<= 1) v += __shfl_xor(v, o);
    return v;
}
__device__ __forceinline__ float sigmoidf_(float x) { return 1.0f / (1.0f + __expf(-x)); }
__device__ __forceinline__ float siluf_(float x) { return x / (1.0f + __expf(-x)); }
__device__ __forceinline__ int tid_() { int t = threadIdx.x; asm volatile("" : "+v"(t)); return t; }
__device__ __forceinline__ int opaque_zero() { int z = 0; asm volatile("" : "+v"(z)); return z; }

__device__ __forceinline__ int orig_col(int n) { return n < 3520 ? n : (n < 3584 ? -1 : (n < 3968 ? n - 64 : -1)); }

__device__ void transpose_tile(const float* W, int ldw, int ncol_src, const float* gain, bf16_t* WT, int K, int n0, int k0, bool permute, float* tile  ) {
    const int tid = tid_();
#pragma unroll
    for (int i = 0; i < 8; ++i) {
        const int kl = (tid >> 6) + 8 * i, nl = tid & 63;
        const int n = n0 + nl, k = k0 + kl;
        const int oc = permute ? orig_col(n) : n;
        float v = 0.f;
        if (oc >= 0 && oc < ncol_src) v = W[(size_t)k * ldw + oc] * (gain ? gain[k] : 1.0f);
        tile[kl * 65 + nl] = v;
    }
    __syncthreads();
#pragma unroll
    for (int i = 0; i < 8; ++i) {
        const int nl = (tid >> 6) + 8 * i, kl = tid & 63;
        WT[(size_t)(n0 + nl) * K + k0 + kl] = f2bf(tile[kl * 65 + nl]);
    }
    __syncthreads();
}

__device__ void rows_to_xb(const float* X, bf16_t* XB) {
    const int tid = tid_(), lane = tid & 63, wave = tid >> 6;
    for (int row = blockIdx.x * 8 + wave; row < M; row += gridDim.x * 8) {
        const float* xr = X + (size_t)row * DM;
        f32x4 v[4]; float ss = 0.f;
#pragma unroll
        for (int i = 0; i < 4; ++i) { v[i] = *(const f32x4*)(xr + i * 256 + lane * 4); ss += v[i][0] * v[i][0] + v[i][1] * v[i][1] + v[i][2] * v[i][2] + v[i][3] * v[i][3]; }
        ss = wave_sum(ss);
        const float rstd = rsqrtf(ss * (1.0f / DM) + RMS_EPS);
#pragma unroll
        for (int i = 0; i < 4; ++i) { uint2 w; w.x = pk2(v[i][0] * rstd, v[i][1] * rstd); w.y = pk2(v[i][2] * rstd, v[i][3] * rstd); *(uint2*)(XB + (size_t)row * DM + i * 256 + lane * 4) = w; }
    }
}

__device__ void phase_prologue(const Params& p, unsigned char* lds) {
    float* tile = (float*)lds;
    bf16_t* WinT = (bf16_t*)(p.ws + WS_WIN); bf16_t* WoutT = (bf16_t*)(p.ws + WS_WOUT);
    const int nt_in = (NINT / 64) * (DM / 64), nt_out = (DM / 64) * (DM / 64);
    const int total = DEPTH * (nt_in + nt_out);
    for (int j = blockIdx.x; j < total; j += gridDim.x) {
        int l = j / (nt_in + nt_out), r = j % (nt_in + nt_out);
        if (r < nt_in) { const int tn = r / (DM / 64), tk = r % (DM / 64);
            transpose_tile(p.in[3] + (size_t)l * DM * DIN, DIN, DIN, p.in[1] + l * DM, WinT + (size_t)l * NINT * DM, DM, tn * 64, tk * 64, true, tile);
        } else { r -= nt_in; const int tn = r / (DM / 64), tk = r % (DM / 64);
            transpose_tile(p.in[4] + (size_t)l * DM * DM, DM, DM, nullptr, WoutT + (size_t)l * DM * DM, DM, tn * 64, tk * 64, false, tile);
        }
    }
    rows_to_xb(p.in[0], (bf16_t*)(p.ws + WS_XB));
}

template <class Epi>
__device__ void gemm_simple(const bf16_t* A, const bf16_t* Bt, int Mr, int N, int K, const Epi& epi) {
    const int tid = tid_(), wave = tid >> 6, lane = tid & 63, wm = wave >> 1, wn = wave & 1, fr = lane & 15, fq = lane >> 4;
    const int nNt = N / 128, nMt = Mr / 128;
    for (int tile = blockIdx.x; tile < nNt * nMt; tile += gridDim.x) {
        const int tm = tile / nNt, tn = tile % nNt;
        const int m0 = tm * 128 + wm * 32, n0 = tn * 128 + wn * 64;
        f32x4 acc[2][4];
#pragma unroll
        for (int i = 0; i < 2; ++i)
#pragma unroll
            for (int j = 0; j < 4; ++j) acc[i][j] = (f32x4){0.f, 0.f, 0.f, 0.f};
        const bf16_t* ap = A + (size_t)(m0 + fr) * K + fq * 8;
        const bf16_t* bp = Bt + (size_t)(n0 + fr) * K + fq * 8;
        for (int k = 0; k < K; k += 32) {
            bf16x8 af[2], bfr[4];
#pragma unroll
            for (int i = 0; i < 2; ++i) af[i] = *(const bf16x8*)(ap + (size_t)i * 16 * K + k);
#pragma unroll
            for (int j = 0; j < 4; ++j) bfr[j] = *(const bf16x8*)(bp + (size_t)j * 16 * K + k);
#pragma unroll
            for (int i = 0; i < 2; ++i)
#pragma unroll
                for (int j = 0; j < 4; ++j) acc[i][j] = __builtin_amdgcn_mfma_f32_16x16x32_bf16(bfr[j], af[i], acc[i][j], 0, 0, 0);
        }
#pragma unroll
        for (int i = 0; i < 2; ++i)
#pragma unroll
            for (int j = 0; j < 4; ++j) epi(m0 + i * 16 + fr, n0 + j * 16 + fq * 4, acc[i][j]);
    }
}

struct EpiInProj {
    bf16_t *PC, *PS, *PR, *PG;
    __device__ __forceinline__ void operator()(int m, int n, const f32x4& v) const {
        bf16_t* dst;
        if (n < 768) dst = PC + (size_t)m * PC_W + n;
        else if (n < 2304) dst = PS + (size_t)m * PS_W + (n - 768);
        else if (n < 3584) dst = PR + (size_t)m * PR_W + (n - 2304);
        else if (n < 3968) dst = PG + (size_t)m * PG_W + (n - 3584);
        else return;
        uint2 w; w.x = pk2(v[0], v[1]); w.y = pk2(v[2], v[3]); *(uint2*)dst = w;
    }
};
struct EpiF32 {
    float* Y; int ld;
    __device__ __forceinline__ void operator()(int m, int n, const f32x4& v) const { *(f32x4*)(Y + (size_t)m * ld + n) = v; }
};

__device__ void phase_rowpass(const float* Xin, const float* Y, const float* gpost, float* Xout, bf16_t* XB) {
    const int tid = tid_(), lane = tid & 63, wave = tid >> 6;
    for (int row = blockIdx.x * 8 + wave; row < M; row += gridDim.x * 8) {
        f32x4 y[4], x[4]; float ss = 0.f;
#pragma unroll
        for (int i = 0; i < 4; ++i) { y[i] = *(const f32x4*)(Y + (size_t)row * DM + i * 256 + lane * 4); x[i] = *(const f32x4*)(Xin + (size_t)row * DM + i * 256 + lane * 4);
            ss += y[i][0] * y[i][0] + y[i][1] * y[i][1] + y[i][2] * y[i][2] + y[i][3] * y[i][3]; }
        ss = wave_sum(ss);
        const float rstd = rsqrtf(ss * (1.0f / DM) + RMS_EPS);
        float s2 = 0.f;
#pragma unroll
        for (int i = 0; i < 4; ++i) { const f32x4 g = *(const f32x4*)(gpost + i * 256 + lane * 4);
            x[i] = x[i] + y[i] * rstd * g; s2 += x[i][0] * x[i][0] + x[i][1] * x[i][1] + x[i][2] * x[i][2] + x[i][3] * x[i][3];
            *(f32x4*)(Xout + (size_t)row * DM + i * 256 + lane * 4) = x[i]; }
        if (XB) {
            s2 = wave_sum(s2);
            const float r2 = rsqrtf(s2 * (1.0f / DM) + RMS_EPS);
#pragma unroll
            for (int i = 0; i < 4; ++i) { uint2 w; w.x = pk2(x[i][0] * r2, x[i][1] * r2); w.y = pk2(x[i][2] * r2, x[i][3] * r2); *(uint2*)(XB + (size_t)row * DM + i * 256 + lane * 4) = w; }
        }
    }
}

__device__ void conv_job(const Params& p, int l, int job, float* lds) {
    const int tid = tid_(), lane = tid & 63, wave = tid >> 6;
    const int b = job / (SEQ / 32), t0 = (job % (SEQ / 32)) * 32;
    const bf16_t* PC = (const bf16_t*)(p.ws + WS_PC); bf16_t* MIX = (bf16_t*)(p.ws + WS_MIX);
    const float* dw = p.in[5] + l * TAPS * CW; const float* dwb = p.in[6] + l * CW; const float* lng = p.in[7] + l * CW; const float* lnb = p.in[8] + l * CW;
    const float* pw = p.in[9] + (size_t)l * CW * CW; const float* pwb = p.in[10] + l * CW;
    float* u = lds;
    float* cv = lds + 62 * 256;
    for (int idx = tid; idx < 62 * 256; idx += 512) {
        const int r = idx >> 8, c = idx & 255, t = t0 - 30 + r;
        float v = 0.f;
        if (t >= 0) { const bf16_t* pr = PC + (size_t)(b * SEQ + t) * PC_W; v = bf2f(pr[c]) * sigmoidf_(bf2f(pr[256 + c])); }
        u[idx] = v;
    }
    __syncthreads();
    for (int idx = tid; idx < 32 * 256; idx += 512) {
        const int tt = idx >> 8, c = idx & 255;
        float a = dwb[c];
#pragma unroll 4
        for (int j = 0; j < TAPS; ++j) a += dw[j * CW + c] * u[(tt + j) * 256 + c];
        cv[idx] = a;
    }
    __syncthreads();
    for (int q = 0; q < 4; ++q) {
        const int tt = wave * 4 + q; float x[4], s = 0.f;
#pragma unroll
        for (int i = 0; i < 4; ++i) { x[i] = cv[tt * 256 + lane + 64 * i]; s += x[i]; }
        const float mean = wave_sum(s) * (1.0f / CW); float vs = 0.f;
#pragma unroll
        for (int i = 0; i < 4; ++i) { const float d = x[i] - mean; vs += d * d; }
        const float rstd = rsqrtf(wave_sum(vs) * (1.0f / CW) + LN_EPS);
#pragma unroll
        for (int i = 0; i < 4; ++i) { const int c = lane + 64 * i; cv[tt * 256 + c] = siluf_((x[i] - mean) * rstd * lng[c] + lnb[c]); }
    }
    __syncthreads();
    {
        const int n = tid & 255, half = tid >> 8;
        float acc[16];
#pragma unroll
        for (int i = 0; i < 16; ++i) acc[i] = pwb[n];
#pragma unroll 2
        for (int k = 0; k < CW; ++k) {
            const float w = pw[(size_t)k * CW + n];
#pragma unroll
            for (int i = 0; i < 16; ++i) acc[i] += cv[(half * 16 + i) * 256 + k] * w;
        }
#pragma unroll
        for (int i = 0; i < 16; ++i) { const size_t row = (size_t)b * SEQ + t0 + half * 16 + i;
            const float g = bf2f(PC[row * PC_W + 512 + n]);
            MIX[row * DM + n] = f2bf(acc[i] * siluf_(g)); }
    }
    __syncthreads();
}

__device__ void attn_job(const Params& p, int job) {
    const int tid = tid_(), lane = tid & 63, wave = tid >> 6;
    const int bh = job >> 2, qb = job & 3, b = bh / NH, h = bh % NH;
    const bf16_t* PS = (const bf16_t*)(p.ws + WS_PS); bf16_t* MIX = (bf16_t*)(p.ws + WS_MIX);
    const int tw = qb * 512 + wave * 64, t = tw + lane;
    const size_t row = (size_t)b * SEQ + t;
    const float qs = 0.125f * 1.4426950408889634f;
    float q[64], o[64];
    {
        const bf16_t* qp = PS + row * PS_W + h * HD;
#pragma unroll
        for (int i = 0; i < 8; ++i) { const bf16x8 v = *(const bf16x8*)(qp + i * 8);
#pragma unroll
            for (int j = 0; j < 8; ++j) { q[i * 8 + j] = bf2f((bf16_t)v[j]) * qs; o[i * 8 + j] = 0.f; } }
    }
    float rp = 1.0f;
    const int z = opaque_zero();
    for (int s = tw + 62; s >= 0; --s) {
        const bf16_t* kp = PS + ((size_t)b * SEQ + s) * PS_W + 384 + h * HD + z;
        float dot = 0.f;
#pragma unroll
        for (int i = 0; i < 8; ++i) { const bf16x8 v = *(const bf16x8*)(kp + i * 8);
#pragma unroll
            for (int j = 0; j < 8; ++j) dot += q[i * 8 + j] * bf2f((bf16_t)v[j]); }
        const bool act = s < t;
        const float e = __builtin_amdgcn_exp2f(dot);
        const float keep = __builtin_amdgcn_rcpf(1.0f + e);
        const float pr = act ? (1.0f - keep) * rp : 0.f;
        rp = act ? rp * keep : rp;
        const bf16_t* vp = kp + 384;
#pragma unroll
        for (int i = 0; i < 8; ++i) { const bf16x8 v = *(const bf16x8*)(vp + i * 8);
#pragma unroll
            for (int j = 0; j < 8; ++j) o[i * 8 + j] += pr * bf2f((bf16_t)v[j]); }
        if (__all(rp == 0.0f)) break;
    }
    const bf16_t* gp = PS + row * PS_W + 1152 + h * HD;
    bf16_t* op = MIX + row * DM + CW + h * HD;
#pragma unroll
    for (int i = 0; i < 8; ++i) { const bf16x8 g = *(const bf16x8*)(gp + i * 8); uint4 w;
        w.x = pk2(o[i * 8 + 0] * siluf_(bf2f((bf16_t)g[0])), o[i * 8 + 1] * siluf_(bf2f((bf16_t)g[1])));
        w.y = pk2(o[i * 8 + 2] * siluf_(bf2f((bf16_t)g[2])), o[i * 8 + 3] * siluf_(bf2f((bf16_t)g[3])));
        w.z = pk2(o[i * 8 + 4] * siluf_(bf2f((bf16_t)g[4])), o[i * 8 + 5] * siluf_(bf2f((bf16_t)g[5])));
        w.w = pk2(o[i * 8 + 6] * siluf_(bf2f((bf16_t)g[6])), o[i * 8 + 7] * siluf_(bf2f((bf16_t)g[7])));
        *(uint4*)(op + i * 8) = w; }
}

__device__ void rwkv_job(const Params& p, int l, int job, float* lds) {
    const int tid = tid_(), lane = tid & 63, wave = tid >> 6;
    const int b = job / NH, h = job % NH;
    const bf16_t* PR = (const bf16_t*)(p.ws + WS_PR); const bf16_t* PG = (const bf16_t*)(p.ws + WS_PG);
    float* VF = (float*)(p.ws + WS_VF); bf16_t* MIX = (bf16_t*)(p.ws + WS_MIX);
    const float* mu = p.in[11] + l * 1216; const float* w0 = p.in[12] + l * RWW; const float* w2 = p.in[13] + l * LORA * RWW;
    const float* a0 = p.in[14] + l * RWW; const float* a2 = p.in[15] + l * LORA * RWW; const float* kks = p.in[16] + l * RWW; const float* ka = p.in[17] + l * RWW;
    const float* rk = p.in[18] + l * RWW; const float* gng = p.in[19] + l * RWW; const float* gnb = p.in[20] + l * RWW;
    const float* v0 = p.in[21]; const float* v1 = p.in[22]; const float* v2 = p.in[23];
    float* R = lds; float* W = R + 4096; float* K = W + 4096; float* V = K + 4096; float* A = V + 4096; float* Bm = A + 4096; float* Y = Bm + 4096;
    float* WD = Y + 4096; float* AD = WD + 2048; float* VL = AD + 2048;
    float S[64];
#pragma unroll
    for (int i = 0; i < 64; ++i) S[i] = 0.f;
    for (int c = 0; c < SEQ / 64; ++c) {
        const int t0 = c * 64;
        for (int idx = tid; idx < 64 * 64; idx += 512) {
            const int tt = idx >> 6, i = idx & 63, t = t0 + tt;
            const bf16_t* cur = PR + ((size_t)b * SEQ + t) * PR_W;
            const float xc = bf2f(cur[1152 + i]), xp = t > 0 ? bf2f(cur[1152 + i - PR_W]) : 0.f;
            const float f = xc + (xp - xc) * mu[1152 + i];
            if (i < 32) WD[tt * 32 + i] = tanhf(f); else AD[tt * 32 + i - 32] = f;
        }
        if (l > 0) {
            for (int idx = tid; idx < 64 * 32; idx += 512) {
                const int tt = idx >> 5, i = idx & 31, t = t0 + tt;
                const bf16_t* cur = PR + ((size_t)b * SEQ + t) * PR_W + 768;
                float a = 0.f;
                for (int cc = 0; cc < RWW; ++cc) {
                    const float xc = bf2f(cur[cc]), xp = t > 0 ? bf2f(cur[cc - PR_W]) : 0.f;
                    a += (xc + (xp - xc) * mu[768 + cc]) * v1[cc * LORA + i];
                }
                VL[idx] = a;
            }
        }
        __syncthreads();
        for (int idx = tid; idx < 64 * 64; idx += 512) {
            const int tt = idx >> 6, j = idx & 63, t = t0 + tt, cj = h * HD + j;
            const size_t row = (size_t)b * SEQ + t;
            const bf16_t* cur = PR + row * PR_W;
            const bool hp = t > 0;
            float rc = bf2f(cur[cj]), kc = bf2f(cur[384 + cj]), vc = bf2f(cur[768 + cj]);
            const float rp_ = hp ? bf2f(cur[cj - PR_W]) : 0.f, kp_ = hp ? bf2f(cur[384 + cj - PR_W]) : 0.f, vp_ = hp ? bf2f(cur[768 + cj - PR_W]) : 0.f;
            rc += (rp_ - rc) * mu[cj]; kc += (kp_ - kc) * mu[384 + cj]; vc += (vp_ - vc) * mu[768 + cj];
            float wl = w0[cj], al = a0[cj];
#pragma unroll 8
            for (int i = 0; i < LORA; ++i) { wl += WD[tt * 32 + i] * w2[i * RWW + cj]; al += AD[tt * 32 + i] * a2[i * RWW + cj]; }
            const float sp = fmaxf(-wl, 0.f) + log1pf(__expf(-fabsf(wl)));
            const float decay = __expf(-__expf(-sp - 0.5f));
            const float alr = sigmoidf_(al);
            if (l > 0) {
                float vg = v0[cj];
#pragma unroll 8
                for (int i = 0; i < LORA; ++i) vg += VL[tt * 32 + i] * v2[i * RWW + cj];
                vg = sigmoidf_(vg);
                vc = vc + (VF[row * RWW + cj] - vc) * vg;
            } else VF[row * RWW + cj] = vc;
            R[idx] = rc; W[idx] = decay; V[idx] = vc;
            K[idx] = kc * (1.0f + (alr - 1.0f) * ka[cj]);
            A[idx] = kc * kks[cj];
            Bm[idx] = alr;
        }
        __syncthreads();
        for (int q = 0; q < 8; ++q) {
            const int tt = wave * 8 + q; const float kk = A[tt * 64 + lane];
            const float nrm = sqrtf(wave_sum(kk * kk));
            const float kn = kk / fmaxf(nrm, 1e-12f);
            A[tt * 64 + lane] = -kn; Bm[tt * 64 + lane] = kn * Bm[tt * 64 + lane];
        }
        __syncthreads();
        if (wave == 0) {
            for (int tt = 0; tt < 64; ++tt) {
                const f32x4* a4 = (const f32x4*)(A + tt * 64); const f32x4* w4 = (const f32x4*)(W + tt * 64); const f32x4* b4 = (const f32x4*)(Bm + tt * 64);
                const f32x4* k4 = (const f32x4*)(K + tt * 64); const f32x4* r4 = (const f32x4*)(R + tt * 64);
                float sa = 0.f;
#pragma unroll
                for (int i = 0; i < 16; ++i) { const f32x4 a = a4[i]; sa += S[4 * i] * a[0] + S[4 * i + 1] * a[1] + S[4 * i + 2] * a[2] + S[4 * i + 3] * a[3];
                    if ((i & 7) == 7) asm volatile("" ::: "memory"); }
                const float vv = V[tt * 64 + lane];
                float y = 0.f;
#pragma unroll
                for (int i = 0; i < 16; ++i) { const f32x4 w = w4[i], bb = b4[i], kk = k4[i], rr = r4[i];
#pragma unroll
                    for (int e = 0; e < 4; ++e) { const float s = S[4 * i + e] * w[e] + sa * bb[e] + vv * kk[e]; S[4 * i + e] = s; y += s * rr[e]; }
                    if ((i & 1) == 1) asm volatile("" ::: "memory"); }
                Y[tt * 64 + lane] = y;
            }
        }
        __syncthreads();
        for (int q = 0; q < 8; ++q) {
            const int tt = wave * 8 + q, t = t0 + tt, cj = h * HD + lane; const size_t row = (size_t)b * SEQ + t;
            const float y = Y[tt * 64 + lane];
            const float mean = wave_sum(y) * (1.0f / HD); const float d = y - mean;
            const float var = wave_sum(d * d) * (1.0f / HD);
            const float yn = d * rsqrtf(var + GN_EPS) * gng[cj] + gnb[cj];
            const float bonus = wave_sum(R[tt * 64 + lane] * K[tt * 64 + lane] * rk[cj]);
            const float o = yn + bonus * V[tt * 64 + lane];
            const float g = bf2f(PG[row * PG_W + cj]);
            MIX[row * DM + CW + SBW + cj] = f2bf(o * siluf_(g));
        }
        __syncthreads();
    }
}

__device__ void phase_mixers(const Params& p, int l, unsigned char* lds) {
    constexpr int NRW = BATCH * NH, NAT = BATCH * NH * 4, NCV = BATCH * (SEQ / 32);
    const int G = gridDim.x;
    for (int job = blockIdx.x; job < NRW; job += G) rwkv_job(p, l, job, (float*)lds);
    const int start = (blockIdx.x + G - (NRW % G)) % G;
    for (int job = start; job < NAT; job += G) attn_job(p, job);
    for (int job = start; job < NCV; job += G) conv_job(p, l, job, (float*)lds);
}

constexpr int N_PHASES = 1 + 4 * DEPTH;
__device__ __forceinline__ void run_phase(const Params& p, int ph, unsigned char* lds) {
    unsigned char* ws = p.ws;
    if (ph == 0) { phase_prologue(p, lds); return; }
    const int l = (ph - 1) >> 2, k = (ph - 1) & 3;
    if (k == 0) {
        EpiInProj E{(bf16_t*)(ws + WS_PC), (bf16_t*)(ws + WS_PS), (bf16_t*)(ws + WS_PR), (bf16_t*)(ws + WS_PG)};
        gemm_simple((const bf16_t*)(ws + WS_XB), (const bf16_t*)(ws + WS_WIN) + (size_t)l * NINT * DM, M, NINT, DM, E);
    } else if (k == 1) {
        phase_mixers(p, l, lds);
    } else if (k == 2) {
        EpiF32 E{(float*)(ws + WS_Y), DM};
        gemm_simple((const bf16_t*)(ws + WS_MIX), (const bf16_t*)(ws + WS_WOUT) + (size_t)l * DM * DM, M, DM, DM, E);
    } else {
        phase_rowpass(l == 0 ? p.in[0] : p.out, (const float*)(ws + WS_Y), p.in[2] + l * DM, p.out, l + 1 < DEPTH ? (bf16_t*)(ws + WS_XB) : nullptr);
    }
}

constexpr int LDS_BYTES = 147456;

#if MK_COOP
__global__ void __launch_bounds__(512, 2) fwd_kernel(Params p) {
    extern __shared__ __attribute__((aligned(16))) unsigned char lds[];
    cg::grid_group grid = cg::this_grid();
    for (int ph = p.ph_lo; ph < p.ph_hi; ++ph) {
        run_phase(p, ph, lds);
        if (ph + 1 < p.ph_hi) grid.sync();
    }
}
#else
__global__ void __launch_bounds__(512, 2) fwd_kernel(Params p) {
    extern __shared__ __attribute__((aligned(16))) unsigned char lds[];
    for (int ph = p.ph_lo; ph < p.ph_hi; ++ph) run_phase(p, ph, lds);
}
#endif

extern "C" void kernel_launch(void* const* d_in, const int* in_sizes, int n_in, void* d_out, int out_size, void* d_ws, size_t ws_size, hipStream_t stream) {
    static int grid = 0;
    if (grid == 0) {
        if (n_in != 24 || out_size != M * DM || ws_size < WS_END) { fprintf(stderr, "kernel_launch: unexpected problem (n_in %d out %d ws %zu)\n", n_in, out_size, ws_size); grid = -1; return; }
        int dev = 0, cus = 0, per_cu = 0;
        hipGetDevice(&dev); hipDeviceGetAttribute(&cus, hipDeviceAttributeMultiprocessorCount, dev);
        hipFuncSetAttribute((const void*)fwd_kernel, hipFuncAttributeMaxDynamicSharedMemorySize, LDS_BYTES);
        hipOccupancyMaxActiveBlocksPerMultiprocessor(&per_cu, (const void*)fwd_kernel, 512, LDS_BYTES);
        if (per_cu < 1) { fprintf(stderr, "kernel_launch: occupancy query says %d blocks per CU\n", per_cu); per_cu = 1; }
        grid = cus;
        (void)hipGetLastError();
    }
    if (grid < 0) return;
    Params p{};
    for (int i = 0; i < 24; ++i) p.in[i] = (const float*)d_in[i];
    p.out = (float*)d_out; p.ws = (unsigned char*)d_ws;
#if MK_COOP
    p.ph_lo = 0; p.ph_hi = N_PHASES;
    void* args[] = {&p};
    hipError_t e = hipLaunchCooperativeKernel((const void*)fwd_kernel, dim3(grid), dim3(512), args, LDS_BYTES, stream);
    if (e != hipSuccess) fprintf(stderr, "cooperative launch failed: %s (grid %d)\n", hipGetErrorString(e), grid);
#else
    for (int ph = 0; ph < N_PHASES; ++ph) {
        p.ph_lo = ph; p.ph_hi = ph + 1;
        hipLaunchKernelGGL(fwd_kernel, dim3(grid), dim3(512), LDS_BYTES, stream, p);
    }
#endif
}
```

```cpp
#include <hip/hip_runtime.h>
#include <hip/hip_cooperative_groups.h>
#include <cstdio>
#include <cstdint>
namespace cg = cooperative_groups;

#ifndef MK_COOP
#define MK_COOP 1
#endif

constexpr int BATCH = 16, SEQ = 2048, DM = 1024, DEPTH = 2;
constexpr int M = BATCH * SEQ;
constexpr int HD = 64, NH = 6;
constexpr int CW = 256, SBW = 384, RWW = 384, LORA = 32, TAPS = 31;
constexpr int DIN = 3904;
constexpr int NINT = 4096;
constexpr int PC_W = 768, PS_W = 1536, PR_W = 1280, PG_W = 384;
constexpr float RMS_EPS = 1e-6f, LN_EPS = 1e-5f, GN_EPS = 64e-5f;

typedef unsigned short bf16_t;
typedef short bf16x8 __attribute__((ext_vector_type(8)));
typedef float f32x4 __attribute__((ext_vector_type(4)));
typedef unsigned short us4 __attribute__((ext_vector_type(4)));

constexpr size_t MiB = 1u << 20;
constexpr size_t WS_CTL = 0;
constexpr size_t WS_WIN = 1 * MiB;
constexpr size_t WS_WOUT = 17 * MiB;
constexpr size_t WS_XB = 21 * MiB;
constexpr size_t WS_MIX = WS_XB;
constexpr size_t WS_PC = 85 * MiB;
constexpr size_t WS_PS = 133 * MiB;
constexpr size_t WS_Y = WS_PC;
constexpr size_t WS_PR = 229 * MiB;
constexpr size_t WS_PG = 309 * MiB;
constexpr size_t WS_VF = 333 * MiB;
constexpr size_t WS_END = 381 * MiB;

struct Params {
    const float* in[24];
    float* out;
    unsigned char* ws;
    int ph_lo, ph_hi;
};

__device__ __forceinline__ float bf2f(bf16_t v) { return __uint_as_float(((unsigned)v) << 16); }
__device__ __forceinline__ bf16_t f2bf(float f) { unsigned u = __float_as_uint(f); return (bf16_t)((u + 0x7fffu + ((u >> 16) & 1u)) >> 16); }
__device__ __forceinline__ unsigned pk2(float lo, float hi) { return (unsigned)f2bf(lo) | ((unsigned)f2bf(hi) << 16); }
__device__ __forceinline__ float wave_sum(float v) {
#pragma unroll
    for (int o = 1; o < 64; o <<= 1) v += __shfl_xor(v, o);
    return v;
}
__device__ __forceinline__ float sigmoidf_(float x) { return 1.0f / (1.0f + __expf(-x)); }
__device__ __forceinline__ float siluf_(float x) { return x / (1.0f + __expf(-x)); }
__device__ __forceinline__ int tid_() { int t = threadIdx.x; asm volatile("" : "+v"(t)); return t; }
__device__ __forceinline__ int opaque_zero() { int z = 0; asm volatile("" : "+v"(z)); return z; }

__device__ __forceinline__ int orig_col(int n) { return n < 3520 ? n : (n < 3584 ? -1 : (n < 3968 ? n - 64 : -1)); }

__device__ void transpose_tile(const float* W, int ldw, int ncol_src, const float* gain, bf16_t* WT, int K, int n0, int k0, bool permute, float* tile  ) {
    const int tid = tid_();
#pragma unroll
    for (int i = 0; i < 8; ++i) {
        const int kl = (tid >> 6) + 8 * i, nl = tid & 63;
        const int n = n0 + nl, k = k0 + kl;
        const int oc = permute ? orig_col(n) : n;
        float v = 0.f;
        if (oc >= 0 && oc < ncol_src) v = W[(size_t)k * ldw + oc] * (gain ? gain[k] : 1.0f);
        tile[kl * 65 + nl] = v;
    }
    __syncthreads();
#pragma unroll
    for (int i = 0; i < 8; ++i) {
        const int nl = (tid >> 6) + 8 * i, kl = tid & 63;
        WT[(size_t)(n0 + nl) * K + k0 + kl] = f2bf(tile[kl * 65 + nl]);
    }
    __syncthreads();
}

__device__ void rows_to_xb(const float* X, bf16_t* XB) {
    const int tid = tid_(), lane = tid & 63, wave = tid >> 6;
    for (int row = blockIdx.x * 8 + wave; row < M; row += gridDim.x * 8) {
        const float* xr = X + (size_t)row * DM;
        f32x4 v[4]; float ss = 0.f;
#pragma unroll
        for (int i = 0; i < 4; ++i) { v[i] = *(const f32x4*)(xr + i * 256 + lane * 4); ss += v[i][0] * v[i][0] + v[i][1] * v[i][1] + v[i][2] * v[i][2] + v[i][3] * v[i][3]; }
        ss = wave_sum(ss);
        const float rstd = rsqrtf(ss * (1.0f / DM) + RMS_EPS);
#pragma unroll
        for (int i = 0; i < 4; ++i) { uint2 w; w.x = pk2(v[i][0] * rstd, v[i][1] * rstd); w.y = pk2(v[i][2] * rstd, v[i][3] * rstd); *(uint2*)(XB + (size_t)row * DM + i * 256 + lane * 4) = w; }
    }
}

__device__ void phase_prologue(const Params& p, unsigned char* lds) {
    float* tile = (float*)lds;
    bf16_t* WinT = (bf16_t*)(p.ws + WS_WIN); bf16_t* WoutT = (bf16_t*)(p.ws + WS_WOUT);
    const int nt_in = (NINT / 64) * (DM / 64), nt_out = (DM / 64) * (DM / 64);
    const int total = DEPTH * (nt_in + nt_out);
    for (int j = blockIdx.x; j < total; j += gridDim.x) {
        int l = j / (nt_in + nt_out), r = j % (nt_in + nt_out);
        if (r < nt_in) { const int tn = r / (DM / 64), tk = r % (DM / 64);
            transpose_tile(p.in[3] + (size_t)l * DM * DIN, DIN, DIN, p.in[1] + l * DM, WinT + (size_t)l * NINT * DM, DM, tn * 64, tk * 64, true, tile);
        } else { r -= nt_in; const int tn = r / (DM / 64), tk = r % (DM / 64);
            transpose_tile(p.in[4] + (size_t)l * DM * DM, DM, DM, nullptr, WoutT + (size_t)l * DM * DM, DM, tn * 64, tk * 64, false, tile);
        }
    }
    rows_to_xb(p.in[0], (bf16_t*)(p.ws + WS_XB));
}

template <class Epi>
__device__ void gemm_simple(const bf16_t* A, const bf16_t* Bt, int Mr, int N, int K, const Epi& epi) {
    const int tid = tid_(), wave = tid >> 6, lane = tid & 63, wm = wave >> 1, wn = wave & 1, fr = lane & 15, fq = lane >> 4;
    const int nNt = N / 128, nMt = Mr / 128;
    for (int tile = blockIdx.x; tile < nNt * nMt; tile += gridDim.x) {
        const int tm = tile / nNt, tn = tile % nNt;
        const int m0 = tm * 128 + wm * 32, n0 = tn * 128 + wn * 64;
        f32x4 acc[2][4];
#pragma unroll
        for (int i = 0; i < 2; ++i)
#pragma unroll
            for (int j = 0; j < 4; ++j) acc[i][j] = (f32x4){0.f, 0.f, 0.f, 0.f};
        const bf16_t* ap = A + (size_t)(m0 + fr) * K + fq * 8;
        const bf16_t* bp = Bt + (size_t)(n0 + fr) * K + fq * 8;
        for (int k = 0; k < K; k += 32) {
            bf16x8 af[2], bfr[4];
#pragma unroll
            for (int i = 0; i < 2; ++i) af[i] = *(const bf16x8*)(ap + (size_t)i * 16 * K + k);
#pragma unroll
            for (int j = 0; j < 4; ++j) bfr[j] = *(const bf16x8*)(bp + (size_t)j * 16 * K + k);
#pragma unroll
            for (int i = 0; i < 2; ++i)
#pragma unroll
                for (int j = 0; j < 4; ++j) acc[i][j] = __builtin_amdgcn_mfma_f32_16x16x32_bf16(bfr[j], af[i], acc[i][j], 0, 0, 0);
        }
#pragma unroll
        for (int i = 0; i < 2; ++i)
#pragma unroll
            for (int j = 0; j < 4; ++j) epi(m0 + i * 16 + fr, n0 + j * 16 + fq * 4, acc[i][j]);
    }
}

struct EpiInProj {
    bf16_t *PC, *PS, *PR, *PG;
    __device__ __forceinline__ void operator()(int m, int n, const f32x4& v) const {
        bf16_t* dst;
        if (n < 768) dst = PC + (size_t)m * PC_W + n;
        else if (n < 2304) dst = PS + (size_t)m * PS_W + (n - 768);
        else if (n < 3584) dst = PR + (size_t)m * PR_W + (n - 2304);
        else if (n < 3968) dst = PG + (size_t)m * PG_W + (n - 3584);
        else return;
        uint2 w; w.x = pk2(v[0], v[1]); w.y = pk2(v[2], v[3]); *(uint2*)dst = w;
    }
};
struct EpiF32 {
    float* Y; int ld;
    __device__ __forceinline__ void operator()(int m, int n, const f32x4& v) const { *(f32x4*)(Y + (size_t)m * ld + n) = v; }
};

__device__ void phase_rowpass(const float* Xin, const float* Y, const float* gpost, float* Xout, bf16_t* XB) {
    const int tid = tid_(), lane = tid & 63, wave = tid >> 6;
    for (int row = blockIdx.x * 8 + wave; row < M; row += gridDim.x * 8) {
        f32x4 y[4], x[4]; float ss = 0.f;
#pragma unroll
        for (int i = 0; i < 4; ++i) { y[i] = *(const f32x4*)(Y + (size_t)row * DM + i * 256 + lane * 4); x[i] = *(const f32x4*)(Xin + (size_t)row * DM + i * 256 + lane * 4);
            ss += y[i][0] * y[i][0] + y[i][1] * y[i][1] + y[i][2] * y[i][2] + y[i][3] * y[i][3]; }
        ss = wave_sum(ss);
        const float rstd = rsqrtf(ss * (1.0f / DM) + RMS_EPS);
        float s2 = 0.f;
#pragma unroll
        for (int i = 0; i < 4; ++i) { const f32x4 g = *(const f32x4*)(gpost + i * 256 + lane * 4);
            x[i] = x[i] + y[i] * rstd * g; s2 += x[i][0] * x[i][0] + x[i][1] * x[i][1] + x[i][2] * x[i][2] + x[i][3] * x[i][3];
            *(f32x4*)(Xout + (size_t)row * DM + i * 256 + lane * 4) = x[i]; }
        if (XB) {
            s2 = wave_sum(s2);
            const float r2 = rsqrtf(s2 * (1.0f / DM) + RMS_EPS);
#pragma unroll
            for (int i = 0; i < 4; ++i) { uint2 w; w.x = pk2(x[i][0] * r2, x[i][1] * r2); w.y = pk2(x[i][2] * r2, x[i][3] * r2); *(uint2*)(XB + (size_t)row * DM + i * 256 + lane * 4) = w; }
        }
    }
}

__device__ void conv_job(const Params& p, int l, int job, float* lds) {
    const int tid = tid_(), lane = tid & 63, wave = tid >> 6;
    const int b = job / (SEQ / 32), t0 = (job % (SEQ / 32)) * 32;
    const bf16_t* PC = (const bf16_t*)(p.ws + WS_PC); bf16_t* MIX = (bf16_t*)(p.ws + WS_MIX);
    const float* dw = p.in[5] + l * TAPS * CW; const float* dwb = p.in[6] + l * CW; const float* lng = p.in[7] + l * CW; const float* lnb = p.in[8] + l * CW;
    const float* pw = p.in[9] + (size_t)l * CW * CW; const float* pwb = p.in[10] + l * CW;
    float* u = lds;
    float* cv = lds + 62 * 256;
    for (int idx = tid; idx < 62 * 256; idx += 512) {
        const int r = idx >> 8, c = idx & 255, t = t0 - 30 + r;
        float v = 0.f;
        if (t >= 0) { const bf16_t* pr = PC + (size_t)(b * SEQ + t) * PC_W; v = bf2f(pr[c]) * sigmoidf_(bf2f(pr[256 + c])); }
        u[idx] = v;
    }
    __syncthreads();
    for (int idx = tid; idx < 32 * 256; idx += 512) {
        const int tt = idx >> 8, c = idx & 255;
        float a = dwb[c];
#pragma unroll 4
        for (int j = 0; j < TAPS; ++j) a += dw[j * CW + c] * u[(tt + j) * 256 + c];
        cv[idx] = a;
    }
    __syncthreads();
    for (int q = 0; q < 4; ++q) {
        const int tt = wave * 4 + q; float x[4], s = 0.f;
#pragma unroll
        for (int i = 0; i < 4; ++i) { x[i] = cv[tt * 256 + lane + 64 * i]; s += x[i]; }
        const float mean = wave_sum(s) * (1.0f / CW); float vs = 0.f;
#pragma unroll
        for (int i = 0; i < 4; ++i) { const float d = x[i] - mean; vs += d * d; }
        const float rstd = rsqrtf(wave_sum(vs) * (1.0f / CW) + LN_EPS);
#pragma unroll
        for (int i = 0; i < 4; ++i) { const int c = lane + 64 * i; cv[tt * 256 + c] = siluf_((x[i] - mean) * rstd * lng[c] + lnb[c]); }
    }
    __syncthreads();
    {
        const int n = tid & 255, half = tid >> 8;
        float acc[16];
#pragma unroll
        for (int i = 0; i < 16; ++i) acc[i] = pwb[n];
#pragma unroll 2
        for (int k = 0; k < CW; ++k) {
            const float w = pw[(size_t)k * CW + n];
#pragma unroll
            for (int i = 0; i < 16; ++i) acc[i] += cv[(half * 16 + i) * 256 + k] * w;
        }
#pragma unroll
        for (int i = 0; i < 16; ++i) { const size_t row = (size_t)b * SEQ + t0 + half * 16 + i;
            const float g = bf2f(PC[row * PC_W + 512 + n]);
            MIX[row * DM + n] = f2bf(acc[i] * siluf_(g)); }
    }
    __syncthreads();
}

__device__ void attn_job(const Params& p, int job) {
    const int tid = tid_(), lane = tid & 63, wave = tid >> 6;
    const int bh = job >> 2, qb = job & 3, b = bh / NH, h = bh % NH;
    const bf16_t* PS = (const bf16_t*)(p.ws + WS_PS); bf16_t* MIX = (bf16_t*)(p.ws + WS_MIX);
    const int tw = qb * 512 + wave * 64, t = tw + lane;
    const size_t row = (size_t)b * SEQ + t;
    const float qs = 0.125f * 1.4426950408889634f;
    float q[64], o[64];
    {
        const bf16_t* qp = PS + row * PS_W + h * HD;
#pragma unroll
        for (int i = 0; i < 8; ++i) { const bf16x8 v = *(const bf16x8*)(qp + i * 8);
#pragma unroll
            for (int j = 0; j < 8; ++j) { q[i * 8 + j] = bf2f((bf16_t)v[j]) * qs; o[i * 8 + j] = 0.f; } }
    }
    float rp = 1.0f;
    const int z = opaque_zero();
    for (int s = tw + 62; s >= 0; --s) {
        const bf16_t* kp = PS + ((size_t)b * SEQ + s) * PS_W + 384 + h * HD + z;
        float dot = 0.f;
#pragma unroll
        for (int i = 0; i < 8; ++i) { const bf16x8 v = *(const bf16x8*)(kp + i * 8);
#pragma unroll
            for (int j = 0; j < 8; ++j) dot += q[i * 8 + j] * bf2f((bf16_t)v[j]); }
        const bool act = s < t;
        const float e = __builtin_amdgcn_exp2f(dot);
        const float keep = __builtin_amdgcn_rcpf(1.0f + e);
        const float pr = act ? (1.0f - keep) * rp : 0.f;
        rp = act ? rp * keep : rp;
        const bf16_t* vp = kp + 384;
#pragma unroll
        for (int i = 0; i < 8; ++i) { const bf16x8 v = *(const bf16x8*)(vp + i * 8);
#pragma unroll
            for (int j = 0; j < 8; ++j) o[i * 8 + j] += pr * bf2f((bf16_t)v[j]); }
        if (__all(rp == 0.0f)) break;
    }
    const bf16_t* gp = PS + row * PS_W + 1152 + h * HD;
    bf16_t* op = MIX + row * DM + CW + h * HD;
#pragma unroll
    for (int i = 0; i < 8; ++i) { const bf16x8 g = *(const bf16x8*)(gp + i * 8); uint4 w;
        w.x = pk2(o[i * 8 + 0] * siluf_(bf2f((bf16_t)g[0])), o[i * 8 + 1] * siluf_(bf2f((bf16_t)g[1])));
        w.y = pk2(o[i * 8 + 2] * siluf_(bf2f((bf16_t)g[2])), o[i * 8 + 3] * siluf_(bf2f((bf16_t)g[3])));
        w.z = pk2(o[i * 8 + 4] * siluf_(bf2f((bf16_t)g[4])), o[i * 8 + 5] * siluf_(bf2f((bf16_t)g[5])));
        w.w = pk2(o[i * 8 + 6] * siluf_(bf2f((bf16_t)g[6])), o[i * 8 + 7] * siluf_(bf2f((bf16_t)g[7])));
        *(uint4*)(op + i * 8) = w; }
}

__device__ void rwkv_job(const Params& p, int l, int job, float* lds) {
    const int tid = tid_(), lane = tid & 63, wave = tid >> 6;
    const int b = job / NH, h = job % NH;
    const bf16_t* PR = (const bf16_t*)(p.ws + WS_PR); const bf16_t* PG = (const bf16_t*)(p.ws + WS_PG);
    float* VF = (float*)(p.ws + WS_VF); bf16_t* MIX = (bf16_t*)(p.ws + WS_MIX);
    const float* mu = p.in[11] + l * 1216; const float* w0 = p.in[12] + l * RWW; const float* w2 = p.in[13] + l * LORA * RWW;
    const float* a0 = p.in[14] + l * RWW; const float* a2 = p.in[15] + l * LORA * RWW; const float* kks = p.in[16] + l * RWW; const float* ka = p.in[17] + l * RWW;
    const float* rk = p.in[18] + l * RWW; const float* gng = p.in[19] + l * RWW; const float* gnb = p.in[20] + l * RWW;
    const float* v0 = p.in[21]; const float* v1 = p.in[22]; const float* v2 = p.in[23];
    float* R = lds; float* W = R + 4096; float* K = W + 4096; float* V = K + 4096; float* A = V + 4096; float* Bm = A + 4096; float* Y = Bm + 4096;
    float* WD = Y + 4096; float* AD = WD + 2048; float* VL = AD + 2048;
    float S[64];
#pragma unroll
    for (int i = 0; i < 64; ++i) S[i] = 0.f;
    for (int c = 0; c < SEQ / 64; ++c) {
        const int t0 = c * 64;
        for (int idx = tid; idx < 64 * 64; idx += 512) {
            const int tt = idx >> 6, i = idx & 63, t = t0 + tt;
            const bf16_t* cur = PR + ((size_t)b * SEQ + t) * PR_W;
            const float xc = bf2f(cur[1152 + i]), xp = t > 0 ? bf2f(cur[1152 + i - PR_W]) : 0.f;
            const float f = xc + (xp - xc) * mu[1152 + i];
            if (i < 32) WD[tt * 32 + i] = tanhf(f); else AD[tt * 32 + i - 32] = f;
        }
        if (l > 0) {
            for (int idx = tid; idx < 64 * 32; idx += 512) {
                const int tt = idx >> 5, i = idx & 31, t = t0 + tt;
                const bf16_t* cur = PR + ((size_t)b * SEQ + t) * PR_W + 768;
                float a = 0.f;
                for (int cc = 0; cc < RWW; ++cc) {
                    const float xc = bf2f(cur[cc]), xp = t > 0 ? bf2f(cur[cc - PR_W]) : 0.f;
                    a += (xc + (xp - xc) * mu[768 + cc]) * v1[cc * LORA + i];
                }
                VL[idx] = a;
            }
        }
        __syncthreads();
        for (int idx = tid; idx < 64 * 64; idx += 512) {
            const int tt = idx >> 6, j = idx & 63, t = t0 + tt, cj = h * HD + j;
            const size_t row = (size_t)b * SEQ + t;
            const bf16_t* cur = PR + row * PR_W;
            const bool hp = t > 0;
            float rc = bf2f(cur[cj]), kc = bf2f(cur[384 + cj]), vc = bf2f(cur[768 + cj]);
            const float rp_ = hp ? bf2f(cur[cj - PR_W]) : 0.f, kp_ = hp ? bf2f(cur[384 + cj - PR_W]) : 0.f, vp_ = hp ? bf2f(cur[768 + cj - PR_W]) : 0.f;
            rc += (rp_ - rc) * mu[cj]; kc += (kp_ - kc) * mu[384 + cj]; vc += (vp_ - vc) * mu[768 + cj];
            float wl = w0[cj], al = a0[cj];
#pragma unroll 8
            for (int i = 0; i < LORA; ++i) { wl += WD[tt * 32 + i] * w2[i * RWW + cj]; al += AD[tt * 32 + i] * a2[i * RWW + cj]; }
            const float sp = fmaxf(-wl, 0.f) + log1pf(__expf(-fabsf(wl)));
            const float decay = __expf(-__expf(-sp - 0.5f));
            const float alr = sigmoidf_(al);
            if (l > 0) {
                float vg = v0[cj];
#pragma unroll 8
                for (int i = 0; i < LORA; ++i) vg += VL[tt * 32 + i] * v2[i * RWW + cj];
                vg = sigmoidf_(vg);
                vc = vc + (VF[row * RWW + cj] - vc) * vg;
            } else VF[row * RWW + cj] = vc;
            R[idx] = rc; W[idx] = decay; V[idx] = vc;
            K[idx] = kc * (1.0f + (alr - 1.0f) * ka[cj]);
            A[idx] = kc * kks[cj];
            Bm[idx] = alr;
        }
        __syncthreads();
        for (int q = 0; q < 8; ++q) {
            const int tt = wave * 8 + q; const float kk = A[tt * 64 + lane];
            const float nrm = sqrtf(wave_sum(kk * kk));
            const float kn = kk / fmaxf(nrm, 1e-12f);
            A[tt * 64 + lane] = -kn; Bm[tt * 64 + lane] = kn * Bm[tt * 64 + lane];
        }
        __syncthreads();
        if (wave == 0) {
            for (int tt = 0; tt < 64; ++tt) {
                const f32x4* a4 = (const f32x4*)(A + tt * 64); const f32x4* w4 = (const f32x4*)(W + tt * 64); const f32x4* b4 = (const f32x4*)(Bm + tt * 64);
                const f32x4* k4 = (const f32x4*)(K + tt * 64); const f32x4* r4 = (const f32x4*)(R + tt * 64);
                float sa = 0.f;
#pragma unroll
                for (int i = 0; i < 16; ++i) { const f32x4 a = a4[i]; sa += S[4 * i] * a[0] + S[4 * i + 1] * a[1] + S[4 * i + 2] * a[2] + S[4 * i + 3] * a[3];
                    if ((i & 7) == 7) asm volatile("" ::: "memory"); }
                const float vv = V[tt * 64 + lane];
                float y = 0.f;
#pragma unroll
                for (int i = 0; i < 16; ++i) { const f32x4 w = w4[i], bb = b4[i], kk = k4[i], rr = r4[i];
#pragma unroll
                    for (int e = 0; e < 4; ++e) { const float s = S[4 * i + e] * w[e] + sa * bb[e] + vv * kk[e]; S[4 * i + e] = s; y += s * rr[e]; }
                    if ((i & 1) == 1) asm volatile("" ::: "memory"); }
                Y[tt * 64 + lane] = y;
            }
        }
        __syncthreads();
        for (int q = 0; q < 8; ++q) {
            const int tt = wave * 8 + q, t = t0 + tt, cj = h * HD + lane; const size_t row = (size_t)b * SEQ + t;
            const float y = Y[tt * 64 + lane];
            const float mean = wave_sum(y) * (1.0f / HD); const float d = y - mean;
            const float var = wave_sum(d * d) * (1.0f / HD);
            const float yn = d * rsqrtf(var + GN_EPS) * gng[cj] + gnb[cj];
            const float bonus = wave_sum(R[tt * 64 + lane] * K[tt * 64 + lane] * rk[cj]);
            const float o = yn + bonus * V[tt * 64 + lane];
            const float g = bf2f(PG[row * PG_W + cj]);
            MIX[row * DM + CW + SBW + cj] = f2bf(o * siluf_(g));
        }
        __syncthreads();
    }
}

__device__ void phase_mixers(const Params& p, int l, unsigned char* lds) {
    constexpr int NRW = BATCH * NH, NAT = BATCH * NH * 4, NCV = BATCH * (SEQ / 32);
    const int G = gridDim.x;
    for (int job = blockIdx.x; job < NRW; job += G) rwkv_job(p, l, job, (float*)lds);
    const int start = (blockIdx.x + G - (NRW % G)) % G;
    for (int job = start; job < NAT; job += G) attn_job(p, job);
    for (int job = start; job < NCV; job += G) conv_job(p, l, job, (float*)lds);
}

constexpr int N_PHASES = 1 + 4 * DEPTH;
__device__ __forceinline__ void run_phase(const Params& p, int ph, unsigned char* lds) {
    unsigned char* ws = p.ws;
    if (ph == 0) { phase_prologue(p, lds); return; }
    const int l = (ph - 1) >> 2, k = (ph - 1) & 3;
    if (k == 0) {
        EpiInProj E{(bf16_t*)(ws + WS_PC), (bf16_t*)(ws + WS_PS), (bf16_t*)(ws + WS_PR), (bf16_t*)(ws + WS_PG)};
        gemm_simple((const bf16_t*)(ws + WS_XB), (const bf16_t*)(ws + WS_WIN) + (size_t)l * NINT * DM, M, NINT, DM, E);
    } else if (k == 1) {
        phase_mixers(p, l, lds);
    } else if (k == 2) {
        EpiF32 E{(float*)(ws + WS_Y), DM};
        gemm_simple((const bf16_t*)(ws + WS_MIX), (const bf16_t*)(ws + WS_WOUT) + (size_t)l * DM * DM, M, DM, DM, E);
    } else {
        phase_rowpass(l == 0 ? p.in[0] : p.out, (const float*)(ws + WS_Y), p.in[2] + l * DM, p.out, l + 1 < DEPTH ? (bf16_t*)(ws + WS_XB) : nullptr);
    }
}

constexpr int LDS_BYTES = 147456;

#if MK_COOP
__global__ void __launch_bounds__(512, 2) fwd_kernel(Params p) {
    extern __shared__ __attribute__((aligned(16))) unsigned char lds[];
    cg::grid_group grid = cg::this_grid();
    for (int ph = p.ph_lo; ph < p.ph_hi; ++ph) {
        run_phase(p, ph, lds);
        if (ph + 1 < p.ph_hi) grid.sync();
    }
}
#else
__global__ void __launch_bounds__(512, 2) fwd_kernel(Params p) {
    extern __shared__ __attribute__((aligned(16))) unsigned char lds[];
    for (int ph = p.ph_lo; ph < p.ph_hi; ++ph) run_phase(p, ph, lds);
}
#endif

extern "C" void kernel_launch(void* const* d_in, const int* in_sizes, int n_in, void* d_out, int out_size, void* d_ws, size_t ws_size, hipStream_t stream) {
    static int grid = 0;
    if (grid == 0) {
        if (n_in != 24 || out_size != M * DM || ws_size < WS_END) { fprintf(stderr, "kernel_launch: unexpected problem (n_in %d out %d ws %zu)\n", n_in, out_size, ws_size); grid = -1; return; }
        int dev = 0, cus = 0, per_cu = 0;
        hipGetDevice(&dev); hipDeviceGetAttribute(&cus, hipDeviceAttributeMultiprocessorCount, dev);
        hipFuncSetAttribute((const void*)fwd_kernel, hipFuncAttributeMaxDynamicSharedMemorySize, LDS_BYTES);
        hipOccupancyMaxActiveBlocksPerMultiprocessor(&per_cu, (const void*)fwd_kernel, 512, LDS_BYTES);
        if (per_cu < 1) { fprintf(stderr, "kernel_launch: occupancy query says %d blocks per CU\n", per_cu); per_cu = 1; }
        grid = cus;
        (void)hipGetLastError();
    }
    if (grid < 0) return;
    Params p{};
    for (int i = 0; i < 24; ++i) p.in[i] = (const float*)d_in[i];
    p.out = (float*)d_out; p.ws = (unsigned char*)d_ws;
#if MK_COOP
    p.ph_lo = 0; p.ph_hi = N_PHASES;
    void* args[] = {&p};
    hipError_t e = hipLaunchCooperativeKernel((const void*)fwd_kernel, dim3(grid), dim3(512), args, LDS_BYTES, stream);
    if (e != hipSuccess) fprintf(stderr, "cooperative launch failed: %s (grid %d)\n", hipGetErrorString(e), grid);
#else
    for (int ph = 0; ph < N_PHASES; ++ph) {
        p.ph_lo = ph; p.ph_hi = ph + 1;
        hipLaunchKernelGGL(fwd_kernel, dim3(grid), dim3(512), LDS_BYTES, stream, p);
    }
#endif
}
```

```cpp
#include <hip/hip_runtime.h>
#include <hip/hip_cooperative_groups.h>
#include <cstdio>
#include <cstdint>
namespace cg = cooperative_groups;

#ifndef SIMPLE_GEMM
#define SIMPLE_GEMM 0
#endif
#ifndef MK_COOP
#define MK_COOP 1
#endif

constexpr int BATCH = 16, SEQ = 2048, DM = 1024, DEPTH = 2;
constexpr int M = BATCH * SEQ;
constexpr int HD = 64, NH = 6;
constexpr int CW = 256, SBW = 384, RWW = 384, LORA = 32, TAPS = 31;
constexpr int DIN = 3904;
constexpr int NINT = 4096;
constexpr int PC_W = 768, PS_W = 1536, PR_W = 1280, PG_W = 384;
constexpr float RMS_EPS = 1e-6f, LN_EPS = 1e-5f, GN_EPS = 64e-5f;

typedef unsigned short bf16_t;
typedef short bf16x8 __attribute__((ext_vector_type(8)));
typedef float f32x4 __attribute__((ext_vector_type(4)));
typedef unsigned short us4 __attribute__((ext_vector_type(4)));

constexpr size_t MiB = 1u << 20;
constexpr size_t WS_CTL = 0;
constexpr size_t WS_WIN = 1 * MiB;
constexpr size_t WS_WOUT = 17 * MiB;
constexpr size_t WS_XB = 21 * MiB;
constexpr size_t WS_MIX = WS_XB;
constexpr size_t WS_PC = 85 * MiB;
constexpr size_t WS_PS = 133 * MiB;
constexpr size_t WS_Y = WS_PC;
constexpr size_t WS_PR = 229 * MiB;
constexpr size_t WS_PG = 309 * MiB;
constexpr size_t WS_VF = 333 * MiB;
constexpr size_t WS_END = 381 * MiB;

struct Params {
    const float* in[24];
    float* out;
    unsigned char* ws;
    int ph_lo, ph_hi;
};

__device__ __forceinline__ float bf2f(bf16_t v) { return __uint_as_float(((unsigned)v) << 16); }
__device__ __forceinline__ bf16_t f2bf(float f) { unsigned u = __float_as_uint(f); return (bf16_t)((u + 0x7fffu + ((u >> 16) & 1u)) >> 16); }
__device__ __forceinline__ unsigned pk2(float lo, float hi) { return (unsigned)f2bf(lo) | ((unsigned)f2bf(hi) << 16); }
__device__ __forceinline__ float wave_sum(float v) {
#pragma unroll
    for (int o = 1; o < 64; o <<= 1) v += __shfl_xor(v, o);
    return v;
}
__device__ __forceinline__ float sigmoidf_(float x) { return 1.0f / (1.0f + __expf(-x)); }
__device__ __forceinline__ float siluf_(float x) { return x / (1.0f + __expf(-x)); }
__device__ __forceinline__ int tid_() { int t = threadIdx.x; asm volatile("" : "+v"(t)); return t; }
__device__ __forceinline__ int opaque_zero() { int z = 0; asm volatile("" : "+v"(z)); return z; }

__device__ __forceinline__ int orig_col(int n) { return n < 3520 ? n : (n < 3584 ? -1 : (n < 3968 ? n - 64 : -1)); }

__device__ void transpose_tile(const float* W, int ldw, int ncol_src, const float* gain, bf16_t* WT, int K, int n0, int k0, bool permute, float* tile  ) {
    const int tid = tid_();
#pragma unroll
    for (int i = 0; i < 8; ++i) {
        const int kl = (tid >> 6) + 8 * i, nl = tid & 63;
        const int n = n0 + nl, k = k0 + kl;
        const int oc = permute ? orig_col(n) : n;
        float v = 0.f;
        if (oc >= 0 && oc < ncol_src) v = W[(size_t)k * ldw + oc] * (gain ? gain[k] : 1.0f);
        tile[kl * 65 + nl] = v;
    }
    __syncthreads();
#pragma unroll
    for (int i = 0; i < 8; ++i) {
        const int nl = (tid >> 6) + 8 * i, kl = tid & 63;
        WT[(size_t)(n0 + nl) * K + k0 + kl] = f2bf(tile[kl * 65 + nl]);
    }
    __syncthreads();
}

__device__ void rows_to_xb(const float* X, bf16_t* XB) {
    const int tid = tid_(), lane = tid & 63, wave = tid >> 6;
    for (int row = blockIdx.x * 8 + wave; row < M; row += gridDim.x * 8) {
        const float* xr = X + (size_t)row * DM;
        f32x4 v[4]; float ss = 0.f;
#pragma unroll
        for (int i = 0; i < 4; ++i) { v[i] = *(const f32x4*)(xr + i * 256 + lane * 4); ss += v[i][0] * v[i][0] + v[i][1] * v[i][1] + v[i][2] * v[i][2] + v[i][3] * v[i][3]; }
        ss = wave_sum(ss);
        const float rstd = rsqrtf(ss * (1.0f / DM) + RMS_EPS);
#pragma unroll
        for (int i = 0; i < 4; ++i) { uint2 w; w.x = pk2(v[i][0] * rstd, v[i][1] * rstd); w.y = pk2(v[i][2] * rstd, v[i][3] * rstd); *(uint2*)(XB + (size_t)row * DM + i * 256 + lane * 4) = w; }
    }
}

__device__ void phase_prologue(const Params& p, unsigned char* lds) {
    float* tile = (float*)lds;
    bf16_t* WinT = (bf16_t*)(p.ws + WS_WIN); bf16_t* WoutT = (bf16_t*)(p.ws + WS_WOUT);
    const int nt_in = (NINT / 64) * (DM / 64), nt_out = (DM / 64) * (DM / 64);
    const int total = DEPTH * (nt_in + nt_out);
    for (int j = blockIdx.x; j < total; j += gridDim.x) {
        int l = j / (nt_in + nt_out), r = j % (nt_in + nt_out);
        if (r < nt_in) { const int tn = r / (DM / 64), tk = r % (DM / 64);
            transpose_tile(p.in[3] + (size_t)l * DM * DIN, DIN, DIN, p.in[1] + l * DM, WinT + (size_t)l * NINT * DM, DM, tn * 64, tk * 64, true, tile);
        } else { r -= nt_in; const int tn = r / (DM / 64), tk = r % (DM / 64);
            transpose_tile(p.in[4] + (size_t)l * DM * DM, DM, DM, nullptr, WoutT + (size_t)l * DM * DM, DM, tn * 64, tk * 64, false, tile);
        }
    }
    rows_to_xb(p.in[0], (bf16_t*)(p.ws + WS_XB));
}

namespace pg8 {
#define PG8_LAS __attribute__((address_space(3)))
typedef unsigned short bf16_t;
typedef short bf16x8 __attribute__((ext_vector_type(8)));
typedef float f32x4 __attribute__((ext_vector_type(4)));
typedef unsigned u32x4 __attribute__((ext_vector_type(4)));
constexpr int BM = 256, BK = 64, HALF = 128, HTB = HALF * BK * 2  , STAGE_BYTES = 8 * HTB, NXCD = 8, WGM = 8;

__host__ __device__ __forceinline__ int lds_byte(int r, int c) { const int st = (r >> 4) * 2 + (c >> 5), rr = r & 15, cc = c & 31, ob = rr * 64 + cc * 2; return st * 1024 + (ob ^ (((ob >> 9) & 1) << 5)); }
__host__ __device__ __forceinline__ void stage_rc(int b, int& R, int& C) { const int st = b / 1024, sb = b % 1024, swz = sb ^ (((sb >> 9) & 1) << 5); R = (st >> 1) * 16 + swz / 64; C = (st & 1) * 32 + (swz % 64) / 2; }
__host__ __device__ __forceinline__ int perm32(int rho) { const int n = rho >> 4, i = rho & 15; return 8 * (i >> 2) + 4 * n + (i & 3); }

struct Unit { int pm, pn; };
struct Gemm { const bf16_t* A; const bf16_t* Bt; int M, N, K; };

struct StaticOrder {
    int nM, nN, nwg, G, c;
    __host__ __device__ void init(int M, int N, int G_, int c_) { nM = M / BM; nN = N / BM; nwg = nM * nN; G = G_; c = c_; }
    __host__ __device__ bool next(int i, Unit& u) const {
        const long L = (long)i * G + c; if (L >= nwg) return false;
        int wgid = (int)L; { const int q = nwg / NXCD, r = nwg % NXCD, xcd = wgid % NXCD, off = wgid / NXCD; wgid = (xcd < r ? xcd * (q + 1) : r * (q + 1) + (xcd - r) * q) + off; }
        const int nig = WGM * nN, gid = wgid / nig, fm = gid * WGM, gsz = (nM - fm) < WGM ? (nM - fm) : WGM;
        u.pm = fm + ((wgid % nig) % gsz); u.pn = (wgid % nig) / gsz; return true;
    }
    __device__ __forceinline__ void a_ready(const Unit&) const {}
    __device__ __forceinline__ void done(const Unit&) const {}
};


__device__ __forceinline__ unsigned cvt_pk_bf16(float lo, float hi) { unsigned r; asm volatile("v_cvt_pk_bf16_f32 %0, %1, %2" : "=v"(r) : "v"(lo), "v"(hi)); return r; }

template <class Epi, class Sched, bool ALIGN_EPI = false, bool SP2 = false>
__device__ __forceinline__ void gemm_phase(PG8_LAS unsigned char* lds, const Gemm g, const Sched& S, const Epi& E) {
    const int tid = tid_(), wid = __builtin_amdgcn_readfirstlane(tid >> 6), lane = tid & 63, wr = wid >> 2, wc = wid & 3, fr = lane & 15, fq = lane >> 4;
    const int K = g.K, nt = K / BK;
    unsigned voffA[2], voffB[2];
#pragma unroll
    for (int i = 0; i < 2; ++i) { int R, C; stage_rc(tid * 16 + i * 8192, R, C); const int Rb = Epi::PERM ? ((R & ~31) + perm32(R & 31)) : R;
        voffA[i] = (unsigned)(R * K + C) * 2u; voffB[i] = (unsigned)(Rb * K + C) * 2u; }
    const size_t kstep = (size_t)(BK * 2);
    const size_t hstep = (size_t)HALF * K * 2;
    const size_t tstep = 2 * hstep;
    const unsigned ldsw = (unsigned)wid * 1024u;
    const int aoff = lds_byte(wr * 64 + fr, fq * 8), boff = lds_byte(wc * 32 + fr, fq * 8);
#define PG8_SA(b, h) (((b) * 2 + (h)) * HTB)
#define PG8_SB(b, h) ((4 + (b) * 2 + (h)) * HTB)
#define PG8_STAGE(bufoff, gbase, voff) do { _Pragma("unroll") for (int _i = 0; _i < 2; ++_i) \
        __builtin_amdgcn_global_load_lds((const unsigned*)((const char*)(gbase) + (voff)[_i]), (PG8_LAS unsigned*)(lds + (bufoff) + ldsw + _i * 8192), 16, 0, 0); } while (0)
#define PG8_LDA(dst, b, h) do { _Pragma("unroll") for (int m = 0; m < 4; ++m) _Pragma("unroll") for (int k = 0; k < 2; ++k) dst[m][k] = *(const PG8_LAS bf16x8*)(lds + PG8_SA(b, h) + aoff + m * 2048 + k * 1024); } while (0)
#define PG8_LDB(dst, b, h) do { _Pragma("unroll") for (int n = 0; n < 2; ++n) _Pragma("unroll") for (int k = 0; k < 2; ++k) dst[n][k] = *(const PG8_LAS bf16x8*)(lds + PG8_SB(b, h) + boff + n * 2048 + k * 1024); } while (0)
#define PG8_MMA(ai, bj, At, Bt) do { __builtin_amdgcn_s_setprio(1); _Pragma("unroll") for (int m = 0; m < 4; ++m) _Pragma("unroll") for (int n = 0; n < 2; ++n) _Pragma("unroll") for (int k = 0; k < 2; ++k) \
        acc[ai][bj][m][n] = __builtin_amdgcn_mfma_f32_16x16x32_bf16(Bt[n][k], At[m][k], acc[ai][bj][m][n], 0, 0, 0); __builtin_amdgcn_s_setprio(0); } while (0)
#define PG8_WAIT_V(n) asm volatile("s_waitcnt vmcnt(" #n ")" ::: "memory")
#define PG8_WAIT_L(n) asm volatile("s_waitcnt lgkmcnt(" #n ")" ::: "memory")
#define PG8_BAR __builtin_amdgcn_s_barrier()
#define PG8_SCHED __builtin_amdgcn_sched_barrier(0)
    Unit cur, nxt; int ui = 0;
    if (!S.next(0, cur)) return;
    f32x4 acc[2][2][4][2];
#pragma unroll
    for (int a = 0; a < 2; ++a)
#pragma unroll
        for (int b = 0; b < 2; ++b)
#pragma unroll
            for (int m = 0; m < 4; ++m)
#pragma unroll
                for (int n = 0; n < 2; ++n) acc[a][b][m][n] = (f32x4){0.f, 0.f, 0.f, 0.f};
    bf16x8 At[4][2], B0[2][2], B1[2][2];
    const char* cA = (const char*)g.A + (size_t)cur.pm * tstep; const char* cB = (const char*)g.Bt + (size_t)cur.pn * tstep;
    S.a_ready(cur);
    if constexpr (SP2) {
        PG8_STAGE(PG8_SB(0, 0), cB, voffB); PG8_STAGE(PG8_SB(0, 1), cB + hstep, voffB); PG8_STAGE(PG8_SA(0, 0), cA, voffA); PG8_STAGE(PG8_SA(0, 1), cA + hstep, voffA);
        if (wr == 1) PG8_BAR;
        PG8_WAIT_V(2); PG8_BAR;
        PG8_STAGE(PG8_SB(1, 0), cB + kstep, voffB); PG8_STAGE(PG8_SA(1, 0), cA + kstep, voffA); PG8_STAGE(PG8_SB(1, 1), cB + hstep + kstep, voffB);
        PG8_WAIT_V(6); PG8_BAR;
    } else {
        PG8_STAGE(PG8_SB(0, 0), cB, voffB); PG8_STAGE(PG8_SA(0, 0), cA, voffA); PG8_STAGE(PG8_SB(0, 1), cB + hstep, voffB); PG8_STAGE(PG8_SA(0, 1), cA + hstep, voffA);
        if (wr == 1) PG8_BAR;
        PG8_WAIT_V(4); PG8_BAR;
        PG8_STAGE(PG8_SB(1, 0), cB + kstep, voffB); PG8_STAGE(PG8_SA(1, 0), cA + kstep, voffA); PG8_STAGE(PG8_SB(1, 1), cB + hstep + kstep, voffB);
        PG8_WAIT_V(6); PG8_BAR;
    }
    for (;;) {
        const bool has_next = S.next(ui + 1, nxt);
        const char* nA = has_next ? (const char*)g.A + (size_t)nxt.pm * tstep : cA; const char* nB = has_next ? (const char*)g.Bt + (size_t)nxt.pn * tstep : cB;
        for (int t = 0; t < nt; t += 2) {
            const bool last = (t == nt - 2);
            const char* a1 = cA + (size_t)(t + 1) * kstep;
            const char* a2 = last ? nA : cA + (size_t)(t + 2) * kstep; const char* b2 = last ? nB : cB + (size_t)(t + 2) * kstep;
            const char* a3 = a2 + kstep; const char* b3 = b2 + kstep;
            if (last && has_next) S.a_ready(nxt);
            if constexpr (SP2) {
            PG8_LDB(B0, 0, 0); PG8_LDB(B1, 0, 1); PG8_SCHED; PG8_LDA(At, 0, 0); PG8_STAGE(PG8_SA(1, 1), a1 + hstep, voffA);
            PG8_WAIT_V(8); PG8_WAIT_L(0); PG8_BAR; PG8_MMA(0, 0, At, B0); PG8_MMA(0, 1, At, B1); PG8_BAR; PG8_SCHED;
            PG8_LDA(At, 0, 1); PG8_STAGE(PG8_SB(0, 0), b2, voffB); PG8_STAGE(PG8_SB(0, 1), b2 + hstep, voffB); PG8_STAGE(PG8_SA(0, 0), a2, voffA);
            PG8_WAIT_V(8); PG8_WAIT_L(0); PG8_BAR; PG8_MMA(1, 0, At, B0); PG8_MMA(1, 1, At, B1); PG8_BAR; PG8_SCHED;
            PG8_LDB(B0, 1, 0); PG8_LDB(B1, 1, 1); PG8_SCHED; PG8_LDA(At, 1, 0); PG8_STAGE(PG8_SA(0, 1), a2 + hstep, voffA);
            PG8_WAIT_V(8); PG8_WAIT_L(0); PG8_BAR; PG8_MMA(0, 0, At, B0); PG8_MMA(0, 1, At, B1); PG8_BAR; PG8_SCHED;
            PG8_LDA(At, 1, 1); PG8_STAGE(PG8_SB(1, 0), b3, voffB); PG8_STAGE(PG8_SB(1, 1), b3 + hstep, voffB); PG8_STAGE(PG8_SA(1, 0), a3, voffA);
            PG8_WAIT_V(8); PG8_WAIT_L(0); PG8_BAR; PG8_MMA(1, 0, At, B0); PG8_MMA(1, 1, At, B1); PG8_BAR; PG8_SCHED;
            } else {
            PG8_LDB(B0, 0, 0); PG8_SCHED; PG8_LDA(At, 0, 0); PG8_STAGE(PG8_SA(1, 1), a1 + hstep, voffA);
            PG8_WAIT_L(8); PG8_BAR; PG8_WAIT_L(0); PG8_MMA(0, 0, At, B0); PG8_BAR; PG8_SCHED;
            PG8_LDB(B1, 0, 1); PG8_STAGE(PG8_SB(0, 0), b2, voffB);
            PG8_BAR; PG8_WAIT_L(0); PG8_MMA(0, 1, At, B1); PG8_BAR;
            PG8_LDA(At, 0, 1); PG8_STAGE(PG8_SA(0, 0), a2, voffA);
            PG8_BAR; PG8_WAIT_L(0); PG8_MMA(1, 0, At, B0); PG8_BAR; PG8_SCHED;
            PG8_STAGE(PG8_SB(0, 1), b2 + hstep, voffB);
            PG8_WAIT_V(6); PG8_BAR; PG8_MMA(1, 1, At, B1); PG8_BAR;
            PG8_LDB(B0, 1, 0); PG8_SCHED; PG8_LDA(At, 1, 0); PG8_STAGE(PG8_SA(0, 1), a2 + hstep, voffA);
            PG8_WAIT_L(8); PG8_BAR; PG8_WAIT_L(0); PG8_MMA(0, 0, At, B0); PG8_BAR; PG8_SCHED;
            PG8_LDB(B1, 1, 1); PG8_STAGE(PG8_SB(1, 0), b3, voffB);
            PG8_BAR; PG8_WAIT_L(0); PG8_MMA(0, 1, At, B1); PG8_BAR;
            PG8_LDA(At, 1, 1); PG8_STAGE(PG8_SA(1, 0), a3, voffA);
            PG8_BAR; PG8_WAIT_L(0); PG8_MMA(1, 0, At, B0); PG8_BAR; PG8_SCHED;
            PG8_STAGE(PG8_SB(1, 1), b3 + hstep, voffB);
            PG8_WAIT_V(6); PG8_BAR; PG8_MMA(1, 1, At, B1); PG8_BAR;
            }
        }
        if constexpr (ALIGN_EPI) { if (wr == 0) PG8_BAR; }
        if constexpr (!Epi::AFTER_DRAIN) { E(acc, cur, wr, wc, fr, fq); S.done(cur); }
        if (!has_next) break;
#pragma unroll
        for (int a = 0; a < 2; ++a)
#pragma unroll
            for (int b = 0; b < 2; ++b)
#pragma unroll
                for (int m = 0; m < 4; ++m)
#pragma unroll
                    for (int n = 0; n < 2; ++n) acc[a][b][m][n] = (f32x4){0.f, 0.f, 0.f, 0.f};
        cur = nxt; cA = nA; cB = nB; ++ui;
        if constexpr (ALIGN_EPI) { if (wr == 1) PG8_BAR; }
    }
    PG8_WAIT_V(0);
    if constexpr (!ALIGN_EPI) { if (wr == 0) PG8_BAR; }
    PG8_BAR;
    if constexpr (Epi::AFTER_DRAIN) { E.fused(acc, cur, wr, wc, fr, fq, lds, wid, lane); S.done(cur); }
#undef PG8_SA
#undef PG8_SB
#undef PG8_STAGE
#undef PG8_LDA
#undef PG8_LDB
#undef PG8_MMA
#undef PG8_WAIT_V
#undef PG8_WAIT_L
#undef PG8_BAR
#undef PG8_SCHED
}
}

template <class Epi>
__device__ void gemm_simple(const bf16_t* A, const bf16_t* Bt, int Mr, int N, int K, const Epi& epi) {
    const int tid = tid_(), wave = tid >> 6, lane = tid & 63, wm = wave >> 1, wn = wave & 1, fr = lane & 15, fq = lane >> 4;
    const int nNt = N / 128, nMt = Mr / 128;
    for (int tile = blockIdx.x; tile < nNt * nMt; tile += gridDim.x) {
        const int tm = tile / nNt, tn = tile % nNt;
        const int m0 = tm * 128 + wm * 32, n0 = tn * 128 + wn * 64;
        f32x4 acc[2][4];
#pragma unroll
        for (int i = 0; i < 2; ++i)
#pragma unroll
            for (int j = 0; j < 4; ++j) acc[i][j] = (f32x4){0.f, 0.f, 0.f, 0.f};
        const bf16_t* ap = A + (size_t)(m0 + fr) * K + fq * 8;
        const bf16_t* bp = Bt + (size_t)(n0 + fr) * K + fq * 8;
        for (int k = 0; k < K; k += 32) {
            bf16x8 af[2], bfr[4];
#pragma unroll
            for (int i = 0; i < 2; ++i) af[i] = *(const bf16x8*)(ap + (size_t)i * 16 * K + k);
#pragma unroll
            for (int j = 0; j < 4; ++j) bfr[j] = *(const bf16x8*)(bp + (size_t)j * 16 * K + k);
#pragma unroll
            for (int i = 0; i < 2; ++i)
#pragma unroll
                for (int j = 0; j < 4; ++j) acc[i][j] = __builtin_amdgcn_mfma_f32_16x16x32_bf16(bfr[j], af[i], acc[i][j], 0, 0, 0);
        }
#pragma unroll
        for (int i = 0; i < 2; ++i)
#pragma unroll
            for (int j = 0; j < 4; ++j) epi(m0 + i * 16 + fr, n0 + j * 16 + fq * 4, acc[i][j]);
    }
}

struct EpiInProj {
    bf16_t *PC, *PS, *PR, *PG;
    __device__ __forceinline__ void operator()(int m, int n, const f32x4& v) const {
        bf16_t* dst;
        if (n < 768) dst = PC + (size_t)m * PC_W + n;
        else if (n < 2304) dst = PS + (size_t)m * PS_W + (n - 768);
        else if (n < 3584) dst = PR + (size_t)m * PR_W + (n - 2304);
        else if (n < 3968) dst = PG + (size_t)m * PG_W + (n - 3584);
        else return;
        uint2 w; w.x = pk2(v[0], v[1]); w.y = pk2(v[2], v[3]); *(uint2*)dst = w;
    }
};
struct EpiF32 {
    float* Y; int ld;
    __device__ __forceinline__ void operator()(int m, int n, const f32x4& v) const { *(f32x4*)(Y + (size_t)m * ld + n) = v; }
};


struct EpiInProjP {
    static constexpr bool PERM = true, AFTER_DRAIN = false;
    bf16_t *PC, *PS, *PR, *PG;
    __device__ __forceinline__ void operator()(const pg8::f32x4 (&acc)[2][2][4][2], const pg8::Unit& u, int wr, int wc, int fr, int fq) const {
        const int row0 = u.pm * 256 + wr * 64 + fr;
#pragma unroll
        for (int bj = 0; bj < 2; ++bj) {
            const int blk = 2 * u.pn + bj; bf16_t* base; int ld, c0;
            if (blk < 6) { base = PC; ld = PC_W; c0 = 128 * blk; }
            else if (blk < 18) { base = PS; ld = PS_W; c0 = 128 * (blk - 6); }
            else if (blk < 28) { base = PR; ld = PR_W; c0 = 128 * (blk - 18); }
            else if (blk < 31) { base = PG; ld = PG_W; c0 = 128 * (blk - 28); }
            else continue;
            const int col = c0 + wc * 32 + 8 * fq;
#pragma unroll
            for (int ai = 0; ai < 2; ++ai)
#pragma unroll
                for (int m = 0; m < 4; ++m) {
                    const pg8::f32x4 v0 = acc[ai][bj][m][0], v1 = acc[ai][bj][m][1]; pg8::u32x4 w;
                    w.x = pg8::cvt_pk_bf16(v0[0], v0[1]); w.y = pg8::cvt_pk_bf16(v0[2], v0[3]); w.z = pg8::cvt_pk_bf16(v1[0], v1[1]); w.w = pg8::cvt_pk_bf16(v1[2], v1[3]);
                    *(pg8::u32x4*)(base + (size_t)(row0 + ai * 128 + m * 16) * ld + col) = w;
                }
        }
    }
};
struct EpiOutF32P {
    static constexpr bool PERM = false, AFTER_DRAIN = false;
    float* Y; int ld;
    __device__ __forceinline__ void operator()(const pg8::f32x4 (&acc)[2][2][4][2], const pg8::Unit& u, int wr, int wc, int fr, int fq) const {
        const int row0 = u.pm * 256 + wr * 64 + fr, col0 = u.pn * 256 + wc * 32 + 4 * fq;
#pragma unroll
        for (int ai = 0; ai < 2; ++ai)
#pragma unroll
            for (int m = 0; m < 4; ++m)
#pragma unroll
                for (int bj = 0; bj < 2; ++bj)
#pragma unroll
                    for (int n = 0; n < 2; ++n) *(pg8::f32x4*)(Y + (size_t)(row0 + ai * 128 + m * 16) * ld + col0 + bj * 128 + n * 16) = acc[ai][bj][m][n];
    }
};

__device__ void phase_rowpass(const float* Xin, const float* Y, const float* gpost, float* Xout, bf16_t* XB) {
    const int tid = tid_(), lane = tid & 63, wave = tid >> 6;
    for (int row = blockIdx.x * 8 + wave; row < M; row += gridDim.x * 8) {
        f32x4 y[4], x[4]; float ss = 0.f;
#pragma unroll
        for (int i = 0; i < 4; ++i) { y[i] = *(const f32x4*)(Y + (size_t)row * DM + i * 256 + lane * 4); x[i] = *(const f32x4*)(Xin + (size_t)row * DM + i * 256 + lane * 4);
            ss += y[i][0] * y[i][0] + y[i][1] * y[i][1] + y[i][2] * y[i][2] + y[i][3] * y[i][3]; }
        ss = wave_sum(ss);
        const float rstd = rsqrtf(ss * (1.0f / DM) + RMS_EPS);
        float s2 = 0.f;
#pragma unroll
        for (int i = 0; i < 4; ++i) { const f32x4 g = *(const f32x4*)(gpost + i * 256 + lane * 4);
            x[i] = x[i] + y[i] * rstd * g; s2 += x[i][0] * x[i][0] + x[i][1] * x[i][1] + x[i][2] * x[i][2] + x[i][3] * x[i][3];
            *(f32x4*)(Xout + (size_t)row * DM + i * 256 + lane * 4) = x[i]; }
        if (XB) {
            s2 = wave_sum(s2);
            const float r2 = rsqrtf(s2 * (1.0f / DM) + RMS_EPS);
#pragma unroll
            for (int i = 0; i < 4; ++i) { uint2 w; w.x = pk2(x[i][0] * r2, x[i][1] * r2); w.y = pk2(x[i][2] * r2, x[i][3] * r2); *(uint2*)(XB + (size_t)row * DM + i * 256 + lane * 4) = w; }
        }
    }
}

__device__ void conv_job(const Params& p, int l, int job, float* lds) {
    const int tid = tid_(), lane = tid & 63, wave = tid >> 6;
    const int b = job / (SEQ / 32), t0 = (job % (SEQ / 32)) * 32;
    const bf16_t* PC = (const bf16_t*)(p.ws + WS_PC); bf16_t* MIX = (bf16_t*)(p.ws + WS_MIX);
    const float* dw = p.in[5] + l * TAPS * CW; const float* dwb = p.in[6] + l * CW; const float* lng = p.in[7] + l * CW; const float* lnb = p.in[8] + l * CW;
    const float* pw = p.in[9] + (size_t)l * CW * CW; const float* pwb = p.in[10] + l * CW;
    float* u = lds;
    float* cv = lds + 62 * 256;
    for (int idx = tid; idx < 62 * 256; idx += 512) {
        const int r = idx >> 8, c = idx & 255, t = t0 - 30 + r;
        float v = 0.f;
        if (t >= 0) { const bf16_t* pr = PC + (size_t)(b * SEQ + t) * PC_W; v = bf2f(pr[c]) * sigmoidf_(bf2f(pr[256 + c])); }
        u[idx] = v;
    }
    __syncthreads();
    for (int idx = tid; idx < 32 * 256; idx += 512) {
        const int tt = idx >> 8, c = idx & 255;
        float a = dwb[c];
#pragma unroll 4
        for (int j = 0; j < TAPS; ++j) a += dw[j * CW + c] * u[(tt + j) * 256 + c];
        cv[idx] = a;
    }
    __syncthreads();
    for (int q = 0; q < 4; ++q) {
        const int tt = wave * 4 + q; float x[4], s = 0.f;
#pragma unroll
        for (int i = 0; i < 4; ++i) { x[i] = cv[tt * 256 + lane + 64 * i]; s += x[i]; }
        const float mean = wave_sum(s) * (1.0f / CW); float vs = 0.f;
#pragma unroll
        for (int i = 0; i < 4; ++i) { const float d = x[i] - mean; vs += d * d; }
        const float rstd = rsqrtf(wave_sum(vs) * (1.0f / CW) + LN_EPS);
#pragma unroll
        for (int i = 0; i < 4; ++i) { const int c = lane + 64 * i; cv[tt * 256 + c] = siluf_((x[i] - mean) * rstd * lng[c] + lnb[c]); }
    }
    __syncthreads();
    {
        const int n = tid & 255, half = tid >> 8;
        float acc[16];
#pragma unroll
        for (int i = 0; i < 16; ++i) acc[i] = pwb[n];
#pragma unroll 2
        for (int k = 0; k < CW; ++k) {
            const float w = pw[(size_t)k * CW + n];
#pragma unroll
            for (int i = 0; i < 16; ++i) acc[i] += cv[(half * 16 + i) * 256 + k] * w;
        }
#pragma unroll
        for (int i = 0; i < 16; ++i) { const size_t row = (size_t)b * SEQ + t0 + half * 16 + i;
            const float g = bf2f(PC[row * PC_W + 512 + n]);
            MIX[row * DM + n] = f2bf(acc[i] * siluf_(g)); }
    }
    __syncthreads();
}

__device__ void attn_job(const Params& p, int job) {
    const int tid = tid_(), lane = tid & 63, wave = tid >> 6;
    const int bh = job >> 2, qb = job & 3, b = bh / NH, h = bh % NH;
    const bf16_t* PS = (const bf16_t*)(p.ws + WS_PS); bf16_t* MIX = (bf16_t*)(p.ws + WS_MIX);
    const int tw = qb * 512 + wave * 64, t = tw + lane;
    const size_t row = (size_t)b * SEQ + t;
    const float qs = 0.125f * 1.4426950408889634f;
    float q[64], o[64];
    {
        const bf16_t* qp = PS + row * PS_W + h * HD;
#pragma unroll
        for (int i = 0; i < 8; ++i) { const bf16x8 v = *(const bf16x8*)(qp + i * 8);
#pragma unroll
            for (int j = 0; j < 8; ++j) { q[i * 8 + j] = bf2f((bf16_t)v[j]) * qs; o[i * 8 + j] = 0.f; } }
    }
    float rp = 1.0f;
    const int z = opaque_zero();
    for (int s = tw + 62; s >= 0; --s) {
        const bf16_t* kp = PS + ((size_t)b * SEQ + s) * PS_W + 384 + h * HD + z;
        float dot = 0.f;
#pragma unroll
        for (int i = 0; i < 8; ++i) { const bf16x8 v = *(const bf16x8*)(kp + i * 8);
#pragma unroll
            for (int j = 0; j < 8; ++j) dot += q[i * 8 + j] * bf2f((bf16_t)v[j]); }
        const bool act = s < t;
        const float e = __builtin_amdgcn_exp2f(dot);
        const float keep = __builtin_amdgcn_rcpf(1.0f + e);
        const float pr = act ? (1.0f - keep) * rp : 0.f;
        rp = act ? rp * keep : rp;
        const bf16_t* vp = kp + 384;
#pragma unroll
        for (int i = 0; i < 8; ++i) { const bf16x8 v = *(const bf16x8*)(vp + i * 8);
#pragma unroll
            for (int j = 0; j < 8; ++j) o[i * 8 + j] += pr * bf2f((bf16_t)v[j]); }
        if (__all(rp == 0.0f)) break;
    }
    const bf16_t* gp = PS + row * PS_W + 1152 + h * HD;
    bf16_t* op = MIX + row * DM + CW + h * HD;
#pragma unroll
    for (int i = 0; i < 8; ++i) { const bf16x8 g = *(const bf16x8*)(gp + i * 8); uint4 w;
        w.x = pk2(o[i * 8 + 0] * siluf_(bf2f((bf16_t)g[0])), o[i * 8 + 1] * siluf_(bf2f((bf16_t)g[1])));
        w.y = pk2(o[i * 8 + 2] * siluf_(bf2f((bf16_t)g[2])), o[i * 8 + 3] * siluf_(bf2f((bf16_t)g[3])));
        w.z = pk2(o[i * 8 + 4] * siluf_(bf2f((bf16_t)g[4])), o[i * 8 + 5] * siluf_(bf2f((bf16_t)g[5])));
        w.w = pk2(o[i * 8 + 6] * siluf_(bf2f((bf16_t)g[6])), o[i * 8 + 7] * siluf_(bf2f((bf16_t)g[7])));
        *(uint4*)(op + i * 8) = w; }
}

__device__ void rwkv_job(const Params& p, int l, int job, float* lds) {
    const int tid = tid_(), lane = tid & 63, wave = tid >> 6;
    const int b = job / NH, h = job % NH;
    const bf16_t* PR = (const bf16_t*)(p.ws + WS_PR); const bf16_t* PG = (const bf16_t*)(p.ws + WS_PG);
    float* VF = (float*)(p.ws + WS_VF); bf16_t* MIX = (bf16_t*)(p.ws + WS_MIX);
    const float* mu = p.in[11] + l * 1216; const float* w0 = p.in[12] + l * RWW; const float* w2 = p.in[13] + l * LORA * RWW;
    const float* a0 = p.in[14] + l * RWW; const float* a2 = p.in[15] + l * LORA * RWW; const float* kks = p.in[16] + l * RWW; const float* ka = p.in[17] + l * RWW;
    const float* rk = p.in[18] + l * RWW; const float* gng = p.in[19] + l * RWW; const float* gnb = p.in[20] + l * RWW;
    const float* v0 = p.in[21]; const float* v1 = p.in[22]; const float* v2 = p.in[23];
    float* R = lds; float* W = R + 4096; float* K = W + 4096; float* V = K + 4096; float* A = V + 4096; float* Bm = A + 4096; float* Y = Bm + 4096;
    float* WD = Y + 4096; float* AD = WD + 2048; float* VL = AD + 2048;
    float S[64];
#pragma unroll
    for (int i = 0; i < 64; ++i) S[i] = 0.f;
    for (int c = 0; c < SEQ / 64; ++c) {
        const int t0 = c * 64;
        for (int idx = tid; idx < 64 * 64; idx += 512) {
            const int tt = idx >> 6, i = idx & 63, t = t0 + tt;
            const bf16_t* cur = PR + ((size_t)b * SEQ + t) * PR_W;
            const float xc = bf2f(cur[1152 + i]), xp = t > 0 ? bf2f(cur[1152 + i - PR_W]) : 0.f;
            const float f = xc + (xp - xc) * mu[1152 + i];
            if (i < 32) WD[tt * 32 + i] = tanhf(f); else AD[tt * 32 + i - 32] = f;
        }
        if (l > 0) {
            for (int idx = tid; idx < 64 * 32; idx += 512) {
                const int tt = idx >> 5, i = idx & 31, t = t0 + tt;
                const bf16_t* cur = PR + ((size_t)b * SEQ + t) * PR_W + 768;
                float a = 0.f;
                for (int cc = 0; cc < RWW; ++cc) {
                    const float xc = bf2f(cur[cc]), xp = t > 0 ? bf2f(cur[cc - PR_W]) : 0.f;
                    a += (xc + (xp - xc) * mu[768 + cc]) * v1[cc * LORA + i];
                }
                VL[idx] = a;
            }
        }
        __syncthreads();
        for (int idx = tid; idx < 64 * 64; idx += 512) {
            const int tt = idx >> 6, j = idx & 63, t = t0 + tt, cj = h * HD + j;
            const size_t row = (size_t)b * SEQ + t;
            const bf16_t* cur = PR + row * PR_W;
            const bool hp = t > 0;
            float rc = bf2f(cur[cj]), kc = bf2f(cur[384 + cj]), vc = bf2f(cur[768 + cj]);
            const float rp_ = hp ? bf2f(cur[cj - PR_W]) : 0.f, kp_ = hp ? bf2f(cur[384 + cj - PR_W]) : 0.f, vp_ = hp ? bf2f(cur[768 + cj - PR_W]) : 0.f;
            rc += (rp_ - rc) * mu[cj]; kc += (kp_ - kc) * mu[384 + cj]; vc += (vp_ - vc) * mu[768 + cj];
            float wl = w0[cj], al = a0[cj];
#pragma unroll 8
            for (int i = 0; i < LORA; ++i) { wl += WD[tt * 32 + i] * w2[i * RWW + cj]; al += AD[tt * 32 + i] * a2[i * RWW + cj]; }
            const float sp = fmaxf(-wl, 0.f) + log1pf(__expf(-fabsf(wl)));
            const float decay = __expf(-__expf(-sp - 0.5f));
            const float alr = sigmoidf_(al);
            if (l > 0) {
                float vg = v0[cj];
#pragma unroll 8
                for (int i = 0; i < LORA; ++i) vg += VL[tt * 32 + i] * v2[i * RWW + cj];
                vg = sigmoidf_(vg);
                vc = vc + (VF[row * RWW + cj] - vc) * vg;
            } else VF[row * RWW + cj] = vc;
            R[idx] = rc; W[idx] = decay; V[idx] = vc;
            K[idx] = kc * (1.0f + (alr - 1.0f) * ka[cj]);
            A[idx] = kc * kks[cj];
            Bm[idx] = alr;
        }
        __syncthreads();
        for (int q = 0; q < 8; ++q) {
            const int tt = wave * 8 + q; const float kk = A[tt * 64 + lane];
            const float nrm = sqrtf(wave_sum(kk * kk));
            const float kn = kk / fmaxf(nrm, 1e-12f);
            A[tt * 64 + lane] = -kn; Bm[tt * 64 + lane] = kn * Bm[tt * 64 + lane];
        }
        __syncthreads();
        if (wave == 0) {
            for (int tt = 0; tt < 64; ++tt) {
                const f32x4* a4 = (const f32x4*)(A + tt * 64); const f32x4* w4 = (const f32x4*)(W + tt * 64); const f32x4* b4 = (const f32x4*)(Bm + tt * 64);
                const f32x4* k4 = (const f32x4*)(K + tt * 64); const f32x4* r4 = (const f32x4*)(R + tt * 64);
                float sa = 0.f;
#pragma unroll
                for (int i = 0; i < 16; ++i) { const f32x4 a = a4[i]; sa += S[4 * i] * a[0] + S[4 * i + 1] * a[1] + S[4 * i + 2] * a[2] + S[4 * i + 3] * a[3];
                    if ((i & 7) == 7) asm volatile("" ::: "memory"); }
                const float vv = V[tt * 64 + lane];
                float y = 0.f;
#pragma unroll
                for (int i = 0; i < 16; ++i) { const f32x4 w = w4[i], bb = b4[i], kk = k4[i], rr = r4[i];
#pragma unroll
                    for (int e = 0; e < 4; ++e) { const float s = S[4 * i + e] * w[e] + sa * bb[e] + vv * kk[e]; S[4 * i + e] = s; y += s * rr[e]; }
                    if ((i & 1) == 1) asm volatile("" ::: "memory"); }
                Y[tt * 64 + lane] = y;
            }
        }
        __syncthreads();
        for (int q = 0; q < 8; ++q) {
            const int tt = wave * 8 + q, t = t0 + tt, cj = h * HD + lane; const size_t row = (size_t)b * SEQ + t;
            const float y = Y[tt * 64 + lane];
            const float mean = wave_sum(y) * (1.0f / HD); const float d = y - mean;
            const float var = wave_sum(d * d) * (1.0f / HD);
            const float yn = d * rsqrtf(var + GN_EPS) * gng[cj] + gnb[cj];
            const float bonus = wave_sum(R[tt * 64 + lane] * K[tt * 64 + lane] * rk[cj]);
            const float o = yn + bonus * V[tt * 64 + lane];
            const float g = bf2f(PG[row * PG_W + cj]);
            MIX[row * DM + CW + SBW + cj] = f2bf(o * siluf_(g));
        }
        __syncthreads();
    }
}

__device__ void phase_mixers(const Params& p, int l, unsigned char* lds) {
    constexpr int NRW = BATCH * NH, NAT = BATCH * NH * 4, NCV = BATCH * (SEQ / 32);
    const int G = gridDim.x;
    for (int job = blockIdx.x; job < NRW; job += G) rwkv_job(p, l, job, (float*)lds);
    const int start = (blockIdx.x + G - (NRW % G)) % G;
    for (int job = start; job < NAT; job += G) attn_job(p, job);
    for (int job = start; job < NCV; job += G) conv_job(p, l, job, (float*)lds);
}

constexpr int N_PHASES = 1 + 4 * DEPTH;
__device__ __forceinline__ void run_phase(const Params& p, int ph, unsigned char* lds) {
    unsigned char* ws = p.ws;
    if (ph == 0) { phase_prologue(p, lds); return; }
    const int l = (ph - 1) >> 2, k = (ph - 1) & 3;
    if (k == 0) {
#if SIMPLE_GEMM
        EpiInProj E{(bf16_t*)(ws + WS_PC), (bf16_t*)(ws + WS_PS), (bf16_t*)(ws + WS_PR), (bf16_t*)(ws + WS_PG)};
        gemm_simple((const bf16_t*)(ws + WS_XB), (const bf16_t*)(ws + WS_WIN) + (size_t)l * NINT * DM, M, NINT, DM, E);
#else
        EpiInProjP E{(bf16_t*)(ws + WS_PC), (bf16_t*)(ws + WS_PS), (bf16_t*)(ws + WS_PR), (bf16_t*)(ws + WS_PG)};
        pg8::Gemm g{(const bf16_t*)(ws + WS_XB), (const bf16_t*)(ws + WS_WIN) + (size_t)l * NINT * DM, M, NINT, DM}; pg8::StaticOrder S; S.init(M, NINT, (int)gridDim.x, (int)blockIdx.x);
        pg8::gemm_phase<EpiInProjP, pg8::StaticOrder, true, true>((PG8_LAS unsigned char*)lds, g, S, E);
#endif
    } else if (k == 1) {
        phase_mixers(p, l, lds);
    } else if (k == 2) {
#if SIMPLE_GEMM
        EpiF32 E{(float*)(ws + WS_Y), DM};
        gemm_simple((const bf16_t*)(ws + WS_MIX), (const bf16_t*)(ws + WS_WOUT) + (size_t)l * DM * DM, M, DM, DM, E);
#else
        EpiOutF32P E{(float*)(ws + WS_Y), DM};
        pg8::Gemm g{(const bf16_t*)(ws + WS_MIX), (const bf16_t*)(ws + WS_WOUT) + (size_t)l * DM * DM, M, DM, DM}; pg8::StaticOrder S; S.init(M, DM, (int)gridDim.x, (int)blockIdx.x);
        pg8::gemm_phase<EpiOutF32P, pg8::StaticOrder, true, true>((PG8_LAS unsigned char*)lds, g, S, E);
#endif
    } else {
        phase_rowpass(l == 0 ? p.in[0] : p.out, (const float*)(ws + WS_Y), p.in[2] + l * DM, p.out, l + 1 < DEPTH ? (bf16_t*)(ws + WS_XB) : nullptr);
    }
}

constexpr int LDS_BYTES = 147456;

#if MK_COOP
__global__ void __launch_bounds__(512, 2) fwd_kernel(Params p) {
    extern __shared__ __attribute__((aligned(16))) unsigned char lds[];
    cg::grid_group grid = cg::this_grid();
    for (int ph = p.ph_lo; ph < p.ph_hi; ++ph) {
        run_phase(p, ph, lds);
        if (ph + 1 < p.ph_hi) grid.sync();
    }
}
#else
__global__ void __launch_bounds__(512, 2) fwd_kernel(Params p) {
    extern __shared__ __attribute__((aligned(16))) unsigned char lds[];
    for (int ph = p.ph_lo; ph < p.ph_hi; ++ph) run_phase(p, ph, lds);
}
#endif

extern "C" void kernel_launch(void* const* d_in, const int* in_sizes, int n_in, void* d_out, int out_size, void* d_ws, size_t ws_size, hipStream_t stream) {
    static int grid = 0;
    if (grid == 0) {
        if (n_in != 24 || out_size != M * DM || ws_size < WS_END) { fprintf(stderr, "kernel_launch: unexpected problem (n_in %d out %d ws %zu)\n", n_in, out_size, ws_size); grid = -1; return; }
        int dev = 0, cus = 0, per_cu = 0;
        hipGetDevice(&dev); hipDeviceGetAttribute(&cus, hipDeviceAttributeMultiprocessorCount, dev);
        hipFuncSetAttribute((const void*)fwd_kernel, hipFuncAttributeMaxDynamicSharedMemorySize, LDS_BYTES);
        hipOccupancyMaxActiveBlocksPerMultiprocessor(&per_cu, (const void*)fwd_kernel, 512, LDS_BYTES);
        if (per_cu < 1) { fprintf(stderr, "kernel_launch: occupancy query says %d blocks per CU\n", per_cu); per_cu = 1; }
        grid = cus;
        (void)hipGetLastError();
    }
    if (grid < 0) return;
    Params p{};
    for (int i = 0; i < 24; ++i) p.in[i] = (const float*)d_in[i];
    p.out = (float*)d_out; p.ws = (unsigned char*)d_ws;
#if MK_COOP
    p.ph_lo = 0; p.ph_hi = N_PHASES;
    void* args[] = {&p};
    hipError_t e = hipLaunchCooperativeKernel((const void*)fwd_kernel, dim3(grid), dim3(512), args, LDS_BYTES, stream);
    if (e != hipSuccess) fprintf(stderr, "cooperative launch failed: %s (grid %d)\n", hipGetErrorString(e), grid);
#else
    for (int ph = 0; ph < N_PHASES; ++ph) {
        p.ph_lo = ph; p.ph_hi = ph + 1;
        hipLaunchKernelGGL(fwd_kernel, dim3(grid), dim3(512), LDS_BYTES, stream, p);
    }
#endif
}
```

```cpp
#include <hip/hip_runtime.h>
#include <hip/hip_cooperative_groups.h>
#include <cstdio>
#include <cstdint>
namespace cg = cooperative_groups;

#ifndef SIMPLE_GEMM
#define SIMPLE_GEMM 0
#endif
#ifndef MK_COOP
#define MK_COOP 1
#endif

constexpr int BATCH = 16, SEQ = 2048, DM = 1024, DEPTH = 2;
constexpr int M = BATCH * SEQ;
constexpr int HD = 64, NH = 6;
constexpr int CW = 256, SBW = 384, RWW = 384, LORA = 32, TAPS = 31;
constexpr int DIN = 3904;
constexpr int NINT = 4096;
constexpr int PC_W = 768, PS_W = 1536, PR_W = 1280, PG_W = 384;
constexpr float RMS_EPS = 1e-6f, LN_EPS = 1e-5f, GN_EPS = 64e-5f;

typedef unsigned short bf16_t;
typedef short bf16x8 __attribute__((ext_vector_type(8)));
typedef float f32x4 __attribute__((ext_vector_type(4)));
typedef unsigned short us4 __attribute__((ext_vector_type(4)));

constexpr size_t MiB = 1u << 20;
constexpr size_t WS_CTL = 0;
constexpr size_t WS_WIN = 1 * MiB;
constexpr size_t WS_WOUT = 17 * MiB;
constexpr size_t WS_XB = 21 * MiB;
constexpr size_t WS_MIX = WS_XB;
constexpr size_t WS_PC = 85 * MiB;
constexpr size_t WS_PS = 133 * MiB;
constexpr size_t WS_Y = WS_PC;
constexpr size_t WS_PR = 229 * MiB;
constexpr size_t WS_PG = 309 * MiB;
constexpr size_t WS_VF = 333 * MiB;
constexpr size_t WS_CH = 381 * MiB;
constexpr size_t CH_SZ = (size_t)3072 * 4096 * 2;
constexpr size_t WS_CH_M = WS_CH, WS_CH_NT = WS_CH + CH_SZ, WS_CH_G = WS_CH + 2 * CH_SZ, WS_CH_Y1T = WS_CH + 3 * CH_SZ, WS_CH_BV = WS_CH + 4 * CH_SZ;
constexpr size_t WS_ZT = WS_PR;
constexpr size_t WS_END = 501 * MiB;

struct Params {
    const float* in[24];
    float* out;
    unsigned char* ws;
    int ph_lo, ph_hi;
};

__device__ __forceinline__ float bf2f(bf16_t v) { return __uint_as_float(((unsigned)v) << 16); }
__device__ __forceinline__ bf16_t f2bf(float f) { unsigned u = __float_as_uint(f); return (bf16_t)((u + 0x7fffu + ((u >> 16) & 1u)) >> 16); }
__device__ __forceinline__ unsigned pk2(float lo, float hi) { return (unsigned)f2bf(lo) | ((unsigned)f2bf(hi) << 16); }
__device__ __forceinline__ float wave_sum(float v) {
#pragma unroll
    for (int o = 1; o < 64; o <<= 1) v += __shfl_xor(v, o);
    return v;
}
__device__ __forceinline__ float sigmoidf_(float x) { return 1.0f / (1.0f + __expf(-x)); }
__device__ __forceinline__ float siluf_(float x) { return x / (1.0f + __expf(-x)); }
__device__ __forceinline__ int tid_() { int t = threadIdx.x; asm volatile("" : "+v"(t)); return t; }
__device__ __forceinline__ int opaque_zero() { int z = 0; asm volatile("" : "+v"(z)); return z; }

__device__ __forceinline__ int orig_col(int n) { return n < 3520 ? n : (n < 3584 ? -1 : (n < 3968 ? n - 64 : -1)); }

__device__ void transpose_tile(const float* W, int ldw, int ncol_src, const float* gain, bf16_t* WT, int K, int n0, int k0, bool permute, float* tile  , const float* fold_v1 = nullptr, const float* fold_mu = nullptr) {
    const int tid = tid_();
#pragma unroll
    for (int i = 0; i < 8; ++i) {
        const int kl = (tid >> 6) + 8 * i, nl = tid & 63;
        const int n = n0 + nl, k = k0 + kl;
        const int oc = permute ? orig_col(n) : n;
        float v = 0.f;
        if (oc >= 0 && oc < ncol_src) v = W[(size_t)k * ldw + oc] * (gain ? gain[k] : 1.0f);
        if (fold_v1 && n >= 3520 && n < 3584) {
            const int i = (n - 3520) & 31; const bool second = n >= 3552; float a = 0.f;
            for (int c = 0; c < RWW; ++c) { const float m = fold_mu[c]; a += W[(size_t)k * ldw + 3072 + c] * (second ? m : 1.0f - m) * fold_v1[c * LORA + i]; }
            v = a * gain[k];
        }
        tile[kl * 65 + nl] = v;
    }
    __syncthreads();
#pragma unroll
    for (int i = 0; i < 8; ++i) {
        const int nl = (tid >> 6) + 8 * i, kl = tid & 63;
        WT[(size_t)(n0 + nl) * K + k0 + kl] = f2bf(tile[kl * 65 + nl]);
    }
    __syncthreads();
}

__device__ void rows_to_xb(const float* X, bf16_t* XB) {
    const int tid = tid_(), lane = tid & 63, wave = tid >> 6;
    for (int row = blockIdx.x * 8 + wave; row < M; row += gridDim.x * 8) {
        const float* xr = X + (size_t)row * DM;
        f32x4 v[4]; float ss = 0.f;
#pragma unroll
        for (int i = 0; i < 4; ++i) { v[i] = *(const f32x4*)(xr + i * 256 + lane * 4); ss += v[i][0] * v[i][0] + v[i][1] * v[i][1] + v[i][2] * v[i][2] + v[i][3] * v[i][3]; }
        ss = wave_sum(ss);
        const float rstd = rsqrtf(ss * (1.0f / DM) + RMS_EPS);
#pragma unroll
        for (int i = 0; i < 4; ++i) { uint2 w; w.x = pk2(v[i][0] * rstd, v[i][1] * rstd); w.y = pk2(v[i][2] * rstd, v[i][3] * rstd); *(uint2*)(XB + (size_t)row * DM + i * 256 + lane * 4) = w; }
    }
}

__device__ void phase_prologue(const Params& p, unsigned char* lds) {
    float* tile = (float*)lds;
    bf16_t* WinT = (bf16_t*)(p.ws + WS_WIN); bf16_t* WoutT = (bf16_t*)(p.ws + WS_WOUT);
    const int nt_in = (NINT / 64) * (DM / 64), nt_out = (DM / 64) * (DM / 64);
    const int total = DEPTH * (nt_in + nt_out);
    for (int j = blockIdx.x; j < total; j += gridDim.x) {
        int l = j / (nt_in + nt_out), r = j % (nt_in + nt_out);
        if (r < nt_in) { const int tn = r / (DM / 64), tk = r % (DM / 64);
            transpose_tile(p.in[3] + (size_t)l * DM * DIN, DIN, DIN, p.in[1] + l * DM, WinT + (size_t)l * NINT * DM, DM, tn * 64, tk * 64, true, tile, l > 0 ? p.in[22] : nullptr, p.in[11] + l * 1216 + 768);
        } else { r -= nt_in; const int tn = r / (DM / 64), tk = r % (DM / 64);
            transpose_tile(p.in[4] + (size_t)l * DM * DM, DM, DM, nullptr, WoutT + (size_t)l * DM * DM, DM, tn * 64, tk * 64, false, tile);
        }
    }
    rows_to_xb(p.in[0], (bf16_t*)(p.ws + WS_XB));
}

namespace pg8 {
#define PG8_LAS __attribute__((address_space(3)))
typedef unsigned short bf16_t;
typedef short bf16x8 __attribute__((ext_vector_type(8)));
typedef float f32x4 __attribute__((ext_vector_type(4)));
typedef unsigned u32x4 __attribute__((ext_vector_type(4)));
constexpr int BM = 256, BK = 64, HALF = 128, HTB = HALF * BK * 2  , STAGE_BYTES = 8 * HTB, NXCD = 8, WGM = 8;

__host__ __device__ __forceinline__ int lds_byte(int r, int c) { const int st = (r >> 4) * 2 + (c >> 5), rr = r & 15, cc = c & 31, ob = rr * 64 + cc * 2; return st * 1024 + (ob ^ (((ob >> 9) & 1) << 5)); }
__host__ __device__ __forceinline__ void stage_rc(int b, int& R, int& C) { const int st = b / 1024, sb = b % 1024, swz = sb ^ (((sb >> 9) & 1) << 5); R = (st >> 1) * 16 + swz / 64; C = (st & 1) * 32 + (swz % 64) / 2; }
__host__ __device__ __forceinline__ int perm32(int rho) { const int n = rho >> 4, i = rho & 15; return 8 * (i >> 2) + 4 * n + (i & 3); }

struct Unit { int pm, pn; };
struct Gemm { const bf16_t* A; const bf16_t* Bt; int M, N, K; };

struct StaticOrder {
    int nM, nN, nwg, G, c;
    __host__ __device__ void init(int M, int N, int G_, int c_) { nM = M / BM; nN = N / BM; nwg = nM * nN; G = G_; c = c_; }
    __host__ __device__ bool next(int i, Unit& u) const {
        const long L = (long)i * G + c; if (L >= nwg) return false;
        int wgid = (int)L; { const int q = nwg / NXCD, r = nwg % NXCD, xcd = wgid % NXCD, off = wgid / NXCD; wgid = (xcd < r ? xcd * (q + 1) : r * (q + 1) + (xcd - r) * q) + off; }
        const int nig = WGM * nN, gid = wgid / nig, fm = gid * WGM, gsz = (nM - fm) < WGM ? (nM - fm) : WGM;
        u.pm = fm + ((wgid % nig) % gsz); u.pn = (wgid % nig) / gsz; return true;
    }
    __device__ __forceinline__ void a_ready(const Unit&) const {}
    __device__ __forceinline__ void done(const Unit&) const {}
};


__device__ __forceinline__ unsigned cvt_pk_bf16(float lo, float hi) { unsigned r; asm volatile("v_cvt_pk_bf16_f32 %0, %1, %2" : "=v"(r) : "v"(lo), "v"(hi)); return r; }

template <class Epi, class Sched, bool ALIGN_EPI = false, bool SP2 = false>
__device__ __forceinline__ void gemm_phase(PG8_LAS unsigned char* lds, const Gemm g, const Sched& S, const Epi& E) {
    const int tid = tid_(), wid = __builtin_amdgcn_readfirstlane(tid >> 6), lane = tid & 63, wr = wid >> 2, wc = wid & 3, fr = lane & 15, fq = lane >> 4;
    const int K = g.K, nt = K / BK;
    unsigned voffA[2], voffB[2];
#pragma unroll
    for (int i = 0; i < 2; ++i) { int R, C; stage_rc(tid * 16 + i * 8192, R, C); const int Rb = Epi::PERM ? ((R & ~31) + perm32(R & 31)) : R;
        voffA[i] = (unsigned)(R * K + C) * 2u; voffB[i] = (unsigned)(Rb * K + C) * 2u; }
    const size_t kstep = (size_t)(BK * 2);
    const size_t hstep = (size_t)HALF * K * 2;
    const size_t tstep = 2 * hstep;
    const unsigned ldsw = (unsigned)wid * 1024u;
    const int aoff = lds_byte(wr * 64 + fr, fq * 8), boff = lds_byte(wc * 32 + fr, fq * 8);
#define PG8_SA(b, h) (((b) * 2 + (h)) * HTB)
#define PG8_SB(b, h) ((4 + (b) * 2 + (h)) * HTB)
#define PG8_STAGE(bufoff, gbase, voff) do { _Pragma("unroll") for (int _i = 0; _i < 2; ++_i) \
        __builtin_amdgcn_global_load_lds((const unsigned*)((const char*)(gbase) + (voff)[_i]), (PG8_LAS unsigned*)(lds + (bufoff) + ldsw + _i * 8192), 16, 0, 0); } while (0)
#define PG8_LDA(dst, b, h) do { _Pragma("unroll") for (int m = 0; m < 4; ++m) _Pragma("unroll") for (int k = 0; k < 2; ++k) dst[m][k] = *(const PG8_LAS bf16x8*)(lds + PG8_SA(b, h) + aoff + m * 2048 + k * 1024); } while (0)
#define PG8_LDB(dst, b, h) do { _Pragma("unroll") for (int n = 0; n < 2; ++n) _Pragma("unroll") for (int k = 0; k < 2; ++k) dst[n][k] = *(const PG8_LAS bf16x8*)(lds + PG8_SB(b, h) + boff + n * 2048 + k * 1024); } while (0)
#define PG8_MMA(ai, bj, At, Bt) do { __builtin_amdgcn_s_setprio(1); _Pragma("unroll") for (int m = 0; m < 4; ++m) _Pragma("unroll") for (int n = 0; n < 2; ++n) _Pragma("unroll") for (int k = 0; k < 2; ++k) \
        acc[ai][bj][m][n] = __builtin_amdgcn_mfma_f32_16x16x32_bf16(Bt[n][k], At[m][k], acc[ai][bj][m][n], 0, 0, 0); __builtin_amdgcn_s_setprio(0); } while (0)
#define PG8_WAIT_V(n) asm volatile("s_waitcnt vmcnt(" #n ")" ::: "memory")
#define PG8_WAIT_L(n) asm volatile("s_waitcnt lgkmcnt(" #n ")" ::: "memory")
#define PG8_BAR __builtin_amdgcn_s_barrier()
#define PG8_SCHED __builtin_amdgcn_sched_barrier(0)
    Unit cur, nxt; int ui = 0;
    if (!S.next(0, cur)) return;
    f32x4 acc[2][2][4][2];
#pragma unroll
    for (int a = 0; a < 2; ++a)
#pragma unroll
        for (int b = 0; b < 2; ++b)
#pragma unroll
            for (int m = 0; m < 4; ++m)
#pragma unroll
                for (int n = 0; n < 2; ++n) acc[a][b][m][n] = (f32x4){0.f, 0.f, 0.f, 0.f};
    bf16x8 At[4][2], B0[2][2], B1[2][2];
    const char* cA = (const char*)g.A + (size_t)cur.pm * tstep; const char* cB = (const char*)g.Bt + (size_t)cur.pn * tstep;
    S.a_ready(cur);
    if constexpr (SP2) {
        PG8_STAGE(PG8_SB(0, 0), cB, voffB); PG8_STAGE(PG8_SB(0, 1), cB + hstep, voffB); PG8_STAGE(PG8_SA(0, 0), cA, voffA); PG8_STAGE(PG8_SA(0, 1), cA + hstep, voffA);
        if (wr == 1) PG8_BAR;
        PG8_WAIT_V(2); PG8_BAR;
        PG8_STAGE(PG8_SB(1, 0), cB + kstep, voffB); PG8_STAGE(PG8_SA(1, 0), cA + kstep, voffA); PG8_STAGE(PG8_SB(1, 1), cB + hstep + kstep, voffB);
        PG8_WAIT_V(6); PG8_BAR;
    } else {
        PG8_STAGE(PG8_SB(0, 0), cB, voffB); PG8_STAGE(PG8_SA(0, 0), cA, voffA); PG8_STAGE(PG8_SB(0, 1), cB + hstep, voffB); PG8_STAGE(PG8_SA(0, 1), cA + hstep, voffA);
        if (wr == 1) PG8_BAR;
        PG8_WAIT_V(4); PG8_BAR;
        PG8_STAGE(PG8_SB(1, 0), cB + kstep, voffB); PG8_STAGE(PG8_SA(1, 0), cA + kstep, voffA); PG8_STAGE(PG8_SB(1, 1), cB + hstep + kstep, voffB);
        PG8_WAIT_V(6); PG8_BAR;
    }
    for (;;) {
        const bool has_next = S.next(ui + 1, nxt);
        const char* nA = has_next ? (const char*)g.A + (size_t)nxt.pm * tstep : cA; const char* nB = has_next ? (const char*)g.Bt + (size_t)nxt.pn * tstep : cB;
        for (int t = 0; t < nt; t += 2) {
            const bool last = (t == nt - 2);
            const char* a1 = cA + (size_t)(t + 1) * kstep;
            const char* a2 = last ? nA : cA + (size_t)(t + 2) * kstep; const char* b2 = last ? nB : cB + (size_t)(t + 2) * kstep;
            const char* a3 = a2 + kstep; const char* b3 = b2 + kstep;
            if (last && has_next) S.a_ready(nxt);
            if constexpr (SP2) {
            PG8_LDB(B0, 0, 0); PG8_LDB(B1, 0, 1); PG8_SCHED; PG8_LDA(At, 0, 0); PG8_STAGE(PG8_SA(1, 1), a1 + hstep, voffA);
            PG8_WAIT_V(8); PG8_WAIT_L(0); PG8_BAR; PG8_MMA(0, 0, At, B0); PG8_MMA(0, 1, At, B1); PG8_BAR; PG8_SCHED;
            PG8_LDA(At, 0, 1); PG8_STAGE(PG8_SB(0, 0), b2, voffB); PG8_STAGE(PG8_SB(0, 1), b2 + hstep, voffB); PG8_STAGE(PG8_SA(0, 0), a2, voffA);
            PG8_WAIT_V(8); PG8_WAIT_L(0); PG8_BAR; PG8_MMA(1, 0, At, B0); PG8_MMA(1, 1, At, B1); PG8_BAR; PG8_SCHED;
            PG8_LDB(B0, 1, 0); PG8_LDB(B1, 1, 1); PG8_SCHED; PG8_LDA(At, 1, 0); PG8_STAGE(PG8_SA(0, 1), a2 + hstep, voffA);
            PG8_WAIT_V(8); PG8_WAIT_L(0); PG8_BAR; PG8_MMA(0, 0, At, B0); PG8_MMA(0, 1, At, B1); PG8_BAR; PG8_SCHED;
            PG8_LDA(At, 1, 1); PG8_STAGE(PG8_SB(1, 0), b3, voffB); PG8_STAGE(PG8_SB(1, 1), b3 + hstep, voffB); PG8_STAGE(PG8_SA(1, 0), a3, voffA);
            PG8_WAIT_V(8); PG8_WAIT_L(0); PG8_BAR; PG8_MMA(1, 0, At, B0); PG8_MMA(1, 1, At, B1); PG8_BAR; PG8_SCHED;
            } else {
            PG8_LDB(B0, 0, 0); PG8_SCHED; PG8_LDA(At, 0, 0); PG8_STAGE(PG8_SA(1, 1), a1 + hstep, voffA);
            PG8_WAIT_L(8); PG8_BAR; PG8_WAIT_L(0); PG8_MMA(0, 0, At, B0); PG8_BAR; PG8_SCHED;
            PG8_LDB(B1, 0, 1); PG8_STAGE(PG8_SB(0, 0), b2, voffB);
            PG8_BAR; PG8_WAIT_L(0); PG8_MMA(0, 1, At, B1); PG8_BAR;
            PG8_LDA(At, 0, 1); PG8_STAGE(PG8_SA(0, 0), a2, voffA);
            PG8_BAR; PG8_WAIT_L(0); PG8_MMA(1, 0, At, B0); PG8_BAR; PG8_SCHED;
            PG8_STAGE(PG8_SB(0, 1), b2 + hstep, voffB);
            PG8_WAIT_V(6); PG8_BAR; PG8_MMA(1, 1, At, B1); PG8_BAR;
            PG8_LDB(B0, 1, 0); PG8_SCHED; PG8_LDA(At, 1, 0); PG8_STAGE(PG8_SA(0, 1), a2 + hstep, voffA);
            PG8_WAIT_L(8); PG8_BAR; PG8_WAIT_L(0); PG8_MMA(0, 0, At, B0); PG8_BAR; PG8_SCHED;
            PG8_LDB(B1, 1, 1); PG8_STAGE(PG8_SB(1, 0), b3, voffB);
            PG8_BAR; PG8_WAIT_L(0); PG8_MMA(0, 1, At, B1); PG8_BAR;
            PG8_LDA(At, 1, 1); PG8_STAGE(PG8_SA(1, 0), a3, voffA);
            PG8_BAR; PG8_WAIT_L(0); PG8_MMA(1, 0, At, B0); PG8_BAR; PG8_SCHED;
            PG8_STAGE(PG8_SB(1, 1), b3 + hstep, voffB);
            PG8_WAIT_V(6); PG8_BAR; PG8_MMA(1, 1, At, B1); PG8_BAR;
            }
        }
        if constexpr (ALIGN_EPI) { if (wr == 0) PG8_BAR; }
        if constexpr (!Epi::AFTER_DRAIN) { E(acc, cur, wr, wc, fr, fq); S.done(cur); }
        if (!has_next) break;
#pragma unroll
        for (int a = 0; a < 2; ++a)
#pragma unroll
            for (int b = 0; b < 2; ++b)
#pragma unroll
                for (int m = 0; m < 4; ++m)
#pragma unroll
                    for (int n = 0; n < 2; ++n) acc[a][b][m][n] = (f32x4){0.f, 0.f, 0.f, 0.f};
        cur = nxt; cA = nA; cB = nB; ++ui;
        if constexpr (ALIGN_EPI) { if (wr == 1) PG8_BAR; }
    }
    PG8_WAIT_V(0);
    if constexpr (!ALIGN_EPI) { if (wr == 0) PG8_BAR; }
    PG8_BAR;
    if constexpr (Epi::AFTER_DRAIN) { E.fused(acc, cur, wr, wc, fr, fq, lds, wid, lane); S.done(cur); }
#undef PG8_SA
#undef PG8_SB
#undef PG8_STAGE
#undef PG8_LDA
#undef PG8_LDB
#undef PG8_MMA
#undef PG8_WAIT_V
#undef PG8_WAIT_L
#undef PG8_BAR
#undef PG8_SCHED
}
}

template <class Epi>
__device__ void gemm_simple(const bf16_t* A, const bf16_t* Bt, int Mr, int N, int K, const Epi& epi) {
    const int tid = tid_(), wave = tid >> 6, lane = tid & 63, wm = wave >> 1, wn = wave & 1, fr = lane & 15, fq = lane >> 4;
    const int nNt = N / 128, nMt = Mr / 128;
    for (int tile = blockIdx.x; tile < nNt * nMt; tile += gridDim.x) {
        const int tm = tile / nNt, tn = tile % nNt;
        const int m0 = tm * 128 + wm * 32, n0 = tn * 128 + wn * 64;
        f32x4 acc[2][4];
#pragma unroll
        for (int i = 0; i < 2; ++i)
#pragma unroll
            for (int j = 0; j < 4; ++j) acc[i][j] = (f32x4){0.f, 0.f, 0.f, 0.f};
        const bf16_t* ap = A + (size_t)(m0 + fr) * K + fq * 8;
        const bf16_t* bp = Bt + (size_t)(n0 + fr) * K + fq * 8;
        for (int k = 0; k < K; k += 32) {
            bf16x8 af[2], bfr[4];
#pragma unroll
            for (int i = 0; i < 2; ++i) af[i] = *(const bf16x8*)(ap + (size_t)i * 16 * K + k);
#pragma unroll
            for (int j = 0; j < 4; ++j) bfr[j] = *(const bf16x8*)(bp + (size_t)j * 16 * K + k);
#pragma unroll
            for (int i = 0; i < 2; ++i)
#pragma unroll
                for (int j = 0; j < 4; ++j) acc[i][j] = __builtin_amdgcn_mfma_f32_16x16x32_bf16(bfr[j], af[i], acc[i][j], 0, 0, 0);
        }
#pragma unroll
        for (int i = 0; i < 2; ++i)
#pragma unroll
            for (int j = 0; j < 4; ++j) epi(m0 + i * 16 + fr, n0 + j * 16 + fq * 4, acc[i][j]);
    }
}

struct EpiInProj {
    bf16_t *PC, *PS, *PR, *PG;
    __device__ __forceinline__ void operator()(int m, int n, const f32x4& v) const {
        bf16_t* dst;
        if (n < 768) dst = PC + (size_t)m * PC_W + n;
        else if (n < 2304) dst = PS + (size_t)m * PS_W + (n - 768);
        else if (n < 3584) dst = PR + (size_t)m * PR_W + (n - 2304);
        else if (n < 3968) dst = PG + (size_t)m * PG_W + (n - 3584);
        else return;
        uint2 w; w.x = pk2(v[0], v[1]); w.y = pk2(v[2], v[3]); *(uint2*)dst = w;
    }
};
struct EpiF32 {
    float* Y; int ld;
    __device__ __forceinline__ void operator()(int m, int n, const f32x4& v) const { *(f32x4*)(Y + (size_t)m * ld + n) = v; }
};


struct EpiInProjP {
    static constexpr bool PERM = true, AFTER_DRAIN = false;
    bf16_t *PC, *PS, *PR, *PG;
    __device__ __forceinline__ void operator()(const pg8::f32x4 (&acc)[2][2][4][2], const pg8::Unit& u, int wr, int wc, int fr, int fq) const {
        const int row0 = u.pm * 256 + wr * 64 + fr;
#pragma unroll
        for (int bj = 0; bj < 2; ++bj) {
            const int blk = 2 * u.pn + bj; bf16_t* base; int ld, c0;
            if (blk < 6) { base = PC; ld = PC_W; c0 = 128 * blk; }
            else if (blk < 18) { base = PS; ld = PS_W; c0 = 128 * (blk - 6); }
            else if (blk < 28) { base = PR; ld = PR_W; c0 = 128 * (blk - 18); }
            else if (blk < 31) { base = PG; ld = PG_W; c0 = 128 * (blk - 28); }
            else continue;
            const int col = c0 + wc * 32 + 8 * fq;
#pragma unroll
            for (int ai = 0; ai < 2; ++ai)
#pragma unroll
                for (int m = 0; m < 4; ++m) {
                    const pg8::f32x4 v0 = acc[ai][bj][m][0], v1 = acc[ai][bj][m][1]; pg8::u32x4 w;
                    w.x = pg8::cvt_pk_bf16(v0[0], v0[1]); w.y = pg8::cvt_pk_bf16(v0[2], v0[3]); w.z = pg8::cvt_pk_bf16(v1[0], v1[1]); w.w = pg8::cvt_pk_bf16(v1[2], v1[3]);
                    *(pg8::u32x4*)(base + (size_t)(row0 + ai * 128 + m * 16) * ld + col) = w;
                }
        }
    }
};
struct EpiOutF32P {
    static constexpr bool PERM = false, AFTER_DRAIN = false;
    float* Y; int ld;
    __device__ __forceinline__ void operator()(const pg8::f32x4 (&acc)[2][2][4][2], const pg8::Unit& u, int wr, int wc, int fr, int fq) const {
        const int row0 = u.pm * 256 + wr * 64 + fr, col0 = u.pn * 256 + wc * 32 + 4 * fq;
#pragma unroll
        for (int ai = 0; ai < 2; ++ai)
#pragma unroll
            for (int m = 0; m < 4; ++m)
#pragma unroll
                for (int bj = 0; bj < 2; ++bj)
#pragma unroll
                    for (int n = 0; n < 2; ++n) *(pg8::f32x4*)(Y + (size_t)(row0 + ai * 128 + m * 16) * ld + col0 + bj * 128 + n * 16) = acc[ai][bj][m][n];
    }
};

__device__ void phase_rowpass(const float* Xin, const float* Y, const float* gpost, float* Xout, bf16_t* XB) {
    const int tid = tid_(), lane = tid & 63, wave = tid >> 6;
    for (int row = blockIdx.x * 8 + wave; row < M; row += gridDim.x * 8) {
        f32x4 y[4], x[4]; float ss = 0.f;
#pragma unroll
        for (int i = 0; i < 4; ++i) { y[i] = *(const f32x4*)(Y + (size_t)row * DM + i * 256 + lane * 4); x[i] = *(const f32x4*)(Xin + (size_t)row * DM + i * 256 + lane * 4);
            ss += y[i][0] * y[i][0] + y[i][1] * y[i][1] + y[i][2] * y[i][2] + y[i][3] * y[i][3]; }
        ss = wave_sum(ss);
        const float rstd = rsqrtf(ss * (1.0f / DM) + RMS_EPS);
        float s2 = 0.f;
#pragma unroll
        for (int i = 0; i < 4; ++i) { const f32x4 g = *(const f32x4*)(gpost + i * 256 + lane * 4);
            x[i] = x[i] + y[i] * rstd * g; s2 += x[i][0] * x[i][0] + x[i][1] * x[i][1] + x[i][2] * x[i][2] + x[i][3] * x[i][3];
            *(f32x4*)(Xout + (size_t)row * DM + i * 256 + lane * 4) = x[i]; }
        if (XB) {
            s2 = wave_sum(s2);
            const float r2 = rsqrtf(s2 * (1.0f / DM) + RMS_EPS);
#pragma unroll
            for (int i = 0; i < 4; ++i) { uint2 w; w.x = pk2(x[i][0] * r2, x[i][1] * r2); w.y = pk2(x[i][2] * r2, x[i][3] * r2); *(uint2*)(XB + (size_t)row * DM + i * 256 + lane * 4) = w; }
        }
    }
}

__device__ void conv_job(const Params& p, int l, int job, float* lds) {
    const int tid = tid_(), lane = tid & 63, wave = tid >> 6;
    const int b = job / (SEQ / 32), t0 = (job % (SEQ / 32)) * 32;
    const bf16_t* PC = (const bf16_t*)(p.ws + WS_PC); bf16_t* MIX = (bf16_t*)(p.ws + WS_MIX);
    const float* dw = p.in[5] + l * TAPS * CW; const float* dwb = p.in[6] + l * CW; const float* lng = p.in[7] + l * CW; const float* lnb = p.in[8] + l * CW;
    const float* pw = p.in[9] + (size_t)l * CW * CW; const float* pwb = p.in[10] + l * CW;
    float* u = lds;
    float* cv = lds + 62 * 256;
    for (int idx = tid; idx < 62 * 256; idx += 512) {
        const int r = idx >> 8, c = idx & 255, t = t0 - 30 + r;
        float v = 0.f;
        if (t >= 0) { const bf16_t* pr = PC + (size_t)(b * SEQ + t) * PC_W; v = bf2f(pr[c]) * sigmoidf_(bf2f(pr[256 + c])); }
        u[idx] = v;
    }
    __syncthreads();
    for (int idx = tid; idx < 32 * 256; idx += 512) {
        const int tt = idx >> 8, c = idx & 255;
        float a = dwb[c];
#pragma unroll 4
        for (int j = 0; j < TAPS; ++j) a += dw[j * CW + c] * u[(tt + j) * 256 + c];
        cv[idx] = a;
    }
    __syncthreads();
    for (int q = 0; q < 4; ++q) {
        const int tt = wave * 4 + q; float x[4], s = 0.f;
#pragma unroll
        for (int i = 0; i < 4; ++i) { x[i] = cv[tt * 256 + lane + 64 * i]; s += x[i]; }
        const float mean = wave_sum(s) * (1.0f / CW); float vs = 0.f;
#pragma unroll
        for (int i = 0; i < 4; ++i) { const float d = x[i] - mean; vs += d * d; }
        const float rstd = rsqrtf(wave_sum(vs) * (1.0f / CW) + LN_EPS);
#pragma unroll
        for (int i = 0; i < 4; ++i) { const int c = lane + 64 * i; cv[tt * 256 + c] = siluf_((x[i] - mean) * rstd * lng[c] + lnb[c]); }
    }
    __syncthreads();
    {
        const int n = tid & 255, half = tid >> 8;
        float acc[16];
#pragma unroll
        for (int i = 0; i < 16; ++i) acc[i] = pwb[n];
#pragma unroll 2
        for (int k = 0; k < CW; ++k) {
            const float w = pw[(size_t)k * CW + n];
#pragma unroll
            for (int i = 0; i < 16; ++i) acc[i] += cv[(half * 16 + i) * 256 + k] * w;
        }
#pragma unroll
        for (int i = 0; i < 16; ++i) { const size_t row = (size_t)b * SEQ + t0 + half * 16 + i;
            const float g = bf2f(PC[row * PC_W + 512 + n]);
            MIX[row * DM + n] = f2bf(acc[i] * siluf_(g)); }
    }
    __syncthreads();
}

__device__ void attn_job(const Params& p, int job) {
    const int tid = tid_(), lane = tid & 63, wave = tid >> 6;
    const int bh = job >> 2, qb = job & 3, b = bh / NH, h = bh % NH;
    const bf16_t* PS = (const bf16_t*)(p.ws + WS_PS); bf16_t* MIX = (bf16_t*)(p.ws + WS_MIX);
    const int tw = qb * 512 + wave * 64, t = tw + lane;
    const size_t row = (size_t)b * SEQ + t;
    const float qs = 0.125f * 1.4426950408889634f;
    float q[64], o[64];
    {
        const bf16_t* qp = PS + row * PS_W + h * HD;
#pragma unroll
        for (int i = 0; i < 8; ++i) { const bf16x8 v = *(const bf16x8*)(qp + i * 8);
#pragma unroll
            for (int j = 0; j < 8; ++j) { q[i * 8 + j] = bf2f((bf16_t)v[j]) * qs; o[i * 8 + j] = 0.f; } }
    }
    float rp = 1.0f;
    const int z = opaque_zero();
    for (int s = tw + 62; s >= 0; --s) {
        const bf16_t* kp = PS + ((size_t)b * SEQ + s) * PS_W + 384 + h * HD + z;
        float dot = 0.f;
#pragma unroll
        for (int i = 0; i < 8; ++i) { const bf16x8 v = *(const bf16x8*)(kp + i * 8);
#pragma unroll
            for (int j = 0; j < 8; ++j) dot += q[i * 8 + j] * bf2f((bf16_t)v[j]); }
        const bool act = s < t;
        const float e = __builtin_amdgcn_exp2f(dot);
        const float keep = __builtin_amdgcn_rcpf(1.0f + e);
        const float pr = act ? (1.0f - keep) * rp : 0.f;
        rp = act ? rp * keep : rp;
        const bf16_t* vp = kp + 384;
#pragma unroll
        for (int i = 0; i < 8; ++i) { const bf16x8 v = *(const bf16x8*)(vp + i * 8);
#pragma unroll
            for (int j = 0; j < 8; ++j) o[i * 8 + j] += pr * bf2f((bf16_t)v[j]); }
        if (__all(rp == 0.0f)) break;
    }
    const bf16_t* gp = PS + row * PS_W + 1152 + h * HD;
    bf16_t* op = MIX + row * DM + CW + h * HD;
#pragma unroll
    for (int i = 0; i < 8; ++i) { const bf16x8 g = *(const bf16x8*)(gp + i * 8); uint4 w;
        w.x = pk2(o[i * 8 + 0] * siluf_(bf2f((bf16_t)g[0])), o[i * 8 + 1] * siluf_(bf2f((bf16_t)g[1])));
        w.y = pk2(o[i * 8 + 2] * siluf_(bf2f((bf16_t)g[2])), o[i * 8 + 3] * siluf_(bf2f((bf16_t)g[3])));
        w.z = pk2(o[i * 8 + 4] * siluf_(bf2f((bf16_t)g[4])), o[i * 8 + 5] * siluf_(bf2f((bf16_t)g[5])));
        w.w = pk2(o[i * 8 + 6] * siluf_(bf2f((bf16_t)g[6])), o[i * 8 + 7] * siluf_(bf2f((bf16_t)g[7])));
        *(uint4*)(op + i * 8) = w; }
}

__device__ void rwkv_job(const Params& p, int l, int job, float* lds) {
    const int tid = tid_(), lane = tid & 63, wave = tid >> 6;
    const int b = job / NH, h = job % NH;
    const bf16_t* PR = (const bf16_t*)(p.ws + WS_PR); const bf16_t* PG = (const bf16_t*)(p.ws + WS_PG);
    float* VF = (float*)(p.ws + WS_VF); bf16_t* MIX = (bf16_t*)(p.ws + WS_MIX);
    const float* mu = p.in[11] + l * 1216; const float* w0 = p.in[12] + l * RWW; const float* w2 = p.in[13] + l * LORA * RWW;
    const float* a0 = p.in[14] + l * RWW; const float* a2 = p.in[15] + l * LORA * RWW; const float* kks = p.in[16] + l * RWW; const float* ka = p.in[17] + l * RWW;
    const float* rk = p.in[18] + l * RWW; const float* gng = p.in[19] + l * RWW; const float* gnb = p.in[20] + l * RWW;
    const float* v0 = p.in[21]; const float* v1 = p.in[22]; const float* v2 = p.in[23];
    float* R = lds; float* W = R + 4096; float* K = W + 4096; float* V = K + 4096; float* A = V + 4096; float* Bm = A + 4096; float* Y = Bm + 4096;
    float* WD = Y + 4096; float* AD = WD + 2048; float* VL = AD + 2048;
    float S[64];
#pragma unroll
    for (int i = 0; i < 64; ++i) S[i] = 0.f;
    for (int c = 0; c < SEQ / 64; ++c) {
        const int t0 = c * 64;
        for (int idx = tid; idx < 64 * 64; idx += 512) {
            const int tt = idx >> 6, i = idx & 63, t = t0 + tt;
            const bf16_t* cur = PR + ((size_t)b * SEQ + t) * PR_W;
            const float xc = bf2f(cur[1152 + i]), xp = t > 0 ? bf2f(cur[1152 + i - PR_W]) : 0.f;
            const float f = xc + (xp - xc) * mu[1152 + i];
            if (i < 32) WD[tt * 32 + i] = tanhf(f); else AD[tt * 32 + i - 32] = f;
        }
        if (l > 0) {
            for (int idx = tid; idx < 64 * 32; idx += 512) {
                const int tt = idx >> 5, i = idx & 31, t = t0 + tt;
                const bf16_t* cur = PR + ((size_t)b * SEQ + t) * PR_W + 768;
                float a = 0.f;
                for (int cc = 0; cc < RWW; ++cc) {
                    const float xc = bf2f(cur[cc]), xp = t > 0 ? bf2f(cur[cc - PR_W]) : 0.f;
                    a += (xc + (xp - xc) * mu[768 + cc]) * v1[cc * LORA + i];
                }
                VL[idx] = a;
            }
        }
        __syncthreads();
        for (int idx = tid; idx < 64 * 64; idx += 512) {
            const int tt = idx >> 6, j = idx & 63, t = t0 + tt, cj = h * HD + j;
            const size_t row = (size_t)b * SEQ + t;
            const bf16_t* cur = PR + row * PR_W;
            const bool hp = t > 0;
            float rc = bf2f(cur[cj]), kc = bf2f(cur[384 + cj]), vc = bf2f(cur[768 + cj]);
            const float rp_ = hp ? bf2f(cur[cj - PR_W]) : 0.f, kp_ = hp ? bf2f(cur[384 + cj - PR_W]) : 0.f, vp_ = hp ? bf2f(cur[768 + cj - PR_W]) : 0.f;
            rc += (rp_ - rc) * mu[cj]; kc += (kp_ - kc) * mu[384 + cj]; vc += (vp_ - vc) * mu[768 + cj];
            float wl = w0[cj], al = a0[cj];
#pragma unroll 8
            for (int i = 0; i < LORA; ++i) { wl += WD[tt * 32 + i] * w2[i * RWW + cj]; al += AD[tt * 32 + i] * a2[i * RWW + cj]; }
            const float sp = fmaxf(-wl, 0.f) + log1pf(__expf(-fabsf(wl)));
            const float decay = __expf(-__expf(-sp - 0.5f));
            const float alr = sigmoidf_(al);
            if (l > 0) {
                float vg = v0[cj];
#pragma unroll 8
                for (int i = 0; i < LORA; ++i) vg += VL[tt * 32 + i] * v2[i * RWW + cj];
                vg = sigmoidf_(vg);
                vc = vc + (VF[row * RWW + cj] - vc) * vg;
            } else VF[row * RWW + cj] = vc;
            R[idx] = rc; W[idx] = decay; V[idx] = vc;
            K[idx] = kc * (1.0f + (alr - 1.0f) * ka[cj]);
            A[idx] = kc * kks[cj];
            Bm[idx] = alr;
        }
        __syncthreads();
        for (int q = 0; q < 8; ++q) {
            const int tt = wave * 8 + q; const float kk = A[tt * 64 + lane];
            const float nrm = sqrtf(wave_sum(kk * kk));
            const float kn = kk / fmaxf(nrm, 1e-12f);
            A[tt * 64 + lane] = -kn; Bm[tt * 64 + lane] = kn * Bm[tt * 64 + lane];
        }
        __syncthreads();
        if (wave == 0) {
            for (int tt = 0; tt < 64; ++tt) {
                const f32x4* a4 = (const f32x4*)(A + tt * 64); const f32x4* w4 = (const f32x4*)(W + tt * 64); const f32x4* b4 = (const f32x4*)(Bm + tt * 64);
                const f32x4* k4 = (const f32x4*)(K + tt * 64); const f32x4* r4 = (const f32x4*)(R + tt * 64);
                float sa = 0.f;
#pragma unroll
                for (int i = 0; i < 16; ++i) { const f32x4 a = a4[i]; sa += S[4 * i] * a[0] + S[4 * i + 1] * a[1] + S[4 * i + 2] * a[2] + S[4 * i + 3] * a[3];
                    if ((i & 7) == 7) asm volatile("" ::: "memory"); }
                const float vv = V[tt * 64 + lane];
                float y = 0.f;
#pragma unroll
                for (int i = 0; i < 16; ++i) { const f32x4 w = w4[i], bb = b4[i], kk = k4[i], rr = r4[i];
#pragma unroll
                    for (int e = 0; e < 4; ++e) { const float s = S[4 * i + e] * w[e] + sa * bb[e] + vv * kk[e]; S[4 * i + e] = s; y += s * rr[e]; }
                    if ((i & 1) == 1) asm volatile("" ::: "memory"); }
                Y[tt * 64 + lane] = y;
            }
        }
        __syncthreads();
        for (int q = 0; q < 8; ++q) {
            const int tt = wave * 8 + q, t = t0 + tt, cj = h * HD + lane; const size_t row = (size_t)b * SEQ + t;
            const float y = Y[tt * 64 + lane];
            const float mean = wave_sum(y) * (1.0f / HD); const float d = y - mean;
            const float var = wave_sum(d * d) * (1.0f / HD);
            const float yn = d * rsqrtf(var + GN_EPS) * gng[cj] + gnb[cj];
            const float bonus = wave_sum(R[tt * 64 + lane] * K[tt * 64 + lane] * rk[cj]);
            const float o = yn + bonus * V[tt * 64 + lane];
            const float g = bf2f(PG[row * PG_W + cj]);
            MIX[row * DM + CW + SBW + cj] = f2bf(o * siluf_(g));
        }
        __syncthreads();
    }
}

constexpr int TS = 72;
constexpr int TILE_B = 64 * TS * 2;
constexpr int AABS = 68, XTS = 65, CSS = 65;

__device__ __forceinline__ f32x4 mm_tile(const bf16_t* X, int m0, const bf16_t* Yt, int n0, int K, int fr, int fq, f32x4 acc) {
#pragma unroll
    for (int kk = 0; kk < 2; ++kk) {
        if (kk * 32 < K) {
            const bf16x8 a = *(const bf16x8*)(X + (m0 + fr) * TS + kk * 32 + fq * 8);
            const bf16x8 b = *(const bf16x8*)(Yt + (n0 + fr) * TS + kk * 32 + fq * 8);
            acc = __builtin_amdgcn_mfma_f32_16x16x32_bf16(a, b, acc, 0, 0, 0);
        }
    }
    return acc;
}
__device__ __forceinline__ uint2 pk4(const f32x4& v) { uint2 w; w.x = pk2(v[0], v[1]); w.y = pk2(v[2], v[3]); return w; }

__device__ void rwkv_b1_job(const Params& p, int l, int jb, unsigned char* lds) {
    const int tid = tid_(), lane = tid & 63, wave = tid >> 6, fr = lane & 15, fq = lane >> 4;
    const int bh = jb >> 5, c = jb & 31, b = bh / NH, h = bh % NH, t0 = c * 64;
    const bf16_t* PR = (const bf16_t*)(p.ws + WS_PR); float* VF = (float*)(p.ws + WS_VF);
    const float* mu = p.in[11] + l * 1216; const float* w0 = p.in[12] + l * RWW; const float* w2 = p.in[13] + l * LORA * RWW;
    const float* a0 = p.in[14] + l * RWW; const float* a2 = p.in[15] + l * LORA * RWW; const float* kks = p.in[16] + l * RWW; const float* ka = p.in[17] + l * RWW;
    const float* rk = p.in[18] + l * RWW; const float* v0 = p.in[21]; const float* v2 = p.in[23];
    bf16_t* T_At = (bf16_t*)lds; bf16_t* T_Rt = T_At + 64 * TS; bf16_t* T_Bt = T_Rt + 64 * TS; bf16_t* T_Kt = T_Bt + 64 * TS;
    bf16_t* T_VT = T_Kt + 64 * TS; bf16_t* T_bhT = T_VT + 64 * TS; bf16_t* T_khT = T_bhT + 64 * TS;
    bf16_t* T_Aak = T_khT + 64 * TS; bf16_t* T_Arb = T_Aak + 64 * TS; bf16_t* T_Ark = T_Arb + 64 * TS;
    bf16_t* T_WT = T_At; bf16_t* T_U0T = T_Bt;
    float* Aab = (float*)(lds + 10 * TILE_B);
    float* XT = (float*)(lds + 10 * TILE_B + 64 * AABS * 4);
    float* PCv = XT + 128 * XTS;
    float* CS = (float*)T_Aak;
    float* WD = XT + 64 * XTS; float* AD = WD + 2048;
    float* VL = Aab;

    for (int idx = tid; idx < 2048; idx += 512) {
        const int tt = idx >> 5, i = idx & 31, t = t0 + tt;
        const bf16_t* cur = PR + ((size_t)b * SEQ + t) * PR_W; const bool hp = t > 0;
        { const float xc = bf2f(cur[1152 + i]), xp = hp ? bf2f(cur[1152 + i - PR_W]) : 0.f; WD[idx] = tanhf(xc + (xp - xc) * mu[1152 + i]); }
        { const float xc = bf2f(cur[1184 + i]), xp = hp ? bf2f(cur[1184 + i - PR_W]) : 0.f; AD[idx] = xc + (xp - xc) * mu[1184 + i]; }
        if (l > 0) VL[idx] = bf2f(cur[1216 + i]) + (hp ? bf2f(cur[1248 + i - PR_W]) : 0.f);
    }
    __syncthreads();
    const int tt = tid >> 3, j0 = (tid & 7) * 8, t = t0 + tt, cj0 = h * HD + j0;
    const size_t row = (size_t)b * SEQ + t;
    float rr[8], kk_[8], vv[8], aa[8], bb[8], lw[8];
    {
        const bf16_t* cur = PR + row * PR_W; const bool hp = t > 0;
        const bf16x8 rc = *(const bf16x8*)(cur + cj0), kc = *(const bf16x8*)(cur + 384 + cj0), vc = *(const bf16x8*)(cur + 768 + cj0);
        bf16x8 rp = rc, kp = kc, vp = vc;
        if (hp) { rp = *(const bf16x8*)(cur + cj0 - PR_W); kp = *(const bf16x8*)(cur + 384 + cj0 - PR_W); vp = *(const bf16x8*)(cur + 768 + cj0 - PR_W); }
        float wl[8], al[8], vg[8];
#pragma unroll
        for (int e = 0; e < 8; ++e) {
            const float r_c = bf2f((bf16_t)rc[e]), k_c = bf2f((bf16_t)kc[e]), v_c = bf2f((bf16_t)vc[e]);
            const float r_p = hp ? bf2f((bf16_t)rp[e]) : 0.f, k_p = hp ? bf2f((bf16_t)kp[e]) : 0.f, v_p = hp ? bf2f((bf16_t)vp[e]) : 0.f;
            rr[e] = r_c + (r_p - r_c) * mu[cj0 + e]; kk_[e] = k_c + (k_p - k_c) * mu[384 + cj0 + e]; vv[e] = v_c + (v_p - v_c) * mu[768 + cj0 + e];
            wl[e] = w0[cj0 + e]; al[e] = a0[cj0 + e]; vg[e] = l > 0 ? v0[cj0 + e] : 0.f;
        }
#pragma unroll 4
        for (int i = 0; i < LORA; ++i) {
            const float wd = WD[tt * 32 + i], ad = AD[tt * 32 + i];
            const f32x4 wa = *(const f32x4*)(w2 + i * RWW + cj0), wb = *(const f32x4*)(w2 + i * RWW + cj0 + 4);
            const f32x4 xa = *(const f32x4*)(a2 + i * RWW + cj0), xb = *(const f32x4*)(a2 + i * RWW + cj0 + 4);
#pragma unroll
            for (int e = 0; e < 4; ++e) { wl[e] += wd * wa[e]; wl[4 + e] += wd * wb[e]; al[e] += ad * xa[e]; al[4 + e] += ad * xb[e]; }
            if (l > 0) { const float vl = VL[tt * 32 + i];
                const f32x4 ya = *(const f32x4*)(v2 + i * RWW + cj0), yb = *(const f32x4*)(v2 + i * RWW + cj0 + 4);
#pragma unroll
                for (int e = 0; e < 4; ++e) { vg[e] += vl * ya[e]; vg[4 + e] += vl * yb[e]; } }
        }
        float ssq = 0.f, bon = 0.f;
#pragma unroll
        for (int e = 0; e < 8; ++e) {
            const float sp = fmaxf(-wl[e], 0.f) + log1pf(__expf(-fabsf(wl[e])));
            lw[e] = -__expf(-sp - 0.5f);
            const float alr = sigmoidf_(al[e]);
            if (l > 0) vv[e] = vv[e] + (VF[row * RWW + cj0 + e] - vv[e]) * sigmoidf_(vg[e]); else VF[row * RWW + cj0 + e] = vv[e];
            const float kkr = kk_[e] * kks[cj0 + e];
            kk_[e] = kk_[e] * (1.0f + (alr - 1.0f) * ka[cj0 + e]);
            aa[e] = kkr; bb[e] = alr; ssq += kkr * kkr; bon += rr[e] * kk_[e] * rk[cj0 + e];
        }
        ssq += __shfl_xor(ssq, 1); ssq += __shfl_xor(ssq, 2); ssq += __shfl_xor(ssq, 4);
        bon += __shfl_xor(bon, 1); bon += __shfl_xor(bon, 2); bon += __shfl_xor(bon, 4);
        const float inv = 1.0f / fmaxf(sqrtf(ssq), 1e-12f);
        uint4 bvw; float bv[8];
#pragma unroll
        for (int e = 0; e < 8; ++e) { const float kn = aa[e] * inv; aa[e] = -kn; bb[e] = kn * bb[e]; bv[e] = bon * vv[e]; CS[tt * CSS + j0 + e] = lw[e]; }
        bvw.x = pk2(bv[0], bv[1]); bvw.y = pk2(bv[2], bv[3]); bvw.z = pk2(bv[4], bv[5]); bvw.w = pk2(bv[6], bv[7]);
        *(uint4*)((bf16_t*)(p.ws + WS_CH_BV) + (size_t)jb * 4096 + tt * 64 + j0) = bvw;
    }
    __syncthreads();
#pragma unroll
    for (int e = 0; e < 8; ++e) {
        const int j = wave * 8 + e; float x = CS[lane * CSS + j];
#pragma unroll
        for (int o = 1; o < 64; o <<= 1) { const float y = __shfl_up(x, o); if (lane >= o) x += y; }
        CS[lane * CSS + j] = x;
    }
    __syncthreads();
    {
        float at[8], rt[8], bt[8], kt[8];
#pragma unroll
        for (int e = 0; e < 8; ++e) {
            const int j = j0 + e; const float cs = CS[tt * CSS + j], csC = CS[63 * CSS + j];
            const float e_in = __expf(cs), e_ex = __expf(cs - lw[e]), e_ng = __expf(-cs), e_ht = __expf(csC - cs);
            at[e] = aa[e] * e_ex; rt[e] = rr[e] * e_in; bt[e] = bb[e] * e_ng; kt[e] = kk_[e] * e_ng;
            T_VT[j * TS + tt] = f2bf(vv[e]); T_bhT[j * TS + tt] = f2bf(bb[e] * e_ht); T_khT[j * TS + tt] = f2bf(kk_[e] * e_ht);
            XT[j * XTS + tt] = at[e];
            if (tt == 63) PCv[j] = __expf(csC);
        }
        uint4 w;
        w.x = pk2(at[0], at[1]); w.y = pk2(at[2], at[3]); w.z = pk2(at[4], at[5]); w.w = pk2(at[6], at[7]); *(uint4*)(T_At + tt * TS + j0) = w;
        w.x = pk2(rt[0], rt[1]); w.y = pk2(rt[2], rt[3]); w.z = pk2(rt[4], rt[5]); w.w = pk2(rt[6], rt[7]); *(uint4*)(T_Rt + tt * TS + j0) = w;
        w.x = pk2(bt[0], bt[1]); w.y = pk2(bt[2], bt[3]); w.z = pk2(bt[4], bt[5]); w.w = pk2(bt[6], bt[7]); *(uint4*)(T_Bt + tt * TS + j0) = w;
        w.x = pk2(kt[0], kt[1]); w.y = pk2(kt[2], kt[3]); w.z = pk2(kt[4], kt[5]); w.w = pk2(kt[6], kt[7]); *(uint4*)(T_Kt + tt * TS + j0) = w;
    }
    __syncthreads();
#pragma unroll 1
    for (int q = 0; q < 8; ++q) {
        const int id = wave * 8 + q, mat = id >> 4, ti = (id >> 2) & 3, tj = id & 3;
        const bf16_t* As = (mat == 0 || mat == 2) ? T_Bt : T_Kt; const bf16_t* Bs = (mat < 2) ? T_At : T_Rt;
        f32x4 acc = (f32x4){0.f, 0.f, 0.f, 0.f};
        if (ti <= tj) acc = mm_tile(As, ti * 16, Bs, tj * 16, 64, fr, fq, acc);
        const int tcol = tj * 16 + fr, i0 = ti * 16 + fq * 4;
#pragma unroll
        for (int r = 0; r < 4; ++r) { const bool keep = (mat < 2) ? (i0 + r < tcol) : (i0 + r <= tcol); if (!keep) acc[r] = 0.f; }
        if (mat == 0) *(f32x4*)(Aab + tcol * AABS + i0) = acc;
        else { bf16_t* dst = (mat == 1 ? T_Aak : (mat == 2 ? T_Arb : T_Ark)); *(uint2*)(dst + tcol * TS + i0) = pk4(acc); }
    }
    __syncthreads();
#pragma unroll 1
    for (int q = 0; q < 2; ++q) {
        const int id = wave * 2 + q, ti = id >> 2, tj = id & 3;
        f32x4 acc = mm_tile(T_Aak, ti * 16, T_VT, tj * 16, 64, fr, fq, (f32x4){0.f, 0.f, 0.f, 0.f});
        const int j = tj * 16 + fr, tr = ti * 16 + fq * 4;
#pragma unroll
        for (int r = 0; r < 4; ++r) XT[(64 + j) * XTS + tr + r] = acc[r];
    }
    __syncthreads();
#pragma unroll 1
    for (int I = 0; I < 4; ++I) {
        if (I > 0) {
            const int jp = tid & 127, tq = tid >> 7; float s[4] = {0.f, 0.f, 0.f, 0.f};
            const float* xr = XT + jp * XTS; const float* ar = Aab + (16 * I + 4 * tq) * AABS;
            for (int i = 0; i < 16 * I; ++i) { const float x = xr[i];
#pragma unroll
                for (int r = 0; r < 4; ++r) s[r] += ar[r * AABS + i] * x; }
            __syncthreads();
#pragma unroll
            for (int r = 0; r < 4; ++r) XT[jp * XTS + 16 * I + 4 * tq + r] += s[r];
            __syncthreads();
        }
        if (tid < 128) {
            float x[16]; float* xr = XT + tid * XTS + 16 * I; const float* ar = Aab + (16 * I) * AABS + 16 * I;
#pragma unroll
            for (int u = 0; u < 16; ++u) { float v = xr[u];
#pragma unroll
                for (int i = 0; i < u; ++i) v += ar[u * AABS + i] * x[i];
                x[u] = v; }
#pragma unroll
            for (int u = 0; u < 16; ++u) xr[u] = x[u];
        }
        __syncthreads();
    }
    {
        const int col = tid >> 2, tg = (tid & 3) * 16;
        const float* xr = XT + col * XTS + tg; bf16_t* dst = (col < 64 ? T_WT + col * TS : T_U0T + (col - 64) * TS) + tg;
        uint4 w0_, w1_;
        w0_.x = pk2(xr[0], xr[1]); w0_.y = pk2(xr[2], xr[3]); w0_.z = pk2(xr[4], xr[5]); w0_.w = pk2(xr[6], xr[7]);
        w1_.x = pk2(xr[8], xr[9]); w1_.y = pk2(xr[10], xr[11]); w1_.z = pk2(xr[12], xr[13]); w1_.w = pk2(xr[14], xr[15]);
        *(uint4*)dst = w0_; *(uint4*)(dst + 8) = w1_;
    }
    __syncthreads();
    {
        bf16_t* gM = (bf16_t*)(p.ws + WS_CH_M) + (size_t)jb * 4096; bf16_t* gNT = (bf16_t*)(p.ws + WS_CH_NT) + (size_t)jb * 4096;
        bf16_t* gG = (bf16_t*)(p.ws + WS_CH_G) + (size_t)jb * 4096; bf16_t* gY1T = (bf16_t*)(p.ws + WS_CH_Y1T) + (size_t)jb * 4096;
#pragma unroll 1
        for (int q = 0; q < 8; ++q) {
            const int id = wave * 8 + q, mat = id >> 4, ti = (id >> 2) & 3, tj = id & 3;
            const int col = tj * 16 + fr, r0 = ti * 16 + fq * 4;
            f32x4 acc = (f32x4){0.f, 0.f, 0.f, 0.f};
            if (mat == 0) {
                acc = mm_tile(T_WT, ti * 16, T_Arb, tj * 16, 64, fr, fq, acc);
                const uint2 rw = *(const uint2*)(T_Rt + col * TS + r0);
                acc[0] += bf2f((bf16_t)(rw.x & 0xffff)); acc[1] += bf2f((bf16_t)(rw.x >> 16)); acc[2] += bf2f((bf16_t)(rw.y & 0xffff)); acc[3] += bf2f((bf16_t)(rw.y >> 16));
                *(uint2*)(gG + col * 64 + r0) = pk4(acc);
            } else if (mat == 1) {
                acc = mm_tile(T_Arb, ti * 16, T_U0T, tj * 16, 64, fr, fq, acc);
                acc = mm_tile(T_Ark, ti * 16, T_VT, tj * 16, 64, fr, fq, acc);
                *(uint2*)(gY1T + col * 64 + r0) = pk4(acc);
            } else if (mat == 2) {
                acc = mm_tile(T_WT, ti * 16, T_bhT, tj * 16, 64, fr, fq, acc);
                const float pc = PCv[col];
#pragma unroll
                for (int r = 0; r < 4; ++r) if (r0 + r == col) acc[r] += pc;
                *(uint2*)(gM + col * 64 + r0) = pk4(acc);
            } else {
                acc = mm_tile(T_bhT, ti * 16, T_U0T, tj * 16, 64, fr, fq, acc);
                acc = mm_tile(T_khT, ti * 16, T_VT, tj * 16, 64, fr, fq, acc);
                *(uint2*)(gNT + col * 64 + r0) = pk4(acc);
            }
        }
    }
    __syncthreads();
}

__device__ void rwkv_b2_job(const Params& p, int bh, unsigned char* lds) {
    const int tid = tid_(), lane = tid & 63, wave = tid >> 6, fr = lane & 15, fq = lane >> 4;
    const int mi = wave >> 1, nj0 = (wave & 1) * 2;
    const bf16_t* gM = (const bf16_t*)(p.ws + WS_CH_M); const bf16_t* gNT = (const bf16_t*)(p.ws + WS_CH_NT); bf16_t* gZT = (bf16_t*)(p.ws + WS_ZT);
    bf16_t* zbuf = (bf16_t*)lds;
    f32x4 z[2];
    z[0] = (f32x4){0.f, 0.f, 0.f, 0.f}; z[1] = z[0];
    const int c0 = mi * 16 + fq * 4;
#pragma unroll 1
    for (int c = 0; c < SEQ / 64; ++c) {
        const size_t jb = (size_t)bh * 32 + c;
        bf16_t* zh = zbuf + (c & 1) * 2 * 64 * TS; bf16_t* zl = zh + 64 * TS;
#pragma unroll
        for (int q = 0; q < 2; ++q) {
            const int j = (nj0 + q) * 16 + fr;
            const uint2 hi = pk4(z[q]);
            f32x4 lo;
            lo[0] = z[q][0] - bf2f((bf16_t)(hi.x & 0xffff)); lo[1] = z[q][1] - bf2f((bf16_t)(hi.x >> 16)); lo[2] = z[q][2] - bf2f((bf16_t)(hi.y & 0xffff)); lo[3] = z[q][3] - bf2f((bf16_t)(hi.y >> 16));
            *(uint2*)(zh + j * TS + c0) = hi; *(uint2*)(zl + j * TS + c0) = pk4(lo);
            *(uint2*)(gZT + jb * 4096 + j * 64 + c0) = hi;
        }
        __syncthreads();
        bf16x8 am[2];
#pragma unroll
        for (int kk = 0; kk < 2; ++kk) am[kk] = *(const bf16x8*)(gM + jb * 4096 + (mi * 16 + fr) * 64 + kk * 32 + fq * 8);
#pragma unroll
        for (int q = 0; q < 2; ++q) {
            const int j = (nj0 + q) * 16 + fr;
            const uint2 nw = *(const uint2*)(gNT + jb * 4096 + j * 64 + c0);
            f32x4 acc; acc[0] = bf2f((bf16_t)(nw.x & 0xffff)); acc[1] = bf2f((bf16_t)(nw.x >> 16)); acc[2] = bf2f((bf16_t)(nw.y & 0xffff)); acc[3] = bf2f((bf16_t)(nw.y >> 16));
#pragma unroll
            for (int kk = 0; kk < 2; ++kk) {
                const bf16x8 bh_ = *(const bf16x8*)(zh + j * TS + kk * 32 + fq * 8), bl_ = *(const bf16x8*)(zl + j * TS + kk * 32 + fq * 8);
                acc = __builtin_amdgcn_mfma_f32_16x16x32_bf16(am[kk], bh_, acc, 0, 0, 0);
                acc = __builtin_amdgcn_mfma_f32_16x16x32_bf16(am[kk], bl_, acc, 0, 0, 0);
            }
            z[q] = acc;
        }
    }
    __syncthreads();
}

__device__ void rwkv_b3_pair(const Params& p, int l, int pair) {
    const int tid = tid_(), lane = tid & 63, wave = tid >> 6, fr = lane & 15, fq = lane >> 4;
    const int jb = pair * 2 + (wave >> 2), mi = wave & 3;
    const int bh = jb >> 5, c = jb & 31, b = bh / NH, h = bh % NH;
    const bf16_t* gG = (const bf16_t*)(p.ws + WS_CH_G) + (size_t)jb * 4096; const bf16_t* gY1T = (const bf16_t*)(p.ws + WS_CH_Y1T) + (size_t)jb * 4096;
    const bf16_t* gBV = (const bf16_t*)(p.ws + WS_CH_BV) + (size_t)jb * 4096; const bf16_t* gZT = (const bf16_t*)(p.ws + WS_ZT) + (size_t)jb * 4096;
    const bf16_t* PG = (const bf16_t*)(p.ws + WS_PG); bf16_t* MIX = (bf16_t*)(p.ws + WS_MIX);
    const float* gng = p.in[19] + l * RWW; const float* gnb = p.in[20] + l * RWW;
    const int tr = mi * 16 + fq * 4;
    bf16x8 ag[2];
#pragma unroll
    for (int kk = 0; kk < 2; ++kk) ag[kk] = *(const bf16x8*)(gG + (mi * 16 + fr) * 64 + kk * 32 + fq * 8);
    f32x4 acc[4];
#pragma unroll
    for (int nj = 0; nj < 4; ++nj) {
        const int j = nj * 16 + fr;
        const uint2 yw = *(const uint2*)(gY1T + j * 64 + tr);
        acc[nj][0] = bf2f((bf16_t)(yw.x & 0xffff)); acc[nj][1] = bf2f((bf16_t)(yw.x >> 16)); acc[nj][2] = bf2f((bf16_t)(yw.y & 0xffff)); acc[nj][3] = bf2f((bf16_t)(yw.y >> 16));
#pragma unroll
        for (int kk = 0; kk < 2; ++kk) { const bf16x8 bz = *(const bf16x8*)(gZT + j * 64 + kk * 32 + fq * 8); acc[nj] = __builtin_amdgcn_mfma_f32_16x16x32_bf16(ag[kk], bz, acc[nj], 0, 0, 0); }
    }
#pragma unroll
    for (int r = 0; r < 4; ++r) {
        float s = acc[0][r] + acc[1][r] + acc[2][r] + acc[3][r];
        s += __shfl_xor(s, 1); s += __shfl_xor(s, 2); s += __shfl_xor(s, 4); s += __shfl_xor(s, 8);
        const float mean = s * (1.0f / HD);
        float d[4], vs = 0.f;
#pragma unroll
        for (int nj = 0; nj < 4; ++nj) { d[nj] = acc[nj][r] - mean; vs += d[nj] * d[nj]; }
        vs += __shfl_xor(vs, 1); vs += __shfl_xor(vs, 2); vs += __shfl_xor(vs, 4); vs += __shfl_xor(vs, 8);
        const float rstd = rsqrtf(vs * (1.0f / HD) + GN_EPS);
        const int tt = tr + r; const size_t row = (size_t)b * SEQ + c * 64 + tt;
#pragma unroll
        for (int nj = 0; nj < 4; ++nj) {
            const int j = nj * 16 + fr, cj = h * HD + j;
            const float o = d[nj] * rstd * gng[cj] + gnb[cj] + bf2f(gBV[tt * 64 + j]);
            const float g = bf2f(PG[row * PG_W + cj]);
            MIX[row * DM + CW + SBW + cj] = f2bf(o * siluf_(g));
        }
    }
}

#ifndef RWKV_REF
#define RWKV_REF 0
#endif
__device__ void phase_mix1(const Params& p, int l, unsigned char* lds) {
    constexpr int NAT = BATCH * NH * 4, NCV = BATCH * (SEQ / 32);
    const int G = gridDim.x;
#if RWKV_REF
    for (int job = blockIdx.x; job < BATCH * NH; job += G) rwkv_job(p, l, job, (float*)lds);
#else
    for (int job = blockIdx.x; job < BATCH * NH * 32; job += G) rwkv_b1_job(p, l, job, lds);
#endif
    for (int job = blockIdx.x; job < NAT; job += G) attn_job(p, job);
    for (int job = blockIdx.x; job < NCV; job += G) conv_job(p, l, job, (float*)lds);
}
__device__ void phase_mix2(const Params& p, int l, unsigned char* lds) {
#if !RWKV_REF
    for (int job = blockIdx.x; job < BATCH * NH; job += gridDim.x) rwkv_b2_job(p, job, lds);
#endif
}
__device__ void phase_mix3(const Params& p, int l, unsigned char* lds) {
#if !RWKV_REF
    for (int pair = blockIdx.x; pair < BATCH * NH * 16; pair += gridDim.x) rwkv_b3_pair(p, l, pair);
#endif
}

constexpr int PH_PER_LAYER = 6;
constexpr int N_PHASES = 1 + PH_PER_LAYER * DEPTH;
__device__ __forceinline__ void run_phase(const Params& p, int ph, unsigned char* lds) {
    unsigned char* ws = p.ws;
    if (ph == 0) { phase_prologue(p, lds); return; }
    const int l = (ph - 1) / PH_PER_LAYER, k = (ph - 1) % PH_PER_LAYER;
    if (k == 0) {
#if SIMPLE_GEMM
        EpiInProj E{(bf16_t*)(ws + WS_PC), (bf16_t*)(ws + WS_PS), (bf16_t*)(ws + WS_PR), (bf16_t*)(ws + WS_PG)};
        gemm_simple((const bf16_t*)(ws + WS_XB), (const bf16_t*)(ws + WS_WIN) + (size_t)l * NINT * DM, M, NINT, DM, E);
#else
        EpiInProjP E{(bf16_t*)(ws + WS_PC), (bf16_t*)(ws + WS_PS), (bf16_t*)(ws + WS_PR), (bf16_t*)(ws + WS_PG)};
        pg8::Gemm g{(const bf16_t*)(ws + WS_XB), (const bf16_t*)(ws + WS_WIN) + (size_t)l * NINT * DM, M, NINT, DM}; pg8::StaticOrder S; S.init(M, NINT, (int)gridDim.x, (int)blockIdx.x);
        pg8::gemm_phase<EpiInProjP, pg8::StaticOrder, true, true>((PG8_LAS unsigned char*)lds, g, S, E);
#endif
    } else if (k == 1) {
        phase_mix1(p, l, lds);
    } else if (k == 2) {
        phase_mix2(p, l, lds);
    } else if (k == 3) {
        phase_mix3(p, l, lds);
    } else if (k == 4) {
#if SIMPLE_GEMM
        EpiF32 E{(float*)(ws + WS_Y), DM};
        gemm_simple((const bf16_t*)(ws + WS_MIX), (const bf16_t*)(ws + WS_WOUT) + (size_t)l * DM * DM, M, DM, DM, E);
#else
        EpiOutF32P E{(float*)(ws + WS_Y), DM};
        pg8::Gemm g{(const bf16_t*)(ws + WS_MIX), (const bf16_t*)(ws + WS_WOUT) + (size_t)l * DM * DM, M, DM, DM}; pg8::StaticOrder S; S.init(M, DM, (int)gridDim.x, (int)blockIdx.x);
        pg8::gemm_phase<EpiOutF32P, pg8::StaticOrder, true, true>((PG8_LAS unsigned char*)lds, g, S, E);
#endif
    } else {
        phase_rowpass(l == 0 ? p.in[0] : p.out, (const float*)(ws + WS_Y), p.in[2] + l * DM, p.out, l + 1 < DEPTH ? (bf16_t*)(ws + WS_XB) : nullptr);
    }
}

constexpr int LDS_BYTES = 147456;

#if MK_COOP
__global__ void __launch_bounds__(512, 2) fwd_kernel(Params p) {
    extern __shared__ __attribute__((aligned(16))) unsigned char lds[];
    cg::grid_group grid = cg::this_grid();
    for (int ph = p.ph_lo; ph < p.ph_hi; ++ph) {
        run_phase(p, ph, lds);
        if (ph + 1 < p.ph_hi) grid.sync();
    }
}
#else
__global__ void __launch_bounds__(512, 2) fwd_kernel(Params p) {
    extern __shared__ __attribute__((aligned(16))) unsigned char lds[];
    for (int ph = p.ph_lo; ph < p.ph_hi; ++ph) run_phase(p, ph, lds);
}
#endif

extern "C" void kernel_launch(void* const* d_in, const int* in_sizes, int n_in, void* d_out, int out_size, void* d_ws, size_t ws_size, hipStream_t stream) {
    static int grid = 0;
    if (grid == 0) {
        if (n_in != 24 || out_size != M * DM || ws_size < WS_END) { fprintf(stderr, "kernel_launch: unexpected problem (n_in %d out %d ws %zu)\n", n_in, out_size, ws_size); grid = -1; return; }
        int dev = 0, cus = 0, per_cu = 0;
        hipGetDevice(&dev); hipDeviceGetAttribute(&cus, hipDeviceAttributeMultiprocessorCount, dev);
        hipFuncSetAttribute((const void*)fwd_kernel, hipFuncAttributeMaxDynamicSharedMemorySize, LDS_BYTES);
        hipOccupancyMaxActiveBlocksPerMultiprocessor(&per_cu, (const void*)fwd_kernel, 512, LDS_BYTES);
        if (per_cu < 1) { fprintf(stderr, "kernel_launch: occupancy query says %d blocks per CU\n", per_cu); per_cu = 1; }
        grid = cus;
        (void)hipGetLastError();
    }
    if (grid < 0) return;
    Params p{};
    for (int i = 0; i < 24; ++i) p.in[i] = (const float*)d_in[i];
    p.out = (float*)d_out; p.ws = (unsigned char*)d_ws;
#if MK_COOP
    p.ph_lo = 0; p.ph_hi = N_PHASES;
    void* args[] = {&p};
    hipError_t e = hipLaunchCooperativeKernel((const void*)fwd_kernel, dim3(grid), dim3(512), args, LDS_BYTES, stream);
    if (e != hipSuccess) fprintf(stderr, "cooperative launch failed: %s (grid %d)\n", hipGetErrorString(e), grid);
#else
    for (int ph = 0; ph < N_PHASES; ++ph) {
        p.ph_lo = ph; p.ph_hi = ph + 1;
        hipLaunchKernelGGL(fwd_kernel, dim3(grid), dim3(512), LDS_BYTES, stream, p);
    }
#endif
}
```

```cpp
#include <hip/hip_runtime.h>
#include <hip/hip_cooperative_groups.h>
#include <cstdio>
#include <cstdint>
namespace cg = cooperative_groups;

#ifndef SIMPLE_GEMM
#define SIMPLE_GEMM 0
#endif
#ifndef MK_COOP
#define MK_COOP 1
#endif

constexpr int BATCH = 16, SEQ = 2048, DM = 1024, DEPTH = 2;
constexpr int M = BATCH * SEQ;
constexpr int HD = 64, NH = 6;
constexpr int CW = 256, SBW = 384, RWW = 384, LORA = 32, TAPS = 31;
constexpr int DIN = 3904;
constexpr int NINT = 4096;
constexpr int PC_W = 768, PS_W = 1152, PR_W = 1280, PG_W = 384;
constexpr float RMS_EPS = 1e-6f, LN_EPS = 1e-5f, GN_EPS = 64e-5f;

typedef unsigned short bf16_t;
typedef short bf16x8 __attribute__((ext_vector_type(8)));
typedef float f32x4 __attribute__((ext_vector_type(4)));
typedef unsigned short us4 __attribute__((ext_vector_type(4)));

constexpr size_t MiB = 1u << 20;
constexpr size_t WS_CTL = 0;
constexpr size_t WS_WIN = 1 * MiB;
constexpr size_t WS_WOUT = 17 * MiB;
constexpr size_t WS_XB = 21 * MiB;
constexpr size_t WS_MIX = WS_XB;
constexpr size_t WS_PC = 85 * MiB;
constexpr size_t WS_PS = 133 * MiB;
constexpr size_t WS_VT = 205 * MiB;
constexpr size_t WS_Y = WS_PC;
constexpr size_t WS_PR = 229 * MiB;
constexpr size_t WS_PG = 309 * MiB;
constexpr size_t WS_VF = 333 * MiB;
constexpr size_t WS_CH = 381 * MiB;
constexpr size_t CH_SZ = (size_t)3072 * 4096 * 2;
constexpr size_t WS_CH_M = WS_CH, WS_CH_NT = WS_CH + CH_SZ, WS_CH_G = WS_CH + 2 * CH_SZ, WS_CH_Y1T = WS_CH + 3 * CH_SZ, WS_CH_BV = WS_CH + 4 * CH_SZ;
constexpr size_t WS_ZT = WS_PR;
constexpr size_t WS_END = 501 * MiB;

struct Params {
    const float* in[24];
    float* out;
    unsigned char* ws;
    int ph_lo, ph_hi;
};

__device__ __forceinline__ float bf2f(bf16_t v) { return __uint_as_float(((unsigned)v) << 16); }
__device__ __forceinline__ bf16_t f2bf(float f) { unsigned u = __float_as_uint(f); return (bf16_t)((u + 0x7fffu + ((u >> 16) & 1u)) >> 16); }
__device__ __forceinline__ unsigned pk2(float lo, float hi) { return (unsigned)f2bf(lo) | ((unsigned)f2bf(hi) << 16); }
__device__ __forceinline__ float wave_sum(float v) {
#pragma unroll
    for (int o = 1; o < 64; o <<= 1) v += __shfl_xor(v, o);
    return v;
}
__device__ __forceinline__ float sigmoidf_(float x) { return 1.0f / (1.0f + __expf(-x)); }
__device__ __forceinline__ float siluf_(float x) { return x / (1.0f + __expf(-x)); }
__device__ __forceinline__ int tid_() { int t = threadIdx.x; asm volatile("" : "+v"(t)); return t; }
__device__ __forceinline__ int opaque_zero() { int z = 0; asm volatile("" : "+v"(z)); return z; }

__device__ __forceinline__ int orig_col(int n) { return n < 3520 ? n : (n < 3584 ? -1 : (n < 3968 ? n - 64 : -1)); }

__device__ void transpose_tile(const float* W, int ldw, int ncol_src, const float* gain, bf16_t* WT, int K, int n0, int k0, bool permute, float* tile  , const float* fold_v1 = nullptr, const float* fold_mu = nullptr) {
    const int tid = tid_();
#pragma unroll
    for (int i = 0; i < 8; ++i) {
        const int kl = (tid >> 6) + 8 * i, nl = tid & 63;
        const int n = n0 + nl, k = k0 + kl;
        const int oc = permute ? orig_col(n) : n;
        float v = 0.f;
        if (oc >= 0 && oc < ncol_src) v = W[(size_t)k * ldw + oc] * (gain ? gain[k] : 1.0f);
        if (permute && n >= 768 && n < 1152) v *= 0.125f * 1.4426950408889634f;
        if (fold_v1 && n >= 3520 && n < 3584) {
            const int i = (n - 3520) & 31; const bool second = n >= 3552; float a = 0.f;
            for (int c = 0; c < RWW; ++c) { const float m = fold_mu[c]; a += W[(size_t)k * ldw + 3072 + c] * (second ? m : 1.0f - m) * fold_v1[c * LORA + i]; }
            v = a * gain[k];
        }
        tile[kl * 65 + nl] = v;
    }
    __syncthreads();
#pragma unroll
    for (int i = 0; i < 8; ++i) {
        const int nl = (tid >> 6) + 8 * i, kl = tid & 63;
        WT[(size_t)(n0 + nl) * K + k0 + kl] = f2bf(tile[kl * 65 + nl]);
    }
    __syncthreads();
}

__device__ void rows_to_xb(const float* X, bf16_t* XB) {
    const int tid = tid_(), lane = tid & 63, wave = tid >> 6;
    for (int row = blockIdx.x * 8 + wave; row < M; row += gridDim.x * 8) {
        const float* xr = X + (size_t)row * DM;
        f32x4 v[4]; float ss = 0.f;
#pragma unroll
        for (int i = 0; i < 4; ++i) { v[i] = *(const f32x4*)(xr + i * 256 + lane * 4); ss += v[i][0] * v[i][0] + v[i][1] * v[i][1] + v[i][2] * v[i][2] + v[i][3] * v[i][3]; }
        ss = wave_sum(ss);
        const float rstd = rsqrtf(ss * (1.0f / DM) + RMS_EPS);
#pragma unroll
        for (int i = 0; i < 4; ++i) { uint2 w; w.x = pk2(v[i][0] * rstd, v[i][1] * rstd); w.y = pk2(v[i][2] * rstd, v[i][3] * rstd); *(uint2*)(XB + (size_t)row * DM + i * 256 + lane * 4) = w; }
    }
}

__device__ void phase_prologue(const Params& p, unsigned char* lds) {
    float* tile = (float*)lds;
    bf16_t* WinT = (bf16_t*)(p.ws + WS_WIN); bf16_t* WoutT = (bf16_t*)(p.ws + WS_WOUT);
    const int nt_in = (NINT / 64) * (DM / 64), nt_out = (DM / 64) * (DM / 64);
    const int total = DEPTH * (nt_in + nt_out);
    for (int j = blockIdx.x; j < total; j += gridDim.x) {
        int l = j / (nt_in + nt_out), r = j % (nt_in + nt_out);
        if (r < nt_in) { const int tn = r / (DM / 64), tk = r % (DM / 64);
            transpose_tile(p.in[3] + (size_t)l * DM * DIN, DIN, DIN, p.in[1] + l * DM, WinT + (size_t)l * NINT * DM, DM, tn * 64, tk * 64, true, tile, l > 0 ? p.in[22] : nullptr, p.in[11] + l * 1216 + 768);
        } else { r -= nt_in; const int tn = r / (DM / 64), tk = r % (DM / 64);
            transpose_tile(p.in[4] + (size_t)l * DM * DM, DM, DM, nullptr, WoutT + (size_t)l * DM * DM, DM, tn * 64, tk * 64, false, tile);
        }
    }
    rows_to_xb(p.in[0], (bf16_t*)(p.ws + WS_XB));
}

namespace pg8 {
#define PG8_LAS __attribute__((address_space(3)))
typedef unsigned short bf16_t;
typedef short bf16x8 __attribute__((ext_vector_type(8)));
typedef float f32x4 __attribute__((ext_vector_type(4)));
typedef unsigned u32x4 __attribute__((ext_vector_type(4)));
constexpr int BM = 256, BK = 64, HALF = 128, HTB = HALF * BK * 2  , STAGE_BYTES = 8 * HTB, NXCD = 8, WGM = 8;

__host__ __device__ __forceinline__ int lds_byte(int r, int c) { const int st = (r >> 4) * 2 + (c >> 5), rr = r & 15, cc = c & 31, ob = rr * 64 + cc * 2; return st * 1024 + (ob ^ (((ob >> 9) & 1) << 5)); }
__host__ __device__ __forceinline__ void stage_rc(int b, int& R, int& C) { const int st = b / 1024, sb = b % 1024, swz = sb ^ (((sb >> 9) & 1) << 5); R = (st >> 1) * 16 + swz / 64; C = (st & 1) * 32 + (swz % 64) / 2; }
__host__ __device__ __forceinline__ int perm32(int rho) { const int n = rho >> 4, i = rho & 15; return 8 * (i >> 2) + 4 * n + (i & 3); }

struct Unit { int pm, pn; };
struct Gemm { const bf16_t* A; const bf16_t* Bt; int M, N, K; };

struct StaticOrder {
    int nM, nN, nwg, G, c;
    __host__ __device__ void init(int M, int N, int G_, int c_) { nM = M / BM; nN = N / BM; nwg = nM * nN; G = G_; c = c_; }
    __host__ __device__ bool next(int i, Unit& u) const {
        const long L = (long)i * G + c; if (L >= nwg) return false;
        int wgid = (int)L; { const int q = nwg / NXCD, r = nwg % NXCD, xcd = wgid % NXCD, off = wgid / NXCD; wgid = (xcd < r ? xcd * (q + 1) : r * (q + 1) + (xcd - r) * q) + off; }
        const int nig = WGM * nN, gid = wgid / nig, fm = gid * WGM, gsz = (nM - fm) < WGM ? (nM - fm) : WGM;
        u.pm = fm + ((wgid % nig) % gsz); u.pn = (wgid % nig) / gsz; return true;
    }
    __device__ __forceinline__ void a_ready(const Unit&) const {}
    __device__ __forceinline__ void done(const Unit&) const {}
};


__device__ __forceinline__ unsigned cvt_pk_bf16(float lo, float hi) { unsigned r; asm volatile("v_cvt_pk_bf16_f32 %0, %1, %2" : "=v"(r) : "v"(lo), "v"(hi)); return r; }

template <class Epi, class Sched, bool ALIGN_EPI = false, bool SP2 = false>
__device__ __forceinline__ void gemm_phase(PG8_LAS unsigned char* lds, const Gemm g, const Sched& S, const Epi& E) {
    const int tid = tid_(), wid = __builtin_amdgcn_readfirstlane(tid >> 6), lane = tid & 63, wr = wid >> 2, wc = wid & 3, fr = lane & 15, fq = lane >> 4;
    const int K = g.K, nt = K / BK;
    unsigned voffA[2], voffB[2];
#pragma unroll
    for (int i = 0; i < 2; ++i) { int R, C; stage_rc(tid * 16 + i * 8192, R, C); const int Rb = Epi::PERM ? ((R & ~31) + perm32(R & 31)) : R;
        voffA[i] = (unsigned)(R * K + C) * 2u; voffB[i] = (unsigned)(Rb * K + C) * 2u; }
    const size_t kstep = (size_t)(BK * 2);
    const size_t hstep = (size_t)HALF * K * 2;
    const size_t tstep = 2 * hstep;
    const unsigned ldsw = (unsigned)wid * 1024u;
    const int aoff = lds_byte(wr * 64 + fr, fq * 8), boff = lds_byte(wc * 32 + fr, fq * 8);
#define PG8_SA(b, h) (((b) * 2 + (h)) * HTB)
#define PG8_SB(b, h) ((4 + (b) * 2 + (h)) * HTB)
#define PG8_STAGE(bufoff, gbase, voff) do { _Pragma("unroll") for (int _i = 0; _i < 2; ++_i) \
        __builtin_amdgcn_global_load_lds((const unsigned*)((const char*)(gbase) + (voff)[_i]), (PG8_LAS unsigned*)(lds + (bufoff) + ldsw + _i * 8192), 16, 0, 0); } while (0)
#define PG8_LDA(dst, b, h) do { _Pragma("unroll") for (int m = 0; m < 4; ++m) _Pragma("unroll") for (int k = 0; k < 2; ++k) dst[m][k] = *(const PG8_LAS bf16x8*)(lds + PG8_SA(b, h) + aoff + m * 2048 + k * 1024); } while (0)
#define PG8_LDB(dst, b, h) do { _Pragma("unroll") for (int n = 0; n < 2; ++n) _Pragma("unroll") for (int k = 0; k < 2; ++k) dst[n][k] = *(const PG8_LAS bf16x8*)(lds + PG8_SB(b, h) + boff + n * 2048 + k * 1024); } while (0)
#define PG8_MMA(ai, bj, At, Bt) do { __builtin_amdgcn_s_setprio(1); _Pragma("unroll") for (int m = 0; m < 4; ++m) _Pragma("unroll") for (int n = 0; n < 2; ++n) _Pragma("unroll") for (int k = 0; k < 2; ++k) \
        acc[ai][bj][m][n] = __builtin_amdgcn_mfma_f32_16x16x32_bf16(Bt[n][k], At[m][k], acc[ai][bj][m][n], 0, 0, 0); __builtin_amdgcn_s_setprio(0); } while (0)
#define PG8_WAIT_V(n) asm volatile("s_waitcnt vmcnt(" #n ")" ::: "memory")
#define PG8_WAIT_L(n) asm volatile("s_waitcnt lgkmcnt(" #n ")" ::: "memory")
#define PG8_BAR __builtin_amdgcn_s_barrier()
#define PG8_SCHED __builtin_amdgcn_sched_barrier(0)
    Unit cur, nxt; int ui = 0;
    if (!S.next(0, cur)) return;
    f32x4 acc[2][2][4][2];
#pragma unroll
    for (int a = 0; a < 2; ++a)
#pragma unroll
        for (int b = 0; b < 2; ++b)
#pragma unroll
            for (int m = 0; m < 4; ++m)
#pragma unroll
                for (int n = 0; n < 2; ++n) acc[a][b][m][n] = (f32x4){0.f, 0.f, 0.f, 0.f};
    bf16x8 At[4][2], B0[2][2], B1[2][2];
    const char* cA = (const char*)g.A + (size_t)cur.pm * tstep; const char* cB = (const char*)g.Bt + (size_t)cur.pn * tstep;
    S.a_ready(cur);
    if constexpr (SP2) {
        PG8_STAGE(PG8_SB(0, 0), cB, voffB); PG8_STAGE(PG8_SB(0, 1), cB + hstep, voffB); PG8_STAGE(PG8_SA(0, 0), cA, voffA); PG8_STAGE(PG8_SA(0, 1), cA + hstep, voffA);
        if (wr == 1) PG8_BAR;
        PG8_WAIT_V(2); PG8_BAR;
        PG8_STAGE(PG8_SB(1, 0), cB + kstep, voffB); PG8_STAGE(PG8_SA(1, 0), cA + kstep, voffA); PG8_STAGE(PG8_SB(1, 1), cB + hstep + kstep, voffB);
        PG8_WAIT_V(6); PG8_BAR;
    } else {
        PG8_STAGE(PG8_SB(0, 0), cB, voffB); PG8_STAGE(PG8_SA(0, 0), cA, voffA); PG8_STAGE(PG8_SB(0, 1), cB + hstep, voffB); PG8_STAGE(PG8_SA(0, 1), cA + hstep, voffA);
        if (wr == 1) PG8_BAR;
        PG8_WAIT_V(4); PG8_BAR;
        PG8_STAGE(PG8_SB(1, 0), cB + kstep, voffB); PG8_STAGE(PG8_SA(1, 0), cA + kstep, voffA); PG8_STAGE(PG8_SB(1, 1), cB + hstep + kstep, voffB);
        PG8_WAIT_V(6); PG8_BAR;
    }
    for (;;) {
        const bool has_next = S.next(ui + 1, nxt);
        const char* nA = has_next ? (const char*)g.A + (size_t)nxt.pm * tstep : cA; const char* nB = has_next ? (const char*)g.Bt + (size_t)nxt.pn * tstep : cB;
        for (int t = 0; t < nt; t += 2) {
            const bool last = (t == nt - 2);
            const char* a1 = cA + (size_t)(t + 1) * kstep;
            const char* a2 = last ? nA : cA + (size_t)(t + 2) * kstep; const char* b2 = last ? nB : cB + (size_t)(t + 2) * kstep;
            const char* a3 = a2 + kstep; const char* b3 = b2 + kstep;
            if (last && has_next) S.a_ready(nxt);
            if constexpr (SP2) {
            PG8_LDB(B0, 0, 0); PG8_LDB(B1, 0, 1); PG8_SCHED; PG8_LDA(At, 0, 0); PG8_STAGE(PG8_SA(1, 1), a1 + hstep, voffA);
            PG8_WAIT_V(8); PG8_WAIT_L(0); PG8_BAR; PG8_MMA(0, 0, At, B0); PG8_MMA(0, 1, At, B1); PG8_BAR; PG8_SCHED;
            PG8_LDA(At, 0, 1); PG8_STAGE(PG8_SB(0, 0), b2, voffB); PG8_STAGE(PG8_SB(0, 1), b2 + hstep, voffB); PG8_STAGE(PG8_SA(0, 0), a2, voffA);
            PG8_WAIT_V(8); PG8_WAIT_L(0); PG8_BAR; PG8_MMA(1, 0, At, B0); PG8_MMA(1, 1, At, B1); PG8_BAR; PG8_SCHED;
            PG8_LDB(B0, 1, 0); PG8_LDB(B1, 1, 1); PG8_SCHED; PG8_LDA(At, 1, 0); PG8_STAGE(PG8_SA(0, 1), a2 + hstep, voffA);
            PG8_WAIT_V(8); PG8_WAIT_L(0); PG8_BAR; PG8_MMA(0, 0, At, B0); PG8_MMA(0, 1, At, B1); PG8_BAR; PG8_SCHED;
            PG8_LDA(At, 1, 1); PG8_STAGE(PG8_SB(1, 0), b3, voffB); PG8_STAGE(PG8_SB(1, 1), b3 + hstep, voffB); PG8_STAGE(PG8_SA(1, 0), a3, voffA);
            PG8_WAIT_V(8); PG8_WAIT_L(0); PG8_BAR; PG8_MMA(1, 0, At, B0); PG8_MMA(1, 1, At, B1); PG8_BAR; PG8_SCHED;
            } else {
            PG8_LDB(B0, 0, 0); PG8_SCHED; PG8_LDA(At, 0, 0); PG8_STAGE(PG8_SA(1, 1), a1 + hstep, voffA);
            PG8_WAIT_L(8); PG8_BAR; PG8_WAIT_L(0); PG8_MMA(0, 0, At, B0); PG8_BAR; PG8_SCHED;
            PG8_LDB(B1, 0, 1); PG8_STAGE(PG8_SB(0, 0), b2, voffB);
            PG8_BAR; PG8_WAIT_L(0); PG8_MMA(0, 1, At, B1); PG8_BAR;
            PG8_LDA(At, 0, 1); PG8_STAGE(PG8_SA(0, 0), a2, voffA);
            PG8_BAR; PG8_WAIT_L(0); PG8_MMA(1, 0, At, B0); PG8_BAR; PG8_SCHED;
            PG8_STAGE(PG8_SB(0, 1), b2 + hstep, voffB);
            PG8_WAIT_V(6); PG8_BAR; PG8_MMA(1, 1, At, B1); PG8_BAR;
            PG8_LDB(B0, 1, 0); PG8_SCHED; PG8_LDA(At, 1, 0); PG8_STAGE(PG8_SA(0, 1), a2 + hstep, voffA);
            PG8_WAIT_L(8); PG8_BAR; PG8_WAIT_L(0); PG8_MMA(0, 0, At, B0); PG8_BAR; PG8_SCHED;
            PG8_LDB(B1, 1, 1); PG8_STAGE(PG8_SB(1, 0), b3, voffB);
            PG8_BAR; PG8_WAIT_L(0); PG8_MMA(0, 1, At, B1); PG8_BAR;
            PG8_LDA(At, 1, 1); PG8_STAGE(PG8_SA(1, 0), a3, voffA);
            PG8_BAR; PG8_WAIT_L(0); PG8_MMA(1, 0, At, B0); PG8_BAR; PG8_SCHED;
            PG8_STAGE(PG8_SB(1, 1), b3 + hstep, voffB);
            PG8_WAIT_V(6); PG8_BAR; PG8_MMA(1, 1, At, B1); PG8_BAR;
            }
        }
        if constexpr (ALIGN_EPI) { if (wr == 0) PG8_BAR; }
        if constexpr (!Epi::AFTER_DRAIN) { E(acc, cur, wr, wc, fr, fq); S.done(cur); }
        if (!has_next) break;
#pragma unroll
        for (int a = 0; a < 2; ++a)
#pragma unroll
            for (int b = 0; b < 2; ++b)
#pragma unroll
                for (int m = 0; m < 4; ++m)
#pragma unroll
                    for (int n = 0; n < 2; ++n) acc[a][b][m][n] = (f32x4){0.f, 0.f, 0.f, 0.f};
        cur = nxt; cA = nA; cB = nB; ++ui;
        if constexpr (ALIGN_EPI) { if (wr == 1) PG8_BAR; }
    }
    PG8_WAIT_V(0);
    if constexpr (!ALIGN_EPI) { if (wr == 0) PG8_BAR; }
    PG8_BAR;
    if constexpr (Epi::AFTER_DRAIN) { E.fused(acc, cur, wr, wc, fr, fq, lds, wid, lane); S.done(cur); }
#undef PG8_SA
#undef PG8_SB
#undef PG8_STAGE
#undef PG8_LDA
#undef PG8_LDB
#undef PG8_MMA
#undef PG8_WAIT_V
#undef PG8_WAIT_L
#undef PG8_BAR
#undef PG8_SCHED
}
}

template <class Epi>
__device__ void gemm_simple(const bf16_t* A, const bf16_t* Bt, int Mr, int N, int K, const Epi& epi) {
    const int tid = tid_(), wave = tid >> 6, lane = tid & 63, wm = wave >> 1, wn = wave & 1, fr = lane & 15, fq = lane >> 4;
    const int nNt = N / 128, nMt = Mr / 128;
    for (int tile = blockIdx.x; tile < nNt * nMt; tile += gridDim.x) {
        const int tm = tile / nNt, tn = tile % nNt;
        const int m0 = tm * 128 + wm * 32, n0 = tn * 128 + wn * 64;
        f32x4 acc[2][4];
#pragma unroll
        for (int i = 0; i < 2; ++i)
#pragma unroll
            for (int j = 0; j < 4; ++j) acc[i][j] = (f32x4){0.f, 0.f, 0.f, 0.f};
        const bf16_t* ap = A + (size_t)(m0 + fr) * K + fq * 8;
        const bf16_t* bp = Bt + (size_t)(n0 + fr) * K + fq * 8;
        for (int k = 0; k < K; k += 32) {
            bf16x8 af[2], bfr[4];
#pragma unroll
            for (int i = 0; i < 2; ++i) af[i] = *(const bf16x8*)(ap + (size_t)i * 16 * K + k);
#pragma unroll
            for (int j = 0; j < 4; ++j) bfr[j] = *(const bf16x8*)(bp + (size_t)j * 16 * K + k);
#pragma unroll
            for (int i = 0; i < 2; ++i)
#pragma unroll
                for (int j = 0; j < 4; ++j) acc[i][j] = __builtin_amdgcn_mfma_f32_16x16x32_bf16(bfr[j], af[i], acc[i][j], 0, 0, 0);
        }
#pragma unroll
        for (int i = 0; i < 2; ++i)
#pragma unroll
            for (int j = 0; j < 4; ++j) epi(m0 + i * 16 + fr, n0 + j * 16 + fq * 4, acc[i][j]);
    }
}

struct EpiInProj {
    bf16_t *PC, *PS, *PR, *PG;
    __device__ __forceinline__ void operator()(int m, int n, const f32x4& v) const {
        bf16_t* dst;
        if (n < 768) dst = PC + (size_t)m * PC_W + n;
        else if (n < 2304) dst = PS + (size_t)m * PS_W + (n - 768);
        else if (n < 3584) dst = PR + (size_t)m * PR_W + (n - 2304);
        else if (n < 3968) dst = PG + (size_t)m * PG_W + (n - 3584);
        else return;
        uint2 w; w.x = pk2(v[0], v[1]); w.y = pk2(v[2], v[3]); *(uint2*)dst = w;
    }
};
struct EpiF32 {
    float* Y; int ld;
    __device__ __forceinline__ void operator()(int m, int n, const f32x4& v) const { *(f32x4*)(Y + (size_t)m * ld + n) = v; }
};


struct EpiInProjP {
    static constexpr bool PERM = true, AFTER_DRAIN = false;
    bf16_t *PC, *PS, *PR, *PG, *VT;
    __device__ __forceinline__ void operator()(const pg8::f32x4 (&acc)[2][2][4][2], const pg8::Unit& u, int wr, int wc, int fr, int fq) const {
        const int row0 = u.pm * 256 + wr * 64 + fr;
#pragma unroll
        for (int bj = 0; bj < 2; ++bj) {
            const int blk = 2 * u.pn + bj; bf16_t* base; int ld, c0;
            if (blk >= 12 && blk < 15) {
                const int vc = 128 * (blk - 12) + wc * 32 + 8 * fq;
#pragma unroll
                for (int ai = 0; ai < 2; ++ai)
#pragma unroll
                    for (int m = 0; m < 4; ++m) {
                        const int row = row0 + ai * 128 + m * 16, b = row >> 11, t = row & 2047;
#pragma unroll
                        for (int n = 0; n < 2; ++n)
#pragma unroll
                            for (int e = 0; e < 4; ++e) { const int col = vc + 4 * n + e, hh = col >> 6, d = col & 63;
                                VT[((size_t)(b * NH + hh) * HD + d) * SEQ + t] = f2bf(acc[ai][bj][m][n][e]); }
                    }
                continue;
            }
            if (blk < 6) { base = PC; ld = PC_W; c0 = 128 * blk; }
            else if (blk < 12) { base = PS; ld = PS_W; c0 = 128 * (blk - 6); }
            else if (blk < 18) { base = PS; ld = PS_W; c0 = 768 + 128 * (blk - 15); }
            else if (blk < 28) { base = PR; ld = PR_W; c0 = 128 * (blk - 18); }
            else if (blk < 31) { base = PG; ld = PG_W; c0 = 128 * (blk - 28); }
            else continue;
            const int col = c0 + wc * 32 + 8 * fq;
#pragma unroll
            for (int ai = 0; ai < 2; ++ai)
#pragma unroll
                for (int m = 0; m < 4; ++m) {
                    const pg8::f32x4 v0 = acc[ai][bj][m][0], v1 = acc[ai][bj][m][1]; pg8::u32x4 w;
                    w.x = pg8::cvt_pk_bf16(v0[0], v0[1]); w.y = pg8::cvt_pk_bf16(v0[2], v0[3]); w.z = pg8::cvt_pk_bf16(v1[0], v1[1]); w.w = pg8::cvt_pk_bf16(v1[2], v1[3]);
                    *(pg8::u32x4*)(base + (size_t)(row0 + ai * 128 + m * 16) * ld + col) = w;
                }
        }
    }
};
struct EpiOutF32P {
    static constexpr bool PERM = false, AFTER_DRAIN = false;
    float* Y; int ld;
    __device__ __forceinline__ void operator()(const pg8::f32x4 (&acc)[2][2][4][2], const pg8::Unit& u, int wr, int wc, int fr, int fq) const {
        const int row0 = u.pm * 256 + wr * 64 + fr, col0 = u.pn * 256 + wc * 32 + 4 * fq;
#pragma unroll
        for (int ai = 0; ai < 2; ++ai)
#pragma unroll
            for (int m = 0; m < 4; ++m)
#pragma unroll
                for (int bj = 0; bj < 2; ++bj)
#pragma unroll
                    for (int n = 0; n < 2; ++n) *(pg8::f32x4*)(Y + (size_t)(row0 + ai * 128 + m * 16) * ld + col0 + bj * 128 + n * 16) = acc[ai][bj][m][n];
    }
};

__device__ void phase_rowpass(const float* Xin, const float* Y, const float* gpost, float* Xout, bf16_t* XB) {
    const int tid = tid_(), lane = tid & 63, wave = tid >> 6;
    for (int row = blockIdx.x * 8 + wave; row < M; row += gridDim.x * 8) {
        f32x4 y[4], x[4]; float ss = 0.f;
#pragma unroll
        for (int i = 0; i < 4; ++i) { y[i] = *(const f32x4*)(Y + (size_t)row * DM + i * 256 + lane * 4); x[i] = *(const f32x4*)(Xin + (size_t)row * DM + i * 256 + lane * 4);
            ss += y[i][0] * y[i][0] + y[i][1] * y[i][1] + y[i][2] * y[i][2] + y[i][3] * y[i][3]; }
        ss = wave_sum(ss);
        const float rstd = rsqrtf(ss * (1.0f / DM) + RMS_EPS);
        float s2 = 0.f;
#pragma unroll
        for (int i = 0; i < 4; ++i) { const f32x4 g = *(const f32x4*)(gpost + i * 256 + lane * 4);
            x[i] = x[i] + y[i] * rstd * g; s2 += x[i][0] * x[i][0] + x[i][1] * x[i][1] + x[i][2] * x[i][2] + x[i][3] * x[i][3];
            *(f32x4*)(Xout + (size_t)row * DM + i * 256 + lane * 4) = x[i]; }
        if (XB) {
            s2 = wave_sum(s2);
            const float r2 = rsqrtf(s2 * (1.0f / DM) + RMS_EPS);
#pragma unroll
            for (int i = 0; i < 4; ++i) { uint2 w; w.x = pk2(x[i][0] * r2, x[i][1] * r2); w.y = pk2(x[i][2] * r2, x[i][3] * r2); *(uint2*)(XB + (size_t)row * DM + i * 256 + lane * 4) = w; }
        }
    }
}

__device__ void conv_job(const Params& p, int l, int job, float* lds) {
    const int tid = tid_(), lane = tid & 63, wave = tid >> 6;
    const int b = job / (SEQ / 32), t0 = (job % (SEQ / 32)) * 32;
    const bf16_t* PC = (const bf16_t*)(p.ws + WS_PC); bf16_t* MIX = (bf16_t*)(p.ws + WS_MIX);
    const float* dw = p.in[5] + l * TAPS * CW; const float* dwb = p.in[6] + l * CW; const float* lng = p.in[7] + l * CW; const float* lnb = p.in[8] + l * CW;
    const float* pw = p.in[9] + (size_t)l * CW * CW; const float* pwb = p.in[10] + l * CW;
    float* u = lds;
    float* cv = lds + 62 * 256;
    for (int idx = tid; idx < 62 * 256; idx += 512) {
        const int r = idx >> 8, c = idx & 255, t = t0 - 30 + r;
        float v = 0.f;
        if (t >= 0) { const bf16_t* pr = PC + (size_t)(b * SEQ + t) * PC_W; v = bf2f(pr[c]) * sigmoidf_(bf2f(pr[256 + c])); }
        u[idx] = v;
    }
    __syncthreads();
    for (int idx = tid; idx < 32 * 256; idx += 512) {
        const int tt = idx >> 8, c = idx & 255;
        float a = dwb[c];
#pragma unroll 4
        for (int j = 0; j < TAPS; ++j) a += dw[j * CW + c] * u[(tt + j) * 256 + c];
        cv[idx] = a;
    }
    __syncthreads();
    for (int q = 0; q < 4; ++q) {
        const int tt = wave * 4 + q; float x[4], s = 0.f;
#pragma unroll
        for (int i = 0; i < 4; ++i) { x[i] = cv[tt * 256 + lane + 64 * i]; s += x[i]; }
        const float mean = wave_sum(s) * (1.0f / CW); float vs = 0.f;
#pragma unroll
        for (int i = 0; i < 4; ++i) { const float d = x[i] - mean; vs += d * d; }
        const float rstd = rsqrtf(wave_sum(vs) * (1.0f / CW) + LN_EPS);
#pragma unroll
        for (int i = 0; i < 4; ++i) { const int c = lane + 64 * i; cv[tt * 256 + c] = siluf_((x[i] - mean) * rstd * lng[c] + lnb[c]); }
    }
    __syncthreads();
    {
        const int n = tid & 255, half = tid >> 8;
        float acc[16];
#pragma unroll
        for (int i = 0; i < 16; ++i) acc[i] = pwb[n];
#pragma unroll 2
        for (int k = 0; k < CW; ++k) {
            const float w = pw[(size_t)k * CW + n];
#pragma unroll
            for (int i = 0; i < 16; ++i) acc[i] += cv[(half * 16 + i) * 256 + k] * w;
        }
#pragma unroll
        for (int i = 0; i < 16; ++i) { const size_t row = (size_t)b * SEQ + t0 + half * 16 + i;
            const float g = bf2f(PC[row * PC_W + 512 + n]);
            MIX[row * DM + n] = f2bf(acc[i] * siluf_(g)); }
    }
    __syncthreads();
}

__device__ void attn_job(const Params& p, int job) {
    const int tid = tid_(), lane = tid & 63, wave = tid >> 6;
    const int bh = job >> 2, qb = job & 3, b = bh / NH, h = bh % NH;
    const bf16_t* PS = (const bf16_t*)(p.ws + WS_PS); bf16_t* MIX = (bf16_t*)(p.ws + WS_MIX);
    const int tw = qb * 512 + wave * 64, t = tw + lane;
    const size_t row = (size_t)b * SEQ + t;
    const float qs = 1.0f;
    const bf16_t* VT = (const bf16_t*)(p.ws + WS_VT) + (size_t)bh * HD * SEQ;
    float q[64], o[64];
    {
        const bf16_t* qp = PS + row * PS_W + h * HD;
#pragma unroll
        for (int i = 0; i < 8; ++i) { const bf16x8 v = *(const bf16x8*)(qp + i * 8);
#pragma unroll
            for (int j = 0; j < 8; ++j) { q[i * 8 + j] = bf2f((bf16_t)v[j]) * qs; o[i * 8 + j] = 0.f; } }
    }
    float rp = 1.0f;
    const int z = opaque_zero();
    for (int s = tw + 62; s >= 0; --s) {
        const bf16_t* kp = PS + ((size_t)b * SEQ + s) * PS_W + 384 + h * HD + z;
        float dot = 0.f;
#pragma unroll
        for (int i = 0; i < 8; ++i) { const bf16x8 v = *(const bf16x8*)(kp + i * 8);
#pragma unroll
            for (int j = 0; j < 8; ++j) dot += q[i * 8 + j] * bf2f((bf16_t)v[j]); }
        const bool act = s < t;
        const float e = __builtin_amdgcn_exp2f(dot);
        const float keep = __builtin_amdgcn_rcpf(1.0f + e);
        const float pr = act ? (1.0f - keep) * rp : 0.f;
        rp = act ? rp * keep : rp;
#pragma unroll
        for (int d = 0; d < 64; ++d) o[d] += pr * bf2f(VT[(size_t)d * SEQ + s + z]);
        if (__all(rp == 0.0f)) break;
    }
    const bf16_t* gp = PS + row * PS_W + 768 + h * HD;
    bf16_t* op = MIX + row * DM + CW + h * HD;
#pragma unroll
    for (int i = 0; i < 8; ++i) { const bf16x8 g = *(const bf16x8*)(gp + i * 8); uint4 w;
        w.x = pk2(o[i * 8 + 0] * siluf_(bf2f((bf16_t)g[0])), o[i * 8 + 1] * siluf_(bf2f((bf16_t)g[1])));
        w.y = pk2(o[i * 8 + 2] * siluf_(bf2f((bf16_t)g[2])), o[i * 8 + 3] * siluf_(bf2f((bf16_t)g[3])));
        w.z = pk2(o[i * 8 + 4] * siluf_(bf2f((bf16_t)g[4])), o[i * 8 + 5] * siluf_(bf2f((bf16_t)g[5])));
        w.w = pk2(o[i * 8 + 6] * siluf_(bf2f((bf16_t)g[6])), o[i * 8 + 7] * siluf_(bf2f((bf16_t)g[7])));
        *(uint4*)(op + i * 8) = w; }
}

typedef float f32x16 __attribute__((ext_vector_type(16)));
__device__ void attn_mfma_wave(const Params& p, int bh, int qblk) {
    const int tid = tid_(), lane = tid & 63, qi = lane & 31, hf = lane >> 5;
    const int b = bh / NH, h = bh % NH, q0 = qblk * 32;
    const bf16_t* PS = (const bf16_t*)(p.ws + WS_PS); const bf16_t* VT = (const bf16_t*)(p.ws + WS_VT) + (size_t)bh * HD * SEQ; bf16_t* MIX = (bf16_t*)(p.ws + WS_MIX);
    const size_t rowq = (size_t)b * SEQ + q0 + qi;
    bf16x8 Qf[4];
#pragma unroll
    for (int ks = 0; ks < 4; ++ks) Qf[ks] = *(const bf16x8*)(PS + rowq * PS_W + h * HD + ks * 16 + hf * 8);
    const int pi = (qi & 3) + 4 * (qi >> 3) + 16 * ((qi >> 2) & 1);
    const bf16_t* kbase = PS + ((size_t)b * SEQ + pi) * PS_W + SBW + h * HD + hf * 8;
    const bf16_t* vbase = VT + (size_t)qi * SEQ + hf * 16;
    f32x16 O0, O1;
#pragma unroll
    for (int r = 0; r < 16; ++r) { O0[r] = 0.f; O1[r] = 0.f; }
    float rp = 1.0f;
    for (int kt = qblk; kt >= 0; --kt) {
        const int s0 = kt * 32;
        bf16x8 Kf[4], Vf[2][2];
#pragma unroll
        for (int ks = 0; ks < 4; ++ks) Kf[ks] = *(const bf16x8*)(kbase + (size_t)s0 * PS_W + ks * 16);
#pragma unroll
        for (int db = 0; db < 2; ++db)
#pragma unroll
            for (int s = 0; s < 2; ++s) Vf[db][s] = *(const bf16x8*)(vbase + (size_t)db * 32 * SEQ + s0 + s * 8);
        f32x16 S;
#pragma unroll
        for (int r = 0; r < 16; ++r) S[r] = 0.f;
#pragma unroll
        for (int ks = 0; ks < 4; ++ks) S = __builtin_amdgcn_mfma_f32_32x32x16_bf16(Kf[ks], Qf[ks], S, 0, 0, 0);
        float keep[16], beta[16];
        const bool diag = kt == qblk;
        float tot = 1.0f;
#pragma unroll
        for (int r = 0; r < 16; ++r) {
            const float e = __builtin_amdgcn_exp2f(S[r]);
            float k_ = __builtin_amdgcn_rcpf(1.0f + e);
            float b_ = 1.0f - k_;
            if (diag && (hf * 16 + r >= qi)) { k_ = 1.0f; b_ = 0.f; }
            keep[r] = k_; beta[r] = b_; tot *= k_;
        }
        const float toto = __shfl_xor(tot, 32);
        float e = hf ? rp : rp * toto;
        float pw[16];
#pragma unroll
        for (int r = 15; r >= 0; --r) { pw[r] = beta[r] * e; e *= keep[r]; }
        rp = rp * tot * toto;
        bf16x8 Pf[2];
#pragma unroll
        for (int s = 0; s < 2; ++s) {
            union { bf16x8 v; unsigned u[4]; } pk;
#pragma unroll
            for (int j = 0; j < 4; ++j) pk.u[j] = pk2(pw[8 * s + 2 * j], pw[8 * s + 2 * j + 1]);
            Pf[s] = pk.v;
        }
#pragma unroll
        for (int s = 0; s < 2; ++s) { O0 = __builtin_amdgcn_mfma_f32_32x32x16_bf16(Vf[0][s], Pf[s], O0, 0, 0, 0); O1 = __builtin_amdgcn_mfma_f32_32x32x16_bf16(Vf[1][s], Pf[s], O1, 0, 0, 0); }
        if (__ballot(rp != 0.0f) == 0ull) break;
    }
    const bf16_t* gp = PS + rowq * PS_W + 768 + h * HD; bf16_t* op = MIX + rowq * DM + CW + h * HD;
#pragma unroll
    for (int db = 0; db < 2; ++db)
#pragma unroll
        for (int g = 0; g < 4; ++g) {
            const int d0 = db * 32 + g * 8 + hf * 4;
            const uint2 gw = *(const uint2*)(gp + d0);
            const float g0 = bf2f((bf16_t)(gw.x & 0xffff)), g1 = bf2f((bf16_t)(gw.x >> 16)), g2 = bf2f((bf16_t)(gw.y & 0xffff)), g3 = bf2f((bf16_t)(gw.y >> 16));
            const f32x16& O = db ? O1 : O0;
            uint2 w; w.x = pk2(O[4 * g] * siluf_(g0), O[4 * g + 1] * siluf_(g1)); w.y = pk2(O[4 * g + 2] * siluf_(g2), O[4 * g + 3] * siluf_(g3));
            *(uint2*)(op + d0) = w;
        }
}

__device__ void rwkv_job(const Params& p, int l, int job, float* lds) {
    const int tid = tid_(), lane = tid & 63, wave = tid >> 6;
    const int b = job / NH, h = job % NH;
    const bf16_t* PR = (const bf16_t*)(p.ws + WS_PR); const bf16_t* PG = (const bf16_t*)(p.ws + WS_PG);
    float* VF = (float*)(p.ws + WS_VF); bf16_t* MIX = (bf16_t*)(p.ws + WS_MIX);
    const float* mu = p.in[11] + l * 1216; const float* w0 = p.in[12] + l * RWW; const float* w2 = p.in[13] + l * LORA * RWW;
    const float* a0 = p.in[14] + l * RWW; const float* a2 = p.in[15] + l * LORA * RWW; const float* kks = p.in[16] + l * RWW; const float* ka = p.in[17] + l * RWW;
    const float* rk = p.in[18] + l * RWW; const float* gng = p.in[19] + l * RWW; const float* gnb = p.in[20] + l * RWW;
    const float* v0 = p.in[21]; const float* v1 = p.in[22]; const float* v2 = p.in[23];
    float* R = lds; float* W = R + 4096; float* K = W + 4096; float* V = K + 4096; float* A = V + 4096; float* Bm = A + 4096; float* Y = Bm + 4096;
    float* WD = Y + 4096; float* AD = WD + 2048; float* VL = AD + 2048;
    float S[64];
#pragma unroll
    for (int i = 0; i < 64; ++i) S[i] = 0.f;
    for (int c = 0; c < SEQ / 64; ++c) {
        const int t0 = c * 64;
        for (int idx = tid; idx < 64 * 64; idx += 512) {
            const int tt = idx >> 6, i = idx & 63, t = t0 + tt;
            const bf16_t* cur = PR + ((size_t)b * SEQ + t) * PR_W;
            const float xc = bf2f(cur[1152 + i]), xp = t > 0 ? bf2f(cur[1152 + i - PR_W]) : 0.f;
            const float f = xc + (xp - xc) * mu[1152 + i];
            if (i < 32) WD[tt * 32 + i] = tanhf(f); else AD[tt * 32 + i - 32] = f;
        }
        if (l > 0) {
            for (int idx = tid; idx < 64 * 32; idx += 512) {
                const int tt = idx >> 5, i = idx & 31, t = t0 + tt;
                const bf16_t* cur = PR + ((size_t)b * SEQ + t) * PR_W + 768;
                float a = 0.f;
                for (int cc = 0; cc < RWW; ++cc) {
                    const float xc = bf2f(cur[cc]), xp = t > 0 ? bf2f(cur[cc - PR_W]) : 0.f;
                    a += (xc + (xp - xc) * mu[768 + cc]) * v1[cc * LORA + i];
                }
                VL[idx] = a;
            }
        }
        __syncthreads();
        for (int idx = tid; idx < 64 * 64; idx += 512) {
            const int tt = idx >> 6, j = idx & 63, t = t0 + tt, cj = h * HD + j;
            const size_t row = (size_t)b * SEQ + t;
            const bf16_t* cur = PR + row * PR_W;
            const bool hp = t > 0;
            float rc = bf2f(cur[cj]), kc = bf2f(cur[384 + cj]), vc = bf2f(cur[768 + cj]);
            const float rp_ = hp ? bf2f(cur[cj - PR_W]) : 0.f, kp_ = hp ? bf2f(cur[384 + cj - PR_W]) : 0.f, vp_ = hp ? bf2f(cur[768 + cj - PR_W]) : 0.f;
            rc += (rp_ - rc) * mu[cj]; kc += (kp_ - kc) * mu[384 + cj]; vc += (vp_ - vc) * mu[768 + cj];
            float wl = w0[cj], al = a0[cj];
#pragma unroll 8
            for (int i = 0; i < LORA; ++i) { wl += WD[tt * 32 + i] * w2[i * RWW + cj]; al += AD[tt * 32 + i] * a2[i * RWW + cj]; }
            const float sp = fmaxf(-wl, 0.f) + log1pf(__expf(-fabsf(wl)));
            const float decay = __expf(-__expf(-sp - 0.5f));
            const float alr = sigmoidf_(al);
            if (l > 0) {
                float vg = v0[cj];
#pragma unroll 8
                for (int i = 0; i < LORA; ++i) vg += VL[tt * 32 + i] * v2[i * RWW + cj];
                vg = sigmoidf_(vg);
                vc = vc + (VF[row * RWW + cj] - vc) * vg;
            } else VF[row * RWW + cj] = vc;
            R[idx] = rc; W[idx] = decay; V[idx] = vc;
            K[idx] = kc * (1.0f + (alr - 1.0f) * ka[cj]);
            A[idx] = kc * kks[cj];
            Bm[idx] = alr;
        }
        __syncthreads();
        for (int q = 0; q < 8; ++q) {
            const int tt = wave * 8 + q; const float kk = A[tt * 64 + lane];
            const float nrm = sqrtf(wave_sum(kk * kk));
            const float kn = kk / fmaxf(nrm, 1e-12f);
            A[tt * 64 + lane] = -kn; Bm[tt * 64 + lane] = kn * Bm[tt * 64 + lane];
        }
        __syncthreads();
        if (wave == 0) {
            for (int tt = 0; tt < 64; ++tt) {
                const f32x4* a4 = (const f32x4*)(A + tt * 64); const f32x4* w4 = (const f32x4*)(W + tt * 64); const f32x4* b4 = (const f32x4*)(Bm + tt * 64);
                const f32x4* k4 = (const f32x4*)(K + tt * 64); const f32x4* r4 = (const f32x4*)(R + tt * 64);
                float sa = 0.f;
#pragma unroll
                for (int i = 0; i < 16; ++i) { const f32x4 a = a4[i]; sa += S[4 * i] * a[0] + S[4 * i + 1] * a[1] + S[4 * i + 2] * a[2] + S[4 * i + 3] * a[3];
                    if ((i & 7) == 7) asm volatile("" ::: "memory"); }
                const float vv = V[tt * 64 + lane];
                float y = 0.f;
#pragma unroll
                for (int i = 0; i < 16; ++i) { const f32x4 w = w4[i], bb = b4[i], kk = k4[i], rr = r4[i];
#pragma unroll
                    for (int e = 0; e < 4; ++e) { const float s = S[4 * i + e] * w[e] + sa * bb[e] + vv * kk[e]; S[4 * i + e] = s; y += s * rr[e]; }
                    if ((i & 1) == 1) asm volatile("" ::: "memory"); }
                Y[tt * 64 + lane] = y;
            }
        }
        __syncthreads();
        for (int q = 0; q < 8; ++q) {
            const int tt = wave * 8 + q, t = t0 + tt, cj = h * HD + lane; const size_t row = (size_t)b * SEQ + t;
            const float y = Y[tt * 64 + lane];
            const float mean = wave_sum(y) * (1.0f / HD); const float d = y - mean;
            const float var = wave_sum(d * d) * (1.0f / HD);
            const float yn = d * rsqrtf(var + GN_EPS) * gng[cj] + gnb[cj];
            const float bonus = wave_sum(R[tt * 64 + lane] * K[tt * 64 + lane] * rk[cj]);
            const float o = yn + bonus * V[tt * 64 + lane];
            const float g = bf2f(PG[row * PG_W + cj]);
            MIX[row * DM + CW + SBW + cj] = f2bf(o * siluf_(g));
        }
        __syncthreads();
    }
}

constexpr int TS = 72;
constexpr int TILE_B = 64 * TS * 2;
constexpr int AABS = 68, XTS = 65, CSS = 65;

__device__ __forceinline__ f32x4 mm_tile(const bf16_t* X, int m0, const bf16_t* Yt, int n0, int K, int fr, int fq, f32x4 acc) {
#pragma unroll
    for (int kk = 0; kk < 2; ++kk) {
        if (kk * 32 < K) {
            const bf16x8 a = *(const bf16x8*)(X + (m0 + fr) * TS + kk * 32 + fq * 8);
            const bf16x8 b = *(const bf16x8*)(Yt + (n0 + fr) * TS + kk * 32 + fq * 8);
            acc = __builtin_amdgcn_mfma_f32_16x16x32_bf16(a, b, acc, 0, 0, 0);
        }
    }
    return acc;
}
__device__ __forceinline__ uint2 pk4(const f32x4& v) { uint2 w; w.x = pk2(v[0], v[1]); w.y = pk2(v[2], v[3]); return w; }

__device__ void rwkv_b1_job(const Params& p, int l, int jb, unsigned char* lds) {
    const int tid = tid_(), lane = tid & 63, wave = tid >> 6, fr = lane & 15, fq = lane >> 4;
    const int bh = jb >> 5, c = jb & 31, b = bh / NH, h = bh % NH, t0 = c * 64;
    const bf16_t* PR = (const bf16_t*)(p.ws + WS_PR); float* VF = (float*)(p.ws + WS_VF);
    const float* mu = p.in[11] + l * 1216; const float* w0 = p.in[12] + l * RWW; const float* w2 = p.in[13] + l * LORA * RWW;
    const float* a0 = p.in[14] + l * RWW; const float* a2 = p.in[15] + l * LORA * RWW; const float* kks = p.in[16] + l * RWW; const float* ka = p.in[17] + l * RWW;
    const float* rk = p.in[18] + l * RWW; const float* v0 = p.in[21]; const float* v2 = p.in[23];
    bf16_t* T_At = (bf16_t*)lds; bf16_t* T_Rt = T_At + 64 * TS; bf16_t* T_Bt = T_Rt + 64 * TS; bf16_t* T_Kt = T_Bt + 64 * TS;
    bf16_t* T_VT = T_Kt + 64 * TS; bf16_t* T_bhT = T_VT + 64 * TS; bf16_t* T_khT = T_bhT + 64 * TS;
    bf16_t* T_Aak = T_khT + 64 * TS; bf16_t* T_Arb = T_Aak + 64 * TS; bf16_t* T_Ark = T_Arb + 64 * TS;
    bf16_t* T_WT = T_At; bf16_t* T_U0T = T_Bt;
    float* Aab = (float*)(lds + 10 * TILE_B);
    float* XT = (float*)(lds + 10 * TILE_B + 64 * AABS * 4);
    float* PCv = XT + 128 * XTS;
    float* CS = (float*)T_Aak;
    float* WD = XT + 64 * XTS; float* AD = WD + 2048;
    float* VL = Aab;

    for (int idx = tid; idx < 2048; idx += 512) {
        const int tt = idx >> 5, i = idx & 31, t = t0 + tt;
        const bf16_t* cur = PR + ((size_t)b * SEQ + t) * PR_W; const bool hp = t > 0;
        { const float xc = bf2f(cur[1152 + i]), xp = hp ? bf2f(cur[1152 + i - PR_W]) : 0.f; WD[idx] = tanhf(xc + (xp - xc) * mu[1152 + i]); }
        { const float xc = bf2f(cur[1184 + i]), xp = hp ? bf2f(cur[1184 + i - PR_W]) : 0.f; AD[idx] = xc + (xp - xc) * mu[1184 + i]; }
        if (l > 0) VL[idx] = bf2f(cur[1216 + i]) + (hp ? bf2f(cur[1248 + i - PR_W]) : 0.f);
    }
    __syncthreads();
    const int tt = tid >> 3, j0 = (tid & 7) * 8, t = t0 + tt, cj0 = h * HD + j0;
    const size_t row = (size_t)b * SEQ + t;
    float rr[8], kk_[8], vv[8], aa[8], bb[8], lw[8];
    {
        const bf16_t* cur = PR + row * PR_W; const bool hp = t > 0;
        const bf16x8 rc = *(const bf16x8*)(cur + cj0), kc = *(const bf16x8*)(cur + 384 + cj0), vc = *(const bf16x8*)(cur + 768 + cj0);
        bf16x8 rp = rc, kp = kc, vp = vc;
        if (hp) { rp = *(const bf16x8*)(cur + cj0 - PR_W); kp = *(const bf16x8*)(cur + 384 + cj0 - PR_W); vp = *(const bf16x8*)(cur + 768 + cj0 - PR_W); }
        float wl[8], al[8], vg[8];
#pragma unroll
        for (int e = 0; e < 8; ++e) {
            const float r_c = bf2f((bf16_t)rc[e]), k_c = bf2f((bf16_t)kc[e]), v_c = bf2f((bf16_t)vc[e]);
            const float r_p = hp ? bf2f((bf16_t)rp[e]) : 0.f, k_p = hp ? bf2f((bf16_t)kp[e]) : 0.f, v_p = hp ? bf2f((bf16_t)vp[e]) : 0.f;
            rr[e] = r_c + (r_p - r_c) * mu[cj0 + e]; kk_[e] = k_c + (k_p - k_c) * mu[384 + cj0 + e]; vv[e] = v_c + (v_p - v_c) * mu[768 + cj0 + e];
            wl[e] = w0[cj0 + e]; al[e] = a0[cj0 + e]; vg[e] = l > 0 ? v0[cj0 + e] : 0.f;
        }
#pragma unroll 4
        for (int i = 0; i < LORA; ++i) {
            const float wd = WD[tt * 32 + i], ad = AD[tt * 32 + i];
            const f32x4 wa = *(const f32x4*)(w2 + i * RWW + cj0), wb = *(const f32x4*)(w2 + i * RWW + cj0 + 4);
            const f32x4 xa = *(const f32x4*)(a2 + i * RWW + cj0), xb = *(const f32x4*)(a2 + i * RWW + cj0 + 4);
#pragma unroll
            for (int e = 0; e < 4; ++e) { wl[e] += wd * wa[e]; wl[4 + e] += wd * wb[e]; al[e] += ad * xa[e]; al[4 + e] += ad * xb[e]; }
            if (l > 0) { const float vl = VL[tt * 32 + i];
                const f32x4 ya = *(const f32x4*)(v2 + i * RWW + cj0), yb = *(const f32x4*)(v2 + i * RWW + cj0 + 4);
#pragma unroll
                for (int e = 0; e < 4; ++e) { vg[e] += vl * ya[e]; vg[4 + e] += vl * yb[e]; } }
        }
        float ssq = 0.f, bon = 0.f;
#pragma unroll
        for (int e = 0; e < 8; ++e) {
            const float sp = fmaxf(-wl[e], 0.f) + log1pf(__expf(-fabsf(wl[e])));
            lw[e] = -__expf(-sp - 0.5f);
            const float alr = sigmoidf_(al[e]);
            if (l > 0) vv[e] = vv[e] + (VF[row * RWW + cj0 + e] - vv[e]) * sigmoidf_(vg[e]); else VF[row * RWW + cj0 + e] = vv[e];
            const float kkr = kk_[e] * kks[cj0 + e];
            kk_[e] = kk_[e] * (1.0f + (alr - 1.0f) * ka[cj0 + e]);
            aa[e] = kkr; bb[e] = alr; ssq += kkr * kkr; bon += rr[e] * kk_[e] * rk[cj0 + e];
        }
        ssq += __shfl_xor(ssq, 1); ssq += __shfl_xor(ssq, 2); ssq += __shfl_xor(ssq, 4);
        bon += __shfl_xor(bon, 1); bon += __shfl_xor(bon, 2); bon += __shfl_xor(bon, 4);
        const float inv = 1.0f / fmaxf(sqrtf(ssq), 1e-12f);
        uint4 bvw; float bv[8];
#pragma unroll
        for (int e = 0; e < 8; ++e) { const float kn = aa[e] * inv; aa[e] = -kn; bb[e] = kn * bb[e]; bv[e] = bon * vv[e]; CS[tt * CSS + j0 + e] = lw[e]; }
        bvw.x = pk2(bv[0], bv[1]); bvw.y = pk2(bv[2], bv[3]); bvw.z = pk2(bv[4], bv[5]); bvw.w = pk2(bv[6], bv[7]);
        *(uint4*)((bf16_t*)(p.ws + WS_CH_BV) + (size_t)jb * 4096 + tt * 64 + j0) = bvw;
    }
    __syncthreads();
#pragma unroll
    for (int e = 0; e < 8; ++e) {
        const int j = wave * 8 + e; float x = CS[lane * CSS + j];
#pragma unroll
        for (int o = 1; o < 64; o <<= 1) { const float y = __shfl_up(x, o); if (lane >= o) x += y; }
        CS[lane * CSS + j] = x;
    }
    __syncthreads();
    {
        float at[8], rt[8], bt[8], kt[8];
#pragma unroll
        for (int e = 0; e < 8; ++e) {
            const int j = j0 + e; const float cs = CS[tt * CSS + j], csC = CS[63 * CSS + j];
            const float e_in = __expf(cs), e_ex = __expf(cs - lw[e]), e_ng = __expf(-cs), e_ht = __expf(csC - cs);
            at[e] = aa[e] * e_ex; rt[e] = rr[e] * e_in; bt[e] = bb[e] * e_ng; kt[e] = kk_[e] * e_ng;
            T_VT[j * TS + tt] = f2bf(vv[e]); T_bhT[j * TS + tt] = f2bf(bb[e] * e_ht); T_khT[j * TS + tt] = f2bf(kk_[e] * e_ht);
            XT[j * XTS + tt] = at[e];
            if (tt == 63) PCv[j] = __expf(csC);
        }
        uint4 w;
        w.x = pk2(at[0], at[1]); w.y = pk2(at[2], at[3]); w.z = pk2(at[4], at[5]); w.w = pk2(at[6], at[7]); *(uint4*)(T_At + tt * TS + j0) = w;
        w.x = pk2(rt[0], rt[1]); w.y = pk2(rt[2], rt[3]); w.z = pk2(rt[4], rt[5]); w.w = pk2(rt[6], rt[7]); *(uint4*)(T_Rt + tt * TS + j0) = w;
        w.x = pk2(bt[0], bt[1]); w.y = pk2(bt[2], bt[3]); w.z = pk2(bt[4], bt[5]); w.w = pk2(bt[6], bt[7]); *(uint4*)(T_Bt + tt * TS + j0) = w;
        w.x = pk2(kt[0], kt[1]); w.y = pk2(kt[2], kt[3]); w.z = pk2(kt[4], kt[5]); w.w = pk2(kt[6], kt[7]); *(uint4*)(T_Kt + tt * TS + j0) = w;
    }
    __syncthreads();
#pragma unroll 1
    for (int q = 0; q < 8; ++q) {
        const int id = wave * 8 + q, mat = id >> 4, ti = (id >> 2) & 3, tj = id & 3;
        const bf16_t* As = (mat == 0 || mat == 2) ? T_Bt : T_Kt; const bf16_t* Bs = (mat < 2) ? T_At : T_Rt;
        f32x4 acc = (f32x4){0.f, 0.f, 0.f, 0.f};
        if (ti <= tj) acc = mm_tile(As, ti * 16, Bs, tj * 16, 64, fr, fq, acc);
        const int tcol = tj * 16 + fr, i0 = ti * 16 + fq * 4;
#pragma unroll
        for (int r = 0; r < 4; ++r) { const bool keep = (mat < 2) ? (i0 + r < tcol) : (i0 + r <= tcol); if (!keep) acc[r] = 0.f; }
        if (mat == 0) *(f32x4*)(Aab + tcol * AABS + i0) = acc;
        else { bf16_t* dst = (mat == 1 ? T_Aak : (mat == 2 ? T_Arb : T_Ark)); *(uint2*)(dst + tcol * TS + i0) = pk4(acc); }
    }
    __syncthreads();
#pragma unroll 1
    for (int q = 0; q < 2; ++q) {
        const int id = wave * 2 + q, ti = id >> 2, tj = id & 3;
        f32x4 acc = mm_tile(T_Aak, ti * 16, T_VT, tj * 16, 64, fr, fq, (f32x4){0.f, 0.f, 0.f, 0.f});
        const int j = tj * 16 + fr, tr = ti * 16 + fq * 4;
#pragma unroll
        for (int r = 0; r < 4; ++r) XT[(64 + j) * XTS + tr + r] = acc[r];
    }
    __syncthreads();
#pragma unroll 1
    for (int I = 0; I < 4; ++I) {
        if (I > 0) {
            const int jp = tid & 127, tq = tid >> 7; float s[4] = {0.f, 0.f, 0.f, 0.f};
            const float* xr = XT + jp * XTS; const float* ar = Aab + (16 * I + 4 * tq) * AABS;
            for (int i = 0; i < 16 * I; ++i) { const float x = xr[i];
#pragma unroll
                for (int r = 0; r < 4; ++r) s[r] += ar[r * AABS + i] * x; }
            __syncthreads();
#pragma unroll
            for (int r = 0; r < 4; ++r) XT[jp * XTS + 16 * I + 4 * tq + r] += s[r];
            __syncthreads();
        }
        if (tid < 128) {
            float x[16]; float* xr = XT + tid * XTS + 16 * I; const float* ar = Aab + (16 * I) * AABS + 16 * I;
#pragma unroll
            for (int u = 0; u < 16; ++u) { float v = xr[u];
#pragma unroll
                for (int i = 0; i < u; ++i) v += ar[u * AABS + i] * x[i];
                x[u] = v; }
#pragma unroll
            for (int u = 0; u < 16; ++u) xr[u] = x[u];
        }
        __syncthreads();
    }
    {
        const int col = tid >> 2, tg = (tid & 3) * 16;
        const float* xr = XT + col * XTS + tg; bf16_t* dst = (col < 64 ? T_WT + col * TS : T_U0T + (col - 64) * TS) + tg;
        uint4 w0_, w1_;
        w0_.x = pk2(xr[0], xr[1]); w0_.y = pk2(xr[2], xr[3]); w0_.z = pk2(xr[4], xr[5]); w0_.w = pk2(xr[6], xr[7]);
        w1_.x = pk2(xr[8], xr[9]); w1_.y = pk2(xr[10], xr[11]); w1_.z = pk2(xr[12], xr[13]); w1_.w = pk2(xr[14], xr[15]);
        *(uint4*)dst = w0_; *(uint4*)(dst + 8) = w1_;
    }
    __syncthreads();
    {
        bf16_t* gM = (bf16_t*)(p.ws + WS_CH_M) + (size_t)jb * 4096; bf16_t* gNT = (bf16_t*)(p.ws + WS_CH_NT) + (size_t)jb * 4096;
        bf16_t* gG = (bf16_t*)(p.ws + WS_CH_G) + (size_t)jb * 4096; bf16_t* gY1T = (bf16_t*)(p.ws + WS_CH_Y1T) + (size_t)jb * 4096;
#pragma unroll 1
        for (int q = 0; q < 8; ++q) {
            const int id = wave * 8 + q, mat = id >> 4, ti = (id >> 2) & 3, tj = id & 3;
            const int col = tj * 16 + fr, r0 = ti * 16 + fq * 4;
            f32x4 acc = (f32x4){0.f, 0.f, 0.f, 0.f};
            if (mat == 0) {
                acc = mm_tile(T_WT, ti * 16, T_Arb, tj * 16, 64, fr, fq, acc);
                const uint2 rw = *(const uint2*)(T_Rt + col * TS + r0);
                acc[0] += bf2f((bf16_t)(rw.x & 0xffff)); acc[1] += bf2f((bf16_t)(rw.x >> 16)); acc[2] += bf2f((bf16_t)(rw.y & 0xffff)); acc[3] += bf2f((bf16_t)(rw.y >> 16));
                *(uint2*)(gG + col * 64 + r0) = pk4(acc);
            } else if (mat == 1) {
                acc = mm_tile(T_Arb, ti * 16, T_U0T, tj * 16, 64, fr, fq, acc);
                acc = mm_tile(T_Ark, ti * 16, T_VT, tj * 16, 64, fr, fq, acc);
                *(uint2*)(gY1T + col * 64 + r0) = pk4(acc);
            } else if (mat == 2) {
                acc = mm_tile(T_WT, ti * 16, T_bhT, tj * 16, 64, fr, fq, acc);
                const float pc = PCv[col];
#pragma unroll
                for (int r = 0; r < 4; ++r) if (r0 + r == col) acc[r] += pc;
                *(uint2*)(gM + col * 64 + r0) = pk4(acc);
            } else {
                acc = mm_tile(T_bhT, ti * 16, T_U0T, tj * 16, 64, fr, fq, acc);
                acc = mm_tile(T_khT, ti * 16, T_VT, tj * 16, 64, fr, fq, acc);
                *(uint2*)(gNT + col * 64 + r0) = pk4(acc);
            }
        }
    }
    __syncthreads();
}

__device__ void rwkv_b2_job(const Params& p, int bh, unsigned char* lds) {
    const int tid = tid_(), lane = tid & 63, wave = tid >> 6, fr = lane & 15, fq = lane >> 4;
    const int mi = wave >> 1, nj0 = (wave & 1) * 2;
    const bf16_t* gM = (const bf16_t*)(p.ws + WS_CH_M); const bf16_t* gNT = (const bf16_t*)(p.ws + WS_CH_NT); bf16_t* gZT = (bf16_t*)(p.ws + WS_ZT);
    bf16_t* zbuf = (bf16_t*)lds;
    f32x4 z[2];
    z[0] = (f32x4){0.f, 0.f, 0.f, 0.f}; z[1] = z[0];
    const int c0 = mi * 16 + fq * 4;
#pragma unroll 1
    for (int c = 0; c < SEQ / 64; ++c) {
        const size_t jb = (size_t)bh * 32 + c;
        bf16_t* zh = zbuf + (c & 1) * 2 * 64 * TS; bf16_t* zl = zh + 64 * TS;
#pragma unroll
        for (int q = 0; q < 2; ++q) {
            const int j = (nj0 + q) * 16 + fr;
            const uint2 hi = pk4(z[q]);
            f32x4 lo;
            lo[0] = z[q][0] - bf2f((bf16_t)(hi.x & 0xffff)); lo[1] = z[q][1] - bf2f((bf16_t)(hi.x >> 16)); lo[2] = z[q][2] - bf2f((bf16_t)(hi.y & 0xffff)); lo[3] = z[q][3] - bf2f((bf16_t)(hi.y >> 16));
            *(uint2*)(zh + j * TS + c0) = hi; *(uint2*)(zl + j * TS + c0) = pk4(lo);
            *(uint2*)(gZT + jb * 4096 + j * 64 + c0) = hi;
        }
        __syncthreads();
        bf16x8 am[2];
#pragma unroll
        for (int kk = 0; kk < 2; ++kk) am[kk] = *(const bf16x8*)(gM + jb * 4096 + (mi * 16 + fr) * 64 + kk * 32 + fq * 8);
#pragma unroll
        for (int q = 0; q < 2; ++q) {
            const int j = (nj0 + q) * 16 + fr;
            const uint2 nw = *(const uint2*)(gNT + jb * 4096 + j * 64 + c0);
            f32x4 acc; acc[0] = bf2f((bf16_t)(nw.x & 0xffff)); acc[1] = bf2f((bf16_t)(nw.x >> 16)); acc[2] = bf2f((bf16_t)(nw.y & 0xffff)); acc[3] = bf2f((bf16_t)(nw.y >> 16));
#pragma unroll
            for (int kk = 0; kk < 2; ++kk) {
                const bf16x8 bh_ = *(const bf16x8*)(zh + j * TS + kk * 32 + fq * 8), bl_ = *(const bf16x8*)(zl + j * TS + kk * 32 + fq * 8);
                acc = __builtin_amdgcn_mfma_f32_16x16x32_bf16(am[kk], bh_, acc, 0, 0, 0);
                acc = __builtin_amdgcn_mfma_f32_16x16x32_bf16(am[kk], bl_, acc, 0, 0, 0);
            }
            z[q] = acc;
        }
    }
    __syncthreads();
}

__device__ void rwkv_b3_pair(const Params& p, int l, int pair) {
    const int tid = tid_(), lane = tid & 63, wave = tid >> 6, fr = lane & 15, fq = lane >> 4;
    const int jb = pair * 2 + (wave >> 2), mi = wave & 3;
    const int bh = jb >> 5, c = jb & 31, b = bh / NH, h = bh % NH;
    const bf16_t* gG = (const bf16_t*)(p.ws + WS_CH_G) + (size_t)jb * 4096; const bf16_t* gY1T = (const bf16_t*)(p.ws + WS_CH_Y1T) + (size_t)jb * 4096;
    const bf16_t* gBV = (const bf16_t*)(p.ws + WS_CH_BV) + (size_t)jb * 4096; const bf16_t* gZT = (const bf16_t*)(p.ws + WS_ZT) + (size_t)jb * 4096;
    const bf16_t* PG = (const bf16_t*)(p.ws + WS_PG); bf16_t* MIX = (bf16_t*)(p.ws + WS_MIX);
    const float* gng = p.in[19] + l * RWW; const float* gnb = p.in[20] + l * RWW;
    const int tr = mi * 16 + fq * 4;
    bf16x8 ag[2];
#pragma unroll
    for (int kk = 0; kk < 2; ++kk) ag[kk] = *(const bf16x8*)(gG + (mi * 16 + fr) * 64 + kk * 32 + fq * 8);
    f32x4 acc[4];
#pragma unroll
    for (int nj = 0; nj < 4; ++nj) {
        const int j = nj * 16 + fr;
        const uint2 yw = *(const uint2*)(gY1T + j * 64 + tr);
        acc[nj][0] = bf2f((bf16_t)(yw.x & 0xffff)); acc[nj][1] = bf2f((bf16_t)(yw.x >> 16)); acc[nj][2] = bf2f((bf16_t)(yw.y & 0xffff)); acc[nj][3] = bf2f((bf16_t)(yw.y >> 16));
#pragma unroll
        for (int kk = 0; kk < 2; ++kk) { const bf16x8 bz = *(const bf16x8*)(gZT + j * 64 + kk * 32 + fq * 8); acc[nj] = __builtin_amdgcn_mfma_f32_16x16x32_bf16(ag[kk], bz, acc[nj], 0, 0, 0); }
    }
#pragma unroll
    for (int r = 0; r < 4; ++r) {
        float s = acc[0][r] + acc[1][r] + acc[2][r] + acc[3][r];
        s += __shfl_xor(s, 1); s += __shfl_xor(s, 2); s += __shfl_xor(s, 4); s += __shfl_xor(s, 8);
        const float mean = s * (1.0f / HD);
        float d[4], vs = 0.f;
#pragma unroll
        for (int nj = 0; nj < 4; ++nj) { d[nj] = acc[nj][r] - mean; vs += d[nj] * d[nj]; }
        vs += __shfl_xor(vs, 1); vs += __shfl_xor(vs, 2); vs += __shfl_xor(vs, 4); vs += __shfl_xor(vs, 8);
        const float rstd = rsqrtf(vs * (1.0f / HD) + GN_EPS);
        const int tt = tr + r; const size_t row = (size_t)b * SEQ + c * 64 + tt;
#pragma unroll
        for (int nj = 0; nj < 4; ++nj) {
            const int j = nj * 16 + fr, cj = h * HD + j;
            const float o = d[nj] * rstd * gng[cj] + gnb[cj] + bf2f(gBV[tt * 64 + j]);
            const float g = bf2f(PG[row * PG_W + cj]);
            MIX[row * DM + CW + SBW + cj] = f2bf(o * siluf_(g));
        }
    }
}

#ifndef PROBE_REP
#define PROBE_REP 0
#endif
#ifndef ATTN_REF
#define ATTN_REF 0
#endif
#ifndef RWKV_REF
#define RWKV_REF 0
#endif
__device__ void phase_mix1(const Params& p, int l, unsigned char* lds) {
    constexpr int NAT = BATCH * NH * 4, NCV = BATCH * (SEQ / 32);
    const int G = gridDim.x;
#if RWKV_REF
    for (int job = blockIdx.x; job < BATCH * NH; job += G) rwkv_job(p, l, job, (float*)lds);
#else
    for (int rep = 0; rep < ((PROBE_REP & 1) ? 2 : 1); ++rep)
    for (int job = blockIdx.x; job < BATCH * NH * 32; job += G) rwkv_b1_job(p, l, job, lds);
#endif
    for (int rep = 0; rep < ((PROBE_REP & 2) ? 2 : 1); ++rep)
#if ATTN_REF
    for (int job = blockIdx.x; job < NAT; job += G) attn_job(p, job);
#else
    for (int job = blockIdx.x; job < NAT * 2; job += G) attn_mfma_wave(p, job >> 3, (job & 7) * 8 + (tid_() >> 6));
#endif
    for (int rep = 0; rep < ((PROBE_REP & 4) ? 2 : 1); ++rep)
    for (int job = blockIdx.x; job < NCV; job += G) conv_job(p, l, job, (float*)lds);
}
__device__ void phase_mix2(const Params& p, int l, unsigned char* lds) {
#if !RWKV_REF
    for (int rep = 0; rep < ((PROBE_REP & 8) ? 2 : 1); ++rep)
    for (int job = blockIdx.x; job < BATCH * NH; job += gridDim.x) rwkv_b2_job(p, job, lds);
#endif
}
__device__ void phase_mix3(const Params& p, int l, unsigned char* lds) {
#if !RWKV_REF
    for (int rep = 0; rep < ((PROBE_REP & 16) ? 2 : 1); ++rep)
    for (int pair = blockIdx.x; pair < BATCH * NH * 16; pair += gridDim.x) rwkv_b3_pair(p, l, pair);
#endif
}

constexpr int PH_PER_LAYER = 6;
constexpr int N_PHASES = 1 + PH_PER_LAYER * DEPTH;
__device__ __forceinline__ void run_phase(const Params& p, int ph, unsigned char* lds) {
    unsigned char* ws = p.ws;
    if (ph == 0) { phase_prologue(p, lds); return; }
    const int l = (ph - 1) / PH_PER_LAYER, k = (ph - 1) % PH_PER_LAYER;
    if (k == 0) {
#if SIMPLE_GEMM
        EpiInProj E{(bf16_t*)(ws + WS_PC), (bf16_t*)(ws + WS_PS), (bf16_t*)(ws + WS_PR), (bf16_t*)(ws + WS_PG)};
        gemm_simple((const bf16_t*)(ws + WS_XB), (const bf16_t*)(ws + WS_WIN) + (size_t)l * NINT * DM, M, NINT, DM, E);
#else
        EpiInProjP E{(bf16_t*)(ws + WS_PC), (bf16_t*)(ws + WS_PS), (bf16_t*)(ws + WS_PR), (bf16_t*)(ws + WS_PG), (bf16_t*)(ws + WS_VT)};
        pg8::Gemm g{(const bf16_t*)(ws + WS_XB), (const bf16_t*)(ws + WS_WIN) + (size_t)l * NINT * DM, M, NINT, DM}; pg8::StaticOrder S; S.init(M, NINT, (int)gridDim.x, (int)blockIdx.x);
        for (int rep = 0; rep < ((PROBE_REP & 32) ? 2 : 1); ++rep)
        pg8::gemm_phase<EpiInProjP, pg8::StaticOrder, true, true>((PG8_LAS unsigned char*)lds, g, S, E);
#endif
    } else if (k == 1) {
        phase_mix1(p, l, lds);
    } else if (k == 2) {
        phase_mix2(p, l, lds);
    } else if (k == 3) {
        phase_mix3(p, l, lds);
    } else if (k == 4) {
#if SIMPLE_GEMM
        EpiF32 E{(float*)(ws + WS_Y), DM};
        gemm_simple((const bf16_t*)(ws + WS_MIX), (const bf16_t*)(ws + WS_WOUT) + (size_t)l * DM * DM, M, DM, DM, E);
#else
        EpiOutF32P E{(float*)(ws + WS_Y), DM};
        pg8::Gemm g{(const bf16_t*)(ws + WS_MIX), (const bf16_t*)(ws + WS_WOUT) + (size_t)l * DM * DM, M, DM, DM}; pg8::StaticOrder S; S.init(M, DM, (int)gridDim.x, (int)blockIdx.x);
        for (int rep = 0; rep < ((PROBE_REP & 64) ? 2 : 1); ++rep)
        pg8::gemm_phase<EpiOutF32P, pg8::StaticOrder, true, true>((PG8_LAS unsigned char*)lds, g, S, E);
#endif
    } else {
        phase_rowpass(l == 0 ? p.in[0] : p.out, (const float*)(ws + WS_Y), p.in[2] + l * DM, p.out, l + 1 < DEPTH ? (bf16_t*)(ws + WS_XB) : nullptr);
    }
}

constexpr int LDS_BYTES = 147456;

#if MK_COOP
__global__ void __launch_bounds__(512, 2) fwd_kernel(Params p) {
    extern __shared__ __attribute__((aligned(16))) unsigned char lds[];
    cg::grid_group grid = cg::this_grid();
    for (int ph = p.ph_lo; ph < p.ph_hi; ++ph) {
        run_phase(p, ph, lds);
        if (ph + 1 < p.ph_hi) grid.sync();
    }
}
#else
__global__ void __launch_bounds__(512, 2) fwd_kernel(Params p) {
    extern __shared__ __attribute__((aligned(16))) unsigned char lds[];
    for (int ph = p.ph_lo; ph < p.ph_hi; ++ph) run_phase(p, ph, lds);
}
#endif

extern "C" void kernel_launch(void* const* d_in, const int* in_sizes, int n_in, void* d_out, int out_size, void* d_ws, size_t ws_size, hipStream_t stream) {
    static int grid = 0;
    if (grid == 0) {
        if (n_in != 24 || out_size != M * DM || ws_size < WS_END) { fprintf(stderr, "kernel_launch: unexpected problem (n_in %d out %d ws %zu)\n", n_in, out_size, ws_size); grid = -1; return; }
        int dev = 0, cus = 0, per_cu = 0;
        hipGetDevice(&dev); hipDeviceGetAttribute(&cus, hipDeviceAttributeMultiprocessorCount, dev);
        hipFuncSetAttribute((const void*)fwd_kernel, hipFuncAttributeMaxDynamicSharedMemorySize, LDS_BYTES);
        hipOccupancyMaxActiveBlocksPerMultiprocessor(&per_cu, (const void*)fwd_kernel, 512, LDS_BYTES);
        if (per_cu < 1) { fprintf(stderr, "kernel_launch: occupancy query says %d blocks per CU\n", per_cu); per_cu = 1; }
        grid = cus;
        (void)hipGetLastError();
    }
    if (grid < 0) return;
    Params p{};
    for (int i = 0; i < 24; ++i) p.in[i] = (const float*)d_in[i];
    p.out = (float*)d_out; p.ws = (unsigned char*)d_ws;
#if MK_COOP
    p.ph_lo = 0; p.ph_hi = N_PHASES;
    void* args[] = {&p};
    hipError_t e = hipLaunchCooperativeKernel((const void*)fwd_kernel, dim3(grid), dim3(512), args, LDS_BYTES, stream);
    if (e != hipSuccess) fprintf(stderr, "cooperative launch failed: %s (grid %d)\n", hipGetErrorString(e), grid);
#else
    for (int ph = 0; ph < N_PHASES; ++ph) {
        p.ph_lo = ph; p.ph_hi = ph + 1;
        hipLaunchKernelGGL(fwd_kernel, dim3(grid), dim3(512), LDS_BYTES, stream, p);
    }
#endif
}
```

```cpp
#include <hip/hip_runtime.h>
#include <hip/hip_cooperative_groups.h>
#include <cstdio>
#include <cstdint>
namespace cg = cooperative_groups;

#ifndef SIMPLE_GEMM
#define SIMPLE_GEMM 0
#endif
#ifndef PROBE_REP
#define PROBE_REP 0
#endif
#ifndef MK_COOP
#define MK_COOP 1
#endif

constexpr int BATCH = 16, SEQ = 2048, DM = 1024, DEPTH = 2;
constexpr int M = BATCH * SEQ;
constexpr int HD = 64, NH = 6;
constexpr int CW = 256, SBW = 384, RWW = 384, LORA = 32, TAPS = 31;
constexpr int DIN = 3904;
constexpr int NINT = 4096;
constexpr int PC_W = 768, PS_W = 1152, PR_W = 1280, PG_W = 384;
constexpr float RMS_EPS = 1e-6f, LN_EPS = 1e-5f, GN_EPS = 64e-5f;

typedef unsigned short bf16_t;
typedef short bf16x8 __attribute__((ext_vector_type(8)));
typedef float f32x4 __attribute__((ext_vector_type(4)));
typedef unsigned short us4 __attribute__((ext_vector_type(4)));

constexpr size_t MiB = 1u << 20;
constexpr size_t WS_CTL = 0;
constexpr size_t WS_WPW = 512 * 1024;
constexpr size_t WS_WIN = 1 * MiB;
constexpr size_t WS_WOUT = 17 * MiB;
constexpr size_t WS_XB = 21 * MiB;
constexpr size_t WS_MIX = WS_XB;
constexpr size_t WS_PC = 85 * MiB;
constexpr size_t WS_PS = 133 * MiB;
constexpr size_t WS_VT = 205 * MiB;
constexpr size_t WS_Y = WS_PC;
constexpr size_t WS_PR = 229 * MiB;
constexpr size_t WS_PG = 309 * MiB;
constexpr size_t WS_VF = 333 * MiB;
constexpr size_t WS_CH = 381 * MiB;
constexpr size_t CH_SZ = (size_t)3072 * 4096 * 2;
constexpr size_t WS_CH_M = WS_CH, WS_CH_NT = WS_CH + CH_SZ, WS_CH_G = WS_CH + 2 * CH_SZ, WS_CH_Y1T = WS_CH + 3 * CH_SZ, WS_CH_BV = WS_CH + 4 * CH_SZ;
constexpr size_t WS_ZT = WS_PR;
constexpr size_t WS_END = 501 * MiB;

struct Params {
    const float* in[24];
    float* out;
    unsigned char* ws;
    int ph_lo, ph_hi;
};

__device__ __forceinline__ float bf2f(bf16_t v) { return __uint_as_float(((unsigned)v) << 16); }
__device__ __forceinline__ bf16_t f2bf(float f) { unsigned u = __float_as_uint(f); return (bf16_t)((u + 0x7fffu + ((u >> 16) & 1u)) >> 16); }
__device__ __forceinline__ unsigned pk2(float lo, float hi) { return (unsigned)f2bf(lo) | ((unsigned)f2bf(hi) << 16); }
__device__ __forceinline__ float wave_sum(float v) {
#pragma unroll
    for (int o = 1; o < 64; o <<= 1) v += __shfl_xor(v, o);
    return v;
}
__device__ __forceinline__ float sigmoidf_(float x) { return 1.0f / (1.0f + __expf(-x)); }
__device__ __forceinline__ float siluf_(float x) { return x / (1.0f + __expf(-x)); }
__device__ __forceinline__ int tid_() { int t = threadIdx.x; asm volatile("" : "+v"(t)); return t; }
__device__ __forceinline__ int opaque_zero() { int z = 0; asm volatile("" : "+v"(z)); return z; }

__device__ __forceinline__ int orig_col(int n) { return n < 3520 ? n : (n < 3584 ? -1 : (n < 3968 ? n - 64 : -1)); }

__device__ void transpose_tile(const float* W, int ldw, int ncol_src, const float* gain, bf16_t* WT, int K, int n0, int k0, bool permute, float* tile  , const float* fold_v1 = nullptr, const float* fold_mu = nullptr) {
    const int tid = tid_();
#pragma unroll
    for (int i = 0; i < 8; ++i) {
        const int kl = (tid >> 6) + 8 * i, nl = tid & 63;
        const int n = n0 + nl, k = k0 + kl;
        const int oc = permute ? orig_col(n) : n;
        float v = 0.f;
        if (oc >= 0 && oc < ncol_src) v = W[(size_t)k * ldw + oc] * (gain ? gain[k] : 1.0f);
        if (permute && n >= 768 && n < 1152) v *= 0.125f * 1.4426950408889634f;
        if (fold_v1 && n >= 3520 && n < 3584) {
            const int i = (n - 3520) & 31; const bool second = n >= 3552; float a = 0.f;
            for (int c = 0; c < RWW; ++c) { const float m = fold_mu[c]; a += W[(size_t)k * ldw + 3072 + c] * (second ? m : 1.0f - m) * fold_v1[c * LORA + i]; }
            v = a * gain[k];
        }
        tile[kl * 65 + nl] = v;
    }
    __syncthreads();
#pragma unroll
    for (int i = 0; i < 8; ++i) {
        const int nl = (tid >> 6) + 8 * i, kl = tid & 63;
        WT[(size_t)(n0 + nl) * K + k0 + kl] = f2bf(tile[kl * 65 + nl]);
    }
    __syncthreads();
}

__device__ void rows_to_xb(const float* X, bf16_t* XB) {
    const int tid = tid_(), lane = tid & 63, wave = tid >> 6;
    for (int row = blockIdx.x * 8 + wave; row < M; row += gridDim.x * 8) {
        const float* xr = X + (size_t)row * DM;
        f32x4 v[4]; float ss = 0.f;
#pragma unroll
        for (int i = 0; i < 4; ++i) { v[i] = *(const f32x4*)(xr + i * 256 + lane * 4); ss += v[i][0] * v[i][0] + v[i][1] * v[i][1] + v[i][2] * v[i][2] + v[i][3] * v[i][3]; }
        ss = wave_sum(ss);
        const float rstd = rsqrtf(ss * (1.0f / DM) + RMS_EPS);
#pragma unroll
        for (int i = 0; i < 4; ++i) { uint2 w; w.x = pk2(v[i][0] * rstd, v[i][1] * rstd); w.y = pk2(v[i][2] * rstd, v[i][3] * rstd); *(uint2*)(XB + (size_t)row * DM + i * 256 + lane * 4) = w; }
    }
}

__device__ void phase_prologue(const Params& p, unsigned char* lds) {
    float* tile = (float*)lds;
    bf16_t* WinT = (bf16_t*)(p.ws + WS_WIN); bf16_t* WoutT = (bf16_t*)(p.ws + WS_WOUT);
    const int nt_in = (NINT / 64) * (DM / 64), nt_out = (DM / 64) * (DM / 64), nt_pw = (CW / 64) * (CW / 64);
    const int total = DEPTH * (nt_in + nt_out);
    for (int j = blockIdx.x; j < DEPTH * nt_pw; j += gridDim.x) { const int l = j / nt_pw, r = j % nt_pw;
        transpose_tile(p.in[9] + (size_t)l * CW * CW, CW, CW, nullptr, (bf16_t*)(p.ws + WS_WPW) + (size_t)l * CW * CW, CW, (r >> 2) * 64, (r & 3) * 64, false, tile); }
    for (int j = blockIdx.x; j < total; j += gridDim.x) {
        int l = j / (nt_in + nt_out), r = j % (nt_in + nt_out);
        if (r < nt_in) { const int tn = r / (DM / 64), tk = r % (DM / 64);
            transpose_tile(p.in[3] + (size_t)l * DM * DIN, DIN, DIN, p.in[1] + l * DM, WinT + (size_t)l * NINT * DM, DM, tn * 64, tk * 64, true, tile, l > 0 ? p.in[22] : nullptr, p.in[11] + l * 1216 + 768);
        } else { r -= nt_in; const int tn = r / (DM / 64), tk = r % (DM / 64);
            transpose_tile(p.in[4] + (size_t)l * DM * DM, DM, DM, nullptr, WoutT + (size_t)l * DM * DM, DM, tn * 64, tk * 64, false, tile);
        }
    }
    rows_to_xb(p.in[0], (bf16_t*)(p.ws + WS_XB));
}

namespace pg8 {
#define PG8_LAS __attribute__((address_space(3)))
typedef unsigned short bf16_t;
typedef short bf16x8 __attribute__((ext_vector_type(8)));
typedef float f32x4 __attribute__((ext_vector_type(4)));
typedef unsigned u32x4 __attribute__((ext_vector_type(4)));
constexpr int BM = 256, BK = 64, HALF = 128, HTB = HALF * BK * 2  , STAGE_BYTES = 8 * HTB, NXCD = 8, WGM = 8;

__host__ __device__ __forceinline__ int lds_byte(int r, int c) { const int st = (r >> 4) * 2 + (c >> 5), rr = r & 15, cc = c & 31, ob = rr * 64 + cc * 2; return st * 1024 + (ob ^ (((ob >> 9) & 1) << 5)); }
__host__ __device__ __forceinline__ void stage_rc(int b, int& R, int& C) { const int st = b / 1024, sb = b % 1024, swz = sb ^ (((sb >> 9) & 1) << 5); R = (st >> 1) * 16 + swz / 64; C = (st & 1) * 32 + (swz % 64) / 2; }
__host__ __device__ __forceinline__ int perm32(int rho) { const int n = rho >> 4, i = rho & 15; return 8 * (i >> 2) + 4 * n + (i & 3); }

struct Unit { int pm, pn; };
struct Gemm { const bf16_t* A; const bf16_t* Bt; int M, N, K; };

struct StaticOrder {
    int nM, nN, nwg, G, c;
    __host__ __device__ void init(int M, int N, int G_, int c_) { nM = M / BM; nN = N / BM; nwg = nM * nN; G = G_; c = c_; }
    __host__ __device__ bool next(int i, Unit& u) const {
        const long L = (long)i * G + c; if (L >= nwg) return false;
        int wgid = (int)L; { const int q = nwg / NXCD, r = nwg % NXCD, xcd = wgid % NXCD, off = wgid / NXCD; wgid = (xcd < r ? xcd * (q + 1) : r * (q + 1) + (xcd - r) * q) + off; }
        const int nig = WGM * nN, gid = wgid / nig, fm = gid * WGM, gsz = (nM - fm) < WGM ? (nM - fm) : WGM;
        u.pm = fm + ((wgid % nig) % gsz); u.pn = (wgid % nig) / gsz; return true;
    }
    __device__ __forceinline__ void a_ready(const Unit&) const {}
    __device__ __forceinline__ void done(const Unit&) const {}
};


__device__ __forceinline__ unsigned cvt_pk_bf16(float lo, float hi) { unsigned r; asm volatile("v_cvt_pk_bf16_f32 %0, %1, %2" : "=v"(r) : "v"(lo), "v"(hi)); return r; }

template <class Epi, class Sched, bool ALIGN_EPI = false, bool SP2 = false>
__device__ __forceinline__ void gemm_phase(PG8_LAS unsigned char* lds, const Gemm g, const Sched& S, const Epi& E) {
    const int tid = tid_(), wid = __builtin_amdgcn_readfirstlane(tid >> 6), lane = tid & 63, wr = wid >> 2, wc = wid & 3, fr = lane & 15, fq = lane >> 4;
    const int K = g.K, nt = K / BK;
    unsigned voffA[2], voffB[2];
#pragma unroll
    for (int i = 0; i < 2; ++i) { int R, C; stage_rc(tid * 16 + i * 8192, R, C); const int Rb = Epi::PERM ? ((R & ~31) + perm32(R & 31)) : R;
        voffA[i] = (unsigned)(R * K + C) * 2u; voffB[i] = (unsigned)(Rb * K + C) * 2u; }
    const size_t kstep = (size_t)(BK * 2);
    const size_t hstep = (size_t)HALF * K * 2;
    const size_t tstep = 2 * hstep;
    const unsigned ldsw = (unsigned)wid * 1024u;
    const int aoff = lds_byte(wr * 64 + fr, fq * 8), boff = lds_byte(wc * 32 + fr, fq * 8);
#define PG8_SA(b, h) (((b) * 2 + (h)) * HTB)
#define PG8_SB(b, h) ((4 + (b) * 2 + (h)) * HTB)
#define PG8_STAGE(bufoff, gbase, voff) do { _Pragma("unroll") for (int _i = 0; _i < 2; ++_i) \
        __builtin_amdgcn_global_load_lds((const unsigned*)((const char*)(gbase) + (voff)[_i]), (PG8_LAS unsigned*)(lds + (bufoff) + ldsw + _i * 8192), 16, 0, 0); } while (0)
#define PG8_LDA(dst, b, h) do { _Pragma("unroll") for (int m = 0; m < 4; ++m) _Pragma("unroll") for (int k = 0; k < 2; ++k) dst[m][k] = *(const PG8_LAS bf16x8*)(lds + PG8_SA(b, h) + aoff + m * 2048 + k * 1024); } while (0)
#define PG8_LDB(dst, b, h) do { _Pragma("unroll") for (int n = 0; n < 2; ++n) _Pragma("unroll") for (int k = 0; k < 2; ++k) dst[n][k] = *(const PG8_LAS bf16x8*)(lds + PG8_SB(b, h) + boff + n * 2048 + k * 1024); } while (0)
#define PG8_MMA(ai, bj, At, Bt) do { __builtin_amdgcn_s_setprio(1); _Pragma("unroll") for (int m = 0; m < 4; ++m) _Pragma("unroll") for (int n = 0; n < 2; ++n) _Pragma("unroll") for (int k = 0; k < 2; ++k) \
        acc[ai][bj][m][n] = __builtin_amdgcn_mfma_f32_16x16x32_bf16(Bt[n][k], At[m][k], acc[ai][bj][m][n], 0, 0, 0); __builtin_amdgcn_s_setprio(0); } while (0)
#define PG8_WAIT_V(n) asm volatile("s_waitcnt vmcnt(" #n ")" ::: "memory")
#define PG8_WAIT_L(n) asm volatile("s_waitcnt lgkmcnt(" #n ")" ::: "memory")
#define PG8_BAR __builtin_amdgcn_s_barrier()
#define PG8_SCHED __builtin_amdgcn_sched_barrier(0)
    Unit cur, nxt; int ui = 0;
    if (!S.next(0, cur)) return;
    f32x4 acc[2][2][4][2];
#pragma unroll
    for (int a = 0; a < 2; ++a)
#pragma unroll
        for (int b = 0; b < 2; ++b)
#pragma unroll
            for (int m = 0; m < 4; ++m)
#pragma unroll
                for (int n = 0; n < 2; ++n) acc[a][b][m][n] = (f32x4){0.f, 0.f, 0.f, 0.f};
    bf16x8 At[4][2], B0[2][2], B1[2][2];
    const char* cA = (const char*)g.A + (size_t)cur.pm * tstep; const char* cB = (const char*)g.Bt + (size_t)cur.pn * tstep;
    S.a_ready(cur);
    if constexpr (SP2) {
        PG8_STAGE(PG8_SB(0, 0), cB, voffB); PG8_STAGE(PG8_SB(0, 1), cB + hstep, voffB); PG8_STAGE(PG8_SA(0, 0), cA, voffA); PG8_STAGE(PG8_SA(0, 1), cA + hstep, voffA);
        if (wr == 1) PG8_BAR;
        PG8_WAIT_V(2); PG8_BAR;
        PG8_STAGE(PG8_SB(1, 0), cB + kstep, voffB); PG8_STAGE(PG8_SA(1, 0), cA + kstep, voffA); PG8_STAGE(PG8_SB(1, 1), cB + hstep + kstep, voffB);
        PG8_WAIT_V(6); PG8_BAR;
    } else {
        PG8_STAGE(PG8_SB(0, 0), cB, voffB); PG8_STAGE(PG8_SA(0, 0), cA, voffA); PG8_STAGE(PG8_SB(0, 1), cB + hstep, voffB); PG8_STAGE(PG8_SA(0, 1), cA + hstep, voffA);
        if (wr == 1) PG8_BAR;
        PG8_WAIT_V(4); PG8_BAR;
        PG8_STAGE(PG8_SB(1, 0), cB + kstep, voffB); PG8_STAGE(PG8_SA(1, 0), cA + kstep, voffA); PG8_STAGE(PG8_SB(1, 1), cB + hstep + kstep, voffB);
        PG8_WAIT_V(6); PG8_BAR;
    }
    for (;;) {
        const bool has_next = S.next(ui + 1, nxt);
        const char* nA = has_next ? (const char*)g.A + (size_t)nxt.pm * tstep : cA; const char* nB = has_next ? (const char*)g.Bt + (size_t)nxt.pn * tstep : cB;
        for (int t = 0; t < nt; t += 2) {
            const bool last = (t == nt - 2);
            const char* a1 = cA + (size_t)(t + 1) * kstep;
            const char* a2 = last ? nA : cA + (size_t)(t + 2) * kstep; const char* b2 = last ? nB : cB + (size_t)(t + 2) * kstep;
            const char* a3 = a2 + kstep; const char* b3 = b2 + kstep;
            if (last && has_next) S.a_ready(nxt);
            if constexpr (SP2) {
            PG8_LDB(B0, 0, 0); PG8_LDB(B1, 0, 1); PG8_SCHED; PG8_LDA(At, 0, 0); PG8_STAGE(PG8_SA(1, 1), a1 + hstep, voffA);
            PG8_WAIT_V(8); PG8_WAIT_L(0); PG8_BAR; PG8_MMA(0, 0, At, B0); PG8_MMA(0, 1, At, B1); PG8_BAR; PG8_SCHED;
            PG8_LDA(At, 0, 1); PG8_STAGE(PG8_SB(0, 0), b2, voffB); PG8_STAGE(PG8_SB(0, 1), b2 + hstep, voffB); PG8_STAGE(PG8_SA(0, 0), a2, voffA);
            PG8_WAIT_V(8); PG8_WAIT_L(0); PG8_BAR; PG8_MMA(1, 0, At, B0); PG8_MMA(1, 1, At, B1); PG8_BAR; PG8_SCHED;
            PG8_LDB(B0, 1, 0); PG8_LDB(B1, 1, 1); PG8_SCHED; PG8_LDA(At, 1, 0); PG8_STAGE(PG8_SA(0, 1), a2 + hstep, voffA);
            PG8_WAIT_V(8); PG8_WAIT_L(0); PG8_BAR; PG8_MMA(0, 0, At, B0); PG8_MMA(0, 1, At, B1); PG8_BAR; PG8_SCHED;
            PG8_LDA(At, 1, 1); PG8_STAGE(PG8_SB(1, 0), b3, voffB); PG8_STAGE(PG8_SB(1, 1), b3 + hstep, voffB); PG8_STAGE(PG8_SA(1, 0), a3, voffA);
            PG8_WAIT_V(8); PG8_WAIT_L(0); PG8_BAR; PG8_MMA(1, 0, At, B0); PG8_MMA(1, 1, At, B1); PG8_BAR; PG8_SCHED;
            } else {
            PG8_LDB(B0, 0, 0); PG8_SCHED; PG8_LDA(At, 0, 0); PG8_STAGE(PG8_SA(1, 1), a1 + hstep, voffA);
            PG8_WAIT_L(8); PG8_BAR; PG8_WAIT_L(0); PG8_MMA(0, 0, At, B0); PG8_BAR; PG8_SCHED;
            PG8_LDB(B1, 0, 1); PG8_STAGE(PG8_SB(0, 0), b2, voffB);
            PG8_BAR; PG8_WAIT_L(0); PG8_MMA(0, 1, At, B1); PG8_BAR;
            PG8_LDA(At, 0, 1); PG8_STAGE(PG8_SA(0, 0), a2, voffA);
            PG8_BAR; PG8_WAIT_L(0); PG8_MMA(1, 0, At, B0); PG8_BAR; PG8_SCHED;
            PG8_STAGE(PG8_SB(0, 1), b2 + hstep, voffB);
            PG8_WAIT_V(6); PG8_BAR; PG8_MMA(1, 1, At, B1); PG8_BAR;
            PG8_LDB(B0, 1, 0); PG8_SCHED; PG8_LDA(At, 1, 0); PG8_STAGE(PG8_SA(0, 1), a2 + hstep, voffA);
            PG8_WAIT_L(8); PG8_BAR; PG8_WAIT_L(0); PG8_MMA(0, 0, At, B0); PG8_BAR; PG8_SCHED;
            PG8_LDB(B1, 1, 1); PG8_STAGE(PG8_SB(1, 0), b3, voffB);
            PG8_BAR; PG8_WAIT_L(0); PG8_MMA(0, 1, At, B1); PG8_BAR;
            PG8_LDA(At, 1, 1); PG8_STAGE(PG8_SA(1, 0), a3, voffA);
            PG8_BAR; PG8_WAIT_L(0); PG8_MMA(1, 0, At, B0); PG8_BAR; PG8_SCHED;
            PG8_STAGE(PG8_SB(1, 1), b3 + hstep, voffB);
            PG8_WAIT_V(6); PG8_BAR; PG8_MMA(1, 1, At, B1); PG8_BAR;
            }
        }
        if constexpr (ALIGN_EPI) { if (wr == 0) PG8_BAR; }
        if constexpr (!Epi::AFTER_DRAIN) { E(acc, cur, wr, wc, fr, fq); S.done(cur); }
        if (!has_next) break;
#pragma unroll
        for (int a = 0; a < 2; ++a)
#pragma unroll
            for (int b = 0; b < 2; ++b)
#pragma unroll
                for (int m = 0; m < 4; ++m)
#pragma unroll
                    for (int n = 0; n < 2; ++n) acc[a][b][m][n] = (f32x4){0.f, 0.f, 0.f, 0.f};
        cur = nxt; cA = nA; cB = nB; ++ui;
        if constexpr (ALIGN_EPI) { if (wr == 1) PG8_BAR; }
    }
    PG8_WAIT_V(0);
    if constexpr (!ALIGN_EPI) { if (wr == 0) PG8_BAR; }
    PG8_BAR;
    if constexpr (Epi::AFTER_DRAIN) { E.fused(acc, cur, wr, wc, fr, fq, lds, wid, lane); S.done(cur); }
#undef PG8_SA
#undef PG8_SB
#undef PG8_STAGE
#undef PG8_LDA
#undef PG8_LDB
#undef PG8_MMA
#undef PG8_WAIT_V
#undef PG8_WAIT_L
#undef PG8_BAR
#undef PG8_SCHED
}
}

template <class Epi>
__device__ void gemm_simple(const bf16_t* A, const bf16_t* Bt, int Mr, int N, int K, const Epi& epi) {
    const int tid = tid_(), wave = tid >> 6, lane = tid & 63, wm = wave >> 1, wn = wave & 1, fr = lane & 15, fq = lane >> 4;
    const int nNt = N / 128, nMt = Mr / 128;
    for (int tile = blockIdx.x; tile < nNt * nMt; tile += gridDim.x) {
        const int tm = tile / nNt, tn = tile % nNt;
        const int m0 = tm * 128 + wm * 32, n0 = tn * 128 + wn * 64;
        f32x4 acc[2][4];
#pragma unroll
        for (int i = 0; i < 2; ++i)
#pragma unroll
            for (int j = 0; j < 4; ++j) acc[i][j] = (f32x4){0.f, 0.f, 0.f, 0.f};
        const bf16_t* ap = A + (size_t)(m0 + fr) * K + fq * 8;
        const bf16_t* bp = Bt + (size_t)(n0 + fr) * K + fq * 8;
        for (int k = 0; k < K; k += 32) {
            bf16x8 af[2], bfr[4];
#pragma unroll
            for (int i = 0; i < 2; ++i) af[i] = *(const bf16x8*)(ap + (size_t)i * 16 * K + k);
#pragma unroll
            for (int j = 0; j < 4; ++j) bfr[j] = *(const bf16x8*)(bp + (size_t)j * 16 * K + k);
#pragma unroll
            for (int i = 0; i < 2; ++i)
#pragma unroll
                for (int j = 0; j < 4; ++j) acc[i][j] = __builtin_amdgcn_mfma_f32_16x16x32_bf16(bfr[j], af[i], acc[i][j], 0, 0, 0);
        }
#pragma unroll
        for (int i = 0; i < 2; ++i)
#pragma unroll
            for (int j = 0; j < 4; ++j) epi(m0 + i * 16 + fr, n0 + j * 16 + fq * 4, acc[i][j]);
    }
}

struct EpiInProj {
    bf16_t *PC, *PS, *PR, *PG;
    __device__ __forceinline__ void operator()(int m, int n, const f32x4& v) const {
        bf16_t* dst;
        if (n < 768) dst = PC + (size_t)m * PC_W + n;
        else if (n < 2304) dst = PS + (size_t)m * PS_W + (n - 768);
        else if (n < 3584) dst = PR + (size_t)m * PR_W + (n - 2304);
        else if (n < 3968) dst = PG + (size_t)m * PG_W + (n - 3584);
        else return;
        uint2 w; w.x = pk2(v[0], v[1]); w.y = pk2(v[2], v[3]); *(uint2*)dst = w;
    }
};
struct EpiF32 {
    float* Y; int ld;
    __device__ __forceinline__ void operator()(int m, int n, const f32x4& v) const { *(f32x4*)(Y + (size_t)m * ld + n) = v; }
};


struct EpiInProjP {
    static constexpr bool PERM = true, AFTER_DRAIN = false;
    bf16_t *PC, *PS, *PR, *PG, *VT;
    __device__ __forceinline__ void operator()(const pg8::f32x4 (&acc)[2][2][4][2], const pg8::Unit& u, int wr, int wc, int fr, int fq) const {
        const int row0 = u.pm * 256 + wr * 64 + fr;
#pragma unroll
        for (int bj = 0; bj < 2; ++bj) {
            const int blk = 2 * u.pn + bj; bf16_t* base; int ld, c0;
            if (blk >= 12 && blk < 15) {
                const int vc = 128 * (blk - 12) + wc * 32 + 8 * fq;
#pragma unroll
                for (int ai = 0; ai < 2; ++ai)
#pragma unroll
                    for (int m = 0; m < 4; ++m) {
                        const int row = row0 + ai * 128 + m * 16, b = row >> 11, t = row & 2047;
#pragma unroll
                        for (int n = 0; n < 2; ++n)
#pragma unroll
                            for (int e = 0; e < 4; ++e) { const int col = vc + 4 * n + e, hh = col >> 6, d = col & 63;
                                VT[((size_t)(b * NH + hh) * HD + d) * SEQ + t] = f2bf(acc[ai][bj][m][n][e]); }
                    }
                continue;
            }
            if (blk < 6) { base = PC; ld = PC_W; c0 = 128 * blk; }
            else if (blk < 12) { base = PS; ld = PS_W; c0 = 128 * (blk - 6); }
            else if (blk < 18) { base = PS; ld = PS_W; c0 = 768 + 128 * (blk - 15); }
            else if (blk < 28) { base = PR; ld = PR_W; c0 = 128 * (blk - 18); }
            else if (blk < 31) { base = PG; ld = PG_W; c0 = 128 * (blk - 28); }
            else continue;
            const int col = c0 + wc * 32 + 8 * fq;
#pragma unroll
            for (int ai = 0; ai < 2; ++ai)
#pragma unroll
                for (int m = 0; m < 4; ++m) {
                    const pg8::f32x4 v0 = acc[ai][bj][m][0], v1 = acc[ai][bj][m][1]; pg8::u32x4 w;
                    w.x = pg8::cvt_pk_bf16(v0[0], v0[1]); w.y = pg8::cvt_pk_bf16(v0[2], v0[3]); w.z = pg8::cvt_pk_bf16(v1[0], v1[1]); w.w = pg8::cvt_pk_bf16(v1[2], v1[3]);
                    *(pg8::u32x4*)(base + (size_t)(row0 + ai * 128 + m * 16) * ld + col) = w;
                }
        }
    }
};
struct EpiOutF32P {
    static constexpr bool PERM = false, AFTER_DRAIN = false;
    float* Y; int ld;
    __device__ __forceinline__ void operator()(const pg8::f32x4 (&acc)[2][2][4][2], const pg8::Unit& u, int wr, int wc, int fr, int fq) const {
        const int row0 = u.pm * 256 + wr * 64 + fr, col0 = u.pn * 256 + wc * 32 + 4 * fq;
#pragma unroll
        for (int ai = 0; ai < 2; ++ai)
#pragma unroll
            for (int m = 0; m < 4; ++m)
#pragma unroll
                for (int bj = 0; bj < 2; ++bj)
#pragma unroll
                    for (int n = 0; n < 2; ++n) *(pg8::f32x4*)(Y + (size_t)(row0 + ai * 128 + m * 16) * ld + col0 + bj * 128 + n * 16) = acc[ai][bj][m][n];
    }
};

__device__ void phase_rowpass(const float* Xin, const float* Y, const float* gpost, float* Xout, bf16_t* XB) {
    const int tid = tid_(), lane = tid & 63, wave = tid >> 6;
    for (int row = blockIdx.x * 8 + wave; row < M; row += gridDim.x * 8) {
        f32x4 y[4], x[4]; float ss = 0.f;
#pragma unroll
        for (int i = 0; i < 4; ++i) { y[i] = *(const f32x4*)(Y + (size_t)row * DM + i * 256 + lane * 4); x[i] = *(const f32x4*)(Xin + (size_t)row * DM + i * 256 + lane * 4);
            ss += y[i][0] * y[i][0] + y[i][1] * y[i][1] + y[i][2] * y[i][2] + y[i][3] * y[i][3]; }
        ss = wave_sum(ss);
        const float rstd = rsqrtf(ss * (1.0f / DM) + RMS_EPS);
        float s2 = 0.f;
#pragma unroll
        for (int i = 0; i < 4; ++i) { const f32x4 g = *(const f32x4*)(gpost + i * 256 + lane * 4);
            x[i] = x[i] + y[i] * rstd * g; s2 += x[i][0] * x[i][0] + x[i][1] * x[i][1] + x[i][2] * x[i][2] + x[i][3] * x[i][3];
            *(f32x4*)(Xout + (size_t)row * DM + i * 256 + lane * 4) = x[i]; }
        if (XB) {
            s2 = wave_sum(s2);
            const float r2 = rsqrtf(s2 * (1.0f / DM) + RMS_EPS);
#pragma unroll
            for (int i = 0; i < 4; ++i) { uint2 w; w.x = pk2(x[i][0] * r2, x[i][1] * r2); w.y = pk2(x[i][2] * r2, x[i][3] * r2); *(uint2*)(XB + (size_t)row * DM + i * 256 + lane * 4) = w; }
        }
    }
}

__device__ void conv_job(const Params& p, int l, int job, float* lds) {
    const int tid = tid_(), lane = tid & 63, wave = tid >> 6;
    const int b = job / (SEQ / 32), t0 = (job % (SEQ / 32)) * 32;
    const bf16_t* PC = (const bf16_t*)(p.ws + WS_PC); bf16_t* MIX = (bf16_t*)(p.ws + WS_MIX);
    const float* dw = p.in[5] + l * TAPS * CW; const float* dwb = p.in[6] + l * CW; const float* lng = p.in[7] + l * CW; const float* lnb = p.in[8] + l * CW;
    const float* pw = p.in[9] + (size_t)l * CW * CW; const float* pwb = p.in[10] + l * CW;
    float* u = lds;
    float* cv = lds + 62 * 256;
    for (int idx = tid; idx < 62 * 256; idx += 512) {
        const int r = idx >> 8, c = idx & 255, t = t0 - 30 + r;
        float v = 0.f;
        if (t >= 0) { const bf16_t* pr = PC + (size_t)(b * SEQ + t) * PC_W; v = bf2f(pr[c]) * sigmoidf_(bf2f(pr[256 + c])); }
        u[idx] = v;
    }
    __syncthreads();
    for (int idx = tid; idx < 32 * 256; idx += 512) {
        const int tt = idx >> 8, c = idx & 255;
        float a = dwb[c];
#pragma unroll 4
        for (int j = 0; j < TAPS; ++j) a += dw[j * CW + c] * u[(tt + j) * 256 + c];
        cv[idx] = a;
    }
    __syncthreads();
    for (int q = 0; q < 4; ++q) {
        const int tt = wave * 4 + q; float x[4], s = 0.f;
#pragma unroll
        for (int i = 0; i < 4; ++i) { x[i] = cv[tt * 256 + lane + 64 * i]; s += x[i]; }
        const float mean = wave_sum(s) * (1.0f / CW); float vs = 0.f;
#pragma unroll
        for (int i = 0; i < 4; ++i) { const float d = x[i] - mean; vs += d * d; }
        const float rstd = rsqrtf(wave_sum(vs) * (1.0f / CW) + LN_EPS);
#pragma unroll
        for (int i = 0; i < 4; ++i) { const int c = lane + 64 * i; cv[tt * 256 + c] = siluf_((x[i] - mean) * rstd * lng[c] + lnb[c]); }
    }
    __syncthreads();
    {
        const int n = tid & 255, half = tid >> 8;
        float acc[16];
#pragma unroll
        for (int i = 0; i < 16; ++i) acc[i] = pwb[n];
#pragma unroll 2
        for (int k = 0; k < CW; ++k) {
            const float w = pw[(size_t)k * CW + n];
#pragma unroll
            for (int i = 0; i < 16; ++i) acc[i] += cv[(half * 16 + i) * 256 + k] * w;
        }
#pragma unroll
        for (int i = 0; i < 16; ++i) { const size_t row = (size_t)b * SEQ + t0 + half * 16 + i;
            const float g = bf2f(PC[row * PC_W + 512 + n]);
            MIX[row * DM + n] = f2bf(acc[i] * siluf_(g)); }
    }
    __syncthreads();
}

constexpr int CV_AS = 264;
__device__ void conv_job64(const Params& p, int l, int job, unsigned char* lds) {
    const int tid = tid_(), lane = tid & 63, wave = tid >> 6, fr = lane & 15, fq = lane >> 4;
    const int b = job >> 5, t0 = (job & 31) * 64;
    const bf16_t* PC = (const bf16_t*)(p.ws + WS_PC); bf16_t* MIX = (bf16_t*)(p.ws + WS_MIX);
    const float* dw = p.in[5] + l * TAPS * CW; const float* dwb = p.in[6] + l * CW; const float* lng = p.in[7] + l * CW; const float* lnb = p.in[8] + l * CW;
    const bf16_t* pwT = (const bf16_t*)(p.ws + WS_WPW) + (size_t)l * CW * CW; const float* pwb = p.in[10] + l * CW;
    float* u = (float*)lds;
    bf16_t* act = (bf16_t*)(lds + 94 * 256 * 4);
    for (int idx = tid; idx < 94 * 32; idx += 512) {
        const int r = idx >> 5, c8 = (idx & 31) * 8, t = t0 - 30 + r;
        float v[8];
        if (t >= 0) { const bf16_t* pr = PC + ((size_t)b * SEQ + t) * PC_W + c8; const bf16x8 a = *(const bf16x8*)pr, g = *(const bf16x8*)(pr + 256);
#pragma unroll
            for (int e = 0; e < 8; ++e) v[e] = bf2f((bf16_t)a[e]) * __builtin_amdgcn_rcpf(1.0f + __builtin_amdgcn_exp2f(-1.4426950408889634f * bf2f((bf16_t)g[e]))); }
        else {
#pragma unroll
            for (int e = 0; e < 8; ++e) v[e] = 0.f; }
        *(f32x4*)(u + r * 256 + c8) = (f32x4){v[0], v[1], v[2], v[3]}; *(f32x4*)(u + r * 256 + c8 + 4) = (f32x4){v[4], v[5], v[6], v[7]};
    }
    __syncthreads();
    const int c = tid & 255, half = tid >> 8;
    float acc[32];
    {
        float w[TAPS];
#pragma unroll
        for (int j = 0; j < TAPS; ++j) w[j] = dw[j * CW + c];
        const float bias = dwb[c];
#pragma unroll
        for (int i = 0; i < 32; ++i) acc[i] = bias;
        const float* up = u + (half * 32) * 256 + c;
#pragma unroll
        for (int rr = 0; rr < 62; ++rr) {
            const float uv = up[rr * 256];
#pragma unroll
            for (int i = 0; i < 32; ++i) { if (rr - i >= 0 && rr - i < TAPS) acc[i] += w[rr - i] * uv; }
        }
    }
    __syncthreads();
    float* cv = u;
#pragma unroll
    for (int i = 0; i < 32; ++i) cv[(half * 32 + i) * 256 + c] = acc[i];
    __syncthreads();
#pragma unroll 2
    for (int q = 0; q < 8; ++q) {
        const int tt = wave * 8 + q; const f32x4 x = *(const f32x4*)(cv + tt * 256 + lane * 4);
        const float mean = wave_sum(x[0] + x[1] + x[2] + x[3]) * (1.0f / CW);
        const f32x4 d = x - mean;
        const float rstd = rsqrtf(wave_sum(d[0] * d[0] + d[1] * d[1] + d[2] * d[2] + d[3] * d[3]) * (1.0f / CW) + LN_EPS);
        const f32x4 g = *(const f32x4*)(lng + lane * 4), bb = *(const f32x4*)(lnb + lane * 4);
        float y[4];
#pragma unroll
        for (int e = 0; e < 4; ++e) { const float v = d[e] * rstd * g[e] + bb[e]; y[e] = v * __builtin_amdgcn_rcpf(1.0f + __builtin_amdgcn_exp2f(-1.4426950408889634f * v)); }
        uint2 w; w.x = pk2(y[0], y[1]); w.y = pk2(y[2], y[3]); *(uint2*)(act + tt * CV_AS + lane * 4) = w;
    }
    __syncthreads();
    {
        f32x4 o[2][4];
#pragma unroll
        for (int i = 0; i < 2; ++i)
#pragma unroll
            for (int j = 0; j < 4; ++j) o[i][j] = (f32x4){0.f, 0.f, 0.f, 0.f};
#pragma unroll 2
        for (int kk = 0; kk < 8; ++kk) {
            bf16x8 a[2], bq[4];
#pragma unroll
            for (int i = 0; i < 2; ++i) a[i] = *(const bf16x8*)(pwT + (size_t)(wave * 32 + i * 16 + fr) * CW + kk * 32 + fq * 8);
#pragma unroll
            for (int j = 0; j < 4; ++j) bq[j] = *(const bf16x8*)(act + (j * 16 + fr) * CV_AS + kk * 32 + fq * 8);
#pragma unroll
            for (int i = 0; i < 2; ++i)
#pragma unroll
                for (int j = 0; j < 4; ++j) o[i][j] = __builtin_amdgcn_mfma_f32_16x16x32_bf16(a[i], bq[j], o[i][j], 0, 0, 0);
        }
#pragma unroll
        for (int i = 0; i < 2; ++i) {
            const int n0 = wave * 32 + i * 16 + fq * 4; const f32x4 bias = *(const f32x4*)(pwb + n0);
#pragma unroll
            for (int j = 0; j < 4; ++j) {
                const size_t row = (size_t)b * SEQ + t0 + j * 16 + fr;
                const uint2 gw = *(const uint2*)(PC + row * PC_W + 512 + n0);
                const float g0 = bf2f((bf16_t)(gw.x & 0xffff)), g1 = bf2f((bf16_t)(gw.x >> 16)), g2 = bf2f((bf16_t)(gw.y & 0xffff)), g3 = bf2f((bf16_t)(gw.y >> 16));
                const f32x4 v = o[i][j] + bias;
                uint2 w; w.x = pk2(v[0] * siluf_(g0), v[1] * siluf_(g1)); w.y = pk2(v[2] * siluf_(g2), v[3] * siluf_(g3));
                *(uint2*)(MIX + row * DM + n0) = w;
            }
        }
    }
    __syncthreads();
}

__device__ void attn_job(const Params& p, int job) {
    const int tid = tid_(), lane = tid & 63, wave = tid >> 6;
    const int bh = job >> 2, qb = job & 3, b = bh / NH, h = bh % NH;
    const bf16_t* PS = (const bf16_t*)(p.ws + WS_PS); bf16_t* MIX = (bf16_t*)(p.ws + WS_MIX);
    const int tw = qb * 512 + wave * 64, t = tw + lane;
    const size_t row = (size_t)b * SEQ + t;
    const float qs = 1.0f;
    const bf16_t* VT = (const bf16_t*)(p.ws + WS_VT) + (size_t)bh * HD * SEQ;
    float q[64], o[64];
    {
        const bf16_t* qp = PS + row * PS_W + h * HD;
#pragma unroll
        for (int i = 0; i < 8; ++i) { const bf16x8 v = *(const bf16x8*)(qp + i * 8);
#pragma unroll
            for (int j = 0; j < 8; ++j) { q[i * 8 + j] = bf2f((bf16_t)v[j]) * qs; o[i * 8 + j] = 0.f; } }
    }
    float rp = 1.0f;
    const int z = opaque_zero();
    for (int s = tw + 62; s >= 0; --s) {
        const bf16_t* kp = PS + ((size_t)b * SEQ + s) * PS_W + 384 + h * HD + z;
        float dot = 0.f;
#pragma unroll
        for (int i = 0; i < 8; ++i) { const bf16x8 v = *(const bf16x8*)(kp + i * 8);
#pragma unroll
            for (int j = 0; j < 8; ++j) dot += q[i * 8 + j] * bf2f((bf16_t)v[j]); }
        const bool act = s < t;
        const float e = __builtin_amdgcn_exp2f(dot);
        const float keep = __builtin_amdgcn_rcpf(1.0f + e);
        const float pr = act ? (1.0f - keep) * rp : 0.f;
        rp = act ? rp * keep : rp;
#pragma unroll
        for (int d = 0; d < 64; ++d) o[d] += pr * bf2f(VT[(size_t)d * SEQ + s + z]);
        if (__all(rp == 0.0f)) break;
    }
    const bf16_t* gp = PS + row * PS_W + 768 + h * HD;
    bf16_t* op = MIX + row * DM + CW + h * HD;
#pragma unroll
    for (int i = 0; i < 8; ++i) { const bf16x8 g = *(const bf16x8*)(gp + i * 8); uint4 w;
        w.x = pk2(o[i * 8 + 0] * siluf_(bf2f((bf16_t)g[0])), o[i * 8 + 1] * siluf_(bf2f((bf16_t)g[1])));
        w.y = pk2(o[i * 8 + 2] * siluf_(bf2f((bf16_t)g[2])), o[i * 8 + 3] * siluf_(bf2f((bf16_t)g[3])));
        w.z = pk2(o[i * 8 + 4] * siluf_(bf2f((bf16_t)g[4])), o[i * 8 + 5] * siluf_(bf2f((bf16_t)g[5])));
        w.w = pk2(o[i * 8 + 6] * siluf_(bf2f((bf16_t)g[6])), o[i * 8 + 7] * siluf_(bf2f((bf16_t)g[7])));
        *(uint4*)(op + i * 8) = w; }
}

typedef float f32x16 __attribute__((ext_vector_type(16)));
__device__ void attn_mfma_wave(const Params& p, int bh, int qblk) {
    const int tid = tid_(), lane = tid & 63, qi = lane & 31, hf = lane >> 5;
    const int b = bh / NH, h = bh % NH, q0 = qblk * 32;
    const bf16_t* PS = (const bf16_t*)(p.ws + WS_PS); const bf16_t* VT = (const bf16_t*)(p.ws + WS_VT) + (size_t)bh * HD * SEQ; bf16_t* MIX = (bf16_t*)(p.ws + WS_MIX);
    const size_t rowq = (size_t)b * SEQ + q0 + qi;
    bf16x8 Qf[4];
#pragma unroll
    for (int ks = 0; ks < 4; ++ks) Qf[ks] = *(const bf16x8*)(PS + rowq * PS_W + h * HD + ks * 16 + hf * 8);
    const int pi = (qi & 3) + 4 * (qi >> 3) + 16 * ((qi >> 2) & 1);
    const bf16_t* kbase = PS + ((size_t)b * SEQ + pi) * PS_W + SBW + h * HD + hf * 8;
    const bf16_t* vbase = VT + (size_t)qi * SEQ + hf * 16;
    f32x16 O0, O1;
#pragma unroll
    for (int r = 0; r < 16; ++r) { O0[r] = 0.f; O1[r] = 0.f; }
    float rp = 1.0f;
    for (int kt = qblk; kt >= 0; --kt) {
        const int s0 = kt * 32;
        bf16x8 Kf[4], Vf[2][2];
#pragma unroll
        for (int ks = 0; ks < 4; ++ks) Kf[ks] = *(const bf16x8*)(kbase + (size_t)s0 * PS_W + ks * 16);
#pragma unroll
        for (int db = 0; db < 2; ++db)
#pragma unroll
            for (int s = 0; s < 2; ++s) Vf[db][s] = *(const bf16x8*)(vbase + (size_t)db * 32 * SEQ + s0 + s * 8);
        f32x16 S;
#pragma unroll
        for (int r = 0; r < 16; ++r) S[r] = 0.f;
#pragma unroll
        for (int ks = 0; ks < 4; ++ks) S = __builtin_amdgcn_mfma_f32_32x32x16_bf16(Kf[ks], Qf[ks], S, 0, 0, 0);
        float keep[16], beta[16];
        const bool diag = kt == qblk;
        float tot = 1.0f;
#pragma unroll
        for (int r = 0; r < 16; ++r) {
            const float e = __builtin_amdgcn_exp2f(S[r]);
            float k_ = __builtin_amdgcn_rcpf(1.0f + e);
            float b_ = 1.0f - k_;
            if (diag && (hf * 16 + r >= qi)) { k_ = 1.0f; b_ = 0.f; }
            keep[r] = k_; beta[r] = b_; tot *= k_;
        }
        const float toto = __shfl_xor(tot, 32);
        float e = hf ? rp : rp * toto;
        float pw[16];
#pragma unroll
        for (int r = 15; r >= 0; --r) { pw[r] = beta[r] * e; e *= keep[r]; }
        rp = rp * tot * toto;
        bf16x8 Pf[2];
#pragma unroll
        for (int s = 0; s < 2; ++s) {
            union { bf16x8 v; unsigned u[4]; } pk;
#pragma unroll
            for (int j = 0; j < 4; ++j) pk.u[j] = pk2(pw[8 * s + 2 * j], pw[8 * s + 2 * j + 1]);
            Pf[s] = pk.v;
        }
#pragma unroll
        for (int s = 0; s < 2; ++s) { O0 = __builtin_amdgcn_mfma_f32_32x32x16_bf16(Vf[0][s], Pf[s], O0, 0, 0, 0); O1 = __builtin_amdgcn_mfma_f32_32x32x16_bf16(Vf[1][s], Pf[s], O1, 0, 0, 0); }
        if (__ballot(rp != 0.0f) == 0ull) break;
    }
    const bf16_t* gp = PS + rowq * PS_W + 768 + h * HD; bf16_t* op = MIX + rowq * DM + CW + h * HD;
#pragma unroll
    for (int db = 0; db < 2; ++db)
#pragma unroll
        for (int g = 0; g < 4; ++g) {
            const int d0 = db * 32 + g * 8 + hf * 4;
            const uint2 gw = *(const uint2*)(gp + d0);
            const float g0 = bf2f((bf16_t)(gw.x & 0xffff)), g1 = bf2f((bf16_t)(gw.x >> 16)), g2 = bf2f((bf16_t)(gw.y & 0xffff)), g3 = bf2f((bf16_t)(gw.y >> 16));
            const f32x16& O = db ? O1 : O0;
            uint2 w; w.x = pk2(O[4 * g] * siluf_(g0), O[4 * g + 1] * siluf_(g1)); w.y = pk2(O[4 * g + 2] * siluf_(g2), O[4 * g + 3] * siluf_(g3));
            *(uint2*)(op + d0) = w;
        }
}

__device__ void rwkv_job(const Params& p, int l, int job, float* lds) {
    const int tid = tid_(), lane = tid & 63, wave = tid >> 6;
    const int b = job / NH, h = job % NH;
    const bf16_t* PR = (const bf16_t*)(p.ws + WS_PR); const bf16_t* PG = (const bf16_t*)(p.ws + WS_PG);
    float* VF = (float*)(p.ws + WS_VF); bf16_t* MIX = (bf16_t*)(p.ws + WS_MIX);
    const float* mu = p.in[11] + l * 1216; const float* w0 = p.in[12] + l * RWW; const float* w2 = p.in[13] + l * LORA * RWW;
    const float* a0 = p.in[14] + l * RWW; const float* a2 = p.in[15] + l * LORA * RWW; const float* kks = p.in[16] + l * RWW; const float* ka = p.in[17] + l * RWW;
    const float* rk = p.in[18] + l * RWW; const float* gng = p.in[19] + l * RWW; const float* gnb = p.in[20] + l * RWW;
    const float* v0 = p.in[21]; const float* v1 = p.in[22]; const float* v2 = p.in[23];
    float* R = lds; float* W = R + 4096; float* K = W + 4096; float* V = K + 4096; float* A = V + 4096; float* Bm = A + 4096; float* Y = Bm + 4096;
    float* WD = Y + 4096; float* AD = WD + 2048; float* VL = AD + 2048;
    float S[64];
#pragma unroll
    for (int i = 0; i < 64; ++i) S[i] = 0.f;
    for (int c = 0; c < SEQ / 64; ++c) {
        const int t0 = c * 64;
        for (int idx = tid; idx < 64 * 64; idx += 512) {
            const int tt = idx >> 6, i = idx & 63, t = t0 + tt;
            const bf16_t* cur = PR + ((size_t)b * SEQ + t) * PR_W;
            const float xc = bf2f(cur[1152 + i]), xp = t > 0 ? bf2f(cur[1152 + i - PR_W]) : 0.f;
            const float f = xc + (xp - xc) * mu[1152 + i];
            if (i < 32) WD[tt * 32 + i] = tanhf(f); else AD[tt * 32 + i - 32] = f;
        }
        if (l > 0) {
            for (int idx = tid; idx < 64 * 32; idx += 512) {
                const int tt = idx >> 5, i = idx & 31, t = t0 + tt;
                const bf16_t* cur = PR + ((size_t)b * SEQ + t) * PR_W + 768;
                float a = 0.f;
                for (int cc = 0; cc < RWW; ++cc) {
                    const float xc = bf2f(cur[cc]), xp = t > 0 ? bf2f(cur[cc - PR_W]) : 0.f;
                    a += (xc + (xp - xc) * mu[768 + cc]) * v1[cc * LORA + i];
                }
                VL[idx] = a;
            }
        }
        __syncthreads();
        for (int idx = tid; idx < 64 * 64; idx += 512) {
            const int tt = idx >> 6, j = idx & 63, t = t0 + tt, cj = h * HD + j;
            const size_t row = (size_t)b * SEQ + t;
            const bf16_t* cur = PR + row * PR_W;
            const bool hp = t > 0;
            float rc = bf2f(cur[cj]), kc = bf2f(cur[384 + cj]), vc = bf2f(cur[768 + cj]);
            const float rp_ = hp ? bf2f(cur[cj - PR_W]) : 0.f, kp_ = hp ? bf2f(cur[384 + cj - PR_W]) : 0.f, vp_ = hp ? bf2f(cur[768 + cj - PR_W]) : 0.f;
            rc += (rp_ - rc) * mu[cj]; kc += (kp_ - kc) * mu[384 + cj]; vc += (vp_ - vc) * mu[768 + cj];
            float wl = w0[cj], al = a0[cj];
#pragma unroll 8
            for (int i = 0; i < LORA; ++i) { wl += WD[tt * 32 + i] * w2[i * RWW + cj]; al += AD[tt * 32 + i] * a2[i * RWW + cj]; }
            const float sp = fmaxf(-wl, 0.f) + log1pf(__expf(-fabsf(wl)));
            const float decay = __expf(-__expf(-sp - 0.5f));
            const float alr = sigmoidf_(al);
            if (l > 0) {
                float vg = v0[cj];
#pragma unroll 8
                for (int i = 0; i < LORA; ++i) vg += VL[tt * 32 + i] * v2[i * RWW + cj];
                vg = sigmoidf_(vg);
                vc = vc + (VF[row * RWW + cj] - vc) * vg;
            } else VF[row * RWW + cj] = vc;
            R[idx] = rc; W[idx] = decay; V[idx] = vc;
            K[idx] = kc * (1.0f + (alr - 1.0f) * ka[cj]);
            A[idx] = kc * kks[cj];
            Bm[idx] = alr;
        }
        __syncthreads();
        for (int q = 0; q < 8; ++q) {
            const int tt = wave * 8 + q; const float kk = A[tt * 64 + lane];
            const float nrm = sqrtf(wave_sum(kk * kk));
            const float kn = kk / fmaxf(nrm, 1e-12f);
            A[tt * 64 + lane] = -kn; Bm[tt * 64 + lane] = kn * Bm[tt * 64 + lane];
        }
        __syncthreads();
        if (wave == 0) {
            for (int tt = 0; tt < 64; ++tt) {
                const f32x4* a4 = (const f32x4*)(A + tt * 64); const f32x4* w4 = (const f32x4*)(W + tt * 64); const f32x4* b4 = (const f32x4*)(Bm + tt * 64);
                const f32x4* k4 = (const f32x4*)(K + tt * 64); const f32x4* r4 = (const f32x4*)(R + tt * 64);
                float sa = 0.f;
#pragma unroll
                for (int i = 0; i < 16; ++i) { const f32x4 a = a4[i]; sa += S[4 * i] * a[0] + S[4 * i + 1] * a[1] + S[4 * i + 2] * a[2] + S[4 * i + 3] * a[3];
                    if ((i & 7) == 7) asm volatile("" ::: "memory"); }
                const float vv = V[tt * 64 + lane];
                float y = 0.f;
#pragma unroll
                for (int i = 0; i < 16; ++i) { const f32x4 w = w4[i], bb = b4[i], kk = k4[i], rr = r4[i];
#pragma unroll
                    for (int e = 0; e < 4; ++e) { const float s = S[4 * i + e] * w[e] + sa * bb[e] + vv * kk[e]; S[4 * i + e] = s; y += s * rr[e]; }
                    if ((i & 1) == 1) asm volatile("" ::: "memory"); }
                Y[tt * 64 + lane] = y;
            }
        }
        __syncthreads();
        for (int q = 0; q < 8; ++q) {
            const int tt = wave * 8 + q, t = t0 + tt, cj = h * HD + lane; const size_t row = (size_t)b * SEQ + t;
            const float y = Y[tt * 64 + lane];
            const float mean = wave_sum(y) * (1.0f / HD); const float d = y - mean;
            const float var = wave_sum(d * d) * (1.0f / HD);
            const float yn = d * rsqrtf(var + GN_EPS) * gng[cj] + gnb[cj];
            const float bonus = wave_sum(R[tt * 64 + lane] * K[tt * 64 + lane] * rk[cj]);
            const float o = yn + bonus * V[tt * 64 + lane];
            const float g = bf2f(PG[row * PG_W + cj]);
            MIX[row * DM + CW + SBW + cj] = f2bf(o * siluf_(g));
        }
        __syncthreads();
    }
}

constexpr int TS = 72;
constexpr int TILE_B = 64 * TS * 2;
constexpr int AABS = 68, XTS = 65, CSS = 65;

__device__ __forceinline__ f32x4 mm_tile(const bf16_t* X, int m0, const bf16_t* Yt, int n0, int K, int fr, int fq, f32x4 acc) {
#pragma unroll
    for (int kk = 0; kk < 2; ++kk) {
        if (kk * 32 < K) {
            const bf16x8 a = *(const bf16x8*)(X + (m0 + fr) * TS + kk * 32 + fq * 8);
            const bf16x8 b = *(const bf16x8*)(Yt + (n0 + fr) * TS + kk * 32 + fq * 8);
            acc = __builtin_amdgcn_mfma_f32_16x16x32_bf16(a, b, acc, 0, 0, 0);
        }
    }
    return acc;
}
__device__ __forceinline__ uint2 pk4(const f32x4& v) { uint2 w; w.x = pk2(v[0], v[1]); w.y = pk2(v[2], v[3]); return w; }

__device__ void rwkv_b1_job(const Params& p, int l, int jb, unsigned char* lds) {
    const int tid = tid_(), lane = tid & 63, wave = tid >> 6, fr = lane & 15, fq = lane >> 4;
    const int bh = jb >> 5, c = jb & 31, b = bh / NH, h = bh % NH, t0 = c * 64;
    const bf16_t* PR = (const bf16_t*)(p.ws + WS_PR); float* VF = (float*)(p.ws + WS_VF);
    const float* mu = p.in[11] + l * 1216; const float* w0 = p.in[12] + l * RWW; const float* w2 = p.in[13] + l * LORA * RWW;
    const float* a0 = p.in[14] + l * RWW; const float* a2 = p.in[15] + l * LORA * RWW; const float* kks = p.in[16] + l * RWW; const float* ka = p.in[17] + l * RWW;
    const float* rk = p.in[18] + l * RWW; const float* v0 = p.in[21]; const float* v2 = p.in[23];
    bf16_t* T_At = (bf16_t*)lds; bf16_t* T_Rt = T_At + 64 * TS; bf16_t* T_Bt = T_Rt + 64 * TS; bf16_t* T_Kt = T_Bt + 64 * TS;
    bf16_t* T_VT = T_Kt + 64 * TS; bf16_t* T_bhT = T_VT + 64 * TS; bf16_t* T_khT = T_bhT + 64 * TS;
    bf16_t* T_Aak = T_khT + 64 * TS; bf16_t* T_Arb = T_Aak + 64 * TS; bf16_t* T_Ark = T_Arb + 64 * TS;
    bf16_t* T_WT = T_At; bf16_t* T_U0T = T_Bt;
    float* Aab = (float*)(lds + 10 * TILE_B);
    float* XT = (float*)(lds + 10 * TILE_B + 64 * AABS * 4);
    float* PCv = XT + 128 * XTS;
    float* CS = (float*)T_Aak;
    float* WD = XT + 64 * XTS; float* AD = WD + 2048;
    float* VL = Aab;

    float rr[8], kk_[8], vv[8], aa[8], bb[8], lw[8];
    const int tt = tid >> 3, j0 = (tid & 7) * 8, t = t0 + tt, cj0 = h * HD + j0;
    const size_t row = (size_t)b * SEQ + t;
    for (int repA = 0; repA < ((PROBE_REP & 128) ? 2 : 1); ++repA) {
    for (int idx = tid; idx < 2048; idx += 512) {
        const int tt = idx >> 5, i = idx & 31, t = t0 + tt;
        const bf16_t* cur = PR + ((size_t)b * SEQ + t) * PR_W; const bool hp = t > 0;
        { const float xc = bf2f(cur[1152 + i]), xp = hp ? bf2f(cur[1152 + i - PR_W]) : 0.f; WD[idx] = tanhf(xc + (xp - xc) * mu[1152 + i]); }
        { const float xc = bf2f(cur[1184 + i]), xp = hp ? bf2f(cur[1184 + i - PR_W]) : 0.f; AD[idx] = xc + (xp - xc) * mu[1184 + i]; }
        if (l > 0) VL[idx] = bf2f(cur[1216 + i]) + (hp ? bf2f(cur[1248 + i - PR_W]) : 0.f);
    }
    __syncthreads();
    {
        const bf16_t* cur = PR + row * PR_W; const bool hp = t > 0;
        const bf16x8 rc = *(const bf16x8*)(cur + cj0), kc = *(const bf16x8*)(cur + 384 + cj0), vc = *(const bf16x8*)(cur + 768 + cj0);
        bf16x8 rp = rc, kp = kc, vp = vc;
        if (hp) { rp = *(const bf16x8*)(cur + cj0 - PR_W); kp = *(const bf16x8*)(cur + 384 + cj0 - PR_W); vp = *(const bf16x8*)(cur + 768 + cj0 - PR_W); }
        float wl[8], al[8], vg[8];
#pragma unroll
        for (int e = 0; e < 8; ++e) {
            const float r_c = bf2f((bf16_t)rc[e]), k_c = bf2f((bf16_t)kc[e]), v_c = bf2f((bf16_t)vc[e]);
            const float r_p = hp ? bf2f((bf16_t)rp[e]) : 0.f, k_p = hp ? bf2f((bf16_t)kp[e]) : 0.f, v_p = hp ? bf2f((bf16_t)vp[e]) : 0.f;
            rr[e] = r_c + (r_p - r_c) * mu[cj0 + e]; kk_[e] = k_c + (k_p - k_c) * mu[384 + cj0 + e]; vv[e] = v_c + (v_p - v_c) * mu[768 + cj0 + e];
            wl[e] = w0[cj0 + e]; al[e] = a0[cj0 + e]; vg[e] = l > 0 ? v0[cj0 + e] : 0.f;
        }
#pragma unroll 4
        for (int i = 0; i < LORA; ++i) {
            const float wd = WD[tt * 32 + i], ad = AD[tt * 32 + i];
            const f32x4 wa = *(const f32x4*)(w2 + i * RWW + cj0), wb = *(const f32x4*)(w2 + i * RWW + cj0 + 4);
            const f32x4 xa = *(const f32x4*)(a2 + i * RWW + cj0), xb = *(const f32x4*)(a2 + i * RWW + cj0 + 4);
#pragma unroll
            for (int e = 0; e < 4; ++e) { wl[e] += wd * wa[e]; wl[4 + e] += wd * wb[e]; al[e] += ad * xa[e]; al[4 + e] += ad * xb[e]; }
            if (l > 0) { const float vl = VL[tt * 32 + i];
                const f32x4 ya = *(const f32x4*)(v2 + i * RWW + cj0), yb = *(const f32x4*)(v2 + i * RWW + cj0 + 4);
#pragma unroll
                for (int e = 0; e < 4; ++e) { vg[e] += vl * ya[e]; vg[4 + e] += vl * yb[e]; } }
        }
        float ssq = 0.f, bon = 0.f;
#pragma unroll
        for (int e = 0; e < 8; ++e) {
            const float sp = fmaxf(-wl[e], 0.f) + log1pf(__expf(-fabsf(wl[e])));
            lw[e] = -__expf(-sp - 0.5f);
            const float alr = sigmoidf_(al[e]);
            if (l > 0) vv[e] = vv[e] + (VF[row * RWW + cj0 + e] - vv[e]) * sigmoidf_(vg[e]); else VF[row * RWW + cj0 + e] = vv[e];
            const float kkr = kk_[e] * kks[cj0 + e];
            kk_[e] = kk_[e] * (1.0f + (alr - 1.0f) * ka[cj0 + e]);
            aa[e] = kkr; bb[e] = alr; ssq += kkr * kkr; bon += rr[e] * kk_[e] * rk[cj0 + e];
        }
        ssq += __shfl_xor(ssq, 1); ssq += __shfl_xor(ssq, 2); ssq += __shfl_xor(ssq, 4);
        bon += __shfl_xor(bon, 1); bon += __shfl_xor(bon, 2); bon += __shfl_xor(bon, 4);
        const float inv = 1.0f / fmaxf(sqrtf(ssq), 1e-12f);
        uint4 bvw; float bv[8];
#pragma unroll
        for (int e = 0; e < 8; ++e) { const float kn = aa[e] * inv; aa[e] = -kn; bb[e] = kn * bb[e]; bv[e] = bon * vv[e]; CS[tt * CSS + j0 + e] = lw[e]; }
        bvw.x = pk2(bv[0], bv[1]); bvw.y = pk2(bv[2], bv[3]); bvw.z = pk2(bv[4], bv[5]); bvw.w = pk2(bv[6], bv[7]);
        *(uint4*)((bf16_t*)(p.ws + WS_CH_BV) + (size_t)jb * 4096 + tt * 64 + j0) = bvw;
    }
    __syncthreads();
#pragma unroll
    for (int e = 0; e < 8; ++e) {
        const int j = wave * 8 + e; float x = CS[lane * CSS + j];
#pragma unroll
        for (int o = 1; o < 64; o <<= 1) { const float y = __shfl_up(x, o); if (lane >= o) x += y; }
        CS[lane * CSS + j] = x;
    }
    __syncthreads();
    }
    float at[8];
    for (int repB = 0; repB < ((PROBE_REP & 256) ? 2 : 1); ++repB) {
    {
        float rt[8], bt[8], kt[8];
#pragma unroll
        for (int e = 0; e < 8; ++e) {
            const int j = j0 + e; const float cs = CS[tt * CSS + j], csC = CS[63 * CSS + j];
            const float e_in = __expf(cs), e_ex = __expf(cs - lw[e]), e_ng = __expf(-cs), e_ht = __expf(csC - cs);
            at[e] = aa[e] * e_ex; rt[e] = rr[e] * e_in; bt[e] = bb[e] * e_ng; kt[e] = kk_[e] * e_ng;
            T_VT[j * TS + tt] = f2bf(vv[e]); T_bhT[j * TS + tt] = f2bf(bb[e] * e_ht); T_khT[j * TS + tt] = f2bf(kk_[e] * e_ht);
            XT[j * XTS + tt] = at[e];
            if (tt == 63) PCv[j] = __expf(csC);
        }
        uint4 w;
        w.x = pk2(at[0], at[1]); w.y = pk2(at[2], at[3]); w.z = pk2(at[4], at[5]); w.w = pk2(at[6], at[7]); *(uint4*)(T_At + tt * TS + j0) = w;
        w.x = pk2(rt[0], rt[1]); w.y = pk2(rt[2], rt[3]); w.z = pk2(rt[4], rt[5]); w.w = pk2(rt[6], rt[7]); *(uint4*)(T_Rt + tt * TS + j0) = w;
        w.x = pk2(bt[0], bt[1]); w.y = pk2(bt[2], bt[3]); w.z = pk2(bt[4], bt[5]); w.w = pk2(bt[6], bt[7]); *(uint4*)(T_Bt + tt * TS + j0) = w;
        w.x = pk2(kt[0], kt[1]); w.y = pk2(kt[2], kt[3]); w.z = pk2(kt[4], kt[5]); w.w = pk2(kt[6], kt[7]); *(uint4*)(T_Kt + tt * TS + j0) = w;
    }
    __syncthreads();
    }
    for (int repD = 0; repD < ((PROBE_REP & 1024) ? 2 : 1); ++repD) {
    if (repD) { for (int e = 0; e < 8; ++e) XT[(j0 + e) * XTS + tt] = at[e]; __syncthreads(); }
    for (int repC = 0; repC < ((PROBE_REP & 512) ? 2 : 1); ++repC) {
#pragma unroll 1
    for (int q = 0; q < 8; ++q) {
        const int id = wave * 8 + q, mat = id >> 4, ti = (id >> 2) & 3, tj = id & 3;
        const bf16_t* As = (mat == 0 || mat == 2) ? T_Bt : T_Kt; const bf16_t* Bs = (mat < 2) ? T_At : T_Rt;
        f32x4 acc = (f32x4){0.f, 0.f, 0.f, 0.f};
        if (ti <= tj) acc = mm_tile(As, ti * 16, Bs, tj * 16, 64, fr, fq, acc);
        const int tcol = tj * 16 + fr, i0 = ti * 16 + fq * 4;
#pragma unroll
        for (int r = 0; r < 4; ++r) { const bool keep = (mat < 2) ? (i0 + r < tcol) : (i0 + r <= tcol); if (!keep) acc[r] = 0.f; }
        if (mat == 0) *(f32x4*)(Aab + tcol * AABS + i0) = acc;
        else { bf16_t* dst = (mat == 1 ? T_Aak : (mat == 2 ? T_Arb : T_Ark)); *(uint2*)(dst + tcol * TS + i0) = pk4(acc); }
    }
    __syncthreads();
#pragma unroll 1
    for (int q = 0; q < 2; ++q) {
        const int id = wave * 2 + q, ti = id >> 2, tj = id & 3;
        f32x4 acc = mm_tile(T_Aak, ti * 16, T_VT, tj * 16, 64, fr, fq, (f32x4){0.f, 0.f, 0.f, 0.f});
        const int j = tj * 16 + fr, tr = ti * 16 + fq * 4;
#pragma unroll
        for (int r = 0; r < 4; ++r) XT[(64 + j) * XTS + tr + r] = acc[r];
    }
    __syncthreads();
    }
#pragma unroll 1
    for (int I = 0; I < 4; ++I) {
        if (I > 0) {
            const int jp = tid & 127, tq = tid >> 7; float s[4] = {0.f, 0.f, 0.f, 0.f};
            const float* xr = XT + jp * XTS; const float* ar = Aab + (16 * I + 4 * tq) * AABS;
            for (int i = 0; i < 16 * I; ++i) { const float x = xr[i];
#pragma unroll
                for (int r = 0; r < 4; ++r) s[r] += ar[r * AABS + i] * x; }
            __syncthreads();
#pragma unroll
            for (int r = 0; r < 4; ++r) XT[jp * XTS + 16 * I + 4 * tq + r] += s[r];
            __syncthreads();
        }
        if (tid < 128) {
            float x[16]; float* xr = XT + tid * XTS + 16 * I; const float* ar = Aab + (16 * I) * AABS + 16 * I;
#pragma unroll
            for (int u = 0; u < 16; ++u) { float v = xr[u];
#pragma unroll
                for (int i = 0; i < u; ++i) v += ar[u * AABS + i] * x[i];
                x[u] = v; }
#pragma unroll
            for (int u = 0; u < 16; ++u) xr[u] = x[u];
        }
        __syncthreads();
    }
    }
    for (int repE = 0; repE < ((PROBE_REP & 2048) ? 2 : 1); ++repE) {
    {
        const int col = tid >> 2, tg = (tid & 3) * 16;
        const float* xr = XT + col * XTS + tg; bf16_t* dst = (col < 64 ? T_WT + col * TS : T_U0T + (col - 64) * TS) + tg;
        uint4 w0_, w1_;
        w0_.x = pk2(xr[0], xr[1]); w0_.y = pk2(xr[2], xr[3]); w0_.z = pk2(xr[4], xr[5]); w0_.w = pk2(xr[6], xr[7]);
        w1_.x = pk2(xr[8], xr[9]); w1_.y = pk2(xr[10], xr[11]); w1_.z = pk2(xr[12], xr[13]); w1_.w = pk2(xr[14], xr[15]);
        *(uint4*)dst = w0_; *(uint4*)(dst + 8) = w1_;
    }
    __syncthreads();
    {
        bf16_t* gM = (bf16_t*)(p.ws + WS_CH_M) + (size_t)jb * 4096; bf16_t* gNT = (bf16_t*)(p.ws + WS_CH_NT) + (size_t)jb * 4096;
        bf16_t* gG = (bf16_t*)(p.ws + WS_CH_G) + (size_t)jb * 4096; bf16_t* gY1T = (bf16_t*)(p.ws + WS_CH_Y1T) + (size_t)jb * 4096;
#pragma unroll 1
        for (int q = 0; q < 8; ++q) {
            const int id = wave * 8 + q, mat = id >> 4, ti = (id >> 2) & 3, tj = id & 3;
            const int col = tj * 16 + fr, r0 = ti * 16 + fq * 4;
            f32x4 acc = (f32x4){0.f, 0.f, 0.f, 0.f};
            if (mat == 0) {
                acc = mm_tile(T_WT, ti * 16, T_Arb, tj * 16, 64, fr, fq, acc);
                const uint2 rw = *(const uint2*)(T_Rt + col * TS + r0);
                acc[0] += bf2f((bf16_t)(rw.x & 0xffff)); acc[1] += bf2f((bf16_t)(rw.x >> 16)); acc[2] += bf2f((bf16_t)(rw.y & 0xffff)); acc[3] += bf2f((bf16_t)(rw.y >> 16));
                *(uint2*)(gG + col * 64 + r0) = pk4(acc);
            } else if (mat == 1) {
                acc = mm_tile(T_Arb, ti * 16, T_U0T, tj * 16, 64, fr, fq, acc);
                acc = mm_tile(T_Ark, ti * 16, T_VT, tj * 16, 64, fr, fq, acc);
                *(uint2*)(gY1T + col * 64 + r0) = pk4(acc);
            } else if (mat == 2) {
                acc = mm_tile(T_WT, ti * 16, T_bhT, tj * 16, 64, fr, fq, acc);
                const float pc = PCv[col];
#pragma unroll
                for (int r = 0; r < 4; ++r) if (r0 + r == col) acc[r] += pc;
                *(uint2*)(gM + col * 64 + r0) = pk4(acc);
            } else {
                acc = mm_tile(T_bhT, ti * 16, T_U0T, tj * 16, 64, fr, fq, acc);
                acc = mm_tile(T_khT, ti * 16, T_VT, tj * 16, 64, fr, fq, acc);
                *(uint2*)(gNT + col * 64 + r0) = pk4(acc);
            }
        }
    }
    __syncthreads();
    }
}

__device__ void rwkv_b2_job(const Params& p, int bh, unsigned char* lds) {
    const int tid = tid_(), lane = tid & 63, wave = tid >> 6, fr = lane & 15, fq = lane >> 4;
    const int mi = wave >> 1, nj0 = (wave & 1) * 2;
    const bf16_t* gM = (const bf16_t*)(p.ws + WS_CH_M); const bf16_t* gNT = (const bf16_t*)(p.ws + WS_CH_NT); bf16_t* gZT = (bf16_t*)(p.ws + WS_ZT);
    bf16_t* zbuf = (bf16_t*)lds;
    f32x4 z[2];
    z[0] = (f32x4){0.f, 0.f, 0.f, 0.f}; z[1] = z[0];
    const int c0 = mi * 16 + fq * 4;
#pragma unroll 1
    for (int c = 0; c < SEQ / 64; ++c) {
        const size_t jb = (size_t)bh * 32 + c;
        bf16_t* zh = zbuf + (c & 1) * 2 * 64 * TS; bf16_t* zl = zh + 64 * TS;
#pragma unroll
        for (int q = 0; q < 2; ++q) {
            const int j = (nj0 + q) * 16 + fr;
            const uint2 hi = pk4(z[q]);
            f32x4 lo;
            lo[0] = z[q][0] - bf2f((bf16_t)(hi.x & 0xffff)); lo[1] = z[q][1] - bf2f((bf16_t)(hi.x >> 16)); lo[2] = z[q][2] - bf2f((bf16_t)(hi.y & 0xffff)); lo[3] = z[q][3] - bf2f((bf16_t)(hi.y >> 16));
            *(uint2*)(zh + j * TS + c0) = hi; *(uint2*)(zl + j * TS + c0) = pk4(lo);
            *(uint2*)(gZT + jb * 4096 + j * 64 + c0) = hi;
        }
        __syncthreads();
        bf16x8 am[2];
#pragma unroll
        for (int kk = 0; kk < 2; ++kk) am[kk] = *(const bf16x8*)(gM + jb * 4096 + (mi * 16 + fr) * 64 + kk * 32 + fq * 8);
#pragma unroll
        for (int q = 0; q < 2; ++q) {
            const int j = (nj0 + q) * 16 + fr;
            const uint2 nw = *(const uint2*)(gNT + jb * 4096 + j * 64 + c0);
            f32x4 acc; acc[0] = bf2f((bf16_t)(nw.x & 0xffff)); acc[1] = bf2f((bf16_t)(nw.x >> 16)); acc[2] = bf2f((bf16_t)(nw.y & 0xffff)); acc[3] = bf2f((bf16_t)(nw.y >> 16));
#pragma unroll
            for (int kk = 0; kk < 2; ++kk) {
                const bf16x8 bh_ = *(const bf16x8*)(zh + j * TS + kk * 32 + fq * 8), bl_ = *(const bf16x8*)(zl + j * TS + kk * 32 + fq * 8);
                acc = __builtin_amdgcn_mfma_f32_16x16x32_bf16(am[kk], bh_, acc, 0, 0, 0);
                acc = __builtin_amdgcn_mfma_f32_16x16x32_bf16(am[kk], bl_, acc, 0, 0, 0);
            }
            z[q] = acc;
        }
    }
    __syncthreads();
}

__device__ void rwkv_b3_pair(const Params& p, int l, int pair) {
    const int tid = tid_(), lane = tid & 63, wave = tid >> 6, fr = lane & 15, fq = lane >> 4;
    const int jb = pair * 2 + (wave >> 2), mi = wave & 3;
    const int bh = jb >> 5, c = jb & 31, b = bh / NH, h = bh % NH;
    const bf16_t* gG = (const bf16_t*)(p.ws + WS_CH_G) + (size_t)jb * 4096; const bf16_t* gY1T = (const bf16_t*)(p.ws + WS_CH_Y1T) + (size_t)jb * 4096;
    const bf16_t* gBV = (const bf16_t*)(p.ws + WS_CH_BV) + (size_t)jb * 4096; const bf16_t* gZT = (const bf16_t*)(p.ws + WS_ZT) + (size_t)jb * 4096;
    const bf16_t* PG = (const bf16_t*)(p.ws + WS_PG); bf16_t* MIX = (bf16_t*)(p.ws + WS_MIX);
    const float* gng = p.in[19] + l * RWW; const float* gnb = p.in[20] + l * RWW;
    const int tr = mi * 16 + fq * 4;
    bf16x8 ag[2];
#pragma unroll
    for (int kk = 0; kk < 2; ++kk) ag[kk] = *(const bf16x8*)(gG + (mi * 16 + fr) * 64 + kk * 32 + fq * 8);
    f32x4 acc[4];
#pragma unroll
    for (int nj = 0; nj < 4; ++nj) {
        const int j = nj * 16 + fr;
        const uint2 yw = *(const uint2*)(gY1T + j * 64 + tr);
        acc[nj][0] = bf2f((bf16_t)(yw.x & 0xffff)); acc[nj][1] = bf2f((bf16_t)(yw.x >> 16)); acc[nj][2] = bf2f((bf16_t)(yw.y & 0xffff)); acc[nj][3] = bf2f((bf16_t)(yw.y >> 16));
#pragma unroll
        for (int kk = 0; kk < 2; ++kk) { const bf16x8 bz = *(const bf16x8*)(gZT + j * 64 + kk * 32 + fq * 8); acc[nj] = __builtin_amdgcn_mfma_f32_16x16x32_bf16(ag[kk], bz, acc[nj], 0, 0, 0); }
    }
#pragma unroll
    for (int r = 0; r < 4; ++r) {
        float s = acc[0][r] + acc[1][r] + acc[2][r] + acc[3][r];
        s += __shfl_xor(s, 1); s += __shfl_xor(s, 2); s += __shfl_xor(s, 4); s += __shfl_xor(s, 8);
        const float mean = s * (1.0f / HD);
        float d[4], vs = 0.f;
#pragma unroll
        for (int nj = 0; nj < 4; ++nj) { d[nj] = acc[nj][r] - mean; vs += d[nj] * d[nj]; }
        vs += __shfl_xor(vs, 1); vs += __shfl_xor(vs, 2); vs += __shfl_xor(vs, 4); vs += __shfl_xor(vs, 8);
        const float rstd = rsqrtf(vs * (1.0f / HD) + GN_EPS);
        const int tt = tr + r; const size_t row = (size_t)b * SEQ + c * 64 + tt;
#pragma unroll
        for (int nj = 0; nj < 4; ++nj) {
            const int j = nj * 16 + fr, cj = h * HD + j;
            const float o = d[nj] * rstd * gng[cj] + gnb[cj] + bf2f(gBV[tt * 64 + j]);
            const float g = bf2f(PG[row * PG_W + cj]);
            MIX[row * DM + CW + SBW + cj] = f2bf(o * siluf_(g));
        }
    }
}

#ifndef ATTN_REF
#define ATTN_REF 0
#endif
#ifndef RWKV_REF
#define RWKV_REF 0
#endif
__device__ void phase_mix1(const Params& p, int l, unsigned char* lds) {
    constexpr int NAT = BATCH * NH * 4, NCV = BATCH * (SEQ / 32);
    const int G = gridDim.x;
#if RWKV_REF
    for (int job = blockIdx.x; job < BATCH * NH; job += G) rwkv_job(p, l, job, (float*)lds);
#else
    for (int rep = 0; rep < ((PROBE_REP & 1) ? 2 : 1); ++rep)
    for (int job = blockIdx.x; job < BATCH * NH * 32; job += G) rwkv_b1_job(p, l, job, lds);
#endif
    for (int rep = 0; rep < ((PROBE_REP & 2) ? 2 : 1); ++rep)
#if ATTN_REF
    for (int job = blockIdx.x; job < NAT; job += G) attn_job(p, job);
#else
    for (int job = blockIdx.x; job < NAT * 2; job += G) attn_mfma_wave(p, job >> 3, (job & 7) * 8 + (tid_() >> 6));
#endif
#ifndef CONV_REF
#define CONV_REF 0
#endif
    for (int rep = 0; rep < ((PROBE_REP & 4) ? 2 : 1); ++rep)
#if CONV_REF
    for (int job = blockIdx.x; job < NCV; job += G) conv_job(p, l, job, (float*)lds);
#else
    for (int job = blockIdx.x; job < BATCH * (SEQ / 64); job += G) conv_job64(p, l, job, lds);
#endif
}
__device__ void phase_mix2(const Params& p, int l, unsigned char* lds) {
#if !RWKV_REF
    for (int rep = 0; rep < ((PROBE_REP & 8) ? 2 : 1); ++rep)
    for (int job = blockIdx.x; job < BATCH * NH; job += gridDim.x) rwkv_b2_job(p, job, lds);
#endif
}
__device__ void phase_mix3(const Params& p, int l, unsigned char* lds) {
#if !RWKV_REF
    for (int rep = 0; rep < ((PROBE_REP & 16) ? 2 : 1); ++rep)
    for (int pair = blockIdx.x; pair < BATCH * NH * 16; pair += gridDim.x) rwkv_b3_pair(p, l, pair);
#endif
}

constexpr int PH_PER_LAYER = 6;
constexpr int N_PHASES = 1 + PH_PER_LAYER * DEPTH;
__device__ __forceinline__ void run_phase(const Params& p, int ph, unsigned char* lds) {
    unsigned char* ws = p.ws;
    if (ph == 0) { phase_prologue(p, lds); return; }
    const int l = (ph - 1) / PH_PER_LAYER, k = (ph - 1) % PH_PER_LAYER;
    if (k == 0) {
#if SIMPLE_GEMM
        EpiInProj E{(bf16_t*)(ws + WS_PC), (bf16_t*)(ws + WS_PS), (bf16_t*)(ws + WS_PR), (bf16_t*)(ws + WS_PG)};
        gemm_simple((const bf16_t*)(ws + WS_XB), (const bf16_t*)(ws + WS_WIN) + (size_t)l * NINT * DM, M, NINT, DM, E);
#else
        EpiInProjP E{(bf16_t*)(ws + WS_PC), (bf16_t*)(ws + WS_PS), (bf16_t*)(ws + WS_PR), (bf16_t*)(ws + WS_PG), (bf16_t*)(ws + WS_VT)};
        pg8::Gemm g{(const bf16_t*)(ws + WS_XB), (const bf16_t*)(ws + WS_WIN) + (size_t)l * NINT * DM, M, NINT, DM}; pg8::StaticOrder S; S.init(M, NINT, (int)gridDim.x, (int)blockIdx.x);
        for (int rep = 0; rep < ((PROBE_REP & 32) ? 2 : 1); ++rep)
        pg8::gemm_phase<EpiInProjP, pg8::StaticOrder, true, true>((PG8_LAS unsigned char*)lds, g, S, E);
#endif
    } else if (k == 1) {
        phase_mix1(p, l, lds);
    } else if (k == 2) {
        phase_mix2(p, l, lds);
    } else if (k == 3) {
        phase_mix3(p, l, lds);
    } else if (k == 4) {
#if SIMPLE_GEMM
        EpiF32 E{(float*)(ws + WS_Y), DM};
        gemm_simple((const bf16_t*)(ws + WS_MIX), (const bf16_t*)(ws + WS_WOUT) + (size_t)l * DM * DM, M, DM, DM, E);
#else
        EpiOutF32P E{(float*)(ws + WS_Y), DM};
        pg8::Gemm g{(const bf16_t*)(ws + WS_MIX), (const bf16_t*)(ws + WS_WOUT) + (size_t)l * DM * DM, M, DM, DM}; pg8::StaticOrder S; S.init(M, DM, (int)gridDim.x, (int)blockIdx.x);
        for (int rep = 0; rep < ((PROBE_REP & 64) ? 2 : 1); ++rep)
        pg8::gemm_phase<EpiOutF32P, pg8::StaticOrder, true, true>((PG8_LAS unsigned char*)lds, g, S, E);
#endif
    } else {
        phase_rowpass(l == 0 ? p.in[0] : p.out, (const float*)(ws + WS_Y), p.in[2] + l * DM, p.out, l + 1 < DEPTH ? (bf16_t*)(ws + WS_XB) : nullptr);
    }
}

constexpr int LDS_BYTES = 147456;

#if MK_COOP
__global__ void __launch_bounds__(512, 2) fwd_kernel(Params p) {
    extern __shared__ __attribute__((aligned(16))) unsigned char lds[];
    cg::grid_group grid = cg::this_grid();
    for (int ph = p.ph_lo; ph < p.ph_hi; ++ph) {
        run_phase(p, ph, lds);
        if (ph + 1 < p.ph_hi) grid.sync();
    }
}
#else
__global__ void __launch_bounds__(512, 2) fwd_kernel(Params p) {
    extern __shared__ __attribute__((aligned(16))) unsigned char lds[];
    for (int ph = p.ph_lo; ph < p.ph_hi; ++ph) run_phase(p, ph, lds);
}
#endif

extern "C" void kernel_launch(void* const* d_in, const int* in_sizes, int n_in, void* d_out, int out_size, void* d_ws, size_t ws_size, hipStream_t stream) {
    static int grid = 0;
    if (grid == 0) {
        if (n_in != 24 || out_size != M * DM || ws_size < WS_END) { fprintf(stderr, "kernel_launch: unexpected problem (n_in %d out %d ws %zu)\n", n_in, out_size, ws_size); grid = -1; return; }
        int dev = 0, cus = 0, per_cu = 0;
        hipGetDevice(&dev); hipDeviceGetAttribute(&cus, hipDeviceAttributeMultiprocessorCount, dev);
        hipFuncSetAttribute((const void*)fwd_kernel, hipFuncAttributeMaxDynamicSharedMemorySize, LDS_BYTES);
        hipOccupancyMaxActiveBlocksPerMultiprocessor(&per_cu, (const void*)fwd_kernel, 512, LDS_BYTES);
        if (per_cu < 1) { fprintf(stderr, "kernel_launch: occupancy query says %d blocks per CU\n", per_cu); per_cu = 1; }
        grid = cus;
        (void)hipGetLastError();
    }
    if (grid < 0) return;
    Params p{};
    for (int i = 0; i < 24; ++i) p.in[i] = (const float*)d_in[i];
    p.out = (float*)d_out; p.ws = (unsigned char*)d_ws;
#if MK_COOP
    p.ph_lo = 0; p.ph_hi = N_PHASES;
    void* args[] = {&p};
    hipError_t e = hipLaunchCooperativeKernel((const void*)fwd_kernel, dim3(grid), dim3(512), args, LDS_BYTES, stream);
    if (e != hipSuccess) fprintf(stderr, "cooperative launch failed: %s (grid %d)\n", hipGetErrorString(e), grid);
#else
    for (int ph = 0; ph < N_PHASES; ++ph) {
        p.ph_lo = ph; p.ph_hi = ph + 1;
        hipLaunchKernelGGL(fwd_kernel, dim3(grid), dim3(512), LDS_BYTES, stream, p);
    }
#endif
}
```

```cpp
#include <hip/hip_runtime.h>
#include <hip/hip_cooperative_groups.h>
#include <cstdio>
#include <cstdint>
namespace cg = cooperative_groups;

#ifndef SIMPLE_GEMM
#define SIMPLE_GEMM 0
#endif
#ifndef PROBE_REP
#define PROBE_REP 0
#endif
#ifndef MK_COOP
#define MK_COOP 1
#endif

constexpr int BATCH = 16, SEQ = 2048, DM = 1024, DEPTH = 2;
constexpr int M = BATCH * SEQ;
constexpr int HD = 64, NH = 6;
constexpr int CW = 256, SBW = 384, RWW = 384, LORA = 32, TAPS = 31;
constexpr int DIN = 3904;
constexpr int NINT = 4096;
constexpr int PC_W = 768, PS_W = 1152, PR_W = 1280, PG_W = 384;
constexpr float RMS_EPS = 1e-6f, LN_EPS = 1e-5f, GN_EPS = 64e-5f;

typedef unsigned short bf16_t;
typedef short bf16x8 __attribute__((ext_vector_type(8)));
typedef float f32x4 __attribute__((ext_vector_type(4)));
typedef unsigned short us4 __attribute__((ext_vector_type(4)));

constexpr size_t MiB = 1u << 20;
constexpr size_t WS_CTL = 0;
constexpr size_t WS_WPW = 512 * 1024;
constexpr size_t WS_WIN = 1 * MiB;
constexpr size_t WS_WOUT = 17 * MiB;
constexpr size_t WS_XB = 21 * MiB;
constexpr size_t WS_MIX = WS_XB;
constexpr size_t WS_PC = 85 * MiB;
constexpr size_t WS_PS = 133 * MiB;
constexpr size_t WS_VT = 205 * MiB;
constexpr size_t WS_Y = WS_PC;
constexpr size_t WS_PR = 229 * MiB;
constexpr size_t WS_PG = 309 * MiB;
constexpr size_t WS_VF = 333 * MiB;
constexpr size_t WS_CH = 381 * MiB;
constexpr size_t CH_SZ = (size_t)3072 * 4096 * 2;
constexpr size_t WS_CH_M = WS_CH, WS_CH_NT = WS_CH + CH_SZ, WS_CH_G = WS_CH + 2 * CH_SZ, WS_CH_Y1T = WS_CH + 3 * CH_SZ, WS_CH_BV = WS_CH + 4 * CH_SZ;
constexpr size_t WS_ZT = WS_PR;
constexpr size_t WS_END = 501 * MiB;

struct Params {
    const float* in[24];
    float* out;
    unsigned char* ws;
    int ph_lo, ph_hi;
};

__device__ __forceinline__ float bf2f(bf16_t v) { return __uint_as_float(((unsigned)v) << 16); }
__device__ __forceinline__ bf16_t f2bf(float f) { unsigned u = __float_as_uint(f); return (bf16_t)((u + 0x7fffu + ((u >> 16) & 1u)) >> 16); }
__device__ __forceinline__ unsigned pk2(float lo, float hi) { return (unsigned)f2bf(lo) | ((unsigned)f2bf(hi) << 16); }
__device__ __forceinline__ float wave_sum(float v) {
#pragma unroll
    for (int o = 1; o < 64; o <<= 1) v += __shfl_xor(v, o);
    return v;
}
__device__ __forceinline__ float sigmoidf_(float x) { return 1.0f / (1.0f + __expf(-x)); }
__device__ __forceinline__ float siluf_(float x) { return x / (1.0f + __expf(-x)); }
__device__ __forceinline__ int tid_() { int t = threadIdx.x; asm volatile("" : "+v"(t)); return t; }
__device__ __forceinline__ int opaque_zero() { int z = 0; asm volatile("" : "+v"(z)); return z; }

__device__ __forceinline__ int orig_col(int n) { return n < 3520 ? n : (n < 3584 ? -1 : (n < 3968 ? n - 64 : -1)); }

__device__ void transpose_tile(const float* W, int ldw, int ncol_src, const float* gain, bf16_t* WT, int K, int n0, int k0, bool permute, float* tile  , const float* fold_v1 = nullptr, const float* fold_mu = nullptr) {
    const int tid = tid_();
#pragma unroll
    for (int i = 0; i < 8; ++i) {
        const int kl = (tid >> 6) + 8 * i, nl = tid & 63;
        const int n = n0 + nl, k = k0 + kl;
        const int oc = permute ? orig_col(n) : n;
        float v = 0.f;
        if (oc >= 0 && oc < ncol_src) v = W[(size_t)k * ldw + oc] * (gain ? gain[k] : 1.0f);
        if (permute && n >= 768 && n < 1152) v *= 0.125f * 1.4426950408889634f;
        if (fold_v1 && n >= 3520 && n < 3584) {
            const int i = (n - 3520) & 31; const bool second = n >= 3552; float a = 0.f;
            for (int c = 0; c < RWW; ++c) { const float m = fold_mu[c]; a += W[(size_t)k * ldw + 3072 + c] * (second ? m : 1.0f - m) * fold_v1[c * LORA + i]; }
            v = a * gain[k];
        }
        tile[kl * 65 + nl] = v;
    }
    __syncthreads();
#pragma unroll
    for (int i = 0; i < 8; ++i) {
        const int nl = (tid >> 6) + 8 * i, kl = tid & 63;
        WT[(size_t)(n0 + nl) * K + k0 + kl] = f2bf(tile[kl * 65 + nl]);
    }
    __syncthreads();
}

__device__ void rows_to_xb(const float* X, bf16_t* XB) {
    const int tid = tid_(), lane = tid & 63, wave = tid >> 6;
    for (int row = blockIdx.x * 8 + wave; row < M; row += gridDim.x * 8) {
        const float* xr = X + (size_t)row * DM;
        f32x4 v[4]; float ss = 0.f;
#pragma unroll
        for (int i = 0; i < 4; ++i) { v[i] = *(const f32x4*)(xr + i * 256 + lane * 4); ss += v[i][0] * v[i][0] + v[i][1] * v[i][1] + v[i][2] * v[i][2] + v[i][3] * v[i][3]; }
        ss = wave_sum(ss);
        const float rstd = rsqrtf(ss * (1.0f / DM) + RMS_EPS);
#pragma unroll
        for (int i = 0; i < 4; ++i) { uint2 w; w.x = pk2(v[i][0] * rstd, v[i][1] * rstd); w.y = pk2(v[i][2] * rstd, v[i][3] * rstd); *(uint2*)(XB + (size_t)row * DM + i * 256 + lane * 4) = w; }
    }
}

__device__ void phase_prologue(const Params& p, unsigned char* lds) {
    float* tile = (float*)lds;
    bf16_t* WinT = (bf16_t*)(p.ws + WS_WIN); bf16_t* WoutT = (bf16_t*)(p.ws + WS_WOUT);
    const int nt_in = (NINT / 64) * (DM / 64), nt_out = (DM / 64) * (DM / 64), nt_pw = (CW / 64) * (CW / 64);
    const int total = DEPTH * (nt_in + nt_out);
    for (int j = blockIdx.x; j < DEPTH * nt_pw; j += gridDim.x) { const int l = j / nt_pw, r = j % nt_pw;
        transpose_tile(p.in[9] + (size_t)l * CW * CW, CW, CW, nullptr, (bf16_t*)(p.ws + WS_WPW) + (size_t)l * CW * CW, CW, (r >> 2) * 64, (r & 3) * 64, false, tile); }
    for (int j = blockIdx.x; j < total; j += gridDim.x) {
        int l = j / (nt_in + nt_out), r = j % (nt_in + nt_out);
        if (r < nt_in) { const int tn = r / (DM / 64), tk = r % (DM / 64);
            transpose_tile(p.in[3] + (size_t)l * DM * DIN, DIN, DIN, p.in[1] + l * DM, WinT + (size_t)l * NINT * DM, DM, tn * 64, tk * 64, true, tile, l > 0 ? p.in[22] : nullptr, p.in[11] + l * 1216 + 768);
        } else { r -= nt_in; const int tn = r / (DM / 64), tk = r % (DM / 64);
            transpose_tile(p.in[4] + (size_t)l * DM * DM, DM, DM, nullptr, WoutT + (size_t)l * DM * DM, DM, tn * 64, tk * 64, false, tile);
        }
    }
    rows_to_xb(p.in[0], (bf16_t*)(p.ws + WS_XB));
}

namespace pg8 {
#define PG8_LAS __attribute__((address_space(3)))
typedef unsigned short bf16_t;
typedef short bf16x8 __attribute__((ext_vector_type(8)));
typedef float f32x4 __attribute__((ext_vector_type(4)));
typedef unsigned u32x4 __attribute__((ext_vector_type(4)));
constexpr int BM = 256, BK = 64, HALF = 128, HTB = HALF * BK * 2  , STAGE_BYTES = 8 * HTB, NXCD = 8, WGM = 8;

__host__ __device__ __forceinline__ int lds_byte(int r, int c) { const int st = (r >> 4) * 2 + (c >> 5), rr = r & 15, cc = c & 31, ob = rr * 64 + cc * 2; return st * 1024 + (ob ^ (((ob >> 9) & 1) << 5)); }
__host__ __device__ __forceinline__ void stage_rc(int b, int& R, int& C) { const int st = b / 1024, sb = b % 1024, swz = sb ^ (((sb >> 9) & 1) << 5); R = (st >> 1) * 16 + swz / 64; C = (st & 1) * 32 + (swz % 64) / 2; }
__host__ __device__ __forceinline__ int perm32(int rho) { const int n = rho >> 4, i = rho & 15; return 8 * (i >> 2) + 4 * n + (i & 3); }

struct Unit { int pm, pn; };
struct Gemm { const bf16_t* A; const bf16_t* Bt; int M, N, K; };

struct StaticOrder {
    int nM, nN, nwg, G, c;
    __host__ __device__ void init(int M, int N, int G_, int c_) { nM = M / BM; nN = N / BM; nwg = nM * nN; G = G_; c = c_; }
    __host__ __device__ bool next(int i, Unit& u) const {
        const long L = (long)i * G + c; if (L >= nwg) return false;
        int wgid = (int)L; { const int q = nwg / NXCD, r = nwg % NXCD, xcd = wgid % NXCD, off = wgid / NXCD; wgid = (xcd < r ? xcd * (q + 1) : r * (q + 1) + (xcd - r) * q) + off; }
        const int nig = WGM * nN, gid = wgid / nig, fm = gid * WGM, gsz = (nM - fm) < WGM ? (nM - fm) : WGM;
        u.pm = fm + ((wgid % nig) % gsz); u.pn = (wgid % nig) / gsz; return true;
    }
    __device__ __forceinline__ void a_ready(const Unit&) const {}
    __device__ __forceinline__ void done(const Unit&) const {}
};


__device__ __forceinline__ unsigned cvt_pk_bf16(float lo, float hi) { unsigned r; asm volatile("v_cvt_pk_bf16_f32 %0, %1, %2" : "=v"(r) : "v"(lo), "v"(hi)); return r; }

template <class Epi, class Sched, bool ALIGN_EPI = false, bool SP2 = false>
__device__ __forceinline__ void gemm_phase(PG8_LAS unsigned char* lds, const Gemm g, const Sched& S, const Epi& E) {
    const int tid = tid_(), wid = __builtin_amdgcn_readfirstlane(tid >> 6), lane = tid & 63, wr = wid >> 2, wc = wid & 3, fr = lane & 15, fq = lane >> 4;
    const int K = g.K, nt = K / BK;
    unsigned voffA[2], voffB[2];
#pragma unroll
    for (int i = 0; i < 2; ++i) { int R, C; stage_rc(tid * 16 + i * 8192, R, C); const int Rb = Epi::PERM ? ((R & ~31) + perm32(R & 31)) : R;
        voffA[i] = (unsigned)(R * K + C) * 2u; voffB[i] = (unsigned)(Rb * K + C) * 2u; }
    const size_t kstep = (size_t)(BK * 2);
    const size_t hstep = (size_t)HALF * K * 2;
    const size_t tstep = 2 * hstep;
    const unsigned ldsw = (unsigned)wid * 1024u;
    const int aoff = lds_byte(wr * 64 + fr, fq * 8), boff = lds_byte(wc * 32 + fr, fq * 8);
#define PG8_SA(b, h) (((b) * 2 + (h)) * HTB)
#define PG8_SB(b, h) ((4 + (b) * 2 + (h)) * HTB)
#define PG8_STAGE(bufoff, gbase, voff) do { _Pragma("unroll") for (int _i = 0; _i < 2; ++_i) \
        __builtin_amdgcn_global_load_lds((const unsigned*)((const char*)(gbase) + (voff)[_i]), (PG8_LAS unsigned*)(lds + (bufoff) + ldsw + _i * 8192), 16, 0, 0); } while (0)
#define PG8_LDA(dst, b, h) do { _Pragma("unroll") for (int m = 0; m < 4; ++m) _Pragma("unroll") for (int k = 0; k < 2; ++k) dst[m][k] = *(const PG8_LAS bf16x8*)(lds + PG8_SA(b, h) + aoff + m * 2048 + k * 1024); } while (0)
#define PG8_LDB(dst, b, h) do { _Pragma("unroll") for (int n = 0; n < 2; ++n) _Pragma("unroll") for (int k = 0; k < 2; ++k) dst[n][k] = *(const PG8_LAS bf16x8*)(lds + PG8_SB(b, h) + boff + n * 2048 + k * 1024); } while (0)
#define PG8_MMA(ai, bj, At, Bt) do { __builtin_amdgcn_s_setprio(1); _Pragma("unroll") for (int m = 0; m < 4; ++m) _Pragma("unroll") for (int n = 0; n < 2; ++n) _Pragma("unroll") for (int k = 0; k < 2; ++k) \
        acc[ai][bj][m][n] = __builtin_amdgcn_mfma_f32_16x16x32_bf16(Bt[n][k], At[m][k], acc[ai][bj][m][n], 0, 0, 0); __builtin_amdgcn_s_setprio(0); } while (0)
#define PG8_WAIT_V(n) asm volatile("s_waitcnt vmcnt(" #n ")" ::: "memory")
#define PG8_WAIT_L(n) asm volatile("s_waitcnt lgkmcnt(" #n ")" ::: "memory")
#define PG8_BAR __builtin_amdgcn_s_barrier()
#define PG8_SCHED __builtin_amdgcn_sched_barrier(0)
    Unit cur, nxt; int ui = 0;
    if (!S.next(0, cur)) return;
    f32x4 acc[2][2][4][2];
#pragma unroll
    for (int a = 0; a < 2; ++a)
#pragma unroll
        for (int b = 0; b < 2; ++b)
#pragma unroll
            for (int m = 0; m < 4; ++m)
#pragma unroll
                for (int n = 0; n < 2; ++n) acc[a][b][m][n] = (f32x4){0.f, 0.f, 0.f, 0.f};
    bf16x8 At[4][2], B0[2][2], B1[2][2];
    const char* cA = (const char*)g.A + (size_t)cur.pm * tstep; const char* cB = (const char*)g.Bt + (size_t)cur.pn * tstep;
    S.a_ready(cur);
    if constexpr (SP2) {
        PG8_STAGE(PG8_SB(0, 0), cB, voffB); PG8_STAGE(PG8_SB(0, 1), cB + hstep, voffB); PG8_STAGE(PG8_SA(0, 0), cA, voffA); PG8_STAGE(PG8_SA(0, 1), cA + hstep, voffA);
        if (wr == 1) PG8_BAR;
        PG8_WAIT_V(2); PG8_BAR;
        PG8_STAGE(PG8_SB(1, 0), cB + kstep, voffB); PG8_STAGE(PG8_SA(1, 0), cA + kstep, voffA); PG8_STAGE(PG8_SB(1, 1), cB + hstep + kstep, voffB);
        PG8_WAIT_V(6); PG8_BAR;
    } else {
        PG8_STAGE(PG8_SB(0, 0), cB, voffB); PG8_STAGE(PG8_SA(0, 0), cA, voffA); PG8_STAGE(PG8_SB(0, 1), cB + hstep, voffB); PG8_STAGE(PG8_SA(0, 1), cA + hstep, voffA);
        if (wr == 1) PG8_BAR;
        PG8_WAIT_V(4); PG8_BAR;
        PG8_STAGE(PG8_SB(1, 0), cB + kstep, voffB); PG8_STAGE(PG8_SA(1, 0), cA + kstep, voffA); PG8_STAGE(PG8_SB(1, 1), cB + hstep + kstep, voffB);
        PG8_WAIT_V(6); PG8_BAR;
    }
    for (;;) {
        const bool has_next = S.next(ui + 1, nxt);
        const char* nA = has_next ? (const char*)g.A + (size_t)nxt.pm * tstep : cA; const char* nB = has_next ? (const char*)g.Bt + (size_t)nxt.pn * tstep : cB;
        for (int t = 0; t < nt; t += 2) {
            const bool last = (t == nt - 2);
            const char* a1 = cA + (size_t)(t + 1) * kstep;
            const char* a2 = last ? nA : cA + (size_t)(t + 2) * kstep; const char* b2 = last ? nB : cB + (size_t)(t + 2) * kstep;
            const char* a3 = a2 + kstep; const char* b3 = b2 + kstep;
            if (last && has_next) S.a_ready(nxt);
            if constexpr (SP2) {
            PG8_LDB(B0, 0, 0); PG8_LDB(B1, 0, 1); PG8_SCHED; PG8_LDA(At, 0, 0); PG8_STAGE(PG8_SA(1, 1), a1 + hstep, voffA);
            PG8_WAIT_V(8); PG8_WAIT_L(0); PG8_BAR; PG8_MMA(0, 0, At, B0); PG8_MMA(0, 1, At, B1); PG8_BAR; PG8_SCHED;
            PG8_LDA(At, 0, 1); PG8_STAGE(PG8_SB(0, 0), b2, voffB); PG8_STAGE(PG8_SB(0, 1), b2 + hstep, voffB); PG8_STAGE(PG8_SA(0, 0), a2, voffA);
            PG8_WAIT_V(8); PG8_WAIT_L(0); PG8_BAR; PG8_MMA(1, 0, At, B0); PG8_MMA(1, 1, At, B1); PG8_BAR; PG8_SCHED;
            PG8_LDB(B0, 1, 0); PG8_LDB(B1, 1, 1); PG8_SCHED; PG8_LDA(At, 1, 0); PG8_STAGE(PG8_SA(0, 1), a2 + hstep, voffA);
            PG8_WAIT_V(8); PG8_WAIT_L(0); PG8_BAR; PG8_MMA(0, 0, At, B0); PG8_MMA(0, 1, At, B1); PG8_BAR; PG8_SCHED;
            PG8_LDA(At, 1, 1); PG8_STAGE(PG8_SB(1, 0), b3, voffB); PG8_STAGE(PG8_SB(1, 1), b3 + hstep, voffB); PG8_STAGE(PG8_SA(1, 0), a3, voffA);
            PG8_WAIT_V(8); PG8_WAIT_L(0); PG8_BAR; PG8_MMA(1, 0, At, B0); PG8_MMA(1, 1, At, B1); PG8_BAR; PG8_SCHED;
            } else {
            PG8_LDB(B0, 0, 0); PG8_SCHED; PG8_LDA(At, 0, 0); PG8_STAGE(PG8_SA(1, 1), a1 + hstep, voffA);
            PG8_WAIT_L(8); PG8_BAR; PG8_WAIT_L(0); PG8_MMA(0, 0, At, B0); PG8_BAR; PG8_SCHED;
            PG8_LDB(B1, 0, 1); PG8_STAGE(PG8_SB(0, 0), b2, voffB);
            PG8_BAR; PG8_WAIT_L(0); PG8_MMA(0, 1, At, B1); PG8_BAR;
            PG8_LDA(At, 0, 1); PG8_STAGE(PG8_SA(0, 0), a2, voffA);
            PG8_BAR; PG8_WAIT_L(0); PG8_MMA(1, 0, At, B0); PG8_BAR; PG8_SCHED;
            PG8_STAGE(PG8_SB(0, 1), b2 + hstep, voffB);
            PG8_WAIT_V(6); PG8_BAR; PG8_MMA(1, 1, At, B1); PG8_BAR;
            PG8_LDB(B0, 1, 0); PG8_SCHED; PG8_LDA(At, 1, 0); PG8_STAGE(PG8_SA(0, 1), a2 + hstep, voffA);
            PG8_WAIT_L(8); PG8_BAR; PG8_WAIT_L(0); PG8_MMA(0, 0, At, B0); PG8_BAR; PG8_SCHED;
            PG8_LDB(B1, 1, 1); PG8_STAGE(PG8_SB(1, 0), b3, voffB);
            PG8_BAR; PG8_WAIT_L(0); PG8_MMA(0, 1, At, B1); PG8_BAR;
            PG8_LDA(At, 1, 1); PG8_STAGE(PG8_SA(1, 0), a3, voffA);
            PG8_BAR; PG8_WAIT_L(0); PG8_MMA(1, 0, At, B0); PG8_BAR; PG8_SCHED;
            PG8_STAGE(PG8_SB(1, 1), b3 + hstep, voffB);
            PG8_WAIT_V(6); PG8_BAR; PG8_MMA(1, 1, At, B1); PG8_BAR;
            }
        }
        if constexpr (ALIGN_EPI) { if (wr == 0) PG8_BAR; }
        if constexpr (!Epi::AFTER_DRAIN) { E(acc, cur, wr, wc, fr, fq); S.done(cur); }
        if (!has_next) break;
#pragma unroll
        for (int a = 0; a < 2; ++a)
#pragma unroll
            for (int b = 0; b < 2; ++b)
#pragma unroll
                for (int m = 0; m < 4; ++m)
#pragma unroll
                    for (int n = 0; n < 2; ++n) acc[a][b][m][n] = (f32x4){0.f, 0.f, 0.f, 0.f};
        cur = nxt; cA = nA; cB = nB; ++ui;
        if constexpr (ALIGN_EPI) { if (wr == 1) PG8_BAR; }
    }
    PG8_WAIT_V(0);
    if constexpr (!ALIGN_EPI) { if (wr == 0) PG8_BAR; }
    PG8_BAR;
    if constexpr (Epi::AFTER_DRAIN) { E.fused(acc, cur, wr, wc, fr, fq, lds, wid, lane); S.done(cur); }
#undef PG8_SA
#undef PG8_SB
#undef PG8_STAGE
#undef PG8_LDA
#undef PG8_LDB
#undef PG8_MMA
#undef PG8_WAIT_V
#undef PG8_WAIT_L
#undef PG8_BAR
#undef PG8_SCHED
}
}

template <class Epi>
__device__ void gemm_simple(const bf16_t* A, const bf16_t* Bt, int Mr, int N, int K, const Epi& epi) {
    const int tid = tid_(), wave = tid >> 6, lane = tid & 63, wm = wave >> 1, wn = wave & 1, fr = lane & 15, fq = lane >> 4;
    const int nNt = N / 128, nMt = Mr / 128;
    for (int tile = blockIdx.x; tile < nNt * nMt; tile += gridDim.x) {
        const int tm = tile / nNt, tn = tile % nNt;
        const int m0 = tm * 128 + wm * 32, n0 = tn * 128 + wn * 64;
        f32x4 acc[2][4];
#pragma unroll
        for (int i = 0; i < 2; ++i)
#pragma unroll
            for (int j = 0; j < 4; ++j) acc[i][j] = (f32x4){0.f, 0.f, 0.f, 0.f};
        const bf16_t* ap = A + (size_t)(m0 + fr) * K + fq * 8;
        const bf16_t* bp = Bt + (size_t)(n0 + fr) * K + fq * 8;
        for (int k = 0; k < K; k += 32) {
            bf16x8 af[2], bfr[4];
#pragma unroll
            for (int i = 0; i < 2; ++i) af[i] = *(const bf16x8*)(ap + (size_t)i * 16 * K + k);
#pragma unroll
            for (int j = 0; j < 4; ++j) bfr[j] = *(const bf16x8*)(bp + (size_t)j * 16 * K + k);
#pragma unroll
            for (int i = 0; i < 2; ++i)
#pragma unroll
                for (int j = 0; j < 4; ++j) acc[i][j] = __builtin_amdgcn_mfma_f32_16x16x32_bf16(bfr[j], af[i], acc[i][j], 0, 0, 0);
        }
#pragma unroll
        for (int i = 0; i < 2; ++i)
#pragma unroll
            for (int j = 0; j < 4; ++j) epi(m0 + i * 16 + fr, n0 + j * 16 + fq * 4, acc[i][j]);
    }
}

struct EpiInProj {
    bf16_t *PC, *PS, *PR, *PG;
    __device__ __forceinline__ void operator()(int m, int n, const f32x4& v) const {
        bf16_t* dst;
        if (n < 768) dst = PC + (size_t)m * PC_W + n;
        else if (n < 2304) dst = PS + (size_t)m * PS_W + (n - 768);
        else if (n < 3584) dst = PR + (size_t)m * PR_W + (n - 2304);
        else if (n < 3968) dst = PG + (size_t)m * PG_W + (n - 3584);
        else return;
        uint2 w; w.x = pk2(v[0], v[1]); w.y = pk2(v[2], v[3]); *(uint2*)dst = w;
    }
};
struct EpiF32 {
    float* Y; int ld;
    __device__ __forceinline__ void operator()(int m, int n, const f32x4& v) const { *(f32x4*)(Y + (size_t)m * ld + n) = v; }
};


struct EpiInProjP {
    static constexpr bool PERM = true, AFTER_DRAIN = false;
    bf16_t *PC, *PS, *PR, *PG, *VT;
    __device__ __forceinline__ void operator()(const pg8::f32x4 (&acc)[2][2][4][2], const pg8::Unit& u, int wr, int wc, int fr, int fq) const {
        const int row0 = u.pm * 256 + wr * 64 + fr;
#pragma unroll
        for (int bj = 0; bj < 2; ++bj) {
            const int blk = 2 * u.pn + bj; bf16_t* base; int ld, c0;
            if (blk >= 12 && blk < 15) {
                const int vc = 128 * (blk - 12) + wc * 32 + 8 * fq;
#pragma unroll
                for (int ai = 0; ai < 2; ++ai)
#pragma unroll
                    for (int m = 0; m < 4; ++m) {
                        const int row = row0 + ai * 128 + m * 16, b = row >> 11, t = row & 2047;
#pragma unroll
                        for (int n = 0; n < 2; ++n)
#pragma unroll
                            for (int e = 0; e < 4; ++e) { const int col = vc + 4 * n + e, hh = col >> 6, d = col & 63;
                                VT[((size_t)(b * NH + hh) * HD + d) * SEQ + t] = f2bf(acc[ai][bj][m][n][e]); }
                    }
                continue;
            }
            if (blk < 6) { base = PC; ld = PC_W; c0 = 128 * blk; }
            else if (blk < 12) { base = PS; ld = PS_W; c0 = 128 * (blk - 6); }
            else if (blk < 18) { base = PS; ld = PS_W; c0 = 768 + 128 * (blk - 15); }
            else if (blk < 28) { base = PR; ld = PR_W; c0 = 128 * (blk - 18); }
            else if (blk < 31) { base = PG; ld = PG_W; c0 = 128 * (blk - 28); }
            else continue;
            const int col = c0 + wc * 32 + 8 * fq;
#pragma unroll
            for (int ai = 0; ai < 2; ++ai)
#pragma unroll
                for (int m = 0; m < 4; ++m) {
                    const pg8::f32x4 v0 = acc[ai][bj][m][0], v1 = acc[ai][bj][m][1]; pg8::u32x4 w;
                    w.x = pg8::cvt_pk_bf16(v0[0], v0[1]); w.y = pg8::cvt_pk_bf16(v0[2], v0[3]); w.z = pg8::cvt_pk_bf16(v1[0], v1[1]); w.w = pg8::cvt_pk_bf16(v1[2], v1[3]);
                    *(pg8::u32x4*)(base + (size_t)(row0 + ai * 128 + m * 16) * ld + col) = w;
                }
        }
    }
};
struct EpiOutF32P {
    static constexpr bool PERM = false, AFTER_DRAIN = false;
    float* Y; int ld;
    __device__ __forceinline__ void operator()(const pg8::f32x4 (&acc)[2][2][4][2], const pg8::Unit& u, int wr, int wc, int fr, int fq) const {
        const int row0 = u.pm * 256 + wr * 64 + fr, col0 = u.pn * 256 + wc * 32 + 4 * fq;
#pragma unroll
        for (int ai = 0; ai < 2; ++ai)
#pragma unroll
            for (int m = 0; m < 4; ++m)
#pragma unroll
                for (int bj = 0; bj < 2; ++bj)
#pragma unroll
                    for (int n = 0; n < 2; ++n) *(pg8::f32x4*)(Y + (size_t)(row0 + ai * 128 + m * 16) * ld + col0 + bj * 128 + n * 16) = acc[ai][bj][m][n];
    }
};

__device__ void phase_rowpass(const float* Xin, const float* Y, const float* gpost, float* Xout, bf16_t* XB) {
    const int tid = tid_(), lane = tid & 63, wave = tid >> 6;
    for (int row = blockIdx.x * 8 + wave; row < M; row += gridDim.x * 8) {
        f32x4 y[4], x[4]; float ss = 0.f;
#pragma unroll
        for (int i = 0; i < 4; ++i) { y[i] = *(const f32x4*)(Y + (size_t)row * DM + i * 256 + lane * 4); x[i] = *(const f32x4*)(Xin + (size_t)row * DM + i * 256 + lane * 4);
            ss += y[i][0] * y[i][0] + y[i][1] * y[i][1] + y[i][2] * y[i][2] + y[i][3] * y[i][3]; }
        ss = wave_sum(ss);
        const float rstd = rsqrtf(ss * (1.0f / DM) + RMS_EPS);
        float s2 = 0.f;
#pragma unroll
        for (int i = 0; i < 4; ++i) { const f32x4 g = *(const f32x4*)(gpost + i * 256 + lane * 4);
            x[i] = x[i] + y[i] * rstd * g; s2 += x[i][0] * x[i][0] + x[i][1] * x[i][1] + x[i][2] * x[i][2] + x[i][3] * x[i][3];
            *(f32x4*)(Xout + (size_t)row * DM + i * 256 + lane * 4) = x[i]; }
        if (XB) {
            s2 = wave_sum(s2);
            const float r2 = rsqrtf(s2 * (1.0f / DM) + RMS_EPS);
#pragma unroll
            for (int i = 0; i < 4; ++i) { uint2 w; w.x = pk2(x[i][0] * r2, x[i][1] * r2); w.y = pk2(x[i][2] * r2, x[i][3] * r2); *(uint2*)(XB + (size_t)row * DM + i * 256 + lane * 4) = w; }
        }
    }
}

__device__ void conv_job(const Params& p, int l, int job, float* lds) {
    const int tid = tid_(), lane = tid & 63, wave = tid >> 6;
    const int b = job / (SEQ / 32), t0 = (job % (SEQ / 32)) * 32;
    const bf16_t* PC = (const bf16_t*)(p.ws + WS_PC); bf16_t* MIX = (bf16_t*)(p.ws + WS_MIX);
    const float* dw = p.in[5] + l * TAPS * CW; const float* dwb = p.in[6] + l * CW; const float* lng = p.in[7] + l * CW; const float* lnb = p.in[8] + l * CW;
    const float* pw = p.in[9] + (size_t)l * CW * CW; const float* pwb = p.in[10] + l * CW;
    float* u = lds;
    float* cv = lds + 62 * 256;
    for (int idx = tid; idx < 62 * 256; idx += 512) {
        const int r = idx >> 8, c = idx & 255, t = t0 - 30 + r;
        float v = 0.f;
        if (t >= 0) { const bf16_t* pr = PC + (size_t)(b * SEQ + t) * PC_W; v = bf2f(pr[c]) * sigmoidf_(bf2f(pr[256 + c])); }
        u[idx] = v;
    }
    __syncthreads();
    for (int idx = tid; idx < 32 * 256; idx += 512) {
        const int tt = idx >> 8, c = idx & 255;
        float a = dwb[c];
#pragma unroll 4
        for (int j = 0; j < TAPS; ++j) a += dw[j * CW + c] * u[(tt + j) * 256 + c];
        cv[idx] = a;
    }
    __syncthreads();
    for (int q = 0; q < 4; ++q) {
        const int tt = wave * 4 + q; float x[4], s = 0.f;
#pragma unroll
        for (int i = 0; i < 4; ++i) { x[i] = cv[tt * 256 + lane + 64 * i]; s += x[i]; }
        const float mean = wave_sum(s) * (1.0f / CW); float vs = 0.f;
#pragma unroll
        for (int i = 0; i < 4; ++i) { const float d = x[i] - mean; vs += d * d; }
        const float rstd = rsqrtf(wave_sum(vs) * (1.0f / CW) + LN_EPS);
#pragma unroll
        for (int i = 0; i < 4; ++i) { const int c = lane + 64 * i; cv[tt * 256 + c] = siluf_((x[i] - mean) * rstd * lng[c] + lnb[c]); }
    }
    __syncthreads();
    {
        const int n = tid & 255, half = tid >> 8;
        float acc[16];
#pragma unroll
        for (int i = 0; i < 16; ++i) acc[i] = pwb[n];
#pragma unroll 2
        for (int k = 0; k < CW; ++k) {
            const float w = pw[(size_t)k * CW + n];
#pragma unroll
            for (int i = 0; i < 16; ++i) acc[i] += cv[(half * 16 + i) * 256 + k] * w;
        }
#pragma unroll
        for (int i = 0; i < 16; ++i) { const size_t row = (size_t)b * SEQ + t0 + half * 16 + i;
            const float g = bf2f(PC[row * PC_W + 512 + n]);
            MIX[row * DM + n] = f2bf(acc[i] * siluf_(g)); }
    }
    __syncthreads();
}

constexpr int CV_AS = 264;
__device__ void conv_job64(const Params& p, int l, int job, unsigned char* lds) {
    const int tid = tid_(), lane = tid & 63, wave = tid >> 6, fr = lane & 15, fq = lane >> 4;
    const int b = job >> 5, t0 = (job & 31) * 64;
    const bf16_t* PC = (const bf16_t*)(p.ws + WS_PC); bf16_t* MIX = (bf16_t*)(p.ws + WS_MIX);
    const float* dw = p.in[5] + l * TAPS * CW; const float* dwb = p.in[6] + l * CW; const float* lng = p.in[7] + l * CW; const float* lnb = p.in[8] + l * CW;
    const bf16_t* pwT = (const bf16_t*)(p.ws + WS_WPW) + (size_t)l * CW * CW; const float* pwb = p.in[10] + l * CW;
    float* u = (float*)lds;
    bf16_t* act = (bf16_t*)(lds + 94 * 256 * 4);
    for (int idx = tid; idx < 94 * 32; idx += 512) {
        const int r = idx >> 5, c8 = (idx & 31) * 8, t = t0 - 30 + r;
        float v[8];
        if (t >= 0) { const bf16_t* pr = PC + ((size_t)b * SEQ + t) * PC_W + c8; const bf16x8 a = *(const bf16x8*)pr, g = *(const bf16x8*)(pr + 256);
#pragma unroll
            for (int e = 0; e < 8; ++e) v[e] = bf2f((bf16_t)a[e]) * __builtin_amdgcn_rcpf(1.0f + __builtin_amdgcn_exp2f(-1.4426950408889634f * bf2f((bf16_t)g[e]))); }
        else {
#pragma unroll
            for (int e = 0; e < 8; ++e) v[e] = 0.f; }
        *(f32x4*)(u + r * 256 + c8) = (f32x4){v[0], v[1], v[2], v[3]}; *(f32x4*)(u + r * 256 + c8 + 4) = (f32x4){v[4], v[5], v[6], v[7]};
    }
    __syncthreads();
    const int c = tid & 255, half = tid >> 8;
    float acc[32];
    {
        float w[TAPS];
#pragma unroll
        for (int j = 0; j < TAPS; ++j) w[j] = dw[j * CW + c];
        const float bias = dwb[c];
#pragma unroll
        for (int i = 0; i < 32; ++i) acc[i] = bias;
        const float* up = u + (half * 32) * 256 + c;
#pragma unroll
        for (int rr = 0; rr < 62; ++rr) {
            const float uv = up[rr * 256];
#pragma unroll
            for (int i = 0; i < 32; ++i) { if (rr - i >= 0 && rr - i < TAPS) acc[i] += w[rr - i] * uv; }
        }
    }
    __syncthreads();
    float* cv = u;
#pragma unroll
    for (int i = 0; i < 32; ++i) cv[(half * 32 + i) * 256 + c] = acc[i];
    __syncthreads();
#pragma unroll 2
    for (int q = 0; q < 8; ++q) {
        const int tt = wave * 8 + q; const f32x4 x = *(const f32x4*)(cv + tt * 256 + lane * 4);
        const float mean = wave_sum(x[0] + x[1] + x[2] + x[3]) * (1.0f / CW);
        const f32x4 d = x - mean;
        const float rstd = rsqrtf(wave_sum(d[0] * d[0] + d[1] * d[1] + d[2] * d[2] + d[3] * d[3]) * (1.0f / CW) + LN_EPS);
        const f32x4 g = *(const f32x4*)(lng + lane * 4), bb = *(const f32x4*)(lnb + lane * 4);
        float y[4];
#pragma unroll
        for (int e = 0; e < 4; ++e) { const float v = d[e] * rstd * g[e] + bb[e]; y[e] = v * __builtin_amdgcn_rcpf(1.0f + __builtin_amdgcn_exp2f(-1.4426950408889634f * v)); }
        uint2 w; w.x = pk2(y[0], y[1]); w.y = pk2(y[2], y[3]); *(uint2*)(act + tt * CV_AS + lane * 4) = w;
    }
    __syncthreads();
    {
        f32x4 o[2][4];
#pragma unroll
        for (int i = 0; i < 2; ++i)
#pragma unroll
            for (int j = 0; j < 4; ++j) o[i][j] = (f32x4){0.f, 0.f, 0.f, 0.f};
#pragma unroll 2
        for (int kk = 0; kk < 8; ++kk) {
            bf16x8 a[2], bq[4];
#pragma unroll
            for (int i = 0; i < 2; ++i) a[i] = *(const bf16x8*)(pwT + (size_t)(wave * 32 + i * 16 + fr) * CW + kk * 32 + fq * 8);
#pragma unroll
            for (int j = 0; j < 4; ++j) bq[j] = *(const bf16x8*)(act + (j * 16 + fr) * CV_AS + kk * 32 + fq * 8);
#pragma unroll
            for (int i = 0; i < 2; ++i)
#pragma unroll
                for (int j = 0; j < 4; ++j) o[i][j] = __builtin_amdgcn_mfma_f32_16x16x32_bf16(a[i], bq[j], o[i][j], 0, 0, 0);
        }
#pragma unroll
        for (int i = 0; i < 2; ++i) {
            const int n0 = wave * 32 + i * 16 + fq * 4; const f32x4 bias = *(const f32x4*)(pwb + n0);
#pragma unroll
            for (int j = 0; j < 4; ++j) {
                const size_t row = (size_t)b * SEQ + t0 + j * 16 + fr;
                const uint2 gw = *(const uint2*)(PC + row * PC_W + 512 + n0);
                const float g0 = bf2f((bf16_t)(gw.x & 0xffff)), g1 = bf2f((bf16_t)(gw.x >> 16)), g2 = bf2f((bf16_t)(gw.y & 0xffff)), g3 = bf2f((bf16_t)(gw.y >> 16));
                const f32x4 v = o[i][j] + bias;
                uint2 w; w.x = pk2(v[0] * siluf_(g0), v[1] * siluf_(g1)); w.y = pk2(v[2] * siluf_(g2), v[3] * siluf_(g3));
                *(uint2*)(MIX + row * DM + n0) = w;
            }
        }
    }
    __syncthreads();
}

__device__ void attn_job(const Params& p, int job) {
    const int tid = tid_(), lane = tid & 63, wave = tid >> 6;
    const int bh = job >> 2, qb = job & 3, b = bh / NH, h = bh % NH;
    const bf16_t* PS = (const bf16_t*)(p.ws + WS_PS); bf16_t* MIX = (bf16_t*)(p.ws + WS_MIX);
    const int tw = qb * 512 + wave * 64, t = tw + lane;
    const size_t row = (size_t)b * SEQ + t;
    const float qs = 1.0f;
    const bf16_t* VT = (const bf16_t*)(p.ws + WS_VT) + (size_t)bh * HD * SEQ;
    float q[64], o[64];
    {
        const bf16_t* qp = PS + row * PS_W + h * HD;
#pragma unroll
        for (int i = 0; i < 8; ++i) { const bf16x8 v = *(const bf16x8*)(qp + i * 8);
#pragma unroll
            for (int j = 0; j < 8; ++j) { q[i * 8 + j] = bf2f((bf16_t)v[j]) * qs; o[i * 8 + j] = 0.f; } }
    }
    float rp = 1.0f;
    const int z = opaque_zero();
    for (int s = tw + 62; s >= 0; --s) {
        const bf16_t* kp = PS + ((size_t)b * SEQ + s) * PS_W + 384 + h * HD + z;
        float dot = 0.f;
#pragma unroll
        for (int i = 0; i < 8; ++i) { const bf16x8 v = *(const bf16x8*)(kp + i * 8);
#pragma unroll
            for (int j = 0; j < 8; ++j) dot += q[i * 8 + j] * bf2f((bf16_t)v[j]); }
        const bool act = s < t;
        const float e = __builtin_amdgcn_exp2f(dot);
        const float keep = __builtin_amdgcn_rcpf(1.0f + e);
        const float pr = act ? (1.0f - keep) * rp : 0.f;
        rp = act ? rp * keep : rp;
#pragma unroll
        for (int d = 0; d < 64; ++d) o[d] += pr * bf2f(VT[(size_t)d * SEQ + s + z]);
        if (__all(rp == 0.0f)) break;
    }
    const bf16_t* gp = PS + row * PS_W + 768 + h * HD;
    bf16_t* op = MIX + row * DM + CW + h * HD;
#pragma unroll
    for (int i = 0; i < 8; ++i) { const bf16x8 g = *(const bf16x8*)(gp + i * 8); uint4 w;
        w.x = pk2(o[i * 8 + 0] * siluf_(bf2f((bf16_t)g[0])), o[i * 8 + 1] * siluf_(bf2f((bf16_t)g[1])));
        w.y = pk2(o[i * 8 + 2] * siluf_(bf2f((bf16_t)g[2])), o[i * 8 + 3] * siluf_(bf2f((bf16_t)g[3])));
        w.z = pk2(o[i * 8 + 4] * siluf_(bf2f((bf16_t)g[4])), o[i * 8 + 5] * siluf_(bf2f((bf16_t)g[5])));
        w.w = pk2(o[i * 8 + 6] * siluf_(bf2f((bf16_t)g[6])), o[i * 8 + 7] * siluf_(bf2f((bf16_t)g[7])));
        *(uint4*)(op + i * 8) = w; }
}

typedef float f32x16 __attribute__((ext_vector_type(16)));
__device__ void attn_mfma_wave(const Params& p, int bh, int qblk) {
    const int tid = tid_(), lane = tid & 63, qi = lane & 31, hf = lane >> 5;
    const int b = bh / NH, h = bh % NH, q0 = qblk * 32;
    const bf16_t* PS = (const bf16_t*)(p.ws + WS_PS); const bf16_t* VT = (const bf16_t*)(p.ws + WS_VT) + (size_t)bh * HD * SEQ; bf16_t* MIX = (bf16_t*)(p.ws + WS_MIX);
    const size_t rowq = (size_t)b * SEQ + q0 + qi;
    bf16x8 Qf[4];
#pragma unroll
    for (int ks = 0; ks < 4; ++ks) Qf[ks] = *(const bf16x8*)(PS + rowq * PS_W + h * HD + ks * 16 + hf * 8);
    const int pi = (qi & 3) + 4 * (qi >> 3) + 16 * ((qi >> 2) & 1);
    const bf16_t* kbase = PS + ((size_t)b * SEQ + pi) * PS_W + SBW + h * HD + hf * 8;
    const bf16_t* vbase = VT + (size_t)qi * SEQ + hf * 16;
    f32x16 O0, O1;
#pragma unroll
    for (int r = 0; r < 16; ++r) { O0[r] = 0.f; O1[r] = 0.f; }
    float rp = 1.0f;
    for (int kt = qblk; kt >= 0; --kt) {
        const int s0 = kt * 32;
        bf16x8 Kf[4], Vf[2][2];
#pragma unroll
        for (int ks = 0; ks < 4; ++ks) Kf[ks] = *(const bf16x8*)(kbase + (size_t)s0 * PS_W + ks * 16);
#pragma unroll
        for (int db = 0; db < 2; ++db)
#pragma unroll
            for (int s = 0; s < 2; ++s) Vf[db][s] = *(const bf16x8*)(vbase + (size_t)db * 32 * SEQ + s0 + s * 8);
        f32x16 S;
#pragma unroll
        for (int r = 0; r < 16; ++r) S[r] = 0.f;
#pragma unroll
        for (int ks = 0; ks < 4; ++ks) S = __builtin_amdgcn_mfma_f32_32x32x16_bf16(Kf[ks], Qf[ks], S, 0, 0, 0);
        float keep[16], beta[16];
        const bool diag = kt == qblk;
        float tot = 1.0f;
#pragma unroll
        for (int r = 0; r < 16; ++r) {
            const float e = __builtin_amdgcn_exp2f(S[r]);
            float k_ = __builtin_amdgcn_rcpf(1.0f + e);
            float b_ = 1.0f - k_;
            if (diag && (hf * 16 + r >= qi)) { k_ = 1.0f; b_ = 0.f; }
            keep[r] = k_; beta[r] = b_; tot *= k_;
        }
        const float toto = __shfl_xor(tot, 32);
        float e = hf ? rp : rp * toto;
        float pw[16];
#pragma unroll
        for (int r = 15; r >= 0; --r) { pw[r] = beta[r] * e; e *= keep[r]; }
        rp = rp * tot * toto;
        bf16x8 Pf[2];
#pragma unroll
        for (int s = 0; s < 2; ++s) {
            union { bf16x8 v; unsigned u[4]; } pk;
#pragma unroll
            for (int j = 0; j < 4; ++j) pk.u[j] = pk2(pw[8 * s + 2 * j], pw[8 * s + 2 * j + 1]);
            Pf[s] = pk.v;
        }
#pragma unroll
        for (int s = 0; s < 2; ++s) { O0 = __builtin_amdgcn_mfma_f32_32x32x16_bf16(Vf[0][s], Pf[s], O0, 0, 0, 0); O1 = __builtin_amdgcn_mfma_f32_32x32x16_bf16(Vf[1][s], Pf[s], O1, 0, 0, 0); }
        if (__ballot(rp != 0.0f) == 0ull) break;
    }
    const bf16_t* gp = PS + rowq * PS_W + 768 + h * HD; bf16_t* op = MIX + rowq * DM + CW + h * HD;
#pragma unroll
    for (int db = 0; db < 2; ++db)
#pragma unroll
        for (int g = 0; g < 4; ++g) {
            const int d0 = db * 32 + g * 8 + hf * 4;
            const uint2 gw = *(const uint2*)(gp + d0);
            const float g0 = bf2f((bf16_t)(gw.x & 0xffff)), g1 = bf2f((bf16_t)(gw.x >> 16)), g2 = bf2f((bf16_t)(gw.y & 0xffff)), g3 = bf2f((bf16_t)(gw.y >> 16));
            const f32x16& O = db ? O1 : O0;
            uint2 w; w.x = pk2(O[4 * g] * siluf_(g0), O[4 * g + 1] * siluf_(g1)); w.y = pk2(O[4 * g + 2] * siluf_(g2), O[4 * g + 3] * siluf_(g3));
            *(uint2*)(op + d0) = w;
        }
}

__device__ void rwkv_job(const Params& p, int l, int job, float* lds) {
    const int tid = tid_(), lane = tid & 63, wave = tid >> 6;
    const int b = job / NH, h = job % NH;
    const bf16_t* PR = (const bf16_t*)(p.ws + WS_PR); const bf16_t* PG = (const bf16_t*)(p.ws + WS_PG);
    float* VF = (float*)(p.ws + WS_VF); bf16_t* MIX = (bf16_t*)(p.ws + WS_MIX);
    const float* mu = p.in[11] + l * 1216; const float* w0 = p.in[12] + l * RWW; const float* w2 = p.in[13] + l * LORA * RWW;
    const float* a0 = p.in[14] + l * RWW; const float* a2 = p.in[15] + l * LORA * RWW; const float* kks = p.in[16] + l * RWW; const float* ka = p.in[17] + l * RWW;
    const float* rk = p.in[18] + l * RWW; const float* gng = p.in[19] + l * RWW; const float* gnb = p.in[20] + l * RWW;
    const float* v0 = p.in[21]; const float* v1 = p.in[22]; const float* v2 = p.in[23];
    float* R = lds; float* W = R + 4096; float* K = W + 4096; float* V = K + 4096; float* A = V + 4096; float* Bm = A + 4096; float* Y = Bm + 4096;
    float* WD = Y + 4096; float* AD = WD + 2048; float* VL = AD + 2048;
    float S[64];
#pragma unroll
    for (int i = 0; i < 64; ++i) S[i] = 0.f;
    for (int c = 0; c < SEQ / 64; ++c) {
        const int t0 = c * 64;
        for (int idx = tid; idx < 64 * 64; idx += 512) {
            const int tt = idx >> 6, i = idx & 63, t = t0 + tt;
            const bf16_t* cur = PR + ((size_t)b * SEQ + t) * PR_W;
            const float xc = bf2f(cur[1152 + i]), xp = t > 0 ? bf2f(cur[1152 + i - PR_W]) : 0.f;
            const float f = xc + (xp - xc) * mu[1152 + i];
            if (i < 32) WD[tt * 32 + i] = tanhf(f); else AD[tt * 32 + i - 32] = f;
        }
        if (l > 0) {
            for (int idx = tid; idx < 64 * 32; idx += 512) {
                const int tt = idx >> 5, i = idx & 31, t = t0 + tt;
                const bf16_t* cur = PR + ((size_t)b * SEQ + t) * PR_W + 768;
                float a = 0.f;
                for (int cc = 0; cc < RWW; ++cc) {
                    const float xc = bf2f(cur[cc]), xp = t > 0 ? bf2f(cur[cc - PR_W]) : 0.f;
                    a += (xc + (xp - xc) * mu[768 + cc]) * v1[cc * LORA + i];
                }
                VL[idx] = a;
            }
        }
        __syncthreads();
        for (int idx = tid; idx < 64 * 64; idx += 512) {
            const int tt = idx >> 6, j = idx & 63, t = t0 + tt, cj = h * HD + j;
            const size_t row = (size_t)b * SEQ + t;
            const bf16_t* cur = PR + row * PR_W;
            const bool hp = t > 0;
            float rc = bf2f(cur[cj]), kc = bf2f(cur[384 + cj]), vc = bf2f(cur[768 + cj]);
            const float rp_ = hp ? bf2f(cur[cj - PR_W]) : 0.f, kp_ = hp ? bf2f(cur[384 + cj - PR_W]) : 0.f, vp_ = hp ? bf2f(cur[768 + cj - PR_W]) : 0.f;
            rc += (rp_ - rc) * mu[cj]; kc += (kp_ - kc) * mu[384 + cj]; vc += (vp_ - vc) * mu[768 + cj];
            float wl = w0[cj], al = a0[cj];
#pragma unroll 8
            for (int i = 0; i < LORA; ++i) { wl += WD[tt * 32 + i] * w2[i * RWW + cj]; al += AD[tt * 32 + i] * a2[i * RWW + cj]; }
            const float sp = fmaxf(-wl, 0.f) + log1pf(__expf(-fabsf(wl)));
            const float decay = __expf(-__expf(-sp - 0.5f));
            const float alr = sigmoidf_(al);
            if (l > 0) {
                float vg = v0[cj];
#pragma unroll 8
                for (int i = 0; i < LORA; ++i) vg += VL[tt * 32 + i] * v2[i * RWW + cj];
                vg = sigmoidf_(vg);
                vc = vc + (VF[row * RWW + cj] - vc) * vg;
            } else VF[row * RWW + cj] = vc;
            R[idx] = rc; W[idx] = decay; V[idx] = vc;
            K[idx] = kc * (1.0f + (alr - 1.0f) * ka[cj]);
            A[idx] = kc * kks[cj];
            Bm[idx] = alr;
        }
        __syncthreads();
        for (int q = 0; q < 8; ++q) {
            const int tt = wave * 8 + q; const float kk = A[tt * 64 + lane];
            const float nrm = sqrtf(wave_sum(kk * kk));
            const float kn = kk / fmaxf(nrm, 1e-12f);
            A[tt * 64 + lane] = -kn; Bm[tt * 64 + lane] = kn * Bm[tt * 64 + lane];
        }
        __syncthreads();
        if (wave == 0) {
            for (int tt = 0; tt < 64; ++tt) {
                const f32x4* a4 = (const f32x4*)(A + tt * 64); const f32x4* w4 = (const f32x4*)(W + tt * 64); const f32x4* b4 = (const f32x4*)(Bm + tt * 64);
                const f32x4* k4 = (const f32x4*)(K + tt * 64); const f32x4* r4 = (const f32x4*)(R + tt * 64);
                float sa = 0.f;
#pragma unroll
                for (int i = 0; i < 16; ++i) { const f32x4 a = a4[i]; sa += S[4 * i] * a[0] + S[4 * i + 1] * a[1] + S[4 * i + 2] * a[2] + S[4 * i + 3] * a[3];
                    if ((i & 7) == 7) asm volatile("" ::: "memory"); }
                const float vv = V[tt * 64 + lane];
                float y = 0.f;
#pragma unroll
                for (int i = 0; i < 16; ++i) { const f32x4 w = w4[i], bb = b4[i], kk = k4[i], rr = r4[i];
#pragma unroll
                    for (int e = 0; e < 4; ++e) { const float s = S[4 * i + e] * w[e] + sa * bb[e] + vv * kk[e]; S[4 * i + e] = s; y += s * rr[e]; }
                    if ((i & 1) == 1) asm volatile("" ::: "memory"); }
                Y[tt * 64 + lane] = y;
            }
        }
        __syncthreads();
        for (int q = 0; q < 8; ++q) {
            const int tt = wave * 8 + q, t = t0 + tt, cj = h * HD + lane; const size_t row = (size_t)b * SEQ + t;
            const float y = Y[tt * 64 + lane];
            const float mean = wave_sum(y) * (1.0f / HD); const float d = y - mean;
            const float var = wave_sum(d * d) * (1.0f / HD);
            const float yn = d * rsqrtf(var + GN_EPS) * gng[cj] + gnb[cj];
            const float bonus = wave_sum(R[tt * 64 + lane] * K[tt * 64 + lane] * rk[cj]);
            const float o = yn + bonus * V[tt * 64 + lane];
            const float g = bf2f(PG[row * PG_W + cj]);
            MIX[row * DM + CW + SBW + cj] = f2bf(o * siluf_(g));
        }
        __syncthreads();
    }
}

constexpr int TS = 72;
constexpr int TILE_B = 64 * TS * 2;
constexpr int AABS = 68, XTS = 65, CSS = 65;

__device__ __forceinline__ f32x4 mm_tile(const bf16_t* X, int m0, const bf16_t* Yt, int n0, int K, int fr, int fq, f32x4 acc) {
#pragma unroll
    for (int kk = 0; kk < 2; ++kk) {
        if (kk * 32 < K) {
            const bf16x8 a = *(const bf16x8*)(X + (m0 + fr) * TS + kk * 32 + fq * 8);
            const bf16x8 b = *(const bf16x8*)(Yt + (n0 + fr) * TS + kk * 32 + fq * 8);
            acc = __builtin_amdgcn_mfma_f32_16x16x32_bf16(a, b, acc, 0, 0, 0);
        }
    }
    return acc;
}
__device__ __forceinline__ uint2 pk4(const f32x4& v) { uint2 w; w.x = pk2(v[0], v[1]); w.y = pk2(v[2], v[3]); return w; }

__device__ void rwkv_b1_job(const Params& p, int l, int jb, unsigned char* lds) {
    const int tid = tid_(), lane = tid & 63, wave = tid >> 6, fr = lane & 15, fq = lane >> 4;
    const int bh = jb >> 5, c = jb & 31, b = bh / NH, h = bh % NH, t0 = c * 64;
    const bf16_t* PR = (const bf16_t*)(p.ws + WS_PR); float* VF = (float*)(p.ws + WS_VF);
    const float* mu = p.in[11] + l * 1216; const float* w0 = p.in[12] + l * RWW; const float* w2 = p.in[13] + l * LORA * RWW;
    const float* a0 = p.in[14] + l * RWW; const float* a2 = p.in[15] + l * LORA * RWW; const float* kks = p.in[16] + l * RWW; const float* ka = p.in[17] + l * RWW;
    const float* rk = p.in[18] + l * RWW; const float* v0 = p.in[21]; const float* v2 = p.in[23];
    bf16_t* T_At = (bf16_t*)lds; bf16_t* T_Rt = T_At + 64 * TS; bf16_t* T_Bt = T_Rt + 64 * TS; bf16_t* T_Kt = T_Bt + 64 * TS;
    bf16_t* T_VT = T_Kt + 64 * TS; bf16_t* T_bhT = T_VT + 64 * TS; bf16_t* T_khT = T_bhT + 64 * TS;
    bf16_t* T_Aak = T_khT + 64 * TS; bf16_t* T_Arb = T_Aak + 64 * TS; bf16_t* T_Ark = T_Arb + 64 * TS;
    bf16_t* T_WT = T_At; bf16_t* T_U0T = T_Bt;
    float* Aab = (float*)(lds + 10 * TILE_B);
    float* XT = (float*)(lds + 10 * TILE_B + 64 * AABS * 4);
    float* PCv = XT + 128 * XTS;
    float* CS = (float*)T_Aak;
    constexpr int LS = 33;
    float* WD = Aab; float* AD = WD + 64 * LS;
    float* VL = XT + 64 * XTS;
    float* WLT = (float*)lds; float* ALT = WLT + 64 * XTS; float* VGT = ALT + 64 * XTS;
    float* TI = PCv + 64;

    float rr[8], kk_[8], vv[8], aa[8], bb[8], lw[8];
    const int tt = tid >> 3, j0 = (tid & 7) * 8, t = t0 + tt, cj0 = h * HD + j0;
    const size_t row = (size_t)b * SEQ + t;
    for (int repA = 0; repA < ((PROBE_REP & 128) ? 2 : 1); ++repA) {
    for (int idx = tid; idx < 2048; idx += 512) {
        const int tt = idx >> 5, i = idx & 31, t = t0 + tt;
        const bf16_t* cur = PR + ((size_t)b * SEQ + t) * PR_W; const bool hp = t > 0;
        { const float xc = bf2f(cur[1152 + i]), xp = hp ? bf2f(cur[1152 + i - PR_W]) : 0.f; { const float x_ = xc + (xp - xc) * mu[1152 + i]; WD[tt * LS + i] = 1.0f - 2.0f * __builtin_amdgcn_rcpf(1.0f + __builtin_amdgcn_exp2f(2.8853900817779268f * x_)); } }
        { const float xc = bf2f(cur[1184 + i]), xp = hp ? bf2f(cur[1184 + i - PR_W]) : 0.f; AD[tt * LS + i] = xc + (xp - xc) * mu[1184 + i]; }
        if (l > 0) VL[tt * LS + i] = bf2f(cur[1216 + i]) + (hp ? bf2f(cur[1248 + i - PR_W]) : 0.f);
    }
    __syncthreads();
    {
        const int ntile = (l > 0 ? 3 : 2) * 16;
#pragma unroll 1
        for (int id = wave; id < ntile; id += 8) {
            const int L = id >> 4, ti = (id >> 2) & 3, tj = id & 3;
            const float* Xs = (L == 0 ? WD : (L == 1 ? AD : VL)) + (ti * 16 + fr) * LS + fq;
            const float* Wg = (L == 0 ? w2 : (L == 1 ? a2 : v2)) + (size_t)fq * RWW + h * HD + tj * 16 + fr;
            f32x4 acc = (f32x4){0.f, 0.f, 0.f, 0.f};
#pragma unroll
            for (int kk = 0; kk < 8; ++kk) acc = __builtin_amdgcn_mfma_f32_16x16x4f32(Xs[kk * 4], Wg[(size_t)kk * 4 * RWW], acc, 0, 0, 0);
            float* out = (L == 0 ? WLT : (L == 1 ? ALT : VGT)) + (tj * 16 + fr) * XTS + ti * 16 + fq * 4;
#pragma unroll
            for (int r = 0; r < 4; ++r) out[r] = acc[r];
        }
    }
    __syncthreads();
    {
        const bf16_t* cur = PR + row * PR_W; const bool hp = t > 0;
        const bf16x8 rc = *(const bf16x8*)(cur + cj0), kc = *(const bf16x8*)(cur + 384 + cj0), vc = *(const bf16x8*)(cur + 768 + cj0);
        bf16x8 rp = rc, kp = kc, vp = vc;
        if (hp) { rp = *(const bf16x8*)(cur + cj0 - PR_W); kp = *(const bf16x8*)(cur + 384 + cj0 - PR_W); vp = *(const bf16x8*)(cur + 768 + cj0 - PR_W); }
        float wl[8], al[8], vg[8];
#pragma unroll
        for (int e = 0; e < 8; ++e) {
            const float r_c = bf2f((bf16_t)rc[e]), k_c = bf2f((bf16_t)kc[e]), v_c = bf2f((bf16_t)vc[e]);
            const float r_p = hp ? bf2f((bf16_t)rp[e]) : 0.f, k_p = hp ? bf2f((bf16_t)kp[e]) : 0.f, v_p = hp ? bf2f((bf16_t)vp[e]) : 0.f;
            rr[e] = r_c + (r_p - r_c) * mu[cj0 + e]; kk_[e] = k_c + (k_p - k_c) * mu[384 + cj0 + e]; vv[e] = v_c + (v_p - v_c) * mu[768 + cj0 + e];
            wl[e] = w0[cj0 + e] + WLT[(j0 + e) * XTS + tt]; al[e] = a0[cj0 + e] + ALT[(j0 + e) * XTS + tt]; vg[e] = l > 0 ? v0[cj0 + e] + VGT[(j0 + e) * XTS + tt] : 0.f;
        }
        float ssq = 0.f, bon = 0.f;
#pragma unroll
        for (int e = 0; e < 8; ++e) {
            const float sp2 = fmaxf(-wl[e], 0.f) * 1.4426950408889634f + __builtin_amdgcn_logf(1.0f + __builtin_amdgcn_exp2f(-1.4426950408889634f * fabsf(wl[e])));
            lw[e] = -__builtin_amdgcn_exp2f(-sp2 - 0.7213475204444817f);
            const float alr = __builtin_amdgcn_rcpf(1.0f + __builtin_amdgcn_exp2f(-1.4426950408889634f * al[e]));
            if (l > 0) vv[e] = vv[e] + (VF[row * RWW + cj0 + e] - vv[e]) * __builtin_amdgcn_rcpf(1.0f + __builtin_amdgcn_exp2f(-1.4426950408889634f * vg[e])); else VF[row * RWW + cj0 + e] = vv[e];
            const float kkr = kk_[e] * kks[cj0 + e];
            kk_[e] = kk_[e] * (1.0f + (alr - 1.0f) * ka[cj0 + e]);
            aa[e] = kkr; bb[e] = alr; ssq += kkr * kkr; bon += rr[e] * kk_[e] * rk[cj0 + e];
        }
        ssq += __shfl_xor(ssq, 1); ssq += __shfl_xor(ssq, 2); ssq += __shfl_xor(ssq, 4);
        bon += __shfl_xor(bon, 1); bon += __shfl_xor(bon, 2); bon += __shfl_xor(bon, 4);
        const float inv = fminf(__builtin_amdgcn_rsqf(ssq), 1e12f);
        uint4 bvw; float bv[8];
#pragma unroll
        for (int e = 0; e < 8; ++e) { const float kn = aa[e] * inv; aa[e] = -kn; bb[e] = kn * bb[e]; bv[e] = bon * vv[e]; CS[tt * CSS + j0 + e] = lw[e]; }
        bvw.x = pk2(bv[0], bv[1]); bvw.y = pk2(bv[2], bv[3]); bvw.z = pk2(bv[4], bv[5]); bvw.w = pk2(bv[6], bv[7]);
        *(uint4*)((bf16_t*)(p.ws + WS_CH_BV) + (size_t)jb * 4096 + tt * 64 + j0) = bvw;
    }
    __syncthreads();
#pragma unroll
    for (int e = 0; e < 8; ++e) {
        const int j = wave * 8 + e; float x = CS[lane * CSS + j];
#pragma unroll
        for (int o = 1; o < 64; o <<= 1) { const float y = __shfl_up(x, o); if (lane >= o) x += y; }
        CS[lane * CSS + j] = x;
    }
    __syncthreads();
    }
    float at[8];
    for (int repB = 0; repB < ((PROBE_REP & 256) ? 2 : 1); ++repB) {
    {
        float rt[8], bt[8], kt[8];
#pragma unroll
        for (int e = 0; e < 8; ++e) {
            const int j = j0 + e; const float cs = CS[tt * CSS + j], csC = CS[63 * CSS + j];
            const float e_in = __expf(cs), e_ex = __expf(cs - lw[e]), e_ng = __expf(-cs), e_ht = __expf(csC - cs);
            at[e] = aa[e] * e_ex; rt[e] = rr[e] * e_in; bt[e] = bb[e] * e_ng; kt[e] = kk_[e] * e_ng;
            T_VT[j * TS + tt] = f2bf(vv[e]); T_bhT[j * TS + tt] = f2bf(bb[e] * e_ht); T_khT[j * TS + tt] = f2bf(kk_[e] * e_ht);
            XT[j * XTS + tt] = at[e];
            if (tt == 63) PCv[j] = __expf(csC);
        }
        uint4 w;
        w.x = pk2(at[0], at[1]); w.y = pk2(at[2], at[3]); w.z = pk2(at[4], at[5]); w.w = pk2(at[6], at[7]); *(uint4*)(T_At + tt * TS + j0) = w;
        w.x = pk2(rt[0], rt[1]); w.y = pk2(rt[2], rt[3]); w.z = pk2(rt[4], rt[5]); w.w = pk2(rt[6], rt[7]); *(uint4*)(T_Rt + tt * TS + j0) = w;
        w.x = pk2(bt[0], bt[1]); w.y = pk2(bt[2], bt[3]); w.z = pk2(bt[4], bt[5]); w.w = pk2(bt[6], bt[7]); *(uint4*)(T_Bt + tt * TS + j0) = w;
        w.x = pk2(kt[0], kt[1]); w.y = pk2(kt[2], kt[3]); w.z = pk2(kt[4], kt[5]); w.w = pk2(kt[6], kt[7]); *(uint4*)(T_Kt + tt * TS + j0) = w;
    }
    __syncthreads();
    }
    for (int repD = 0; repD < ((PROBE_REP & 1024) ? 2 : 1); ++repD) {
    if (repD) { for (int e = 0; e < 8; ++e) XT[(j0 + e) * XTS + tt] = at[e]; __syncthreads(); }
    for (int repC = 0; repC < ((PROBE_REP & 512) ? 2 : 1); ++repC) {
#pragma unroll 1
    for (int q = 0; q < 8; ++q) {
        const int id = wave * 8 + q, mat = id >> 4, ti = (id >> 2) & 3, tj = id & 3;
        const bf16_t* As = (mat == 0 || mat == 2) ? T_Bt : T_Kt; const bf16_t* Bs = (mat < 2) ? T_At : T_Rt;
        f32x4 acc = (f32x4){0.f, 0.f, 0.f, 0.f};
        if (ti <= tj) acc = mm_tile(As, ti * 16, Bs, tj * 16, 64, fr, fq, acc);
        const int tcol = tj * 16 + fr, i0 = ti * 16 + fq * 4;
#pragma unroll
        for (int r = 0; r < 4; ++r) { const bool keep = (mat < 2) ? (i0 + r < tcol) : (i0 + r <= tcol); if (!keep) acc[r] = 0.f; }
        if (mat == 0) *(f32x4*)(Aab + tcol * AABS + i0) = acc;
        else { bf16_t* dst = (mat == 1 ? T_Aak : (mat == 2 ? T_Arb : T_Ark)); *(uint2*)(dst + tcol * TS + i0) = pk4(acc); }
    }
    __syncthreads();
    if (wave == 0) {
        const int blk = lane >> 4, cc = lane & 15; const float* ar = Aab + (16 * blk) * AABS + 16 * blk;
        float x[16];
#pragma unroll
        for (int u = 0; u < 16; ++u) { float v = (u == cc) ? 1.0f : 0.f;
#pragma unroll
            for (int i = 0; i < u; ++i) v += ar[u * AABS + i] * x[i];
            x[u] = v; }
#pragma unroll
        for (int u = 0; u < 16; ++u) TI[(blk * 16 + u) * 17 + cc] = x[u];
    } else {
#pragma unroll 1
        for (int id = wave - 1; id < 16; id += 7) {
            const int ti = id >> 2, tj = id & 3;
            f32x4 acc = mm_tile(T_Aak, ti * 16, T_VT, tj * 16, 64, fr, fq, (f32x4){0.f, 0.f, 0.f, 0.f});
            const int j = tj * 16 + fr, tr = ti * 16 + fq * 4;
#pragma unroll
            for (int r = 0; r < 4; ++r) XT[(64 + j) * XTS + tr + r] = acc[r];
        }
    }
    __syncthreads();
    }
    {
        float* xc = XT + (wave * 16 + fr) * XTS;
#pragma unroll
        for (int I = 0; I < 4; ++I) {
            f32x4 acc;
#pragma unroll
            for (int r = 0; r < 4; ++r) acc[r] = xc[16 * I + 4 * fq + r];
#pragma unroll
            for (int J = 0; J < I; ++J)
#pragma unroll
                for (int kk = 0; kk < 4; ++kk) acc = __builtin_amdgcn_mfma_f32_16x16x4f32(Aab[(16 * I + fr) * AABS + 16 * J + 4 * kk + fq], xc[16 * J + 4 * kk + fq], acc, 0, 0, 0);
#pragma unroll
            for (int r = 0; r < 4; ++r) xc[16 * I + 4 * fq + r] = acc[r];
            asm volatile("s_waitcnt lgkmcnt(0)" ::: "memory");
            f32x4 xs = (f32x4){0.f, 0.f, 0.f, 0.f};
#pragma unroll
            for (int kk = 0; kk < 4; ++kk) xs = __builtin_amdgcn_mfma_f32_16x16x4f32(TI[(I * 16 + fr) * 17 + 4 * kk + fq], xc[16 * I + 4 * kk + fq], xs, 0, 0, 0);
            asm volatile("s_waitcnt lgkmcnt(0)" ::: "memory");
#pragma unroll
            for (int r = 0; r < 4; ++r) xc[16 * I + 4 * fq + r] = xs[r];
            asm volatile("s_waitcnt lgkmcnt(0)" ::: "memory");
        }
    }
    __syncthreads();
    {
        const int col = tid >> 2, tg = (tid & 3) * 16;
        const float* xr = XT + col * XTS + tg; bf16_t* dst = (col < 64 ? T_WT + col * TS : T_U0T + (col - 64) * TS) + tg;
        uint4 w0_, w1_;
        w0_.x = pk2(xr[0], xr[1]); w0_.y = pk2(xr[2], xr[3]); w0_.z = pk2(xr[4], xr[5]); w0_.w = pk2(xr[6], xr[7]);
        w1_.x = pk2(xr[8], xr[9]); w1_.y = pk2(xr[10], xr[11]); w1_.z = pk2(xr[12], xr[13]); w1_.w = pk2(xr[14], xr[15]);
        *(uint4*)dst = w0_; *(uint4*)(dst + 8) = w1_;
    }
    __syncthreads();
    {
        bf16_t* gM = (bf16_t*)(p.ws + WS_CH_M) + (size_t)jb * 4096; bf16_t* gNT = (bf16_t*)(p.ws + WS_CH_NT) + (size_t)jb * 4096;
        bf16_t* gG = (bf16_t*)(p.ws + WS_CH_G) + (size_t)jb * 4096; bf16_t* gY1T = (bf16_t*)(p.ws + WS_CH_Y1T) + (size_t)jb * 4096;
#pragma unroll 1
        for (int q = 0; q < 8; ++q) {
            const int id = wave * 8 + q, mat = id >> 4, ti = (id >> 2) & 3, tj = id & 3;
            const int col = tj * 16 + fr, r0 = ti * 16 + fq * 4;
            f32x4 acc = (f32x4){0.f, 0.f, 0.f, 0.f};
            if (mat == 0) {
                acc = mm_tile(T_WT, ti * 16, T_Arb, tj * 16, 64, fr, fq, acc);
                const uint2 rw = *(const uint2*)(T_Rt + col * TS + r0);
                acc[0] += bf2f((bf16_t)(rw.x & 0xffff)); acc[1] += bf2f((bf16_t)(rw.x >> 16)); acc[2] += bf2f((bf16_t)(rw.y & 0xffff)); acc[3] += bf2f((bf16_t)(rw.y >> 16));
                *(uint2*)(gG + col * 64 + r0) = pk4(acc);
            } else if (mat == 1) {
                acc = mm_tile(T_Arb, ti * 16, T_U0T, tj * 16, 64, fr, fq, acc);
                acc = mm_tile(T_Ark, ti * 16, T_VT, tj * 16, 64, fr, fq, acc);
                *(uint2*)(gY1T + col * 64 + r0) = pk4(acc);
            } else if (mat == 2) {
                acc = mm_tile(T_WT, ti * 16, T_bhT, tj * 16, 64, fr, fq, acc);
                const float pc = PCv[col];
#pragma unroll
                for (int r = 0; r < 4; ++r) if (r0 + r == col) acc[r] += pc;
                *(uint2*)(gM + col * 64 + r0) = pk4(acc);
            } else {
                acc = mm_tile(T_bhT, ti * 16, T_U0T, tj * 16, 64, fr, fq, acc);
                acc = mm_tile(T_khT, ti * 16, T_VT, tj * 16, 64, fr, fq, acc);
                *(uint2*)(gNT + col * 64 + r0) = pk4(acc);
            }
        }
    }
    __syncthreads();
    }
}

__device__ void rwkv_b2_job(const Params& p, int bh, unsigned char* lds) {
    const int tid = tid_(), lane = tid & 63, wave = tid >> 6, fr = lane & 15, fq = lane >> 4;
    const int mi = wave >> 1, nj0 = (wave & 1) * 2;
    const bf16_t* gM = (const bf16_t*)(p.ws + WS_CH_M); const bf16_t* gNT = (const bf16_t*)(p.ws + WS_CH_NT); bf16_t* gZT = (bf16_t*)(p.ws + WS_ZT);
    bf16_t* zbuf = (bf16_t*)lds;
    f32x4 z[2];
    z[0] = (f32x4){0.f, 0.f, 0.f, 0.f}; z[1] = z[0];
    const int c0 = mi * 16 + fq * 4;
#pragma unroll 1
    for (int c = 0; c < SEQ / 64; ++c) {
        const size_t jb = (size_t)bh * 32 + c;
        bf16_t* zh = zbuf + (c & 1) * 2 * 64 * TS; bf16_t* zl = zh + 64 * TS;
#pragma unroll
        for (int q = 0; q < 2; ++q) {
            const int j = (nj0 + q) * 16 + fr;
            const uint2 hi = pk4(z[q]);
            f32x4 lo;
            lo[0] = z[q][0] - bf2f((bf16_t)(hi.x & 0xffff)); lo[1] = z[q][1] - bf2f((bf16_t)(hi.x >> 16)); lo[2] = z[q][2] - bf2f((bf16_t)(hi.y & 0xffff)); lo[3] = z[q][3] - bf2f((bf16_t)(hi.y >> 16));
            *(uint2*)(zh + j * TS + c0) = hi; *(uint2*)(zl + j * TS + c0) = pk4(lo);
            *(uint2*)(gZT + jb * 4096 + j * 64 + c0) = hi;
        }
        __syncthreads();
        bf16x8 am[2];
#pragma unroll
        for (int kk = 0; kk < 2; ++kk) am[kk] = *(const bf16x8*)(gM + jb * 4096 + (mi * 16 + fr) * 64 + kk * 32 + fq * 8);
#pragma unroll
        for (int q = 0; q < 2; ++q) {
            const int j = (nj0 + q) * 16 + fr;
            const uint2 nw = *(const uint2*)(gNT + jb * 4096 + j * 64 + c0);
            f32x4 acc; acc[0] = bf2f((bf16_t)(nw.x & 0xffff)); acc[1] = bf2f((bf16_t)(nw.x >> 16)); acc[2] = bf2f((bf16_t)(nw.y & 0xffff)); acc[3] = bf2f((bf16_t)(nw.y >> 16));
#pragma unroll
            for (int kk = 0; kk < 2; ++kk) {
                const bf16x8 bh_ = *(const bf16x8*)(zh + j * TS + kk * 32 + fq * 8), bl_ = *(const bf16x8*)(zl + j * TS + kk * 32 + fq * 8);
                acc = __builtin_amdgcn_mfma_f32_16x16x32_bf16(am[kk], bh_, acc, 0, 0, 0);
                acc = __builtin_amdgcn_mfma_f32_16x16x32_bf16(am[kk], bl_, acc, 0, 0, 0);
            }
            z[q] = acc;
        }
    }
    __syncthreads();
}

__device__ void rwkv_b3_pair(const Params& p, int l, int pair) {
    const int tid = tid_(), lane = tid & 63, wave = tid >> 6, fr = lane & 15, fq = lane >> 4;
    const int jb = pair * 2 + (wave >> 2), mi = wave & 3;
    const int bh = jb >> 5, c = jb & 31, b = bh / NH, h = bh % NH;
    const bf16_t* gG = (const bf16_t*)(p.ws + WS_CH_G) + (size_t)jb * 4096; const bf16_t* gY1T = (const bf16_t*)(p.ws + WS_CH_Y1T) + (size_t)jb * 4096;
    const bf16_t* gBV = (const bf16_t*)(p.ws + WS_CH_BV) + (size_t)jb * 4096; const bf16_t* gZT = (const bf16_t*)(p.ws + WS_ZT) + (size_t)jb * 4096;
    const bf16_t* PG = (const bf16_t*)(p.ws + WS_PG); bf16_t* MIX = (bf16_t*)(p.ws + WS_MIX);
    const float* gng = p.in[19] + l * RWW; const float* gnb = p.in[20] + l * RWW;
    const int tr = mi * 16 + fq * 4;
    bf16x8 ag[2];
#pragma unroll
    for (int kk = 0; kk < 2; ++kk) ag[kk] = *(const bf16x8*)(gG + (mi * 16 + fr) * 64 + kk * 32 + fq * 8);
    f32x4 acc[4];
#pragma unroll
    for (int nj = 0; nj < 4; ++nj) {
        const int j = nj * 16 + fr;
        const uint2 yw = *(const uint2*)(gY1T + j * 64 + tr);
        acc[nj][0] = bf2f((bf16_t)(yw.x & 0xffff)); acc[nj][1] = bf2f((bf16_t)(yw.x >> 16)); acc[nj][2] = bf2f((bf16_t)(yw.y & 0xffff)); acc[nj][3] = bf2f((bf16_t)(yw.y >> 16));
#pragma unroll
        for (int kk = 0; kk < 2; ++kk) { const bf16x8 bz = *(const bf16x8*)(gZT + j * 64 + kk * 32 + fq * 8); acc[nj] = __builtin_amdgcn_mfma_f32_16x16x32_bf16(ag[kk], bz, acc[nj], 0, 0, 0); }
    }
#pragma unroll
    for (int r = 0; r < 4; ++r) {
        float s = acc[0][r] + acc[1][r] + acc[2][r] + acc[3][r];
        s += __shfl_xor(s, 1); s += __shfl_xor(s, 2); s += __shfl_xor(s, 4); s += __shfl_xor(s, 8);
        const float mean = s * (1.0f / HD);
        float d[4], vs = 0.f;
#pragma unroll
        for (int nj = 0; nj < 4; ++nj) { d[nj] = acc[nj][r] - mean; vs += d[nj] * d[nj]; }
        vs += __shfl_xor(vs, 1); vs += __shfl_xor(vs, 2); vs += __shfl_xor(vs, 4); vs += __shfl_xor(vs, 8);
        const float rstd = rsqrtf(vs * (1.0f / HD) + GN_EPS);
        const int tt = tr + r; const size_t row = (size_t)b * SEQ + c * 64 + tt;
#pragma unroll
        for (int nj = 0; nj < 4; ++nj) {
            const int j = nj * 16 + fr, cj = h * HD + j;
            const float o = d[nj] * rstd * gng[cj] + gnb[cj] + bf2f(gBV[tt * 64 + j]);
            const float g = bf2f(PG[row * PG_W + cj]);
            MIX[row * DM + CW + SBW + cj] = f2bf(o * siluf_(g));
        }
    }
}

#ifndef ATTN_REF
#define ATTN_REF 0
#endif
#ifndef RWKV_REF
#define RWKV_REF 0
#endif
__device__ void phase_mix1(const Params& p, int l, unsigned char* lds) {
    constexpr int NAT = BATCH * NH * 4, NCV = BATCH * (SEQ / 32);
    const int G = gridDim.x;
#if RWKV_REF
    for (int job = blockIdx.x; job < BATCH * NH; job += G) rwkv_job(p, l, job, (float*)lds);
#else
    for (int rep = 0; rep < ((PROBE_REP & 1) ? 2 : 1); ++rep)
    for (int job = blockIdx.x; job < BATCH * NH * 32; job += G) rwkv_b1_job(p, l, job, lds);
#endif
    for (int rep = 0; rep < ((PROBE_REP & 2) ? 2 : 1); ++rep)
#if ATTN_REF
    for (int job = blockIdx.x; job < NAT; job += G) attn_job(p, job);
#else
    for (int job = blockIdx.x; job < NAT * 2; job += G) attn_mfma_wave(p, job >> 3, (job & 7) * 8 + (tid_() >> 6));
#endif
#ifndef CONV_REF
#define CONV_REF 0
#endif
    for (int rep = 0; rep < ((PROBE_REP & 4) ? 2 : 1); ++rep)
#if CONV_REF
    for (int job = blockIdx.x; job < NCV; job += G) conv_job(p, l, job, (float*)lds);
#else
    for (int job = blockIdx.x; job < BATCH * (SEQ / 64); job += G) conv_job64(p, l, job, lds);
#endif
}
__device__ void phase_mix2(const Params& p, int l, unsigned char* lds) {
#if !RWKV_REF
    for (int rep = 0; rep < ((PROBE_REP & 8) ? 2 : 1); ++rep)
    for (int job = blockIdx.x; job < BATCH * NH; job += gridDim.x) rwkv_b2_job(p, job, lds);
#endif
}
__device__ void phase_mix3(const Params& p, int l, unsigned char* lds) {
#if !RWKV_REF
    for (int rep = 0; rep < ((PROBE_REP & 16) ? 2 : 1); ++rep)
    for (int pair = blockIdx.x; pair < BATCH * NH * 16; pair += gridDim.x) rwkv_b3_pair(p, l, pair);
#endif
}

constexpr int PH_PER_LAYER = 6;
constexpr int N_PHASES = 1 + PH_PER_LAYER * DEPTH;
__device__ __forceinline__ void run_phase(const Params& p, int ph, unsigned char* lds) {
    unsigned char* ws = p.ws;
    if (ph == 0) { phase_prologue(p, lds); return; }
    const int l = (ph - 1) / PH_PER_LAYER, k = (ph - 1) % PH_PER_LAYER;
    if (k == 0) {
#if SIMPLE_GEMM
        EpiInProj E{(bf16_t*)(ws + WS_PC), (bf16_t*)(ws + WS_PS), (bf16_t*)(ws + WS_PR), (bf16_t*)(ws + WS_PG)};
        gemm_simple((const bf16_t*)(ws + WS_XB), (const bf16_t*)(ws + WS_WIN) + (size_t)l * NINT * DM, M, NINT, DM, E);
#else
        EpiInProjP E{(bf16_t*)(ws + WS_PC), (bf16_t*)(ws + WS_PS), (bf16_t*)(ws + WS_PR), (bf16_t*)(ws + WS_PG), (bf16_t*)(ws + WS_VT)};
        pg8::Gemm g{(const bf16_t*)(ws + WS_XB), (const bf16_t*)(ws + WS_WIN) + (size_t)l * NINT * DM, M, NINT, DM}; pg8::StaticOrder S; S.init(M, NINT, (int)gridDim.x, (int)blockIdx.x);
        for (int rep = 0; rep < ((PROBE_REP & 32) ? 2 : 1); ++rep)
        pg8::gemm_phase<EpiInProjP, pg8::StaticOrder, true, true>((PG8_LAS unsigned char*)lds, g, S, E);
#endif
    } else if (k == 1) {
        phase_mix1(p, l, lds);
    } else if (k == 2) {
        phase_mix2(p, l, lds);
    } else if (k == 3) {
        phase_mix3(p, l, lds);
    } else if (k == 4) {
#if SIMPLE_GEMM
        EpiF32 E{(float*)(ws + WS_Y), DM};
        gemm_simple((const bf16_t*)(ws + WS_MIX), (const bf16_t*)(ws + WS_WOUT) + (size_t)l * DM * DM, M, DM, DM, E);
#else
        EpiOutF32P E{(float*)(ws + WS_Y), DM};
        pg8::Gemm g{(const bf16_t*)(ws + WS_MIX), (const bf16_t*)(ws + WS_WOUT) + (size_t)l * DM * DM, M, DM, DM}; pg8::StaticOrder S; S.init(M, DM, (int)gridDim.x, (int)blockIdx.x);
        for (int rep = 0; rep < ((PROBE_REP & 64) ? 2 : 1); ++rep)
        pg8::gemm_phase<EpiOutF32P, pg8::StaticOrder, true, true>((PG8_LAS unsigned char*)lds, g, S, E);
#endif
    } else {
        phase_rowpass(l == 0 ? p.in[0] : p.out, (const float*)(ws + WS_Y), p.in[2] + l * DM, p.out, l + 1 < DEPTH ? (bf16_t*)(ws + WS_XB) : nullptr);
    }
}

static_assert(10 * TILE_B + 64 * AABS * 4 + 128 * XTS * 4 + 64 * 4 + 4 * 16 * 17 * 4 <= 147456, "B1 LDS map");
constexpr int LDS_BYTES = 147456;

#if MK_COOP
__global__ void __launch_bounds__(512, 2) fwd_kernel(Params p) {
    extern __shared__ __attribute__((aligned(16))) unsigned char lds[];
    cg::grid_group grid = cg::this_grid();
    for (int ph = p.ph_lo; ph < p.ph_hi; ++ph) {
        run_phase(p, ph, lds);
        if (ph + 1 < p.ph_hi) grid.sync();
    }
}
#else
__global__ void __launch_bounds__(512, 2) fwd_kernel(Params p) {
    extern __shared__ __attribute__((aligned(16))) unsigned char lds[];
    for (int ph = p.ph_lo; ph < p.ph_hi; ++ph) run_phase(p, ph, lds);
}
#endif

extern "C" void kernel_launch(void* const* d_in, const int* in_sizes, int n_in, void* d_out, int out_size, void* d_ws, size_t ws_size, hipStream_t stream) {
    static int grid = 0;
    if (grid == 0) {
        if (n_in != 24 || out_size != M * DM || ws_size < WS_END) { fprintf(stderr, "kernel_launch: unexpected problem (n_in %d out %d ws %zu)\n", n_in, out_size, ws_size); grid = -1; return; }
        int dev = 0, cus = 0, per_cu = 0;
        hipGetDevice(&dev); hipDeviceGetAttribute(&cus, hipDeviceAttributeMultiprocessorCount, dev);
        hipFuncSetAttribute((const void*)fwd_kernel, hipFuncAttributeMaxDynamicSharedMemorySize, LDS_BYTES);
        hipOccupancyMaxActiveBlocksPerMultiprocessor(&per_cu, (const void*)fwd_kernel, 512, LDS_BYTES);
        if (per_cu < 1) { fprintf(stderr, "kernel_launch: occupancy query says %d blocks per CU\n", per_cu); per_cu = 1; }
        grid = cus;
        (void)hipGetLastError();
    }
    if (grid < 0) return;
    Params p{};
    for (int i = 0; i < 24; ++i) p.in[i] = (const float*)d_in[i];
    p.out = (float*)d_out; p.ws = (unsigned char*)d_ws;
#if MK_COOP
    p.ph_lo = 0; p.ph_hi = N_PHASES;
    void* args[] = {&p};
    hipError_t e = hipLaunchCooperativeKernel((const void*)fwd_kernel, dim3(grid), dim3(512), args, LDS_BYTES, stream);
    if (e != hipSuccess) fprintf(stderr, "cooperative launch failed: %s (grid %d)\n", hipGetErrorString(e), grid);
#else
    for (int ph = 0; ph < N_PHASES; ++ph) {
        p.ph_lo = ph; p.ph_hi = ph + 1;
        hipLaunchKernelGGL(fwd_kernel, dim3(grid), dim3(512), LDS_BYTES, stream, p);
    }
#endif
}
```

```cpp
#include <hip/hip_runtime.h>
#include <hip/hip_cooperative_groups.h>
#include <cstdio>
#include <cstdint>
namespace cg = cooperative_groups;

#ifndef SIMPLE_GEMM
#define SIMPLE_GEMM 0
#endif
#ifndef PROBE_REP
#define PROBE_REP 0
#endif
#ifndef MK_COOP
#define MK_COOP 2
#endif

constexpr int BATCH = 16, SEQ = 2048, DM = 1024, DEPTH = 2;
constexpr int M = BATCH * SEQ;
constexpr int HD = 64, NH = 6;
constexpr int CW = 256, SBW = 384, RWW = 384, LORA = 32, TAPS = 31;
constexpr int DIN = 3904;
constexpr int NINT = 4096;
constexpr int PC_W = 768, PS_W = 1152, PR_W = 1280, PG_W = 384;
constexpr float RMS_EPS = 1e-6f, LN_EPS = 1e-5f, GN_EPS = 64e-5f;

typedef unsigned short bf16_t;
typedef short bf16x8 __attribute__((ext_vector_type(8)));
typedef float f32x4 __attribute__((ext_vector_type(4)));
typedef unsigned short us4 __attribute__((ext_vector_type(4)));

constexpr size_t MiB = 1u << 20;
constexpr size_t WS_CTL = 0;
constexpr size_t WS_WPW = 512 * 1024;
constexpr size_t WS_WIN = 1 * MiB;
constexpr size_t WS_WOUT = 17 * MiB;
constexpr size_t WS_XB = 21 * MiB;
constexpr size_t WS_MIX = WS_XB;
constexpr size_t WS_PC = 85 * MiB;
constexpr size_t WS_PS = 133 * MiB;
constexpr size_t WS_VT = 205 * MiB;
constexpr size_t WS_Y = WS_PC;
constexpr size_t WS_PR = 229 * MiB;
constexpr size_t WS_PG = 309 * MiB;
constexpr size_t WS_VF = 333 * MiB;
constexpr size_t WS_CH = 381 * MiB;
constexpr size_t CH_SZ = (size_t)3072 * 4096 * 2;
constexpr size_t WS_CH_M = WS_CH, WS_CH_NT = WS_CH + CH_SZ, WS_CH_G = WS_CH + 2 * CH_SZ, WS_CH_Y1T = WS_CH + 3 * CH_SZ, WS_CH_BV = WS_CH + 4 * CH_SZ;
constexpr size_t WS_ZT = WS_PR;
constexpr size_t WS_END = 501 * MiB;

struct Params {
    const float* in[24];
    float* out;
    unsigned char* ws;
    int ph_lo, ph_hi;
};

__device__ __forceinline__ float bf2f(bf16_t v) { return __uint_as_float(((unsigned)v) << 16); }
__device__ __forceinline__ bf16_t f2bf(float f) { unsigned u = __float_as_uint(f); return (bf16_t)((u + 0x7fffu + ((u >> 16) & 1u)) >> 16); }
__device__ __forceinline__ unsigned pk2(float lo, float hi) { return (unsigned)f2bf(lo) | ((unsigned)f2bf(hi) << 16); }
__device__ __forceinline__ float wave_sum(float v) {
#pragma unroll
    for (int o = 1; o < 64; o <<= 1) v += __shfl_xor(v, o);
    return v;
}
__device__ __forceinline__ float sigmoidf_(float x) { return 1.0f / (1.0f + __expf(-x)); }
__device__ __forceinline__ float siluf_(float x) { return x / (1.0f + __expf(-x)); }
__device__ __forceinline__ int tid_() { int t = threadIdx.x; asm volatile("" : "+v"(t)); return t; }
__device__ __forceinline__ int opaque_zero() { int z = 0; asm volatile("" : "+v"(z)); return z; }

__device__ __forceinline__ int orig_col(int n) { return n < 3520 ? n : (n < 3584 ? -1 : (n < 3968 ? n - 64 : -1)); }

__device__ void transpose_tile(const float* W, int ldw, int ncol_src, const float* gain, bf16_t* WT, int K, int n0, int k0, bool permute, float* tile  , const float* fold_v1 = nullptr, const float* fold_mu = nullptr) {
    const int tid = tid_();
#pragma unroll
    for (int i = 0; i < 8; ++i) {
        const int kl = (tid >> 6) + 8 * i, nl = tid & 63;
        const int n = n0 + nl, k = k0 + kl;
        const int oc = permute ? orig_col(n) : n;
        float v = 0.f;
        if (oc >= 0 && oc < ncol_src) v = W[(size_t)k * ldw + oc] * (gain ? gain[k] : 1.0f);
        if (permute && n >= 768 && n < 1152) v *= 0.125f * 1.4426950408889634f;
        if (fold_v1 && n >= 3520 && n < 3584) {
            const int i = (n - 3520) & 31; const bool second = n >= 3552; float a = 0.f;
            for (int c = 0; c < RWW; ++c) { const float m = fold_mu[c]; a += W[(size_t)k * ldw + 3072 + c] * (second ? m : 1.0f - m) * fold_v1[c * LORA + i]; }
            v = a * gain[k];
        }
        tile[kl * 65 + nl] = v;
    }
    __syncthreads();
#pragma unroll
    for (int i = 0; i < 8; ++i) {
        const int nl = (tid >> 6) + 8 * i, kl = tid & 63;
        WT[(size_t)(n0 + nl) * K + k0 + kl] = f2bf(tile[kl * 65 + nl]);
    }
    __syncthreads();
}

__device__ void rows_to_xb(const float* X, bf16_t* XB) {
    const int tid = tid_(), lane = tid & 63, wave = tid >> 6;
    for (int row = blockIdx.x * 8 + wave; row < M; row += gridDim.x * 8) {
        const float* xr = X + (size_t)row * DM;
        f32x4 v[4]; float ss = 0.f;
#pragma unroll
        for (int i = 0; i < 4; ++i) { v[i] = *(const f32x4*)(xr + i * 256 + lane * 4); ss += v[i][0] * v[i][0] + v[i][1] * v[i][1] + v[i][2] * v[i][2] + v[i][3] * v[i][3]; }
        ss = wave_sum(ss);
        const float rstd = rsqrtf(ss * (1.0f / DM) + RMS_EPS);
#pragma unroll
        for (int i = 0; i < 4; ++i) { uint2 w; w.x = pk2(v[i][0] * rstd, v[i][1] * rstd); w.y = pk2(v[i][2] * rstd, v[i][3] * rstd); *(uint2*)(XB + (size_t)row * DM + i * 256 + lane * 4) = w; }
    }
}

__device__ void phase_prologue(const Params& p, unsigned char* lds) {
    float* tile = (float*)lds;
    bf16_t* WinT = (bf16_t*)(p.ws + WS_WIN); bf16_t* WoutT = (bf16_t*)(p.ws + WS_WOUT);
    const int nt_in = (NINT / 64) * (DM / 64), nt_out = (DM / 64) * (DM / 64), nt_pw = (CW / 64) * (CW / 64);
    const int total = DEPTH * (nt_in + nt_out);
    for (int j = blockIdx.x; j < DEPTH * nt_pw; j += gridDim.x) { const int l = j / nt_pw, r = j % nt_pw;
        transpose_tile(p.in[9] + (size_t)l * CW * CW, CW, CW, nullptr, (bf16_t*)(p.ws + WS_WPW) + (size_t)l * CW * CW, CW, (r >> 2) * 64, (r & 3) * 64, false, tile); }
    for (int j = blockIdx.x; j < total; j += gridDim.x) {
        int l = j / (nt_in + nt_out), r = j % (nt_in + nt_out);
        if (r < nt_in) { const int tn = r / (DM / 64), tk = r % (DM / 64);
            transpose_tile(p.in[3] + (size_t)l * DM * DIN, DIN, DIN, p.in[1] + l * DM, WinT + (size_t)l * NINT * DM, DM, tn * 64, tk * 64, true, tile, l > 0 ? p.in[22] : nullptr, p.in[11] + l * 1216 + 768);
        } else { r -= nt_in; const int tn = r / (DM / 64), tk = r % (DM / 64);
            transpose_tile(p.in[4] + (size_t)l * DM * DM, DM, DM, nullptr, WoutT + (size_t)l * DM * DM, DM, tn * 64, tk * 64, false, tile);
        }
    }
    rows_to_xb(p.in[0], (bf16_t*)(p.ws + WS_XB));
}

namespace pg8 {
#define PG8_LAS __attribute__((address_space(3)))
typedef unsigned short bf16_t;
typedef short bf16x8 __attribute__((ext_vector_type(8)));
typedef float f32x4 __attribute__((ext_vector_type(4)));
typedef unsigned u32x4 __attribute__((ext_vector_type(4)));
constexpr int BM = 256, BK = 64, HALF = 128, HTB = HALF * BK * 2  , STAGE_BYTES = 8 * HTB, NXCD = 8, WGM = 8;

__host__ __device__ __forceinline__ int lds_byte(int r, int c) { const int st = (r >> 4) * 2 + (c >> 5), rr = r & 15, cc = c & 31, ob = rr * 64 + cc * 2; return st * 1024 + (ob ^ (((ob >> 9) & 1) << 5)); }
__host__ __device__ __forceinline__ void stage_rc(int b, int& R, int& C) { const int st = b / 1024, sb = b % 1024, swz = sb ^ (((sb >> 9) & 1) << 5); R = (st >> 1) * 16 + swz / 64; C = (st & 1) * 32 + (swz % 64) / 2; }
__host__ __device__ __forceinline__ int perm32(int rho) { const int n = rho >> 4, i = rho & 15; return 8 * (i >> 2) + 4 * n + (i & 3); }

struct Unit { int pm, pn; };
struct Gemm { const bf16_t* A; const bf16_t* Bt; int M, N, K; };

struct StaticOrder {
    int nM, nN, nwg, G, c;
    __host__ __device__ void init(int M, int N, int G_, int c_) { nM = M / BM; nN = N / BM; nwg = nM * nN; G = G_; c = c_; }
    __host__ __device__ bool next(int i, Unit& u) const {
        const long L = (long)i * G + c; if (L >= nwg) return false;
        int wgid = (int)L; { const int q = nwg / NXCD, r = nwg % NXCD, xcd = wgid % NXCD, off = wgid / NXCD; wgid = (xcd < r ? xcd * (q + 1) : r * (q + 1) + (xcd - r) * q) + off; }
        const int nig = WGM * nN, gid = wgid / nig, fm = gid * WGM, gsz = (nM - fm) < WGM ? (nM - fm) : WGM;
        u.pm = fm + ((wgid % nig) % gsz); u.pn = (wgid % nig) / gsz; return true;
    }
    __device__ __forceinline__ void a_ready(const Unit&) const {}
    __device__ __forceinline__ void done(const Unit&) const {}
};


__device__ __forceinline__ unsigned cvt_pk_bf16(float lo, float hi) { unsigned r; asm volatile("v_cvt_pk_bf16_f32 %0, %1, %2" : "=v"(r) : "v"(lo), "v"(hi)); return r; }

template <class Epi, class Sched, bool ALIGN_EPI = false, bool SP2 = false>
__device__ __forceinline__ void gemm_phase(PG8_LAS unsigned char* lds, const Gemm g, const Sched& S, const Epi& E) {
    const int tid = tid_(), wid = __builtin_amdgcn_readfirstlane(tid >> 6), lane = tid & 63, wr = wid >> 2, wc = wid & 3, fr = lane & 15, fq = lane >> 4;
    const int K = g.K, nt = K / BK;
    unsigned voffA[2], voffB[2];
#pragma unroll
    for (int i = 0; i < 2; ++i) { int R, C; stage_rc(tid * 16 + i * 8192, R, C); const int Rb = Epi::PERM ? ((R & ~31) + perm32(R & 31)) : R;
        voffA[i] = (unsigned)(R * K + C) * 2u; voffB[i] = (unsigned)(Rb * K + C) * 2u; }
    const size_t kstep = (size_t)(BK * 2);
    const size_t hstep = (size_t)HALF * K * 2;
    const size_t tstep = 2 * hstep;
    const unsigned ldsw = (unsigned)wid * 1024u;
    const int aoff = lds_byte(wr * 64 + fr, fq * 8), boff = lds_byte(wc * 32 + fr, fq * 8);
#define PG8_SA(b, h) (((b) * 2 + (h)) * HTB)
#define PG8_SB(b, h) ((4 + (b) * 2 + (h)) * HTB)
#define PG8_STAGE(bufoff, gbase, voff) do { _Pragma("unroll") for (int _i = 0; _i < 2; ++_i) \
        __builtin_amdgcn_global_load_lds((const unsigned*)((const char*)(gbase) + (voff)[_i]), (PG8_LAS unsigned*)(lds + (bufoff) + ldsw + _i * 8192), 16, 0, 0); } while (0)
#define PG8_LDA(dst, b, h) do { _Pragma("unroll") for (int m = 0; m < 4; ++m) _Pragma("unroll") for (int k = 0; k < 2; ++k) dst[m][k] = *(const PG8_LAS bf16x8*)(lds + PG8_SA(b, h) + aoff + m * 2048 + k * 1024); } while (0)
#define PG8_LDB(dst, b, h) do { _Pragma("unroll") for (int n = 0; n < 2; ++n) _Pragma("unroll") for (int k = 0; k < 2; ++k) dst[n][k] = *(const PG8_LAS bf16x8*)(lds + PG8_SB(b, h) + boff + n * 2048 + k * 1024); } while (0)
#define PG8_MMA(ai, bj, At, Bt) do { __builtin_amdgcn_s_setprio(1); _Pragma("unroll") for (int m = 0; m < 4; ++m) _Pragma("unroll") for (int n = 0; n < 2; ++n) _Pragma("unroll") for (int k = 0; k < 2; ++k) \
        acc[ai][bj][m][n] = __builtin_amdgcn_mfma_f32_16x16x32_bf16(Bt[n][k], At[m][k], acc[ai][bj][m][n], 0, 0, 0); __builtin_amdgcn_s_setprio(0); } while (0)
#define PG8_WAIT_V(n) asm volatile("s_waitcnt vmcnt(" #n ")" ::: "memory")
#define PG8_WAIT_L(n) asm volatile("s_waitcnt lgkmcnt(" #n ")" ::: "memory")
#define PG8_BAR __builtin_amdgcn_s_barrier()
#define PG8_SCHED __builtin_amdgcn_sched_barrier(0)
    Unit cur, nxt; int ui = 0;
    if (!S.next(0, cur)) return;
    f32x4 acc[2][2][4][2];
#pragma unroll
    for (int a = 0; a < 2; ++a)
#pragma unroll
        for (int b = 0; b < 2; ++b)
#pragma unroll
            for (int m = 0; m < 4; ++m)
#pragma unroll
                for (int n = 0; n < 2; ++n) acc[a][b][m][n] = (f32x4){0.f, 0.f, 0.f, 0.f};
    bf16x8 At[4][2], B0[2][2], B1[2][2];
    const char* cA = (const char*)g.A + (size_t)cur.pm * tstep; const char* cB = (const char*)g.Bt + (size_t)cur.pn * tstep;
    S.a_ready(cur);
    if constexpr (SP2) {
        PG8_STAGE(PG8_SB(0, 0), cB, voffB); PG8_STAGE(PG8_SB(0, 1), cB + hstep, voffB); PG8_STAGE(PG8_SA(0, 0), cA, voffA); PG8_STAGE(PG8_SA(0, 1), cA + hstep, voffA);
        if (wr == 1) PG8_BAR;
        PG8_WAIT_V(2); PG8_BAR;
        PG8_STAGE(PG8_SB(1, 0), cB + kstep, voffB); PG8_STAGE(PG8_SA(1, 0), cA + kstep, voffA); PG8_STAGE(PG8_SB(1, 1), cB + hstep + kstep, voffB);
        PG8_WAIT_V(6); PG8_BAR;
    } else {
        PG8_STAGE(PG8_SB(0, 0), cB, voffB); PG8_STAGE(PG8_SA(0, 0), cA, voffA); PG8_STAGE(PG8_SB(0, 1), cB + hstep, voffB); PG8_STAGE(PG8_SA(0, 1), cA + hstep, voffA);
        if (wr == 1) PG8_BAR;
        PG8_WAIT_V(4); PG8_BAR;
        PG8_STAGE(PG8_SB(1, 0), cB + kstep, voffB); PG8_STAGE(PG8_SA(1, 0), cA + kstep, voffA); PG8_STAGE(PG8_SB(1, 1), cB + hstep + kstep, voffB);
        PG8_WAIT_V(6); PG8_BAR;
    }
    for (;;) {
        const bool has_next = S.next(ui + 1, nxt);
        const char* nA = has_next ? (const char*)g.A + (size_t)nxt.pm * tstep : cA; const char* nB = has_next ? (const char*)g.Bt + (size_t)nxt.pn * tstep : cB;
        for (int t = 0; t < nt; t += 2) {
            const bool last = (t == nt - 2);
            const char* a1 = cA + (size_t)(t + 1) * kstep;
            const char* a2 = last ? nA : cA + (size_t)(t + 2) * kstep; const char* b2 = last ? nB : cB + (size_t)(t + 2) * kstep;
            const char* a3 = a2 + kstep; const char* b3 = b2 + kstep;
            if (last && has_next) S.a_ready(nxt);
            if constexpr (SP2) {
            PG8_LDB(B0, 0, 0); PG8_LDB(B1, 0, 1); PG8_SCHED; PG8_LDA(At, 0, 0); PG8_STAGE(PG8_SA(1, 1), a1 + hstep, voffA);
            PG8_WAIT_V(8); PG8_WAIT_L(0); PG8_BAR; PG8_MMA(0, 0, At, B0); PG8_MMA(0, 1, At, B1); PG8_BAR; PG8_SCHED;
            PG8_LDA(At, 0, 1); PG8_STAGE(PG8_SB(0, 0), b2, voffB); PG8_STAGE(PG8_SB(0, 1), b2 + hstep, voffB); PG8_STAGE(PG8_SA(0, 0), a2, voffA);
            PG8_WAIT_V(8); PG8_WAIT_L(0); PG8_BAR; PG8_MMA(1, 0, At, B0); PG8_MMA(1, 1, At, B1); PG8_BAR; PG8_SCHED;
            PG8_LDB(B0, 1, 0); PG8_LDB(B1, 1, 1); PG8_SCHED; PG8_LDA(At, 1, 0); PG8_STAGE(PG8_SA(0, 1), a2 + hstep, voffA);
            PG8_WAIT_V(8); PG8_WAIT_L(0); PG8_BAR; PG8_MMA(0, 0, At, B0); PG8_MMA(0, 1, At, B1); PG8_BAR; PG8_SCHED;
            PG8_LDA(At, 1, 1); PG8_STAGE(PG8_SB(1, 0), b3, voffB); PG8_STAGE(PG8_SB(1, 1), b3 + hstep, voffB); PG8_STAGE(PG8_SA(1, 0), a3, voffA);
            PG8_WAIT_V(8); PG8_WAIT_L(0); PG8_BAR; PG8_MMA(1, 0, At, B0); PG8_MMA(1, 1, At, B1); PG8_BAR; PG8_SCHED;
            } else {
            PG8_LDB(B0, 0, 0); PG8_SCHED; PG8_LDA(At, 0, 0); PG8_STAGE(PG8_SA(1, 1), a1 + hstep, voffA);
            PG8_WAIT_L(8); PG8_BAR; PG8_WAIT_L(0); PG8_MMA(0, 0, At, B0); PG8_BAR; PG8_SCHED;
            PG8_LDB(B1, 0, 1); PG8_STAGE(PG8_SB(0, 0), b2, voffB);
            PG8_BAR; PG8_WAIT_L(0); PG8_MMA(0, 1, At, B1); PG8_BAR;
            PG8_LDA(At, 0, 1); PG8_STAGE(PG8_SA(0, 0), a2, voffA);
            PG8_BAR; PG8_WAIT_L(0); PG8_MMA(1, 0, At, B0); PG8_BAR; PG8_SCHED;
            PG8_STAGE(PG8_SB(0, 1), b2 + hstep, voffB);
            PG8_WAIT_V(6); PG8_BAR; PG8_MMA(1, 1, At, B1); PG8_BAR;
            PG8_LDB(B0, 1, 0); PG8_SCHED; PG8_LDA(At, 1, 0); PG8_STAGE(PG8_SA(0, 1), a2 + hstep, voffA);
            PG8_WAIT_L(8); PG8_BAR; PG8_WAIT_L(0); PG8_MMA(0, 0, At, B0); PG8_BAR; PG8_SCHED;
            PG8_LDB(B1, 1, 1); PG8_STAGE(PG8_SB(1, 0), b3, voffB);
            PG8_BAR; PG8_WAIT_L(0); PG8_MMA(0, 1, At, B1); PG8_BAR;
            PG8_LDA(At, 1, 1); PG8_STAGE(PG8_SA(1, 0), a3, voffA);
            PG8_BAR; PG8_WAIT_L(0); PG8_MMA(1, 0, At, B0); PG8_BAR; PG8_SCHED;
            PG8_STAGE(PG8_SB(1, 1), b3 + hstep, voffB);
            PG8_WAIT_V(6); PG8_BAR; PG8_MMA(1, 1, At, B1); PG8_BAR;
            }
        }
        if constexpr (ALIGN_EPI) { if (wr == 0) PG8_BAR; }
        if constexpr (!Epi::AFTER_DRAIN) { E(acc, cur, wr, wc, fr, fq); S.done(cur); }
        if (!has_next) break;
#pragma unroll
        for (int a = 0; a < 2; ++a)
#pragma unroll
            for (int b = 0; b < 2; ++b)
#pragma unroll
                for (int m = 0; m < 4; ++m)
#pragma unroll
                    for (int n = 0; n < 2; ++n) acc[a][b][m][n] = (f32x4){0.f, 0.f, 0.f, 0.f};
        cur = nxt; cA = nA; cB = nB; ++ui;
        if constexpr (ALIGN_EPI) { if (wr == 1) PG8_BAR; }
    }
    PG8_WAIT_V(0);
    if constexpr (!ALIGN_EPI) { if (wr == 0) PG8_BAR; }
    PG8_BAR;
    if constexpr (Epi::AFTER_DRAIN) { E.fused(acc, cur, wr, wc, fr, fq, lds, wid, lane); S.done(cur); }
#undef PG8_SA
#undef PG8_SB
#undef PG8_STAGE
#undef PG8_LDA
#undef PG8_LDB
#undef PG8_MMA
#undef PG8_WAIT_V
#undef PG8_WAIT_L
#undef PG8_BAR
#undef PG8_SCHED
}
}

template <class Epi>
__device__ void gemm_simple(const bf16_t* A, const bf16_t* Bt, int Mr, int N, int K, const Epi& epi) {
    const int tid = tid_(), wave = tid >> 6, lane = tid & 63, wm = wave >> 1, wn = wave & 1, fr = lane & 15, fq = lane >> 4;
    const int nNt = N / 128, nMt = Mr / 128;
    for (int tile = blockIdx.x; tile < nNt * nMt; tile += gridDim.x) {
        const int tm = tile / nNt, tn = tile % nNt;
        const int m0 = tm * 128 + wm * 32, n0 = tn * 128 + wn * 64;
        f32x4 acc[2][4];
#pragma unroll
        for (int i = 0; i < 2; ++i)
#pragma unroll
            for (int j = 0; j < 4; ++j) acc[i][j] = (f32x4){0.f, 0.f, 0.f, 0.f};
        const bf16_t* ap = A + (size_t)(m0 + fr) * K + fq * 8;
        const bf16_t* bp = Bt + (size_t)(n0 + fr) * K + fq * 8;
        for (int k = 0; k < K; k += 32) {
            bf16x8 af[2], bfr[4];
#pragma unroll
            for (int i = 0; i < 2; ++i) af[i] = *(const bf16x8*)(ap + (size_t)i * 16 * K + k);
#pragma unroll
            for (int j = 0; j < 4; ++j) bfr[j] = *(const bf16x8*)(bp + (size_t)j * 16 * K + k);
#pragma unroll
            for (int i = 0; i < 2; ++i)
#pragma unroll
                for (int j = 0; j < 4; ++j) acc[i][j] = __builtin_amdgcn_mfma_f32_16x16x32_bf16(bfr[j], af[i], acc[i][j], 0, 0, 0);
        }
#pragma unroll
        for (int i = 0; i < 2; ++i)
#pragma unroll
            for (int j = 0; j < 4; ++j) epi(m0 + i * 16 + fr, n0 + j * 16 + fq * 4, acc[i][j]);
    }
}

struct EpiInProj {
    bf16_t *PC, *PS, *PR, *PG;
    __device__ __forceinline__ void operator()(int m, int n, const f32x4& v) const {
        bf16_t* dst;
        if (n < 768) dst = PC + (size_t)m * PC_W + n;
        else if (n < 2304) dst = PS + (size_t)m * PS_W + (n - 768);
        else if (n < 3584) dst = PR + (size_t)m * PR_W + (n - 2304);
        else if (n < 3968) dst = PG + (size_t)m * PG_W + (n - 3584);
        else return;
        uint2 w; w.x = pk2(v[0], v[1]); w.y = pk2(v[2], v[3]); *(uint2*)dst = w;
    }
};
struct EpiF32 {
    float* Y; int ld;
    __device__ __forceinline__ void operator()(int m, int n, const f32x4& v) const { *(f32x4*)(Y + (size_t)m * ld + n) = v; }
};


struct EpiInProjP {
    static constexpr bool PERM = true, AFTER_DRAIN = false;
    bf16_t *PC, *PS, *PR, *PG, *VT;
    __device__ __forceinline__ void operator()(const pg8::f32x4 (&acc)[2][2][4][2], const pg8::Unit& u, int wr, int wc, int fr, int fq) const {
        const int row0 = u.pm * 256 + wr * 64 + fr;
#pragma unroll
        for (int bj = 0; bj < 2; ++bj) {
            const int blk = 2 * u.pn + bj; bf16_t* base; int ld, c0;
            if (blk >= 12 && blk < 15) {
                const int vc = 128 * (blk - 12) + wc * 32 + 8 * fq;
#pragma unroll
                for (int ai = 0; ai < 2; ++ai)
#pragma unroll
                    for (int m = 0; m < 4; ++m) {
                        const int row = row0 + ai * 128 + m * 16, b = row >> 11, t = row & 2047;
#pragma unroll
                        for (int n = 0; n < 2; ++n)
#pragma unroll
                            for (int e = 0; e < 4; ++e) { const int col = vc + 4 * n + e, hh = col >> 6, d = col & 63;
                                VT[((size_t)(b * NH + hh) * HD + d) * SEQ + t] = f2bf(acc[ai][bj][m][n][e]); }
                    }
                continue;
            }
            if (blk < 6) { base = PC; ld = PC_W; c0 = 128 * blk; }
            else if (blk < 12) { base = PS; ld = PS_W; c0 = 128 * (blk - 6); }
            else if (blk < 18) { base = PS; ld = PS_W; c0 = 768 + 128 * (blk - 15); }
            else if (blk < 28) { base = PR; ld = PR_W; c0 = 128 * (blk - 18); }
            else if (blk < 31) { base = PG; ld = PG_W; c0 = 128 * (blk - 28); }
            else continue;
            const int col = c0 + wc * 32 + 8 * fq;
#pragma unroll
            for (int ai = 0; ai < 2; ++ai)
#pragma unroll
                for (int m = 0; m < 4; ++m) {
                    const pg8::f32x4 v0 = acc[ai][bj][m][0], v1 = acc[ai][bj][m][1]; pg8::u32x4 w;
                    w.x = pg8::cvt_pk_bf16(v0[0], v0[1]); w.y = pg8::cvt_pk_bf16(v0[2], v0[3]); w.z = pg8::cvt_pk_bf16(v1[0], v1[1]); w.w = pg8::cvt_pk_bf16(v1[2], v1[3]);
                    *(pg8::u32x4*)(base + (size_t)(row0 + ai * 128 + m * 16) * ld + col) = w;
                }
        }
    }
};
struct EpiOutF32P {
    static constexpr bool PERM = false, AFTER_DRAIN = false;
    float* Y; int ld;
    __device__ __forceinline__ void operator()(const pg8::f32x4 (&acc)[2][2][4][2], const pg8::Unit& u, int wr, int wc, int fr, int fq) const {
        const int row0 = u.pm * 256 + wr * 64 + fr, col0 = u.pn * 256 + wc * 32 + 4 * fq;
#pragma unroll
        for (int ai = 0; ai < 2; ++ai)
#pragma unroll
            for (int m = 0; m < 4; ++m)
#pragma unroll
                for (int bj = 0; bj < 2; ++bj)
#pragma unroll
                    for (int n = 0; n < 2; ++n) *(pg8::f32x4*)(Y + (size_t)(row0 + ai * 128 + m * 16) * ld + col0 + bj * 128 + n * 16) = acc[ai][bj][m][n];
    }
};

__device__ void phase_rowpass(const float* Xin, const float* Y, const float* gpost, float* Xout, bf16_t* XB) {
    const int tid = tid_(), lane = tid & 63, wave = tid >> 6;
    for (int row = blockIdx.x * 8 + wave; row < M; row += gridDim.x * 8) {
        f32x4 y[4], x[4]; float ss = 0.f;
#pragma unroll
        for (int i = 0; i < 4; ++i) { y[i] = *(const f32x4*)(Y + (size_t)row * DM + i * 256 + lane * 4); x[i] = *(const f32x4*)(Xin + (size_t)row * DM + i * 256 + lane * 4);
            ss += y[i][0] * y[i][0] + y[i][1] * y[i][1] + y[i][2] * y[i][2] + y[i][3] * y[i][3]; }
        ss = wave_sum(ss);
        const float rstd = rsqrtf(ss * (1.0f / DM) + RMS_EPS);
        float s2 = 0.f;
#pragma unroll
        for (int i = 0; i < 4; ++i) { const f32x4 g = *(const f32x4*)(gpost + i * 256 + lane * 4);
            x[i] = x[i] + y[i] * rstd * g; s2 += x[i][0] * x[i][0] + x[i][1] * x[i][1] + x[i][2] * x[i][2] + x[i][3] * x[i][3];
            *(f32x4*)(Xout + (size_t)row * DM + i * 256 + lane * 4) = x[i]; }
        if (XB) {
            s2 = wave_sum(s2);
            const float r2 = rsqrtf(s2 * (1.0f / DM) + RMS_EPS);
#pragma unroll
            for (int i = 0; i < 4; ++i) { uint2 w; w.x = pk2(x[i][0] * r2, x[i][1] * r2); w.y = pk2(x[i][2] * r2, x[i][3] * r2); *(uint2*)(XB + (size_t)row * DM + i * 256 + lane * 4) = w; }
        }
    }
}

__device__ void conv_job(const Params& p, int l, int job, float* lds) {
    const int tid = tid_(), lane = tid & 63, wave = tid >> 6;
    const int b = job / (SEQ / 32), t0 = (job % (SEQ / 32)) * 32;
    const bf16_t* PC = (const bf16_t*)(p.ws + WS_PC); bf16_t* MIX = (bf16_t*)(p.ws + WS_MIX);
    const float* dw = p.in[5] + l * TAPS * CW; const float* dwb = p.in[6] + l * CW; const float* lng = p.in[7] + l * CW; const float* lnb = p.in[8] + l * CW;
    const float* pw = p.in[9] + (size_t)l * CW * CW; const float* pwb = p.in[10] + l * CW;
    float* u = lds;
    float* cv = lds + 62 * 256;
    for (int idx = tid; idx < 62 * 256; idx += 512) {
        const int r = idx >> 8, c = idx & 255, t = t0 - 30 + r;
        float v = 0.f;
        if (t >= 0) { const bf16_t* pr = PC + (size_t)(b * SEQ + t) * PC_W; v = bf2f(pr[c]) * sigmoidf_(bf2f(pr[256 + c])); }
        u[idx] = v;
    }
    __syncthreads();
    for (int idx = tid; idx < 32 * 256; idx += 512) {
        const int tt = idx >> 8, c = idx & 255;
        float a = dwb[c];
#pragma unroll 4
        for (int j = 0; j < TAPS; ++j) a += dw[j * CW + c] * u[(tt + j) * 256 + c];
        cv[idx] = a;
    }
    __syncthreads();
    for (int q = 0; q < 4; ++q) {
        const int tt = wave * 4 + q; float x[4], s = 0.f;
#pragma unroll
        for (int i = 0; i < 4; ++i) { x[i] = cv[tt * 256 + lane + 64 * i]; s += x[i]; }
        const float mean = wave_sum(s) * (1.0f / CW); float vs = 0.f;
#pragma unroll
        for (int i = 0; i < 4; ++i) { const float d = x[i] - mean; vs += d * d; }
        const float rstd = rsqrtf(wave_sum(vs) * (1.0f / CW) + LN_EPS);
#pragma unroll
        for (int i = 0; i < 4; ++i) { const int c = lane + 64 * i; cv[tt * 256 + c] = siluf_((x[i] - mean) * rstd * lng[c] + lnb[c]); }
    }
    __syncthreads();
    {
        const int n = tid & 255, half = tid >> 8;
        float acc[16];
#pragma unroll
        for (int i = 0; i < 16; ++i) acc[i] = pwb[n];
#pragma unroll 2
        for (int k = 0; k < CW; ++k) {
            const float w = pw[(size_t)k * CW + n];
#pragma unroll
            for (int i = 0; i < 16; ++i) acc[i] += cv[(half * 16 + i) * 256 + k] * w;
        }
#pragma unroll
        for (int i = 0; i < 16; ++i) { const size_t row = (size_t)b * SEQ + t0 + half * 16 + i;
            const float g = bf2f(PC[row * PC_W + 512 + n]);
            MIX[row * DM + n] = f2bf(acc[i] * siluf_(g)); }
    }
    __syncthreads();
}

constexpr int CV_AS = 264;
__device__ void conv_job64(const Params& p, int l, int job, unsigned char* lds) {
    const int tid = tid_(), lane = tid & 63, wave = tid >> 6, fr = lane & 15, fq = lane >> 4;
    const int b = job >> 5, t0 = (job & 31) * 64;
    const bf16_t* PC = (const bf16_t*)(p.ws + WS_PC); bf16_t* MIX = (bf16_t*)(p.ws + WS_MIX);
    const float* dw = p.in[5] + l * TAPS * CW; const float* dwb = p.in[6] + l * CW; const float* lng = p.in[7] + l * CW; const float* lnb = p.in[8] + l * CW;
    const bf16_t* pwT = (const bf16_t*)(p.ws + WS_WPW) + (size_t)l * CW * CW; const float* pwb = p.in[10] + l * CW;
    float* u = (float*)lds;
    bf16_t* act = (bf16_t*)(lds + 94 * 256 * 4);
    for (int idx = tid; idx < 94 * 32; idx += 512) {
        const int r = idx >> 5, c8 = (idx & 31) * 8, t = t0 - 30 + r;
        float v[8];
        if (t >= 0) { const bf16_t* pr = PC + ((size_t)b * SEQ + t) * PC_W + c8; const bf16x8 a = *(const bf16x8*)pr, g = *(const bf16x8*)(pr + 256);
#pragma unroll
            for (int e = 0; e < 8; ++e) v[e] = bf2f((bf16_t)a[e]) * __builtin_amdgcn_rcpf(1.0f + __builtin_amdgcn_exp2f(-1.4426950408889634f * bf2f((bf16_t)g[e]))); }
        else {
#pragma unroll
            for (int e = 0; e < 8; ++e) v[e] = 0.f; }
        *(f32x4*)(u + r * 256 + c8) = (f32x4){v[0], v[1], v[2], v[3]}; *(f32x4*)(u + r * 256 + c8 + 4) = (f32x4){v[4], v[5], v[6], v[7]};
    }
    __syncthreads();
    const int c = tid & 255, half = tid >> 8;
    float acc[32];
    {
        float w[TAPS];
#pragma unroll
        for (int j = 0; j < TAPS; ++j) w[j] = dw[j * CW + c];
        const float bias = dwb[c];
#pragma unroll
        for (int i = 0; i < 32; ++i) acc[i] = bias;
        const float* up = u + (half * 32) * 256 + c;
#pragma unroll
        for (int rr = 0; rr < 62; ++rr) {
            const float uv = up[rr * 256];
#pragma unroll
            for (int i = 0; i < 32; ++i) { if (rr - i >= 0 && rr - i < TAPS) acc[i] += w[rr - i] * uv; }
        }
    }
    __syncthreads();
    float* cv = u;
#pragma unroll
    for (int i = 0; i < 32; ++i) cv[(half * 32 + i) * 256 + c] = acc[i];
    __syncthreads();
#pragma unroll 2
    for (int q = 0; q < 8; ++q) {
        const int tt = wave * 8 + q; const f32x4 x = *(const f32x4*)(cv + tt * 256 + lane * 4);
        const float mean = wave_sum(x[0] + x[1] + x[2] + x[3]) * (1.0f / CW);
        const f32x4 d = x - mean;
        const float rstd = rsqrtf(wave_sum(d[0] * d[0] + d[1] * d[1] + d[2] * d[2] + d[3] * d[3]) * (1.0f / CW) + LN_EPS);
        const f32x4 g = *(const f32x4*)(lng + lane * 4), bb = *(const f32x4*)(lnb + lane * 4);
        float y[4];
#pragma unroll
        for (int e = 0; e < 4; ++e) { const float v = d[e] * rstd * g[e] + bb[e]; y[e] = v * __builtin_amdgcn_rcpf(1.0f + __builtin_amdgcn_exp2f(-1.4426950408889634f * v)); }
        uint2 w; w.x = pk2(y[0], y[1]); w.y = pk2(y[2], y[3]); *(uint2*)(act + tt * CV_AS + lane * 4) = w;
    }
    __syncthreads();
    {
        f32x4 o[2][4];
#pragma unroll
        for (int i = 0; i < 2; ++i)
#pragma unroll
            for (int j = 0; j < 4; ++j) o[i][j] = (f32x4){0.f, 0.f, 0.f, 0.f};
#pragma unroll 2
        for (int kk = 0; kk < 8; ++kk) {
            bf16x8 a[2], bq[4];
#pragma unroll
            for (int i = 0; i < 2; ++i) a[i] = *(const bf16x8*)(pwT + (size_t)(wave * 32 + i * 16 + fr) * CW + kk * 32 + fq * 8);
#pragma unroll
            for (int j = 0; j < 4; ++j) bq[j] = *(const bf16x8*)(act + (j * 16 + fr) * CV_AS + kk * 32 + fq * 8);
#pragma unroll
            for (int i = 0; i < 2; ++i)
#pragma unroll
                for (int j = 0; j < 4; ++j) o[i][j] = __builtin_amdgcn_mfma_f32_16x16x32_bf16(a[i], bq[j], o[i][j], 0, 0, 0);
        }
#pragma unroll
        for (int i = 0; i < 2; ++i) {
            const int n0 = wave * 32 + i * 16 + fq * 4; const f32x4 bias = *(const f32x4*)(pwb + n0);
#pragma unroll
            for (int j = 0; j < 4; ++j) {
                const size_t row = (size_t)b * SEQ + t0 + j * 16 + fr;
                const uint2 gw = *(const uint2*)(PC + row * PC_W + 512 + n0);
                const float g0 = bf2f((bf16_t)(gw.x & 0xffff)), g1 = bf2f((bf16_t)(gw.x >> 16)), g2 = bf2f((bf16_t)(gw.y & 0xffff)), g3 = bf2f((bf16_t)(gw.y >> 16));
                const f32x4 v = o[i][j] + bias;
                uint2 w; w.x = pk2(v[0] * siluf_(g0), v[1] * siluf_(g1)); w.y = pk2(v[2] * siluf_(g2), v[3] * siluf_(g3));
                *(uint2*)(MIX + row * DM + n0) = w;
            }
        }
    }
    __syncthreads();
}

__device__ void attn_job(const Params& p, int job) {
    const int tid = tid_(), lane = tid & 63, wave = tid >> 6;
    const int bh = job >> 2, qb = job & 3, b = bh / NH, h = bh % NH;
    const bf16_t* PS = (const bf16_t*)(p.ws + WS_PS); bf16_t* MIX = (bf16_t*)(p.ws + WS_MIX);
    const int tw = qb * 512 + wave * 64, t = tw + lane;
    const size_t row = (size_t)b * SEQ + t;
    const float qs = 1.0f;
    const bf16_t* VT = (const bf16_t*)(p.ws + WS_VT) + (size_t)bh * HD * SEQ;
    float q[64], o[64];
    {
        const bf16_t* qp = PS + row * PS_W + h * HD;
#pragma unroll
        for (int i = 0; i < 8; ++i) { const bf16x8 v = *(const bf16x8*)(qp + i * 8);
#pragma unroll
            for (int j = 0; j < 8; ++j) { q[i * 8 + j] = bf2f((bf16_t)v[j]) * qs; o[i * 8 + j] = 0.f; } }
    }
    float rp = 1.0f;
    const int z = opaque_zero();
    for (int s = tw + 62; s >= 0; --s) {
        const bf16_t* kp = PS + ((size_t)b * SEQ + s) * PS_W + 384 + h * HD + z;
        float dot = 0.f;
#pragma unroll
        for (int i = 0; i < 8; ++i) { const bf16x8 v = *(const bf16x8*)(kp + i * 8);
#pragma unroll
            for (int j = 0; j < 8; ++j) dot += q[i * 8 + j] * bf2f((bf16_t)v[j]); }
        const bool act = s < t;
        const float e = __builtin_amdgcn_exp2f(dot);
        const float keep = __builtin_amdgcn_rcpf(1.0f + e);
        const float pr = act ? (1.0f - keep) * rp : 0.f;
        rp = act ? rp * keep : rp;
#pragma unroll
        for (int d = 0; d < 64; ++d) o[d] += pr * bf2f(VT[(size_t)d * SEQ + s + z]);
        if (__all(rp == 0.0f)) break;
    }
    const bf16_t* gp = PS + row * PS_W + 768 + h * HD;
    bf16_t* op = MIX + row * DM + CW + h * HD;
#pragma unroll
    for (int i = 0; i < 8; ++i) { const bf16x8 g = *(const bf16x8*)(gp + i * 8); uint4 w;
        w.x = pk2(o[i * 8 + 0] * siluf_(bf2f((bf16_t)g[0])), o[i * 8 + 1] * siluf_(bf2f((bf16_t)g[1])));
        w.y = pk2(o[i * 8 + 2] * siluf_(bf2f((bf16_t)g[2])), o[i * 8 + 3] * siluf_(bf2f((bf16_t)g[3])));
        w.z = pk2(o[i * 8 + 4] * siluf_(bf2f((bf16_t)g[4])), o[i * 8 + 5] * siluf_(bf2f((bf16_t)g[5])));
        w.w = pk2(o[i * 8 + 6] * siluf_(bf2f((bf16_t)g[6])), o[i * 8 + 7] * siluf_(bf2f((bf16_t)g[7])));
        *(uint4*)(op + i * 8) = w; }
}

typedef float f32x16 __attribute__((ext_vector_type(16)));
__device__ void attn_mfma_wave(const Params& p, int bh, int qblk) {
    const int tid = tid_(), lane = tid & 63, qi = lane & 31, hf = lane >> 5;
    const int b = bh / NH, h = bh % NH, q0 = qblk * 32;
    const bf16_t* PS = (const bf16_t*)(p.ws + WS_PS); const bf16_t* VT = (const bf16_t*)(p.ws + WS_VT) + (size_t)bh * HD * SEQ; bf16_t* MIX = (bf16_t*)(p.ws + WS_MIX);
    const size_t rowq = (size_t)b * SEQ + q0 + qi;
    bf16x8 Qf[4];
#pragma unroll
    for (int ks = 0; ks < 4; ++ks) Qf[ks] = *(const bf16x8*)(PS + rowq * PS_W + h * HD + ks * 16 + hf * 8);
    const int pi = (qi & 3) + 4 * (qi >> 3) + 16 * ((qi >> 2) & 1);
    const bf16_t* kbase = PS + ((size_t)b * SEQ + pi) * PS_W + SBW + h * HD + hf * 8;
    const bf16_t* vbase = VT + (size_t)qi * SEQ + hf * 16;
    f32x16 O0, O1;
#pragma unroll
    for (int r = 0; r < 16; ++r) { O0[r] = 0.f; O1[r] = 0.f; }
    float rp = 1.0f;
    for (int kt = qblk; kt >= 0; --kt) {
        const int s0 = kt * 32;
        bf16x8 Kf[4], Vf[2][2];
#pragma unroll
        for (int ks = 0; ks < 4; ++ks) Kf[ks] = *(const bf16x8*)(kbase + (size_t)s0 * PS_W + ks * 16);
#pragma unroll
        for (int db = 0; db < 2; ++db)
#pragma unroll
            for (int s = 0; s < 2; ++s) Vf[db][s] = *(const bf16x8*)(vbase + (size_t)db * 32 * SEQ + s0 + s * 8);
        f32x16 S;
#pragma unroll
        for (int r = 0; r < 16; ++r) S[r] = 0.f;
#pragma unroll
        for (int ks = 0; ks < 4; ++ks) S = __builtin_amdgcn_mfma_f32_32x32x16_bf16(Kf[ks], Qf[ks], S, 0, 0, 0);
        float keep[16], beta[16];
        const bool diag = kt == qblk;
        float tot = 1.0f;
#pragma unroll
        for (int r = 0; r < 16; ++r) {
            const float e = __builtin_amdgcn_exp2f(S[r]);
            float k_ = __builtin_amdgcn_rcpf(1.0f + e);
            float b_ = 1.0f - k_;
            if (diag && (hf * 16 + r >= qi)) { k_ = 1.0f; b_ = 0.f; }
            keep[r] = k_; beta[r] = b_; tot *= k_;
        }
        const float toto = __shfl_xor(tot, 32);
        float e = hf ? rp : rp * toto;
        float pw[16];
#pragma unroll
        for (int r = 15; r >= 0; --r) { pw[r] = beta[r] * e; e *= keep[r]; }
        rp = rp * tot * toto;
        bf16x8 Pf[2];
#pragma unroll
        for (int s = 0; s < 2; ++s) {
            union { bf16x8 v; unsigned u[4]; } pk;
#pragma unroll
            for (int j = 0; j < 4; ++j) pk.u[j] = pk2(pw[8 * s + 2 * j], pw[8 * s + 2 * j + 1]);
            Pf[s] = pk.v;
        }
#pragma unroll
        for (int s = 0; s < 2; ++s) { O0 = __builtin_amdgcn_mfma_f32_32x32x16_bf16(Vf[0][s], Pf[s], O0, 0, 0, 0); O1 = __builtin_amdgcn_mfma_f32_32x32x16_bf16(Vf[1][s], Pf[s], O1, 0, 0, 0); }
        if (__ballot(rp != 0.0f) == 0ull) break;
    }
    const bf16_t* gp = PS + rowq * PS_W + 768 + h * HD; bf16_t* op = MIX + rowq * DM + CW + h * HD;
#pragma unroll
    for (int db = 0; db < 2; ++db)
#pragma unroll
        for (int g = 0; g < 4; ++g) {
            const int d0 = db * 32 + g * 8 + hf * 4;
            const uint2 gw = *(const uint2*)(gp + d0);
            const float g0 = bf2f((bf16_t)(gw.x & 0xffff)), g1 = bf2f((bf16_t)(gw.x >> 16)), g2 = bf2f((bf16_t)(gw.y & 0xffff)), g3 = bf2f((bf16_t)(gw.y >> 16));
            const f32x16& O = db ? O1 : O0;
            uint2 w; w.x = pk2(O[4 * g] * siluf_(g0), O[4 * g + 1] * siluf_(g1)); w.y = pk2(O[4 * g + 2] * siluf_(g2), O[4 * g + 3] * siluf_(g3));
            *(uint2*)(op + d0) = w;
        }
}

__device__ void rwkv_job(const Params& p, int l, int job, float* lds) {
    const int tid = tid_(), lane = tid & 63, wave = tid >> 6;
    const int b = job / NH, h = job % NH;
    const bf16_t* PR = (const bf16_t*)(p.ws + WS_PR); const bf16_t* PG = (const bf16_t*)(p.ws + WS_PG);
    float* VF = (float*)(p.ws + WS_VF); bf16_t* MIX = (bf16_t*)(p.ws + WS_MIX);
    const float* mu = p.in[11] + l * 1216; const float* w0 = p.in[12] + l * RWW; const float* w2 = p.in[13] + l * LORA * RWW;
    const float* a0 = p.in[14] + l * RWW; const float* a2 = p.in[15] + l * LORA * RWW; const float* kks = p.in[16] + l * RWW; const float* ka = p.in[17] + l * RWW;
    const float* rk = p.in[18] + l * RWW; const float* gng = p.in[19] + l * RWW; const float* gnb = p.in[20] + l * RWW;
    const float* v0 = p.in[21]; const float* v1 = p.in[22]; const float* v2 = p.in[23];
    float* R = lds; float* W = R + 4096; float* K = W + 4096; float* V = K + 4096; float* A = V + 4096; float* Bm = A + 4096; float* Y = Bm + 4096;
    float* WD = Y + 4096; float* AD = WD + 2048; float* VL = AD + 2048;
    float S[64];
#pragma unroll
    for (int i = 0; i < 64; ++i) S[i] = 0.f;
    for (int c = 0; c < SEQ / 64; ++c) {
        const int t0 = c * 64;
        for (int idx = tid; idx < 64 * 64; idx += 512) {
            const int tt = idx >> 6, i = idx & 63, t = t0 + tt;
            const bf16_t* cur = PR + ((size_t)b * SEQ + t) * PR_W;
            const float xc = bf2f(cur[1152 + i]), xp = t > 0 ? bf2f(cur[1152 + i - PR_W]) : 0.f;
            const float f = xc + (xp - xc) * mu[1152 + i];
            if (i < 32) WD[tt * 32 + i] = tanhf(f); else AD[tt * 32 + i - 32] = f;
        }
        if (l > 0) {
            for (int idx = tid; idx < 64 * 32; idx += 512) {
                const int tt = idx >> 5, i = idx & 31, t = t0 + tt;
                const bf16_t* cur = PR + ((size_t)b * SEQ + t) * PR_W + 768;
                float a = 0.f;
                for (int cc = 0; cc < RWW; ++cc) {
                    const float xc = bf2f(cur[cc]), xp = t > 0 ? bf2f(cur[cc - PR_W]) : 0.f;
                    a += (xc + (xp - xc) * mu[768 + cc]) * v1[cc * LORA + i];
                }
                VL[idx] = a;
            }
        }
        __syncthreads();
        for (int idx = tid; idx < 64 * 64; idx += 512) {
            const int tt = idx >> 6, j = idx & 63, t = t0 + tt, cj = h * HD + j;
            const size_t row = (size_t)b * SEQ + t;
            const bf16_t* cur = PR + row * PR_W;
            const bool hp = t > 0;
            float rc = bf2f(cur[cj]), kc = bf2f(cur[384 + cj]), vc = bf2f(cur[768 + cj]);
            const float rp_ = hp ? bf2f(cur[cj - PR_W]) : 0.f, kp_ = hp ? bf2f(cur[384 + cj - PR_W]) : 0.f, vp_ = hp ? bf2f(cur[768 + cj - PR_W]) : 0.f;
            rc += (rp_ - rc) * mu[cj]; kc += (kp_ - kc) * mu[384 + cj]; vc += (vp_ - vc) * mu[768 + cj];
            float wl = w0[cj], al = a0[cj];
#pragma unroll 8
            for (int i = 0; i < LORA; ++i) { wl += WD[tt * 32 + i] * w2[i * RWW + cj]; al += AD[tt * 32 + i] * a2[i * RWW + cj]; }
            const float sp = fmaxf(-wl, 0.f) + log1pf(__expf(-fabsf(wl)));
            const float decay = __expf(-__expf(-sp - 0.5f));
            const float alr = sigmoidf_(al);
            if (l > 0) {
                float vg = v0[cj];
#pragma unroll 8
                for (int i = 0; i < LORA; ++i) vg += VL[tt * 32 + i] * v2[i * RWW + cj];
                vg = sigmoidf_(vg);
                vc = vc + (VF[row * RWW + cj] - vc) * vg;
            } else VF[row * RWW + cj] = vc;
            R[idx] = rc; W[idx] = decay; V[idx] = vc;
            K[idx] = kc * (1.0f + (alr - 1.0f) * ka[cj]);
            A[idx] = kc * kks[cj];
            Bm[idx] = alr;
        }
        __syncthreads();
        for (int q = 0; q < 8; ++q) {
            const int tt = wave * 8 + q; const float kk = A[tt * 64 + lane];
            const float nrm = sqrtf(wave_sum(kk * kk));
            const float kn = kk / fmaxf(nrm, 1e-12f);
            A[tt * 64 + lane] = -kn; Bm[tt * 64 + lane] = kn * Bm[tt * 64 + lane];
        }
        __syncthreads();
        if (wave == 0) {
            for (int tt = 0; tt < 64; ++tt) {
                const f32x4* a4 = (const f32x4*)(A + tt * 64); const f32x4* w4 = (const f32x4*)(W + tt * 64); const f32x4* b4 = (const f32x4*)(Bm + tt * 64);
                const f32x4* k4 = (const f32x4*)(K + tt * 64); const f32x4* r4 = (const f32x4*)(R + tt * 64);
                float sa = 0.f;
#pragma unroll
                for (int i = 0; i < 16; ++i) { const f32x4 a = a4[i]; sa += S[4 * i] * a[0] + S[4 * i + 1] * a[1] + S[4 * i + 2] * a[2] + S[4 * i + 3] * a[3];
                    if ((i & 7) == 7) asm volatile("" ::: "memory"); }
                const float vv = V[tt * 64 + lane];
                float y = 0.f;
#pragma unroll
                for (int i = 0; i < 16; ++i) { const f32x4 w = w4[i], bb = b4[i], kk = k4[i], rr = r4[i];
#pragma unroll
                    for (int e = 0; e < 4; ++e) { const float s = S[4 * i + e] * w[e] + sa * bb[e] + vv * kk[e]; S[4 * i + e] = s; y += s * rr[e]; }
                    if ((i & 1) == 1) asm volatile("" ::: "memory"); }
                Y[tt * 64 + lane] = y;
            }
        }
        __syncthreads();
        for (int q = 0; q < 8; ++q) {
            const int tt = wave * 8 + q, t = t0 + tt, cj = h * HD + lane; const size_t row = (size_t)b * SEQ + t;
            const float y = Y[tt * 64 + lane];
            const float mean = wave_sum(y) * (1.0f / HD); const float d = y - mean;
            const float var = wave_sum(d * d) * (1.0f / HD);
            const float yn = d * rsqrtf(var + GN_EPS) * gng[cj] + gnb[cj];
            const float bonus = wave_sum(R[tt * 64 + lane] * K[tt * 64 + lane] * rk[cj]);
            const float o = yn + bonus * V[tt * 64 + lane];
            const float g = bf2f(PG[row * PG_W + cj]);
            MIX[row * DM + CW + SBW + cj] = f2bf(o * siluf_(g));
        }
        __syncthreads();
    }
}

constexpr int TS = 72;
constexpr int TILE_B = 64 * TS * 2;
constexpr int AABS = 68, XTS = 65, CSS = 65;

__device__ __forceinline__ f32x4 mm_tile(const bf16_t* X, int m0, const bf16_t* Yt, int n0, int K, int fr, int fq, f32x4 acc) {
#pragma unroll
    for (int kk = 0; kk < 2; ++kk) {
        if (kk * 32 < K) {
            const bf16x8 a = *(const bf16x8*)(X + (m0 + fr) * TS + kk * 32 + fq * 8);
            const bf16x8 b = *(const bf16x8*)(Yt + (n0 + fr) * TS + kk * 32 + fq * 8);
            acc = __builtin_amdgcn_mfma_f32_16x16x32_bf16(a, b, acc, 0, 0, 0);
        }
    }
    return acc;
}
__device__ __forceinline__ uint2 pk4(const f32x4& v) { uint2 w; w.x = pk2(v[0], v[1]); w.y = pk2(v[2], v[3]); return w; }

__device__ void rwkv_b1_job(const Params& p, int l, int jb, unsigned char* lds) {
    const int tid = tid_(), lane = tid & 63, wave = tid >> 6, fr = lane & 15, fq = lane >> 4;
    const int bh = jb >> 5, c = jb & 31, b = bh / NH, h = bh % NH, t0 = c * 64;
    const bf16_t* PR = (const bf16_t*)(p.ws + WS_PR); float* VF = (float*)(p.ws + WS_VF);
    const float* mu = p.in[11] + l * 1216; const float* w0 = p.in[12] + l * RWW; const float* w2 = p.in[13] + l * LORA * RWW;
    const float* a0 = p.in[14] + l * RWW; const float* a2 = p.in[15] + l * LORA * RWW; const float* kks = p.in[16] + l * RWW; const float* ka = p.in[17] + l * RWW;
    const float* rk = p.in[18] + l * RWW; const float* v0 = p.in[21]; const float* v2 = p.in[23];
    bf16_t* T_At = (bf16_t*)lds; bf16_t* T_Rt = T_At + 64 * TS; bf16_t* T_Bt = T_Rt + 64 * TS; bf16_t* T_Kt = T_Bt + 64 * TS;
    bf16_t* T_VT = T_Kt + 64 * TS; bf16_t* T_bhT = T_VT + 64 * TS; bf16_t* T_khT = T_bhT + 64 * TS;
    bf16_t* T_Aak = T_khT + 64 * TS; bf16_t* T_Arb = T_Aak + 64 * TS; bf16_t* T_Ark = T_Arb + 64 * TS;
    bf16_t* T_WT = T_At; bf16_t* T_U0T = T_Bt;
    float* Aab = (float*)(lds + 10 * TILE_B);
    float* XT = (float*)(lds + 10 * TILE_B + 64 * AABS * 4);
    float* PCv = XT + 128 * XTS;
    float* CS = (float*)T_Aak;
    constexpr int LS = 33;
    float* WD = Aab; float* AD = WD + 64 * LS;
    float* VL = XT + 64 * XTS;
    float* WLT = (float*)lds; float* ALT = WLT + 64 * XTS; float* VGT = ALT + 64 * XTS;
    float* TI = PCv + 64;

    float rr[8], kk_[8], vv[8], aa[8], bb[8], lw[8];
    const int tt = tid >> 3, j0 = (tid & 7) * 8, t = t0 + tt, cj0 = h * HD + j0;
    const size_t row = (size_t)b * SEQ + t;
    for (int repA = 0; repA < ((PROBE_REP & 128) ? 2 : 1); ++repA) {
    for (int idx = tid; idx < 2048; idx += 512) {
        const int tt = idx >> 5, i = idx & 31, t = t0 + tt;
        const bf16_t* cur = PR + ((size_t)b * SEQ + t) * PR_W; const bool hp = t > 0;
        { const float xc = bf2f(cur[1152 + i]), xp = hp ? bf2f(cur[1152 + i - PR_W]) : 0.f; { const float x_ = xc + (xp - xc) * mu[1152 + i]; WD[tt * LS + i] = 1.0f - 2.0f * __builtin_amdgcn_rcpf(1.0f + __builtin_amdgcn_exp2f(2.8853900817779268f * x_)); } }
        { const float xc = bf2f(cur[1184 + i]), xp = hp ? bf2f(cur[1184 + i - PR_W]) : 0.f; AD[tt * LS + i] = xc + (xp - xc) * mu[1184 + i]; }
        if (l > 0) VL[tt * LS + i] = bf2f(cur[1216 + i]) + (hp ? bf2f(cur[1248 + i - PR_W]) : 0.f);
    }
    __syncthreads();
    {
        const int ntile = (l > 0 ? 3 : 2) * 16;
#pragma unroll 1
        for (int id = wave; id < ntile; id += 8) {
            const int L = id >> 4, ti = (id >> 2) & 3, tj = id & 3;
            const float* Xs = (L == 0 ? WD : (L == 1 ? AD : VL)) + (ti * 16 + fr) * LS + fq;
            const float* Wg = (L == 0 ? w2 : (L == 1 ? a2 : v2)) + (size_t)fq * RWW + h * HD + tj * 16 + fr;
            f32x4 acc = (f32x4){0.f, 0.f, 0.f, 0.f};
#pragma unroll
            for (int kk = 0; kk < 8; ++kk) acc = __builtin_amdgcn_mfma_f32_16x16x4f32(Xs[kk * 4], Wg[(size_t)kk * 4 * RWW], acc, 0, 0, 0);
            float* out = (L == 0 ? WLT : (L == 1 ? ALT : VGT)) + (tj * 16 + fr) * XTS + ti * 16 + fq * 4;
#pragma unroll
            for (int r = 0; r < 4; ++r) out[r] = acc[r];
        }
    }
    __syncthreads();
    {
        const bf16_t* cur = PR + row * PR_W; const bool hp = t > 0;
        const bf16x8 rc = *(const bf16x8*)(cur + cj0), kc = *(const bf16x8*)(cur + 384 + cj0), vc = *(const bf16x8*)(cur + 768 + cj0);
        bf16x8 rp = rc, kp = kc, vp = vc;
        if (hp) { rp = *(const bf16x8*)(cur + cj0 - PR_W); kp = *(const bf16x8*)(cur + 384 + cj0 - PR_W); vp = *(const bf16x8*)(cur + 768 + cj0 - PR_W); }
        float wl[8], al[8], vg[8];
#pragma unroll
        for (int e = 0; e < 8; ++e) {
            const float r_c = bf2f((bf16_t)rc[e]), k_c = bf2f((bf16_t)kc[e]), v_c = bf2f((bf16_t)vc[e]);
            const float r_p = hp ? bf2f((bf16_t)rp[e]) : 0.f, k_p = hp ? bf2f((bf16_t)kp[e]) : 0.f, v_p = hp ? bf2f((bf16_t)vp[e]) : 0.f;
            rr[e] = r_c + (r_p - r_c) * mu[cj0 + e]; kk_[e] = k_c + (k_p - k_c) * mu[384 + cj0 + e]; vv[e] = v_c + (v_p - v_c) * mu[768 + cj0 + e];
            wl[e] = w0[cj0 + e] + WLT[(j0 + e) * XTS + tt]; al[e] = a0[cj0 + e] + ALT[(j0 + e) * XTS + tt]; vg[e] = l > 0 ? v0[cj0 + e] + VGT[(j0 + e) * XTS + tt] : 0.f;
        }
        float ssq = 0.f, bon = 0.f;
#pragma unroll
        for (int e = 0; e < 8; ++e) {
            const float sp2 = fmaxf(-wl[e], 0.f) * 1.4426950408889634f + __builtin_amdgcn_logf(1.0f + __builtin_amdgcn_exp2f(-1.4426950408889634f * fabsf(wl[e])));
            lw[e] = -__builtin_amdgcn_exp2f(-sp2 - 0.7213475204444817f);
            const float alr = __builtin_amdgcn_rcpf(1.0f + __builtin_amdgcn_exp2f(-1.4426950408889634f * al[e]));
            if (l > 0) vv[e] = vv[e] + (VF[row * RWW + cj0 + e] - vv[e]) * __builtin_amdgcn_rcpf(1.0f + __builtin_amdgcn_exp2f(-1.4426950408889634f * vg[e])); else VF[row * RWW + cj0 + e] = vv[e];
            const float kkr = kk_[e] * kks[cj0 + e];
            kk_[e] = kk_[e] * (1.0f + (alr - 1.0f) * ka[cj0 + e]);
            aa[e] = kkr; bb[e] = alr; ssq += kkr * kkr; bon += rr[e] * kk_[e] * rk[cj0 + e];
        }
        ssq += __shfl_xor(ssq, 1); ssq += __shfl_xor(ssq, 2); ssq += __shfl_xor(ssq, 4);
        bon += __shfl_xor(bon, 1); bon += __shfl_xor(bon, 2); bon += __shfl_xor(bon, 4);
        const float inv = fminf(__builtin_amdgcn_rsqf(ssq), 1e12f);
        uint4 bvw; float bv[8];
#pragma unroll
        for (int e = 0; e < 8; ++e) { const float kn = aa[e] * inv; aa[e] = -kn; bb[e] = kn * bb[e]; bv[e] = bon * vv[e]; CS[tt * CSS + j0 + e] = lw[e]; }
        bvw.x = pk2(bv[0], bv[1]); bvw.y = pk2(bv[2], bv[3]); bvw.z = pk2(bv[4], bv[5]); bvw.w = pk2(bv[6], bv[7]);
        *(uint4*)((bf16_t*)(p.ws + WS_CH_BV) + (size_t)jb * 4096 + tt * 64 + j0) = bvw;
    }
    __syncthreads();
#pragma unroll
    for (int e = 0; e < 8; ++e) {
        const int j = wave * 8 + e; float x = CS[lane * CSS + j];
#pragma unroll
        for (int o = 1; o < 64; o <<= 1) { const float y = __shfl_up(x, o); if (lane >= o) x += y; }
        CS[lane * CSS + j] = x;
    }
    __syncthreads();
    }
    float at[8];
    for (int repB = 0; repB < ((PROBE_REP & 256) ? 2 : 1); ++repB) {
    {
        float rt[8], bt[8], kt[8];
#pragma unroll
        for (int e = 0; e < 8; ++e) {
            const int j = j0 + e; const float cs = CS[tt * CSS + j], csC = CS[63 * CSS + j];
            const float e_in = __expf(cs), e_ex = __expf(cs - lw[e]), e_ng = __expf(-cs), e_ht = __expf(csC - cs);
            at[e] = aa[e] * e_ex; rt[e] = rr[e] * e_in; bt[e] = bb[e] * e_ng; kt[e] = kk_[e] * e_ng;
            T_VT[j * TS + tt] = f2bf(vv[e]); T_bhT[j * TS + tt] = f2bf(bb[e] * e_ht); T_khT[j * TS + tt] = f2bf(kk_[e] * e_ht);
            XT[j * XTS + tt] = at[e];
            if (tt == 63) PCv[j] = __expf(csC);
        }
        uint4 w;
        w.x = pk2(at[0], at[1]); w.y = pk2(at[2], at[3]); w.z = pk2(at[4], at[5]); w.w = pk2(at[6], at[7]); *(uint4*)(T_At + tt * TS + j0) = w;
        w.x = pk2(rt[0], rt[1]); w.y = pk2(rt[2], rt[3]); w.z = pk2(rt[4], rt[5]); w.w = pk2(rt[6], rt[7]); *(uint4*)(T_Rt + tt * TS + j0) = w;
        w.x = pk2(bt[0], bt[1]); w.y = pk2(bt[2], bt[3]); w.z = pk2(bt[4], bt[5]); w.w = pk2(bt[6], bt[7]); *(uint4*)(T_Bt + tt * TS + j0) = w;
        w.x = pk2(kt[0], kt[1]); w.y = pk2(kt[2], kt[3]); w.z = pk2(kt[4], kt[5]); w.w = pk2(kt[6], kt[7]); *(uint4*)(T_Kt + tt * TS + j0) = w;
    }
    __syncthreads();
    }
    for (int repD = 0; repD < ((PROBE_REP & 1024) ? 2 : 1); ++repD) {
    if (repD) { for (int e = 0; e < 8; ++e) XT[(j0 + e) * XTS + tt] = at[e]; __syncthreads(); }
    for (int repC = 0; repC < ((PROBE_REP & 512) ? 2 : 1); ++repC) {
#pragma unroll 1
    for (int q = 0; q < 8; ++q) {
        const int id = wave * 8 + q, mat = id >> 4, ti = (id >> 2) & 3, tj = id & 3;
        const bf16_t* As = (mat == 0 || mat == 2) ? T_Bt : T_Kt; const bf16_t* Bs = (mat < 2) ? T_At : T_Rt;
        f32x4 acc = (f32x4){0.f, 0.f, 0.f, 0.f};
        if (ti <= tj) acc = mm_tile(As, ti * 16, Bs, tj * 16, 64, fr, fq, acc);
        const int tcol = tj * 16 + fr, i0 = ti * 16 + fq * 4;
#pragma unroll
        for (int r = 0; r < 4; ++r) { const bool keep = (mat < 2) ? (i0 + r < tcol) : (i0 + r <= tcol); if (!keep) acc[r] = 0.f; }
        if (mat == 0) *(f32x4*)(Aab + tcol * AABS + i0) = acc;
        else { bf16_t* dst = (mat == 1 ? T_Aak : (mat == 2 ? T_Arb : T_Ark)); *(uint2*)(dst + tcol * TS + i0) = pk4(acc); }
    }
    __syncthreads();
    if (wave == 0) {
        const int blk = lane >> 4, cc = lane & 15; const float* ar = Aab + (16 * blk) * AABS + 16 * blk;
        float x[16];
#pragma unroll
        for (int u = 0; u < 16; ++u) { float v = (u == cc) ? 1.0f : 0.f;
#pragma unroll
            for (int i = 0; i < u; ++i) v += ar[u * AABS + i] * x[i];
            x[u] = v; }
#pragma unroll
        for (int u = 0; u < 16; ++u) TI[(blk * 16 + u) * 17 + cc] = x[u];
    } else {
#pragma unroll 1
        for (int id = wave - 1; id < 16; id += 7) {
            const int ti = id >> 2, tj = id & 3;
            f32x4 acc = mm_tile(T_Aak, ti * 16, T_VT, tj * 16, 64, fr, fq, (f32x4){0.f, 0.f, 0.f, 0.f});
            const int j = tj * 16 + fr, tr = ti * 16 + fq * 4;
#pragma unroll
            for (int r = 0; r < 4; ++r) XT[(64 + j) * XTS + tr + r] = acc[r];
        }
    }
    __syncthreads();
    }
    {
        float* xc = XT + (wave * 16 + fr) * XTS;
#pragma unroll
        for (int I = 0; I < 4; ++I) {
            f32x4 acc;
#pragma unroll
            for (int r = 0; r < 4; ++r) acc[r] = xc[16 * I + 4 * fq + r];
#pragma unroll
            for (int J = 0; J < I; ++J)
#pragma unroll
                for (int kk = 0; kk < 4; ++kk) acc = __builtin_amdgcn_mfma_f32_16x16x4f32(Aab[(16 * I + fr) * AABS + 16 * J + 4 * kk + fq], xc[16 * J + 4 * kk + fq], acc, 0, 0, 0);
#pragma unroll
            for (int r = 0; r < 4; ++r) xc[16 * I + 4 * fq + r] = acc[r];
            asm volatile("s_waitcnt lgkmcnt(0)" ::: "memory");
            f32x4 xs = (f32x4){0.f, 0.f, 0.f, 0.f};
#pragma unroll
            for (int kk = 0; kk < 4; ++kk) xs = __builtin_amdgcn_mfma_f32_16x16x4f32(TI[(I * 16 + fr) * 17 + 4 * kk + fq], xc[16 * I + 4 * kk + fq], xs, 0, 0, 0);
            asm volatile("s_waitcnt lgkmcnt(0)" ::: "memory");
#pragma unroll
            for (int r = 0; r < 4; ++r) xc[16 * I + 4 * fq + r] = xs[r];
            asm volatile("s_waitcnt lgkmcnt(0)" ::: "memory");
        }
    }
    __syncthreads();
    {
        const int col = tid >> 2, tg = (tid & 3) * 16;
        const float* xr = XT + col * XTS + tg; bf16_t* dst = (col < 64 ? T_WT + col * TS : T_U0T + (col - 64) * TS) + tg;
        uint4 w0_, w1_;
        w0_.x = pk2(xr[0], xr[1]); w0_.y = pk2(xr[2], xr[3]); w0_.z = pk2(xr[4], xr[5]); w0_.w = pk2(xr[6], xr[7]);
        w1_.x = pk2(xr[8], xr[9]); w1_.y = pk2(xr[10], xr[11]); w1_.z = pk2(xr[12], xr[13]); w1_.w = pk2(xr[14], xr[15]);
        *(uint4*)dst = w0_; *(uint4*)(dst + 8) = w1_;
    }
    __syncthreads();
    {
        bf16_t* gM = (bf16_t*)(p.ws + WS_CH_M) + (size_t)jb * 4096; bf16_t* gNT = (bf16_t*)(p.ws + WS_CH_NT) + (size_t)jb * 4096;
        bf16_t* gG = (bf16_t*)(p.ws + WS_CH_G) + (size_t)jb * 4096; bf16_t* gY1T = (bf16_t*)(p.ws + WS_CH_Y1T) + (size_t)jb * 4096;
#pragma unroll 1
        for (int q = 0; q < 8; ++q) {
            const int id = wave * 8 + q, mat = id >> 4, ti = (id >> 2) & 3, tj = id & 3;
            const int col = tj * 16 + fr, r0 = ti * 16 + fq * 4;
            f32x4 acc = (f32x4){0.f, 0.f, 0.f, 0.f};
            if (mat == 0) {
                acc = mm_tile(T_WT, ti * 16, T_Arb, tj * 16, 64, fr, fq, acc);
                const uint2 rw = *(const uint2*)(T_Rt + col * TS + r0);
                acc[0] += bf2f((bf16_t)(rw.x & 0xffff)); acc[1] += bf2f((bf16_t)(rw.x >> 16)); acc[2] += bf2f((bf16_t)(rw.y & 0xffff)); acc[3] += bf2f((bf16_t)(rw.y >> 16));
                *(uint2*)(gG + col * 64 + r0) = pk4(acc);
            } else if (mat == 1) {
                acc = mm_tile(T_Arb, ti * 16, T_U0T, tj * 16, 64, fr, fq, acc);
                acc = mm_tile(T_Ark, ti * 16, T_VT, tj * 16, 64, fr, fq, acc);
                *(uint2*)(gY1T + col * 64 + r0) = pk4(acc);
            } else if (mat == 2) {
                acc = mm_tile(T_WT, ti * 16, T_bhT, tj * 16, 64, fr, fq, acc);
                const float pc = PCv[col];
#pragma unroll
                for (int r = 0; r < 4; ++r) if (r0 + r == col) acc[r] += pc;
                *(uint2*)(gM + col * 64 + r0) = pk4(acc);
            } else {
                acc = mm_tile(T_bhT, ti * 16, T_U0T, tj * 16, 64, fr, fq, acc);
                acc = mm_tile(T_khT, ti * 16, T_VT, tj * 16, 64, fr, fq, acc);
                *(uint2*)(gNT + col * 64 + r0) = pk4(acc);
            }
        }
    }
    __syncthreads();
    }
}

__device__ void rwkv_b2_job(const Params& p, int bh, unsigned char* lds) {
    const int tid = tid_(), lane = tid & 63, wave = tid >> 6, fr = lane & 15, fq = lane >> 4;
    const int mi = wave >> 1, nj0 = (wave & 1) * 2;
    const bf16_t* gM = (const bf16_t*)(p.ws + WS_CH_M); const bf16_t* gNT = (const bf16_t*)(p.ws + WS_CH_NT); bf16_t* gZT = (bf16_t*)(p.ws + WS_ZT);
    bf16_t* zbuf = (bf16_t*)lds;
    f32x4 z[2];
    z[0] = (f32x4){0.f, 0.f, 0.f, 0.f}; z[1] = z[0];
    const int c0 = mi * 16 + fq * 4;
#pragma unroll 1
    for (int c = 0; c < SEQ / 64; ++c) {
        const size_t jb = (size_t)bh * 32 + c;
        bf16_t* zh = zbuf + (c & 1) * 2 * 64 * TS; bf16_t* zl = zh + 64 * TS;
#pragma unroll
        for (int q = 0; q < 2; ++q) {
            const int j = (nj0 + q) * 16 + fr;
            const uint2 hi = pk4(z[q]);
            f32x4 lo;
            lo[0] = z[q][0] - bf2f((bf16_t)(hi.x & 0xffff)); lo[1] = z[q][1] - bf2f((bf16_t)(hi.x >> 16)); lo[2] = z[q][2] - bf2f((bf16_t)(hi.y & 0xffff)); lo[3] = z[q][3] - bf2f((bf16_t)(hi.y >> 16));
            *(uint2*)(zh + j * TS + c0) = hi; *(uint2*)(zl + j * TS + c0) = pk4(lo);
            *(uint2*)(gZT + jb * 4096 + j * 64 + c0) = hi;
        }
        __syncthreads();
        bf16x8 am[2];
#pragma unroll
        for (int kk = 0; kk < 2; ++kk) am[kk] = *(const bf16x8*)(gM + jb * 4096 + (mi * 16 + fr) * 64 + kk * 32 + fq * 8);
#pragma unroll
        for (int q = 0; q < 2; ++q) {
            const int j = (nj0 + q) * 16 + fr;
            const uint2 nw = *(const uint2*)(gNT + jb * 4096 + j * 64 + c0);
            f32x4 acc; acc[0] = bf2f((bf16_t)(nw.x & 0xffff)); acc[1] = bf2f((bf16_t)(nw.x >> 16)); acc[2] = bf2f((bf16_t)(nw.y & 0xffff)); acc[3] = bf2f((bf16_t)(nw.y >> 16));
#pragma unroll
            for (int kk = 0; kk < 2; ++kk) {
                const bf16x8 bh_ = *(const bf16x8*)(zh + j * TS + kk * 32 + fq * 8), bl_ = *(const bf16x8*)(zl + j * TS + kk * 32 + fq * 8);
                acc = __builtin_amdgcn_mfma_f32_16x16x32_bf16(am[kk], bh_, acc, 0, 0, 0);
                acc = __builtin_amdgcn_mfma_f32_16x16x32_bf16(am[kk], bl_, acc, 0, 0, 0);
            }
            z[q] = acc;
        }
    }
    __syncthreads();
}

__device__ void rwkv_b3_pair(const Params& p, int l, int pair) {
    const int tid = tid_(), lane = tid & 63, wave = tid >> 6, fr = lane & 15, fq = lane >> 4;
    const int jb = pair * 2 + (wave >> 2), mi = wave & 3;
    const int bh = jb >> 5, c = jb & 31, b = bh / NH, h = bh % NH;
    const bf16_t* gG = (const bf16_t*)(p.ws + WS_CH_G) + (size_t)jb * 4096; const bf16_t* gY1T = (const bf16_t*)(p.ws + WS_CH_Y1T) + (size_t)jb * 4096;
    const bf16_t* gBV = (const bf16_t*)(p.ws + WS_CH_BV) + (size_t)jb * 4096; const bf16_t* gZT = (const bf16_t*)(p.ws + WS_ZT) + (size_t)jb * 4096;
    const bf16_t* PG = (const bf16_t*)(p.ws + WS_PG); bf16_t* MIX = (bf16_t*)(p.ws + WS_MIX);
    const float* gng = p.in[19] + l * RWW; const float* gnb = p.in[20] + l * RWW;
    const int tr = mi * 16 + fq * 4;
    bf16x8 ag[2];
#pragma unroll
    for (int kk = 0; kk < 2; ++kk) ag[kk] = *(const bf16x8*)(gG + (mi * 16 + fr) * 64 + kk * 32 + fq * 8);
    f32x4 acc[4];
#pragma unroll
    for (int nj = 0; nj < 4; ++nj) {
        const int j = nj * 16 + fr;
        const uint2 yw = *(const uint2*)(gY1T + j * 64 + tr);
        acc[nj][0] = bf2f((bf16_t)(yw.x & 0xffff)); acc[nj][1] = bf2f((bf16_t)(yw.x >> 16)); acc[nj][2] = bf2f((bf16_t)(yw.y & 0xffff)); acc[nj][3] = bf2f((bf16_t)(yw.y >> 16));
#pragma unroll
        for (int kk = 0; kk < 2; ++kk) { const bf16x8 bz = *(const bf16x8*)(gZT + j * 64 + kk * 32 + fq * 8); acc[nj] = __builtin_amdgcn_mfma_f32_16x16x32_bf16(ag[kk], bz, acc[nj], 0, 0, 0); }
    }
#pragma unroll
    for (int r = 0; r < 4; ++r) {
        float s = acc[0][r] + acc[1][r] + acc[2][r] + acc[3][r];
        s += __shfl_xor(s, 1); s += __shfl_xor(s, 2); s += __shfl_xor(s, 4); s += __shfl_xor(s, 8);
        const float mean = s * (1.0f / HD);
        float d[4], vs = 0.f;
#pragma unroll
        for (int nj = 0; nj < 4; ++nj) { d[nj] = acc[nj][r] - mean; vs += d[nj] * d[nj]; }
        vs += __shfl_xor(vs, 1); vs += __shfl_xor(vs, 2); vs += __shfl_xor(vs, 4); vs += __shfl_xor(vs, 8);
        const float rstd = rsqrtf(vs * (1.0f / HD) + GN_EPS);
        const int tt = tr + r; const size_t row = (size_t)b * SEQ + c * 64 + tt;
#pragma unroll
        for (int nj = 0; nj < 4; ++nj) {
            const int j = nj * 16 + fr, cj = h * HD + j;
            const float o = d[nj] * rstd * gng[cj] + gnb[cj] + bf2f(gBV[tt * 64 + j]);
            const float g = bf2f(PG[row * PG_W + cj]);
            MIX[row * DM + CW + SBW + cj] = f2bf(o * siluf_(g));
        }
    }
}

#ifndef ATTN_REF
#define ATTN_REF 0
#endif
#ifndef RWKV_REF
#define RWKV_REF 0
#endif
__device__ void phase_mix1(const Params& p, int l, unsigned char* lds) {
    constexpr int NAT = BATCH * NH * 4, NCV = BATCH * (SEQ / 32);
    const int G = gridDim.x;
#if RWKV_REF
    for (int job = blockIdx.x; job < BATCH * NH; job += G) rwkv_job(p, l, job, (float*)lds);
#else
    for (int rep = 0; rep < ((PROBE_REP & 1) ? 2 : 1); ++rep)
    for (int job = blockIdx.x; job < BATCH * NH * 32; job += G) rwkv_b1_job(p, l, job, lds);
#endif
    for (int rep = 0; rep < ((PROBE_REP & 2) ? 2 : 1); ++rep)
#if ATTN_REF
    for (int job = blockIdx.x; job < NAT; job += G) attn_job(p, job);
#else
    for (int job = blockIdx.x; job < NAT * 2; job += G) attn_mfma_wave(p, job >> 3, (job & 7) * 8 + (tid_() >> 6));
#endif
#ifndef CONV_REF
#define CONV_REF 0
#endif
    for (int rep = 0; rep < ((PROBE_REP & 4) ? 2 : 1); ++rep)
#if CONV_REF
    for (int job = blockIdx.x; job < NCV; job += G) conv_job(p, l, job, (float*)lds);
#else
    for (int job = blockIdx.x; job < BATCH * (SEQ / 64); job += G) conv_job64(p, l, job, lds);
#endif
}
__device__ void phase_mix2(const Params& p, int l, unsigned char* lds) {
#if !RWKV_REF
    for (int rep = 0; rep < ((PROBE_REP & 8) ? 2 : 1); ++rep)
    for (int job = blockIdx.x; job < BATCH * NH; job += gridDim.x) rwkv_b2_job(p, job, lds);
#endif
}
__device__ void phase_mix3(const Params& p, int l, unsigned char* lds) {
#if !RWKV_REF
    for (int rep = 0; rep < ((PROBE_REP & 16) ? 2 : 1); ++rep)
    for (int pair = blockIdx.x; pair < BATCH * NH * 16; pair += gridDim.x) rwkv_b3_pair(p, l, pair);
#endif
}

#define LAS __attribute__((address_space(3)))
#define XB_TMO      128
#define XB_XCNT(j)  (256  + 64 * (j))
#define XB_XSUB(j)  (1280 + 64 * (j))
#define XB_XGEN(j)  (2304 + 64 * (j))
#define XB_TOP      3328
#define XB_TOPGEN   3392
#define XCD_BAR_WORDS 3456
#define XB_SPIN_CAP (1u << 18)

__device__ __forceinline__ unsigned xb_ld(unsigned* p)              { return __hip_atomic_load(p, __ATOMIC_RELAXED, __HIP_MEMORY_SCOPE_AGENT); }
__device__ __forceinline__ unsigned xb_add(unsigned* p, unsigned v) { return __hip_atomic_fetch_add(p, v, __ATOMIC_RELAXED, __HIP_MEMORY_SCOPE_AGENT); }
__device__ __forceinline__ unsigned xb_xcc_id() { return (unsigned)__builtin_amdgcn_s_getreg((3 << 11) | 20) & 0xFu; }
#define XB_SPIN(cond, bar) do { unsigned _sp = 0; while (cond) { __builtin_amdgcn_s_sleep(1); \
    if ((++_sp & 255u) == 0u) { if (xb_ld(&(bar)[XB_TMO])) break; if (_sp > XB_SPIN_CAP) { atomicAdd(&(bar)[XB_TMO], 1u); break; } } } } while (0)

struct XcdBarrier {
    unsigned* bar; unsigned x;
    volatile LAS unsigned* st;
};

__device__ __forceinline__ XcdBarrier xcd_barrier_post(unsigned* bar, volatile LAS unsigned* st) {
    XcdBarrier b; b.bar = bar; b.x = xb_xcc_id(); b.st = st;
    if (threadIdx.x == 0) (void)xb_add(&bar[XB_XCNT(b.x)], 1u);
    return b;
}
__device__ __forceinline__ void xcd_barrier_complete(unsigned* bar, unsigned x, unsigned& nloc, unsigned& nx) {
    const unsigned G = gridDim.x * gridDim.y * gridDim.z;
    unsigned sum, cnt, mine, sp = 0u;
    for (;;) {
        sum = 0u; cnt = 0u; mine = 0u;
#pragma unroll
        for (unsigned j = 0; j < 16; ++j) { const unsigned c = xb_ld(&bar[XB_XCNT(j)]); sum += c; cnt += (c > 0u) ? 1u : 0u; mine = (j == x) ? c : mine; }
        if (sum == G) break;
        __builtin_amdgcn_s_sleep(1);
        if ((++sp & 255u) == 0u) { if (xb_ld(&bar[XB_TMO])) break; if (sp > XB_SPIN_CAP) { atomicAdd(&bar[XB_TMO], 1u); break; } }
    }
    nloc = mine > 0u ? mine : 1u; nx = cnt > 0u ? cnt : 1u;
}

__device__ __forceinline__ void xcd_barrier(const XcdBarrier& b) {
    asm volatile("s_waitcnt vmcnt(0)" ::: "memory");
    __syncthreads();
    if (threadIdx.x == 0) {
        unsigned* bar = b.bar;
        __builtin_amdgcn_s_waitcnt(0);
        unsigned nloc = b.st[0], nx = b.st[1];
        if (nloc == 0u) { xcd_barrier_complete(bar, b.x, nloc, nx); b.st[0] = nloc; b.st[1] = nx; }
        const unsigned old = xb_add(&bar[XB_XSUB(b.x)], 1u);
        const unsigned gen = old / nloc;
        if (old + 1u == (gen + 1u) * nloc) {
            __builtin_amdgcn_fence(__ATOMIC_RELEASE, "agent");
            asm volatile("s_waitcnt vmcnt(0)" ::: "memory");
            const unsigned og = xb_add(&bar[XB_TOP], 1u);
            const unsigned tg = og / nx;
            if (og + 1u == (tg + 1u) * nx) xb_add(&bar[XB_TOPGEN], 1u);
            else XB_SPIN(xb_ld(&bar[XB_TOPGEN]) == tg, bar);
            __builtin_amdgcn_fence(__ATOMIC_ACQUIRE, "agent");
            xb_add(&bar[XB_XGEN(b.x)], 1u);
            asm volatile("s_waitcnt vmcnt(0)" ::: "memory");
        } else {
            XB_SPIN(xb_ld(&bar[XB_XGEN(b.x)]) == gen, bar);
            __builtin_amdgcn_fence(__ATOMIC_ACQUIRE, "agent");
            asm volatile("s_waitcnt vmcnt(0)" ::: "memory");
        }
    }
    __syncthreads();
}

constexpr int PH_PER_LAYER = 6;
constexpr int N_PHASES = 1 + PH_PER_LAYER * DEPTH;
__device__ __forceinline__ void run_phase(const Params& p, int ph, unsigned char* lds) {
    unsigned char* ws = p.ws;
    if (ph == 0) { phase_prologue(p, lds); return; }
    const int l = (ph - 1) / PH_PER_LAYER, k = (ph - 1) % PH_PER_LAYER;
    if (k == 0) {
#if SIMPLE_GEMM
        EpiInProj E{(bf16_t*)(ws + WS_PC), (bf16_t*)(ws + WS_PS), (bf16_t*)(ws + WS_PR), (bf16_t*)(ws + WS_PG)};
        gemm_simple((const bf16_t*)(ws + WS_XB), (const bf16_t*)(ws + WS_WIN) + (size_t)l * NINT * DM, M, NINT, DM, E);
#else
        EpiInProjP E{(bf16_t*)(ws + WS_PC), (bf16_t*)(ws + WS_PS), (bf16_t*)(ws + WS_PR), (bf16_t*)(ws + WS_PG), (bf16_t*)(ws + WS_VT)};
        pg8::Gemm g{(const bf16_t*)(ws + WS_XB), (const bf16_t*)(ws + WS_WIN) + (size_t)l * NINT * DM, M, NINT, DM}; pg8::StaticOrder S; S.init(M, NINT, (int)gridDim.x, (int)blockIdx.x);
        for (int rep = 0; rep < ((PROBE_REP & 32) ? 2 : 1); ++rep)
        pg8::gemm_phase<EpiInProjP, pg8::StaticOrder, true, true>((PG8_LAS unsigned char*)lds, g, S, E);
#endif
    } else if (k == 1) {
        phase_mix1(p, l, lds);
    } else if (k == 2) {
        phase_mix2(p, l, lds);
    } else if (k == 3) {
        phase_mix3(p, l, lds);
    } else if (k == 4) {
#if SIMPLE_GEMM
        EpiF32 E{(float*)(ws + WS_Y), DM};
        gemm_simple((const bf16_t*)(ws + WS_MIX), (const bf16_t*)(ws + WS_WOUT) + (size_t)l * DM * DM, M, DM, DM, E);
#else
        EpiOutF32P E{(float*)(ws + WS_Y), DM};
        pg8::Gemm g{(const bf16_t*)(ws + WS_MIX), (const bf16_t*)(ws + WS_WOUT) + (size_t)l * DM * DM, M, DM, DM}; pg8::StaticOrder S; S.init(M, DM, (int)gridDim.x, (int)blockIdx.x);
        for (int rep = 0; rep < ((PROBE_REP & 64) ? 2 : 1); ++rep)
        pg8::gemm_phase<EpiOutF32P, pg8::StaticOrder, true, true>((PG8_LAS unsigned char*)lds, g, S, E);
#endif
    } else {
        phase_rowpass(l == 0 ? p.in[0] : p.out, (const float*)(ws + WS_Y), p.in[2] + l * DM, p.out, l + 1 < DEPTH ? (bf16_t*)(ws + WS_XB) : nullptr);
    }
}

static_assert(10 * TILE_B + 64 * AABS * 4 + 128 * XTS * 4 + 64 * 4 + 4 * 16 * 17 * 4 <= 147456, "B1 LDS map");
constexpr int LDS_BYTES = 147456 + 256;

constexpr int MISC_OFF = 147456;
#if MK_COOP == 2
__global__ void __launch_bounds__(512, 2) fwd_kernel(Params p) {
    extern __shared__ __attribute__((aligned(16))) unsigned char lds[];
    volatile LAS unsigned* misc = (volatile LAS unsigned*)((LAS unsigned char*)lds + MISC_OFF);
    if (threadIdx.x < 16) misc[threadIdx.x] = 0u;
    __syncthreads();
    XcdBarrier bar = xcd_barrier_post((unsigned*)(p.ws + WS_CTL), misc);
    for (int ph = p.ph_lo; ph < p.ph_hi; ++ph) {
        run_phase(p, ph, lds);
        if (ph + 1 < p.ph_hi) xcd_barrier(bar);
    }
}
#elif MK_COOP == 1
__global__ void __launch_bounds__(512, 2) fwd_kernel(Params p) {
    extern __shared__ __attribute__((aligned(16))) unsigned char lds[];
    cg::grid_group grid = cg::this_grid();
    for (int ph = p.ph_lo; ph < p.ph_hi; ++ph) {
        run_phase(p, ph, lds);
        if (ph + 1 < p.ph_hi) grid.sync();
    }
}
#else
__global__ void __launch_bounds__(512, 2) fwd_kernel(Params p) {
    extern __shared__ __attribute__((aligned(16))) unsigned char lds[];
    for (int ph = p.ph_lo; ph < p.ph_hi; ++ph) run_phase(p, ph, lds);
}
#endif

extern "C" void kernel_launch(void* const* d_in, const int* in_sizes, int n_in, void* d_out, int out_size, void* d_ws, size_t ws_size, hipStream_t stream) {
    static int grid = 0;
    if (grid == 0) {
        if (n_in != 24 || out_size != M * DM || ws_size < WS_END) { fprintf(stderr, "kernel_launch: unexpected problem (n_in %d out %d ws %zu)\n", n_in, out_size, ws_size); grid = -1; return; }
        int dev = 0, cus = 0, per_cu = 0;
        hipGetDevice(&dev); hipDeviceGetAttribute(&cus, hipDeviceAttributeMultiprocessorCount, dev);
        hipFuncSetAttribute((const void*)fwd_kernel, hipFuncAttributeMaxDynamicSharedMemorySize, LDS_BYTES);
        hipOccupancyMaxActiveBlocksPerMultiprocessor(&per_cu, (const void*)fwd_kernel, 512, LDS_BYTES);
        if (per_cu < 1) { fprintf(stderr, "kernel_launch: occupancy query says %d blocks per CU\n", per_cu); per_cu = 1; }
        grid = cus;
        (void)hipGetLastError();
    }
    if (grid < 0) return;
    Params p{};
    for (int i = 0; i < 24; ++i) p.in[i] = (const float*)d_in[i];
    p.out = (float*)d_out; p.ws = (unsigned char*)d_ws;
#if MK_COOP == 2
    p.ph_lo = 0; p.ph_hi = N_PHASES;
    if (hipMemsetAsync((char*)d_ws + WS_CTL, 0, XCD_BAR_WORDS * 4, stream) != hipSuccess) { fprintf(stderr, "kernel_launch: memset of the barrier words failed\n"); return; }
    hipLaunchKernelGGL(fwd_kernel, dim3(grid), dim3(512), LDS_BYTES, stream, p);
#elif MK_COOP == 1
    p.ph_lo = 0; p.ph_hi = N_PHASES;
    void* args[] = {&p};
    hipError_t e = hipLaunchCooperativeKernel((const void*)fwd_kernel, dim3(grid), dim3(512), args, LDS_BYTES, stream);
    if (e != hipSuccess) fprintf(stderr, "cooperative launch failed: %s (grid %d)\n", hipGetErrorString(e), grid);
#else
    for (int ph = 0; ph < N_PHASES; ++ph) {
        p.ph_lo = ph; p.ph_hi = ph + 1;
        hipLaunchKernelGGL(fwd_kernel, dim3(grid), dim3(512), LDS_BYTES, stream, p);
    }
#endif
}
```

```cpp
#include <hip/hip_runtime.h>
#include <hip/hip_cooperative_groups.h>
#include <cstdio>
#include <cstdint>
namespace cg = cooperative_groups;

#ifndef PROBE_REP
#define PROBE_REP 0
#endif
#ifndef MK_COOP
#define MK_COOP 2
#endif

constexpr int BATCH = 16, SEQ = 2048, DM = 1024, DEPTH = 2;
constexpr int M = BATCH * SEQ;
constexpr int HD = 64, NH = 6;
constexpr int CW = 256, SBW = 384, RWW = 384, LORA = 32, TAPS = 31;
constexpr int DIN = 3904;
constexpr int NINT = 4096;
constexpr int PC_W = 768, PS_W = 1152, PR_W = 1280, PG_W = 384;
constexpr float RMS_EPS = 1e-6f, LN_EPS = 1e-5f, GN_EPS = 64e-5f;

typedef unsigned short bf16_t;
typedef short bf16x8 __attribute__((ext_vector_type(8)));
typedef float f32x4 __attribute__((ext_vector_type(4)));
typedef unsigned short us4 __attribute__((ext_vector_type(4)));

constexpr size_t MiB = 1u << 20;
constexpr size_t WS_CTL = 0;
constexpr size_t WS_WPW = 512 * 1024;
constexpr size_t WS_WIN = 1 * MiB;
constexpr size_t WS_WOUT = 17 * MiB;
constexpr size_t WS_XB = 21 * MiB;
constexpr size_t WS_MIX = WS_XB;
constexpr size_t WS_PC = 85 * MiB;
constexpr size_t WS_PS = 133 * MiB;
constexpr size_t WS_VT = 205 * MiB;
constexpr size_t WS_Y = WS_PC;
constexpr size_t WS_PR = 229 * MiB;
constexpr size_t WS_PG = 309 * MiB;
constexpr size_t WS_VF = 333 * MiB;
constexpr size_t WS_CH = 381 * MiB;
constexpr size_t CH_SZ = (size_t)3072 * 4096 * 2;
constexpr size_t WS_CH_M = WS_CH, WS_CH_NT = WS_CH + CH_SZ, WS_CH_G = WS_CH + 2 * CH_SZ, WS_CH_Y1T = WS_CH + 3 * CH_SZ, WS_CH_BV = WS_CH + 4 * CH_SZ;
constexpr size_t WS_ZT = WS_PR;
constexpr size_t WS_END = 501 * MiB;

struct Params {
    const float* in[24];
    float* out;
    unsigned char* ws;
    int ph_lo, ph_hi;
};

__device__ __forceinline__ float bf2f(bf16_t v) { return __uint_as_float(((unsigned)v) << 16); }
__device__ __forceinline__ bf16_t f2bf(float f) { unsigned u = __float_as_uint(f); return (bf16_t)((u + 0x7fffu + ((u >> 16) & 1u)) >> 16); }
__device__ __forceinline__ unsigned pk2(float lo, float hi) { return (unsigned)f2bf(lo) | ((unsigned)f2bf(hi) << 16); }
__device__ __forceinline__ float wave_sum(float v) {
#pragma unroll
    for (int o = 1; o < 64; o <<= 1) v += __shfl_xor(v, o);
    return v;
}
__device__ __forceinline__ float sigmoidf_(float x) { return 1.0f / (1.0f + __expf(-x)); }
__device__ __forceinline__ float siluf_(float x) { return x / (1.0f + __expf(-x)); }
__device__ __forceinline__ int tid_() { int t = threadIdx.x; asm volatile("" : "+v"(t)); return t; }
__device__ __forceinline__ int opaque_zero() { int z = 0; asm volatile("" : "+v"(z)); return z; }

__device__ __forceinline__ int orig_col(int n) { return n < 3520 ? n : (n < 3584 ? -1 : (n < 3968 ? n - 64 : -1)); }

__device__ void transpose_tile(const float* W, int ldw, int ncol_src, const float* gain, bf16_t* WT, int K, int n0, int k0, bool permute, float* tile  , const float* fold_v1 = nullptr, const float* fold_mu = nullptr) {
    const int tid = tid_();
#pragma unroll
    for (int i = 0; i < 8; ++i) {
        const int kl = (tid >> 6) + 8 * i, nl = tid & 63;
        const int n = n0 + nl, k = k0 + kl;
        const int oc = permute ? orig_col(n) : n;
        float v = 0.f;
        if (oc >= 0 && oc < ncol_src) v = W[(size_t)k * ldw + oc] * (gain ? gain[k] : 1.0f);
        if (permute && n >= 768 && n < 1152) v *= 0.125f * 1.4426950408889634f;
        if (fold_v1 && n >= 3520 && n < 3584) {
            const int i = (n - 3520) & 31; const bool second = n >= 3552; float a = 0.f;
            for (int c = 0; c < RWW; ++c) { const float m = fold_mu[c]; a += W[(size_t)k * ldw + 3072 + c] * (second ? m : 1.0f - m) * fold_v1[c * LORA + i]; }
            v = a * gain[k];
        }
        tile[kl * 65 + nl] = v;
    }
    __syncthreads();
#pragma unroll
    for (int i = 0; i < 8; ++i) {
        const int nl = (tid >> 6) + 8 * i, kl = tid & 63;
        WT[(size_t)(n0 + nl) * K + k0 + kl] = f2bf(tile[kl * 65 + nl]);
    }
    __syncthreads();
}

__device__ void rows_to_xb(const float* X, bf16_t* XB) {
    const int tid = tid_(), lane = tid & 63, wave = tid >> 6;
    for (int row = blockIdx.x * 8 + wave; row < M; row += gridDim.x * 8) {
        const float* xr = X + (size_t)row * DM;
        f32x4 v[4]; float ss = 0.f;
#pragma unroll
        for (int i = 0; i < 4; ++i) { v[i] = *(const f32x4*)(xr + i * 256 + lane * 4); ss += v[i][0] * v[i][0] + v[i][1] * v[i][1] + v[i][2] * v[i][2] + v[i][3] * v[i][3]; }
        ss = wave_sum(ss);
        const float rstd = rsqrtf(ss * (1.0f / DM) + RMS_EPS);
#pragma unroll
        for (int i = 0; i < 4; ++i) { uint2 w; w.x = pk2(v[i][0] * rstd, v[i][1] * rstd); w.y = pk2(v[i][2] * rstd, v[i][3] * rstd); *(uint2*)(XB + (size_t)row * DM + i * 256 + lane * 4) = w; }
    }
}

__device__ void phase_prologue(const Params& p, unsigned char* lds) {
    float* tile = (float*)lds;
    bf16_t* WinT = (bf16_t*)(p.ws + WS_WIN); bf16_t* WoutT = (bf16_t*)(p.ws + WS_WOUT);
    const int nt_in = (NINT / 64) * (DM / 64), nt_out = (DM / 64) * (DM / 64), nt_pw = (CW / 64) * (CW / 64);
    const int total = DEPTH * (nt_in + nt_out);
    for (int j = blockIdx.x; j < DEPTH * nt_pw; j += gridDim.x) { const int l = j / nt_pw, r = j % nt_pw;
        transpose_tile(p.in[9] + (size_t)l * CW * CW, CW, CW, nullptr, (bf16_t*)(p.ws + WS_WPW) + (size_t)l * CW * CW, CW, (r >> 2) * 64, (r & 3) * 64, false, tile); }
    for (int j = blockIdx.x; j < total; j += gridDim.x) {
        int l = j / (nt_in + nt_out), r = j % (nt_in + nt_out);
        if (r < nt_in) { const int tn = r / (DM / 64), tk = r % (DM / 64);
            transpose_tile(p.in[3] + (size_t)l * DM * DIN, DIN, DIN, p.in[1] + l * DM, WinT + (size_t)l * NINT * DM, DM, tn * 64, tk * 64, true, tile, l > 0 ? p.in[22] : nullptr, p.in[11] + l * 1216 + 768);
        } else { r -= nt_in; const int tn = r / (DM / 64), tk = r % (DM / 64);
            transpose_tile(p.in[4] + (size_t)l * DM * DM, DM, DM, nullptr, WoutT + (size_t)l * DM * DM, DM, tn * 64, tk * 64, false, tile);
        }
    }
    rows_to_xb(p.in[0], (bf16_t*)(p.ws + WS_XB));
}

namespace pg8 {
#define PG8_LAS __attribute__((address_space(3)))
typedef unsigned short bf16_t;
typedef short bf16x8 __attribute__((ext_vector_type(8)));
typedef float f32x4 __attribute__((ext_vector_type(4)));
typedef unsigned u32x4 __attribute__((ext_vector_type(4)));
constexpr int BM = 256, BK = 64, HALF = 128, HTB = HALF * BK * 2  , STAGE_BYTES = 8 * HTB, NXCD = 8, WGM = 8;

__host__ __device__ __forceinline__ int lds_byte(int r, int c) { const int st = (r >> 4) * 2 + (c >> 5), rr = r & 15, cc = c & 31, ob = rr * 64 + cc * 2; return st * 1024 + (ob ^ (((ob >> 9) & 1) << 5)); }
__host__ __device__ __forceinline__ void stage_rc(int b, int& R, int& C) { const int st = b / 1024, sb = b % 1024, swz = sb ^ (((sb >> 9) & 1) << 5); R = (st >> 1) * 16 + swz / 64; C = (st & 1) * 32 + (swz % 64) / 2; }
__host__ __device__ __forceinline__ int perm32(int rho) { const int n = rho >> 4, i = rho & 15; return 8 * (i >> 2) + 4 * n + (i & 3); }

struct Unit { int pm, pn; };
struct Gemm { const bf16_t* A; const bf16_t* Bt; int M, N, K; };

struct StaticOrder {
    int nM, nN, nwg, G, c;
    __host__ __device__ void init(int M, int N, int G_, int c_) { nM = M / BM; nN = N / BM; nwg = nM * nN; G = G_; c = c_; }
    __host__ __device__ bool next(int i, Unit& u) const {
        const long L = (long)i * G + c; if (L >= nwg) return false;
        int wgid = (int)L; { const int q = nwg / NXCD, r = nwg % NXCD, xcd = wgid % NXCD, off = wgid / NXCD; wgid = (xcd < r ? xcd * (q + 1) : r * (q + 1) + (xcd - r) * q) + off; }
        const int nig = WGM * nN, gid = wgid / nig, fm = gid * WGM, gsz = (nM - fm) < WGM ? (nM - fm) : WGM;
        u.pm = fm + ((wgid % nig) % gsz); u.pn = (wgid % nig) / gsz; return true;
    }
    __device__ __forceinline__ void a_ready(const Unit&) const {}
    __device__ __forceinline__ void done(const Unit&) const {}
};


__device__ __forceinline__ unsigned cvt_pk_bf16(float lo, float hi) { unsigned r; asm volatile("v_cvt_pk_bf16_f32 %0, %1, %2" : "=v"(r) : "v"(lo), "v"(hi)); return r; }

template <class Epi, class Sched, bool ALIGN_EPI = false, bool SP2 = false>
__device__ __forceinline__ void gemm_phase(PG8_LAS unsigned char* lds, const Gemm g, const Sched& S, const Epi& E) {
    const int tid = tid_(), wid = __builtin_amdgcn_readfirstlane(tid >> 6), lane = tid & 63, wr = wid >> 2, wc = wid & 3, fr = lane & 15, fq = lane >> 4;
    const int K = g.K, nt = K / BK;
    unsigned voffA[2], voffB[2];
#pragma unroll
    for (int i = 0; i < 2; ++i) { int R, C; stage_rc(tid * 16 + i * 8192, R, C); const int Rb = Epi::PERM ? ((R & ~31) + perm32(R & 31)) : R;
        voffA[i] = (unsigned)(R * K + C) * 2u; voffB[i] = (unsigned)(Rb * K + C) * 2u; }
    const size_t kstep = (size_t)(BK * 2);
    const size_t hstep = (size_t)HALF * K * 2;
    const size_t tstep = 2 * hstep;
    const unsigned ldsw = (unsigned)wid * 1024u;
    const int aoff = lds_byte(wr * 64 + fr, fq * 8), boff = lds_byte(wc * 32 + fr, fq * 8);
#define PG8_SA(b, h) (((b) * 2 + (h)) * HTB)
#define PG8_SB(b, h) ((4 + (b) * 2 + (h)) * HTB)
#define PG8_STAGE(bufoff, gbase, voff) do { _Pragma("unroll") for (int _i = 0; _i < 2; ++_i) \
        __builtin_amdgcn_global_load_lds((const unsigned*)((const char*)(gbase) + (voff)[_i]), (PG8_LAS unsigned*)(lds + (bufoff) + ldsw + _i * 8192), 16, 0, 0); } while (0)
#define PG8_LDA(dst, b, h) do { _Pragma("unroll") for (int m = 0; m < 4; ++m) _Pragma("unroll") for (int k = 0; k < 2; ++k) dst[m][k] = *(const PG8_LAS bf16x8*)(lds + PG8_SA(b, h) + aoff + m * 2048 + k * 1024); } while (0)
#define PG8_LDB(dst, b, h) do { _Pragma("unroll") for (int n = 0; n < 2; ++n) _Pragma("unroll") for (int k = 0; k < 2; ++k) dst[n][k] = *(const PG8_LAS bf16x8*)(lds + PG8_SB(b, h) + boff + n * 2048 + k * 1024); } while (0)
#define PG8_MMA(ai, bj, At, Bt) do { __builtin_amdgcn_s_setprio(1); _Pragma("unroll") for (int m = 0; m < 4; ++m) _Pragma("unroll") for (int n = 0; n < 2; ++n) _Pragma("unroll") for (int k = 0; k < 2; ++k) \
        acc[ai][bj][m][n] = __builtin_amdgcn_mfma_f32_16x16x32_bf16(Bt[n][k], At[m][k], acc[ai][bj][m][n], 0, 0, 0); __builtin_amdgcn_s_setprio(0); } while (0)
#define PG8_WAIT_V(n) asm volatile("s_waitcnt vmcnt(" #n ")" ::: "memory")
#define PG8_WAIT_L(n) asm volatile("s_waitcnt lgkmcnt(" #n ")" ::: "memory")
#define PG8_BAR __builtin_amdgcn_s_barrier()
#define PG8_SCHED __builtin_amdgcn_sched_barrier(0)
    Unit cur, nxt; int ui = 0;
    if (!S.next(0, cur)) return;
    f32x4 acc[2][2][4][2];
#pragma unroll
    for (int a = 0; a < 2; ++a)
#pragma unroll
        for (int b = 0; b < 2; ++b)
#pragma unroll
            for (int m = 0; m < 4; ++m)
#pragma unroll
                for (int n = 0; n < 2; ++n) acc[a][b][m][n] = (f32x4){0.f, 0.f, 0.f, 0.f};
    bf16x8 At[4][2], B0[2][2], B1[2][2];
    const char* cA = (const char*)g.A + (size_t)cur.pm * tstep; const char* cB = (const char*)g.Bt + (size_t)cur.pn * tstep;
    S.a_ready(cur);
    if constexpr (SP2) {
        PG8_STAGE(PG8_SB(0, 0), cB, voffB); PG8_STAGE(PG8_SB(0, 1), cB + hstep, voffB); PG8_STAGE(PG8_SA(0, 0), cA, voffA); PG8_STAGE(PG8_SA(0, 1), cA + hstep, voffA);
        if (wr == 1) PG8_BAR;
        PG8_WAIT_V(2); PG8_BAR;
        PG8_STAGE(PG8_SB(1, 0), cB + kstep, voffB); PG8_STAGE(PG8_SA(1, 0), cA + kstep, voffA); PG8_STAGE(PG8_SB(1, 1), cB + hstep + kstep, voffB);
        PG8_WAIT_V(6); PG8_BAR;
    } else {
        PG8_STAGE(PG8_SB(0, 0), cB, voffB); PG8_STAGE(PG8_SA(0, 0), cA, voffA); PG8_STAGE(PG8_SB(0, 1), cB + hstep, voffB); PG8_STAGE(PG8_SA(0, 1), cA + hstep, voffA);
        if (wr == 1) PG8_BAR;
        PG8_WAIT_V(4); PG8_BAR;
        PG8_STAGE(PG8_SB(1, 0), cB + kstep, voffB); PG8_STAGE(PG8_SA(1, 0), cA + kstep, voffA); PG8_STAGE(PG8_SB(1, 1), cB + hstep + kstep, voffB);
        PG8_WAIT_V(6); PG8_BAR;
    }
    for (;;) {
        const bool has_next = S.next(ui + 1, nxt);
        const char* nA = has_next ? (const char*)g.A + (size_t)nxt.pm * tstep : cA; const char* nB = has_next ? (const char*)g.Bt + (size_t)nxt.pn * tstep : cB;
        for (int t = 0; t < nt; t += 2) {
            const bool last = (t == nt - 2);
            const char* a1 = cA + (size_t)(t + 1) * kstep;
            const char* a2 = last ? nA : cA + (size_t)(t + 2) * kstep; const char* b2 = last ? nB : cB + (size_t)(t + 2) * kstep;
            const char* a3 = a2 + kstep; const char* b3 = b2 + kstep;
            if (last && has_next) S.a_ready(nxt);
            if constexpr (SP2) {
            PG8_LDB(B0, 0, 0); PG8_LDB(B1, 0, 1); PG8_SCHED; PG8_LDA(At, 0, 0); PG8_STAGE(PG8_SA(1, 1), a1 + hstep, voffA);
            PG8_WAIT_V(8); PG8_WAIT_L(0); PG8_BAR; PG8_MMA(0, 0, At, B0); PG8_MMA(0, 1, At, B1); PG8_BAR; PG8_SCHED;
            PG8_LDA(At, 0, 1); PG8_STAGE(PG8_SB(0, 0), b2, voffB); PG8_STAGE(PG8_SB(0, 1), b2 + hstep, voffB); PG8_STAGE(PG8_SA(0, 0), a2, voffA);
            PG8_WAIT_V(8); PG8_WAIT_L(0); PG8_BAR; PG8_MMA(1, 0, At, B0); PG8_MMA(1, 1, At, B1); PG8_BAR; PG8_SCHED;
            PG8_LDB(B0, 1, 0); PG8_LDB(B1, 1, 1); PG8_SCHED; PG8_LDA(At, 1, 0); PG8_STAGE(PG8_SA(0, 1), a2 + hstep, voffA);
            PG8_WAIT_V(8); PG8_WAIT_L(0); PG8_BAR; PG8_MMA(0, 0, At, B0); PG8_MMA(0, 1, At, B1); PG8_BAR; PG8_SCHED;
            PG8_LDA(At, 1, 1); PG8_STAGE(PG8_SB(1, 0), b3, voffB); PG8_STAGE(PG8_SB(1, 1), b3 + hstep, voffB); PG8_STAGE(PG8_SA(1, 0), a3, voffA);
            PG8_WAIT_V(8); PG8_WAIT_L(0); PG8_BAR; PG8_MMA(1, 0, At, B0); PG8_MMA(1, 1, At, B1); PG8_BAR; PG8_SCHED;
            } else {
            PG8_LDB(B0, 0, 0); PG8_SCHED; PG8_LDA(At, 0, 0); PG8_STAGE(PG8_SA(1, 1), a1 + hstep, voffA);
            PG8_WAIT_L(8); PG8_BAR; PG8_WAIT_L(0); PG8_MMA(0, 0, At, B0); PG8_BAR; PG8_SCHED;
            PG8_LDB(B1, 0, 1); PG8_STAGE(PG8_SB(0, 0), b2, voffB);
            PG8_BAR; PG8_WAIT_L(0); PG8_MMA(0, 1, At, B1); PG8_BAR;
            PG8_LDA(At, 0, 1); PG8_STAGE(PG8_SA(0, 0), a2, voffA);
            PG8_BAR; PG8_WAIT_L(0); PG8_MMA(1, 0, At, B0); PG8_BAR; PG8_SCHED;
            PG8_STAGE(PG8_SB(0, 1), b2 + hstep, voffB);
            PG8_WAIT_V(6); PG8_BAR; PG8_MMA(1, 1, At, B1); PG8_BAR;
            PG8_LDB(B0, 1, 0); PG8_SCHED; PG8_LDA(At, 1, 0); PG8_STAGE(PG8_SA(0, 1), a2 + hstep, voffA);
            PG8_WAIT_L(8); PG8_BAR; PG8_WAIT_L(0); PG8_MMA(0, 0, At, B0); PG8_BAR; PG8_SCHED;
            PG8_LDB(B1, 1, 1); PG8_STAGE(PG8_SB(1, 0), b3, voffB);
            PG8_BAR; PG8_WAIT_L(0); PG8_MMA(0, 1, At, B1); PG8_BAR;
            PG8_LDA(At, 1, 1); PG8_STAGE(PG8_SA(1, 0), a3, voffA);
            PG8_BAR; PG8_WAIT_L(0); PG8_MMA(1, 0, At, B0); PG8_BAR; PG8_SCHED;
            PG8_STAGE(PG8_SB(1, 1), b3 + hstep, voffB);
            PG8_WAIT_V(6); PG8_BAR; PG8_MMA(1, 1, At, B1); PG8_BAR;
            }
        }
        if constexpr (ALIGN_EPI) { if (wr == 0) PG8_BAR; }
        if constexpr (!Epi::AFTER_DRAIN) { E(acc, cur, wr, wc, fr, fq); S.done(cur); }
        if (!has_next) break;
#pragma unroll
        for (int a = 0; a < 2; ++a)
#pragma unroll
            for (int b = 0; b < 2; ++b)
#pragma unroll
                for (int m = 0; m < 4; ++m)
#pragma unroll
                    for (int n = 0; n < 2; ++n) acc[a][b][m][n] = (f32x4){0.f, 0.f, 0.f, 0.f};
        cur = nxt; cA = nA; cB = nB; ++ui;
        if constexpr (ALIGN_EPI) { if (wr == 1) PG8_BAR; }
    }
    PG8_WAIT_V(0);
    if constexpr (!ALIGN_EPI) { if (wr == 0) PG8_BAR; }
    PG8_BAR;
    if constexpr (Epi::AFTER_DRAIN) { E.fused(acc, cur, wr, wc, fr, fq, lds, wid, lane); S.done(cur); }
#undef PG8_SA
#undef PG8_SB
#undef PG8_STAGE
#undef PG8_LDA
#undef PG8_LDB
#undef PG8_MMA
#undef PG8_WAIT_V
#undef PG8_WAIT_L
#undef PG8_BAR
#undef PG8_SCHED
}
}

struct EpiInProjP {
    static constexpr bool PERM = true, AFTER_DRAIN = false;
    bf16_t *PC, *PS, *PR, *PG, *VT;
    __device__ __forceinline__ void operator()(const pg8::f32x4 (&acc)[2][2][4][2], const pg8::Unit& u, int wr, int wc, int fr, int fq) const {
        const int row0 = u.pm * 256 + wr * 64 + fr;
#pragma unroll
        for (int bj = 0; bj < 2; ++bj) {
            const int blk = 2 * u.pn + bj; bf16_t* base; int ld, c0;
            if (blk >= 12 && blk < 15) {
                const int vc = 128 * (blk - 12) + wc * 32 + 8 * fq;
#pragma unroll
                for (int ai = 0; ai < 2; ++ai)
#pragma unroll
                    for (int m = 0; m < 4; ++m) {
                        const int row = row0 + ai * 128 + m * 16, b = row >> 11, t = row & 2047;
#pragma unroll
                        for (int n = 0; n < 2; ++n)
#pragma unroll
                            for (int e = 0; e < 4; ++e) { const int col = vc + 4 * n + e, hh = col >> 6, d = col & 63;
                                VT[((size_t)(b * NH + hh) * HD + d) * SEQ + t] = f2bf(acc[ai][bj][m][n][e]); }
                    }
                continue;
            }
            if (blk < 6) { base = PC; ld = PC_W; c0 = 128 * blk; }
            else if (blk < 12) { base = PS; ld = PS_W; c0 = 128 * (blk - 6); }
            else if (blk < 18) { base = PS; ld = PS_W; c0 = 768 + 128 * (blk - 15); }
            else if (blk < 28) { base = PR; ld = PR_W; c0 = 128 * (blk - 18); }
            else if (blk < 31) { base = PG; ld = PG_W; c0 = 128 * (blk - 28); }
            else continue;
            const int col = c0 + wc * 32 + 8 * fq;
#pragma unroll
            for (int ai = 0; ai < 2; ++ai)
#pragma unroll
                for (int m = 0; m < 4; ++m) {
                    const pg8::f32x4 v0 = acc[ai][bj][m][0], v1 = acc[ai][bj][m][1]; pg8::u32x4 w;
                    w.x = pg8::cvt_pk_bf16(v0[0], v0[1]); w.y = pg8::cvt_pk_bf16(v0[2], v0[3]); w.z = pg8::cvt_pk_bf16(v1[0], v1[1]); w.w = pg8::cvt_pk_bf16(v1[2], v1[3]);
                    *(pg8::u32x4*)(base + (size_t)(row0 + ai * 128 + m * 16) * ld + col) = w;
                }
        }
    }
};
struct EpiOutBf16P {
    static constexpr bool PERM = true, AFTER_DRAIN = false;
    bf16_t* Y; int ld;
    __device__ __forceinline__ void operator()(const pg8::f32x4 (&acc)[2][2][4][2], const pg8::Unit& u, int wr, int wc, int fr, int fq) const {
        const int row0 = u.pm * 256 + wr * 64 + fr, col0 = u.pn * 256 + wc * 32 + 8 * fq;
#pragma unroll
        for (int ai = 0; ai < 2; ++ai)
#pragma unroll
            for (int m = 0; m < 4; ++m)
#pragma unroll
                for (int bj = 0; bj < 2; ++bj) {
                    const pg8::f32x4 v0 = acc[ai][bj][m][0], v1 = acc[ai][bj][m][1]; pg8::u32x4 w;
                    w.x = pg8::cvt_pk_bf16(v0[0], v0[1]); w.y = pg8::cvt_pk_bf16(v0[2], v0[3]); w.z = pg8::cvt_pk_bf16(v1[0], v1[1]); w.w = pg8::cvt_pk_bf16(v1[2], v1[3]);
                    *(pg8::u32x4*)(Y + (size_t)(row0 + ai * 128 + m * 16) * ld + col0 + bj * 128) = w;
                }
    }
};

__device__ void phase_rowpass(const float* Xin, const bf16_t* Y, const float* gpost, float* Xout, bf16_t* XB) {
    const int tid = tid_(), lane = tid & 63, wave = tid >> 6;
    for (int row = blockIdx.x * 8 + wave; row < M; row += gridDim.x * 8) {
        f32x4 y[4], x[4]; float ss = 0.f;
#pragma unroll
        for (int i = 0; i < 4; ++i) { const uint2 yw = *(const uint2*)(Y + (size_t)row * DM + i * 256 + lane * 4);
            y[i] = (f32x4){bf2f((bf16_t)(yw.x & 0xffff)), bf2f((bf16_t)(yw.x >> 16)), bf2f((bf16_t)(yw.y & 0xffff)), bf2f((bf16_t)(yw.y >> 16))};
            x[i] = *(const f32x4*)(Xin + (size_t)row * DM + i * 256 + lane * 4);
            ss += y[i][0] * y[i][0] + y[i][1] * y[i][1] + y[i][2] * y[i][2] + y[i][3] * y[i][3]; }
        ss = wave_sum(ss);
        const float rstd = rsqrtf(ss * (1.0f / DM) + RMS_EPS);
        float s2 = 0.f;
#pragma unroll
        for (int i = 0; i < 4; ++i) { const f32x4 g = *(const f32x4*)(gpost + i * 256 + lane * 4);
            x[i] = x[i] + y[i] * rstd * g; s2 += x[i][0] * x[i][0] + x[i][1] * x[i][1] + x[i][2] * x[i][2] + x[i][3] * x[i][3];
            *(f32x4*)(Xout + (size_t)row * DM + i * 256 + lane * 4) = x[i]; }
        if (XB) {
            s2 = wave_sum(s2);
            const float r2 = rsqrtf(s2 * (1.0f / DM) + RMS_EPS);
#pragma unroll
            for (int i = 0; i < 4; ++i) { uint2 w; w.x = pk2(x[i][0] * r2, x[i][1] * r2); w.y = pk2(x[i][2] * r2, x[i][3] * r2); *(uint2*)(XB + (size_t)row * DM + i * 256 + lane * 4) = w; }
        }
    }
}

__device__ void conv_job(const Params& p, int l, int job, float* lds) {
    const int tid = tid_(), lane = tid & 63, wave = tid >> 6;
    const int b = job / (SEQ / 32), t0 = (job % (SEQ / 32)) * 32;
    const bf16_t* PC = (const bf16_t*)(p.ws + WS_PC); bf16_t* MIX = (bf16_t*)(p.ws + WS_MIX);
    const float* dw = p.in[5] + l * TAPS * CW; const float* dwb = p.in[6] + l * CW; const float* lng = p.in[7] + l * CW; const float* lnb = p.in[8] + l * CW;
    const float* pw = p.in[9] + (size_t)l * CW * CW; const float* pwb = p.in[10] + l * CW;
    float* u = lds;
    float* cv = lds + 62 * 256;
    for (int idx = tid; idx < 62 * 256; idx += 512) {
        const int r = idx >> 8, c = idx & 255, t = t0 - 30 + r;
        float v = 0.f;
        if (t >= 0) { const bf16_t* pr = PC + (size_t)(b * SEQ + t) * PC_W; v = bf2f(pr[c]) * sigmoidf_(bf2f(pr[256 + c])); }
        u[idx] = v;
    }
    __syncthreads();
    for (int idx = tid; idx < 32 * 256; idx += 512) {
        const int tt = idx >> 8, c = idx & 255;
        float a = dwb[c];
#pragma unroll 4
        for (int j = 0; j < TAPS; ++j) a += dw[j * CW + c] * u[(tt + j) * 256 + c];
        cv[idx] = a;
    }
    __syncthreads();
    for (int q = 0; q < 4; ++q) {
        const int tt = wave * 4 + q; float x[4], s = 0.f;
#pragma unroll
        for (int i = 0; i < 4; ++i) { x[i] = cv[tt * 256 + lane + 64 * i]; s += x[i]; }
        const float mean = wave_sum(s) * (1.0f / CW); float vs = 0.f;
#pragma unroll
        for (int i = 0; i < 4; ++i) { const float d = x[i] - mean; vs += d * d; }
        const float rstd = rsqrtf(wave_sum(vs) * (1.0f / CW) + LN_EPS);
#pragma unroll
        for (int i = 0; i < 4; ++i) { const int c = lane + 64 * i; cv[tt * 256 + c] = siluf_((x[i] - mean) * rstd * lng[c] + lnb[c]); }
    }
    __syncthreads();
    {
        const int n = tid & 255, half = tid >> 8;
        float acc[16];
#pragma unroll
        for (int i = 0; i < 16; ++i) acc[i] = pwb[n];
#pragma unroll 2
        for (int k = 0; k < CW; ++k) {
            const float w = pw[(size_t)k * CW + n];
#pragma unroll
            for (int i = 0; i < 16; ++i) acc[i] += cv[(half * 16 + i) * 256 + k] * w;
        }
#pragma unroll
        for (int i = 0; i < 16; ++i) { const size_t row = (size_t)b * SEQ + t0 + half * 16 + i;
            const float g = bf2f(PC[row * PC_W + 512 + n]);
            MIX[row * DM + n] = f2bf(acc[i] * siluf_(g)); }
    }
    __syncthreads();
}

constexpr int CV_AS = 264;
__device__ void conv_job64(const Params& p, int l, int job, unsigned char* lds) {
    const int tid = tid_(), lane = tid & 63, wave = tid >> 6, fr = lane & 15, fq = lane >> 4;
    const int b = job >> 5, t0 = (job & 31) * 64;
    const bf16_t* PC = (const bf16_t*)(p.ws + WS_PC); bf16_t* MIX = (bf16_t*)(p.ws + WS_MIX);
    const float* dw = p.in[5] + l * TAPS * CW; const float* dwb = p.in[6] + l * CW; const float* lng = p.in[7] + l * CW; const float* lnb = p.in[8] + l * CW;
    const bf16_t* pwT = (const bf16_t*)(p.ws + WS_WPW) + (size_t)l * CW * CW; const float* pwb = p.in[10] + l * CW;
    float* u = (float*)lds;
    bf16_t* act = (bf16_t*)(lds + 94 * 256 * 4);
    for (int idx = tid; idx < 94 * 32; idx += 512) {
        const int r = idx >> 5, c8 = (idx & 31) * 8, t = t0 - 30 + r;
        float v[8];
        if (t >= 0) { const bf16_t* pr = PC + ((size_t)b * SEQ + t) * PC_W + c8; const bf16x8 a = *(const bf16x8*)pr, g = *(const bf16x8*)(pr + 256);
#pragma unroll
            for (int e = 0; e < 8; ++e) v[e] = bf2f((bf16_t)a[e]) * __builtin_amdgcn_rcpf(1.0f + __builtin_amdgcn_exp2f(-1.4426950408889634f * bf2f((bf16_t)g[e]))); }
        else {
#pragma unroll
            for (int e = 0; e < 8; ++e) v[e] = 0.f; }
        *(f32x4*)(u + r * 256 + c8) = (f32x4){v[0], v[1], v[2], v[3]}; *(f32x4*)(u + r * 256 + c8 + 4) = (f32x4){v[4], v[5], v[6], v[7]};
    }
    __syncthreads();
    const int c = tid & 255, half = tid >> 8;
    float acc[32];
    {
        float w[TAPS];
#pragma unroll
        for (int j = 0; j < TAPS; ++j) w[j] = dw[j * CW + c];
        const float bias = dwb[c];
#pragma unroll
        for (int i = 0; i < 32; ++i) acc[i] = bias;
        const float* up = u + (half * 32) * 256 + c;
#pragma unroll
        for (int rr = 0; rr < 62; ++rr) {
            const float uv = up[rr * 256];
#pragma unroll
            for (int i = 0; i < 32; ++i) { if (rr - i >= 0 && rr - i < TAPS) acc[i] += w[rr - i] * uv; }
        }
    }
    __syncthreads();
    float* cv = u;
#pragma unroll
    for (int i = 0; i < 32; ++i) cv[(half * 32 + i) * 256 + c] = acc[i];
    __syncthreads();
#pragma unroll 2
    for (int q = 0; q < 8; ++q) {
        const int tt = wave * 8 + q; const f32x4 x = *(const f32x4*)(cv + tt * 256 + lane * 4);
        const float mean = wave_sum(x[0] + x[1] + x[2] + x[3]) * (1.0f / CW);
        const f32x4 d = x - mean;
        const float rstd = rsqrtf(wave_sum(d[0] * d[0] + d[1] * d[1] + d[2] * d[2] + d[3] * d[3]) * (1.0f / CW) + LN_EPS);
        const f32x4 g = *(const f32x4*)(lng + lane * 4), bb = *(const f32x4*)(lnb + lane * 4);
        float y[4];
#pragma unroll
        for (int e = 0; e < 4; ++e) { const float v = d[e] * rstd * g[e] + bb[e]; y[e] = v * __builtin_amdgcn_rcpf(1.0f + __builtin_amdgcn_exp2f(-1.4426950408889634f * v)); }
        uint2 w; w.x = pk2(y[0], y[1]); w.y = pk2(y[2], y[3]); *(uint2*)(act + tt * CV_AS + lane * 4) = w;
    }
    __syncthreads();
    {
        f32x4 o[2][4];
#pragma unroll
        for (int i = 0; i < 2; ++i)
#pragma unroll
            for (int j = 0; j < 4; ++j) o[i][j] = (f32x4){0.f, 0.f, 0.f, 0.f};
#pragma unroll 2
        for (int kk = 0; kk < 8; ++kk) {
            bf16x8 a[2], bq[4];
#pragma unroll
            for (int i = 0; i < 2; ++i) a[i] = *(const bf16x8*)(pwT + (size_t)(wave * 32 + i * 16 + fr) * CW + kk * 32 + fq * 8);
#pragma unroll
            for (int j = 0; j < 4; ++j) bq[j] = *(const bf16x8*)(act + (j * 16 + fr) * CV_AS + kk * 32 + fq * 8);
#pragma unroll
            for (int i = 0; i < 2; ++i)
#pragma unroll
                for (int j = 0; j < 4; ++j) o[i][j] = __builtin_amdgcn_mfma_f32_16x16x32_bf16(a[i], bq[j], o[i][j], 0, 0, 0);
        }
#pragma unroll
        for (int i = 0; i < 2; ++i) {
            const int n0 = wave * 32 + i * 16 + fq * 4; const f32x4 bias = *(const f32x4*)(pwb + n0);
#pragma unroll
            for (int j = 0; j < 4; ++j) {
                const size_t row = (size_t)b * SEQ + t0 + j * 16 + fr;
                const uint2 gw = *(const uint2*)(PC + row * PC_W + 512 + n0);
                const float g0 = bf2f((bf16_t)(gw.x & 0xffff)), g1 = bf2f((bf16_t)(gw.x >> 16)), g2 = bf2f((bf16_t)(gw.y & 0xffff)), g3 = bf2f((bf16_t)(gw.y >> 16));
                const f32x4 v = o[i][j] + bias;
                uint2 w; w.x = pk2(v[0] * siluf_(g0), v[1] * siluf_(g1)); w.y = pk2(v[2] * siluf_(g2), v[3] * siluf_(g3));
                *(uint2*)(MIX + row * DM + n0) = w;
            }
        }
    }
    __syncthreads();
}

__device__ void attn_job(const Params& p, int job) {
    const int tid = tid_(), lane = tid & 63, wave = tid >> 6;
    const int bh = job >> 2, qb = job & 3, b = bh / NH, h = bh % NH;
    const bf16_t* PS = (const bf16_t*)(p.ws + WS_PS); bf16_t* MIX = (bf16_t*)(p.ws + WS_MIX);
    const int tw = qb * 512 + wave * 64, t = tw + lane;
    const size_t row = (size_t)b * SEQ + t;
    const float qs = 1.0f;
    const bf16_t* VT = (const bf16_t*)(p.ws + WS_VT) + (size_t)bh * HD * SEQ;
    float q[64], o[64];
    {
        const bf16_t* qp = PS + row * PS_W + h * HD;
#pragma unroll
        for (int i = 0; i < 8; ++i) { const bf16x8 v = *(const bf16x8*)(qp + i * 8);
#pragma unroll
            for (int j = 0; j < 8; ++j) { q[i * 8 + j] = bf2f((bf16_t)v[j]) * qs; o[i * 8 + j] = 0.f; } }
    }
    float rp = 1.0f;
    const int z = opaque_zero();
    for (int s = tw + 62; s >= 0; --s) {
        const bf16_t* kp = PS + ((size_t)b * SEQ + s) * PS_W + 384 + h * HD + z;
        float dot = 0.f;
#pragma unroll
        for (int i = 0; i < 8; ++i) { const bf16x8 v = *(const bf16x8*)(kp + i * 8);
#pragma unroll
            for (int j = 0; j < 8; ++j) dot += q[i * 8 + j] * bf2f((bf16_t)v[j]); }
        const bool act = s < t;
        const float e = __builtin_amdgcn_exp2f(dot);
        const float keep = __builtin_amdgcn_rcpf(1.0f + e);
        const float pr = act ? (1.0f - keep) * rp : 0.f;
        rp = act ? rp * keep : rp;
#pragma unroll
        for (int d = 0; d < 64; ++d) o[d] += pr * bf2f(VT[(size_t)d * SEQ + s + z]);
        if (__all(rp == 0.0f)) break;
    }
    const bf16_t* gp = PS + row * PS_W + 768 + h * HD;
    bf16_t* op = MIX + row * DM + CW + h * HD;
#pragma unroll
    for (int i = 0; i < 8; ++i) { const bf16x8 g = *(const bf16x8*)(gp + i * 8); uint4 w;
        w.x = pk2(o[i * 8 + 0] * siluf_(bf2f((bf16_t)g[0])), o[i * 8 + 1] * siluf_(bf2f((bf16_t)g[1])));
        w.y = pk2(o[i * 8 + 2] * siluf_(bf2f((bf16_t)g[2])), o[i * 8 + 3] * siluf_(bf2f((bf16_t)g[3])));
        w.z = pk2(o[i * 8 + 4] * siluf_(bf2f((bf16_t)g[4])), o[i * 8 + 5] * siluf_(bf2f((bf16_t)g[5])));
        w.w = pk2(o[i * 8 + 6] * siluf_(bf2f((bf16_t)g[6])), o[i * 8 + 7] * siluf_(bf2f((bf16_t)g[7])));
        *(uint4*)(op + i * 8) = w; }
}

typedef float f32x16 __attribute__((ext_vector_type(16)));
__device__ void attn_mfma_wave(const Params& p, int bh, int qblk) {
    const int tid = tid_(), lane = tid & 63, qi = lane & 31, hf = lane >> 5;
    const int b = bh / NH, h = bh % NH, q0 = qblk * 32;
    const bf16_t* PS = (const bf16_t*)(p.ws + WS_PS); const bf16_t* VT = (const bf16_t*)(p.ws + WS_VT) + (size_t)bh * HD * SEQ; bf16_t* MIX = (bf16_t*)(p.ws + WS_MIX);
    const size_t rowq = (size_t)b * SEQ + q0 + qi;
    bf16x8 Qf[4];
#pragma unroll
    for (int ks = 0; ks < 4; ++ks) Qf[ks] = *(const bf16x8*)(PS + rowq * PS_W + h * HD + ks * 16 + hf * 8);
    const int pi = (qi & 3) + 4 * (qi >> 3) + 16 * ((qi >> 2) & 1);
    const bf16_t* kbase = PS + ((size_t)b * SEQ + pi) * PS_W + SBW + h * HD + hf * 8;
    const bf16_t* vbase = VT + (size_t)qi * SEQ + hf * 16;
    f32x16 O0, O1;
#pragma unroll
    for (int r = 0; r < 16; ++r) { O0[r] = 0.f; O1[r] = 0.f; }
    float rp = 1.0f;
    for (int kt = qblk; kt >= 0; --kt) {
        const int s0 = kt * 32;
        bf16x8 Kf[4], Vf[2][2];
#pragma unroll
        for (int ks = 0; ks < 4; ++ks) Kf[ks] = *(const bf16x8*)(kbase + (size_t)s0 * PS_W + ks * 16);
#pragma unroll
        for (int db = 0; db < 2; ++db)
#pragma unroll
            for (int s = 0; s < 2; ++s) Vf[db][s] = *(const bf16x8*)(vbase + (size_t)db * 32 * SEQ + s0 + s * 8);
        f32x16 S;
#pragma unroll
        for (int r = 0; r < 16; ++r) S[r] = 0.f;
#pragma unroll
        for (int ks = 0; ks < 4; ++ks) S = __builtin_amdgcn_mfma_f32_32x32x16_bf16(Kf[ks], Qf[ks], S, 0, 0, 0);
        float keep[16], beta[16];
        const bool diag = kt == qblk;
        float tot = 1.0f;
#pragma unroll
        for (int r = 0; r < 16; ++r) {
            const float e = __builtin_amdgcn_exp2f(S[r]);
            float k_ = __builtin_amdgcn_rcpf(1.0f + e);
            float b_ = 1.0f - k_;
            if (diag && (hf * 16 + r >= qi)) { k_ = 1.0f; b_ = 0.f; }
            keep[r] = k_; beta[r] = b_; tot *= k_;
        }
        const float toto = __shfl_xor(tot, 32);
        float e = hf ? rp : rp * toto;
        float pw[16];
#pragma unroll
        for (int r = 15; r >= 0; --r) { pw[r] = beta[r] * e; e *= keep[r]; }
        rp = rp * tot * toto;
        bf16x8 Pf[2];
#pragma unroll
        for (int s = 0; s < 2; ++s) {
            union { bf16x8 v; unsigned u[4]; } pk;
#pragma unroll
            for (int j = 0; j < 4; ++j) pk.u[j] = pk2(pw[8 * s + 2 * j], pw[8 * s + 2 * j + 1]);
            Pf[s] = pk.v;
        }
#pragma unroll
        for (int s = 0; s < 2; ++s) { O0 = __builtin_amdgcn_mfma_f32_32x32x16_bf16(Vf[0][s], Pf[s], O0, 0, 0, 0); O1 = __builtin_amdgcn_mfma_f32_32x32x16_bf16(Vf[1][s], Pf[s], O1, 0, 0, 0); }
        if (__ballot(rp != 0.0f) == 0ull) break;
    }
    const bf16_t* gp = PS + rowq * PS_W + 768 + h * HD; bf16_t* op = MIX + rowq * DM + CW + h * HD;
#pragma unroll
    for (int db = 0; db < 2; ++db)
#pragma unroll
        for (int g = 0; g < 4; ++g) {
            const int d0 = db * 32 + g * 8 + hf * 4;
            const uint2 gw = *(const uint2*)(gp + d0);
            const float g0 = bf2f((bf16_t)(gw.x & 0xffff)), g1 = bf2f((bf16_t)(gw.x >> 16)), g2 = bf2f((bf16_t)(gw.y & 0xffff)), g3 = bf2f((bf16_t)(gw.y >> 16));
            const f32x16& O = db ? O1 : O0;
            uint2 w; w.x = pk2(O[4 * g] * siluf_(g0), O[4 * g + 1] * siluf_(g1)); w.y = pk2(O[4 * g + 2] * siluf_(g2), O[4 * g + 3] * siluf_(g3));
            *(uint2*)(op + d0) = w;
        }
}

__device__ void rwkv_job(const Params& p, int l, int job, float* lds) {
    const int tid = tid_(), lane = tid & 63, wave = tid >> 6;
    const int b = job / NH, h = job % NH;
    const bf16_t* PR = (const bf16_t*)(p.ws + WS_PR); const bf16_t* PG = (const bf16_t*)(p.ws + WS_PG);
    float* VF = (float*)(p.ws + WS_VF); bf16_t* MIX = (bf16_t*)(p.ws + WS_MIX);
    const float* mu = p.in[11] + l * 1216; const float* w0 = p.in[12] + l * RWW; const float* w2 = p.in[13] + l * LORA * RWW;
    const float* a0 = p.in[14] + l * RWW; const float* a2 = p.in[15] + l * LORA * RWW; const float* kks = p.in[16] + l * RWW; const float* ka = p.in[17] + l * RWW;
    const float* rk = p.in[18] + l * RWW; const float* gng = p.in[19] + l * RWW; const float* gnb = p.in[20] + l * RWW;
    const float* v0 = p.in[21]; const float* v1 = p.in[22]; const float* v2 = p.in[23];
    float* R = lds; float* W = R + 4096; float* K = W + 4096; float* V = K + 4096; float* A = V + 4096; float* Bm = A + 4096; float* Y = Bm + 4096;
    float* WD = Y + 4096; float* AD = WD + 2048; float* VL = AD + 2048;
    float S[64];
#pragma unroll
    for (int i = 0; i < 64; ++i) S[i] = 0.f;
    for (int c = 0; c < SEQ / 64; ++c) {
        const int t0 = c * 64;
        for (int idx = tid; idx < 64 * 64; idx += 512) {
            const int tt = idx >> 6, i = idx & 63, t = t0 + tt;
            const bf16_t* cur = PR + ((size_t)b * SEQ + t) * PR_W;
            const float xc = bf2f(cur[1152 + i]), xp = t > 0 ? bf2f(cur[1152 + i - PR_W]) : 0.f;
            const float f = xc + (xp - xc) * mu[1152 + i];
            if (i < 32) WD[tt * 32 + i] = tanhf(f); else AD[tt * 32 + i - 32] = f;
        }
        if (l > 0) {
            for (int idx = tid; idx < 64 * 32; idx += 512) {
                const int tt = idx >> 5, i = idx & 31, t = t0 + tt;
                const bf16_t* cur = PR + ((size_t)b * SEQ + t) * PR_W + 768;
                float a = 0.f;
                for (int cc = 0; cc < RWW; ++cc) {
                    const float xc = bf2f(cur[cc]), xp = t > 0 ? bf2f(cur[cc - PR_W]) : 0.f;
                    a += (xc + (xp - xc) * mu[768 + cc]) * v1[cc * LORA + i];
                }
                VL[idx] = a;
            }
        }
        __syncthreads();
        for (int idx = tid; idx < 64 * 64; idx += 512) {
            const int tt = idx >> 6, j = idx & 63, t = t0 + tt, cj = h * HD + j;
            const size_t row = (size_t)b * SEQ + t;
            const bf16_t* cur = PR + row * PR_W;
            const bool hp = t > 0;
            float rc = bf2f(cur[cj]), kc = bf2f(cur[384 + cj]), vc = bf2f(cur[768 + cj]);
            const float rp_ = hp ? bf2f(cur[cj - PR_W]) : 0.f, kp_ = hp ? bf2f(cur[384 + cj - PR_W]) : 0.f, vp_ = hp ? bf2f(cur[768 + cj - PR_W]) : 0.f;
            rc += (rp_ - rc) * mu[cj]; kc += (kp_ - kc) * mu[384 + cj]; vc += (vp_ - vc) * mu[768 + cj];
            float wl = w0[cj], al = a0[cj];
#pragma unroll 8
            for (int i = 0; i < LORA; ++i) { wl += WD[tt * 32 + i] * w2[i * RWW + cj]; al += AD[tt * 32 + i] * a2[i * RWW + cj]; }
            const float sp = fmaxf(-wl, 0.f) + log1pf(__expf(-fabsf(wl)));
            const float decay = __expf(-__expf(-sp - 0.5f));
            const float alr = sigmoidf_(al);
            if (l > 0) {
                float vg = v0[cj];
#pragma unroll 8
                for (int i = 0; i < LORA; ++i) vg += VL[tt * 32 + i] * v2[i * RWW + cj];
                vg = sigmoidf_(vg);
                vc = vc + (VF[row * RWW + cj] - vc) * vg;
            } else VF[row * RWW + cj] = vc;
            R[idx] = rc; W[idx] = decay; V[idx] = vc;
            K[idx] = kc * (1.0f + (alr - 1.0f) * ka[cj]);
            A[idx] = kc * kks[cj];
            Bm[idx] = alr;
        }
        __syncthreads();
        for (int q = 0; q < 8; ++q) {
            const int tt = wave * 8 + q; const float kk = A[tt * 64 + lane];
            const float nrm = sqrtf(wave_sum(kk * kk));
            const float kn = kk / fmaxf(nrm, 1e-12f);
            A[tt * 64 + lane] = -kn; Bm[tt * 64 + lane] = kn * Bm[tt * 64 + lane];
        }
        __syncthreads();
        if (wave == 0) {
            for (int tt = 0; tt < 64; ++tt) {
                const f32x4* a4 = (const f32x4*)(A + tt * 64); const f32x4* w4 = (const f32x4*)(W + tt * 64); const f32x4* b4 = (const f32x4*)(Bm + tt * 64);
                const f32x4* k4 = (const f32x4*)(K + tt * 64); const f32x4* r4 = (const f32x4*)(R + tt * 64);
                float sa = 0.f;
#pragma unroll
                for (int i = 0; i < 16; ++i) { const f32x4 a = a4[i]; sa += S[4 * i] * a[0] + S[4 * i + 1] * a[1] + S[4 * i + 2] * a[2] + S[4 * i + 3] * a[3];
                    if ((i & 7) == 7) asm volatile("" ::: "memory"); }
                const float vv = V[tt * 64 + lane];
                float y = 0.f;
#pragma unroll
                for (int i = 0; i < 16; ++i) { const f32x4 w = w4[i], bb = b4[i], kk = k4[i], rr = r4[i];
#pragma unroll
                    for (int e = 0; e < 4; ++e) { const float s = S[4 * i + e] * w[e] + sa * bb[e] + vv * kk[e]; S[4 * i + e] = s; y += s * rr[e]; }
                    if ((i & 1) == 1) asm volatile("" ::: "memory"); }
                Y[tt * 64 + lane] = y;
            }
        }
        __syncthreads();
        for (int q = 0; q < 8; ++q) {
            const int tt = wave * 8 + q, t = t0 + tt, cj = h * HD + lane; const size_t row = (size_t)b * SEQ + t;
            const float y = Y[tt * 64 + lane];
            const float mean = wave_sum(y) * (1.0f / HD); const float d = y - mean;
            const float var = wave_sum(d * d) * (1.0f / HD);
            const float yn = d * rsqrtf(var + GN_EPS) * gng[cj] + gnb[cj];
            const float bonus = wave_sum(R[tt * 64 + lane] * K[tt * 64 + lane] * rk[cj]);
            const float o = yn + bonus * V[tt * 64 + lane];
            const float g = bf2f(PG[row * PG_W + cj]);
            MIX[row * DM + CW + SBW + cj] = f2bf(o * siluf_(g));
        }
        __syncthreads();
    }
}

constexpr int TS = 72;
constexpr int TILE_B = 64 * TS * 2;
constexpr int AABS = 68, XTS = 65, CSS = 65;

__device__ __forceinline__ f32x4 mm_tile(const bf16_t* X, int m0, const bf16_t* Yt, int n0, int K, int fr, int fq, f32x4 acc) {
#pragma unroll
    for (int kk = 0; kk < 2; ++kk) {
        if (kk * 32 < K) {
            const bf16x8 a = *(const bf16x8*)(X + (m0 + fr) * TS + kk * 32 + fq * 8);
            const bf16x8 b = *(const bf16x8*)(Yt + (n0 + fr) * TS + kk * 32 + fq * 8);
            acc = __builtin_amdgcn_mfma_f32_16x16x32_bf16(a, b, acc, 0, 0, 0);
        }
    }
    return acc;
}
__device__ __forceinline__ uint2 pk4(const f32x4& v) { uint2 w; w.x = pk2(v[0], v[1]); w.y = pk2(v[2], v[3]); return w; }

struct B1Loads {
    bf16x8 rc, kc, vc, rp, kp, vp;
    f32x4 vf0, vf1;
    bf16x8 cc[2], cp[2];
};
__device__ __forceinline__ void b1_issue_loads(const Params& p, int l, int jb, int tid, B1Loads& L) {
    const int lane = tid & 63, wave = tid >> 6, fr = lane & 15, fq = lane >> 4;
    const int bh = jb >> 5, c = jb & 31, b = bh / NH, h = bh % NH, t0 = c * 64;
    const bf16_t* PR = (const bf16_t*)(p.ws + WS_PR); const float* VF = (const float*)(p.ws + WS_VF);
    {
        const int tt = tid >> 3, j0 = (tid & 7) * 8, t = t0 + tt, cj0 = h * HD + j0; const size_t row = (size_t)b * SEQ + t;
        const bf16_t* cur = PR + row * PR_W; const bf16_t* prv = cur - (t > 0 ? PR_W : 0);
        L.rc = *(const bf16x8*)(cur + cj0); L.kc = *(const bf16x8*)(cur + 384 + cj0); L.vc = *(const bf16x8*)(cur + 768 + cj0);
        L.rp = *(const bf16x8*)(prv + cj0); L.kp = *(const bf16x8*)(prv + 384 + cj0); L.vp = *(const bf16x8*)(prv + 768 + cj0);
        if (l > 0) { L.vf0 = *(const f32x4*)(VF + row * RWW + cj0); L.vf1 = *(const f32x4*)(VF + row * RWW + cj0 + 4); }
    }
#pragma unroll
    for (int q = 0; q < 2; ++q) {
        const int item = tid + 512 * q, tt = item >> 4, g = item & 15, t = t0 + tt;
        const bf16_t* cur = PR + ((size_t)b * SEQ + t) * PR_W + 1152; const bf16_t* prv = cur - (t > 0 ? PR_W : 0);
        const int gc = g < 12 ? g : 0, gp = g < 8 ? g : (g < 12 ? g + 4 : 0);
        L.cc[q] = *(const bf16x8*)(cur + 8 * gc); L.cp[q] = *(const bf16x8*)(prv + 8 * gp);
    }
}

__device__ void rwkv_b1_phase(const Params& p, int l, unsigned char* lds) {
    const int G = gridDim.x;
    float* VF = (float*)(p.ws + WS_VF);
    const float* mu = p.in[11] + l * 1216; const float* w0 = p.in[12] + l * RWW;
    const float* a0 = p.in[14] + l * RWW; const float* kks = p.in[16] + l * RWW; const float* ka = p.in[17] + l * RWW;
    const float* rk = p.in[18] + l * RWW; const float* v0 = p.in[21];
    const float* w2 = p.in[13] + l * LORA * RWW; const float* a2 = p.in[15] + l * LORA * RWW; const float* v2 = p.in[23];
    bf16_t* T_At = (bf16_t*)lds; bf16_t* T_Rt = T_At + 64 * TS; bf16_t* T_Bt = T_Rt + 64 * TS; bf16_t* T_Kt = T_Bt + 64 * TS;
    bf16_t* T_VT = T_Kt + 64 * TS; bf16_t* T_bhT = T_VT + 64 * TS; bf16_t* T_khT = T_bhT + 64 * TS;
    bf16_t* T_Aak = T_khT + 64 * TS; bf16_t* T_Arb = T_Aak + 64 * TS; bf16_t* T_Ark = T_Arb + 64 * TS;
    bf16_t* T_WT = T_At; bf16_t* T_U0T = T_Bt;
    float* Aab = (float*)(lds + 10 * TILE_B);
    float* XT = (float*)(lds + 10 * TILE_B + 64 * AABS * 4);
    float* PCv = XT + 128 * XTS;
    float* TI = PCv + 64;
    float* CS = (float*)T_Aak;
    constexpr int LS = 33;
    float* WD = Aab; float* AD = WD + 64 * LS;
    float* VL = XT + 64 * XTS;
    float* WLT = (float*)lds; float* ALT = WLT + 64 * XTS; float* VGT = ALT + 64 * XTS;

    int jb = blockIdx.x;
    if (jb >= BATCH * NH * 32) return;
    B1Loads L;
    b1_issue_loads(p, l, jb, tid_(), L);
#pragma unroll 1
    for (; jb < BATCH * NH * 32; jb += G) {
        const int tid = tid_(), lane = tid & 63, wave = tid >> 6, fr = lane & 15, fq = lane >> 4;
        const int bh = jb >> 5, c = jb & 31, b = bh / NH, h = bh % NH, t0 = c * 64;
        float wg[6][8];
#pragma unroll
        for (int q = 0; q < 6; ++q) {
            const int id = wave + 8 * q, Lk = id >> 4, tj = id & 3;
            if (q < 4 || l > 0) {
                const float* Wg = (Lk == 0 ? w2 : (Lk == 1 ? a2 : v2)) + (size_t)fq * RWW + h * HD + tj * 16 + fr;
#pragma unroll
                for (int kk = 0; kk < 8; ++kk) wg[q][kk] = Wg[(size_t)kk * 4 * RWW];
            }
        }
#pragma unroll
        for (int q = 0; q < 2; ++q) {
            const int item = tid + 512 * q, tt = item >> 4, g = item & 15, t = t0 + tt; const bool hp = t > 0;
            if (g < 8) {
                float* dst = (g < 4 ? WD + tt * LS + 8 * g : AD + tt * LS + 8 * (g - 4));
#pragma unroll
                for (int e = 0; e < 8; ++e) {
                    const float xc = bf2f((bf16_t)L.cc[q][e]), xp = hp ? bf2f((bf16_t)L.cp[q][e]) : 0.f;
                    const float x_ = xc + (xp - xc) * mu[1152 + 8 * g + e];
                    dst[e] = g < 4 ? 1.0f - 2.0f * __builtin_amdgcn_rcpf(1.0f + __builtin_amdgcn_exp2f(2.8853900817779268f * x_)) : x_;
                }
            } else if (g < 12 && l > 0) {
#pragma unroll
                for (int e = 0; e < 8; ++e) VL[tt * LS + 8 * (g - 8) + e] = bf2f((bf16_t)L.cc[q][e]) + (hp ? bf2f((bf16_t)L.cp[q][e]) : 0.f);
            }
        }
        __syncthreads();
#pragma unroll
        for (int q = 0; q < 6; ++q) {
            if (q < 4 || l > 0) {
                const int id = wave + 8 * q, Lk = id >> 4, ti = (id >> 2) & 3, tj = id & 3;
                const float* Xs = (Lk == 0 ? WD : (Lk == 1 ? AD : VL)) + (ti * 16 + fr) * LS + fq;
                f32x4 acc = (f32x4){0.f, 0.f, 0.f, 0.f};
#pragma unroll
                for (int kk = 0; kk < 8; ++kk) acc = __builtin_amdgcn_mfma_f32_16x16x4f32(Xs[kk * 4], wg[q][kk], acc, 0, 0, 0);
                float* out = (Lk == 0 ? WLT : (Lk == 1 ? ALT : VGT)) + (tj * 16 + fr) * XTS + ti * 16 + fq * 4;
#pragma unroll
                for (int r = 0; r < 4; ++r) out[r] = acc[r];
            }
        }
        __syncthreads();
        const int tt = tid >> 3, j0 = (tid & 7) * 8, t = t0 + tt, cj0 = h * HD + j0;
        const size_t row = (size_t)b * SEQ + t;
        float rr[8], kk_[8], vv[8], aa[8], bb[8], lw[8];
        {
            const bool hp = t > 0;
            float wl[8], al[8], vg[8];
#pragma unroll
            for (int e = 0; e < 8; ++e) {
                const float r_c = bf2f((bf16_t)L.rc[e]), k_c = bf2f((bf16_t)L.kc[e]), v_c = bf2f((bf16_t)L.vc[e]);
                const float r_p = hp ? bf2f((bf16_t)L.rp[e]) : 0.f, k_p = hp ? bf2f((bf16_t)L.kp[e]) : 0.f, v_p = hp ? bf2f((bf16_t)L.vp[e]) : 0.f;
                rr[e] = r_c + (r_p - r_c) * mu[cj0 + e]; kk_[e] = k_c + (k_p - k_c) * mu[384 + cj0 + e]; vv[e] = v_c + (v_p - v_c) * mu[768 + cj0 + e];
                wl[e] = w0[cj0 + e] + WLT[(j0 + e) * XTS + tt]; al[e] = a0[cj0 + e] + ALT[(j0 + e) * XTS + tt]; vg[e] = l > 0 ? v0[cj0 + e] + VGT[(j0 + e) * XTS + tt] : 0.f;
            }
            float ssq = 0.f, bon = 0.f;
#pragma unroll
            for (int e = 0; e < 8; ++e) {
                const float sp2 = fmaxf(-wl[e], 0.f) * 1.4426950408889634f + __builtin_amdgcn_logf(1.0f + __builtin_amdgcn_exp2f(-1.4426950408889634f * fabsf(wl[e])));
                lw[e] = -__builtin_amdgcn_exp2f(-sp2 - 0.7213475204444817f);
                const float alr = __builtin_amdgcn_rcpf(1.0f + __builtin_amdgcn_exp2f(-1.4426950408889634f * al[e]));
                if (l > 0) { const float vf = e < 4 ? L.vf0[e & 3] : L.vf1[e & 3]; vv[e] = vv[e] + (vf - vv[e]) * __builtin_amdgcn_rcpf(1.0f + __builtin_amdgcn_exp2f(-1.4426950408889634f * vg[e])); }
                const float kkr = kk_[e] * kks[cj0 + e];
                kk_[e] = kk_[e] * (1.0f + (alr - 1.0f) * ka[cj0 + e]);
                aa[e] = kkr; bb[e] = alr; ssq += kkr * kkr; bon += rr[e] * kk_[e] * rk[cj0 + e];
            }
            if (l == 0) { *(f32x4*)(VF + row * RWW + cj0) = (f32x4){vv[0], vv[1], vv[2], vv[3]}; *(f32x4*)(VF + row * RWW + cj0 + 4) = (f32x4){vv[4], vv[5], vv[6], vv[7]}; }
            ssq += __shfl_xor(ssq, 1); ssq += __shfl_xor(ssq, 2); ssq += __shfl_xor(ssq, 4);
            bon += __shfl_xor(bon, 1); bon += __shfl_xor(bon, 2); bon += __shfl_xor(bon, 4);
            const float inv = fminf(__builtin_amdgcn_rsqf(ssq), 1e12f);
            uint4 bvw; float bv[8];
#pragma unroll
            for (int e = 0; e < 8; ++e) { const float kn = aa[e] * inv; aa[e] = -kn; bb[e] = kn * bb[e]; bv[e] = bon * vv[e]; CS[tt * CSS + j0 + e] = lw[e]; }
            bvw.x = pk2(bv[0], bv[1]); bvw.y = pk2(bv[2], bv[3]); bvw.z = pk2(bv[4], bv[5]); bvw.w = pk2(bv[6], bv[7]);
            *(uint4*)((bf16_t*)(p.ws + WS_CH_BV) + (size_t)jb * 4096 + tt * 64 + j0) = bvw;
        }
        __syncthreads();
#pragma unroll
        for (int e = 0; e < 8; ++e) {
            const int j = wave * 8 + e; float x = CS[lane * CSS + j];
#pragma unroll
            for (int o = 1; o < 64; o <<= 1) { const float y = __shfl_up(x, o); if (lane >= o) x += y; }
            CS[lane * CSS + j] = x;
        }
        __syncthreads();
        {
            float at[8], rt[8], bt[8], kt[8];
#pragma unroll
            for (int e = 0; e < 8; ++e) {
                const int j = j0 + e; const float cs = CS[tt * CSS + j] * 1.4426950408889634f, csC = CS[63 * CSS + j] * 1.4426950408889634f, lw2 = lw[e] * 1.4426950408889634f;
                const float e_in = __builtin_amdgcn_exp2f(cs), e_ex = __builtin_amdgcn_exp2f(cs - lw2), e_ng = __builtin_amdgcn_exp2f(-cs), e_ht = __builtin_amdgcn_exp2f(csC - cs);
                at[e] = aa[e] * e_ex; rt[e] = rr[e] * e_in; bt[e] = bb[e] * e_ng; kt[e] = kk_[e] * e_ng;
                T_VT[j * TS + tt] = f2bf(vv[e]); T_bhT[j * TS + tt] = f2bf(bb[e] * e_ht); T_khT[j * TS + tt] = f2bf(kk_[e] * e_ht);
                XT[j * XTS + tt] = at[e];
                if (tt == 63) PCv[j] = __builtin_amdgcn_exp2f(csC);
            }
            uint4 w;
            w.x = pk2(at[0], at[1]); w.y = pk2(at[2], at[3]); w.z = pk2(at[4], at[5]); w.w = pk2(at[6], at[7]); *(uint4*)(T_At + tt * TS + j0) = w;
            w.x = pk2(rt[0], rt[1]); w.y = pk2(rt[2], rt[3]); w.z = pk2(rt[4], rt[5]); w.w = pk2(rt[6], rt[7]); *(uint4*)(T_Rt + tt * TS + j0) = w;
            w.x = pk2(bt[0], bt[1]); w.y = pk2(bt[2], bt[3]); w.z = pk2(bt[4], bt[5]); w.w = pk2(bt[6], bt[7]); *(uint4*)(T_Bt + tt * TS + j0) = w;
            w.x = pk2(kt[0], kt[1]); w.y = pk2(kt[2], kt[3]); w.z = pk2(kt[4], kt[5]); w.w = pk2(kt[6], kt[7]); *(uint4*)(T_Kt + tt * TS + j0) = w;
        }
        __syncthreads();
        if (jb + G < BATCH * NH * 32) b1_issue_loads(p, l, jb + G, tid, L);
#pragma unroll 2
        for (int q = 0; q < 8; ++q) {
            const int id = wave * 8 + q, mat = id >> 4, ti = (id >> 2) & 3, tj = id & 3;
            const bf16_t* As = (mat == 0 || mat == 2) ? T_Bt : T_Kt; const bf16_t* Bs = (mat < 2) ? T_At : T_Rt;
            f32x4 acc = (f32x4){0.f, 0.f, 0.f, 0.f};
            if (ti <= tj) acc = mm_tile(As, ti * 16, Bs, tj * 16, 64, fr, fq, acc);
            const int tcol = tj * 16 + fr, i0 = ti * 16 + fq * 4;
#pragma unroll
            for (int r = 0; r < 4; ++r) { const bool keep = (mat < 2) ? (i0 + r < tcol) : (i0 + r <= tcol); if (!keep) acc[r] = 0.f; }
            if (mat == 0) *(f32x4*)(Aab + tcol * AABS + i0) = acc;
            else { bf16_t* dst = (mat == 1 ? T_Aak : (mat == 2 ? T_Arb : T_Ark)); *(uint2*)(dst + tcol * TS + i0) = pk4(acc); }
        }
        __syncthreads();
        if (wave == 0) {
            const int blk = lane >> 4, cc = lane & 15; const float* ar = Aab + (16 * blk) * AABS + 16 * blk;
            float x[16];
#pragma unroll
            for (int u = 0; u < 16; ++u) { float v = (u == cc) ? 1.0f : 0.f;
#pragma unroll
                for (int i = 0; i < u; ++i) v += ar[u * AABS + i] * x[i];
                x[u] = v; }
#pragma unroll
            for (int u = 0; u < 16; ++u) TI[(blk * 16 + u) * 17 + cc] = x[u];
        } else {
#pragma unroll 1
            for (int id = wave - 1; id < 16; id += 7) {
                const int ti = id >> 2, tj = id & 3;
                f32x4 acc = mm_tile(T_Aak, ti * 16, T_VT, tj * 16, 64, fr, fq, (f32x4){0.f, 0.f, 0.f, 0.f});
                const int j = tj * 16 + fr, tr = ti * 16 + fq * 4;
#pragma unroll
                for (int r = 0; r < 4; ++r) XT[(64 + j) * XTS + tr + r] = acc[r];
            }
        }
        __syncthreads();
        {
            float* xc = XT + (wave * 16 + fr) * XTS;
#pragma unroll
            for (int I = 0; I < 4; ++I) {
                f32x4 acc;
#pragma unroll
                for (int r = 0; r < 4; ++r) acc[r] = xc[16 * I + 4 * fq + r];
#pragma unroll
                for (int J = 0; J < I; ++J)
#pragma unroll
                    for (int kk = 0; kk < 4; ++kk) acc = __builtin_amdgcn_mfma_f32_16x16x4f32(Aab[(16 * I + fr) * AABS + 16 * J + 4 * kk + fq], xc[16 * J + 4 * kk + fq], acc, 0, 0, 0);
#pragma unroll
                for (int r = 0; r < 4; ++r) xc[16 * I + 4 * fq + r] = acc[r];
                asm volatile("s_waitcnt lgkmcnt(0)" ::: "memory");
                f32x4 xs = (f32x4){0.f, 0.f, 0.f, 0.f};
#pragma unroll
                for (int kk = 0; kk < 4; ++kk) xs = __builtin_amdgcn_mfma_f32_16x16x4f32(TI[(I * 16 + fr) * 17 + 4 * kk + fq], xc[16 * I + 4 * kk + fq], xs, 0, 0, 0);
                asm volatile("s_waitcnt lgkmcnt(0)" ::: "memory");
#pragma unroll
                for (int r = 0; r < 4; ++r) xc[16 * I + 4 * fq + r] = xs[r];
                asm volatile("s_waitcnt lgkmcnt(0)" ::: "memory");
            }
        }
        __syncthreads();
        {
            const int col = tid >> 2, tg = (tid & 3) * 16;
            const float* xr = XT + col * XTS + tg; bf16_t* dst = (col < 64 ? T_WT + col * TS : T_U0T + (col - 64) * TS) + tg;
            uint4 w0_, w1_;
            w0_.x = pk2(xr[0], xr[1]); w0_.y = pk2(xr[2], xr[3]); w0_.z = pk2(xr[4], xr[5]); w0_.w = pk2(xr[6], xr[7]);
            w1_.x = pk2(xr[8], xr[9]); w1_.y = pk2(xr[10], xr[11]); w1_.z = pk2(xr[12], xr[13]); w1_.w = pk2(xr[14], xr[15]);
            *(uint4*)dst = w0_; *(uint4*)(dst + 8) = w1_;
        }
        __syncthreads();
        {
            bf16_t* gM = (bf16_t*)(p.ws + WS_CH_M) + (size_t)jb * 4096; bf16_t* gNT = (bf16_t*)(p.ws + WS_CH_NT) + (size_t)jb * 4096;
            bf16_t* gG = (bf16_t*)(p.ws + WS_CH_G) + (size_t)jb * 4096; bf16_t* gY1T = (bf16_t*)(p.ws + WS_CH_Y1T) + (size_t)jb * 4096;
#pragma unroll 2
            for (int q = 0; q < 8; ++q) {
                const int id = wave * 8 + q, mat = id >> 4, ti = (id >> 2) & 3, tj = id & 3;
                const int col = tj * 16 + fr, r0 = ti * 16 + fq * 4;
                f32x4 acc = (f32x4){0.f, 0.f, 0.f, 0.f};
                if (mat == 0) {
                    acc = mm_tile(T_WT, ti * 16, T_Arb, tj * 16, 64, fr, fq, acc);
                    const uint2 rw = *(const uint2*)(T_Rt + col * TS + r0);
                    acc[0] += bf2f((bf16_t)(rw.x & 0xffff)); acc[1] += bf2f((bf16_t)(rw.x >> 16)); acc[2] += bf2f((bf16_t)(rw.y & 0xffff)); acc[3] += bf2f((bf16_t)(rw.y >> 16));
                    *(uint2*)(gG + col * 64 + r0) = pk4(acc);
                } else if (mat == 1) {
                    acc = mm_tile(T_Arb, ti * 16, T_U0T, tj * 16, 64, fr, fq, acc);
                    acc = mm_tile(T_Ark, ti * 16, T_VT, tj * 16, 64, fr, fq, acc);
                    *(uint2*)(gY1T + col * 64 + r0) = pk4(acc);
                } else if (mat == 2) {
                    acc = mm_tile(T_WT, ti * 16, T_bhT, tj * 16, 64, fr, fq, acc);
                    const float pc = PCv[col];
#pragma unroll
                    for (int r = 0; r < 4; ++r) if (r0 + r == col) acc[r] += pc;
                    *(uint2*)(gM + col * 64 + r0) = pk4(acc);
                } else {
                    acc = mm_tile(T_bhT, ti * 16, T_U0T, tj * 16, 64, fr, fq, acc);
                    acc = mm_tile(T_khT, ti * 16, T_VT, tj * 16, 64, fr, fq, acc);
                    *(uint2*)(gNT + col * 64 + r0) = pk4(acc);
                }
            }
        }
        __syncthreads();
    }
}

__device__ void rwkv_b2_job(const Params& p, int bh, unsigned char* lds) {
    const int tid = tid_(), lane = tid & 63, wave = tid >> 6, fr = lane & 15, fq = lane >> 4;
    const int mi = wave >> 1, nj0 = (wave & 1) * 2;
    const bf16_t* gM = (const bf16_t*)(p.ws + WS_CH_M); const bf16_t* gNT = (const bf16_t*)(p.ws + WS_CH_NT); bf16_t* gZT = (bf16_t*)(p.ws + WS_ZT);
    bf16_t* zbuf = (bf16_t*)lds;
    f32x4 z[2];
    z[0] = (f32x4){0.f, 0.f, 0.f, 0.f}; z[1] = z[0];
    const int c0 = mi * 16 + fq * 4;
    bf16x8 am[2]; uint2 nw[2];
    {
        const size_t jb = (size_t)bh * 32;
#pragma unroll
        for (int kk = 0; kk < 2; ++kk) am[kk] = *(const bf16x8*)(gM + jb * 4096 + (mi * 16 + fr) * 64 + kk * 32 + fq * 8);
#pragma unroll
        for (int q = 0; q < 2; ++q) nw[q] = *(const uint2*)(gNT + jb * 4096 + ((nj0 + q) * 16 + fr) * 64 + c0);
    }
#pragma unroll 1
    for (int c = 0; c < SEQ / 64; ++c) {
        const size_t jb = (size_t)bh * 32 + c;
        bf16_t* zh = zbuf + (c & 1) * 2 * 64 * TS; bf16_t* zl = zh + 64 * TS;
#pragma unroll
        for (int q = 0; q < 2; ++q) {
            const int j = (nj0 + q) * 16 + fr;
            const uint2 hi = pk4(z[q]);
            f32x4 lo;
            lo[0] = z[q][0] - bf2f((bf16_t)(hi.x & 0xffff)); lo[1] = z[q][1] - bf2f((bf16_t)(hi.x >> 16)); lo[2] = z[q][2] - bf2f((bf16_t)(hi.y & 0xffff)); lo[3] = z[q][3] - bf2f((bf16_t)(hi.y >> 16));
            *(uint2*)(zh + j * TS + c0) = hi; *(uint2*)(zl + j * TS + c0) = pk4(lo);
            *(uint2*)(gZT + jb * 4096 + j * 64 + c0) = hi;
        }
        bf16x8 amn[2]; uint2 nwn[2];
        {
            const size_t jn = (size_t)bh * 32 + (c + 1 < SEQ / 64 ? c + 1 : c);
#pragma unroll
            for (int kk = 0; kk < 2; ++kk) amn[kk] = *(const bf16x8*)(gM + jn * 4096 + (mi * 16 + fr) * 64 + kk * 32 + fq * 8);
#pragma unroll
            for (int q = 0; q < 2; ++q) nwn[q] = *(const uint2*)(gNT + jn * 4096 + ((nj0 + q) * 16 + fr) * 64 + c0);
        }
        __syncthreads();
#pragma unroll
        for (int q = 0; q < 2; ++q) {
            const int j = (nj0 + q) * 16 + fr;
            f32x4 acc; acc[0] = bf2f((bf16_t)(nw[q].x & 0xffff)); acc[1] = bf2f((bf16_t)(nw[q].x >> 16)); acc[2] = bf2f((bf16_t)(nw[q].y & 0xffff)); acc[3] = bf2f((bf16_t)(nw[q].y >> 16));
#pragma unroll
            for (int kk = 0; kk < 2; ++kk) {
                const bf16x8 bh_ = *(const bf16x8*)(zh + j * TS + kk * 32 + fq * 8), bl_ = *(const bf16x8*)(zl + j * TS + kk * 32 + fq * 8);
                acc = __builtin_amdgcn_mfma_f32_16x16x32_bf16(am[kk], bh_, acc, 0, 0, 0);
                acc = __builtin_amdgcn_mfma_f32_16x16x32_bf16(am[kk], bl_, acc, 0, 0, 0);
            }
            z[q] = acc;
        }
        am[0] = amn[0]; am[1] = amn[1]; nw[0] = nwn[0]; nw[1] = nwn[1];
    }
    __syncthreads();
}

__device__ void rwkv_b3_pair(const Params& p, int l, int pair) {
    const int tid = tid_(), lane = tid & 63, wave = tid >> 6, fr = lane & 15, fq = lane >> 4;
    const int jb = pair * 2 + (wave >> 2), mi = wave & 3;
    const int bh = jb >> 5, c = jb & 31, b = bh / NH, h = bh % NH;
    const bf16_t* gG = (const bf16_t*)(p.ws + WS_CH_G) + (size_t)jb * 4096; const bf16_t* gY1T = (const bf16_t*)(p.ws + WS_CH_Y1T) + (size_t)jb * 4096;
    const bf16_t* gBV = (const bf16_t*)(p.ws + WS_CH_BV) + (size_t)jb * 4096; const bf16_t* gZT = (const bf16_t*)(p.ws + WS_ZT) + (size_t)jb * 4096;
    const bf16_t* PG = (const bf16_t*)(p.ws + WS_PG); bf16_t* MIX = (bf16_t*)(p.ws + WS_MIX);
    const float* gng = p.in[19] + l * RWW; const float* gnb = p.in[20] + l * RWW;
    const int tr = mi * 16 + fq * 4;
    bf16x8 ag[2];
#pragma unroll
    for (int kk = 0; kk < 2; ++kk) ag[kk] = *(const bf16x8*)(gG + (mi * 16 + fr) * 64 + kk * 32 + fq * 8);
    f32x4 acc[4];
#pragma unroll
    for (int nj = 0; nj < 4; ++nj) {
        const int j = nj * 16 + fr;
        const uint2 yw = *(const uint2*)(gY1T + j * 64 + tr);
        acc[nj][0] = bf2f((bf16_t)(yw.x & 0xffff)); acc[nj][1] = bf2f((bf16_t)(yw.x >> 16)); acc[nj][2] = bf2f((bf16_t)(yw.y & 0xffff)); acc[nj][3] = bf2f((bf16_t)(yw.y >> 16));
#pragma unroll
        for (int kk = 0; kk < 2; ++kk) { const bf16x8 bz = *(const bf16x8*)(gZT + j * 64 + kk * 32 + fq * 8); acc[nj] = __builtin_amdgcn_mfma_f32_16x16x32_bf16(ag[kk], bz, acc[nj], 0, 0, 0); }
    }
#pragma unroll
    for (int r = 0; r < 4; ++r) {
        float s = acc[0][r] + acc[1][r] + acc[2][r] + acc[3][r];
        s += __shfl_xor(s, 1); s += __shfl_xor(s, 2); s += __shfl_xor(s, 4); s += __shfl_xor(s, 8);
        const float mean = s * (1.0f / HD);
        float d[4], vs = 0.f;
#pragma unroll
        for (int nj = 0; nj < 4; ++nj) { d[nj] = acc[nj][r] - mean; vs += d[nj] * d[nj]; }
        vs += __shfl_xor(vs, 1); vs += __shfl_xor(vs, 2); vs += __shfl_xor(vs, 4); vs += __shfl_xor(vs, 8);
        const float rstd = rsqrtf(vs * (1.0f / HD) + GN_EPS);
        const int tt = tr + r; const size_t row = (size_t)b * SEQ + c * 64 + tt;
#pragma unroll
        for (int nj = 0; nj < 4; ++nj) {
            const int j = nj * 16 + fr, cj = h * HD + j;
            const float o = d[nj] * rstd * gng[cj] + gnb[cj] + bf2f(gBV[tt * 64 + j]);
            const float g = bf2f(PG[row * PG_W + cj]);
            MIX[row * DM + CW + SBW + cj] = f2bf(o * siluf_(g));
        }
    }
}

#ifndef ATTN_REF
#define ATTN_REF 0
#endif
#ifndef RWKV_REF
#define RWKV_REF 0
#endif
__device__ void phase_mix1(const Params& p, int l, unsigned char* lds) {
    constexpr int NAT = BATCH * NH * 4, NCV = BATCH * (SEQ / 32);
    const int G = gridDim.x;
#if RWKV_REF
    for (int job = blockIdx.x; job < BATCH * NH; job += G) rwkv_job(p, l, job, (float*)lds);
#else
    for (int rep = 0; rep < ((PROBE_REP & 1) ? 2 : 1); ++rep) rwkv_b1_phase(p, l, lds);
#endif
    for (int rep = 0; rep < ((PROBE_REP & 2) ? 2 : 1); ++rep)
#if ATTN_REF
    for (int job = blockIdx.x; job < NAT; job += G) attn_job(p, job);
#else
    for (int job = blockIdx.x; job < NAT * 2; job += G) attn_mfma_wave(p, job >> 3, (job & 7) * 8 + (tid_() >> 6));
#endif
#ifndef CONV_REF
#define CONV_REF 0
#endif
    for (int rep = 0; rep < ((PROBE_REP & 4) ? 2 : 1); ++rep)
#if CONV_REF
    for (int job = blockIdx.x; job < NCV; job += G) conv_job(p, l, job, (float*)lds);
#else
    for (int job = blockIdx.x; job < BATCH * (SEQ / 64); job += G) conv_job64(p, l, job, lds);
#endif
}
__device__ void phase_mix2(const Params& p, int l, unsigned char* lds) {
#if !RWKV_REF
    for (int rep = 0; rep < ((PROBE_REP & 8) ? 2 : 1); ++rep)
    for (int job = blockIdx.x; job < BATCH * NH; job += gridDim.x) rwkv_b2_job(p, job, lds);
#endif
}
__device__ void phase_mix3(const Params& p, int l, unsigned char* lds) {
#if !RWKV_REF
    for (int rep = 0; rep < ((PROBE_REP & 16) ? 2 : 1); ++rep)
    for (int pair = blockIdx.x; pair < BATCH * NH * 16; pair += gridDim.x) rwkv_b3_pair(p, l, pair);
#endif
}

#define LAS __attribute__((address_space(3)))
#define XB_TMO      128
#define XB_XCNT(j)  (256  + 64 * (j))
#define XB_XSUB(j)  (1280 + 64 * (j))
#define XB_XGEN(j)  (2304 + 64 * (j))
#define XB_TOP      3328
#define XB_TOPGEN   3392
#define XCD_BAR_WORDS 3456
#define XB_SPIN_CAP (1u << 18)

__device__ __forceinline__ unsigned xb_ld(unsigned* p)              { return __hip_atomic_load(p, __ATOMIC_RELAXED, __HIP_MEMORY_SCOPE_AGENT); }
__device__ __forceinline__ unsigned xb_add(unsigned* p, unsigned v) { return __hip_atomic_fetch_add(p, v, __ATOMIC_RELAXED, __HIP_MEMORY_SCOPE_AGENT); }
__device__ __forceinline__ unsigned xb_xcc_id() { return (unsigned)__builtin_amdgcn_s_getreg((3 << 11) | 20) & 0xFu; }
#define XB_SPIN(cond, bar) do { unsigned _sp = 0; while (cond) { __builtin_amdgcn_s_sleep(1); \
    if ((++_sp & 255u) == 0u) { if (xb_ld(&(bar)[XB_TMO])) break; if (_sp > XB_SPIN_CAP) { atomicAdd(&(bar)[XB_TMO], 1u); break; } } } } while (0)

struct XcdBarrier {
    unsigned* bar; unsigned x;
    volatile LAS unsigned* st;
};

__device__ __forceinline__ XcdBarrier xcd_barrier_post(unsigned* bar, volatile LAS unsigned* st) {
    XcdBarrier b; b.bar = bar; b.x = xb_xcc_id(); b.st = st;
    if (threadIdx.x == 0) (void)xb_add(&bar[XB_XCNT(b.x)], 1u);
    return b;
}
__device__ __forceinline__ void xcd_barrier_complete(unsigned* bar, unsigned x, unsigned& nloc, unsigned& nx) {
    const unsigned G = gridDim.x * gridDim.y * gridDim.z;
    unsigned sum, cnt, mine, sp = 0u;
    for (;;) {
        sum = 0u; cnt = 0u; mine = 0u;
#pragma unroll
        for (unsigned j = 0; j < 16; ++j) { const unsigned c = xb_ld(&bar[XB_XCNT(j)]); sum += c; cnt += (c > 0u) ? 1u : 0u; mine = (j == x) ? c : mine; }
        if (sum == G) break;
        __builtin_amdgcn_s_sleep(1);
        if ((++sp & 255u) == 0u) { if (xb_ld(&bar[XB_TMO])) break; if (sp > XB_SPIN_CAP) { atomicAdd(&bar[XB_TMO], 1u); break; } }
    }
    nloc = mine > 0u ? mine : 1u; nx = cnt > 0u ? cnt : 1u;
}

__device__ __forceinline__ void xcd_barrier(const XcdBarrier& b) {
    asm volatile("s_waitcnt vmcnt(0)" ::: "memory");
    __syncthreads();
    if (threadIdx.x == 0) {
        unsigned* bar = b.bar;
        __builtin_amdgcn_s_waitcnt(0);
        unsigned nloc = b.st[0], nx = b.st[1];
        if (nloc == 0u) { xcd_barrier_complete(bar, b.x, nloc, nx); b.st[0] = nloc; b.st[1] = nx; }
        const unsigned old = xb_add(&bar[XB_XSUB(b.x)], 1u);
        const unsigned gen = old / nloc;
        if (old + 1u == (gen + 1u) * nloc) {
            __builtin_amdgcn_fence(__ATOMIC_RELEASE, "agent");
            asm volatile("s_waitcnt vmcnt(0)" ::: "memory");
            const unsigned og = xb_add(&bar[XB_TOP], 1u);
            const unsigned tg = og / nx;
            if (og + 1u == (tg + 1u) * nx) xb_add(&bar[XB_TOPGEN], 1u);
            else XB_SPIN(xb_ld(&bar[XB_TOPGEN]) == tg, bar);
            __builtin_amdgcn_fence(__ATOMIC_ACQUIRE, "agent");
            xb_add(&bar[XB_XGEN(b.x)], 1u);
            asm volatile("s_waitcnt vmcnt(0)" ::: "memory");
        } else {
            XB_SPIN(xb_ld(&bar[XB_XGEN(b.x)]) == gen, bar);
            __builtin_amdgcn_fence(__ATOMIC_ACQUIRE, "agent");
            asm volatile("s_waitcnt vmcnt(0)" ::: "memory");
        }
    }
    __syncthreads();
}

constexpr int PH_PER_LAYER = 6;
constexpr int N_PHASES = 1 + PH_PER_LAYER * DEPTH;
__device__ __forceinline__ void run_phase(const Params& p, int ph, unsigned char* lds) {
    unsigned char* ws = p.ws;
    if (ph == 0) { for (int rep = 0; rep < ((PROBE_REP & 4096) ? 2 : 1); ++rep) phase_prologue(p, lds); return; }
    const int l = (ph - 1) / PH_PER_LAYER, k = (ph - 1) % PH_PER_LAYER;
    if (k == 0) {
        EpiInProjP E{(bf16_t*)(ws + WS_PC), (bf16_t*)(ws + WS_PS), (bf16_t*)(ws + WS_PR), (bf16_t*)(ws + WS_PG), (bf16_t*)(ws + WS_VT)};
        pg8::Gemm g{(const bf16_t*)(ws + WS_XB), (const bf16_t*)(ws + WS_WIN) + (size_t)l * NINT * DM, M, NINT, DM}; pg8::StaticOrder S; S.init(M, NINT, (int)gridDim.x, (int)blockIdx.x);
        for (int rep = 0; rep < ((PROBE_REP & 32) ? 2 : 1); ++rep)
        pg8::gemm_phase<EpiInProjP, pg8::StaticOrder, true, true>((PG8_LAS unsigned char*)lds, g, S, E);
    } else if (k == 1) {
        phase_mix1(p, l, lds);
    } else if (k == 2) {
        phase_mix2(p, l, lds);
    } else if (k == 3) {
        phase_mix3(p, l, lds);
    } else if (k == 4) {
        EpiOutBf16P E{(bf16_t*)(ws + WS_Y), DM};
        pg8::Gemm g{(const bf16_t*)(ws + WS_MIX), (const bf16_t*)(ws + WS_WOUT) + (size_t)l * DM * DM, M, DM, DM}; pg8::StaticOrder S; S.init(M, DM, (int)gridDim.x, (int)blockIdx.x);
        for (int rep = 0; rep < ((PROBE_REP & 64) ? 2 : 1); ++rep)
        pg8::gemm_phase<EpiOutBf16P, pg8::StaticOrder, true, true>((PG8_LAS unsigned char*)lds, g, S, E);
    } else {
        for (int rep = 0; rep < ((PROBE_REP & 8192) && l == 0 ? 2 : 1); ++rep)
        phase_rowpass(l == 0 ? p.in[0] : p.out, (const bf16_t*)(ws + WS_Y), p.in[2] + l * DM, p.out, l + 1 < DEPTH ? (bf16_t*)(ws + WS_XB) : nullptr);
    }
}

static_assert(10 * TILE_B + 64 * AABS * 4 + 128 * XTS * 4 + 64 * 4 + 4 * 16 * 17 * 4 <= 147456, "B1 LDS map");
constexpr int LDS_BYTES = 147456 + 256;

constexpr int MISC_OFF = 147456;
#if MK_COOP == 2
__global__ void __launch_bounds__(512, 2) fwd_kernel(Params p) {
    extern __shared__ __attribute__((aligned(16))) unsigned char lds[];
    volatile LAS unsigned* misc = (volatile LAS unsigned*)((LAS unsigned char*)lds + MISC_OFF);
    if (threadIdx.x < 16) misc[threadIdx.x] = 0u;
    __syncthreads();
    XcdBarrier bar = xcd_barrier_post((unsigned*)(p.ws + WS_CTL), misc);
    for (int ph = p.ph_lo; ph < p.ph_hi; ++ph) {
        run_phase(p, ph, lds);
        if (ph + 1 < p.ph_hi) xcd_barrier(bar);
    }
}
#elif MK_COOP == 1
__global__ void __launch_bounds__(512, 2) fwd_kernel(Params p) {
    extern __shared__ __attribute__((aligned(16))) unsigned char lds[];
    cg::grid_group grid = cg::this_grid();
    for (int ph = p.ph_lo; ph < p.ph_hi; ++ph) {
        run_phase(p, ph, lds);
        if (ph + 1 < p.ph_hi) grid.sync();
    }
}
#else
__global__ void __launch_bounds__(512, 2) fwd_kernel(Params p) {
    extern __shared__ __attribute__((aligned(16))) unsigned char lds[];
    for (int ph = p.ph_lo; ph < p.ph_hi; ++ph) run_phase(p, ph, lds);
}
#endif

extern "C" void kernel_launch(void* const* d_in, const int* in_sizes, int n_in, void* d_out, int out_size, void* d_ws, size_t ws_size, hipStream_t stream) {
    static int grid = 0;
    if (grid == 0) {
        if (n_in != 24 || out_size != M * DM || ws_size < WS_END) { fprintf(stderr, "kernel_launch: unexpected problem (n_in %d out %d ws %zu)\n", n_in, out_size, ws_size); grid = -1; return; }
        int dev = 0, cus = 0, per_cu = 0;
        hipGetDevice(&dev); hipDeviceGetAttribute(&cus, hipDeviceAttributeMultiprocessorCount, dev);
        hipFuncSetAttribute((const void*)fwd_kernel, hipFuncAttributeMaxDynamicSharedMemorySize, LDS_BYTES);
        hipOccupancyMaxActiveBlocksPerMultiprocessor(&per_cu, (const void*)fwd_kernel, 512, LDS_BYTES);
        if (per_cu < 1) { fprintf(stderr, "kernel_launch: occupancy query says %d blocks per CU\n", per_cu); per_cu = 1; }
        grid = cus;
        (void)hipGetLastError();
    }
    if (grid < 0) return;
    Params p{};
    for (int i = 0; i < 24; ++i) p.in[i] = (const float*)d_in[i];
    p.out = (float*)d_out; p.ws = (unsigned char*)d_ws;
#if MK_COOP == 2
    p.ph_lo = 0; p.ph_hi = N_PHASES;
    if (hipMemsetAsync((char*)d_ws + WS_CTL, 0, XCD_BAR_WORDS * 4, stream) != hipSuccess) { fprintf(stderr, "kernel_launch: memset of the barrier words failed\n"); return; }
    hipLaunchKernelGGL(fwd_kernel, dim3(grid), dim3(512), LDS_BYTES, stream, p);
#elif MK_COOP == 1
    p.ph_lo = 0; p.ph_hi = N_PHASES;
    void* args[] = {&p};
    hipError_t e = hipLaunchCooperativeKernel((const void*)fwd_kernel, dim3(grid), dim3(512), args, LDS_BYTES, stream);
    if (e != hipSuccess) fprintf(stderr, "cooperative launch failed: %s (grid %d)\n", hipGetErrorString(e), grid);
#else
    for (int ph = 0; ph < N_PHASES; ++ph) {
        p.ph_lo = ph; p.ph_hi = ph + 1;
        hipLaunchKernelGGL(fwd_kernel, dim3(grid), dim3(512), LDS_BYTES, stream, p);
    }
#endif
}
```

```cpp
#include <hip/hip_runtime.h>
#include <hip/hip_cooperative_groups.h>
#include <cstdio>
#include <cstdint>
namespace cg = cooperative_groups;

#ifndef PROBE_REP
#define PROBE_REP 0
#endif
#ifndef MK_COOP
#define MK_COOP 2
#endif

constexpr int BATCH = 16, SEQ = 2048, DM = 1024, DEPTH = 2;
constexpr int M = BATCH * SEQ;
constexpr int HD = 64, NH = 6;
constexpr int CW = 256, SBW = 384, RWW = 384, LORA = 32, TAPS = 31;
constexpr int DIN = 3904;
constexpr int NINT = 4096;
constexpr int PC_W = 768, PS_W = 1152, PR_W = 1280, PG_W = 384;
constexpr float RMS_EPS = 1e-6f, LN_EPS = 1e-5f, GN_EPS = 64e-5f;

typedef unsigned short bf16_t;
typedef short bf16x8 __attribute__((ext_vector_type(8)));
typedef float f32x4 __attribute__((ext_vector_type(4)));
typedef unsigned short us4 __attribute__((ext_vector_type(4)));

constexpr size_t MiB = 1u << 20;
constexpr size_t WS_CTL = 0;
constexpr size_t WS_WPW = 512 * 1024;
constexpr size_t WS_WIN = 1 * MiB;
constexpr size_t WS_WOUT = 17 * MiB;
constexpr size_t WS_XB = 21 * MiB;
constexpr size_t WS_MIX = WS_XB;
constexpr size_t WS_PC = 85 * MiB;
constexpr size_t WS_PS = 133 * MiB;
constexpr size_t WS_VT = 205 * MiB;
constexpr size_t WS_Y = WS_PC;
constexpr size_t WS_PR = 229 * MiB;
constexpr size_t WS_PG = 309 * MiB;
constexpr size_t WS_VF = 333 * MiB;
constexpr size_t WS_CH = 381 * MiB;
constexpr size_t CH_SZ = (size_t)3072 * 4096 * 2;
constexpr size_t WS_CH_M = WS_CH, WS_CH_NT = WS_CH + CH_SZ, WS_CH_G = WS_CH + 2 * CH_SZ, WS_CH_Y1T = WS_CH + 3 * CH_SZ, WS_CH_BV = WS_CH + 4 * CH_SZ;
constexpr size_t WS_ZT = WS_PR;
constexpr size_t WS_END = 501 * MiB;

struct Params {
    const float* in[24];
    float* out;
    unsigned char* ws;
    int ph_lo, ph_hi;
};

__device__ __forceinline__ float bf2f(bf16_t v) { return __uint_as_float(((unsigned)v) << 16); }
typedef float f32x2_t __attribute__((ext_vector_type(2)));
typedef __bf16 bf16x2_t __attribute__((ext_vector_type(2)));
__device__ __forceinline__ unsigned pk2(float lo, float hi) { f32x2_t v = {lo, hi}; bf16x2_t b = __builtin_convertvector(v, bf16x2_t); return __builtin_bit_cast(unsigned, b); }
__device__ __forceinline__ bf16_t f2bf(float f) { return (bf16_t)(pk2(f, f) & 0xffffu); }
__device__ __forceinline__ float wave_sum(float v) {
#pragma unroll
    for (int o = 1; o < 64; o <<= 1) v += __shfl_xor(v, o);
    return v;
}
__device__ __forceinline__ float sigmoidf_(float x) { return 1.0f / (1.0f + __expf(-x)); }
__device__ __forceinline__ float siluf_(float x) { return x / (1.0f + __expf(-x)); }
__device__ __forceinline__ int tid_() { int t = threadIdx.x; asm volatile("" : "+v"(t)); return t; }
__device__ __forceinline__ int opaque_zero() { int z = 0; asm volatile("" : "+v"(z)); return z; }

__device__ __forceinline__ int orig_col(int n) { return n < 3520 ? n : (n < 3584 ? -1 : (n < 3968 ? n - 64 : -1)); }

__device__ void transpose_tile(const float* W, int ldw, int ncol_src, const float* gain, bf16_t* WT, int K, int n0, int k0, bool permute, float* tile  , bool skip_fold_rows = false) {
    const int tid = tid_();
#pragma unroll
    for (int i = 0; i < 8; ++i) {
        const int kl = (tid >> 6) + 8 * i, nl = tid & 63;
        const int n = n0 + nl, k = k0 + kl;
        const int oc = permute ? orig_col(n) : n;
        float v = 0.f;
        if (oc >= 0 && oc < ncol_src) v = W[(size_t)k * ldw + oc] * (gain ? gain[k] : 1.0f);
        if (permute && n >= 768 && n < 1152) v *= 0.125f * 1.4426950408889634f;
        tile[kl * 65 + nl] = v;
    }
    __syncthreads();
#pragma unroll
    for (int i = 0; i < 8; ++i) {
        const int nl = (tid >> 6) + 8 * i, kl = tid & 63;
        if (!(skip_fold_rows && n0 + nl >= 3520 && n0 + nl < 3584)) WT[(size_t)(n0 + nl) * K + k0 + kl] = f2bf(tile[kl * 65 + nl]);
    }
    __syncthreads();
}
__device__ void fold_v1_rows(const Params& p, int l, bf16_t* WinT_l, float* scr  , int worker, int nworkers) {
    const int tid = tid_(), o = tid & 63, kl = (tid >> 6) & 3, half = tid >> 8;
    const float* W = p.in[3] + (size_t)l * DM * DIN; const float* gain = p.in[1] + l * DM; const float* v1 = p.in[22] + (size_t)(l - 1) * RWW * LORA; const float* muv = p.in[11] + l * 1216 + 768;
    for (int k4 = worker * 4; k4 < DM; k4 += nworkers * 4) {
        const int k = k4 + kl; const float* wr = W + (size_t)k * DIN + 3072 + half * 192; const float* mv = muv + half * 192; const float* vr = v1 + (size_t)(half * 192) * LORA + (o & 31);
        float a = 0.f;
#pragma unroll 4
        for (int c = 0; c < 192; ++c) { const float m = mv[c]; a += wr[c] * (o >= 32 ? m : 1.0f - m) * vr[c * LORA]; }
        scr[half * 256 + kl * 64 + o] = a;
        __syncthreads();
        if (half == 0) WinT_l[(size_t)(3520 + o) * DM + k] = f2bf((scr[kl * 64 + o] + scr[256 + kl * 64 + o]) * gain[k]);
        __syncthreads();
    }
}
__device__ void prep_weights(const Params& p, int l, unsigned char* lds, int worker, int nworkers) {
    float* tile = (float*)lds;
    bf16_t* WinT = (bf16_t*)(p.ws + WS_WIN) + (size_t)l * NINT * DM; bf16_t* WoutT = (bf16_t*)(p.ws + WS_WOUT) + (size_t)l * DM * DM; bf16_t* WpwT = (bf16_t*)(p.ws + WS_WPW) + (size_t)l * CW * CW;
    const int nt_in = (NINT / 64) * (DM / 64), nt_out = (DM / 64) * (DM / 64), nt_pw = (CW / 64) * (CW / 64);
    for (int j = worker; j < nt_in + nt_out + nt_pw; j += nworkers) {
        if (j < nt_in) transpose_tile(p.in[3] + (size_t)l * DM * DIN, DIN, DIN, p.in[1] + l * DM, WinT, DM, (j / (DM / 64)) * 64, (j % (DM / 64)) * 64, true, tile, l > 0);
        else if (j < nt_in + nt_out) { const int r = j - nt_in; transpose_tile(p.in[4] + (size_t)l * DM * DM, DM, DM, nullptr, WoutT, DM, (r / (DM / 64)) * 64, (r % (DM / 64)) * 64, false, tile); }
        else { const int r = j - nt_in - nt_out; transpose_tile(p.in[9] + (size_t)l * CW * CW, CW, CW, nullptr, WpwT, CW, (r >> 2) * 64, (r & 3) * 64, false, tile); }
    }
    if (l > 0) fold_v1_rows(p, l, WinT, tile, worker, nworkers);
}

__device__ void rows_to_xb(const float* X, bf16_t* XB) {
    const int tid = tid_(), lane = tid & 63, wave = tid >> 6;
    for (int row = blockIdx.x * 8 + wave; row < M; row += gridDim.x * 8) {
        const float* xr = X + (size_t)row * DM;
        f32x4 v[4]; float ss = 0.f;
#pragma unroll
        for (int i = 0; i < 4; ++i) { v[i] = *(const f32x4*)(xr + i * 256 + lane * 4); ss += v[i][0] * v[i][0] + v[i][1] * v[i][1] + v[i][2] * v[i][2] + v[i][3] * v[i][3]; }
        ss = wave_sum(ss);
        const float rstd = rsqrtf(ss * (1.0f / DM) + RMS_EPS);
#pragma unroll
        for (int i = 0; i < 4; ++i) { uint2 w; w.x = pk2(v[i][0] * rstd, v[i][1] * rstd); w.y = pk2(v[i][2] * rstd, v[i][3] * rstd); *(uint2*)(XB + (size_t)row * DM + i * 256 + lane * 4) = w; }
    }
}

__device__ __forceinline__ bool defer_layer1_weights() { return gridDim.x >= BATCH * NH + 32; }
__device__ void phase_prologue(const Params& p, unsigned char* lds) {
    prep_weights(p, 0, lds, blockIdx.x, gridDim.x);
    if (!defer_layer1_weights()) for (int l = 1; l < DEPTH; ++l) prep_weights(p, l, lds, blockIdx.x, gridDim.x);
    rows_to_xb(p.in[0], (bf16_t*)(p.ws + WS_XB));
}

namespace pg8 {
#define PG8_LAS __attribute__((address_space(3)))
typedef unsigned short bf16_t;
typedef short bf16x8 __attribute__((ext_vector_type(8)));
typedef float f32x4 __attribute__((ext_vector_type(4)));
typedef unsigned u32x4 __attribute__((ext_vector_type(4)));
constexpr int BM = 256, BK = 64, HALF = 128, HTB = HALF * BK * 2  , STAGE_BYTES = 8 * HTB, NXCD = 8, WGM = 8;

__host__ __device__ __forceinline__ int lds_byte(int r, int c) { const int st = (r >> 4) * 2 + (c >> 5), rr = r & 15, cc = c & 31, ob = rr * 64 + cc * 2; return st * 1024 + (ob ^ (((ob >> 9) & 1) << 5)); }
__host__ __device__ __forceinline__ void stage_rc(int b, int& R, int& C) { const int st = b / 1024, sb = b % 1024, swz = sb ^ (((sb >> 9) & 1) << 5); R = (st >> 1) * 16 + swz / 64; C = (st & 1) * 32 + (swz % 64) / 2; }
__host__ __device__ __forceinline__ int perm32(int rho) { const int n = rho >> 4, i = rho & 15; return 8 * (i >> 2) + 4 * n + (i & 3); }

struct Unit { int pm, pn; };
struct Gemm { const bf16_t* A; const bf16_t* Bt; int M, N, K; };

struct StaticOrder {
    int nM, nN, nwg, G, c;
    __host__ __device__ void init(int M, int N, int G_, int c_) { nM = M / BM; nN = N / BM; nwg = nM * nN; G = G_; c = c_; }
    __host__ __device__ bool next(int i, Unit& u) const {
        const long L = (long)i * G + c; if (L >= nwg) return false;
        int wgid = (int)L; { const int q = nwg / NXCD, r = nwg % NXCD, xcd = wgid % NXCD, off = wgid / NXCD; wgid = (xcd < r ? xcd * (q + 1) : r * (q + 1) + (xcd - r) * q) + off; }
        const int nig = WGM * nN, gid = wgid / nig, fm = gid * WGM, gsz = (nM - fm) < WGM ? (nM - fm) : WGM;
        u.pm = fm + ((wgid % nig) % gsz); u.pn = (wgid % nig) / gsz; return true;
    }
    __device__ __forceinline__ void a_ready(const Unit&) const {}
    __device__ __forceinline__ void done(const Unit&) const {}
};


__device__ __forceinline__ unsigned cvt_pk_bf16(float lo, float hi) { unsigned r; asm volatile("v_cvt_pk_bf16_f32 %0, %1, %2" : "=v"(r) : "v"(lo), "v"(hi)); return r; }

template <class Epi, class Sched, bool ALIGN_EPI = false, bool SP2 = false>
__device__ __forceinline__ void gemm_phase(PG8_LAS unsigned char* lds, const Gemm g, const Sched& S, const Epi& E) {
    const int tid = tid_(), wid = __builtin_amdgcn_readfirstlane(tid >> 6), lane = tid & 63, wr = wid >> 2, wc = wid & 3, fr = lane & 15, fq = lane >> 4;
    const int K = g.K, nt = K / BK;
    unsigned voffA[2], voffB[2];
#pragma unroll
    for (int i = 0; i < 2; ++i) { int R, C; stage_rc(tid * 16 + i * 8192, R, C); const int Rb = Epi::PERM ? ((R & ~31) + perm32(R & 31)) : R;
        voffA[i] = (unsigned)(R * K + C) * 2u; voffB[i] = (unsigned)(Rb * K + C) * 2u; }
    const size_t kstep = (size_t)(BK * 2);
    const size_t hstep = (size_t)HALF * K * 2;
    const size_t tstep = 2 * hstep;
    const unsigned ldsw = (unsigned)wid * 1024u;
    const int aoff = lds_byte(wr * 64 + fr, fq * 8), boff = lds_byte(wc * 32 + fr, fq * 8);
#define PG8_SA(b, h) (((b) * 2 + (h)) * HTB)
#define PG8_SB(b, h) ((4 + (b) * 2 + (h)) * HTB)
#define PG8_STAGE(bufoff, gbase, voff) do { _Pragma("unroll") for (int _i = 0; _i < 2; ++_i) \
        __builtin_amdgcn_global_load_lds((const unsigned*)((const char*)(gbase) + (voff)[_i]), (PG8_LAS unsigned*)(lds + (bufoff) + ldsw + _i * 8192), 16, 0, 0); } while (0)
#define PG8_LDA(dst, b, h) do { _Pragma("unroll") for (int m = 0; m < 4; ++m) _Pragma("unroll") for (int k = 0; k < 2; ++k) dst[m][k] = *(const PG8_LAS bf16x8*)(lds + PG8_SA(b, h) + aoff + m * 2048 + k * 1024); } while (0)
#define PG8_LDB(dst, b, h) do { _Pragma("unroll") for (int n = 0; n < 2; ++n) _Pragma("unroll") for (int k = 0; k < 2; ++k) dst[n][k] = *(const PG8_LAS bf16x8*)(lds + PG8_SB(b, h) + boff + n * 2048 + k * 1024); } while (0)
#define PG8_MMA(ai, bj, At, Bt) do { __builtin_amdgcn_s_setprio(1); _Pragma("unroll") for (int m = 0; m < 4; ++m) _Pragma("unroll") for (int n = 0; n < 2; ++n) _Pragma("unroll") for (int k = 0; k < 2; ++k) \
        acc[ai][bj][m][n] = __builtin_amdgcn_mfma_f32_16x16x32_bf16(Bt[n][k], At[m][k], acc[ai][bj][m][n], 0, 0, 0); __builtin_amdgcn_s_setprio(0); } while (0)
#define PG8_WAIT_V(n) asm volatile("s_waitcnt vmcnt(" #n ")" ::: "memory")
#define PG8_WAIT_L(n) asm volatile("s_waitcnt lgkmcnt(" #n ")" ::: "memory")
#define PG8_BAR __builtin_amdgcn_s_barrier()
#define PG8_SCHED __builtin_amdgcn_sched_barrier(0)
    Unit cur, nxt; int ui = 0;
    if (!S.next(0, cur)) return;
    f32x4 acc[2][2][4][2];
#pragma unroll
    for (int a = 0; a < 2; ++a)
#pragma unroll
        for (int b = 0; b < 2; ++b)
#pragma unroll
            for (int m = 0; m < 4; ++m)
#pragma unroll
                for (int n = 0; n < 2; ++n) acc[a][b][m][n] = (f32x4){0.f, 0.f, 0.f, 0.f};
    bf16x8 At[4][2], B0[2][2], B1[2][2];
    const char* cA = (const char*)g.A + (size_t)cur.pm * tstep; const char* cB = (const char*)g.Bt + (size_t)cur.pn * tstep;
    S.a_ready(cur);
    if constexpr (SP2) {
        PG8_STAGE(PG8_SB(0, 0), cB, voffB); PG8_STAGE(PG8_SB(0, 1), cB + hstep, voffB); PG8_STAGE(PG8_SA(0, 0), cA, voffA); PG8_STAGE(PG8_SA(0, 1), cA + hstep, voffA);
        if (wr == 1) PG8_BAR;
        PG8_WAIT_V(2); PG8_BAR;
        PG8_STAGE(PG8_SB(1, 0), cB + kstep, voffB); PG8_STAGE(PG8_SA(1, 0), cA + kstep, voffA); PG8_STAGE(PG8_SB(1, 1), cB + hstep + kstep, voffB);
        PG8_WAIT_V(6); PG8_BAR;
    } else {
        PG8_STAGE(PG8_SB(0, 0), cB, voffB); PG8_STAGE(PG8_SA(0, 0), cA, voffA); PG8_STAGE(PG8_SB(0, 1), cB + hstep, voffB); PG8_STAGE(PG8_SA(0, 1), cA + hstep, voffA);
        if (wr == 1) PG8_BAR;
        PG8_WAIT_V(4); PG8_BAR;
        PG8_STAGE(PG8_SB(1, 0), cB + kstep, voffB); PG8_STAGE(PG8_SA(1, 0), cA + kstep, voffA); PG8_STAGE(PG8_SB(1, 1), cB + hstep + kstep, voffB);
        PG8_WAIT_V(6); PG8_BAR;
    }
    for (;;) {
        const bool has_next = S.next(ui + 1, nxt);
        const char* nA = has_next ? (const char*)g.A + (size_t)nxt.pm * tstep : cA; const char* nB = has_next ? (const char*)g.Bt + (size_t)nxt.pn * tstep : cB;
        for (int t = 0; t < nt; t += 2) {
            const bool last = (t == nt - 2);
            const char* a1 = cA + (size_t)(t + 1) * kstep;
            const char* a2 = last ? nA : cA + (size_t)(t + 2) * kstep; const char* b2 = last ? nB : cB + (size_t)(t + 2) * kstep;
            const char* a3 = a2 + kstep; const char* b3 = b2 + kstep;
            if (last && has_next) S.a_ready(nxt);
            if constexpr (SP2) {
            PG8_LDB(B0, 0, 0); PG8_LDB(B1, 0, 1); PG8_SCHED; PG8_LDA(At, 0, 0); PG8_STAGE(PG8_SA(1, 1), a1 + hstep, voffA);
            PG8_WAIT_V(8); PG8_WAIT_L(0); PG8_BAR; PG8_MMA(0, 0, At, B0); PG8_MMA(0, 1, At, B1); PG8_BAR; PG8_SCHED;
            PG8_LDA(At, 0, 1); PG8_STAGE(PG8_SB(0, 0), b2, voffB); PG8_STAGE(PG8_SB(0, 1), b2 + hstep, voffB); PG8_STAGE(PG8_SA(0, 0), a2, voffA);
            PG8_WAIT_V(8); PG8_WAIT_L(0); PG8_BAR; PG8_MMA(1, 0, At, B0); PG8_MMA(1, 1, At, B1); PG8_BAR; PG8_SCHED;
            PG8_LDB(B0, 1, 0); PG8_LDB(B1, 1, 1); PG8_SCHED; PG8_LDA(At, 1, 0); PG8_STAGE(PG8_SA(0, 1), a2 + hstep, voffA);
            PG8_WAIT_V(8); PG8_WAIT_L(0); PG8_BAR; PG8_MMA(0, 0, At, B0); PG8_MMA(0, 1, At, B1); PG8_BAR; PG8_SCHED;
            PG8_LDA(At, 1, 1); PG8_STAGE(PG8_SB(1, 0), b3, voffB); PG8_STAGE(PG8_SB(1, 1), b3 + hstep, voffB); PG8_STAGE(PG8_SA(1, 0), a3, voffA);
            PG8_WAIT_V(8); PG8_WAIT_L(0); PG8_BAR; PG8_MMA(1, 0, At, B0); PG8_MMA(1, 1, At, B1); PG8_BAR; PG8_SCHED;
            } else {
            PG8_LDB(B0, 0, 0); PG8_SCHED; PG8_LDA(At, 0, 0); PG8_STAGE(PG8_SA(1, 1), a1 + hstep, voffA);
            PG8_WAIT_L(8); PG8_BAR; PG8_WAIT_L(0); PG8_MMA(0, 0, At, B0); PG8_BAR; PG8_SCHED;
            PG8_LDB(B1, 0, 1); PG8_STAGE(PG8_SB(0, 0), b2, voffB);
            PG8_BAR; PG8_WAIT_L(0); PG8_MMA(0, 1, At, B1); PG8_BAR;
            PG8_LDA(At, 0, 1); PG8_STAGE(PG8_SA(0, 0), a2, voffA);
            PG8_BAR; PG8_WAIT_L(0); PG8_MMA(1, 0, At, B0); PG8_BAR; PG8_SCHED;
            PG8_STAGE(PG8_SB(0, 1), b2 + hstep, voffB);
            PG8_WAIT_V(6); PG8_BAR; PG8_MMA(1, 1, At, B1); PG8_BAR;
            PG8_LDB(B0, 1, 0); PG8_SCHED; PG8_LDA(At, 1, 0); PG8_STAGE(PG8_SA(0, 1), a2 + hstep, voffA);
            PG8_WAIT_L(8); PG8_BAR; PG8_WAIT_L(0); PG8_MMA(0, 0, At, B0); PG8_BAR; PG8_SCHED;
            PG8_LDB(B1, 1, 1); PG8_STAGE(PG8_SB(1, 0), b3, voffB);
            PG8_BAR; PG8_WAIT_L(0); PG8_MMA(0, 1, At, B1); PG8_BAR;
            PG8_LDA(At, 1, 1); PG8_STAGE(PG8_SA(1, 0), a3, voffA);
            PG8_BAR; PG8_WAIT_L(0); PG8_MMA(1, 0, At, B0); PG8_BAR; PG8_SCHED;
            PG8_STAGE(PG8_SB(1, 1), b3 + hstep, voffB);
            PG8_WAIT_V(6); PG8_BAR; PG8_MMA(1, 1, At, B1); PG8_BAR;
            }
        }
        if constexpr (ALIGN_EPI) { if (wr == 0) PG8_BAR; }
        if constexpr (!Epi::AFTER_DRAIN) { E(acc, cur, wr, wc, fr, fq); S.done(cur); }
        if (!has_next) break;
#pragma unroll
        for (int a = 0; a < 2; ++a)
#pragma unroll
            for (int b = 0; b < 2; ++b)
#pragma unroll
                for (int m = 0; m < 4; ++m)
#pragma unroll
                    for (int n = 0; n < 2; ++n) acc[a][b][m][n] = (f32x4){0.f, 0.f, 0.f, 0.f};
        cur = nxt; cA = nA; cB = nB; ++ui;
        if constexpr (ALIGN_EPI) { if (wr == 1) PG8_BAR; }
    }
    PG8_WAIT_V(0);
    if constexpr (!ALIGN_EPI) { if (wr == 0) PG8_BAR; }
    PG8_BAR;
    if constexpr (Epi::AFTER_DRAIN) { E.fused(acc, cur, wr, wc, fr, fq, lds, wid, lane); S.done(cur); }
#undef PG8_SA
#undef PG8_SB
#undef PG8_STAGE
#undef PG8_LDA
#undef PG8_LDB
#undef PG8_MMA
#undef PG8_WAIT_V
#undef PG8_WAIT_L
#undef PG8_BAR
#undef PG8_SCHED
}
}

struct EpiInProjP {
    static constexpr bool PERM = true, AFTER_DRAIN = false;
    bf16_t *PC, *PS, *PR, *PG, *VT;
    __device__ __forceinline__ void operator()(const pg8::f32x4 (&acc)[2][2][4][2], const pg8::Unit& u, int wr, int wc, int fr, int fq) const {
        const int row0 = u.pm * 256 + wr * 64 + fr;
#pragma unroll
        for (int bj = 0; bj < 2; ++bj) {
            const int blk = 2 * u.pn + bj; bf16_t* base; int ld, c0;
            if (blk >= 12 && blk < 15) {
                const int vc = 128 * (blk - 12) + wc * 32 + 8 * fq;
#pragma unroll
                for (int ai = 0; ai < 2; ++ai)
#pragma unroll
                    for (int m = 0; m < 4; ++m) {
                        const int row = row0 + ai * 128 + m * 16, b = row >> 11, t = row & 2047;
#pragma unroll
                        for (int n = 0; n < 2; ++n)
#pragma unroll
                            for (int e = 0; e < 4; ++e) { const int col = vc + 4 * n + e, hh = col >> 6, d = col & 63;
                                VT[((size_t)(b * NH + hh) * HD + d) * SEQ + t] = f2bf(acc[ai][bj][m][n][e]); }
                    }
                continue;
            }
            if (blk < 6) { base = PC; ld = PC_W; c0 = 128 * blk; }
            else if (blk < 12) { base = PS; ld = PS_W; c0 = 128 * (blk - 6); }
            else if (blk < 18) { base = PS; ld = PS_W; c0 = 768 + 128 * (blk - 15); }
            else if (blk < 28) { base = PR; ld = PR_W; c0 = 128 * (blk - 18); }
            else if (blk < 31) { base = PG; ld = PG_W; c0 = 128 * (blk - 28); }
            else continue;
            const int col = c0 + wc * 32 + 8 * fq;
#pragma unroll
            for (int ai = 0; ai < 2; ++ai)
#pragma unroll
                for (int m = 0; m < 4; ++m) {
                    const pg8::f32x4 v0 = acc[ai][bj][m][0], v1 = acc[ai][bj][m][1]; pg8::u32x4 w;
                    w.x = pg8::cvt_pk_bf16(v0[0], v0[1]); w.y = pg8::cvt_pk_bf16(v0[2], v0[3]); w.z = pg8::cvt_pk_bf16(v1[0], v1[1]); w.w = pg8::cvt_pk_bf16(v1[2], v1[3]);
                    *(pg8::u32x4*)(base + (size_t)(row0 + ai * 128 + m * 16) * ld + col) = w;
                }
        }
    }
};
struct EpiOutBf16P {
    static constexpr bool PERM = true, AFTER_DRAIN = false;
    bf16_t* Y; int ld;
    __device__ __forceinline__ void operator()(const pg8::f32x4 (&acc)[2][2][4][2], const pg8::Unit& u, int wr, int wc, int fr, int fq) const {
        const int row0 = u.pm * 256 + wr * 64 + fr, col0 = u.pn * 256 + wc * 32 + 8 * fq;
#pragma unroll
        for (int ai = 0; ai < 2; ++ai)
#pragma unroll
            for (int m = 0; m < 4; ++m)
#pragma unroll
                for (int bj = 0; bj < 2; ++bj) {
                    const pg8::f32x4 v0 = acc[ai][bj][m][0], v1 = acc[ai][bj][m][1]; pg8::u32x4 w;
                    w.x = pg8::cvt_pk_bf16(v0[0], v0[1]); w.y = pg8::cvt_pk_bf16(v0[2], v0[3]); w.z = pg8::cvt_pk_bf16(v1[0], v1[1]); w.w = pg8::cvt_pk_bf16(v1[2], v1[3]);
                    *(pg8::u32x4*)(Y + (size_t)(row0 + ai * 128 + m * 16) * ld + col0 + bj * 128) = w;
                }
    }
};

__device__ void phase_rowpass(const float* Xin, const bf16_t* Y, const float* gpost, float* Xout, bf16_t* XB) {
    const int tid = tid_(), lane = tid & 63, wave = tid >> 6;
    for (int row = blockIdx.x * 8 + wave; row < M; row += gridDim.x * 8) {
        f32x4 y[4], x[4]; float ss = 0.f;
#pragma unroll
        for (int i = 0; i < 4; ++i) { const uint2 yw = *(const uint2*)(Y + (size_t)row * DM + i * 256 + lane * 4);
            y[i] = (f32x4){bf2f((bf16_t)(yw.x & 0xffff)), bf2f((bf16_t)(yw.x >> 16)), bf2f((bf16_t)(yw.y & 0xffff)), bf2f((bf16_t)(yw.y >> 16))};
            x[i] = *(const f32x4*)(Xin + (size_t)row * DM + i * 256 + lane * 4);
            ss += y[i][0] * y[i][0] + y[i][1] * y[i][1] + y[i][2] * y[i][2] + y[i][3] * y[i][3]; }
        ss = wave_sum(ss);
        const float rstd = rsqrtf(ss * (1.0f / DM) + RMS_EPS);
        float s2 = 0.f;
#pragma unroll
        for (int i = 0; i < 4; ++i) { const f32x4 g = *(const f32x4*)(gpost + i * 256 + lane * 4);
            x[i] = x[i] + y[i] * rstd * g; s2 += x[i][0] * x[i][0] + x[i][1] * x[i][1] + x[i][2] * x[i][2] + x[i][3] * x[i][3];
            *(f32x4*)(Xout + (size_t)row * DM + i * 256 + lane * 4) = x[i]; }
        if (XB) {
            s2 = wave_sum(s2);
            const float r2 = rsqrtf(s2 * (1.0f / DM) + RMS_EPS);
#pragma unroll
            for (int i = 0; i < 4; ++i) { uint2 w; w.x = pk2(x[i][0] * r2, x[i][1] * r2); w.y = pk2(x[i][2] * r2, x[i][3] * r2); *(uint2*)(XB + (size_t)row * DM + i * 256 + lane * 4) = w; }
        }
    }
}

__device__ void conv_job(const Params& p, int l, int job, float* lds) {
    const int tid = tid_(), lane = tid & 63, wave = tid >> 6;
    const int b = job / (SEQ / 32), t0 = (job % (SEQ / 32)) * 32;
    const bf16_t* PC = (const bf16_t*)(p.ws + WS_PC); bf16_t* MIX = (bf16_t*)(p.ws + WS_MIX);
    const float* dw = p.in[5] + l * TAPS * CW; const float* dwb = p.in[6] + l * CW; const float* lng = p.in[7] + l * CW; const float* lnb = p.in[8] + l * CW;
    const float* pw = p.in[9] + (size_t)l * CW * CW; const float* pwb = p.in[10] + l * CW;
    float* u = lds;
    float* cv = lds + 62 * 256;
    for (int idx = tid; idx < 62 * 256; idx += 512) {
        const int r = idx >> 8, c = idx & 255, t = t0 - 30 + r;
        float v = 0.f;
        if (t >= 0) { const bf16_t* pr = PC + (size_t)(b * SEQ + t) * PC_W; v = bf2f(pr[c]) * sigmoidf_(bf2f(pr[256 + c])); }
        u[idx] = v;
    }
    __syncthreads();
    for (int idx = tid; idx < 32 * 256; idx += 512) {
        const int tt = idx >> 8, c = idx & 255;
        float a = dwb[c];
#pragma unroll 4
        for (int j = 0; j < TAPS; ++j) a += dw[j * CW + c] * u[(tt + j) * 256 + c];
        cv[idx] = a;
    }
    __syncthreads();
    for (int q = 0; q < 4; ++q) {
        const int tt = wave * 4 + q; float x[4], s = 0.f;
#pragma unroll
        for (int i = 0; i < 4; ++i) { x[i] = cv[tt * 256 + lane + 64 * i]; s += x[i]; }
        const float mean = wave_sum(s) * (1.0f / CW); float vs = 0.f;
#pragma unroll
        for (int i = 0; i < 4; ++i) { const float d = x[i] - mean; vs += d * d; }
        const float rstd = rsqrtf(wave_sum(vs) * (1.0f / CW) + LN_EPS);
#pragma unroll
        for (int i = 0; i < 4; ++i) { const int c = lane + 64 * i; cv[tt * 256 + c] = siluf_((x[i] - mean) * rstd * lng[c] + lnb[c]); }
    }
    __syncthreads();
    {
        const int n = tid & 255, half = tid >> 8;
        float acc[16];
#pragma unroll
        for (int i = 0; i < 16; ++i) acc[i] = pwb[n];
#pragma unroll 2
        for (int k = 0; k < CW; ++k) {
            const float w = pw[(size_t)k * CW + n];
#pragma unroll
            for (int i = 0; i < 16; ++i) acc[i] += cv[(half * 16 + i) * 256 + k] * w;
        }
#pragma unroll
        for (int i = 0; i < 16; ++i) { const size_t row = (size_t)b * SEQ + t0 + half * 16 + i;
            const float g = bf2f(PC[row * PC_W + 512 + n]);
            MIX[row * DM + n] = f2bf(acc[i] * siluf_(g)); }
    }
    __syncthreads();
}

constexpr int CV_AS = 264;
__device__ void conv_job64(const Params& p, int l, int job, unsigned char* lds) {
    const int tid = tid_(), lane = tid & 63, wave = tid >> 6, fr = lane & 15, fq = lane >> 4;
    const int b = job >> 5, t0 = (job & 31) * 64;
    const bf16_t* PC = (const bf16_t*)(p.ws + WS_PC); bf16_t* MIX = (bf16_t*)(p.ws + WS_MIX);
    const float* dw = p.in[5] + l * TAPS * CW; const float* dwb = p.in[6] + l * CW; const float* lng = p.in[7] + l * CW; const float* lnb = p.in[8] + l * CW;
    const bf16_t* pwT = (const bf16_t*)(p.ws + WS_WPW) + (size_t)l * CW * CW; const float* pwb = p.in[10] + l * CW;
    float* u = (float*)lds;
    bf16_t* act = (bf16_t*)(lds + 94 * 256 * 4);
    for (int idx = tid; idx < 94 * 32; idx += 512) {
        const int r = idx >> 5, c8 = (idx & 31) * 8, t = t0 - 30 + r;
        float v[8];
        if (t >= 0) { const bf16_t* pr = PC + ((size_t)b * SEQ + t) * PC_W + c8; const bf16x8 a = *(const bf16x8*)pr, g = *(const bf16x8*)(pr + 256);
#pragma unroll
            for (int e = 0; e < 8; ++e) v[e] = bf2f((bf16_t)a[e]) * __builtin_amdgcn_rcpf(1.0f + __builtin_amdgcn_exp2f(-1.4426950408889634f * bf2f((bf16_t)g[e]))); }
        else {
#pragma unroll
            for (int e = 0; e < 8; ++e) v[e] = 0.f; }
        *(f32x4*)(u + r * 256 + c8) = (f32x4){v[0], v[1], v[2], v[3]}; *(f32x4*)(u + r * 256 + c8 + 4) = (f32x4){v[4], v[5], v[6], v[7]};
    }
    __syncthreads();
    const int c = tid & 255, half = tid >> 8;
    float acc[32];
    {
        float w[TAPS];
#pragma unroll
        for (int j = 0; j < TAPS; ++j) w[j] = dw[j * CW + c];
        const float bias = dwb[c];
#pragma unroll
        for (int i = 0; i < 32; ++i) acc[i] = bias;
        const float* up = u + (half * 32) * 256 + c;
#pragma unroll
        for (int rr = 0; rr < 62; ++rr) {
            const float uv = up[rr * 256];
#pragma unroll
            for (int i = 0; i < 32; ++i) { if (rr - i >= 0 && rr - i < TAPS) acc[i] += w[rr - i] * uv; }
        }
    }
    __syncthreads();
    float* cv = u;
#pragma unroll
    for (int i = 0; i < 32; ++i) cv[(half * 32 + i) * 256 + c] = acc[i];
    __syncthreads();
#pragma unroll 2
    for (int q = 0; q < 8; ++q) {
        const int tt = wave * 8 + q; const f32x4 x = *(const f32x4*)(cv + tt * 256 + lane * 4);
        const float mean = wave_sum(x[0] + x[1] + x[2] + x[3]) * (1.0f / CW);
        const f32x4 d = x - mean;
        const float rstd = rsqrtf(wave_sum(d[0] * d[0] + d[1] * d[1] + d[2] * d[2] + d[3] * d[3]) * (1.0f / CW) + LN_EPS);
        const f32x4 g = *(const f32x4*)(lng + lane * 4), bb = *(const f32x4*)(lnb + lane * 4);
        float y[4];
#pragma unroll
        for (int e = 0; e < 4; ++e) { const float v = d[e] * rstd * g[e] + bb[e]; y[e] = v * __builtin_amdgcn_rcpf(1.0f + __builtin_amdgcn_exp2f(-1.4426950408889634f * v)); }
        uint2 w; w.x = pk2(y[0], y[1]); w.y = pk2(y[2], y[3]); *(uint2*)(act + tt * CV_AS + lane * 4) = w;
    }
    __syncthreads();
    {
        f32x4 o[2][4];
#pragma unroll
        for (int i = 0; i < 2; ++i)
#pragma unroll
            for (int j = 0; j < 4; ++j) o[i][j] = (f32x4){0.f, 0.f, 0.f, 0.f};
#pragma unroll 2
        for (int kk = 0; kk < 8; ++kk) {
            bf16x8 a[2], bq[4];
#pragma unroll
            for (int i = 0; i < 2; ++i) a[i] = *(const bf16x8*)(pwT + (size_t)(wave * 32 + i * 16 + fr) * CW + kk * 32 + fq * 8);
#pragma unroll
            for (int j = 0; j < 4; ++j) bq[j] = *(const bf16x8*)(act + (j * 16 + fr) * CV_AS + kk * 32 + fq * 8);
#pragma unroll
            for (int i = 0; i < 2; ++i)
#pragma unroll
                for (int j = 0; j < 4; ++j) o[i][j] = __builtin_amdgcn_mfma_f32_16x16x32_bf16(a[i], bq[j], o[i][j], 0, 0, 0);
        }
#pragma unroll
        for (int i = 0; i < 2; ++i) {
            const int n0 = wave * 32 + i * 16 + fq * 4; const f32x4 bias = *(const f32x4*)(pwb + n0);
#pragma unroll
            for (int j = 0; j < 4; ++j) {
                const size_t row = (size_t)b * SEQ + t0 + j * 16 + fr;
                const uint2 gw = *(const uint2*)(PC + row * PC_W + 512 + n0);
                const float g0 = bf2f((bf16_t)(gw.x & 0xffff)), g1 = bf2f((bf16_t)(gw.x >> 16)), g2 = bf2f((bf16_t)(gw.y & 0xffff)), g3 = bf2f((bf16_t)(gw.y >> 16));
                const f32x4 v = o[i][j] + bias;
                uint2 w; w.x = pk2(v[0] * siluf_(g0), v[1] * siluf_(g1)); w.y = pk2(v[2] * siluf_(g2), v[3] * siluf_(g3));
                *(uint2*)(MIX + row * DM + n0) = w;
            }
        }
    }
    __syncthreads();
}

__device__ void attn_job(const Params& p, int job) {
    const int tid = tid_(), lane = tid & 63, wave = tid >> 6;
    const int bh = job >> 2, qb = job & 3, b = bh / NH, h = bh % NH;
    const bf16_t* PS = (const bf16_t*)(p.ws + WS_PS); bf16_t* MIX = (bf16_t*)(p.ws + WS_MIX);
    const int tw = qb * 512 + wave * 64, t = tw + lane;
    const size_t row = (size_t)b * SEQ + t;
    const float qs = 1.0f;
    const bf16_t* VT = (const bf16_t*)(p.ws + WS_VT) + (size_t)bh * HD * SEQ;
    float q[64], o[64];
    {
        const bf16_t* qp = PS + row * PS_W + h * HD;
#pragma unroll
        for (int i = 0; i < 8; ++i) { const bf16x8 v = *(const bf16x8*)(qp + i * 8);
#pragma unroll
            for (int j = 0; j < 8; ++j) { q[i * 8 + j] = bf2f((bf16_t)v[j]) * qs; o[i * 8 + j] = 0.f; } }
    }
    float rp = 1.0f;
    const int z = opaque_zero();
    for (int s = tw + 62; s >= 0; --s) {
        const bf16_t* kp = PS + ((size_t)b * SEQ + s) * PS_W + 384 + h * HD + z;
        float dot = 0.f;
#pragma unroll
        for (int i = 0; i < 8; ++i) { const bf16x8 v = *(const bf16x8*)(kp + i * 8);
#pragma unroll
            for (int j = 0; j < 8; ++j) dot += q[i * 8 + j] * bf2f((bf16_t)v[j]); }
        const bool act = s < t;
        const float e = __builtin_amdgcn_exp2f(dot);
        const float keep = __builtin_amdgcn_rcpf(1.0f + e);
        const float pr = act ? (1.0f - keep) * rp : 0.f;
        rp = act ? rp * keep : rp;
#pragma unroll
        for (int d = 0; d < 64; ++d) o[d] += pr * bf2f(VT[(size_t)d * SEQ + s + z]);
        if (__all(rp == 0.0f)) break;
    }
    const bf16_t* gp = PS + row * PS_W + 768 + h * HD;
    bf16_t* op = MIX + row * DM + CW + h * HD;
#pragma unroll
    for (int i = 0; i < 8; ++i) { const bf16x8 g = *(const bf16x8*)(gp + i * 8); uint4 w;
        w.x = pk2(o[i * 8 + 0] * siluf_(bf2f((bf16_t)g[0])), o[i * 8 + 1] * siluf_(bf2f((bf16_t)g[1])));
        w.y = pk2(o[i * 8 + 2] * siluf_(bf2f((bf16_t)g[2])), o[i * 8 + 3] * siluf_(bf2f((bf16_t)g[3])));
        w.z = pk2(o[i * 8 + 4] * siluf_(bf2f((bf16_t)g[4])), o[i * 8 + 5] * siluf_(bf2f((bf16_t)g[5])));
        w.w = pk2(o[i * 8 + 6] * siluf_(bf2f((bf16_t)g[6])), o[i * 8 + 7] * siluf_(bf2f((bf16_t)g[7])));
        *(uint4*)(op + i * 8) = w; }
}

typedef float f32x16 __attribute__((ext_vector_type(16)));
__device__ void attn_mfma_wave(const Params& p, int bh, int qblk) {
    const int tid = tid_(), lane = tid & 63, qi = lane & 31, hf = lane >> 5;
    const int b = bh / NH, h = bh % NH, q0 = qblk * 32;
    const bf16_t* PS = (const bf16_t*)(p.ws + WS_PS); const bf16_t* VT = (const bf16_t*)(p.ws + WS_VT) + (size_t)bh * HD * SEQ; bf16_t* MIX = (bf16_t*)(p.ws + WS_MIX);
    const size_t rowq = (size_t)b * SEQ + q0 + qi;
    bf16x8 Qf[4];
#pragma unroll
    for (int ks = 0; ks < 4; ++ks) Qf[ks] = *(const bf16x8*)(PS + rowq * PS_W + h * HD + ks * 16 + hf * 8);
    const int pi = (qi & 3) + 4 * (qi >> 3) + 16 * ((qi >> 2) & 1);
    const bf16_t* kbase = PS + ((size_t)b * SEQ + pi) * PS_W + SBW + h * HD + hf * 8;
    const bf16_t* vbase = VT + (size_t)qi * SEQ + hf * 16;
    f32x16 O0, O1;
#pragma unroll
    for (int r = 0; r < 16; ++r) { O0[r] = 0.f; O1[r] = 0.f; }
    float rp = 1.0f;
    for (int kt = qblk; kt >= 0; --kt) {
        const int s0 = kt * 32;
        bf16x8 Kf[4], Vf[2][2];
#pragma unroll
        for (int ks = 0; ks < 4; ++ks) Kf[ks] = *(const bf16x8*)(kbase + (size_t)s0 * PS_W + ks * 16);
#pragma unroll
        for (int db = 0; db < 2; ++db)
#pragma unroll
            for (int s = 0; s < 2; ++s) Vf[db][s] = *(const bf16x8*)(vbase + (size_t)db * 32 * SEQ + s0 + s * 8);
        f32x16 S;
#pragma unroll
        for (int r = 0; r < 16; ++r) S[r] = 0.f;
#pragma unroll
        for (int ks = 0; ks < 4; ++ks) S = __builtin_amdgcn_mfma_f32_32x32x16_bf16(Kf[ks], Qf[ks], S, 0, 0, 0);
        float keep[16], beta[16];
        const bool diag = kt == qblk;
        float tot = 1.0f;
#pragma unroll
        for (int r = 0; r < 16; ++r) {
            const float e = __builtin_amdgcn_exp2f(S[r]);
            float k_ = __builtin_amdgcn_rcpf(1.0f + e);
            float b_ = 1.0f - k_;
            if (diag && (hf * 16 + r >= qi)) { k_ = 1.0f; b_ = 0.f; }
            keep[r] = k_; beta[r] = b_; tot *= k_;
        }
        const float toto = __shfl_xor(tot, 32);
        float e = hf ? rp : rp * toto;
        float pw[16];
#pragma unroll
        for (int r = 15; r >= 0; --r) { pw[r] = beta[r] * e; e *= keep[r]; }
        rp = rp * tot * toto;
        bf16x8 Pf[2];
#pragma unroll
        for (int s = 0; s < 2; ++s) {
            union { bf16x8 v; unsigned u[4]; } pk;
#pragma unroll
            for (int j = 0; j < 4; ++j) pk.u[j] = pk2(pw[8 * s + 2 * j], pw[8 * s + 2 * j + 1]);
            Pf[s] = pk.v;
        }
#pragma unroll
        for (int s = 0; s < 2; ++s) { O0 = __builtin_amdgcn_mfma_f32_32x32x16_bf16(Vf[0][s], Pf[s], O0, 0, 0, 0); O1 = __builtin_amdgcn_mfma_f32_32x32x16_bf16(Vf[1][s], Pf[s], O1, 0, 0, 0); }
        if (__ballot(rp != 0.0f) == 0ull) break;
    }
    const bf16_t* gp = PS + rowq * PS_W + 768 + h * HD; bf16_t* op = MIX + rowq * DM + CW + h * HD;
#pragma unroll
    for (int db = 0; db < 2; ++db)
#pragma unroll
        for (int g = 0; g < 4; ++g) {
            const int d0 = db * 32 + g * 8 + hf * 4;
            const uint2 gw = *(const uint2*)(gp + d0);
            const float g0 = bf2f((bf16_t)(gw.x & 0xffff)), g1 = bf2f((bf16_t)(gw.x >> 16)), g2 = bf2f((bf16_t)(gw.y & 0xffff)), g3 = bf2f((bf16_t)(gw.y >> 16));
            const f32x16& O = db ? O1 : O0;
            uint2 w; w.x = pk2(O[4 * g] * siluf_(g0), O[4 * g + 1] * siluf_(g1)); w.y = pk2(O[4 * g + 2] * siluf_(g2), O[4 * g + 3] * siluf_(g3));
            *(uint2*)(op + d0) = w;
        }
}

__device__ void rwkv_job(const Params& p, int l, int job, float* lds) {
    const int tid = tid_(), lane = tid & 63, wave = tid >> 6;
    const int b = job / NH, h = job % NH;
    const bf16_t* PR = (const bf16_t*)(p.ws + WS_PR); const bf16_t* PG = (const bf16_t*)(p.ws + WS_PG);
    float* VF = (float*)(p.ws + WS_VF); bf16_t* MIX = (bf16_t*)(p.ws + WS_MIX);
    const float* mu = p.in[11] + l * 1216; const float* w0 = p.in[12] + l * RWW; const float* w2 = p.in[13] + l * LORA * RWW;
    const float* a0 = p.in[14] + l * RWW; const float* a2 = p.in[15] + l * LORA * RWW; const float* kks = p.in[16] + l * RWW; const float* ka = p.in[17] + l * RWW;
    const float* rk = p.in[18] + l * RWW; const float* gng = p.in[19] + l * RWW; const float* gnb = p.in[20] + l * RWW;
    const float* v0 = p.in[21]; const float* v1 = p.in[22]; const float* v2 = p.in[23];
    float* R = lds; float* W = R + 4096; float* K = W + 4096; float* V = K + 4096; float* A = V + 4096; float* Bm = A + 4096; float* Y = Bm + 4096;
    float* WD = Y + 4096; float* AD = WD + 2048; float* VL = AD + 2048;
    float S[64];
#pragma unroll
    for (int i = 0; i < 64; ++i) S[i] = 0.f;
    for (int c = 0; c < SEQ / 64; ++c) {
        const int t0 = c * 64;
        for (int idx = tid; idx < 64 * 64; idx += 512) {
            const int tt = idx >> 6, i = idx & 63, t = t0 + tt;
            const bf16_t* cur = PR + ((size_t)b * SEQ + t) * PR_W;
            const float xc = bf2f(cur[1152 + i]), xp = t > 0 ? bf2f(cur[1152 + i - PR_W]) : 0.f;
            const float f = xc + (xp - xc) * mu[1152 + i];
            if (i < 32) WD[tt * 32 + i] = tanhf(f); else AD[tt * 32 + i - 32] = f;
        }
        if (l > 0) {
            for (int idx = tid; idx < 64 * 32; idx += 512) {
                const int tt = idx >> 5, i = idx & 31, t = t0 + tt;
                const bf16_t* cur = PR + ((size_t)b * SEQ + t) * PR_W + 768;
                float a = 0.f;
                for (int cc = 0; cc < RWW; ++cc) {
                    const float xc = bf2f(cur[cc]), xp = t > 0 ? bf2f(cur[cc - PR_W]) : 0.f;
                    a += (xc + (xp - xc) * mu[768 + cc]) * v1[cc * LORA + i];
                }
                VL[idx] = a;
            }
        }
        __syncthreads();
        for (int idx = tid; idx < 64 * 64; idx += 512) {
            const int tt = idx >> 6, j = idx & 63, t = t0 + tt, cj = h * HD + j;
            const size_t row = (size_t)b * SEQ + t;
            const bf16_t* cur = PR + row * PR_W;
            const bool hp = t > 0;
            float rc = bf2f(cur[cj]), kc = bf2f(cur[384 + cj]), vc = bf2f(cur[768 + cj]);
            const float rp_ = hp ? bf2f(cur[cj - PR_W]) : 0.f, kp_ = hp ? bf2f(cur[384 + cj - PR_W]) : 0.f, vp_ = hp ? bf2f(cur[768 + cj - PR_W]) : 0.f;
            rc += (rp_ - rc) * mu[cj]; kc += (kp_ - kc) * mu[384 + cj]; vc += (vp_ - vc) * mu[768 + cj];
            float wl = w0[cj], al = a0[cj];
#pragma unroll 8
            for (int i = 0; i < LORA; ++i) { wl += WD[tt * 32 + i] * w2[i * RWW + cj]; al += AD[tt * 32 + i] * a2[i * RWW + cj]; }
            const float sp = fmaxf(-wl, 0.f) + log1pf(__expf(-fabsf(wl)));
            const float decay = __expf(-__expf(-sp - 0.5f));
            const float alr = sigmoidf_(al);
            if (l > 0) {
                float vg = v0[cj];
#pragma unroll 8
                for (int i = 0; i < LORA; ++i) vg += VL[tt * 32 + i] * v2[i * RWW + cj];
                vg = sigmoidf_(vg);
                vc = vc + (VF[row * RWW + cj] - vc) * vg;
            } else VF[row * RWW + cj] = vc;
            R[idx] = rc; W[idx] = decay; V[idx] = vc;
            K[idx] = kc * (1.0f + (alr - 1.0f) * ka[cj]);
            A[idx] = kc * kks[cj];
            Bm[idx] = alr;
        }
        __syncthreads();
        for (int q = 0; q < 8; ++q) {
            const int tt = wave * 8 + q; const float kk = A[tt * 64 + lane];
            const float nrm = sqrtf(wave_sum(kk * kk));
            const float kn = kk / fmaxf(nrm, 1e-12f);
            A[tt * 64 + lane] = -kn; Bm[tt * 64 + lane] = kn * Bm[tt * 64 + lane];
        }
        __syncthreads();
        if (wave == 0) {
            for (int tt = 0; tt < 64; ++tt) {
                const f32x4* a4 = (const f32x4*)(A + tt * 64); const f32x4* w4 = (const f32x4*)(W + tt * 64); const f32x4* b4 = (const f32x4*)(Bm + tt * 64);
                const f32x4* k4 = (const f32x4*)(K + tt * 64); const f32x4* r4 = (const f32x4*)(R + tt * 64);
                float sa = 0.f;
#pragma unroll
                for (int i = 0; i < 16; ++i) { const f32x4 a = a4[i]; sa += S[4 * i] * a[0] + S[4 * i + 1] * a[1] + S[4 * i + 2] * a[2] + S[4 * i + 3] * a[3];
                    if ((i & 7) == 7) asm volatile("" ::: "memory"); }
                const float vv = V[tt * 64 + lane];
                float y = 0.f;
#pragma unroll
                for (int i = 0; i < 16; ++i) { const f32x4 w = w4[i], bb = b4[i], kk = k4[i], rr = r4[i];
#pragma unroll
                    for (int e = 0; e < 4; ++e) { const float s = S[4 * i + e] * w[e] + sa * bb[e] + vv * kk[e]; S[4 * i + e] = s; y += s * rr[e]; }
                    if ((i & 1) == 1) asm volatile("" ::: "memory"); }
                Y[tt * 64 + lane] = y;
            }
        }
        __syncthreads();
        for (int q = 0; q < 8; ++q) {
            const int tt = wave * 8 + q, t = t0 + tt, cj = h * HD + lane; const size_t row = (size_t)b * SEQ + t;
            const float y = Y[tt * 64 + lane];
            const float mean = wave_sum(y) * (1.0f / HD); const float d = y - mean;
            const float var = wave_sum(d * d) * (1.0f / HD);
            const float yn = d * rsqrtf(var + GN_EPS) * gng[cj] + gnb[cj];
            const float bonus = wave_sum(R[tt * 64 + lane] * K[tt * 64 + lane] * rk[cj]);
            const float o = yn + bonus * V[tt * 64 + lane];
            const float g = bf2f(PG[row * PG_W + cj]);
            MIX[row * DM + CW + SBW + cj] = f2bf(o * siluf_(g));
        }
        __syncthreads();
    }
}

constexpr int TS = 72;
constexpr int TILE_B = 64 * TS * 2;
constexpr int AABS = 68, XTS = 65, CSS = 65;

__device__ __forceinline__ f32x4 mm_tile(const bf16_t* X, int m0, const bf16_t* Yt, int n0, int K, int fr, int fq, f32x4 acc) {
#pragma unroll
    for (int kk = 0; kk < 2; ++kk) {
        if (kk * 32 < K) {
            const bf16x8 a = *(const bf16x8*)(X + (m0 + fr) * TS + kk * 32 + fq * 8);
            const bf16x8 b = *(const bf16x8*)(Yt + (n0 + fr) * TS + kk * 32 + fq * 8);
            acc = __builtin_amdgcn_mfma_f32_16x16x32_bf16(a, b, acc, 0, 0, 0);
        }
    }
    return acc;
}
__device__ __forceinline__ uint2 pk4(const f32x4& v) { uint2 w; w.x = pk2(v[0], v[1]); w.y = pk2(v[2], v[3]); return w; }

struct B1Loads {
    bf16x8 rc, kc, vc, rp, kp, vp;
    f32x4 vf0, vf1;
    bf16x8 cc[2], cp[2];
};
__device__ __forceinline__ void b1_issue_loads(const Params& p, int l, int jb, int tid, B1Loads& L) {
    const int lane = tid & 63, wave = tid >> 6, fr = lane & 15, fq = lane >> 4;
    const int bh = jb >> 5, c = jb & 31, b = bh / NH, h = bh % NH, t0 = c * 64;
    const bf16_t* PR = (const bf16_t*)(p.ws + WS_PR); const float* VF = (const float*)(p.ws + WS_VF);
    {
        const int tt = tid >> 3, j0 = (tid & 7) * 8, t = t0 + tt, cj0 = h * HD + j0; const size_t row = (size_t)b * SEQ + t;
        const bf16_t* cur = PR + row * PR_W; const bf16_t* prv = cur - (t > 0 ? PR_W : 0);
        L.rc = *(const bf16x8*)(cur + cj0); L.kc = *(const bf16x8*)(cur + 384 + cj0); L.vc = *(const bf16x8*)(cur + 768 + cj0);
        L.rp = *(const bf16x8*)(prv + cj0); L.kp = *(const bf16x8*)(prv + 384 + cj0); L.vp = *(const bf16x8*)(prv + 768 + cj0);
        if (l > 0) { L.vf0 = *(const f32x4*)(VF + row * RWW + cj0); L.vf1 = *(const f32x4*)(VF + row * RWW + cj0 + 4); }
    }
#pragma unroll
    for (int q = 0; q < 2; ++q) {
        const int item = tid + 512 * q, tt = item >> 4, g = item & 15, t = t0 + tt;
        const bf16_t* cur = PR + ((size_t)b * SEQ + t) * PR_W + 1152; const bf16_t* prv = cur - (t > 0 ? PR_W : 0);
        const int gc = g < 12 ? g : 0, gp = g < 8 ? g : (g < 12 ? g + 4 : 0);
        L.cc[q] = *(const bf16x8*)(cur + 8 * gc); L.cp[q] = *(const bf16x8*)(prv + 8 * gp);
    }
}

__device__ void rwkv_b1_phase(const Params& p, int l, unsigned char* lds) {
    const int G = gridDim.x;
    float* VF = (float*)(p.ws + WS_VF);
    const float* mu = p.in[11] + l * 1216; const float* w0 = p.in[12] + l * RWW;
    const float* a0 = p.in[14] + l * RWW; const float* kks = p.in[16] + l * RWW; const float* ka = p.in[17] + l * RWW;
    const float* rk = p.in[18] + l * RWW; const float* v0 = p.in[21];
    const float* w2 = p.in[13] + l * LORA * RWW; const float* a2 = p.in[15] + l * LORA * RWW; const float* v2 = p.in[23];
    bf16_t* T_At = (bf16_t*)lds; bf16_t* T_Rt = T_At + 64 * TS; bf16_t* T_Bt = T_Rt + 64 * TS; bf16_t* T_Kt = T_Bt + 64 * TS;
    bf16_t* T_VT = T_Kt + 64 * TS; bf16_t* T_bhT = T_VT + 64 * TS; bf16_t* T_khT = T_bhT + 64 * TS;
    bf16_t* T_Aak = T_khT + 64 * TS; bf16_t* T_Arb = T_Aak + 64 * TS; bf16_t* T_Ark = T_Arb + 64 * TS;
    bf16_t* T_WT = T_At; bf16_t* T_U0T = T_Bt;
    float* Aab = (float*)(lds + 10 * TILE_B);
    float* XT = (float*)(lds + 10 * TILE_B + 64 * AABS * 4);
    float* PCv = XT + 128 * XTS;
    float* TI = PCv + 64;
    float* CS = (float*)T_Aak;
    constexpr int LS = 33;
    float* WD = Aab; float* AD = WD + 64 * LS;
    float* VL = XT + 64 * XTS;
    float* WLT = (float*)lds; float* ALT = WLT + 64 * XTS; float* VGT = ALT + 64 * XTS;

    int jb = blockIdx.x;
    if (jb >= BATCH * NH * 32) return;
    B1Loads L;
    b1_issue_loads(p, l, jb, tid_(), L);
#pragma unroll 1
    for (; jb < BATCH * NH * 32; jb += G) {
        const int tid = tid_(), lane = tid & 63, wave = tid >> 6, fr = lane & 15, fq = lane >> 4;
        const int bh = jb >> 5, c = jb & 31, b = bh / NH, h = bh % NH, t0 = c * 64;
        for (int repA = 0; repA < ((PROBE_REP & 128) ? 2 : 1); ++repA) {
        float wg[6][8];
#pragma unroll
        for (int q = 0; q < 6; ++q) {
            const int id = wave + 8 * q, Lk = id >> 4, tj = id & 3;
            if (q < 4 || l > 0) {
                const float* Wg = (Lk == 0 ? w2 : (Lk == 1 ? a2 : v2)) + (size_t)fq * RWW + h * HD + tj * 16 + fr;
#pragma unroll
                for (int kk = 0; kk < 8; ++kk) wg[q][kk] = Wg[(size_t)kk * 4 * RWW];
            }
        }
#pragma unroll
        for (int q = 0; q < 2; ++q) {
            const int item = tid + 512 * q, tt = item >> 4, g = item & 15, t = t0 + tt; const bool hp = t > 0;
            if (g < 8) {
                float* dst = (g < 4 ? WD + tt * LS + 8 * g : AD + tt * LS + 8 * (g - 4));
#pragma unroll
                for (int e = 0; e < 8; ++e) {
                    const float xc = bf2f((bf16_t)L.cc[q][e]), xp = hp ? bf2f((bf16_t)L.cp[q][e]) : 0.f;
                    const float x_ = xc + (xp - xc) * mu[1152 + 8 * g + e];
                    dst[e] = g < 4 ? 1.0f - 2.0f * __builtin_amdgcn_rcpf(1.0f + __builtin_amdgcn_exp2f(2.8853900817779268f * x_)) : x_;
                }
            } else if (g < 12 && l > 0) {
#pragma unroll
                for (int e = 0; e < 8; ++e) VL[tt * LS + 8 * (g - 8) + e] = bf2f((bf16_t)L.cc[q][e]) + (hp ? bf2f((bf16_t)L.cp[q][e]) : 0.f);
            }
        }
        __syncthreads();
#pragma unroll
        for (int q = 0; q < 6; ++q) {
            if (q < 4 || l > 0) {
                const int id = wave + 8 * q, Lk = id >> 4, ti = (id >> 2) & 3, tj = id & 3;
                const float* Xs = (Lk == 0 ? WD : (Lk == 1 ? AD : VL)) + (ti * 16 + fr) * LS + fq;
                f32x4 acc = (f32x4){0.f, 0.f, 0.f, 0.f};
#pragma unroll
                for (int kk = 0; kk < 8; ++kk) acc = __builtin_amdgcn_mfma_f32_16x16x4f32(Xs[kk * 4], wg[q][kk], acc, 0, 0, 0);
                float* out = (Lk == 0 ? WLT : (Lk == 1 ? ALT : VGT)) + (tj * 16 + fr) * XTS + ti * 16 + fq * 4;
#pragma unroll
                for (int r = 0; r < 4; ++r) out[r] = acc[r];
            }
        }
        __syncthreads();
        }
        const int tt = tid >> 3, j0 = (tid & 7) * 8, t = t0 + tt, cj0 = h * HD + j0;
        const size_t row = (size_t)b * SEQ + t;
        float rr[8], kk_[8], vv[8], aa[8], bb[8], lw[8];
        for (int repA2 = 0; repA2 < ((PROBE_REP & 16384) ? 2 : 1); ++repA2) {
        {
            const bool hp = t > 0;
            float wl[8], al[8], vg[8];
#pragma unroll
            for (int e = 0; e < 8; ++e) {
                const float r_c = bf2f((bf16_t)L.rc[e]), k_c = bf2f((bf16_t)L.kc[e]), v_c = bf2f((bf16_t)L.vc[e]);
                const float r_p = hp ? bf2f((bf16_t)L.rp[e]) : 0.f, k_p = hp ? bf2f((bf16_t)L.kp[e]) : 0.f, v_p = hp ? bf2f((bf16_t)L.vp[e]) : 0.f;
                rr[e] = r_c + (r_p - r_c) * mu[cj0 + e]; kk_[e] = k_c + (k_p - k_c) * mu[384 + cj0 + e]; vv[e] = v_c + (v_p - v_c) * mu[768 + cj0 + e];
                wl[e] = w0[cj0 + e] + WLT[(j0 + e) * XTS + tt]; al[e] = a0[cj0 + e] + ALT[(j0 + e) * XTS + tt]; vg[e] = l > 0 ? v0[cj0 + e] + VGT[(j0 + e) * XTS + tt] : 0.f;
            }
            float ssq = 0.f, bon = 0.f;
#pragma unroll
            for (int e = 0; e < 8; ++e) {
                const float sp2 = fmaxf(-wl[e], 0.f) * 1.4426950408889634f + __builtin_amdgcn_logf(1.0f + __builtin_amdgcn_exp2f(-1.4426950408889634f * fabsf(wl[e])));
                lw[e] = -__builtin_amdgcn_exp2f(-sp2 - 0.7213475204444817f);
                const float alr = __builtin_amdgcn_rcpf(1.0f + __builtin_amdgcn_exp2f(-1.4426950408889634f * al[e]));
                if (l > 0) { const float vf = e < 4 ? L.vf0[e & 3] : L.vf1[e & 3]; vv[e] = vv[e] + (vf - vv[e]) * __builtin_amdgcn_rcpf(1.0f + __builtin_amdgcn_exp2f(-1.4426950408889634f * vg[e])); }
                const float kkr = kk_[e] * kks[cj0 + e];
                kk_[e] = kk_[e] * (1.0f + (alr - 1.0f) * ka[cj0 + e]);
                aa[e] = kkr; bb[e] = alr; ssq += kkr * kkr; bon += rr[e] * kk_[e] * rk[cj0 + e];
            }
            if (l == 0) { *(f32x4*)(VF + row * RWW + cj0) = (f32x4){vv[0], vv[1], vv[2], vv[3]}; *(f32x4*)(VF + row * RWW + cj0 + 4) = (f32x4){vv[4], vv[5], vv[6], vv[7]}; }
            ssq += __shfl_xor(ssq, 1); ssq += __shfl_xor(ssq, 2); ssq += __shfl_xor(ssq, 4);
            bon += __shfl_xor(bon, 1); bon += __shfl_xor(bon, 2); bon += __shfl_xor(bon, 4);
            const float inv = fminf(__builtin_amdgcn_rsqf(ssq), 1e12f);
            uint4 bvw; float bv[8];
#pragma unroll
            for (int e = 0; e < 8; ++e) { const float kn = aa[e] * inv; aa[e] = -kn; bb[e] = kn * bb[e]; bv[e] = bon * vv[e]; CS[tt * CSS + j0 + e] = lw[e]; }
            bvw.x = pk2(bv[0], bv[1]); bvw.y = pk2(bv[2], bv[3]); bvw.z = pk2(bv[4], bv[5]); bvw.w = pk2(bv[6], bv[7]);
            *(uint4*)((bf16_t*)(p.ws + WS_CH_BV) + (size_t)jb * 4096 + tt * 64 + j0) = bvw;
        }
        __syncthreads();
#pragma unroll
        for (int e = 0; e < 8; ++e) {
            const int j = wave * 8 + e; float x = CS[lane * CSS + j];
#pragma unroll
            for (int o = 1; o < 64; o <<= 1) { const float y = __shfl_up(x, o); if (lane >= o) x += y; }
            CS[lane * CSS + j] = x;
        }
        __syncthreads();
        }
        for (int repB = 0; repB < ((PROBE_REP & 256) ? 2 : 1); ++repB) {
        {
            float at[8], rt[8], bt[8], kt[8];
#pragma unroll
            for (int e = 0; e < 8; ++e) {
                const int j = j0 + e; const float cs = CS[tt * CSS + j] * 1.4426950408889634f, csC = CS[63 * CSS + j] * 1.4426950408889634f, lw2 = lw[e] * 1.4426950408889634f;
                const float e_in = __builtin_amdgcn_exp2f(cs), e_ex = __builtin_amdgcn_exp2f(cs - lw2), e_ng = __builtin_amdgcn_exp2f(-cs), e_ht = __builtin_amdgcn_exp2f(csC - cs);
                at[e] = aa[e] * e_ex; rt[e] = rr[e] * e_in; bt[e] = bb[e] * e_ng; kt[e] = kk_[e] * e_ng;
                T_VT[j * TS + tt] = f2bf(vv[e]); T_bhT[j * TS + tt] = f2bf(bb[e] * e_ht); T_khT[j * TS + tt] = f2bf(kk_[e] * e_ht);
                XT[j * XTS + tt] = at[e];
                if (tt == 63) PCv[j] = __builtin_amdgcn_exp2f(csC);
            }
            uint4 w;
            w.x = pk2(at[0], at[1]); w.y = pk2(at[2], at[3]); w.z = pk2(at[4], at[5]); w.w = pk2(at[6], at[7]); *(uint4*)(T_At + tt * TS + j0) = w;
            w.x = pk2(rt[0], rt[1]); w.y = pk2(rt[2], rt[3]); w.z = pk2(rt[4], rt[5]); w.w = pk2(rt[6], rt[7]); *(uint4*)(T_Rt + tt * TS + j0) = w;
            w.x = pk2(bt[0], bt[1]); w.y = pk2(bt[2], bt[3]); w.z = pk2(bt[4], bt[5]); w.w = pk2(bt[6], bt[7]); *(uint4*)(T_Bt + tt * TS + j0) = w;
            w.x = pk2(kt[0], kt[1]); w.y = pk2(kt[2], kt[3]); w.z = pk2(kt[4], kt[5]); w.w = pk2(kt[6], kt[7]); *(uint4*)(T_Kt + tt * TS + j0) = w;
        }
        __syncthreads();
        }
        if (jb + G < BATCH * NH * 32) b1_issue_loads(p, l, jb + G, tid, L);
        for (int repC = 0; repC < ((PROBE_REP & 512) ? 2 : 1); ++repC) {
        {
            const int mat = wave >> 1;
            const bf16_t* As = (mat == 0 || mat == 2) ? T_Bt : T_Kt; const bf16_t* Bs = (mat < 2) ? T_At : T_Rt;
            bf16_t* dstb = (mat == 1 ? T_Aak : (mat == 2 ? T_Arb : T_Ark));
#pragma unroll
            for (int q = 0; q < 8; ++q) {
                const int ti = ((wave & 1) * 8 + q) >> 2, tj = q & 3;
                f32x4 acc = (f32x4){0.f, 0.f, 0.f, 0.f};
                if (ti <= tj) acc = mm_tile(As, ti * 16, Bs, tj * 16, 64, fr, fq, acc);
                const int tcol = tj * 16 + fr, i0 = ti * 16 + fq * 4;
                if (ti == tj) {
#pragma unroll
                    for (int r = 0; r < 4; ++r) { const bool keep = (mat < 2) ? (i0 + r < tcol) : (i0 + r <= tcol); if (!keep) acc[r] = 0.f; }
                }
                if (mat == 0) *(f32x4*)(Aab + tcol * AABS + i0) = acc;
                else *(uint2*)(dstb + tcol * TS + i0) = pk4(acc);
            }
        }
        __syncthreads();
        if (wave == 0) {
            const int blk = lane >> 4, cc = lane & 15; const float* ar = Aab + (16 * blk) * AABS + 16 * blk;
            float x[16];
#pragma unroll
            for (int u = 0; u < 16; ++u) { float v = (u == cc) ? 1.0f : 0.f;
#pragma unroll
                for (int i = 0; i < u; ++i) v += ar[u * AABS + i] * x[i];
                x[u] = v; }
#pragma unroll
            for (int u = 0; u < 16; ++u) TI[(blk * 16 + u) * 17 + cc] = x[u];
        } else {
#pragma unroll 1
            for (int id = wave - 1; id < 16; id += 7) {
                const int ti = id >> 2, tj = id & 3;
                f32x4 acc = mm_tile(T_Aak, ti * 16, T_VT, tj * 16, 64, fr, fq, (f32x4){0.f, 0.f, 0.f, 0.f});
                const int j = tj * 16 + fr, tr = ti * 16 + fq * 4;
#pragma unroll
                for (int r = 0; r < 4; ++r) XT[(64 + j) * XTS + tr + r] = acc[r];
            }
        }
        __syncthreads();
        }
        {
            float* xc = XT + (wave * 16 + fr) * XTS;
#pragma unroll
            for (int I = 0; I < 4; ++I) {
                f32x4 acc;
#pragma unroll
                for (int r = 0; r < 4; ++r) acc[r] = xc[16 * I + 4 * fq + r];
#pragma unroll
                for (int J = 0; J < I; ++J)
#pragma unroll
                    for (int kk = 0; kk < 4; ++kk) acc = __builtin_amdgcn_mfma_f32_16x16x4f32(Aab[(16 * I + fr) * AABS + 16 * J + 4 * kk + fq], xc[16 * J + 4 * kk + fq], acc, 0, 0, 0);
#pragma unroll
                for (int r = 0; r < 4; ++r) xc[16 * I + 4 * fq + r] = acc[r];
                asm volatile("s_waitcnt lgkmcnt(0)" ::: "memory");
                f32x4 xs = (f32x4){0.f, 0.f, 0.f, 0.f};
#pragma unroll
                for (int kk = 0; kk < 4; ++kk) xs = __builtin_amdgcn_mfma_f32_16x16x4f32(TI[(I * 16 + fr) * 17 + 4 * kk + fq], xc[16 * I + 4 * kk + fq], xs, 0, 0, 0);
                asm volatile("s_waitcnt lgkmcnt(0)" ::: "memory");
#pragma unroll
                for (int r = 0; r < 4; ++r) xc[16 * I + 4 * fq + r] = xs[r];
                asm volatile("s_waitcnt lgkmcnt(0)" ::: "memory");
            }
        }
        __syncthreads();
        for (int repE = 0; repE < ((PROBE_REP & 2048) ? 2 : 1); ++repE) {
        {
            const int col = tid >> 2, tg = (tid & 3) * 16;
            const float* xr = XT + col * XTS + tg; bf16_t* dst = (col < 64 ? T_WT + col * TS : T_U0T + (col - 64) * TS) + tg;
            uint4 w0_, w1_;
            w0_.x = pk2(xr[0], xr[1]); w0_.y = pk2(xr[2], xr[3]); w0_.z = pk2(xr[4], xr[5]); w0_.w = pk2(xr[6], xr[7]);
            w1_.x = pk2(xr[8], xr[9]); w1_.y = pk2(xr[10], xr[11]); w1_.z = pk2(xr[12], xr[13]); w1_.w = pk2(xr[14], xr[15]);
            *(uint4*)dst = w0_; *(uint4*)(dst + 8) = w1_;
        }
        __syncthreads();
        {
            bf16_t* gM = (bf16_t*)(p.ws + WS_CH_M) + (size_t)jb * 4096; bf16_t* gNT = (bf16_t*)(p.ws + WS_CH_NT) + (size_t)jb * 4096;
            bf16_t* gG = (bf16_t*)(p.ws + WS_CH_G) + (size_t)jb * 4096; bf16_t* gY1T = (bf16_t*)(p.ws + WS_CH_Y1T) + (size_t)jb * 4096;
            const int mat = wave >> 1;
            const bf16_t* A1 = (mat == 0 || mat == 2) ? T_WT : (mat == 1 ? T_Arb : T_bhT);
            const bf16_t* B1 = mat == 0 ? T_Arb : (mat == 2 ? T_bhT : T_U0T);
            const bf16_t* A2 = mat == 1 ? T_Ark : T_khT;
            bf16_t* gdst = mat == 0 ? gG : (mat == 1 ? gY1T : (mat == 2 ? gM : gNT));
#pragma unroll
            for (int q = 0; q < 8; ++q) {
                const int ti = ((wave & 1) * 8 + q) >> 2, tj = q & 3;
                const int col = tj * 16 + fr, r0 = ti * 16 + fq * 4;
                f32x4 acc = mm_tile(A1, ti * 16, B1, tj * 16, 64, fr, fq, (f32x4){0.f, 0.f, 0.f, 0.f});
                if (mat & 1) acc = mm_tile(A2, ti * 16, T_VT, tj * 16, 64, fr, fq, acc);
                if (mat == 0) {
                    const uint2 rw = *(const uint2*)(T_Rt + col * TS + r0);
                    acc[0] += bf2f((bf16_t)(rw.x & 0xffff)); acc[1] += bf2f((bf16_t)(rw.x >> 16)); acc[2] += bf2f((bf16_t)(rw.y & 0xffff)); acc[3] += bf2f((bf16_t)(rw.y >> 16));
                } else if (mat == 2 && ti == tj) {
                    const float pc = PCv[col];
#pragma unroll
                    for (int r = 0; r < 4; ++r) if (r0 + r == col) acc[r] += pc;
                }
                *(uint2*)(gdst + col * 64 + r0) = pk4(acc);
            }
        }
        __syncthreads();
        }
    }
}

__device__ void rwkv_b2_job(const Params& p, int bh, unsigned char* lds) {
    const int tid = tid_(), lane = tid & 63, wave = tid >> 6, fr = lane & 15, fq = lane >> 4;
    const int mi = wave >> 1, nj0 = (wave & 1) * 2;
    const bf16_t* gM = (const bf16_t*)(p.ws + WS_CH_M); const bf16_t* gNT = (const bf16_t*)(p.ws + WS_CH_NT); bf16_t* gZT = (bf16_t*)(p.ws + WS_ZT);
    bf16_t* zbuf = (bf16_t*)lds;
    f32x4 z[2];
    z[0] = (f32x4){0.f, 0.f, 0.f, 0.f}; z[1] = z[0];
    const int c0 = mi * 16 + fq * 4;
    bf16x8 am[2]; uint2 nw[2];
    {
        const size_t jb = (size_t)bh * 32;
#pragma unroll
        for (int kk = 0; kk < 2; ++kk) am[kk] = *(const bf16x8*)(gM + jb * 4096 + (mi * 16 + fr) * 64 + kk * 32 + fq * 8);
#pragma unroll
        for (int q = 0; q < 2; ++q) nw[q] = *(const uint2*)(gNT + jb * 4096 + ((nj0 + q) * 16 + fr) * 64 + c0);
    }
#pragma unroll 1
    for (int c = 0; c < SEQ / 64; ++c) {
        const size_t jb = (size_t)bh * 32 + c;
        bf16_t* zh = zbuf + (c & 1) * 2 * 64 * TS; bf16_t* zl = zh + 64 * TS;
#pragma unroll
        for (int q = 0; q < 2; ++q) {
            const int j = (nj0 + q) * 16 + fr;
            const uint2 hi = pk4(z[q]);
            f32x4 lo;
            lo[0] = z[q][0] - bf2f((bf16_t)(hi.x & 0xffff)); lo[1] = z[q][1] - bf2f((bf16_t)(hi.x >> 16)); lo[2] = z[q][2] - bf2f((bf16_t)(hi.y & 0xffff)); lo[3] = z[q][3] - bf2f((bf16_t)(hi.y >> 16));
            *(uint2*)(zh + j * TS + c0) = hi; *(uint2*)(zl + j * TS + c0) = pk4(lo);
            *(uint2*)(gZT + jb * 4096 + j * 64 + c0) = hi;
        }
        bf16x8 amn[2]; uint2 nwn[2];
        {
            const size_t jn = (size_t)bh * 32 + (c + 1 < SEQ / 64 ? c + 1 : c);
#pragma unroll
            for (int kk = 0; kk < 2; ++kk) amn[kk] = *(const bf16x8*)(gM + jn * 4096 + (mi * 16 + fr) * 64 + kk * 32 + fq * 8);
#pragma unroll
            for (int q = 0; q < 2; ++q) nwn[q] = *(const uint2*)(gNT + jn * 4096 + ((nj0 + q) * 16 + fr) * 64 + c0);
        }
        __syncthreads();
#pragma unroll
        for (int q = 0; q < 2; ++q) {
            const int j = (nj0 + q) * 16 + fr;
            f32x4 acc; acc[0] = bf2f((bf16_t)(nw[q].x & 0xffff)); acc[1] = bf2f((bf16_t)(nw[q].x >> 16)); acc[2] = bf2f((bf16_t)(nw[q].y & 0xffff)); acc[3] = bf2f((bf16_t)(nw[q].y >> 16));
#pragma unroll
            for (int kk = 0; kk < 2; ++kk) {
                const bf16x8 bh_ = *(const bf16x8*)(zh + j * TS + kk * 32 + fq * 8), bl_ = *(const bf16x8*)(zl + j * TS + kk * 32 + fq * 8);
                acc = __builtin_amdgcn_mfma_f32_16x16x32_bf16(am[kk], bh_, acc, 0, 0, 0);
                acc = __builtin_amdgcn_mfma_f32_16x16x32_bf16(am[kk], bl_, acc, 0, 0, 0);
            }
            z[q] = acc;
        }
        am[0] = amn[0]; am[1] = amn[1]; nw[0] = nwn[0]; nw[1] = nwn[1];
    }
    __syncthreads();
}

__device__ void rwkv_b3_pair(const Params& p, int l, int pair) {
    const int tid = tid_(), lane = tid & 63, wave = tid >> 6, fr = lane & 15, fq = lane >> 4;
    const int jb = pair * 2 + (wave >> 2), mi = wave & 3;
    const int bh = jb >> 5, c = jb & 31, b = bh / NH, h = bh % NH;
    const bf16_t* gG = (const bf16_t*)(p.ws + WS_CH_G) + (size_t)jb * 4096; const bf16_t* gY1T = (const bf16_t*)(p.ws + WS_CH_Y1T) + (size_t)jb * 4096;
    const bf16_t* gBV = (const bf16_t*)(p.ws + WS_CH_BV) + (size_t)jb * 4096; const bf16_t* gZT = (const bf16_t*)(p.ws + WS_ZT) + (size_t)jb * 4096;
    const bf16_t* PG = (const bf16_t*)(p.ws + WS_PG); bf16_t* MIX = (bf16_t*)(p.ws + WS_MIX);
    const float* gng = p.in[19] + l * RWW; const float* gnb = p.in[20] + l * RWW;
    const int tr = mi * 16 + fq * 4;
    bf16x8 ag[2];
#pragma unroll
    for (int kk = 0; kk < 2; ++kk) ag[kk] = *(const bf16x8*)(gG + (mi * 16 + fr) * 64 + kk * 32 + fq * 8);
    f32x4 acc[4];
#pragma unroll
    for (int nj = 0; nj < 4; ++nj) {
        const int j = nj * 16 + fr;
        const uint2 yw = *(const uint2*)(gY1T + j * 64 + tr);
        acc[nj][0] = bf2f((bf16_t)(yw.x & 0xffff)); acc[nj][1] = bf2f((bf16_t)(yw.x >> 16)); acc[nj][2] = bf2f((bf16_t)(yw.y & 0xffff)); acc[nj][3] = bf2f((bf16_t)(yw.y >> 16));
#pragma unroll
        for (int kk = 0; kk < 2; ++kk) { const bf16x8 bz = *(const bf16x8*)(gZT + j * 64 + kk * 32 + fq * 8); acc[nj] = __builtin_amdgcn_mfma_f32_16x16x32_bf16(ag[kk], bz, acc[nj], 0, 0, 0); }
    }
#pragma unroll
    for (int r = 0; r < 4; ++r) {
        float s = acc[0][r] + acc[1][r] + acc[2][r] + acc[3][r];
        s += __shfl_xor(s, 1); s += __shfl_xor(s, 2); s += __shfl_xor(s, 4); s += __shfl_xor(s, 8);
        const float mean = s * (1.0f / HD);
        float d[4], vs = 0.f;
#pragma unroll
        for (int nj = 0; nj < 4; ++nj) { d[nj] = acc[nj][r] - mean; vs += d[nj] * d[nj]; }
        vs += __shfl_xor(vs, 1); vs += __shfl_xor(vs, 2); vs += __shfl_xor(vs, 4); vs += __shfl_xor(vs, 8);
        const float rstd = rsqrtf(vs * (1.0f / HD) + GN_EPS);
        const int tt = tr + r; const size_t row = (size_t)b * SEQ + c * 64 + tt;
#pragma unroll
        for (int nj = 0; nj < 4; ++nj) {
            const int j = nj * 16 + fr, cj = h * HD + j;
            const float o = d[nj] * rstd * gng[cj] + gnb[cj] + bf2f(gBV[tt * 64 + j]);
            const float g = bf2f(PG[row * PG_W + cj]);
            MIX[row * DM + CW + SBW + cj] = f2bf(o * siluf_(g));
        }
    }
}

#ifndef ATTN_REF
#define ATTN_REF 0
#endif
#ifndef RWKV_REF
#define RWKV_REF 0
#endif
__device__ void phase_mix1(const Params& p, int l, unsigned char* lds) {
    constexpr int NAT = BATCH * NH * 4, NCV = BATCH * (SEQ / 32);
    const int G = gridDim.x;
#if RWKV_REF
    for (int job = blockIdx.x; job < BATCH * NH; job += G) rwkv_job(p, l, job, (float*)lds);
#else
    for (int rep = 0; rep < ((PROBE_REP & 1) ? 2 : 1); ++rep) rwkv_b1_phase(p, l, lds);
#endif
    for (int rep = 0; rep < ((PROBE_REP & 2) ? 2 : 1); ++rep)
#if ATTN_REF
    for (int job = blockIdx.x; job < NAT; job += G) attn_job(p, job);
#else
    for (int job = blockIdx.x; job < NAT * 2; job += G) attn_mfma_wave(p, job >> 3, (job & 7) * 8 + (tid_() >> 6));
#endif
#ifndef CONV_REF
#define CONV_REF 0
#endif
    for (int rep = 0; rep < ((PROBE_REP & 4) ? 2 : 1); ++rep)
#if CONV_REF
    for (int job = blockIdx.x; job < NCV; job += G) conv_job(p, l, job, (float*)lds);
#else
    for (int job = blockIdx.x; job < BATCH * (SEQ / 64); job += G) conv_job64(p, l, job, lds);
#endif
}
__device__ void phase_mix2(const Params& p, int l, unsigned char* lds) {
#if !RWKV_REF
    for (int rep = 0; rep < ((PROBE_REP & 8) ? 2 : 1); ++rep)
    for (int job = blockIdx.x; job < BATCH * NH; job += gridDim.x) rwkv_b2_job(p, job, lds);
    if (l + 1 < DEPTH && defer_layer1_weights() && (int)blockIdx.x >= BATCH * NH) prep_weights(p, l + 1, lds, blockIdx.x - BATCH * NH, gridDim.x - BATCH * NH);
#endif
}
__device__ void phase_mix3(const Params& p, int l, unsigned char* lds) {
#if !RWKV_REF
    for (int rep = 0; rep < ((PROBE_REP & 16) ? 2 : 1); ++rep)
    for (int pair = blockIdx.x; pair < BATCH * NH * 16; pair += gridDim.x) rwkv_b3_pair(p, l, pair);
#endif
}

#define LAS __attribute__((address_space(3)))
#define XB_TMO      128
#define XB_XCNT(j)  (256  + 64 * (j))
#define XB_XSUB(j)  (1280 + 64 * (j))
#define XB_XGEN(j)  (2304 + 64 * (j))
#define XB_TOP      3328
#define XB_TOPGEN   3392
#define XCD_BAR_WORDS 3456
#define XB_SPIN_CAP (1u << 18)

__device__ __forceinline__ unsigned xb_ld(unsigned* p)              { return __hip_atomic_load(p, __ATOMIC_RELAXED, __HIP_MEMORY_SCOPE_AGENT); }
__device__ __forceinline__ unsigned xb_add(unsigned* p, unsigned v) { return __hip_atomic_fetch_add(p, v, __ATOMIC_RELAXED, __HIP_MEMORY_SCOPE_AGENT); }
__device__ __forceinline__ unsigned xb_xcc_id() { return (unsigned)__builtin_amdgcn_s_getreg((3 << 11) | 20) & 0xFu; }
#define XB_SPIN(cond, bar) do { unsigned _sp = 0; while (cond) { __builtin_amdgcn_s_sleep(1); \
    if ((++_sp & 255u) == 0u) { if (xb_ld(&(bar)[XB_TMO])) break; if (_sp > XB_SPIN_CAP) { atomicAdd(&(bar)[XB_TMO], 1u); break; } } } } while (0)

struct XcdBarrier {
    unsigned* bar; unsigned x;
    volatile LAS unsigned* st;
};

__device__ __forceinline__ XcdBarrier xcd_barrier_post(unsigned* bar, volatile LAS unsigned* st) {
    XcdBarrier b; b.bar = bar; b.x = xb_xcc_id(); b.st = st;
    if (threadIdx.x == 0) (void)xb_add(&bar[XB_XCNT(b.x)], 1u);
    return b;
}
__device__ __forceinline__ void xcd_barrier_complete(unsigned* bar, unsigned x, unsigned& nloc, unsigned& nx) {
    const unsigned G = gridDim.x * gridDim.y * gridDim.z;
    unsigned sum, cnt, mine, sp = 0u;
    for (;;) {
        sum = 0u; cnt = 0u; mine = 0u;
#pragma unroll
        for (unsigned j = 0; j < 16; ++j) { const unsigned c = xb_ld(&bar[XB_XCNT(j)]); sum += c; cnt += (c > 0u) ? 1u : 0u; mine = (j == x) ? c : mine; }
        if (sum == G) break;
        __builtin_amdgcn_s_sleep(1);
        if ((++sp & 255u) == 0u) { if (xb_ld(&bar[XB_TMO])) break; if (sp > XB_SPIN_CAP) { atomicAdd(&bar[XB_TMO], 1u); break; } }
    }
    nloc = mine > 0u ? mine : 1u; nx = cnt > 0u ? cnt : 1u;
}

__device__ __forceinline__ void xcd_barrier(const XcdBarrier& b) {
    asm volatile("s_waitcnt vmcnt(0)" ::: "memory");
    __syncthreads();
    if (threadIdx.x == 0) {
        unsigned* bar = b.bar;
        __builtin_amdgcn_s_waitcnt(0);
        unsigned nloc = b.st[0], nx = b.st[1];
        if (nloc == 0u) { xcd_barrier_complete(bar, b.x, nloc, nx); b.st[0] = nloc; b.st[1] = nx; }
        const unsigned old = xb_add(&bar[XB_XSUB(b.x)], 1u);
        const unsigned gen = old / nloc;
        if (old + 1u == (gen + 1u) * nloc) {
            __builtin_amdgcn_fence(__ATOMIC_RELEASE, "agent");
            asm volatile("s_waitcnt vmcnt(0)" ::: "memory");
            const unsigned og = xb_add(&bar[XB_TOP], 1u);
            const unsigned tg = og / nx;
            if (og + 1u == (tg + 1u) * nx) xb_add(&bar[XB_TOPGEN], 1u);
            else XB_SPIN(xb_ld(&bar[XB_TOPGEN]) == tg, bar);
            __builtin_amdgcn_fence(__ATOMIC_ACQUIRE, "agent");
            xb_add(&bar[XB_XGEN(b.x)], 1u);
            asm volatile("s_waitcnt vmcnt(0)" ::: "memory");
        } else {
            XB_SPIN(xb_ld(&bar[XB_XGEN(b.x)]) == gen, bar);
            __builtin_amdgcn_fence(__ATOMIC_ACQUIRE, "agent");
            asm volatile("s_waitcnt vmcnt(0)" ::: "memory");
        }
    }
    __syncthreads();
}

constexpr int PH_PER_LAYER = 6;
constexpr int N_PHASES = 1 + PH_PER_LAYER * DEPTH;
__device__ __forceinline__ void run_phase(const Params& p, int ph, unsigned char* lds) {
    unsigned char* ws = p.ws;
    if (ph == 0) { for (int rep = 0; rep < ((PROBE_REP & 4096) ? 2 : 1); ++rep) phase_prologue(p, lds); return; }
    const int l = (ph - 1) / PH_PER_LAYER, k = (ph - 1) % PH_PER_LAYER;
    if (k == 0) {
        EpiInProjP E{(bf16_t*)(ws + WS_PC), (bf16_t*)(ws + WS_PS), (bf16_t*)(ws + WS_PR), (bf16_t*)(ws + WS_PG), (bf16_t*)(ws + WS_VT)};
        pg8::Gemm g{(const bf16_t*)(ws + WS_XB), (const bf16_t*)(ws + WS_WIN) + (size_t)l * NINT * DM, M, NINT, DM}; pg8::StaticOrder S; S.init(M, NINT, (int)gridDim.x, (int)blockIdx.x);
        for (int rep = 0; rep < ((PROBE_REP & 32) ? 2 : 1); ++rep)
        pg8::gemm_phase<EpiInProjP, pg8::StaticOrder, true, true>((PG8_LAS unsigned char*)lds, g, S, E);
    } else if (k == 1) {
        phase_mix1(p, l, lds);
    } else if (k == 2) {
        phase_mix2(p, l, lds);
    } else if (k == 3) {
        phase_mix3(p, l, lds);
    } else if (k == 4) {
        EpiOutBf16P E{(bf16_t*)(ws + WS_Y), DM};
        pg8::Gemm g{(const bf16_t*)(ws + WS_MIX), (const bf16_t*)(ws + WS_WOUT) + (size_t)l * DM * DM, M, DM, DM}; pg8::StaticOrder S; S.init(M, DM, (int)gridDim.x, (int)blockIdx.x);
        for (int rep = 0; rep < ((PROBE_REP & 64) ? 2 : 1); ++rep)
        pg8::gemm_phase<EpiOutBf16P, pg8::StaticOrder, true, true>((PG8_LAS unsigned char*)lds, g, S, E);
    } else {
        for (int rep = 0; rep < ((PROBE_REP & 8192) && l == 0 ? 2 : 1); ++rep)
        phase_rowpass(l == 0 ? p.in[0] : p.out, (const bf16_t*)(ws + WS_Y), p.in[2] + l * DM, p.out, l + 1 < DEPTH ? (bf16_t*)(ws + WS_XB) : nullptr);
    }
}

static_assert(10 * TILE_B + 64 * AABS * 4 + 128 * XTS * 4 + 64 * 4 + 4 * 16 * 17 * 4 <= 147456, "B1 LDS map");
constexpr int LDS_BYTES = 147456 + 256;

constexpr int MISC_OFF = 147456;
#if MK_COOP == 2
__global__ void __launch_bounds__(512, 2) fwd_kernel(Params p) {
    extern __shared__ __attribute__((aligned(16))) unsigned char lds[];
    volatile LAS unsigned* misc = (volatile LAS unsigned*)((LAS unsigned char*)lds + MISC_OFF);
    if (threadIdx.x < 16) misc[threadIdx.x] = 0u;
    __syncthreads();
    XcdBarrier bar = xcd_barrier_post((unsigned*)(p.ws + WS_CTL), misc);
    for (int ph = p.ph_lo; ph < p.ph_hi; ++ph) {
        run_phase(p, ph, lds);
        if (ph + 1 < p.ph_hi) xcd_barrier(bar);
        if ((PROBE_REP & 32768) && ph == 3) for (int rep = 0; rep < 20; ++rep) xcd_barrier(bar);
    }
}
#elif MK_COOP == 1
__global__ void __launch_bounds__(512, 2) fwd_kernel(Params p) {
    extern __shared__ __attribute__((aligned(16))) unsigned char lds[];
    cg::grid_group grid = cg::this_grid();
    for (int ph = p.ph_lo; ph < p.ph_hi; ++ph) {
        run_phase(p, ph, lds);
        if (ph + 1 < p.ph_hi) grid.sync();
    }
}
#else
__global__ void __launch_bounds__(512, 2) fwd_kernel(Params p) {
    extern __shared__ __attribute__((aligned(16))) unsigned char lds[];
    for (int ph = p.ph_lo; ph < p.ph_hi; ++ph) run_phase(p, ph, lds);
}
#endif

extern "C" void kernel_launch(void* const* d_in, const int* in_sizes, int n_in, void* d_out, int out_size, void* d_ws, size_t ws_size, hipStream_t stream) {
    static int grid = 0;
    if (grid == 0) {
        if (n_in != 24 || out_size != M * DM || ws_size < WS_END) { fprintf(stderr, "kernel_launch: unexpected problem (n_in %d out %d ws %zu)\n", n_in, out_size, ws_size); grid = -1; return; }
        int dev = 0, cus = 0, per_cu = 0;
        hipGetDevice(&dev); hipDeviceGetAttribute(&cus, hipDeviceAttributeMultiprocessorCount, dev);
        hipFuncSetAttribute((const void*)fwd_kernel, hipFuncAttributeMaxDynamicSharedMemorySize, LDS_BYTES);
        hipOccupancyMaxActiveBlocksPerMultiprocessor(&per_cu, (const void*)fwd_kernel, 512, LDS_BYTES);
        if (per_cu < 1) { fprintf(stderr, "kernel_launch: occupancy query says %d blocks per CU\n", per_cu); per_cu = 1; }
        grid = cus;
        (void)hipGetLastError();
    }
    if (grid < 0) return;
    Params p{};
    for (int i = 0; i < 24; ++i) p.in[i] = (const float*)d_in[i];
    p.out = (float*)d_out; p.ws = (unsigned char*)d_ws;
#if MK_COOP == 2
    p.ph_lo = 0; p.ph_hi = N_PHASES;
    if (hipMemsetAsync((char*)d_ws + WS_CTL, 0, XCD_BAR_WORDS * 4, stream) != hipSuccess) { fprintf(stderr, "kernel_launch: memset of the barrier words failed\n"); return; }
    hipLaunchKernelGGL(fwd_kernel, dim3(grid), dim3(512), LDS_BYTES, stream, p);
#elif MK_COOP == 1
    p.ph_lo = 0; p.ph_hi = N_PHASES;
    void* args[] = {&p};
    hipError_t e = hipLaunchCooperativeKernel((const void*)fwd_kernel, dim3(grid), dim3(512), args, LDS_BYTES, stream);
    if (e != hipSuccess) fprintf(stderr, "cooperative launch failed: %s (grid %d)\n", hipGetErrorString(e), grid);
#else
    for (int ph = 0; ph < N_PHASES; ++ph) {
        p.ph_lo = ph; p.ph_hi = ph + 1;
        hipLaunchKernelGGL(fwd_kernel, dim3(grid), dim3(512), LDS_BYTES, stream, p);
    }
#endif
}
```

```cpp
#include <hip/hip_runtime.h>
#include <hip/hip_cooperative_groups.h>
#include <cstdio>
#include <cstdint>
namespace cg = cooperative_groups;

#ifndef PROBE_REP
#define PROBE_REP 0
#endif
#ifndef MK_COOP
#define MK_COOP 2
#endif

constexpr int BATCH = 16, SEQ = 2048, DM = 1024, DEPTH = 2;
constexpr int M = BATCH * SEQ;
constexpr int HD = 64, NH = 6;
constexpr int CW = 256, SBW = 384, RWW = 384, LORA = 32, TAPS = 31;
constexpr int DIN = 3904;
constexpr int NINT = 4096;
constexpr int PC_W = 768, PS_W = 1152, PR_W = 1280, PG_W = 384;
constexpr float RMS_EPS = 1e-6f, LN_EPS = 1e-5f, GN_EPS = 64e-5f;

typedef unsigned short bf16_t;
typedef short bf16x8 __attribute__((ext_vector_type(8)));
typedef float f32x4 __attribute__((ext_vector_type(4)));
typedef unsigned short us4 __attribute__((ext_vector_type(4)));

constexpr size_t MiB = 1u << 20;
constexpr size_t WS_CTL = 0;
constexpr size_t WS_WPW = 512 * 1024;
constexpr size_t WS_WIN = 1 * MiB;
constexpr size_t WS_WOUT = 17 * MiB;
constexpr size_t WS_XB = 21 * MiB;
constexpr size_t WS_MIX = WS_XB;
constexpr size_t WS_PC = 85 * MiB;
constexpr size_t WS_PS = 133 * MiB;
constexpr size_t WS_VT = 205 * MiB;
constexpr size_t WS_Y = WS_PC;
constexpr size_t WS_PR = 229 * MiB;
constexpr size_t WS_PG = 309 * MiB;
constexpr size_t WS_VF = 333 * MiB;
constexpr size_t WS_CH = 381 * MiB;
constexpr size_t CH_SZ = (size_t)3072 * 4096 * 2;
constexpr size_t WS_CH_M = WS_CH, WS_CH_NT = WS_CH + CH_SZ, WS_CH_G = WS_CH + 2 * CH_SZ, WS_CH_Y1T = WS_CH + 3 * CH_SZ, WS_CH_BV = WS_CH + 4 * CH_SZ;
constexpr size_t WS_ZT = WS_PR;
constexpr size_t WS_END = 501 * MiB;

struct Params {
    const float* in[24];
    float* out;
    unsigned char* ws;
    int ph_lo, ph_hi;
};

__device__ __forceinline__ float bf2f(bf16_t v) { return __uint_as_float(((unsigned)v) << 16); }
typedef float f32x2_t __attribute__((ext_vector_type(2)));
typedef __bf16 bf16x2_t __attribute__((ext_vector_type(2)));
__device__ __forceinline__ unsigned pk2(float lo, float hi) { f32x2_t v = {lo, hi}; bf16x2_t b = __builtin_convertvector(v, bf16x2_t); return __builtin_bit_cast(unsigned, b); }
__device__ __forceinline__ bf16_t f2bf(float f) { return (bf16_t)(pk2(f, f) & 0xffffu); }
__device__ __forceinline__ float wave_sum(float v) {
#pragma unroll
    for (int o = 1; o < 64; o <<= 1) v += __shfl_xor(v, o);
    return v;
}
__device__ __forceinline__ float sigmoidf_(float x) { return 1.0f / (1.0f + __expf(-x)); }
__device__ __forceinline__ float siluf_(float x) { return x / (1.0f + __expf(-x)); }
__device__ __forceinline__ int tid_() { int t = threadIdx.x; asm volatile("" : "+v"(t)); return t; }
__device__ __forceinline__ int opaque_zero() { int z = 0; asm volatile("" : "+v"(z)); return z; }

__device__ __forceinline__ int orig_col(int n) { return n < 3520 ? n : (n < 3584 ? -1 : (n < 3968 ? n - 64 : -1)); }

__device__ void transpose_tile(const float* W, int ldw, int ncol_src, const float* gain, bf16_t* WT, int K, int n0, int k0, bool permute, float* tile  , bool skip_fold_rows = false) {
    const int tid = tid_();
#pragma unroll
    for (int i = 0; i < 8; ++i) {
        const int kl = (tid >> 6) + 8 * i, nl = tid & 63;
        const int n = n0 + nl, k = k0 + kl;
        const int oc = permute ? orig_col(n) : n;
        float v = 0.f;
        if (oc >= 0 && oc < ncol_src) v = W[(size_t)k * ldw + oc] * (gain ? gain[k] : 1.0f);
        if (permute && n >= 768 && n < 1152) v *= 0.125f * 1.4426950408889634f;
        tile[kl * 65 + nl] = v;
    }
    __syncthreads();
#pragma unroll
    for (int i = 0; i < 8; ++i) {
        const int nl = (tid >> 6) + 8 * i, kl = tid & 63;
        if (!(skip_fold_rows && n0 + nl >= 3520 && n0 + nl < 3584)) WT[(size_t)(n0 + nl) * K + k0 + kl] = f2bf(tile[kl * 65 + nl]);
    }
    __syncthreads();
}
__device__ void fold_v1_rows(const Params& p, int l, bf16_t* WinT_l, float* scr  , int worker, int nworkers) {
    const int tid = tid_(), o = tid & 63, kl = (tid >> 6) & 3, half = tid >> 8;
    const float* W = p.in[3] + (size_t)l * DM * DIN; const float* gain = p.in[1] + l * DM; const float* v1 = p.in[22] + (size_t)(l - 1) * RWW * LORA; const float* muv = p.in[11] + l * 1216 + 768;
    for (int k4 = worker * 4; k4 < DM; k4 += nworkers * 4) {
        const int k = k4 + kl; const float* wr = W + (size_t)k * DIN + 3072 + half * 192; const float* mv = muv + half * 192; const float* vr = v1 + (size_t)(half * 192) * LORA + (o & 31);
        float a = 0.f;
#pragma unroll 4
        for (int c = 0; c < 192; ++c) { const float m = mv[c]; a += wr[c] * (o >= 32 ? m : 1.0f - m) * vr[c * LORA]; }
        scr[half * 256 + kl * 64 + o] = a;
        __syncthreads();
        if (half == 0) WinT_l[(size_t)(3520 + o) * DM + k] = f2bf((scr[kl * 64 + o] + scr[256 + kl * 64 + o]) * gain[k]);
        __syncthreads();
    }
}
__device__ void prep_weights(const Params& p, int l, unsigned char* lds, int worker, int nworkers) {
    float* tile = (float*)lds;
    bf16_t* WinT = (bf16_t*)(p.ws + WS_WIN) + (size_t)l * NINT * DM; bf16_t* WoutT = (bf16_t*)(p.ws + WS_WOUT) + (size_t)l * DM * DM; bf16_t* WpwT = (bf16_t*)(p.ws + WS_WPW) + (size_t)l * CW * CW;
    const int nt_in = (NINT / 64) * (DM / 64), nt_out = (DM / 64) * (DM / 64), nt_pw = (CW / 64) * (CW / 64);
    for (int j = worker; j < nt_in + nt_out + nt_pw; j += nworkers) {
        if (j < nt_in) transpose_tile(p.in[3] + (size_t)l * DM * DIN, DIN, DIN, p.in[1] + l * DM, WinT, DM, (j / (DM / 64)) * 64, (j % (DM / 64)) * 64, true, tile, l > 0);
        else if (j < nt_in + nt_out) { const int r = j - nt_in; transpose_tile(p.in[4] + (size_t)l * DM * DM, DM, DM, nullptr, WoutT, DM, (r / (DM / 64)) * 64, (r % (DM / 64)) * 64, false, tile); }
        else { const int r = j - nt_in - nt_out; transpose_tile(p.in[9] + (size_t)l * CW * CW, CW, CW, nullptr, WpwT, CW, (r >> 2) * 64, (r & 3) * 64, false, tile); }
    }
    if (l > 0) fold_v1_rows(p, l, WinT, tile, worker, nworkers);
}

__device__ void rows_to_xb(const float* X, bf16_t* XB) {
    const int tid = tid_(), lane = tid & 63, wave = tid >> 6;
    for (int row = blockIdx.x * 8 + wave; row < M; row += gridDim.x * 8) {
        const float* xr = X + (size_t)row * DM;
        f32x4 v[4]; float ss = 0.f;
#pragma unroll
        for (int i = 0; i < 4; ++i) { v[i] = *(const f32x4*)(xr + i * 256 + lane * 4); ss += v[i][0] * v[i][0] + v[i][1] * v[i][1] + v[i][2] * v[i][2] + v[i][3] * v[i][3]; }
        ss = wave_sum(ss);
        const float rstd = rsqrtf(ss * (1.0f / DM) + RMS_EPS);
#pragma unroll
        for (int i = 0; i < 4; ++i) { uint2 w; w.x = pk2(v[i][0] * rstd, v[i][1] * rstd); w.y = pk2(v[i][2] * rstd, v[i][3] * rstd); *(uint2*)(XB + (size_t)row * DM + i * 256 + lane * 4) = w; }
    }
}

__device__ __forceinline__ bool defer_layer1_weights() { return gridDim.x >= BATCH * NH + 32; }
__device__ void phase_prologue(const Params& p, unsigned char* lds) {
    prep_weights(p, 0, lds, blockIdx.x, gridDim.x);
    if (!defer_layer1_weights()) for (int l = 1; l < DEPTH; ++l) prep_weights(p, l, lds, blockIdx.x, gridDim.x);
    rows_to_xb(p.in[0], (bf16_t*)(p.ws + WS_XB));
}

namespace pg8 {
#define PG8_LAS __attribute__((address_space(3)))
typedef unsigned short bf16_t;
typedef short bf16x8 __attribute__((ext_vector_type(8)));
typedef float f32x4 __attribute__((ext_vector_type(4)));
typedef unsigned u32x4 __attribute__((ext_vector_type(4)));
constexpr int BM = 256, BK = 64, HALF = 128, HTB = HALF * BK * 2  , STAGE_BYTES = 8 * HTB, NXCD = 8, WGM = 8;

__host__ __device__ __forceinline__ int lds_byte(int r, int c) { const int st = (r >> 4) * 2 + (c >> 5), rr = r & 15, cc = c & 31, ob = rr * 64 + cc * 2; return st * 1024 + (ob ^ (((ob >> 9) & 1) << 5)); }
__host__ __device__ __forceinline__ void stage_rc(int b, int& R, int& C) { const int st = b / 1024, sb = b % 1024, swz = sb ^ (((sb >> 9) & 1) << 5); R = (st >> 1) * 16 + swz / 64; C = (st & 1) * 32 + (swz % 64) / 2; }
__host__ __device__ __forceinline__ int perm32(int rho) { const int n = rho >> 4, i = rho & 15; return 8 * (i >> 2) + 4 * n + (i & 3); }

struct Unit { int pm, pn; };
struct Gemm { const bf16_t* A; const bf16_t* Bt; int M, N, K; };

struct StaticOrder {
    int nM, nN, nwg, G, c;
    __host__ __device__ void init(int M, int N, int G_, int c_) { nM = M / BM; nN = N / BM; nwg = nM * nN; G = G_; c = c_; }
    __host__ __device__ bool next(int i, Unit& u) const {
        const long L = (long)i * G + c; if (L >= nwg) return false;
        int wgid = (int)L; { const int q = nwg / NXCD, r = nwg % NXCD, xcd = wgid % NXCD, off = wgid / NXCD; wgid = (xcd < r ? xcd * (q + 1) : r * (q + 1) + (xcd - r) * q) + off; }
        const int nig = WGM * nN, gid = wgid / nig, fm = gid * WGM, gsz = (nM - fm) < WGM ? (nM - fm) : WGM;
        u.pm = fm + ((wgid % nig) % gsz); u.pn = (wgid % nig) / gsz; return true;
    }
    __device__ __forceinline__ void a_ready(const Unit&) const {}
    __device__ __forceinline__ void done(const Unit&) const {}
};


__device__ __forceinline__ unsigned cvt_pk_bf16(float lo, float hi) { unsigned r; asm volatile("v_cvt_pk_bf16_f32 %0, %1, %2" : "=v"(r) : "v"(lo), "v"(hi)); return r; }

template <class Epi, class Sched, bool ALIGN_EPI = false, bool SP2 = false>
__device__ __forceinline__ void gemm_phase(PG8_LAS unsigned char* lds, const Gemm g, const Sched& S, const Epi& E) {
    const int tid = tid_(), wid = __builtin_amdgcn_readfirstlane(tid >> 6), lane = tid & 63, wr = wid >> 2, wc = wid & 3, fr = lane & 15, fq = lane >> 4;
    const int K = g.K, nt = K / BK;
    unsigned voffA[2], voffB[2];
#pragma unroll
    for (int i = 0; i < 2; ++i) { int R, C; stage_rc(tid * 16 + i * 8192, R, C); const int Rb = Epi::PERM ? ((R & ~31) + perm32(R & 31)) : R;
        voffA[i] = (unsigned)(R * K + C) * 2u; voffB[i] = (unsigned)(Rb * K + C) * 2u; }
    const size_t kstep = (size_t)(BK * 2);
    const size_t hstep = (size_t)HALF * K * 2;
    const size_t tstep = 2 * hstep;
    const unsigned ldsw = (unsigned)wid * 1024u;
    const int aoff = lds_byte(wr * 64 + fr, fq * 8), boff = lds_byte(wc * 32 + fr, fq * 8);
#define PG8_SA(b, h) (((b) * 2 + (h)) * HTB)
#define PG8_SB(b, h) ((4 + (b) * 2 + (h)) * HTB)
#define PG8_STAGE(bufoff, gbase, voff) do { _Pragma("unroll") for (int _i = 0; _i < 2; ++_i) \
        __builtin_amdgcn_global_load_lds((const unsigned*)((const char*)(gbase) + (voff)[_i]), (PG8_LAS unsigned*)(lds + (bufoff) + ldsw + _i * 8192), 16, 0, 0); } while (0)
#define PG8_LDA(dst, b, h) do { _Pragma("unroll") for (int m = 0; m < 4; ++m) _Pragma("unroll") for (int k = 0; k < 2; ++k) dst[m][k] = *(const PG8_LAS bf16x8*)(lds + PG8_SA(b, h) + aoff + m * 2048 + k * 1024); } while (0)
#define PG8_LDB(dst, b, h) do { _Pragma("unroll") for (int n = 0; n < 2; ++n) _Pragma("unroll") for (int k = 0; k < 2; ++k) dst[n][k] = *(const PG8_LAS bf16x8*)(lds + PG8_SB(b, h) + boff + n * 2048 + k * 1024); } while (0)
#define PG8_MMA(ai, bj, At, Bt) do { __builtin_amdgcn_s_setprio(1); _Pragma("unroll") for (int m = 0; m < 4; ++m) _Pragma("unroll") for (int n = 0; n < 2; ++n) _Pragma("unroll") for (int k = 0; k < 2; ++k) \
        acc[ai][bj][m][n] = __builtin_amdgcn_mfma_f32_16x16x32_bf16(Bt[n][k], At[m][k], acc[ai][bj][m][n], 0, 0, 0); __builtin_amdgcn_s_setprio(0); } while (0)
#define PG8_WAIT_V(n) asm volatile("s_waitcnt vmcnt(" #n ")" ::: "memory")
#define PG8_WAIT_L(n) asm volatile("s_waitcnt lgkmcnt(" #n ")" ::: "memory")
#define PG8_BAR __builtin_amdgcn_s_barrier()
#define PG8_SCHED __builtin_amdgcn_sched_barrier(0)
    Unit cur, nxt; int ui = 0;
    if (!S.next(0, cur)) return;
    f32x4 acc[2][2][4][2];
#pragma unroll
    for (int a = 0; a < 2; ++a)
#pragma unroll
        for (int b = 0; b < 2; ++b)
#pragma unroll
            for (int m = 0; m < 4; ++m)
#pragma unroll
                for (int n = 0; n < 2; ++n) acc[a][b][m][n] = (f32x4){0.f, 0.f, 0.f, 0.f};
    bf16x8 At[4][2], B0[2][2], B1[2][2];
    const char* cA = (const char*)g.A + (size_t)cur.pm * tstep; const char* cB = (const char*)g.Bt + (size_t)cur.pn * tstep;
    S.a_ready(cur);
    if constexpr (SP2) {
        PG8_STAGE(PG8_SB(0, 0), cB, voffB); PG8_STAGE(PG8_SB(0, 1), cB + hstep, voffB); PG8_STAGE(PG8_SA(0, 0), cA, voffA); PG8_STAGE(PG8_SA(0, 1), cA + hstep, voffA);
        if (wr == 1) PG8_BAR;
        PG8_WAIT_V(2); PG8_BAR;
        PG8_STAGE(PG8_SB(1, 0), cB + kstep, voffB); PG8_STAGE(PG8_SA(1, 0), cA + kstep, voffA); PG8_STAGE(PG8_SB(1, 1), cB + hstep + kstep, voffB);
        PG8_WAIT_V(6); PG8_BAR;
    } else {
        PG8_STAGE(PG8_SB(0, 0), cB, voffB); PG8_STAGE(PG8_SA(0, 0), cA, voffA); PG8_STAGE(PG8_SB(0, 1), cB + hstep, voffB); PG8_STAGE(PG8_SA(0, 1), cA + hstep, voffA);
        if (wr == 1) PG8_BAR;
        PG8_WAIT_V(4); PG8_BAR;
        PG8_STAGE(PG8_SB(1, 0), cB + kstep, voffB); PG8_STAGE(PG8_SA(1, 0), cA + kstep, voffA); PG8_STAGE(PG8_SB(1, 1), cB + hstep + kstep, voffB);
        PG8_WAIT_V(6); PG8_BAR;
    }
    for (;;) {
        const bool has_next = S.next(ui + 1, nxt);
        const char* nA = has_next ? (const char*)g.A + (size_t)nxt.pm * tstep : cA; const char* nB = has_next ? (const char*)g.Bt + (size_t)nxt.pn * tstep : cB;
        for (int t = 0; t < nt; t += 2) {
            const bool last = (t == nt - 2);
            const char* a1 = cA + (size_t)(t + 1) * kstep;
            const char* a2 = last ? nA : cA + (size_t)(t + 2) * kstep; const char* b2 = last ? nB : cB + (size_t)(t + 2) * kstep;
            const char* a3 = a2 + kstep; const char* b3 = b2 + kstep;
            if (last && has_next) S.a_ready(nxt);
            if constexpr (SP2) {
            PG8_LDB(B0, 0, 0); PG8_LDB(B1, 0, 1); PG8_SCHED; PG8_LDA(At, 0, 0); PG8_STAGE(PG8_SA(1, 1), a1 + hstep, voffA);
            PG8_WAIT_V(8); PG8_WAIT_L(0); PG8_BAR; PG8_MMA(0, 0, At, B0); PG8_MMA(0, 1, At, B1); PG8_BAR; PG8_SCHED;
            PG8_LDA(At, 0, 1); PG8_STAGE(PG8_SB(0, 0), b2, voffB); PG8_STAGE(PG8_SB(0, 1), b2 + hstep, voffB); PG8_STAGE(PG8_SA(0, 0), a2, voffA);
            PG8_WAIT_V(8); PG8_WAIT_L(0); PG8_BAR; PG8_MMA(1, 0, At, B0); PG8_MMA(1, 1, At, B1); PG8_BAR; PG8_SCHED;
            PG8_LDB(B0, 1, 0); PG8_LDB(B1, 1, 1); PG8_SCHED; PG8_LDA(At, 1, 0); PG8_STAGE(PG8_SA(0, 1), a2 + hstep, voffA);
            PG8_WAIT_V(8); PG8_WAIT_L(0); PG8_BAR; PG8_MMA(0, 0, At, B0); PG8_MMA(0, 1, At, B1); PG8_BAR; PG8_SCHED;
            PG8_LDA(At, 1, 1); PG8_STAGE(PG8_SB(1, 0), b3, voffB); PG8_STAGE(PG8_SB(1, 1), b3 + hstep, voffB); PG8_STAGE(PG8_SA(1, 0), a3, voffA);
            PG8_WAIT_V(8); PG8_WAIT_L(0); PG8_BAR; PG8_MMA(1, 0, At, B0); PG8_MMA(1, 1, At, B1); PG8_BAR; PG8_SCHED;
            } else {
            PG8_LDB(B0, 0, 0); PG8_SCHED; PG8_LDA(At, 0, 0); PG8_STAGE(PG8_SA(1, 1), a1 + hstep, voffA);
            PG8_WAIT_L(8); PG8_BAR; PG8_WAIT_L(0); PG8_MMA(0, 0, At, B0); PG8_BAR; PG8_SCHED;
            PG8_LDB(B1, 0, 1); PG8_STAGE(PG8_SB(0, 0), b2, voffB);
            PG8_BAR; PG8_WAIT_L(0); PG8_MMA(0, 1, At, B1); PG8_BAR;
            PG8_LDA(At, 0, 1); PG8_STAGE(PG8_SA(0, 0), a2, voffA);
            PG8_BAR; PG8_WAIT_L(0); PG8_MMA(1, 0, At, B0); PG8_BAR; PG8_SCHED;
            PG8_STAGE(PG8_SB(0, 1), b2 + hstep, voffB);
            PG8_WAIT_V(6); PG8_BAR; PG8_MMA(1, 1, At, B1); PG8_BAR;
            PG8_LDB(B0, 1, 0); PG8_SCHED; PG8_LDA(At, 1, 0); PG8_STAGE(PG8_SA(0, 1), a2 + hstep, voffA);
            PG8_WAIT_L(8); PG8_BAR; PG8_WAIT_L(0); PG8_MMA(0, 0, At, B0); PG8_BAR; PG8_SCHED;
            PG8_LDB(B1, 1, 1); PG8_STAGE(PG8_SB(1, 0), b3, voffB);
            PG8_BAR; PG8_WAIT_L(0); PG8_MMA(0, 1, At, B1); PG8_BAR;
            PG8_LDA(At, 1, 1); PG8_STAGE(PG8_SA(1, 0), a3, voffA);
            PG8_BAR; PG8_WAIT_L(0); PG8_MMA(1, 0, At, B0); PG8_BAR; PG8_SCHED;
            PG8_STAGE(PG8_SB(1, 1), b3 + hstep, voffB);
            PG8_WAIT_V(6); PG8_BAR; PG8_MMA(1, 1, At, B1); PG8_BAR;
            }
        }
        if constexpr (ALIGN_EPI) { if (wr == 0) PG8_BAR; }
        if constexpr (!Epi::AFTER_DRAIN) { E(acc, cur, wr, wc, fr, fq); S.done(cur); }
        if (!has_next) break;
#pragma unroll
        for (int a = 0; a < 2; ++a)
#pragma unroll
            for (int b = 0; b < 2; ++b)
#pragma unroll
                for (int m = 0; m < 4; ++m)
#pragma unroll
                    for (int n = 0; n < 2; ++n) acc[a][b][m][n] = (f32x4){0.f, 0.f, 0.f, 0.f};
        cur = nxt; cA = nA; cB = nB; ++ui;
        if constexpr (ALIGN_EPI) { if (wr == 1) PG8_BAR; }
    }
    PG8_WAIT_V(0);
    if constexpr (!ALIGN_EPI) { if (wr == 0) PG8_BAR; }
    PG8_BAR;
    if constexpr (Epi::AFTER_DRAIN) { E.fused(acc, cur, wr, wc, fr, fq, lds, wid, lane); S.done(cur); }
#undef PG8_SA
#undef PG8_SB
#undef PG8_STAGE
#undef PG8_LDA
#undef PG8_LDB
#undef PG8_MMA
#undef PG8_WAIT_V
#undef PG8_WAIT_L
#undef PG8_BAR
#undef PG8_SCHED
}
}

struct EpiInProjP {
    static constexpr bool PERM = true, AFTER_DRAIN = false;
    bf16_t *PC, *PS, *PR, *PG, *VT;
    __device__ __forceinline__ void operator()(const pg8::f32x4 (&acc)[2][2][4][2], const pg8::Unit& u, int wr, int wc, int fr, int fq) const {
        const int row0 = u.pm * 256 + wr * 64 + fr;
#pragma unroll
        for (int bj = 0; bj < 2; ++bj) {
            const int blk = 2 * u.pn + bj; bf16_t* base; int ld, c0;
            if (blk >= 12 && blk < 15) {
                const int vc = 128 * (blk - 12) + wc * 32 + 8 * fq;
#pragma unroll
                for (int ai = 0; ai < 2; ++ai)
#pragma unroll
                    for (int m = 0; m < 4; ++m) {
                        const int row = row0 + ai * 128 + m * 16, b = row >> 11, t = row & 2047;
#pragma unroll
                        for (int n = 0; n < 2; ++n)
#pragma unroll
                            for (int e = 0; e < 4; ++e) { const int col = vc + 4 * n + e, hh = col >> 6, d = col & 63;
                                VT[((size_t)(b * NH + hh) * HD + d) * SEQ + t] = f2bf(acc[ai][bj][m][n][e]); }
                    }
                continue;
            }
            if (blk < 6) { base = PC; ld = PC_W; c0 = 128 * blk; }
            else if (blk < 12) { base = PS; ld = PS_W; c0 = 128 * (blk - 6); }
            else if (blk < 18) { base = PS; ld = PS_W; c0 = 768 + 128 * (blk - 15); }
            else if (blk < 28) { base = PR; ld = PR_W; c0 = 128 * (blk - 18); }
            else if (blk < 31) { base = PG; ld = PG_W; c0 = 128 * (blk - 28); }
            else continue;
            const int col = c0 + wc * 32 + 8 * fq;
#pragma unroll
            for (int ai = 0; ai < 2; ++ai)
#pragma unroll
                for (int m = 0; m < 4; ++m) {
                    const pg8::f32x4 v0 = acc[ai][bj][m][0], v1 = acc[ai][bj][m][1]; pg8::u32x4 w;
                    w.x = pg8::cvt_pk_bf16(v0[0], v0[1]); w.y = pg8::cvt_pk_bf16(v0[2], v0[3]); w.z = pg8::cvt_pk_bf16(v1[0], v1[1]); w.w = pg8::cvt_pk_bf16(v1[2], v1[3]);
                    *(pg8::u32x4*)(base + (size_t)(row0 + ai * 128 + m * 16) * ld + col) = w;
                }
        }
    }
};
struct EpiOutBf16P {
    static constexpr bool PERM = true, AFTER_DRAIN = false;
    bf16_t* Y; int ld;
    __device__ __forceinline__ void operator()(const pg8::f32x4 (&acc)[2][2][4][2], const pg8::Unit& u, int wr, int wc, int fr, int fq) const {
        const int row0 = u.pm * 256 + wr * 64 + fr, col0 = u.pn * 256 + wc * 32 + 8 * fq;
#pragma unroll
        for (int ai = 0; ai < 2; ++ai)
#pragma unroll
            for (int m = 0; m < 4; ++m)
#pragma unroll
                for (int bj = 0; bj < 2; ++bj) {
                    const pg8::f32x4 v0 = acc[ai][bj][m][0], v1 = acc[ai][bj][m][1]; pg8::u32x4 w;
                    w.x = pg8::cvt_pk_bf16(v0[0], v0[1]); w.y = pg8::cvt_pk_bf16(v0[2], v0[3]); w.z = pg8::cvt_pk_bf16(v1[0], v1[1]); w.w = pg8::cvt_pk_bf16(v1[2], v1[3]);
                    *(pg8::u32x4*)(Y + (size_t)(row0 + ai * 128 + m * 16) * ld + col0 + bj * 128) = w;
                }
    }
};

__device__ void phase_rowpass(const float* Xin, const bf16_t* Y, const float* gpost, float* Xout, bf16_t* XB) {
    const int tid = tid_(), lane = tid & 63, wave = tid >> 6;
    for (int row = blockIdx.x * 8 + wave; row < M; row += gridDim.x * 8) {
        f32x4 y[4], x[4]; float ss = 0.f;
#pragma unroll
        for (int i = 0; i < 4; ++i) { const uint2 yw = *(const uint2*)(Y + (size_t)row * DM + i * 256 + lane * 4);
            y[i] = (f32x4){bf2f((bf16_t)(yw.x & 0xffff)), bf2f((bf16_t)(yw.x >> 16)), bf2f((bf16_t)(yw.y & 0xffff)), bf2f((bf16_t)(yw.y >> 16))};
            x[i] = *(const f32x4*)(Xin + (size_t)row * DM + i * 256 + lane * 4);
            ss += y[i][0] * y[i][0] + y[i][1] * y[i][1] + y[i][2] * y[i][2] + y[i][3] * y[i][3]; }
        ss = wave_sum(ss);
        const float rstd = rsqrtf(ss * (1.0f / DM) + RMS_EPS);
        float s2 = 0.f;
#pragma unroll
        for (int i = 0; i < 4; ++i) { const f32x4 g = *(const f32x4*)(gpost + i * 256 + lane * 4);
            x[i] = x[i] + y[i] * rstd * g; s2 += x[i][0] * x[i][0] + x[i][1] * x[i][1] + x[i][2] * x[i][2] + x[i][3] * x[i][3];
            *(f32x4*)(Xout + (size_t)row * DM + i * 256 + lane * 4) = x[i]; }
        if (XB) {
            s2 = wave_sum(s2);
            const float r2 = rsqrtf(s2 * (1.0f / DM) + RMS_EPS);
#pragma unroll
            for (int i = 0; i < 4; ++i) { uint2 w; w.x = pk2(x[i][0] * r2, x[i][1] * r2); w.y = pk2(x[i][2] * r2, x[i][3] * r2); *(uint2*)(XB + (size_t)row * DM + i * 256 + lane * 4) = w; }
        }
    }
}

__device__ void conv_job(const Params& p, int l, int job, float* lds) {
    const int tid = tid_(), lane = tid & 63, wave = tid >> 6;
    const int b = job / (SEQ / 32), t0 = (job % (SEQ / 32)) * 32;
    const bf16_t* PC = (const bf16_t*)(p.ws + WS_PC); bf16_t* MIX = (bf16_t*)(p.ws + WS_MIX);
    const float* dw = p.in[5] + l * TAPS * CW; const float* dwb = p.in[6] + l * CW; const float* lng = p.in[7] + l * CW; const float* lnb = p.in[8] + l * CW;
    const float* pw = p.in[9] + (size_t)l * CW * CW; const float* pwb = p.in[10] + l * CW;
    float* u = lds;
    float* cv = lds + 62 * 256;
    for (int idx = tid; idx < 62 * 256; idx += 512) {
        const int r = idx >> 8, c = idx & 255, t = t0 - 30 + r;
        float v = 0.f;
        if (t >= 0) { const bf16_t* pr = PC + (size_t)(b * SEQ + t) * PC_W; v = bf2f(pr[c]) * sigmoidf_(bf2f(pr[256 + c])); }
        u[idx] = v;
    }
    __syncthreads();
    for (int idx = tid; idx < 32 * 256; idx += 512) {
        const int tt = idx >> 8, c = idx & 255;
        float a = dwb[c];
#pragma unroll 4
        for (int j = 0; j < TAPS; ++j) a += dw[j * CW + c] * u[(tt + j) * 256 + c];
        cv[idx] = a;
    }
    __syncthreads();
    for (int q = 0; q < 4; ++q) {
        const int tt = wave * 4 + q; float x[4], s = 0.f;
#pragma unroll
        for (int i = 0; i < 4; ++i) { x[i] = cv[tt * 256 + lane + 64 * i]; s += x[i]; }
        const float mean = wave_sum(s) * (1.0f / CW); float vs = 0.f;
#pragma unroll
        for (int i = 0; i < 4; ++i) { const float d = x[i] - mean; vs += d * d; }
        const float rstd = rsqrtf(wave_sum(vs) * (1.0f / CW) + LN_EPS);
#pragma unroll
        for (int i = 0; i < 4; ++i) { const int c = lane + 64 * i; cv[tt * 256 + c] = siluf_((x[i] - mean) * rstd * lng[c] + lnb[c]); }
    }
    __syncthreads();
    {
        const int n = tid & 255, half = tid >> 8;
        float acc[16];
#pragma unroll
        for (int i = 0; i < 16; ++i) acc[i] = pwb[n];
#pragma unroll 2
        for (int k = 0; k < CW; ++k) {
            const float w = pw[(size_t)k * CW + n];
#pragma unroll
            for (int i = 0; i < 16; ++i) acc[i] += cv[(half * 16 + i) * 256 + k] * w;
        }
#pragma unroll
        for (int i = 0; i < 16; ++i) { const size_t row = (size_t)b * SEQ + t0 + half * 16 + i;
            const float g = bf2f(PC[row * PC_W + 512 + n]);
            MIX[row * DM + n] = f2bf(acc[i] * siluf_(g)); }
    }
    __syncthreads();
}

constexpr int CV_AS = 264;
__device__ void conv_job64(const Params& p, int l, int job, unsigned char* lds) {
    const int tid = tid_(), lane = tid & 63, wave = tid >> 6, fr = lane & 15, fq = lane >> 4;
    const int b = job >> 5, t0 = (job & 31) * 64;
    const bf16_t* PC = (const bf16_t*)(p.ws + WS_PC); bf16_t* MIX = (bf16_t*)(p.ws + WS_MIX);
    const float* dw = p.in[5] + l * TAPS * CW; const float* dwb = p.in[6] + l * CW; const float* lng = p.in[7] + l * CW; const float* lnb = p.in[8] + l * CW;
    const bf16_t* pwT = (const bf16_t*)(p.ws + WS_WPW) + (size_t)l * CW * CW; const float* pwb = p.in[10] + l * CW;
    float* u = (float*)lds;
    bf16_t* act = (bf16_t*)(lds + 94 * 256 * 4);
    for (int idx = tid; idx < 94 * 32; idx += 512) {
        const int r = idx >> 5, c8 = (idx & 31) * 8, t = t0 - 30 + r;
        float v[8];
        if (t >= 0) { const bf16_t* pr = PC + ((size_t)b * SEQ + t) * PC_W + c8; const bf16x8 a = *(const bf16x8*)pr, g = *(const bf16x8*)(pr + 256);
#pragma unroll
            for (int e = 0; e < 8; ++e) v[e] = bf2f((bf16_t)a[e]) * __builtin_amdgcn_rcpf(1.0f + __builtin_amdgcn_exp2f(-1.4426950408889634f * bf2f((bf16_t)g[e]))); }
        else {
#pragma unroll
            for (int e = 0; e < 8; ++e) v[e] = 0.f; }
        *(f32x4*)(u + r * 256 + c8) = (f32x4){v[0], v[1], v[2], v[3]}; *(f32x4*)(u + r * 256 + c8 + 4) = (f32x4){v[4], v[5], v[6], v[7]};
    }
    __syncthreads();
    const int c = tid & 255, half = tid >> 8;
    float acc[32];
    {
        float w[TAPS];
#pragma unroll
        for (int j = 0; j < TAPS; ++j) w[j] = dw[j * CW + c];
        const float bias = dwb[c];
#pragma unroll
        for (int i = 0; i < 32; ++i) acc[i] = bias;
        const float* up = u + (half * 32) * 256 + c;
#pragma unroll
        for (int rr = 0; rr < 62; ++rr) {
            const float uv = up[rr * 256];
#pragma unroll
            for (int i = 0; i < 32; ++i) { if (rr - i >= 0 && rr - i < TAPS) acc[i] += w[rr - i] * uv; }
        }
    }
    __syncthreads();
    float* cv = u;
#pragma unroll
    for (int i = 0; i < 32; ++i) cv[(half * 32 + i) * 256 + c] = acc[i];
    __syncthreads();
#pragma unroll 2
    for (int q = 0; q < 8; ++q) {
        const int tt = wave * 8 + q; const f32x4 x = *(const f32x4*)(cv + tt * 256 + lane * 4);
        const float mean = wave_sum(x[0] + x[1] + x[2] + x[3]) * (1.0f / CW);
        const f32x4 d = x - mean;
        const float rstd = rsqrtf(wave_sum(d[0] * d[0] + d[1] * d[1] + d[2] * d[2] + d[3] * d[3]) * (1.0f / CW) + LN_EPS);
        const f32x4 g = *(const f32x4*)(lng + lane * 4), bb = *(const f32x4*)(lnb + lane * 4);
        float y[4];
#pragma unroll
        for (int e = 0; e < 4; ++e) { const float v = d[e] * rstd * g[e] + bb[e]; y[e] = v * __builtin_amdgcn_rcpf(1.0f + __builtin_amdgcn_exp2f(-1.4426950408889634f * v)); }
        uint2 w; w.x = pk2(y[0], y[1]); w.y = pk2(y[2], y[3]); *(uint2*)(act + tt * CV_AS + lane * 4) = w;
    }
    __syncthreads();
    {
        f32x4 o[2][4];
#pragma unroll
        for (int i = 0; i < 2; ++i)
#pragma unroll
            for (int j = 0; j < 4; ++j) o[i][j] = (f32x4){0.f, 0.f, 0.f, 0.f};
#pragma unroll 2
        for (int kk = 0; kk < 8; ++kk) {
            bf16x8 a[2], bq[4];
#pragma unroll
            for (int i = 0; i < 2; ++i) a[i] = *(const bf16x8*)(pwT + (size_t)(wave * 32 + i * 16 + fr) * CW + kk * 32 + fq * 8);
#pragma unroll
            for (int j = 0; j < 4; ++j) bq[j] = *(const bf16x8*)(act + (j * 16 + fr) * CV_AS + kk * 32 + fq * 8);
#pragma unroll
            for (int i = 0; i < 2; ++i)
#pragma unroll
                for (int j = 0; j < 4; ++j) o[i][j] = __builtin_amdgcn_mfma_f32_16x16x32_bf16(a[i], bq[j], o[i][j], 0, 0, 0);
        }
#pragma unroll
        for (int i = 0; i < 2; ++i) {
            const int n0 = wave * 32 + i * 16 + fq * 4; const f32x4 bias = *(const f32x4*)(pwb + n0);
#pragma unroll
            for (int j = 0; j < 4; ++j) {
                const size_t row = (size_t)b * SEQ + t0 + j * 16 + fr;
                const uint2 gw = *(const uint2*)(PC + row * PC_W + 512 + n0);
                const float g0 = bf2f((bf16_t)(gw.x & 0xffff)), g1 = bf2f((bf16_t)(gw.x >> 16)), g2 = bf2f((bf16_t)(gw.y & 0xffff)), g3 = bf2f((bf16_t)(gw.y >> 16));
                const f32x4 v = o[i][j] + bias;
                uint2 w; w.x = pk2(v[0] * siluf_(g0), v[1] * siluf_(g1)); w.y = pk2(v[2] * siluf_(g2), v[3] * siluf_(g3));
                *(uint2*)(MIX + row * DM + n0) = w;
            }
        }
    }
    __syncthreads();
}

__device__ void attn_job(const Params& p, int job) {
    const int tid = tid_(), lane = tid & 63, wave = tid >> 6;
    const int bh = job >> 2, qb = job & 3, b = bh / NH, h = bh % NH;
    const bf16_t* PS = (const bf16_t*)(p.ws + WS_PS); bf16_t* MIX = (bf16_t*)(p.ws + WS_MIX);
    const int tw = qb * 512 + wave * 64, t = tw + lane;
    const size_t row = (size_t)b * SEQ + t;
    const float qs = 1.0f;
    const bf16_t* VT = (const bf16_t*)(p.ws + WS_VT) + (size_t)bh * HD * SEQ;
    float q[64], o[64];
    {
        const bf16_t* qp = PS + row * PS_W + h * HD;
#pragma unroll
        for (int i = 0; i < 8; ++i) { const bf16x8 v = *(const bf16x8*)(qp + i * 8);
#pragma unroll
            for (int j = 0; j < 8; ++j) { q[i * 8 + j] = bf2f((bf16_t)v[j]) * qs; o[i * 8 + j] = 0.f; } }
    }
    float rp = 1.0f;
    const int z = opaque_zero();
    for (int s = tw + 62; s >= 0; --s) {
        const bf16_t* kp = PS + ((size_t)b * SEQ + s) * PS_W + 384 + h * HD + z;
        float dot = 0.f;
#pragma unroll
        for (int i = 0; i < 8; ++i) { const bf16x8 v = *(const bf16x8*)(kp + i * 8);
#pragma unroll
            for (int j = 0; j < 8; ++j) dot += q[i * 8 + j] * bf2f((bf16_t)v[j]); }
        const bool act = s < t;
        const float e = __builtin_amdgcn_exp2f(dot);
        const float keep = __builtin_amdgcn_rcpf(1.0f + e);
        const float pr = act ? (1.0f - keep) * rp : 0.f;
        rp = act ? rp * keep : rp;
#pragma unroll
        for (int d = 0; d < 64; ++d) o[d] += pr * bf2f(VT[(size_t)d * SEQ + s + z]);
        if (__all(rp == 0.0f)) break;
    }
    const bf16_t* gp = PS + row * PS_W + 768 + h * HD;
    bf16_t* op = MIX + row * DM + CW + h * HD;
#pragma unroll
    for (int i = 0; i < 8; ++i) { const bf16x8 g = *(const bf16x8*)(gp + i * 8); uint4 w;
        w.x = pk2(o[i * 8 + 0] * siluf_(bf2f((bf16_t)g[0])), o[i * 8 + 1] * siluf_(bf2f((bf16_t)g[1])));
        w.y = pk2(o[i * 8 + 2] * siluf_(bf2f((bf16_t)g[2])), o[i * 8 + 3] * siluf_(bf2f((bf16_t)g[3])));
        w.z = pk2(o[i * 8 + 4] * siluf_(bf2f((bf16_t)g[4])), o[i * 8 + 5] * siluf_(bf2f((bf16_t)g[5])));
        w.w = pk2(o[i * 8 + 6] * siluf_(bf2f((bf16_t)g[6])), o[i * 8 + 7] * siluf_(bf2f((bf16_t)g[7])));
        *(uint4*)(op + i * 8) = w; }
}

typedef float f32x16 __attribute__((ext_vector_type(16)));
__device__ void attn_mfma_wave(const Params& p, int bh, int qblk) {
    const int tid = tid_(), lane = tid & 63, qi = lane & 31, hf = lane >> 5;
    const int b = bh / NH, h = bh % NH, q0 = qblk * 32;
    const bf16_t* PS = (const bf16_t*)(p.ws + WS_PS); const bf16_t* VT = (const bf16_t*)(p.ws + WS_VT) + (size_t)bh * HD * SEQ; bf16_t* MIX = (bf16_t*)(p.ws + WS_MIX);
    const size_t rowq = (size_t)b * SEQ + q0 + qi;
    bf16x8 Qf[4];
#pragma unroll
    for (int ks = 0; ks < 4; ++ks) Qf[ks] = *(const bf16x8*)(PS + rowq * PS_W + h * HD + ks * 16 + hf * 8);
    const int pi = (qi & 3) + 4 * (qi >> 3) + 16 * ((qi >> 2) & 1);
    const bf16_t* kbase = PS + ((size_t)b * SEQ + pi) * PS_W + SBW + h * HD + hf * 8;
    const bf16_t* vbase = VT + (size_t)qi * SEQ + hf * 16;
    f32x16 O0, O1;
#pragma unroll
    for (int r = 0; r < 16; ++r) { O0[r] = 0.f; O1[r] = 0.f; }
    float rp = 1.0f;
    for (int kt = qblk; kt >= 0; --kt) {
        const int s0 = kt * 32;
        bf16x8 Kf[4], Vf[2][2];
#pragma unroll
        for (int ks = 0; ks < 4; ++ks) Kf[ks] = *(const bf16x8*)(kbase + (size_t)s0 * PS_W + ks * 16);
#pragma unroll
        for (int db = 0; db < 2; ++db)
#pragma unroll
            for (int s = 0; s < 2; ++s) Vf[db][s] = *(const bf16x8*)(vbase + (size_t)db * 32 * SEQ + s0 + s * 8);
        f32x16 S;
#pragma unroll
        for (int r = 0; r < 16; ++r) S[r] = 0.f;
#pragma unroll
        for (int ks = 0; ks < 4; ++ks) S = __builtin_amdgcn_mfma_f32_32x32x16_bf16(Kf[ks], Qf[ks], S, 0, 0, 0);
        float keep[16], beta[16];
        const bool diag = kt == qblk;
        float tot = 1.0f;
#pragma unroll
        for (int r = 0; r < 16; ++r) {
            const float e = __builtin_amdgcn_exp2f(S[r]);
            float k_ = __builtin_amdgcn_rcpf(1.0f + e);
            float b_ = 1.0f - k_;
            if (diag && (hf * 16 + r >= qi)) { k_ = 1.0f; b_ = 0.f; }
            keep[r] = k_; beta[r] = b_; tot *= k_;
        }
        const float toto = __shfl_xor(tot, 32);
        float e = hf ? rp : rp * toto;
        float pw[16];
#pragma unroll
        for (int r = 15; r >= 0; --r) { pw[r] = beta[r] * e; e *= keep[r]; }
        rp = rp * tot * toto;
        bf16x8 Pf[2];
#pragma unroll
        for (int s = 0; s < 2; ++s) {
            union { bf16x8 v; unsigned u[4]; } pk;
#pragma unroll
            for (int j = 0; j < 4; ++j) pk.u[j] = pk2(pw[8 * s + 2 * j], pw[8 * s + 2 * j + 1]);
            Pf[s] = pk.v;
        }
#pragma unroll
        for (int s = 0; s < 2; ++s) { O0 = __builtin_amdgcn_mfma_f32_32x32x16_bf16(Vf[0][s], Pf[s], O0, 0, 0, 0); O1 = __builtin_amdgcn_mfma_f32_32x32x16_bf16(Vf[1][s], Pf[s], O1, 0, 0, 0); }
        if (__ballot(rp != 0.0f) == 0ull) break;
    }
    const bf16_t* gp = PS + rowq * PS_W + 768 + h * HD; bf16_t* op = MIX + rowq * DM + CW + h * HD;
#pragma unroll
    for (int db = 0; db < 2; ++db)
#pragma unroll
        for (int g = 0; g < 4; ++g) {
            const int d0 = db * 32 + g * 8 + hf * 4;
            const uint2 gw = *(const uint2*)(gp + d0);
            const float g0 = bf2f((bf16_t)(gw.x & 0xffff)), g1 = bf2f((bf16_t)(gw.x >> 16)), g2 = bf2f((bf16_t)(gw.y & 0xffff)), g3 = bf2f((bf16_t)(gw.y >> 16));
            const f32x16& O = db ? O1 : O0;
            uint2 w; w.x = pk2(O[4 * g] * siluf_(g0), O[4 * g + 1] * siluf_(g1)); w.y = pk2(O[4 * g + 2] * siluf_(g2), O[4 * g + 3] * siluf_(g3));
            *(uint2*)(op + d0) = w;
        }
}

__device__ void rwkv_job(const Params& p, int l, int job, float* lds) {
    const int tid = tid_(), lane = tid & 63, wave = tid >> 6;
    const int b = job / NH, h = job % NH;
    const bf16_t* PR = (const bf16_t*)(p.ws + WS_PR); const bf16_t* PG = (const bf16_t*)(p.ws + WS_PG);
    float* VF = (float*)(p.ws + WS_VF); bf16_t* MIX = (bf16_t*)(p.ws + WS_MIX);
    const float* mu = p.in[11] + l * 1216; const float* w0 = p.in[12] + l * RWW; const float* w2 = p.in[13] + l * LORA * RWW;
    const float* a0 = p.in[14] + l * RWW; const float* a2 = p.in[15] + l * LORA * RWW; const float* kks = p.in[16] + l * RWW; const float* ka = p.in[17] + l * RWW;
    const float* rk = p.in[18] + l * RWW; const float* gng = p.in[19] + l * RWW; const float* gnb = p.in[20] + l * RWW;
    const float* v0 = p.in[21]; const float* v1 = p.in[22]; const float* v2 = p.in[23];
    float* R = lds; float* W = R + 4096; float* K = W + 4096; float* V = K + 4096; float* A = V + 4096; float* Bm = A + 4096; float* Y = Bm + 4096;
    float* WD = Y + 4096; float* AD = WD + 2048; float* VL = AD + 2048;
    float S[64];
#pragma unroll
    for (int i = 0; i < 64; ++i) S[i] = 0.f;
    for (int c = 0; c < SEQ / 64; ++c) {
        const int t0 = c * 64;
        for (int idx = tid; idx < 64 * 64; idx += 512) {
            const int tt = idx >> 6, i = idx & 63, t = t0 + tt;
            const bf16_t* cur = PR + ((size_t)b * SEQ + t) * PR_W;
            const float xc = bf2f(cur[1152 + i]), xp = t > 0 ? bf2f(cur[1152 + i - PR_W]) : 0.f;
            const float f = xc + (xp - xc) * mu[1152 + i];
            if (i < 32) WD[tt * 32 + i] = tanhf(f); else AD[tt * 32 + i - 32] = f;
        }
        if (l > 0) {
            for (int idx = tid; idx < 64 * 32; idx += 512) {
                const int tt = idx >> 5, i = idx & 31, t = t0 + tt;
                const bf16_t* cur = PR + ((size_t)b * SEQ + t) * PR_W + 768;
                float a = 0.f;
                for (int cc = 0; cc < RWW; ++cc) {
                    const float xc = bf2f(cur[cc]), xp = t > 0 ? bf2f(cur[cc - PR_W]) : 0.f;
                    a += (xc + (xp - xc) * mu[768 + cc]) * v1[cc * LORA + i];
                }
                VL[idx] = a;
            }
        }
        __syncthreads();
        for (int idx = tid; idx < 64 * 64; idx += 512) {
            const int tt = idx >> 6, j = idx & 63, t = t0 + tt, cj = h * HD + j;
            const size_t row = (size_t)b * SEQ + t;
            const bf16_t* cur = PR + row * PR_W;
            const bool hp = t > 0;
            float rc = bf2f(cur[cj]), kc = bf2f(cur[384 + cj]), vc = bf2f(cur[768 + cj]);
            const float rp_ = hp ? bf2f(cur[cj - PR_W]) : 0.f, kp_ = hp ? bf2f(cur[384 + cj - PR_W]) : 0.f, vp_ = hp ? bf2f(cur[768 + cj - PR_W]) : 0.f;
            rc += (rp_ - rc) * mu[cj]; kc += (kp_ - kc) * mu[384 + cj]; vc += (vp_ - vc) * mu[768 + cj];
            float wl = w0[cj], al = a0[cj];
#pragma unroll 8
            for (int i = 0; i < LORA; ++i) { wl += WD[tt * 32 + i] * w2[i * RWW + cj]; al += AD[tt * 32 + i] * a2[i * RWW + cj]; }
            const float sp = fmaxf(-wl, 0.f) + log1pf(__expf(-fabsf(wl)));
            const float decay = __expf(-__expf(-sp - 0.5f));
            const float alr = sigmoidf_(al);
            if (l > 0) {
                float vg = v0[cj];
#pragma unroll 8
                for (int i = 0; i < LORA; ++i) vg += VL[tt * 32 + i] * v2[i * RWW + cj];
                vg = sigmoidf_(vg);
                vc = vc + (VF[row * RWW + cj] - vc) * vg;
            } else VF[row * RWW + cj] = vc;
            R[idx] = rc; W[idx] = decay; V[idx] = vc;
            K[idx] = kc * (1.0f + (alr - 1.0f) * ka[cj]);
            A[idx] = kc * kks[cj];
            Bm[idx] = alr;
        }
        __syncthreads();
        for (int q = 0; q < 8; ++q) {
            const int tt = wave * 8 + q; const float kk = A[tt * 64 + lane];
            const float nrm = sqrtf(wave_sum(kk * kk));
            const float kn = kk / fmaxf(nrm, 1e-12f);
            A[tt * 64 + lane] = -kn; Bm[tt * 64 + lane] = kn * Bm[tt * 64 + lane];
        }
        __syncthreads();
        if (wave == 0) {
            for (int tt = 0; tt < 64; ++tt) {
                const f32x4* a4 = (const f32x4*)(A + tt * 64); const f32x4* w4 = (const f32x4*)(W + tt * 64); const f32x4* b4 = (const f32x4*)(Bm + tt * 64);
                const f32x4* k4 = (const f32x4*)(K + tt * 64); const f32x4* r4 = (const f32x4*)(R + tt * 64);
                float sa = 0.f;
#pragma unroll
                for (int i = 0; i < 16; ++i) { const f32x4 a = a4[i]; sa += S[4 * i] * a[0] + S[4 * i + 1] * a[1] + S[4 * i + 2] * a[2] + S[4 * i + 3] * a[3];
                    if ((i & 7) == 7) asm volatile("" ::: "memory"); }
                const float vv = V[tt * 64 + lane];
                float y = 0.f;
#pragma unroll
                for (int i = 0; i < 16; ++i) { const f32x4 w = w4[i], bb = b4[i], kk = k4[i], rr = r4[i];
#pragma unroll
                    for (int e = 0; e < 4; ++e) { const float s = S[4 * i + e] * w[e] + sa * bb[e] + vv * kk[e]; S[4 * i + e] = s; y += s * rr[e]; }
                    if ((i & 1) == 1) asm volatile("" ::: "memory"); }
                Y[tt * 64 + lane] = y;
            }
        }
        __syncthreads();
        for (int q = 0; q < 8; ++q) {
            const int tt = wave * 8 + q, t = t0 + tt, cj = h * HD + lane; const size_t row = (size_t)b * SEQ + t;
            const float y = Y[tt * 64 + lane];
            const float mean = wave_sum(y) * (1.0f / HD); const float d = y - mean;
            const float var = wave_sum(d * d) * (1.0f / HD);
            const float yn = d * rsqrtf(var + GN_EPS) * gng[cj] + gnb[cj];
            const float bonus = wave_sum(R[tt * 64 + lane] * K[tt * 64 + lane] * rk[cj]);
            const float o = yn + bonus * V[tt * 64 + lane];
            const float g = bf2f(PG[row * PG_W + cj]);
            MIX[row * DM + CW + SBW + cj] = f2bf(o * siluf_(g));
        }
        __syncthreads();
    }
}

constexpr int TS = 72;
constexpr int TILE_B = 64 * TS * 2;
constexpr int AABS = 68, XTS = 65, CSS = 65;

__device__ __forceinline__ f32x4 mm_tile(const bf16_t* X, int m0, const bf16_t* Yt, int n0, int K, int fr, int fq, f32x4 acc) {
#pragma unroll
    for (int kk = 0; kk < 2; ++kk) {
        if (kk * 32 < K) {
            const bf16x8 a = *(const bf16x8*)(X + (m0 + fr) * TS + kk * 32 + fq * 8);
            const bf16x8 b = *(const bf16x8*)(Yt + (n0 + fr) * TS + kk * 32 + fq * 8);
            acc = __builtin_amdgcn_mfma_f32_16x16x32_bf16(a, b, acc, 0, 0, 0);
        }
    }
    return acc;
}
__device__ __forceinline__ uint2 pk4(const f32x4& v) { uint2 w; w.x = pk2(v[0], v[1]); w.y = pk2(v[2], v[3]); return w; }

struct B1Loads {
    bf16x8 rc, kc, vc, rp, kp, vp;
    f32x4 vf0, vf1;
    bf16x8 cc[2], cp[2];
};
__device__ __forceinline__ void b1_issue_loads(const Params& p, int l, int jb, int tid, B1Loads& L) {
    const int lane = tid & 63, wave = tid >> 6, fr = lane & 15, fq = lane >> 4;
    const int bh = jb >> 5, c = jb & 31, b = bh / NH, h = bh % NH, t0 = c * 64;
    const bf16_t* PR = (const bf16_t*)(p.ws + WS_PR); const float* VF = (const float*)(p.ws + WS_VF);
    {
        const int tt = tid >> 3, j0 = (tid & 7) * 8, t = t0 + tt, cj0 = h * HD + j0; const size_t row = (size_t)b * SEQ + t;
        const bf16_t* cur = PR + row * PR_W; const bf16_t* prv = cur - (t > 0 ? PR_W : 0);
        L.rc = *(const bf16x8*)(cur + cj0); L.kc = *(const bf16x8*)(cur + 384 + cj0); L.vc = *(const bf16x8*)(cur + 768 + cj0);
        L.rp = *(const bf16x8*)(prv + cj0); L.kp = *(const bf16x8*)(prv + 384 + cj0); L.vp = *(const bf16x8*)(prv + 768 + cj0);
        if (l > 0) { L.vf0 = *(const f32x4*)(VF + row * RWW + cj0); L.vf1 = *(const f32x4*)(VF + row * RWW + cj0 + 4); }
    }
#pragma unroll
    for (int q = 0; q < 2; ++q) {
        const int item = tid + 512 * q, tt = item >> 4, g = item & 15, t = t0 + tt;
        const bf16_t* cur = PR + ((size_t)b * SEQ + t) * PR_W + 1152; const bf16_t* prv = cur - (t > 0 ? PR_W : 0);
        const int gc = g < 12 ? g : 0, gp = g < 8 ? g : (g < 12 ? g + 4 : 0);
        L.cc[q] = *(const bf16x8*)(cur + 8 * gc); L.cp[q] = *(const bf16x8*)(prv + 8 * gp);
    }
}

__device__ void rwkv_b1_phase(const Params& p, int l, unsigned char* lds) {
    const int G = gridDim.x;
    float* VF = (float*)(p.ws + WS_VF);
    const float* mu = p.in[11] + l * 1216; const float* w0 = p.in[12] + l * RWW;
    const float* a0 = p.in[14] + l * RWW; const float* kks = p.in[16] + l * RWW; const float* ka = p.in[17] + l * RWW;
    const float* rk = p.in[18] + l * RWW; const float* v0 = p.in[21];
    const float* w2 = p.in[13] + l * LORA * RWW; const float* a2 = p.in[15] + l * LORA * RWW; const float* v2 = p.in[23];
    bf16_t* T_At = (bf16_t*)lds; bf16_t* T_Rt = T_At + 64 * TS; bf16_t* T_Bt = T_Rt + 64 * TS; bf16_t* T_Kt = T_Bt + 64 * TS;
    bf16_t* T_VT = T_Kt + 64 * TS; bf16_t* T_bhT = T_VT + 64 * TS; bf16_t* T_khT = T_bhT + 64 * TS;
    bf16_t* T_Aak = T_khT + 64 * TS; bf16_t* T_Arb = T_Aak + 64 * TS; bf16_t* T_Ark = T_Arb + 64 * TS;
    bf16_t* T_WT = T_At; bf16_t* T_U0T = T_Bt;
    float* Aab = (float*)(lds + 10 * TILE_B);
    float* XT = (float*)(lds + 10 * TILE_B + 64 * AABS * 4);
    float* PCv = XT + 128 * XTS;
    float* TI = PCv + 64;
    float* CS = (float*)T_Aak;
    constexpr int LS = 33;
    float* WD = Aab; float* AD = WD + 64 * LS;
    float* VL = XT + 64 * XTS;
    float* WLT = (float*)lds; float* ALT = WLT + 64 * XTS; float* VGT = ALT + 64 * XTS;

    int jb = blockIdx.x;
    if (jb >= BATCH * NH * 32) return;
    B1Loads L;
    b1_issue_loads(p, l, jb, tid_(), L);
#pragma unroll 1
    for (; jb < BATCH * NH * 32; jb += G) {
        const int tid = tid_(), lane = tid & 63, wave = tid >> 6, fr = lane & 15, fq = lane >> 4;
        const int bh = jb >> 5, c = jb & 31, b = bh / NH, h = bh % NH, t0 = c * 64;
        for (int repA = 0; repA < ((PROBE_REP & 128) ? 2 : 1); ++repA) {
        float wg[6][8];
#pragma unroll
        for (int q = 0; q < 6; ++q) {
            const int id = wave + 8 * q, Lk = id >> 4, tj = id & 3;
            if (q < 4 || l > 0) {
                const float* Wg = (Lk == 0 ? w2 : (Lk == 1 ? a2 : v2)) + (size_t)fq * RWW + h * HD + tj * 16 + fr;
#pragma unroll
                for (int kk = 0; kk < 8; ++kk) wg[q][kk] = Wg[(size_t)kk * 4 * RWW];
            }
        }
#pragma unroll
        for (int q = 0; q < 2; ++q) {
            const int item = tid + 512 * q, tt = item >> 4, g = item & 15, t = t0 + tt; const bool hp = t > 0;
            if (g < 8) {
                float* dst = (g < 4 ? WD + tt * LS + 8 * g : AD + tt * LS + 8 * (g - 4));
#pragma unroll
                for (int e = 0; e < 8; ++e) {
                    const float xc = bf2f((bf16_t)L.cc[q][e]), xp = hp ? bf2f((bf16_t)L.cp[q][e]) : 0.f;
                    const float x_ = xc + (xp - xc) * mu[1152 + 8 * g + e];
                    dst[e] = g < 4 ? 1.0f - 2.0f * __builtin_amdgcn_rcpf(1.0f + __builtin_amdgcn_exp2f(2.8853900817779268f * x_)) : x_;
                }
            } else if (g < 12 && l > 0) {
#pragma unroll
                for (int e = 0; e < 8; ++e) VL[tt * LS + 8 * (g - 8) + e] = bf2f((bf16_t)L.cc[q][e]) + (hp ? bf2f((bf16_t)L.cp[q][e]) : 0.f);
            }
        }
        __syncthreads();
#pragma unroll
        for (int q = 0; q < 6; ++q) {
            if (q < 4 || l > 0) {
                const int id = wave + 8 * q, Lk = id >> 4, ti = (id >> 2) & 3, tj = id & 3;
                const float* Xs = (Lk == 0 ? WD : (Lk == 1 ? AD : VL)) + (ti * 16 + fr) * LS + fq;
                f32x4 acc = (f32x4){0.f, 0.f, 0.f, 0.f};
#pragma unroll
                for (int kk = 0; kk < 8; ++kk) acc = __builtin_amdgcn_mfma_f32_16x16x4f32(Xs[kk * 4], wg[q][kk], acc, 0, 0, 0);
                float* out = (Lk == 0 ? WLT : (Lk == 1 ? ALT : VGT)) + (tj * 16 + fr) * XTS + ti * 16 + fq * 4;
#pragma unroll
                for (int r = 0; r < 4; ++r) out[r] = acc[r];
            }
        }
        __syncthreads();
        }
        const int tt = tid >> 3, j0 = (tid & 7) * 8, t = t0 + tt, cj0 = h * HD + j0;
        const size_t row = (size_t)b * SEQ + t;
        float rr[8], kk_[8], vv[8], aa[8], bb[8], lw[8];
        for (int repA2 = 0; repA2 < ((PROBE_REP & 16384) ? 2 : 1); ++repA2) {
        {
            const bool hp = t > 0;
            float wl[8], al[8], vg[8];
#pragma unroll
            for (int e = 0; e < 8; ++e) {
                const float r_c = bf2f((bf16_t)L.rc[e]), k_c = bf2f((bf16_t)L.kc[e]), v_c = bf2f((bf16_t)L.vc[e]);
                const float r_p = hp ? bf2f((bf16_t)L.rp[e]) : 0.f, k_p = hp ? bf2f((bf16_t)L.kp[e]) : 0.f, v_p = hp ? bf2f((bf16_t)L.vp[e]) : 0.f;
                rr[e] = r_c + (r_p - r_c) * mu[cj0 + e]; kk_[e] = k_c + (k_p - k_c) * mu[384 + cj0 + e]; vv[e] = v_c + (v_p - v_c) * mu[768 + cj0 + e];
                wl[e] = w0[cj0 + e] + WLT[(j0 + e) * XTS + tt]; al[e] = a0[cj0 + e] + ALT[(j0 + e) * XTS + tt]; vg[e] = l > 0 ? v0[cj0 + e] + VGT[(j0 + e) * XTS + tt] : 0.f;
            }
            float ssq = 0.f, bon = 0.f;
#pragma unroll
            for (int e = 0; e < 8; ++e) {
                const float sp2 = fmaxf(-wl[e], 0.f) * 1.4426950408889634f + __builtin_amdgcn_logf(1.0f + __builtin_amdgcn_exp2f(-1.4426950408889634f * fabsf(wl[e])));
                lw[e] = -__builtin_amdgcn_exp2f(-sp2 - 0.7213475204444817f);
                const float alr = __builtin_amdgcn_rcpf(1.0f + __builtin_amdgcn_exp2f(-1.4426950408889634f * al[e]));
                if (l > 0) { const float vf = e < 4 ? L.vf0[e & 3] : L.vf1[e & 3]; vv[e] = vv[e] + (vf - vv[e]) * __builtin_amdgcn_rcpf(1.0f + __builtin_amdgcn_exp2f(-1.4426950408889634f * vg[e])); }
                const float kkr = kk_[e] * kks[cj0 + e];
                kk_[e] = kk_[e] * (1.0f + (alr - 1.0f) * ka[cj0 + e]);
                aa[e] = kkr; bb[e] = alr; ssq += kkr * kkr; bon += rr[e] * kk_[e] * rk[cj0 + e];
            }
            if (l == 0) { *(f32x4*)(VF + row * RWW + cj0) = (f32x4){vv[0], vv[1], vv[2], vv[3]}; *(f32x4*)(VF + row * RWW + cj0 + 4) = (f32x4){vv[4], vv[5], vv[6], vv[7]}; }
            ssq += __shfl_xor(ssq, 1); ssq += __shfl_xor(ssq, 2); ssq += __shfl_xor(ssq, 4);
            bon += __shfl_xor(bon, 1); bon += __shfl_xor(bon, 2); bon += __shfl_xor(bon, 4);
            const float inv = fminf(__builtin_amdgcn_rsqf(ssq), 1e12f);
            uint4 bvw; float bv[8];
#pragma unroll
            for (int e = 0; e < 8; ++e) { const float kn = aa[e] * inv; aa[e] = -kn; bb[e] = kn * bb[e]; bv[e] = bon * vv[e]; CS[tt * CSS + j0 + e] = lw[e]; }
            bvw.x = pk2(bv[0], bv[1]); bvw.y = pk2(bv[2], bv[3]); bvw.z = pk2(bv[4], bv[5]); bvw.w = pk2(bv[6], bv[7]);
            *(uint4*)((bf16_t*)(p.ws + WS_CH_BV) + (size_t)jb * 4096 + tt * 64 + j0) = bvw;
        }
        __syncthreads();
#pragma unroll
        for (int e = 0; e < 8; ++e) {
            const int j = wave * 8 + e; float x = CS[lane * CSS + j];
#pragma unroll
            for (int o = 1; o < 64; o <<= 1) { const float y = __shfl_up(x, o); if (lane >= o) x += y; }
            CS[lane * CSS + j] = x;
        }
        __syncthreads();
        }
        for (int repB = 0; repB < ((PROBE_REP & 256) ? 2 : 1); ++repB) {
        {
            float at[8], rt[8], bt[8], kt[8];
#pragma unroll
            for (int e = 0; e < 8; ++e) {
                const int j = j0 + e; const float cs = CS[tt * CSS + j] * 1.4426950408889634f, csC = CS[63 * CSS + j] * 1.4426950408889634f, lw2 = lw[e] * 1.4426950408889634f;
                const float e_in = __builtin_amdgcn_exp2f(cs), e_ex = __builtin_amdgcn_exp2f(cs - lw2), e_ng = __builtin_amdgcn_exp2f(-cs), e_ht = __builtin_amdgcn_exp2f(csC - cs);
                at[e] = aa[e] * e_ex; rt[e] = rr[e] * e_in; bt[e] = bb[e] * e_ng; kt[e] = kk_[e] * e_ng;
                T_VT[j * TS + tt] = f2bf(vv[e]); T_bhT[j * TS + tt] = f2bf(bb[e] * e_ht); T_khT[j * TS + tt] = f2bf(kk_[e] * e_ht);
                XT[j * XTS + tt] = at[e];
                if (tt == 63) PCv[j] = __builtin_amdgcn_exp2f(csC);
            }
            uint4 w;
            w.x = pk2(at[0], at[1]); w.y = pk2(at[2], at[3]); w.z = pk2(at[4], at[5]); w.w = pk2(at[6], at[7]); *(uint4*)(T_At + tt * TS + j0) = w;
            w.x = pk2(rt[0], rt[1]); w.y = pk2(rt[2], rt[3]); w.z = pk2(rt[4], rt[5]); w.w = pk2(rt[6], rt[7]); *(uint4*)(T_Rt + tt * TS + j0) = w;
            w.x = pk2(bt[0], bt[1]); w.y = pk2(bt[2], bt[3]); w.z = pk2(bt[4], bt[5]); w.w = pk2(bt[6], bt[7]); *(uint4*)(T_Bt + tt * TS + j0) = w;
            w.x = pk2(kt[0], kt[1]); w.y = pk2(kt[2], kt[3]); w.z = pk2(kt[4], kt[5]); w.w = pk2(kt[6], kt[7]); *(uint4*)(T_Kt + tt * TS + j0) = w;
        }
        __syncthreads();
        }
        if (jb + G < BATCH * NH * 32) b1_issue_loads(p, l, jb + G, tid, L);
        for (int repC = 0; repC < ((PROBE_REP & 512) ? 2 : 1); ++repC) {
        {
            const int mat = wave >> 1;
            const bf16_t* As = (mat == 0 || mat == 2) ? T_Bt : T_Kt; const bf16_t* Bs = (mat < 2) ? T_At : T_Rt;
            bf16_t* dstb = (mat == 1 ? T_Aak : (mat == 2 ? T_Arb : T_Ark));
#pragma unroll
            for (int q = 0; q < 8; ++q) {
                const int ti = ((wave & 1) * 8 + q) >> 2, tj = q & 3;
                f32x4 acc = (f32x4){0.f, 0.f, 0.f, 0.f};
                if (ti <= tj) acc = mm_tile(As, ti * 16, Bs, tj * 16, 64, fr, fq, acc);
                const int tcol = tj * 16 + fr, i0 = ti * 16 + fq * 4;
                if (ti == tj) {
#pragma unroll
                    for (int r = 0; r < 4; ++r) { const bool keep = (mat < 2) ? (i0 + r < tcol) : (i0 + r <= tcol); if (!keep) acc[r] = 0.f; }
                }
                if (mat == 0) *(f32x4*)(Aab + tcol * AABS + i0) = acc;
                else *(uint2*)(dstb + tcol * TS + i0) = pk4(acc);
            }
        }
        __syncthreads();
        if (wave == 0) {
            const int blk = lane >> 4, cc = lane & 15; const float* ar = Aab + (16 * blk) * AABS + 16 * blk;
            float x[16];
#pragma unroll
            for (int u = 0; u < 16; ++u) { float v = (u == cc) ? 1.0f : 0.f;
#pragma unroll
                for (int i = 0; i < u; ++i) v += ar[u * AABS + i] * x[i];
                x[u] = v; }
#pragma unroll
            for (int u = 0; u < 16; ++u) TI[(blk * 16 + u) * 17 + cc] = x[u];
        } else {
#pragma unroll 1
            for (int id = wave - 1; id < 16; id += 7) {
                const int ti = id >> 2, tj = id & 3;
                f32x4 acc = mm_tile(T_Aak, ti * 16, T_VT, tj * 16, 64, fr, fq, (f32x4){0.f, 0.f, 0.f, 0.f});
                const int j = tj * 16 + fr, tr = ti * 16 + fq * 4;
#pragma unroll
                for (int r = 0; r < 4; ++r) XT[(64 + j) * XTS + tr + r] = acc[r];
            }
        }
        __syncthreads();
        }
        {
            float* xc = XT + (wave * 16 + fr) * XTS;
#pragma unroll
            for (int I = 0; I < 4; ++I) {
                f32x4 acc;
#pragma unroll
                for (int r = 0; r < 4; ++r) acc[r] = xc[16 * I + 4 * fq + r];
#pragma unroll
                for (int J = 0; J < I; ++J)
#pragma unroll
                    for (int kk = 0; kk < 4; ++kk) acc = __builtin_amdgcn_mfma_f32_16x16x4f32(Aab[(16 * I + fr) * AABS + 16 * J + 4 * kk + fq], xc[16 * J + 4 * kk + fq], acc, 0, 0, 0);
#pragma unroll
                for (int r = 0; r < 4; ++r) xc[16 * I + 4 * fq + r] = acc[r];
                asm volatile("s_waitcnt lgkmcnt(0)" ::: "memory");
                f32x4 xs = (f32x4){0.f, 0.f, 0.f, 0.f};
#pragma unroll
                for (int kk = 0; kk < 4; ++kk) xs = __builtin_amdgcn_mfma_f32_16x16x4f32(TI[(I * 16 + fr) * 17 + 4 * kk + fq], xc[16 * I + 4 * kk + fq], xs, 0, 0, 0);
                asm volatile("s_waitcnt lgkmcnt(0)" ::: "memory");
#pragma unroll
                for (int r = 0; r < 4; ++r) xc[16 * I + 4 * fq + r] = xs[r];
                asm volatile("s_waitcnt lgkmcnt(0)" ::: "memory");
            }
        }
        __syncthreads();
        for (int repE = 0; repE < ((PROBE_REP & 2048) ? 2 : 1); ++repE) {
        {
            const int col = tid >> 2, tg = (tid & 3) * 16;
            const float* xr = XT + col * XTS + tg; bf16_t* dst = (col < 64 ? T_WT + col * TS : T_U0T + (col - 64) * TS) + tg;
            uint4 w0_, w1_;
            w0_.x = pk2(xr[0], xr[1]); w0_.y = pk2(xr[2], xr[3]); w0_.z = pk2(xr[4], xr[5]); w0_.w = pk2(xr[6], xr[7]);
            w1_.x = pk2(xr[8], xr[9]); w1_.y = pk2(xr[10], xr[11]); w1_.z = pk2(xr[12], xr[13]); w1_.w = pk2(xr[14], xr[15]);
            *(uint4*)dst = w0_; *(uint4*)(dst + 8) = w1_;
        }
        __syncthreads();
        {
            bf16_t* gM = (bf16_t*)(p.ws + WS_CH_M) + (size_t)jb * 4096; bf16_t* gNT = (bf16_t*)(p.ws + WS_CH_NT) + (size_t)jb * 4096;
            bf16_t* gG = (bf16_t*)(p.ws + WS_CH_G) + (size_t)jb * 4096; bf16_t* gY1T = (bf16_t*)(p.ws + WS_CH_Y1T) + (size_t)jb * 4096;
            const int mat = wave >> 1;
            const bf16_t* A1 = (mat == 0 || mat == 2) ? T_WT : (mat == 1 ? T_U0T : T_bhT);
            const bf16_t* B1 = (mat == 0 || mat == 1) ? T_Arb : (mat == 2 ? T_bhT : T_U0T);
            const bf16_t* A2 = mat == 1 ? T_VT : T_khT; const bf16_t* B2 = mat == 1 ? T_Ark : T_VT;
            bf16_t* gdst = mat == 0 ? gG : (mat == 1 ? gY1T : (mat == 2 ? gM : gNT));
#pragma unroll
            for (int q = 0; q < 8; ++q) {
                const int ti = ((wave & 1) * 8 + q) >> 2, tj = q & 3;
                const int col = tj * 16 + fr, r0 = ti * 16 + fq * 4;
                f32x4 acc = mm_tile(A1, ti * 16, B1, tj * 16, 64, fr, fq, (f32x4){0.f, 0.f, 0.f, 0.f});
                if (mat & 1) acc = mm_tile(A2, ti * 16, B2, tj * 16, 64, fr, fq, acc);
                if (mat == 0) {
                    const uint2 rw = *(const uint2*)(T_Rt + col * TS + r0);
                    acc[0] += bf2f((bf16_t)(rw.x & 0xffff)); acc[1] += bf2f((bf16_t)(rw.x >> 16)); acc[2] += bf2f((bf16_t)(rw.y & 0xffff)); acc[3] += bf2f((bf16_t)(rw.y >> 16));
                } else if (mat == 2 && ti == tj) {
                    const float pc = PCv[col];
#pragma unroll
                    for (int r = 0; r < 4; ++r) if (r0 + r == col) acc[r] += pc;
                }
                *(uint2*)(gdst + col * 64 + r0) = pk4(acc);
            }
        }
        __syncthreads();
        }
    }
}

__device__ void rwkv_b2_job(const Params& p, int bh, unsigned char* lds) {
    const int tid = tid_(), lane = tid & 63, wave = tid >> 6, fr = lane & 15, fq = lane >> 4;
    const int mi = wave >> 1, nj0 = (wave & 1) * 2;
    const bf16_t* gM = (const bf16_t*)(p.ws + WS_CH_M); const bf16_t* gNT = (const bf16_t*)(p.ws + WS_CH_NT); bf16_t* gZT = (bf16_t*)(p.ws + WS_ZT);
    bf16_t* zbuf = (bf16_t*)lds;
    f32x4 z[2];
    z[0] = (f32x4){0.f, 0.f, 0.f, 0.f}; z[1] = z[0];
    const int c0 = mi * 16 + fq * 4;
    bf16x8 am[2]; uint2 nw[2];
    {
        const size_t jb = (size_t)bh * 32;
#pragma unroll
        for (int kk = 0; kk < 2; ++kk) am[kk] = *(const bf16x8*)(gM + jb * 4096 + (mi * 16 + fr) * 64 + kk * 32 + fq * 8);
#pragma unroll
        for (int q = 0; q < 2; ++q) nw[q] = *(const uint2*)(gNT + jb * 4096 + ((nj0 + q) * 16 + fr) * 64 + c0);
    }
#pragma unroll 1
    for (int c = 0; c < SEQ / 64; ++c) {
        const size_t jb = (size_t)bh * 32 + c;
        bf16_t* zh = zbuf + (c & 1) * 2 * 64 * TS; bf16_t* zl = zh + 64 * TS;
#pragma unroll
        for (int q = 0; q < 2; ++q) {
            const int j = (nj0 + q) * 16 + fr;
            const uint2 hi = pk4(z[q]);
            f32x4 lo;
            lo[0] = z[q][0] - bf2f((bf16_t)(hi.x & 0xffff)); lo[1] = z[q][1] - bf2f((bf16_t)(hi.x >> 16)); lo[2] = z[q][2] - bf2f((bf16_t)(hi.y & 0xffff)); lo[3] = z[q][3] - bf2f((bf16_t)(hi.y >> 16));
            *(uint2*)(zh + j * TS + c0) = hi; *(uint2*)(zl + j * TS + c0) = pk4(lo);
            *(uint2*)(gZT + jb * 4096 + j * 64 + c0) = hi;
        }
        bf16x8 amn[2]; uint2 nwn[2];
        {
            const size_t jn = (size_t)bh * 32 + (c + 1 < SEQ / 64 ? c + 1 : c);
#pragma unroll
            for (int kk = 0; kk < 2; ++kk) amn[kk] = *(const bf16x8*)(gM + jn * 4096 + (mi * 16 + fr) * 64 + kk * 32 + fq * 8);
#pragma unroll
            for (int q = 0; q < 2; ++q) nwn[q] = *(const uint2*)(gNT + jn * 4096 + ((nj0 + q) * 16 + fr) * 64 + c0);
        }
        __syncthreads();
#pragma unroll
        for (int q = 0; q < 2; ++q) {
            const int j = (nj0 + q) * 16 + fr;
            f32x4 acc; acc[0] = bf2f((bf16_t)(nw[q].x & 0xffff)); acc[1] = bf2f((bf16_t)(nw[q].x >> 16)); acc[2] = bf2f((bf16_t)(nw[q].y & 0xffff)); acc[3] = bf2f((bf16_t)(nw[q].y >> 16));
#pragma unroll
            for (int kk = 0; kk < 2; ++kk) {
                const bf16x8 bh_ = *(const bf16x8*)(zh + j * TS + kk * 32 + fq * 8), bl_ = *(const bf16x8*)(zl + j * TS + kk * 32 + fq * 8);
                acc = __builtin_amdgcn_mfma_f32_16x16x32_bf16(am[kk], bh_, acc, 0, 0, 0);
                acc = __builtin_amdgcn_mfma_f32_16x16x32_bf16(am[kk], bl_, acc, 0, 0, 0);
            }
            z[q] = acc;
        }
        am[0] = amn[0]; am[1] = amn[1]; nw[0] = nwn[0]; nw[1] = nwn[1];
    }
    __syncthreads();
}

__device__ void rwkv_b3_pair(const Params& p, int l, int pair) {
    const int tid = tid_(), lane = tid & 63, wave = tid >> 6, fr = lane & 15, fq = lane >> 4;
    const int jb = pair * 2 + (wave >> 2), mi = wave & 3;
    const int bh = jb >> 5, c = jb & 31, b = bh / NH, h = bh % NH;
    const bf16_t* gG = (const bf16_t*)(p.ws + WS_CH_G) + (size_t)jb * 4096; const bf16_t* gY1 = (const bf16_t*)(p.ws + WS_CH_Y1T) + (size_t)jb * 4096;
    const bf16_t* gBV = (const bf16_t*)(p.ws + WS_CH_BV) + (size_t)jb * 4096; const bf16_t* gZT = (const bf16_t*)(p.ws + WS_ZT) + (size_t)jb * 4096;
    const bf16_t* PG = (const bf16_t*)(p.ws + WS_PG); bf16_t* MIX = (bf16_t*)(p.ws + WS_MIX);
    const float* gng = p.in[19] + l * RWW + h * HD; const float* gnb = p.in[20] + l * RWW + h * HD;
    const int tt = mi * 16 + fr; const size_t row = (size_t)b * SEQ + c * 64 + tt;
    bf16x8 bg[2];
#pragma unroll
    for (int kk = 0; kk < 2; ++kk) bg[kk] = *(const bf16x8*)(gG + tt * 64 + kk * 32 + fq * 8);
    uint2 yw[4], bw[4], gw[4];
#pragma unroll
    for (int nj = 0; nj < 4; ++nj) { const int j0 = nj * 16 + fq * 4;
        yw[nj] = *(const uint2*)(gY1 + tt * 64 + j0); bw[nj] = *(const uint2*)(gBV + tt * 64 + j0); gw[nj] = *(const uint2*)(PG + row * PG_W + h * HD + j0); }
    f32x4 acc[4];
#pragma unroll
    for (int nj = 0; nj < 4; ++nj) {
        acc[nj][0] = bf2f((bf16_t)(yw[nj].x & 0xffff)); acc[nj][1] = bf2f((bf16_t)(yw[nj].x >> 16)); acc[nj][2] = bf2f((bf16_t)(yw[nj].y & 0xffff)); acc[nj][3] = bf2f((bf16_t)(yw[nj].y >> 16));
#pragma unroll
        for (int kk = 0; kk < 2; ++kk) { const bf16x8 az = *(const bf16x8*)(gZT + (nj * 16 + fr) * 64 + kk * 32 + fq * 8); acc[nj] = __builtin_amdgcn_mfma_f32_16x16x32_bf16(az, bg[kk], acc[nj], 0, 0, 0); }
    }
    float s = 0.f;
#pragma unroll
    for (int nj = 0; nj < 4; ++nj) s += (acc[nj][0] + acc[nj][1]) + (acc[nj][2] + acc[nj][3]);
    s += __shfl_xor(s, 16); s += __shfl_xor(s, 32);
    const float mean = s * (1.0f / HD);
    float vs = 0.f;
#pragma unroll
    for (int nj = 0; nj < 4; ++nj) { acc[nj] = acc[nj] - mean; vs += (acc[nj][0] * acc[nj][0] + acc[nj][1] * acc[nj][1]) + (acc[nj][2] * acc[nj][2] + acc[nj][3] * acc[nj][3]); }
    vs += __shfl_xor(vs, 16); vs += __shfl_xor(vs, 32);
    const float rstd = rsqrtf(vs * (1.0f / HD) + GN_EPS);
#pragma unroll
    for (int nj = 0; nj < 4; ++nj) {
        const int j0 = nj * 16 + fq * 4;
        const f32x4 gg = *(const f32x4*)(gng + j0), gb = *(const f32x4*)(gnb + j0);
        const float bv0 = bf2f((bf16_t)(bw[nj].x & 0xffff)), bv1 = bf2f((bf16_t)(bw[nj].x >> 16)), bv2 = bf2f((bf16_t)(bw[nj].y & 0xffff)), bv3 = bf2f((bf16_t)(bw[nj].y >> 16));
        const float g0 = bf2f((bf16_t)(gw[nj].x & 0xffff)), g1 = bf2f((bf16_t)(gw[nj].x >> 16)), g2 = bf2f((bf16_t)(gw[nj].y & 0xffff)), g3 = bf2f((bf16_t)(gw[nj].y >> 16));
        const float o0 = acc[nj][0] * rstd * gg[0] + gb[0] + bv0, o1 = acc[nj][1] * rstd * gg[1] + gb[1] + bv1, o2 = acc[nj][2] * rstd * gg[2] + gb[2] + bv2, o3 = acc[nj][3] * rstd * gg[3] + gb[3] + bv3;
        uint2 w; w.x = pk2(o0 * siluf_(g0), o1 * siluf_(g1)); w.y = pk2(o2 * siluf_(g2), o3 * siluf_(g3));
        *(uint2*)(MIX + row * DM + CW + SBW + h * HD + j0) = w;
    }
}

#ifndef ATTN_REF
#define ATTN_REF 0
#endif
#ifndef RWKV_REF
#define RWKV_REF 0
#endif
__device__ void phase_mix1(const Params& p, int l, unsigned char* lds) {
    constexpr int NAT = BATCH * NH * 4, NCV = BATCH * (SEQ / 32);
    const int G = gridDim.x;
#if RWKV_REF
    for (int job = blockIdx.x; job < BATCH * NH; job += G) rwkv_job(p, l, job, (float*)lds);
#else
    for (int rep = 0; rep < ((PROBE_REP & 1) ? 2 : 1); ++rep) rwkv_b1_phase(p, l, lds);
#endif
    for (int rep = 0; rep < ((PROBE_REP & 2) ? 2 : 1); ++rep)
#if ATTN_REF
    for (int job = blockIdx.x; job < NAT; job += G) attn_job(p, job);
#else
    for (int job = blockIdx.x; job < NAT * 2; job += G) attn_mfma_wave(p, job >> 3, (job & 7) * 8 + (tid_() >> 6));
#endif
#ifndef CONV_REF
#define CONV_REF 0
#endif
    for (int rep = 0; rep < ((PROBE_REP & 4) ? 2 : 1); ++rep)
#if CONV_REF
    for (int job = blockIdx.x; job < NCV; job += G) conv_job(p, l, job, (float*)lds);
#else
    for (int job = blockIdx.x; job < BATCH * (SEQ / 64); job += G) conv_job64(p, l, job, lds);
#endif
}
__device__ void phase_mix2(const Params& p, int l, unsigned char* lds) {
#if !RWKV_REF
    for (int rep = 0; rep < ((PROBE_REP & 8) ? 2 : 1); ++rep)
    for (int job = blockIdx.x; job < BATCH * NH; job += gridDim.x) rwkv_b2_job(p, job, lds);
    if (l + 1 < DEPTH && defer_layer1_weights() && (int)blockIdx.x >= BATCH * NH) prep_weights(p, l + 1, lds, blockIdx.x - BATCH * NH, gridDim.x - BATCH * NH);
#endif
}
__device__ void phase_mix3(const Params& p, int l, unsigned char* lds) {
#if !RWKV_REF
    for (int rep = 0; rep < ((PROBE_REP & 16) ? 2 : 1); ++rep)
    for (int pair = blockIdx.x; pair < BATCH * NH * 16; pair += gridDim.x) rwkv_b3_pair(p, l, pair);
#endif
}

#define LAS __attribute__((address_space(3)))
#define XB_TMO      128
#define XB_XCNT(j)  (256  + 64 * (j))
#define XB_XSUB(j)  (1280 + 64 * (j))
#define XB_XGEN(j)  (2304 + 64 * (j))
#define XB_TOP      3328
#define XB_TOPGEN   3392
#define XCD_BAR_WORDS 3456
#define XB_SPIN_CAP (1u << 18)

__device__ __forceinline__ unsigned xb_ld(unsigned* p)              { return __hip_atomic_load(p, __ATOMIC_RELAXED, __HIP_MEMORY_SCOPE_AGENT); }
__device__ __forceinline__ unsigned xb_add(unsigned* p, unsigned v) { return __hip_atomic_fetch_add(p, v, __ATOMIC_RELAXED, __HIP_MEMORY_SCOPE_AGENT); }
__device__ __forceinline__ unsigned xb_xcc_id() { return (unsigned)__builtin_amdgcn_s_getreg((3 << 11) | 20) & 0xFu; }
#define XB_SPIN(cond, bar) do { unsigned _sp = 0; while (cond) { __builtin_amdgcn_s_sleep(1); \
    if ((++_sp & 255u) == 0u) { if (xb_ld(&(bar)[XB_TMO])) break; if (_sp > XB_SPIN_CAP) { atomicAdd(&(bar)[XB_TMO], 1u); break; } } } } while (0)

struct XcdBarrier {
    unsigned* bar; unsigned x;
    volatile LAS unsigned* st;
};

__device__ __forceinline__ XcdBarrier xcd_barrier_post(unsigned* bar, volatile LAS unsigned* st) {
    XcdBarrier b; b.bar = bar; b.x = xb_xcc_id(); b.st = st;
    if (threadIdx.x == 0) (void)xb_add(&bar[XB_XCNT(b.x)], 1u);
    return b;
}
__device__ __forceinline__ void xcd_barrier_complete(unsigned* bar, unsigned x, unsigned& nloc, unsigned& nx) {
    const unsigned G = gridDim.x * gridDim.y * gridDim.z;
    unsigned sum, cnt, mine, sp = 0u;
    for (;;) {
        sum = 0u; cnt = 0u; mine = 0u;
#pragma unroll
        for (unsigned j = 0; j < 16; ++j) { const unsigned c = xb_ld(&bar[XB_XCNT(j)]); sum += c; cnt += (c > 0u) ? 1u : 0u; mine = (j == x) ? c : mine; }
        if (sum == G) break;
        __builtin_amdgcn_s_sleep(1);
        if ((++sp & 255u) == 0u) { if (xb_ld(&bar[XB_TMO])) break; if (sp > XB_SPIN_CAP) { atomicAdd(&bar[XB_TMO], 1u); break; } }
    }
    nloc = mine > 0u ? mine : 1u; nx = cnt > 0u ? cnt : 1u;
}

__device__ __forceinline__ void xcd_barrier(const XcdBarrier& b) {
    asm volatile("s_waitcnt vmcnt(0)" ::: "memory");
    __syncthreads();
    if (threadIdx.x == 0) {
        unsigned* bar = b.bar;
        __builtin_amdgcn_s_waitcnt(0);
        unsigned nloc = b.st[0], nx = b.st[1];
        if (nloc == 0u) { xcd_barrier_complete(bar, b.x, nloc, nx); b.st[0] = nloc; b.st[1] = nx; }
        const unsigned old = xb_add(&bar[XB_XSUB(b.x)], 1u);
        const unsigned gen = old / nloc;
        if (old + 1u == (gen + 1u) * nloc) {
            __builtin_amdgcn_fence(__ATOMIC_RELEASE, "agent");
            asm volatile("s_waitcnt vmcnt(0)" ::: "memory");
            const unsigned og = xb_add(&bar[XB_TOP], 1u);
            const unsigned tg = og / nx;
            if (og + 1u == (tg + 1u) * nx) xb_add(&bar[XB_TOPGEN], 1u);
            else XB_SPIN(xb_ld(&bar[XB_TOPGEN]) == tg, bar);
            __builtin_amdgcn_fence(__ATOMIC_ACQUIRE, "agent");
            xb_add(&bar[XB_XGEN(b.x)], 1u);
            asm volatile("s_waitcnt vmcnt(0)" ::: "memory");
        } else {
            XB_SPIN(xb_ld(&bar[XB_XGEN(b.x)]) == gen, bar);
            __builtin_amdgcn_fence(__ATOMIC_ACQUIRE, "agent");
            asm volatile("s_waitcnt vmcnt(0)" ::: "memory");
        }
    }
    __syncthreads();
}

constexpr int PH_PER_LAYER = 6;
constexpr int N_PHASES = 1 + PH_PER_LAYER * DEPTH;
__device__ __forceinline__ void run_phase(const Params& p, int ph, unsigned char* lds) {
    unsigned char* ws = p.ws;
    if (ph == 0) { for (int rep = 0; rep < ((PROBE_REP & 4096) ? 2 : 1); ++rep) phase_prologue(p, lds); return; }
    const int l = (ph - 1) / PH_PER_LAYER, k = (ph - 1) % PH_PER_LAYER;
    if (k == 0) {
        EpiInProjP E{(bf16_t*)(ws + WS_PC), (bf16_t*)(ws + WS_PS), (bf16_t*)(ws + WS_PR), (bf16_t*)(ws + WS_PG), (bf16_t*)(ws + WS_VT)};
        pg8::Gemm g{(const bf16_t*)(ws + WS_XB), (const bf16_t*)(ws + WS_WIN) + (size_t)l * NINT * DM, M, NINT, DM}; pg8::StaticOrder S; S.init(M, NINT, (int)gridDim.x, (int)blockIdx.x);
        for (int rep = 0; rep < ((PROBE_REP & 32) ? 2 : 1); ++rep)
        pg8::gemm_phase<EpiInProjP, pg8::StaticOrder, true, true>((PG8_LAS unsigned char*)lds, g, S, E);
    } else if (k == 1) {
        phase_mix1(p, l, lds);
    } else if (k == 2) {
        phase_mix2(p, l, lds);
    } else if (k == 3) {
        phase_mix3(p, l, lds);
    } else if (k == 4) {
        EpiOutBf16P E{(bf16_t*)(ws + WS_Y), DM};
        pg8::Gemm g{(const bf16_t*)(ws + WS_MIX), (const bf16_t*)(ws + WS_WOUT) + (size_t)l * DM * DM, M, DM, DM}; pg8::StaticOrder S; S.init(M, DM, (int)gridDim.x, (int)blockIdx.x);
        for (int rep = 0; rep < ((PROBE_REP & 64) ? 2 : 1); ++rep)
        pg8::gemm_phase<EpiOutBf16P, pg8::StaticOrder, true, true>((PG8_LAS unsigned char*)lds, g, S, E);
    } else {
        for (int rep = 0; rep < ((PROBE_REP & 8192) && l == 0 ? 2 : 1); ++rep)
        phase_rowpass(l == 0 ? p.in[0] : p.out, (const bf16_t*)(ws + WS_Y), p.in[2] + l * DM, p.out, l + 1 < DEPTH ? (bf16_t*)(ws + WS_XB) : nullptr);
    }
}

static_assert(10 * TILE_B + 64 * AABS * 4 + 128 * XTS * 4 + 64 * 4 + 4 * 16 * 17 * 4 <= 147456, "B1 LDS map");
constexpr int LDS_BYTES = 147456 + 256;

constexpr int MISC_OFF = 147456;
#if MK_COOP == 2
__global__ void __launch_bounds__(512, 2) fwd_kernel(Params p) {
    extern __shared__ __attribute__((aligned(16))) unsigned char lds[];
    volatile LAS unsigned* misc = (volatile LAS unsigned*)((LAS unsigned char*)lds + MISC_OFF);
    if (threadIdx.x < 16) misc[threadIdx.x] = 0u;
    __syncthreads();
    XcdBarrier bar = xcd_barrier_post((unsigned*)(p.ws + WS_CTL), misc);
    for (int ph = p.ph_lo; ph < p.ph_hi; ++ph) {
        run_phase(p, ph, lds);
        if (ph + 1 < p.ph_hi) xcd_barrier(bar);
        if ((PROBE_REP & 32768) && ph == 3) for (int rep = 0; rep < 20; ++rep) xcd_barrier(bar);
    }
}
#elif MK_COOP == 1
__global__ void __launch_bounds__(512, 2) fwd_kernel(Params p) {
    extern __shared__ __attribute__((aligned(16))) unsigned char lds[];
    cg::grid_group grid = cg::this_grid();
    for (int ph = p.ph_lo; ph < p.ph_hi; ++ph) {
        run_phase(p, ph, lds);
        if (ph + 1 < p.ph_hi) grid.sync();
    }
}
#else
__global__ void __launch_bounds__(512, 2) fwd_kernel(Params p) {
    extern __shared__ __attribute__((aligned(16))) unsigned char lds[];
    for (int ph = p.ph_lo; ph < p.ph_hi; ++ph) run_phase(p, ph, lds);
}
#endif

extern "C" void kernel_launch(void* const* d_in, const int* in_sizes, int n_in, void* d_out, int out_size, void* d_ws, size_t ws_size, hipStream_t stream) {
    static int grid = 0;
    if (grid == 0) {
        if (n_in != 24 || out_size != M * DM || ws_size < WS_END) { fprintf(stderr, "kernel_launch: unexpected problem (n_in %d out %d ws %zu)\n", n_in, out_size, ws_size); grid = -1; return; }
        int dev = 0, cus = 0, per_cu = 0;
        hipGetDevice(&dev); hipDeviceGetAttribute(&cus, hipDeviceAttributeMultiprocessorCount, dev);
        hipFuncSetAttribute((const void*)fwd_kernel, hipFuncAttributeMaxDynamicSharedMemorySize, LDS_BYTES);
        hipOccupancyMaxActiveBlocksPerMultiprocessor(&per_cu, (const void*)fwd_kernel, 512, LDS_BYTES);
        if (per_cu < 1) { fprintf(stderr, "kernel_launch: occupancy query says %d blocks per CU\n", per_cu); per_cu = 1; }
        grid = cus;
        (void)hipGetLastError();
    }
    if (grid < 0) return;
    Params p{};
    for (int i = 0; i < 24; ++i) p.in[i] = (const float*)d_in[i];
    p.out = (float*)d_out; p.ws = (unsigned char*)d_ws;
#if MK_COOP == 2
    p.ph_lo = 0; p.ph_hi = N_PHASES;
    if (hipMemsetAsync((char*)d_ws + WS_CTL, 0, XCD_BAR_WORDS * 4, stream) != hipSuccess) { fprintf(stderr, "kernel_launch: memset of the barrier words failed\n"); return; }
    hipLaunchKernelGGL(fwd_kernel, dim3(grid), dim3(512), LDS_BYTES, stream, p);
#elif MK_COOP == 1
    p.ph_lo = 0; p.ph_hi = N_PHASES;
    void* args[] = {&p};
    hipError_t e = hipLaunchCooperativeKernel((const void*)fwd_kernel, dim3(grid), dim3(512), args, LDS_BYTES, stream);
    if (e != hipSuccess) fprintf(stderr, "cooperative launch failed: %s (grid %d)\n", hipGetErrorString(e), grid);
#else
    for (int ph = 0; ph < N_PHASES; ++ph) {
        p.ph_lo = ph; p.ph_hi = ph + 1;
        hipLaunchKernelGGL(fwd_kernel, dim3(grid), dim3(512), LDS_BYTES, stream, p);
    }
#endif
}
```

```cpp
#include <hip/hip_runtime.h>
#include <hip/hip_cooperative_groups.h>
#include <cstdio>
#include <cstdint>
namespace cg = cooperative_groups;

#ifndef PROBE_REP
#define PROBE_REP 0
#endif
#ifndef MK_COOP
#define MK_COOP 2
#endif

constexpr int BATCH = 16, SEQ = 2048, DM = 1024, DEPTH = 2;
constexpr int M = BATCH * SEQ;
constexpr int HD = 64, NH = 6;
constexpr int CW = 256, SBW = 384, RWW = 384, LORA = 32, TAPS = 31;
constexpr int DIN = 3904;
constexpr int NINT = 4096;
constexpr int PC_W = 768, PS_W = 1152, PR_W = 1280, PG_W = 384;
constexpr float RMS_EPS = 1e-6f, LN_EPS = 1e-5f, GN_EPS = 64e-5f;

typedef unsigned short bf16_t;
typedef short bf16x8 __attribute__((ext_vector_type(8)));
typedef float f32x4 __attribute__((ext_vector_type(4)));
typedef unsigned short us4 __attribute__((ext_vector_type(4)));

constexpr size_t MiB = 1u << 20;
constexpr size_t WS_CTL = 0;
constexpr size_t WS_WPW = 512 * 1024;
constexpr size_t WS_WIN = 1 * MiB;
constexpr size_t WS_WOUT = 17 * MiB;
constexpr size_t WS_XB = 21 * MiB;
constexpr size_t WS_MIX = WS_XB;
constexpr size_t WS_PC = 85 * MiB;
constexpr size_t WS_PS = 133 * MiB;
constexpr size_t WS_VT = 205 * MiB;
constexpr size_t WS_Y = WS_PC;
constexpr size_t WS_PR = 229 * MiB;
constexpr size_t WS_PG = 309 * MiB;
constexpr size_t WS_VF = 333 * MiB;
constexpr size_t WS_CH = 381 * MiB;
constexpr size_t CH_SZ = (size_t)3072 * 4096 * 2;
constexpr size_t WS_CH_M = WS_CH, WS_CH_NT = WS_CH + CH_SZ, WS_CH_G = WS_CH + 2 * CH_SZ, WS_CH_Y1T = WS_CH + 3 * CH_SZ, WS_CH_BV = WS_CH + 4 * CH_SZ;
constexpr size_t WS_ZT = WS_PR;
constexpr size_t WS_END = 501 * MiB;

struct Params {
    const float* in[24];
    float* out;
    unsigned char* ws;
    int ph_lo, ph_hi;
};

__device__ __forceinline__ float bf2f(bf16_t v) { return __uint_as_float(((unsigned)v) << 16); }
typedef float f32x2_t __attribute__((ext_vector_type(2)));
typedef __bf16 bf16x2_t __attribute__((ext_vector_type(2)));
__device__ __forceinline__ unsigned pk2(float lo, float hi) { f32x2_t v = {lo, hi}; bf16x2_t b = __builtin_convertvector(v, bf16x2_t); return __builtin_bit_cast(unsigned, b); }
__device__ __forceinline__ bf16_t f2bf(float f) { return (bf16_t)(pk2(f, f) & 0xffffu); }
__device__ __forceinline__ float wave_sum(float v) {
#pragma unroll
    for (int o = 1; o < 64; o <<= 1) v += __shfl_xor(v, o);
    return v;
}
__device__ __forceinline__ float sigmoidf_(float x) { return 1.0f / (1.0f + __expf(-x)); }
__device__ __forceinline__ float siluf_(float x) { return x / (1.0f + __expf(-x)); }
__device__ __forceinline__ int tid_() { int t = threadIdx.x; asm volatile("" : "+v"(t)); return t; }
__device__ __forceinline__ int opaque_zero() { int z = 0; asm volatile("" : "+v"(z)); return z; }

__device__ __forceinline__ int orig_col(int n) { return n < 3520 ? n : (n < 3584 ? -1 : (n < 3968 ? n - 64 : -1)); }

__device__ void transpose_tile(const float* W, int ldw, int ncol_src, const float* gain, bf16_t* WT, int K, int n0, int k0, bool permute, float* tile  , bool skip_fold_rows = false) {
    const int tid = tid_();
#pragma unroll
    for (int i = 0; i < 8; ++i) {
        const int kl = (tid >> 6) + 8 * i, nl = tid & 63;
        const int n = n0 + nl, k = k0 + kl;
        const int oc = permute ? orig_col(n) : n;
        float v = 0.f;
        if (oc >= 0 && oc < ncol_src) v = W[(size_t)k * ldw + oc] * (gain ? gain[k] : 1.0f);
        if (permute && n >= 768 && n < 1152) v *= 0.125f * 1.4426950408889634f;
        tile[kl * 65 + nl] = v;
    }
    __syncthreads();
#pragma unroll
    for (int i = 0; i < 8; ++i) {
        const int nl = (tid >> 6) + 8 * i, kl = tid & 63;
        if (!(skip_fold_rows && n0 + nl >= 3520 && n0 + nl < 3584)) WT[(size_t)(n0 + nl) * K + k0 + kl] = f2bf(tile[kl * 65 + nl]);
    }
    __syncthreads();
}
__device__ void fold_v1_rows(const Params& p, int l, bf16_t* WinT_l, float* scr  , int worker, int nworkers) {
    const int tid = tid_(), o = tid & 63, kl = (tid >> 6) & 3, half = tid >> 8;
    const float* W = p.in[3] + (size_t)l * DM * DIN; const float* gain = p.in[1] + l * DM; const float* v1 = p.in[22] + (size_t)(l - 1) * RWW * LORA; const float* muv = p.in[11] + l * 1216 + 768;
    for (int k4 = worker * 4; k4 < DM; k4 += nworkers * 4) {
        const int k = k4 + kl; const float* wr = W + (size_t)k * DIN + 3072 + half * 192; const float* mv = muv + half * 192; const float* vr = v1 + (size_t)(half * 192) * LORA + (o & 31);
        float a = 0.f;
#pragma unroll 4
        for (int c = 0; c < 192; ++c) { const float m = mv[c]; a += wr[c] * (o >= 32 ? m : 1.0f - m) * vr[c * LORA]; }
        scr[half * 256 + kl * 64 + o] = a;
        __syncthreads();
        if (half == 0) WinT_l[(size_t)(3520 + o) * DM + k] = f2bf((scr[kl * 64 + o] + scr[256 + kl * 64 + o]) * gain[k]);
        __syncthreads();
    }
}
__device__ void prep_weights(const Params& p, int l, unsigned char* lds, int worker, int nworkers) {
    float* tile = (float*)lds;
    bf16_t* WinT = (bf16_t*)(p.ws + WS_WIN) + (size_t)l * NINT * DM; bf16_t* WoutT = (bf16_t*)(p.ws + WS_WOUT) + (size_t)l * DM * DM; bf16_t* WpwT = (bf16_t*)(p.ws + WS_WPW) + (size_t)l * CW * CW;
    const int nt_in = (NINT / 64) * (DM / 64), nt_out = (DM / 64) * (DM / 64), nt_pw = (CW / 64) * (CW / 64);
    for (int j = worker; j < nt_in + nt_out + nt_pw; j += nworkers) {
        if (j < nt_in) transpose_tile(p.in[3] + (size_t)l * DM * DIN, DIN, DIN, p.in[1] + l * DM, WinT, DM, (j / (DM / 64)) * 64, (j % (DM / 64)) * 64, true, tile, l > 0);
        else if (j < nt_in + nt_out) { const int r = j - nt_in; transpose_tile(p.in[4] + (size_t)l * DM * DM, DM, DM, nullptr, WoutT, DM, (r / (DM / 64)) * 64, (r % (DM / 64)) * 64, false, tile); }
        else { const int r = j - nt_in - nt_out; transpose_tile(p.in[9] + (size_t)l * CW * CW, CW, CW, nullptr, WpwT, CW, (r >> 2) * 64, (r & 3) * 64, false, tile); }
    }
    if (l > 0) fold_v1_rows(p, l, WinT, tile, worker, nworkers);
}

__device__ void rows_to_xb(const float* X, bf16_t* XB) {
    const int tid = tid_(), lane = tid & 63, wave = __builtin_amdgcn_readfirstlane(tid >> 6);
    for (int row = blockIdx.x * 8 + wave; row < M; row += gridDim.x * 8) {
        const float* xr = X + (size_t)row * DM;
        f32x4 v[4]; float ss = 0.f;
#pragma unroll
        for (int i = 0; i < 4; ++i) { v[i] = *(const f32x4*)(xr + i * 256 + lane * 4); ss += v[i][0] * v[i][0] + v[i][1] * v[i][1] + v[i][2] * v[i][2] + v[i][3] * v[i][3]; }
        ss = wave_sum(ss);
        const float rstd = rsqrtf(ss * (1.0f / DM) + RMS_EPS);
#pragma unroll
        for (int i = 0; i < 4; ++i) { uint2 w; w.x = pk2(v[i][0] * rstd, v[i][1] * rstd); w.y = pk2(v[i][2] * rstd, v[i][3] * rstd); *(uint2*)(XB + (size_t)row * DM + i * 256 + lane * 4) = w; }
    }
}

__device__ __forceinline__ bool defer_layer1_weights() { return gridDim.x >= BATCH * NH + 32; }
__device__ void phase_prologue(const Params& p, unsigned char* lds) {
    prep_weights(p, 0, lds, blockIdx.x, gridDim.x);
    if (!defer_layer1_weights()) for (int l = 1; l < DEPTH; ++l) prep_weights(p, l, lds, blockIdx.x, gridDim.x);
    rows_to_xb(p.in[0], (bf16_t*)(p.ws + WS_XB));
}

namespace pg8 {
#define PG8_LAS __attribute__((address_space(3)))
typedef unsigned short bf16_t;
typedef short bf16x8 __attribute__((ext_vector_type(8)));
typedef float f32x4 __attribute__((ext_vector_type(4)));
typedef unsigned u32x4 __attribute__((ext_vector_type(4)));
constexpr int BM = 256, BK = 64, HALF = 128, HTB = HALF * BK * 2  , STAGE_BYTES = 8 * HTB, NXCD = 8, WGM = 8;

__host__ __device__ __forceinline__ int lds_byte(int r, int c) { const int st = (r >> 4) * 2 + (c >> 5), rr = r & 15, cc = c & 31, ob = rr * 64 + cc * 2; return st * 1024 + (ob ^ (((ob >> 9) & 1) << 5)); }
__host__ __device__ __forceinline__ void stage_rc(int b, int& R, int& C) { const int st = b / 1024, sb = b % 1024, swz = sb ^ (((sb >> 9) & 1) << 5); R = (st >> 1) * 16 + swz / 64; C = (st & 1) * 32 + (swz % 64) / 2; }
__host__ __device__ __forceinline__ int perm32(int rho) { const int n = rho >> 4, i = rho & 15; return 8 * (i >> 2) + 4 * n + (i & 3); }

struct Unit { int pm, pn; };
struct Gemm { const bf16_t* A; const bf16_t* Bt; int M, N, K; };

struct StaticOrder {
    int nM, nN, nwg, G, c;
    __host__ __device__ void init(int M, int N, int G_, int c_) { nM = M / BM; nN = N / BM; nwg = nM * nN; G = G_; c = c_; }
    __host__ __device__ bool next(int i, Unit& u) const {
        const long L = (long)i * G + c; if (L >= nwg) return false;
        int wgid = (int)L; { const int q = nwg / NXCD, r = nwg % NXCD, xcd = wgid % NXCD, off = wgid / NXCD; wgid = (xcd < r ? xcd * (q + 1) : r * (q + 1) + (xcd - r) * q) + off; }
        const int nig = WGM * nN, gid = wgid / nig, fm = gid * WGM, gsz = (nM - fm) < WGM ? (nM - fm) : WGM;
        u.pm = fm + ((wgid % nig) % gsz); u.pn = (wgid % nig) / gsz; return true;
    }
    __device__ __forceinline__ void a_ready(const Unit&) const {}
    __device__ __forceinline__ void done(const Unit&) const {}
};


__device__ __forceinline__ unsigned cvt_pk_bf16(float lo, float hi) { unsigned r; asm volatile("v_cvt_pk_bf16_f32 %0, %1, %2" : "=v"(r) : "v"(lo), "v"(hi)); return r; }

template <class Epi, class Sched, bool ALIGN_EPI = false, bool SP2 = false>
__device__ __forceinline__ void gemm_phase(PG8_LAS unsigned char* lds, const Gemm g, const Sched& S, const Epi& E) {
    const int tid = tid_(), wid = __builtin_amdgcn_readfirstlane(tid >> 6), lane = tid & 63, wr = wid >> 2, wc = wid & 3, fr = lane & 15, fq = lane >> 4;
    const int K = g.K, nt = K / BK;
    unsigned voffA[2], voffB[2];
#pragma unroll
    for (int i = 0; i < 2; ++i) { int R, C; stage_rc(tid * 16 + i * 8192, R, C); const int Rb = Epi::PERM ? ((R & ~31) + perm32(R & 31)) : R;
        voffA[i] = (unsigned)(R * K + C) * 2u; voffB[i] = (unsigned)(Rb * K + C) * 2u; }
    const size_t kstep = (size_t)(BK * 2);
    const size_t hstep = (size_t)HALF * K * 2;
    const size_t tstep = 2 * hstep;
    const unsigned ldsw = (unsigned)wid * 1024u;
    const int aoff = lds_byte(wr * 64 + fr, fq * 8), boff = lds_byte(wc * 32 + fr, fq * 8);
#define PG8_SA(b, h) (((b) * 2 + (h)) * HTB)
#define PG8_SB(b, h) ((4 + (b) * 2 + (h)) * HTB)
#define PG8_STAGE(bufoff, gbase, voff) do { _Pragma("unroll") for (int _i = 0; _i < 2; ++_i) \
        __builtin_amdgcn_global_load_lds((const unsigned*)((const char*)(gbase) + (voff)[_i]), (PG8_LAS unsigned*)(lds + (bufoff) + ldsw + _i * 8192), 16, 0, 0); } while (0)
#define PG8_LDA(dst, b, h) do { _Pragma("unroll") for (int m = 0; m < 4; ++m) _Pragma("unroll") for (int k = 0; k < 2; ++k) dst[m][k] = *(const PG8_LAS bf16x8*)(lds + PG8_SA(b, h) + aoff + m * 2048 + k * 1024); } while (0)
#define PG8_LDB(dst, b, h) do { _Pragma("unroll") for (int n = 0; n < 2; ++n) _Pragma("unroll") for (int k = 0; k < 2; ++k) dst[n][k] = *(const PG8_LAS bf16x8*)(lds + PG8_SB(b, h) + boff + n * 2048 + k * 1024); } while (0)
#define PG8_MMA(ai, bj, At, Bt) do { __builtin_amdgcn_s_setprio(1); _Pragma("unroll") for (int m = 0; m < 4; ++m) _Pragma("unroll") for (int n = 0; n < 2; ++n) _Pragma("unroll") for (int k = 0; k < 2; ++k) \
        acc[ai][bj][m][n] = __builtin_amdgcn_mfma_f32_16x16x32_bf16(Bt[n][k], At[m][k], acc[ai][bj][m][n], 0, 0, 0); __builtin_amdgcn_s_setprio(0); } while (0)
#define PG8_WAIT_V(n) asm volatile("s_waitcnt vmcnt(" #n ")" ::: "memory")
#define PG8_WAIT_L(n) asm volatile("s_waitcnt lgkmcnt(" #n ")" ::: "memory")
#define PG8_BAR __builtin_amdgcn_s_barrier()
#define PG8_SCHED __builtin_amdgcn_sched_barrier(0)
    Unit cur, nxt; int ui = 0;
    if (!S.next(0, cur)) return;
    f32x4 acc[2][2][4][2];
#pragma unroll
    for (int a = 0; a < 2; ++a)
#pragma unroll
        for (int b = 0; b < 2; ++b)
#pragma unroll
            for (int m = 0; m < 4; ++m)
#pragma unroll
                for (int n = 0; n < 2; ++n) acc[a][b][m][n] = (f32x4){0.f, 0.f, 0.f, 0.f};
    bf16x8 At[4][2], B0[2][2], B1[2][2];
    const char* cA = (const char*)g.A + (size_t)cur.pm * tstep; const char* cB = (const char*)g.Bt + (size_t)cur.pn * tstep;
    S.a_ready(cur);
    if constexpr (SP2) {
        PG8_STAGE(PG8_SB(0, 0), cB, voffB); PG8_STAGE(PG8_SB(0, 1), cB + hstep, voffB); PG8_STAGE(PG8_SA(0, 0), cA, voffA); PG8_STAGE(PG8_SA(0, 1), cA + hstep, voffA);
        if (wr == 1) PG8_BAR;
        PG8_WAIT_V(2); PG8_BAR;
        PG8_STAGE(PG8_SB(1, 0), cB + kstep, voffB); PG8_STAGE(PG8_SA(1, 0), cA + kstep, voffA); PG8_STAGE(PG8_SB(1, 1), cB + hstep + kstep, voffB);
        PG8_WAIT_V(6); PG8_BAR;
    } else {
        PG8_STAGE(PG8_SB(0, 0), cB, voffB); PG8_STAGE(PG8_SA(0, 0), cA, voffA); PG8_STAGE(PG8_SB(0, 1), cB + hstep, voffB); PG8_STAGE(PG8_SA(0, 1), cA + hstep, voffA);
        if (wr == 1) PG8_BAR;
        PG8_WAIT_V(4); PG8_BAR;
        PG8_STAGE(PG8_SB(1, 0), cB + kstep, voffB); PG8_STAGE(PG8_SA(1, 0), cA + kstep, voffA); PG8_STAGE(PG8_SB(1, 1), cB + hstep + kstep, voffB);
        PG8_WAIT_V(6); PG8_BAR;
    }
    for (;;) {
        const bool has_next = S.next(ui + 1, nxt);
        const char* nA = has_next ? (const char*)g.A + (size_t)nxt.pm * tstep : cA; const char* nB = has_next ? (const char*)g.Bt + (size_t)nxt.pn * tstep : cB;
        for (int t = 0; t < nt; t += 2) {
            const bool last = (t == nt - 2);
            const char* a1 = cA + (size_t)(t + 1) * kstep;
            const char* a2 = last ? nA : cA + (size_t)(t + 2) * kstep; const char* b2 = last ? nB : cB + (size_t)(t + 2) * kstep;
            const char* a3 = a2 + kstep; const char* b3 = b2 + kstep;
            if (last && has_next) S.a_ready(nxt);
            if constexpr (SP2) {
            PG8_LDB(B0, 0, 0); PG8_LDB(B1, 0, 1); PG8_SCHED; PG8_LDA(At, 0, 0); PG8_STAGE(PG8_SA(1, 1), a1 + hstep, voffA);
            PG8_WAIT_V(8); PG8_WAIT_L(0); PG8_BAR; PG8_MMA(0, 0, At, B0); PG8_MMA(0, 1, At, B1); PG8_BAR; PG8_SCHED;
            PG8_LDA(At, 0, 1); PG8_STAGE(PG8_SB(0, 0), b2, voffB); PG8_STAGE(PG8_SB(0, 1), b2 + hstep, voffB); PG8_STAGE(PG8_SA(0, 0), a2, voffA);
            PG8_WAIT_V(8); PG8_WAIT_L(0); PG8_BAR; PG8_MMA(1, 0, At, B0); PG8_MMA(1, 1, At, B1); PG8_BAR; PG8_SCHED;
            PG8_LDB(B0, 1, 0); PG8_LDB(B1, 1, 1); PG8_SCHED; PG8_LDA(At, 1, 0); PG8_STAGE(PG8_SA(0, 1), a2 + hstep, voffA);
            PG8_WAIT_V(8); PG8_WAIT_L(0); PG8_BAR; PG8_MMA(0, 0, At, B0); PG8_MMA(0, 1, At, B1); PG8_BAR; PG8_SCHED;
            PG8_LDA(At, 1, 1); PG8_STAGE(PG8_SB(1, 0), b3, voffB); PG8_STAGE(PG8_SB(1, 1), b3 + hstep, voffB); PG8_STAGE(PG8_SA(1, 0), a3, voffA);
            PG8_WAIT_V(8); PG8_WAIT_L(0); PG8_BAR; PG8_MMA(1, 0, At, B0); PG8_MMA(1, 1, At, B1); PG8_BAR; PG8_SCHED;
            } else {
            PG8_LDB(B0, 0, 0); PG8_SCHED; PG8_LDA(At, 0, 0); PG8_STAGE(PG8_SA(1, 1), a1 + hstep, voffA);
            PG8_WAIT_L(8); PG8_BAR; PG8_WAIT_L(0); PG8_MMA(0, 0, At, B0); PG8_BAR; PG8_SCHED;
            PG8_LDB(B1, 0, 1); PG8_STAGE(PG8_SB(0, 0), b2, voffB);
            PG8_BAR; PG8_WAIT_L(0); PG8_MMA(0, 1, At, B1); PG8_BAR;
            PG8_LDA(At, 0, 1); PG8_STAGE(PG8_SA(0, 0), a2, voffA);
            PG8_BAR; PG8_WAIT_L(0); PG8_MMA(1, 0, At, B0); PG8_BAR; PG8_SCHED;
            PG8_STAGE(PG8_SB(0, 1), b2 + hstep, voffB);
            PG8_WAIT_V(6); PG8_BAR; PG8_MMA(1, 1, At, B1); PG8_BAR;
            PG8_LDB(B0, 1, 0); PG8_SCHED; PG8_LDA(At, 1, 0); PG8_STAGE(PG8_SA(0, 1), a2 + hstep, voffA);
            PG8_WAIT_L(8); PG8_BAR; PG8_WAIT_L(0); PG8_MMA(0, 0, At, B0); PG8_BAR; PG8_SCHED;
            PG8_LDB(B1, 1, 1); PG8_STAGE(PG8_SB(1, 0), b3, voffB);
            PG8_BAR; PG8_WAIT_L(0); PG8_MMA(0, 1, At, B1); PG8_BAR;
            PG8_LDA(At, 1, 1); PG8_STAGE(PG8_SA(1, 0), a3, voffA);
            PG8_BAR; PG8_WAIT_L(0); PG8_MMA(1, 0, At, B0); PG8_BAR; PG8_SCHED;
            PG8_STAGE(PG8_SB(1, 1), b3 + hstep, voffB);
            PG8_WAIT_V(6); PG8_BAR; PG8_MMA(1, 1, At, B1); PG8_BAR;
            }
        }
        if constexpr (ALIGN_EPI) { if (wr == 0) PG8_BAR; }
        if constexpr (!Epi::AFTER_DRAIN) { E(acc, cur, wr, wc, fr, fq); S.done(cur); }
        if (!has_next) break;
#pragma unroll
        for (int a = 0; a < 2; ++a)
#pragma unroll
            for (int b = 0; b < 2; ++b)
#pragma unroll
                for (int m = 0; m < 4; ++m)
#pragma unroll
                    for (int n = 0; n < 2; ++n) acc[a][b][m][n] = (f32x4){0.f, 0.f, 0.f, 0.f};
        cur = nxt; cA = nA; cB = nB; ++ui;
        if constexpr (ALIGN_EPI) { if (wr == 1) PG8_BAR; }
    }
    PG8_WAIT_V(0);
    if constexpr (!ALIGN_EPI) { if (wr == 0) PG8_BAR; }
    PG8_BAR;
    if constexpr (Epi::AFTER_DRAIN) { E.fused(acc, cur, wr, wc, fr, fq, lds, wid, lane); S.done(cur); }
#undef PG8_SA
#undef PG8_SB
#undef PG8_STAGE
#undef PG8_LDA
#undef PG8_LDB
#undef PG8_MMA
#undef PG8_WAIT_V
#undef PG8_WAIT_L
#undef PG8_BAR
#undef PG8_SCHED
}
}

struct EpiInProjP {
    static constexpr bool PERM = true, AFTER_DRAIN = false;
    bf16_t *PC, *PS, *PR, *PG, *VT;
    __device__ __forceinline__ void operator()(const pg8::f32x4 (&acc)[2][2][4][2], const pg8::Unit& u, int wr, int wc, int fr, int fq) const {
        const int row0 = u.pm * 256 + wr * 64 + fr;
#pragma unroll
        for (int bj = 0; bj < 2; ++bj) {
            const int blk = 2 * u.pn + bj; bf16_t* base; int ld, c0;
            if (blk >= 12 && blk < 15) {
                const int vc = 128 * (blk - 12) + wc * 32 + 8 * fq;
#pragma unroll
                for (int ai = 0; ai < 2; ++ai)
#pragma unroll
                    for (int m = 0; m < 4; ++m) {
                        const int row = row0 + ai * 128 + m * 16, b = row >> 11, t = row & 2047;
#pragma unroll
                        for (int n = 0; n < 2; ++n)
#pragma unroll
                            for (int e = 0; e < 4; ++e) { const int col = vc + 4 * n + e, hh = col >> 6, d = col & 63;
                                VT[((size_t)(b * NH + hh) * HD + d) * SEQ + t] = f2bf(acc[ai][bj][m][n][e]); }
                    }
                continue;
            }
            if (blk < 6) { base = PC; ld = PC_W; c0 = 128 * blk; }
            else if (blk < 12) { base = PS; ld = PS_W; c0 = 128 * (blk - 6); }
            else if (blk < 18) { base = PS; ld = PS_W; c0 = 768 + 128 * (blk - 15); }
            else if (blk < 28) { base = PR; ld = PR_W; c0 = 128 * (blk - 18); }
            else if (blk < 31) { base = PG; ld = PG_W; c0 = 128 * (blk - 28); }
            else continue;
            const int col = c0 + wc * 32 + 8 * fq;
#pragma unroll
            for (int ai = 0; ai < 2; ++ai)
#pragma unroll
                for (int m = 0; m < 4; ++m) {
                    const pg8::f32x4 v0 = acc[ai][bj][m][0], v1 = acc[ai][bj][m][1]; pg8::u32x4 w;
                    w.x = pg8::cvt_pk_bf16(v0[0], v0[1]); w.y = pg8::cvt_pk_bf16(v0[2], v0[3]); w.z = pg8::cvt_pk_bf16(v1[0], v1[1]); w.w = pg8::cvt_pk_bf16(v1[2], v1[3]);
                    *(pg8::u32x4*)(base + (size_t)(row0 + ai * 128 + m * 16) * ld + col) = w;
                }
        }
    }
};
struct EpiOutBf16P {
    static constexpr bool PERM = true, AFTER_DRAIN = false;
    bf16_t* Y; int ld;
    __device__ __forceinline__ void operator()(const pg8::f32x4 (&acc)[2][2][4][2], const pg8::Unit& u, int wr, int wc, int fr, int fq) const {
        const int row0 = u.pm * 256 + wr * 64 + fr, col0 = u.pn * 256 + wc * 32 + 8 * fq;
#pragma unroll
        for (int ai = 0; ai < 2; ++ai)
#pragma unroll
            for (int m = 0; m < 4; ++m)
#pragma unroll
                for (int bj = 0; bj < 2; ++bj) {
                    const pg8::f32x4 v0 = acc[ai][bj][m][0], v1 = acc[ai][bj][m][1]; pg8::u32x4 w;
                    w.x = pg8::cvt_pk_bf16(v0[0], v0[1]); w.y = pg8::cvt_pk_bf16(v0[2], v0[3]); w.z = pg8::cvt_pk_bf16(v1[0], v1[1]); w.w = pg8::cvt_pk_bf16(v1[2], v1[3]);
                    *(pg8::u32x4*)(Y + (size_t)(row0 + ai * 128 + m * 16) * ld + col0 + bj * 128) = w;
                }
    }
};

__device__ void phase_rowpass(const float* Xin, const bf16_t* Y, const float* gpost, float* Xout, bf16_t* XB) {
    const int tid = tid_(), lane = tid & 63, wave = __builtin_amdgcn_readfirstlane(tid >> 6);
    for (int row = blockIdx.x * 8 + wave; row < M; row += gridDim.x * 8) {
        f32x4 y[4], x[4]; float ss = 0.f;
#pragma unroll
        for (int i = 0; i < 4; ++i) { const uint2 yw = *(const uint2*)(Y + (size_t)row * DM + i * 256 + lane * 4);
            y[i] = (f32x4){bf2f((bf16_t)(yw.x & 0xffff)), bf2f((bf16_t)(yw.x >> 16)), bf2f((bf16_t)(yw.y & 0xffff)), bf2f((bf16_t)(yw.y >> 16))};
            x[i] = *(const f32x4*)(Xin + (size_t)row * DM + i * 256 + lane * 4);
            ss += y[i][0] * y[i][0] + y[i][1] * y[i][1] + y[i][2] * y[i][2] + y[i][3] * y[i][3]; }
        ss = wave_sum(ss);
        const float rstd = rsqrtf(ss * (1.0f / DM) + RMS_EPS);
        float s2 = 0.f;
#pragma unroll
        for (int i = 0; i < 4; ++i) { const f32x4 g = *(const f32x4*)(gpost + i * 256 + lane * 4);
            x[i] = x[i] + y[i] * rstd * g; s2 += x[i][0] * x[i][0] + x[i][1] * x[i][1] + x[i][2] * x[i][2] + x[i][3] * x[i][3];
            *(f32x4*)(Xout + (size_t)row * DM + i * 256 + lane * 4) = x[i]; }
        if (XB) {
            s2 = wave_sum(s2);
            const float r2 = rsqrtf(s2 * (1.0f / DM) + RMS_EPS);
#pragma unroll
            for (int i = 0; i < 4; ++i) { uint2 w; w.x = pk2(x[i][0] * r2, x[i][1] * r2); w.y = pk2(x[i][2] * r2, x[i][3] * r2); *(uint2*)(XB + (size_t)row * DM + i * 256 + lane * 4) = w; }
        }
    }
}

__device__ void conv_job(const Params& p, int l, int job, float* lds) {
    const int tid = tid_(), lane = tid & 63, wave = __builtin_amdgcn_readfirstlane(tid >> 6);
    const int b = job / (SEQ / 32), t0 = (job % (SEQ / 32)) * 32;
    const bf16_t* PC = (const bf16_t*)(p.ws + WS_PC); bf16_t* MIX = (bf16_t*)(p.ws + WS_MIX);
    const float* dw = p.in[5] + l * TAPS * CW; const float* dwb = p.in[6] + l * CW; const float* lng = p.in[7] + l * CW; const float* lnb = p.in[8] + l * CW;
    const float* pw = p.in[9] + (size_t)l * CW * CW; const float* pwb = p.in[10] + l * CW;
    float* u = lds;
    float* cv = lds + 62 * 256;
    for (int idx = tid; idx < 62 * 256; idx += 512) {
        const int r = idx >> 8, c = idx & 255, t = t0 - 30 + r;
        float v = 0.f;
        if (t >= 0) { const bf16_t* pr = PC + (size_t)(b * SEQ + t) * PC_W; v = bf2f(pr[c]) * sigmoidf_(bf2f(pr[256 + c])); }
        u[idx] = v;
    }
    __syncthreads();
    for (int idx = tid; idx < 32 * 256; idx += 512) {
        const int tt = idx >> 8, c = idx & 255;
        float a = dwb[c];
#pragma unroll 4
        for (int j = 0; j < TAPS; ++j) a += dw[j * CW + c] * u[(tt + j) * 256 + c];
        cv[idx] = a;
    }
    __syncthreads();
    for (int q = 0; q < 4; ++q) {
        const int tt = wave * 4 + q; float x[4], s = 0.f;
#pragma unroll
        for (int i = 0; i < 4; ++i) { x[i] = cv[tt * 256 + lane + 64 * i]; s += x[i]; }
        const float mean = wave_sum(s) * (1.0f / CW); float vs = 0.f;
#pragma unroll
        for (int i = 0; i < 4; ++i) { const float d = x[i] - mean; vs += d * d; }
        const float rstd = rsqrtf(wave_sum(vs) * (1.0f / CW) + LN_EPS);
#pragma unroll
        for (int i = 0; i < 4; ++i) { const int c = lane + 64 * i; cv[tt * 256 + c] = siluf_((x[i] - mean) * rstd * lng[c] + lnb[c]); }
    }
    __syncthreads();
    {
        const int n = tid & 255, half = tid >> 8;
        float acc[16];
#pragma unroll
        for (int i = 0; i < 16; ++i) acc[i] = pwb[n];
#pragma unroll 2
        for (int k = 0; k < CW; ++k) {
            const float w = pw[(size_t)k * CW + n];
#pragma unroll
            for (int i = 0; i < 16; ++i) acc[i] += cv[(half * 16 + i) * 256 + k] * w;
        }
#pragma unroll
        for (int i = 0; i < 16; ++i) { const size_t row = (size_t)b * SEQ + t0 + half * 16 + i;
            const float g = bf2f(PC[row * PC_W + 512 + n]);
            MIX[row * DM + n] = f2bf(acc[i] * siluf_(g)); }
    }
    __syncthreads();
}

constexpr int CV_AS = 264;
__device__ void conv_job64(const Params& p, int l, int job, unsigned char* lds) {
    const int tid = tid_(), lane = tid & 63, wave = __builtin_amdgcn_readfirstlane(tid >> 6), fr = lane & 15, fq = lane >> 4;
    const int b = job >> 5, t0 = (job & 31) * 64;
    const bf16_t* PC = (const bf16_t*)(p.ws + WS_PC); bf16_t* MIX = (bf16_t*)(p.ws + WS_MIX);
    const float* dw = p.in[5] + l * TAPS * CW; const float* dwb = p.in[6] + l * CW; const float* lng = p.in[7] + l * CW; const float* lnb = p.in[8] + l * CW;
    const bf16_t* pwT = (const bf16_t*)(p.ws + WS_WPW) + (size_t)l * CW * CW; const float* pwb = p.in[10] + l * CW;
    float* u = (float*)lds;
    bf16_t* act = (bf16_t*)(lds + 94 * 256 * 4);
    for (int idx = tid; idx < 94 * 32; idx += 512) {
        const int r = idx >> 5, c8 = (idx & 31) * 8, t = t0 - 30 + r;
        float v[8];
        if (t >= 0) { const bf16_t* pr = PC + ((size_t)b * SEQ + t) * PC_W + c8; const bf16x8 a = *(const bf16x8*)pr, g = *(const bf16x8*)(pr + 256);
#pragma unroll
            for (int e = 0; e < 8; ++e) v[e] = bf2f((bf16_t)a[e]) * __builtin_amdgcn_rcpf(1.0f + __builtin_amdgcn_exp2f(-1.4426950408889634f * bf2f((bf16_t)g[e]))); }
        else {
#pragma unroll
            for (int e = 0; e < 8; ++e) v[e] = 0.f; }
        *(f32x4*)(u + r * 256 + c8) = (f32x4){v[0], v[1], v[2], v[3]}; *(f32x4*)(u + r * 256 + c8 + 4) = (f32x4){v[4], v[5], v[6], v[7]};
    }
    __syncthreads();
    const int c = tid & 255, half = tid >> 8;
    float acc[32];
    {
        float w[TAPS];
#pragma unroll
        for (int j = 0; j < TAPS; ++j) w[j] = dw[j * CW + c];
        const float bias = dwb[c];
#pragma unroll
        for (int i = 0; i < 32; ++i) acc[i] = bias;
        const float* up = u + (half * 32) * 256 + c;
#pragma unroll
        for (int rr = 0; rr < 62; ++rr) {
            const float uv = up[rr * 256];
#pragma unroll
            for (int i = 0; i < 32; ++i) { if (rr - i >= 0 && rr - i < TAPS) acc[i] += w[rr - i] * uv; }
        }
    }
    __syncthreads();
    float* cv = u;
#pragma unroll
    for (int i = 0; i < 32; ++i) cv[(half * 32 + i) * 256 + c] = acc[i];
    __syncthreads();
#pragma unroll 2
    for (int q = 0; q < 8; ++q) {
        const int tt = wave * 8 + q; const f32x4 x = *(const f32x4*)(cv + tt * 256 + lane * 4);
        const float mean = wave_sum(x[0] + x[1] + x[2] + x[3]) * (1.0f / CW);
        const f32x4 d = x - mean;
        const float rstd = rsqrtf(wave_sum(d[0] * d[0] + d[1] * d[1] + d[2] * d[2] + d[3] * d[3]) * (1.0f / CW) + LN_EPS);
        const f32x4 g = *(const f32x4*)(lng + lane * 4), bb = *(const f32x4*)(lnb + lane * 4);
        float y[4];
#pragma unroll
        for (int e = 0; e < 4; ++e) { const float v = d[e] * rstd * g[e] + bb[e]; y[e] = v * __builtin_amdgcn_rcpf(1.0f + __builtin_amdgcn_exp2f(-1.4426950408889634f * v)); }
        uint2 w; w.x = pk2(y[0], y[1]); w.y = pk2(y[2], y[3]); *(uint2*)(act + tt * CV_AS + lane * 4) = w;
    }
    __syncthreads();
    {
        f32x4 o[2][4];
#pragma unroll
        for (int i = 0; i < 2; ++i)
#pragma unroll
            for (int j = 0; j < 4; ++j) o[i][j] = (f32x4){0.f, 0.f, 0.f, 0.f};
#pragma unroll 2
        for (int kk = 0; kk < 8; ++kk) {
            bf16x8 a[2], bq[4];
#pragma unroll
            for (int i = 0; i < 2; ++i) a[i] = *(const bf16x8*)(pwT + (size_t)(wave * 32 + i * 16 + fr) * CW + kk * 32 + fq * 8);
#pragma unroll
            for (int j = 0; j < 4; ++j) bq[j] = *(const bf16x8*)(act + (j * 16 + fr) * CV_AS + kk * 32 + fq * 8);
#pragma unroll
            for (int i = 0; i < 2; ++i)
#pragma unroll
                for (int j = 0; j < 4; ++j) o[i][j] = __builtin_amdgcn_mfma_f32_16x16x32_bf16(a[i], bq[j], o[i][j], 0, 0, 0);
        }
#pragma unroll
        for (int i = 0; i < 2; ++i) {
            const int n0 = wave * 32 + i * 16 + fq * 4; const f32x4 bias = *(const f32x4*)(pwb + n0);
#pragma unroll
            for (int j = 0; j < 4; ++j) {
                const size_t row = (size_t)b * SEQ + t0 + j * 16 + fr;
                const uint2 gw = *(const uint2*)(PC + row * PC_W + 512 + n0);
                const float g0 = bf2f((bf16_t)(gw.x & 0xffff)), g1 = bf2f((bf16_t)(gw.x >> 16)), g2 = bf2f((bf16_t)(gw.y & 0xffff)), g3 = bf2f((bf16_t)(gw.y >> 16));
                const f32x4 v = o[i][j] + bias;
                uint2 w; w.x = pk2(v[0] * siluf_(g0), v[1] * siluf_(g1)); w.y = pk2(v[2] * siluf_(g2), v[3] * siluf_(g3));
                *(uint2*)(MIX + row * DM + n0) = w;
            }
        }
    }
    __syncthreads();
}

__device__ void attn_job(const Params& p, int job) {
    const int tid = tid_(), lane = tid & 63, wave = __builtin_amdgcn_readfirstlane(tid >> 6);
    const int bh = job >> 2, qb = job & 3, b = bh / NH, h = bh % NH;
    const bf16_t* PS = (const bf16_t*)(p.ws + WS_PS); bf16_t* MIX = (bf16_t*)(p.ws + WS_MIX);
    const int tw = qb * 512 + wave * 64, t = tw + lane;
    const size_t row = (size_t)b * SEQ + t;
    const float qs = 1.0f;
    const bf16_t* VT = (const bf16_t*)(p.ws + WS_VT) + (size_t)bh * HD * SEQ;
    float q[64], o[64];
    {
        const bf16_t* qp = PS + row * PS_W + h * HD;
#pragma unroll
        for (int i = 0; i < 8; ++i) { const bf16x8 v = *(const bf16x8*)(qp + i * 8);
#pragma unroll
            for (int j = 0; j < 8; ++j) { q[i * 8 + j] = bf2f((bf16_t)v[j]) * qs; o[i * 8 + j] = 0.f; } }
    }
    float rp = 1.0f;
    const int z = opaque_zero();
    for (int s = tw + 62; s >= 0; --s) {
        const bf16_t* kp = PS + ((size_t)b * SEQ + s) * PS_W + 384 + h * HD + z;
        float dot = 0.f;
#pragma unroll
        for (int i = 0; i < 8; ++i) { const bf16x8 v = *(const bf16x8*)(kp + i * 8);
#pragma unroll
            for (int j = 0; j < 8; ++j) dot += q[i * 8 + j] * bf2f((bf16_t)v[j]); }
        const bool act = s < t;
        const float e = __builtin_amdgcn_exp2f(dot);
        const float keep = __builtin_amdgcn_rcpf(1.0f + e);
        const float pr = act ? (1.0f - keep) * rp : 0.f;
        rp = act ? rp * keep : rp;
#pragma unroll
        for (int d = 0; d < 64; ++d) o[d] += pr * bf2f(VT[(size_t)d * SEQ + s + z]);
        if (__all(rp == 0.0f)) break;
    }
    const bf16_t* gp = PS + row * PS_W + 768 + h * HD;
    bf16_t* op = MIX + row * DM + CW + h * HD;
#pragma unroll
    for (int i = 0; i < 8; ++i) { const bf16x8 g = *(const bf16x8*)(gp + i * 8); uint4 w;
        w.x = pk2(o[i * 8 + 0] * siluf_(bf2f((bf16_t)g[0])), o[i * 8 + 1] * siluf_(bf2f((bf16_t)g[1])));
        w.y = pk2(o[i * 8 + 2] * siluf_(bf2f((bf16_t)g[2])), o[i * 8 + 3] * siluf_(bf2f((bf16_t)g[3])));
        w.z = pk2(o[i * 8 + 4] * siluf_(bf2f((bf16_t)g[4])), o[i * 8 + 5] * siluf_(bf2f((bf16_t)g[5])));
        w.w = pk2(o[i * 8 + 6] * siluf_(bf2f((bf16_t)g[6])), o[i * 8 + 7] * siluf_(bf2f((bf16_t)g[7])));
        *(uint4*)(op + i * 8) = w; }
}

typedef float f32x16 __attribute__((ext_vector_type(16)));
__device__ void attn_mfma_wave(const Params& p, int bh, int qblk) {
    const int tid = tid_(), lane = tid & 63, qi = lane & 31, hf = lane >> 5;
    const int b = bh / NH, h = bh % NH, q0 = qblk * 32;
    const bf16_t* PS = (const bf16_t*)(p.ws + WS_PS); const bf16_t* VT = (const bf16_t*)(p.ws + WS_VT) + (size_t)bh * HD * SEQ; bf16_t* MIX = (bf16_t*)(p.ws + WS_MIX);
    const size_t rowq = (size_t)b * SEQ + q0 + qi;
    bf16x8 Qf[4];
#pragma unroll
    for (int ks = 0; ks < 4; ++ks) Qf[ks] = *(const bf16x8*)(PS + rowq * PS_W + h * HD + ks * 16 + hf * 8);
    const int pi = (qi & 3) + 4 * (qi >> 3) + 16 * ((qi >> 2) & 1);
    const bf16_t* kbase = PS + ((size_t)b * SEQ + pi) * PS_W + SBW + h * HD + hf * 8;
    const bf16_t* vbase = VT + (size_t)qi * SEQ + hf * 16;
    f32x16 O0, O1;
#pragma unroll
    for (int r = 0; r < 16; ++r) { O0[r] = 0.f; O1[r] = 0.f; }
    float rp = 1.0f;
    for (int kt = qblk; kt >= 0; --kt) {
        const int s0 = kt * 32;
        bf16x8 Kf[4], Vf[2][2];
#pragma unroll
        for (int ks = 0; ks < 4; ++ks) Kf[ks] = *(const bf16x8*)(kbase + (size_t)s0 * PS_W + ks * 16);
#pragma unroll
        for (int db = 0; db < 2; ++db)
#pragma unroll
            for (int s = 0; s < 2; ++s) Vf[db][s] = *(const bf16x8*)(vbase + (size_t)db * 32 * SEQ + s0 + s * 8);
        f32x16 S;
#pragma unroll
        for (int r = 0; r < 16; ++r) S[r] = 0.f;
#pragma unroll
        for (int ks = 0; ks < 4; ++ks) S = __builtin_amdgcn_mfma_f32_32x32x16_bf16(Kf[ks], Qf[ks], S, 0, 0, 0);
        float keep[16], beta[16];
        const bool diag = kt == qblk;
        float tot = 1.0f;
#pragma unroll
        for (int r = 0; r < 16; ++r) {
            const float e = __builtin_amdgcn_exp2f(S[r]);
            float k_ = __builtin_amdgcn_rcpf(1.0f + e);
            float b_ = 1.0f - k_;
            if (diag && (hf * 16 + r >= qi)) { k_ = 1.0f; b_ = 0.f; }
            keep[r] = k_; beta[r] = b_; tot *= k_;
        }
        const float toto = __shfl_xor(tot, 32);
        float e = hf ? rp : rp * toto;
        float pw[16];
#pragma unroll
        for (int r = 15; r >= 0; --r) { pw[r] = beta[r] * e; e *= keep[r]; }
        rp = rp * tot * toto;
        bf16x8 Pf[2];
#pragma unroll
        for (int s = 0; s < 2; ++s) {
            union { bf16x8 v; unsigned u[4]; } pk;
#pragma unroll
            for (int j = 0; j < 4; ++j) pk.u[j] = pk2(pw[8 * s + 2 * j], pw[8 * s + 2 * j + 1]);
            Pf[s] = pk.v;
        }
#pragma unroll
        for (int s = 0; s < 2; ++s) { O0 = __builtin_amdgcn_mfma_f32_32x32x16_bf16(Vf[0][s], Pf[s], O0, 0, 0, 0); O1 = __builtin_amdgcn_mfma_f32_32x32x16_bf16(Vf[1][s], Pf[s], O1, 0, 0, 0); }
        if (__ballot(rp != 0.0f) == 0ull) break;
    }
    const bf16_t* gp = PS + rowq * PS_W + 768 + h * HD; bf16_t* op = MIX + rowq * DM + CW + h * HD;
#pragma unroll
    for (int db = 0; db < 2; ++db)
#pragma unroll
        for (int g = 0; g < 4; ++g) {
            const int d0 = db * 32 + g * 8 + hf * 4;
            const uint2 gw = *(const uint2*)(gp + d0);
            const float g0 = bf2f((bf16_t)(gw.x & 0xffff)), g1 = bf2f((bf16_t)(gw.x >> 16)), g2 = bf2f((bf16_t)(gw.y & 0xffff)), g3 = bf2f((bf16_t)(gw.y >> 16));
            const f32x16& O = db ? O1 : O0;
            uint2 w; w.x = pk2(O[4 * g] * siluf_(g0), O[4 * g + 1] * siluf_(g1)); w.y = pk2(O[4 * g + 2] * siluf_(g2), O[4 * g + 3] * siluf_(g3));
            *(uint2*)(op + d0) = w;
        }
}

__device__ void rwkv_job(const Params& p, int l, int job, float* lds) {
    const int tid = tid_(), lane = tid & 63, wave = __builtin_amdgcn_readfirstlane(tid >> 6);
    const int b = job / NH, h = job % NH;
    const bf16_t* PR = (const bf16_t*)(p.ws + WS_PR); const bf16_t* PG = (const bf16_t*)(p.ws + WS_PG);
    float* VF = (float*)(p.ws + WS_VF); bf16_t* MIX = (bf16_t*)(p.ws + WS_MIX);
    const float* mu = p.in[11] + l * 1216; const float* w0 = p.in[12] + l * RWW; const float* w2 = p.in[13] + l * LORA * RWW;
    const float* a0 = p.in[14] + l * RWW; const float* a2 = p.in[15] + l * LORA * RWW; const float* kks = p.in[16] + l * RWW; const float* ka = p.in[17] + l * RWW;
    const float* rk = p.in[18] + l * RWW; const float* gng = p.in[19] + l * RWW; const float* gnb = p.in[20] + l * RWW;
    const float* v0 = p.in[21]; const float* v1 = p.in[22]; const float* v2 = p.in[23];
    float* R = lds; float* W = R + 4096; float* K = W + 4096; float* V = K + 4096; float* A = V + 4096; float* Bm = A + 4096; float* Y = Bm + 4096;
    float* WD = Y + 4096; float* AD = WD + 2048; float* VL = AD + 2048;
    float S[64];
#pragma unroll
    for (int i = 0; i < 64; ++i) S[i] = 0.f;
    for (int c = 0; c < SEQ / 64; ++c) {
        const int t0 = c * 64;
        for (int idx = tid; idx < 64 * 64; idx += 512) {
            const int tt = idx >> 6, i = idx & 63, t = t0 + tt;
            const bf16_t* cur = PR + ((size_t)b * SEQ + t) * PR_W;
            const float xc = bf2f(cur[1152 + i]), xp = t > 0 ? bf2f(cur[1152 + i - PR_W]) : 0.f;
            const float f = xc + (xp - xc) * mu[1152 + i];
            if (i < 32) WD[tt * 32 + i] = tanhf(f); else AD[tt * 32 + i - 32] = f;
        }
        if (l > 0) {
            for (int idx = tid; idx < 64 * 32; idx += 512) {
                const int tt = idx >> 5, i = idx & 31, t = t0 + tt;
                const bf16_t* cur = PR + ((size_t)b * SEQ + t) * PR_W + 768;
                float a = 0.f;
                for (int cc = 0; cc < RWW; ++cc) {
                    const float xc = bf2f(cur[cc]), xp = t > 0 ? bf2f(cur[cc - PR_W]) : 0.f;
                    a += (xc + (xp - xc) * mu[768 + cc]) * v1[cc * LORA + i];
                }
                VL[idx] = a;
            }
        }
        __syncthreads();
        for (int idx = tid; idx < 64 * 64; idx += 512) {
            const int tt = idx >> 6, j = idx & 63, t = t0 + tt, cj = h * HD + j;
            const size_t row = (size_t)b * SEQ + t;
            const bf16_t* cur = PR + row * PR_W;
            const bool hp = t > 0;
            float rc = bf2f(cur[cj]), kc = bf2f(cur[384 + cj]), vc = bf2f(cur[768 + cj]);
            const float rp_ = hp ? bf2f(cur[cj - PR_W]) : 0.f, kp_ = hp ? bf2f(cur[384 + cj - PR_W]) : 0.f, vp_ = hp ? bf2f(cur[768 + cj - PR_W]) : 0.f;
            rc += (rp_ - rc) * mu[cj]; kc += (kp_ - kc) * mu[384 + cj]; vc += (vp_ - vc) * mu[768 + cj];
            float wl = w0[cj], al = a0[cj];
#pragma unroll 8
            for (int i = 0; i < LORA; ++i) { wl += WD[tt * 32 + i] * w2[i * RWW + cj]; al += AD[tt * 32 + i] * a2[i * RWW + cj]; }
            const float sp = fmaxf(-wl, 0.f) + log1pf(__expf(-fabsf(wl)));
            const float decay = __expf(-__expf(-sp - 0.5f));
            const float alr = sigmoidf_(al);
            if (l > 0) {
                float vg = v0[cj];
#pragma unroll 8
                for (int i = 0; i < LORA; ++i) vg += VL[tt * 32 + i] * v2[i * RWW + cj];
                vg = sigmoidf_(vg);
                vc = vc + (VF[row * RWW + cj] - vc) * vg;
            } else VF[row * RWW + cj] = vc;
            R[idx] = rc; W[idx] = decay; V[idx] = vc;
            K[idx] = kc * (1.0f + (alr - 1.0f) * ka[cj]);
            A[idx] = kc * kks[cj];
            Bm[idx] = alr;
        }
        __syncthreads();
        for (int q = 0; q < 8; ++q) {
            const int tt = wave * 8 + q; const float kk = A[tt * 64 + lane];
            const float nrm = sqrtf(wave_sum(kk * kk));
            const float kn = kk / fmaxf(nrm, 1e-12f);
            A[tt * 64 + lane] = -kn; Bm[tt * 64 + lane] = kn * Bm[tt * 64 + lane];
        }
        __syncthreads();
        if (wave == 0) {
            for (int tt = 0; tt < 64; ++tt) {
                const f32x4* a4 = (const f32x4*)(A + tt * 64); const f32x4* w4 = (const f32x4*)(W + tt * 64); const f32x4* b4 = (const f32x4*)(Bm + tt * 64);
                const f32x4* k4 = (const f32x4*)(K + tt * 64); const f32x4* r4 = (const f32x4*)(R + tt * 64);
                float sa = 0.f;
#pragma unroll
                for (int i = 0; i < 16; ++i) { const f32x4 a = a4[i]; sa += S[4 * i] * a[0] + S[4 * i + 1] * a[1] + S[4 * i + 2] * a[2] + S[4 * i + 3] * a[3];
                    if ((i & 7) == 7) asm volatile("" ::: "memory"); }
                const float vv = V[tt * 64 + lane];
                float y = 0.f;
#pragma unroll
                for (int i = 0; i < 16; ++i) { const f32x4 w = w4[i], bb = b4[i], kk = k4[i], rr = r4[i];
#pragma unroll
                    for (int e = 0; e < 4; ++e) { const float s = S[4 * i + e] * w[e] + sa * bb[e] + vv * kk[e]; S[4 * i + e] = s; y += s * rr[e]; }
                    if ((i & 1) == 1) asm volatile("" ::: "memory"); }
                Y[tt * 64 + lane] = y;
            }
        }
        __syncthreads();
        for (int q = 0; q < 8; ++q) {
            const int tt = wave * 8 + q, t = t0 + tt, cj = h * HD + lane; const size_t row = (size_t)b * SEQ + t;
            const float y = Y[tt * 64 + lane];
            const float mean = wave_sum(y) * (1.0f / HD); const float d = y - mean;
            const float var = wave_sum(d * d) * (1.0f / HD);
            const float yn = d * rsqrtf(var + GN_EPS) * gng[cj] + gnb[cj];
            const float bonus = wave_sum(R[tt * 64 + lane] * K[tt * 64 + lane] * rk[cj]);
            const float o = yn + bonus * V[tt * 64 + lane];
            const float g = bf2f(PG[row * PG_W + cj]);
            MIX[row * DM + CW + SBW + cj] = f2bf(o * siluf_(g));
        }
        __syncthreads();
    }
}

constexpr int TS = 72;
constexpr int TILE_B = 64 * TS * 2;
constexpr int AABS = 68, XTS = 65, CSS = 65;

__device__ __forceinline__ f32x4 mm_tile(const bf16_t* X, int m0, const bf16_t* Yt, int n0, int K, int fr, int fq, f32x4 acc) {
#pragma unroll
    for (int kk = 0; kk < 2; ++kk) {
        if (kk * 32 < K) {
            const bf16x8 a = *(const bf16x8*)(X + (m0 + fr) * TS + kk * 32 + fq * 8);
            const bf16x8 b = *(const bf16x8*)(Yt + (n0 + fr) * TS + kk * 32 + fq * 8);
            acc = __builtin_amdgcn_mfma_f32_16x16x32_bf16(a, b, acc, 0, 0, 0);
        }
    }
    return acc;
}
__device__ __forceinline__ uint2 pk4(const f32x4& v) { uint2 w; w.x = pk2(v[0], v[1]); w.y = pk2(v[2], v[3]); return w; }

struct B1Loads {
    bf16x8 rc, kc, vc, rp, kp, vp;
    f32x4 vf0, vf1;
    bf16x8 cc[2], cp[2];
};
__device__ __forceinline__ void b1_issue_loads(const Params& p, int l, int gi, int h, int tid, B1Loads& L) {
    const int b = gi >> 5, c = gi & 31, t0 = c * 64;
    const bf16_t* PR = (const bf16_t*)(p.ws + WS_PR); const float* VF = (const float*)(p.ws + WS_VF);
    {
        const int tt = tid >> 3, j0 = (tid & 7) * 8, t = t0 + tt, cj0 = h * HD + j0; const size_t row = (size_t)b * SEQ + t;
        const bf16_t* cur = PR + row * PR_W; const bf16_t* prv = cur - (t > 0 ? PR_W : 0);
        L.rc = *(const bf16x8*)(cur + cj0); L.kc = *(const bf16x8*)(cur + 384 + cj0); L.vc = *(const bf16x8*)(cur + 768 + cj0);
        L.rp = *(const bf16x8*)(prv + cj0); L.kp = *(const bf16x8*)(prv + 384 + cj0); L.vp = *(const bf16x8*)(prv + 768 + cj0);
        if (l > 0) { L.vf0 = *(const f32x4*)(VF + row * RWW + cj0); L.vf1 = *(const f32x4*)(VF + row * RWW + cj0 + 4); }
    }
    if (h == 0) {
#pragma unroll
        for (int q = 0; q < 2; ++q) {
            const int item = tid + 512 * q, tt = item >> 4, g = item & 15, t = t0 + tt;
            const bf16_t* cur = PR + ((size_t)b * SEQ + t) * PR_W + 1152; const bf16_t* prv = cur - (t > 0 ? PR_W : 0);
            const int gc = g < 12 ? g : 0, gp = g < 8 ? g : (g < 12 ? g + 4 : 0);
            L.cc[q] = *(const bf16x8*)(cur + 8 * gc); L.cp[q] = *(const bf16x8*)(prv + 8 * gp);
        }
    }
}

__device__ void rwkv_b1_phase(const Params& p, int l, unsigned char* lds) {
    const int G = gridDim.x;
    float* VF = (float*)(p.ws + WS_VF);
    const float* mu = p.in[11] + l * 1216; const float* w0 = p.in[12] + l * RWW;
    const float* a0 = p.in[14] + l * RWW; const float* kks = p.in[16] + l * RWW; const float* ka = p.in[17] + l * RWW;
    const float* rk = p.in[18] + l * RWW; const float* v0 = p.in[21];
    const float* w2 = p.in[13] + l * LORA * RWW; const float* a2 = p.in[15] + l * LORA * RWW; const float* v2 = p.in[23];
    bf16_t* T_At = (bf16_t*)lds; bf16_t* T_Rt = T_At + 64 * TS; bf16_t* T_Bt = T_Rt + 64 * TS; bf16_t* T_Kt = T_Bt + 64 * TS;
    bf16_t* T_VT = T_Kt + 64 * TS; bf16_t* T_bhT = T_VT + 64 * TS; bf16_t* T_khT = T_bhT + 64 * TS;
    bf16_t* T_Aak = T_khT + 64 * TS; bf16_t* T_Arb = T_Aak + 64 * TS; bf16_t* T_Ark = T_Arb + 64 * TS;
    bf16_t* T_WT = T_At; bf16_t* T_U0T = T_Bt;
    float* Aab = (float*)(lds + 10 * TILE_B);
    float* XT = (float*)(lds + 10 * TILE_B + 64 * AABS * 4);
    float* PCv = XT + 128 * XTS;
    float* TI = PCv + 64;
    float* CS = (float*)T_Aak;
    constexpr int LS = 33;
    float* WD = Aab; float* AD = WD + 64 * LS;
    float* VL = XT + 64 * XTS;
    float* WLT = (float*)lds; float* ALT = WLT + 64 * XTS; float* VGT = ALT + 64 * XTS;

    constexpr int NGRP = BATCH * (SEQ / 64);
    int gi = blockIdx.x;
    if (gi >= NGRP) return;
    B1Loads L;
    b1_issue_loads(p, l, gi, 0, tid_(), L);
    float codes[2][8];
#pragma unroll 1
    for (int it = 0; gi < NGRP; ++it) {
        const int h = it % NH;
        const int tid = tid_(), lane = tid & 63, wave = __builtin_amdgcn_readfirstlane(tid >> 6), fr = lane & 15, fq = lane >> 4;
        const int b = gi >> 5, c = gi & 31, bh = b * NH + h, jb = bh * 32 + c, t0 = c * 64;
        float wg[6][8];
#pragma unroll
        for (int q = 0; q < 6; ++q) {
            const int id = wave + 8 * q, Lk = id >> 4, tj = id & 3;
            if (q < 4 || l > 0) {
                const float* Wg = (Lk == 0 ? w2 : (Lk == 1 ? a2 : v2)) + (size_t)fq * RWW + h * HD + tj * 16 + fr;
#pragma unroll
                for (int kk = 0; kk < 8; ++kk) wg[q][kk] = Wg[(size_t)kk * 4 * RWW];
            }
        }
#pragma unroll
        for (int q = 0; q < 2; ++q) {
            const int item = tid + 512 * q, tt = item >> 4, g = item & 15, t = t0 + tt; const bool hp = t > 0;
            if (h == 0) {
#pragma unroll
                for (int e = 0; e < 8; ++e) {
                    const float xc = bf2f((bf16_t)L.cc[q][e]), xp = hp ? bf2f((bf16_t)L.cp[q][e]) : 0.f;
                    const float x_ = xc + (xp - xc) * mu[1152 + 8 * (g & 7) + e];
                    codes[q][e] = g < 4 ? 1.0f - 2.0f * __builtin_amdgcn_rcpf(1.0f + __builtin_amdgcn_exp2f(2.8853900817779268f * x_)) : (g < 8 ? x_ : xc + xp);
                }
            }
            if (g < 8 || (g < 12 && l > 0)) {
                float* dst = (g < 4 ? WD + tt * LS + 8 * g : (g < 8 ? AD + tt * LS + 8 * (g - 4) : VL + tt * LS + 8 * (g - 8)));
#pragma unroll
                for (int e = 0; e < 8; ++e) dst[e] = codes[q][e];
            }
        }
        __syncthreads();
#pragma unroll
        for (int q = 0; q < 6; ++q) {
            if (q < 4 || l > 0) {
                const int id = wave + 8 * q, Lk = id >> 4, ti = (id >> 2) & 3, tj = id & 3;
                const float* Xs = (Lk == 0 ? WD : (Lk == 1 ? AD : VL)) + (ti * 16 + fr) * LS + fq;
                f32x4 acc = (f32x4){0.f, 0.f, 0.f, 0.f};
#pragma unroll
                for (int kk = 0; kk < 8; ++kk) acc = __builtin_amdgcn_mfma_f32_16x16x4f32(Xs[kk * 4], wg[q][kk], acc, 0, 0, 0);
                float* out = (Lk == 0 ? WLT : (Lk == 1 ? ALT : VGT)) + (tj * 16 + fr) * XTS + ti * 16 + fq * 4;
#pragma unroll
                for (int r = 0; r < 4; ++r) out[r] = acc[r];
            }
        }
        __syncthreads();
        const int tt = tid >> 3, j0 = (tid & 7) * 8, t = t0 + tt, cj0 = h * HD + j0;
        const size_t row = (size_t)b * SEQ + t;
        float rr[8], kk_[8], vv[8], aa[8], bb[8], lw[8];
        {
            const bool hp = t > 0;
            float wl[8], al[8], vg[8];
#pragma unroll
            for (int e = 0; e < 8; ++e) {
                const float r_c = bf2f((bf16_t)L.rc[e]), k_c = bf2f((bf16_t)L.kc[e]), v_c = bf2f((bf16_t)L.vc[e]);
                const float r_p = hp ? bf2f((bf16_t)L.rp[e]) : 0.f, k_p = hp ? bf2f((bf16_t)L.kp[e]) : 0.f, v_p = hp ? bf2f((bf16_t)L.vp[e]) : 0.f;
                rr[e] = r_c + (r_p - r_c) * mu[cj0 + e]; kk_[e] = k_c + (k_p - k_c) * mu[384 + cj0 + e]; vv[e] = v_c + (v_p - v_c) * mu[768 + cj0 + e];
                wl[e] = w0[cj0 + e] + WLT[(j0 + e) * XTS + tt]; al[e] = a0[cj0 + e] + ALT[(j0 + e) * XTS + tt]; vg[e] = l > 0 ? v0[cj0 + e] + VGT[(j0 + e) * XTS + tt] : 0.f;
            }
            float ssq = 0.f, bon = 0.f;
#pragma unroll
            for (int e = 0; e < 8; ++e) {
                const float sp2 = fmaxf(-wl[e], 0.f) * 1.4426950408889634f + __builtin_amdgcn_logf(1.0f + __builtin_amdgcn_exp2f(-1.4426950408889634f * fabsf(wl[e])));
                lw[e] = -__builtin_amdgcn_exp2f(-sp2 - 0.7213475204444817f);
                const float alr = __builtin_amdgcn_rcpf(1.0f + __builtin_amdgcn_exp2f(-1.4426950408889634f * al[e]));
                if (l > 0) { const float vf = e < 4 ? L.vf0[e & 3] : L.vf1[e & 3]; vv[e] = vv[e] + (vf - vv[e]) * __builtin_amdgcn_rcpf(1.0f + __builtin_amdgcn_exp2f(-1.4426950408889634f * vg[e])); }
                const float kkr = kk_[e] * kks[cj0 + e];
                kk_[e] = kk_[e] * (1.0f + (alr - 1.0f) * ka[cj0 + e]);
                aa[e] = kkr; bb[e] = alr; ssq += kkr * kkr; bon += rr[e] * kk_[e] * rk[cj0 + e];
            }
            if (l == 0) { *(f32x4*)(VF + row * RWW + cj0) = (f32x4){vv[0], vv[1], vv[2], vv[3]}; *(f32x4*)(VF + row * RWW + cj0 + 4) = (f32x4){vv[4], vv[5], vv[6], vv[7]}; }
            ssq += __shfl_xor(ssq, 1); ssq += __shfl_xor(ssq, 2); ssq += __shfl_xor(ssq, 4);
            bon += __shfl_xor(bon, 1); bon += __shfl_xor(bon, 2); bon += __shfl_xor(bon, 4);
            const float inv = fminf(__builtin_amdgcn_rsqf(ssq), 1e12f);
            uint4 bvw; float bv[8];
#pragma unroll
            for (int e = 0; e < 8; ++e) { const float kn = aa[e] * inv; aa[e] = -kn; bb[e] = kn * bb[e]; bv[e] = bon * vv[e]; CS[tt * CSS + j0 + e] = lw[e]; }
            bvw.x = pk2(bv[0], bv[1]); bvw.y = pk2(bv[2], bv[3]); bvw.z = pk2(bv[4], bv[5]); bvw.w = pk2(bv[6], bv[7]);
            *(uint4*)((bf16_t*)(p.ws + WS_CH_BV) + (size_t)jb * 4096 + tt * 64 + j0) = bvw;
        }
        __syncthreads();
#pragma unroll
        for (int e = 0; e < 8; ++e) {
            const int j = wave * 8 + e; float x = CS[lane * CSS + j];
#pragma unroll
            for (int o = 1; o < 64; o <<= 1) { const float y = __shfl_up(x, o); if (lane >= o) x += y; }
            CS[lane * CSS + j] = x;
        }
        __syncthreads();
        {
            float at[8], rt[8], bt[8], kt[8];
#pragma unroll
            for (int e = 0; e < 8; ++e) {
                const int j = j0 + e; const float cs = CS[tt * CSS + j] * 1.4426950408889634f, csC = CS[63 * CSS + j] * 1.4426950408889634f, lw2 = lw[e] * 1.4426950408889634f;
                const float e_in = __builtin_amdgcn_exp2f(cs), e_ex = __builtin_amdgcn_exp2f(cs - lw2), e_ng = __builtin_amdgcn_exp2f(-cs), e_ht = __builtin_amdgcn_exp2f(csC - cs);
                at[e] = aa[e] * e_ex; rt[e] = rr[e] * e_in; bt[e] = bb[e] * e_ng; kt[e] = kk_[e] * e_ng;
                T_VT[j * TS + tt] = f2bf(vv[e]); T_bhT[j * TS + tt] = f2bf(bb[e] * e_ht); T_khT[j * TS + tt] = f2bf(kk_[e] * e_ht);
                XT[j * XTS + tt] = at[e];
                if (tt == 63) PCv[j] = __builtin_amdgcn_exp2f(csC);
            }
            uint4 w;
            w.x = pk2(at[0], at[1]); w.y = pk2(at[2], at[3]); w.z = pk2(at[4], at[5]); w.w = pk2(at[6], at[7]); *(uint4*)(T_At + tt * TS + j0) = w;
            w.x = pk2(rt[0], rt[1]); w.y = pk2(rt[2], rt[3]); w.z = pk2(rt[4], rt[5]); w.w = pk2(rt[6], rt[7]); *(uint4*)(T_Rt + tt * TS + j0) = w;
            w.x = pk2(bt[0], bt[1]); w.y = pk2(bt[2], bt[3]); w.z = pk2(bt[4], bt[5]); w.w = pk2(bt[6], bt[7]); *(uint4*)(T_Bt + tt * TS + j0) = w;
            w.x = pk2(kt[0], kt[1]); w.y = pk2(kt[2], kt[3]); w.z = pk2(kt[4], kt[5]); w.w = pk2(kt[6], kt[7]); *(uint4*)(T_Kt + tt * TS + j0) = w;
        }
        __syncthreads();
        { const int hn = h + 1 < NH ? h + 1 : 0, gn = h + 1 < NH ? gi : gi + G; if (gn < NGRP) b1_issue_loads(p, l, gn, hn, tid, L); }
        {
            const int mat = wave >> 1;
            const bf16_t* As = (mat == 0 || mat == 2) ? T_Bt : T_Kt; const bf16_t* Bs = (mat < 2) ? T_At : T_Rt;
            bf16_t* dstb = (mat == 1 ? T_Aak : (mat == 2 ? T_Arb : T_Ark));
#pragma unroll
            for (int q = 0; q < 8; ++q) {
                const int ti = ((wave & 1) * 8 + q) >> 2, tj = q & 3;
                f32x4 acc = (f32x4){0.f, 0.f, 0.f, 0.f};
                if (ti <= tj) acc = mm_tile(As, ti * 16, Bs, tj * 16, 64, fr, fq, acc);
                const int tcol = tj * 16 + fr, i0 = ti * 16 + fq * 4;
                if (ti == tj) {
#pragma unroll
                    for (int r = 0; r < 4; ++r) { const bool keep = (mat < 2) ? (i0 + r < tcol) : (i0 + r <= tcol); if (!keep) acc[r] = 0.f; }
                }
                if (mat == 0) *(f32x4*)(Aab + tcol * AABS + i0) = acc;
                else *(uint2*)(dstb + tcol * TS + i0) = pk4(acc);
            }
        }
        __syncthreads();
        if (wave == 0) {
            const int blk = lane >> 4, cc = lane & 15; const float* ar = Aab + (16 * blk) * AABS + 16 * blk;
            float x[16];
#pragma unroll
            for (int u = 0; u < 16; ++u) { float v = (u == cc) ? 1.0f : 0.f;
#pragma unroll
                for (int i = 0; i < u; ++i) v += ar[u * AABS + i] * x[i];
                x[u] = v; }
#pragma unroll
            for (int u = 0; u < 16; ++u) TI[(blk * 16 + u) * 17 + cc] = x[u];
        } else {
#pragma unroll 1
            for (int id = wave - 1; id < 16; id += 7) {
                const int ti = id >> 2, tj = id & 3;
                f32x4 acc = mm_tile(T_Aak, ti * 16, T_VT, tj * 16, 64, fr, fq, (f32x4){0.f, 0.f, 0.f, 0.f});
                const int j = tj * 16 + fr, tr = ti * 16 + fq * 4;
#pragma unroll
                for (int r = 0; r < 4; ++r) XT[(64 + j) * XTS + tr + r] = acc[r];
            }
        }
        __syncthreads();
        {
            float* xc = XT + (wave * 16 + fr) * XTS;
#pragma unroll
            for (int I = 0; I < 4; ++I) {
                f32x4 acc;
#pragma unroll
                for (int r = 0; r < 4; ++r) acc[r] = xc[16 * I + 4 * fq + r];
#pragma unroll
                for (int J = 0; J < I; ++J)
#pragma unroll
                    for (int kk = 0; kk < 4; ++kk) acc = __builtin_amdgcn_mfma_f32_16x16x4f32(Aab[(16 * I + fr) * AABS + 16 * J + 4 * kk + fq], xc[16 * J + 4 * kk + fq], acc, 0, 0, 0);
#pragma unroll
                for (int r = 0; r < 4; ++r) xc[16 * I + 4 * fq + r] = acc[r];
                asm volatile("s_waitcnt lgkmcnt(0)" ::: "memory");
                f32x4 xs = (f32x4){0.f, 0.f, 0.f, 0.f};
#pragma unroll
                for (int kk = 0; kk < 4; ++kk) xs = __builtin_amdgcn_mfma_f32_16x16x4f32(TI[(I * 16 + fr) * 17 + 4 * kk + fq], xc[16 * I + 4 * kk + fq], xs, 0, 0, 0);
                asm volatile("s_waitcnt lgkmcnt(0)" ::: "memory");
#pragma unroll
                for (int r = 0; r < 4; ++r) xc[16 * I + 4 * fq + r] = xs[r];
                asm volatile("s_waitcnt lgkmcnt(0)" ::: "memory");
            }
        }
        __syncthreads();
        {
            const int col = tid >> 2, tg = (tid & 3) * 16;
            const float* xr = XT + col * XTS + tg; bf16_t* dst = (col < 64 ? T_WT + col * TS : T_U0T + (col - 64) * TS) + tg;
            uint4 w0_, w1_;
            w0_.x = pk2(xr[0], xr[1]); w0_.y = pk2(xr[2], xr[3]); w0_.z = pk2(xr[4], xr[5]); w0_.w = pk2(xr[6], xr[7]);
            w1_.x = pk2(xr[8], xr[9]); w1_.y = pk2(xr[10], xr[11]); w1_.z = pk2(xr[12], xr[13]); w1_.w = pk2(xr[14], xr[15]);
            *(uint4*)dst = w0_; *(uint4*)(dst + 8) = w1_;
        }
        __syncthreads();
        {
            bf16_t* gM = (bf16_t*)(p.ws + WS_CH_M) + (size_t)jb * 4096; bf16_t* gNT = (bf16_t*)(p.ws + WS_CH_NT) + (size_t)jb * 4096;
            bf16_t* gG = (bf16_t*)(p.ws + WS_CH_G) + (size_t)jb * 4096; bf16_t* gY1T = (bf16_t*)(p.ws + WS_CH_Y1T) + (size_t)jb * 4096;
            const int mat = wave >> 1;
            const bf16_t* A1 = (mat == 0 || mat == 2) ? T_WT : (mat == 1 ? T_U0T : T_bhT);
            const bf16_t* B1 = (mat == 0 || mat == 1) ? T_Arb : (mat == 2 ? T_bhT : T_U0T);
            const bf16_t* A2 = mat == 1 ? T_VT : T_khT; const bf16_t* B2 = mat == 1 ? T_Ark : T_VT;
            bf16_t* gdst = mat == 0 ? gG : (mat == 1 ? gY1T : (mat == 2 ? gM : gNT));
#pragma unroll
            for (int q = 0; q < 8; ++q) {
                const int ti = ((wave & 1) * 8 + q) >> 2, tj = q & 3;
                const int col = tj * 16 + fr, r0 = ti * 16 + fq * 4;
                f32x4 acc = mm_tile(A1, ti * 16, B1, tj * 16, 64, fr, fq, (f32x4){0.f, 0.f, 0.f, 0.f});
                if (mat & 1) acc = mm_tile(A2, ti * 16, B2, tj * 16, 64, fr, fq, acc);
                if (mat == 0) {
                    const uint2 rw = *(const uint2*)(T_Rt + col * TS + r0);
                    acc[0] += bf2f((bf16_t)(rw.x & 0xffff)); acc[1] += bf2f((bf16_t)(rw.x >> 16)); acc[2] += bf2f((bf16_t)(rw.y & 0xffff)); acc[3] += bf2f((bf16_t)(rw.y >> 16));
                } else if (mat == 2 && ti == tj) {
                    const float pc = PCv[col];
#pragma unroll
                    for (int r = 0; r < 4; ++r) if (r0 + r == col) acc[r] += pc;
                }
                *(uint2*)(gdst + col * 64 + r0) = pk4(acc);
            }
        }
        __syncthreads();
        if (h == NH - 1) gi += G;
    }
}

__device__ void rwkv_b2_job(const Params& p, int bh, unsigned char* lds) {
    const int tid = tid_(), lane = tid & 63, wave = __builtin_amdgcn_readfirstlane(tid >> 6), fr = lane & 15, fq = lane >> 4;
    const int mi = wave >> 1, nj0 = (wave & 1) * 2;
    const bf16_t* gM = (const bf16_t*)(p.ws + WS_CH_M); const bf16_t* gNT = (const bf16_t*)(p.ws + WS_CH_NT); bf16_t* gZT = (bf16_t*)(p.ws + WS_ZT);
    bf16_t* zbuf = (bf16_t*)lds;
    f32x4 z[2];
    z[0] = (f32x4){0.f, 0.f, 0.f, 0.f}; z[1] = z[0];
    const int c0 = mi * 16 + fq * 4;
    bf16x8 am[2]; uint2 nw[2];
    {
        const size_t jb = (size_t)bh * 32;
#pragma unroll
        for (int kk = 0; kk < 2; ++kk) am[kk] = *(const bf16x8*)(gM + jb * 4096 + (mi * 16 + fr) * 64 + kk * 32 + fq * 8);
#pragma unroll
        for (int q = 0; q < 2; ++q) nw[q] = *(const uint2*)(gNT + jb * 4096 + ((nj0 + q) * 16 + fr) * 64 + c0);
    }
#pragma unroll 1
    for (int c = 0; c < SEQ / 64; ++c) {
        const size_t jb = (size_t)bh * 32 + c;
        bf16_t* zh = zbuf + (c & 1) * 2 * 64 * TS; bf16_t* zl = zh + 64 * TS;
#pragma unroll
        for (int q = 0; q < 2; ++q) {
            const int j = (nj0 + q) * 16 + fr;
            const uint2 hi = pk4(z[q]);
            f32x4 lo;
            lo[0] = z[q][0] - bf2f((bf16_t)(hi.x & 0xffff)); lo[1] = z[q][1] - bf2f((bf16_t)(hi.x >> 16)); lo[2] = z[q][2] - bf2f((bf16_t)(hi.y & 0xffff)); lo[3] = z[q][3] - bf2f((bf16_t)(hi.y >> 16));
            *(uint2*)(zh + j * TS + c0) = hi; *(uint2*)(zl + j * TS + c0) = pk4(lo);
            *(uint2*)(gZT + jb * 4096 + j * 64 + c0) = hi;
        }
        bf16x8 amn[2]; uint2 nwn[2];
        {
            const size_t jn = (size_t)bh * 32 + (c + 1 < SEQ / 64 ? c + 1 : c);
#pragma unroll
            for (int kk = 0; kk < 2; ++kk) amn[kk] = *(const bf16x8*)(gM + jn * 4096 + (mi * 16 + fr) * 64 + kk * 32 + fq * 8);
#pragma unroll
            for (int q = 0; q < 2; ++q) nwn[q] = *(const uint2*)(gNT + jn * 4096 + ((nj0 + q) * 16 + fr) * 64 + c0);
        }
        __syncthreads();
#pragma unroll
        for (int q = 0; q < 2; ++q) {
            const int j = (nj0 + q) * 16 + fr;
            f32x4 acc; acc[0] = bf2f((bf16_t)(nw[q].x & 0xffff)); acc[1] = bf2f((bf16_t)(nw[q].x >> 16)); acc[2] = bf2f((bf16_t)(nw[q].y & 0xffff)); acc[3] = bf2f((bf16_t)(nw[q].y >> 16));
#pragma unroll
            for (int kk = 0; kk < 2; ++kk) {
                const bf16x8 bh_ = *(const bf16x8*)(zh + j * TS + kk * 32 + fq * 8), bl_ = *(const bf16x8*)(zl + j * TS + kk * 32 + fq * 8);
                acc = __builtin_amdgcn_mfma_f32_16x16x32_bf16(am[kk], bh_, acc, 0, 0, 0);
                acc = __builtin_amdgcn_mfma_f32_16x16x32_bf16(am[kk], bl_, acc, 0, 0, 0);
            }
            z[q] = acc;
        }
        am[0] = amn[0]; am[1] = amn[1]; nw[0] = nwn[0]; nw[1] = nwn[1];
    }
    __syncthreads();
}

__device__ void rwkv_b3_pair(const Params& p, int l, int pair) {
    const int tid = tid_(), lane = tid & 63, wave = __builtin_amdgcn_readfirstlane(tid >> 6), fr = lane & 15, fq = lane >> 4;
    const int jb = pair * 2 + (wave >> 2), mi = wave & 3;
    const int bh = jb >> 5, c = jb & 31, b = bh / NH, h = bh % NH;
    const bf16_t* gG = (const bf16_t*)(p.ws + WS_CH_G) + (size_t)jb * 4096; const bf16_t* gY1 = (const bf16_t*)(p.ws + WS_CH_Y1T) + (size_t)jb * 4096;
    const bf16_t* gBV = (const bf16_t*)(p.ws + WS_CH_BV) + (size_t)jb * 4096; const bf16_t* gZT = (const bf16_t*)(p.ws + WS_ZT) + (size_t)jb * 4096;
    const bf16_t* PG = (const bf16_t*)(p.ws + WS_PG); bf16_t* MIX = (bf16_t*)(p.ws + WS_MIX);
    const float* gng = p.in[19] + l * RWW + h * HD; const float* gnb = p.in[20] + l * RWW + h * HD;
    const int tt = mi * 16 + fr; const size_t row = (size_t)b * SEQ + c * 64 + tt;
    bf16x8 bg[2];
#pragma unroll
    for (int kk = 0; kk < 2; ++kk) bg[kk] = *(const bf16x8*)(gG + tt * 64 + kk * 32 + fq * 8);
    uint2 yw[4], bw[4], gw[4];
#pragma unroll
    for (int nj = 0; nj < 4; ++nj) { const int j0 = nj * 16 + fq * 4;
        yw[nj] = *(const uint2*)(gY1 + tt * 64 + j0); bw[nj] = *(const uint2*)(gBV + tt * 64 + j0); gw[nj] = *(const uint2*)(PG + row * PG_W + h * HD + j0); }
    f32x4 acc[4];
#pragma unroll
    for (int nj = 0; nj < 4; ++nj) {
        acc[nj][0] = bf2f((bf16_t)(yw[nj].x & 0xffff)); acc[nj][1] = bf2f((bf16_t)(yw[nj].x >> 16)); acc[nj][2] = bf2f((bf16_t)(yw[nj].y & 0xffff)); acc[nj][3] = bf2f((bf16_t)(yw[nj].y >> 16));
#pragma unroll
        for (int kk = 0; kk < 2; ++kk) { const bf16x8 az = *(const bf16x8*)(gZT + (nj * 16 + fr) * 64 + kk * 32 + fq * 8); acc[nj] = __builtin_amdgcn_mfma_f32_16x16x32_bf16(az, bg[kk], acc[nj], 0, 0, 0); }
    }
    float s = 0.f;
#pragma unroll
    for (int nj = 0; nj < 4; ++nj) s += (acc[nj][0] + acc[nj][1]) + (acc[nj][2] + acc[nj][3]);
    s += __shfl_xor(s, 16); s += __shfl_xor(s, 32);
    const float mean = s * (1.0f / HD);
    float vs = 0.f;
#pragma unroll
    for (int nj = 0; nj < 4; ++nj) { acc[nj] = acc[nj] - mean; vs += (acc[nj][0] * acc[nj][0] + acc[nj][1] * acc[nj][1]) + (acc[nj][2] * acc[nj][2] + acc[nj][3] * acc[nj][3]); }
    vs += __shfl_xor(vs, 16); vs += __shfl_xor(vs, 32);
    const float rstd = rsqrtf(vs * (1.0f / HD) + GN_EPS);
#pragma unroll
    for (int nj = 0; nj < 4; ++nj) {
        const int j0 = nj * 16 + fq * 4;
        const f32x4 gg = *(const f32x4*)(gng + j0), gb = *(const f32x4*)(gnb + j0);
        const float bv0 = bf2f((bf16_t)(bw[nj].x & 0xffff)), bv1 = bf2f((bf16_t)(bw[nj].x >> 16)), bv2 = bf2f((bf16_t)(bw[nj].y & 0xffff)), bv3 = bf2f((bf16_t)(bw[nj].y >> 16));
        const float g0 = bf2f((bf16_t)(gw[nj].x & 0xffff)), g1 = bf2f((bf16_t)(gw[nj].x >> 16)), g2 = bf2f((bf16_t)(gw[nj].y & 0xffff)), g3 = bf2f((bf16_t)(gw[nj].y >> 16));
        const float o0 = acc[nj][0] * rstd * gg[0] + gb[0] + bv0, o1 = acc[nj][1] * rstd * gg[1] + gb[1] + bv1, o2 = acc[nj][2] * rstd * gg[2] + gb[2] + bv2, o3 = acc[nj][3] * rstd * gg[3] + gb[3] + bv3;
        uint2 w; w.x = pk2(o0 * siluf_(g0), o1 * siluf_(g1)); w.y = pk2(o2 * siluf_(g2), o3 * siluf_(g3));
        *(uint2*)(MIX + row * DM + CW + SBW + h * HD + j0) = w;
    }
}

#ifndef ATTN_REF
#define ATTN_REF 0
#endif
#ifndef RWKV_REF
#define RWKV_REF 0
#endif
__device__ void phase_mix1(const Params& p, int l, unsigned char* lds) {
    constexpr int NAT = BATCH * NH * 4, NCV = BATCH * (SEQ / 32);
    const int G = gridDim.x;
#if RWKV_REF
    for (int job = blockIdx.x; job < BATCH * NH; job += G) rwkv_job(p, l, job, (float*)lds);
#else
    for (int rep = 0; rep < ((PROBE_REP & 1) ? 2 : 1); ++rep) rwkv_b1_phase(p, l, lds);
#endif
    for (int rep = 0; rep < ((PROBE_REP & 2) ? 2 : 1); ++rep)
#if ATTN_REF
    for (int job = blockIdx.x; job < NAT; job += G) attn_job(p, job);
#else
    for (int job = blockIdx.x; job < NAT * 2; job += G) attn_mfma_wave(p, job >> 3, (job & 7) * 8 + __builtin_amdgcn_readfirstlane(tid_() >> 6));
#endif
#ifndef CONV_REF
#define CONV_REF 0
#endif
    for (int rep = 0; rep < ((PROBE_REP & 4) ? 2 : 1); ++rep)
#if CONV_REF
    for (int job = blockIdx.x; job < NCV; job += G) conv_job(p, l, job, (float*)lds);
#else
    for (int job = blockIdx.x; job < BATCH * (SEQ / 64); job += G) conv_job64(p, l, job, lds);
#endif
}
__device__ void phase_mix2(const Params& p, int l, unsigned char* lds) {
#if !RWKV_REF
    for (int rep = 0; rep < ((PROBE_REP & 8) ? 2 : 1); ++rep)
    for (int job = blockIdx.x; job < BATCH * NH; job += gridDim.x) rwkv_b2_job(p, job, lds);
    if (l + 1 < DEPTH && defer_layer1_weights() && (int)blockIdx.x >= BATCH * NH) prep_weights(p, l + 1, lds, blockIdx.x - BATCH * NH, gridDim.x - BATCH * NH);
#endif
}
__device__ void phase_mix3(const Params& p, int l, unsigned char* lds) {
#if !RWKV_REF
    for (int rep = 0; rep < ((PROBE_REP & 16) ? 2 : 1); ++rep)
    for (int pair = blockIdx.x; pair < BATCH * NH * 16; pair += gridDim.x) rwkv_b3_pair(p, l, pair);
#endif
}

#define LAS __attribute__((address_space(3)))
#define XB_TMO      128
#define XB_XCNT(j)  (256  + 64 * (j))
#define XB_XSUB(j)  (1280 + 64 * (j))
#define XB_XGEN(j)  (2304 + 64 * (j))
#define XB_TOP      3328
#define XB_TOPGEN   3392
#define XCD_BAR_WORDS 3456
#define XB_SPIN_CAP (1u << 18)

__device__ __forceinline__ unsigned xb_ld(unsigned* p)              { return __hip_atomic_load(p, __ATOMIC_RELAXED, __HIP_MEMORY_SCOPE_AGENT); }
__device__ __forceinline__ unsigned xb_add(unsigned* p, unsigned v) { return __hip_atomic_fetch_add(p, v, __ATOMIC_RELAXED, __HIP_MEMORY_SCOPE_AGENT); }
__device__ __forceinline__ unsigned xb_xcc_id() { return (unsigned)__builtin_amdgcn_s_getreg((3 << 11) | 20) & 0xFu; }
#define XB_SPIN(cond, bar) do { unsigned _sp = 0; while (cond) { __builtin_amdgcn_s_sleep(1); \
    if ((++_sp & 255u) == 0u) { if (xb_ld(&(bar)[XB_TMO])) break; if (_sp > XB_SPIN_CAP) { atomicAdd(&(bar)[XB_TMO], 1u); break; } } } } while (0)

struct XcdBarrier {
    unsigned* bar; unsigned x;
    volatile LAS unsigned* st;
};

__device__ __forceinline__ XcdBarrier xcd_barrier_post(unsigned* bar, volatile LAS unsigned* st) {
    XcdBarrier b; b.bar = bar; b.x = xb_xcc_id(); b.st = st;
    if (threadIdx.x == 0) (void)xb_add(&bar[XB_XCNT(b.x)], 1u);
    return b;
}
__device__ __forceinline__ void xcd_barrier_complete(unsigned* bar, unsigned x, unsigned& nloc, unsigned& nx) {
    const unsigned G = gridDim.x * gridDim.y * gridDim.z;
    unsigned sum, cnt, mine, sp = 0u;
    for (;;) {
        sum = 0u; cnt = 0u; mine = 0u;
#pragma unroll
        for (unsigned j = 0; j < 16; ++j) { const unsigned c = xb_ld(&bar[XB_XCNT(j)]); sum += c; cnt += (c > 0u) ? 1u : 0u; mine = (j == x) ? c : mine; }
        if (sum == G) break;
        __builtin_amdgcn_s_sleep(1);
        if ((++sp & 255u) == 0u) { if (xb_ld(&bar[XB_TMO])) break; if (sp > XB_SPIN_CAP) { atomicAdd(&bar[XB_TMO], 1u); break; } }
    }
    nloc = mine > 0u ? mine : 1u; nx = cnt > 0u ? cnt : 1u;
}

__device__ __forceinline__ void xcd_barrier(const XcdBarrier& b) {
    asm volatile("s_waitcnt vmcnt(0)" ::: "memory");
    __syncthreads();
    if (threadIdx.x == 0) {
        unsigned* bar = b.bar;
        __builtin_amdgcn_s_waitcnt(0);
        unsigned nloc = b.st[0], nx = b.st[1];
        if (nloc == 0u) { xcd_barrier_complete(bar, b.x, nloc, nx); b.st[0] = nloc; b.st[1] = nx; }
        const unsigned old = xb_add(&bar[XB_XSUB(b.x)], 1u);
        const unsigned gen = old / nloc;
        if (old + 1u == (gen + 1u) * nloc) {
            __builtin_amdgcn_fence(__ATOMIC_RELEASE, "agent");
            asm volatile("s_waitcnt vmcnt(0)" ::: "memory");
            const unsigned og = xb_add(&bar[XB_TOP], 1u);
            const unsigned tg = og / nx;
            if (og + 1u == (tg + 1u) * nx) xb_add(&bar[XB_TOPGEN], 1u);
            else XB_SPIN(xb_ld(&bar[XB_TOPGEN]) == tg, bar);
            __builtin_amdgcn_fence(__ATOMIC_ACQUIRE, "agent");
            xb_add(&bar[XB_XGEN(b.x)], 1u);
            asm volatile("s_waitcnt vmcnt(0)" ::: "memory");
        } else {
            XB_SPIN(xb_ld(&bar[XB_XGEN(b.x)]) == gen, bar);
            __builtin_amdgcn_fence(__ATOMIC_ACQUIRE, "agent");
            asm volatile("s_waitcnt vmcnt(0)" ::: "memory");
        }
    }
    __syncthreads();
}

constexpr int PH_PER_LAYER = 6;
constexpr int N_PHASES = 1 + PH_PER_LAYER * DEPTH;
__device__ __forceinline__ void run_phase(const Params& p, int ph, unsigned char* lds) {
    unsigned char* ws = p.ws;
    if (ph == 0) { for (int rep = 0; rep < ((PROBE_REP & 4096) ? 2 : 1); ++rep) phase_prologue(p, lds); return; }
    const int l = (ph - 1) / PH_PER_LAYER, k = (ph - 1) % PH_PER_LAYER;
    if (k == 0) {
        EpiInProjP E{(bf16_t*)(ws + WS_PC), (bf16_t*)(ws + WS_PS), (bf16_t*)(ws + WS_PR), (bf16_t*)(ws + WS_PG), (bf16_t*)(ws + WS_VT)};
        pg8::Gemm g{(const bf16_t*)(ws + WS_XB), (const bf16_t*)(ws + WS_WIN) + (size_t)l * NINT * DM, M, NINT, DM}; pg8::StaticOrder S; S.init(M, NINT, (int)gridDim.x, (int)blockIdx.x);
        for (int rep = 0; rep < ((PROBE_REP & 32) ? 2 : 1); ++rep)
        pg8::gemm_phase<EpiInProjP, pg8::StaticOrder, true, true>((PG8_LAS unsigned char*)lds, g, S, E);
    } else if (k == 1) {
        phase_mix1(p, l, lds);
    } else if (k == 2) {
        phase_mix2(p, l, lds);
    } else if (k == 3) {
        phase_mix3(p, l, lds);
    } else if (k == 4) {
        EpiOutBf16P E{(bf16_t*)(ws + WS_Y), DM};
        pg8::Gemm g{(const bf16_t*)(ws + WS_MIX), (const bf16_t*)(ws + WS_WOUT) + (size_t)l * DM * DM, M, DM, DM}; pg8::StaticOrder S; S.init(M, DM, (int)gridDim.x, (int)blockIdx.x);
        for (int rep = 0; rep < ((PROBE_REP & 64) ? 2 : 1); ++rep)
        pg8::gemm_phase<EpiOutBf16P, pg8::StaticOrder, true, true>((PG8_LAS unsigned char*)lds, g, S, E);
    } else {
        for (int rep = 0; rep < ((PROBE_REP & 8192) && l == 0 ? 2 : 1); ++rep)
        phase_rowpass(l == 0 ? p.in[0] : p.out, (const bf16_t*)(ws + WS_Y), p.in[2] + l * DM, p.out, l + 1 < DEPTH ? (bf16_t*)(ws + WS_XB) : nullptr);
    }
}

static_assert(10 * TILE_B + 64 * AABS * 4 + 128 * XTS * 4 + 64 * 4 + 4 * 16 * 17 * 4 <= 147456, "B1 LDS map");
constexpr int LDS_BYTES = 147456 + 256;

constexpr int MISC_OFF = 147456;
#if MK_COOP == 2
__global__ void __launch_bounds__(512, 2) fwd_kernel(Params p) {
    extern __shared__ __attribute__((aligned(16))) unsigned char lds[];
    volatile LAS unsigned* misc = (volatile LAS unsigned*)((LAS unsigned char*)lds + MISC_OFF);
    if (threadIdx.x < 16) misc[threadIdx.x] = 0u;
    __syncthreads();
    XcdBarrier bar = xcd_barrier_post((unsigned*)(p.ws + WS_CTL), misc);
    for (int ph = p.ph_lo; ph < p.ph_hi; ++ph) {
        run_phase(p, ph, lds);
        if (ph + 1 < p.ph_hi) xcd_barrier(bar);
        if ((PROBE_REP & 32768) && ph == 3) for (int rep = 0; rep < 20; ++rep) xcd_barrier(bar);
    }
}
#elif MK_COOP == 1
__global__ void __launch_bounds__(512, 2) fwd_kernel(Params p) {
    extern __shared__ __attribute__((aligned(16))) unsigned char lds[];
    cg::grid_group grid = cg::this_grid();
    for (int ph = p.ph_lo; ph < p.ph_hi; ++ph) {
        run_phase(p, ph, lds);
        if (ph + 1 < p.ph_hi) grid.sync();
    }
}
#else
__global__ void __launch_bounds__(512, 2) fwd_kernel(Params p) {
    extern __shared__ __attribute__((aligned(16))) unsigned char lds[];
    for (int ph = p.ph_lo; ph < p.ph_hi; ++ph) run_phase(p, ph, lds);
}
#endif

extern "C" void kernel_launch(void* const* d_in, const int* in_sizes, int n_in, void* d_out, int out_size, void* d_ws, size_t ws_size, hipStream_t stream) {
    static int grid = 0;
    if (grid == 0) {
        if (n_in != 24 || out_size != M * DM || ws_size < WS_END) { fprintf(stderr, "kernel_launch: unexpected problem (n_in %d out %d ws %zu)\n", n_in, out_size, ws_size); grid = -1; return; }
        int dev = 0, cus = 0, per_cu = 0;
        hipGetDevice(&dev); hipDeviceGetAttribute(&cus, hipDeviceAttributeMultiprocessorCount, dev);
        hipFuncSetAttribute((const void*)fwd_kernel, hipFuncAttributeMaxDynamicSharedMemorySize, LDS_BYTES);
        hipOccupancyMaxActiveBlocksPerMultiprocessor(&per_cu, (const void*)fwd_kernel, 512, LDS_BYTES);
        if (per_cu < 1) { fprintf(stderr, "kernel_launch: occupancy query says %d blocks per CU\n", per_cu); per_cu = 1; }
        grid = cus;
        (void)hipGetLastError();
    }
    if (grid < 0) return;
    Params p{};
    for (int i = 0; i < 24; ++i) p.in[i] = (const float*)d_in[i];
    p.out = (float*)d_out; p.ws = (unsigned char*)d_ws;
#if MK_COOP == 2
    p.ph_lo = 0; p.ph_hi = N_PHASES;
    if (hipMemsetAsync((char*)d_ws + WS_CTL, 0, XCD_BAR_WORDS * 4, stream) != hipSuccess) { fprintf(stderr, "kernel_launch: memset of the barrier words failed\n"); return; }
    hipLaunchKernelGGL(fwd_kernel, dim3(grid), dim3(512), LDS_BYTES, stream, p);
#elif MK_COOP == 1
    p.ph_lo = 0; p.ph_hi = N_PHASES;
    void* args[] = {&p};
    hipError_t e = hipLaunchCooperativeKernel((const void*)fwd_kernel, dim3(grid), dim3(512), args, LDS_BYTES, stream);
    if (e != hipSuccess) fprintf(stderr, "cooperative launch failed: %s (grid %d)\n", hipGetErrorString(e), grid);
#else
    for (int ph = 0; ph < N_PHASES; ++ph) {
        p.ph_lo = ph; p.ph_hi = ph + 1;
        hipLaunchKernelGGL(fwd_kernel, dim3(grid), dim3(512), LDS_BYTES, stream, p);
    }
#endif
}
```

```cpp
#include <hip/hip_runtime.h>
#include <hip/hip_cooperative_groups.h>
#include <cstdio>
#include <cstdint>
namespace cg = cooperative_groups;

#ifndef PROBE_REP
#define PROBE_REP 0
#endif
#ifndef MK_COOP
#define MK_COOP 2
#endif

constexpr int BATCH = 16, SEQ = 2048, DM = 1024, DEPTH = 2;
constexpr int M = BATCH * SEQ;
constexpr int HD = 64, NH = 6;
constexpr int CW = 256, SBW = 384, RWW = 384, LORA = 32, TAPS = 31;
constexpr int DIN = 3904;
constexpr int NINT = 4096;
constexpr int PC_W = 768, PS_W = 1152, PR_W = 1280, PG_W = 384;
constexpr float RMS_EPS = 1e-6f, LN_EPS = 1e-5f, GN_EPS = 64e-5f;

typedef unsigned short bf16_t;
typedef short bf16x8 __attribute__((ext_vector_type(8)));
typedef float f32x4 __attribute__((ext_vector_type(4)));
typedef unsigned short us4 __attribute__((ext_vector_type(4)));

constexpr size_t MiB = 1u << 20;
constexpr size_t WS_CTL = 0;
constexpr size_t WS_WPW = 512 * 1024;
constexpr size_t WS_WIN = 1 * MiB;
constexpr size_t WS_WOUT = 17 * MiB;
constexpr size_t WS_XB = 21 * MiB;
constexpr size_t WS_MIX = WS_XB;
constexpr size_t WS_PC = 85 * MiB;
constexpr size_t WS_PS = 133 * MiB;
constexpr size_t WS_VT = 205 * MiB;
constexpr size_t WS_Y = WS_PC;
constexpr size_t WS_PR = 229 * MiB;
constexpr size_t WS_PG = 309 * MiB;
constexpr size_t WS_VF = 333 * MiB;
constexpr size_t WS_CH = 381 * MiB;
constexpr size_t CH_SZ = (size_t)3072 * 4096 * 2;
constexpr size_t WS_CH_M = WS_CH, WS_CH_NT = WS_CH + CH_SZ, WS_CH_G = WS_CH + 2 * CH_SZ, WS_CH_Y1T = WS_CH + 3 * CH_SZ, WS_CH_BV = WS_CH + 4 * CH_SZ;
constexpr size_t WS_ZT = WS_PR;
constexpr size_t WS_END = 501 * MiB;

struct Params {
    const float* in[24];
    float* out;
    unsigned char* ws;
    int ph_lo, ph_hi;
};

__device__ __forceinline__ float bf2f(bf16_t v) { return __uint_as_float(((unsigned)v) << 16); }
typedef float f32x2_t __attribute__((ext_vector_type(2)));
typedef __bf16 bf16x2_t __attribute__((ext_vector_type(2)));
__device__ __forceinline__ unsigned pk2(float lo, float hi) { f32x2_t v = {lo, hi}; bf16x2_t b = __builtin_convertvector(v, bf16x2_t); return __builtin_bit_cast(unsigned, b); }
__device__ __forceinline__ bf16_t f2bf(float f) { return (bf16_t)(pk2(f, f) & 0xffffu); }
__device__ __forceinline__ float wave_sum(float v) {
#pragma unroll
    for (int o = 1; o < 64; o <<= 1) v += __shfl_xor(v, o);
    return v;
}
__device__ __forceinline__ float sigmoidf_(float x) { return 1.0f / (1.0f + __expf(-x)); }
__device__ __forceinline__ float siluf_(float x) { return x / (1.0f + __expf(-x)); }
__device__ __forceinline__ int tid_() { int t = threadIdx.x; asm volatile("" : "+v"(t)); return t; }
typedef unsigned u32x2_t __attribute__((ext_vector_type(2)));
__device__ __forceinline__ uint2 ldnt_u2(const void* p) { const u32x2_t v = __builtin_nontemporal_load((const u32x2_t*)p); uint2 r; r.x = v[0]; r.y = v[1]; return r; }
__device__ __forceinline__ int opaque_zero() { int z = 0; asm volatile("" : "+v"(z)); return z; }

__device__ __forceinline__ int orig_col(int n) { return n < 3520 ? n : (n < 3584 ? -1 : (n < 3968 ? n - 64 : -1)); }

__device__ void transpose_tile(const float* W, int ldw, int ncol_src, const float* gain, bf16_t* WT, int K, int n0, int k0, bool permute, float* tile  , bool skip_fold_rows = false) {
    const int tid = tid_();
#pragma unroll
    for (int i = 0; i < 8; ++i) {
        const int kl = (tid >> 6) + 8 * i, nl = tid & 63;
        const int n = n0 + nl, k = k0 + kl;
        const int oc = permute ? orig_col(n) : n;
        float v = 0.f;
        if (oc >= 0 && oc < ncol_src) v = W[(size_t)k * ldw + oc] * (gain ? gain[k] : 1.0f);
        if (permute && n >= 768 && n < 1152) v *= 0.125f * 1.4426950408889634f;
        tile[kl * 65 + nl] = v;
    }
    __syncthreads();
#pragma unroll
    for (int i = 0; i < 8; ++i) {
        const int nl = (tid >> 6) + 8 * i, kl = tid & 63;
        if (!(skip_fold_rows && n0 + nl >= 3520 && n0 + nl < 3584)) WT[(size_t)(n0 + nl) * K + k0 + kl] = f2bf(tile[kl * 65 + nl]);
    }
    __syncthreads();
}
__device__ void fold_v1_rows(const Params& p, int l, bf16_t* WinT_l, float* scr  , int worker, int nworkers) {
    const int tid = tid_(), o = tid & 63, kl = (tid >> 6) & 3, half = tid >> 8;
    const float* W = p.in[3] + (size_t)l * DM * DIN; const float* gain = p.in[1] + l * DM; const float* v1 = p.in[22] + (size_t)(l - 1) * RWW * LORA; const float* muv = p.in[11] + l * 1216 + 768;
    for (int k4 = worker * 4; k4 < DM; k4 += nworkers * 4) {
        const int k = k4 + kl; const float* wr = W + (size_t)k * DIN + 3072 + half * 192; const float* mv = muv + half * 192; const float* vr = v1 + (size_t)(half * 192) * LORA + (o & 31);
        float a = 0.f;
#pragma unroll 4
        for (int c = 0; c < 192; ++c) { const float m = mv[c]; a += wr[c] * (o >= 32 ? m : 1.0f - m) * vr[c * LORA]; }
        scr[half * 256 + kl * 64 + o] = a;
        __syncthreads();
        if (half == 0) WinT_l[(size_t)(3520 + o) * DM + k] = f2bf((scr[kl * 64 + o] + scr[256 + kl * 64 + o]) * gain[k]);
        __syncthreads();
    }
}
__device__ void prep_weights(const Params& p, int l, unsigned char* lds, int worker, int nworkers) {
    float* tile = (float*)lds;
    bf16_t* WinT = (bf16_t*)(p.ws + WS_WIN) + (size_t)l * NINT * DM; bf16_t* WoutT = (bf16_t*)(p.ws + WS_WOUT) + (size_t)l * DM * DM; bf16_t* WpwT = (bf16_t*)(p.ws + WS_WPW) + (size_t)l * CW * CW;
    const int nt_in = (NINT / 64) * (DM / 64), nt_out = (DM / 64) * (DM / 64), nt_pw = (CW / 64) * (CW / 64);
    for (int j = worker; j < nt_in + nt_out + nt_pw; j += nworkers) {
        if (j < nt_in) transpose_tile(p.in[3] + (size_t)l * DM * DIN, DIN, DIN, p.in[1] + l * DM, WinT, DM, (j / (DM / 64)) * 64, (j % (DM / 64)) * 64, true, tile, l > 0);
        else if (j < nt_in + nt_out) { const int r = j - nt_in; transpose_tile(p.in[4] + (size_t)l * DM * DM, DM, DM, nullptr, WoutT, DM, (r / (DM / 64)) * 64, (r % (DM / 64)) * 64, false, tile); }
        else { const int r = j - nt_in - nt_out; transpose_tile(p.in[9] + (size_t)l * CW * CW, CW, CW, nullptr, WpwT, CW, (r >> 2) * 64, (r & 3) * 64, false, tile); }
    }
    if (l > 0) fold_v1_rows(p, l, WinT, tile, worker, nworkers);
}

__device__ void rows_to_xb(const float* X, bf16_t* XB) {
    const int tid = tid_(), lane = tid & 63, wave = __builtin_amdgcn_readfirstlane(tid >> 6);
    for (int row = blockIdx.x * 8 + wave; row < M; row += gridDim.x * 8) {
        const float* xr = X + (size_t)row * DM;
        f32x4 v[4]; float ss = 0.f;
#pragma unroll
        for (int i = 0; i < 4; ++i) { v[i] = __builtin_nontemporal_load((const f32x4*)(xr + i * 256 + lane * 4)); ss += v[i][0] * v[i][0] + v[i][1] * v[i][1] + v[i][2] * v[i][2] + v[i][3] * v[i][3]; }
        ss = wave_sum(ss);
        const float rstd = rsqrtf(ss * (1.0f / DM) + RMS_EPS);
#pragma unroll
        for (int i = 0; i < 4; ++i) { uint2 w; w.x = pk2(v[i][0] * rstd, v[i][1] * rstd); w.y = pk2(v[i][2] * rstd, v[i][3] * rstd); *(uint2*)(XB + (size_t)row * DM + i * 256 + lane * 4) = w; }
    }
}

__device__ __forceinline__ bool defer_layer1_weights() { return gridDim.x >= BATCH * NH + 32; }
__device__ void phase_prologue(const Params& p, unsigned char* lds) {
    prep_weights(p, 0, lds, blockIdx.x, gridDim.x);
    if (!defer_layer1_weights()) for (int l = 1; l < DEPTH; ++l) prep_weights(p, l, lds, blockIdx.x, gridDim.x);
    rows_to_xb(p.in[0], (bf16_t*)(p.ws + WS_XB));
}

namespace pg8 {
#define PG8_LAS __attribute__((address_space(3)))
typedef unsigned short bf16_t;
typedef short bf16x8 __attribute__((ext_vector_type(8)));
typedef float f32x4 __attribute__((ext_vector_type(4)));
typedef unsigned u32x4 __attribute__((ext_vector_type(4)));
constexpr int BM = 256, BK = 64, HALF = 128, HTB = HALF * BK * 2  , STAGE_BYTES = 8 * HTB, NXCD = 8, WGM = 8;

__host__ __device__ __forceinline__ int lds_byte(int r, int c) { const int st = (r >> 4) * 2 + (c >> 5), rr = r & 15, cc = c & 31, ob = rr * 64 + cc * 2; return st * 1024 + (ob ^ (((ob >> 9) & 1) << 5)); }
__host__ __device__ __forceinline__ void stage_rc(int b, int& R, int& C) { const int st = b / 1024, sb = b % 1024, swz = sb ^ (((sb >> 9) & 1) << 5); R = (st >> 1) * 16 + swz / 64; C = (st & 1) * 32 + (swz % 64) / 2; }
__host__ __device__ __forceinline__ int perm32(int rho) { const int n = rho >> 4, i = rho & 15; return 8 * (i >> 2) + 4 * n + (i & 3); }

struct Unit { int pm, pn; };
struct Gemm { const bf16_t* A; const bf16_t* Bt; int M, N, K; };

struct StaticOrder {
    int nM, nN, nwg, G, c;
    __host__ __device__ void init(int M, int N, int G_, int c_) { nM = M / BM; nN = N / BM; nwg = nM * nN; G = G_; c = c_; }
    __host__ __device__ bool next(int i, Unit& u) const {
        const long L = (long)i * G + c; if (L >= nwg) return false;
        int wgid = (int)L; { const int q = nwg / NXCD, r = nwg % NXCD, xcd = wgid % NXCD, off = wgid / NXCD; wgid = (xcd < r ? xcd * (q + 1) : r * (q + 1) + (xcd - r) * q) + off; }
        const int nig = WGM * nN, gid = wgid / nig, fm = gid * WGM, gsz = (nM - fm) < WGM ? (nM - fm) : WGM;
        u.pm = fm + ((wgid % nig) % gsz); u.pn = (wgid % nig) / gsz; return true;
    }
    __device__ __forceinline__ void a_ready(const Unit&) const {}
    __device__ __forceinline__ void done(const Unit&) const {}
};


__device__ __forceinline__ unsigned cvt_pk_bf16(float lo, float hi) { unsigned r; asm volatile("v_cvt_pk_bf16_f32 %0, %1, %2" : "=v"(r) : "v"(lo), "v"(hi)); return r; }

template <class Epi, class Sched, bool ALIGN_EPI = false, bool SP2 = false>
__device__ __forceinline__ void gemm_phase(PG8_LAS unsigned char* lds, const Gemm g, const Sched& S, const Epi& E) {
    const int tid = tid_(), wid = __builtin_amdgcn_readfirstlane(tid >> 6), lane = tid & 63, wr = wid >> 2, wc = wid & 3, fr = lane & 15, fq = lane >> 4;
    const int K = g.K, nt = K / BK;
    unsigned voffA[2], voffB[2];
#pragma unroll
    for (int i = 0; i < 2; ++i) { int R, C; stage_rc(tid * 16 + i * 8192, R, C); const int Rb = Epi::PERM ? ((R & ~31) + perm32(R & 31)) : R;
        voffA[i] = (unsigned)(R * K + C) * 2u; voffB[i] = (unsigned)(Rb * K + C) * 2u; }
    const size_t kstep = (size_t)(BK * 2);
    const size_t hstep = (size_t)HALF * K * 2;
    const size_t tstep = 2 * hstep;
    const unsigned ldsw = (unsigned)wid * 1024u;
    const int aoff = lds_byte(wr * 64 + fr, fq * 8), boff = lds_byte(wc * 32 + fr, fq * 8);
#define PG8_SA(b, h) (((b) * 2 + (h)) * HTB)
#define PG8_SB(b, h) ((4 + (b) * 2 + (h)) * HTB)
#define PG8_STAGE(bufoff, gbase, voff) do { _Pragma("unroll") for (int _i = 0; _i < 2; ++_i) \
        __builtin_amdgcn_global_load_lds((const unsigned*)((const char*)(gbase) + (voff)[_i]), (PG8_LAS unsigned*)(lds + (bufoff) + ldsw + _i * 8192), 16, 0, 0); } while (0)
#define PG8_LDA(dst, b, h) do { _Pragma("unroll") for (int m = 0; m < 4; ++m) _Pragma("unroll") for (int k = 0; k < 2; ++k) dst[m][k] = *(const PG8_LAS bf16x8*)(lds + PG8_SA(b, h) + aoff + m * 2048 + k * 1024); } while (0)
#define PG8_LDB(dst, b, h) do { _Pragma("unroll") for (int n = 0; n < 2; ++n) _Pragma("unroll") for (int k = 0; k < 2; ++k) dst[n][k] = *(const PG8_LAS bf16x8*)(lds + PG8_SB(b, h) + boff + n * 2048 + k * 1024); } while (0)
#define PG8_MMA(ai, bj, At, Bt) do { __builtin_amdgcn_s_setprio(1); _Pragma("unroll") for (int m = 0; m < 4; ++m) _Pragma("unroll") for (int n = 0; n < 2; ++n) _Pragma("unroll") for (int k = 0; k < 2; ++k) \
        acc[ai][bj][m][n] = __builtin_amdgcn_mfma_f32_16x16x32_bf16(Bt[n][k], At[m][k], acc[ai][bj][m][n], 0, 0, 0); __builtin_amdgcn_s_setprio(0); } while (0)
#define PG8_WAIT_V(n) asm volatile("s_waitcnt vmcnt(" #n ")" ::: "memory")
#define PG8_WAIT_L(n) asm volatile("s_waitcnt lgkmcnt(" #n ")" ::: "memory")
#define PG8_BAR __builtin_amdgcn_s_barrier()
#define PG8_SCHED __builtin_amdgcn_sched_barrier(0)
    Unit cur, nxt; int ui = 0;
    if (!S.next(0, cur)) return;
    f32x4 acc[2][2][4][2];
#pragma unroll
    for (int a = 0; a < 2; ++a)
#pragma unroll
        for (int b = 0; b < 2; ++b)
#pragma unroll
            for (int m = 0; m < 4; ++m)
#pragma unroll
                for (int n = 0; n < 2; ++n) acc[a][b][m][n] = (f32x4){0.f, 0.f, 0.f, 0.f};
    bf16x8 At[4][2], B0[2][2], B1[2][2];
    const char* cA = (const char*)g.A + (size_t)cur.pm * tstep; const char* cB = (const char*)g.Bt + (size_t)cur.pn * tstep;
    S.a_ready(cur);
    if constexpr (SP2) {
        PG8_STAGE(PG8_SB(0, 0), cB, voffB); PG8_STAGE(PG8_SB(0, 1), cB + hstep, voffB); PG8_STAGE(PG8_SA(0, 0), cA, voffA); PG8_STAGE(PG8_SA(0, 1), cA + hstep, voffA);
        if (wr == 1) PG8_BAR;
        PG8_WAIT_V(2); PG8_BAR;
        PG8_STAGE(PG8_SB(1, 0), cB + kstep, voffB); PG8_STAGE(PG8_SA(1, 0), cA + kstep, voffA); PG8_STAGE(PG8_SB(1, 1), cB + hstep + kstep, voffB);
        PG8_WAIT_V(6); PG8_BAR;
    } else {
        PG8_STAGE(PG8_SB(0, 0), cB, voffB); PG8_STAGE(PG8_SA(0, 0), cA, voffA); PG8_STAGE(PG8_SB(0, 1), cB + hstep, voffB); PG8_STAGE(PG8_SA(0, 1), cA + hstep, voffA);
        if (wr == 1) PG8_BAR;
        PG8_WAIT_V(4); PG8_BAR;
        PG8_STAGE(PG8_SB(1, 0), cB + kstep, voffB); PG8_STAGE(PG8_SA(1, 0), cA + kstep, voffA); PG8_STAGE(PG8_SB(1, 1), cB + hstep + kstep, voffB);
        PG8_WAIT_V(6); PG8_BAR;
    }
    for (;;) {
        const bool has_next = S.next(ui + 1, nxt);
        const char* nA = has_next ? (const char*)g.A + (size_t)nxt.pm * tstep : cA; const char* nB = has_next ? (const char*)g.Bt + (size_t)nxt.pn * tstep : cB;
        for (int t = 0; t < nt; t += 2) {
            const bool last = (t == nt - 2);
            const char* a1 = cA + (size_t)(t + 1) * kstep;
            const char* a2 = last ? nA : cA + (size_t)(t + 2) * kstep; const char* b2 = last ? nB : cB + (size_t)(t + 2) * kstep;
            const char* a3 = a2 + kstep; const char* b3 = b2 + kstep;
            if (last && has_next) S.a_ready(nxt);
            if constexpr (SP2) {
            PG8_LDB(B0, 0, 0); PG8_LDB(B1, 0, 1); PG8_SCHED; PG8_LDA(At, 0, 0); PG8_STAGE(PG8_SA(1, 1), a1 + hstep, voffA);
            PG8_WAIT_V(8); PG8_WAIT_L(0); PG8_BAR; PG8_MMA(0, 0, At, B0); PG8_MMA(0, 1, At, B1); PG8_BAR; PG8_SCHED;
            PG8_LDA(At, 0, 1); PG8_STAGE(PG8_SB(0, 0), b2, voffB); PG8_STAGE(PG8_SB(0, 1), b2 + hstep, voffB); PG8_STAGE(PG8_SA(0, 0), a2, voffA);
            PG8_WAIT_V(8); PG8_WAIT_L(0); PG8_BAR; PG8_MMA(1, 0, At, B0); PG8_MMA(1, 1, At, B1); PG8_BAR; PG8_SCHED;
            PG8_LDB(B0, 1, 0); PG8_LDB(B1, 1, 1); PG8_SCHED; PG8_LDA(At, 1, 0); PG8_STAGE(PG8_SA(0, 1), a2 + hstep, voffA);
            PG8_WAIT_V(8); PG8_WAIT_L(0); PG8_BAR; PG8_MMA(0, 0, At, B0); PG8_MMA(0, 1, At, B1); PG8_BAR; PG8_SCHED;
            PG8_LDA(At, 1, 1); PG8_STAGE(PG8_SB(1, 0), b3, voffB); PG8_STAGE(PG8_SB(1, 1), b3 + hstep, voffB); PG8_STAGE(PG8_SA(1, 0), a3, voffA);
            PG8_WAIT_V(8); PG8_WAIT_L(0); PG8_BAR; PG8_MMA(1, 0, At, B0); PG8_MMA(1, 1, At, B1); PG8_BAR; PG8_SCHED;
            } else {
            PG8_LDB(B0, 0, 0); PG8_SCHED; PG8_LDA(At, 0, 0); PG8_STAGE(PG8_SA(1, 1), a1 + hstep, voffA);
            PG8_WAIT_L(8); PG8_BAR; PG8_WAIT_L(0); PG8_MMA(0, 0, At, B0); PG8_BAR; PG8_SCHED;
            PG8_LDB(B1, 0, 1); PG8_STAGE(PG8_SB(0, 0), b2, voffB);
            PG8_BAR; PG8_WAIT_L(0); PG8_MMA(0, 1, At, B1); PG8_BAR;
            PG8_LDA(At, 0, 1); PG8_STAGE(PG8_SA(0, 0), a2, voffA);
            PG8_BAR; PG8_WAIT_L(0); PG8_MMA(1, 0, At, B0); PG8_BAR; PG8_SCHED;
            PG8_STAGE(PG8_SB(0, 1), b2 + hstep, voffB);
            PG8_WAIT_V(6); PG8_BAR; PG8_MMA(1, 1, At, B1); PG8_BAR;
            PG8_LDB(B0, 1, 0); PG8_SCHED; PG8_LDA(At, 1, 0); PG8_STAGE(PG8_SA(0, 1), a2 + hstep, voffA);
            PG8_WAIT_L(8); PG8_BAR; PG8_WAIT_L(0); PG8_MMA(0, 0, At, B0); PG8_BAR; PG8_SCHED;
            PG8_LDB(B1, 1, 1); PG8_STAGE(PG8_SB(1, 0), b3, voffB);
            PG8_BAR; PG8_WAIT_L(0); PG8_MMA(0, 1, At, B1); PG8_BAR;
            PG8_LDA(At, 1, 1); PG8_STAGE(PG8_SA(1, 0), a3, voffA);
            PG8_BAR; PG8_WAIT_L(0); PG8_MMA(1, 0, At, B0); PG8_BAR; PG8_SCHED;
            PG8_STAGE(PG8_SB(1, 1), b3 + hstep, voffB);
            PG8_WAIT_V(6); PG8_BAR; PG8_MMA(1, 1, At, B1); PG8_BAR;
            }
        }
        if constexpr (ALIGN_EPI) { if (wr == 0) PG8_BAR; }
        if constexpr (!Epi::AFTER_DRAIN) { E(acc, cur, wr, wc, fr, fq); S.done(cur); }
        if (!has_next) break;
#pragma unroll
        for (int a = 0; a < 2; ++a)
#pragma unroll
            for (int b = 0; b < 2; ++b)
#pragma unroll
                for (int m = 0; m < 4; ++m)
#pragma unroll
                    for (int n = 0; n < 2; ++n) acc[a][b][m][n] = (f32x4){0.f, 0.f, 0.f, 0.f};
        cur = nxt; cA = nA; cB = nB; ++ui;
        if constexpr (ALIGN_EPI) { if (wr == 1) PG8_BAR; }
    }
    PG8_WAIT_V(0);
    if constexpr (!ALIGN_EPI) { if (wr == 0) PG8_BAR; }
    PG8_BAR;
    if constexpr (Epi::AFTER_DRAIN) { E.fused(acc, cur, wr, wc, fr, fq, lds, wid, lane); S.done(cur); }
#undef PG8_SA
#undef PG8_SB
#undef PG8_STAGE
#undef PG8_LDA
#undef PG8_LDB
#undef PG8_MMA
#undef PG8_WAIT_V
#undef PG8_WAIT_L
#undef PG8_BAR
#undef PG8_SCHED
}
}

struct EpiInProjP {
    static constexpr bool PERM = true, AFTER_DRAIN = false;
    bf16_t *PC, *PS, *PR, *PG, *VT;
    __device__ __forceinline__ void operator()(const pg8::f32x4 (&acc)[2][2][4][2], const pg8::Unit& u, int wr, int wc, int fr, int fq) const {
        const int row0 = u.pm * 256 + wr * 64 + fr;
#pragma unroll
        for (int bj = 0; bj < 2; ++bj) {
            const int blk = 2 * u.pn + bj; bf16_t* base; int ld, c0;
            if (blk >= 12 && blk < 15) {
                const int vc = 128 * (blk - 12) + wc * 32 + 8 * fq;
#pragma unroll
                for (int ai = 0; ai < 2; ++ai)
#pragma unroll
                    for (int m = 0; m < 4; ++m) {
                        const int row = row0 + ai * 128 + m * 16, b = row >> 11, t = row & 2047;
#pragma unroll
                        for (int n = 0; n < 2; ++n)
#pragma unroll
                            for (int e = 0; e < 4; ++e) { const int col = vc + 4 * n + e, hh = col >> 6, d = col & 63;
                                VT[((size_t)(b * NH + hh) * HD + d) * SEQ + t] = f2bf(acc[ai][bj][m][n][e]); }
                    }
                continue;
            }
            if (blk < 6) { base = PC; ld = PC_W; c0 = 128 * blk; }
            else if (blk < 12) { base = PS; ld = PS_W; c0 = 128 * (blk - 6); }
            else if (blk < 18) { base = PS; ld = PS_W; c0 = 768 + 128 * (blk - 15); }
            else if (blk < 28) { base = PR; ld = PR_W; c0 = 128 * (blk - 18); }
            else if (blk < 31) { base = PG; ld = PG_W; c0 = 128 * (blk - 28); }
            else continue;
            const int col = c0 + wc * 32 + 8 * fq;
#pragma unroll
            for (int ai = 0; ai < 2; ++ai)
#pragma unroll
                for (int m = 0; m < 4; ++m) {
                    const pg8::f32x4 v0 = acc[ai][bj][m][0], v1 = acc[ai][bj][m][1]; pg8::u32x4 w;
                    w.x = pg8::cvt_pk_bf16(v0[0], v0[1]); w.y = pg8::cvt_pk_bf16(v0[2], v0[3]); w.z = pg8::cvt_pk_bf16(v1[0], v1[1]); w.w = pg8::cvt_pk_bf16(v1[2], v1[3]);
                    *(pg8::u32x4*)(base + (size_t)(row0 + ai * 128 + m * 16) * ld + col) = w;
                }
        }
    }
};
struct EpiOutBf16P {
    static constexpr bool PERM = true, AFTER_DRAIN = false;
    bf16_t* Y; int ld;
    __device__ __forceinline__ void operator()(const pg8::f32x4 (&acc)[2][2][4][2], const pg8::Unit& u, int wr, int wc, int fr, int fq) const {
        const int row0 = u.pm * 256 + wr * 64 + fr, col0 = u.pn * 256 + wc * 32 + 8 * fq;
#pragma unroll
        for (int ai = 0; ai < 2; ++ai)
#pragma unroll
            for (int m = 0; m < 4; ++m)
#pragma unroll
                for (int bj = 0; bj < 2; ++bj) {
                    const pg8::f32x4 v0 = acc[ai][bj][m][0], v1 = acc[ai][bj][m][1]; pg8::u32x4 w;
                    w.x = pg8::cvt_pk_bf16(v0[0], v0[1]); w.y = pg8::cvt_pk_bf16(v0[2], v0[3]); w.z = pg8::cvt_pk_bf16(v1[0], v1[1]); w.w = pg8::cvt_pk_bf16(v1[2], v1[3]);
                    *(pg8::u32x4*)(Y + (size_t)(row0 + ai * 128 + m * 16) * ld + col0 + bj * 128) = w;
                }
    }
};

__device__ void phase_rowpass(const float* Xin, const bf16_t* Y, const float* gpost, float* Xout, bf16_t* XB) {
    const int tid = tid_(), lane = tid & 63, wave = __builtin_amdgcn_readfirstlane(tid >> 6);
    for (int row = blockIdx.x * 8 + wave; row < M; row += gridDim.x * 8) {
        f32x4 y[4], x[4]; float ss = 0.f;
#pragma unroll
        for (int i = 0; i < 4; ++i) { const uint2 yw = ldnt_u2((const void*)(Y + (size_t)row * DM + i * 256 + lane * 4));
            y[i] = (f32x4){bf2f((bf16_t)(yw.x & 0xffff)), bf2f((bf16_t)(yw.x >> 16)), bf2f((bf16_t)(yw.y & 0xffff)), bf2f((bf16_t)(yw.y >> 16))};
            x[i] = __builtin_nontemporal_load((const f32x4*)(Xin + (size_t)row * DM + i * 256 + lane * 4));
            ss += y[i][0] * y[i][0] + y[i][1] * y[i][1] + y[i][2] * y[i][2] + y[i][3] * y[i][3]; }
        ss = wave_sum(ss);
        const float rstd = rsqrtf(ss * (1.0f / DM) + RMS_EPS);
        float s2 = 0.f;
#pragma unroll
        for (int i = 0; i < 4; ++i) { const f32x4 g = *(const f32x4*)(gpost + i * 256 + lane * 4);
            x[i] = x[i] + y[i] * rstd * g; s2 += x[i][0] * x[i][0] + x[i][1] * x[i][1] + x[i][2] * x[i][2] + x[i][3] * x[i][3];
            __builtin_nontemporal_store(x[i], (f32x4*)(Xout + (size_t)row * DM + i * 256 + lane * 4)); }
        if (XB) {
            s2 = wave_sum(s2);
            const float r2 = rsqrtf(s2 * (1.0f / DM) + RMS_EPS);
#pragma unroll
            for (int i = 0; i < 4; ++i) { uint2 w; w.x = pk2(x[i][0] * r2, x[i][1] * r2); w.y = pk2(x[i][2] * r2, x[i][3] * r2); *(uint2*)(XB + (size_t)row * DM + i * 256 + lane * 4) = w; }
        }
    }
}

__device__ void conv_job(const Params& p, int l, int job, float* lds) {
    const int tid = tid_(), lane = tid & 63, wave = __builtin_amdgcn_readfirstlane(tid >> 6);
    const int b = job / (SEQ / 32), t0 = (job % (SEQ / 32)) * 32;
    const bf16_t* PC = (const bf16_t*)(p.ws + WS_PC); bf16_t* MIX = (bf16_t*)(p.ws + WS_MIX);
    const float* dw = p.in[5] + l * TAPS * CW; const float* dwb = p.in[6] + l * CW; const float* lng = p.in[7] + l * CW; const float* lnb = p.in[8] + l * CW;
    const float* pw = p.in[9] + (size_t)l * CW * CW; const float* pwb = p.in[10] + l * CW;
    float* u = lds;
    float* cv = lds + 62 * 256;
    for (int idx = tid; idx < 62 * 256; idx += 512) {
        const int r = idx >> 8, c = idx & 255, t = t0 - 30 + r;
        float v = 0.f;
        if (t >= 0) { const bf16_t* pr = PC + (size_t)(b * SEQ + t) * PC_W; v = bf2f(pr[c]) * sigmoidf_(bf2f(pr[256 + c])); }
        u[idx] = v;
    }
    __syncthreads();
    for (int idx = tid; idx < 32 * 256; idx += 512) {
        const int tt = idx >> 8, c = idx & 255;
        float a = dwb[c];
#pragma unroll 4
        for (int j = 0; j < TAPS; ++j) a += dw[j * CW + c] * u[(tt + j) * 256 + c];
        cv[idx] = a;
    }
    __syncthreads();
    for (int q = 0; q < 4; ++q) {
        const int tt = wave * 4 + q; float x[4], s = 0.f;
#pragma unroll
        for (int i = 0; i < 4; ++i) { x[i] = cv[tt * 256 + lane + 64 * i]; s += x[i]; }
        const float mean = wave_sum(s) * (1.0f / CW); float vs = 0.f;
#pragma unroll
        for (int i = 0; i < 4; ++i) { const float d = x[i] - mean; vs += d * d; }
        const float rstd = rsqrtf(wave_sum(vs) * (1.0f / CW) + LN_EPS);
#pragma unroll
        for (int i = 0; i < 4; ++i) { const int c = lane + 64 * i; cv[tt * 256 + c] = siluf_((x[i] - mean) * rstd * lng[c] + lnb[c]); }
    }
    __syncthreads();
    {
        const int n = tid & 255, half = tid >> 8;
        float acc[16];
#pragma unroll
        for (int i = 0; i < 16; ++i) acc[i] = pwb[n];
#pragma unroll 2
        for (int k = 0; k < CW; ++k) {
            const float w = pw[(size_t)k * CW + n];
#pragma unroll
            for (int i = 0; i < 16; ++i) acc[i] += cv[(half * 16 + i) * 256 + k] * w;
        }
#pragma unroll
        for (int i = 0; i < 16; ++i) { const size_t row = (size_t)b * SEQ + t0 + half * 16 + i;
            const float g = bf2f(PC[row * PC_W + 512 + n]);
            MIX[row * DM + n] = f2bf(acc[i] * siluf_(g)); }
    }
    __syncthreads();
}

constexpr int CV_AS = 264;
__device__ void conv_job64(const Params& p, int l, int job, unsigned char* lds) {
    const int tid = tid_(), lane = tid & 63, wave = __builtin_amdgcn_readfirstlane(tid >> 6), fr = lane & 15, fq = lane >> 4;
    const int b = job >> 5, t0 = (job & 31) * 64;
    const bf16_t* PC = (const bf16_t*)(p.ws + WS_PC); bf16_t* MIX = (bf16_t*)(p.ws + WS_MIX);
    const float* dw = p.in[5] + l * TAPS * CW; const float* dwb = p.in[6] + l * CW; const float* lng = p.in[7] + l * CW; const float* lnb = p.in[8] + l * CW;
    const bf16_t* pwT = (const bf16_t*)(p.ws + WS_WPW) + (size_t)l * CW * CW; const float* pwb = p.in[10] + l * CW;
    float* u = (float*)lds;
    bf16_t* act = (bf16_t*)(lds + 94 * 256 * 4);
    for (int idx = tid; idx < 94 * 32; idx += 512) {
        const int r = idx >> 5, c8 = (idx & 31) * 8, t = t0 - 30 + r;
        float v[8];
        if (t >= 0) { const bf16_t* pr = PC + ((size_t)b * SEQ + t) * PC_W + c8; const bf16x8 a = *(const bf16x8*)pr, g = *(const bf16x8*)(pr + 256);
#pragma unroll
            for (int e = 0; e < 8; ++e) v[e] = bf2f((bf16_t)a[e]) * __builtin_amdgcn_rcpf(1.0f + __builtin_amdgcn_exp2f(-1.4426950408889634f * bf2f((bf16_t)g[e]))); }
        else {
#pragma unroll
            for (int e = 0; e < 8; ++e) v[e] = 0.f; }
        *(f32x4*)(u + r * 256 + c8) = (f32x4){v[0], v[1], v[2], v[3]}; *(f32x4*)(u + r * 256 + c8 + 4) = (f32x4){v[4], v[5], v[6], v[7]};
    }
    __syncthreads();
    const int c = tid & 255, half = tid >> 8;
    float acc[32];
    {
        float w[TAPS];
#pragma unroll
        for (int j = 0; j < TAPS; ++j) w[j] = dw[j * CW + c];
        const float bias = dwb[c];
#pragma unroll
        for (int i = 0; i < 32; ++i) acc[i] = bias;
        const float* up = u + (half * 32) * 256 + c;
#pragma unroll
        for (int rr = 0; rr < 62; ++rr) {
            const float uv = up[rr * 256];
#pragma unroll
            for (int i = 0; i < 32; ++i) { if (rr - i >= 0 && rr - i < TAPS) acc[i] += w[rr - i] * uv; }
        }
    }
    __syncthreads();
    float* cv = u;
#pragma unroll
    for (int i = 0; i < 32; ++i) cv[(half * 32 + i) * 256 + c] = acc[i];
    __syncthreads();
#pragma unroll 2
    for (int q = 0; q < 8; ++q) {
        const int tt = wave * 8 + q; const f32x4 x = *(const f32x4*)(cv + tt * 256 + lane * 4);
        const float mean = wave_sum(x[0] + x[1] + x[2] + x[3]) * (1.0f / CW);
        const f32x4 d = x - mean;
        const float rstd = rsqrtf(wave_sum(d[0] * d[0] + d[1] * d[1] + d[2] * d[2] + d[3] * d[3]) * (1.0f / CW) + LN_EPS);
        const f32x4 g = *(const f32x4*)(lng + lane * 4), bb = *(const f32x4*)(lnb + lane * 4);
        float y[4];
#pragma unroll
        for (int e = 0; e < 4; ++e) { const float v = d[e] * rstd * g[e] + bb[e]; y[e] = v * __builtin_amdgcn_rcpf(1.0f + __builtin_amdgcn_exp2f(-1.4426950408889634f * v)); }
        uint2 w; w.x = pk2(y[0], y[1]); w.y = pk2(y[2], y[3]); *(uint2*)(act + tt * CV_AS + lane * 4) = w;
    }
    __syncthreads();
    {
        f32x4 o[2][4];
#pragma unroll
        for (int i = 0; i < 2; ++i)
#pragma unroll
            for (int j = 0; j < 4; ++j) o[i][j] = (f32x4){0.f, 0.f, 0.f, 0.f};
#pragma unroll 2
        for (int kk = 0; kk < 8; ++kk) {
            bf16x8 a[2], bq[4];
#pragma unroll
            for (int i = 0; i < 2; ++i) a[i] = *(const bf16x8*)(pwT + (size_t)(wave * 32 + i * 16 + fr) * CW + kk * 32 + fq * 8);
#pragma unroll
            for (int j = 0; j < 4; ++j) bq[j] = *(const bf16x8*)(act + (j * 16 + fr) * CV_AS + kk * 32 + fq * 8);
#pragma unroll
            for (int i = 0; i < 2; ++i)
#pragma unroll
                for (int j = 0; j < 4; ++j) o[i][j] = __builtin_amdgcn_mfma_f32_16x16x32_bf16(a[i], bq[j], o[i][j], 0, 0, 0);
        }
#pragma unroll
        for (int i = 0; i < 2; ++i) {
            const int n0 = wave * 32 + i * 16 + fq * 4; const f32x4 bias = *(const f32x4*)(pwb + n0);
#pragma unroll
            for (int j = 0; j < 4; ++j) {
                const size_t row = (size_t)b * SEQ + t0 + j * 16 + fr;
                const uint2 gw = *(const uint2*)(PC + row * PC_W + 512 + n0);
                const float g0 = bf2f((bf16_t)(gw.x & 0xffff)), g1 = bf2f((bf16_t)(gw.x >> 16)), g2 = bf2f((bf16_t)(gw.y & 0xffff)), g3 = bf2f((bf16_t)(gw.y >> 16));
                const f32x4 v = o[i][j] + bias;
                uint2 w; w.x = pk2(v[0] * siluf_(g0), v[1] * siluf_(g1)); w.y = pk2(v[2] * siluf_(g2), v[3] * siluf_(g3));
                *(uint2*)(MIX + row * DM + n0) = w;
            }
        }
    }
    __syncthreads();
}

__device__ void attn_job(const Params& p, int job) {
    const int tid = tid_(), lane = tid & 63, wave = __builtin_amdgcn_readfirstlane(tid >> 6);
    const int bh = job >> 2, qb = job & 3, b = bh / NH, h = bh % NH;
    const bf16_t* PS = (const bf16_t*)(p.ws + WS_PS); bf16_t* MIX = (bf16_t*)(p.ws + WS_MIX);
    const int tw = qb * 512 + wave * 64, t = tw + lane;
    const size_t row = (size_t)b * SEQ + t;
    const float qs = 1.0f;
    const bf16_t* VT = (const bf16_t*)(p.ws + WS_VT) + (size_t)bh * HD * SEQ;
    float q[64], o[64];
    {
        const bf16_t* qp = PS + row * PS_W + h * HD;
#pragma unroll
        for (int i = 0; i < 8; ++i) { const bf16x8 v = *(const bf16x8*)(qp + i * 8);
#pragma unroll
            for (int j = 0; j < 8; ++j) { q[i * 8 + j] = bf2f((bf16_t)v[j]) * qs; o[i * 8 + j] = 0.f; } }
    }
    float rp = 1.0f;
    const int z = opaque_zero();
    for (int s = tw + 62; s >= 0; --s) {
        const bf16_t* kp = PS + ((size_t)b * SEQ + s) * PS_W + 384 + h * HD + z;
        float dot = 0.f;
#pragma unroll
        for (int i = 0; i < 8; ++i) { const bf16x8 v = *(const bf16x8*)(kp + i * 8);
#pragma unroll
            for (int j = 0; j < 8; ++j) dot += q[i * 8 + j] * bf2f((bf16_t)v[j]); }
        const bool act = s < t;
        const float e = __builtin_amdgcn_exp2f(dot);
        const float keep = __builtin_amdgcn_rcpf(1.0f + e);
        const float pr = act ? (1.0f - keep) * rp : 0.f;
        rp = act ? rp * keep : rp;
#pragma unroll
        for (int d = 0; d < 64; ++d) o[d] += pr * bf2f(VT[(size_t)d * SEQ + s + z]);
        if (__all(rp == 0.0f)) break;
    }
    const bf16_t* gp = PS + row * PS_W + 768 + h * HD;
    bf16_t* op = MIX + row * DM + CW + h * HD;
#pragma unroll
    for (int i = 0; i < 8; ++i) { const bf16x8 g = *(const bf16x8*)(gp + i * 8); uint4 w;
        w.x = pk2(o[i * 8 + 0] * siluf_(bf2f((bf16_t)g[0])), o[i * 8 + 1] * siluf_(bf2f((bf16_t)g[1])));
        w.y = pk2(o[i * 8 + 2] * siluf_(bf2f((bf16_t)g[2])), o[i * 8 + 3] * siluf_(bf2f((bf16_t)g[3])));
        w.z = pk2(o[i * 8 + 4] * siluf_(bf2f((bf16_t)g[4])), o[i * 8 + 5] * siluf_(bf2f((bf16_t)g[5])));
        w.w = pk2(o[i * 8 + 6] * siluf_(bf2f((bf16_t)g[6])), o[i * 8 + 7] * siluf_(bf2f((bf16_t)g[7])));
        *(uint4*)(op + i * 8) = w; }
}

typedef float f32x16 __attribute__((ext_vector_type(16)));
struct AttFrag { bf16x8 K[4], V[2][2]; };
constexpr int AT_WIN = 224;
constexpr int AT_KS = 144, AT_VS = 976;
constexpr int AT_VOFF = (AT_WIN + 256) * AT_KS;
static_assert(AT_VOFF + 64 * AT_VS <= 147456, "attention LDS map");
__device__ __forceinline__ void att_load(AttFrag& F, const bf16_t* kbase, const bf16_t* vbase, const unsigned char* klds, const unsigned char* vlds, int w0, int kt) {
    const int s0 = (kt > 0 ? kt : 0) * 32;
    if (s0 >= w0) {
        const unsigned char* kp = klds + (s0 - w0) * AT_KS; const unsigned char* vp = vlds + (s0 - w0) * 2;
#pragma unroll
        for (int ks = 0; ks < 4; ++ks) F.K[ks] = *(const bf16x8*)(kp + ks * 32);
#pragma unroll
        for (int db = 0; db < 2; ++db)
#pragma unroll
            for (int s = 0; s < 2; ++s) F.V[db][s] = *(const bf16x8*)(vp + db * 32 * AT_VS + s * 16);
    } else {
#pragma unroll
        for (int ks = 0; ks < 4; ++ks) F.K[ks] = *(const bf16x8*)(kbase + (size_t)s0 * PS_W + ks * 16);
#pragma unroll
        for (int db = 0; db < 2; ++db)
#pragma unroll
            for (int s = 0; s < 2; ++s) F.V[db][s] = *(const bf16x8*)(vbase + (size_t)db * 32 * SEQ + s0 + s * 8);
    }
}
__device__ __forceinline__ bool att_tile(const AttFrag& F, const bf16x8 (&Qf)[4], f32x16& O0, f32x16& O1, float& rp, bool diag, int qi, int hf) {
    f32x16 S;
#pragma unroll
    for (int r = 0; r < 16; ++r) S[r] = 0.f;
#pragma unroll
    for (int ks = 0; ks < 4; ++ks) S = __builtin_amdgcn_mfma_f32_32x32x16_bf16(F.K[ks], Qf[ks], S, 0, 0, 0);
    float tot = 1.0f;
#pragma unroll
    for (int r = 0; r < 16; ++r) {
        float k_ = __builtin_amdgcn_rcpf(1.0f + __builtin_amdgcn_exp2f(S[r]));
        if (diag && (hf * 16 + r >= qi)) k_ = 1.0f;
        S[r] = k_; tot *= k_;
    }
    const float toto = __shfl_xor(tot, 32);
    float e = hf ? rp : rp * toto;
#pragma unroll
    for (int r = 15; r >= 0; --r) { const float k_ = S[r]; S[r] = (1.0f - k_) * e; e *= k_; }
    rp = rp * tot * toto;
    bf16x8 Pf[2];
#pragma unroll
    for (int s = 0; s < 2; ++s) {
        union { bf16x8 v; unsigned u[4]; } pk;
#pragma unroll
        for (int j = 0; j < 4; ++j) pk.u[j] = pk2(S[8 * s + 2 * j], S[8 * s + 2 * j + 1]);
        Pf[s] = pk.v;
    }
#pragma unroll
    for (int s = 0; s < 2; ++s) { O0 = __builtin_amdgcn_mfma_f32_32x32x16_bf16(F.V[0][s], Pf[s], O0, 0, 0, 0); O1 = __builtin_amdgcn_mfma_f32_32x32x16_bf16(F.V[1][s], Pf[s], O1, 0, 0, 0); }
    return __ballot(rp != 0.0f) == 0ull;
}
__device__ void attn_wg_job(const Params& p, int job, unsigned char* lds) {
    const int tid = tid_(), lane = tid & 63, wave = __builtin_amdgcn_readfirstlane(tid >> 6), qi = lane & 31, hf = lane >> 5;
    const int bh = job >> 3, g = job & 7, b = bh / NH, h = bh % NH;
    const bf16_t* PS = (const bf16_t*)(p.ws + WS_PS); const bf16_t* VT = (const bf16_t*)(p.ws + WS_VT) + (size_t)bh * HD * SEQ; bf16_t* MIX = (bf16_t*)(p.ws + WS_MIX);
    const int w0 = g * 256 > AT_WIN ? g * 256 - AT_WIN : 0, nkeys = g * 256 + 256 - w0;
    unsigned char* klds = lds; unsigned char* vlds = lds + AT_VOFF;
    {
        const bf16_t* ksrc = PS + ((size_t)b * SEQ + w0) * PS_W + SBW + h * HD;
        for (int idx = tid; idx < nkeys * 8; idx += 512) { const int row = idx >> 3, pc = idx & 7; *(uint4*)(klds + row * AT_KS + pc * 16) = *(const uint4*)(ksrc + (size_t)row * PS_W + pc * 8); }
        const int pc = tid & 63, npc = nkeys >> 3;
        if (pc < npc) {
#pragma unroll
            for (int i = 0; i < 8; ++i) { const int d = (tid >> 6) + 8 * i; *(uint4*)(vlds + d * AT_VS + pc * 16) = *(const uint4*)(VT + (size_t)d * SEQ + w0 + pc * 8); }
        }
    }
    __syncthreads();
    {
        const int qblk = g * 8 + wave, q0 = qblk * 32;
        const size_t rowq = (size_t)b * SEQ + q0 + qi;
        const int pi = (qi & 3) + 4 * (qi >> 3) + 16 * ((qi >> 2) & 1);
        const bf16_t* kbase = PS + ((size_t)b * SEQ + pi) * PS_W + SBW + h * HD + hf * 8;
        const bf16_t* vbase = VT + (size_t)qi * SEQ + hf * 16;
        const unsigned char* kl = klds + pi * AT_KS + hf * 16; const unsigned char* vl = vlds + qi * AT_VS + hf * 32;
        AttFrag FA, FB;
        att_load(FA, kbase, vbase, kl, vl, w0, qblk);
        bf16x8 Qf[4];
#pragma unroll
        for (int ks = 0; ks < 4; ++ks) Qf[ks] = *(const bf16x8*)(PS + rowq * PS_W + h * HD + ks * 16 + hf * 8);
        f32x16 O0, O1;
#pragma unroll
        for (int r = 0; r < 16; ++r) { O0[r] = 0.f; O1[r] = 0.f; }
        float rp = 1.0f;
        for (int kt = qblk; kt >= 0; kt -= 2) {
            att_load(FB, kbase, vbase, kl, vl, w0, kt - 1);
            if (att_tile(FA, Qf, O0, O1, rp, kt == qblk, qi, hf) || kt < 1) break;
            att_load(FA, kbase, vbase, kl, vl, w0, kt - 2);
            if (att_tile(FB, Qf, O0, O1, rp, false, qi, hf)) break;
        }
        const bf16_t* gp = PS + rowq * PS_W + 768 + h * HD; bf16_t* op = MIX + rowq * DM + CW + h * HD;
#pragma unroll
        for (int db = 0; db < 2; ++db)
#pragma unroll
            for (int gq = 0; gq < 4; ++gq) {
                const int d0 = db * 32 + gq * 8 + hf * 4;
                const uint2 gw = *(const uint2*)(gp + d0);
                const float g0 = bf2f((bf16_t)(gw.x & 0xffff)), g1 = bf2f((bf16_t)(gw.x >> 16)), g2 = bf2f((bf16_t)(gw.y & 0xffff)), g3 = bf2f((bf16_t)(gw.y >> 16));
                const f32x16& O = db ? O1 : O0;
                uint2 w; w.x = pk2(O[4 * gq] * siluf_(g0), O[4 * gq + 1] * siluf_(g1)); w.y = pk2(O[4 * gq + 2] * siluf_(g2), O[4 * gq + 3] * siluf_(g3));
                *(uint2*)(op + d0) = w;
            }
    }
    __syncthreads();
}

__device__ void rwkv_job(const Params& p, int l, int job, float* lds) {
    const int tid = tid_(), lane = tid & 63, wave = __builtin_amdgcn_readfirstlane(tid >> 6);
    const int b = job / NH, h = job % NH;
    const bf16_t* PR = (const bf16_t*)(p.ws + WS_PR); const bf16_t* PG = (const bf16_t*)(p.ws + WS_PG);
    float* VF = (float*)(p.ws + WS_VF); bf16_t* MIX = (bf16_t*)(p.ws + WS_MIX);
    const float* mu = p.in[11] + l * 1216; const float* w0 = p.in[12] + l * RWW; const float* w2 = p.in[13] + l * LORA * RWW;
    const float* a0 = p.in[14] + l * RWW; const float* a2 = p.in[15] + l * LORA * RWW; const float* kks = p.in[16] + l * RWW; const float* ka = p.in[17] + l * RWW;
    const float* rk = p.in[18] + l * RWW; const float* gng = p.in[19] + l * RWW; const float* gnb = p.in[20] + l * RWW;
    const float* v0 = p.in[21]; const float* v1 = p.in[22]; const float* v2 = p.in[23];
    float* R = lds; float* W = R + 4096; float* K = W + 4096; float* V = K + 4096; float* A = V + 4096; float* Bm = A + 4096; float* Y = Bm + 4096;
    float* WD = Y + 4096; float* AD = WD + 2048; float* VL = AD + 2048;
    float S[64];
#pragma unroll
    for (int i = 0; i < 64; ++i) S[i] = 0.f;
    for (int c = 0; c < SEQ / 64; ++c) {
        const int t0 = c * 64;
        for (int idx = tid; idx < 64 * 64; idx += 512) {
            const int tt = idx >> 6, i = idx & 63, t = t0 + tt;
            const bf16_t* cur = PR + ((size_t)b * SEQ + t) * PR_W;
            const float xc = bf2f(cur[1152 + i]), xp = t > 0 ? bf2f(cur[1152 + i - PR_W]) : 0.f;
            const float f = xc + (xp - xc) * mu[1152 + i];
            if (i < 32) WD[tt * 32 + i] = tanhf(f); else AD[tt * 32 + i - 32] = f;
        }
        if (l > 0) {
            for (int idx = tid; idx < 64 * 32; idx += 512) {
                const int tt = idx >> 5, i = idx & 31, t = t0 + tt;
                const bf16_t* cur = PR + ((size_t)b * SEQ + t) * PR_W + 768;
                float a = 0.f;
                for (int cc = 0; cc < RWW; ++cc) {
                    const float xc = bf2f(cur[cc]), xp = t > 0 ? bf2f(cur[cc - PR_W]) : 0.f;
                    a += (xc + (xp - xc) * mu[768 + cc]) * v1[cc * LORA + i];
                }
                VL[idx] = a;
            }
        }
        __syncthreads();
        for (int idx = tid; idx < 64 * 64; idx += 512) {
            const int tt = idx >> 6, j = idx & 63, t = t0 + tt, cj = h * HD + j;
            const size_t row = (size_t)b * SEQ + t;
            const bf16_t* cur = PR + row * PR_W;
            const bool hp = t > 0;
            float rc = bf2f(cur[cj]), kc = bf2f(cur[384 + cj]), vc = bf2f(cur[768 + cj]);
            const float rp_ = hp ? bf2f(cur[cj - PR_W]) : 0.f, kp_ = hp ? bf2f(cur[384 + cj - PR_W]) : 0.f, vp_ = hp ? bf2f(cur[768 + cj - PR_W]) : 0.f;
            rc += (rp_ - rc) * mu[cj]; kc += (kp_ - kc) * mu[384 + cj]; vc += (vp_ - vc) * mu[768 + cj];
            float wl = w0[cj], al = a0[cj];
#pragma unroll 8
            for (int i = 0; i < LORA; ++i) { wl += WD[tt * 32 + i] * w2[i * RWW + cj]; al += AD[tt * 32 + i] * a2[i * RWW + cj]; }
            const float sp = fmaxf(-wl, 0.f) + log1pf(__expf(-fabsf(wl)));
            const float decay = __expf(-__expf(-sp - 0.5f));
            const float alr = sigmoidf_(al);
            if (l > 0) {
                float vg = v0[cj];
#pragma unroll 8
                for (int i = 0; i < LORA; ++i) vg += VL[tt * 32 + i] * v2[i * RWW + cj];
                vg = sigmoidf_(vg);
                vc = vc + (VF[row * RWW + cj] - vc) * vg;
            } else VF[row * RWW + cj] = vc;
            R[idx] = rc; W[idx] = decay; V[idx] = vc;
            K[idx] = kc * (1.0f + (alr - 1.0f) * ka[cj]);
            A[idx] = kc * kks[cj];
            Bm[idx] = alr;
        }
        __syncthreads();
        for (int q = 0; q < 8; ++q) {
            const int tt = wave * 8 + q; const float kk = A[tt * 64 + lane];
            const float nrm = sqrtf(wave_sum(kk * kk));
            const float kn = kk / fmaxf(nrm, 1e-12f);
            A[tt * 64 + lane] = -kn; Bm[tt * 64 + lane] = kn * Bm[tt * 64 + lane];
        }
        __syncthreads();
        if (wave == 0) {
            for (int tt = 0; tt < 64; ++tt) {
                const f32x4* a4 = (const f32x4*)(A + tt * 64); const f32x4* w4 = (const f32x4*)(W + tt * 64); const f32x4* b4 = (const f32x4*)(Bm + tt * 64);
                const f32x4* k4 = (const f32x4*)(K + tt * 64); const f32x4* r4 = (const f32x4*)(R + tt * 64);
                float sa = 0.f;
#pragma unroll
                for (int i = 0; i < 16; ++i) { const f32x4 a = a4[i]; sa += S[4 * i] * a[0] + S[4 * i + 1] * a[1] + S[4 * i + 2] * a[2] + S[4 * i + 3] * a[3];
                    if ((i & 7) == 7) asm volatile("" ::: "memory"); }
                const float vv = V[tt * 64 + lane];
                float y = 0.f;
#pragma unroll
                for (int i = 0; i < 16; ++i) { const f32x4 w = w4[i], bb = b4[i], kk = k4[i], rr = r4[i];
#pragma unroll
                    for (int e = 0; e < 4; ++e) { const float s = S[4 * i + e] * w[e] + sa * bb[e] + vv * kk[e]; S[4 * i + e] = s; y += s * rr[e]; }
                    if ((i & 1) == 1) asm volatile("" ::: "memory"); }
                Y[tt * 64 + lane] = y;
            }
        }
        __syncthreads();
        for (int q = 0; q < 8; ++q) {
            const int tt = wave * 8 + q, t = t0 + tt, cj = h * HD + lane; const size_t row = (size_t)b * SEQ + t;
            const float y = Y[tt * 64 + lane];
            const float mean = wave_sum(y) * (1.0f / HD); const float d = y - mean;
            const float var = wave_sum(d * d) * (1.0f / HD);
            const float yn = d * rsqrtf(var + GN_EPS) * gng[cj] + gnb[cj];
            const float bonus = wave_sum(R[tt * 64 + lane] * K[tt * 64 + lane] * rk[cj]);
            const float o = yn + bonus * V[tt * 64 + lane];
            const float g = bf2f(PG[row * PG_W + cj]);
            MIX[row * DM + CW + SBW + cj] = f2bf(o * siluf_(g));
        }
        __syncthreads();
    }
}

constexpr int TS = 72;
constexpr int TILE_B = 64 * TS * 2;
constexpr int AABS = 68, XTS = 65, CSS = 65;

__device__ __forceinline__ f32x4 mm_tile(const bf16_t* X, int m0, const bf16_t* Yt, int n0, int K, int fr, int fq, f32x4 acc) {
#pragma unroll
    for (int kk = 0; kk < 2; ++kk) {
        if (kk * 32 < K) {
            const bf16x8 a = *(const bf16x8*)(X + (m0 + fr) * TS + kk * 32 + fq * 8);
            const bf16x8 b = *(const bf16x8*)(Yt + (n0 + fr) * TS + kk * 32 + fq * 8);
            acc = __builtin_amdgcn_mfma_f32_16x16x32_bf16(a, b, acc, 0, 0, 0);
        }
    }
    return acc;
}
__device__ __forceinline__ uint2 pk4(const f32x4& v) { uint2 w; w.x = pk2(v[0], v[1]); w.y = pk2(v[2], v[3]); return w; }

struct B1Loads {
    bf16x8 rc, kc, vc, rp, kp, vp;
    f32x4 vf0, vf1;
    bf16x8 cc[2], cp[2];
};
__device__ __forceinline__ void b1_issue_loads(const Params& p, int l, int gi, int h, int tid, B1Loads& L) {
    const int b = gi >> 5, c = gi & 31, t0 = c * 64;
    const bf16_t* PR = (const bf16_t*)(p.ws + WS_PR); const float* VF = (const float*)(p.ws + WS_VF);
    {
        const int tt = tid >> 3, j0 = (tid & 7) * 8, t = t0 + tt, cj0 = h * HD + j0; const size_t row = (size_t)b * SEQ + t;
        const bf16_t* cur = PR + row * PR_W; const bf16_t* prv = cur - (t > 0 ? PR_W : 0);
        L.rc = *(const bf16x8*)(cur + cj0); L.kc = *(const bf16x8*)(cur + 384 + cj0); L.vc = *(const bf16x8*)(cur + 768 + cj0);
        L.rp = *(const bf16x8*)(prv + cj0); L.kp = *(const bf16x8*)(prv + 384 + cj0); L.vp = *(const bf16x8*)(prv + 768 + cj0);
        if (l > 0) { L.vf0 = *(const f32x4*)(VF + row * RWW + cj0); L.vf1 = *(const f32x4*)(VF + row * RWW + cj0 + 4); }
    }
    if (h == 0) {
#pragma unroll
        for (int q = 0; q < 2; ++q) {
            const int item = tid + 512 * q, tt = item >> 4, g = item & 15, t = t0 + tt;
            const bf16_t* cur = PR + ((size_t)b * SEQ + t) * PR_W + 1152; const bf16_t* prv = cur - (t > 0 ? PR_W : 0);
            const int gc = g < 12 ? g : 0, gp = g < 8 ? g : (g < 12 ? g + 4 : 0);
            L.cc[q] = *(const bf16x8*)(cur + 8 * gc); L.cp[q] = *(const bf16x8*)(prv + 8 * gp);
        }
    }
}

__device__ void rwkv_b1_phase(const Params& p, int l, unsigned char* lds) {
    const int G = gridDim.x;
    float* VF = (float*)(p.ws + WS_VF);
    const float* mu = p.in[11] + l * 1216; const float* w0 = p.in[12] + l * RWW;
    const float* a0 = p.in[14] + l * RWW; const float* kks = p.in[16] + l * RWW; const float* ka = p.in[17] + l * RWW;
    const float* rk = p.in[18] + l * RWW; const float* v0 = p.in[21];
    const float* w2 = p.in[13] + l * LORA * RWW; const float* a2 = p.in[15] + l * LORA * RWW; const float* v2 = p.in[23];
    bf16_t* T_At = (bf16_t*)lds; bf16_t* T_Rt = T_At + 64 * TS; bf16_t* T_Bt = T_Rt + 64 * TS; bf16_t* T_Kt = T_Bt + 64 * TS;
    bf16_t* T_VT = T_Kt + 64 * TS; bf16_t* T_bhT = T_VT + 64 * TS; bf16_t* T_khT = T_bhT + 64 * TS;
    bf16_t* T_Aak = T_khT + 64 * TS; bf16_t* T_Arb = T_Aak + 64 * TS; bf16_t* T_Ark = T_Arb + 64 * TS;
    bf16_t* T_WT = T_At; bf16_t* T_U0T = T_Bt;
    float* Aab = (float*)(lds + 10 * TILE_B);
    float* XT = (float*)(lds + 10 * TILE_B + 64 * AABS * 4);
    float* PCv = XT + 128 * XTS;
    float* TI = PCv + 64;
    float* CS = (float*)T_Aak;
    constexpr int LS = 33;
    float* WD = Aab; float* AD = WD + 64 * LS;
    float* VL = XT + 64 * XTS;
    float* WLT = (float*)lds; float* ALT = WLT + 64 * XTS; float* VGT = ALT + 64 * XTS;

    constexpr int NGRP = BATCH * (SEQ / 64);
    int gi = blockIdx.x;
    if (gi >= NGRP) return;
    B1Loads L;
    b1_issue_loads(p, l, gi, 0, tid_(), L);
    float codes[2][8];
#pragma unroll 1
    for (int it = 0; gi < NGRP; ++it) {
        const int h = it % NH;
        const int tid = tid_(), lane = tid & 63, wave = __builtin_amdgcn_readfirstlane(tid >> 6), fr = lane & 15, fq = lane >> 4;
        const int b = gi >> 5, c = gi & 31, bh = b * NH + h, jb = bh * 32 + c, t0 = c * 64;
        float wg[6][8];
#pragma unroll
        for (int q = 0; q < 6; ++q) {
            const int id = wave + 8 * q, Lk = id >> 4, tj = id & 3;
            if (q < 4 || l > 0) {
                const float* Wg = (Lk == 0 ? w2 : (Lk == 1 ? a2 : v2)) + (size_t)fq * RWW + h * HD + tj * 16 + fr;
#pragma unroll
                for (int kk = 0; kk < 8; ++kk) wg[q][kk] = Wg[(size_t)kk * 4 * RWW];
            }
        }
#pragma unroll
        for (int q = 0; q < 2; ++q) {
            const int item = tid + 512 * q, tt = item >> 4, g = item & 15, t = t0 + tt; const bool hp = t > 0;
            if (h == 0) {
#pragma unroll
                for (int e = 0; e < 8; ++e) {
                    const float xc = bf2f((bf16_t)L.cc[q][e]), xp = hp ? bf2f((bf16_t)L.cp[q][e]) : 0.f;
                    const float x_ = xc + (xp - xc) * mu[1152 + 8 * (g & 7) + e];
                    codes[q][e] = g < 4 ? 1.0f - 2.0f * __builtin_amdgcn_rcpf(1.0f + __builtin_amdgcn_exp2f(2.8853900817779268f * x_)) : (g < 8 ? x_ : xc + xp);
                }
            }
            if (g < 8 || (g < 12 && l > 0)) {
                float* dst = (g < 4 ? WD + tt * LS + 8 * g : (g < 8 ? AD + tt * LS + 8 * (g - 4) : VL + tt * LS + 8 * (g - 8)));
#pragma unroll
                for (int e = 0; e < 8; ++e) dst[e] = codes[q][e];
            }
        }
        __syncthreads();
#pragma unroll
        for (int q = 0; q < 6; ++q) {
            if (q < 4 || l > 0) {
                const int id = wave + 8 * q, Lk = id >> 4, ti = (id >> 2) & 3, tj = id & 3;
                const float* Xs = (Lk == 0 ? WD : (Lk == 1 ? AD : VL)) + (ti * 16 + fr) * LS + fq;
                f32x4 acc = (f32x4){0.f, 0.f, 0.f, 0.f};
#pragma unroll
                for (int kk = 0; kk < 8; ++kk) acc = __builtin_amdgcn_mfma_f32_16x16x4f32(Xs[kk * 4], wg[q][kk], acc, 0, 0, 0);
                float* out = (Lk == 0 ? WLT : (Lk == 1 ? ALT : VGT)) + (tj * 16 + fr) * XTS + ti * 16 + fq * 4;
#pragma unroll
                for (int r = 0; r < 4; ++r) out[r] = acc[r];
            }
        }
        __syncthreads();
        const int tt = tid >> 3, j0 = (tid & 7) * 8, t = t0 + tt, cj0 = h * HD + j0;
        const size_t row = (size_t)b * SEQ + t;
        float rr[8], kk_[8], vv[8], aa[8], bb[8], lw[8];
        {
            const bool hp = t > 0;
            float wl[8], al[8], vg[8];
#pragma unroll
            for (int e = 0; e < 8; ++e) {
                const float r_c = bf2f((bf16_t)L.rc[e]), k_c = bf2f((bf16_t)L.kc[e]), v_c = bf2f((bf16_t)L.vc[e]);
                const float r_p = hp ? bf2f((bf16_t)L.rp[e]) : 0.f, k_p = hp ? bf2f((bf16_t)L.kp[e]) : 0.f, v_p = hp ? bf2f((bf16_t)L.vp[e]) : 0.f;
                rr[e] = r_c + (r_p - r_c) * mu[cj0 + e]; kk_[e] = k_c + (k_p - k_c) * mu[384 + cj0 + e]; vv[e] = v_c + (v_p - v_c) * mu[768 + cj0 + e];
                wl[e] = w0[cj0 + e] + WLT[(j0 + e) * XTS + tt]; al[e] = a0[cj0 + e] + ALT[(j0 + e) * XTS + tt]; vg[e] = l > 0 ? v0[cj0 + e] + VGT[(j0 + e) * XTS + tt] : 0.f;
            }
            float ssq = 0.f, bon = 0.f;
#pragma unroll
            for (int e = 0; e < 8; ++e) {
                const float sp2 = fmaxf(-wl[e], 0.f) * 1.4426950408889634f + __builtin_amdgcn_logf(1.0f + __builtin_amdgcn_exp2f(-1.4426950408889634f * fabsf(wl[e])));
                lw[e] = -__builtin_amdgcn_exp2f(-sp2 - 0.7213475204444817f);
                const float alr = __builtin_amdgcn_rcpf(1.0f + __builtin_amdgcn_exp2f(-1.4426950408889634f * al[e]));
                if (l > 0) { const float vf = e < 4 ? L.vf0[e & 3] : L.vf1[e & 3]; vv[e] = vv[e] + (vf - vv[e]) * __builtin_amdgcn_rcpf(1.0f + __builtin_amdgcn_exp2f(-1.4426950408889634f * vg[e])); }
                const float kkr = kk_[e] * kks[cj0 + e];
                kk_[e] = kk_[e] * (1.0f + (alr - 1.0f) * ka[cj0 + e]);
                aa[e] = kkr; bb[e] = alr; ssq += kkr * kkr; bon += rr[e] * kk_[e] * rk[cj0 + e];
            }
            if (l == 0) { __builtin_nontemporal_store((f32x4){vv[0], vv[1], vv[2], vv[3]}, (f32x4*)(VF + row * RWW + cj0)); __builtin_nontemporal_store((f32x4){vv[4], vv[5], vv[6], vv[7]}, (f32x4*)(VF + row * RWW + cj0 + 4)); }
            ssq += __shfl_xor(ssq, 1); ssq += __shfl_xor(ssq, 2); ssq += __shfl_xor(ssq, 4);
            bon += __shfl_xor(bon, 1); bon += __shfl_xor(bon, 2); bon += __shfl_xor(bon, 4);
            const float inv = fminf(__builtin_amdgcn_rsqf(ssq), 1e12f);
            uint4 bvw; float bv[8];
#pragma unroll
            for (int e = 0; e < 8; ++e) { const float kn = aa[e] * inv; aa[e] = -kn; bb[e] = kn * bb[e]; bv[e] = bon * vv[e]; CS[tt * CSS + j0 + e] = lw[e]; }
            bvw.x = pk2(bv[0], bv[1]); bvw.y = pk2(bv[2], bv[3]); bvw.z = pk2(bv[4], bv[5]); bvw.w = pk2(bv[6], bv[7]);
            *(uint4*)((bf16_t*)(p.ws + WS_CH_BV) + (size_t)jb * 4096 + tt * 64 + j0) = bvw;
        }
        __syncthreads();
#pragma unroll
        for (int e = 0; e < 8; ++e) {
            const int j = wave * 8 + e; float x = CS[lane * CSS + j];
#pragma unroll
            for (int o = 1; o < 64; o <<= 1) { const float y = __shfl_up(x, o); if (lane >= o) x += y; }
            CS[lane * CSS + j] = x;
        }
        __syncthreads();
        {
            float at[8], rt[8], bt[8], kt[8];
#pragma unroll
            for (int e = 0; e < 8; ++e) {
                const int j = j0 + e; const float cs = CS[tt * CSS + j] * 1.4426950408889634f, csC = CS[63 * CSS + j] * 1.4426950408889634f, lw2 = lw[e] * 1.4426950408889634f;
                const float e_in = __builtin_amdgcn_exp2f(cs), e_ex = __builtin_amdgcn_exp2f(cs - lw2), e_ng = __builtin_amdgcn_exp2f(-cs), e_ht = __builtin_amdgcn_exp2f(csC - cs);
                at[e] = aa[e] * e_ex; rt[e] = rr[e] * e_in; bt[e] = bb[e] * e_ng; kt[e] = kk_[e] * e_ng;
                T_VT[j * TS + tt] = f2bf(vv[e]); T_bhT[j * TS + tt] = f2bf(bb[e] * e_ht); T_khT[j * TS + tt] = f2bf(kk_[e] * e_ht);
                XT[j * XTS + tt] = at[e];
                if (tt == 63) PCv[j] = __builtin_amdgcn_exp2f(csC);
            }
            uint4 w;
            w.x = pk2(at[0], at[1]); w.y = pk2(at[2], at[3]); w.z = pk2(at[4], at[5]); w.w = pk2(at[6], at[7]); *(uint4*)(T_At + tt * TS + j0) = w;
            w.x = pk2(rt[0], rt[1]); w.y = pk2(rt[2], rt[3]); w.z = pk2(rt[4], rt[5]); w.w = pk2(rt[6], rt[7]); *(uint4*)(T_Rt + tt * TS + j0) = w;
            w.x = pk2(bt[0], bt[1]); w.y = pk2(bt[2], bt[3]); w.z = pk2(bt[4], bt[5]); w.w = pk2(bt[6], bt[7]); *(uint4*)(T_Bt + tt * TS + j0) = w;
            w.x = pk2(kt[0], kt[1]); w.y = pk2(kt[2], kt[3]); w.z = pk2(kt[4], kt[5]); w.w = pk2(kt[6], kt[7]); *(uint4*)(T_Kt + tt * TS + j0) = w;
        }
        __syncthreads();
        { const int hn = h + 1 < NH ? h + 1 : 0, gn = h + 1 < NH ? gi : gi + G; if (gn < NGRP) b1_issue_loads(p, l, gn, hn, tid, L); }
        {
            const int mat = wave >> 1;
            const bf16_t* As = (mat == 0 || mat == 2) ? T_Bt : T_Kt; const bf16_t* Bs = (mat < 2) ? T_At : T_Rt;
            bf16_t* dstb = (mat == 1 ? T_Aak : (mat == 2 ? T_Arb : T_Ark));
#pragma unroll
            for (int q = 0; q < 8; ++q) {
                const int ti = ((wave & 1) * 8 + q) >> 2, tj = q & 3;
                f32x4 acc = (f32x4){0.f, 0.f, 0.f, 0.f};
                if (ti <= tj) acc = mm_tile(As, ti * 16, Bs, tj * 16, 64, fr, fq, acc);
                const int tcol = tj * 16 + fr, i0 = ti * 16 + fq * 4;
                if (ti == tj) {
#pragma unroll
                    for (int r = 0; r < 4; ++r) { const bool keep = (mat < 2) ? (i0 + r < tcol) : (i0 + r <= tcol); if (!keep) acc[r] = 0.f; }
                }
                if (mat == 0) *(f32x4*)(Aab + tcol * AABS + i0) = acc;
                else *(uint2*)(dstb + tcol * TS + i0) = pk4(acc);
            }
        }
        __syncthreads();
        if (wave == 0) {
            const int blk = lane >> 4, cc = lane & 15; const float* ar = Aab + (16 * blk) * AABS + 16 * blk;
            float x[16];
#pragma unroll
            for (int u = 0; u < 16; ++u) { float v = (u == cc) ? 1.0f : 0.f;
#pragma unroll
                for (int i = 0; i < u; ++i) v += ar[u * AABS + i] * x[i];
                x[u] = v; }
#pragma unroll
            for (int u = 0; u < 16; ++u) TI[(blk * 16 + u) * 17 + cc] = x[u];
        } else {
#pragma unroll 1
            for (int id = wave - 1; id < 16; id += 7) {
                const int ti = id >> 2, tj = id & 3;
                f32x4 acc = mm_tile(T_Aak, ti * 16, T_VT, tj * 16, 64, fr, fq, (f32x4){0.f, 0.f, 0.f, 0.f});
                const int j = tj * 16 + fr, tr = ti * 16 + fq * 4;
#pragma unroll
                for (int r = 0; r < 4; ++r) XT[(64 + j) * XTS + tr + r] = acc[r];
            }
        }
        __syncthreads();
        {
            float* xc = XT + (wave * 16 + fr) * XTS;
#pragma unroll
            for (int I = 0; I < 4; ++I) {
                f32x4 acc;
#pragma unroll
                for (int r = 0; r < 4; ++r) acc[r] = xc[16 * I + 4 * fq + r];
#pragma unroll
                for (int J = 0; J < I; ++J)
#pragma unroll
                    for (int kk = 0; kk < 4; ++kk) acc = __builtin_amdgcn_mfma_f32_16x16x4f32(Aab[(16 * I + fr) * AABS + 16 * J + 4 * kk + fq], xc[16 * J + 4 * kk + fq], acc, 0, 0, 0);
#pragma unroll
                for (int r = 0; r < 4; ++r) xc[16 * I + 4 * fq + r] = acc[r];
                asm volatile("s_waitcnt lgkmcnt(0)" ::: "memory");
                f32x4 xs = (f32x4){0.f, 0.f, 0.f, 0.f};
#pragma unroll
                for (int kk = 0; kk < 4; ++kk) xs = __builtin_amdgcn_mfma_f32_16x16x4f32(TI[(I * 16 + fr) * 17 + 4 * kk + fq], xc[16 * I + 4 * kk + fq], xs, 0, 0, 0);
                asm volatile("s_waitcnt lgkmcnt(0)" ::: "memory");
#pragma unroll
                for (int r = 0; r < 4; ++r) xc[16 * I + 4 * fq + r] = xs[r];
                asm volatile("s_waitcnt lgkmcnt(0)" ::: "memory");
            }
        }
        __syncthreads();
        {
            const int col = tid >> 2, tg = (tid & 3) * 16;
            const float* xr = XT + col * XTS + tg; bf16_t* dst = (col < 64 ? T_WT + col * TS : T_U0T + (col - 64) * TS) + tg;
            uint4 w0_, w1_;
            w0_.x = pk2(xr[0], xr[1]); w0_.y = pk2(xr[2], xr[3]); w0_.z = pk2(xr[4], xr[5]); w0_.w = pk2(xr[6], xr[7]);
            w1_.x = pk2(xr[8], xr[9]); w1_.y = pk2(xr[10], xr[11]); w1_.z = pk2(xr[12], xr[13]); w1_.w = pk2(xr[14], xr[15]);
            *(uint4*)dst = w0_; *(uint4*)(dst + 8) = w1_;
        }
        __syncthreads();
        {
            bf16_t* gM = (bf16_t*)(p.ws + WS_CH_M) + (size_t)jb * 4096; bf16_t* gNT = (bf16_t*)(p.ws + WS_CH_NT) + (size_t)jb * 4096;
            bf16_t* gG = (bf16_t*)(p.ws + WS_CH_G) + (size_t)jb * 4096; bf16_t* gY1T = (bf16_t*)(p.ws + WS_CH_Y1T) + (size_t)jb * 4096;
            const int mat = wave >> 1;
            const bf16_t* A1 = (mat == 0 || mat == 2) ? T_WT : (mat == 1 ? T_U0T : T_bhT);
            const bf16_t* B1 = (mat == 0 || mat == 1) ? T_Arb : (mat == 2 ? T_bhT : T_U0T);
            const bf16_t* A2 = mat == 1 ? T_VT : T_khT; const bf16_t* B2 = mat == 1 ? T_Ark : T_VT;
            bf16_t* gdst = mat == 0 ? gG : (mat == 1 ? gY1T : (mat == 2 ? gM : gNT));
#pragma unroll
            for (int q = 0; q < 8; ++q) {
                const int ti = ((wave & 1) * 8 + q) >> 2, tj = q & 3;
                const int col = tj * 16 + fr, r0 = ti * 16 + fq * 4;
                f32x4 acc = mm_tile(A1, ti * 16, B1, tj * 16, 64, fr, fq, (f32x4){0.f, 0.f, 0.f, 0.f});
                if (mat & 1) acc = mm_tile(A2, ti * 16, B2, tj * 16, 64, fr, fq, acc);
                if (mat == 0) {
                    const uint2 rw = *(const uint2*)(T_Rt + col * TS + r0);
                    acc[0] += bf2f((bf16_t)(rw.x & 0xffff)); acc[1] += bf2f((bf16_t)(rw.x >> 16)); acc[2] += bf2f((bf16_t)(rw.y & 0xffff)); acc[3] += bf2f((bf16_t)(rw.y >> 16));
                } else if (mat == 2 && ti == tj) {
                    const float pc = PCv[col];
#pragma unroll
                    for (int r = 0; r < 4; ++r) if (r0 + r == col) acc[r] += pc;
                }
                *(uint2*)(gdst + col * 64 + r0) = pk4(acc);
            }
        }
        __syncthreads();
        if (h == NH - 1) gi += G;
    }
}

__device__ void rwkv_b2_job(const Params& p, int bh, unsigned char* lds) {
    const int tid = tid_(), lane = tid & 63, wave = __builtin_amdgcn_readfirstlane(tid >> 6), fr = lane & 15, fq = lane >> 4;
    const int mi = wave >> 1, nj0 = (wave & 1) * 2;
    const bf16_t* gM = (const bf16_t*)(p.ws + WS_CH_M); const bf16_t* gNT = (const bf16_t*)(p.ws + WS_CH_NT); bf16_t* gZT = (bf16_t*)(p.ws + WS_ZT);
    bf16_t* zbuf = (bf16_t*)lds;
    f32x4 z[2];
    z[0] = (f32x4){0.f, 0.f, 0.f, 0.f}; z[1] = z[0];
    const int c0 = mi * 16 + fq * 4;
    bf16x8 am[2]; uint2 nw[2];
    {
        const size_t jb = (size_t)bh * 32;
#pragma unroll
        for (int kk = 0; kk < 2; ++kk) am[kk] = *(const bf16x8*)(gM + jb * 4096 + (mi * 16 + fr) * 64 + kk * 32 + fq * 8);
#pragma unroll
        for (int q = 0; q < 2; ++q) nw[q] = *(const uint2*)(gNT + jb * 4096 + ((nj0 + q) * 16 + fr) * 64 + c0);
    }
#pragma unroll 1
    for (int c = 0; c < SEQ / 64; ++c) {
        const size_t jb = (size_t)bh * 32 + c;
        bf16_t* zh = zbuf + (c & 1) * 2 * 64 * TS; bf16_t* zl = zh + 64 * TS;
#pragma unroll
        for (int q = 0; q < 2; ++q) {
            const int j = (nj0 + q) * 16 + fr;
            const uint2 hi = pk4(z[q]);
            f32x4 lo;
            lo[0] = z[q][0] - bf2f((bf16_t)(hi.x & 0xffff)); lo[1] = z[q][1] - bf2f((bf16_t)(hi.x >> 16)); lo[2] = z[q][2] - bf2f((bf16_t)(hi.y & 0xffff)); lo[3] = z[q][3] - bf2f((bf16_t)(hi.y >> 16));
            *(uint2*)(zh + j * TS + c0) = hi; *(uint2*)(zl + j * TS + c0) = pk4(lo);
            *(uint2*)(gZT + jb * 4096 + j * 64 + c0) = hi;
        }
        bf16x8 amn[2]; uint2 nwn[2];
        {
            const size_t jn = (size_t)bh * 32 + (c + 1 < SEQ / 64 ? c + 1 : c);
#pragma unroll
            for (int kk = 0; kk < 2; ++kk) amn[kk] = *(const bf16x8*)(gM + jn * 4096 + (mi * 16 + fr) * 64 + kk * 32 + fq * 8);
#pragma unroll
            for (int q = 0; q < 2; ++q) nwn[q] = *(const uint2*)(gNT + jn * 4096 + ((nj0 + q) * 16 + fr) * 64 + c0);
        }
        __syncthreads();
#pragma unroll
        for (int q = 0; q < 2; ++q) {
            const int j = (nj0 + q) * 16 + fr;
            f32x4 acc; acc[0] = bf2f((bf16_t)(nw[q].x & 0xffff)); acc[1] = bf2f((bf16_t)(nw[q].x >> 16)); acc[2] = bf2f((bf16_t)(nw[q].y & 0xffff)); acc[3] = bf2f((bf16_t)(nw[q].y >> 16));
#pragma unroll
            for (int kk = 0; kk < 2; ++kk) {
                const bf16x8 bh_ = *(const bf16x8*)(zh + j * TS + kk * 32 + fq * 8), bl_ = *(const bf16x8*)(zl + j * TS + kk * 32 + fq * 8);
                acc = __builtin_amdgcn_mfma_f32_16x16x32_bf16(am[kk], bh_, acc, 0, 0, 0);
                acc = __builtin_amdgcn_mfma_f32_16x16x32_bf16(am[kk], bl_, acc, 0, 0, 0);
            }
            z[q] = acc;
        }
        am[0] = amn[0]; am[1] = amn[1]; nw[0] = nwn[0]; nw[1] = nwn[1];
    }
    __syncthreads();
}

__device__ void rwkv_b3_pair(const Params& p, int l, int pair) {
    const int tid = tid_(), lane = tid & 63, wave = __builtin_amdgcn_readfirstlane(tid >> 6), fr = lane & 15, fq = lane >> 4;
    const int jb = pair * 2 + (wave >> 2), mi = wave & 3;
    const int bh = jb >> 5, c = jb & 31, b = bh / NH, h = bh % NH;
    const bf16_t* gG = (const bf16_t*)(p.ws + WS_CH_G) + (size_t)jb * 4096; const bf16_t* gY1 = (const bf16_t*)(p.ws + WS_CH_Y1T) + (size_t)jb * 4096;
    const bf16_t* gBV = (const bf16_t*)(p.ws + WS_CH_BV) + (size_t)jb * 4096; const bf16_t* gZT = (const bf16_t*)(p.ws + WS_ZT) + (size_t)jb * 4096;
    const bf16_t* PG = (const bf16_t*)(p.ws + WS_PG); bf16_t* MIX = (bf16_t*)(p.ws + WS_MIX);
    const float* gng = p.in[19] + l * RWW + h * HD; const float* gnb = p.in[20] + l * RWW + h * HD;
    const int tt = mi * 16 + fr; const size_t row = (size_t)b * SEQ + c * 64 + tt;
    bf16x8 bg[2];
#pragma unroll
    for (int kk = 0; kk < 2; ++kk) bg[kk] = __builtin_nontemporal_load((const bf16x8*)(gG + tt * 64 + kk * 32 + fq * 8));
    uint2 yw[4], bw[4], gw[4];
#pragma unroll
    for (int nj = 0; nj < 4; ++nj) { const int j0 = nj * 16 + fq * 4;
        yw[nj] = ldnt_u2((const void*)(gY1 + tt * 64 + j0)); bw[nj] = ldnt_u2((const void*)(gBV + tt * 64 + j0)); gw[nj] = ldnt_u2((const void*)(PG + row * PG_W + h * HD + j0)); }
    f32x4 acc[4];
#pragma unroll
    for (int nj = 0; nj < 4; ++nj) {
        acc[nj][0] = bf2f((bf16_t)(yw[nj].x & 0xffff)); acc[nj][1] = bf2f((bf16_t)(yw[nj].x >> 16)); acc[nj][2] = bf2f((bf16_t)(yw[nj].y & 0xffff)); acc[nj][3] = bf2f((bf16_t)(yw[nj].y >> 16));
#pragma unroll
        for (int kk = 0; kk < 2; ++kk) { const bf16x8 az = *(const bf16x8*)(gZT + (nj * 16 + fr) * 64 + kk * 32 + fq * 8); acc[nj] = __builtin_amdgcn_mfma_f32_16x16x32_bf16(az, bg[kk], acc[nj], 0, 0, 0); }
    }
    float s = 0.f;
#pragma unroll
    for (int nj = 0; nj < 4; ++nj) s += (acc[nj][0] + acc[nj][1]) + (acc[nj][2] + acc[nj][3]);
    s += __shfl_xor(s, 16); s += __shfl_xor(s, 32);
    const float mean = s * (1.0f / HD);
    float vs = 0.f;
#pragma unroll
    for (int nj = 0; nj < 4; ++nj) { acc[nj] = acc[nj] - mean; vs += (acc[nj][0] * acc[nj][0] + acc[nj][1] * acc[nj][1]) + (acc[nj][2] * acc[nj][2] + acc[nj][3] * acc[nj][3]); }
    vs += __shfl_xor(vs, 16); vs += __shfl_xor(vs, 32);
    const float rstd = rsqrtf(vs * (1.0f / HD) + GN_EPS);
#pragma unroll
    for (int nj = 0; nj < 4; ++nj) {
        const int j0 = nj * 16 + fq * 4;
        const f32x4 gg = *(const f32x4*)(gng + j0), gb = *(const f32x4*)(gnb + j0);
        const float bv0 = bf2f((bf16_t)(bw[nj].x & 0xffff)), bv1 = bf2f((bf16_t)(bw[nj].x >> 16)), bv2 = bf2f((bf16_t)(bw[nj].y & 0xffff)), bv3 = bf2f((bf16_t)(bw[nj].y >> 16));
        const float g0 = bf2f((bf16_t)(gw[nj].x & 0xffff)), g1 = bf2f((bf16_t)(gw[nj].x >> 16)), g2 = bf2f((bf16_t)(gw[nj].y & 0xffff)), g3 = bf2f((bf16_t)(gw[nj].y >> 16));
        const float o0 = acc[nj][0] * rstd * gg[0] + gb[0] + bv0, o1 = acc[nj][1] * rstd * gg[1] + gb[1] + bv1, o2 = acc[nj][2] * rstd * gg[2] + gb[2] + bv2, o3 = acc[nj][3] * rstd * gg[3] + gb[3] + bv3;
        uint2 w; w.x = pk2(o0 * siluf_(g0), o1 * siluf_(g1)); w.y = pk2(o2 * siluf_(g2), o3 * siluf_(g3));
        *(uint2*)(MIX + row * DM + CW + SBW + h * HD + j0) = w;
    }
}

#ifndef ATTN_REF
#define ATTN_REF 0
#endif
#ifndef RWKV_REF
#define RWKV_REF 0
#endif
__device__ void phase_mix1(const Params& p, int l, unsigned char* lds) {
    constexpr int NAT = BATCH * NH * 4, NCV = BATCH * (SEQ / 32);
    const int G = gridDim.x;
#if RWKV_REF
    for (int job = blockIdx.x; job < BATCH * NH; job += G) rwkv_job(p, l, job, (float*)lds);
#else
    for (int rep = 0; rep < ((PROBE_REP & 1) ? 2 : 1); ++rep) rwkv_b1_phase(p, l, lds);
#endif
    for (int rep = 0; rep < ((PROBE_REP & 2) ? 2 : 1); ++rep)
#if ATTN_REF
    for (int job = blockIdx.x; job < NAT; job += G) attn_job(p, job);
#else
    for (int job = blockIdx.x; job < NAT * 2; job += G) attn_wg_job(p, job, lds);
#endif
#ifndef CONV_REF
#define CONV_REF 0
#endif
    for (int rep = 0; rep < ((PROBE_REP & 4) ? 2 : 1); ++rep)
#if CONV_REF
    for (int job = blockIdx.x; job < NCV; job += G) conv_job(p, l, job, (float*)lds);
#else
    for (int job = blockIdx.x; job < BATCH * (SEQ / 64); job += G) conv_job64(p, l, job, lds);
#endif
}
__device__ void phase_mix2(const Params& p, int l, unsigned char* lds) {
#if !RWKV_REF
    for (int rep = 0; rep < ((PROBE_REP & 8) ? 2 : 1); ++rep)
    for (int job = blockIdx.x; job < BATCH * NH; job += gridDim.x) rwkv_b2_job(p, job, lds);
    if (l + 1 < DEPTH && defer_layer1_weights() && (int)blockIdx.x >= BATCH * NH) prep_weights(p, l + 1, lds, blockIdx.x - BATCH * NH, gridDim.x - BATCH * NH);
#endif
}
__device__ void phase_mix3(const Params& p, int l, unsigned char* lds) {
#if !RWKV_REF
    for (int rep = 0; rep < ((PROBE_REP & 16) ? 2 : 1); ++rep)
    for (int pair = blockIdx.x; pair < BATCH * NH * 16; pair += gridDim.x) rwkv_b3_pair(p, l, pair);
#endif
}

#define LAS __attribute__((address_space(3)))
#define XB_TMO      128
#define XB_XCNT(j)  (256  + 64 * (j))
#define XB_XSUB(j)  (1280 + 64 * (j))
#define XB_XGEN(j)  (2304 + 64 * (j))
#define XB_TOP      3328
#define XB_TOPGEN   3392
#define XCD_BAR_WORDS 3456
#define XB_SPIN_CAP (1u << 18)

__device__ __forceinline__ unsigned xb_ld(unsigned* p)              { return __hip_atomic_load(p, __ATOMIC_RELAXED, __HIP_MEMORY_SCOPE_AGENT); }
__device__ __forceinline__ unsigned xb_add(unsigned* p, unsigned v) { return __hip_atomic_fetch_add(p, v, __ATOMIC_RELAXED, __HIP_MEMORY_SCOPE_AGENT); }
__device__ __forceinline__ unsigned xb_xcc_id() { return (unsigned)__builtin_amdgcn_s_getreg((3 << 11) | 20) & 0xFu; }
#define XB_SPIN(cond, bar) do { unsigned _sp = 0; while (cond) { __builtin_amdgcn_s_sleep(1); \
    if ((++_sp & 255u) == 0u) { if (xb_ld(&(bar)[XB_TMO])) break; if (_sp > XB_SPIN_CAP) { atomicAdd(&(bar)[XB_TMO], 1u); break; } } } } while (0)

struct XcdBarrier {
    unsigned* bar; unsigned x;
    volatile LAS unsigned* st;
};

__device__ __forceinline__ XcdBarrier xcd_barrier_post(unsigned* bar, volatile LAS unsigned* st) {
    XcdBarrier b; b.bar = bar; b.x = xb_xcc_id(); b.st = st;
    if (threadIdx.x == 0) (void)xb_add(&bar[XB_XCNT(b.x)], 1u);
    return b;
}
__device__ __forceinline__ void xcd_barrier_complete(unsigned* bar, unsigned x, unsigned& nloc, unsigned& nx) {
    const unsigned G = gridDim.x * gridDim.y * gridDim.z;
    unsigned sum, cnt, mine, sp = 0u;
    for (;;) {
        sum = 0u; cnt = 0u; mine = 0u;
#pragma unroll
        for (unsigned j = 0; j < 16; ++j) { const unsigned c = xb_ld(&bar[XB_XCNT(j)]); sum += c; cnt += (c > 0u) ? 1u : 0u; mine = (j == x) ? c : mine; }
        if (sum == G) break;
        __builtin_amdgcn_s_sleep(1);
        if ((++sp & 255u) == 0u) { if (xb_ld(&bar[XB_TMO])) break; if (sp > XB_SPIN_CAP) { atomicAdd(&bar[XB_TMO], 1u); break; } }
    }
    nloc = mine > 0u ? mine : 1u; nx = cnt > 0u ? cnt : 1u;
}

__device__ __forceinline__ void xcd_barrier(const XcdBarrier& b) {
    asm volatile("s_waitcnt vmcnt(0)" ::: "memory");
    __syncthreads();
    if (threadIdx.x == 0) {
        unsigned* bar = b.bar;
        __builtin_amdgcn_s_waitcnt(0);
        unsigned nloc = b.st[0], nx = b.st[1];
        if (nloc == 0u) { xcd_barrier_complete(bar, b.x, nloc, nx); b.st[0] = nloc; b.st[1] = nx; }
        const unsigned old = xb_add(&bar[XB_XSUB(b.x)], 1u);
        const unsigned gen = old / nloc;
        if (old + 1u == (gen + 1u) * nloc) {
            __builtin_amdgcn_fence(__ATOMIC_RELEASE, "agent");
            asm volatile("s_waitcnt vmcnt(0)" ::: "memory");
            const unsigned og = xb_add(&bar[XB_TOP], 1u);
            const unsigned tg = og / nx;
            if (og + 1u == (tg + 1u) * nx) xb_add(&bar[XB_TOPGEN], 1u);
            else XB_SPIN(xb_ld(&bar[XB_TOPGEN]) == tg, bar);
            __builtin_amdgcn_fence(__ATOMIC_ACQUIRE, "agent");
            xb_add(&bar[XB_XGEN(b.x)], 1u);
            asm volatile("s_waitcnt vmcnt(0)" ::: "memory");
        } else {
            XB_SPIN(xb_ld(&bar[XB_XGEN(b.x)]) == gen, bar);
            __builtin_amdgcn_fence(__ATOMIC_ACQUIRE, "agent");
            asm volatile("s_waitcnt vmcnt(0)" ::: "memory");
        }
    }
    __syncthreads();
}

constexpr int PH_PER_LAYER = 6;
constexpr int N_PHASES = 1 + PH_PER_LAYER * DEPTH;
__device__ __forceinline__ void run_phase(const Params& p, int ph, unsigned char* lds) {
    unsigned char* ws = p.ws;
    if (ph == 0) { for (int rep = 0; rep < ((PROBE_REP & 4096) ? 2 : 1); ++rep) phase_prologue(p, lds); return; }
    const int l = (ph - 1) / PH_PER_LAYER, k = (ph - 1) % PH_PER_LAYER;
    if (k == 0) {
        EpiInProjP E{(bf16_t*)(ws + WS_PC), (bf16_t*)(ws + WS_PS), (bf16_t*)(ws + WS_PR), (bf16_t*)(ws + WS_PG), (bf16_t*)(ws + WS_VT)};
        pg8::Gemm g{(const bf16_t*)(ws + WS_XB), (const bf16_t*)(ws + WS_WIN) + (size_t)l * NINT * DM, M, NINT, DM}; pg8::StaticOrder S; S.init(M, NINT, (int)gridDim.x, (int)blockIdx.x);
        for (int rep = 0; rep < ((PROBE_REP & 32) ? 2 : 1); ++rep)
        pg8::gemm_phase<EpiInProjP, pg8::StaticOrder, true, true>((PG8_LAS unsigned char*)lds, g, S, E);
    } else if (k == 1) {
        phase_mix1(p, l, lds);
    } else if (k == 2) {
        phase_mix2(p, l, lds);
    } else if (k == 3) {
        phase_mix3(p, l, lds);
    } else if (k == 4) {
        EpiOutBf16P E{(bf16_t*)(ws + WS_Y), DM};
        pg8::Gemm g{(const bf16_t*)(ws + WS_MIX), (const bf16_t*)(ws + WS_WOUT) + (size_t)l * DM * DM, M, DM, DM}; pg8::StaticOrder S; S.init(M, DM, (int)gridDim.x, (int)blockIdx.x);
        for (int rep = 0; rep < ((PROBE_REP & 64) ? 2 : 1); ++rep)
        pg8::gemm_phase<EpiOutBf16P, pg8::StaticOrder, true, true>((PG8_LAS unsigned char*)lds, g, S, E);
    } else {
        for (int rep = 0; rep < ((PROBE_REP & 8192) && l == 0 ? 2 : 1); ++rep)
        phase_rowpass(l == 0 ? p.in[0] : p.out, (const bf16_t*)(ws + WS_Y), p.in[2] + l * DM, p.out, l + 1 < DEPTH ? (bf16_t*)(ws + WS_XB) : nullptr);
    }
}

static_assert(10 * TILE_B + 64 * AABS * 4 + 128 * XTS * 4 + 64 * 4 + 4 * 16 * 17 * 4 <= 147456, "B1 LDS map");
constexpr int LDS_BYTES = 147456 + 256;

constexpr int MISC_OFF = 147456;
#if MK_COOP == 2
__global__ void __launch_bounds__(512, 2) fwd_kernel(Params p) {
    extern __shared__ __attribute__((aligned(16))) unsigned char lds[];
    volatile LAS unsigned* misc = (volatile LAS unsigned*)((LAS unsigned char*)lds + MISC_OFF);
    if (threadIdx.x < 16) misc[threadIdx.x] = 0u;
    __syncthreads();
    XcdBarrier bar = xcd_barrier_post((unsigned*)(p.ws + WS_CTL), misc);
    for (int ph = p.ph_lo; ph < p.ph_hi; ++ph) {
        run_phase(p, ph, lds);
        if (ph + 1 < p.ph_hi) xcd_barrier(bar);
        if ((PROBE_REP & 32768) && ph == 3) for (int rep = 0; rep < 20; ++rep) xcd_barrier(bar);
    }
}
#elif MK_COOP == 1
__global__ void __launch_bounds__(512, 2) fwd_kernel(Params p) {
    extern __shared__ __attribute__((aligned(16))) unsigned char lds[];
    cg::grid_group grid = cg::this_grid();
    for (int ph = p.ph_lo; ph < p.ph_hi; ++ph) {
        run_phase(p, ph, lds);
        if (ph + 1 < p.ph_hi) grid.sync();
    }
}
#else
__global__ void __launch_bounds__(512, 2) fwd_kernel(Params p) {
    extern __shared__ __attribute__((aligned(16))) unsigned char lds[];
    for (int ph = p.ph_lo; ph < p.ph_hi; ++ph) run_phase(p, ph, lds);
}
#endif

extern "C" void kernel_launch(void* const* d_in, const int* in_sizes, int n_in, void* d_out, int out_size, void* d_ws, size_t ws_size, hipStream_t stream) {
    static int grid = 0;
    if (grid == 0) {
        if (n_in != 24 || out_size != M * DM || ws_size < WS_END) { fprintf(stderr, "kernel_launch: unexpected problem (n_in %d out %d ws %zu)\n", n_in, out_size, ws_size); grid = -1; return; }
        int dev = 0, cus = 0, per_cu = 0;
        hipGetDevice(&dev); hipDeviceGetAttribute(&cus, hipDeviceAttributeMultiprocessorCount, dev);
        hipFuncSetAttribute((const void*)fwd_kernel, hipFuncAttributeMaxDynamicSharedMemorySize, LDS_BYTES);
        hipOccupancyMaxActiveBlocksPerMultiprocessor(&per_cu, (const void*)fwd_kernel, 512, LDS_BYTES);
        if (per_cu < 1) { fprintf(stderr, "kernel_launch: occupancy query says %d blocks per CU\n", per_cu); per_cu = 1; }
        grid = cus;
        (void)hipGetLastError();
    }
    if (grid < 0) return;
    Params p{};
    for (int i = 0; i < 24; ++i) p.in[i] = (const float*)d_in[i];
    p.out = (float*)d_out; p.ws = (unsigned char*)d_ws;
#if MK_COOP == 2
    p.ph_lo = 0; p.ph_hi = N_PHASES;
    if (hipMemsetAsync((char*)d_ws + WS_CTL, 0, XCD_BAR_WORDS * 4, stream) != hipSuccess) { fprintf(stderr, "kernel_launch: memset of the barrier words failed\n"); return; }
    hipLaunchKernelGGL(fwd_kernel, dim3(grid), dim3(512), LDS_BYTES, stream, p);
#elif MK_COOP == 1
    p.ph_lo = 0; p.ph_hi = N_PHASES;
    void* args[] = {&p};
    hipError_t e = hipLaunchCooperativeKernel((const void*)fwd_kernel, dim3(grid), dim3(512), args, LDS_BYTES, stream);
    if (e != hipSuccess) fprintf(stderr, "cooperative launch failed: %s (grid %d)\n", hipGetErrorString(e), grid);
#else
    for (int ph = 0; ph < N_PHASES; ++ph) {
        p.ph_lo = ph; p.ph_hi = ph + 1;
        hipLaunchKernelGGL(fwd_kernel, dim3(grid), dim3(512), LDS_BYTES, stream, p);
    }
#endif
}
```

```cpp
#include <hip/hip_runtime.h>
#include <hip/hip_cooperative_groups.h>
#include <cstdio>
#include <cstdint>
namespace cg = cooperative_groups;

#ifndef PROBE_REP
#define PROBE_REP 0
#endif
#ifndef MK_COOP
#define MK_COOP 2
#endif

constexpr int BATCH = 16, SEQ = 2048, DM = 1024, DEPTH = 2;
constexpr int M = BATCH * SEQ;
constexpr int HD = 64, NH = 6;
constexpr int CW = 256, SBW = 384, RWW = 384, LORA = 32, TAPS = 31;
constexpr int DIN = 3904;
constexpr int NINT = 4096;
constexpr int PC_W = 768, PS_W = 1152, PR_W = 1280, PG_W = 384;
constexpr float RMS_EPS = 1e-6f, LN_EPS = 1e-5f, GN_EPS = 64e-5f;

typedef unsigned short bf16_t;
typedef short bf16x8 __attribute__((ext_vector_type(8)));
typedef float f32x4 __attribute__((ext_vector_type(4)));
typedef unsigned short us4 __attribute__((ext_vector_type(4)));

constexpr size_t MiB = 1u << 20;
constexpr size_t WS_CTL = 0;
constexpr size_t WS_WPW = 512 * 1024;
constexpr size_t WS_WIN = 1 * MiB;
constexpr size_t WS_WOUT = 17 * MiB;
constexpr size_t WS_XB = 21 * MiB;
constexpr size_t WS_MIX = WS_XB;
constexpr size_t WS_PC = 85 * MiB;
constexpr size_t WS_PS = 133 * MiB;
constexpr size_t WS_VT = 205 * MiB;
constexpr size_t WS_Y = WS_PC;
constexpr size_t WS_PR = 229 * MiB;
constexpr size_t WS_PG = 309 * MiB;
constexpr size_t WS_VF = 333 * MiB;
constexpr size_t WS_CH = 381 * MiB;
constexpr size_t CH_SZ = (size_t)3072 * 4096 * 2;
constexpr size_t WS_CH_M = WS_CH, WS_CH_NT = WS_CH + CH_SZ, WS_CH_G = WS_CH + 2 * CH_SZ, WS_CH_Y1T = WS_CH + 3 * CH_SZ, WS_CH_BV = WS_CH + 4 * CH_SZ;
constexpr size_t WS_ZT = WS_PR;
constexpr size_t WS_END = 501 * MiB;

struct Params {
    const float* in[24];
    float* out;
    unsigned char* ws;
    int ph_lo, ph_hi;
};

__device__ __forceinline__ float bf2f(bf16_t v) { return __uint_as_float(((unsigned)v) << 16); }
typedef float f32x2_t __attribute__((ext_vector_type(2)));
typedef __bf16 bf16x2_t __attribute__((ext_vector_type(2)));
__device__ __forceinline__ unsigned pk2(float lo, float hi) { f32x2_t v = {lo, hi}; bf16x2_t b = __builtin_convertvector(v, bf16x2_t); return __builtin_bit_cast(unsigned, b); }
__device__ __forceinline__ bf16_t f2bf(float f) { return (bf16_t)(pk2(f, f) & 0xffffu); }
__device__ __forceinline__ float wave_sum(float v) {
#pragma unroll
    for (int o = 1; o < 64; o <<= 1) v += __shfl_xor(v, o);
    return v;
}
__device__ __forceinline__ float sigmoidf_(float x) { return 1.0f / (1.0f + __expf(-x)); }
__device__ __forceinline__ float siluf_(float x) { return x / (1.0f + __expf(-x)); }
__device__ __forceinline__ int tid_() { int t = threadIdx.x; asm volatile("" : "+v"(t)); return t; }
typedef unsigned u32x2_t __attribute__((ext_vector_type(2)));
__device__ __forceinline__ uint2 ldnt_u2(const void* p) { const u32x2_t v = __builtin_nontemporal_load((const u32x2_t*)p); uint2 r; r.x = v[0]; r.y = v[1]; return r; }
__device__ __forceinline__ int opaque_zero() { int z = 0; asm volatile("" : "+v"(z)); return z; }

__device__ __forceinline__ int orig_col(int n) { return n < 3520 ? n : (n < 3584 ? -1 : (n < 3968 ? n - 64 : -1)); }

__device__ void transpose_tile(const float* W, int ldw, int ncol_src, const float* gain, bf16_t* WT, int K, int n0, int k0, bool permute, float* tile  , bool skip_fold_rows = false) {
    const int tid = tid_();
#pragma unroll
    for (int i = 0; i < 8; ++i) {
        const int kl = (tid >> 6) + 8 * i, nl = tid & 63;
        const int n = n0 + nl, k = k0 + kl;
        const int oc = permute ? orig_col(n) : n;
        float v = 0.f;
        if (oc >= 0 && oc < ncol_src) v = W[(size_t)k * ldw + oc] * (gain ? gain[k] : 1.0f);
        if (permute && n >= 768 && n < 1152) v *= 0.125f * 1.4426950408889634f;
        tile[kl * 65 + nl] = v;
    }
    __syncthreads();
#pragma unroll
    for (int i = 0; i < 8; ++i) {
        const int nl = (tid >> 6) + 8 * i, kl = tid & 63;
        if (!(skip_fold_rows && n0 + nl >= 3520 && n0 + nl < 3584)) WT[(size_t)(n0 + nl) * K + k0 + kl] = f2bf(tile[kl * 65 + nl]);
    }
    __syncthreads();
}
__device__ void fold_v1_rows(const Params& p, int l, bf16_t* WinT_l, float* scr, int worker, int nworkers) {
    const int tid = tid_(), lane = tid & 63, wave = __builtin_amdgcn_readfirstlane(tid >> 6);
    const float* W = p.in[3] + (size_t)l * DM * DIN; const float* gain = p.in[1] + l * DM; const float* v1 = p.in[22] + (size_t)(l - 1) * RWW * LORA; const float* muv = p.in[11] + l * 1216 + 768;
    float* V1c = scr;
    float* Wr = scr + RWW * 64 + wave * RWW;
    for (int idx = tid; idx < RWW * 64; idx += 512) { const int c = idx >> 6, o = idx & 63; const float m = muv[c]; V1c[idx] = (o >= 32 ? m : 1.0f - m) * v1[c * LORA + (o & 31)]; }
    __syncthreads();
    for (int k = worker * 8 + wave; k < DM; k += nworkers * 8) {
        const float* wr = W + (size_t)k * DIN + 3072;
#pragma unroll
        for (int i = 0; i < 6; ++i) Wr[lane + 64 * i] = wr[lane + 64 * i];
        asm volatile("s_waitcnt lgkmcnt(0)" ::: "memory");
        float a0 = 0.f, a1 = 0.f, a2 = 0.f, a3 = 0.f;
#pragma unroll 4
        for (int c4 = 0; c4 < RWW / 4; ++c4) { const f32x4 w = *(const f32x4*)(Wr + 4 * c4);
            a0 += w[0] * V1c[(4 * c4) * 64 + lane]; a1 += w[1] * V1c[(4 * c4 + 1) * 64 + lane]; a2 += w[2] * V1c[(4 * c4 + 2) * 64 + lane]; a3 += w[3] * V1c[(4 * c4 + 3) * 64 + lane]; }
        WinT_l[(size_t)(3520 + lane) * DM + k] = f2bf(((a0 + a1) + (a2 + a3)) * gain[k]);
        asm volatile("s_waitcnt lgkmcnt(0)" ::: "memory");
    }
    __syncthreads();
}
__device__ void prep_weights(const Params& p, int l, unsigned char* lds, int worker, int nworkers) {
    float* tile = (float*)lds;
    bf16_t* WinT = (bf16_t*)(p.ws + WS_WIN) + (size_t)l * NINT * DM; bf16_t* WoutT = (bf16_t*)(p.ws + WS_WOUT) + (size_t)l * DM * DM; bf16_t* WpwT = (bf16_t*)(p.ws + WS_WPW) + (size_t)l * CW * CW;
    const int nt_in = (NINT / 64) * (DM / 64), nt_out = (DM / 64) * (DM / 64), nt_pw = (CW / 64) * (CW / 64);
    for (int j = worker; j < nt_in + nt_out + nt_pw; j += nworkers) {
        if (j < nt_in) transpose_tile(p.in[3] + (size_t)l * DM * DIN, DIN, DIN, p.in[1] + l * DM, WinT, DM, (j / (DM / 64)) * 64, (j % (DM / 64)) * 64, true, tile, l > 0);
        else if (j < nt_in + nt_out) { const int r = j - nt_in; transpose_tile(p.in[4] + (size_t)l * DM * DM, DM, DM, nullptr, WoutT, DM, (r / (DM / 64)) * 64, (r % (DM / 64)) * 64, false, tile); }
        else { const int r = j - nt_in - nt_out; transpose_tile(p.in[9] + (size_t)l * CW * CW, CW, CW, nullptr, WpwT, CW, (r >> 2) * 64, (r & 3) * 64, false, tile); }
    }
    if (l > 0) fold_v1_rows(p, l, WinT, tile, worker, nworkers);
}

__device__ void rows_to_xb(const float* X, bf16_t* XB) {
    const int tid = tid_(), lane = tid & 63, wave = __builtin_amdgcn_readfirstlane(tid >> 6);
    for (int row = blockIdx.x * 8 + wave; row < M; row += gridDim.x * 8) {
        const float* xr = X + (size_t)row * DM;
        f32x4 v[4]; float ss = 0.f;
#pragma unroll
        for (int i = 0; i < 4; ++i) { v[i] = __builtin_nontemporal_load((const f32x4*)(xr + i * 256 + lane * 4)); ss += v[i][0] * v[i][0] + v[i][1] * v[i][1] + v[i][2] * v[i][2] + v[i][3] * v[i][3]; }
        ss = wave_sum(ss);
        const float rstd = rsqrtf(ss * (1.0f / DM) + RMS_EPS);
#pragma unroll
        for (int i = 0; i < 4; ++i) { uint2 w; w.x = pk2(v[i][0] * rstd, v[i][1] * rstd); w.y = pk2(v[i][2] * rstd, v[i][3] * rstd); *(uint2*)(XB + (size_t)row * DM + i * 256 + lane * 4) = w; }
    }
}

__device__ __forceinline__ bool defer_layer1_weights() { return gridDim.x >= BATCH * NH + 32; }
__device__ void phase_prologue(const Params& p, unsigned char* lds) {
    prep_weights(p, 0, lds, blockIdx.x, gridDim.x);
    if (!defer_layer1_weights()) for (int l = 1; l < DEPTH; ++l) prep_weights(p, l, lds, blockIdx.x, gridDim.x);
    rows_to_xb(p.in[0], (bf16_t*)(p.ws + WS_XB));
}

namespace pg8 {
#define PG8_LAS __attribute__((address_space(3)))
typedef unsigned short bf16_t;
typedef short bf16x8 __attribute__((ext_vector_type(8)));
typedef float f32x4 __attribute__((ext_vector_type(4)));
typedef unsigned u32x4 __attribute__((ext_vector_type(4)));
constexpr int BM = 256, BK = 64, HALF = 128, HTB = HALF * BK * 2  , STAGE_BYTES = 8 * HTB, NXCD = 8, WGM = 8;

__host__ __device__ __forceinline__ int lds_byte(int r, int c) { const int st = (r >> 4) * 2 + (c >> 5), rr = r & 15, cc = c & 31, ob = rr * 64 + cc * 2; return st * 1024 + (ob ^ (((ob >> 9) & 1) << 5)); }
__host__ __device__ __forceinline__ void stage_rc(int b, int& R, int& C) { const int st = b / 1024, sb = b % 1024, swz = sb ^ (((sb >> 9) & 1) << 5); R = (st >> 1) * 16 + swz / 64; C = (st & 1) * 32 + (swz % 64) / 2; }
__host__ __device__ __forceinline__ int perm32(int rho) { const int n = rho >> 4, i = rho & 15; return 8 * (i >> 2) + 4 * n + (i & 3); }

struct Unit { int pm, pn; };
struct Gemm { const bf16_t* A; const bf16_t* Bt; int M, N, K; };

struct StaticOrder {
    int nM, nN, nwg, G, c;
    __host__ __device__ void init(int M, int N, int G_, int c_) { nM = M / BM; nN = N / BM; nwg = nM * nN; G = G_; c = c_; }
    __host__ __device__ bool next(int i, Unit& u) const {
        const long L = (long)i * G + c; if (L >= nwg) return false;
        int wgid = (int)L; { const int q = nwg / NXCD, r = nwg % NXCD, xcd = wgid % NXCD, off = wgid / NXCD; wgid = (xcd < r ? xcd * (q + 1) : r * (q + 1) + (xcd - r) * q) + off; }
        const int nig = WGM * nN, gid = wgid / nig, fm = gid * WGM, gsz = (nM - fm) < WGM ? (nM - fm) : WGM;
        u.pm = fm + ((wgid % nig) % gsz); u.pn = (wgid % nig) / gsz; return true;
    }
    __device__ __forceinline__ void a_ready(const Unit&) const {}
    __device__ __forceinline__ void done(const Unit&) const {}
};


__device__ __forceinline__ unsigned cvt_pk_bf16(float lo, float hi) { unsigned r; asm volatile("v_cvt_pk_bf16_f32 %0, %1, %2" : "=v"(r) : "v"(lo), "v"(hi)); return r; }

template <class Epi, class Sched, bool ALIGN_EPI = false, bool SP2 = false>
__device__ __forceinline__ void gemm_phase(PG8_LAS unsigned char* lds, const Gemm g, const Sched& S, const Epi& E) {
    const int tid = tid_(), wid = __builtin_amdgcn_readfirstlane(tid >> 6), lane = tid & 63, wr = wid >> 2, wc = wid & 3, fr = lane & 15, fq = lane >> 4;
    const int K = g.K, nt = K / BK;
    unsigned voffA[2], voffB[2];
#pragma unroll
    for (int i = 0; i < 2; ++i) { int R, C; stage_rc(tid * 16 + i * 8192, R, C); const int Rb = Epi::PERM ? ((R & ~31) + perm32(R & 31)) : R;
        voffA[i] = (unsigned)(R * K + C) * 2u; voffB[i] = (unsigned)(Rb * K + C) * 2u; }
    const size_t kstep = (size_t)(BK * 2);
    const size_t hstep = (size_t)HALF * K * 2;
    const size_t tstep = 2 * hstep;
    const unsigned ldsw = (unsigned)wid * 1024u;
    const int aoff = lds_byte(wr * 64 + fr, fq * 8), boff = lds_byte(wc * 32 + fr, fq * 8);
#define PG8_SA(b, h) (((b) * 2 + (h)) * HTB)
#define PG8_SB(b, h) ((4 + (b) * 2 + (h)) * HTB)
#define PG8_STAGE(bufoff, gbase, voff) do { _Pragma("unroll") for (int _i = 0; _i < 2; ++_i) \
        __builtin_amdgcn_global_load_lds((const unsigned*)((const char*)(gbase) + (voff)[_i]), (PG8_LAS unsigned*)(lds + (bufoff) + ldsw + _i * 8192), 16, 0, 0); } while (0)
#define PG8_LDA(dst, b, h) do { _Pragma("unroll") for (int m = 0; m < 4; ++m) _Pragma("unroll") for (int k = 0; k < 2; ++k) dst[m][k] = *(const PG8_LAS bf16x8*)(lds + PG8_SA(b, h) + aoff + m * 2048 + k * 1024); } while (0)
#define PG8_LDB(dst, b, h) do { _Pragma("unroll") for (int n = 0; n < 2; ++n) _Pragma("unroll") for (int k = 0; k < 2; ++k) dst[n][k] = *(const PG8_LAS bf16x8*)(lds + PG8_SB(b, h) + boff + n * 2048 + k * 1024); } while (0)
#define PG8_MMA(ai, bj, At, Bt) do { __builtin_amdgcn_s_setprio(1); _Pragma("unroll") for (int m = 0; m < 4; ++m) _Pragma("unroll") for (int n = 0; n < 2; ++n) _Pragma("unroll") for (int k = 0; k < 2; ++k) \
        acc[ai][bj][m][n] = __builtin_amdgcn_mfma_f32_16x16x32_bf16(Bt[n][k], At[m][k], acc[ai][bj][m][n], 0, 0, 0); __builtin_amdgcn_s_setprio(0); } while (0)
#define PG8_WAIT_V(n) asm volatile("s_waitcnt vmcnt(" #n ")" ::: "memory")
#define PG8_WAIT_L(n) asm volatile("s_waitcnt lgkmcnt(" #n ")" ::: "memory")
#define PG8_BAR __builtin_amdgcn_s_barrier()
#define PG8_SCHED __builtin_amdgcn_sched_barrier(0)
    Unit cur, nxt; int ui = 0;
    if (!S.next(0, cur)) return;
    f32x4 acc[2][2][4][2];
#pragma unroll
    for (int a = 0; a < 2; ++a)
#pragma unroll
        for (int b = 0; b < 2; ++b)
#pragma unroll
            for (int m = 0; m < 4; ++m)
#pragma unroll
                for (int n = 0; n < 2; ++n) acc[a][b][m][n] = (f32x4){0.f, 0.f, 0.f, 0.f};
    bf16x8 At[4][2], B0[2][2], B1[2][2];
    const char* cA = (const char*)g.A + (size_t)cur.pm * tstep; const char* cB = (const char*)g.Bt + (size_t)cur.pn * tstep;
    S.a_ready(cur);
    if constexpr (SP2) {
        PG8_STAGE(PG8_SB(0, 0), cB, voffB); PG8_STAGE(PG8_SB(0, 1), cB + hstep, voffB); PG8_STAGE(PG8_SA(0, 0), cA, voffA); PG8_STAGE(PG8_SA(0, 1), cA + hstep, voffA);
        if (wr == 1) PG8_BAR;
        PG8_WAIT_V(2); PG8_BAR;
        PG8_STAGE(PG8_SB(1, 0), cB + kstep, voffB); PG8_STAGE(PG8_SA(1, 0), cA + kstep, voffA); PG8_STAGE(PG8_SB(1, 1), cB + hstep + kstep, voffB);
        PG8_WAIT_V(6); PG8_BAR;
    } else {
        PG8_STAGE(PG8_SB(0, 0), cB, voffB); PG8_STAGE(PG8_SA(0, 0), cA, voffA); PG8_STAGE(PG8_SB(0, 1), cB + hstep, voffB); PG8_STAGE(PG8_SA(0, 1), cA + hstep, voffA);
        if (wr == 1) PG8_BAR;
        PG8_WAIT_V(4); PG8_BAR;
        PG8_STAGE(PG8_SB(1, 0), cB + kstep, voffB); PG8_STAGE(PG8_SA(1, 0), cA + kstep, voffA); PG8_STAGE(PG8_SB(1, 1), cB + hstep + kstep, voffB);
        PG8_WAIT_V(6); PG8_BAR;
    }
    for (;;) {
        const bool has_next = S.next(ui + 1, nxt);
        const char* nA = has_next ? (const char*)g.A + (size_t)nxt.pm * tstep : cA; const char* nB = has_next ? (const char*)g.Bt + (size_t)nxt.pn * tstep : cB;
        for (int t = 0; t < nt; t += 2) {
            const bool last = (t == nt - 2);
            const char* a1 = cA + (size_t)(t + 1) * kstep;
            const char* a2 = last ? nA : cA + (size_t)(t + 2) * kstep; const char* b2 = last ? nB : cB + (size_t)(t + 2) * kstep;
            const char* a3 = a2 + kstep; const char* b3 = b2 + kstep;
            if (last && has_next) S.a_ready(nxt);
            if constexpr (SP2) {
            PG8_LDB(B0, 0, 0); PG8_LDB(B1, 0, 1); PG8_SCHED; PG8_LDA(At, 0, 0); PG8_STAGE(PG8_SA(1, 1), a1 + hstep, voffA);
            PG8_WAIT_V(8); PG8_WAIT_L(0); PG8_BAR; PG8_MMA(0, 0, At, B0); PG8_MMA(0, 1, At, B1); PG8_BAR; PG8_SCHED;
            PG8_LDA(At, 0, 1); PG8_STAGE(PG8_SB(0, 0), b2, voffB); PG8_STAGE(PG8_SB(0, 1), b2 + hstep, voffB); PG8_STAGE(PG8_SA(0, 0), a2, voffA);
            PG8_WAIT_V(8); PG8_WAIT_L(0); PG8_BAR; PG8_MMA(1, 0, At, B0); PG8_MMA(1, 1, At, B1); PG8_BAR; PG8_SCHED;
            PG8_LDB(B0, 1, 0); PG8_LDB(B1, 1, 1); PG8_SCHED; PG8_LDA(At, 1, 0); PG8_STAGE(PG8_SA(0, 1), a2 + hstep, voffA);
            PG8_WAIT_V(8); PG8_WAIT_L(0); PG8_BAR; PG8_MMA(0, 0, At, B0); PG8_MMA(0, 1, At, B1); PG8_BAR; PG8_SCHED;
            PG8_LDA(At, 1, 1); PG8_STAGE(PG8_SB(1, 0), b3, voffB); PG8_STAGE(PG8_SB(1, 1), b3 + hstep, voffB); PG8_STAGE(PG8_SA(1, 0), a3, voffA);
            PG8_WAIT_V(8); PG8_WAIT_L(0); PG8_BAR; PG8_MMA(1, 0, At, B0); PG8_MMA(1, 1, At, B1); PG8_BAR; PG8_SCHED;
            } else {
            PG8_LDB(B0, 0, 0); PG8_SCHED; PG8_LDA(At, 0, 0); PG8_STAGE(PG8_SA(1, 1), a1 + hstep, voffA);
            PG8_WAIT_L(8); PG8_BAR; PG8_WAIT_L(0); PG8_MMA(0, 0, At, B0); PG8_BAR; PG8_SCHED;
            PG8_LDB(B1, 0, 1); PG8_STAGE(PG8_SB(0, 0), b2, voffB);
            PG8_BAR; PG8_WAIT_L(0); PG8_MMA(0, 1, At, B1); PG8_BAR;
            PG8_LDA(At, 0, 1); PG8_STAGE(PG8_SA(0, 0), a2, voffA);
            PG8_BAR; PG8_WAIT_L(0); PG8_MMA(1, 0, At, B0); PG8_BAR; PG8_SCHED;
            PG8_STAGE(PG8_SB(0, 1), b2 + hstep, voffB);
            PG8_WAIT_V(6); PG8_BAR; PG8_MMA(1, 1, At, B1); PG8_BAR;
            PG8_LDB(B0, 1, 0); PG8_SCHED; PG8_LDA(At, 1, 0); PG8_STAGE(PG8_SA(0, 1), a2 + hstep, voffA);
            PG8_WAIT_L(8); PG8_BAR; PG8_WAIT_L(0); PG8_MMA(0, 0, At, B0); PG8_BAR; PG8_SCHED;
            PG8_LDB(B1, 1, 1); PG8_STAGE(PG8_SB(1, 0), b3, voffB);
            PG8_BAR; PG8_WAIT_L(0); PG8_MMA(0, 1, At, B1); PG8_BAR;
            PG8_LDA(At, 1, 1); PG8_STAGE(PG8_SA(1, 0), a3, voffA);
            PG8_BAR; PG8_WAIT_L(0); PG8_MMA(1, 0, At, B0); PG8_BAR; PG8_SCHED;
            PG8_STAGE(PG8_SB(1, 1), b3 + hstep, voffB);
            PG8_WAIT_V(6); PG8_BAR; PG8_MMA(1, 1, At, B1); PG8_BAR;
            }
        }
        if constexpr (ALIGN_EPI) { if (wr == 0) PG8_BAR; }
        if constexpr (!Epi::AFTER_DRAIN) { E(acc, cur, wr, wc, fr, fq); S.done(cur); }
        if (!has_next) break;
#pragma unroll
        for (int a = 0; a < 2; ++a)
#pragma unroll
            for (int b = 0; b < 2; ++b)
#pragma unroll
                for (int m = 0; m < 4; ++m)
#pragma unroll
                    for (int n = 0; n < 2; ++n) acc[a][b][m][n] = (f32x4){0.f, 0.f, 0.f, 0.f};
        cur = nxt; cA = nA; cB = nB; ++ui;
        if constexpr (ALIGN_EPI) { if (wr == 1) PG8_BAR; }
    }
    PG8_WAIT_V(0);
    if constexpr (!ALIGN_EPI) { if (wr == 0) PG8_BAR; }
    PG8_BAR;
    if constexpr (Epi::AFTER_DRAIN) { E.fused(acc, cur, wr, wc, fr, fq, lds, wid, lane); S.done(cur); }
#undef PG8_SA
#undef PG8_SB
#undef PG8_STAGE
#undef PG8_LDA
#undef PG8_LDB
#undef PG8_MMA
#undef PG8_WAIT_V
#undef PG8_WAIT_L
#undef PG8_BAR
#undef PG8_SCHED
}
}

struct EpiInProjP {
    static constexpr bool PERM = true, AFTER_DRAIN = false;
    bf16_t *PC, *PS, *PR, *PG, *VT;
    __device__ __forceinline__ void operator()(const pg8::f32x4 (&acc)[2][2][4][2], const pg8::Unit& u, int wr, int wc, int fr, int fq) const {
        const int row0 = u.pm * 256 + wr * 64 + fr;
#pragma unroll
        for (int bj = 0; bj < 2; ++bj) {
            const int blk = 2 * u.pn + bj; bf16_t* base; int ld, c0;
            if (blk >= 12 && blk < 15) {
                const int vc = 128 * (blk - 12) + wc * 32 + 8 * fq;
#pragma unroll
                for (int ai = 0; ai < 2; ++ai)
#pragma unroll
                    for (int m = 0; m < 4; ++m) {
                        const int row = row0 + ai * 128 + m * 16, b = row >> 11, t = row & 2047;
#pragma unroll
                        for (int n = 0; n < 2; ++n)
#pragma unroll
                            for (int e = 0; e < 4; ++e) { const int col = vc + 4 * n + e, hh = col >> 6, d = col & 63;
                                VT[((size_t)(b * NH + hh) * HD + d) * SEQ + t] = f2bf(acc[ai][bj][m][n][e]); }
                    }
                continue;
            }
            if (blk < 6) { base = PC; ld = PC_W; c0 = 128 * blk; }
            else if (blk < 12) { base = PS; ld = PS_W; c0 = 128 * (blk - 6); }
            else if (blk < 18) { base = PS; ld = PS_W; c0 = 768 + 128 * (blk - 15); }
            else if (blk < 28) { base = PR; ld = PR_W; c0 = 128 * (blk - 18); }
            else if (blk < 31) { base = PG; ld = PG_W; c0 = 128 * (blk - 28); }
            else continue;
            const int col = c0 + wc * 32 + 8 * fq;
#pragma unroll
            for (int ai = 0; ai < 2; ++ai)
#pragma unroll
                for (int m = 0; m < 4; ++m) {
                    const pg8::f32x4 v0 = acc[ai][bj][m][0], v1 = acc[ai][bj][m][1]; pg8::u32x4 w;
                    w.x = pg8::cvt_pk_bf16(v0[0], v0[1]); w.y = pg8::cvt_pk_bf16(v0[2], v0[3]); w.z = pg8::cvt_pk_bf16(v1[0], v1[1]); w.w = pg8::cvt_pk_bf16(v1[2], v1[3]);
                    *(pg8::u32x4*)(base + (size_t)(row0 + ai * 128 + m * 16) * ld + col) = w;
                }
        }
    }
};
struct EpiOutBf16P {
    static constexpr bool PERM = true, AFTER_DRAIN = false;
    bf16_t* Y; int ld;
    __device__ __forceinline__ void operator()(const pg8::f32x4 (&acc)[2][2][4][2], const pg8::Unit& u, int wr, int wc, int fr, int fq) const {
        const int row0 = u.pm * 256 + wr * 64 + fr, col0 = u.pn * 256 + wc * 32 + 8 * fq;
#pragma unroll
        for (int ai = 0; ai < 2; ++ai)
#pragma unroll
            for (int m = 0; m < 4; ++m)
#pragma unroll
                for (int bj = 0; bj < 2; ++bj) {
                    const pg8::f32x4 v0 = acc[ai][bj][m][0], v1 = acc[ai][bj][m][1]; pg8::u32x4 w;
                    w.x = pg8::cvt_pk_bf16(v0[0], v0[1]); w.y = pg8::cvt_pk_bf16(v0[2], v0[3]); w.z = pg8::cvt_pk_bf16(v1[0], v1[1]); w.w = pg8::cvt_pk_bf16(v1[2], v1[3]);
                    *(pg8::u32x4*)(Y + (size_t)(row0 + ai * 128 + m * 16) * ld + col0 + bj * 128) = w;
                }
    }
};

__device__ void phase_rowpass(const float* Xin, const bf16_t* Y, const float* gpost, float* Xout, bf16_t* XB) {
    const int tid = tid_(), lane = tid & 63, wave = __builtin_amdgcn_readfirstlane(tid >> 6);
    for (int row = blockIdx.x * 8 + wave; row < M; row += gridDim.x * 8) {
        f32x4 y[4], x[4]; float ss = 0.f;
#pragma unroll
        for (int i = 0; i < 4; ++i) { const uint2 yw = ldnt_u2((const void*)(Y + (size_t)row * DM + i * 256 + lane * 4));
            y[i] = (f32x4){bf2f((bf16_t)(yw.x & 0xffff)), bf2f((bf16_t)(yw.x >> 16)), bf2f((bf16_t)(yw.y & 0xffff)), bf2f((bf16_t)(yw.y >> 16))};
            x[i] = __builtin_nontemporal_load((const f32x4*)(Xin + (size_t)row * DM + i * 256 + lane * 4));
            ss += y[i][0] * y[i][0] + y[i][1] * y[i][1] + y[i][2] * y[i][2] + y[i][3] * y[i][3]; }
        ss = wave_sum(ss);
        const float rstd = rsqrtf(ss * (1.0f / DM) + RMS_EPS);
        float s2 = 0.f;
#pragma unroll
        for (int i = 0; i < 4; ++i) { const f32x4 g = *(const f32x4*)(gpost + i * 256 + lane * 4);
            x[i] = x[i] + y[i] * rstd * g; s2 += x[i][0] * x[i][0] + x[i][1] * x[i][1] + x[i][2] * x[i][2] + x[i][3] * x[i][3];
            __builtin_nontemporal_store(x[i], (f32x4*)(Xout + (size_t)row * DM + i * 256 + lane * 4)); }
        if (XB) {
            s2 = wave_sum(s2);
            const float r2 = rsqrtf(s2 * (1.0f / DM) + RMS_EPS);
#pragma unroll
            for (int i = 0; i < 4; ++i) { uint2 w; w.x = pk2(x[i][0] * r2, x[i][1] * r2); w.y = pk2(x[i][2] * r2, x[i][3] * r2); *(uint2*)(XB + (size_t)row * DM + i * 256 + lane * 4) = w; }
        }
    }
}

__device__ void conv_job(const Params& p, int l, int job, float* lds) {
    const int tid = tid_(), lane = tid & 63, wave = __builtin_amdgcn_readfirstlane(tid >> 6);
    const int b = job / (SEQ / 32), t0 = (job % (SEQ / 32)) * 32;
    const bf16_t* PC = (const bf16_t*)(p.ws + WS_PC); bf16_t* MIX = (bf16_t*)(p.ws + WS_MIX);
    const float* dw = p.in[5] + l * TAPS * CW; const float* dwb = p.in[6] + l * CW; const float* lng = p.in[7] + l * CW; const float* lnb = p.in[8] + l * CW;
    const float* pw = p.in[9] + (size_t)l * CW * CW; const float* pwb = p.in[10] + l * CW;
    float* u = lds;
    float* cv = lds + 62 * 256;
    for (int idx = tid; idx < 62 * 256; idx += 512) {
        const int r = idx >> 8, c = idx & 255, t = t0 - 30 + r;
        float v = 0.f;
        if (t >= 0) { const bf16_t* pr = PC + (size_t)(b * SEQ + t) * PC_W; v = bf2f(pr[c]) * sigmoidf_(bf2f(pr[256 + c])); }
        u[idx] = v;
    }
    __syncthreads();
    for (int idx = tid; idx < 32 * 256; idx += 512) {
        const int tt = idx >> 8, c = idx & 255;
        float a = dwb[c];
#pragma unroll 4
        for (int j = 0; j < TAPS; ++j) a += dw[j * CW + c] * u[(tt + j) * 256 + c];
        cv[idx] = a;
    }
    __syncthreads();
    for (int q = 0; q < 4; ++q) {
        const int tt = wave * 4 + q; float x[4], s = 0.f;
#pragma unroll
        for (int i = 0; i < 4; ++i) { x[i] = cv[tt * 256 + lane + 64 * i]; s += x[i]; }
        const float mean = wave_sum(s) * (1.0f / CW); float vs = 0.f;
#pragma unroll
        for (int i = 0; i < 4; ++i) { const float d = x[i] - mean; vs += d * d; }
        const float rstd = rsqrtf(wave_sum(vs) * (1.0f / CW) + LN_EPS);
#pragma unroll
        for (int i = 0; i < 4; ++i) { const int c = lane + 64 * i; cv[tt * 256 + c] = siluf_((x[i] - mean) * rstd * lng[c] + lnb[c]); }
    }
    __syncthreads();
    {
        const int n = tid & 255, half = tid >> 8;
        float acc[16];
#pragma unroll
        for (int i = 0; i < 16; ++i) acc[i] = pwb[n];
#pragma unroll 2
        for (int k = 0; k < CW; ++k) {
            const float w = pw[(size_t)k * CW + n];
#pragma unroll
            for (int i = 0; i < 16; ++i) acc[i] += cv[(half * 16 + i) * 256 + k] * w;
        }
#pragma unroll
        for (int i = 0; i < 16; ++i) { const size_t row = (size_t)b * SEQ + t0 + half * 16 + i;
            const float g = bf2f(PC[row * PC_W + 512 + n]);
            MIX[row * DM + n] = f2bf(acc[i] * siluf_(g)); }
    }
    __syncthreads();
}

constexpr int CV_AS = 264;
__device__ void conv_job64(const Params& p, int l, int job, unsigned char* lds) {
    const int tid = tid_(), lane = tid & 63, wave = __builtin_amdgcn_readfirstlane(tid >> 6), fr = lane & 15, fq = lane >> 4;
    const int b = job >> 5, t0 = (job & 31) * 64;
    const bf16_t* PC = (const bf16_t*)(p.ws + WS_PC); bf16_t* MIX = (bf16_t*)(p.ws + WS_MIX);
    const float* dw = p.in[5] + l * TAPS * CW; const float* dwb = p.in[6] + l * CW; const float* lng = p.in[7] + l * CW; const float* lnb = p.in[8] + l * CW;
    const bf16_t* pwT = (const bf16_t*)(p.ws + WS_WPW) + (size_t)l * CW * CW; const float* pwb = p.in[10] + l * CW;
    float* u = (float*)lds;
    bf16_t* act = (bf16_t*)(lds + 94 * 256 * 4);
    for (int idx = tid; idx < 94 * 32; idx += 512) {
        const int r = idx >> 5, c8 = (idx & 31) * 8, t = t0 - 30 + r;
        float v[8];
        if (t >= 0) { const bf16_t* pr = PC + ((size_t)b * SEQ + t) * PC_W + c8; const bf16x8 a = *(const bf16x8*)pr, g = *(const bf16x8*)(pr + 256);
#pragma unroll
            for (int e = 0; e < 8; ++e) v[e] = bf2f((bf16_t)a[e]) * __builtin_amdgcn_rcpf(1.0f + __builtin_amdgcn_exp2f(-1.4426950408889634f * bf2f((bf16_t)g[e]))); }
        else {
#pragma unroll
            for (int e = 0; e < 8; ++e) v[e] = 0.f; }
        *(f32x4*)(u + r * 256 + c8) = (f32x4){v[0], v[1], v[2], v[3]}; *(f32x4*)(u + r * 256 + c8 + 4) = (f32x4){v[4], v[5], v[6], v[7]};
    }
    __syncthreads();
    const int c = tid & 255, half = tid >> 8;
    float acc[32];
    {
        float w[TAPS];
#pragma unroll
        for (int j = 0; j < TAPS; ++j) w[j] = dw[j * CW + c];
        const float bias = dwb[c];
#pragma unroll
        for (int i = 0; i < 32; ++i) acc[i] = bias;
        const float* up = u + (half * 32) * 256 + c;
#pragma unroll
        for (int rr = 0; rr < 62; ++rr) {
            const float uv = up[rr * 256];
#pragma unroll
            for (int i = 0; i < 32; ++i) { if (rr - i >= 0 && rr - i < TAPS) acc[i] += w[rr - i] * uv; }
        }
    }
    __syncthreads();
    float* cv = u;
#pragma unroll
    for (int i = 0; i < 32; ++i) cv[(half * 32 + i) * 256 + c] = acc[i];
    __syncthreads();
#pragma unroll 2
    for (int q = 0; q < 8; ++q) {
        const int tt = wave * 8 + q; const f32x4 x = *(const f32x4*)(cv + tt * 256 + lane * 4);
        const float mean = wave_sum(x[0] + x[1] + x[2] + x[3]) * (1.0f / CW);
        const f32x4 d = x - mean;
        const float rstd = rsqrtf(wave_sum(d[0] * d[0] + d[1] * d[1] + d[2] * d[2] + d[3] * d[3]) * (1.0f / CW) + LN_EPS);
        const f32x4 g = *(const f32x4*)(lng + lane * 4), bb = *(const f32x4*)(lnb + lane * 4);
        float y[4];
#pragma unroll
        for (int e = 0; e < 4; ++e) { const float v = d[e] * rstd * g[e] + bb[e]; y[e] = v * __builtin_amdgcn_rcpf(1.0f + __builtin_amdgcn_exp2f(-1.4426950408889634f * v)); }
        uint2 w; w.x = pk2(y[0], y[1]); w.y = pk2(y[2], y[3]); *(uint2*)(act + tt * CV_AS + lane * 4) = w;
    }
    __syncthreads();
    {
        f32x4 o[2][4];
#pragma unroll
        for (int i = 0; i < 2; ++i)
#pragma unroll
            for (int j = 0; j < 4; ++j) o[i][j] = (f32x4){0.f, 0.f, 0.f, 0.f};
#pragma unroll 2
        for (int kk = 0; kk < 8; ++kk) {
            bf16x8 a[2], bq[4];
#pragma unroll
            for (int i = 0; i < 2; ++i) a[i] = *(const bf16x8*)(pwT + (size_t)(wave * 32 + i * 16 + fr) * CW + kk * 32 + fq * 8);
#pragma unroll
            for (int j = 0; j < 4; ++j) bq[j] = *(const bf16x8*)(act + (j * 16 + fr) * CV_AS + kk * 32 + fq * 8);
#pragma unroll
            for (int i = 0; i < 2; ++i)
#pragma unroll
                for (int j = 0; j < 4; ++j) o[i][j] = __builtin_amdgcn_mfma_f32_16x16x32_bf16(a[i], bq[j], o[i][j], 0, 0, 0);
        }
#pragma unroll
        for (int i = 0; i < 2; ++i) {
            const int n0 = wave * 32 + i * 16 + fq * 4; const f32x4 bias = *(const f32x4*)(pwb + n0);
#pragma unroll
            for (int j = 0; j < 4; ++j) {
                const size_t row = (size_t)b * SEQ + t0 + j * 16 + fr;
                const uint2 gw = *(const uint2*)(PC + row * PC_W + 512 + n0);
                const float g0 = bf2f((bf16_t)(gw.x & 0xffff)), g1 = bf2f((bf16_t)(gw.x >> 16)), g2 = bf2f((bf16_t)(gw.y & 0xffff)), g3 = bf2f((bf16_t)(gw.y >> 16));
                const f32x4 v = o[i][j] + bias;
                uint2 w; w.x = pk2(v[0] * siluf_(g0), v[1] * siluf_(g1)); w.y = pk2(v[2] * siluf_(g2), v[3] * siluf_(g3));
                *(uint2*)(MIX + row * DM + n0) = w;
            }
        }
    }
    __syncthreads();
}

__device__ void attn_job(const Params& p, int job) {
    const int tid = tid_(), lane = tid & 63, wave = __builtin_amdgcn_readfirstlane(tid >> 6);
    const int bh = job >> 2, qb = job & 3, b = bh / NH, h = bh % NH;
    const bf16_t* PS = (const bf16_t*)(p.ws + WS_PS); bf16_t* MIX = (bf16_t*)(p.ws + WS_MIX);
    const int tw = qb * 512 + wave * 64, t = tw + lane;
    const size_t row = (size_t)b * SEQ + t;
    const float qs = 1.0f;
    const bf16_t* VT = (const bf16_t*)(p.ws + WS_VT) + (size_t)bh * HD * SEQ;
    float q[64], o[64];
    {
        const bf16_t* qp = PS + row * PS_W + h * HD;
#pragma unroll
        for (int i = 0; i < 8; ++i) { const bf16x8 v = *(const bf16x8*)(qp + i * 8);
#pragma unroll
            for (int j = 0; j < 8; ++j) { q[i * 8 + j] = bf2f((bf16_t)v[j]) * qs; o[i * 8 + j] = 0.f; } }
    }
    float rp = 1.0f;
    const int z = opaque_zero();
    for (int s = tw + 62; s >= 0; --s) {
        const bf16_t* kp = PS + ((size_t)b * SEQ + s) * PS_W + 384 + h * HD + z;
        float dot = 0.f;
#pragma unroll
        for (int i = 0; i < 8; ++i) { const bf16x8 v = *(const bf16x8*)(kp + i * 8);
#pragma unroll
            for (int j = 0; j < 8; ++j) dot += q[i * 8 + j] * bf2f((bf16_t)v[j]); }
        const bool act = s < t;
        const float e = __builtin_amdgcn_exp2f(dot);
        const float keep = __builtin_amdgcn_rcpf(1.0f + e);
        const float pr = act ? (1.0f - keep) * rp : 0.f;
        rp = act ? rp * keep : rp;
#pragma unroll
        for (int d = 0; d < 64; ++d) o[d] += pr * bf2f(VT[(size_t)d * SEQ + s + z]);
        if (__all(rp == 0.0f)) break;
    }
    const bf16_t* gp = PS + row * PS_W + 768 + h * HD;
    bf16_t* op = MIX + row * DM + CW + h * HD;
#pragma unroll
    for (int i = 0; i < 8; ++i) { const bf16x8 g = *(const bf16x8*)(gp + i * 8); uint4 w;
        w.x = pk2(o[i * 8 + 0] * siluf_(bf2f((bf16_t)g[0])), o[i * 8 + 1] * siluf_(bf2f((bf16_t)g[1])));
        w.y = pk2(o[i * 8 + 2] * siluf_(bf2f((bf16_t)g[2])), o[i * 8 + 3] * siluf_(bf2f((bf16_t)g[3])));
        w.z = pk2(o[i * 8 + 4] * siluf_(bf2f((bf16_t)g[4])), o[i * 8 + 5] * siluf_(bf2f((bf16_t)g[5])));
        w.w = pk2(o[i * 8 + 6] * siluf_(bf2f((bf16_t)g[6])), o[i * 8 + 7] * siluf_(bf2f((bf16_t)g[7])));
        *(uint4*)(op + i * 8) = w; }
}

typedef float f32x16 __attribute__((ext_vector_type(16)));
struct AttFrag { bf16x8 K[4], V[2][2]; };
constexpr int AT_WIN = 224;
constexpr int AT_KS = 144, AT_VS = 976;
constexpr int AT_VOFF = (AT_WIN + 256) * AT_KS;
static_assert(AT_VOFF + 64 * AT_VS <= 147456, "attention LDS map");
__device__ __forceinline__ void att_load(AttFrag& F, const bf16_t* kbase, const bf16_t* vbase, const unsigned char* klds, const unsigned char* vlds, int w0, int kt) {
    const int s0 = (kt > 0 ? kt : 0) * 32;
    if (s0 >= w0) {
        const unsigned char* kp = klds + (s0 - w0) * AT_KS; const unsigned char* vp = vlds + (s0 - w0) * 2;
#pragma unroll
        for (int ks = 0; ks < 4; ++ks) F.K[ks] = *(const bf16x8*)(kp + ks * 32);
#pragma unroll
        for (int db = 0; db < 2; ++db)
#pragma unroll
            for (int s = 0; s < 2; ++s) F.V[db][s] = *(const bf16x8*)(vp + db * 32 * AT_VS + s * 16);
    } else {
#pragma unroll
        for (int ks = 0; ks < 4; ++ks) F.K[ks] = *(const bf16x8*)(kbase + (size_t)s0 * PS_W + ks * 16);
#pragma unroll
        for (int db = 0; db < 2; ++db)
#pragma unroll
            for (int s = 0; s < 2; ++s) F.V[db][s] = *(const bf16x8*)(vbase + (size_t)db * 32 * SEQ + s0 + s * 8);
    }
}
__device__ __forceinline__ bool att_tile(const AttFrag& F, const bf16x8 (&Qf)[4], f32x16& O0, f32x16& O1, float& rp, bool diag, int qi, int hf) {
    f32x16 S;
#pragma unroll
    for (int r = 0; r < 16; ++r) S[r] = 0.f;
#pragma unroll
    for (int ks = 0; ks < 4; ++ks) S = __builtin_amdgcn_mfma_f32_32x32x16_bf16(F.K[ks], Qf[ks], S, 0, 0, 0);
    float tot = 1.0f;
#pragma unroll
    for (int r = 0; r < 16; ++r) {
        float k_ = __builtin_amdgcn_rcpf(1.0f + __builtin_amdgcn_exp2f(S[r]));
        if (diag && (hf * 16 + r >= qi)) k_ = 1.0f;
        S[r] = k_; tot *= k_;
    }
    const float toto = __shfl_xor(tot, 32);
    float e = hf ? rp : rp * toto;
#pragma unroll
    for (int r = 15; r >= 0; --r) { const float k_ = S[r]; S[r] = (1.0f - k_) * e; e *= k_; }
    rp = rp * tot * toto;
    bf16x8 Pf[2];
#pragma unroll
    for (int s = 0; s < 2; ++s) {
        union { bf16x8 v; unsigned u[4]; } pk;
#pragma unroll
        for (int j = 0; j < 4; ++j) pk.u[j] = pk2(S[8 * s + 2 * j], S[8 * s + 2 * j + 1]);
        Pf[s] = pk.v;
    }
#pragma unroll
    for (int s = 0; s < 2; ++s) { O0 = __builtin_amdgcn_mfma_f32_32x32x16_bf16(F.V[0][s], Pf[s], O0, 0, 0, 0); O1 = __builtin_amdgcn_mfma_f32_32x32x16_bf16(F.V[1][s], Pf[s], O1, 0, 0, 0); }
    return __ballot(rp != 0.0f) == 0ull;
}
__device__ void attn_wg_job(const Params& p, int job, unsigned char* lds) {
    const int tid = tid_(), lane = tid & 63, wave = __builtin_amdgcn_readfirstlane(tid >> 6), qi = lane & 31, hf = lane >> 5;
    const int bh = job >> 3, g = job & 7, b = bh / NH, h = bh % NH;
    const bf16_t* PS = (const bf16_t*)(p.ws + WS_PS); const bf16_t* VT = (const bf16_t*)(p.ws + WS_VT) + (size_t)bh * HD * SEQ; bf16_t* MIX = (bf16_t*)(p.ws + WS_MIX);
    const int w0 = g * 256 > AT_WIN ? g * 256 - AT_WIN : 0, nkeys = g * 256 + 256 - w0;
    unsigned char* klds = lds; unsigned char* vlds = lds + AT_VOFF;
    {
        const bf16_t* ksrc = PS + ((size_t)b * SEQ + w0) * PS_W + SBW + h * HD;
        for (int idx = tid; idx < nkeys * 8; idx += 512) { const int row = idx >> 3, pc = idx & 7; *(uint4*)(klds + row * AT_KS + pc * 16) = *(const uint4*)(ksrc + (size_t)row * PS_W + pc * 8); }
        const int pc = tid & 63, npc = nkeys >> 3;
        if (pc < npc) {
#pragma unroll
            for (int i = 0; i < 8; ++i) { const int d = (tid >> 6) + 8 * i; *(uint4*)(vlds + d * AT_VS + pc * 16) = *(const uint4*)(VT + (size_t)d * SEQ + w0 + pc * 8); }
        }
    }
    __syncthreads();
    {
        const int qblk = g * 8 + wave, q0 = qblk * 32;
        const size_t rowq = (size_t)b * SEQ + q0 + qi;
        const int pi = (qi & 3) + 4 * (qi >> 3) + 16 * ((qi >> 2) & 1);
        const bf16_t* kbase = PS + ((size_t)b * SEQ + pi) * PS_W + SBW + h * HD + hf * 8;
        const bf16_t* vbase = VT + (size_t)qi * SEQ + hf * 16;
        const unsigned char* kl = klds + pi * AT_KS + hf * 16; const unsigned char* vl = vlds + qi * AT_VS + hf * 32;
        AttFrag FA, FB;
        att_load(FA, kbase, vbase, kl, vl, w0, qblk);
        bf16x8 Qf[4];
#pragma unroll
        for (int ks = 0; ks < 4; ++ks) Qf[ks] = *(const bf16x8*)(PS + rowq * PS_W + h * HD + ks * 16 + hf * 8);
        f32x16 O0, O1;
#pragma unroll
        for (int r = 0; r < 16; ++r) { O0[r] = 0.f; O1[r] = 0.f; }
        float rp = 1.0f;
        for (int kt = qblk; kt >= 0; kt -= 2) {
            att_load(FB, kbase, vbase, kl, vl, w0, kt - 1);
            if (att_tile(FA, Qf, O0, O1, rp, kt == qblk, qi, hf) || kt < 1) break;
            att_load(FA, kbase, vbase, kl, vl, w0, kt - 2);
            if (att_tile(FB, Qf, O0, O1, rp, false, qi, hf)) break;
        }
        const bf16_t* gp = PS + rowq * PS_W + 768 + h * HD; bf16_t* op = MIX + rowq * DM + CW + h * HD;
#pragma unroll
        for (int db = 0; db < 2; ++db)
#pragma unroll
            for (int gq = 0; gq < 4; ++gq) {
                const int d0 = db * 32 + gq * 8 + hf * 4;
                const uint2 gw = *(const uint2*)(gp + d0);
                const float g0 = bf2f((bf16_t)(gw.x & 0xffff)), g1 = bf2f((bf16_t)(gw.x >> 16)), g2 = bf2f((bf16_t)(gw.y & 0xffff)), g3 = bf2f((bf16_t)(gw.y >> 16));
                const f32x16& O = db ? O1 : O0;
                uint2 w; w.x = pk2(O[4 * gq] * siluf_(g0), O[4 * gq + 1] * siluf_(g1)); w.y = pk2(O[4 * gq + 2] * siluf_(g2), O[4 * gq + 3] * siluf_(g3));
                *(uint2*)(op + d0) = w;
            }
    }
    __syncthreads();
}

__device__ void rwkv_job(const Params& p, int l, int job, float* lds) {
    const int tid = tid_(), lane = tid & 63, wave = __builtin_amdgcn_readfirstlane(tid >> 6);
    const int b = job / NH, h = job % NH;
    const bf16_t* PR = (const bf16_t*)(p.ws + WS_PR); const bf16_t* PG = (const bf16_t*)(p.ws + WS_PG);
    float* VF = (float*)(p.ws + WS_VF); bf16_t* MIX = (bf16_t*)(p.ws + WS_MIX);
    const float* mu = p.in[11] + l * 1216; const float* w0 = p.in[12] + l * RWW; const float* w2 = p.in[13] + l * LORA * RWW;
    const float* a0 = p.in[14] + l * RWW; const float* a2 = p.in[15] + l * LORA * RWW; const float* kks = p.in[16] + l * RWW; const float* ka = p.in[17] + l * RWW;
    const float* rk = p.in[18] + l * RWW; const float* gng = p.in[19] + l * RWW; const float* gnb = p.in[20] + l * RWW;
    const float* v0 = p.in[21]; const float* v1 = p.in[22]; const float* v2 = p.in[23];
    float* R = lds; float* W = R + 4096; float* K = W + 4096; float* V = K + 4096; float* A = V + 4096; float* Bm = A + 4096; float* Y = Bm + 4096;
    float* WD = Y + 4096; float* AD = WD + 2048; float* VL = AD + 2048;
    float S[64];
#pragma unroll
    for (int i = 0; i < 64; ++i) S[i] = 0.f;
    for (int c = 0; c < SEQ / 64; ++c) {
        const int t0 = c * 64;
        for (int idx = tid; idx < 64 * 64; idx += 512) {
            const int tt = idx >> 6, i = idx & 63, t = t0 + tt;
            const bf16_t* cur = PR + ((size_t)b * SEQ + t) * PR_W;
            const float xc = bf2f(cur[1152 + i]), xp = t > 0 ? bf2f(cur[1152 + i - PR_W]) : 0.f;
            const float f = xc + (xp - xc) * mu[1152 + i];
            if (i < 32) WD[tt * 32 + i] = tanhf(f); else AD[tt * 32 + i - 32] = f;
        }
        if (l > 0) {
            for (int idx = tid; idx < 64 * 32; idx += 512) {
                const int tt = idx >> 5, i = idx & 31, t = t0 + tt;
                const bf16_t* cur = PR + ((size_t)b * SEQ + t) * PR_W + 768;
                float a = 0.f;
                for (int cc = 0; cc < RWW; ++cc) {
                    const float xc = bf2f(cur[cc]), xp = t > 0 ? bf2f(cur[cc - PR_W]) : 0.f;
                    a += (xc + (xp - xc) * mu[768 + cc]) * v1[cc * LORA + i];
                }
                VL[idx] = a;
            }
        }
        __syncthreads();
        for (int idx = tid; idx < 64 * 64; idx += 512) {
            const int tt = idx >> 6, j = idx & 63, t = t0 + tt, cj = h * HD + j;
            const size_t row = (size_t)b * SEQ + t;
            const bf16_t* cur = PR + row * PR_W;
            const bool hp = t > 0;
            float rc = bf2f(cur[cj]), kc = bf2f(cur[384 + cj]), vc = bf2f(cur[768 + cj]);
            const float rp_ = hp ? bf2f(cur[cj - PR_W]) : 0.f, kp_ = hp ? bf2f(cur[384 + cj - PR_W]) : 0.f, vp_ = hp ? bf2f(cur[768 + cj - PR_W]) : 0.f;
            rc += (rp_ - rc) * mu[cj]; kc += (kp_ - kc) * mu[384 + cj]; vc += (vp_ - vc) * mu[768 + cj];
            float wl = w0[cj], al = a0[cj];
#pragma unroll 8
            for (int i = 0; i < LORA; ++i) { wl += WD[tt * 32 + i] * w2[i * RWW + cj]; al += AD[tt * 32 + i] * a2[i * RWW + cj]; }
            const float sp = fmaxf(-wl, 0.f) + log1pf(__expf(-fabsf(wl)));
            const float decay = __expf(-__expf(-sp - 0.5f));
            const float alr = sigmoidf_(al);
            if (l > 0) {
                float vg = v0[cj];
#pragma unroll 8
                for (int i = 0; i < LORA; ++i) vg += VL[tt * 32 + i] * v2[i * RWW + cj];
                vg = sigmoidf_(vg);
                vc = vc + (VF[row * RWW + cj] - vc) * vg;
            } else VF[row * RWW + cj] = vc;
            R[idx] = rc; W[idx] = decay; V[idx] = vc;
            K[idx] = kc * (1.0f + (alr - 1.0f) * ka[cj]);
            A[idx] = kc * kks[cj];
            Bm[idx] = alr;
        }
        __syncthreads();
        for (int q = 0; q < 8; ++q) {
            const int tt = wave * 8 + q; const float kk = A[tt * 64 + lane];
            const float nrm = sqrtf(wave_sum(kk * kk));
            const float kn = kk / fmaxf(nrm, 1e-12f);
            A[tt * 64 + lane] = -kn; Bm[tt * 64 + lane] = kn * Bm[tt * 64 + lane];
        }
        __syncthreads();
        if (wave == 0) {
            for (int tt = 0; tt < 64; ++tt) {
                const f32x4* a4 = (const f32x4*)(A + tt * 64); const f32x4* w4 = (const f32x4*)(W + tt * 64); const f32x4* b4 = (const f32x4*)(Bm + tt * 64);
                const f32x4* k4 = (const f32x4*)(K + tt * 64); const f32x4* r4 = (const f32x4*)(R + tt * 64);
                float sa = 0.f;
#pragma unroll
                for (int i = 0; i < 16; ++i) { const f32x4 a = a4[i]; sa += S[4 * i] * a[0] + S[4 * i + 1] * a[1] + S[4 * i + 2] * a[2] + S[4 * i + 3] * a[3];
                    if ((i & 7) == 7) asm volatile("" ::: "memory"); }
                const float vv = V[tt * 64 + lane];
                float y = 0.f;
#pragma unroll
                for (int i = 0; i < 16; ++i) { const f32x4 w = w4[i], bb = b4[i], kk = k4[i], rr = r4[i];
#pragma unroll
                    for (int e = 0; e < 4; ++e) { const float s = S[4 * i + e] * w[e] + sa * bb[e] + vv * kk[e]; S[4 * i + e] = s; y += s * rr[e]; }
                    if ((i & 1) == 1) asm volatile("" ::: "memory"); }
                Y[tt * 64 + lane] = y;
            }
        }
        __syncthreads();
        for (int q = 0; q < 8; ++q) {
            const int tt = wave * 8 + q, t = t0 + tt, cj = h * HD + lane; const size_t row = (size_t)b * SEQ + t;
            const float y = Y[tt * 64 + lane];
            const float mean = wave_sum(y) * (1.0f / HD); const float d = y - mean;
            const float var = wave_sum(d * d) * (1.0f / HD);
            const float yn = d * rsqrtf(var + GN_EPS) * gng[cj] + gnb[cj];
            const float bonus = wave_sum(R[tt * 64 + lane] * K[tt * 64 + lane] * rk[cj]);
            const float o = yn + bonus * V[tt * 64 + lane];
            const float g = bf2f(PG[row * PG_W + cj]);
            MIX[row * DM + CW + SBW + cj] = f2bf(o * siluf_(g));
        }
        __syncthreads();
    }
}

constexpr int TS = 72;
constexpr int TILE_B = 64 * TS * 2;
constexpr int AABS = 68, XTS = 65, CSS = 65;

__device__ __forceinline__ f32x4 mm_tile(const bf16_t* X, int m0, const bf16_t* Yt, int n0, int K, int fr, int fq, f32x4 acc) {
#pragma unroll
    for (int kk = 0; kk < 2; ++kk) {
        if (kk * 32 < K) {
            const bf16x8 a = *(const bf16x8*)(X + (m0 + fr) * TS + kk * 32 + fq * 8);
            const bf16x8 b = *(const bf16x8*)(Yt + (n0 + fr) * TS + kk * 32 + fq * 8);
            acc = __builtin_amdgcn_mfma_f32_16x16x32_bf16(a, b, acc, 0, 0, 0);
        }
    }
    return acc;
}
__device__ __forceinline__ uint2 pk4(const f32x4& v) { uint2 w; w.x = pk2(v[0], v[1]); w.y = pk2(v[2], v[3]); return w; }

struct B1Loads {
    bf16x8 rc, kc, vc, rp, kp, vp;
    f32x4 vf0, vf1;
    bf16x8 cc[2], cp[2];
};
__device__ __forceinline__ void b1_issue_loads(const Params& p, int l, int gi, int h, int tid, B1Loads& L) {
    const int b = gi >> 5, c = gi & 31, t0 = c * 64;
    const bf16_t* PR = (const bf16_t*)(p.ws + WS_PR); const float* VF = (const float*)(p.ws + WS_VF);
    {
        const int tt = tid >> 3, j0 = (tid & 7) * 8, t = t0 + tt, cj0 = h * HD + j0; const size_t row = (size_t)b * SEQ + t;
        const bf16_t* cur = PR + row * PR_W; const bf16_t* prv = cur - (t > 0 ? PR_W : 0);
        L.rc = *(const bf16x8*)(cur + cj0); L.kc = *(const bf16x8*)(cur + 384 + cj0); L.vc = *(const bf16x8*)(cur + 768 + cj0);
        L.rp = *(const bf16x8*)(prv + cj0); L.kp = *(const bf16x8*)(prv + 384 + cj0); L.vp = *(const bf16x8*)(prv + 768 + cj0);
        if (l > 0) { L.vf0 = *(const f32x4*)(VF + row * RWW + cj0); L.vf1 = *(const f32x4*)(VF + row * RWW + cj0 + 4); }
    }
    if (h == 0) {
#pragma unroll
        for (int q = 0; q < 2; ++q) {
            const int item = tid + 512 * q, tt = item >> 4, g = item & 15, t = t0 + tt;
            const bf16_t* cur = PR + ((size_t)b * SEQ + t) * PR_W + 1152; const bf16_t* prv = cur - (t > 0 ? PR_W : 0);
            const int gc = g < 12 ? g : 0, gp = g < 8 ? g : (g < 12 ? g + 4 : 0);
            L.cc[q] = *(const bf16x8*)(cur + 8 * gc); L.cp[q] = *(const bf16x8*)(prv + 8 * gp);
        }
    }
}

__device__ void rwkv_b1_phase(const Params& p, int l, unsigned char* lds) {
    const int G = gridDim.x;
    float* VF = (float*)(p.ws + WS_VF);
    const float* mu = p.in[11] + l * 1216; const float* w0 = p.in[12] + l * RWW;
    const float* a0 = p.in[14] + l * RWW; const float* kks = p.in[16] + l * RWW; const float* ka = p.in[17] + l * RWW;
    const float* rk = p.in[18] + l * RWW; const float* v0 = p.in[21];
    const float* w2 = p.in[13] + l * LORA * RWW; const float* a2 = p.in[15] + l * LORA * RWW; const float* v2 = p.in[23];
    bf16_t* T_At = (bf16_t*)lds; bf16_t* T_Rt = T_At + 64 * TS; bf16_t* T_Bt = T_Rt + 64 * TS; bf16_t* T_Kt = T_Bt + 64 * TS;
    bf16_t* T_VT = T_Kt + 64 * TS; bf16_t* T_bhT = T_VT + 64 * TS; bf16_t* T_khT = T_bhT + 64 * TS;
    bf16_t* T_Aak = T_khT + 64 * TS; bf16_t* T_Arb = T_Aak + 64 * TS; bf16_t* T_Ark = T_Arb + 64 * TS;
    bf16_t* T_WT = T_At; bf16_t* T_U0T = T_Bt;
    float* Aab = (float*)(lds + 10 * TILE_B);
    float* XT = (float*)(lds + 10 * TILE_B + 64 * AABS * 4);
    float* PCv = XT + 128 * XTS;
    float* TI = PCv + 64;
    float* CS = (float*)T_Aak;
    constexpr int LS = 33;
    float* WD = Aab; float* AD = WD + 64 * LS;
    float* VL = XT + 64 * XTS;
    float* WLT = (float*)lds; float* ALT = WLT + 64 * XTS; float* VGT = ALT + 64 * XTS;

    constexpr int NGRP = BATCH * (SEQ / 64);
    int gi = blockIdx.x;
    if (gi >= NGRP) return;
    B1Loads L;
    b1_issue_loads(p, l, gi, 0, tid_(), L);
    float codes[2][8];
#pragma unroll 1
    for (int it = 0; gi < NGRP; ++it) {
        const int h = it % NH;
        const int tid = tid_(), lane = tid & 63, wave = __builtin_amdgcn_readfirstlane(tid >> 6), fr = lane & 15, fq = lane >> 4;
        const int b = gi >> 5, c = gi & 31, bh = b * NH + h, jb = bh * 32 + c, t0 = c * 64;
        float wg[6][8];
#pragma unroll
        for (int q = 0; q < 6; ++q) {
            const int id = wave + 8 * q, Lk = id >> 4, tj = id & 3;
            if (q < 4 || l > 0) {
                const float* Wg = (Lk == 0 ? w2 : (Lk == 1 ? a2 : v2)) + (size_t)fq * RWW + h * HD + tj * 16 + fr;
#pragma unroll
                for (int kk = 0; kk < 8; ++kk) wg[q][kk] = Wg[(size_t)kk * 4 * RWW];
            }
        }
#pragma unroll
        for (int q = 0; q < 2; ++q) {
            const int item = tid + 512 * q, tt = item >> 4, g = item & 15, t = t0 + tt; const bool hp = t > 0;
            if (h == 0) {
#pragma unroll
                for (int e = 0; e < 8; ++e) {
                    const float xc = bf2f((bf16_t)L.cc[q][e]), xp = hp ? bf2f((bf16_t)L.cp[q][e]) : 0.f;
                    const float x_ = xc + (xp - xc) * mu[1152 + 8 * (g & 7) + e];
                    codes[q][e] = g < 4 ? 1.0f - 2.0f * __builtin_amdgcn_rcpf(1.0f + __builtin_amdgcn_exp2f(2.8853900817779268f * x_)) : (g < 8 ? x_ : xc + xp);
                }
            }
            if (g < 8 || (g < 12 && l > 0)) {
                float* dst = (g < 4 ? WD + tt * LS + 8 * g : (g < 8 ? AD + tt * LS + 8 * (g - 4) : VL + tt * LS + 8 * (g - 8)));
#pragma unroll
                for (int e = 0; e < 8; ++e) dst[e] = codes[q][e];
            }
        }
        __syncthreads();
#pragma unroll
        for (int q = 0; q < 6; ++q) {
            if (q < 4 || l > 0) {
                const int id = wave + 8 * q, Lk = id >> 4, ti = (id >> 2) & 3, tj = id & 3;
                const float* Xs = (Lk == 0 ? WD : (Lk == 1 ? AD : VL)) + (ti * 16 + fr) * LS + fq;
                f32x4 acc = (f32x4){0.f, 0.f, 0.f, 0.f};
#pragma unroll
                for (int kk = 0; kk < 8; ++kk) acc = __builtin_amdgcn_mfma_f32_16x16x4f32(Xs[kk * 4], wg[q][kk], acc, 0, 0, 0);
                float* out = (Lk == 0 ? WLT : (Lk == 1 ? ALT : VGT)) + (tj * 16 + fr) * XTS + ti * 16 + fq * 4;
#pragma unroll
                for (int r = 0; r < 4; ++r) out[r] = acc[r];
            }
        }
        __syncthreads();
        const int tt = tid >> 3, j0 = (tid & 7) * 8, t = t0 + tt, cj0 = h * HD + j0;
        const size_t row = (size_t)b * SEQ + t;
        float rr[8], kk_[8], vv[8], aa[8], bb[8], lw[8];
        {
            const bool hp = t > 0;
            float wl[8], al[8], vg[8];
#pragma unroll
            for (int e = 0; e < 8; ++e) {
                const float r_c = bf2f((bf16_t)L.rc[e]), k_c = bf2f((bf16_t)L.kc[e]), v_c = bf2f((bf16_t)L.vc[e]);
                const float r_p = hp ? bf2f((bf16_t)L.rp[e]) : 0.f, k_p = hp ? bf2f((bf16_t)L.kp[e]) : 0.f, v_p = hp ? bf2f((bf16_t)L.vp[e]) : 0.f;
                rr[e] = r_c + (r_p - r_c) * mu[cj0 + e]; kk_[e] = k_c + (k_p - k_c) * mu[384 + cj0 + e]; vv[e] = v_c + (v_p - v_c) * mu[768 + cj0 + e];
                wl[e] = w0[cj0 + e] + WLT[(j0 + e) * XTS + tt]; al[e] = a0[cj0 + e] + ALT[(j0 + e) * XTS + tt]; vg[e] = l > 0 ? v0[cj0 + e] + VGT[(j0 + e) * XTS + tt] : 0.f;
            }
            float ssq = 0.f, bon = 0.f;
#pragma unroll
            for (int e = 0; e < 8; ++e) {
                const float sp2 = fmaxf(-wl[e], 0.f) * 1.4426950408889634f + __builtin_amdgcn_logf(1.0f + __builtin_amdgcn_exp2f(-1.4426950408889634f * fabsf(wl[e])));
                lw[e] = -__builtin_amdgcn_exp2f(-sp2 - 0.7213475204444817f);
                const float alr = __builtin_amdgcn_rcpf(1.0f + __builtin_amdgcn_exp2f(-1.4426950408889634f * al[e]));
                if (l > 0) { const float vf = e < 4 ? L.vf0[e & 3] : L.vf1[e & 3]; vv[e] = vv[e] + (vf - vv[e]) * __builtin_amdgcn_rcpf(1.0f + __builtin_amdgcn_exp2f(-1.4426950408889634f * vg[e])); }
                const float kkr = kk_[e] * kks[cj0 + e];
                kk_[e] = kk_[e] * (1.0f + (alr - 1.0f) * ka[cj0 + e]);
                aa[e] = kkr; bb[e] = alr; ssq += kkr * kkr; bon += rr[e] * kk_[e] * rk[cj0 + e];
            }
            if (l == 0) { __builtin_nontemporal_store((f32x4){vv[0], vv[1], vv[2], vv[3]}, (f32x4*)(VF + row * RWW + cj0)); __builtin_nontemporal_store((f32x4){vv[4], vv[5], vv[6], vv[7]}, (f32x4*)(VF + row * RWW + cj0 + 4)); }
            ssq += __shfl_xor(ssq, 1); ssq += __shfl_xor(ssq, 2); ssq += __shfl_xor(ssq, 4);
            bon += __shfl_xor(bon, 1); bon += __shfl_xor(bon, 2); bon += __shfl_xor(bon, 4);
            const float inv = fminf(__builtin_amdgcn_rsqf(ssq), 1e12f);
            uint4 bvw; float bv[8];
#pragma unroll
            for (int e = 0; e < 8; ++e) { const float kn = aa[e] * inv; aa[e] = -kn; bb[e] = kn * bb[e]; bv[e] = bon * vv[e]; CS[tt * CSS + j0 + e] = lw[e]; }
            bvw.x = pk2(bv[0], bv[1]); bvw.y = pk2(bv[2], bv[3]); bvw.z = pk2(bv[4], bv[5]); bvw.w = pk2(bv[6], bv[7]);
            *(uint4*)((bf16_t*)(p.ws + WS_CH_BV) + (size_t)jb * 4096 + tt * 64 + j0) = bvw;
        }
        __syncthreads();
#pragma unroll
        for (int e = 0; e < 8; ++e) {
            const int j = wave * 8 + e; float x = CS[lane * CSS + j];
#pragma unroll
            for (int o = 1; o < 64; o <<= 1) { const float y = __shfl_up(x, o); if (lane >= o) x += y; }
            CS[lane * CSS + j] = x;
        }
        __syncthreads();
        {
            float at[8], rt[8], bt[8], kt[8];
#pragma unroll
            for (int e = 0; e < 8; ++e) {
                const int j = j0 + e; const float cs = CS[tt * CSS + j] * 1.4426950408889634f, csC = CS[63 * CSS + j] * 1.4426950408889634f, lw2 = lw[e] * 1.4426950408889634f;
                const float e_in = __builtin_amdgcn_exp2f(cs), e_ex = __builtin_amdgcn_exp2f(cs - lw2), e_ng = __builtin_amdgcn_exp2f(-cs), e_ht = __builtin_amdgcn_exp2f(csC - cs);
                at[e] = aa[e] * e_ex; rt[e] = rr[e] * e_in; bt[e] = bb[e] * e_ng; kt[e] = kk_[e] * e_ng;
                T_VT[j * TS + tt] = f2bf(vv[e]); T_bhT[j * TS + tt] = f2bf(bb[e] * e_ht); T_khT[j * TS + tt] = f2bf(kk_[e] * e_ht);
                XT[j * XTS + tt] = at[e];
                if (tt == 63) PCv[j] = __builtin_amdgcn_exp2f(csC);
            }
            uint4 w;
            w.x = pk2(at[0], at[1]); w.y = pk2(at[2], at[3]); w.z = pk2(at[4], at[5]); w.w = pk2(at[6], at[7]); *(uint4*)(T_At + tt * TS + j0) = w;
            w.x = pk2(rt[0], rt[1]); w.y = pk2(rt[2], rt[3]); w.z = pk2(rt[4], rt[5]); w.w = pk2(rt[6], rt[7]); *(uint4*)(T_Rt + tt * TS + j0) = w;
            w.x = pk2(bt[0], bt[1]); w.y = pk2(bt[2], bt[3]); w.z = pk2(bt[4], bt[5]); w.w = pk2(bt[6], bt[7]); *(uint4*)(T_Bt + tt * TS + j0) = w;
            w.x = pk2(kt[0], kt[1]); w.y = pk2(kt[2], kt[3]); w.z = pk2(kt[4], kt[5]); w.w = pk2(kt[6], kt[7]); *(uint4*)(T_Kt + tt * TS + j0) = w;
        }
        __syncthreads();
        { const int hn = h + 1 < NH ? h + 1 : 0, gn = h + 1 < NH ? gi : gi + G; if (gn < NGRP) b1_issue_loads(p, l, gn, hn, tid, L); }
        {
            const int mat = wave >> 1;
            const bf16_t* As = (mat == 0 || mat == 2) ? T_Bt : T_Kt; const bf16_t* Bs = (mat < 2) ? T_At : T_Rt;
            bf16_t* dstb = (mat == 1 ? T_Aak : (mat == 2 ? T_Arb : T_Ark));
#pragma unroll
            for (int q = 0; q < 8; ++q) {
                const int ti = ((wave & 1) * 8 + q) >> 2, tj = q & 3;
                f32x4 acc = (f32x4){0.f, 0.f, 0.f, 0.f};
                if (ti <= tj) acc = mm_tile(As, ti * 16, Bs, tj * 16, 64, fr, fq, acc);
                const int tcol = tj * 16 + fr, i0 = ti * 16 + fq * 4;
                if (ti == tj) {
#pragma unroll
                    for (int r = 0; r < 4; ++r) { const bool keep = (mat < 2) ? (i0 + r < tcol) : (i0 + r <= tcol); if (!keep) acc[r] = 0.f; }
                }
                if (mat == 0) *(f32x4*)(Aab + tcol * AABS + i0) = acc;
                else *(uint2*)(dstb + tcol * TS + i0) = pk4(acc);
            }
        }
        __syncthreads();
        if (wave == 0) {
            const int blk = lane >> 4, cc = lane & 15; const float* ar = Aab + (16 * blk) * AABS + 16 * blk;
            float x[16];
#pragma unroll
            for (int u = 0; u < 16; ++u) { float v = (u == cc) ? 1.0f : 0.f;
#pragma unroll
                for (int i = 0; i < u; ++i) v += ar[u * AABS + i] * x[i];
                x[u] = v; }
#pragma unroll
            for (int u = 0; u < 16; ++u) TI[(blk * 16 + u) * 17 + cc] = x[u];
        } else {
#pragma unroll 1
            for (int id = wave - 1; id < 16; id += 7) {
                const int ti = id >> 2, tj = id & 3;
                f32x4 acc = mm_tile(T_Aak, ti * 16, T_VT, tj * 16, 64, fr, fq, (f32x4){0.f, 0.f, 0.f, 0.f});
                const int j = tj * 16 + fr, tr = ti * 16 + fq * 4;
#pragma unroll
                for (int r = 0; r < 4; ++r) XT[(64 + j) * XTS + tr + r] = acc[r];
            }
        }
        __syncthreads();
        {
            float* xc = XT + (wave * 16 + fr) * XTS;
#pragma unroll
            for (int I = 0; I < 4; ++I) {
                f32x4 acc;
#pragma unroll
                for (int r = 0; r < 4; ++r) acc[r] = xc[16 * I + 4 * fq + r];
#pragma unroll
                for (int J = 0; J < I; ++J)
#pragma unroll
                    for (int kk = 0; kk < 4; ++kk) acc = __builtin_amdgcn_mfma_f32_16x16x4f32(Aab[(16 * I + fr) * AABS + 16 * J + 4 * kk + fq], xc[16 * J + 4 * kk + fq], acc, 0, 0, 0);
#pragma unroll
                for (int r = 0; r < 4; ++r) xc[16 * I + 4 * fq + r] = acc[r];
                asm volatile("s_waitcnt lgkmcnt(0)" ::: "memory");
                f32x4 xs = (f32x4){0.f, 0.f, 0.f, 0.f};
#pragma unroll
                for (int kk = 0; kk < 4; ++kk) xs = __builtin_amdgcn_mfma_f32_16x16x4f32(TI[(I * 16 + fr) * 17 + 4 * kk + fq], xc[16 * I + 4 * kk + fq], xs, 0, 0, 0);
                asm volatile("s_waitcnt lgkmcnt(0)" ::: "memory");
#pragma unroll
                for (int r = 0; r < 4; ++r) xc[16 * I + 4 * fq + r] = xs[r];
                asm volatile("s_waitcnt lgkmcnt(0)" ::: "memory");
            }
        }
        __syncthreads();
        {
            const int col = tid >> 2, tg = (tid & 3) * 16;
            const float* xr = XT + col * XTS + tg; bf16_t* dst = (col < 64 ? T_WT + col * TS : T_U0T + (col - 64) * TS) + tg;
            uint4 w0_, w1_;
            w0_.x = pk2(xr[0], xr[1]); w0_.y = pk2(xr[2], xr[3]); w0_.z = pk2(xr[4], xr[5]); w0_.w = pk2(xr[6], xr[7]);
            w1_.x = pk2(xr[8], xr[9]); w1_.y = pk2(xr[10], xr[11]); w1_.z = pk2(xr[12], xr[13]); w1_.w = pk2(xr[14], xr[15]);
            *(uint4*)dst = w0_; *(uint4*)(dst + 8) = w1_;
        }
        __syncthreads();
        {
            bf16_t* gM = (bf16_t*)(p.ws + WS_CH_M) + (size_t)jb * 4096; bf16_t* gNT = (bf16_t*)(p.ws + WS_CH_NT) + (size_t)jb * 4096;
            bf16_t* gG = (bf16_t*)(p.ws + WS_CH_G) + (size_t)jb * 4096; bf16_t* gY1T = (bf16_t*)(p.ws + WS_CH_Y1T) + (size_t)jb * 4096;
            const int mat = wave >> 1;
            const bf16_t* A1 = (mat == 0 || mat == 2) ? T_WT : (mat == 1 ? T_U0T : T_bhT);
            const bf16_t* B1 = (mat == 0 || mat == 1) ? T_Arb : (mat == 2 ? T_bhT : T_U0T);
            const bf16_t* A2 = mat == 1 ? T_VT : T_khT; const bf16_t* B2 = mat == 1 ? T_Ark : T_VT;
            bf16_t* gdst = mat == 0 ? gG : (mat == 1 ? gY1T : (mat == 2 ? gM : gNT));
#pragma unroll
            for (int q = 0; q < 8; ++q) {
                const int ti = ((wave & 1) * 8 + q) >> 2, tj = q & 3;
                const int col = tj * 16 + fr, r0 = ti * 16 + fq * 4;
                f32x4 acc = mm_tile(A1, ti * 16, B1, tj * 16, 64, fr, fq, (f32x4){0.f, 0.f, 0.f, 0.f});
                if (mat & 1) acc = mm_tile(A2, ti * 16, B2, tj * 16, 64, fr, fq, acc);
                if (mat == 0) {
                    const uint2 rw = *(const uint2*)(T_Rt + col * TS + r0);
                    acc[0] += bf2f((bf16_t)(rw.x & 0xffff)); acc[1] += bf2f((bf16_t)(rw.x >> 16)); acc[2] += bf2f((bf16_t)(rw.y & 0xffff)); acc[3] += bf2f((bf16_t)(rw.y >> 16));
                } else if (mat == 2 && ti == tj) {
                    const float pc = PCv[col];
#pragma unroll
                    for (int r = 0; r < 4; ++r) if (r0 + r == col) acc[r] += pc;
                }
                *(uint2*)(gdst + col * 64 + r0) = pk4(acc);
            }
        }
        __syncthreads();
        if (h == NH - 1) gi += G;
    }
}

__device__ void rwkv_b2_job(const Params& p, int bh, unsigned char* lds) {
    const int tid = tid_(), lane = tid & 63, wave = __builtin_amdgcn_readfirstlane(tid >> 6), fr = lane & 15, fq = lane >> 4;
    const int mi = wave >> 1, nj0 = (wave & 1) * 2;
    const bf16_t* gM = (const bf16_t*)(p.ws + WS_CH_M); const bf16_t* gNT = (const bf16_t*)(p.ws + WS_CH_NT); bf16_t* gZT = (bf16_t*)(p.ws + WS_ZT);
    bf16_t* zbuf = (bf16_t*)lds;
    f32x4 z[2];
    z[0] = (f32x4){0.f, 0.f, 0.f, 0.f}; z[1] = z[0];
    const int c0 = mi * 16 + fq * 4;
    bf16x8 am[2]; uint2 nw[2];
    {
        const size_t jb = (size_t)bh * 32;
#pragma unroll
        for (int kk = 0; kk < 2; ++kk) am[kk] = *(const bf16x8*)(gM + jb * 4096 + (mi * 16 + fr) * 64 + kk * 32 + fq * 8);
#pragma unroll
        for (int q = 0; q < 2; ++q) nw[q] = *(const uint2*)(gNT + jb * 4096 + ((nj0 + q) * 16 + fr) * 64 + c0);
    }
#pragma unroll 1
    for (int c = 0; c < SEQ / 64; ++c) {
        const size_t jb = (size_t)bh * 32 + c;
        bf16_t* zh = zbuf + (c & 1) * 2 * 64 * TS; bf16_t* zl = zh + 64 * TS;
#pragma unroll
        for (int q = 0; q < 2; ++q) {
            const int j = (nj0 + q) * 16 + fr;
            const uint2 hi = pk4(z[q]);
            f32x4 lo;
            lo[0] = z[q][0] - bf2f((bf16_t)(hi.x & 0xffff)); lo[1] = z[q][1] - bf2f((bf16_t)(hi.x >> 16)); lo[2] = z[q][2] - bf2f((bf16_t)(hi.y & 0xffff)); lo[3] = z[q][3] - bf2f((bf16_t)(hi.y >> 16));
            *(uint2*)(zh + j * TS + c0) = hi; *(uint2*)(zl + j * TS + c0) = pk4(lo);
            *(uint2*)(gZT + jb * 4096 + j * 64 + c0) = hi;
        }
        bf16x8 amn[2]; uint2 nwn[2];
        {
            const size_t jn = (size_t)bh * 32 + (c + 1 < SEQ / 64 ? c + 1 : c);
#pragma unroll
            for (int kk = 0; kk < 2; ++kk) amn[kk] = *(const bf16x8*)(gM + jn * 4096 + (mi * 16 + fr) * 64 + kk * 32 + fq * 8);
#pragma unroll
            for (int q = 0; q < 2; ++q) nwn[q] = *(const uint2*)(gNT + jn * 4096 + ((nj0 + q) * 16 + fr) * 64 + c0);
        }
        __syncthreads();
#pragma unroll
        for (int q = 0; q < 2; ++q) {
            const int j = (nj0 + q) * 16 + fr;
            f32x4 acc; acc[0] = bf2f((bf16_t)(nw[q].x & 0xffff)); acc[1] = bf2f((bf16_t)(nw[q].x >> 16)); acc[2] = bf2f((bf16_t)(nw[q].y & 0xffff)); acc[3] = bf2f((bf16_t)(nw[q].y >> 16));
#pragma unroll
            for (int kk = 0; kk < 2; ++kk) {
                const bf16x8 bh_ = *(const bf16x8*)(zh + j * TS + kk * 32 + fq * 8), bl_ = *(const bf16x8*)(zl + j * TS + kk * 32 + fq * 8);
                acc = __builtin_amdgcn_mfma_f32_16x16x32_bf16(am[kk], bh_, acc, 0, 0, 0);
                acc = __builtin_amdgcn_mfma_f32_16x16x32_bf16(am[kk], bl_, acc, 0, 0, 0);
            }
            z[q] = acc;
        }
        am[0] = amn[0]; am[1] = amn[1]; nw[0] = nwn[0]; nw[1] = nwn[1];
    }
    __syncthreads();
}

__device__ void rwkv_b3_pair(const Params& p, int l, int pair) {
    const int tid = tid_(), lane = tid & 63, wave = __builtin_amdgcn_readfirstlane(tid >> 6), fr = lane & 15, fq = lane >> 4;
    const int jb = pair * 2 + (wave >> 2), mi = wave & 3;
    const int bh = jb >> 5, c = jb & 31, b = bh / NH, h = bh % NH;
    const bf16_t* gG = (const bf16_t*)(p.ws + WS_CH_G) + (size_t)jb * 4096; const bf16_t* gY1 = (const bf16_t*)(p.ws + WS_CH_Y1T) + (size_t)jb * 4096;
    const bf16_t* gBV = (const bf16_t*)(p.ws + WS_CH_BV) + (size_t)jb * 4096; const bf16_t* gZT = (const bf16_t*)(p.ws + WS_ZT) + (size_t)jb * 4096;
    const bf16_t* PG = (const bf16_t*)(p.ws + WS_PG); bf16_t* MIX = (bf16_t*)(p.ws + WS_MIX);
    const float* gng = p.in[19] + l * RWW + h * HD; const float* gnb = p.in[20] + l * RWW + h * HD;
    const int tt = mi * 16 + fr; const size_t row = (size_t)b * SEQ + c * 64 + tt;
    bf16x8 bg[2];
#pragma unroll
    for (int kk = 0; kk < 2; ++kk) bg[kk] = __builtin_nontemporal_load((const bf16x8*)(gG + tt * 64 + kk * 32 + fq * 8));
    uint2 yw[4], bw[4], gw[4];
#pragma unroll
    for (int nj = 0; nj < 4; ++nj) { const int j0 = nj * 16 + fq * 4;
        yw[nj] = ldnt_u2((const void*)(gY1 + tt * 64 + j0)); bw[nj] = ldnt_u2((const void*)(gBV + tt * 64 + j0)); gw[nj] = ldnt_u2((const void*)(PG + row * PG_W + h * HD + j0)); }
    f32x4 acc[4];
#pragma unroll
    for (int nj = 0; nj < 4; ++nj) {
        acc[nj][0] = bf2f((bf16_t)(yw[nj].x & 0xffff)); acc[nj][1] = bf2f((bf16_t)(yw[nj].x >> 16)); acc[nj][2] = bf2f((bf16_t)(yw[nj].y & 0xffff)); acc[nj][3] = bf2f((bf16_t)(yw[nj].y >> 16));
#pragma unroll
        for (int kk = 0; kk < 2; ++kk) { const bf16x8 az = *(const bf16x8*)(gZT + (nj * 16 + fr) * 64 + kk * 32 + fq * 8); acc[nj] = __builtin_amdgcn_mfma_f32_16x16x32_bf16(az, bg[kk], acc[nj], 0, 0, 0); }
    }
    float s = 0.f;
#pragma unroll
    for (int nj = 0; nj < 4; ++nj) s += (acc[nj][0] + acc[nj][1]) + (acc[nj][2] + acc[nj][3]);
    s += __shfl_xor(s, 16); s += __shfl_xor(s, 32);
    const float mean = s * (1.0f / HD);
    float vs = 0.f;
#pragma unroll
    for (int nj = 0; nj < 4; ++nj) { acc[nj] = acc[nj] - mean; vs += (acc[nj][0] * acc[nj][0] + acc[nj][1] * acc[nj][1]) + (acc[nj][2] * acc[nj][2] + acc[nj][3] * acc[nj][3]); }
    vs += __shfl_xor(vs, 16); vs += __shfl_xor(vs, 32);
    const float rstd = rsqrtf(vs * (1.0f / HD) + GN_EPS);
#pragma unroll
    for (int nj = 0; nj < 4; ++nj) {
        const int j0 = nj * 16 + fq * 4;
        const f32x4 gg = *(const f32x4*)(gng + j0), gb = *(const f32x4*)(gnb + j0);
        const float bv0 = bf2f((bf16_t)(bw[nj].x & 0xffff)), bv1 = bf2f((bf16_t)(bw[nj].x >> 16)), bv2 = bf2f((bf16_t)(bw[nj].y & 0xffff)), bv3 = bf2f((bf16_t)(bw[nj].y >> 16));
        const float g0 = bf2f((bf16_t)(gw[nj].x & 0xffff)), g1 = bf2f((bf16_t)(gw[nj].x >> 16)), g2 = bf2f((bf16_t)(gw[nj].y & 0xffff)), g3 = bf2f((bf16_t)(gw[nj].y >> 16));
        const float o0 = acc[nj][0] * rstd * gg[0] + gb[0] + bv0, o1 = acc[nj][1] * rstd * gg[1] + gb[1] + bv1, o2 = acc[nj][2] * rstd * gg[2] + gb[2] + bv2, o3 = acc[nj][3] * rstd * gg[3] + gb[3] + bv3;
        uint2 w; w.x = pk2(o0 * siluf_(g0), o1 * siluf_(g1)); w.y = pk2(o2 * siluf_(g2), o3 * siluf_(g3));
        *(uint2*)(MIX + row * DM + CW + SBW + h * HD + j0) = w;
    }
}

#ifndef ATTN_REF
#define ATTN_REF 0
#endif
#ifndef RWKV_REF
#define RWKV_REF 0
#endif
__device__ void phase_mix1(const Params& p, int l, unsigned char* lds) {
    constexpr int NAT = BATCH * NH * 4, NCV = BATCH * (SEQ / 32);
    const int G = gridDim.x;
#if RWKV_REF
    for (int job = blockIdx.x; job < BATCH * NH; job += G) rwkv_job(p, l, job, (float*)lds);
#else
    for (int rep = 0; rep < ((PROBE_REP & 1) ? 2 : 1); ++rep) rwkv_b1_phase(p, l, lds);
#endif
    for (int rep = 0; rep < ((PROBE_REP & 2) ? 2 : 1); ++rep)
#if ATTN_REF
    for (int job = blockIdx.x; job < NAT; job += G) attn_job(p, job);
#else
    for (int job = blockIdx.x; job < NAT * 2; job += G) attn_wg_job(p, job, lds);
#endif
#ifndef CONV_REF
#define CONV_REF 0
#endif
    for (int rep = 0; rep < ((PROBE_REP & 4) ? 2 : 1); ++rep)
#if CONV_REF
    for (int job = blockIdx.x; job < NCV; job += G) conv_job(p, l, job, (float*)lds);
#else
    for (int job = blockIdx.x; job < BATCH * (SEQ / 64); job += G) conv_job64(p, l, job, lds);
#endif
}
__device__ void phase_mix2(const Params& p, int l, unsigned char* lds) {
#if !RWKV_REF
    for (int rep = 0; rep < ((PROBE_REP & 8) ? 2 : 1); ++rep)
    for (int job = blockIdx.x; job < BATCH * NH; job += gridDim.x) rwkv_b2_job(p, job, lds);
    if (l + 1 < DEPTH && defer_layer1_weights() && (int)blockIdx.x >= BATCH * NH) prep_weights(p, l + 1, lds, blockIdx.x - BATCH * NH, gridDim.x - BATCH * NH);
#endif
}
__device__ void phase_mix3(const Params& p, int l, unsigned char* lds) {
#if !RWKV_REF
    for (int rep = 0; rep < ((PROBE_REP & 16) ? 2 : 1); ++rep)
    for (int pair = blockIdx.x; pair < BATCH * NH * 16; pair += gridDim.x) rwkv_b3_pair(p, l, pair);
#endif
}

#define LAS __attribute__((address_space(3)))
#define XB_TMO      128
#define XB_XCNT(j)  (256  + 64 * (j))
#define XB_XSUB(j)  (1280 + 64 * (j))
#define XB_XGEN(j)  (2304 + 64 * (j))
#define XB_TOP      3328
#define XB_TOPGEN   3392
#define XCD_BAR_WORDS 3456
#define XB_SPIN_CAP (1u << 18)

__device__ __forceinline__ unsigned xb_ld(unsigned* p)              { return __hip_atomic_load(p, __ATOMIC_RELAXED, __HIP_MEMORY_SCOPE_AGENT); }
__device__ __forceinline__ unsigned xb_add(unsigned* p, unsigned v) { return __hip_atomic_fetch_add(p, v, __ATOMIC_RELAXED, __HIP_MEMORY_SCOPE_AGENT); }
__device__ __forceinline__ unsigned xb_xcc_id() { return (unsigned)__builtin_amdgcn_s_getreg((3 << 11) | 20) & 0xFu; }
#define XB_SPIN(cond, bar) do { unsigned _sp = 0; while (cond) { __builtin_amdgcn_s_sleep(1); \
    if ((++_sp & 255u) == 0u) { if (xb_ld(&(bar)[XB_TMO])) break; if (_sp > XB_SPIN_CAP) { atomicAdd(&(bar)[XB_TMO], 1u); break; } } } } while (0)

struct XcdBarrier {
    unsigned* bar; unsigned x;
    volatile LAS unsigned* st;
};

__device__ __forceinline__ XcdBarrier xcd_barrier_post(unsigned* bar, volatile LAS unsigned* st) {
    XcdBarrier b; b.bar = bar; b.x = xb_xcc_id(); b.st = st;
    if (threadIdx.x == 0) (void)xb_add(&bar[XB_XCNT(b.x)], 1u);
    return b;
}
__device__ __forceinline__ void xcd_barrier_complete(unsigned* bar, unsigned x, unsigned& nloc, unsigned& nx) {
    const unsigned G = gridDim.x * gridDim.y * gridDim.z;
    unsigned sum, cnt, mine, sp = 0u;
    for (;;) {
        sum = 0u; cnt = 0u; mine = 0u;
#pragma unroll
        for (unsigned j = 0; j < 16; ++j) { const unsigned c = xb_ld(&bar[XB_XCNT(j)]); sum += c; cnt += (c > 0u) ? 1u : 0u; mine = (j == x) ? c : mine; }
        if (sum == G) break;
        __builtin_amdgcn_s_sleep(1);
        if ((++sp & 255u) == 0u) { if (xb_ld(&bar[XB_TMO])) break; if (sp > XB_SPIN_CAP) { atomicAdd(&bar[XB_TMO], 1u); break; } }
    }
    nloc = mine > 0u ? mine : 1u; nx = cnt > 0u ? cnt : 1u;
}

__device__ __forceinline__ void xcd_barrier(const XcdBarrier& b) {
    asm volatile("s_waitcnt vmcnt(0)" ::: "memory");
    __syncthreads();
    if (threadIdx.x == 0) {
        unsigned* bar = b.bar;
        __builtin_amdgcn_s_waitcnt(0);
        unsigned nloc = b.st[0], nx = b.st[1];
        if (nloc == 0u) { xcd_barrier_complete(bar, b.x, nloc, nx); b.st[0] = nloc; b.st[1] = nx; }
        const unsigned old = xb_add(&bar[XB_XSUB(b.x)], 1u);
        const unsigned gen = old / nloc;
        if (old + 1u == (gen + 1u) * nloc) {
            __builtin_amdgcn_fence(__ATOMIC_RELEASE, "agent");
            asm volatile("s_waitcnt vmcnt(0)" ::: "memory");
            const unsigned og = xb_add(&bar[XB_TOP], 1u);
            const unsigned tg = og / nx;
            if (og + 1u == (tg + 1u) * nx) xb_add(&bar[XB_TOPGEN], 1u);
            else XB_SPIN(xb_ld(&bar[XB_TOPGEN]) == tg, bar);
            __builtin_amdgcn_fence(__ATOMIC_ACQUIRE, "agent");
            xb_add(&bar[XB_XGEN(b.x)], 1u);
            asm volatile("s_waitcnt vmcnt(0)" ::: "memory");
        } else {
            XB_SPIN(xb_ld(&bar[XB_XGEN(b.x)]) == gen, bar);
            __builtin_amdgcn_fence(__ATOMIC_ACQUIRE, "agent");
            asm volatile("s_waitcnt vmcnt(0)" ::: "memory");
        }
    }
    __syncthreads();
}

constexpr int PH_PER_LAYER = 6;
constexpr int N_PHASES = 1 + PH_PER_LAYER * DEPTH;
__device__ __forceinline__ void run_phase(const Params& p, int ph, unsigned char* lds) {
    unsigned char* ws = p.ws;
    if (ph == 0) { for (int rep = 0; rep < ((PROBE_REP & 4096) ? 2 : 1); ++rep) phase_prologue(p, lds); return; }
    const int l = (ph - 1) / PH_PER_LAYER, k = (ph - 1) % PH_PER_LAYER;
    if (k == 0) {
        EpiInProjP E{(bf16_t*)(ws + WS_PC), (bf16_t*)(ws + WS_PS), (bf16_t*)(ws + WS_PR), (bf16_t*)(ws + WS_PG), (bf16_t*)(ws + WS_VT)};
        pg8::Gemm g{(const bf16_t*)(ws + WS_XB), (const bf16_t*)(ws + WS_WIN) + (size_t)l * NINT * DM, M, NINT, DM}; pg8::StaticOrder S; S.init(M, NINT, (int)gridDim.x, (int)blockIdx.x);
        for (int rep = 0; rep < ((PROBE_REP & 32) ? 2 : 1); ++rep)
        pg8::gemm_phase<EpiInProjP, pg8::StaticOrder, true, true>((PG8_LAS unsigned char*)lds, g, S, E);
    } else if (k == 1) {
        phase_mix1(p, l, lds);
    } else if (k == 2) {
        phase_mix2(p, l, lds);
    } else if (k == 3) {
        phase_mix3(p, l, lds);
    } else if (k == 4) {
        EpiOutBf16P E{(bf16_t*)(ws + WS_Y), DM};
        pg8::Gemm g{(const bf16_t*)(ws + WS_MIX), (const bf16_t*)(ws + WS_WOUT) + (size_t)l * DM * DM, M, DM, DM}; pg8::StaticOrder S; S.init(M, DM, (int)gridDim.x, (int)blockIdx.x);
        for (int rep = 0; rep < ((PROBE_REP & 64) ? 2 : 1); ++rep)
        pg8::gemm_phase<EpiOutBf16P, pg8::StaticOrder, true, true>((PG8_LAS unsigned char*)lds, g, S, E);
    } else {
        for (int rep = 0; rep < ((PROBE_REP & 8192) && l == 0 ? 2 : 1); ++rep)
        phase_rowpass(l == 0 ? p.in[0] : p.out, (const bf16_t*)(ws + WS_Y), p.in[2] + l * DM, p.out, l + 1 < DEPTH ? (bf16_t*)(ws + WS_XB) : nullptr);
    }
}

static_assert(10 * TILE_B + 64 * AABS * 4 + 128 * XTS * 4 + 64 * 4 + 4 * 16 * 17 * 4 <= 147456, "B1 LDS map");
constexpr int LDS_BYTES = 147456 + 256;

constexpr int MISC_OFF = 147456;
#if MK_COOP == 2
__global__ void __launch_bounds__(512, 2) fwd_kernel(Params p) {
    extern __shared__ __attribute__((aligned(16))) unsigned char lds[];
    volatile LAS unsigned* misc = (volatile LAS unsigned*)((LAS unsigned char*)lds + MISC_OFF);
    if (threadIdx.x < 16) misc[threadIdx.x] = 0u;
    __syncthreads();
    XcdBarrier bar = xcd_barrier_post((unsigned*)(p.ws + WS_CTL), misc);
    for (int ph = p.ph_lo; ph < p.ph_hi; ++ph) {
        run_phase(p, ph, lds);
        if (ph + 1 < p.ph_hi) xcd_barrier(bar);
        if ((PROBE_REP & 32768) && ph == 3) for (int rep = 0; rep < 20; ++rep) xcd_barrier(bar);
    }
}
#elif MK_COOP == 1
__global__ void __launch_bounds__(512, 2) fwd_kernel(Params p) {
    extern __shared__ __attribute__((aligned(16))) unsigned char lds[];
    cg::grid_group grid = cg::this_grid();
    for (int ph = p.ph_lo; ph < p.ph_hi; ++ph) {
        run_phase(p, ph, lds);
        if (ph + 1 < p.ph_hi) grid.sync();
    }
}
#else
__global__ void __launch_bounds__(512, 2) fwd_kernel(Params p) {
    extern __shared__ __attribute__((aligned(16))) unsigned char lds[];
    for (int ph = p.ph_lo; ph < p.ph_hi; ++ph) run_phase(p, ph, lds);
}
#endif

extern "C" void kernel_launch(void* const* d_in, const int* in_sizes, int n_in, void* d_out, int out_size, void* d_ws, size_t ws_size, hipStream_t stream) {
    static int grid = 0;
    if (grid == 0) {
        if (n_in != 24 || out_size != M * DM || ws_size < WS_END) { fprintf(stderr, "kernel_launch: unexpected problem (n_in %d out %d ws %zu)\n", n_in, out_size, ws_size); grid = -1; return; }
        int dev = 0, cus = 0, per_cu = 0;
        hipGetDevice(&dev); hipDeviceGetAttribute(&cus, hipDeviceAttributeMultiprocessorCount, dev);
        hipFuncSetAttribute((const void*)fwd_kernel, hipFuncAttributeMaxDynamicSharedMemorySize, LDS_BYTES);
        hipOccupancyMaxActiveBlocksPerMultiprocessor(&per_cu, (const void*)fwd_kernel, 512, LDS_BYTES);
        if (per_cu < 1) { fprintf(stderr, "kernel_launch: occupancy query says %d blocks per CU\n", per_cu); per_cu = 1; }
        grid = cus;
        (void)hipGetLastError();
    }
    if (grid < 0) return;
    Params p{};
    for (int i = 0; i < 24; ++i) p.in[i] = (const float*)d_in[i];
    p.out = (float*)d_out; p.ws = (unsigned char*)d_ws;
#if MK_COOP == 2
    p.ph_lo = 0; p.ph_hi = N_PHASES;
    if (hipMemsetAsync((char*)d_ws + WS_CTL, 0, XCD_BAR_WORDS * 4, stream) != hipSuccess) { fprintf(stderr, "kernel_launch: memset of the barrier words failed\n"); return; }
    hipLaunchKernelGGL(fwd_kernel, dim3(grid), dim3(512), LDS_BYTES, stream, p);
#elif MK_COOP == 1
    p.ph_lo = 0; p.ph_hi = N_PHASES;
    void* args[] = {&p};
    hipError_t e = hipLaunchCooperativeKernel((const void*)fwd_kernel, dim3(grid), dim3(512), args, LDS_BYTES, stream);
    if (e != hipSuccess) fprintf(stderr, "cooperative launch failed: %s (grid %d)\n", hipGetErrorString(e), grid);
#else
    for (int ph = 0; ph < N_PHASES; ++ph) {
        p.ph_lo = ph; p.ph_hi = ph + 1;
        hipLaunchKernelGGL(fwd_kernel, dim3(grid), dim3(512), LDS_BYTES, stream, p);
    }
#endif
}
```

```cpp
#include <hip/hip_runtime.h>
#include <hip/hip_cooperative_groups.h>
#include <cstdio>
#include <cstdint>
namespace cg = cooperative_groups;

#ifndef PROBE_REP
#define PROBE_REP 0
#endif
#ifndef MK_COOP
#define MK_COOP 2
#endif

constexpr int BATCH = 16, SEQ = 2048, DM = 1024, DEPTH = 2;
constexpr int M = BATCH * SEQ;
constexpr int HD = 64, NH = 6;
constexpr int CW = 256, SBW = 384, RWW = 384, LORA = 32, TAPS = 31;
constexpr int DIN = 3904;
constexpr int NINT = 4096;
constexpr int PC_W = 768, PS_W = 1152, PR_W = 1280, PG_W = 384;
constexpr float RMS_EPS = 1e-6f, LN_EPS = 1e-5f, GN_EPS = 64e-5f;

typedef unsigned short bf16_t;
typedef short bf16x8 __attribute__((ext_vector_type(8)));
typedef float f32x4 __attribute__((ext_vector_type(4)));
typedef unsigned short us4 __attribute__((ext_vector_type(4)));

constexpr size_t MiB = 1u << 20;
constexpr size_t WS_CTL = 0;
constexpr size_t WS_WPW = 512 * 1024;
constexpr size_t WS_WIN = 1 * MiB;
constexpr size_t WS_WOUT = 17 * MiB;
constexpr size_t WS_XB = 21 * MiB;
constexpr size_t WS_MIX = WS_XB;
constexpr size_t WS_PC = 85 * MiB;
constexpr size_t WS_PS = 133 * MiB;
constexpr size_t WS_VT = 205 * MiB;
constexpr size_t WS_Y = WS_PC;
constexpr size_t WS_PR = 229 * MiB;
constexpr size_t WS_PG = 309 * MiB;
constexpr size_t WS_VF = 333 * MiB;
constexpr size_t WS_CH = 381 * MiB;
constexpr size_t CH_SZ = (size_t)3072 * 4096 * 2;
constexpr size_t WS_CH_M = WS_CH, WS_CH_NT = WS_CH + CH_SZ, WS_CH_G = WS_CH + 2 * CH_SZ, WS_CH_Y1T = WS_CH + 3 * CH_SZ, WS_CH_BV = WS_CH + 4 * CH_SZ;
constexpr size_t WS_ZT = WS_PR;
constexpr size_t WS_END = 501 * MiB;

struct Params {
    const float* in[24];
    float* out;
    unsigned char* ws;
    int ph_lo, ph_hi;
};

__device__ __forceinline__ float bf2f(bf16_t v) { return __uint_as_float(((unsigned)v) << 16); }
typedef float f32x2_t __attribute__((ext_vector_type(2)));
typedef __bf16 bf16x2_t __attribute__((ext_vector_type(2)));
__device__ __forceinline__ unsigned pk2(float lo, float hi) { f32x2_t v = {lo, hi}; bf16x2_t b = __builtin_convertvector(v, bf16x2_t); return __builtin_bit_cast(unsigned, b); }
__device__ __forceinline__ bf16_t f2bf(float f) { return (bf16_t)(pk2(f, f) & 0xffffu); }
__device__ __forceinline__ float wave_sum(float v) {
#pragma unroll
    for (int o = 1; o < 64; o <<= 1) v += __shfl_xor(v, o);
    return v;
}
__device__ __forceinline__ float sigmoidf_(float x) { return 1.0f / (1.0f + __expf(-x)); }
__device__ __forceinline__ float siluf_(float x) { return x / (1.0f + __expf(-x)); }
__device__ __forceinline__ int tid_() { int t = threadIdx.x; asm volatile("" : "+v"(t)); return t; }
typedef unsigned u32x2_t __attribute__((ext_vector_type(2)));
__device__ __forceinline__ uint2 ldnt_u2(const void* p) { const u32x2_t v = __builtin_nontemporal_load((const u32x2_t*)p); uint2 r; r.x = v[0]; r.y = v[1]; return r; }
__device__ __forceinline__ int opaque_zero() { int z = 0; asm volatile("" : "+v"(z)); return z; }

__device__ __forceinline__ int orig_col(int n) { return n < 3520 ? n : (n < 3584 ? -1 : (n < 3968 ? n - 64 : -1)); }

__device__ void transpose_tile(const float* W, int ldw, int ncol_src, const float* gain, bf16_t* WT, int K, int n0, int k0, bool permute, float* tile  , bool skip_fold_rows = false) {
    const int tid = tid_();
#pragma unroll
    for (int i = 0; i < 8; ++i) {
        const int kl = (tid >> 6) + 8 * i, nl = tid & 63;
        const int n = n0 + nl, k = k0 + kl;
        const int oc = permute ? orig_col(n) : n;
        float v = 0.f;
        if (oc >= 0 && oc < ncol_src) v = W[(size_t)k * ldw + oc] * (gain ? gain[k] : 1.0f);
        if (permute && n >= 768 && n < 1152) v *= 0.125f * 1.4426950408889634f;
        tile[kl * 65 + nl] = v;
    }
    __syncthreads();
#pragma unroll
    for (int i = 0; i < 8; ++i) {
        const int nl = (tid >> 6) + 8 * i, kl = tid & 63;
        if (!(skip_fold_rows && n0 + nl >= 3520 && n0 + nl < 3584)) WT[(size_t)(n0 + nl) * K + k0 + kl] = f2bf(tile[kl * 65 + nl]);
    }
    __syncthreads();
}
__device__ void fold_v1_rows(const Params& p, int l, bf16_t* WinT_l, float* scr, int worker, int nworkers) {
    const int tid = tid_(), lane = tid & 63, wave = __builtin_amdgcn_readfirstlane(tid >> 6);
    const float* W = p.in[3] + (size_t)l * DM * DIN; const float* gain = p.in[1] + l * DM; const float* v1 = p.in[22] + (size_t)(l - 1) * RWW * LORA; const float* muv = p.in[11] + l * 1216 + 768;
    float* V1c = scr;
    float* Wr = scr + RWW * 64 + wave * RWW;
    for (int idx = tid; idx < RWW * 64; idx += 512) { const int c = idx >> 6, o = idx & 63; const float m = muv[c]; V1c[idx] = (o >= 32 ? m : 1.0f - m) * v1[c * LORA + (o & 31)]; }
    __syncthreads();
    for (int k = worker * 8 + wave; k < DM; k += nworkers * 8) {
        const float* wr = W + (size_t)k * DIN + 3072;
#pragma unroll
        for (int i = 0; i < 6; ++i) Wr[lane + 64 * i] = wr[lane + 64 * i];
        asm volatile("s_waitcnt lgkmcnt(0)" ::: "memory");
        float a0 = 0.f, a1 = 0.f, a2 = 0.f, a3 = 0.f;
#pragma unroll 4
        for (int c4 = 0; c4 < RWW / 4; ++c4) { const f32x4 w = *(const f32x4*)(Wr + 4 * c4);
            a0 += w[0] * V1c[(4 * c4) * 64 + lane]; a1 += w[1] * V1c[(4 * c4 + 1) * 64 + lane]; a2 += w[2] * V1c[(4 * c4 + 2) * 64 + lane]; a3 += w[3] * V1c[(4 * c4 + 3) * 64 + lane]; }
        WinT_l[(size_t)(3520 + lane) * DM + k] = f2bf(((a0 + a1) + (a2 + a3)) * gain[k]);
        asm volatile("s_waitcnt lgkmcnt(0)" ::: "memory");
    }
    __syncthreads();
}
__device__ void prep_weights(const Params& p, int l, unsigned char* lds, int worker, int nworkers) {
    float* tile = (float*)lds;
    bf16_t* WinT = (bf16_t*)(p.ws + WS_WIN) + (size_t)l * NINT * DM; bf16_t* WoutT = (bf16_t*)(p.ws + WS_WOUT) + (size_t)l * DM * DM; bf16_t* WpwT = (bf16_t*)(p.ws + WS_WPW) + (size_t)l * CW * CW;
    const int nt_in = (NINT / 64) * (DM / 64), nt_out = (DM / 64) * (DM / 64), nt_pw = (CW / 64) * (CW / 64);
    for (int j = worker; j < nt_in + nt_out + nt_pw; j += nworkers) {
        if (j < nt_in) transpose_tile(p.in[3] + (size_t)l * DM * DIN, DIN, DIN, p.in[1] + l * DM, WinT, DM, (j / (DM / 64)) * 64, (j % (DM / 64)) * 64, true, tile, l > 0);
        else if (j < nt_in + nt_out) { const int r = j - nt_in; transpose_tile(p.in[4] + (size_t)l * DM * DM, DM, DM, nullptr, WoutT, DM, (r / (DM / 64)) * 64, (r % (DM / 64)) * 64, false, tile); }
        else { const int r = j - nt_in - nt_out; transpose_tile(p.in[9] + (size_t)l * CW * CW, CW, CW, nullptr, WpwT, CW, (r >> 2) * 64, (r & 3) * 64, false, tile); }
    }
    if (l > 0) fold_v1_rows(p, l, WinT, tile, worker, nworkers);
}

__device__ void rows_to_xb(const float* X, bf16_t* XB) {
    const int tid = tid_(), lane = tid & 63, wave = __builtin_amdgcn_readfirstlane(tid >> 6);
    for (int row = blockIdx.x * 8 + wave; row < M; row += gridDim.x * 8) {
        const float* xr = X + (size_t)row * DM;
        f32x4 v[4]; float ss = 0.f;
#pragma unroll
        for (int i = 0; i < 4; ++i) { v[i] = __builtin_nontemporal_load((const f32x4*)(xr + i * 256 + lane * 4)); ss += v[i][0] * v[i][0] + v[i][1] * v[i][1] + v[i][2] * v[i][2] + v[i][3] * v[i][3]; }
        ss = wave_sum(ss);
        const float rstd = rsqrtf(ss * (1.0f / DM) + RMS_EPS);
#pragma unroll
        for (int i = 0; i < 4; ++i) { uint2 w; w.x = pk2(v[i][0] * rstd, v[i][1] * rstd); w.y = pk2(v[i][2] * rstd, v[i][3] * rstd); *(uint2*)(XB + (size_t)row * DM + i * 256 + lane * 4) = w; }
    }
}

__device__ __forceinline__ bool defer_layer1_weights() { return gridDim.x >= BATCH * NH + 32; }
__device__ void phase_prologue(const Params& p, unsigned char* lds) {
    prep_weights(p, 0, lds, blockIdx.x, gridDim.x);
    if (!defer_layer1_weights()) for (int l = 1; l < DEPTH; ++l) prep_weights(p, l, lds, blockIdx.x, gridDim.x);
    rows_to_xb(p.in[0], (bf16_t*)(p.ws + WS_XB));
}

namespace pg8 {
#define PG8_LAS __attribute__((address_space(3)))
typedef unsigned short bf16_t;
typedef short bf16x8 __attribute__((ext_vector_type(8)));
typedef float f32x4 __attribute__((ext_vector_type(4)));
typedef unsigned u32x4 __attribute__((ext_vector_type(4)));
constexpr int BM = 256, BK = 64, HALF = 128, HTB = HALF * BK * 2  , STAGE_BYTES = 8 * HTB, NXCD = 8, WGM = 8;

__host__ __device__ __forceinline__ int lds_byte(int r, int c) { const int st = (r >> 4) * 2 + (c >> 5), rr = r & 15, cc = c & 31, ob = rr * 64 + cc * 2; return st * 1024 + (ob ^ (((ob >> 9) & 1) << 5)); }
__host__ __device__ __forceinline__ void stage_rc(int b, int& R, int& C) { const int st = b / 1024, sb = b % 1024, swz = sb ^ (((sb >> 9) & 1) << 5); R = (st >> 1) * 16 + swz / 64; C = (st & 1) * 32 + (swz % 64) / 2; }
__host__ __device__ __forceinline__ int perm32(int rho) { const int n = rho >> 4, i = rho & 15; return 8 * (i >> 2) + 4 * n + (i & 3); }

struct Unit { int pm, pn; };
struct Gemm { const bf16_t* A; const bf16_t* Bt; int M, N, K; };

struct StaticOrder {
    int nM, nN, nwg, G, c;
    __host__ __device__ void init(int M, int N, int G_, int c_) { nM = M / BM; nN = N / BM; nwg = nM * nN; G = G_; c = c_; }
    __host__ __device__ bool next(int i, Unit& u) const {
        const long L = (long)i * G + c; if (L >= nwg) return false;
        int wgid = (int)L; { const int q = nwg / NXCD, r = nwg % NXCD, xcd = wgid % NXCD, off = wgid / NXCD; wgid = (xcd < r ? xcd * (q + 1) : r * (q + 1) + (xcd - r) * q) + off; }
        const int nig = WGM * nN, gid = wgid / nig, fm = gid * WGM, gsz = (nM - fm) < WGM ? (nM - fm) : WGM;
        u.pm = fm + ((wgid % nig) % gsz); u.pn = (wgid % nig) / gsz; return true;
    }
    __device__ __forceinline__ void a_ready(const Unit&) const {}
    __device__ __forceinline__ void done(const Unit&) const {}
};


__device__ __forceinline__ unsigned cvt_pk_bf16(float lo, float hi) { unsigned r; asm volatile("v_cvt_pk_bf16_f32 %0, %1, %2" : "=v"(r) : "v"(lo), "v"(hi)); return r; }

template <class Epi, class Sched, bool ALIGN_EPI = false, bool SP2 = false>
__device__ __forceinline__ void gemm_phase(PG8_LAS unsigned char* lds, const Gemm g, const Sched& S, const Epi& E) {
    const int tid = tid_(), wid = __builtin_amdgcn_readfirstlane(tid >> 6), lane = tid & 63, wr = wid >> 2, wc = wid & 3, fr = lane & 15, fq = lane >> 4;
    const int K = g.K, nt = K / BK;
    unsigned voffA[2], voffB[2];
#pragma unroll
    for (int i = 0; i < 2; ++i) { int R, C; stage_rc(tid * 16 + i * 8192, R, C); const int Rb = Epi::PERM ? ((R & ~31) + perm32(R & 31)) : R;
        voffA[i] = (unsigned)(R * K + C) * 2u; voffB[i] = (unsigned)(Rb * K + C) * 2u; }
    const size_t kstep = (size_t)(BK * 2);
    const size_t hstep = (size_t)HALF * K * 2;
    const size_t tstep = 2 * hstep;
    const unsigned ldsw = (unsigned)wid * 1024u;
    const int aoff = lds_byte(wr * 64 + fr, fq * 8), boff = lds_byte(wc * 32 + fr, fq * 8);
#define PG8_SA(b, h) (((b) * 2 + (h)) * HTB)
#define PG8_SB(b, h) ((4 + (b) * 2 + (h)) * HTB)
#define PG8_STAGE(bufoff, gbase, voff) do { _Pragma("unroll") for (int _i = 0; _i < 2; ++_i) \
        __builtin_amdgcn_global_load_lds((const unsigned*)((const char*)(gbase) + (voff)[_i]), (PG8_LAS unsigned*)(lds + (bufoff) + ldsw + _i * 8192), 16, 0, 0); } while (0)
#define PG8_LDA(dst, b, h) do { _Pragma("unroll") for (int m = 0; m < 4; ++m) _Pragma("unroll") for (int k = 0; k < 2; ++k) dst[m][k] = *(const PG8_LAS bf16x8*)(lds + PG8_SA(b, h) + aoff + m * 2048 + k * 1024); } while (0)
#define PG8_LDB(dst, b, h) do { _Pragma("unroll") for (int n = 0; n < 2; ++n) _Pragma("unroll") for (int k = 0; k < 2; ++k) dst[n][k] = *(const PG8_LAS bf16x8*)(lds + PG8_SB(b, h) + boff + n * 2048 + k * 1024); } while (0)
#define PG8_MMA(ai, bj, At, Bt) do { __builtin_amdgcn_s_setprio(1); _Pragma("unroll") for (int m = 0; m < 4; ++m) _Pragma("unroll") for (int n = 0; n < 2; ++n) _Pragma("unroll") for (int k = 0; k < 2; ++k) \
        acc[ai][bj][m][n] = __builtin_amdgcn_mfma_f32_16x16x32_bf16(Bt[n][k], At[m][k], acc[ai][bj][m][n], 0, 0, 0); __builtin_amdgcn_s_setprio(0); } while (0)
#define PG8_WAIT_V(n) asm volatile("s_waitcnt vmcnt(" #n ")" ::: "memory")
#define PG8_WAIT_L(n) asm volatile("s_waitcnt lgkmcnt(" #n ")" ::: "memory")
#define PG8_BAR __builtin_amdgcn_s_barrier()
#define PG8_SCHED __builtin_amdgcn_sched_barrier(0)
    Unit cur, nxt; int ui = 0;
    if (!S.next(0, cur)) return;
    f32x4 acc[2][2][4][2];
#pragma unroll
    for (int a = 0; a < 2; ++a)
#pragma unroll
        for (int b = 0; b < 2; ++b)
#pragma unroll
            for (int m = 0; m < 4; ++m)
#pragma unroll
                for (int n = 0; n < 2; ++n) acc[a][b][m][n] = (f32x4){0.f, 0.f, 0.f, 0.f};
    bf16x8 At[4][2], B0[2][2], B1[2][2];
    const char* cA = (const char*)g.A + (size_t)cur.pm * tstep; const char* cB = (const char*)g.Bt + (size_t)cur.pn * tstep;
    S.a_ready(cur);
    if constexpr (SP2) {
        PG8_STAGE(PG8_SB(0, 0), cB, voffB); PG8_STAGE(PG8_SB(0, 1), cB + hstep, voffB); PG8_STAGE(PG8_SA(0, 0), cA, voffA); PG8_STAGE(PG8_SA(0, 1), cA + hstep, voffA);
        if (wr == 1) PG8_BAR;
        PG8_WAIT_V(2); PG8_BAR;
        PG8_STAGE(PG8_SB(1, 0), cB + kstep, voffB); PG8_STAGE(PG8_SA(1, 0), cA + kstep, voffA); PG8_STAGE(PG8_SB(1, 1), cB + hstep + kstep, voffB);
        PG8_WAIT_V(6); PG8_BAR;
    } else {
        PG8_STAGE(PG8_SB(0, 0), cB, voffB); PG8_STAGE(PG8_SA(0, 0), cA, voffA); PG8_STAGE(PG8_SB(0, 1), cB + hstep, voffB); PG8_STAGE(PG8_SA(0, 1), cA + hstep, voffA);
        if (wr == 1) PG8_BAR;
        PG8_WAIT_V(4); PG8_BAR;
        PG8_STAGE(PG8_SB(1, 0), cB + kstep, voffB); PG8_STAGE(PG8_SA(1, 0), cA + kstep, voffA); PG8_STAGE(PG8_SB(1, 1), cB + hstep + kstep, voffB);
        PG8_WAIT_V(6); PG8_BAR;
    }
    for (;;) {
        const bool has_next = S.next(ui + 1, nxt);
        const char* nA = has_next ? (const char*)g.A + (size_t)nxt.pm * tstep : cA; const char* nB = has_next ? (const char*)g.Bt + (size_t)nxt.pn * tstep : cB;
        for (int t = 0; t < nt; t += 2) {
            const bool last = (t == nt - 2);
            const char* a1 = cA + (size_t)(t + 1) * kstep;
            const char* a2 = last ? nA : cA + (size_t)(t + 2) * kstep; const char* b2 = last ? nB : cB + (size_t)(t + 2) * kstep;
            const char* a3 = a2 + kstep; const char* b3 = b2 + kstep;
            if (last && has_next) S.a_ready(nxt);
            if constexpr (SP2) {
            PG8_LDB(B0, 0, 0); PG8_LDB(B1, 0, 1); PG8_SCHED; PG8_LDA(At, 0, 0); PG8_STAGE(PG8_SA(1, 1), a1 + hstep, voffA);
            PG8_WAIT_V(8); PG8_WAIT_L(0); PG8_BAR; PG8_MMA(0, 0, At, B0); PG8_MMA(0, 1, At, B1); PG8_BAR; PG8_SCHED;
            PG8_LDA(At, 0, 1); PG8_STAGE(PG8_SB(0, 0), b2, voffB); PG8_STAGE(PG8_SB(0, 1), b2 + hstep, voffB); PG8_STAGE(PG8_SA(0, 0), a2, voffA);
            PG8_WAIT_V(8); PG8_WAIT_L(0); PG8_BAR; PG8_MMA(1, 0, At, B0); PG8_MMA(1, 1, At, B1); PG8_BAR; PG8_SCHED;
            PG8_LDB(B0, 1, 0); PG8_LDB(B1, 1, 1); PG8_SCHED; PG8_LDA(At, 1, 0); PG8_STAGE(PG8_SA(0, 1), a2 + hstep, voffA);
            PG8_WAIT_V(8); PG8_WAIT_L(0); PG8_BAR; PG8_MMA(0, 0, At, B0); PG8_MMA(0, 1, At, B1); PG8_BAR; PG8_SCHED;
            PG8_LDA(At, 1, 1); PG8_STAGE(PG8_SB(1, 0), b3, voffB); PG8_STAGE(PG8_SB(1, 1), b3 + hstep, voffB); PG8_STAGE(PG8_SA(1, 0), a3, voffA);
            PG8_WAIT_V(8); PG8_WAIT_L(0); PG8_BAR; PG8_MMA(1, 0, At, B0); PG8_MMA(1, 1, At, B1); PG8_BAR; PG8_SCHED;
            } else {
            PG8_LDB(B0, 0, 0); PG8_SCHED; PG8_LDA(At, 0, 0); PG8_STAGE(PG8_SA(1, 1), a1 + hstep, voffA);
            PG8_WAIT_L(8); PG8_BAR; PG8_WAIT_L(0); PG8_MMA(0, 0, At, B0); PG8_BAR; PG8_SCHED;
            PG8_LDB(B1, 0, 1); PG8_STAGE(PG8_SB(0, 0), b2, voffB);
            PG8_BAR; PG8_WAIT_L(0); PG8_MMA(0, 1, At, B1); PG8_BAR;
            PG8_LDA(At, 0, 1); PG8_STAGE(PG8_SA(0, 0), a2, voffA);
            PG8_BAR; PG8_WAIT_L(0); PG8_MMA(1, 0, At, B0); PG8_BAR; PG8_SCHED;
            PG8_STAGE(PG8_SB(0, 1), b2 + hstep, voffB);
            PG8_WAIT_V(6); PG8_BAR; PG8_MMA(1, 1, At, B1); PG8_BAR;
            PG8_LDB(B0, 1, 0); PG8_SCHED; PG8_LDA(At, 1, 0); PG8_STAGE(PG8_SA(0, 1), a2 + hstep, voffA);
            PG8_WAIT_L(8); PG8_BAR; PG8_WAIT_L(0); PG8_MMA(0, 0, At, B0); PG8_BAR; PG8_SCHED;
            PG8_LDB(B1, 1, 1); PG8_STAGE(PG8_SB(1, 0), b3, voffB);
            PG8_BAR; PG8_WAIT_L(0); PG8_MMA(0, 1, At, B1); PG8_BAR;
            PG8_LDA(At, 1, 1); PG8_STAGE(PG8_SA(1, 0), a3, voffA);
            PG8_BAR; PG8_WAIT_L(0); PG8_MMA(1, 0, At, B0); PG8_BAR; PG8_SCHED;
            PG8_STAGE(PG8_SB(1, 1), b3 + hstep, voffB);
            PG8_WAIT_V(6); PG8_BAR; PG8_MMA(1, 1, At, B1); PG8_BAR;
            }
        }
        if constexpr (ALIGN_EPI) { if (wr == 0) PG8_BAR; }
        if constexpr (!Epi::AFTER_DRAIN) { E(acc, cur, wr, wc, fr, fq); S.done(cur); }
        if (!has_next) break;
#pragma unroll
        for (int a = 0; a < 2; ++a)
#pragma unroll
            for (int b = 0; b < 2; ++b)
#pragma unroll
                for (int m = 0; m < 4; ++m)
#pragma unroll
                    for (int n = 0; n < 2; ++n) acc[a][b][m][n] = (f32x4){0.f, 0.f, 0.f, 0.f};
        cur = nxt; cA = nA; cB = nB; ++ui;
        if constexpr (ALIGN_EPI) { if (wr == 1) PG8_BAR; }
    }
    PG8_WAIT_V(0);
    if constexpr (!ALIGN_EPI) { if (wr == 0) PG8_BAR; }
    PG8_BAR;
    if constexpr (Epi::AFTER_DRAIN) { E.fused(acc, cur, wr, wc, fr, fq, lds, wid, lane); S.done(cur); }
#undef PG8_SA
#undef PG8_SB
#undef PG8_STAGE
#undef PG8_LDA
#undef PG8_LDB
#undef PG8_MMA
#undef PG8_WAIT_V
#undef PG8_WAIT_L
#undef PG8_BAR
#undef PG8_SCHED
}
}

struct EpiInProjP {
    static constexpr bool PERM = true, AFTER_DRAIN = false;
    bf16_t *PC, *PS, *PR, *PG, *VT;
    __device__ __forceinline__ void operator()(const pg8::f32x4 (&acc)[2][2][4][2], const pg8::Unit& u, int wr, int wc, int fr, int fq) const {
        const int row0 = u.pm * 256 + wr * 64 + fr;
#pragma unroll
        for (int bj = 0; bj < 2; ++bj) {
            const int blk = 2 * u.pn + bj; bf16_t* base; int ld, c0;
            if (blk >= 12 && blk < 15) {
                const int vc = 128 * (blk - 12) + wc * 32 + 8 * fq;
#pragma unroll
                for (int ai = 0; ai < 2; ++ai)
#pragma unroll
                    for (int m = 0; m < 4; ++m) {
                        const int row = row0 + ai * 128 + m * 16, b = row >> 11, t = row & 2047;
#pragma unroll
                        for (int n = 0; n < 2; ++n)
#pragma unroll
                            for (int e = 0; e < 4; ++e) { const int col = vc + 4 * n + e, hh = col >> 6, d = col & 63;
                                VT[((size_t)(b * NH + hh) * HD + d) * SEQ + t] = f2bf(acc[ai][bj][m][n][e]); }
                    }
                continue;
            }
            if (blk < 6) { base = PC; ld = PC_W; c0 = 128 * blk; }
            else if (blk < 12) { base = PS; ld = PS_W; c0 = 128 * (blk - 6); }
            else if (blk < 18) { base = PS; ld = PS_W; c0 = 768 + 128 * (blk - 15); }
            else if (blk < 28) { base = PR; ld = PR_W; c0 = 128 * (blk - 18); }
            else if (blk < 31) { base = PG; ld = PG_W; c0 = 128 * (blk - 28); }
            else continue;
            const int col = c0 + wc * 32 + 8 * fq;
#pragma unroll
            for (int ai = 0; ai < 2; ++ai)
#pragma unroll
                for (int m = 0; m < 4; ++m) {
                    const pg8::f32x4 v0 = acc[ai][bj][m][0], v1 = acc[ai][bj][m][1]; pg8::u32x4 w;
                    w.x = pg8::cvt_pk_bf16(v0[0], v0[1]); w.y = pg8::cvt_pk_bf16(v0[2], v0[3]); w.z = pg8::cvt_pk_bf16(v1[0], v1[1]); w.w = pg8::cvt_pk_bf16(v1[2], v1[3]);
                    *(pg8::u32x4*)(base + (size_t)(row0 + ai * 128 + m * 16) * ld + col) = w;
                }
        }
    }
};
struct EpiOutBf16P {
    static constexpr bool PERM = true, AFTER_DRAIN = false;
    bf16_t* Y; int ld;
    __device__ __forceinline__ void operator()(const pg8::f32x4 (&acc)[2][2][4][2], const pg8::Unit& u, int wr, int wc, int fr, int fq) const {
        const int row0 = u.pm * 256 + wr * 64 + fr, col0 = u.pn * 256 + wc * 32 + 8 * fq;
#pragma unroll
        for (int ai = 0; ai < 2; ++ai)
#pragma unroll
            for (int m = 0; m < 4; ++m)
#pragma unroll
                for (int bj = 0; bj < 2; ++bj) {
                    const pg8::f32x4 v0 = acc[ai][bj][m][0], v1 = acc[ai][bj][m][1]; pg8::u32x4 w;
                    w.x = pg8::cvt_pk_bf16(v0[0], v0[1]); w.y = pg8::cvt_pk_bf16(v0[2], v0[3]); w.z = pg8::cvt_pk_bf16(v1[0], v1[1]); w.w = pg8::cvt_pk_bf16(v1[2], v1[3]);
                    *(pg8::u32x4*)(Y + (size_t)(row0 + ai * 128 + m * 16) * ld + col0 + bj * 128) = w;
                }
    }
};

__device__ void phase_rowpass(const float* Xin, const bf16_t* Y, const float* gpost, float* Xout, bf16_t* XB) {
    const int tid = tid_(), lane = tid & 63, wave = __builtin_amdgcn_readfirstlane(tid >> 6);
    for (int row = blockIdx.x * 8 + wave; row < M; row += gridDim.x * 8) {
        f32x4 y[4], x[4]; float ss = 0.f;
#pragma unroll
        for (int i = 0; i < 4; ++i) { const uint2 yw = ldnt_u2((const void*)(Y + (size_t)row * DM + i * 256 + lane * 4));
            y[i] = (f32x4){bf2f((bf16_t)(yw.x & 0xffff)), bf2f((bf16_t)(yw.x >> 16)), bf2f((bf16_t)(yw.y & 0xffff)), bf2f((bf16_t)(yw.y >> 16))};
            x[i] = __builtin_nontemporal_load((const f32x4*)(Xin + (size_t)row * DM + i * 256 + lane * 4));
            ss += y[i][0] * y[i][0] + y[i][1] * y[i][1] + y[i][2] * y[i][2] + y[i][3] * y[i][3]; }
        ss = wave_sum(ss);
        const float rstd = rsqrtf(ss * (1.0f / DM) + RMS_EPS);
        float s2 = 0.f;
#pragma unroll
        for (int i = 0; i < 4; ++i) { const f32x4 g = *(const f32x4*)(gpost + i * 256 + lane * 4);
            x[i] = x[i] + y[i] * rstd * g; s2 += x[i][0] * x[i][0] + x[i][1] * x[i][1] + x[i][2] * x[i][2] + x[i][3] * x[i][3];
            __builtin_nontemporal_store(x[i], (f32x4*)(Xout + (size_t)row * DM + i * 256 + lane * 4)); }
        if (XB) {
            s2 = wave_sum(s2);
            const float r2 = rsqrtf(s2 * (1.0f / DM) + RMS_EPS);
#pragma unroll
            for (int i = 0; i < 4; ++i) { uint2 w; w.x = pk2(x[i][0] * r2, x[i][1] * r2); w.y = pk2(x[i][2] * r2, x[i][3] * r2); *(uint2*)(XB + (size_t)row * DM + i * 256 + lane * 4) = w; }
        }
    }
}

__device__ void conv_job(const Params& p, int l, int job, float* lds) {
    const int tid = tid_(), lane = tid & 63, wave = __builtin_amdgcn_readfirstlane(tid >> 6);
    const int b = job / (SEQ / 32), t0 = (job % (SEQ / 32)) * 32;
    const bf16_t* PC = (const bf16_t*)(p.ws + WS_PC); bf16_t* MIX = (bf16_t*)(p.ws + WS_MIX);
    const float* dw = p.in[5] + l * TAPS * CW; const float* dwb = p.in[6] + l * CW; const float* lng = p.in[7] + l * CW; const float* lnb = p.in[8] + l * CW;
    const float* pw = p.in[9] + (size_t)l * CW * CW; const float* pwb = p.in[10] + l * CW;
    float* u = lds;
    float* cv = lds + 62 * 256;
    for (int idx = tid; idx < 62 * 256; idx += 512) {
        const int r = idx >> 8, c = idx & 255, t = t0 - 30 + r;
        float v = 0.f;
        if (t >= 0) { const bf16_t* pr = PC + (size_t)(b * SEQ + t) * PC_W; v = bf2f(pr[c]) * sigmoidf_(bf2f(pr[256 + c])); }
        u[idx] = v;
    }
    __syncthreads();
    for (int idx = tid; idx < 32 * 256; idx += 512) {
        const int tt = idx >> 8, c = idx & 255;
        float a = dwb[c];
#pragma unroll 4
        for (int j = 0; j < TAPS; ++j) a += dw[j * CW + c] * u[(tt + j) * 256 + c];
        cv[idx] = a;
    }
    __syncthreads();
    for (int q = 0; q < 4; ++q) {
        const int tt = wave * 4 + q; float x[4], s = 0.f;
#pragma unroll
        for (int i = 0; i < 4; ++i) { x[i] = cv[tt * 256 + lane + 64 * i]; s += x[i]; }
        const float mean = wave_sum(s) * (1.0f / CW); float vs = 0.f;
#pragma unroll
        for (int i = 0; i < 4; ++i) { const float d = x[i] - mean; vs += d * d; }
        const float rstd = rsqrtf(wave_sum(vs) * (1.0f / CW) + LN_EPS);
#pragma unroll
        for (int i = 0; i < 4; ++i) { const int c = lane + 64 * i; cv[tt * 256 + c] = siluf_((x[i] - mean) * rstd * lng[c] + lnb[c]); }
    }
    __syncthreads();
    {
        const int n = tid & 255, half = tid >> 8;
        float acc[16];
#pragma unroll
        for (int i = 0; i < 16; ++i) acc[i] = pwb[n];
#pragma unroll 2
        for (int k = 0; k < CW; ++k) {
            const float w = pw[(size_t)k * CW + n];
#pragma unroll
            for (int i = 0; i < 16; ++i) acc[i] += cv[(half * 16 + i) * 256 + k] * w;
        }
#pragma unroll
        for (int i = 0; i < 16; ++i) { const size_t row = (size_t)b * SEQ + t0 + half * 16 + i;
            const float g = bf2f(PC[row * PC_W + 512 + n]);
            MIX[row * DM + n] = f2bf(acc[i] * siluf_(g)); }
    }
    __syncthreads();
}

constexpr int CV_AS = 264;
__device__ void conv_job64(const Params& p, int l, int job, unsigned char* lds) {
    const int tid = tid_(), lane = tid & 63, wave = __builtin_amdgcn_readfirstlane(tid >> 6), fr = lane & 15, fq = lane >> 4;
    const int b = job >> 5, t0 = (job & 31) * 64;
    const bf16_t* PC = (const bf16_t*)(p.ws + WS_PC); bf16_t* MIX = (bf16_t*)(p.ws + WS_MIX);
    const float* dw = p.in[5] + l * TAPS * CW; const float* dwb = p.in[6] + l * CW; const float* lng = p.in[7] + l * CW; const float* lnb = p.in[8] + l * CW;
    const bf16_t* pwT = (const bf16_t*)(p.ws + WS_WPW) + (size_t)l * CW * CW; const float* pwb = p.in[10] + l * CW;
    float* u = (float*)lds;
    bf16_t* act = (bf16_t*)(lds + 94 * 256 * 4);
    for (int idx = tid; idx < 94 * 32; idx += 512) {
        const int r = idx >> 5, c8 = (idx & 31) * 8, t = t0 - 30 + r;
        float v[8];
        if (t >= 0) { const bf16_t* pr = PC + ((size_t)b * SEQ + t) * PC_W + c8; const bf16x8 a = *(const bf16x8*)pr, g = *(const bf16x8*)(pr + 256);
#pragma unroll
            for (int e = 0; e < 8; ++e) v[e] = bf2f((bf16_t)a[e]) * __builtin_amdgcn_rcpf(1.0f + __builtin_amdgcn_exp2f(-1.4426950408889634f * bf2f((bf16_t)g[e]))); }
        else {
#pragma unroll
            for (int e = 0; e < 8; ++e) v[e] = 0.f; }
        *(f32x4*)(u + r * 256 + c8) = (f32x4){v[0], v[1], v[2], v[3]}; *(f32x4*)(u + r * 256 + c8 + 4) = (f32x4){v[4], v[5], v[6], v[7]};
    }
    __syncthreads();
    const int c = tid & 255, half = tid >> 8;
    float acc[32];
    {
        float w[TAPS];
#pragma unroll
        for (int j = 0; j < TAPS; ++j) w[j] = dw[j * CW + c];
        const float bias = dwb[c];
#pragma unroll
        for (int i = 0; i < 32; ++i) acc[i] = bias;
        const float* up = u + (half * 32) * 256 + c;
#pragma unroll
        for (int rr = 0; rr < 62; ++rr) {
            const float uv = up[rr * 256];
#pragma unroll
            for (int i = 0; i < 32; ++i) { if (rr - i >= 0 && rr - i < TAPS) acc[i] += w[rr - i] * uv; }
        }
    }
    __syncthreads();
    float* cv = u;
#pragma unroll
    for (int i = 0; i < 32; ++i) cv[(half * 32 + i) * 256 + c] = acc[i];
    __syncthreads();
#pragma unroll 2
    for (int q = 0; q < 8; ++q) {
        const int tt = wave * 8 + q; const f32x4 x = *(const f32x4*)(cv + tt * 256 + lane * 4);
        const float mean = wave_sum(x[0] + x[1] + x[2] + x[3]) * (1.0f / CW);
        const f32x4 d = x - mean;
        const float rstd = rsqrtf(wave_sum(d[0] * d[0] + d[1] * d[1] + d[2] * d[2] + d[3] * d[3]) * (1.0f / CW) + LN_EPS);
        const f32x4 g = *(const f32x4*)(lng + lane * 4), bb = *(const f32x4*)(lnb + lane * 4);
        float y[4];
#pragma unroll
        for (int e = 0; e < 4; ++e) { const float v = d[e] * rstd * g[e] + bb[e]; y[e] = v * __builtin_amdgcn_rcpf(1.0f + __builtin_amdgcn_exp2f(-1.4426950408889634f * v)); }
        uint2 w; w.x = pk2(y[0], y[1]); w.y = pk2(y[2], y[3]); *(uint2*)(act + tt * CV_AS + lane * 4) = w;
    }
    __syncthreads();
    {
        f32x4 o[2][4];
#pragma unroll
        for (int i = 0; i < 2; ++i)
#pragma unroll
            for (int j = 0; j < 4; ++j) o[i][j] = (f32x4){0.f, 0.f, 0.f, 0.f};
#pragma unroll 2
        for (int kk = 0; kk < 8; ++kk) {
            bf16x8 a[2], bq[4];
#pragma unroll
            for (int i = 0; i < 2; ++i) a[i] = *(const bf16x8*)(pwT + (size_t)(wave * 32 + i * 16 + fr) * CW + kk * 32 + fq * 8);
#pragma unroll
            for (int j = 0; j < 4; ++j) bq[j] = *(const bf16x8*)(act + (j * 16 + fr) * CV_AS + kk * 32 + fq * 8);
#pragma unroll
            for (int i = 0; i < 2; ++i)
#pragma unroll
                for (int j = 0; j < 4; ++j) o[i][j] = __builtin_amdgcn_mfma_f32_16x16x32_bf16(a[i], bq[j], o[i][j], 0, 0, 0);
        }
#pragma unroll
        for (int i = 0; i < 2; ++i) {
            const int n0 = wave * 32 + i * 16 + fq * 4; const f32x4 bias = *(const f32x4*)(pwb + n0);
#pragma unroll
            for (int j = 0; j < 4; ++j) {
                const size_t row = (size_t)b * SEQ + t0 + j * 16 + fr;
                const uint2 gw = *(const uint2*)(PC + row * PC_W + 512 + n0);
                const float g0 = bf2f((bf16_t)(gw.x & 0xffff)), g1 = bf2f((bf16_t)(gw.x >> 16)), g2 = bf2f((bf16_t)(gw.y & 0xffff)), g3 = bf2f((bf16_t)(gw.y >> 16));
                const f32x4 v = o[i][j] + bias;
                uint2 w; w.x = pk2(v[0] * siluf_(g0), v[1] * siluf_(g1)); w.y = pk2(v[2] * siluf_(g2), v[3] * siluf_(g3));
                *(uint2*)(MIX + row * DM + n0) = w;
            }
        }
    }
    __syncthreads();
}

__device__ void attn_job(const Params& p, int job) {
    const int tid = tid_(), lane = tid & 63, wave = __builtin_amdgcn_readfirstlane(tid >> 6);
    const int bh = job >> 2, qb = job & 3, b = bh / NH, h = bh % NH;
    const bf16_t* PS = (const bf16_t*)(p.ws + WS_PS); bf16_t* MIX = (bf16_t*)(p.ws + WS_MIX);
    const int tw = qb * 512 + wave * 64, t = tw + lane;
    const size_t row = (size_t)b * SEQ + t;
    const float qs = 1.0f;
    const bf16_t* VT = (const bf16_t*)(p.ws + WS_VT) + (size_t)bh * HD * SEQ;
    float q[64], o[64];
    {
        const bf16_t* qp = PS + row * PS_W + h * HD;
#pragma unroll
        for (int i = 0; i < 8; ++i) { const bf16x8 v = *(const bf16x8*)(qp + i * 8);
#pragma unroll
            for (int j = 0; j < 8; ++j) { q[i * 8 + j] = bf2f((bf16_t)v[j]) * qs; o[i * 8 + j] = 0.f; } }
    }
    float rp = 1.0f;
    const int z = opaque_zero();
    for (int s = tw + 62; s >= 0; --s) {
        const bf16_t* kp = PS + ((size_t)b * SEQ + s) * PS_W + 384 + h * HD + z;
        float dot = 0.f;
#pragma unroll
        for (int i = 0; i < 8; ++i) { const bf16x8 v = *(const bf16x8*)(kp + i * 8);
#pragma unroll
            for (int j = 0; j < 8; ++j) dot += q[i * 8 + j] * bf2f((bf16_t)v[j]); }
        const bool act = s < t;
        const float e = __builtin_amdgcn_exp2f(dot);
        const float keep = __builtin_amdgcn_rcpf(1.0f + e);
        const float pr = act ? (1.0f - keep) * rp : 0.f;
        rp = act ? rp * keep : rp;
#pragma unroll
        for (int d = 0; d < 64; ++d) o[d] += pr * bf2f(VT[(size_t)d * SEQ + s + z]);
        if (__all(rp == 0.0f)) break;
    }
    const bf16_t* gp = PS + row * PS_W + 768 + h * HD;
    bf16_t* op = MIX + row * DM + CW + h * HD;
#pragma unroll
    for (int i = 0; i < 8; ++i) { const bf16x8 g = *(const bf16x8*)(gp + i * 8); uint4 w;
        w.x = pk2(o[i * 8 + 0] * siluf_(bf2f((bf16_t)g[0])), o[i * 8 + 1] * siluf_(bf2f((bf16_t)g[1])));
        w.y = pk2(o[i * 8 + 2] * siluf_(bf2f((bf16_t)g[2])), o[i * 8 + 3] * siluf_(bf2f((bf16_t)g[3])));
        w.z = pk2(o[i * 8 + 4] * siluf_(bf2f((bf16_t)g[4])), o[i * 8 + 5] * siluf_(bf2f((bf16_t)g[5])));
        w.w = pk2(o[i * 8 + 6] * siluf_(bf2f((bf16_t)g[6])), o[i * 8 + 7] * siluf_(bf2f((bf16_t)g[7])));
        *(uint4*)(op + i * 8) = w; }
}

typedef float f32x16 __attribute__((ext_vector_type(16)));
struct AttFrag { bf16x8 K[4], V[2][2]; };
constexpr int AT_WIN = 224;
constexpr int AT_KS = 144, AT_VS = 976;
constexpr int AT_VOFF = (AT_WIN + 256) * AT_KS;
static_assert(AT_VOFF + 64 * AT_VS <= 147456, "attention LDS map");
__device__ __forceinline__ void att_load(AttFrag& F, const bf16_t* kbase, const bf16_t* vbase, const unsigned char* klds, const unsigned char* vlds, int w0, int kt) {
    const int s0 = (kt > 0 ? kt : 0) * 32;
    if (s0 >= w0) {
        const unsigned char* kp = klds + (s0 - w0) * AT_KS; const unsigned char* vp = vlds + (s0 - w0) * 2;
#pragma unroll
        for (int ks = 0; ks < 4; ++ks) F.K[ks] = *(const bf16x8*)(kp + ks * 32);
#pragma unroll
        for (int db = 0; db < 2; ++db)
#pragma unroll
            for (int s = 0; s < 2; ++s) F.V[db][s] = *(const bf16x8*)(vp + db * 32 * AT_VS + s * 16);
    } else {
#pragma unroll
        for (int ks = 0; ks < 4; ++ks) F.K[ks] = *(const bf16x8*)(kbase + (size_t)s0 * PS_W + ks * 16);
#pragma unroll
        for (int db = 0; db < 2; ++db)
#pragma unroll
            for (int s = 0; s < 2; ++s) F.V[db][s] = *(const bf16x8*)(vbase + (size_t)db * 32 * SEQ + s0 + s * 8);
    }
}
__device__ __forceinline__ bool att_tile(const AttFrag& F, const bf16x8 (&Qf)[4], f32x16& O0, f32x16& O1, float& rp, bool diag, int qi, int hf) {
    f32x16 S;
#pragma unroll
    for (int r = 0; r < 16; ++r) S[r] = 0.f;
#pragma unroll
    for (int ks = 0; ks < 4; ++ks) S = __builtin_amdgcn_mfma_f32_32x32x16_bf16(F.K[ks], Qf[ks], S, 0, 0, 0);
    float tot = 1.0f;
#pragma unroll
    for (int r = 0; r < 16; ++r) {
        float k_ = __builtin_amdgcn_rcpf(1.0f + __builtin_amdgcn_exp2f(S[r]));
        if (diag && (hf * 16 + r >= qi)) k_ = 1.0f;
        S[r] = k_; tot *= k_;
    }
    const float toto = __shfl_xor(tot, 32);
    float e = hf ? rp : rp * toto;
#pragma unroll
    for (int r = 15; r >= 0; --r) { const float k_ = S[r]; S[r] = (1.0f - k_) * e; e *= k_; }
    rp = rp * tot * toto;
    bf16x8 Pf[2];
#pragma unroll
    for (int s = 0; s < 2; ++s) {
        union { bf16x8 v; unsigned u[4]; } pk;
#pragma unroll
        for (int j = 0; j < 4; ++j) pk.u[j] = pk2(S[8 * s + 2 * j], S[8 * s + 2 * j + 1]);
        Pf[s] = pk.v;
    }
#pragma unroll
    for (int s = 0; s < 2; ++s) { O0 = __builtin_amdgcn_mfma_f32_32x32x16_bf16(F.V[0][s], Pf[s], O0, 0, 0, 0); O1 = __builtin_amdgcn_mfma_f32_32x32x16_bf16(F.V[1][s], Pf[s], O1, 0, 0, 0); }
    return __ballot(rp != 0.0f) == 0ull;
}
__device__ void attn_wg_job(const Params& p, int job, unsigned char* lds) {
    const int tid = tid_(), lane = tid & 63, wave = __builtin_amdgcn_readfirstlane(tid >> 6), qi = lane & 31, hf = lane >> 5;
    const int bh = job >> 3, g = job & 7, b = bh / NH, h = bh % NH;
    const bf16_t* PS = (const bf16_t*)(p.ws + WS_PS); const bf16_t* VT = (const bf16_t*)(p.ws + WS_VT) + (size_t)bh * HD * SEQ; bf16_t* MIX = (bf16_t*)(p.ws + WS_MIX);
    const int w0 = g * 256 > AT_WIN ? g * 256 - AT_WIN : 0, nkeys = g * 256 + 256 - w0;
    unsigned char* klds = lds; unsigned char* vlds = lds + AT_VOFF;
    {
        const bf16_t* ksrc = PS + ((size_t)b * SEQ + w0) * PS_W + SBW + h * HD;
        for (int idx = tid; idx < nkeys * 8; idx += 512) { const int row = idx >> 3, pc = idx & 7; *(uint4*)(klds + row * AT_KS + pc * 16) = *(const uint4*)(ksrc + (size_t)row * PS_W + pc * 8); }
        const int pc = tid & 63, npc = nkeys >> 3;
        if (pc < npc) {
#pragma unroll
            for (int i = 0; i < 8; ++i) { const int d = (tid >> 6) + 8 * i; *(uint4*)(vlds + d * AT_VS + pc * 16) = *(const uint4*)(VT + (size_t)d * SEQ + w0 + pc * 8); }
        }
    }
    __syncthreads();
    {
        const int qblk = g * 8 + wave, q0 = qblk * 32;
        const size_t rowq = (size_t)b * SEQ + q0 + qi;
        const int pi = (qi & 3) + 4 * (qi >> 3) + 16 * ((qi >> 2) & 1);
        const bf16_t* kbase = PS + ((size_t)b * SEQ + pi) * PS_W + SBW + h * HD + hf * 8;
        const bf16_t* vbase = VT + (size_t)qi * SEQ + hf * 16;
        const unsigned char* kl = klds + pi * AT_KS + hf * 16; const unsigned char* vl = vlds + qi * AT_VS + hf * 32;
        AttFrag FA, FB;
        att_load(FA, kbase, vbase, kl, vl, w0, qblk);
        bf16x8 Qf[4];
#pragma unroll
        for (int ks = 0; ks < 4; ++ks) Qf[ks] = *(const bf16x8*)(PS + rowq * PS_W + h * HD + ks * 16 + hf * 8);
        f32x16 O0, O1;
#pragma unroll
        for (int r = 0; r < 16; ++r) { O0[r] = 0.f; O1[r] = 0.f; }
        float rp = 1.0f;
        for (int kt = qblk; kt >= 0; kt -= 2) {
            att_load(FB, kbase, vbase, kl, vl, w0, kt - 1);
            if (att_tile(FA, Qf, O0, O1, rp, kt == qblk, qi, hf) || kt < 1) break;
            att_load(FA, kbase, vbase, kl, vl, w0, kt - 2);
            if (att_tile(FB, Qf, O0, O1, rp, false, qi, hf)) break;
        }
        const bf16_t* gp = PS + rowq * PS_W + 768 + h * HD; bf16_t* op = MIX + rowq * DM + CW + h * HD;
#pragma unroll
        for (int db = 0; db < 2; ++db)
#pragma unroll
            for (int gq = 0; gq < 4; ++gq) {
                const int d0 = db * 32 + gq * 8 + hf * 4;
                const uint2 gw = *(const uint2*)(gp + d0);
                const float g0 = bf2f((bf16_t)(gw.x & 0xffff)), g1 = bf2f((bf16_t)(gw.x >> 16)), g2 = bf2f((bf16_t)(gw.y & 0xffff)), g3 = bf2f((bf16_t)(gw.y >> 16));
                const f32x16& O = db ? O1 : O0;
                uint2 w; w.x = pk2(O[4 * gq] * siluf_(g0), O[4 * gq + 1] * siluf_(g1)); w.y = pk2(O[4 * gq + 2] * siluf_(g2), O[4 * gq + 3] * siluf_(g3));
                *(uint2*)(op + d0) = w;
            }
    }
    __syncthreads();
}

__device__ void rwkv_job(const Params& p, int l, int job, float* lds) {
    const int tid = tid_(), lane = tid & 63, wave = __builtin_amdgcn_readfirstlane(tid >> 6);
    const int b = job / NH, h = job % NH;
    const bf16_t* PR = (const bf16_t*)(p.ws + WS_PR); const bf16_t* PG = (const bf16_t*)(p.ws + WS_PG);
    float* VF = (float*)(p.ws + WS_VF); bf16_t* MIX = (bf16_t*)(p.ws + WS_MIX);
    const float* mu = p.in[11] + l * 1216; const float* w0 = p.in[12] + l * RWW; const float* w2 = p.in[13] + l * LORA * RWW;
    const float* a0 = p.in[14] + l * RWW; const float* a2 = p.in[15] + l * LORA * RWW; const float* kks = p.in[16] + l * RWW; const float* ka = p.in[17] + l * RWW;
    const float* rk = p.in[18] + l * RWW; const float* gng = p.in[19] + l * RWW; const float* gnb = p.in[20] + l * RWW;
    const float* v0 = p.in[21]; const float* v1 = p.in[22]; const float* v2 = p.in[23];
    float* R = lds; float* W = R + 4096; float* K = W + 4096; float* V = K + 4096; float* A = V + 4096; float* Bm = A + 4096; float* Y = Bm + 4096;
    float* WD = Y + 4096; float* AD = WD + 2048; float* VL = AD + 2048;
    float S[64];
#pragma unroll
    for (int i = 0; i < 64; ++i) S[i] = 0.f;
    for (int c = 0; c < SEQ / 64; ++c) {
        const int t0 = c * 64;
        for (int idx = tid; idx < 64 * 64; idx += 512) {
            const int tt = idx >> 6, i = idx & 63, t = t0 + tt;
            const bf16_t* cur = PR + ((size_t)b * SEQ + t) * PR_W;
            const float xc = bf2f(cur[1152 + i]), xp = t > 0 ? bf2f(cur[1152 + i - PR_W]) : 0.f;
            const float f = xc + (xp - xc) * mu[1152 + i];
            if (i < 32) WD[tt * 32 + i] = tanhf(f); else AD[tt * 32 + i - 32] = f;
        }
        if (l > 0) {
            for (int idx = tid; idx < 64 * 32; idx += 512) {
                const int tt = idx >> 5, i = idx & 31, t = t0 + tt;
                const bf16_t* cur = PR + ((size_t)b * SEQ + t) * PR_W + 768;
                float a = 0.f;
                for (int cc = 0; cc < RWW; ++cc) {
                    const float xc = bf2f(cur[cc]), xp = t > 0 ? bf2f(cur[cc - PR_W]) : 0.f;
                    a += (xc + (xp - xc) * mu[768 + cc]) * v1[cc * LORA + i];
                }
                VL[idx] = a;
            }
        }
        __syncthreads();
        for (int idx = tid; idx < 64 * 64; idx += 512) {
            const int tt = idx >> 6, j = idx & 63, t = t0 + tt, cj = h * HD + j;
            const size_t row = (size_t)b * SEQ + t;
            const bf16_t* cur = PR + row * PR_W;
            const bool hp = t > 0;
            float rc = bf2f(cur[cj]), kc = bf2f(cur[384 + cj]), vc = bf2f(cur[768 + cj]);
            const float rp_ = hp ? bf2f(cur[cj - PR_W]) : 0.f, kp_ = hp ? bf2f(cur[384 + cj - PR_W]) : 0.f, vp_ = hp ? bf2f(cur[768 + cj - PR_W]) : 0.f;
            rc += (rp_ - rc) * mu[cj]; kc += (kp_ - kc) * mu[384 + cj]; vc += (vp_ - vc) * mu[768 + cj];
            float wl = w0[cj], al = a0[cj];
#pragma unroll 8
            for (int i = 0; i < LORA; ++i) { wl += WD[tt * 32 + i] * w2[i * RWW + cj]; al += AD[tt * 32 + i] * a2[i * RWW + cj]; }
            const float sp = fmaxf(-wl, 0.f) + log1pf(__expf(-fabsf(wl)));
            const float decay = __expf(-__expf(-sp - 0.5f));
            const float alr = sigmoidf_(al);
            if (l > 0) {
                float vg = v0[cj];
#pragma unroll 8
                for (int i = 0; i < LORA; ++i) vg += VL[tt * 32 + i] * v2[i * RWW + cj];
                vg = sigmoidf_(vg);
                vc = vc + (VF[row * RWW + cj] - vc) * vg;
            } else VF[row * RWW + cj] = vc;
            R[idx] = rc; W[idx] = decay; V[idx] = vc;
            K[idx] = kc * (1.0f + (alr - 1.0f) * ka[cj]);
            A[idx] = kc * kks[cj];
            Bm[idx] = alr;
        }
        __syncthreads();
        for (int q = 0; q < 8; ++q) {
            const int tt = wave * 8 + q; const float kk = A[tt * 64 + lane];
            const float nrm = sqrtf(wave_sum(kk * kk));
            const float kn = kk / fmaxf(nrm, 1e-12f);
            A[tt * 64 + lane] = -kn; Bm[tt * 64 + lane] = kn * Bm[tt * 64 + lane];
        }
        __syncthreads();
        if (wave == 0) {
            for (int tt = 0; tt < 64; ++tt) {
                const f32x4* a4 = (const f32x4*)(A + tt * 64); const f32x4* w4 = (const f32x4*)(W + tt * 64); const f32x4* b4 = (const f32x4*)(Bm + tt * 64);
                const f32x4* k4 = (const f32x4*)(K + tt * 64); const f32x4* r4 = (const f32x4*)(R + tt * 64);
                float sa = 0.f;
#pragma unroll
                for (int i = 0; i < 16; ++i) { const f32x4 a = a4[i]; sa += S[4 * i] * a[0] + S[4 * i + 1] * a[1] + S[4 * i + 2] * a[2] + S[4 * i + 3] * a[3];
                    if ((i & 7) == 7) asm volatile("" ::: "memory"); }
                const float vv = V[tt * 64 + lane];
                float y = 0.f;
#pragma unroll
                for (int i = 0; i < 16; ++i) { const f32x4 w = w4[i], bb = b4[i], kk = k4[i], rr = r4[i];
#pragma unroll
                    for (int e = 0; e < 4; ++e) { const float s = S[4 * i + e] * w[e] + sa * bb[e] + vv * kk[e]; S[4 * i + e] = s; y += s * rr[e]; }
                    if ((i & 1) == 1) asm volatile("" ::: "memory"); }
                Y[tt * 64 + lane] = y;
            }
        }
        __syncthreads();
        for (int q = 0; q < 8; ++q) {
            const int tt = wave * 8 + q, t = t0 + tt, cj = h * HD + lane; const size_t row = (size_t)b * SEQ + t;
            const float y = Y[tt * 64 + lane];
            const float mean = wave_sum(y) * (1.0f / HD); const float d = y - mean;
            const float var = wave_sum(d * d) * (1.0f / HD);
            const float yn = d * rsqrtf(var + GN_EPS) * gng[cj] + gnb[cj];
            const float bonus = wave_sum(R[tt * 64 + lane] * K[tt * 64 + lane] * rk[cj]);
            const float o = yn + bonus * V[tt * 64 + lane];
            const float g = bf2f(PG[row * PG_W + cj]);
            MIX[row * DM + CW + SBW + cj] = f2bf(o * siluf_(g));
        }
        __syncthreads();
    }
}

constexpr int TS = 72;
constexpr int TILE_B = 64 * TS * 2;
constexpr int AABS = 68, XTS = 65, CSS = 65;

__device__ __forceinline__ f32x4 mm_tile(const bf16_t* X, int m0, const bf16_t* Yt, int n0, int K, int fr, int fq, f32x4 acc) {
#pragma unroll
    for (int kk = 0; kk < 2; ++kk) {
        if (kk * 32 < K) {
            const bf16x8 a = *(const bf16x8*)(X + (m0 + fr) * TS + kk * 32 + fq * 8);
            const bf16x8 b = *(const bf16x8*)(Yt + (n0 + fr) * TS + kk * 32 + fq * 8);
            acc = __builtin_amdgcn_mfma_f32_16x16x32_bf16(a, b, acc, 0, 0, 0);
        }
    }
    return acc;
}
__device__ __forceinline__ uint2 pk4(const f32x4& v) { uint2 w; w.x = pk2(v[0], v[1]); w.y = pk2(v[2], v[3]); return w; }

struct B1Loads {
    bf16x8 rc, kc, vc, rp, kp, vp;
    f32x4 vf0, vf1;
    bf16x8 cc[2], cp[2];
};
__device__ __forceinline__ void b1_issue_loads(const Params& p, int l, int gi, int h, int tid, B1Loads& L) {
    const int b = gi >> 5, c = gi & 31, t0 = c * 64;
    const bf16_t* PR = (const bf16_t*)(p.ws + WS_PR); const float* VF = (const float*)(p.ws + WS_VF);
    {
        const int tt = tid >> 3, j0 = (tid & 7) * 8, t = t0 + tt, cj0 = h * HD + j0; const size_t row = (size_t)b * SEQ + t;
        const bf16_t* cur = PR + row * PR_W; const bf16_t* prv = cur - (t > 0 ? PR_W : 0);
        L.rc = *(const bf16x8*)(cur + cj0); L.kc = *(const bf16x8*)(cur + 384 + cj0); L.vc = *(const bf16x8*)(cur + 768 + cj0);
        L.rp = *(const bf16x8*)(prv + cj0); L.kp = *(const bf16x8*)(prv + 384 + cj0); L.vp = *(const bf16x8*)(prv + 768 + cj0);
        if (l > 0) { L.vf0 = *(const f32x4*)(VF + row * RWW + cj0); L.vf1 = *(const f32x4*)(VF + row * RWW + cj0 + 4); }
    }
    if (h == 0) {
#pragma unroll
        for (int q = 0; q < 2; ++q) {
            const int item = tid + 512 * q, tt = item >> 4, g = item & 15, t = t0 + tt;
            const bf16_t* cur = PR + ((size_t)b * SEQ + t) * PR_W + 1152; const bf16_t* prv = cur - (t > 0 ? PR_W : 0);
            const int gc = g < 12 ? g : 0, gp = g < 8 ? g : (g < 12 ? g + 4 : 0);
            L.cc[q] = *(const bf16x8*)(cur + 8 * gc); L.cp[q] = *(const bf16x8*)(prv + 8 * gp);
        }
    }
}

__device__ void rwkv_b1_phase(const Params& p, int l, unsigned char* lds) {
    const int G = gridDim.x;
    float* VF = (float*)(p.ws + WS_VF);
    const float* mu = p.in[11] + l * 1216; const float* w0 = p.in[12] + l * RWW;
    const float* a0 = p.in[14] + l * RWW; const float* kks = p.in[16] + l * RWW; const float* ka = p.in[17] + l * RWW;
    const float* rk = p.in[18] + l * RWW; const float* v0 = p.in[21];
    const float* w2 = p.in[13] + l * LORA * RWW; const float* a2 = p.in[15] + l * LORA * RWW; const float* v2 = p.in[23];
    bf16_t* T_At = (bf16_t*)lds; bf16_t* T_Rt = T_At + 64 * TS; bf16_t* T_Bt = T_Rt + 64 * TS; bf16_t* T_Kt = T_Bt + 64 * TS;
    bf16_t* T_VT = T_Kt + 64 * TS; bf16_t* T_bhT = T_VT + 64 * TS; bf16_t* T_khT = T_bhT + 64 * TS;
    bf16_t* T_Aak = T_khT + 64 * TS; bf16_t* T_Arb = T_Aak + 64 * TS; bf16_t* T_Ark = T_Arb + 64 * TS;
    bf16_t* T_WT = T_At; bf16_t* T_U0T = T_Bt;
    float* Aab = (float*)(lds + 10 * TILE_B);
    float* XT = (float*)(lds + 10 * TILE_B + 64 * AABS * 4);
    float* PCv = XT + 128 * XTS;
    float* TI = PCv + 64;
    float* CS = (float*)T_Aak;
    constexpr int LS = 33;
    float* WD = Aab; float* AD = WD + 64 * LS;
    float* VL = XT + 64 * XTS;
    float* WLT = (float*)lds; float* ALT = WLT + 64 * XTS; float* VGT = ALT + 64 * XTS;

    constexpr int NGRP = BATCH * (SEQ / 64);
    int gi = blockIdx.x;
    if (gi >= NGRP) return;
    B1Loads L;
    b1_issue_loads(p, l, gi, 0, tid_(), L);
    float codes[2][8];
#pragma unroll 1
    for (int it = 0; gi < NGRP; ++it) {
        const int h = it % NH;
        const int tid = tid_(), lane = tid & 63, wave = __builtin_amdgcn_readfirstlane(tid >> 6), fr = lane & 15, fq = lane >> 4;
        const int b = gi >> 5, c = gi & 31, bh = b * NH + h, jb = bh * 32 + c, t0 = c * 64;
        float wg[6][8];
#pragma unroll
        for (int q = 0; q < 6; ++q) {
            const int id = wave + 8 * q, Lk = id >> 4, tj = id & 3;
            if (q < 4 || l > 0) {
                const float* Wg = (Lk == 0 ? w2 : (Lk == 1 ? a2 : v2)) + (size_t)fq * RWW + h * HD + tj * 16 + fr;
#pragma unroll
                for (int kk = 0; kk < 8; ++kk) wg[q][kk] = Wg[(size_t)kk * 4 * RWW];
            }
        }
#pragma unroll
        for (int q = 0; q < 2; ++q) {
            const int item = tid + 512 * q, tt = item >> 4, g = item & 15, t = t0 + tt; const bool hp = t > 0;
            if (h == 0) {
#pragma unroll
                for (int e = 0; e < 8; ++e) {
                    const float xc = bf2f((bf16_t)L.cc[q][e]), xp = hp ? bf2f((bf16_t)L.cp[q][e]) : 0.f;
                    const float x_ = xc + (xp - xc) * mu[1152 + 8 * (g & 7) + e];
                    codes[q][e] = g < 4 ? 1.0f - 2.0f * __builtin_amdgcn_rcpf(1.0f + __builtin_amdgcn_exp2f(2.8853900817779268f * x_)) : (g < 8 ? x_ : xc + xp);
                }
            }
            if (g < 8 || (g < 12 && l > 0)) {
                float* dst = (g < 4 ? WD + tt * LS + 8 * g : (g < 8 ? AD + tt * LS + 8 * (g - 4) : VL + tt * LS + 8 * (g - 8)));
#pragma unroll
                for (int e = 0; e < 8; ++e) dst[e] = codes[q][e];
            }
        }
        __syncthreads();
#pragma unroll
        for (int q = 0; q < 6; ++q) {
            if (q < 4 || l > 0) {
                const int id = wave + 8 * q, Lk = id >> 4, ti = (id >> 2) & 3, tj = id & 3;
                const float* Xs = (Lk == 0 ? WD : (Lk == 1 ? AD : VL)) + (ti * 16 + fr) * LS + fq;
                f32x4 acc = (f32x4){0.f, 0.f, 0.f, 0.f};
#pragma unroll
                for (int kk = 0; kk < 8; ++kk) acc = __builtin_amdgcn_mfma_f32_16x16x4f32(Xs[kk * 4], wg[q][kk], acc, 0, 0, 0);
                float* out = (Lk == 0 ? WLT : (Lk == 1 ? ALT : VGT)) + (tj * 16 + fr) * XTS + ti * 16 + fq * 4;
#pragma unroll
                for (int r = 0; r < 4; ++r) out[r] = acc[r];
            }
        }
        __syncthreads();
        const int tt = tid >> 3, j0 = (tid & 7) * 8, t = t0 + tt, cj0 = h * HD + j0;
        const size_t row = (size_t)b * SEQ + t;
        float rr[8], kk_[8], vv[8], aa[8], bb[8], lw[8];
        {
            const bool hp = t > 0;
            float wl[8], al[8], vg[8];
#pragma unroll
            for (int e = 0; e < 8; ++e) {
                const float r_c = bf2f((bf16_t)L.rc[e]), k_c = bf2f((bf16_t)L.kc[e]), v_c = bf2f((bf16_t)L.vc[e]);
                const float r_p = hp ? bf2f((bf16_t)L.rp[e]) : 0.f, k_p = hp ? bf2f((bf16_t)L.kp[e]) : 0.f, v_p = hp ? bf2f((bf16_t)L.vp[e]) : 0.f;
                rr[e] = r_c + (r_p - r_c) * mu[cj0 + e]; kk_[e] = k_c + (k_p - k_c) * mu[384 + cj0 + e]; vv[e] = v_c + (v_p - v_c) * mu[768 + cj0 + e];
                wl[e] = w0[cj0 + e] + WLT[(j0 + e) * XTS + tt]; al[e] = a0[cj0 + e] + ALT[(j0 + e) * XTS + tt]; vg[e] = l > 0 ? v0[cj0 + e] + VGT[(j0 + e) * XTS + tt] : 0.f;
            }
            float ssq = 0.f, bon = 0.f;
#pragma unroll
            for (int e = 0; e < 8; ++e) {
                const float sp2 = fmaxf(-wl[e], 0.f) * 1.4426950408889634f + __builtin_amdgcn_logf(1.0f + __builtin_amdgcn_exp2f(-1.4426950408889634f * fabsf(wl[e])));
                lw[e] = -__builtin_amdgcn_exp2f(-sp2 - 0.7213475204444817f);
                const float alr = __builtin_amdgcn_rcpf(1.0f + __builtin_amdgcn_exp2f(-1.4426950408889634f * al[e]));
                if (l > 0) { const float vf = e < 4 ? L.vf0[e & 3] : L.vf1[e & 3]; vv[e] = vv[e] + (vf - vv[e]) * __builtin_amdgcn_rcpf(1.0f + __builtin_amdgcn_exp2f(-1.4426950408889634f * vg[e])); }
                const float kkr = kk_[e] * kks[cj0 + e];
                kk_[e] = kk_[e] * (1.0f + (alr - 1.0f) * ka[cj0 + e]);
                aa[e] = kkr; bb[e] = alr; ssq += kkr * kkr; bon += rr[e] * kk_[e] * rk[cj0 + e];
            }
            if (l == 0) { __builtin_nontemporal_store((f32x4){vv[0], vv[1], vv[2], vv[3]}, (f32x4*)(VF + row * RWW + cj0)); __builtin_nontemporal_store((f32x4){vv[4], vv[5], vv[6], vv[7]}, (f32x4*)(VF + row * RWW + cj0 + 4)); }
            ssq += __shfl_xor(ssq, 1); ssq += __shfl_xor(ssq, 2); ssq += __shfl_xor(ssq, 4);
            bon += __shfl_xor(bon, 1); bon += __shfl_xor(bon, 2); bon += __shfl_xor(bon, 4);
            const float inv = fminf(__builtin_amdgcn_rsqf(ssq), 1e12f);
            uint4 bvw; float bv[8];
#pragma unroll
            for (int e = 0; e < 8; ++e) { const float kn = aa[e] * inv; aa[e] = -kn; bb[e] = kn * bb[e]; bv[e] = bon * vv[e]; CS[tt * CSS + j0 + e] = lw[e]; }
            bvw.x = pk2(bv[0], bv[1]); bvw.y = pk2(bv[2], bv[3]); bvw.z = pk2(bv[4], bv[5]); bvw.w = pk2(bv[6], bv[7]);
            *(uint4*)((bf16_t*)(p.ws + WS_CH_BV) + (size_t)jb * 4096 + tt * 64 + j0) = bvw;
        }
        __syncthreads();
#pragma unroll
        for (int e = 0; e < 8; ++e) {
            const int j = wave * 8 + e; float x = CS[lane * CSS + j];
#pragma unroll
            for (int o = 1; o < 64; o <<= 1) { const float y = __shfl_up(x, o); if (lane >= o) x += y; }
            CS[lane * CSS + j] = x;
        }
        __syncthreads();
        {
            float at[8], rt[8], bt[8], kt[8];
#pragma unroll
            for (int e = 0; e < 8; ++e) {
                const int j = j0 + e; const float cs = CS[tt * CSS + j] * 1.4426950408889634f, csC = CS[63 * CSS + j] * 1.4426950408889634f, lw2 = lw[e] * 1.4426950408889634f;
                const float e_in = __builtin_amdgcn_exp2f(cs), e_ex = __builtin_amdgcn_exp2f(cs - lw2), e_ng = __builtin_amdgcn_exp2f(-cs), e_ht = __builtin_amdgcn_exp2f(csC - cs);
                at[e] = aa[e] * e_ex; rt[e] = rr[e] * e_in; bt[e] = bb[e] * e_ng; kt[e] = kk_[e] * e_ng;
                T_VT[j * TS + tt] = f2bf(vv[e]); T_bhT[j * TS + tt] = f2bf(bb[e] * e_ht); T_khT[j * TS + tt] = f2bf(kk_[e] * e_ht);
                XT[j * XTS + tt] = at[e];
                if (tt == 63) PCv[j] = __builtin_amdgcn_exp2f(csC);
            }
            uint4 w;
            w.x = pk2(at[0], at[1]); w.y = pk2(at[2], at[3]); w.z = pk2(at[4], at[5]); w.w = pk2(at[6], at[7]); *(uint4*)(T_At + tt * TS + j0) = w;
            w.x = pk2(rt[0], rt[1]); w.y = pk2(rt[2], rt[3]); w.z = pk2(rt[4], rt[5]); w.w = pk2(rt[6], rt[7]); *(uint4*)(T_Rt + tt * TS + j0) = w;
            w.x = pk2(bt[0], bt[1]); w.y = pk2(bt[2], bt[3]); w.z = pk2(bt[4], bt[5]); w.w = pk2(bt[6], bt[7]); *(uint4*)(T_Bt + tt * TS + j0) = w;
            w.x = pk2(kt[0], kt[1]); w.y = pk2(kt[2], kt[3]); w.z = pk2(kt[4], kt[5]); w.w = pk2(kt[6], kt[7]); *(uint4*)(T_Kt + tt * TS + j0) = w;
        }
        __syncthreads();
        { const int hn = h + 1 < NH ? h + 1 : 0, gn = h + 1 < NH ? gi : gi + G; if (gn < NGRP) b1_issue_loads(p, l, gn, hn, tid, L); }
        {
            const int mat = wave >> 1;
            const bf16_t* As = (mat == 0 || mat == 2) ? T_Bt : T_Kt; const bf16_t* Bs = (mat < 2) ? T_At : T_Rt;
            bf16_t* dstb = (mat == 1 ? T_Aak : (mat == 2 ? T_Arb : T_Ark));
#pragma unroll
            for (int q = 0; q < 8; ++q) {
                const int ti = ((wave & 1) * 8 + q) >> 2, tj = q & 3;
                f32x4 acc = (f32x4){0.f, 0.f, 0.f, 0.f};
                if (ti <= tj) acc = mm_tile(As, ti * 16, Bs, tj * 16, 64, fr, fq, acc);
                const int tcol = tj * 16 + fr, i0 = ti * 16 + fq * 4;
                if (ti == tj) {
#pragma unroll
                    for (int r = 0; r < 4; ++r) { const bool keep = (mat < 2) ? (i0 + r < tcol) : (i0 + r <= tcol); if (!keep) acc[r] = 0.f; }
                }
                if (mat == 0) *(f32x4*)(Aab + tcol * AABS + i0) = acc;
                else *(uint2*)(dstb + tcol * TS + i0) = pk4(acc);
            }
        }
        __syncthreads();
        if (wave == 0) {
            const int blk = lane >> 4, cc = lane & 15; const float* ar = Aab + (16 * blk) * AABS + 16 * blk;
            float x[16];
#pragma unroll
            for (int u = 0; u < 16; ++u) { float v = (u == cc) ? 1.0f : 0.f;
#pragma unroll
                for (int i = 0; i < u; ++i) v += ar[u * AABS + i] * x[i];
                x[u] = v; }
#pragma unroll
            for (int u = 0; u < 16; ++u) TI[(blk * 16 + u) * 17 + cc] = x[u];
        } else {
#pragma unroll 1
            for (int id = wave - 1; id < 16; id += 7) {
                const int ti = id >> 2, tj = id & 3;
                f32x4 acc = mm_tile(T_Aak, ti * 16, T_VT, tj * 16, 64, fr, fq, (f32x4){0.f, 0.f, 0.f, 0.f});
                const int j = tj * 16 + fr, tr = ti * 16 + fq * 4;
#pragma unroll
                for (int r = 0; r < 4; ++r) XT[(64 + j) * XTS + tr + r] = acc[r];
            }
        }
        __syncthreads();
        {
            float* xc = XT + (wave * 16 + fr) * XTS;
#pragma unroll
            for (int I = 0; I < 4; ++I) {
                f32x4 acc;
#pragma unroll
                for (int r = 0; r < 4; ++r) acc[r] = xc[16 * I + 4 * fq + r];
#pragma unroll
                for (int J = 0; J < I; ++J)
#pragma unroll
                    for (int kk = 0; kk < 4; ++kk) acc = __builtin_amdgcn_mfma_f32_16x16x4f32(Aab[(16 * I + fr) * AABS + 16 * J + 4 * kk + fq], xc[16 * J + 4 * kk + fq], acc, 0, 0, 0);
#pragma unroll
                for (int r = 0; r < 4; ++r) xc[16 * I + 4 * fq + r] = acc[r];
                asm volatile("s_waitcnt lgkmcnt(0)" ::: "memory");
                f32x4 xs = (f32x4){0.f, 0.f, 0.f, 0.f};
#pragma unroll
                for (int kk = 0; kk < 4; ++kk) xs = __builtin_amdgcn_mfma_f32_16x16x4f32(TI[(I * 16 + fr) * 17 + 4 * kk + fq], xc[16 * I + 4 * kk + fq], xs, 0, 0, 0);
                asm volatile("s_waitcnt lgkmcnt(0)" ::: "memory");
#pragma unroll
                for (int r = 0; r < 4; ++r) xc[16 * I + 4 * fq + r] = xs[r];
                asm volatile("s_waitcnt lgkmcnt(0)" ::: "memory");
            }
        }
        __syncthreads();
        {
            const int col = tid >> 2, tg = (tid & 3) * 16;
            const float* xr = XT + col * XTS + tg; bf16_t* dst = (col < 64 ? T_WT + col * TS : T_U0T + (col - 64) * TS) + tg;
            uint4 w0_, w1_;
            w0_.x = pk2(xr[0], xr[1]); w0_.y = pk2(xr[2], xr[3]); w0_.z = pk2(xr[4], xr[5]); w0_.w = pk2(xr[6], xr[7]);
            w1_.x = pk2(xr[8], xr[9]); w1_.y = pk2(xr[10], xr[11]); w1_.z = pk2(xr[12], xr[13]); w1_.w = pk2(xr[14], xr[15]);
            *(uint4*)dst = w0_; *(uint4*)(dst + 8) = w1_;
        }
        __syncthreads();
        {
            bf16_t* gM = (bf16_t*)(p.ws + WS_CH_M) + (size_t)jb * 4096; bf16_t* gNT = (bf16_t*)(p.ws + WS_CH_NT) + (size_t)jb * 4096;
            bf16_t* gG = (bf16_t*)(p.ws + WS_CH_G) + (size_t)jb * 4096; bf16_t* gY1T = (bf16_t*)(p.ws + WS_CH_Y1T) + (size_t)jb * 4096;
            const int mat = wave >> 1;
            const bf16_t* A1 = (mat == 0 || mat == 2) ? T_WT : (mat == 1 ? T_U0T : T_bhT);
            const bf16_t* B1 = (mat == 0 || mat == 1) ? T_Arb : (mat == 2 ? T_bhT : T_U0T);
            const bf16_t* A2 = mat == 1 ? T_VT : T_khT; const bf16_t* B2 = mat == 1 ? T_Ark : T_VT;
            bf16_t* gdst = mat == 0 ? gG : (mat == 1 ? gY1T : (mat == 2 ? gM : gNT));
#pragma unroll
            for (int q = 0; q < 8; ++q) {
                const int ti = ((wave & 1) * 8 + q) >> 2, tj = q & 3;
                const int col = tj * 16 + fr, r0 = ti * 16 + fq * 4;
                f32x4 acc = mm_tile(A1, ti * 16, B1, tj * 16, 64, fr, fq, (f32x4){0.f, 0.f, 0.f, 0.f});
                if (mat & 1) acc = mm_tile(A2, ti * 16, B2, tj * 16, 64, fr, fq, acc);
                if (mat == 0) {
                    const uint2 rw = *(const uint2*)(T_Rt + col * TS + r0);
                    acc[0] += bf2f((bf16_t)(rw.x & 0xffff)); acc[1] += bf2f((bf16_t)(rw.x >> 16)); acc[2] += bf2f((bf16_t)(rw.y & 0xffff)); acc[3] += bf2f((bf16_t)(rw.y >> 16));
                } else if (mat == 2 && ti == tj) {
                    const float pc = PCv[col];
#pragma unroll
                    for (int r = 0; r < 4; ++r) if (r0 + r == col) acc[r] += pc;
                }
                *(uint2*)(gdst + col * 64 + r0) = pk4(acc);
            }
        }
        __syncthreads();
        if (h == NH - 1) gi += G;
    }
}

__device__ void rwkv_b2_job(const Params& p, int bh, unsigned char* lds) {
    const int tid = tid_(), lane = tid & 63, wave = __builtin_amdgcn_readfirstlane(tid >> 6), fr = lane & 15, fq = lane >> 4;
    const int mi = wave >> 1, nj0 = (wave & 1) * 2;
    const bf16_t* gM = (const bf16_t*)(p.ws + WS_CH_M); const bf16_t* gNT = (const bf16_t*)(p.ws + WS_CH_NT); bf16_t* gZT = (bf16_t*)(p.ws + WS_ZT);
    bf16_t* zbuf = (bf16_t*)lds;
    f32x4 z[2];
    z[0] = (f32x4){0.f, 0.f, 0.f, 0.f}; z[1] = z[0];
    const int c0 = mi * 16 + fq * 4;
    bf16x8 am[2]; uint2 nw[2];
    {
        const size_t jb = (size_t)bh * 32;
#pragma unroll
        for (int kk = 0; kk < 2; ++kk) am[kk] = *(const bf16x8*)(gM + jb * 4096 + (mi * 16 + fr) * 64 + kk * 32 + fq * 8);
#pragma unroll
        for (int q = 0; q < 2; ++q) nw[q] = *(const uint2*)(gNT + jb * 4096 + ((nj0 + q) * 16 + fr) * 64 + c0);
    }
#pragma unroll 1
    for (int c = 0; c < SEQ / 64; ++c) {
        const size_t jb = (size_t)bh * 32 + c;
        bf16_t* zh = zbuf + (c & 1) * 2 * 64 * TS; bf16_t* zl = zh + 64 * TS;
#pragma unroll
        for (int q = 0; q < 2; ++q) {
            const int j = (nj0 + q) * 16 + fr;
            const uint2 hi = pk4(z[q]);
            f32x4 lo;
            lo[0] = z[q][0] - bf2f((bf16_t)(hi.x & 0xffff)); lo[1] = z[q][1] - bf2f((bf16_t)(hi.x >> 16)); lo[2] = z[q][2] - bf2f((bf16_t)(hi.y & 0xffff)); lo[3] = z[q][3] - bf2f((bf16_t)(hi.y >> 16));
            *(uint2*)(zh + j * TS + c0) = hi; *(uint2*)(zl + j * TS + c0) = pk4(lo);
            *(uint2*)(gZT + jb * 4096 + j * 64 + c0) = hi;
        }
        bf16x8 amn[2]; uint2 nwn[2];
        {
            const size_t jn = (size_t)bh * 32 + (c + 1 < SEQ / 64 ? c + 1 : c);
#pragma unroll
            for (int kk = 0; kk < 2; ++kk) amn[kk] = *(const bf16x8*)(gM + jn * 4096 + (mi * 16 + fr) * 64 + kk * 32 + fq * 8);
#pragma unroll
            for (int q = 0; q < 2; ++q) nwn[q] = *(const uint2*)(gNT + jn * 4096 + ((nj0 + q) * 16 + fr) * 64 + c0);
        }
        __syncthreads();
#pragma unroll
        for (int q = 0; q < 2; ++q) {
            const int j = (nj0 + q) * 16 + fr;
            f32x4 acc; acc[0] = bf2f((bf16_t)(nw[q].x & 0xffff)); acc[1] = bf2f((bf16_t)(nw[q].x >> 16)); acc[2] = bf2f((bf16_t)(nw[q].y & 0xffff)); acc[3] = bf2f((bf16_t)(nw[q].y >> 16));
#pragma unroll
            for (int kk = 0; kk < 2; ++kk) {
                const bf16x8 bh_ = *(const bf16x8*)(zh + j * TS + kk * 32 + fq * 8), bl_ = *(const bf16x8*)(zl + j * TS + kk * 32 + fq * 8);
                acc = __builtin_amdgcn_mfma_f32_16x16x32_bf16(am[kk], bh_, acc, 0, 0, 0);
                acc = __builtin_amdgcn_mfma_f32_16x16x32_bf16(am[kk], bl_, acc, 0, 0, 0);
            }
            z[q] = acc;
        }
        am[0] = amn[0]; am[1] = amn[1]; nw[0] = nwn[0]; nw[1] = nwn[1];
    }
    __syncthreads();
}

__device__ void rwkv_b3_pair(const Params& p, int l, int pair) {
    const int tid = tid_(), lane = tid & 63, wave = __builtin_amdgcn_readfirstlane(tid >> 6), fr = lane & 15, fq = lane >> 4;
    const int jb = pair * 2 + (wave >> 2), mi = wave & 3;
    const int bh = jb >> 5, c = jb & 31, b = bh / NH, h = bh % NH;
    const bf16_t* gG = (const bf16_t*)(p.ws + WS_CH_G) + (size_t)jb * 4096; const bf16_t* gY1 = (const bf16_t*)(p.ws + WS_CH_Y1T) + (size_t)jb * 4096;
    const bf16_t* gBV = (const bf16_t*)(p.ws + WS_CH_BV) + (size_t)jb * 4096; const bf16_t* gZT = (const bf16_t*)(p.ws + WS_ZT) + (size_t)jb * 4096;
    const bf16_t* PG = (const bf16_t*)(p.ws + WS_PG); bf16_t* MIX = (bf16_t*)(p.ws + WS_MIX);
    const float* gng = p.in[19] + l * RWW + h * HD; const float* gnb = p.in[20] + l * RWW + h * HD;
    const int tt = mi * 16 + fr; const size_t row = (size_t)b * SEQ + c * 64 + tt;
    bf16x8 bg[2];
#pragma unroll
    for (int kk = 0; kk < 2; ++kk) bg[kk] = __builtin_nontemporal_load((const bf16x8*)(gG + tt * 64 + kk * 32 + fq * 8));
    uint2 yw[4], bw[4], gw[4];
#pragma unroll
    for (int nj = 0; nj < 4; ++nj) { const int j0 = nj * 16 + fq * 4;
        yw[nj] = ldnt_u2((const void*)(gY1 + tt * 64 + j0)); bw[nj] = ldnt_u2((const void*)(gBV + tt * 64 + j0)); gw[nj] = ldnt_u2((const void*)(PG + row * PG_W + h * HD + j0)); }
    f32x4 acc[4];
#pragma unroll
    for (int nj = 0; nj < 4; ++nj) {
        acc[nj][0] = bf2f((bf16_t)(yw[nj].x & 0xffff)); acc[nj][1] = bf2f((bf16_t)(yw[nj].x >> 16)); acc[nj][2] = bf2f((bf16_t)(yw[nj].y & 0xffff)); acc[nj][3] = bf2f((bf16_t)(yw[nj].y >> 16));
#pragma unroll
        for (int kk = 0; kk < 2; ++kk) { const bf16x8 az = *(const bf16x8*)(gZT + (nj * 16 + fr) * 64 + kk * 32 + fq * 8); acc[nj] = __builtin_amdgcn_mfma_f32_16x16x32_bf16(az, bg[kk], acc[nj], 0, 0, 0); }
    }
    float s = 0.f;
#pragma unroll
    for (int nj = 0; nj < 4; ++nj) s += (acc[nj][0] + acc[nj][1]) + (acc[nj][2] + acc[nj][3]);
    s += __shfl_xor(s, 16); s += __shfl_xor(s, 32);
    const float mean = s * (1.0f / HD);
    float vs = 0.f;
#pragma unroll
    for (int nj = 0; nj < 4; ++nj) { acc[nj] = acc[nj] - mean; vs += (acc[nj][0] * acc[nj][0] + acc[nj][1] * acc[nj][1]) + (acc[nj][2] * acc[nj][2] + acc[nj][3] * acc[nj][3]); }
    vs += __shfl_xor(vs, 16); vs += __shfl_xor(vs, 32);
    const float rstd = rsqrtf(vs * (1.0f / HD) + GN_EPS);
#pragma unroll
    for (int nj = 0; nj < 4; ++nj) {
        const int j0 = nj * 16 + fq * 4;
        const f32x4 gg = *(const f32x4*)(gng + j0), gb = *(const f32x4*)(gnb + j0);
        const float bv0 = bf2f((bf16_t)(bw[nj].x & 0xffff)), bv1 = bf2f((bf16_t)(bw[nj].x >> 16)), bv2 = bf2f((bf16_t)(bw[nj].y & 0xffff)), bv3 = bf2f((bf16_t)(bw[nj].y >> 16));
        const float g0 = bf2f((bf16_t)(gw[nj].x & 0xffff)), g1 = bf2f((bf16_t)(gw[nj].x >> 16)), g2 = bf2f((bf16_t)(gw[nj].y & 0xffff)), g3 = bf2f((bf16_t)(gw[nj].y >> 16));
        const float o0 = acc[nj][0] * rstd * gg[0] + gb[0] + bv0, o1 = acc[nj][1] * rstd * gg[1] + gb[1] + bv1, o2 = acc[nj][2] * rstd * gg[2] + gb[2] + bv2, o3 = acc[nj][3] * rstd * gg[3] + gb[3] + bv3;
        uint2 w; w.x = pk2(o0 * siluf_(g0), o1 * siluf_(g1)); w.y = pk2(o2 * siluf_(g2), o3 * siluf_(g3));
        *(uint2*)(MIX + row * DM + CW + SBW + h * HD + j0) = w;
    }
}

#ifndef ATTN_REF
#define ATTN_REF 0
#endif
#ifndef RWKV_REF
#define RWKV_REF 0
#endif
constexpr int N_ATT_JOBS = BATCH * NH * 8, N_CONV_JOBS = BATCH * (SEQ / 64), N_CHAINS = BATCH * NH;
__device__ __forceinline__ void run_side_job(const Params& p, int l, int id, unsigned char* lds) {
    if (id < N_ATT_JOBS) attn_wg_job(p, id, lds); else conv_job64(p, l, id - N_ATT_JOBS, lds);
}
__device__ void phase_mix1(const Params& p, int l, unsigned char* lds) {
    rwkv_b1_phase(p, l, lds);
    if (!defer_layer1_weights()) for (int id = blockIdx.x; id < N_ATT_JOBS + N_CONV_JOBS; id += gridDim.x) run_side_job(p, l, id, lds);
}
__device__ void phase_mix2(const Params& p, int l, unsigned char* lds) {
    const int G = gridDim.x, w = blockIdx.x, NJ = N_ATT_JOBS + N_CONV_JOBS;
    if (!defer_layer1_weights()) { for (int job = w; job < N_CHAINS; job += G) rwkv_b2_job(p, job, lds); return; }
    const bool prep = l + 1 < DEPTH;
    const int nlow = prep ? 5 : 4;
    if (w < N_CHAINS) {
        rwkv_b2_job(p, w, lds);
        for (int s_ = 0; s_ < nlow; ++s_) { const int id = s_ * N_CHAINS + w; if (id < NJ) run_side_job(p, l, id, lds); }
    } else {
        if (prep) prep_weights(p, l + 1, lds, w - N_CHAINS, G - N_CHAINS);
        for (int id = nlow * N_CHAINS + (w - N_CHAINS); id < NJ; id += G - N_CHAINS) run_side_job(p, l, id, lds);
    }
}
__device__ void phase_mix3(const Params& p, int l, unsigned char* lds) {
#if !RWKV_REF
    for (int rep = 0; rep < ((PROBE_REP & 16) ? 2 : 1); ++rep)
    for (int pair = blockIdx.x; pair < BATCH * NH * 16; pair += gridDim.x) rwkv_b3_pair(p, l, pair);
#endif
}

#define LAS __attribute__((address_space(3)))
#define XB_TMO      128
#define XB_XCNT(j)  (256  + 64 * (j))
#define XB_XSUB(j)  (1280 + 64 * (j))
#define XB_XGEN(j)  (2304 + 64 * (j))
#define XB_TOP      3328
#define XB_TOPGEN   3392
#define XCD_BAR_WORDS 3456
#define XB_SPIN_CAP (1u << 18)

__device__ __forceinline__ unsigned xb_ld(unsigned* p)              { return __hip_atomic_load(p, __ATOMIC_RELAXED, __HIP_MEMORY_SCOPE_AGENT); }
__device__ __forceinline__ unsigned xb_add(unsigned* p, unsigned v) { return __hip_atomic_fetch_add(p, v, __ATOMIC_RELAXED, __HIP_MEMORY_SCOPE_AGENT); }
__device__ __forceinline__ unsigned xb_xcc_id() { return (unsigned)__builtin_amdgcn_s_getreg((3 << 11) | 20) & 0xFu; }
#define XB_SPIN(cond, bar) do { unsigned _sp = 0; while (cond) { __builtin_amdgcn_s_sleep(1); \
    if ((++_sp & 255u) == 0u) { if (xb_ld(&(bar)[XB_TMO])) break; if (_sp > XB_SPIN_CAP) { atomicAdd(&(bar)[XB_TMO], 1u); break; } } } } while (0)

struct XcdBarrier {
    unsigned* bar; unsigned x;
    volatile LAS unsigned* st;
};

__device__ __forceinline__ XcdBarrier xcd_barrier_post(unsigned* bar, volatile LAS unsigned* st) {
    XcdBarrier b; b.bar = bar; b.x = xb_xcc_id(); b.st = st;
    if (threadIdx.x == 0) (void)xb_add(&bar[XB_XCNT(b.x)], 1u);
    return b;
}
__device__ __forceinline__ void xcd_barrier_complete(unsigned* bar, unsigned x, unsigned& nloc, unsigned& nx) {
    const unsigned G = gridDim.x * gridDim.y * gridDim.z;
    unsigned sum, cnt, mine, sp = 0u;
    for (;;) {
        sum = 0u; cnt = 0u; mine = 0u;
#pragma unroll
        for (unsigned j = 0; j < 16; ++j) { const unsigned c = xb_ld(&bar[XB_XCNT(j)]); sum += c; cnt += (c > 0u) ? 1u : 0u; mine = (j == x) ? c : mine; }
        if (sum == G) break;
        __builtin_amdgcn_s_sleep(1);
        if ((++sp & 255u) == 0u) { if (xb_ld(&bar[XB_TMO])) break; if (sp > XB_SPIN_CAP) { atomicAdd(&bar[XB_TMO], 1u); break; } }
    }
    nloc = mine > 0u ? mine : 1u; nx = cnt > 0u ? cnt : 1u;
}

__device__ __forceinline__ void xcd_barrier(const XcdBarrier& b) {
    asm volatile("s_waitcnt vmcnt(0)" ::: "memory");
    __syncthreads();
    if (threadIdx.x == 0) {
        unsigned* bar = b.bar;
        __builtin_amdgcn_s_waitcnt(0);
        unsigned nloc = b.st[0], nx = b.st[1];
        if (nloc == 0u) { xcd_barrier_complete(bar, b.x, nloc, nx); b.st[0] = nloc; b.st[1] = nx; }
        const unsigned old = xb_add(&bar[XB_XSUB(b.x)], 1u);
        const unsigned gen = old / nloc;
        if (old + 1u == (gen + 1u) * nloc) {
            __builtin_amdgcn_fence(__ATOMIC_RELEASE, "agent");
            asm volatile("s_waitcnt vmcnt(0)" ::: "memory");
            const unsigned og = xb_add(&bar[XB_TOP], 1u);
            const unsigned tg = og / nx;
            if (og + 1u == (tg + 1u) * nx) xb_add(&bar[XB_TOPGEN], 1u);
            else XB_SPIN(xb_ld(&bar[XB_TOPGEN]) == tg, bar);
            __builtin_amdgcn_fence(__ATOMIC_ACQUIRE, "agent");
            xb_add(&bar[XB_XGEN(b.x)], 1u);
            asm volatile("s_waitcnt vmcnt(0)" ::: "memory");
        } else {
            XB_SPIN(xb_ld(&bar[XB_XGEN(b.x)]) == gen, bar);
            __builtin_amdgcn_fence(__ATOMIC_ACQUIRE, "agent");
            asm volatile("s_waitcnt vmcnt(0)" ::: "memory");
        }
    }
    __syncthreads();
}

constexpr int PH_PER_LAYER = 6;
constexpr int N_PHASES = 1 + PH_PER_LAYER * DEPTH;
__device__ __forceinline__ void run_phase(const Params& p, int ph, unsigned char* lds) {
    unsigned char* ws = p.ws;
    if (ph == 0) { for (int rep = 0; rep < ((PROBE_REP & 4096) ? 2 : 1); ++rep) phase_prologue(p, lds); return; }
    const int l = (ph - 1) / PH_PER_LAYER, k = (ph - 1) % PH_PER_LAYER;
    if (k == 0) {
        EpiInProjP E{(bf16_t*)(ws + WS_PC), (bf16_t*)(ws + WS_PS), (bf16_t*)(ws + WS_PR), (bf16_t*)(ws + WS_PG), (bf16_t*)(ws + WS_VT)};
        pg8::Gemm g{(const bf16_t*)(ws + WS_XB), (const bf16_t*)(ws + WS_WIN) + (size_t)l * NINT * DM, M, NINT, DM}; pg8::StaticOrder S; S.init(M, NINT, (int)gridDim.x, (int)blockIdx.x);
        for (int rep = 0; rep < ((PROBE_REP & 32) ? 2 : 1); ++rep)
        pg8::gemm_phase<EpiInProjP, pg8::StaticOrder, true, true>((PG8_LAS unsigned char*)lds, g, S, E);
    } else if (k == 1) {
        phase_mix1(p, l, lds);
    } else if (k == 2) {
        phase_mix2(p, l, lds);
    } else if (k == 3) {
        phase_mix3(p, l, lds);
    } else if (k == 4) {
        EpiOutBf16P E{(bf16_t*)(ws + WS_Y), DM};
        pg8::Gemm g{(const bf16_t*)(ws + WS_MIX), (const bf16_t*)(ws + WS_WOUT) + (size_t)l * DM * DM, M, DM, DM}; pg8::StaticOrder S; S.init(M, DM, (int)gridDim.x, (int)blockIdx.x);
        for (int rep = 0; rep < ((PROBE_REP & 64) ? 2 : 1); ++rep)
        pg8::gemm_phase<EpiOutBf16P, pg8::StaticOrder, true, true>((PG8_LAS unsigned char*)lds, g, S, E);
    } else {
        for (int rep = 0; rep < ((PROBE_REP & 8192) && l == 0 ? 2 : 1); ++rep)
        phase_rowpass(l == 0 ? p.in[0] : p.out, (const bf16_t*)(ws + WS_Y), p.in[2] + l * DM, p.out, l + 1 < DEPTH ? (bf16_t*)(ws + WS_XB) : nullptr);
    }
}

static_assert(10 * TILE_B + 64 * AABS * 4 + 128 * XTS * 4 + 64 * 4 + 4 * 16 * 17 * 4 <= 147456, "B1 LDS map");
constexpr int LDS_BYTES = 147456 + 256;

constexpr int MISC_OFF = 147456;
#if MK_COOP == 2
__global__ void __launch_bounds__(512, 2) fwd_kernel(Params p) {
    extern __shared__ __attribute__((aligned(16))) unsigned char lds[];
    volatile LAS unsigned* misc = (volatile LAS unsigned*)((LAS unsigned char*)lds + MISC_OFF);
    if (threadIdx.x < 16) misc[threadIdx.x] = 0u;
    __syncthreads();
    XcdBarrier bar = xcd_barrier_post((unsigned*)(p.ws + WS_CTL), misc);
    for (int ph = p.ph_lo; ph < p.ph_hi; ++ph) {
        run_phase(p, ph, lds);
        if (ph + 1 < p.ph_hi) xcd_barrier(bar);
        if ((PROBE_REP & 32768) && ph == 3) for (int rep = 0; rep < 20; ++rep) xcd_barrier(bar);
    }
}
#elif MK_COOP == 1
__global__ void __launch_bounds__(512, 2) fwd_kernel(Params p) {
    extern __shared__ __attribute__((aligned(16))) unsigned char lds[];
    cg::grid_group grid = cg::this_grid();
    for (int ph = p.ph_lo; ph < p.ph_hi; ++ph) {
        run_phase(p, ph, lds);
        if (ph + 1 < p.ph_hi) grid.sync();
    }
}
#else
__global__ void __launch_bounds__(512, 2) fwd_kernel(Params p) {
    extern __shared__ __attribute__((aligned(16))) unsigned char lds[];
    for (int ph = p.ph_lo; ph < p.ph_hi; ++ph) run_phase(p, ph, lds);
}
#endif

extern "C" void kernel_launch(void* const* d_in, const int* in_sizes, int n_in, void* d_out, int out_size, void* d_ws, size_t ws_size, hipStream_t stream) {
    static int grid = 0;
    if (grid == 0) {
        if (n_in != 24 || out_size != M * DM || ws_size < WS_END) { fprintf(stderr, "kernel_launch: unexpected problem (n_in %d out %d ws %zu)\n", n_in, out_size, ws_size); grid = -1; return; }
        int dev = 0, cus = 0, per_cu = 0;
        hipGetDevice(&dev); hipDeviceGetAttribute(&cus, hipDeviceAttributeMultiprocessorCount, dev);
        hipFuncSetAttribute((const void*)fwd_kernel, hipFuncAttributeMaxDynamicSharedMemorySize, LDS_BYTES);
        hipOccupancyMaxActiveBlocksPerMultiprocessor(&per_cu, (const void*)fwd_kernel, 512, LDS_BYTES);
        if (per_cu < 1) { fprintf(stderr, "kernel_launch: occupancy query says %d blocks per CU\n", per_cu); per_cu = 1; }
        grid = cus;
        (void)hipGetLastError();
    }
    if (grid < 0) return;
    Params p{};
    for (int i = 0; i < 24; ++i) p.in[i] = (const float*)d_in[i];
    p.out = (float*)d_out; p.ws = (unsigned char*)d_ws;
#if MK_COOP == 2
    p.ph_lo = 0; p.ph_hi = N_PHASES;
    if (hipMemsetAsync((char*)d_ws + WS_CTL, 0, XCD_BAR_WORDS * 4, stream) != hipSuccess) { fprintf(stderr, "kernel_launch: memset of the barrier words failed\n"); return; }
    hipLaunchKernelGGL(fwd_kernel, dim3(grid), dim3(512), LDS_BYTES, stream, p);
#elif MK_COOP == 1
    p.ph_lo = 0; p.ph_hi = N_PHASES;
    void* args[] = {&p};
    hipError_t e = hipLaunchCooperativeKernel((const void*)fwd_kernel, dim3(grid), dim3(512), args, LDS_BYTES, stream);
    if (e != hipSuccess) fprintf(stderr, "cooperative launch failed: %s (grid %d)\n", hipGetErrorString(e), grid);
#else
    for (int ph = 0; ph < N_PHASES; ++ph) {
        p.ph_lo = ph; p.ph_hi = ph + 1;
        hipLaunchKernelGGL(fwd_kernel, dim3(grid), dim3(512), LDS_BYTES, stream, p);
    }
#endif
}
```

```cpp
#include <hip/hip_runtime.h>
#include <hip/hip_cooperative_groups.h>
#include <cstdio>
#include <cstdint>
namespace cg = cooperative_groups;

#ifndef MK_COOP
#define MK_COOP 2
#endif

constexpr int BATCH = 16, SEQ = 2048, DM = 1024, DEPTH = 2;
constexpr int M = BATCH * SEQ;
constexpr int HD = 64, NH = 6;
constexpr int CW = 256, SBW = 384, RWW = 384, LORA = 32, TAPS = 31;
constexpr int DIN = 3904;
constexpr int NINT = 4096;
constexpr int PC_W = 768, PS_W = 1152, PR_W = 1280, PG_W = 384;
constexpr float RMS_EPS = 1e-6f, LN_EPS = 1e-5f, GN_EPS = 64e-5f;

typedef unsigned short bf16_t;
typedef short bf16x8 __attribute__((ext_vector_type(8)));
typedef float f32x4 __attribute__((ext_vector_type(4)));
typedef unsigned short us4 __attribute__((ext_vector_type(4)));

constexpr size_t MiB = 1u << 20;
constexpr size_t WS_CTL = 0;
constexpr size_t WS_WPW = 512 * 1024;
constexpr size_t WS_WIN = 1 * MiB;
constexpr size_t WS_WOUT = 17 * MiB;
constexpr size_t WS_XB = 21 * MiB;
constexpr size_t WS_MIX = WS_XB;
constexpr size_t WS_PC = 85 * MiB;
constexpr size_t WS_PS = 133 * MiB;
constexpr size_t WS_VT = 205 * MiB;
constexpr size_t WS_Y = WS_PC;
constexpr size_t WS_PR = 229 * MiB;
constexpr size_t WS_PG = 309 * MiB;
constexpr size_t WS_VF = 333 * MiB;
constexpr size_t WS_CH = 381 * MiB;
constexpr size_t CH_SZ = (size_t)3072 * 4096 * 2;
constexpr size_t WS_CH_M = WS_CH, WS_CH_NT = WS_CH + CH_SZ, WS_CH_G = WS_CH + 2 * CH_SZ, WS_CH_Y1T = WS_CH + 3 * CH_SZ, WS_CH_BV = WS_CH + 4 * CH_SZ;
constexpr size_t WS_ZT = WS_PR;
constexpr size_t WS_END = 501 * MiB;

struct Params {
    const float* in[24];
    float* out;
    unsigned char* ws;
    int ph_lo, ph_hi;
};

__device__ __forceinline__ float bf2f(bf16_t v) { return __uint_as_float(((unsigned)v) << 16); }
typedef float f32x2_t __attribute__((ext_vector_type(2)));
typedef __bf16 bf16x2_t __attribute__((ext_vector_type(2)));
__device__ __forceinline__ unsigned pk2(float lo, float hi) { f32x2_t v = {lo, hi}; bf16x2_t b = __builtin_convertvector(v, bf16x2_t); return __builtin_bit_cast(unsigned, b); }
__device__ __forceinline__ bf16_t f2bf(float f) { return (bf16_t)(pk2(f, f) & 0xffffu); }
__device__ __forceinline__ float wave_sum(float v) {
#pragma unroll
    for (int o = 1; o < 64; o <<= 1) v += __shfl_xor(v, o);
    return v;
}
__device__ __forceinline__ float sigmoidf_(float x) { return 1.0f / (1.0f + __expf(-x)); }
__device__ __forceinline__ float siluf_(float x) { return x / (1.0f + __expf(-x)); }
__device__ __forceinline__ int tid_() { int t = threadIdx.x; asm volatile("" : "+v"(t)); return t; }
typedef unsigned u32x2_t __attribute__((ext_vector_type(2)));
__device__ __forceinline__ uint2 ldnt_u2(const void* p) { const u32x2_t v = __builtin_nontemporal_load((const u32x2_t*)p); uint2 r; r.x = v[0]; r.y = v[1]; return r; }

__device__ __forceinline__ int orig_col(int n) { return n < 3520 ? n : (n < 3584 ? -1 : (n < 3968 ? n - 64 : -1)); }

__device__ void transpose_tile(const float* W, int ldw, int ncol_src, const float* gain, bf16_t* WT, int K, int n0, int k0, bool permute, float* tile  , bool skip_fold_rows = false) {
    const int tid = tid_();
#pragma unroll
    for (int i = 0; i < 8; ++i) {
        const int kl = (tid >> 6) + 8 * i, nl = tid & 63;
        const int n = n0 + nl, k = k0 + kl;
        const int oc = permute ? orig_col(n) : n;
        float v = 0.f;
        if (oc >= 0 && oc < ncol_src) v = W[(size_t)k * ldw + oc] * (gain ? gain[k] : 1.0f);
        if (permute && n >= 768 && n < 1152) v *= 0.125f * 1.4426950408889634f;
        tile[kl * 65 + nl] = v;
    }
    __syncthreads();
#pragma unroll
    for (int i = 0; i < 8; ++i) {
        const int nl = (tid >> 6) + 8 * i, kl = tid & 63;
        if (!(skip_fold_rows && n0 + nl >= 3520 && n0 + nl < 3584)) WT[(size_t)(n0 + nl) * K + k0 + kl] = f2bf(tile[kl * 65 + nl]);
    }
    __syncthreads();
}
__device__ void fold_v1_rows(const Params& p, int l, bf16_t* WinT_l, float* scr, int worker, int nworkers) {
    const int tid = tid_(), lane = tid & 63, wave = __builtin_amdgcn_readfirstlane(tid >> 6);
    const float* W = p.in[3] + (size_t)l * DM * DIN; const float* gain = p.in[1] + l * DM; const float* v1 = p.in[22] + (size_t)(l - 1) * RWW * LORA; const float* muv = p.in[11] + l * 1216 + 768;
    float* V1c = scr;
    float* Wr = scr + RWW * 64 + wave * RWW;
    for (int idx = tid; idx < RWW * 64; idx += 512) { const int c = idx >> 6, o = idx & 63; const float m = muv[c]; V1c[idx] = (o >= 32 ? m : 1.0f - m) * v1[c * LORA + (o & 31)]; }
    __syncthreads();
    for (int k = worker * 8 + wave; k < DM; k += nworkers * 8) {
        const float* wr = W + (size_t)k * DIN + 3072;
#pragma unroll
        for (int i = 0; i < 6; ++i) Wr[lane + 64 * i] = wr[lane + 64 * i];
        asm volatile("s_waitcnt lgkmcnt(0)" ::: "memory");
        float a0 = 0.f, a1 = 0.f, a2 = 0.f, a3 = 0.f;
#pragma unroll 4
        for (int c4 = 0; c4 < RWW / 4; ++c4) { const f32x4 w = *(const f32x4*)(Wr + 4 * c4);
            a0 += w[0] * V1c[(4 * c4) * 64 + lane]; a1 += w[1] * V1c[(4 * c4 + 1) * 64 + lane]; a2 += w[2] * V1c[(4 * c4 + 2) * 64 + lane]; a3 += w[3] * V1c[(4 * c4 + 3) * 64 + lane]; }
        WinT_l[(size_t)(3520 + lane) * DM + k] = f2bf(((a0 + a1) + (a2 + a3)) * gain[k]);
        asm volatile("s_waitcnt lgkmcnt(0)" ::: "memory");
    }
    __syncthreads();
}
__device__ void prep_weights(const Params& p, int l, unsigned char* lds, int worker, int nworkers) {
    float* tile = (float*)lds;
    bf16_t* WinT = (bf16_t*)(p.ws + WS_WIN) + (size_t)l * NINT * DM; bf16_t* WoutT = (bf16_t*)(p.ws + WS_WOUT) + (size_t)l * DM * DM; bf16_t* WpwT = (bf16_t*)(p.ws + WS_WPW) + (size_t)l * CW * CW;
    const int nt_in = (NINT / 64) * (DM / 64), nt_out = (DM / 64) * (DM / 64), nt_pw = (CW / 64) * (CW / 64);
    for (int j = worker; j < nt_in + nt_out + nt_pw; j += nworkers) {
        if (j < nt_in) transpose_tile(p.in[3] + (size_t)l * DM * DIN, DIN, DIN, p.in[1] + l * DM, WinT, DM, (j / (DM / 64)) * 64, (j % (DM / 64)) * 64, true, tile, l > 0);
        else if (j < nt_in + nt_out) { const int r = j - nt_in; transpose_tile(p.in[4] + (size_t)l * DM * DM, DM, DM, nullptr, WoutT, DM, (r / (DM / 64)) * 64, (r % (DM / 64)) * 64, false, tile); }
        else { const int r = j - nt_in - nt_out; transpose_tile(p.in[9] + (size_t)l * CW * CW, CW, CW, nullptr, WpwT, CW, (r >> 2) * 64, (r & 3) * 64, false, tile); }
    }
    if (l > 0) fold_v1_rows(p, l, WinT, tile, worker, nworkers);
}

__device__ void rows_to_xb(const float* X, bf16_t* XB) {
    const int tid = tid_(), lane = tid & 63, wave = __builtin_amdgcn_readfirstlane(tid >> 6);
    for (int row = blockIdx.x * 8 + wave; row < M; row += gridDim.x * 8) {
        const float* xr = X + (size_t)row * DM;
        f32x4 v[4]; float ss = 0.f;
#pragma unroll
        for (int i = 0; i < 4; ++i) { v[i] = __builtin_nontemporal_load((const f32x4*)(xr + i * 256 + lane * 4)); ss += v[i][0] * v[i][0] + v[i][1] * v[i][1] + v[i][2] * v[i][2] + v[i][3] * v[i][3]; }
        ss = wave_sum(ss);
        const float rstd = rsqrtf(ss * (1.0f / DM) + RMS_EPS);
#pragma unroll
        for (int i = 0; i < 4; ++i) { uint2 w; w.x = pk2(v[i][0] * rstd, v[i][1] * rstd); w.y = pk2(v[i][2] * rstd, v[i][3] * rstd); *(uint2*)(XB + (size_t)row * DM + i * 256 + lane * 4) = w; }
    }
}

__device__ __forceinline__ bool defer_layer1_weights() { return gridDim.x >= BATCH * NH + 32; }
__device__ void phase_prologue(const Params& p, unsigned char* lds) {
    prep_weights(p, 0, lds, blockIdx.x, gridDim.x);
    if (!defer_layer1_weights()) for (int l = 1; l < DEPTH; ++l) prep_weights(p, l, lds, blockIdx.x, gridDim.x);
    rows_to_xb(p.in[0], (bf16_t*)(p.ws + WS_XB));
}

namespace pg8 {
#define PG8_LAS __attribute__((address_space(3)))
typedef unsigned short bf16_t;
typedef short bf16x8 __attribute__((ext_vector_type(8)));
typedef float f32x4 __attribute__((ext_vector_type(4)));
typedef unsigned u32x4 __attribute__((ext_vector_type(4)));
constexpr int BM = 256, BK = 64, HALF = 128, HTB = HALF * BK * 2  , STAGE_BYTES = 8 * HTB, NXCD = 8, WGM = 8;

__host__ __device__ __forceinline__ int lds_byte(int r, int c) { const int st = (r >> 4) * 2 + (c >> 5), rr = r & 15, cc = c & 31, ob = rr * 64 + cc * 2; return st * 1024 + (ob ^ (((ob >> 9) & 1) << 5)); }
__host__ __device__ __forceinline__ void stage_rc(int b, int& R, int& C) { const int st = b / 1024, sb = b % 1024, swz = sb ^ (((sb >> 9) & 1) << 5); R = (st >> 1) * 16 + swz / 64; C = (st & 1) * 32 + (swz % 64) / 2; }
__host__ __device__ __forceinline__ int perm32(int rho) { const int n = rho >> 4, i = rho & 15; return 8 * (i >> 2) + 4 * n + (i & 3); }

struct Unit { int pm, pn; };
struct Gemm { const bf16_t* A; const bf16_t* Bt; int M, N, K; };

struct StaticOrder {
    int nM, nN, nwg, G, c;
    __host__ __device__ void init(int M, int N, int G_, int c_) { nM = M / BM; nN = N / BM; nwg = nM * nN; G = G_; c = c_; }
    __host__ __device__ bool next(int i, Unit& u) const {
        const long L = (long)i * G + c; if (L >= nwg) return false;
        int wgid = (int)L; { const int q = nwg / NXCD, r = nwg % NXCD, xcd = wgid % NXCD, off = wgid / NXCD; wgid = (xcd < r ? xcd * (q + 1) : r * (q + 1) + (xcd - r) * q) + off; }
        const int nig = WGM * nN, gid = wgid / nig, fm = gid * WGM, gsz = (nM - fm) < WGM ? (nM - fm) : WGM;
        u.pm = fm + ((wgid % nig) % gsz); u.pn = (wgid % nig) / gsz; return true;
    }
    __device__ __forceinline__ void a_ready(const Unit&) const {}
    __device__ __forceinline__ void done(const Unit&) const {}
};


__device__ __forceinline__ unsigned cvt_pk_bf16(float lo, float hi) { unsigned r; asm volatile("v_cvt_pk_bf16_f32 %0, %1, %2" : "=v"(r) : "v"(lo), "v"(hi)); return r; }

template <class Epi, class Sched, bool ALIGN_EPI = false, bool SP2 = false>
__device__ __forceinline__ void gemm_phase(PG8_LAS unsigned char* lds, const Gemm g, const Sched& S, const Epi& E) {
    const int tid = tid_(), wid = __builtin_amdgcn_readfirstlane(tid >> 6), lane = tid & 63, wr = wid >> 2, wc = wid & 3, fr = lane & 15, fq = lane >> 4;
    const int K = g.K, nt = K / BK;
    unsigned voffA[2], voffB[2];
#pragma unroll
    for (int i = 0; i < 2; ++i) { int R, C; stage_rc(tid * 16 + i * 8192, R, C); const int Rb = Epi::PERM ? ((R & ~31) + perm32(R & 31)) : R;
        voffA[i] = (unsigned)(R * K + C) * 2u; voffB[i] = (unsigned)(Rb * K + C) * 2u; }
    const size_t kstep = (size_t)(BK * 2);
    const size_t hstep = (size_t)HALF * K * 2;
    const size_t tstep = 2 * hstep;
    const unsigned ldsw = (unsigned)wid * 1024u;
    const int aoff = lds_byte(wr * 64 + fr, fq * 8), boff = lds_byte(wc * 32 + fr, fq * 8);
#define PG8_SA(b, h) (((b) * 2 + (h)) * HTB)
#define PG8_SB(b, h) ((4 + (b) * 2 + (h)) * HTB)
#define PG8_STAGE(bufoff, gbase, voff) do { _Pragma("unroll") for (int _i = 0; _i < 2; ++_i) \
        __builtin_amdgcn_global_load_lds((const unsigned*)((const char*)(gbase) + (voff)[_i]), (PG8_LAS unsigned*)(lds + (bufoff) + ldsw + _i * 8192), 16, 0, 0); } while (0)
#define PG8_LDA(dst, b, h) do { _Pragma("unroll") for (int m = 0; m < 4; ++m) _Pragma("unroll") for (int k = 0; k < 2; ++k) dst[m][k] = *(const PG8_LAS bf16x8*)(lds + PG8_SA(b, h) + aoff + m * 2048 + k * 1024); } while (0)
#define PG8_LDB(dst, b, h) do { _Pragma("unroll") for (int n = 0; n < 2; ++n) _Pragma("unroll") for (int k = 0; k < 2; ++k) dst[n][k] = *(const PG8_LAS bf16x8*)(lds + PG8_SB(b, h) + boff + n * 2048 + k * 1024); } while (0)
#define PG8_MMA(ai, bj, At, Bt) do { __builtin_amdgcn_s_setprio(1); _Pragma("unroll") for (int m = 0; m < 4; ++m) _Pragma("unroll") for (int n = 0; n < 2; ++n) _Pragma("unroll") for (int k = 0; k < 2; ++k) \
        acc[ai][bj][m][n] = __builtin_amdgcn_mfma_f32_16x16x32_bf16(Bt[n][k], At[m][k], acc[ai][bj][m][n], 0, 0, 0); __builtin_amdgcn_s_setprio(0); } while (0)
#define PG8_WAIT_V(n) asm volatile("s_waitcnt vmcnt(" #n ")" ::: "memory")
#define PG8_WAIT_L(n) asm volatile("s_waitcnt lgkmcnt(" #n ")" ::: "memory")
#define PG8_BAR __builtin_amdgcn_s_barrier()
#define PG8_SCHED __builtin_amdgcn_sched_barrier(0)
    Unit cur, nxt; int ui = 0;
    if (!S.next(0, cur)) return;
    f32x4 acc[2][2][4][2];
#pragma unroll
    for (int a = 0; a < 2; ++a)
#pragma unroll
        for (int b = 0; b < 2; ++b)
#pragma unroll
            for (int m = 0; m < 4; ++m)
#pragma unroll
                for (int n = 0; n < 2; ++n) acc[a][b][m][n] = (f32x4){0.f, 0.f, 0.f, 0.f};
    bf16x8 At[4][2], B0[2][2], B1[2][2];
    const char* cA = (const char*)g.A + (size_t)cur.pm * tstep; const char* cB = (const char*)g.Bt + (size_t)cur.pn * tstep;
    S.a_ready(cur);
    if constexpr (SP2) {
        PG8_STAGE(PG8_SB(0, 0), cB, voffB); PG8_STAGE(PG8_SB(0, 1), cB + hstep, voffB); PG8_STAGE(PG8_SA(0, 0), cA, voffA); PG8_STAGE(PG8_SA(0, 1), cA + hstep, voffA);
        if (wr == 1) PG8_BAR;
        PG8_WAIT_V(2); PG8_BAR;
        PG8_STAGE(PG8_SB(1, 0), cB + kstep, voffB); PG8_STAGE(PG8_SA(1, 0), cA + kstep, voffA); PG8_STAGE(PG8_SB(1, 1), cB + hstep + kstep, voffB);
        PG8_WAIT_V(6); PG8_BAR;
    } else {
        PG8_STAGE(PG8_SB(0, 0), cB, voffB); PG8_STAGE(PG8_SA(0, 0), cA, voffA); PG8_STAGE(PG8_SB(0, 1), cB + hstep, voffB); PG8_STAGE(PG8_SA(0, 1), cA + hstep, voffA);
        if (wr == 1) PG8_BAR;
        PG8_WAIT_V(4); PG8_BAR;
        PG8_STAGE(PG8_SB(1, 0), cB + kstep, voffB); PG8_STAGE(PG8_SA(1, 0), cA + kstep, voffA); PG8_STAGE(PG8_SB(1, 1), cB + hstep + kstep, voffB);
        PG8_WAIT_V(6); PG8_BAR;
    }
    for (;;) {
        const bool has_next = S.next(ui + 1, nxt);
        const char* nA = has_next ? (const char*)g.A + (size_t)nxt.pm * tstep : cA; const char* nB = has_next ? (const char*)g.Bt + (size_t)nxt.pn * tstep : cB;
        for (int t = 0; t < nt; t += 2) {
            const bool last = (t == nt - 2);
            const char* a1 = cA + (size_t)(t + 1) * kstep;
            const char* a2 = last ? nA : cA + (size_t)(t + 2) * kstep; const char* b2 = last ? nB : cB + (size_t)(t + 2) * kstep;
            const char* a3 = a2 + kstep; const char* b3 = b2 + kstep;
            if (last && has_next) S.a_ready(nxt);
            if constexpr (SP2) {
            PG8_LDB(B0, 0, 0); PG8_LDB(B1, 0, 1); PG8_SCHED; PG8_LDA(At, 0, 0); PG8_STAGE(PG8_SA(1, 1), a1 + hstep, voffA);
            PG8_WAIT_V(8); PG8_WAIT_L(0); PG8_BAR; PG8_MMA(0, 0, At, B0); PG8_MMA(0, 1, At, B1); PG8_BAR; PG8_SCHED;
            PG8_LDA(At, 0, 1); PG8_STAGE(PG8_SB(0, 0), b2, voffB); PG8_STAGE(PG8_SB(0, 1), b2 + hstep, voffB); PG8_STAGE(PG8_SA(0, 0), a2, voffA);
            PG8_WAIT_V(8); PG8_WAIT_L(0); PG8_BAR; PG8_MMA(1, 0, At, B0); PG8_MMA(1, 1, At, B1); PG8_BAR; PG8_SCHED;
            PG8_LDB(B0, 1, 0); PG8_LDB(B1, 1, 1); PG8_SCHED; PG8_LDA(At, 1, 0); PG8_STAGE(PG8_SA(0, 1), a2 + hstep, voffA);
            PG8_WAIT_V(8); PG8_WAIT_L(0); PG8_BAR; PG8_MMA(0, 0, At, B0); PG8_MMA(0, 1, At, B1); PG8_BAR; PG8_SCHED;
            PG8_LDA(At, 1, 1); PG8_STAGE(PG8_SB(1, 0), b3, voffB); PG8_STAGE(PG8_SB(1, 1), b3 + hstep, voffB); PG8_STAGE(PG8_SA(1, 0), a3, voffA);
            PG8_WAIT_V(8); PG8_WAIT_L(0); PG8_BAR; PG8_MMA(1, 0, At, B0); PG8_MMA(1, 1, At, B1); PG8_BAR; PG8_SCHED;
            } else {
            PG8_LDB(B0, 0, 0); PG8_SCHED; PG8_LDA(At, 0, 0); PG8_STAGE(PG8_SA(1, 1), a1 + hstep, voffA);
            PG8_WAIT_L(8); PG8_BAR; PG8_WAIT_L(0); PG8_MMA(0, 0, At, B0); PG8_BAR; PG8_SCHED;
            PG8_LDB(B1, 0, 1); PG8_STAGE(PG8_SB(0, 0), b2, voffB);
            PG8_BAR; PG8_WAIT_L(0); PG8_MMA(0, 1, At, B1); PG8_BAR;
            PG8_LDA(At, 0, 1); PG8_STAGE(PG8_SA(0, 0), a2, voffA);
            PG8_BAR; PG8_WAIT_L(0); PG8_MMA(1, 0, At, B0); PG8_BAR; PG8_SCHED;
            PG8_STAGE(PG8_SB(0, 1), b2 + hstep, voffB);
            PG8_WAIT_V(6); PG8_BAR; PG8_MMA(1, 1, At, B1); PG8_BAR;
            PG8_LDB(B0, 1, 0); PG8_SCHED; PG8_LDA(At, 1, 0); PG8_STAGE(PG8_SA(0, 1), a2 + hstep, voffA);
            PG8_WAIT_L(8); PG8_BAR; PG8_WAIT_L(0); PG8_MMA(0, 0, At, B0); PG8_BAR; PG8_SCHED;
            PG8_LDB(B1, 1, 1); PG8_STAGE(PG8_SB(1, 0), b3, voffB);
            PG8_BAR; PG8_WAIT_L(0); PG8_MMA(0, 1, At, B1); PG8_BAR;
            PG8_LDA(At, 1, 1); PG8_STAGE(PG8_SA(1, 0), a3, voffA);
            PG8_BAR; PG8_WAIT_L(0); PG8_MMA(1, 0, At, B0); PG8_BAR; PG8_SCHED;
            PG8_STAGE(PG8_SB(1, 1), b3 + hstep, voffB);
            PG8_WAIT_V(6); PG8_BAR; PG8_MMA(1, 1, At, B1); PG8_BAR;
            }
        }
        if constexpr (ALIGN_EPI) { if (wr == 0) PG8_BAR; }
        if constexpr (!Epi::AFTER_DRAIN) { E(acc, cur, wr, wc, fr, fq); S.done(cur); }
        if (!has_next) break;
#pragma unroll
        for (int a = 0; a < 2; ++a)
#pragma unroll
            for (int b = 0; b < 2; ++b)
#pragma unroll
                for (int m = 0; m < 4; ++m)
#pragma unroll
                    for (int n = 0; n < 2; ++n) acc[a][b][m][n] = (f32x4){0.f, 0.f, 0.f, 0.f};
        cur = nxt; cA = nA; cB = nB; ++ui;
        if constexpr (ALIGN_EPI) { if (wr == 1) PG8_BAR; }
    }
    PG8_WAIT_V(0);
    if constexpr (!ALIGN_EPI) { if (wr == 0) PG8_BAR; }
    PG8_BAR;
    if constexpr (Epi::AFTER_DRAIN) { E.fused(acc, cur, wr, wc, fr, fq, lds, wid, lane); S.done(cur); }
#undef PG8_SA
#undef PG8_SB
#undef PG8_STAGE
#undef PG8_LDA
#undef PG8_LDB
#undef PG8_MMA
#undef PG8_WAIT_V
#undef PG8_WAIT_L
#undef PG8_BAR
#undef PG8_SCHED
}
}

struct EpiInProjP {
    static constexpr bool PERM = true, AFTER_DRAIN = false;
    bf16_t *PC, *PS, *PR, *PG, *VT;
    __device__ __forceinline__ void operator()(const pg8::f32x4 (&acc)[2][2][4][2], const pg8::Unit& u, int wr, int wc, int fr, int fq) const {
        const int row0 = u.pm * 256 + wr * 64 + fr;
#pragma unroll
        for (int bj = 0; bj < 2; ++bj) {
            const int blk = 2 * u.pn + bj; bf16_t* base; int ld, c0;
            if (blk >= 12 && blk < 15) {
                const int vc = 128 * (blk - 12) + wc * 32 + 8 * fq;
#pragma unroll
                for (int ai = 0; ai < 2; ++ai)
#pragma unroll
                    for (int m = 0; m < 4; ++m) {
                        const int row = row0 + ai * 128 + m * 16, b = row >> 11, t = row & 2047;
#pragma unroll
                        for (int n = 0; n < 2; ++n)
#pragma unroll
                            for (int e = 0; e < 4; ++e) { const int col = vc + 4 * n + e, hh = col >> 6, d = col & 63;
                                VT[((size_t)(b * NH + hh) * HD + d) * SEQ + t] = f2bf(acc[ai][bj][m][n][e]); }
                    }
                continue;
            }
            if (blk < 6) { base = PC; ld = PC_W; c0 = 128 * blk; }
            else if (blk < 12) { base = PS; ld = PS_W; c0 = 128 * (blk - 6); }
            else if (blk < 18) { base = PS; ld = PS_W; c0 = 768 + 128 * (blk - 15); }
            else if (blk < 28) { base = PR; ld = PR_W; c0 = 128 * (blk - 18); }
            else if (blk < 31) { base = PG; ld = PG_W; c0 = 128 * (blk - 28); }
            else continue;
            const int col = c0 + wc * 32 + 8 * fq;
#pragma unroll
            for (int ai = 0; ai < 2; ++ai)
#pragma unroll
                for (int m = 0; m < 4; ++m) {
                    const pg8::f32x4 v0 = acc[ai][bj][m][0], v1 = acc[ai][bj][m][1]; pg8::u32x4 w;
                    w.x = pg8::cvt_pk_bf16(v0[0], v0[1]); w.y = pg8::cvt_pk_bf16(v0[2], v0[3]); w.z = pg8::cvt_pk_bf16(v1[0], v1[1]); w.w = pg8::cvt_pk_bf16(v1[2], v1[3]);
                    *(pg8::u32x4*)(base + (size_t)(row0 + ai * 128 + m * 16) * ld + col) = w;
                }
        }
    }
};
struct EpiOutBf16P {
    static constexpr bool PERM = true, AFTER_DRAIN = false;
    bf16_t* Y; int ld;
    __device__ __forceinline__ void operator()(const pg8::f32x4 (&acc)[2][2][4][2], const pg8::Unit& u, int wr, int wc, int fr, int fq) const {
        const int row0 = u.pm * 256 + wr * 64 + fr, col0 = u.pn * 256 + wc * 32 + 8 * fq;
#pragma unroll
        for (int ai = 0; ai < 2; ++ai)
#pragma unroll
            for (int m = 0; m < 4; ++m)
#pragma unroll
                for (int bj = 0; bj < 2; ++bj) {
                    const pg8::f32x4 v0 = acc[ai][bj][m][0], v1 = acc[ai][bj][m][1]; pg8::u32x4 w;
                    w.x = pg8::cvt_pk_bf16(v0[0], v0[1]); w.y = pg8::cvt_pk_bf16(v0[2], v0[3]); w.z = pg8::cvt_pk_bf16(v1[0], v1[1]); w.w = pg8::cvt_pk_bf16(v1[2], v1[3]);
                    *(pg8::u32x4*)(Y + (size_t)(row0 + ai * 128 + m * 16) * ld + col0 + bj * 128) = w;
                }
    }
};

__device__ void phase_rowpass(const float* Xin, const bf16_t* Y, const float* gpost, float* Xout, bf16_t* XB) {
    const int tid = tid_(), lane = tid & 63, wave = __builtin_amdgcn_readfirstlane(tid >> 6);
    for (int row = blockIdx.x * 8 + wave; row < M; row += gridDim.x * 8) {
        f32x4 y[4], x[4]; float ss = 0.f;
#pragma unroll
        for (int i = 0; i < 4; ++i) { const uint2 yw = ldnt_u2((const void*)(Y + (size_t)row * DM + i * 256 + lane * 4));
            y[i] = (f32x4){bf2f((bf16_t)(yw.x & 0xffff)), bf2f((bf16_t)(yw.x >> 16)), bf2f((bf16_t)(yw.y & 0xffff)), bf2f((bf16_t)(yw.y >> 16))};
            x[i] = __builtin_nontemporal_load((const f32x4*)(Xin + (size_t)row * DM + i * 256 + lane * 4));
            ss += y[i][0] * y[i][0] + y[i][1] * y[i][1] + y[i][2] * y[i][2] + y[i][3] * y[i][3]; }
        ss = wave_sum(ss);
        const float rstd = rsqrtf(ss * (1.0f / DM) + RMS_EPS);
        float s2 = 0.f;
#pragma unroll
        for (int i = 0; i < 4; ++i) { const f32x4 g = *(const f32x4*)(gpost + i * 256 + lane * 4);
            x[i] = x[i] + y[i] * rstd * g; s2 += x[i][0] * x[i][0] + x[i][1] * x[i][1] + x[i][2] * x[i][2] + x[i][3] * x[i][3];
            __builtin_nontemporal_store(x[i], (f32x4*)(Xout + (size_t)row * DM + i * 256 + lane * 4)); }
        if (XB) {
            s2 = wave_sum(s2);
            const float r2 = rsqrtf(s2 * (1.0f / DM) + RMS_EPS);
#pragma unroll
            for (int i = 0; i < 4; ++i) { uint2 w; w.x = pk2(x[i][0] * r2, x[i][1] * r2); w.y = pk2(x[i][2] * r2, x[i][3] * r2); *(uint2*)(XB + (size_t)row * DM + i * 256 + lane * 4) = w; }
        }
    }
}

constexpr int CV_AS = 264;
__device__ void conv_job64(const Params& p, int l, int job, unsigned char* lds) {
    const int tid = tid_(), lane = tid & 63, wave = __builtin_amdgcn_readfirstlane(tid >> 6), fr = lane & 15, fq = lane >> 4;
    const int b = job >> 5, t0 = (job & 31) * 64;
    const bf16_t* PC = (const bf16_t*)(p.ws + WS_PC); bf16_t* MIX = (bf16_t*)(p.ws + WS_MIX);
    const float* dw = p.in[5] + l * TAPS * CW; const float* dwb = p.in[6] + l * CW; const float* lng = p.in[7] + l * CW; const float* lnb = p.in[8] + l * CW;
    const bf16_t* pwT = (const bf16_t*)(p.ws + WS_WPW) + (size_t)l * CW * CW; const float* pwb = p.in[10] + l * CW;
    float* u = (float*)lds;
    bf16_t* act = (bf16_t*)(lds + 94 * 256 * 4);
    for (int idx = tid; idx < 94 * 32; idx += 512) {
        const int r = idx >> 5, c8 = (idx & 31) * 8, t = t0 - 30 + r;
        float v[8];
        if (t >= 0) { const bf16_t* pr = PC + ((size_t)b * SEQ + t) * PC_W + c8; const bf16x8 a = *(const bf16x8*)pr, g = *(const bf16x8*)(pr + 256);
#pragma unroll
            for (int e = 0; e < 8; ++e) v[e] = bf2f((bf16_t)a[e]) * __builtin_amdgcn_rcpf(1.0f + __builtin_amdgcn_exp2f(-1.4426950408889634f * bf2f((bf16_t)g[e]))); }
        else {
#pragma unroll
            for (int e = 0; e < 8; ++e) v[e] = 0.f; }
        *(f32x4*)(u + r * 256 + c8) = (f32x4){v[0], v[1], v[2], v[3]}; *(f32x4*)(u + r * 256 + c8 + 4) = (f32x4){v[4], v[5], v[6], v[7]};
    }
    __syncthreads();
    const int c = tid & 255, half = tid >> 8;
    float acc[32];
    {
        float w[TAPS];
#pragma unroll
        for (int j = 0; j < TAPS; ++j) w[j] = dw[j * CW + c];
        const float bias = dwb[c];
#pragma unroll
        for (int i = 0; i < 32; ++i) acc[i] = bias;
        const float* up = u + (half * 32) * 256 + c;
#pragma unroll
        for (int rr = 0; rr < 62; ++rr) {
            const float uv = up[rr * 256];
#pragma unroll
            for (int i = 0; i < 32; ++i) { if (rr - i >= 0 && rr - i < TAPS) acc[i] += w[rr - i] * uv; }
        }
    }
    __syncthreads();
    float* cv = u;
#pragma unroll
    for (int i = 0; i < 32; ++i) cv[(half * 32 + i) * 256 + c] = acc[i];
    __syncthreads();
#pragma unroll 2
    for (int q = 0; q < 8; ++q) {
        const int tt = wave * 8 + q; const f32x4 x = *(const f32x4*)(cv + tt * 256 + lane * 4);
        const float mean = wave_sum(x[0] + x[1] + x[2] + x[3]) * (1.0f / CW);
        const f32x4 d = x - mean;
        const float rstd = rsqrtf(wave_sum(d[0] * d[0] + d[1] * d[1] + d[2] * d[2] + d[3] * d[3]) * (1.0f / CW) + LN_EPS);
        const f32x4 g = *(const f32x4*)(lng + lane * 4), bb = *(const f32x4*)(lnb + lane * 4);
        float y[4];
#pragma unroll
        for (int e = 0; e < 4; ++e) { const float v = d[e] * rstd * g[e] + bb[e]; y[e] = v * __builtin_amdgcn_rcpf(1.0f + __builtin_amdgcn_exp2f(-1.4426950408889634f * v)); }
        uint2 w; w.x = pk2(y[0], y[1]); w.y = pk2(y[2], y[3]); *(uint2*)(act + tt * CV_AS + lane * 4) = w;
    }
    __syncthreads();
    {
        f32x4 o[2][4];
#pragma unroll
        for (int i = 0; i < 2; ++i)
#pragma unroll
            for (int j = 0; j < 4; ++j) o[i][j] = (f32x4){0.f, 0.f, 0.f, 0.f};
#pragma unroll 2
        for (int kk = 0; kk < 8; ++kk) {
            bf16x8 a[2], bq[4];
#pragma unroll
            for (int i = 0; i < 2; ++i) a[i] = *(const bf16x8*)(pwT + (size_t)(wave * 32 + i * 16 + fr) * CW + kk * 32 + fq * 8);
#pragma unroll
            for (int j = 0; j < 4; ++j) bq[j] = *(const bf16x8*)(act + (j * 16 + fr) * CV_AS + kk * 32 + fq * 8);
#pragma unroll
            for (int i = 0; i < 2; ++i)
#pragma unroll
                for (int j = 0; j < 4; ++j) o[i][j] = __builtin_amdgcn_mfma_f32_16x16x32_bf16(a[i], bq[j], o[i][j], 0, 0, 0);
        }
#pragma unroll
        for (int i = 0; i < 2; ++i) {
            const int n0 = wave * 32 + i * 16 + fq * 4; const f32x4 bias = *(const f32x4*)(pwb + n0);
#pragma unroll
            for (int j = 0; j < 4; ++j) {
                const size_t row = (size_t)b * SEQ + t0 + j * 16 + fr;
                const uint2 gw = *(const uint2*)(PC + row * PC_W + 512 + n0);
                const float g0 = bf2f((bf16_t)(gw.x & 0xffff)), g1 = bf2f((bf16_t)(gw.x >> 16)), g2 = bf2f((bf16_t)(gw.y & 0xffff)), g3 = bf2f((bf16_t)(gw.y >> 16));
                const f32x4 v = o[i][j] + bias;
                uint2 w; w.x = pk2(v[0] * siluf_(g0), v[1] * siluf_(g1)); w.y = pk2(v[2] * siluf_(g2), v[3] * siluf_(g3));
                *(uint2*)(MIX + row * DM + n0) = w;
            }
        }
    }
    __syncthreads();
}

typedef float f32x16 __attribute__((ext_vector_type(16)));
struct AttFrag { bf16x8 K[4], V[2][2]; };
constexpr int AT_WIN = 224;
constexpr int AT_KS = 144, AT_VS = 976;
constexpr int AT_VOFF = (AT_WIN + 256) * AT_KS;
static_assert(AT_VOFF + 64 * AT_VS <= 147456, "attention LDS map");
__device__ __forceinline__ void att_load(AttFrag& F, const bf16_t* kbase, const bf16_t* vbase, const unsigned char* klds, const unsigned char* vlds, int w0, int kt) {
    const int s0 = (kt > 0 ? kt : 0) * 32;
    if (s0 >= w0) {
        const unsigned char* kp = klds + (s0 - w0) * AT_KS; const unsigned char* vp = vlds + (s0 - w0) * 2;
#pragma unroll
        for (int ks = 0; ks < 4; ++ks) F.K[ks] = *(const bf16x8*)(kp + ks * 32);
#pragma unroll
        for (int db = 0; db < 2; ++db)
#pragma unroll
            for (int s = 0; s < 2; ++s) F.V[db][s] = *(const bf16x8*)(vp + db * 32 * AT_VS + s * 16);
    } else {
#pragma unroll
        for (int ks = 0; ks < 4; ++ks) F.K[ks] = *(const bf16x8*)(kbase + (size_t)s0 * PS_W + ks * 16);
#pragma unroll
        for (int db = 0; db < 2; ++db)
#pragma unroll
            for (int s = 0; s < 2; ++s) F.V[db][s] = *(const bf16x8*)(vbase + (size_t)db * 32 * SEQ + s0 + s * 8);
    }
}
__device__ __forceinline__ bool att_tile(const AttFrag& F, const bf16x8 (&Qf)[4], f32x16& O0, f32x16& O1, float& rp, bool diag, int qi, int hf) {
    f32x16 S;
#pragma unroll
    for (int r = 0; r < 16; ++r) S[r] = 0.f;
#pragma unroll
    for (int ks = 0; ks < 4; ++ks) S = __builtin_amdgcn_mfma_f32_32x32x16_bf16(F.K[ks], Qf[ks], S, 0, 0, 0);
    float tot = 1.0f;
#pragma unroll
    for (int r = 0; r < 16; ++r) {
        float k_ = __builtin_amdgcn_rcpf(1.0f + __builtin_amdgcn_exp2f(S[r]));
        if (diag && (hf * 16 + r >= qi)) k_ = 1.0f;
        S[r] = k_; tot *= k_;
    }
    const float toto = __shfl_xor(tot, 32);
    float e = hf ? rp : rp * toto;
#pragma unroll
    for (int r = 15; r >= 0; --r) { const float k_ = S[r]; S[r] = (1.0f - k_) * e; e *= k_; }
    rp = rp * tot * toto;
    bf16x8 Pf[2];
#pragma unroll
    for (int s = 0; s < 2; ++s) {
        union { bf16x8 v; unsigned u[4]; } pk;
#pragma unroll
        for (int j = 0; j < 4; ++j) pk.u[j] = pk2(S[8 * s + 2 * j], S[8 * s + 2 * j + 1]);
        Pf[s] = pk.v;
    }
#pragma unroll
    for (int s = 0; s < 2; ++s) { O0 = __builtin_amdgcn_mfma_f32_32x32x16_bf16(F.V[0][s], Pf[s], O0, 0, 0, 0); O1 = __builtin_amdgcn_mfma_f32_32x32x16_bf16(F.V[1][s], Pf[s], O1, 0, 0, 0); }
    return __ballot(rp != 0.0f) == 0ull;
}
__device__ void attn_wg_job(const Params& p, int job, unsigned char* lds) {
    const int tid = tid_(), lane = tid & 63, wave = __builtin_amdgcn_readfirstlane(tid >> 6), qi = lane & 31, hf = lane >> 5;
    const int bh = job >> 3, g = job & 7, b = bh / NH, h = bh % NH;
    const bf16_t* PS = (const bf16_t*)(p.ws + WS_PS); const bf16_t* VT = (const bf16_t*)(p.ws + WS_VT) + (size_t)bh * HD * SEQ; bf16_t* MIX = (bf16_t*)(p.ws + WS_MIX);
    const int w0 = g * 256 > AT_WIN ? g * 256 - AT_WIN : 0, nkeys = g * 256 + 256 - w0;
    unsigned char* klds = lds; unsigned char* vlds = lds + AT_VOFF;
    bf16x8 Qf[4];
#pragma unroll
    for (int ks = 0; ks < 4; ++ks) Qf[ks] = *(const bf16x8*)(PS + ((size_t)b * SEQ + (g * 8 + wave) * 32 + qi) * PS_W + h * HD + ks * 16 + hf * 8);
    {
        const bf16_t* ksrc = PS + ((size_t)b * SEQ + w0) * PS_W + SBW + h * HD;
        for (int idx = tid; idx < nkeys * 8; idx += 512) { const int row = idx >> 3, pc = idx & 7; *(uint4*)(klds + row * AT_KS + pc * 16) = *(const uint4*)(ksrc + (size_t)row * PS_W + pc * 8); }
        const int pc = tid & 63, npc = nkeys >> 3;
        if (pc < npc) {
#pragma unroll
            for (int i = 0; i < 8; ++i) { const int d = (tid >> 6) + 8 * i; *(uint4*)(vlds + d * AT_VS + pc * 16) = *(const uint4*)(VT + (size_t)d * SEQ + w0 + pc * 8); }
        }
    }
    __syncthreads();
    {
        const int qblk = g * 8 + wave, q0 = qblk * 32;
        const size_t rowq = (size_t)b * SEQ + q0 + qi;
        const int pi = (qi & 3) + 4 * (qi >> 3) + 16 * ((qi >> 2) & 1);
        const bf16_t* kbase = PS + ((size_t)b * SEQ + pi) * PS_W + SBW + h * HD + hf * 8;
        const bf16_t* vbase = VT + (size_t)qi * SEQ + hf * 16;
        const unsigned char* kl = klds + pi * AT_KS + hf * 16; const unsigned char* vl = vlds + qi * AT_VS + hf * 32;
        AttFrag FA, FB;
        att_load(FA, kbase, vbase, kl, vl, w0, qblk);
        f32x16 O0, O1;
#pragma unroll
        for (int r = 0; r < 16; ++r) { O0[r] = 0.f; O1[r] = 0.f; }
        float rp = 1.0f;
        for (int kt = qblk; kt >= 0; kt -= 2) {
            att_load(FB, kbase, vbase, kl, vl, w0, kt - 1);
            if (att_tile(FA, Qf, O0, O1, rp, kt == qblk, qi, hf) || kt < 1) break;
            att_load(FA, kbase, vbase, kl, vl, w0, kt - 2);
            if (att_tile(FB, Qf, O0, O1, rp, false, qi, hf)) break;
        }
        const bf16_t* gp = PS + rowq * PS_W + 768 + h * HD; bf16_t* op = MIX + rowq * DM + CW + h * HD;
#pragma unroll
        for (int db = 0; db < 2; ++db)
#pragma unroll
            for (int gq = 0; gq < 4; ++gq) {
                const int d0 = db * 32 + gq * 8 + hf * 4;
                const uint2 gw = *(const uint2*)(gp + d0);
                const float g0 = bf2f((bf16_t)(gw.x & 0xffff)), g1 = bf2f((bf16_t)(gw.x >> 16)), g2 = bf2f((bf16_t)(gw.y & 0xffff)), g3 = bf2f((bf16_t)(gw.y >> 16));
                const f32x16& O = db ? O1 : O0;
                uint2 w; w.x = pk2(O[4 * gq] * siluf_(g0), O[4 * gq + 1] * siluf_(g1)); w.y = pk2(O[4 * gq + 2] * siluf_(g2), O[4 * gq + 3] * siluf_(g3));
                *(uint2*)(op + d0) = w;
            }
    }
    __syncthreads();
}

constexpr int TS = 72;
constexpr int TILE_B = 64 * TS * 2;
constexpr int AABS = 68, XTS = 65, CSS = 65;

__device__ __forceinline__ f32x4 mm_tile(const bf16_t* X, int m0, const bf16_t* Yt, int n0, int K, int fr, int fq, f32x4 acc) {
#pragma unroll
    for (int kk = 0; kk < 2; ++kk) {
        if (kk * 32 < K) {
            const bf16x8 a = *(const bf16x8*)(X + (m0 + fr) * TS + kk * 32 + fq * 8);
            const bf16x8 b = *(const bf16x8*)(Yt + (n0 + fr) * TS + kk * 32 + fq * 8);
            acc = __builtin_amdgcn_mfma_f32_16x16x32_bf16(a, b, acc, 0, 0, 0);
        }
    }
    return acc;
}
__device__ __forceinline__ uint2 pk4(const f32x4& v) { uint2 w; w.x = pk2(v[0], v[1]); w.y = pk2(v[2], v[3]); return w; }

struct B1Loads {
    bf16x8 rc, kc, vc, rp, kp, vp;
    f32x4 vf0, vf1;
    bf16x8 cc[2], cp[2];
};
__device__ __forceinline__ void b1_issue_loads(const Params& p, int l, int gi, int h, int tid, B1Loads& L) {
    const int b = gi >> 5, c = gi & 31, t0 = c * 64;
    const bf16_t* PR = (const bf16_t*)(p.ws + WS_PR); const float* VF = (const float*)(p.ws + WS_VF);
    {
        const int tt = tid >> 3, j0 = (tid & 7) * 8, t = t0 + tt, cj0 = h * HD + j0; const size_t row = (size_t)b * SEQ + t;
        const bf16_t* cur = PR + row * PR_W; const bf16_t* prv = cur - (t > 0 ? PR_W : 0);
        L.rc = *(const bf16x8*)(cur + cj0); L.kc = *(const bf16x8*)(cur + 384 + cj0); L.vc = *(const bf16x8*)(cur + 768 + cj0);
        L.rp = *(const bf16x8*)(prv + cj0); L.kp = *(const bf16x8*)(prv + 384 + cj0); L.vp = *(const bf16x8*)(prv + 768 + cj0);
        if (l > 0) { L.vf0 = *(const f32x4*)(VF + row * RWW + cj0); L.vf1 = *(const f32x4*)(VF + row * RWW + cj0 + 4); }
    }
    if (h == 0) {
#pragma unroll
        for (int q = 0; q < 2; ++q) {
            const int item = tid + 512 * q, tt = item >> 4, g = item & 15, t = t0 + tt;
            const bf16_t* cur = PR + ((size_t)b * SEQ + t) * PR_W + 1152; const bf16_t* prv = cur - (t > 0 ? PR_W : 0);
            const int gc = g < 12 ? g : 0, gp = g < 8 ? g : (g < 12 ? g + 4 : 0);
            L.cc[q] = *(const bf16x8*)(cur + 8 * gc); L.cp[q] = *(const bf16x8*)(prv + 8 * gp);
        }
    }
}

__device__ void rwkv_b1_phase(const Params& p, int l, unsigned char* lds) {
    const int G = gridDim.x;
    float* VF = (float*)(p.ws + WS_VF);
    const float* mu = p.in[11] + l * 1216; const float* w0 = p.in[12] + l * RWW;
    const float* a0 = p.in[14] + l * RWW; const float* kks = p.in[16] + l * RWW; const float* ka = p.in[17] + l * RWW;
    const float* rk = p.in[18] + l * RWW; const float* v0 = p.in[21];
    const float* w2 = p.in[13] + l * LORA * RWW; const float* a2 = p.in[15] + l * LORA * RWW; const float* v2 = p.in[23];
    bf16_t* T_At = (bf16_t*)lds; bf16_t* T_Rt = T_At + 64 * TS; bf16_t* T_Bt = T_Rt + 64 * TS; bf16_t* T_Kt = T_Bt + 64 * TS;
    bf16_t* T_VT = T_Kt + 64 * TS; bf16_t* T_bhT = T_VT + 64 * TS; bf16_t* T_khT = T_bhT + 64 * TS;
    bf16_t* T_Aak = T_khT + 64 * TS; bf16_t* T_Arb = T_Aak + 64 * TS; bf16_t* T_Ark = T_Arb + 64 * TS;
    bf16_t* T_WT = T_At; bf16_t* T_U0T = T_Bt;
    float* Aab = (float*)(lds + 10 * TILE_B);
    float* XT = (float*)(lds + 10 * TILE_B + 64 * AABS * 4);
    float* PCv = XT + 128 * XTS;
    float* TI = PCv + 64;
    float* CS = (float*)T_Aak;
    constexpr int LS = 33;
    float* WD = Aab; float* AD = WD + 64 * LS;
    float* VL = XT + 64 * XTS;
    float* WLT = (float*)lds; float* ALT = WLT + 64 * XTS; float* VGT = ALT + 64 * XTS;

    constexpr int NGRP = BATCH * (SEQ / 64);
    int gi = blockIdx.x;
    if (gi >= NGRP) return;
    B1Loads L;
    b1_issue_loads(p, l, gi, 0, tid_(), L);
    float codes[2][8];
#pragma unroll 1
    for (int it = 0; gi < NGRP; ++it) {
        const int h = it % NH;
        const int tid = tid_(), lane = tid & 63, wave = __builtin_amdgcn_readfirstlane(tid >> 6), fr = lane & 15, fq = lane >> 4;
        const int b = gi >> 5, c = gi & 31, bh = b * NH + h, jb = bh * 32 + c, t0 = c * 64;
        float wg[6][8];
#pragma unroll
        for (int q = 0; q < 6; ++q) {
            const int id = wave + 8 * q, Lk = id >> 4, tj = id & 3;
            if (q < 4 || l > 0) {
                const float* Wg = (Lk == 0 ? w2 : (Lk == 1 ? a2 : v2)) + (size_t)fq * RWW + h * HD + tj * 16 + fr;
#pragma unroll
                for (int kk = 0; kk < 8; ++kk) wg[q][kk] = Wg[(size_t)kk * 4 * RWW];
            }
        }
#pragma unroll
        for (int q = 0; q < 2; ++q) {
            const int item = tid + 512 * q, tt = item >> 4, g = item & 15, t = t0 + tt; const bool hp = t > 0;
            if (h == 0) {
#pragma unroll
                for (int e = 0; e < 8; ++e) {
                    const float xc = bf2f((bf16_t)L.cc[q][e]), xp = hp ? bf2f((bf16_t)L.cp[q][e]) : 0.f;
                    const float x_ = xc + (xp - xc) * mu[1152 + 8 * (g & 7) + e];
                    codes[q][e] = g < 4 ? 1.0f - 2.0f * __builtin_amdgcn_rcpf(1.0f + __builtin_amdgcn_exp2f(2.8853900817779268f * x_)) : (g < 8 ? x_ : xc + xp);
                }
            }
            if (g < 8 || (g < 12 && l > 0)) {
                float* dst = (g < 4 ? WD + tt * LS + 8 * g : (g < 8 ? AD + tt * LS + 8 * (g - 4) : VL + tt * LS + 8 * (g - 8)));
#pragma unroll
                for (int e = 0; e < 8; ++e) dst[e] = codes[q][e];
            }
        }
        __syncthreads();
#pragma unroll
        for (int q = 0; q < 6; ++q) {
            if (q < 4 || l > 0) {
                const int id = wave + 8 * q, Lk = id >> 4, ti = (id >> 2) & 3, tj = id & 3;
                const float* Xs = (Lk == 0 ? WD : (Lk == 1 ? AD : VL)) + (ti * 16 + fr) * LS + fq;
                f32x4 acc = (f32x4){0.f, 0.f, 0.f, 0.f};
#pragma unroll
                for (int kk = 0; kk < 8; ++kk) acc = __builtin_amdgcn_mfma_f32_16x16x4f32(Xs[kk * 4], wg[q][kk], acc, 0, 0, 0);
                float* out = (Lk == 0 ? WLT : (Lk == 1 ? ALT : VGT)) + (tj * 16 + fr) * XTS + ti * 16 + fq * 4;
#pragma unroll
                for (int r = 0; r < 4; ++r) out[r] = acc[r];
            }
        }
        __syncthreads();
        const int tt = tid >> 3, j0 = (tid & 7) * 8, t = t0 + tt, cj0 = h * HD + j0;
        const size_t row = (size_t)b * SEQ + t;
        float rr[8], kk_[8], vv[8], aa[8], bb[8], lw[8];
        {
            const bool hp = t > 0;
            float wl[8], al[8], vg[8];
#pragma unroll
            for (int e = 0; e < 8; ++e) {
                const float r_c = bf2f((bf16_t)L.rc[e]), k_c = bf2f((bf16_t)L.kc[e]), v_c = bf2f((bf16_t)L.vc[e]);
                const float r_p = hp ? bf2f((bf16_t)L.rp[e]) : 0.f, k_p = hp ? bf2f((bf16_t)L.kp[e]) : 0.f, v_p = hp ? bf2f((bf16_t)L.vp[e]) : 0.f;
                rr[e] = r_c + (r_p - r_c) * mu[cj0 + e]; kk_[e] = k_c + (k_p - k_c) * mu[384 + cj0 + e]; vv[e] = v_c + (v_p - v_c) * mu[768 + cj0 + e];
                wl[e] = w0[cj0 + e] + WLT[(j0 + e) * XTS + tt]; al[e] = a0[cj0 + e] + ALT[(j0 + e) * XTS + tt]; vg[e] = l > 0 ? v0[cj0 + e] + VGT[(j0 + e) * XTS + tt] : 0.f;
            }
            float ssq = 0.f, bon = 0.f;
#pragma unroll
            for (int e = 0; e < 8; ++e) {
                const float sp2 = fmaxf(-wl[e], 0.f) * 1.4426950408889634f + __builtin_amdgcn_logf(1.0f + __builtin_amdgcn_exp2f(-1.4426950408889634f * fabsf(wl[e])));
                lw[e] = -__builtin_amdgcn_exp2f(-sp2 - 0.7213475204444817f);
                const float alr = __builtin_amdgcn_rcpf(1.0f + __builtin_amdgcn_exp2f(-1.4426950408889634f * al[e]));
                if (l > 0) { const float vf = e < 4 ? L.vf0[e & 3] : L.vf1[e & 3]; vv[e] = vv[e] + (vf - vv[e]) * __builtin_amdgcn_rcpf(1.0f + __builtin_amdgcn_exp2f(-1.4426950408889634f * vg[e])); }
                const float kkr = kk_[e] * kks[cj0 + e];
                kk_[e] = kk_[e] * (1.0f + (alr - 1.0f) * ka[cj0 + e]);
                aa[e] = kkr; bb[e] = alr; ssq += kkr * kkr; bon += rr[e] * kk_[e] * rk[cj0 + e];
            }
            if (l == 0) { __builtin_nontemporal_store((f32x4){vv[0], vv[1], vv[2], vv[3]}, (f32x4*)(VF + row * RWW + cj0)); __builtin_nontemporal_store((f32x4){vv[4], vv[5], vv[6], vv[7]}, (f32x4*)(VF + row * RWW + cj0 + 4)); }
            ssq += __shfl_xor(ssq, 1); ssq += __shfl_xor(ssq, 2); ssq += __shfl_xor(ssq, 4);
            bon += __shfl_xor(bon, 1); bon += __shfl_xor(bon, 2); bon += __shfl_xor(bon, 4);
            const float inv = fminf(__builtin_amdgcn_rsqf(ssq), 1e12f);
            uint4 bvw; float bv[8];
#pragma unroll
            for (int e = 0; e < 8; ++e) { const float kn = aa[e] * inv; aa[e] = -kn; bb[e] = kn * bb[e]; bv[e] = bon * vv[e]; CS[tt * CSS + j0 + e] = lw[e]; }
            bvw.x = pk2(bv[0], bv[1]); bvw.y = pk2(bv[2], bv[3]); bvw.z = pk2(bv[4], bv[5]); bvw.w = pk2(bv[6], bv[7]);
            *(uint4*)((bf16_t*)(p.ws + WS_CH_BV) + (size_t)jb * 4096 + tt * 64 + j0) = bvw;
        }
        __syncthreads();
#pragma unroll
        for (int e = 0; e < 8; ++e) {
            const int j = wave * 8 + e; float x = CS[lane * CSS + j];
#pragma unroll
            for (int o = 1; o < 64; o <<= 1) { const float y = __shfl_up(x, o); if (lane >= o) x += y; }
            CS[lane * CSS + j] = x;
        }
        __syncthreads();
        {
            float at[8], rt[8], bt[8], kt[8];
#pragma unroll
            for (int e = 0; e < 8; ++e) {
                const int j = j0 + e; const float cs = CS[tt * CSS + j] * 1.4426950408889634f, csC = CS[63 * CSS + j] * 1.4426950408889634f, lw2 = lw[e] * 1.4426950408889634f;
                const float e_in = __builtin_amdgcn_exp2f(cs), e_ex = __builtin_amdgcn_exp2f(cs - lw2), e_ng = __builtin_amdgcn_exp2f(-cs), e_ht = __builtin_amdgcn_exp2f(csC - cs);
                at[e] = aa[e] * e_ex; rt[e] = rr[e] * e_in; bt[e] = bb[e] * e_ng; kt[e] = kk_[e] * e_ng;
                T_VT[j * TS + tt] = f2bf(vv[e]); T_bhT[j * TS + tt] = f2bf(bb[e] * e_ht); T_khT[j * TS + tt] = f2bf(kk_[e] * e_ht);
                XT[j * XTS + tt] = at[e];
                if (tt == 63) PCv[j] = __builtin_amdgcn_exp2f(csC);
            }
            uint4 w;
            w.x = pk2(at[0], at[1]); w.y = pk2(at[2], at[3]); w.z = pk2(at[4], at[5]); w.w = pk2(at[6], at[7]); *(uint4*)(T_At + tt * TS + j0) = w;
            w.x = pk2(rt[0], rt[1]); w.y = pk2(rt[2], rt[3]); w.z = pk2(rt[4], rt[5]); w.w = pk2(rt[6], rt[7]); *(uint4*)(T_Rt + tt * TS + j0) = w;
            w.x = pk2(bt[0], bt[1]); w.y = pk2(bt[2], bt[3]); w.z = pk2(bt[4], bt[5]); w.w = pk2(bt[6], bt[7]); *(uint4*)(T_Bt + tt * TS + j0) = w;
            w.x = pk2(kt[0], kt[1]); w.y = pk2(kt[2], kt[3]); w.z = pk2(kt[4], kt[5]); w.w = pk2(kt[6], kt[7]); *(uint4*)(T_Kt + tt * TS + j0) = w;
        }
        __syncthreads();
        { const int hn = h + 1 < NH ? h + 1 : 0, gn = h + 1 < NH ? gi : gi + G; if (gn < NGRP) b1_issue_loads(p, l, gn, hn, tid, L); }
        {
            const int mat = wave >> 1;
            const bf16_t* As = (mat == 0 || mat == 2) ? T_Bt : T_Kt; const bf16_t* Bs = (mat < 2) ? T_At : T_Rt;
            bf16_t* dstb = (mat == 1 ? T_Aak : (mat == 2 ? T_Arb : T_Ark));
#pragma unroll
            for (int q = 0; q < 8; ++q) {
                constexpr int TI0[8] = {0, 0, 0, 0, 3, 1, 2, 3}, TJ0[8] = {0, 1, 2, 3, 3, 0, 0, 0}, TI1[8] = {1, 1, 1, 2, 2, 2, 3, 3}, TJ1[8] = {1, 2, 3, 2, 3, 1, 1, 2};
                const int ti = (wave & 1) ? TI1[q] : TI0[q], tj = (wave & 1) ? TJ1[q] : TJ0[q];
                f32x4 acc = (f32x4){0.f, 0.f, 0.f, 0.f};
                if (ti <= tj) acc = mm_tile(As, ti * 16, Bs, tj * 16, 64, fr, fq, acc);
                const int tcol = tj * 16 + fr, i0 = ti * 16 + fq * 4;
                if (ti == tj) {
#pragma unroll
                    for (int r = 0; r < 4; ++r) { const bool keep = (mat < 2) ? (i0 + r < tcol) : (i0 + r <= tcol); if (!keep) acc[r] = 0.f; }
                }
                if (mat == 0) *(f32x4*)(Aab + tcol * AABS + i0) = acc;
                else *(uint2*)(dstb + tcol * TS + i0) = pk4(acc);
            }
        }
        __syncthreads();
        if (wave == 0) {
            const int blk = lane >> 4, cc = lane & 15; const float* ar = Aab + (16 * blk) * AABS + 16 * blk;
            float x[16];
#pragma unroll
            for (int u = 0; u < 16; ++u) { float v = (u == cc) ? 1.0f : 0.f;
#pragma unroll
                for (int i = 0; i < u; ++i) v += ar[u * AABS + i] * x[i];
                x[u] = v; }
#pragma unroll
            for (int u = 0; u < 16; ++u) TI[(blk * 16 + u) * 17 + cc] = x[u];
        } else {
#pragma unroll 1
            for (int id = wave - 1; id < 16; id += 7) {
                const int ti = id >> 2, tj = id & 3;
                f32x4 acc = mm_tile(T_Aak, ti * 16, T_VT, tj * 16, 64, fr, fq, (f32x4){0.f, 0.f, 0.f, 0.f});
                const int j = tj * 16 + fr, tr = ti * 16 + fq * 4;
#pragma unroll
                for (int r = 0; r < 4; ++r) XT[(64 + j) * XTS + tr + r] = acc[r];
            }
        }
        __syncthreads();
        {
            float* xc = XT + (wave * 16 + fr) * XTS;
#pragma unroll
            for (int I = 0; I < 4; ++I) {
                f32x4 acc;
#pragma unroll
                for (int r = 0; r < 4; ++r) acc[r] = xc[16 * I + 4 * fq + r];
#pragma unroll
                for (int J = 0; J < I; ++J)
#pragma unroll
                    for (int kk = 0; kk < 4; ++kk) acc = __builtin_amdgcn_mfma_f32_16x16x4f32(Aab[(16 * I + fr) * AABS + 16 * J + 4 * kk + fq], xc[16 * J + 4 * kk + fq], acc, 0, 0, 0);
#pragma unroll
                for (int r = 0; r < 4; ++r) xc[16 * I + 4 * fq + r] = acc[r];
                asm volatile("s_waitcnt lgkmcnt(0)" ::: "memory");
                f32x4 xs = (f32x4){0.f, 0.f, 0.f, 0.f};
#pragma unroll
                for (int kk = 0; kk < 4; ++kk) xs = __builtin_amdgcn_mfma_f32_16x16x4f32(TI[(I * 16 + fr) * 17 + 4 * kk + fq], xc[16 * I + 4 * kk + fq], xs, 0, 0, 0);
                asm volatile("s_waitcnt lgkmcnt(0)" ::: "memory");
#pragma unroll
                for (int r = 0; r < 4; ++r) xc[16 * I + 4 * fq + r] = xs[r];
                asm volatile("s_waitcnt lgkmcnt(0)" ::: "memory");
            }
        }
        __syncthreads();
        {
            const int col = tid >> 2, tg = (tid & 3) * 16;
            const float* xr = XT + col * XTS + tg; bf16_t* dst = (col < 64 ? T_WT + col * TS : T_U0T + (col - 64) * TS) + tg;
            uint4 w0_, w1_;
            w0_.x = pk2(xr[0], xr[1]); w0_.y = pk2(xr[2], xr[3]); w0_.z = pk2(xr[4], xr[5]); w0_.w = pk2(xr[6], xr[7]);
            w1_.x = pk2(xr[8], xr[9]); w1_.y = pk2(xr[10], xr[11]); w1_.z = pk2(xr[12], xr[13]); w1_.w = pk2(xr[14], xr[15]);
            *(uint4*)dst = w0_; *(uint4*)(dst + 8) = w1_;
        }
        __syncthreads();
        {
            bf16_t* gM = (bf16_t*)(p.ws + WS_CH_M) + (size_t)jb * 4096; bf16_t* gNT = (bf16_t*)(p.ws + WS_CH_NT) + (size_t)jb * 4096;
            bf16_t* gG = (bf16_t*)(p.ws + WS_CH_G) + (size_t)jb * 4096; bf16_t* gY1T = (bf16_t*)(p.ws + WS_CH_Y1T) + (size_t)jb * 4096;
            const int mat = wave >> 1;
            const bf16_t* A1 = (mat == 0 || mat == 2) ? T_WT : (mat == 1 ? T_U0T : T_bhT);
            const bf16_t* B1 = (mat == 0 || mat == 1) ? T_Arb : (mat == 2 ? T_bhT : T_U0T);
            const bf16_t* A2 = mat == 1 ? T_VT : T_khT; const bf16_t* B2 = mat == 1 ? T_Ark : T_VT;
            bf16_t* gdst = mat == 0 ? gG : (mat == 1 ? gY1T : (mat == 2 ? gM : gNT));
#pragma unroll
            for (int q = 0; q < 8; ++q) {
                const int ti = ((wave & 1) * 8 + q) >> 2, tj = q & 3;
                const int col = tj * 16 + fr, r0 = ti * 16 + fq * 4;
                f32x4 acc = mm_tile(A1, ti * 16, B1, tj * 16, 64, fr, fq, (f32x4){0.f, 0.f, 0.f, 0.f});
                if (mat & 1) acc = mm_tile(A2, ti * 16, B2, tj * 16, 64, fr, fq, acc);
                if (mat == 0) {
                    const uint2 rw = *(const uint2*)(T_Rt + col * TS + r0);
                    acc[0] += bf2f((bf16_t)(rw.x & 0xffff)); acc[1] += bf2f((bf16_t)(rw.x >> 16)); acc[2] += bf2f((bf16_t)(rw.y & 0xffff)); acc[3] += bf2f((bf16_t)(rw.y >> 16));
                } else if (mat == 2 && ti == tj) {
                    const float pc = PCv[col];
#pragma unroll
                    for (int r = 0; r < 4; ++r) if (r0 + r == col) acc[r] += pc;
                }
                *(uint2*)(gdst + col * 64 + r0) = pk4(acc);
            }
        }
        __syncthreads();
        if (h == NH - 1) gi += G;
    }
}

__device__ void rwkv_b2_job(const Params& p, int bh, unsigned char* lds) {
    const int tid = tid_(), lane = tid & 63, wave = __builtin_amdgcn_readfirstlane(tid >> 6), fr = lane & 15, fq = lane >> 4;
    const int mi = wave >> 1, nj0 = (wave & 1) * 2;
    const bf16_t* gM = (const bf16_t*)(p.ws + WS_CH_M); const bf16_t* gNT = (const bf16_t*)(p.ws + WS_CH_NT); bf16_t* gZT = (bf16_t*)(p.ws + WS_ZT);
    bf16_t* zbuf = (bf16_t*)lds;
    f32x4 z[2];
    z[0] = (f32x4){0.f, 0.f, 0.f, 0.f}; z[1] = z[0];
    const int c0 = mi * 16 + fq * 4;
    bf16x8 am[2]; uint2 nw[2];
    {
        const size_t jb = (size_t)bh * 32;
#pragma unroll
        for (int kk = 0; kk < 2; ++kk) am[kk] = *(const bf16x8*)(gM + jb * 4096 + (mi * 16 + fr) * 64 + kk * 32 + fq * 8);
#pragma unroll
        for (int q = 0; q < 2; ++q) nw[q] = *(const uint2*)(gNT + jb * 4096 + ((nj0 + q) * 16 + fr) * 64 + c0);
    }
#pragma unroll 1
    for (int c = 0; c < SEQ / 64; ++c) {
        const size_t jb = (size_t)bh * 32 + c;
        bf16_t* zh = zbuf + (c & 1) * 2 * 64 * TS; bf16_t* zl = zh + 64 * TS;
#pragma unroll
        for (int q = 0; q < 2; ++q) {
            const int j = (nj0 + q) * 16 + fr;
            const uint2 hi = pk4(z[q]);
            f32x4 lo;
            lo[0] = z[q][0] - bf2f((bf16_t)(hi.x & 0xffff)); lo[1] = z[q][1] - bf2f((bf16_t)(hi.x >> 16)); lo[2] = z[q][2] - bf2f((bf16_t)(hi.y & 0xffff)); lo[3] = z[q][3] - bf2f((bf16_t)(hi.y >> 16));
            *(uint2*)(zh + j * TS + c0) = hi; *(uint2*)(zl + j * TS + c0) = pk4(lo);
            *(uint2*)(gZT + jb * 4096 + j * 64 + c0) = hi;
        }
        bf16x8 amn[2]; uint2 nwn[2];
        {
            const size_t jn = (size_t)bh * 32 + (c + 1 < SEQ / 64 ? c + 1 : c);
#pragma unroll
            for (int kk = 0; kk < 2; ++kk) amn[kk] = *(const bf16x8*)(gM + jn * 4096 + (mi * 16 + fr) * 64 + kk * 32 + fq * 8);
#pragma unroll
            for (int q = 0; q < 2; ++q) nwn[q] = *(const uint2*)(gNT + jn * 4096 + ((nj0 + q) * 16 + fr) * 64 + c0);
        }
        __syncthreads();
#pragma unroll
        for (int q = 0; q < 2; ++q) {
            const int j = (nj0 + q) * 16 + fr;
            f32x4 acc; acc[0] = bf2f((bf16_t)(nw[q].x & 0xffff)); acc[1] = bf2f((bf16_t)(nw[q].x >> 16)); acc[2] = bf2f((bf16_t)(nw[q].y & 0xffff)); acc[3] = bf2f((bf16_t)(nw[q].y >> 16));
#pragma unroll
            for (int kk = 0; kk < 2; ++kk) {
                const bf16x8 bh_ = *(const bf16x8*)(zh + j * TS + kk * 32 + fq * 8), bl_ = *(const bf16x8*)(zl + j * TS + kk * 32 + fq * 8);
                acc = __builtin_amdgcn_mfma_f32_16x16x32_bf16(am[kk], bh_, acc, 0, 0, 0);
                acc = __builtin_amdgcn_mfma_f32_16x16x32_bf16(am[kk], bl_, acc, 0, 0, 0);
            }
            z[q] = acc;
        }
        am[0] = amn[0]; am[1] = amn[1]; nw[0] = nwn[0]; nw[1] = nwn[1];
    }
    __syncthreads();
}

__device__ void rwkv_b3_pair(const Params& p, int l, int pair) {
    const int tid = tid_(), lane = tid & 63, wave = __builtin_amdgcn_readfirstlane(tid >> 6), fr = lane & 15, fq = lane >> 4;
    const int jb = pair * 2 + (wave >> 2), mi = wave & 3;
    const int bh = jb >> 5, c = jb & 31, b = bh / NH, h = bh % NH;
    const bf16_t* gG = (const bf16_t*)(p.ws + WS_CH_G) + (size_t)jb * 4096; const bf16_t* gY1 = (const bf16_t*)(p.ws + WS_CH_Y1T) + (size_t)jb * 4096;
    const bf16_t* gBV = (const bf16_t*)(p.ws + WS_CH_BV) + (size_t)jb * 4096; const bf16_t* gZT = (const bf16_t*)(p.ws + WS_ZT) + (size_t)jb * 4096;
    const bf16_t* PG = (const bf16_t*)(p.ws + WS_PG); bf16_t* MIX = (bf16_t*)(p.ws + WS_MIX);
    const float* gng = p.in[19] + l * RWW + h * HD; const float* gnb = p.in[20] + l * RWW + h * HD;
    const int tt = mi * 16 + fr; const size_t row = (size_t)b * SEQ + c * 64 + tt;
    bf16x8 bg[2];
#pragma unroll
    for (int kk = 0; kk < 2; ++kk) bg[kk] = __builtin_nontemporal_load((const bf16x8*)(gG + tt * 64 + kk * 32 + fq * 8));
    uint2 yw[4], bw[4], gw[4];
#pragma unroll
    for (int nj = 0; nj < 4; ++nj) { const int j0 = nj * 16 + fq * 4;
        yw[nj] = ldnt_u2((const void*)(gY1 + tt * 64 + j0)); bw[nj] = ldnt_u2((const void*)(gBV + tt * 64 + j0)); gw[nj] = ldnt_u2((const void*)(PG + row * PG_W + h * HD + j0)); }
    f32x4 acc[4];
#pragma unroll
    for (int nj = 0; nj < 4; ++nj) {
        acc[nj][0] = bf2f((bf16_t)(yw[nj].x & 0xffff)); acc[nj][1] = bf2f((bf16_t)(yw[nj].x >> 16)); acc[nj][2] = bf2f((bf16_t)(yw[nj].y & 0xffff)); acc[nj][3] = bf2f((bf16_t)(yw[nj].y >> 16));
#pragma unroll
        for (int kk = 0; kk < 2; ++kk) { const bf16x8 az = *(const bf16x8*)(gZT + (nj * 16 + fr) * 64 + kk * 32 + fq * 8); acc[nj] = __builtin_amdgcn_mfma_f32_16x16x32_bf16(az, bg[kk], acc[nj], 0, 0, 0); }
    }
    float s = 0.f;
#pragma unroll
    for (int nj = 0; nj < 4; ++nj) s += (acc[nj][0] + acc[nj][1]) + (acc[nj][2] + acc[nj][3]);
    s += __shfl_xor(s, 16); s += __shfl_xor(s, 32);
    const float mean = s * (1.0f / HD);
    float vs = 0.f;
#pragma unroll
    for (int nj = 0; nj < 4; ++nj) { acc[nj] = acc[nj] - mean; vs += (acc[nj][0] * acc[nj][0] + acc[nj][1] * acc[nj][1]) + (acc[nj][2] * acc[nj][2] + acc[nj][3] * acc[nj][3]); }
    vs += __shfl_xor(vs, 16); vs += __shfl_xor(vs, 32);
    const float rstd = rsqrtf(vs * (1.0f / HD) + GN_EPS);
#pragma unroll
    for (int nj = 0; nj < 4; ++nj) {
        const int j0 = nj * 16 + fq * 4;
        const f32x4 gg = *(const f32x4*)(gng + j0), gb = *(const f32x4*)(gnb + j0);
        const float bv0 = bf2f((bf16_t)(bw[nj].x & 0xffff)), bv1 = bf2f((bf16_t)(bw[nj].x >> 16)), bv2 = bf2f((bf16_t)(bw[nj].y & 0xffff)), bv3 = bf2f((bf16_t)(bw[nj].y >> 16));
        const float g0 = bf2f((bf16_t)(gw[nj].x & 0xffff)), g1 = bf2f((bf16_t)(gw[nj].x >> 16)), g2 = bf2f((bf16_t)(gw[nj].y & 0xffff)), g3 = bf2f((bf16_t)(gw[nj].y >> 16));
        const float o0 = acc[nj][0] * rstd * gg[0] + gb[0] + bv0, o1 = acc[nj][1] * rstd * gg[1] + gb[1] + bv1, o2 = acc[nj][2] * rstd * gg[2] + gb[2] + bv2, o3 = acc[nj][3] * rstd * gg[3] + gb[3] + bv3;
        uint2 w; w.x = pk2(o0 * siluf_(g0), o1 * siluf_(g1)); w.y = pk2(o2 * siluf_(g2), o3 * siluf_(g3));
        *(uint2*)(MIX + row * DM + CW + SBW + h * HD + j0) = w;
    }
}

constexpr int N_ATT_JOBS = BATCH * NH * 8, N_CONV_JOBS = BATCH * (SEQ / 64), N_CHAINS = BATCH * NH;
__device__ __forceinline__ void run_side_job(const Params& p, int l, int id, unsigned char* lds) {
    if (id < N_ATT_JOBS) attn_wg_job(p, id, lds); else conv_job64(p, l, id - N_ATT_JOBS, lds);
}
__device__ void phase_mix1(const Params& p, int l, unsigned char* lds) {
    rwkv_b1_phase(p, l, lds);
    if (!defer_layer1_weights()) for (int id = blockIdx.x; id < N_ATT_JOBS + N_CONV_JOBS; id += gridDim.x) run_side_job(p, l, id, lds);
}
__device__ void phase_mix2(const Params& p, int l, unsigned char* lds) {
    const int G = gridDim.x, w = blockIdx.x, NJ = N_ATT_JOBS + N_CONV_JOBS;
    if (!defer_layer1_weights()) { for (int job = w; job < N_CHAINS; job += G) rwkv_b2_job(p, job, lds); return; }
    const bool prep = l + 1 < DEPTH;
    const int nlow = prep ? 5 : 4;
    if (w < N_CHAINS) {
        rwkv_b2_job(p, w, lds);
        for (int s_ = 0; s_ < nlow; ++s_) { const int id = s_ * N_CHAINS + w; if (id < NJ) run_side_job(p, l, id, lds); }
    } else {
        if (prep) prep_weights(p, l + 1, lds, w - N_CHAINS, G - N_CHAINS);
        for (int id = nlow * N_CHAINS + (w - N_CHAINS); id < NJ; id += G - N_CHAINS) run_side_job(p, l, id, lds);
    }
}
__device__ void phase_mix3(const Params& p, int l, unsigned char* lds) {
    for (int pair = blockIdx.x; pair < BATCH * NH * 16; pair += gridDim.x) rwkv_b3_pair(p, l, pair);
}

#define LAS __attribute__((address_space(3)))
#define XB_TMO      128
#define XB_XCNT(j)  (256  + 64 * (j))
#define XB_XSUB(j)  (1280 + 64 * (j))
#define XB_XGEN(j)  (2304 + 64 * (j))
#define XB_TOP      3328
#define XB_TOPGEN   3392
#define XCD_BAR_WORDS 3456
#define XB_SPIN_CAP (1u << 18)

__device__ __forceinline__ unsigned xb_ld(unsigned* p)              { return __hip_atomic_load(p, __ATOMIC_RELAXED, __HIP_MEMORY_SCOPE_AGENT); }
__device__ __forceinline__ unsigned xb_add(unsigned* p, unsigned v) { return __hip_atomic_fetch_add(p, v, __ATOMIC_RELAXED, __HIP_MEMORY_SCOPE_AGENT); }
__device__ __forceinline__ unsigned xb_xcc_id() { return (unsigned)__builtin_amdgcn_s_getreg((3 << 11) | 20) & 0xFu; }
#define XB_SPIN(cond, bar) do { unsigned _sp = 0; while (cond) { __builtin_amdgcn_s_sleep(1); \
    if ((++_sp & 255u) == 0u) { if (xb_ld(&(bar)[XB_TMO])) break; if (_sp > XB_SPIN_CAP) { atomicAdd(&(bar)[XB_TMO], 1u); break; } } } } while (0)

struct XcdBarrier {
    unsigned* bar; unsigned x;
    volatile LAS unsigned* st;
};

__device__ __forceinline__ XcdBarrier xcd_barrier_post(unsigned* bar, volatile LAS unsigned* st) {
    XcdBarrier b; b.bar = bar; b.x = xb_xcc_id(); b.st = st;
    if (threadIdx.x == 0) (void)xb_add(&bar[XB_XCNT(b.x)], 1u);
    return b;
}
__device__ __forceinline__ void xcd_barrier_complete(unsigned* bar, unsigned x, unsigned& nloc, unsigned& nx) {
    const unsigned G = gridDim.x * gridDim.y * gridDim.z;
    unsigned sum, cnt, mine, sp = 0u;
    for (;;) {
        sum = 0u; cnt = 0u; mine = 0u;
#pragma unroll
        for (unsigned j = 0; j < 16; ++j) { const unsigned c = xb_ld(&bar[XB_XCNT(j)]); sum += c; cnt += (c > 0u) ? 1u : 0u; mine = (j == x) ? c : mine; }
        if (sum == G) break;
        __builtin_amdgcn_s_sleep(1);
        if ((++sp & 255u) == 0u) { if (xb_ld(&bar[XB_TMO])) break; if (sp > XB_SPIN_CAP) { atomicAdd(&bar[XB_TMO], 1u); break; } }
    }
    nloc = mine > 0u ? mine : 1u; nx = cnt > 0u ? cnt : 1u;
}

__device__ __forceinline__ void xcd_barrier(const XcdBarrier& b) {
    asm volatile("s_waitcnt vmcnt(0)" ::: "memory");
    __syncthreads();
    if (threadIdx.x == 0) {
        unsigned* bar = b.bar;
        __builtin_amdgcn_s_waitcnt(0);
        unsigned nloc = b.st[0], nx = b.st[1];
        if (nloc == 0u) { xcd_barrier_complete(bar, b.x, nloc, nx); b.st[0] = nloc; b.st[1] = nx; }
        const unsigned old = xb_add(&bar[XB_XSUB(b.x)], 1u);
        const unsigned gen = old / nloc;
        if (old + 1u == (gen + 1u) * nloc) {
            __builtin_amdgcn_fence(__ATOMIC_RELEASE, "agent");
            asm volatile("s_waitcnt vmcnt(0)" ::: "memory");
            const unsigned og = xb_add(&bar[XB_TOP], 1u);
            const unsigned tg = og / nx;
            if (og + 1u == (tg + 1u) * nx) xb_add(&bar[XB_TOPGEN], 1u);
            else XB_SPIN(xb_ld(&bar[XB_TOPGEN]) == tg, bar);
            __builtin_amdgcn_fence(__ATOMIC_ACQUIRE, "agent");
            xb_add(&bar[XB_XGEN(b.x)], 1u);
            asm volatile("s_waitcnt vmcnt(0)" ::: "memory");
        } else {
            XB_SPIN(xb_ld(&bar[XB_XGEN(b.x)]) == gen, bar);
            __builtin_amdgcn_fence(__ATOMIC_ACQUIRE, "agent");
            asm volatile("s_waitcnt vmcnt(0)" ::: "memory");
        }
    }
    __syncthreads();
}

constexpr int PH_PER_LAYER = 6;
constexpr int N_PHASES = 1 + PH_PER_LAYER * DEPTH;
__device__ __forceinline__ void run_phase(const Params& p, int ph, unsigned char* lds) {
    unsigned char* ws = p.ws;
    if (ph == 0) { phase_prologue(p, lds); return; }
    const int l = (ph - 1) / PH_PER_LAYER, k = (ph - 1) % PH_PER_LAYER;
    if (k == 0) {
        EpiInProjP E{(bf16_t*)(ws + WS_PC), (bf16_t*)(ws + WS_PS), (bf16_t*)(ws + WS_PR), (bf16_t*)(ws + WS_PG), (bf16_t*)(ws + WS_VT)};
        pg8::Gemm g{(const bf16_t*)(ws + WS_XB), (const bf16_t*)(ws + WS_WIN) + (size_t)l * NINT * DM, M, NINT, DM}; pg8::StaticOrder S; S.init(M, NINT, (int)gridDim.x, (int)blockIdx.x);
        pg8::gemm_phase<EpiInProjP, pg8::StaticOrder, true, true>((PG8_LAS unsigned char*)lds, g, S, E);
    } else if (k == 1) {
        phase_mix1(p, l, lds);
    } else if (k == 2) {
        phase_mix2(p, l, lds);
    } else if (k == 3) {
        phase_mix3(p, l, lds);
    } else if (k == 4) {
        EpiOutBf16P E{(bf16_t*)(ws + WS_Y), DM};
        pg8::Gemm g{(const bf16_t*)(ws + WS_MIX), (const bf16_t*)(ws + WS_WOUT) + (size_t)l * DM * DM, M, DM, DM}; pg8::StaticOrder S; S.init(M, DM, (int)gridDim.x, (int)blockIdx.x);
        pg8::gemm_phase<EpiOutBf16P, pg8::StaticOrder, true, true>((PG8_LAS unsigned char*)lds, g, S, E);
    } else {
        phase_rowpass(l == 0 ? p.in[0] : p.out, (const bf16_t*)(ws + WS_Y), p.in[2] + l * DM, p.out, l + 1 < DEPTH ? (bf16_t*)(ws + WS_XB) : nullptr);
    }
}

static_assert(10 * TILE_B + 64 * AABS * 4 + 128 * XTS * 4 + 64 * 4 + 4 * 16 * 17 * 4 <= 147456, "B1 LDS map");
constexpr int LDS_BYTES = 147456 + 256;

constexpr int MISC_OFF = 147456;
#if MK_COOP == 2
__global__ void __launch_bounds__(512, 2) fwd_kernel(Params p) {
    extern __shared__ __attribute__((aligned(16))) unsigned char lds[];
    volatile LAS unsigned* misc = (volatile LAS unsigned*)((LAS unsigned char*)lds + MISC_OFF);
    if (threadIdx.x < 16) misc[threadIdx.x] = 0u;
    __syncthreads();
    XcdBarrier bar = xcd_barrier_post((unsigned*)(p.ws + WS_CTL), misc);
    for (int ph = p.ph_lo; ph < p.ph_hi; ++ph) {
        run_phase(p, ph, lds);
        if (ph + 1 < p.ph_hi) xcd_barrier(bar);
    }
}
#elif MK_COOP == 1
__global__ void __launch_bounds__(512, 2) fwd_kernel(Params p) {
    extern __shared__ __attribute__((aligned(16))) unsigned char lds[];
    cg::grid_group grid = cg::this_grid();
    for (int ph = p.ph_lo; ph < p.ph_hi; ++ph) {
        run_phase(p, ph, lds);
        if (ph + 1 < p.ph_hi) grid.sync();
    }
}
#else
__global__ void __launch_bounds__(512, 2) fwd_kernel(Params p) {
    extern __shared__ __attribute__((aligned(16))) unsigned char lds[];
    for (int ph = p.ph_lo; ph < p.ph_hi; ++ph) run_phase(p, ph, lds);
}
#endif

extern "C" void kernel_launch(void* const* d_in, const int* in_sizes, int n_in, void* d_out, int out_size, void* d_ws, size_t ws_size, hipStream_t stream) {
    static int grid = 0;
    if (grid == 0) {
        if (n_in != 24 || out_size != M * DM || ws_size < WS_END) { fprintf(stderr, "kernel_launch: unexpected problem (n_in %d out %d ws %zu)\n", n_in, out_size, ws_size); grid = -1; return; }
        int dev = 0, cus = 0, per_cu = 0;
        hipGetDevice(&dev); hipDeviceGetAttribute(&cus, hipDeviceAttributeMultiprocessorCount, dev);
        hipFuncSetAttribute((const void*)fwd_kernel, hipFuncAttributeMaxDynamicSharedMemorySize, LDS_BYTES);
        hipOccupancyMaxActiveBlocksPerMultiprocessor(&per_cu, (const void*)fwd_kernel, 512, LDS_BYTES);
        if (per_cu < 1) { fprintf(stderr, "kernel_launch: occupancy query says %d blocks per CU\n", per_cu); per_cu = 1; }
        grid = cus;
        (void)hipGetLastError();
    }
    if (grid < 0) return;
    Params p{};
    for (int i = 0; i < 24; ++i) p.in[i] = (const float*)d_in[i];
    p.out = (float*)d_out; p.ws = (unsigned char*)d_ws;
#if MK_COOP == 2
    p.ph_lo = 0; p.ph_hi = N_PHASES;
    if (hipMemsetAsync((char*)d_ws + WS_CTL, 0, XCD_BAR_WORDS * 4, stream) != hipSuccess) { fprintf(stderr, "kernel_launch: memset of the barrier words failed\n"); return; }
    hipLaunchKernelGGL(fwd_kernel, dim3(grid), dim3(512), LDS_BYTES, stream, p);
#elif MK_COOP == 1
    p.ph_lo = 0; p.ph_hi = N_PHASES;
    void* args[] = {&p};
    hipError_t e = hipLaunchCooperativeKernel((const void*)fwd_kernel, dim3(grid), dim3(512), args, LDS_BYTES, stream);
    if (e != hipSuccess) fprintf(stderr, "cooperative launch failed: %s (grid %d)\n", hipGetErrorString(e), grid);
#else
    for (int ph = 0; ph < N_PHASES; ++ph) {
        p.ph_lo = ph; p.ph_hi = ph + 1;
        hipLaunchKernelGGL(fwd_kernel, dim3(grid), dim3(512), LDS_BYTES, stream, p);
    }
#endif
}
```

```cpp
#include <hip/hip_runtime.h>
#include <hip/hip_cooperative_groups.h>
#include <cstdio>
#include <cstdint>
namespace cg = cooperative_groups;

#ifndef MK_COOP
#define MK_COOP 2
#endif

constexpr int BATCH = 16, SEQ = 2048, DM = 1024, DEPTH = 2;
constexpr int M = BATCH * SEQ;
constexpr int HD = 64, NH = 6;
constexpr int CW = 256, SBW = 384, RWW = 384, LORA = 32, TAPS = 31;
constexpr int DIN = 3904;
constexpr int NINT = 4096;
constexpr int PC_W = 768, PS_W = 1152, PR_W = 1280, PG_W = 384;
constexpr float RMS_EPS = 1e-6f, LN_EPS = 1e-5f, GN_EPS = 64e-5f;

typedef unsigned short bf16_t;
typedef short bf16x8 __attribute__((ext_vector_type(8)));
typedef float f32x4 __attribute__((ext_vector_type(4)));
typedef unsigned short us4 __attribute__((ext_vector_type(4)));

constexpr size_t MiB = 1u << 20;
constexpr size_t WS_CTL = 0;
constexpr size_t WS_WPW = 512 * 1024;
constexpr size_t WS_WIN = 1 * MiB;
constexpr size_t WS_WOUT = 17 * MiB;
constexpr size_t WS_XB = 21 * MiB;
constexpr size_t WS_MIX = WS_XB;
constexpr size_t WS_PC = 85 * MiB;
constexpr size_t WS_PS = 133 * MiB;
constexpr size_t WS_VT = 205 * MiB;
constexpr size_t WS_Y = WS_PC;
constexpr size_t WS_PR = 229 * MiB;
constexpr size_t WS_PG = 309 * MiB;
constexpr size_t WS_VF = 333 * MiB;
constexpr size_t WS_CH = 381 * MiB;
constexpr size_t CH_SZ = (size_t)3072 * 4096 * 2;
constexpr size_t WS_CH_M = WS_CH, WS_CH_NT = WS_CH + CH_SZ, WS_CH_G = WS_CH + 2 * CH_SZ, WS_CH_Y1T = WS_CH + 3 * CH_SZ, WS_CH_BV = WS_CH + 4 * CH_SZ;
constexpr size_t WS_ZT = WS_PR;
constexpr size_t WS_END = 501 * MiB;

struct Params {
    const float* in[24];
    float* out;
    unsigned char* ws;
    int ph_lo, ph_hi;
};

__device__ __forceinline__ float bf2f(bf16_t v) { return __uint_as_float(((unsigned)v) << 16); }
typedef float f32x2_t __attribute__((ext_vector_type(2)));
typedef __bf16 bf16x2_t __attribute__((ext_vector_type(2)));
__device__ __forceinline__ unsigned pk2(float lo, float hi) { f32x2_t v = {lo, hi}; bf16x2_t b = __builtin_convertvector(v, bf16x2_t); return __builtin_bit_cast(unsigned, b); }
__device__ __forceinline__ bf16_t f2bf(float f) { return (bf16_t)(pk2(f, f) & 0xffffu); }
__device__ __forceinline__ float wave_sum(float v) {
#pragma unroll
    for (int o = 1; o < 64; o <<= 1) v += __shfl_xor(v, o);
    return v;
}
__device__ __forceinline__ float sigmoidf_(float x) { return 1.0f / (1.0f + __expf(-x)); }
__device__ __forceinline__ float siluf_(float x) { return x / (1.0f + __expf(-x)); }
__device__ __forceinline__ int tid_() { int t = threadIdx.x; asm volatile("" : "+v"(t)); return t; }
typedef unsigned u32x2_t __attribute__((ext_vector_type(2)));
__device__ __forceinline__ uint2 ldnt_u2(const void* p) { const u32x2_t v = __builtin_nontemporal_load((const u32x2_t*)p); uint2 r; r.x = v[0]; r.y = v[1]; return r; }

__device__ __forceinline__ int orig_col(int n) { return n < 3520 ? n : (n < 3584 ? -1 : (n < 3968 ? n - 64 : -1)); }

__device__ void transpose_tile(const float* W, int ldw, int ncol_src, const float* gain, bf16_t* WT, int K, int n0, int k0, bool permute, float* tile  , bool skip_fold_rows = false) {
    const int tid = tid_();
#pragma unroll
    for (int i = 0; i < 8; ++i) {
        const int kl = (tid >> 6) + 8 * i, nl = tid & 63;
        const int n = n0 + nl, k = k0 + kl;
        const int oc = permute ? orig_col(n) : n;
        float v = 0.f;
        if (oc >= 0 && oc < ncol_src) v = W[(size_t)k * ldw + oc] * (gain ? gain[k] : 1.0f);
        if (permute && n >= 768 && n < 1152) v *= 0.125f * 1.4426950408889634f;
        tile[kl * 65 + nl] = v;
    }
    __syncthreads();
#pragma unroll
    for (int i = 0; i < 8; ++i) {
        const int nl = (tid >> 6) + 8 * i, kl = tid & 63;
        if (!(skip_fold_rows && n0 + nl >= 3520 && n0 + nl < 3584)) WT[(size_t)(n0 + nl) * K + k0 + kl] = f2bf(tile[kl * 65 + nl]);
    }
    __syncthreads();
}
__device__ void fold_v1_rows(const Params& p, int l, bf16_t* WinT_l, float* scr, int worker, int nworkers) {
    const int tid = tid_(), lane = tid & 63, wave = __builtin_amdgcn_readfirstlane(tid >> 6);
    const float* W = p.in[3] + (size_t)l * DM * DIN; const float* gain = p.in[1] + l * DM; const float* v1 = p.in[22] + (size_t)(l - 1) * RWW * LORA; const float* muv = p.in[11] + l * 1216 + 768;
    float* V1c = scr;
    float* Wr = scr + RWW * 64 + wave * RWW;
    for (int idx = tid; idx < RWW * 64; idx += 512) { const int c = idx >> 6, o = idx & 63; const float m = muv[c]; V1c[idx] = (o >= 32 ? m : 1.0f - m) * v1[c * LORA + (o & 31)]; }
    __syncthreads();
    for (int k = worker * 8 + wave; k < DM; k += nworkers * 8) {
        const float* wr = W + (size_t)k * DIN + 3072;
#pragma unroll
        for (int i = 0; i < 6; ++i) Wr[lane + 64 * i] = wr[lane + 64 * i];
        asm volatile("s_waitcnt lgkmcnt(0)" ::: "memory");
        float a0 = 0.f, a1 = 0.f, a2 = 0.f, a3 = 0.f;
#pragma unroll 4
        for (int c4 = 0; c4 < RWW / 4; ++c4) { const f32x4 w = *(const f32x4*)(Wr + 4 * c4);
            a0 += w[0] * V1c[(4 * c4) * 64 + lane]; a1 += w[1] * V1c[(4 * c4 + 1) * 64 + lane]; a2 += w[2] * V1c[(4 * c4 + 2) * 64 + lane]; a3 += w[3] * V1c[(4 * c4 + 3) * 64 + lane]; }
        WinT_l[(size_t)(3520 + lane) * DM + k] = f2bf(((a0 + a1) + (a2 + a3)) * gain[k]);
        asm volatile("s_waitcnt lgkmcnt(0)" ::: "memory");
    }
    __syncthreads();
}
__device__ void prep_weights(const Params& p, int l, unsigned char* lds, int worker, int nworkers) {
    float* tile = (float*)lds;
    bf16_t* WinT = (bf16_t*)(p.ws + WS_WIN) + (size_t)l * NINT * DM; bf16_t* WoutT = (bf16_t*)(p.ws + WS_WOUT) + (size_t)l * DM * DM; bf16_t* WpwT = (bf16_t*)(p.ws + WS_WPW) + (size_t)l * CW * CW;
    const int nt_in = (NINT / 64) * (DM / 64), nt_out = (DM / 64) * (DM / 64), nt_pw = (CW / 64) * (CW / 64);
    for (int j = worker; j < nt_in + nt_out + nt_pw; j += nworkers) {
        if (j < nt_in) transpose_tile(p.in[3] + (size_t)l * DM * DIN, DIN, DIN, p.in[1] + l * DM, WinT, DM, (j / (DM / 64)) * 64, (j % (DM / 64)) * 64, true, tile, l > 0);
        else if (j < nt_in + nt_out) { const int r = j - nt_in; transpose_tile(p.in[4] + (size_t)l * DM * DM, DM, DM, nullptr, WoutT, DM, (r / (DM / 64)) * 64, (r % (DM / 64)) * 64, false, tile); }
        else { const int r = j - nt_in - nt_out; transpose_tile(p.in[9] + (size_t)l * CW * CW, CW, CW, nullptr, WpwT, CW, (r >> 2) * 64, (r & 3) * 64, false, tile); }
    }
    if (l > 0) fold_v1_rows(p, l, WinT, tile, worker, nworkers);
}

__device__ void rows_to_xb(const float* X, bf16_t* XB) {
    const int tid = tid_(), lane = tid & 63, wave = __builtin_amdgcn_readfirstlane(tid >> 6);
    for (int row = blockIdx.x * 8 + wave; row < M; row += gridDim.x * 8) {
        const float* xr = X + (size_t)row * DM;
        f32x4 v[4]; float ss = 0.f;
#pragma unroll
        for (int i = 0; i < 4; ++i) { v[i] = __builtin_nontemporal_load((const f32x4*)(xr + i * 256 + lane * 4)); ss += v[i][0] * v[i][0] + v[i][1] * v[i][1] + v[i][2] * v[i][2] + v[i][3] * v[i][3]; }
        ss = wave_sum(ss);
        const float rstd = rsqrtf(ss * (1.0f / DM) + RMS_EPS);
#pragma unroll
        for (int i = 0; i < 4; ++i) { uint2 w; w.x = pk2(v[i][0] * rstd, v[i][1] * rstd); w.y = pk2(v[i][2] * rstd, v[i][3] * rstd); *(uint2*)(XB + (size_t)row * DM + i * 256 + lane * 4) = w; }
    }
}

__device__ __forceinline__ bool defer_layer1_weights() { return gridDim.x >= BATCH * NH + 32; }
__device__ void phase_prologue(const Params& p, unsigned char* lds) {
    prep_weights(p, 0, lds, blockIdx.x, gridDim.x);
    if (!defer_layer1_weights()) for (int l = 1; l < DEPTH; ++l) prep_weights(p, l, lds, blockIdx.x, gridDim.x);
    rows_to_xb(p.in[0], (bf16_t*)(p.ws + WS_XB));
}

namespace pg8 {
#define PG8_LAS __attribute__((address_space(3)))
typedef unsigned short bf16_t;
typedef short bf16x8 __attribute__((ext_vector_type(8)));
typedef float f32x4 __attribute__((ext_vector_type(4)));
typedef unsigned u32x4 __attribute__((ext_vector_type(4)));
constexpr int BM = 256, BK = 64, HALF = 128, HTB = HALF * BK * 2  , STAGE_BYTES = 8 * HTB, NXCD = 8, WGM = 8;

__host__ __device__ __forceinline__ int lds_byte(int r, int c) { const int st = (r >> 4) * 2 + (c >> 5), rr = r & 15, cc = c & 31, ob = rr * 64 + cc * 2; return st * 1024 + (ob ^ (((ob >> 9) & 1) << 5)); }
__host__ __device__ __forceinline__ void stage_rc(int b, int& R, int& C) { const int st = b / 1024, sb = b % 1024, swz = sb ^ (((sb >> 9) & 1) << 5); R = (st >> 1) * 16 + swz / 64; C = (st & 1) * 32 + (swz % 64) / 2; }
__host__ __device__ __forceinline__ int perm32(int rho) { const int n = rho >> 4, i = rho & 15; return 8 * (i >> 2) + 4 * n + (i & 3); }

struct Unit { int pm, pn; };
struct Gemm { const bf16_t* A; const bf16_t* Bt; int M, N, K; };

struct StaticOrder {
    int nM, nN, nwg, G, c;
    __host__ __device__ void init(int M, int N, int G_, int c_) { nM = M / BM; nN = N / BM; nwg = nM * nN; G = G_; c = c_; }
    __host__ __device__ bool next(int i, Unit& u) const {
        const long L = (long)i * G + c; if (L >= nwg) return false;
        int wgid = (int)L; { const int q = nwg / NXCD, r = nwg % NXCD, xcd = wgid % NXCD, off = wgid / NXCD; wgid = (xcd < r ? xcd * (q + 1) : r * (q + 1) + (xcd - r) * q) + off; }
        const int nig = WGM * nN, gid = wgid / nig, fm = gid * WGM, gsz = (nM - fm) < WGM ? (nM - fm) : WGM;
        u.pm = fm + ((wgid % nig) % gsz); u.pn = (wgid % nig) / gsz; return true;
    }
    __device__ __forceinline__ void a_ready(const Unit&) const {}
    __device__ __forceinline__ void done(const Unit&) const {}
};


__device__ __forceinline__ unsigned cvt_pk_bf16(float lo, float hi) { unsigned r; asm volatile("v_cvt_pk_bf16_f32 %0, %1, %2" : "=v"(r) : "v"(lo), "v"(hi)); return r; }

template <class Epi, class Sched, bool ALIGN_EPI = false, bool SP2 = false>
__device__ __forceinline__ void gemm_phase(PG8_LAS unsigned char* lds, const Gemm g, const Sched& S, const Epi& E) {
    const int tid = tid_(), wid = __builtin_amdgcn_readfirstlane(tid >> 6), lane = tid & 63, wr = wid >> 2, wc = wid & 3, fr = lane & 15, fq = lane >> 4;
    const int K = g.K, nt = K / BK;
    unsigned voffA[2], voffB[2];
#pragma unroll
    for (int i = 0; i < 2; ++i) { int R, C; stage_rc(tid * 16 + i * 8192, R, C); const int Rb = Epi::PERM ? ((R & ~31) + perm32(R & 31)) : R;
        voffA[i] = (unsigned)(R * K + C) * 2u; voffB[i] = (unsigned)(Rb * K + C) * 2u; }
    const size_t kstep = (size_t)(BK * 2);
    const size_t hstep = (size_t)HALF * K * 2;
    const size_t tstep = 2 * hstep;
    const unsigned ldsw = (unsigned)wid * 1024u;
    const int aoff = lds_byte(wr * 64 + fr, fq * 8), boff = lds_byte(wc * 32 + fr, fq * 8);
#define PG8_SA(b, h) (((b) * 2 + (h)) * HTB)
#define PG8_SB(b, h) ((4 + (b) * 2 + (h)) * HTB)
#define PG8_STAGE(bufoff, gbase, voff) do { _Pragma("unroll") for (int _i = 0; _i < 2; ++_i) \
        __builtin_amdgcn_global_load_lds((const unsigned*)((const char*)(gbase) + (voff)[_i]), (PG8_LAS unsigned*)(lds + (bufoff) + ldsw + _i * 8192), 16, 0, 0); } while (0)
#define PG8_LDA(dst, b, h) do { _Pragma("unroll") for (int m = 0; m < 4; ++m) _Pragma("unroll") for (int k = 0; k < 2; ++k) dst[m][k] = *(const PG8_LAS bf16x8*)(lds + PG8_SA(b, h) + aoff + m * 2048 + k * 1024); } while (0)
#define PG8_LDB(dst, b, h) do { _Pragma("unroll") for (int n = 0; n < 2; ++n) _Pragma("unroll") for (int k = 0; k < 2; ++k) dst[n][k] = *(const PG8_LAS bf16x8*)(lds + PG8_SB(b, h) + boff + n * 2048 + k * 1024); } while (0)
#define PG8_MMA(ai, bj, At, Bt) do { __builtin_amdgcn_s_setprio(1); _Pragma("unroll") for (int m = 0; m < 4; ++m) _Pragma("unroll") for (int n = 0; n < 2; ++n) _Pragma("unroll") for (int k = 0; k < 2; ++k) \
        acc[ai][bj][m][n] = __builtin_amdgcn_mfma_f32_16x16x32_bf16(Bt[n][k], At[m][k], acc[ai][bj][m][n], 0, 0, 0); __builtin_amdgcn_s_setprio(0); } while (0)
#define PG8_WAIT_V(n) asm volatile("s_waitcnt vmcnt(" #n ")" ::: "memory")
#define PG8_WAIT_L(n) asm volatile("s_waitcnt lgkmcnt(" #n ")" ::: "memory")
#define PG8_BAR __builtin_amdgcn_s_barrier()
#define PG8_SCHED __builtin_amdgcn_sched_barrier(0)
    Unit cur, nxt; int ui = 0;
    if (!S.next(0, cur)) return;
    f32x4 acc[2][2][4][2];
#pragma unroll
    for (int a = 0; a < 2; ++a)
#pragma unroll
        for (int b = 0; b < 2; ++b)
#pragma unroll
            for (int m = 0; m < 4; ++m)
#pragma unroll
                for (int n = 0; n < 2; ++n) acc[a][b][m][n] = (f32x4){0.f, 0.f, 0.f, 0.f};
    bf16x8 At[4][2], B0[2][2], B1[2][2];
    const char* cA = (const char*)g.A + (size_t)cur.pm * tstep; const char* cB = (const char*)g.Bt + (size_t)cur.pn * tstep;
    S.a_ready(cur);
    if constexpr (SP2) {
        PG8_STAGE(PG8_SB(0, 0), cB, voffB); PG8_STAGE(PG8_SB(0, 1), cB + hstep, voffB); PG8_STAGE(PG8_SA(0, 0), cA, voffA); PG8_STAGE(PG8_SA(0, 1), cA + hstep, voffA);
        if (wr == 1) PG8_BAR;
        PG8_WAIT_V(2); PG8_BAR;
        PG8_STAGE(PG8_SB(1, 0), cB + kstep, voffB); PG8_STAGE(PG8_SA(1, 0), cA + kstep, voffA); PG8_STAGE(PG8_SB(1, 1), cB + hstep + kstep, voffB);
        PG8_WAIT_V(6); PG8_BAR;
    } else {
        PG8_STAGE(PG8_SB(0, 0), cB, voffB); PG8_STAGE(PG8_SA(0, 0), cA, voffA); PG8_STAGE(PG8_SB(0, 1), cB + hstep, voffB); PG8_STAGE(PG8_SA(0, 1), cA + hstep, voffA);
        if (wr == 1) PG8_BAR;
        PG8_WAIT_V(4); PG8_BAR;
        PG8_STAGE(PG8_SB(1, 0), cB + kstep, voffB); PG8_STAGE(PG8_SA(1, 0), cA + kstep, voffA); PG8_STAGE(PG8_SB(1, 1), cB + hstep + kstep, voffB);
        PG8_WAIT_V(6); PG8_BAR;
    }
    for (;;) {
        const bool has_next = S.next(ui + 1, nxt);
        const char* nA = has_next ? (const char*)g.A + (size_t)nxt.pm * tstep : cA; const char* nB = has_next ? (const char*)g.Bt + (size_t)nxt.pn * tstep : cB;
        for (int t = 0; t < nt; t += 2) {
            const bool last = (t == nt - 2);
            const char* a1 = cA + (size_t)(t + 1) * kstep;
            const char* a2 = last ? nA : cA + (size_t)(t + 2) * kstep; const char* b2 = last ? nB : cB + (size_t)(t + 2) * kstep;
            const char* a3 = a2 + kstep; const char* b3 = b2 + kstep;
            if (last && has_next) S.a_ready(nxt);
            if constexpr (SP2) {
            PG8_LDB(B0, 0, 0); PG8_LDB(B1, 0, 1); PG8_SCHED; PG8_LDA(At, 0, 0); PG8_STAGE(PG8_SA(1, 1), a1 + hstep, voffA);
            PG8_WAIT_V(8); PG8_WAIT_L(0); PG8_BAR; PG8_MMA(0, 0, At, B0); PG8_MMA(0, 1, At, B1); PG8_BAR; PG8_SCHED;
            PG8_LDA(At, 0, 1); PG8_STAGE(PG8_SB(0, 0), b2, voffB); PG8_STAGE(PG8_SB(0, 1), b2 + hstep, voffB); PG8_STAGE(PG8_SA(0, 0), a2, voffA);
            PG8_WAIT_V(8); PG8_WAIT_L(0); PG8_BAR; PG8_MMA(1, 0, At, B0); PG8_MMA(1, 1, At, B1); PG8_BAR; PG8_SCHED;
            PG8_LDB(B0, 1, 0); PG8_LDB(B1, 1, 1); PG8_SCHED; PG8_LDA(At, 1, 0); PG8_STAGE(PG8_SA(0, 1), a2 + hstep, voffA);
            PG8_WAIT_V(8); PG8_WAIT_L(0); PG8_BAR; PG8_MMA(0, 0, At, B0); PG8_MMA(0, 1, At, B1); PG8_BAR; PG8_SCHED;
            PG8_LDA(At, 1, 1); PG8_STAGE(PG8_SB(1, 0), b3, voffB); PG8_STAGE(PG8_SB(1, 1), b3 + hstep, voffB); PG8_STAGE(PG8_SA(1, 0), a3, voffA);
            PG8_WAIT_V(8); PG8_WAIT_L(0); PG8_BAR; PG8_MMA(1, 0, At, B0); PG8_MMA(1, 1, At, B1); PG8_BAR; PG8_SCHED;
            } else {
            PG8_LDB(B0, 0, 0); PG8_SCHED; PG8_LDA(At, 0, 0); PG8_STAGE(PG8_SA(1, 1), a1 + hstep, voffA);
            PG8_WAIT_L(8); PG8_BAR; PG8_WAIT_L(0); PG8_MMA(0, 0, At, B0); PG8_BAR; PG8_SCHED;
            PG8_LDB(B1, 0, 1); PG8_STAGE(PG8_SB(0, 0), b2, voffB);
            PG8_BAR; PG8_WAIT_L(0); PG8_MMA(0, 1, At, B1); PG8_BAR;
            PG8_LDA(At, 0, 1); PG8_STAGE(PG8_SA(0, 0), a2, voffA);
            PG8_BAR; PG8_WAIT_L(0); PG8_MMA(1, 0, At, B0); PG8_BAR; PG8_SCHED;
            PG8_STAGE(PG8_SB(0, 1), b2 + hstep, voffB);
            PG8_WAIT_V(6); PG8_BAR; PG8_MMA(1, 1, At, B1); PG8_BAR;
            PG8_LDB(B0, 1, 0); PG8_SCHED; PG8_LDA(At, 1, 0); PG8_STAGE(PG8_SA(0, 1), a2 + hstep, voffA);
            PG8_WAIT_L(8); PG8_BAR; PG8_WAIT_L(0); PG8_MMA(0, 0, At, B0); PG8_BAR; PG8_SCHED;
            PG8_LDB(B1, 1, 1); PG8_STAGE(PG8_SB(1, 0), b3, voffB);
            PG8_BAR; PG8_WAIT_L(0); PG8_MMA(0, 1, At, B1); PG8_BAR;
            PG8_LDA(At, 1, 1); PG8_STAGE(PG8_SA(1, 0), a3, voffA);
            PG8_BAR; PG8_WAIT_L(0); PG8_MMA(1, 0, At, B0); PG8_BAR; PG8_SCHED;
            PG8_STAGE(PG8_SB(1, 1), b3 + hstep, voffB);
            PG8_WAIT_V(6); PG8_BAR; PG8_MMA(1, 1, At, B1); PG8_BAR;
            }
        }
        if constexpr (ALIGN_EPI) { if (wr == 0) PG8_BAR; }
        if constexpr (!Epi::AFTER_DRAIN) { E(acc, cur, wr, wc, fr, fq); S.done(cur); }
        if (!has_next) break;
#pragma unroll
        for (int a = 0; a < 2; ++a)
#pragma unroll
            for (int b = 0; b < 2; ++b)
#pragma unroll
                for (int m = 0; m < 4; ++m)
#pragma unroll
                    for (int n = 0; n < 2; ++n) acc[a][b][m][n] = (f32x4){0.f, 0.f, 0.f, 0.f};
        cur = nxt; cA = nA; cB = nB; ++ui;
        if constexpr (ALIGN_EPI) { if (wr == 1) PG8_BAR; }
    }
    PG8_WAIT_V(0);
    if constexpr (!ALIGN_EPI) { if (wr == 0) PG8_BAR; }
    PG8_BAR;
    if constexpr (Epi::AFTER_DRAIN) { E.fused(acc, cur, wr, wc, fr, fq, lds, wid, lane); S.done(cur); }
#undef PG8_SA
#undef PG8_SB
#undef PG8_STAGE
#undef PG8_LDA
#undef PG8_LDB
#undef PG8_MMA
#undef PG8_WAIT_V
#undef PG8_WAIT_L
#undef PG8_BAR
#undef PG8_SCHED
}
}

struct EpiInProjP {
    static constexpr bool PERM = true, AFTER_DRAIN = false;
    bf16_t *PC, *PS, *PR, *PG, *VT;
    __device__ __forceinline__ void operator()(const pg8::f32x4 (&acc)[2][2][4][2], const pg8::Unit& u, int wr, int wc, int fr, int fq) const {
        const int row0 = u.pm * 256 + wr * 64 + fr;
#pragma unroll
        for (int bj = 0; bj < 2; ++bj) {
            const int blk = 2 * u.pn + bj; bf16_t* base; int ld, c0;
            if (blk >= 12 && blk < 15) {
                const int vc = 128 * (blk - 12) + wc * 32 + 8 * fq;
#pragma unroll
                for (int ai = 0; ai < 2; ++ai)
#pragma unroll
                    for (int m = 0; m < 4; ++m) {
                        const int row = row0 + ai * 128 + m * 16, b = row >> 11, t = row & 2047;
#pragma unroll
                        for (int n = 0; n < 2; ++n)
#pragma unroll
                            for (int e = 0; e < 4; ++e) { const int col = vc + 4 * n + e, hh = col >> 6, d = col & 63;
                                VT[((size_t)(b * NH + hh) * HD + d) * SEQ + t] = f2bf(acc[ai][bj][m][n][e]); }
                    }
                continue;
            }
            if (blk < 6) { base = PC; ld = PC_W; c0 = 128 * blk; }
            else if (blk < 12) { base = PS; ld = PS_W; c0 = 128 * (blk - 6); }
            else if (blk < 18) { base = PS; ld = PS_W; c0 = 768 + 128 * (blk - 15); }
            else if (blk < 28) { base = PR; ld = PR_W; c0 = 128 * (blk - 18); }
            else if (blk < 31) { base = PG; ld = PG_W; c0 = 128 * (blk - 28); }
            else continue;
            const int col = c0 + wc * 32 + 8 * fq;
#pragma unroll
            for (int ai = 0; ai < 2; ++ai)
#pragma unroll
                for (int m = 0; m < 4; ++m) {
                    const pg8::f32x4 v0 = acc[ai][bj][m][0], v1 = acc[ai][bj][m][1]; pg8::u32x4 w;
                    w.x = pg8::cvt_pk_bf16(v0[0], v0[1]); w.y = pg8::cvt_pk_bf16(v0[2], v0[3]); w.z = pg8::cvt_pk_bf16(v1[0], v1[1]); w.w = pg8::cvt_pk_bf16(v1[2], v1[3]);
                    *(pg8::u32x4*)(base + (size_t)(row0 + ai * 128 + m * 16) * ld + col) = w;
                }
        }
    }
};
struct EpiOutBf16P {
    static constexpr bool PERM = true, AFTER_DRAIN = false;
    bf16_t* Y; int ld;
    __device__ __forceinline__ void operator()(const pg8::f32x4 (&acc)[2][2][4][2], const pg8::Unit& u, int wr, int wc, int fr, int fq) const {
        const int row0 = u.pm * 256 + wr * 64 + fr, col0 = u.pn * 256 + wc * 32 + 8 * fq;
#pragma unroll
        for (int ai = 0; ai < 2; ++ai)
#pragma unroll
            for (int m = 0; m < 4; ++m)
#pragma unroll
                for (int bj = 0; bj < 2; ++bj) {
                    const pg8::f32x4 v0 = acc[ai][bj][m][0], v1 = acc[ai][bj][m][1]; pg8::u32x4 w;
                    w.x = pg8::cvt_pk_bf16(v0[0], v0[1]); w.y = pg8::cvt_pk_bf16(v0[2], v0[3]); w.z = pg8::cvt_pk_bf16(v1[0], v1[1]); w.w = pg8::cvt_pk_bf16(v1[2], v1[3]);
                    *(pg8::u32x4*)(Y + (size_t)(row0 + ai * 128 + m * 16) * ld + col0 + bj * 128) = w;
                }
    }
};

__device__ void phase_rowpass(const float* Xin, const bf16_t* Y, const float* gpost, float* Xout, bf16_t* XB) {
    const int tid = tid_(), lane = tid & 63, wave = __builtin_amdgcn_readfirstlane(tid >> 6);
    for (int row = blockIdx.x * 8 + wave; row < M; row += gridDim.x * 8) {
        f32x4 y[4], x[4]; float ss = 0.f;
#pragma unroll
        for (int i = 0; i < 4; ++i) { const uint2 yw = ldnt_u2((const void*)(Y + (size_t)row * DM + i * 256 + lane * 4));
            y[i] = (f32x4){bf2f((bf16_t)(yw.x & 0xffff)), bf2f((bf16_t)(yw.x >> 16)), bf2f((bf16_t)(yw.y & 0xffff)), bf2f((bf16_t)(yw.y >> 16))};
            x[i] = __builtin_nontemporal_load((const f32x4*)(Xin + (size_t)row * DM + i * 256 + lane * 4));
            ss += y[i][0] * y[i][0] + y[i][1] * y[i][1] + y[i][2] * y[i][2] + y[i][3] * y[i][3]; }
        ss = wave_sum(ss);
        const float rstd = rsqrtf(ss * (1.0f / DM) + RMS_EPS);
        float s2 = 0.f;
#pragma unroll
        for (int i = 0; i < 4; ++i) { const f32x4 g = *(const f32x4*)(gpost + i * 256 + lane * 4);
            x[i] = x[i] + y[i] * rstd * g; s2 += x[i][0] * x[i][0] + x[i][1] * x[i][1] + x[i][2] * x[i][2] + x[i][3] * x[i][3];
            __builtin_nontemporal_store(x[i], (f32x4*)(Xout + (size_t)row * DM + i * 256 + lane * 4)); }
        if (XB) {
            s2 = wave_sum(s2);
            const float r2 = rsqrtf(s2 * (1.0f / DM) + RMS_EPS);
#pragma unroll
            for (int i = 0; i < 4; ++i) { uint2 w; w.x = pk2(x[i][0] * r2, x[i][1] * r2); w.y = pk2(x[i][2] * r2, x[i][3] * r2); *(uint2*)(XB + (size_t)row * DM + i * 256 + lane * 4) = w; }
        }
    }
}

constexpr int CV_AS = 264;
__device__ void conv_job64(const Params& p, int l, int job, unsigned char* lds) {
    const int tid = tid_(), lane = tid & 63, wave = __builtin_amdgcn_readfirstlane(tid >> 6), fr = lane & 15, fq = lane >> 4;
    const int b = job >> 5, t0 = (job & 31) * 64;
    const bf16_t* PC = (const bf16_t*)(p.ws + WS_PC); bf16_t* MIX = (bf16_t*)(p.ws + WS_MIX);
    const float* dw = p.in[5] + l * TAPS * CW; const float* dwb = p.in[6] + l * CW; const float* lng = p.in[7] + l * CW; const float* lnb = p.in[8] + l * CW;
    const bf16_t* pwT = (const bf16_t*)(p.ws + WS_WPW) + (size_t)l * CW * CW; const float* pwb = p.in[10] + l * CW;
    float* u = (float*)lds;
    bf16_t* act = (bf16_t*)(lds + 94 * 256 * 4);
    for (int idx = tid; idx < 94 * 32; idx += 512) {
        const int r = idx >> 5, c8 = (idx & 31) * 8, t = t0 - 30 + r;
        float v[8];
        if (t >= 0) { const bf16_t* pr = PC + ((size_t)b * SEQ + t) * PC_W + c8; const bf16x8 a = *(const bf16x8*)pr, g = *(const bf16x8*)(pr + 256);
#pragma unroll
            for (int e = 0; e < 8; ++e) v[e] = bf2f((bf16_t)a[e]) * __builtin_amdgcn_rcpf(1.0f + __builtin_amdgcn_exp2f(-1.4426950408889634f * bf2f((bf16_t)g[e]))); }
        else {
#pragma unroll
            for (int e = 0; e < 8; ++e) v[e] = 0.f; }
        *(f32x4*)(u + r * 256 + c8) = (f32x4){v[0], v[1], v[2], v[3]}; *(f32x4*)(u + r * 256 + c8 + 4) = (f32x4){v[4], v[5], v[6], v[7]};
    }
    __syncthreads();
    const int c = tid & 255, half = tid >> 8;
    float acc[32];
    {
        float w[TAPS];
#pragma unroll
        for (int j = 0; j < TAPS; ++j) w[j] = dw[j * CW + c];
        const float bias = dwb[c];
#pragma unroll
        for (int i = 0; i < 32; ++i) acc[i] = bias;
        const float* up = u + (half * 32) * 256 + c;
#pragma unroll
        for (int rr = 0; rr < 62; ++rr) {
            const float uv = up[rr * 256];
#pragma unroll
            for (int i = 0; i < 32; ++i) { if (rr - i >= 0 && rr - i < TAPS) acc[i] += w[rr - i] * uv; }
        }
    }
    __syncthreads();
    float* cv = u;
#pragma unroll
    for (int i = 0; i < 32; ++i) cv[(half * 32 + i) * 256 + c] = acc[i];
    __syncthreads();
#pragma unroll 2
    for (int q = 0; q < 8; ++q) {
        const int tt = wave * 8 + q; const f32x4 x = *(const f32x4*)(cv + tt * 256 + lane * 4);
        const float mean = wave_sum(x[0] + x[1] + x[2] + x[3]) * (1.0f / CW);
        const f32x4 d = x - mean;
        const float rstd = rsqrtf(wave_sum(d[0] * d[0] + d[1] * d[1] + d[2] * d[2] + d[3] * d[3]) * (1.0f / CW) + LN_EPS);
        const f32x4 g = *(const f32x4*)(lng + lane * 4), bb = *(const f32x4*)(lnb + lane * 4);
        float y[4];
#pragma unroll
        for (int e = 0; e < 4; ++e) { const float v = d[e] * rstd * g[e] + bb[e]; y[e] = v * __builtin_amdgcn_rcpf(1.0f + __builtin_amdgcn_exp2f(-1.4426950408889634f * v)); }
        uint2 w; w.x = pk2(y[0], y[1]); w.y = pk2(y[2], y[3]); *(uint2*)(act + tt * CV_AS + lane * 4) = w;
    }
    __syncthreads();
    {
        f32x4 o[2][4];
#pragma unroll
        for (int i = 0; i < 2; ++i)
#pragma unroll
            for (int j = 0; j < 4; ++j) o[i][j] = (f32x4){0.f, 0.f, 0.f, 0.f};
#pragma unroll 2
        for (int kk = 0; kk < 8; ++kk) {
            bf16x8 a[2], bq[4];
#pragma unroll
            for (int i = 0; i < 2; ++i) a[i] = *(const bf16x8*)(pwT + (size_t)(wave * 32 + i * 16 + fr) * CW + kk * 32 + fq * 8);
#pragma unroll
            for (int j = 0; j < 4; ++j) bq[j] = *(const bf16x8*)(act + (j * 16 + fr) * CV_AS + kk * 32 + fq * 8);
#pragma unroll
            for (int i = 0; i < 2; ++i)
#pragma unroll
                for (int j = 0; j < 4; ++j) o[i][j] = __builtin_amdgcn_mfma_f32_16x16x32_bf16(a[i], bq[j], o[i][j], 0, 0, 0);
        }
#pragma unroll
        for (int i = 0; i < 2; ++i) {
            const int n0 = wave * 32 + i * 16 + fq * 4; const f32x4 bias = *(const f32x4*)(pwb + n0);
#pragma unroll
            for (int j = 0; j < 4; ++j) {
                const size_t row = (size_t)b * SEQ + t0 + j * 16 + fr;
                const uint2 gw = *(const uint2*)(PC + row * PC_W + 512 + n0);
                const float g0 = bf2f((bf16_t)(gw.x & 0xffff)), g1 = bf2f((bf16_t)(gw.x >> 16)), g2 = bf2f((bf16_t)(gw.y & 0xffff)), g3 = bf2f((bf16_t)(gw.y >> 16));
                const f32x4 v = o[i][j] + bias;
                uint2 w; w.x = pk2(v[0] * siluf_(g0), v[1] * siluf_(g1)); w.y = pk2(v[2] * siluf_(g2), v[3] * siluf_(g3));
                *(uint2*)(MIX + row * DM + n0) = w;
            }
        }
    }
    __syncthreads();
}

typedef float f32x16 __attribute__((ext_vector_type(16)));
struct AttFrag { bf16x8 K[4], V[2][2]; };
constexpr int AT_WIN = 224;
constexpr int AT_KS = 144, AT_VS = 976;
constexpr int AT_VOFF = (AT_WIN + 256) * AT_KS;
static_assert(AT_VOFF + 64 * AT_VS <= 147456, "attention LDS map");
__device__ __forceinline__ void att_load(AttFrag& F, const bf16_t* kbase, const bf16_t* vbase, const unsigned char* klds, const unsigned char* vlds, int w0, int kt) {
    const int s0 = (kt > 0 ? kt : 0) * 32;
    if (s0 >= w0) {
        const unsigned char* kp = klds + (s0 - w0) * AT_KS; const unsigned char* vp = vlds + (s0 - w0) * 2;
#pragma unroll
        for (int ks = 0; ks < 4; ++ks) F.K[ks] = *(const bf16x8*)(kp + ks * 32);
#pragma unroll
        for (int db = 0; db < 2; ++db)
#pragma unroll
            for (int s = 0; s < 2; ++s) F.V[db][s] = *(const bf16x8*)(vp + db * 32 * AT_VS + s * 16);
    } else {
#pragma unroll
        for (int ks = 0; ks < 4; ++ks) F.K[ks] = *(const bf16x8*)(kbase + (size_t)s0 * PS_W + ks * 16);
#pragma unroll
        for (int db = 0; db < 2; ++db)
#pragma unroll
            for (int s = 0; s < 2; ++s) F.V[db][s] = *(const bf16x8*)(vbase + (size_t)db * 32 * SEQ + s0 + s * 8);
    }
}
__device__ __forceinline__ bool att_tile(const AttFrag& F, const bf16x8 (&Qf)[4], f32x16& O0, f32x16& O1, float& rp, bool diag, int qi, int hf) {
    f32x16 S;
#pragma unroll
    for (int r = 0; r < 16; ++r) S[r] = 0.f;
#pragma unroll
    for (int ks = 0; ks < 4; ++ks) S = __builtin_amdgcn_mfma_f32_32x32x16_bf16(F.K[ks], Qf[ks], S, 0, 0, 0);
    float tot = 1.0f;
#pragma unroll
    for (int r = 0; r < 16; ++r) {
        float k_ = __builtin_amdgcn_rcpf(1.0f + __builtin_amdgcn_exp2f(S[r]));
        if (diag && (hf * 16 + r >= qi)) k_ = 1.0f;
        S[r] = k_; tot *= k_;
    }
    const float toto = __shfl_xor(tot, 32);
    float e = hf ? rp : rp * toto;
#pragma unroll
    for (int r = 15; r >= 0; --r) { const float k_ = S[r]; S[r] = (1.0f - k_) * e; e *= k_; }
    rp = rp * tot * toto;
    bf16x8 Pf[2];
#pragma unroll
    for (int s = 0; s < 2; ++s) {
        union { bf16x8 v; unsigned u[4]; } pk;
#pragma unroll
        for (int j = 0; j < 4; ++j) pk.u[j] = pk2(S[8 * s + 2 * j], S[8 * s + 2 * j + 1]);
        Pf[s] = pk.v;
    }
#pragma unroll
    for (int s = 0; s < 2; ++s) { O0 = __builtin_amdgcn_mfma_f32_32x32x16_bf16(F.V[0][s], Pf[s], O0, 0, 0, 0); O1 = __builtin_amdgcn_mfma_f32_32x32x16_bf16(F.V[1][s], Pf[s], O1, 0, 0, 0); }
    return __ballot(rp != 0.0f) == 0ull;
}
__device__ void attn_wg_job(const Params& p, int job, unsigned char* lds) {
    const int tid = tid_(), lane = tid & 63, wave = __builtin_amdgcn_readfirstlane(tid >> 6), qi = lane & 31, hf = lane >> 5;
    const int bh = job >> 3, g = job & 7, b = bh / NH, h = bh % NH;
    const bf16_t* PS = (const bf16_t*)(p.ws + WS_PS); const bf16_t* VT = (const bf16_t*)(p.ws + WS_VT) + (size_t)bh * HD * SEQ; bf16_t* MIX = (bf16_t*)(p.ws + WS_MIX);
    const int w0 = g * 256 > AT_WIN ? g * 256 - AT_WIN : 0, nkeys = g * 256 + 256 - w0;
    unsigned char* klds = lds; unsigned char* vlds = lds + AT_VOFF;
    bf16x8 Qf[4];
#pragma unroll
    for (int ks = 0; ks < 4; ++ks) Qf[ks] = *(const bf16x8*)(PS + ((size_t)b * SEQ + (g * 8 + wave) * 32 + qi) * PS_W + h * HD + ks * 16 + hf * 8);
    {
        const bf16_t* ksrc = PS + ((size_t)b * SEQ + w0) * PS_W + SBW + h * HD;
        for (int idx = tid; idx < nkeys * 8; idx += 512) { const int row = idx >> 3, pc = idx & 7; *(uint4*)(klds + row * AT_KS + pc * 16) = *(const uint4*)(ksrc + (size_t)row * PS_W + pc * 8); }
        const int pc = tid & 63, npc = nkeys >> 3;
        if (pc < npc) {
#pragma unroll
            for (int i = 0; i < 8; ++i) { const int d = (tid >> 6) + 8 * i; *(uint4*)(vlds + d * AT_VS + pc * 16) = *(const uint4*)(VT + (size_t)d * SEQ + w0 + pc * 8); }
        }
    }
    __syncthreads();
    {
        const int qblk = g * 8 + wave, q0 = qblk * 32;
        const size_t rowq = (size_t)b * SEQ + q0 + qi;
        const int pi = (qi & 3) + 4 * (qi >> 3) + 16 * ((qi >> 2) & 1);
        const bf16_t* kbase = PS + ((size_t)b * SEQ + pi) * PS_W + SBW + h * HD + hf * 8;
        const bf16_t* vbase = VT + (size_t)qi * SEQ + hf * 16;
        const unsigned char* kl = klds + pi * AT_KS + hf * 16; const unsigned char* vl = vlds + qi * AT_VS + hf * 32;
        AttFrag FA, FB;
        att_load(FA, kbase, vbase, kl, vl, w0, qblk);
        f32x16 O0, O1;
#pragma unroll
        for (int r = 0; r < 16; ++r) { O0[r] = 0.f; O1[r] = 0.f; }
        float rp = 1.0f;
        for (int kt = qblk; kt >= 0; kt -= 2) {
            att_load(FB, kbase, vbase, kl, vl, w0, kt - 1);
            if (att_tile(FA, Qf, O0, O1, rp, kt == qblk, qi, hf) || kt < 1) break;
            att_load(FA, kbase, vbase, kl, vl, w0, kt - 2);
            if (att_tile(FB, Qf, O0, O1, rp, false, qi, hf)) break;
        }
        const bf16_t* gp = PS + rowq * PS_W + 768 + h * HD; bf16_t* op = MIX + rowq * DM + CW + h * HD;
#pragma unroll
        for (int db = 0; db < 2; ++db)
#pragma unroll
            for (int gq = 0; gq < 4; ++gq) {
                const int d0 = db * 32 + gq * 8 + hf * 4;
                const uint2 gw = *(const uint2*)(gp + d0);
                const float g0 = bf2f((bf16_t)(gw.x & 0xffff)), g1 = bf2f((bf16_t)(gw.x >> 16)), g2 = bf2f((bf16_t)(gw.y & 0xffff)), g3 = bf2f((bf16_t)(gw.y >> 16));
                const f32x16& O = db ? O1 : O0;
                uint2 w; w.x = pk2(O[4 * gq] * siluf_(g0), O[4 * gq + 1] * siluf_(g1)); w.y = pk2(O[4 * gq + 2] * siluf_(g2), O[4 * gq + 3] * siluf_(g3));
                *(uint2*)(op + d0) = w;
            }
    }
    __syncthreads();
}

constexpr int TS = 72;
constexpr int TILE_B = 64 * TS * 2;
constexpr int AABS = 68, XTS = 65, CSS = 65;

__device__ __forceinline__ f32x4 mm_tile(const bf16_t* X, int m0, const bf16_t* Yt, int n0, int K, int fr, int fq, f32x4 acc) {
#pragma unroll
    for (int kk = 0; kk < 2; ++kk) {
        if (kk * 32 < K) {
            const bf16x8 a = *(const bf16x8*)(X + (m0 + fr) * TS + kk * 32 + fq * 8);
            const bf16x8 b = *(const bf16x8*)(Yt + (n0 + fr) * TS + kk * 32 + fq * 8);
            acc = __builtin_amdgcn_mfma_f32_16x16x32_bf16(a, b, acc, 0, 0, 0);
        }
    }
    return acc;
}
__device__ __forceinline__ uint2 pk4(const f32x4& v) { uint2 w; w.x = pk2(v[0], v[1]); w.y = pk2(v[2], v[3]); return w; }

struct B1Loads {
    bf16x8 rc, kc, vc, rp, kp, vp;
    f32x4 vf0, vf1;
    bf16x8 cc[2], cp[2];
};
__device__ __forceinline__ void b1_issue_loads(const Params& p, int l, int gi, int h, int tid, B1Loads& L) {
    const int b = gi >> 5, c = gi & 31, t0 = c * 64;
    const bf16_t* PR = (const bf16_t*)(p.ws + WS_PR); const float* VF = (const float*)(p.ws + WS_VF);
    {
        const int tt = tid >> 3, j0 = (tid & 7) * 8, t = t0 + tt, cj0 = h * HD + j0; const size_t row = (size_t)b * SEQ + t;
        const bf16_t* cur = PR + row * PR_W; const bf16_t* prv = cur - (t > 0 ? PR_W : 0);
        L.rc = *(const bf16x8*)(cur + cj0); L.kc = *(const bf16x8*)(cur + 384 + cj0); L.vc = *(const bf16x8*)(cur + 768 + cj0);
        L.rp = *(const bf16x8*)(prv + cj0); L.kp = *(const bf16x8*)(prv + 384 + cj0); L.vp = *(const bf16x8*)(prv + 768 + cj0);
        if (l > 0) { L.vf0 = *(const f32x4*)(VF + row * RWW + cj0); L.vf1 = *(const f32x4*)(VF + row * RWW + cj0 + 4); }
    }
    if (h == 0) {
#pragma unroll
        for (int q = 0; q < 2; ++q) {
            const int item = tid + 512 * q, tt = item >> 4, g = item & 15, t = t0 + tt;
            const bf16_t* cur = PR + ((size_t)b * SEQ + t) * PR_W + 1152; const bf16_t* prv = cur - (t > 0 ? PR_W : 0);
            const int gc = g < 12 ? g : 0, gp = g < 8 ? g : (g < 12 ? g + 4 : 0);
            L.cc[q] = *(const bf16x8*)(cur + 8 * gc); L.cp[q] = *(const bf16x8*)(prv + 8 * gp);
        }
    }
}

__device__ void rwkv_b1_phase(const Params& p, int l, unsigned char* lds) {
    const int G = gridDim.x;
    float* VF = (float*)(p.ws + WS_VF);
    const float* mu = p.in[11] + l * 1216; const float* w0 = p.in[12] + l * RWW;
    const float* a0 = p.in[14] + l * RWW; const float* kks = p.in[16] + l * RWW; const float* ka = p.in[17] + l * RWW;
    const float* rk = p.in[18] + l * RWW; const float* v0 = p.in[21];
    const float* w2 = p.in[13] + l * LORA * RWW; const float* a2 = p.in[15] + l * LORA * RWW; const float* v2 = p.in[23];
    bf16_t* T_At = (bf16_t*)lds; bf16_t* T_Rt = T_At + 64 * TS; bf16_t* T_Bt = T_Rt + 64 * TS; bf16_t* T_Kt = T_Bt + 64 * TS;
    bf16_t* T_VT = T_Kt + 64 * TS; bf16_t* T_bhT = T_VT + 64 * TS; bf16_t* T_khT = T_bhT + 64 * TS;
    bf16_t* T_Aak = T_khT + 64 * TS; bf16_t* T_Arb = T_Aak + 64 * TS; bf16_t* T_Ark = T_Arb + 64 * TS;
    bf16_t* T_WT = T_At; bf16_t* T_U0T = T_Bt;
    float* Aab = (float*)(lds + 10 * TILE_B);
    float* XT = (float*)(lds + 10 * TILE_B + 64 * AABS * 4);
    float* PCv = XT + 128 * XTS;
    float* TI = PCv + 64;
    float* CS = (float*)T_Aak;
    constexpr int LS = 33;
    float* WD = Aab; float* AD = WD + 64 * LS;
    float* VL = XT + 64 * XTS;
    float* WLT = (float*)lds; float* ALT = WLT + 64 * XTS; float* VGT = ALT + 64 * XTS;

    constexpr int NGRP = BATCH * (SEQ / 64);
    int gi = blockIdx.x;
    if (gi >= NGRP) return;
    B1Loads L;
    b1_issue_loads(p, l, gi, 0, tid_(), L);
    float codes[2][8];
#pragma unroll 1
    for (int it = 0; gi < NGRP; ++it) {
        const int h = it % NH;
        const int tid = tid_(), lane = tid & 63, wave = __builtin_amdgcn_readfirstlane(tid >> 6), fr = lane & 15, fq = lane >> 4;
        const int b = gi >> 5, c = gi & 31, bh = b * NH + h, jb = bh * 32 + c, t0 = c * 64;
        float wg[6][8];
#pragma unroll
        for (int q = 0; q < 6; ++q) {
            const int id = wave + 8 * q, Lk = id >> 4, tj = id & 3;
            if (q < 4 || l > 0) {
                const float* Wg = (Lk == 0 ? w2 : (Lk == 1 ? a2 : v2)) + (size_t)fq * RWW + h * HD + tj * 16 + fr;
#pragma unroll
                for (int kk = 0; kk < 8; ++kk) wg[q][kk] = Wg[(size_t)kk * 4 * RWW];
            }
        }
#pragma unroll
        for (int q = 0; q < 2; ++q) {
            const int item = tid + 512 * q, tt = item >> 4, g = item & 15, t = t0 + tt; const bool hp = t > 0;
            if (h == 0) {
#pragma unroll
                for (int e = 0; e < 8; ++e) {
                    const float xc = bf2f((bf16_t)L.cc[q][e]), xp = hp ? bf2f((bf16_t)L.cp[q][e]) : 0.f;
                    const float x_ = xc + (xp - xc) * mu[1152 + 8 * (g & 7) + e];
                    codes[q][e] = g < 4 ? 1.0f - 2.0f * __builtin_amdgcn_rcpf(1.0f + __builtin_amdgcn_exp2f(2.8853900817779268f * x_)) : (g < 8 ? x_ : xc + xp);
                }
            }
            if (g < 8 || (g < 12 && l > 0)) {
                float* dst = (g < 4 ? WD + tt * LS + 8 * g : (g < 8 ? AD + tt * LS + 8 * (g - 4) : VL + tt * LS + 8 * (g - 8)));
#pragma unroll
                for (int e = 0; e < 8; ++e) dst[e] = codes[q][e];
            }
        }
        __syncthreads();
#pragma unroll
        for (int q = 0; q < 6; ++q) {
            if (q < 4 || l > 0) {
                const int id = wave + 8 * q, Lk = id >> 4, ti = (id >> 2) & 3, tj = id & 3;
                const float* Xs = (Lk == 0 ? WD : (Lk == 1 ? AD : VL)) + (ti * 16 + fr) * LS + fq;
                f32x4 acc = (f32x4){0.f, 0.f, 0.f, 0.f};
#pragma unroll
                for (int kk = 0; kk < 8; ++kk) acc = __builtin_amdgcn_mfma_f32_16x16x4f32(Xs[kk * 4], wg[q][kk], acc, 0, 0, 0);
                float* out = (Lk == 0 ? WLT : (Lk == 1 ? ALT : VGT)) + (tj * 16 + fr) * XTS + ti * 16 + fq * 4;
#pragma unroll
                for (int r = 0; r < 4; ++r) out[r] = acc[r];
            }
        }
        __syncthreads();
        const int tt = tid >> 3, j0 = (tid & 7) * 8, t = t0 + tt, cj0 = h * HD + j0;
        const size_t row = (size_t)b * SEQ + t;
        float rr[8], kk_[8], vv[8], aa[8], bb[8], lw[8];
        {
            const bool hp = t > 0;
            float wl[8], al[8], vg[8];
#pragma unroll
            for (int e = 0; e < 8; ++e) {
                const float r_c = bf2f((bf16_t)L.rc[e]), k_c = bf2f((bf16_t)L.kc[e]), v_c = bf2f((bf16_t)L.vc[e]);
                const float r_p = hp ? bf2f((bf16_t)L.rp[e]) : 0.f, k_p = hp ? bf2f((bf16_t)L.kp[e]) : 0.f, v_p = hp ? bf2f((bf16_t)L.vp[e]) : 0.f;
                rr[e] = r_c + (r_p - r_c) * mu[cj0 + e]; kk_[e] = k_c + (k_p - k_c) * mu[384 + cj0 + e]; vv[e] = v_c + (v_p - v_c) * mu[768 + cj0 + e];
                wl[e] = w0[cj0 + e] + WLT[(j0 + e) * XTS + tt]; al[e] = a0[cj0 + e] + ALT[(j0 + e) * XTS + tt]; vg[e] = l > 0 ? v0[cj0 + e] + VGT[(j0 + e) * XTS + tt] : 0.f;
            }
            float ssq = 0.f, bon = 0.f;
#pragma unroll
            for (int e = 0; e < 8; ++e) {
                const float sp2 = fmaxf(-wl[e], 0.f) * 1.4426950408889634f + __builtin_amdgcn_logf(1.0f + __builtin_amdgcn_exp2f(-1.4426950408889634f * fabsf(wl[e])));
                lw[e] = -__builtin_amdgcn_exp2f(-sp2 - 0.7213475204444817f);
                const float alr = __builtin_amdgcn_rcpf(1.0f + __builtin_amdgcn_exp2f(-1.4426950408889634f * al[e]));
                if (l > 0) { const float vf = e < 4 ? L.vf0[e & 3] : L.vf1[e & 3]; vv[e] = vv[e] + (vf - vv[e]) * __builtin_amdgcn_rcpf(1.0f + __builtin_amdgcn_exp2f(-1.4426950408889634f * vg[e])); }
                const float kkr = kk_[e] * kks[cj0 + e];
                kk_[e] = kk_[e] * (1.0f + (alr - 1.0f) * ka[cj0 + e]);
                aa[e] = kkr; bb[e] = alr; ssq += kkr * kkr; bon += rr[e] * kk_[e] * rk[cj0 + e];
            }
            if (l == 0) { __builtin_nontemporal_store((f32x4){vv[0], vv[1], vv[2], vv[3]}, (f32x4*)(VF + row * RWW + cj0)); __builtin_nontemporal_store((f32x4){vv[4], vv[5], vv[6], vv[7]}, (f32x4*)(VF + row * RWW + cj0 + 4)); }
            ssq += __shfl_xor(ssq, 1); ssq += __shfl_xor(ssq, 2); ssq += __shfl_xor(ssq, 4);
            bon += __shfl_xor(bon, 1); bon += __shfl_xor(bon, 2); bon += __shfl_xor(bon, 4);
            const float inv = fminf(__builtin_amdgcn_rsqf(ssq), 1e12f);
            uint4 bvw; float bv[8];
#pragma unroll
            for (int e = 0; e < 8; ++e) { const float kn = aa[e] * inv; aa[e] = -kn; bb[e] = kn * bb[e]; bv[e] = bon * vv[e]; CS[tt * CSS + j0 + e] = lw[e]; }
            bvw.x = pk2(bv[0], bv[1]); bvw.y = pk2(bv[2], bv[3]); bvw.z = pk2(bv[4], bv[5]); bvw.w = pk2(bv[6], bv[7]);
            *(uint4*)((bf16_t*)(p.ws + WS_CH_BV) + (size_t)jb * 4096 + tt * 64 + j0) = bvw;
        }
        __syncthreads();
#pragma unroll
        for (int e = 0; e < 8; ++e) {
            const int j = wave * 8 + e; float x = CS[lane * CSS + j];
#pragma unroll
            for (int o = 1; o < 64; o <<= 1) { const float y = __shfl_up(x, o); if (lane >= o) x += y; }
            CS[lane * CSS + j] = x;
        }
        __syncthreads();
        {
            float at[8], rt[8], bt[8], kt[8];
#pragma unroll
            for (int e = 0; e < 8; ++e) {
                const int j = j0 + e; const float cs = CS[tt * CSS + j] * 1.4426950408889634f, csC = CS[63 * CSS + j] * 1.4426950408889634f, lw2 = lw[e] * 1.4426950408889634f;
                const float e_in = __builtin_amdgcn_exp2f(cs), e_ex = __builtin_amdgcn_exp2f(cs - lw2), e_ng = __builtin_amdgcn_exp2f(-cs), e_ht = __builtin_amdgcn_exp2f(csC - cs);
                at[e] = aa[e] * e_ex; rt[e] = rr[e] * e_in; bt[e] = bb[e] * e_ng; kt[e] = kk_[e] * e_ng;
                T_VT[j * TS + tt] = f2bf(vv[e]); T_bhT[j * TS + tt] = f2bf(bb[e] * e_ht); T_khT[j * TS + tt] = f2bf(kk_[e] * e_ht);
                XT[j * XTS + tt] = at[e];
                if (tt == 63) PCv[j] = __builtin_amdgcn_exp2f(csC);
            }
            uint4 w;
            w.x = pk2(at[0], at[1]); w.y = pk2(at[2], at[3]); w.z = pk2(at[4], at[5]); w.w = pk2(at[6], at[7]); *(uint4*)(T_At + tt * TS + j0) = w;
            w.x = pk2(rt[0], rt[1]); w.y = pk2(rt[2], rt[3]); w.z = pk2(rt[4], rt[5]); w.w = pk2(rt[6], rt[7]); *(uint4*)(T_Rt + tt * TS + j0) = w;
            w.x = pk2(bt[0], bt[1]); w.y = pk2(bt[2], bt[3]); w.z = pk2(bt[4], bt[5]); w.w = pk2(bt[6], bt[7]); *(uint4*)(T_Bt + tt * TS + j0) = w;
            w.x = pk2(kt[0], kt[1]); w.y = pk2(kt[2], kt[3]); w.z = pk2(kt[4], kt[5]); w.w = pk2(kt[6], kt[7]); *(uint4*)(T_Kt + tt * TS + j0) = w;
        }
        __syncthreads();
        { const int hn = h + 1 < NH ? h + 1 : 0, gn = h + 1 < NH ? gi : gi + G; if (gn < NGRP) b1_issue_loads(p, l, gn, hn, tid, L); }
        {
            const int mat = wave >> 1;
            const bf16_t* As = (mat == 0 || mat == 2) ? T_Bt : T_Kt; const bf16_t* Bs = (mat < 2) ? T_At : T_Rt;
            bf16_t* dstb = (mat == 1 ? T_Aak : (mat == 2 ? T_Arb : T_Ark));
#pragma unroll
            for (int q = 0; q < 8; ++q) {
                constexpr int TI0[8] = {0, 0, 0, 0, 3, 1, 2, 3}, TJ0[8] = {0, 1, 2, 3, 3, 0, 0, 0}, TI1[8] = {1, 1, 1, 2, 2, 2, 3, 3}, TJ1[8] = {1, 2, 3, 2, 3, 1, 1, 2};
                const int ti = (wave & 1) ? TI1[q] : TI0[q], tj = (wave & 1) ? TJ1[q] : TJ0[q];
                f32x4 acc = (f32x4){0.f, 0.f, 0.f, 0.f};
                if (ti <= tj) acc = mm_tile(As, ti * 16, Bs, tj * 16, 64, fr, fq, acc);
                const int tcol = tj * 16 + fr, i0 = ti * 16 + fq * 4;
                if (ti == tj) {
#pragma unroll
                    for (int r = 0; r < 4; ++r) { const bool keep = (mat < 2) ? (i0 + r < tcol) : (i0 + r <= tcol); if (!keep) acc[r] = 0.f; }
                }
                if (mat == 0) *(f32x4*)(Aab + tcol * AABS + i0) = acc;
                else *(uint2*)(dstb + tcol * TS + i0) = pk4(acc);
            }
        }
        __syncthreads();
        if (wave == 0) {
            const int blk = lane >> 4, cc = lane & 15; const float* ar = Aab + (16 * blk) * AABS + 16 * blk;
            float x[16];
#pragma unroll
            for (int u = 0; u < 16; ++u) { float v = (u == cc) ? 1.0f : 0.f;
#pragma unroll
                for (int i = 0; i < u; ++i) v += ar[u * AABS + i] * x[i];
                x[u] = v; }
#pragma unroll
            for (int u = 0; u < 16; ++u) TI[(blk * 16 + u) * 17 + cc] = x[u];
        } else {
#pragma unroll 1
            for (int id = wave - 1; id < 16; id += 7) {
                const int ti = id >> 2, tj = id & 3;
                f32x4 acc = mm_tile(T_Aak, ti * 16, T_VT, tj * 16, 64, fr, fq, (f32x4){0.f, 0.f, 0.f, 0.f});
                const int j = tj * 16 + fr, tr = ti * 16 + fq * 4;
#pragma unroll
                for (int r = 0; r < 4; ++r) XT[(64 + j) * XTS + tr + r] = acc[r];
            }
        }
        __syncthreads();
        {
            float* xc = XT + (wave * 16 + fr) * XTS;
#pragma unroll
            for (int I = 0; I < 4; ++I) {
                f32x4 acc;
#pragma unroll
                for (int r = 0; r < 4; ++r) acc[r] = xc[16 * I + 4 * fq + r];
#pragma unroll
                for (int J = 0; J < I; ++J)
#pragma unroll
                    for (int kk = 0; kk < 4; ++kk) acc = __builtin_amdgcn_mfma_f32_16x16x4f32(Aab[(16 * I + fr) * AABS + 16 * J + 4 * kk + fq], xc[16 * J + 4 * kk + fq], acc, 0, 0, 0);
#pragma unroll
                for (int r = 0; r < 4; ++r) xc[16 * I + 4 * fq + r] = acc[r];
                asm volatile("s_waitcnt lgkmcnt(0)" ::: "memory");
                f32x4 xs = (f32x4){0.f, 0.f, 0.f, 0.f};
#pragma unroll
                for (int kk = 0; kk < 4; ++kk) xs = __builtin_amdgcn_mfma_f32_16x16x4f32(TI[(I * 16 + fr) * 17 + 4 * kk + fq], xc[16 * I + 4 * kk + fq], xs, 0, 0, 0);
                asm volatile("s_waitcnt lgkmcnt(0)" ::: "memory");
#pragma unroll
                for (int r = 0; r < 4; ++r) xc[16 * I + 4 * fq + r] = xs[r];
                asm volatile("s_waitcnt lgkmcnt(0)" ::: "memory");
            }
        }
        __syncthreads();
        {
            const int col = tid >> 2, tg = (tid & 3) * 16;
            const float* xr = XT + col * XTS + tg; bf16_t* dst = (col < 64 ? T_WT + col * TS : T_U0T + (col - 64) * TS) + tg;
            uint4 w0_, w1_;
            w0_.x = pk2(xr[0], xr[1]); w0_.y = pk2(xr[2], xr[3]); w0_.z = pk2(xr[4], xr[5]); w0_.w = pk2(xr[6], xr[7]);
            w1_.x = pk2(xr[8], xr[9]); w1_.y = pk2(xr[10], xr[11]); w1_.z = pk2(xr[12], xr[13]); w1_.w = pk2(xr[14], xr[15]);
            *(uint4*)dst = w0_; *(uint4*)(dst + 8) = w1_;
        }
        __syncthreads();
        {
            bf16_t* gM = (bf16_t*)(p.ws + WS_CH_M) + (size_t)jb * 4096; bf16_t* gNT = (bf16_t*)(p.ws + WS_CH_NT) + (size_t)jb * 4096;
            bf16_t* gG = (bf16_t*)(p.ws + WS_CH_G) + (size_t)jb * 4096; bf16_t* gY1T = (bf16_t*)(p.ws + WS_CH_Y1T) + (size_t)jb * 4096;
            const int mat = wave >> 1;
            const bf16_t* A1 = (mat == 0 || mat == 2) ? T_WT : (mat == 1 ? T_U0T : T_bhT);
            const bf16_t* B1 = (mat == 0 || mat == 1) ? T_Arb : (mat == 2 ? T_bhT : T_U0T);
            const bf16_t* A2 = mat == 1 ? T_VT : T_khT; const bf16_t* B2 = mat == 1 ? T_Ark : T_VT;
            bf16_t* gdst = mat == 0 ? gG : (mat == 1 ? gY1T : (mat == 2 ? gM : gNT));
#pragma unroll
            for (int q = 0; q < 8; ++q) {
                const int ti = ((wave & 1) * 8 + q) >> 2, tj = q & 3;
                const int col = tj * 16 + fr, r0 = ti * 16 + fq * 4;
                f32x4 acc = mm_tile(A1, ti * 16, B1, tj * 16, 64, fr, fq, (f32x4){0.f, 0.f, 0.f, 0.f});
                if (mat & 1) acc = mm_tile(A2, ti * 16, B2, tj * 16, 64, fr, fq, acc);
                if (mat == 0) {
                    const uint2 rw = *(const uint2*)(T_Rt + col * TS + r0);
                    acc[0] += bf2f((bf16_t)(rw.x & 0xffff)); acc[1] += bf2f((bf16_t)(rw.x >> 16)); acc[2] += bf2f((bf16_t)(rw.y & 0xffff)); acc[3] += bf2f((bf16_t)(rw.y >> 16));
                } else if (mat == 2 && ti == tj) {
                    const float pc = PCv[col];
#pragma unroll
                    for (int r = 0; r < 4; ++r) if (r0 + r == col) acc[r] += pc;
                }
                *(uint2*)(gdst + col * 64 + r0) = pk4(acc);
            }
        }
        __syncthreads();
        if (h == NH - 1) gi += G;
    }
}

__device__ void rwkv_b2_job(const Params& p, int bh, unsigned char* lds) {
    const int tid = tid_(), lane = tid & 63, wave = __builtin_amdgcn_readfirstlane(tid >> 6), fr = lane & 15, fq = lane >> 4;
    const int mi = wave >> 1, nj0 = (wave & 1) * 2;
    const bf16_t* gM = (const bf16_t*)(p.ws + WS_CH_M); const bf16_t* gNT = (const bf16_t*)(p.ws + WS_CH_NT); bf16_t* gZT = (bf16_t*)(p.ws + WS_ZT);
    bf16_t* zbuf = (bf16_t*)lds;
    f32x4 z[2];
    z[0] = (f32x4){0.f, 0.f, 0.f, 0.f}; z[1] = z[0];
    const int c0 = mi * 16 + fq * 4;
    bf16x8 am[2]; uint2 nw[2];
    {
        const size_t jb = (size_t)bh * 32;
#pragma unroll
        for (int kk = 0; kk < 2; ++kk) am[kk] = *(const bf16x8*)(gM + jb * 4096 + (mi * 16 + fr) * 64 + kk * 32 + fq * 8);
#pragma unroll
        for (int q = 0; q < 2; ++q) nw[q] = *(const uint2*)(gNT + jb * 4096 + ((nj0 + q) * 16 + fr) * 64 + c0);
    }
#pragma unroll 1
    for (int c = 0; c < SEQ / 64; ++c) {
        const size_t jb = (size_t)bh * 32 + c;
        bf16_t* zh = zbuf + (c & 1) * 2 * 64 * TS; bf16_t* zl = zh + 64 * TS;
#pragma unroll
        for (int q = 0; q < 2; ++q) {
            const int j = (nj0 + q) * 16 + fr;
            const uint2 hi = pk4(z[q]);
            f32x4 lo;
            lo[0] = z[q][0] - bf2f((bf16_t)(hi.x & 0xffff)); lo[1] = z[q][1] - bf2f((bf16_t)(hi.x >> 16)); lo[2] = z[q][2] - bf2f((bf16_t)(hi.y & 0xffff)); lo[3] = z[q][3] - bf2f((bf16_t)(hi.y >> 16));
            *(uint2*)(zh + j * TS + c0) = hi; *(uint2*)(zl + j * TS + c0) = pk4(lo);
            *(uint2*)(gZT + jb * 4096 + j * 64 + c0) = hi;
        }
        bf16x8 amn[2]; uint2 nwn[2];
        {
            const size_t jn = (size_t)bh * 32 + (c + 1 < SEQ / 64 ? c + 1 : c);
#pragma unroll
            for (int kk = 0; kk < 2; ++kk) amn[kk] = *(const bf16x8*)(gM + jn * 4096 + (mi * 16 + fr) * 64 + kk * 32 + fq * 8);
#pragma unroll
            for (int q = 0; q < 2; ++q) nwn[q] = *(const uint2*)(gNT + jn * 4096 + ((nj0 + q) * 16 + fr) * 64 + c0);
        }
        __syncthreads();
#pragma unroll
        for (int q = 0; q < 2; ++q) {
            const int j = (nj0 + q) * 16 + fr;
            f32x4 acc; acc[0] = bf2f((bf16_t)(nw[q].x & 0xffff)); acc[1] = bf2f((bf16_t)(nw[q].x >> 16)); acc[2] = bf2f((bf16_t)(nw[q].y & 0xffff)); acc[3] = bf2f((bf16_t)(nw[q].y >> 16));
#pragma unroll
            for (int kk = 0; kk < 2; ++kk) {
                const bf16x8 bh_ = *(const bf16x8*)(zh + j * TS + kk * 32 + fq * 8), bl_ = *(const bf16x8*)(zl + j * TS + kk * 32 + fq * 8);
                acc = __builtin_amdgcn_mfma_f32_16x16x32_bf16(am[kk], bh_, acc, 0, 0, 0);
                acc = __builtin_amdgcn_mfma_f32_16x16x32_bf16(am[kk], bl_, acc, 0, 0, 0);
            }
            z[q] = acc;
        }
        am[0] = amn[0]; am[1] = amn[1]; nw[0] = nwn[0]; nw[1] = nwn[1];
    }
    __syncthreads();
}

struct B3Loads { bf16x8 bg[2], az[4][2]; uint2 yw[4], bw[4], gw[4]; };
__device__ __forceinline__ void b3_issue_loads(const Params& p, int pair, int wave, int fr, int fq, B3Loads& L) {
    const int jb = pair * 2 + (wave >> 2), mi = wave & 3, bh = jb >> 5, c = jb & 31, b = bh / NH, h = bh % NH;
    const bf16_t* gG = (const bf16_t*)(p.ws + WS_CH_G) + (size_t)jb * 4096; const bf16_t* gY1 = (const bf16_t*)(p.ws + WS_CH_Y1T) + (size_t)jb * 4096;
    const bf16_t* gBV = (const bf16_t*)(p.ws + WS_CH_BV) + (size_t)jb * 4096; const bf16_t* gZT = (const bf16_t*)(p.ws + WS_ZT) + (size_t)jb * 4096;
    const bf16_t* PG = (const bf16_t*)(p.ws + WS_PG);
    const int tt = mi * 16 + fr; const size_t row = (size_t)b * SEQ + c * 64 + tt;
#pragma unroll
    for (int kk = 0; kk < 2; ++kk) L.bg[kk] = __builtin_nontemporal_load((const bf16x8*)(gG + tt * 64 + kk * 32 + fq * 8));
#pragma unroll
    for (int nj = 0; nj < 4; ++nj) { const int j0 = nj * 16 + fq * 4;
        L.yw[nj] = ldnt_u2((const void*)(gY1 + tt * 64 + j0)); L.bw[nj] = ldnt_u2((const void*)(gBV + tt * 64 + j0)); L.gw[nj] = ldnt_u2((const void*)(PG + row * PG_W + h * HD + j0));
#pragma unroll
        for (int kk = 0; kk < 2; ++kk) L.az[nj][kk] = *(const bf16x8*)(gZT + (nj * 16 + fr) * 64 + kk * 32 + fq * 8); }
}
__device__ void rwkv_b3_phase(const Params& p, int l) {
    const int G = gridDim.x, NPAIR = BATCH * NH * 16;
    int pair = blockIdx.x;
    if (pair >= NPAIR) return;
    B3Loads L;
    { const int tid = tid_(), lane = tid & 63; b3_issue_loads(p, pair, __builtin_amdgcn_readfirstlane(tid >> 6), lane & 15, lane >> 4, L); }
#pragma unroll 1
    for (; pair < NPAIR; pair += G) {
        const int tid = tid_(), lane = tid & 63, wave = __builtin_amdgcn_readfirstlane(tid >> 6), fr = lane & 15, fq = lane >> 4;
        const int jb = pair * 2 + (wave >> 2), mi = wave & 3;
        const int bh = jb >> 5, c = jb & 31, b = bh / NH, h = bh % NH;
        bf16_t* MIX = (bf16_t*)(p.ws + WS_MIX);
        const float* gng = p.in[19] + l * RWW + h * HD; const float* gnb = p.in[20] + l * RWW + h * HD;
        const int tt = mi * 16 + fr; const size_t row = (size_t)b * SEQ + c * 64 + tt;
        f32x4 acc[4];
#pragma unroll
        for (int nj = 0; nj < 4; ++nj) {
            acc[nj][0] = bf2f((bf16_t)(L.yw[nj].x & 0xffff)); acc[nj][1] = bf2f((bf16_t)(L.yw[nj].x >> 16)); acc[nj][2] = bf2f((bf16_t)(L.yw[nj].y & 0xffff)); acc[nj][3] = bf2f((bf16_t)(L.yw[nj].y >> 16));
#pragma unroll
            for (int kk = 0; kk < 2; ++kk) acc[nj] = __builtin_amdgcn_mfma_f32_16x16x32_bf16(L.az[nj][kk], L.bg[kk], acc[nj], 0, 0, 0);
        }
        uint2 bw[4], gw[4];
#pragma unroll
        for (int nj = 0; nj < 4; ++nj) { bw[nj] = L.bw[nj]; gw[nj] = L.gw[nj]; }
        if (pair + G < NPAIR) b3_issue_loads(p, pair + G, wave, fr, fq, L);
        float s = 0.f;
#pragma unroll
        for (int nj = 0; nj < 4; ++nj) s += (acc[nj][0] + acc[nj][1]) + (acc[nj][2] + acc[nj][3]);
        s += __shfl_xor(s, 16); s += __shfl_xor(s, 32);
        const float mean = s * (1.0f / HD);
        float vs = 0.f;
#pragma unroll
        for (int nj = 0; nj < 4; ++nj) { acc[nj] = acc[nj] - mean; vs += (acc[nj][0] * acc[nj][0] + acc[nj][1] * acc[nj][1]) + (acc[nj][2] * acc[nj][2] + acc[nj][3] * acc[nj][3]); }
        vs += __shfl_xor(vs, 16); vs += __shfl_xor(vs, 32);
        const float rstd = rsqrtf(vs * (1.0f / HD) + GN_EPS);
#pragma unroll
        for (int nj = 0; nj < 4; ++nj) {
            const int j0 = nj * 16 + fq * 4;
            const f32x4 gg = *(const f32x4*)(gng + j0), gb = *(const f32x4*)(gnb + j0);
            const float bv0 = bf2f((bf16_t)(bw[nj].x & 0xffff)), bv1 = bf2f((bf16_t)(bw[nj].x >> 16)), bv2 = bf2f((bf16_t)(bw[nj].y & 0xffff)), bv3 = bf2f((bf16_t)(bw[nj].y >> 16));
            const float g0 = bf2f((bf16_t)(gw[nj].x & 0xffff)), g1 = bf2f((bf16_t)(gw[nj].x >> 16)), g2 = bf2f((bf16_t)(gw[nj].y & 0xffff)), g3 = bf2f((bf16_t)(gw[nj].y >> 16));
            const float o0 = acc[nj][0] * rstd * gg[0] + gb[0] + bv0, o1 = acc[nj][1] * rstd * gg[1] + gb[1] + bv1, o2 = acc[nj][2] * rstd * gg[2] + gb[2] + bv2, o3 = acc[nj][3] * rstd * gg[3] + gb[3] + bv3;
            uint2 w; w.x = pk2(o0 * siluf_(g0), o1 * siluf_(g1)); w.y = pk2(o2 * siluf_(g2), o3 * siluf_(g3));
            *(uint2*)(MIX + row * DM + CW + SBW + h * HD + j0) = w;
        }
    }
}

constexpr int N_ATT_JOBS = BATCH * NH * 8, N_CONV_JOBS = BATCH * (SEQ / 64), N_CHAINS = BATCH * NH;
__device__ __forceinline__ void run_side_job(const Params& p, int l, int id, unsigned char* lds) {
    if (id < N_ATT_JOBS) attn_wg_job(p, id, lds); else conv_job64(p, l, id - N_ATT_JOBS, lds);
}
__device__ void phase_mix1(const Params& p, int l, unsigned char* lds) {
    rwkv_b1_phase(p, l, lds);
    if (!defer_layer1_weights()) for (int id = blockIdx.x; id < N_ATT_JOBS + N_CONV_JOBS; id += gridDim.x) run_side_job(p, l, id, lds);
}
__device__ void phase_mix2(const Params& p, int l, unsigned char* lds) {
    const int G = gridDim.x, w = blockIdx.x, NJ = N_ATT_JOBS + N_CONV_JOBS;
    if (!defer_layer1_weights()) { for (int job = w; job < N_CHAINS; job += G) rwkv_b2_job(p, job, lds); return; }
    const bool prep = l + 1 < DEPTH;
    const int nlow = prep ? 5 : 4;
    if (w < N_CHAINS) {
        rwkv_b2_job(p, w, lds);
        for (int s_ = 0; s_ < nlow; ++s_) { const int id = s_ * N_CHAINS + w; if (id < NJ) run_side_job(p, l, id, lds); }
    } else {
        if (prep) prep_weights(p, l + 1, lds, w - N_CHAINS, G - N_CHAINS);
        for (int id = nlow * N_CHAINS + (w - N_CHAINS); id < NJ; id += G - N_CHAINS) run_side_job(p, l, id, lds);
    }
}
__device__ void phase_mix3(const Params& p, int l, unsigned char* lds) {
    rwkv_b3_phase(p, l);
}

#define LAS __attribute__((address_space(3)))
#define XB_TMO      128
#define XB_XCNT(j)  (256  + 64 * (j))
#define XB_XSUB(j)  (1280 + 64 * (j))
#define XB_XGEN(j)  (2304 + 64 * (j))
#define XB_TOP      3328
#define XB_TOPGEN   3392
#define XCD_BAR_WORDS 3456
#define XB_SPIN_CAP (1u << 18)

__device__ __forceinline__ unsigned xb_ld(unsigned* p)              { return __hip_atomic_load(p, __ATOMIC_RELAXED, __HIP_MEMORY_SCOPE_AGENT); }
__device__ __forceinline__ unsigned xb_add(unsigned* p, unsigned v) { return __hip_atomic_fetch_add(p, v, __ATOMIC_RELAXED, __HIP_MEMORY_SCOPE_AGENT); }
__device__ __forceinline__ unsigned xb_xcc_id() { return (unsigned)__builtin_amdgcn_s_getreg((3 << 11) | 20) & 0xFu; }
#define XB_SPIN(cond, bar) do { unsigned _sp = 0; while (cond) { __builtin_amdgcn_s_sleep(1); \
    if ((++_sp & 255u) == 0u) { if (xb_ld(&(bar)[XB_TMO])) break; if (_sp > XB_SPIN_CAP) { atomicAdd(&(bar)[XB_TMO], 1u); break; } } } } while (0)

struct XcdBarrier {
    unsigned* bar; unsigned x;
    volatile LAS unsigned* st;
};

__device__ __forceinline__ XcdBarrier xcd_barrier_post(unsigned* bar, volatile LAS unsigned* st) {
    XcdBarrier b; b.bar = bar; b.x = xb_xcc_id(); b.st = st;
    if (threadIdx.x == 0) (void)xb_add(&bar[XB_XCNT(b.x)], 1u);
    return b;
}
__device__ __forceinline__ void xcd_barrier_complete(unsigned* bar, unsigned x, unsigned& nloc, unsigned& nx) {
    const unsigned G = gridDim.x * gridDim.y * gridDim.z;
    unsigned sum, cnt, mine, sp = 0u;
    for (;;) {
        sum = 0u; cnt = 0u; mine = 0u;
#pragma unroll
        for (unsigned j = 0; j < 16; ++j) { const unsigned c = xb_ld(&bar[XB_XCNT(j)]); sum += c; cnt += (c > 0u) ? 1u : 0u; mine = (j == x) ? c : mine; }
        if (sum == G) break;
        __builtin_amdgcn_s_sleep(1);
        if ((++sp & 255u) == 0u) { if (xb_ld(&bar[XB_TMO])) break; if (sp > XB_SPIN_CAP) { atomicAdd(&bar[XB_TMO], 1u); break; } }
    }
    nloc = mine > 0u ? mine : 1u; nx = cnt > 0u ? cnt : 1u;
}

__device__ __forceinline__ void xcd_barrier(const XcdBarrier& b) {
    asm volatile("s_waitcnt vmcnt(0)" ::: "memory");
    __syncthreads();
    if (threadIdx.x == 0) {
        unsigned* bar = b.bar;
        __builtin_amdgcn_s_waitcnt(0);
        unsigned nloc = b.st[0], nx = b.st[1];
        if (nloc == 0u) { xcd_barrier_complete(bar, b.x, nloc, nx); b.st[0] = nloc; b.st[1] = nx; }
        const unsigned old = xb_add(&bar[XB_XSUB(b.x)], 1u);
        const unsigned gen = old / nloc;
        if (old + 1u == (gen + 1u) * nloc) {
            __builtin_amdgcn_fence(__ATOMIC_RELEASE, "agent");
            asm volatile("s_waitcnt vmcnt(0)" ::: "memory");
            const unsigned og = xb_add(&bar[XB_TOP], 1u);
            const unsigned tg = og / nx;
            if (og + 1u == (tg + 1u) * nx) xb_add(&bar[XB_TOPGEN], 1u);
            else XB_SPIN(xb_ld(&bar[XB_TOPGEN]) == tg, bar);
            __builtin_amdgcn_fence(__ATOMIC_ACQUIRE, "agent");
            xb_add(&bar[XB_XGEN(b.x)], 1u);
            asm volatile("s_waitcnt vmcnt(0)" ::: "memory");
        } else {
            XB_SPIN(xb_ld(&bar[XB_XGEN(b.x)]) == gen, bar);
            __builtin_amdgcn_fence(__ATOMIC_ACQUIRE, "agent");
            asm volatile("s_waitcnt vmcnt(0)" ::: "memory");
        }
    }
    __syncthreads();
}

constexpr int PH_PER_LAYER = 6;
constexpr int N_PHASES = 1 + PH_PER_LAYER * DEPTH;
__device__ __forceinline__ void run_phase(const Params& p, int ph, unsigned char* lds) {
    unsigned char* ws = p.ws;
    if (ph == 0) { phase_prologue(p, lds); return; }
    const int l = (ph - 1) / PH_PER_LAYER, k = (ph - 1) % PH_PER_LAYER;
    if (k == 0) {
        EpiInProjP E{(bf16_t*)(ws + WS_PC), (bf16_t*)(ws + WS_PS), (bf16_t*)(ws + WS_PR), (bf16_t*)(ws + WS_PG), (bf16_t*)(ws + WS_VT)};
        pg8::Gemm g{(const bf16_t*)(ws + WS_XB), (const bf16_t*)(ws + WS_WIN) + (size_t)l * NINT * DM, M, NINT, DM}; pg8::StaticOrder S; S.init(M, NINT, (int)gridDim.x, (int)blockIdx.x);
        pg8::gemm_phase<EpiInProjP, pg8::StaticOrder, true, true>((PG8_LAS unsigned char*)lds, g, S, E);
    } else if (k == 1) {
        phase_mix1(p, l, lds);
    } else if (k == 2) {
        phase_mix2(p, l, lds);
    } else if (k == 3) {
        phase_mix3(p, l, lds);
    } else if (k == 4) {
        EpiOutBf16P E{(bf16_t*)(ws + WS_Y), DM};
        pg8::Gemm g{(const bf16_t*)(ws + WS_MIX), (const bf16_t*)(ws + WS_WOUT) + (size_t)l * DM * DM, M, DM, DM}; pg8::StaticOrder S; S.init(M, DM, (int)gridDim.x, (int)blockIdx.x);
        pg8::gemm_phase<EpiOutBf16P, pg8::StaticOrder, true, true>((PG8_LAS unsigned char*)lds, g, S, E);
    } else {
        phase_rowpass(l == 0 ? p.in[0] : p.out, (const bf16_t*)(ws + WS_Y), p.in[2] + l * DM, p.out, l + 1 < DEPTH ? (bf16_t*)(ws + WS_XB) : nullptr);
    }
}

static_assert(10 * TILE_B + 64 * AABS * 4 + 128 * XTS * 4 + 64 * 4 + 4 * 16 * 17 * 4 <= 147456, "B1 LDS map");
constexpr int LDS_BYTES = 147456 + 256;

constexpr int MISC_OFF = 147456;
#if MK_COOP == 2
__global__ void __launch_bounds__(512, 2) fwd_kernel(Params p) {
    extern __shared__ __attribute__((aligned(16))) unsigned char lds[];
    volatile LAS unsigned* misc = (volatile LAS unsigned*)((LAS unsigned char*)lds + MISC_OFF);
    if (threadIdx.x < 16) misc[threadIdx.x] = 0u;
    __syncthreads();
    XcdBarrier bar = xcd_barrier_post((unsigned*)(p.ws + WS_CTL), misc);
    for (int ph = p.ph_lo; ph < p.ph_hi; ++ph) {
        run_phase(p, ph, lds);
        if (ph + 1 < p.ph_hi) xcd_barrier(bar);
    }
}
#elif MK_COOP == 1
__global__ void __launch_bounds__(512, 2) fwd_kernel(Params p) {
    extern __shared__ __attribute__((aligned(16))) unsigned char lds[];
    cg::grid_group grid = cg::this_grid();
    for (int ph = p.ph_lo; ph < p.ph_hi; ++ph) {
        run_phase(p, ph, lds);
        if (ph + 1 < p.ph_hi) grid.sync();
    }
}
#else
__global__ void __launch_bounds__(512, 2) fwd_kernel(Params p) {
    extern __shared__ __attribute__((aligned(16))) unsigned char lds[];
    for (int ph = p.ph_lo; ph < p.ph_hi; ++ph) run_phase(p, ph, lds);
}
#endif

extern "C" void kernel_launch(void* const* d_in, const int* in_sizes, int n_in, void* d_out, int out_size, void* d_ws, size_t ws_size, hipStream_t stream) {
    static int grid = 0;
    if (grid == 0) {
        if (n_in != 24 || out_size != M * DM || ws_size < WS_END) { fprintf(stderr, "kernel_launch: unexpected problem (n_in %d out %d ws %zu)\n", n_in, out_size, ws_size); grid = -1; return; }
        int dev = 0, cus = 0, per_cu = 0;
        hipGetDevice(&dev); hipDeviceGetAttribute(&cus, hipDeviceAttributeMultiprocessorCount, dev);
        hipFuncSetAttribute((const void*)fwd_kernel, hipFuncAttributeMaxDynamicSharedMemorySize, LDS_BYTES);
        hipOccupancyMaxActiveBlocksPerMultiprocessor(&per_cu, (const void*)fwd_kernel, 512, LDS_BYTES);
        if (per_cu < 1) { fprintf(stderr, "kernel_launch: occupancy query says %d blocks per CU\n", per_cu); per_cu = 1; }
        grid = cus;
        (void)hipGetLastError();
    }
    if (grid < 0) return;
    Params p{};
    for (int i = 0; i < 24; ++i) p.in[i] = (const float*)d_in[i];
    p.out = (float*)d_out; p.ws = (unsigned char*)d_ws;
#if MK_COOP == 2
    p.ph_lo = 0; p.ph_hi = N_PHASES;
    if (hipMemsetAsync((char*)d_ws + WS_CTL, 0, XCD_BAR_WORDS * 4, stream) != hipSuccess) { fprintf(stderr, "kernel_launch: memset of the barrier words failed\n"); return; }
    hipLaunchKernelGGL(fwd_kernel, dim3(grid), dim3(512), LDS_BYTES, stream, p);
#elif MK_COOP == 1
    p.ph_lo = 0; p.ph_hi = N_PHASES;
    void* args[] = {&p};
    hipError_t e = hipLaunchCooperativeKernel((const void*)fwd_kernel, dim3(grid), dim3(512), args, LDS_BYTES, stream);
    if (e != hipSuccess) fprintf(stderr, "cooperative launch failed: %s (grid %d)\n", hipGetErrorString(e), grid);
#else
    for (int ph = 0; ph < N_PHASES; ++ph) {
        p.ph_lo = ph; p.ph_hi = ph + 1;
        hipLaunchKernelGGL(fwd_kernel, dim3(grid), dim3(512), LDS_BYTES, stream, p);
    }
#endif
}
```

```cpp
#include <hip/hip_runtime.h>
#include <hip/hip_cooperative_groups.h>
#include <cstdio>
#include <cstdint>
namespace cg = cooperative_groups;

#ifndef MK_COOP
#define MK_COOP 2
#endif

constexpr int BATCH = 16, SEQ = 2048, DM = 1024, DEPTH = 2;
constexpr int M = BATCH * SEQ;
constexpr int HD = 64, NH = 6;
constexpr int CW = 256, SBW = 384, RWW = 384, LORA = 32, TAPS = 31;
constexpr int DIN = 3904;
constexpr int NINT = 4096;
constexpr int PC_W = 768, PS_W = 1152, PR_W = 1280, PG_W = 384;
constexpr float RMS_EPS = 1e-6f, LN_EPS = 1e-5f, GN_EPS = 64e-5f;

typedef unsigned short bf16_t;
typedef short bf16x8 __attribute__((ext_vector_type(8)));
typedef float f32x4 __attribute__((ext_vector_type(4)));
typedef unsigned short us4 __attribute__((ext_vector_type(4)));

constexpr size_t MiB = 1u << 20;
constexpr size_t WS_CTL = 0;
constexpr size_t WS_WPW = 512 * 1024;
constexpr size_t WS_WIN = 1 * MiB;
constexpr size_t WS_WOUT = 17 * MiB;
constexpr size_t WS_XB = 21 * MiB;
constexpr size_t WS_MIX = WS_XB;
constexpr size_t WS_PC = 85 * MiB;
constexpr size_t WS_PS = 133 * MiB;
constexpr size_t WS_VT = 205 * MiB;
constexpr size_t WS_Y = WS_PC;
constexpr size_t WS_PR = 229 * MiB;
constexpr size_t WS_PG = 309 * MiB;
constexpr size_t WS_VF = 333 * MiB;
constexpr size_t WS_CH = 381 * MiB;
constexpr size_t CH_SZ = (size_t)3072 * 4096 * 2;
constexpr size_t WS_CH_M = WS_CH, WS_CH_NT = WS_CH + CH_SZ, WS_CH_G = WS_CH + 2 * CH_SZ, WS_CH_Y1T = WS_CH + 3 * CH_SZ, WS_CH_BV = WS_CH + 4 * CH_SZ;
constexpr size_t WS_ZT = WS_PR;
constexpr size_t WS_END = 501 * MiB;

struct Params {
    const float* in[24];
    float* out;
    unsigned char* ws;
    int ph_lo, ph_hi;
};

__device__ __forceinline__ float bf2f(bf16_t v) { return __uint_as_float(((unsigned)v) << 16); }
typedef float f32x2_t __attribute__((ext_vector_type(2)));
typedef __bf16 bf16x2_t __attribute__((ext_vector_type(2)));
__device__ __forceinline__ unsigned pk2(float lo, float hi) { f32x2_t v = {lo, hi}; bf16x2_t b = __builtin_convertvector(v, bf16x2_t); return __builtin_bit_cast(unsigned, b); }
__device__ __forceinline__ bf16_t f2bf(float f) { return (bf16_t)(pk2(f, f) & 0xffffu); }
__device__ __forceinline__ float wave_sum(float v) {
#pragma unroll
    for (int o = 1; o < 64; o <<= 1) v += __shfl_xor(v, o);
    return v;
}
__device__ __forceinline__ float sigmoidf_(float x) { return __builtin_amdgcn_rcpf(1.0f + __builtin_amdgcn_exp2f(-1.4426950408889634f * x)); }
__device__ __forceinline__ float siluf_(float x) { return x * __builtin_amdgcn_rcpf(1.0f + __builtin_amdgcn_exp2f(-1.4426950408889634f * x)); }
__device__ __forceinline__ int tid_() { int t = threadIdx.x; asm volatile("" : "+v"(t)); return t; }
typedef unsigned u32x2_t __attribute__((ext_vector_type(2)));
__device__ __forceinline__ uint2 ldnt_u2(const void* p) { const u32x2_t v = __builtin_nontemporal_load((const u32x2_t*)p); uint2 r; r.x = v[0]; r.y = v[1]; return r; }

__device__ __forceinline__ int orig_col(int n) { return n < 3520 ? n : (n < 3584 ? -1 : (n < 3968 ? n - 64 : -1)); }

__device__ void transpose_tile(const float* W, int ldw, int ncol_src, const float* gain, bf16_t* WT, int K, int n0, int k0, bool permute, float* tile  , bool skip_fold_rows = false) {
    const int tid = tid_();
#pragma unroll
    for (int i = 0; i < 8; ++i) {
        const int kl = (tid >> 6) + 8 * i, nl = tid & 63;
        const int n = n0 + nl, k = k0 + kl;
        const int oc = permute ? orig_col(n) : n;
        float v = 0.f;
        if (oc >= 0 && oc < ncol_src) v = W[(size_t)k * ldw + oc] * (gain ? gain[k] : 1.0f);
        if (permute && n >= 768 && n < 1152) v *= 0.125f * 1.4426950408889634f;
        tile[kl * 65 + nl] = v;
    }
    __syncthreads();
#pragma unroll
    for (int i = 0; i < 8; ++i) {
        const int nl = (tid >> 6) + 8 * i, kl = tid & 63;
        if (!(skip_fold_rows && n0 + nl >= 3520 && n0 + nl < 3584)) WT[(size_t)(n0 + nl) * K + k0 + kl] = f2bf(tile[kl * 65 + nl]);
    }
    __syncthreads();
}
__device__ void fold_v1_rows(const Params& p, int l, bf16_t* WinT_l, float* scr, int worker, int nworkers) {
    const int tid = tid_(), lane = tid & 63, wave = __builtin_amdgcn_readfirstlane(tid >> 6);
    const float* W = p.in[3] + (size_t)l * DM * DIN; const float* gain = p.in[1] + l * DM; const float* v1 = p.in[22] + (size_t)(l - 1) * RWW * LORA; const float* muv = p.in[11] + l * 1216 + 768;
    float* V1c = scr;
    float* Wr = scr + RWW * 64 + wave * RWW;
    for (int idx = tid; idx < RWW * 64; idx += 512) { const int c = idx >> 6, o = idx & 63; const float m = muv[c]; V1c[idx] = (o >= 32 ? m : 1.0f - m) * v1[c * LORA + (o & 31)]; }
    __syncthreads();
    for (int k = worker * 8 + wave; k < DM; k += nworkers * 8) {
        const float* wr = W + (size_t)k * DIN + 3072;
#pragma unroll
        for (int i = 0; i < 6; ++i) Wr[lane + 64 * i] = wr[lane + 64 * i];
        asm volatile("s_waitcnt lgkmcnt(0)" ::: "memory");
        float a0 = 0.f, a1 = 0.f, a2 = 0.f, a3 = 0.f;
#pragma unroll 4
        for (int c4 = 0; c4 < RWW / 4; ++c4) { const f32x4 w = *(const f32x4*)(Wr + 4 * c4);
            a0 += w[0] * V1c[(4 * c4) * 64 + lane]; a1 += w[1] * V1c[(4 * c4 + 1) * 64 + lane]; a2 += w[2] * V1c[(4 * c4 + 2) * 64 + lane]; a3 += w[3] * V1c[(4 * c4 + 3) * 64 + lane]; }
        WinT_l[(size_t)(3520 + lane) * DM + k] = f2bf(((a0 + a1) + (a2 + a3)) * gain[k]);
        asm volatile("s_waitcnt lgkmcnt(0)" ::: "memory");
    }
    __syncthreads();
}
__device__ void prep_weights(const Params& p, int l, unsigned char* lds, int worker, int nworkers) {
    float* tile = (float*)lds;
    bf16_t* WinT = (bf16_t*)(p.ws + WS_WIN) + (size_t)l * NINT * DM; bf16_t* WoutT = (bf16_t*)(p.ws + WS_WOUT) + (size_t)l * DM * DM; bf16_t* WpwT = (bf16_t*)(p.ws + WS_WPW) + (size_t)l * CW * CW;
    const int nt_in = (NINT / 64) * (DM / 64), nt_out = (DM / 64) * (DM / 64), nt_pw = (CW / 64) * (CW / 64);
    for (int j = worker; j < nt_in + nt_out + nt_pw; j += nworkers) {
        if (j < nt_in) transpose_tile(p.in[3] + (size_t)l * DM * DIN, DIN, DIN, p.in[1] + l * DM, WinT, DM, (j / (DM / 64)) * 64, (j % (DM / 64)) * 64, true, tile, l > 0);
        else if (j < nt_in + nt_out) { const int r = j - nt_in; transpose_tile(p.in[4] + (size_t)l * DM * DM, DM, DM, nullptr, WoutT, DM, (r / (DM / 64)) * 64, (r % (DM / 64)) * 64, false, tile); }
        else { const int r = j - nt_in - nt_out; transpose_tile(p.in[9] + (size_t)l * CW * CW, CW, CW, nullptr, WpwT, CW, (r >> 2) * 64, (r & 3) * 64, false, tile); }
    }
    if (l > 0) fold_v1_rows(p, l, WinT, tile, worker, nworkers);
}

__device__ void rows_to_xb(const float* X, bf16_t* XB) {
    const int tid = tid_(), lane = tid & 63, wave = __builtin_amdgcn_readfirstlane(tid >> 6);
    for (int row = blockIdx.x * 8 + wave; row < M; row += gridDim.x * 8) {
        const float* xr = X + (size_t)row * DM;
        f32x4 v[4]; float ss = 0.f;
#pragma unroll
        for (int i = 0; i < 4; ++i) { v[i] = __builtin_nontemporal_load((const f32x4*)(xr + i * 256 + lane * 4)); ss += v[i][0] * v[i][0] + v[i][1] * v[i][1] + v[i][2] * v[i][2] + v[i][3] * v[i][3]; }
        ss = wave_sum(ss);
        const float rstd = rsqrtf(ss * (1.0f / DM) + RMS_EPS);
#pragma unroll
        for (int i = 0; i < 4; ++i) { uint2 w; w.x = pk2(v[i][0] * rstd, v[i][1] * rstd); w.y = pk2(v[i][2] * rstd, v[i][3] * rstd); *(uint2*)(XB + (size_t)row * DM + i * 256 + lane * 4) = w; }
    }
}

__device__ __forceinline__ bool defer_layer1_weights() { return gridDim.x >= BATCH * NH + 32; }
__device__ void phase_prologue(const Params& p, unsigned char* lds) {
    prep_weights(p, 0, lds, blockIdx.x, gridDim.x);
    if (!defer_layer1_weights()) for (int l = 1; l < DEPTH; ++l) prep_weights(p, l, lds, blockIdx.x, gridDim.x);
    rows_to_xb(p.in[0], (bf16_t*)(p.ws + WS_XB));
}

namespace pg8 {
#define PG8_LAS __attribute__((address_space(3)))
typedef unsigned short bf16_t;
typedef short bf16x8 __attribute__((ext_vector_type(8)));
typedef float f32x4 __attribute__((ext_vector_type(4)));
typedef unsigned u32x4 __attribute__((ext_vector_type(4)));
constexpr int BM = 256, BK = 64, HALF = 128, HTB = HALF * BK * 2  , STAGE_BYTES = 8 * HTB, NXCD = 8, WGM = 8;

__host__ __device__ __forceinline__ int lds_byte(int r, int c) { const int st = (r >> 4) * 2 + (c >> 5), rr = r & 15, cc = c & 31, ob = rr * 64 + cc * 2; return st * 1024 + (ob ^ (((ob >> 9) & 1) << 5)); }
__host__ __device__ __forceinline__ void stage_rc(int b, int& R, int& C) { const int st = b / 1024, sb = b % 1024, swz = sb ^ (((sb >> 9) & 1) << 5); R = (st >> 1) * 16 + swz / 64; C = (st & 1) * 32 + (swz % 64) / 2; }
__host__ __device__ __forceinline__ int perm32(int rho) { const int n = rho >> 4, i = rho & 15; return 8 * (i >> 2) + 4 * n + (i & 3); }

struct Unit { int pm, pn; };
struct Gemm { const bf16_t* A; const bf16_t* Bt; int M, N, K; };

struct StaticOrder {
    int nM, nN, nwg, G, c;
    __host__ __device__ void init(int M, int N, int G_, int c_) { nM = M / BM; nN = N / BM; nwg = nM * nN; G = G_; c = c_; }
    __host__ __device__ bool next(int i, Unit& u) const {
        const long L = (long)i * G + c; if (L >= nwg) return false;
        int wgid = (int)L; { const int q = nwg / NXCD, r = nwg % NXCD, xcd = wgid % NXCD, off = wgid / NXCD; wgid = (xcd < r ? xcd * (q + 1) : r * (q + 1) + (xcd - r) * q) + off; }
        const int nig = WGM * nN, gid = wgid / nig, fm = gid * WGM, gsz = (nM - fm) < WGM ? (nM - fm) : WGM;
        u.pm = fm + ((wgid % nig) % gsz); u.pn = (wgid % nig) / gsz; return true;
    }
    __device__ __forceinline__ void a_ready(const Unit&) const {}
    __device__ __forceinline__ void done(const Unit&) const {}
};


__device__ __forceinline__ unsigned cvt_pk_bf16(float lo, float hi) { unsigned r; asm volatile("v_cvt_pk_bf16_f32 %0, %1, %2" : "=v"(r) : "v"(lo), "v"(hi)); return r; }

template <class Epi, class Sched, bool ALIGN_EPI = false, bool SP2 = false>
__device__ __forceinline__ void gemm_phase(PG8_LAS unsigned char* lds, const Gemm g, const Sched& S, const Epi& E) {
    const int tid = tid_(), wid = __builtin_amdgcn_readfirstlane(tid >> 6), lane = tid & 63, wr = wid >> 2, wc = wid & 3, fr = lane & 15, fq = lane >> 4;
    const int K = g.K, nt = K / BK;
    unsigned voffA[2], voffB[2];
#pragma unroll
    for (int i = 0; i < 2; ++i) { int R, C; stage_rc(tid * 16 + i * 8192, R, C); const int Rb = Epi::PERM ? ((R & ~31) + perm32(R & 31)) : R;
        voffA[i] = (unsigned)(R * K + C) * 2u; voffB[i] = (unsigned)(Rb * K + C) * 2u; }
    const size_t kstep = (size_t)(BK * 2);
    const size_t hstep = (size_t)HALF * K * 2;
    const size_t tstep = 2 * hstep;
    const unsigned ldsw = (unsigned)wid * 1024u;
    const int aoff = lds_byte(wr * 64 + fr, fq * 8), boff = lds_byte(wc * 32 + fr, fq * 8);
#define PG8_SA(b, h) (((b) * 2 + (h)) * HTB)
#define PG8_SB(b, h) ((4 + (b) * 2 + (h)) * HTB)
#define PG8_STAGE(bufoff, gbase, voff) do { _Pragma("unroll") for (int _i = 0; _i < 2; ++_i) \
        __builtin_amdgcn_global_load_lds((const unsigned*)((const char*)(gbase) + (voff)[_i]), (PG8_LAS unsigned*)(lds + (bufoff) + ldsw + _i * 8192), 16, 0, 0); } while (0)
#define PG8_LDA(dst, b, h) do { _Pragma("unroll") for (int m = 0; m < 4; ++m) _Pragma("unroll") for (int k = 0; k < 2; ++k) dst[m][k] = *(const PG8_LAS bf16x8*)(lds + PG8_SA(b, h) + aoff + m * 2048 + k * 1024); } while (0)
#define PG8_LDB(dst, b, h) do { _Pragma("unroll") for (int n = 0; n < 2; ++n) _Pragma("unroll") for (int k = 0; k < 2; ++k) dst[n][k] = *(const PG8_LAS bf16x8*)(lds + PG8_SB(b, h) + boff + n * 2048 + k * 1024); } while (0)
#define PG8_MMA(ai, bj, At, Bt) do { __builtin_amdgcn_s_setprio(1); _Pragma("unroll") for (int m = 0; m < 4; ++m) _Pragma("unroll") for (int n = 0; n < 2; ++n) _Pragma("unroll") for (int k = 0; k < 2; ++k) \
        acc[ai][bj][m][n] = __builtin_amdgcn_mfma_f32_16x16x32_bf16(Bt[n][k], At[m][k], acc[ai][bj][m][n], 0, 0, 0); __builtin_amdgcn_s_setprio(0); } while (0)
#define PG8_WAIT_V(n) asm volatile("s_waitcnt vmcnt(" #n ")" ::: "memory")
#define PG8_WAIT_L(n) asm volatile("s_waitcnt lgkmcnt(" #n ")" ::: "memory")
#define PG8_BAR __builtin_amdgcn_s_barrier()
#define PG8_SCHED __builtin_amdgcn_sched_barrier(0)
    Unit cur, nxt; int ui = 0;
    if (!S.next(0, cur)) return;
    f32x4 acc[2][2][4][2];
#pragma unroll
    for (int a = 0; a < 2; ++a)
#pragma unroll
        for (int b = 0; b < 2; ++b)
#pragma unroll
            for (int m = 0; m < 4; ++m)
#pragma unroll
                for (int n = 0; n < 2; ++n) acc[a][b][m][n] = (f32x4){0.f, 0.f, 0.f, 0.f};
    bf16x8 At[4][2], B0[2][2], B1[2][2];
    const char* cA = (const char*)g.A + (size_t)cur.pm * tstep; const char* cB = (const char*)g.Bt + (size_t)cur.pn * tstep;
    S.a_ready(cur);
    if constexpr (SP2) {
        PG8_STAGE(PG8_SB(0, 0), cB, voffB); PG8_STAGE(PG8_SB(0, 1), cB + hstep, voffB); PG8_STAGE(PG8_SA(0, 0), cA, voffA); PG8_STAGE(PG8_SA(0, 1), cA + hstep, voffA);
        if (wr == 1) PG8_BAR;
        PG8_WAIT_V(2); PG8_BAR;
        PG8_STAGE(PG8_SB(1, 0), cB + kstep, voffB); PG8_STAGE(PG8_SA(1, 0), cA + kstep, voffA); PG8_STAGE(PG8_SB(1, 1), cB + hstep + kstep, voffB);
        PG8_WAIT_V(6); PG8_BAR;
    } else {
        PG8_STAGE(PG8_SB(0, 0), cB, voffB); PG8_STAGE(PG8_SA(0, 0), cA, voffA); PG8_STAGE(PG8_SB(0, 1), cB + hstep, voffB); PG8_STAGE(PG8_SA(0, 1), cA + hstep, voffA);
        if (wr == 1) PG8_BAR;
        PG8_WAIT_V(4); PG8_BAR;
        PG8_STAGE(PG8_SB(1, 0), cB + kstep, voffB); PG8_STAGE(PG8_SA(1, 0), cA + kstep, voffA); PG8_STAGE(PG8_SB(1, 1), cB + hstep + kstep, voffB);
        PG8_WAIT_V(6); PG8_BAR;
    }
    for (;;) {
        const bool has_next = S.next(ui + 1, nxt);
        const char* nA = has_next ? (const char*)g.A + (size_t)nxt.pm * tstep : cA; const char* nB = has_next ? (const char*)g.Bt + (size_t)nxt.pn * tstep : cB;
        for (int t = 0; t < nt; t += 2) {
            const bool last = (t == nt - 2);
            const char* a1 = cA + (size_t)(t + 1) * kstep;
            const char* a2 = last ? nA : cA + (size_t)(t + 2) * kstep; const char* b2 = last ? nB : cB + (size_t)(t + 2) * kstep;
            const char* a3 = a2 + kstep; const char* b3 = b2 + kstep;
            if (last && has_next) S.a_ready(nxt);
            if constexpr (SP2) {
            PG8_LDB(B0, 0, 0); PG8_LDB(B1, 0, 1); PG8_SCHED; PG8_LDA(At, 0, 0); PG8_STAGE(PG8_SA(1, 1), a1 + hstep, voffA);
            PG8_WAIT_V(8); PG8_WAIT_L(0); PG8_BAR; PG8_MMA(0, 0, At, B0); PG8_MMA(0, 1, At, B1); PG8_BAR; PG8_SCHED;
            PG8_LDA(At, 0, 1); PG8_STAGE(PG8_SB(0, 0), b2, voffB); PG8_STAGE(PG8_SB(0, 1), b2 + hstep, voffB); PG8_STAGE(PG8_SA(0, 0), a2, voffA);
            PG8_WAIT_V(8); PG8_WAIT_L(0); PG8_BAR; PG8_MMA(1, 0, At, B0); PG8_MMA(1, 1, At, B1); PG8_BAR; PG8_SCHED;
            PG8_LDB(B0, 1, 0); PG8_LDB(B1, 1, 1); PG8_SCHED; PG8_LDA(At, 1, 0); PG8_STAGE(PG8_SA(0, 1), a2 + hstep, voffA);
            PG8_WAIT_V(8); PG8_WAIT_L(0); PG8_BAR; PG8_MMA(0, 0, At, B0); PG8_MMA(0, 1, At, B1); PG8_BAR; PG8_SCHED;
            PG8_LDA(At, 1, 1); PG8_STAGE(PG8_SB(1, 0), b3, voffB); PG8_STAGE(PG8_SB(1, 1), b3 + hstep, voffB); PG8_STAGE(PG8_SA(1, 0), a3, voffA);
            PG8_WAIT_V(8); PG8_WAIT_L(0); PG8_BAR; PG8_MMA(1, 0, At, B0); PG8_MMA(1, 1, At, B1); PG8_BAR; PG8_SCHED;
            } else {
            PG8_LDB(B0, 0, 0); PG8_SCHED; PG8_LDA(At, 0, 0); PG8_STAGE(PG8_SA(1, 1), a1 + hstep, voffA);
            PG8_WAIT_L(8); PG8_BAR; PG8_WAIT_L(0); PG8_MMA(0, 0, At, B0); PG8_BAR; PG8_SCHED;
            PG8_LDB(B1, 0, 1); PG8_STAGE(PG8_SB(0, 0), b2, voffB);
            PG8_BAR; PG8_WAIT_L(0); PG8_MMA(0, 1, At, B1); PG8_BAR;
            PG8_LDA(At, 0, 1); PG8_STAGE(PG8_SA(0, 0), a2, voffA);
            PG8_BAR; PG8_WAIT_L(0); PG8_MMA(1, 0, At, B0); PG8_BAR; PG8_SCHED;
            PG8_STAGE(PG8_SB(0, 1), b2 + hstep, voffB);
            PG8_WAIT_V(6); PG8_BAR; PG8_MMA(1, 1, At, B1); PG8_BAR;
            PG8_LDB(B0, 1, 0); PG8_SCHED; PG8_LDA(At, 1, 0); PG8_STAGE(PG8_SA(0, 1), a2 + hstep, voffA);
            PG8_WAIT_L(8); PG8_BAR; PG8_WAIT_L(0); PG8_MMA(0, 0, At, B0); PG8_BAR; PG8_SCHED;
            PG8_LDB(B1, 1, 1); PG8_STAGE(PG8_SB(1, 0), b3, voffB);
            PG8_BAR; PG8_WAIT_L(0); PG8_MMA(0, 1, At, B1); PG8_BAR;
            PG8_LDA(At, 1, 1); PG8_STAGE(PG8_SA(1, 0), a3, voffA);
            PG8_BAR; PG8_WAIT_L(0); PG8_MMA(1, 0, At, B0); PG8_BAR; PG8_SCHED;
            PG8_STAGE(PG8_SB(1, 1), b3 + hstep, voffB);
            PG8_WAIT_V(6); PG8_BAR; PG8_MMA(1, 1, At, B1); PG8_BAR;
            }
        }
        if constexpr (ALIGN_EPI) { if (wr == 0) PG8_BAR; }
        if constexpr (!Epi::AFTER_DRAIN) { E(acc, cur, wr, wc, fr, fq); S.done(cur); }
        if (!has_next) break;
#pragma unroll
        for (int a = 0; a < 2; ++a)
#pragma unroll
            for (int b = 0; b < 2; ++b)
#pragma unroll
                for (int m = 0; m < 4; ++m)
#pragma unroll
                    for (int n = 0; n < 2; ++n) acc[a][b][m][n] = (f32x4){0.f, 0.f, 0.f, 0.f};
        cur = nxt; cA = nA; cB = nB; ++ui;
        if constexpr (ALIGN_EPI) { if (wr == 1) PG8_BAR; }
    }
    PG8_WAIT_V(0);
    if constexpr (!ALIGN_EPI) { if (wr == 0) PG8_BAR; }
    PG8_BAR;
    if constexpr (Epi::AFTER_DRAIN) { E.fused(acc, cur, wr, wc, fr, fq, lds, wid, lane); S.done(cur); }
#undef PG8_SA
#undef PG8_SB
#undef PG8_STAGE
#undef PG8_LDA
#undef PG8_LDB
#undef PG8_MMA
#undef PG8_WAIT_V
#undef PG8_WAIT_L
#undef PG8_BAR
#undef PG8_SCHED
}
}

struct EpiInProjP {
    static constexpr bool PERM = true, AFTER_DRAIN = false;
    bf16_t *PC, *PS, *PR, *PG, *VT;
    __device__ __forceinline__ void operator()(const pg8::f32x4 (&acc)[2][2][4][2], const pg8::Unit& u, int wr, int wc, int fr, int fq) const {
        const int row0 = u.pm * 256 + wr * 64 + fr;
#pragma unroll
        for (int bj = 0; bj < 2; ++bj) {
            const int blk = 2 * u.pn + bj; bf16_t* base; int ld, c0;
            if (blk >= 12 && blk < 15) {
                const int vc = 128 * (blk - 12) + wc * 32 + 8 * fq;
#pragma unroll
                for (int ai = 0; ai < 2; ++ai)
#pragma unroll
                    for (int m = 0; m < 4; ++m) {
                        const int row = row0 + ai * 128 + m * 16, b = row >> 11, t = row & 2047;
#pragma unroll
                        for (int n = 0; n < 2; ++n)
#pragma unroll
                            for (int e = 0; e < 4; ++e) { const int col = vc + 4 * n + e, hh = col >> 6, d = col & 63;
                                VT[((size_t)(b * NH + hh) * HD + d) * SEQ + t] = f2bf(acc[ai][bj][m][n][e]); }
                    }
                continue;
            }
            if (blk < 6) { base = PC; ld = PC_W; c0 = 128 * blk; }
            else if (blk < 12) { base = PS; ld = PS_W; c0 = 128 * (blk - 6); }
            else if (blk < 18) { base = PS; ld = PS_W; c0 = 768 + 128 * (blk - 15); }
            else if (blk < 28) { base = PR; ld = PR_W; c0 = 128 * (blk - 18); }
            else if (blk < 31) { base = PG; ld = PG_W; c0 = 128 * (blk - 28); }
            else continue;
            const int col = c0 + wc * 32 + 8 * fq;
#pragma unroll
            for (int ai = 0; ai < 2; ++ai)
#pragma unroll
                for (int m = 0; m < 4; ++m) {
                    const pg8::f32x4 v0 = acc[ai][bj][m][0], v1 = acc[ai][bj][m][1]; pg8::u32x4 w;
                    w.x = pg8::cvt_pk_bf16(v0[0], v0[1]); w.y = pg8::cvt_pk_bf16(v0[2], v0[3]); w.z = pg8::cvt_pk_bf16(v1[0], v1[1]); w.w = pg8::cvt_pk_bf16(v1[2], v1[3]);
                    *(pg8::u32x4*)(base + (size_t)(row0 + ai * 128 + m * 16) * ld + col) = w;
                }
        }
    }
};
struct EpiOutBf16P {
    static constexpr bool PERM = true, AFTER_DRAIN = false;
    bf16_t* Y; int ld;
    __device__ __forceinline__ void operator()(const pg8::f32x4 (&acc)[2][2][4][2], const pg8::Unit& u, int wr, int wc, int fr, int fq) const {
        const int row0 = u.pm * 256 + wr * 64 + fr, col0 = u.pn * 256 + wc * 32 + 8 * fq;
#pragma unroll
        for (int ai = 0; ai < 2; ++ai)
#pragma unroll
            for (int m = 0; m < 4; ++m)
#pragma unroll
                for (int bj = 0; bj < 2; ++bj) {
                    const pg8::f32x4 v0 = acc[ai][bj][m][0], v1 = acc[ai][bj][m][1]; pg8::u32x4 w;
                    w.x = pg8::cvt_pk_bf16(v0[0], v0[1]); w.y = pg8::cvt_pk_bf16(v0[2], v0[3]); w.z = pg8::cvt_pk_bf16(v1[0], v1[1]); w.w = pg8::cvt_pk_bf16(v1[2], v1[3]);
                    *(pg8::u32x4*)(Y + (size_t)(row0 + ai * 128 + m * 16) * ld + col0 + bj * 128) = w;
                }
    }
};

__device__ void phase_rowpass(const float* Xin, const bf16_t* Y, const float* gpost, float* Xout, bf16_t* XB) {
    const int tid = tid_(), lane = tid & 63, wave = __builtin_amdgcn_readfirstlane(tid >> 6);
    for (int row = blockIdx.x * 8 + wave; row < M; row += gridDim.x * 8) {
        f32x4 y[4], x[4]; float ss = 0.f;
#pragma unroll
        for (int i = 0; i < 4; ++i) { const uint2 yw = ldnt_u2((const void*)(Y + (size_t)row * DM + i * 256 + lane * 4));
            y[i] = (f32x4){bf2f((bf16_t)(yw.x & 0xffff)), bf2f((bf16_t)(yw.x >> 16)), bf2f((bf16_t)(yw.y & 0xffff)), bf2f((bf16_t)(yw.y >> 16))};
            x[i] = __builtin_nontemporal_load((const f32x4*)(Xin + (size_t)row * DM + i * 256 + lane * 4));
            ss += y[i][0] * y[i][0] + y[i][1] * y[i][1] + y[i][2] * y[i][2] + y[i][3] * y[i][3]; }
        ss = wave_sum(ss);
        const float rstd = rsqrtf(ss * (1.0f / DM) + RMS_EPS);
        float s2 = 0.f;
#pragma unroll
        for (int i = 0; i < 4; ++i) { const f32x4 g = *(const f32x4*)(gpost + i * 256 + lane * 4);
            x[i] = x[i] + y[i] * rstd * g; s2 += x[i][0] * x[i][0] + x[i][1] * x[i][1] + x[i][2] * x[i][2] + x[i][3] * x[i][3];
            __builtin_nontemporal_store(x[i], (f32x4*)(Xout + (size_t)row * DM + i * 256 + lane * 4)); }
        if (XB) {
            s2 = wave_sum(s2);
            const float r2 = rsqrtf(s2 * (1.0f / DM) + RMS_EPS);
#pragma unroll
            for (int i = 0; i < 4; ++i) { uint2 w; w.x = pk2(x[i][0] * r2, x[i][1] * r2); w.y = pk2(x[i][2] * r2, x[i][3] * r2); *(uint2*)(XB + (size_t)row * DM + i * 256 + lane * 4) = w; }
        }
    }
}

constexpr int CV_AS = 264;
constexpr int CV_CS = 264;
__device__ void conv_job64(const Params& p, int l, int job, unsigned char* lds) {
    const int tid = tid_(), lane = tid & 63, wave = __builtin_amdgcn_readfirstlane(tid >> 6), fr = lane & 15, fq = lane >> 4;
    const int b = job >> 5, t0 = (job & 31) * 64;
    const bf16_t* PC = (const bf16_t*)(p.ws + WS_PC); bf16_t* MIX = (bf16_t*)(p.ws + WS_MIX);
    const float* dw = p.in[5] + l * TAPS * CW; const float* dwb = p.in[6] + l * CW; const float* lng = p.in[7] + l * CW; const float* lnb = p.in[8] + l * CW;
    const bf16_t* pwT = (const bf16_t*)(p.ws + WS_WPW) + (size_t)l * CW * CW; const float* pwb = p.in[10] + l * CW;
    float* u = (float*)lds;
    bf16_t* act = (bf16_t*)(lds + 94 * 256 * 4);
    for (int idx = tid; idx < 94 * 32; idx += 512) {
        const int r = idx >> 5, c8 = (idx & 31) * 8, t = t0 - 30 + r;
        float v[8];
        if (t >= 0) { const bf16_t* pr = PC + ((size_t)b * SEQ + t) * PC_W + c8; const bf16x8 a = *(const bf16x8*)pr, g = *(const bf16x8*)(pr + 256);
#pragma unroll
            for (int e = 0; e < 8; ++e) v[e] = bf2f((bf16_t)a[e]) * __builtin_amdgcn_rcpf(1.0f + __builtin_amdgcn_exp2f(-1.4426950408889634f * bf2f((bf16_t)g[e]))); }
        else {
#pragma unroll
            for (int e = 0; e < 8; ++e) v[e] = 0.f; }
        *(f32x4*)(u + r * 256 + c8) = (f32x4){v[0], v[1], v[2], v[3]}; *(f32x4*)(u + r * 256 + c8 + 4) = (f32x4){v[4], v[5], v[6], v[7]};
    }
    __syncthreads();
    const int c = tid & 255, half = tid >> 8;
    float acc[32];
    {
        float w[TAPS];
#pragma unroll
        for (int j = 0; j < TAPS; ++j) w[j] = dw[j * CW + c];
        const float bias = dwb[c];
#pragma unroll
        for (int i = 0; i < 32; ++i) acc[i] = bias;
        const float* up = u + (half * 32) * 256 + c;
#pragma unroll
        for (int rr = 0; rr < 62; ++rr) {
            const float uv = up[rr * 256];
#pragma unroll
            for (int i = 0; i < 32; ++i) { if (rr - i >= 0 && rr - i < TAPS) acc[i] += w[rr - i] * uv; }
        }
    }
    __syncthreads();
    float* cv = u;
#pragma unroll
    for (int i = 0; i < 32; ++i) cv[(half * 32 + i) * CV_CS + c] = acc[i];
    __syncthreads();
    {
        const int tt = wave * 8 + (lane >> 3), pp = lane & 7;
        f32x4 x[8]; float s_ = 0.f;
#pragma unroll
        for (int k = 0; k < 8; ++k) { x[k] = *(const f32x4*)(cv + tt * CV_CS + 4 * pp + 32 * k); s_ += (x[k][0] + x[k][1]) + (x[k][2] + x[k][3]); }
        s_ += __shfl_xor(s_, 1); s_ += __shfl_xor(s_, 2); s_ += __shfl_xor(s_, 4);
        const float mean = s_ * (1.0f / CW); float q_ = 0.f;
#pragma unroll
        for (int k = 0; k < 8; ++k) { x[k] = x[k] - mean; q_ += (x[k][0] * x[k][0] + x[k][1] * x[k][1]) + (x[k][2] * x[k][2] + x[k][3] * x[k][3]); }
        q_ += __shfl_xor(q_, 1); q_ += __shfl_xor(q_, 2); q_ += __shfl_xor(q_, 4);
        const float rstd = rsqrtf(q_ * (1.0f / CW) + LN_EPS);
#pragma unroll
        for (int k = 0; k < 8; ++k) {
            const f32x4 g = *(const f32x4*)(lng + 4 * pp + 32 * k), bb = *(const f32x4*)(lnb + 4 * pp + 32 * k);
            float y[4];
#pragma unroll
            for (int e = 0; e < 4; ++e) y[e] = siluf_(x[k][e] * rstd * g[e] + bb[e]);
            uint2 w; w.x = pk2(y[0], y[1]); w.y = pk2(y[2], y[3]); *(uint2*)(act + tt * CV_AS + 4 * pp + 32 * k) = w;
        }
    }
    __syncthreads();
    {
        f32x4 o[2][4];
#pragma unroll
        for (int i = 0; i < 2; ++i)
#pragma unroll
            for (int j = 0; j < 4; ++j) o[i][j] = (f32x4){0.f, 0.f, 0.f, 0.f};
#pragma unroll 2
        for (int kk = 0; kk < 8; ++kk) {
            bf16x8 a[2], bq[4];
#pragma unroll
            for (int i = 0; i < 2; ++i) a[i] = *(const bf16x8*)(pwT + (size_t)(wave * 32 + i * 16 + fr) * CW + kk * 32 + fq * 8);
#pragma unroll
            for (int j = 0; j < 4; ++j) bq[j] = *(const bf16x8*)(act + (j * 16 + fr) * CV_AS + kk * 32 + fq * 8);
#pragma unroll
            for (int i = 0; i < 2; ++i)
#pragma unroll
                for (int j = 0; j < 4; ++j) o[i][j] = __builtin_amdgcn_mfma_f32_16x16x32_bf16(a[i], bq[j], o[i][j], 0, 0, 0);
        }
#pragma unroll
        for (int i = 0; i < 2; ++i) {
            const int n0 = wave * 32 + i * 16 + fq * 4; const f32x4 bias = *(const f32x4*)(pwb + n0);
#pragma unroll
            for (int j = 0; j < 4; ++j) {
                const size_t row = (size_t)b * SEQ + t0 + j * 16 + fr;
                const uint2 gw = *(const uint2*)(PC + row * PC_W + 512 + n0);
                const float g0 = bf2f((bf16_t)(gw.x & 0xffff)), g1 = bf2f((bf16_t)(gw.x >> 16)), g2 = bf2f((bf16_t)(gw.y & 0xffff)), g3 = bf2f((bf16_t)(gw.y >> 16));
                const f32x4 v = o[i][j] + bias;
                uint2 w; w.x = pk2(v[0] * siluf_(g0), v[1] * siluf_(g1)); w.y = pk2(v[2] * siluf_(g2), v[3] * siluf_(g3));
                *(uint2*)(MIX + row * DM + n0) = w;
            }
        }
    }
    __syncthreads();
}

typedef float f32x16 __attribute__((ext_vector_type(16)));
struct AttFrag { bf16x8 K[4], V[2][2]; };
constexpr int AT_WIN = 224;
constexpr int AT_KS = 144, AT_VS = 976;
constexpr int AT_VOFF = (AT_WIN + 256) * AT_KS;
static_assert(AT_VOFF + 64 * AT_VS <= 147456, "attention LDS map");
__device__ __forceinline__ void att_load(AttFrag& F, const bf16_t* kbase, const bf16_t* vbase, const unsigned char* klds, const unsigned char* vlds, int w0, int kt) {
    const int s0 = (kt > 0 ? kt : 0) * 32;
    if (s0 >= w0) {
        const unsigned char* kp = klds + (s0 - w0) * AT_KS; const unsigned char* vp = vlds + (s0 - w0) * 2;
#pragma unroll
        for (int ks = 0; ks < 4; ++ks) F.K[ks] = *(const bf16x8*)(kp + ks * 32);
#pragma unroll
        for (int db = 0; db < 2; ++db)
#pragma unroll
            for (int s = 0; s < 2; ++s) F.V[db][s] = *(const bf16x8*)(vp + db * 32 * AT_VS + s * 16);
    } else {
#pragma unroll
        for (int ks = 0; ks < 4; ++ks) F.K[ks] = *(const bf16x8*)(kbase + (size_t)s0 * PS_W + ks * 16);
#pragma unroll
        for (int db = 0; db < 2; ++db)
#pragma unroll
            for (int s = 0; s < 2; ++s) F.V[db][s] = *(const bf16x8*)(vbase + (size_t)db * 32 * SEQ + s0 + s * 8);
    }
}
__device__ __forceinline__ bool att_tile(const AttFrag& F, const bf16x8 (&Qf)[4], f32x16& O0, f32x16& O1, float& rp, bool diag, int qi, int hf) {
    f32x16 S;
#pragma unroll
    for (int r = 0; r < 16; ++r) S[r] = 0.f;
#pragma unroll
    for (int ks = 0; ks < 4; ++ks) S = __builtin_amdgcn_mfma_f32_32x32x16_bf16(F.K[ks], Qf[ks], S, 0, 0, 0);
    float tot = 1.0f;
#pragma unroll
    for (int r = 0; r < 16; ++r) {
        float k_ = __builtin_amdgcn_rcpf(1.0f + __builtin_amdgcn_exp2f(S[r]));
        if (diag && (hf * 16 + r >= qi)) k_ = 1.0f;
        S[r] = k_; tot *= k_;
    }
    const float toto = __shfl_xor(tot, 32);
    float e = hf ? rp : rp * toto;
#pragma unroll
    for (int r = 15; r >= 0; --r) { const float k_ = S[r]; S[r] = (1.0f - k_) * e; e *= k_; }
    rp = rp * tot * toto;
    bf16x8 Pf[2];
#pragma unroll
    for (int s = 0; s < 2; ++s) {
        union { bf16x8 v; unsigned u[4]; } pk;
#pragma unroll
        for (int j = 0; j < 4; ++j) pk.u[j] = pk2(S[8 * s + 2 * j], S[8 * s + 2 * j + 1]);
        Pf[s] = pk.v;
    }
#pragma unroll
    for (int s = 0; s < 2; ++s) { O0 = __builtin_amdgcn_mfma_f32_32x32x16_bf16(F.V[0][s], Pf[s], O0, 0, 0, 0); O1 = __builtin_amdgcn_mfma_f32_32x32x16_bf16(F.V[1][s], Pf[s], O1, 0, 0, 0); }
    return __ballot(rp != 0.0f) == 0ull;
}
__device__ void attn_wg_job(const Params& p, int job, unsigned char* lds) {
    const int tid = tid_(), lane = tid & 63, wave = __builtin_amdgcn_readfirstlane(tid >> 6), qi = lane & 31, hf = lane >> 5;
    const int bh = job >> 3, g = job & 7, b = bh / NH, h = bh % NH;
    const bf16_t* PS = (const bf16_t*)(p.ws + WS_PS); const bf16_t* VT = (const bf16_t*)(p.ws + WS_VT) + (size_t)bh * HD * SEQ; bf16_t* MIX = (bf16_t*)(p.ws + WS_MIX);
    const int w0 = g * 256 > AT_WIN ? g * 256 - AT_WIN : 0, nkeys = g * 256 + 256 - w0;
    unsigned char* klds = lds; unsigned char* vlds = lds + AT_VOFF;
    bf16x8 Qf[4];
#pragma unroll
    for (int ks = 0; ks < 4; ++ks) Qf[ks] = *(const bf16x8*)(PS + ((size_t)b * SEQ + (g * 8 + wave) * 32 + qi) * PS_W + h * HD + ks * 16 + hf * 8);
    {
        const bf16_t* ksrc = PS + ((size_t)b * SEQ + w0) * PS_W + SBW + h * HD;
        for (int idx = tid; idx < nkeys * 8; idx += 512) { const int row = idx >> 3, pc = idx & 7; *(uint4*)(klds + row * AT_KS + pc * 16) = *(const uint4*)(ksrc + (size_t)row * PS_W + pc * 8); }
        const int pc = tid & 63, npc = nkeys >> 3;
        if (pc < npc) {
#pragma unroll
            for (int i = 0; i < 8; ++i) { const int d = (tid >> 6) + 8 * i; *(uint4*)(vlds + d * AT_VS + pc * 16) = *(const uint4*)(VT + (size_t)d * SEQ + w0 + pc * 8); }
        }
    }
    __syncthreads();
    {
        const int qblk = g * 8 + wave, q0 = qblk * 32;
        const size_t rowq = (size_t)b * SEQ + q0 + qi;
        const int pi = (qi & 3) + 4 * (qi >> 3) + 16 * ((qi >> 2) & 1);
        const bf16_t* kbase = PS + ((size_t)b * SEQ + pi) * PS_W + SBW + h * HD + hf * 8;
        const bf16_t* vbase = VT + (size_t)qi * SEQ + hf * 16;
        const unsigned char* kl = klds + pi * AT_KS + hf * 16; const unsigned char* vl = vlds + qi * AT_VS + hf * 32;
        AttFrag FA, FB;
        att_load(FA, kbase, vbase, kl, vl, w0, qblk);
        f32x16 O0, O1;
#pragma unroll
        for (int r = 0; r < 16; ++r) { O0[r] = 0.f; O1[r] = 0.f; }
        float rp = 1.0f;
        for (int kt = qblk; kt >= 0; kt -= 2) {
            att_load(FB, kbase, vbase, kl, vl, w0, kt - 1);
            if (att_tile(FA, Qf, O0, O1, rp, kt == qblk, qi, hf) || kt < 1) break;
            att_load(FA, kbase, vbase, kl, vl, w0, kt - 2);
            if (att_tile(FB, Qf, O0, O1, rp, false, qi, hf)) break;
        }
        const bf16_t* gp = PS + rowq * PS_W + 768 + h * HD; bf16_t* op = MIX + rowq * DM + CW + h * HD;
#pragma unroll
        for (int db = 0; db < 2; ++db)
#pragma unroll
            for (int gq = 0; gq < 4; ++gq) {
                const int d0 = db * 32 + gq * 8 + hf * 4;
                const uint2 gw = *(const uint2*)(gp + d0);
                const float g0 = bf2f((bf16_t)(gw.x & 0xffff)), g1 = bf2f((bf16_t)(gw.x >> 16)), g2 = bf2f((bf16_t)(gw.y & 0xffff)), g3 = bf2f((bf16_t)(gw.y >> 16));
                const f32x16& O = db ? O1 : O0;
                uint2 w; w.x = pk2(O[4 * gq] * siluf_(g0), O[4 * gq + 1] * siluf_(g1)); w.y = pk2(O[4 * gq + 2] * siluf_(g2), O[4 * gq + 3] * siluf_(g3));
                *(uint2*)(op + d0) = w;
            }
    }
    __syncthreads();
}

constexpr int TS = 72;
constexpr int TILE_B = 64 * TS * 2;
constexpr int AABS = 68, XTS = 65, CSS = 65;

__device__ __forceinline__ f32x4 mm_tile(const bf16_t* X, int m0, const bf16_t* Yt, int n0, int K, int fr, int fq, f32x4 acc) {
#pragma unroll
    for (int kk = 0; kk < 2; ++kk) {
        if (kk * 32 < K) {
            const bf16x8 a = *(const bf16x8*)(X + (m0 + fr) * TS + kk * 32 + fq * 8);
            const bf16x8 b = *(const bf16x8*)(Yt + (n0 + fr) * TS + kk * 32 + fq * 8);
            acc = __builtin_amdgcn_mfma_f32_16x16x32_bf16(a, b, acc, 0, 0, 0);
        }
    }
    return acc;
}
__device__ __forceinline__ uint2 pk4(const f32x4& v) { uint2 w; w.x = pk2(v[0], v[1]); w.y = pk2(v[2], v[3]); return w; }

struct B1Loads {
    bf16x8 rc, kc, vc, rp, kp, vp;
    f32x4 vf0, vf1;
    bf16x8 cc[2], cp[2];
};
__device__ __forceinline__ void b1_issue_loads(const Params& p, int l, int gi, int h, int tid, B1Loads& L) {
    const int b = gi >> 5, c = gi & 31, t0 = c * 64;
    const bf16_t* PR = (const bf16_t*)(p.ws + WS_PR); const float* VF = (const float*)(p.ws + WS_VF);
    {
        const int tt = tid >> 3, j0 = (tid & 7) * 8, t = t0 + tt, cj0 = h * HD + j0; const size_t row = (size_t)b * SEQ + t;
        const bf16_t* cur = PR + row * PR_W; const bf16_t* prv = cur - (t > 0 ? PR_W : 0);
        L.rc = *(const bf16x8*)(cur + cj0); L.kc = *(const bf16x8*)(cur + 384 + cj0); L.vc = *(const bf16x8*)(cur + 768 + cj0);
        L.rp = *(const bf16x8*)(prv + cj0); L.kp = *(const bf16x8*)(prv + 384 + cj0); L.vp = *(const bf16x8*)(prv + 768 + cj0);
        if (l > 0) { L.vf0 = *(const f32x4*)(VF + row * RWW + cj0); L.vf1 = *(const f32x4*)(VF + row * RWW + cj0 + 4); }
    }
    if (h == 0) {
#pragma unroll
        for (int q = 0; q < 2; ++q) {
            const int item = tid + 512 * q, tt = item >> 4, g = item & 15, t = t0 + tt;
            const bf16_t* cur = PR + ((size_t)b * SEQ + t) * PR_W + 1152; const bf16_t* prv = cur - (t > 0 ? PR_W : 0);
            const int gc = g < 12 ? g : 0, gp = g < 8 ? g : (g < 12 ? g + 4 : 0);
            L.cc[q] = *(const bf16x8*)(cur + 8 * gc); L.cp[q] = *(const bf16x8*)(prv + 8 * gp);
        }
    }
}

__device__ void rwkv_b1_phase(const Params& p, int l, unsigned char* lds) {
    const int G = gridDim.x;
    float* VF = (float*)(p.ws + WS_VF);
    const float* mu = p.in[11] + l * 1216; const float* w0 = p.in[12] + l * RWW;
    const float* a0 = p.in[14] + l * RWW; const float* kks = p.in[16] + l * RWW; const float* ka = p.in[17] + l * RWW;
    const float* rk = p.in[18] + l * RWW; const float* v0 = p.in[21];
    const float* w2 = p.in[13] + l * LORA * RWW; const float* a2 = p.in[15] + l * LORA * RWW; const float* v2 = p.in[23];
    bf16_t* T_At = (bf16_t*)lds; bf16_t* T_Rt = T_At + 64 * TS; bf16_t* T_Bt = T_Rt + 64 * TS; bf16_t* T_Kt = T_Bt + 64 * TS;
    bf16_t* T_VT = T_Kt + 64 * TS; bf16_t* T_bhT = T_VT + 64 * TS; bf16_t* T_khT = T_bhT + 64 * TS;
    bf16_t* T_Aak = T_khT + 64 * TS; bf16_t* T_Arb = T_Aak + 64 * TS; bf16_t* T_Ark = T_Arb + 64 * TS;
    bf16_t* T_WT = T_At; bf16_t* T_U0T = T_Bt;
    float* Aab = (float*)(lds + 10 * TILE_B);
    float* XT = (float*)(lds + 10 * TILE_B + 64 * AABS * 4);
    float* PCv = XT + 128 * XTS;
    float* TI = PCv + 64;
    float* CS = (float*)T_Aak;
    constexpr int LS = 33;
    float* WD = Aab; float* AD = WD + 64 * LS;
    float* VL = XT + 64 * XTS;
    float* WLT = (float*)lds; float* ALT = WLT + 64 * XTS; float* VGT = ALT + 64 * XTS;

    constexpr int NGRP = BATCH * (SEQ / 64);
    int gi = blockIdx.x;
    if (gi >= NGRP) return;
    B1Loads L;
    b1_issue_loads(p, l, gi, 0, tid_(), L);
    float codes[2][8];
#pragma unroll 1
    for (int it = 0; gi < NGRP; ++it) {
        const int h = it % NH;
        const int tid = tid_(), lane = tid & 63, wave = __builtin_amdgcn_readfirstlane(tid >> 6), fr = lane & 15, fq = lane >> 4;
        const int b = gi >> 5, c = gi & 31, bh = b * NH + h, jb = bh * 32 + c, t0 = c * 64;
        float wg[6][8];
#pragma unroll
        for (int q = 0; q < 6; ++q) {
            const int id = wave + 8 * q, Lk = id >> 4, tj = id & 3;
            if (q < 4 || l > 0) {
                const float* Wg = (Lk == 0 ? w2 : (Lk == 1 ? a2 : v2)) + (size_t)fq * RWW + h * HD + tj * 16 + fr;
#pragma unroll
                for (int kk = 0; kk < 8; ++kk) wg[q][kk] = Wg[(size_t)kk * 4 * RWW];
            }
        }
#pragma unroll
        for (int q = 0; q < 2; ++q) {
            const int item = tid + 512 * q, tt = item >> 4, g = item & 15, t = t0 + tt; const bool hp = t > 0;
            if (h == 0) {
#pragma unroll
                for (int e = 0; e < 8; ++e) {
                    const float xc = bf2f((bf16_t)L.cc[q][e]), xp = hp ? bf2f((bf16_t)L.cp[q][e]) : 0.f;
                    const float x_ = xc + (xp - xc) * mu[1152 + 8 * (g & 7) + e];
                    codes[q][e] = g < 4 ? 1.0f - 2.0f * __builtin_amdgcn_rcpf(1.0f + __builtin_amdgcn_exp2f(2.8853900817779268f * x_)) : (g < 8 ? x_ : xc + xp);
                }
            }
            if (g < 8 || (g < 12 && l > 0)) {
                float* dst = (g < 4 ? WD + tt * LS + 8 * g : (g < 8 ? AD + tt * LS + 8 * (g - 4) : VL + tt * LS + 8 * (g - 8)));
#pragma unroll
                for (int e = 0; e < 8; ++e) dst[e] = codes[q][e];
            }
        }
        __syncthreads();
#pragma unroll
        for (int q = 0; q < 6; ++q) {
            if (q < 4 || l > 0) {
                const int id = wave + 8 * q, Lk = id >> 4, ti = (id >> 2) & 3, tj = id & 3;
                const float* Xs = (Lk == 0 ? WD : (Lk == 1 ? AD : VL)) + (ti * 16 + fr) * LS + fq;
                f32x4 acc = (f32x4){0.f, 0.f, 0.f, 0.f};
#pragma unroll
                for (int kk = 0; kk < 8; ++kk) acc = __builtin_amdgcn_mfma_f32_16x16x4f32(Xs[kk * 4], wg[q][kk], acc, 0, 0, 0);
                float* out = (Lk == 0 ? WLT : (Lk == 1 ? ALT : VGT)) + (tj * 16 + fr) * XTS + ti * 16 + fq * 4;
#pragma unroll
                for (int r = 0; r < 4; ++r) out[r] = acc[r];
            }
        }
        __syncthreads();
        const int tt = tid >> 3, j0 = (tid & 7) * 8, t = t0 + tt, cj0 = h * HD + j0;
        const size_t row = (size_t)b * SEQ + t;
        float rr[8], kk_[8], vv[8], aa[8], bb[8], lw[8];
        {
            const bool hp = t > 0;
            float wl[8], al[8], vg[8];
#pragma unroll
            for (int e = 0; e < 8; ++e) {
                const float r_c = bf2f((bf16_t)L.rc[e]), k_c = bf2f((bf16_t)L.kc[e]), v_c = bf2f((bf16_t)L.vc[e]);
                const float r_p = hp ? bf2f((bf16_t)L.rp[e]) : 0.f, k_p = hp ? bf2f((bf16_t)L.kp[e]) : 0.f, v_p = hp ? bf2f((bf16_t)L.vp[e]) : 0.f;
                rr[e] = r_c + (r_p - r_c) * mu[cj0 + e]; kk_[e] = k_c + (k_p - k_c) * mu[384 + cj0 + e]; vv[e] = v_c + (v_p - v_c) * mu[768 + cj0 + e];
                wl[e] = w0[cj0 + e] + WLT[(j0 + e) * XTS + tt]; al[e] = a0[cj0 + e] + ALT[(j0 + e) * XTS + tt]; vg[e] = l > 0 ? v0[cj0 + e] + VGT[(j0 + e) * XTS + tt] : 0.f;
            }
            float ssq = 0.f, bon = 0.f;
#pragma unroll
            for (int e = 0; e < 8; ++e) {
                const float sp2 = fmaxf(-wl[e], 0.f) * 1.4426950408889634f + __builtin_amdgcn_logf(1.0f + __builtin_amdgcn_exp2f(-1.4426950408889634f * fabsf(wl[e])));
                lw[e] = -__builtin_amdgcn_exp2f(-sp2 - 0.7213475204444817f);
                const float alr = __builtin_amdgcn_rcpf(1.0f + __builtin_amdgcn_exp2f(-1.4426950408889634f * al[e]));
                if (l > 0) { const float vf = e < 4 ? L.vf0[e & 3] : L.vf1[e & 3]; vv[e] = vv[e] + (vf - vv[e]) * __builtin_amdgcn_rcpf(1.0f + __builtin_amdgcn_exp2f(-1.4426950408889634f * vg[e])); }
                const float kkr = kk_[e] * kks[cj0 + e];
                kk_[e] = kk_[e] * (1.0f + (alr - 1.0f) * ka[cj0 + e]);
                aa[e] = kkr; bb[e] = alr; ssq += kkr * kkr; bon += rr[e] * kk_[e] * rk[cj0 + e];
            }
            if (l == 0) { __builtin_nontemporal_store((f32x4){vv[0], vv[1], vv[2], vv[3]}, (f32x4*)(VF + row * RWW + cj0)); __builtin_nontemporal_store((f32x4){vv[4], vv[5], vv[6], vv[7]}, (f32x4*)(VF + row * RWW + cj0 + 4)); }
            ssq += __shfl_xor(ssq, 1); ssq += __shfl_xor(ssq, 2); ssq += __shfl_xor(ssq, 4);
            bon += __shfl_xor(bon, 1); bon += __shfl_xor(bon, 2); bon += __shfl_xor(bon, 4);
            const float inv = fminf(__builtin_amdgcn_rsqf(ssq), 1e12f);
            uint4 bvw; float bv[8];
#pragma unroll
            for (int e = 0; e < 8; ++e) { const float kn = aa[e] * inv; aa[e] = -kn; bb[e] = kn * bb[e]; bv[e] = bon * vv[e]; CS[tt * CSS + j0 + e] = lw[e]; }
            bvw.x = pk2(bv[0], bv[1]); bvw.y = pk2(bv[2], bv[3]); bvw.z = pk2(bv[4], bv[5]); bvw.w = pk2(bv[6], bv[7]);
            *(uint4*)((bf16_t*)(p.ws + WS_CH_BV) + (size_t)jb * 4096 + tt * 64 + j0) = bvw;
        }
        __syncthreads();
#pragma unroll
        for (int e = 0; e < 8; ++e) {
            const int j = wave * 8 + e; float x = CS[lane * CSS + j];
#pragma unroll
            for (int o = 1; o < 64; o <<= 1) { const float y = __shfl_up(x, o); if (lane >= o) x += y; }
            CS[lane * CSS + j] = x;
        }
        __syncthreads();
        {
            float at[8], rt[8], bt[8], kt[8];
#pragma unroll
            for (int e = 0; e < 8; ++e) {
                const int j = j0 + e; const float cs = CS[tt * CSS + j] * 1.4426950408889634f, csC = CS[63 * CSS + j] * 1.4426950408889634f, lw2 = lw[e] * 1.4426950408889634f;
                const float e_in = __builtin_amdgcn_exp2f(cs), e_ex = __builtin_amdgcn_exp2f(cs - lw2), e_ng = __builtin_amdgcn_exp2f(-cs), e_ht = __builtin_amdgcn_exp2f(csC - cs);
                at[e] = aa[e] * e_ex; rt[e] = rr[e] * e_in; bt[e] = bb[e] * e_ng; kt[e] = kk_[e] * e_ng;
                T_VT[j * TS + tt] = f2bf(vv[e]); T_bhT[j * TS + tt] = f2bf(bb[e] * e_ht); T_khT[j * TS + tt] = f2bf(kk_[e] * e_ht);
                XT[j * XTS + tt] = at[e];
                if (tt == 63) PCv[j] = __builtin_amdgcn_exp2f(csC);
            }
            uint4 w;
            w.x = pk2(at[0], at[1]); w.y = pk2(at[2], at[3]); w.z = pk2(at[4], at[5]); w.w = pk2(at[6], at[7]); *(uint4*)(T_At + tt * TS + j0) = w;
            w.x = pk2(rt[0], rt[1]); w.y = pk2(rt[2], rt[3]); w.z = pk2(rt[4], rt[5]); w.w = pk2(rt[6], rt[7]); *(uint4*)(T_Rt + tt * TS + j0) = w;
            w.x = pk2(bt[0], bt[1]); w.y = pk2(bt[2], bt[3]); w.z = pk2(bt[4], bt[5]); w.w = pk2(bt[6], bt[7]); *(uint4*)(T_Bt + tt * TS + j0) = w;
            w.x = pk2(kt[0], kt[1]); w.y = pk2(kt[2], kt[3]); w.z = pk2(kt[4], kt[5]); w.w = pk2(kt[6], kt[7]); *(uint4*)(T_Kt + tt * TS + j0) = w;
        }
        __syncthreads();
        { const int hn = h + 1 < NH ? h + 1 : 0, gn = h + 1 < NH ? gi : gi + G; if (gn < NGRP) b1_issue_loads(p, l, gn, hn, tid, L); }
        {
            const int mat = wave >> 1;
            const bf16_t* As = (mat == 0 || mat == 2) ? T_Bt : T_Kt; const bf16_t* Bs = (mat < 2) ? T_At : T_Rt;
            bf16_t* dstb = (mat == 1 ? T_Aak : (mat == 2 ? T_Arb : T_Ark));
#pragma unroll
            for (int q = 0; q < 8; ++q) {
                constexpr int TI0[8] = {0, 0, 0, 0, 3, 1, 2, 3}, TJ0[8] = {0, 1, 2, 3, 3, 0, 0, 0}, TI1[8] = {1, 1, 1, 2, 2, 2, 3, 3}, TJ1[8] = {1, 2, 3, 2, 3, 1, 1, 2};
                const int ti = (wave & 1) ? TI1[q] : TI0[q], tj = (wave & 1) ? TJ1[q] : TJ0[q];
                f32x4 acc = (f32x4){0.f, 0.f, 0.f, 0.f};
                if (ti <= tj) acc = mm_tile(As, ti * 16, Bs, tj * 16, 64, fr, fq, acc);
                const int tcol = tj * 16 + fr, i0 = ti * 16 + fq * 4;
                if (ti == tj) {
#pragma unroll
                    for (int r = 0; r < 4; ++r) { const bool keep = (mat < 2) ? (i0 + r < tcol) : (i0 + r <= tcol); if (!keep) acc[r] = 0.f; }
                }
                if (mat == 0) *(f32x4*)(Aab + tcol * AABS + i0) = acc;
                else *(uint2*)(dstb + tcol * TS + i0) = pk4(acc);
            }
        }
        __syncthreads();
        if (wave == 0) {
            const int blk = lane >> 4, cc = lane & 15; const float* ar = Aab + (16 * blk) * AABS + 16 * blk;
            float x[16];
#pragma unroll
            for (int u = 0; u < 16; ++u) { float v = (u == cc) ? 1.0f : 0.f;
#pragma unroll
                for (int i = 0; i < u; ++i) v += ar[u * AABS + i] * x[i];
                x[u] = v; }
#pragma unroll
            for (int u = 0; u < 16; ++u) TI[(blk * 16 + u) * 17 + cc] = x[u];
        } else {
#pragma unroll 1
            for (int id = wave - 1; id < 16; id += 7) {
                const int ti = id >> 2, tj = id & 3;
                f32x4 acc = mm_tile(T_Aak, ti * 16, T_VT, tj * 16, 64, fr, fq, (f32x4){0.f, 0.f, 0.f, 0.f});
                const int j = tj * 16 + fr, tr = ti * 16 + fq * 4;
#pragma unroll
                for (int r = 0; r < 4; ++r) XT[(64 + j) * XTS + tr + r] = acc[r];
            }
        }
        __syncthreads();
        {
            float* xc = XT + (wave * 16 + fr) * XTS;
#pragma unroll
            for (int I = 0; I < 4; ++I) {
                f32x4 acc;
#pragma unroll
                for (int r = 0; r < 4; ++r) acc[r] = xc[16 * I + 4 * fq + r];
#pragma unroll
                for (int J = 0; J < I; ++J)
#pragma unroll
                    for (int kk = 0; kk < 4; ++kk) acc = __builtin_amdgcn_mfma_f32_16x16x4f32(Aab[(16 * I + fr) * AABS + 16 * J + 4 * kk + fq], xc[16 * J + 4 * kk + fq], acc, 0, 0, 0);
#pragma unroll
                for (int r = 0; r < 4; ++r) xc[16 * I + 4 * fq + r] = acc[r];
                asm volatile("s_waitcnt lgkmcnt(0)" ::: "memory");
                f32x4 xs = (f32x4){0.f, 0.f, 0.f, 0.f};
#pragma unroll
                for (int kk = 0; kk < 4; ++kk) xs = __builtin_amdgcn_mfma_f32_16x16x4f32(TI[(I * 16 + fr) * 17 + 4 * kk + fq], xc[16 * I + 4 * kk + fq], xs, 0, 0, 0);
                asm volatile("s_waitcnt lgkmcnt(0)" ::: "memory");
#pragma unroll
                for (int r = 0; r < 4; ++r) xc[16 * I + 4 * fq + r] = xs[r];
                asm volatile("s_waitcnt lgkmcnt(0)" ::: "memory");
            }
        }
        __syncthreads();
        {
            const int col = tid >> 2, tg = (tid & 3) * 16;
            const float* xr = XT + col * XTS + tg; bf16_t* dst = (col < 64 ? T_WT + col * TS : T_U0T + (col - 64) * TS) + tg;
            uint4 w0_, w1_;
            w0_.x = pk2(xr[0], xr[1]); w0_.y = pk2(xr[2], xr[3]); w0_.z = pk2(xr[4], xr[5]); w0_.w = pk2(xr[6], xr[7]);
            w1_.x = pk2(xr[8], xr[9]); w1_.y = pk2(xr[10], xr[11]); w1_.z = pk2(xr[12], xr[13]); w1_.w = pk2(xr[14], xr[15]);
            *(uint4*)dst = w0_; *(uint4*)(dst + 8) = w1_;
        }
        __syncthreads();
        {
            bf16_t* gM = (bf16_t*)(p.ws + WS_CH_M) + (size_t)jb * 4096; bf16_t* gNT = (bf16_t*)(p.ws + WS_CH_NT) + (size_t)jb * 4096;
            bf16_t* gG = (bf16_t*)(p.ws + WS_CH_G) + (size_t)jb * 4096; bf16_t* gY1T = (bf16_t*)(p.ws + WS_CH_Y1T) + (size_t)jb * 4096;
            const int mat = wave >> 1;
            const bf16_t* A1 = (mat == 0 || mat == 2) ? T_WT : (mat == 1 ? T_U0T : T_bhT);
            const bf16_t* B1 = (mat == 0 || mat == 1) ? T_Arb : (mat == 2 ? T_bhT : T_U0T);
            const bf16_t* A2 = mat == 1 ? T_VT : T_khT; const bf16_t* B2 = mat == 1 ? T_Ark : T_VT;
            bf16_t* gdst = mat == 0 ? gG : (mat == 1 ? gY1T : (mat == 2 ? gM : gNT));
#pragma unroll
            for (int q = 0; q < 8; ++q) {
                const int ti = ((wave & 1) * 8 + q) >> 2, tj = q & 3;
                const int col = tj * 16 + fr, r0 = ti * 16 + fq * 4;
                f32x4 acc = mm_tile(A1, ti * 16, B1, tj * 16, 64, fr, fq, (f32x4){0.f, 0.f, 0.f, 0.f});
                if (mat & 1) acc = mm_tile(A2, ti * 16, B2, tj * 16, 64, fr, fq, acc);
                if (mat == 0) {
                    const uint2 rw = *(const uint2*)(T_Rt + col * TS + r0);
                    acc[0] += bf2f((bf16_t)(rw.x & 0xffff)); acc[1] += bf2f((bf16_t)(rw.x >> 16)); acc[2] += bf2f((bf16_t)(rw.y & 0xffff)); acc[3] += bf2f((bf16_t)(rw.y >> 16));
                } else if (mat == 2 && ti == tj) {
                    const float pc = PCv[col];
#pragma unroll
                    for (int r = 0; r < 4; ++r) if (r0 + r == col) acc[r] += pc;
                }
                *(uint2*)(gdst + col * 64 + r0) = pk4(acc);
            }
        }
        __syncthreads();
        if (h == NH - 1) gi += G;
    }
}

__device__ void rwkv_b2_job(const Params& p, int bh, unsigned char* lds) {
    const int tid = tid_(), lane = tid & 63, wave = __builtin_amdgcn_readfirstlane(tid >> 6), fr = lane & 15, fq = lane >> 4;
    const int mi = wave >> 1, nj0 = (wave & 1) * 2;
    const bf16_t* gM = (const bf16_t*)(p.ws + WS_CH_M); const bf16_t* gNT = (const bf16_t*)(p.ws + WS_CH_NT); bf16_t* gZT = (bf16_t*)(p.ws + WS_ZT);
    bf16_t* zbuf = (bf16_t*)lds;
    f32x4 z[2];
    z[0] = (f32x4){0.f, 0.f, 0.f, 0.f}; z[1] = z[0];
    const int c0 = mi * 16 + fq * 4;
    bf16x8 am[2]; uint2 nw[2];
    {
        const size_t jb = (size_t)bh * 32;
#pragma unroll
        for (int kk = 0; kk < 2; ++kk) am[kk] = *(const bf16x8*)(gM + jb * 4096 + (mi * 16 + fr) * 64 + kk * 32 + fq * 8);
#pragma unroll
        for (int q = 0; q < 2; ++q) nw[q] = *(const uint2*)(gNT + jb * 4096 + ((nj0 + q) * 16 + fr) * 64 + c0);
    }
#pragma unroll 1
    for (int c = 0; c < SEQ / 64; ++c) {
        const size_t jb = (size_t)bh * 32 + c;
        bf16_t* zh = zbuf + (c & 1) * 2 * 64 * TS; bf16_t* zl = zh + 64 * TS;
#pragma unroll
        for (int q = 0; q < 2; ++q) {
            const int j = (nj0 + q) * 16 + fr;
            const uint2 hi = pk4(z[q]);
            f32x4 lo;
            lo[0] = z[q][0] - bf2f((bf16_t)(hi.x & 0xffff)); lo[1] = z[q][1] - bf2f((bf16_t)(hi.x >> 16)); lo[2] = z[q][2] - bf2f((bf16_t)(hi.y & 0xffff)); lo[3] = z[q][3] - bf2f((bf16_t)(hi.y >> 16));
            *(uint2*)(zh + j * TS + c0) = hi; *(uint2*)(zl + j * TS + c0) = pk4(lo);
            *(uint2*)(gZT + jb * 4096 + j * 64 + c0) = hi;
        }
        bf16x8 amn[2]; uint2 nwn[2];
        {
            const size_t jn = (size_t)bh * 32 + (c + 1 < SEQ / 64 ? c + 1 : c);
#pragma unroll
            for (int kk = 0; kk < 2; ++kk) amn[kk] = *(const bf16x8*)(gM + jn * 4096 + (mi * 16 + fr) * 64 + kk * 32 + fq * 8);
#pragma unroll
            for (int q = 0; q < 2; ++q) nwn[q] = *(const uint2*)(gNT + jn * 4096 + ((nj0 + q) * 16 + fr) * 64 + c0);
        }
        __syncthreads();
#pragma unroll
        for (int q = 0; q < 2; ++q) {
            const int j = (nj0 + q) * 16 + fr;
            f32x4 acc; acc[0] = bf2f((bf16_t)(nw[q].x & 0xffff)); acc[1] = bf2f((bf16_t)(nw[q].x >> 16)); acc[2] = bf2f((bf16_t)(nw[q].y & 0xffff)); acc[3] = bf2f((bf16_t)(nw[q].y >> 16));
#pragma unroll
            for (int kk = 0; kk < 2; ++kk) {
                const bf16x8 bh_ = *(const bf16x8*)(zh + j * TS + kk * 32 + fq * 8), bl_ = *(const bf16x8*)(zl + j * TS + kk * 32 + fq * 8);
                acc = __builtin_amdgcn_mfma_f32_16x16x32_bf16(am[kk], bh_, acc, 0, 0, 0);
                acc = __builtin_amdgcn_mfma_f32_16x16x32_bf16(am[kk], bl_, acc, 0, 0, 0);
            }
            z[q] = acc;
        }
        am[0] = amn[0]; am[1] = amn[1]; nw[0] = nwn[0]; nw[1] = nwn[1];
    }
    __syncthreads();
}

struct B3Loads { bf16x8 bg[2], az[4][2]; uint2 yw[4], bw[4], gw[4]; };
__device__ __forceinline__ void b3_issue_loads(const Params& p, int pair, int wave, int fr, int fq, B3Loads& L) {
    const int jb = pair * 2 + (wave >> 2), mi = wave & 3, bh = jb >> 5, c = jb & 31, b = bh / NH, h = bh % NH;
    const bf16_t* gG = (const bf16_t*)(p.ws + WS_CH_G) + (size_t)jb * 4096; const bf16_t* gY1 = (const bf16_t*)(p.ws + WS_CH_Y1T) + (size_t)jb * 4096;
    const bf16_t* gBV = (const bf16_t*)(p.ws + WS_CH_BV) + (size_t)jb * 4096; const bf16_t* gZT = (const bf16_t*)(p.ws + WS_ZT) + (size_t)jb * 4096;
    const bf16_t* PG = (const bf16_t*)(p.ws + WS_PG);
    const int tt = mi * 16 + fr; const size_t row = (size_t)b * SEQ + c * 64 + tt;
#pragma unroll
    for (int kk = 0; kk < 2; ++kk) L.bg[kk] = __builtin_nontemporal_load((const bf16x8*)(gG + tt * 64 + kk * 32 + fq * 8));
#pragma unroll
    for (int nj = 0; nj < 4; ++nj) { const int j0 = nj * 16 + fq * 4;
        L.yw[nj] = ldnt_u2((const void*)(gY1 + tt * 64 + j0)); L.bw[nj] = ldnt_u2((const void*)(gBV + tt * 64 + j0)); L.gw[nj] = ldnt_u2((const void*)(PG + row * PG_W + h * HD + j0));
#pragma unroll
        for (int kk = 0; kk < 2; ++kk) L.az[nj][kk] = *(const bf16x8*)(gZT + (nj * 16 + fr) * 64 + kk * 32 + fq * 8); }
}
__device__ void rwkv_b3_phase(const Params& p, int l) {
    const int G = gridDim.x, NPAIR = BATCH * NH * 16;
    int pair = blockIdx.x;
    if (pair >= NPAIR) return;
    B3Loads L;
    { const int tid = tid_(), lane = tid & 63; b3_issue_loads(p, pair, __builtin_amdgcn_readfirstlane(tid >> 6), lane & 15, lane >> 4, L); }
#pragma unroll 1
    for (; pair < NPAIR; pair += G) {
        const int tid = tid_(), lane = tid & 63, wave = __builtin_amdgcn_readfirstlane(tid >> 6), fr = lane & 15, fq = lane >> 4;
        const int jb = pair * 2 + (wave >> 2), mi = wave & 3;
        const int bh = jb >> 5, c = jb & 31, b = bh / NH, h = bh % NH;
        bf16_t* MIX = (bf16_t*)(p.ws + WS_MIX);
        const float* gng = p.in[19] + l * RWW + h * HD; const float* gnb = p.in[20] + l * RWW + h * HD;
        const int tt = mi * 16 + fr; const size_t row = (size_t)b * SEQ + c * 64 + tt;
        f32x4 acc[4];
#pragma unroll
        for (int nj = 0; nj < 4; ++nj) {
            acc[nj][0] = bf2f((bf16_t)(L.yw[nj].x & 0xffff)); acc[nj][1] = bf2f((bf16_t)(L.yw[nj].x >> 16)); acc[nj][2] = bf2f((bf16_t)(L.yw[nj].y & 0xffff)); acc[nj][3] = bf2f((bf16_t)(L.yw[nj].y >> 16));
#pragma unroll
            for (int kk = 0; kk < 2; ++kk) acc[nj] = __builtin_amdgcn_mfma_f32_16x16x32_bf16(L.az[nj][kk], L.bg[kk], acc[nj], 0, 0, 0);
        }
        uint2 bw[4], gw[4];
#pragma unroll
        for (int nj = 0; nj < 4; ++nj) { bw[nj] = L.bw[nj]; gw[nj] = L.gw[nj]; }
        if (pair + G < NPAIR) b3_issue_loads(p, pair + G, wave, fr, fq, L);
        float s = 0.f;
#pragma unroll
        for (int nj = 0; nj < 4; ++nj) s += (acc[nj][0] + acc[nj][1]) + (acc[nj][2] + acc[nj][3]);
        s += __shfl_xor(s, 16); s += __shfl_xor(s, 32);
        const float mean = s * (1.0f / HD);
        float vs = 0.f;
#pragma unroll
        for (int nj = 0; nj < 4; ++nj) { acc[nj] = acc[nj] - mean; vs += (acc[nj][0] * acc[nj][0] + acc[nj][1] * acc[nj][1]) + (acc[nj][2] * acc[nj][2] + acc[nj][3] * acc[nj][3]); }
        vs += __shfl_xor(vs, 16); vs += __shfl_xor(vs, 32);
        const float rstd = rsqrtf(vs * (1.0f / HD) + GN_EPS);
#pragma unroll
        for (int nj = 0; nj < 4; ++nj) {
            const int j0 = nj * 16 + fq * 4;
            const f32x4 gg = *(const f32x4*)(gng + j0), gb = *(const f32x4*)(gnb + j0);
            const float bv0 = bf2f((bf16_t)(bw[nj].x & 0xffff)), bv1 = bf2f((bf16_t)(bw[nj].x >> 16)), bv2 = bf2f((bf16_t)(bw[nj].y & 0xffff)), bv3 = bf2f((bf16_t)(bw[nj].y >> 16));
            const float g0 = bf2f((bf16_t)(gw[nj].x & 0xffff)), g1 = bf2f((bf16_t)(gw[nj].x >> 16)), g2 = bf2f((bf16_t)(gw[nj].y & 0xffff)), g3 = bf2f((bf16_t)(gw[nj].y >> 16));
            const float o0 = acc[nj][0] * rstd * gg[0] + gb[0] + bv0, o1 = acc[nj][1] * rstd * gg[1] + gb[1] + bv1, o2 = acc[nj][2] * rstd * gg[2] + gb[2] + bv2, o3 = acc[nj][3] * rstd * gg[3] + gb[3] + bv3;
            uint2 w; w.x = pk2(o0 * siluf_(g0), o1 * siluf_(g1)); w.y = pk2(o2 * siluf_(g2), o3 * siluf_(g3));
            *(uint2*)(MIX + row * DM + CW + SBW + h * HD + j0) = w;
        }
    }
}

constexpr int N_ATT_JOBS = BATCH * NH * 8, N_CONV_JOBS = BATCH * (SEQ / 64), N_CHAINS = BATCH * NH;
__device__ __forceinline__ void run_side_job(const Params& p, int l, int id, unsigned char* lds) {
    if (id < N_ATT_JOBS) attn_wg_job(p, id, lds); else conv_job64(p, l, id - N_ATT_JOBS, lds);
}
__device__ void phase_mix1(const Params& p, int l, unsigned char* lds) {
    rwkv_b1_phase(p, l, lds);
    if (!defer_layer1_weights()) for (int id = blockIdx.x; id < N_ATT_JOBS + N_CONV_JOBS; id += gridDim.x) run_side_job(p, l, id, lds);
}
__device__ void phase_mix2(const Params& p, int l, unsigned char* lds) {
    const int G = gridDim.x, w = blockIdx.x, NJ = N_ATT_JOBS + N_CONV_JOBS;
    if (!defer_layer1_weights()) { for (int job = w; job < N_CHAINS; job += G) rwkv_b2_job(p, job, lds); return; }
    const bool prep = l + 1 < DEPTH;
    const int nlow = prep ? 5 : 4;
    if (w < N_CHAINS) {
        rwkv_b2_job(p, w, lds);
        for (int s_ = 0; s_ < nlow; ++s_) { const int id = s_ * N_CHAINS + w; if (id < NJ) run_side_job(p, l, id, lds); }
    } else {
        if (prep) prep_weights(p, l + 1, lds, w - N_CHAINS, G - N_CHAINS);
        for (int id = nlow * N_CHAINS + (w - N_CHAINS); id < NJ; id += G - N_CHAINS) run_side_job(p, l, id, lds);
    }
}
__device__ void phase_mix3(const Params& p, int l, unsigned char* lds) {
    rwkv_b3_phase(p, l);
}

#define LAS __attribute__((address_space(3)))
#define XB_TMO      128
#define XB_XCNT(j)  (256  + 64 * (j))
#define XB_XSUB(j)  (1280 + 64 * (j))
#define XB_XGEN(j)  (2304 + 64 * (j))
#define XB_TOP      3328
#define XB_TOPGEN   3392
#define XCD_BAR_WORDS 3456
#define XB_SPIN_CAP (1u << 18)

__device__ __forceinline__ unsigned xb_ld(unsigned* p)              { return __hip_atomic_load(p, __ATOMIC_RELAXED, __HIP_MEMORY_SCOPE_AGENT); }
__device__ __forceinline__ unsigned xb_add(unsigned* p, unsigned v) { return __hip_atomic_fetch_add(p, v, __ATOMIC_RELAXED, __HIP_MEMORY_SCOPE_AGENT); }
__device__ __forceinline__ unsigned xb_xcc_id() { return (unsigned)__builtin_amdgcn_s_getreg((3 << 11) | 20) & 0xFu; }
#define XB_SPIN(cond, bar) do { unsigned _sp = 0; while (cond) { __builtin_amdgcn_s_sleep(1); \
    if ((++_sp & 255u) == 0u) { if (xb_ld(&(bar)[XB_TMO])) break; if (_sp > XB_SPIN_CAP) { atomicAdd(&(bar)[XB_TMO], 1u); break; } } } } while (0)

struct XcdBarrier {
    unsigned* bar; unsigned x;
    volatile LAS unsigned* st;
};

__device__ __forceinline__ XcdBarrier xcd_barrier_post(unsigned* bar, volatile LAS unsigned* st) {
    XcdBarrier b; b.bar = bar; b.x = xb_xcc_id(); b.st = st;
    if (threadIdx.x == 0) (void)xb_add(&bar[XB_XCNT(b.x)], 1u);
    return b;
}
__device__ __forceinline__ void xcd_barrier_complete(unsigned* bar, unsigned x, unsigned& nloc, unsigned& nx) {
    const unsigned G = gridDim.x * gridDim.y * gridDim.z;
    unsigned sum, cnt, mine, sp = 0u;
    for (;;) {
        sum = 0u; cnt = 0u; mine = 0u;
#pragma unroll
        for (unsigned j = 0; j < 16; ++j) { const unsigned c = xb_ld(&bar[XB_XCNT(j)]); sum += c; cnt += (c > 0u) ? 1u : 0u; mine = (j == x) ? c : mine; }
        if (sum == G) break;
        __builtin_amdgcn_s_sleep(1);
        if ((++sp & 255u) == 0u) { if (xb_ld(&bar[XB_TMO])) break; if (sp > XB_SPIN_CAP) { atomicAdd(&bar[XB_TMO], 1u); break; } }
    }
    nloc = mine > 0u ? mine : 1u; nx = cnt > 0u ? cnt : 1u;
}

__device__ __forceinline__ void xcd_barrier(const XcdBarrier& b) {
    asm volatile("s_waitcnt vmcnt(0)" ::: "memory");
    __syncthreads();
    if (threadIdx.x == 0) {
        unsigned* bar = b.bar;
        __builtin_amdgcn_s_waitcnt(0);
        unsigned nloc = b.st[0], nx = b.st[1];
        if (nloc == 0u) { xcd_barrier_complete(bar, b.x, nloc, nx); b.st[0] = nloc; b.st[1] = nx; }
        const unsigned old = xb_add(&bar[XB_XSUB(b.x)], 1u);
        const unsigned gen = old / nloc;
        if (old + 1u == (gen + 1u) * nloc) {
            __builtin_amdgcn_fence(__ATOMIC_RELEASE, "agent");
            asm volatile("s_waitcnt vmcnt(0)" ::: "memory");
            const unsigned og = xb_add(&bar[XB_TOP], 1u);
            const unsigned tg = og / nx;
            if (og + 1u == (tg + 1u) * nx) xb_add(&bar[XB_TOPGEN], 1u);
            else XB_SPIN(xb_ld(&bar[XB_TOPGEN]) == tg, bar);
            __builtin_amdgcn_fence(__ATOMIC_ACQUIRE, "agent");
            xb_add(&bar[XB_XGEN(b.x)], 1u);
            asm volatile("s_waitcnt vmcnt(0)" ::: "memory");
        } else {
            XB_SPIN(xb_ld(&bar[XB_XGEN(b.x)]) == gen, bar);
            __builtin_amdgcn_fence(__ATOMIC_ACQUIRE, "agent");
            asm volatile("s_waitcnt vmcnt(0)" ::: "memory");
        }
    }
    __syncthreads();
}

constexpr int PH_PER_LAYER = 6;
constexpr int N_PHASES = 1 + PH_PER_LAYER * DEPTH;
__device__ __forceinline__ void run_phase(const Params& p, int ph, unsigned char* lds) {
    unsigned char* ws = p.ws;
    if (ph == 0) { phase_prologue(p, lds); return; }
    const int l = (ph - 1) / PH_PER_LAYER, k = (ph - 1) % PH_PER_LAYER;
    if (k == 0) {
        EpiInProjP E{(bf16_t*)(ws + WS_PC), (bf16_t*)(ws + WS_PS), (bf16_t*)(ws + WS_PR), (bf16_t*)(ws + WS_PG), (bf16_t*)(ws + WS_VT)};
        pg8::Gemm g{(const bf16_t*)(ws + WS_XB), (const bf16_t*)(ws + WS_WIN) + (size_t)l * NINT * DM, M, NINT, DM}; pg8::StaticOrder S; S.init(M, NINT, (int)gridDim.x, (int)blockIdx.x);
        pg8::gemm_phase<EpiInProjP, pg8::StaticOrder, true, true>((PG8_LAS unsigned char*)lds, g, S, E);
    } else if (k == 1) {
        phase_mix1(p, l, lds);
    } else if (k == 2) {
        phase_mix2(p, l, lds);
    } else if (k == 3) {
        phase_mix3(p, l, lds);
    } else if (k == 4) {
        EpiOutBf16P E{(bf16_t*)(ws + WS_Y), DM};
        pg8::Gemm g{(const bf16_t*)(ws + WS_MIX), (const bf16_t*)(ws + WS_WOUT) + (size_t)l * DM * DM, M, DM, DM}; pg8::StaticOrder S; S.init(M, DM, (int)gridDim.x, (int)blockIdx.x);
        pg8::gemm_phase<EpiOutBf16P, pg8::StaticOrder, true, true>((PG8_LAS unsigned char*)lds, g, S, E);
    } else {
        phase_rowpass(l == 0 ? p.in[0] : p.out, (const bf16_t*)(ws + WS_Y), p.in[2] + l * DM, p.out, l + 1 < DEPTH ? (bf16_t*)(ws + WS_XB) : nullptr);
    }
}

static_assert(10 * TILE_B + 64 * AABS * 4 + 128 * XTS * 4 + 64 * 4 + 4 * 16 * 17 * 4 <= 147456, "B1 LDS map");
constexpr int LDS_BYTES = 147456 + 256;

constexpr int MISC_OFF = 147456;
#if MK_COOP == 2
__global__ void __launch_bounds__(512, 2) fwd_kernel(Params p) {
    extern __shared__ __attribute__((aligned(16))) unsigned char lds[];
    volatile LAS unsigned* misc = (volatile LAS unsigned*)((LAS unsigned char*)lds + MISC_OFF);
    if (threadIdx.x < 16) misc[threadIdx.x] = 0u;
    __syncthreads();
    XcdBarrier bar = xcd_barrier_post((unsigned*)(p.ws + WS_CTL), misc);
    for (int ph = p.ph_lo; ph < p.ph_hi; ++ph) {
        run_phase(p, ph, lds);
        if (ph + 1 < p.ph_hi) xcd_barrier(bar);
    }
}
#elif MK_COOP == 1
__global__ void __launch_bounds__(512, 2) fwd_kernel(Params p) {
    extern __shared__ __attribute__((aligned(16))) unsigned char lds[];
    cg::grid_group grid = cg::this_grid();
    for (int ph = p.ph_lo; ph < p.ph_hi; ++ph) {
        run_phase(p, ph, lds);
        if (ph + 1 < p.ph_hi) grid.sync();
    }
}
#else
__global__ void __launch_bounds__(512, 2) fwd_kernel(Params p) {
    extern __shared__ __attribute__((aligned(16))) unsigned char lds[];
    for (int ph = p.ph_lo; ph < p.ph_hi; ++ph) run_phase(p, ph, lds);
}
#endif

extern "C" void kernel_launch(void* const* d_in, const int* in_sizes, int n_in, void* d_out, int out_size, void* d_ws, size_t ws_size, hipStream_t stream) {
    static int grid = 0;
    if (grid == 0) {
        if (n_in != 24 || out_size != M * DM || ws_size < WS_END) { fprintf(stderr, "kernel_launch: unexpected problem (n_in %d out %d ws %zu)\n", n_in, out_size, ws_size); grid = -1; return; }
        int dev = 0, cus = 0, per_cu = 0;
        hipGetDevice(&dev); hipDeviceGetAttribute(&cus, hipDeviceAttributeMultiprocessorCount, dev);
        hipFuncSetAttribute((const void*)fwd_kernel, hipFuncAttributeMaxDynamicSharedMemorySize, LDS_BYTES);
        hipOccupancyMaxActiveBlocksPerMultiprocessor(&per_cu, (const void*)fwd_kernel, 512, LDS_BYTES);
        if (per_cu < 1) { fprintf(stderr, "kernel_launch: occupancy query says %d blocks per CU\n", per_cu); per_cu = 1; }
        grid = cus;
        (void)hipGetLastError();
    }
    if (grid < 0) return;
    Params p{};
    for (int i = 0; i < 24; ++i) p.in[i] = (const float*)d_in[i];
    p.out = (float*)d_out; p.ws = (unsigned char*)d_ws;
#if MK_COOP == 2
    p.ph_lo = 0; p.ph_hi = N_PHASES;
    if (hipMemsetAsync((char*)d_ws + WS_CTL, 0, XCD_BAR_WORDS * 4, stream) != hipSuccess) { fprintf(stderr, "kernel_launch: memset of the barrier words failed\n"); return; }
    hipLaunchKernelGGL(fwd_kernel, dim3(grid), dim3(512), LDS_BYTES, stream, p);
#elif MK_COOP == 1
    p.ph_lo = 0; p.ph_hi = N_PHASES;
    void* args[] = {&p};
    hipError_t e = hipLaunchCooperativeKernel((const void*)fwd_kernel, dim3(grid), dim3(512), args, LDS_BYTES, stream);
    if (e != hipSuccess) fprintf(stderr, "cooperative launch failed: %s (grid %d)\n", hipGetErrorString(e), grid);
#else
    for (int ph = 0; ph < N_PHASES; ++ph) {
        p.ph_lo = ph; p.ph_hi = ph + 1;
        hipLaunchKernelGGL(fwd_kernel, dim3(grid), dim3(512), LDS_BYTES, stream, p);
    }
#endif
}
```

```cpp
#include <hip/hip_runtime.h>
#include <hip/hip_cooperative_groups.h>
#include <cstdio>
#include <cstdint>
namespace cg = cooperative_groups;

#ifndef MK_COOP
#define MK_COOP 2
#endif

constexpr int BATCH = 16, SEQ = 2048, DM = 1024, DEPTH = 2;
constexpr int M = BATCH * SEQ;
constexpr int HD = 64, NH = 6;
constexpr int CW = 256, SBW = 384, RWW = 384, LORA = 32, TAPS = 31;
constexpr int DIN = 3904;
constexpr int NINT = 4096;
constexpr int PC_W = 768, PS_W = 1152, PR_W = 1280, PG_W = 384;
constexpr float RMS_EPS = 1e-6f, LN_EPS = 1e-5f, GN_EPS = 64e-5f;

typedef unsigned short bf16_t;
typedef short bf16x8 __attribute__((ext_vector_type(8)));
typedef float f32x4 __attribute__((ext_vector_type(4)));
typedef unsigned short us4 __attribute__((ext_vector_type(4)));

constexpr size_t MiB = 1u << 20;
constexpr size_t WS_CTL = 0;
constexpr size_t WS_WPW = 512 * 1024;
constexpr size_t WS_WIN = 1 * MiB;
constexpr size_t WS_WOUT = 17 * MiB;
constexpr size_t WS_XB = 21 * MiB;
constexpr size_t WS_MIX = WS_XB;
constexpr size_t WS_PC = 85 * MiB;
constexpr size_t WS_PS = 133 * MiB;
constexpr size_t WS_VT = 205 * MiB;
constexpr size_t WS_Y = WS_PC;
constexpr size_t WS_PR = 229 * MiB;
constexpr size_t WS_PG = 309 * MiB;
constexpr size_t WS_VF = 333 * MiB;
constexpr size_t WS_CH = 381 * MiB;
constexpr size_t CH_SZ = (size_t)3072 * 4096 * 2;
constexpr size_t WS_CH_M = WS_CH, WS_CH_NT = WS_CH + CH_SZ, WS_CH_G = WS_CH + 2 * CH_SZ, WS_CH_Y1T = WS_CH + 3 * CH_SZ, WS_CH_BV = WS_CH + 4 * CH_SZ;
constexpr size_t WS_ZT = WS_PR;
constexpr size_t WS_END = 501 * MiB;

struct Params {
    const float* in[24];
    float* out;
    unsigned char* ws;
    int ph_lo, ph_hi;
};

__device__ __forceinline__ float bf2f(bf16_t v) { return __uint_as_float(((unsigned)v) << 16); }
typedef float f32x2_t __attribute__((ext_vector_type(2)));
typedef __bf16 bf16x2_t __attribute__((ext_vector_type(2)));
__device__ __forceinline__ unsigned pk2(float lo, float hi) { f32x2_t v = {lo, hi}; bf16x2_t b = __builtin_convertvector(v, bf16x2_t); return __builtin_bit_cast(unsigned, b); }
__device__ __forceinline__ bf16_t f2bf(float f) { return (bf16_t)(pk2(f, f) & 0xffffu); }
__device__ __forceinline__ float wave_sum(float v) {
#pragma unroll
    for (int o = 1; o < 64; o <<= 1) v += __shfl_xor(v, o);
    return v;
}
__device__ __forceinline__ float sigmoidf_(float x) { return __builtin_amdgcn_rcpf(1.0f + __builtin_amdgcn_exp2f(-1.4426950408889634f * x)); }
__device__ __forceinline__ float siluf_(float x) { return x * __builtin_amdgcn_rcpf(1.0f + __builtin_amdgcn_exp2f(-1.4426950408889634f * x)); }
__device__ __forceinline__ int tid_() { int t = threadIdx.x; asm volatile("" : "+v"(t)); return t; }
typedef unsigned u32x2_t __attribute__((ext_vector_type(2)));
__device__ __forceinline__ uint2 ldnt_u2(const void* p) { const u32x2_t v = __builtin_nontemporal_load((const u32x2_t*)p); uint2 r; r.x = v[0]; r.y = v[1]; return r; }

__device__ __forceinline__ int orig_col(int n) { return n < 3520 ? n : (n < 3584 ? -1 : (n < 3968 ? n - 64 : -1)); }

__device__ void transpose_tile(const float* W, int ldw, int ncol_src, const float* gain, bf16_t* WT, int K, int n0, int k0, bool permute, float* tile  , bool skip_fold_rows = false) {
    const int tid = tid_();
#pragma unroll
    for (int i = 0; i < 8; ++i) {
        const int kl = (tid >> 6) + 8 * i, nl = tid & 63;
        const int n = n0 + nl, k = k0 + kl;
        const int oc = permute ? orig_col(n) : n;
        float v = 0.f;
        if (oc >= 0 && oc < ncol_src) v = W[(size_t)k * ldw + oc] * (gain ? gain[k] : 1.0f);
        if (permute && n >= 768 && n < 1152) v *= 0.125f * 1.4426950408889634f;
        tile[kl * 65 + nl] = v;
    }
    __syncthreads();
#pragma unroll
    for (int i = 0; i < 8; ++i) {
        const int nl = (tid >> 6) + 8 * i, kl = tid & 63;
        if (!(skip_fold_rows && n0 + nl >= 3520 && n0 + nl < 3584)) WT[(size_t)(n0 + nl) * K + k0 + kl] = f2bf(tile[kl * 65 + nl]);
    }
    __syncthreads();
}
__device__ void fold_v1_rows(const Params& p, int l, bf16_t* WinT_l, float* scr, int worker, int nworkers) {
    const int tid = tid_(), lane = tid & 63, wave = __builtin_amdgcn_readfirstlane(tid >> 6);
    const float* W = p.in[3] + (size_t)l * DM * DIN; const float* gain = p.in[1] + l * DM; const float* v1 = p.in[22] + (size_t)(l - 1) * RWW * LORA; const float* muv = p.in[11] + l * 1216 + 768;
    float* V1c = scr;
    float* Wr = scr + RWW * 64 + wave * RWW;
    for (int idx = tid; idx < RWW * 64; idx += 512) { const int c = idx >> 6, o = idx & 63; const float m = muv[c]; V1c[idx] = (o >= 32 ? m : 1.0f - m) * v1[c * LORA + (o & 31)]; }
    __syncthreads();
    for (int k = worker * 8 + wave; k < DM; k += nworkers * 8) {
        const float* wr = W + (size_t)k * DIN + 3072;
#pragma unroll
        for (int i = 0; i < 6; ++i) Wr[lane + 64 * i] = wr[lane + 64 * i];
        asm volatile("s_waitcnt lgkmcnt(0)" ::: "memory");
        float a0 = 0.f, a1 = 0.f, a2 = 0.f, a3 = 0.f;
#pragma unroll 4
        for (int c4 = 0; c4 < RWW / 4; ++c4) { const f32x4 w = *(const f32x4*)(Wr + 4 * c4);
            a0 += w[0] * V1c[(4 * c4) * 64 + lane]; a1 += w[1] * V1c[(4 * c4 + 1) * 64 + lane]; a2 += w[2] * V1c[(4 * c4 + 2) * 64 + lane]; a3 += w[3] * V1c[(4 * c4 + 3) * 64 + lane]; }
        WinT_l[(size_t)(3520 + lane) * DM + k] = f2bf(((a0 + a1) + (a2 + a3)) * gain[k]);
        asm volatile("s_waitcnt lgkmcnt(0)" ::: "memory");
    }
    __syncthreads();
}
__device__ void prep_weights(const Params& p, int l, unsigned char* lds, int worker, int nworkers) {
    float* tile = (float*)lds;
    bf16_t* WinT = (bf16_t*)(p.ws + WS_WIN) + (size_t)l * NINT * DM; bf16_t* WoutT = (bf16_t*)(p.ws + WS_WOUT) + (size_t)l * DM * DM; bf16_t* WpwT = (bf16_t*)(p.ws + WS_WPW) + (size_t)l * CW * CW;
    const int nt_in = (NINT / 64) * (DM / 64), nt_out = (DM / 64) * (DM / 64), nt_pw = (CW / 64) * (CW / 64);
    for (int j = worker; j < nt_in + nt_out + nt_pw; j += nworkers) {
        if (j < nt_in) transpose_tile(p.in[3] + (size_t)l * DM * DIN, DIN, DIN, p.in[1] + l * DM, WinT, DM, (j / (DM / 64)) * 64, (j % (DM / 64)) * 64, true, tile, l > 0);
        else if (j < nt_in + nt_out) { const int r = j - nt_in; transpose_tile(p.in[4] + (size_t)l * DM * DM, DM, DM, nullptr, WoutT, DM, (r / (DM / 64)) * 64, (r % (DM / 64)) * 64, false, tile); }
        else { const int r = j - nt_in - nt_out; transpose_tile(p.in[9] + (size_t)l * CW * CW, CW, CW, nullptr, WpwT, CW, (r >> 2) * 64, (r & 3) * 64, false, tile); }
    }
    if (l > 0) fold_v1_rows(p, l, WinT, tile, worker, nworkers);
}

__device__ void rows_to_xb(const float* X, bf16_t* XB) {
    const int tid = tid_(), lane = tid & 63, wave = __builtin_amdgcn_readfirstlane(tid >> 6);
    for (int row = blockIdx.x * 8 + wave; row < M; row += gridDim.x * 8) {
        const float* xr = X + (size_t)row * DM;
        f32x4 v[4]; float ss = 0.f;
#pragma unroll
        for (int i = 0; i < 4; ++i) { v[i] = __builtin_nontemporal_load((const f32x4*)(xr + i * 256 + lane * 4)); ss += v[i][0] * v[i][0] + v[i][1] * v[i][1] + v[i][2] * v[i][2] + v[i][3] * v[i][3]; }
        ss = wave_sum(ss);
        const float rstd = rsqrtf(ss * (1.0f / DM) + RMS_EPS);
#pragma unroll
        for (int i = 0; i < 4; ++i) { uint2 w; w.x = pk2(v[i][0] * rstd, v[i][1] * rstd); w.y = pk2(v[i][2] * rstd, v[i][3] * rstd); *(uint2*)(XB + (size_t)row * DM + i * 256 + lane * 4) = w; }
    }
}

__device__ __forceinline__ bool defer_layer1_weights() { return gridDim.x >= BATCH * NH + 32; }
__device__ void phase_prologue(const Params& p, unsigned char* lds) {
    prep_weights(p, 0, lds, blockIdx.x, gridDim.x);
    if (!defer_layer1_weights()) for (int l = 1; l < DEPTH; ++l) prep_weights(p, l, lds, blockIdx.x, gridDim.x);
    rows_to_xb(p.in[0], (bf16_t*)(p.ws + WS_XB));
}

namespace pg8 {
#define PG8_LAS __attribute__((address_space(3)))
typedef unsigned short bf16_t;
typedef short bf16x8 __attribute__((ext_vector_type(8)));
typedef float f32x4 __attribute__((ext_vector_type(4)));
typedef unsigned u32x4 __attribute__((ext_vector_type(4)));
constexpr int BM = 256, BK = 64, HALF = 128, HTB = HALF * BK * 2  , STAGE_BYTES = 8 * HTB, NXCD = 8, WGM = 8;

__host__ __device__ __forceinline__ int lds_byte(int r, int c) { const int st = (r >> 4) * 2 + (c >> 5), rr = r & 15, cc = c & 31, ob = rr * 64 + cc * 2; return st * 1024 + (ob ^ (((ob >> 9) & 1) << 5)); }
__host__ __device__ __forceinline__ void stage_rc(int b, int& R, int& C) { const int st = b / 1024, sb = b % 1024, swz = sb ^ (((sb >> 9) & 1) << 5); R = (st >> 1) * 16 + swz / 64; C = (st & 1) * 32 + (swz % 64) / 2; }
__host__ __device__ __forceinline__ int perm32(int rho) { const int n = rho >> 4, i = rho & 15; return 8 * (i >> 2) + 4 * n + (i & 3); }

struct Unit { int pm, pn; };
struct Gemm { const bf16_t* A; const bf16_t* Bt; int M, N, K; };

struct StaticOrder {
    int nM, nN, nwg, G, c;
    __host__ __device__ void init(int M, int N, int G_, int c_) { nM = M / BM; nN = N / BM; nwg = nM * nN; G = G_; c = c_; }
    __host__ __device__ bool next(int i, Unit& u) const {
        const long L = (long)i * G + c; if (L >= nwg) return false;
        int wgid = (int)L; { const int q = nwg / NXCD, r = nwg % NXCD, xcd = wgid % NXCD, off = wgid / NXCD; wgid = (xcd < r ? xcd * (q + 1) : r * (q + 1) + (xcd - r) * q) + off; }
        const int nig = WGM * nN, gid = wgid / nig, fm = gid * WGM, gsz = (nM - fm) < WGM ? (nM - fm) : WGM;
        u.pm = fm + ((wgid % nig) % gsz); u.pn = (wgid % nig) / gsz; return true;
    }
    __device__ __forceinline__ void a_ready(const Unit&) const {}
    __device__ __forceinline__ void done(const Unit&) const {}
};


__device__ __forceinline__ unsigned cvt_pk_bf16(float lo, float hi) { unsigned r; asm volatile("v_cvt_pk_bf16_f32 %0, %1, %2" : "=v"(r) : "v"(lo), "v"(hi)); return r; }

template <class Epi, class Sched, bool ALIGN_EPI = false, bool SP2 = false>
__device__ __forceinline__ void gemm_phase(PG8_LAS unsigned char* lds, const Gemm g, const Sched& S, const Epi& E) {
    const int tid = tid_(), wid = __builtin_amdgcn_readfirstlane(tid >> 6), lane = tid & 63, wr = wid >> 2, wc = wid & 3, fr = lane & 15, fq = lane >> 4;
    const int K = g.K, nt = K / BK;
    unsigned voffA[2], voffB[2];
#pragma unroll
    for (int i = 0; i < 2; ++i) { int R, C; stage_rc(tid * 16 + i * 8192, R, C); const int Rb = Epi::PERM ? ((R & ~31) + perm32(R & 31)) : R;
        voffA[i] = (unsigned)(R * K + C) * 2u; voffB[i] = (unsigned)(Rb * K + C) * 2u; }
    const size_t kstep = (size_t)(BK * 2);
    const size_t hstep = (size_t)HALF * K * 2;
    const size_t tstep = 2 * hstep;
    const unsigned ldsw = (unsigned)wid * 1024u;
    const int aoff = lds_byte(wr * 64 + fr, fq * 8), boff = lds_byte(wc * 32 + fr, fq * 8);
#define PG8_SA(b, h) (((b) * 2 + (h)) * HTB)
#define PG8_SB(b, h) ((4 + (b) * 2 + (h)) * HTB)
#define PG8_STAGE(bufoff, gbase, voff) do { _Pragma("unroll") for (int _i = 0; _i < 2; ++_i) \
        __builtin_amdgcn_global_load_lds((const unsigned*)((const char*)(gbase) + (voff)[_i]), (PG8_LAS unsigned*)(lds + (bufoff) + ldsw + _i * 8192), 16, 0, 0); } while (0)
#define PG8_LDA(dst, b, h) do { _Pragma("unroll") for (int m = 0; m < 4; ++m) _Pragma("unroll") for (int k = 0; k < 2; ++k) dst[m][k] = *(const PG8_LAS bf16x8*)(lds + PG8_SA(b, h) + aoff + m * 2048 + k * 1024); } while (0)
#define PG8_LDB(dst, b, h) do { _Pragma("unroll") for (int n = 0; n < 2; ++n) _Pragma("unroll") for (int k = 0; k < 2; ++k) dst[n][k] = *(const PG8_LAS bf16x8*)(lds + PG8_SB(b, h) + boff + n * 2048 + k * 1024); } while (0)
#define PG8_MMA(ai, bj, At, Bt) do { __builtin_amdgcn_s_setprio(1); _Pragma("unroll") for (int m = 0; m < 4; ++m) _Pragma("unroll") for (int n = 0; n < 2; ++n) _Pragma("unroll") for (int k = 0; k < 2; ++k) \
        acc[ai][bj][m][n] = __builtin_amdgcn_mfma_f32_16x16x32_bf16(Bt[n][k], At[m][k], acc[ai][bj][m][n], 0, 0, 0); __builtin_amdgcn_s_setprio(0); } while (0)
#define PG8_WAIT_V(n) asm volatile("s_waitcnt vmcnt(" #n ")" ::: "memory")
#define PG8_WAIT_L(n) asm volatile("s_waitcnt lgkmcnt(" #n ")" ::: "memory")
#define PG8_BAR __builtin_amdgcn_s_barrier()
#define PG8_SCHED __builtin_amdgcn_sched_barrier(0)
    Unit cur, nxt; int ui = 0;
    if (!S.next(0, cur)) return;
    f32x4 acc[2][2][4][2];
#pragma unroll
    for (int a = 0; a < 2; ++a)
#pragma unroll
        for (int b = 0; b < 2; ++b)
#pragma unroll
            for (int m = 0; m < 4; ++m)
#pragma unroll
                for (int n = 0; n < 2; ++n) acc[a][b][m][n] = (f32x4){0.f, 0.f, 0.f, 0.f};
    bf16x8 At[4][2], B0[2][2], B1[2][2];
    const char* cA = (const char*)g.A + (size_t)cur.pm * tstep; const char* cB = (const char*)g.Bt + (size_t)cur.pn * tstep;
    S.a_ready(cur);
    if constexpr (SP2) {
        PG8_STAGE(PG8_SB(0, 0), cB, voffB); PG8_STAGE(PG8_SB(0, 1), cB + hstep, voffB); PG8_STAGE(PG8_SA(0, 0), cA, voffA); PG8_STAGE(PG8_SA(0, 1), cA + hstep, voffA);
        if (wr == 1) PG8_BAR;
        PG8_WAIT_V(2); PG8_BAR;
        PG8_STAGE(PG8_SB(1, 0), cB + kstep, voffB); PG8_STAGE(PG8_SA(1, 0), cA + kstep, voffA); PG8_STAGE(PG8_SB(1, 1), cB + hstep + kstep, voffB);
        PG8_WAIT_V(6); PG8_BAR;
    } else {
        PG8_STAGE(PG8_SB(0, 0), cB, voffB); PG8_STAGE(PG8_SA(0, 0), cA, voffA); PG8_STAGE(PG8_SB(0, 1), cB + hstep, voffB); PG8_STAGE(PG8_SA(0, 1), cA + hstep, voffA);
        if (wr == 1) PG8_BAR;
        PG8_WAIT_V(4); PG8_BAR;
        PG8_STAGE(PG8_SB(1, 0), cB + kstep, voffB); PG8_STAGE(PG8_SA(1, 0), cA + kstep, voffA); PG8_STAGE(PG8_SB(1, 1), cB + hstep + kstep, voffB);
        PG8_WAIT_V(6); PG8_BAR;
    }
    for (;;) {
        const bool has_next = S.next(ui + 1, nxt);
        const char* nA = has_next ? (const char*)g.A + (size_t)nxt.pm * tstep : cA; const char* nB = has_next ? (const char*)g.Bt + (size_t)nxt.pn * tstep : cB;
        for (int t = 0; t < nt; t += 2) {
            const bool last = (t == nt - 2);
            const char* a1 = cA + (size_t)(t + 1) * kstep;
            const char* a2 = last ? nA : cA + (size_t)(t + 2) * kstep; const char* b2 = last ? nB : cB + (size_t)(t + 2) * kstep;
            const char* a3 = a2 + kstep; const char* b3 = b2 + kstep;
            if (last && has_next) S.a_ready(nxt);
            if constexpr (SP2) {
            PG8_LDB(B0, 0, 0); PG8_LDB(B1, 0, 1); PG8_SCHED; PG8_LDA(At, 0, 0); PG8_STAGE(PG8_SA(1, 1), a1 + hstep, voffA);
            PG8_WAIT_V(8); PG8_WAIT_L(0); PG8_BAR; PG8_MMA(0, 0, At, B0); PG8_MMA(0, 1, At, B1); PG8_BAR; PG8_SCHED;
            PG8_LDA(At, 0, 1); PG8_STAGE(PG8_SB(0, 0), b2, voffB); PG8_STAGE(PG8_SB(0, 1), b2 + hstep, voffB); PG8_STAGE(PG8_SA(0, 0), a2, voffA);
            PG8_WAIT_V(8); PG8_WAIT_L(0); PG8_BAR; PG8_MMA(1, 0, At, B0); PG8_MMA(1, 1, At, B1); PG8_BAR; PG8_SCHED;
            PG8_LDB(B0, 1, 0); PG8_LDB(B1, 1, 1); PG8_SCHED; PG8_LDA(At, 1, 0); PG8_STAGE(PG8_SA(0, 1), a2 + hstep, voffA);
            PG8_WAIT_V(8); PG8_WAIT_L(0); PG8_BAR; PG8_MMA(0, 0, At, B0); PG8_MMA(0, 1, At, B1); PG8_BAR; PG8_SCHED;
            PG8_LDA(At, 1, 1); PG8_STAGE(PG8_SB(1, 0), b3, voffB); PG8_STAGE(PG8_SB(1, 1), b3 + hstep, voffB); PG8_STAGE(PG8_SA(1, 0), a3, voffA);
            PG8_WAIT_V(8); PG8_WAIT_L(0); PG8_BAR; PG8_MMA(1, 0, At, B0); PG8_MMA(1, 1, At, B1); PG8_BAR; PG8_SCHED;
            } else {
            PG8_LDB(B0, 0, 0); PG8_SCHED; PG8_LDA(At, 0, 0); PG8_STAGE(PG8_SA(1, 1), a1 + hstep, voffA);
            PG8_WAIT_L(8); PG8_BAR; PG8_WAIT_L(0); PG8_MMA(0, 0, At, B0); PG8_BAR; PG8_SCHED;
            PG8_LDB(B1, 0, 1); PG8_STAGE(PG8_SB(0, 0), b2, voffB);
            PG8_BAR; PG8_WAIT_L(0); PG8_MMA(0, 1, At, B1); PG8_BAR;
            PG8_LDA(At, 0, 1); PG8_STAGE(PG8_SA(0, 0), a2, voffA);
            PG8_BAR; PG8_WAIT_L(0); PG8_MMA(1, 0, At, B0); PG8_BAR; PG8_SCHED;
            PG8_STAGE(PG8_SB(0, 1), b2 + hstep, voffB);
            PG8_WAIT_V(6); PG8_BAR; PG8_MMA(1, 1, At, B1); PG8_BAR;
            PG8_LDB(B0, 1, 0); PG8_SCHED; PG8_LDA(At, 1, 0); PG8_STAGE(PG8_SA(0, 1), a2 + hstep, voffA);
            PG8_WAIT_L(8); PG8_BAR; PG8_WAIT_L(0); PG8_MMA(0, 0, At, B0); PG8_BAR; PG8_SCHED;
            PG8_LDB(B1, 1, 1); PG8_STAGE(PG8_SB(1, 0), b3, voffB);
            PG8_BAR; PG8_WAIT_L(0); PG8_MMA(0, 1, At, B1); PG8_BAR;
            PG8_LDA(At, 1, 1); PG8_STAGE(PG8_SA(1, 0), a3, voffA);
            PG8_BAR; PG8_WAIT_L(0); PG8_MMA(1, 0, At, B0); PG8_BAR; PG8_SCHED;
            PG8_STAGE(PG8_SB(1, 1), b3 + hstep, voffB);
            PG8_WAIT_V(6); PG8_BAR; PG8_MMA(1, 1, At, B1); PG8_BAR;
            }
        }
        if constexpr (ALIGN_EPI) { if (wr == 0) PG8_BAR; }
        if constexpr (!Epi::AFTER_DRAIN) { E(acc, cur, wr, wc, fr, fq); S.done(cur); }
        if (!has_next) break;
#pragma unroll
        for (int a = 0; a < 2; ++a)
#pragma unroll
            for (int b = 0; b < 2; ++b)
#pragma unroll
                for (int m = 0; m < 4; ++m)
#pragma unroll
                    for (int n = 0; n < 2; ++n) acc[a][b][m][n] = (f32x4){0.f, 0.f, 0.f, 0.f};
        cur = nxt; cA = nA; cB = nB; ++ui;
        if constexpr (ALIGN_EPI) { if (wr == 1) PG8_BAR; }
    }
    PG8_WAIT_V(0);
    if constexpr (!ALIGN_EPI) { if (wr == 0) PG8_BAR; }
    PG8_BAR;
    if constexpr (Epi::AFTER_DRAIN) { E.fused(acc, cur, wr, wc, fr, fq, lds, wid, lane); S.done(cur); }
#undef PG8_SA
#undef PG8_SB
#undef PG8_STAGE
#undef PG8_LDA
#undef PG8_LDB
#undef PG8_MMA
#undef PG8_WAIT_V
#undef PG8_WAIT_L
#undef PG8_BAR
#undef PG8_SCHED
}
}

struct EpiInProjP {
    static constexpr bool PERM = true, AFTER_DRAIN = false;
    bf16_t *PC, *PS, *PR, *PG, *VT;
    __device__ __forceinline__ void operator()(const pg8::f32x4 (&acc)[2][2][4][2], const pg8::Unit& u, int wr, int wc, int fr, int fq) const {
        const int row0 = u.pm * 256 + wr * 64 + fr;
#pragma unroll
        for (int bj = 0; bj < 2; ++bj) {
            const int blk = 2 * u.pn + bj; bf16_t* base; int ld, c0;
            if (blk >= 12 && blk < 15) {
                const int vc = 128 * (blk - 12) + wc * 32 + 8 * fq;
#pragma unroll
                for (int ai = 0; ai < 2; ++ai)
#pragma unroll
                    for (int m = 0; m < 4; ++m) {
                        const int row = row0 + ai * 128 + m * 16, b = row >> 11, t = row & 2047;
#pragma unroll
                        for (int n = 0; n < 2; ++n)
#pragma unroll
                            for (int e = 0; e < 4; ++e) { const int col = vc + 4 * n + e, hh = col >> 6, d = col & 63;
                                VT[((size_t)(b * NH + hh) * HD + d) * SEQ + t] = f2bf(acc[ai][bj][m][n][e]); }
                    }
                continue;
            }
            if (blk < 6) { base = PC; ld = PC_W; c0 = 128 * blk; }
            else if (blk < 12) { base = PS; ld = PS_W; c0 = 128 * (blk - 6); }
            else if (blk < 18) { base = PS; ld = PS_W; c0 = 768 + 128 * (blk - 15); }
            else if (blk < 28) { base = PR; ld = PR_W; c0 = 128 * (blk - 18); }
            else if (blk < 31) { base = PG; ld = PG_W; c0 = 128 * (blk - 28); }
            else continue;
            const int col = c0 + wc * 32 + 8 * fq;
#pragma unroll
            for (int ai = 0; ai < 2; ++ai)
#pragma unroll
                for (int m = 0; m < 4; ++m) {
                    const pg8::f32x4 v0 = acc[ai][bj][m][0], v1 = acc[ai][bj][m][1]; pg8::u32x4 w;
                    w.x = pg8::cvt_pk_bf16(v0[0], v0[1]); w.y = pg8::cvt_pk_bf16(v0[2], v0[3]); w.z = pg8::cvt_pk_bf16(v1[0], v1[1]); w.w = pg8::cvt_pk_bf16(v1[2], v1[3]);
                    *(pg8::u32x4*)(base + (size_t)(row0 + ai * 128 + m * 16) * ld + col) = w;
                }
        }
    }
};
struct EpiOutBf16P {
    static constexpr bool PERM = true, AFTER_DRAIN = false;
    bf16_t* Y; int ld;
    __device__ __forceinline__ void operator()(const pg8::f32x4 (&acc)[2][2][4][2], const pg8::Unit& u, int wr, int wc, int fr, int fq) const {
        const int row0 = u.pm * 256 + wr * 64 + fr, col0 = u.pn * 256 + wc * 32 + 8 * fq;
#pragma unroll
        for (int ai = 0; ai < 2; ++ai)
#pragma unroll
            for (int m = 0; m < 4; ++m)
#pragma unroll
                for (int bj = 0; bj < 2; ++bj) {
                    const pg8::f32x4 v0 = acc[ai][bj][m][0], v1 = acc[ai][bj][m][1]; pg8::u32x4 w;
                    w.x = pg8::cvt_pk_bf16(v0[0], v0[1]); w.y = pg8::cvt_pk_bf16(v0[2], v0[3]); w.z = pg8::cvt_pk_bf16(v1[0], v1[1]); w.w = pg8::cvt_pk_bf16(v1[2], v1[3]);
                    *(pg8::u32x4*)(Y + (size_t)(row0 + ai * 128 + m * 16) * ld + col0 + bj * 128) = w;
                }
    }
};

__device__ void phase_rowpass(const float* Xin, const bf16_t* Y, const float* gpost, float* Xout, bf16_t* XB) {
    const int tid = tid_(), lane = tid & 63, wave = __builtin_amdgcn_readfirstlane(tid >> 6);
    for (int row = blockIdx.x * 8 + wave; row < M; row += gridDim.x * 8) {
        f32x4 y[4], x[4]; float ss = 0.f;
#pragma unroll
        for (int i = 0; i < 4; ++i) { const uint2 yw = ldnt_u2((const void*)(Y + (size_t)row * DM + i * 256 + lane * 4));
            y[i] = (f32x4){bf2f((bf16_t)(yw.x & 0xffff)), bf2f((bf16_t)(yw.x >> 16)), bf2f((bf16_t)(yw.y & 0xffff)), bf2f((bf16_t)(yw.y >> 16))};
            x[i] = __builtin_nontemporal_load((const f32x4*)(Xin + (size_t)row * DM + i * 256 + lane * 4));
            ss += y[i][0] * y[i][0] + y[i][1] * y[i][1] + y[i][2] * y[i][2] + y[i][3] * y[i][3]; }
        ss = wave_sum(ss);
        const float rstd = rsqrtf(ss * (1.0f / DM) + RMS_EPS);
        float s2 = 0.f;
#pragma unroll
        for (int i = 0; i < 4; ++i) { const f32x4 g = *(const f32x4*)(gpost + i * 256 + lane * 4);
            x[i] = x[i] + y[i] * rstd * g; s2 += x[i][0] * x[i][0] + x[i][1] * x[i][1] + x[i][2] * x[i][2] + x[i][3] * x[i][3];
            __builtin_nontemporal_store(x[i], (f32x4*)(Xout + (size_t)row * DM + i * 256 + lane * 4)); }
        if (XB) {
            s2 = wave_sum(s2);
            const float r2 = rsqrtf(s2 * (1.0f / DM) + RMS_EPS);
#pragma unroll
            for (int i = 0; i < 4; ++i) { uint2 w; w.x = pk2(x[i][0] * r2, x[i][1] * r2); w.y = pk2(x[i][2] * r2, x[i][3] * r2); *(uint2*)(XB + (size_t)row * DM + i * 256 + lane * 4) = w; }
        }
    }
}

constexpr int CV_AS = 264;
constexpr int CV_CS = 264;
__device__ void conv_job64(const Params& p, int l, int job, unsigned char* lds) {
    const int tid = tid_(), lane = tid & 63, wave = __builtin_amdgcn_readfirstlane(tid >> 6), fr = lane & 15, fq = lane >> 4;
    const int b = job >> 5, t0 = (job & 31) * 64;
    const bf16_t* PC = (const bf16_t*)(p.ws + WS_PC); bf16_t* MIX = (bf16_t*)(p.ws + WS_MIX);
    const float* dw = p.in[5] + l * TAPS * CW; const float* dwb = p.in[6] + l * CW; const float* lng = p.in[7] + l * CW; const float* lnb = p.in[8] + l * CW;
    const bf16_t* pwT = (const bf16_t*)(p.ws + WS_WPW) + (size_t)l * CW * CW; const float* pwb = p.in[10] + l * CW;
    float* u = (float*)lds;
    bf16_t* act = (bf16_t*)(lds + 94 * 256 * 4);
    for (int idx = tid; idx < 94 * 32; idx += 512) {
        const int r = idx >> 5, c8 = (idx & 31) * 8, t = t0 - 30 + r;
        float v[8];
        if (t >= 0) { const bf16_t* pr = PC + ((size_t)b * SEQ + t) * PC_W + c8; const bf16x8 a = *(const bf16x8*)pr, g = *(const bf16x8*)(pr + 256);
#pragma unroll
            for (int e = 0; e < 8; ++e) v[e] = bf2f((bf16_t)a[e]) * __builtin_amdgcn_rcpf(1.0f + __builtin_amdgcn_exp2f(-1.4426950408889634f * bf2f((bf16_t)g[e]))); }
        else {
#pragma unroll
            for (int e = 0; e < 8; ++e) v[e] = 0.f; }
        *(f32x4*)(u + r * 256 + c8) = (f32x4){v[0], v[1], v[2], v[3]}; *(f32x4*)(u + r * 256 + c8 + 4) = (f32x4){v[4], v[5], v[6], v[7]};
    }
    __syncthreads();
    const int c = tid & 255, half = tid >> 8;
    float acc[32];
    {
        float w[TAPS];
#pragma unroll
        for (int j = 0; j < TAPS; ++j) w[j] = dw[j * CW + c];
        const float bias = dwb[c];
#pragma unroll
        for (int i = 0; i < 32; ++i) acc[i] = bias;
        const float* up = u + (half * 32) * 256 + c;
#pragma unroll
        for (int rr = 0; rr < 62; ++rr) {
            const float uv = up[rr * 256];
#pragma unroll
            for (int i = 0; i < 32; ++i) { if (rr - i >= 0 && rr - i < TAPS) acc[i] += w[rr - i] * uv; }
        }
    }
    __syncthreads();
    float* cv = u;
#pragma unroll
    for (int i = 0; i < 32; ++i) cv[(half * 32 + i) * CV_CS + c] = acc[i];
    __syncthreads();
    uint4 gcv[4];
#pragma unroll
    for (int j = 0; j < 4; ++j) gcv[j] = *(const uint4*)(PC + ((size_t)b * SEQ + t0 + j * 16 + fr) * PC_W + 512 + wave * 32 + fq * 8);
    {
        const int tt = wave * 8 + (lane >> 3), pp = lane & 7;
        f32x4 x[8]; float s_ = 0.f;
#pragma unroll
        for (int k = 0; k < 8; ++k) { x[k] = *(const f32x4*)(cv + tt * CV_CS + 4 * pp + 32 * k); s_ += (x[k][0] + x[k][1]) + (x[k][2] + x[k][3]); }
        s_ += __shfl_xor(s_, 1); s_ += __shfl_xor(s_, 2); s_ += __shfl_xor(s_, 4);
        const float mean = s_ * (1.0f / CW); float q_ = 0.f;
#pragma unroll
        for (int k = 0; k < 8; ++k) { x[k] = x[k] - mean; q_ += (x[k][0] * x[k][0] + x[k][1] * x[k][1]) + (x[k][2] * x[k][2] + x[k][3] * x[k][3]); }
        q_ += __shfl_xor(q_, 1); q_ += __shfl_xor(q_, 2); q_ += __shfl_xor(q_, 4);
        const float rstd = rsqrtf(q_ * (1.0f / CW) + LN_EPS);
#pragma unroll
        for (int k = 0; k < 8; ++k) {
            const f32x4 g = *(const f32x4*)(lng + 4 * pp + 32 * k), bb = *(const f32x4*)(lnb + 4 * pp + 32 * k);
            float y[4];
#pragma unroll
            for (int e = 0; e < 4; ++e) y[e] = siluf_(x[k][e] * rstd * g[e] + bb[e]);
            uint2 w; w.x = pk2(y[0], y[1]); w.y = pk2(y[2], y[3]); *(uint2*)(act + tt * CV_AS + 4 * pp + 32 * k) = w;
        }
    }
    __syncthreads();
    {
        f32x4 o[2][4];
#pragma unroll
        for (int i = 0; i < 2; ++i)
#pragma unroll
            for (int j = 0; j < 4; ++j) o[i][j] = (f32x4){0.f, 0.f, 0.f, 0.f};
#pragma unroll 2
        for (int kk = 0; kk < 8; ++kk) {
            bf16x8 a[2], bq[4];
#pragma unroll
            for (int i = 0; i < 2; ++i) a[i] = *(const bf16x8*)(pwT + (size_t)(wave * 32 + 8 * (fr >> 2) + 4 * i + (fr & 3)) * CW + kk * 32 + fq * 8);
#pragma unroll
            for (int j = 0; j < 4; ++j) bq[j] = *(const bf16x8*)(act + (j * 16 + fr) * CV_AS + kk * 32 + fq * 8);
#pragma unroll
            for (int i = 0; i < 2; ++i)
#pragma unroll
                for (int j = 0; j < 4; ++j) o[i][j] = __builtin_amdgcn_mfma_f32_16x16x32_bf16(a[i], bq[j], o[i][j], 0, 0, 0);
        }
        {
            const int n0 = wave * 32 + fq * 8; const f32x4 bias0 = *(const f32x4*)(pwb + n0), bias1 = *(const f32x4*)(pwb + n0 + 4);
#pragma unroll
            for (int j = 0; j < 4; ++j) {
                const size_t row = (size_t)b * SEQ + t0 + j * 16 + fr;
                const uint4 gw = gcv[j];
                const f32x4 v0 = o[0][j] + bias0, v1 = o[1][j] + bias1;
                uint4 w;
                w.x = pk2(v0[0] * siluf_(bf2f((bf16_t)(gw.x & 0xffff))), v0[1] * siluf_(bf2f((bf16_t)(gw.x >> 16)))); w.y = pk2(v0[2] * siluf_(bf2f((bf16_t)(gw.y & 0xffff))), v0[3] * siluf_(bf2f((bf16_t)(gw.y >> 16))));
                w.z = pk2(v1[0] * siluf_(bf2f((bf16_t)(gw.z & 0xffff))), v1[1] * siluf_(bf2f((bf16_t)(gw.z >> 16)))); w.w = pk2(v1[2] * siluf_(bf2f((bf16_t)(gw.w & 0xffff))), v1[3] * siluf_(bf2f((bf16_t)(gw.w >> 16))));
                *(uint4*)(MIX + row * DM + n0) = w;
            }
        }
    }
    __syncthreads();
}

typedef float f32x16 __attribute__((ext_vector_type(16)));
struct AttFrag { bf16x8 K[4], V[2][2]; };
constexpr int AT_WIN = 224;
constexpr int AT_KS = 144, AT_VS = 976;
constexpr int AT_VOFF = (AT_WIN + 256) * AT_KS;
static_assert(AT_VOFF + 64 * AT_VS <= 147456, "attention LDS map");
__device__ __forceinline__ void att_load(AttFrag& F, const bf16_t* kbase, const bf16_t* vbase, const unsigned char* klds, const unsigned char* vlds, int w0, int kt) {
    const int s0 = (kt > 0 ? kt : 0) * 32;
    if (s0 >= w0) {
        const unsigned char* kp = klds + (s0 - w0) * AT_KS; const unsigned char* vp = vlds + (s0 - w0) * 2;
#pragma unroll
        for (int ks = 0; ks < 4; ++ks) F.K[ks] = *(const bf16x8*)(kp + ks * 32);
#pragma unroll
        for (int db = 0; db < 2; ++db)
#pragma unroll
            for (int s = 0; s < 2; ++s) F.V[db][s] = *(const bf16x8*)(vp + db * 32 * AT_VS + s * 16);
    } else {
#pragma unroll
        for (int ks = 0; ks < 4; ++ks) F.K[ks] = *(const bf16x8*)(kbase + (size_t)s0 * PS_W + ks * 16);
#pragma unroll
        for (int db = 0; db < 2; ++db)
#pragma unroll
            for (int s = 0; s < 2; ++s) F.V[db][s] = *(const bf16x8*)(vbase + (size_t)db * 32 * SEQ + s0 + s * 8);
    }
}
__device__ __forceinline__ bool att_tile(const AttFrag& F, const bf16x8 (&Qf)[4], f32x16& O0, f32x16& O1, float& rp, bool diag, int qi, int hf) {
    f32x16 S;
#pragma unroll
    for (int r = 0; r < 16; ++r) S[r] = 0.f;
#pragma unroll
    for (int ks = 0; ks < 4; ++ks) S = __builtin_amdgcn_mfma_f32_32x32x16_bf16(F.K[ks], Qf[ks], S, 0, 0, 0);
    float tot = 1.0f;
#pragma unroll
    for (int r = 0; r < 16; ++r) {
        float k_ = __builtin_amdgcn_rcpf(1.0f + __builtin_amdgcn_exp2f(S[r]));
        if (diag && (hf * 16 + r >= qi)) k_ = 1.0f;
        S[r] = k_; tot *= k_;
    }
    const float toto = __shfl_xor(tot, 32);
    float e = hf ? rp : rp * toto;
#pragma unroll
    for (int r = 15; r >= 0; --r) { const float k_ = S[r]; S[r] = (1.0f - k_) * e; e *= k_; }
    rp = rp * tot * toto;
    bf16x8 Pf[2];
#pragma unroll
    for (int s = 0; s < 2; ++s) {
        union { bf16x8 v; unsigned u[4]; } pk;
#pragma unroll
        for (int j = 0; j < 4; ++j) pk.u[j] = pk2(S[8 * s + 2 * j], S[8 * s + 2 * j + 1]);
        Pf[s] = pk.v;
    }
#pragma unroll
    for (int s = 0; s < 2; ++s) { O0 = __builtin_amdgcn_mfma_f32_32x32x16_bf16(F.V[0][s], Pf[s], O0, 0, 0, 0); O1 = __builtin_amdgcn_mfma_f32_32x32x16_bf16(F.V[1][s], Pf[s], O1, 0, 0, 0); }
    return __ballot(rp != 0.0f) == 0ull;
}
__device__ void attn_wg_job(const Params& p, int job, unsigned char* lds) {
    const int tid = tid_(), lane = tid & 63, wave = __builtin_amdgcn_readfirstlane(tid >> 6), qi = lane & 31, hf = lane >> 5;
    const int bh = job >> 3, g = job & 7, b = bh / NH, h = bh % NH;
    const bf16_t* PS = (const bf16_t*)(p.ws + WS_PS); const bf16_t* VT = (const bf16_t*)(p.ws + WS_VT) + (size_t)bh * HD * SEQ; bf16_t* MIX = (bf16_t*)(p.ws + WS_MIX);
    const int w0 = g * 256 > AT_WIN ? g * 256 - AT_WIN : 0, nkeys = g * 256 + 256 - w0;
    unsigned char* klds = lds; unsigned char* vlds = lds + AT_VOFF;
    bf16x8 Qf[4];
#pragma unroll
    for (int ks = 0; ks < 4; ++ks) Qf[ks] = *(const bf16x8*)(PS + ((size_t)b * SEQ + (g * 8 + wave) * 32 + qi) * PS_W + h * HD + ks * 16 + hf * 8);
    uint4 gwv[2][2];
#pragma unroll
    for (int db = 0; db < 2; ++db)
#pragma unroll
        for (int gq = 0; gq < 2; ++gq) gwv[db][gq] = *(const uint4*)(PS + ((size_t)b * SEQ + (g * 8 + wave) * 32 + qi) * PS_W + 768 + h * HD + db * 32 + hf * 16 + gq * 8);
    {
        const bf16_t* ksrc = PS + ((size_t)b * SEQ + w0) * PS_W + SBW + h * HD;
        for (int idx = tid; idx < nkeys * 8; idx += 512) { const int row = idx >> 3, pc = idx & 7; *(uint4*)(klds + row * AT_KS + pc * 16) = *(const uint4*)(ksrc + (size_t)row * PS_W + pc * 8); }
        const int pc = tid & 63, npc = nkeys >> 3;
        if (pc < npc) {
#pragma unroll
            for (int i = 0; i < 8; ++i) { const int d = (tid >> 6) + 8 * i; *(uint4*)(vlds + d * AT_VS + pc * 16) = *(const uint4*)(VT + (size_t)d * SEQ + w0 + pc * 8); }
        }
    }
    __syncthreads();
    {
        const int qblk = g * 8 + wave, q0 = qblk * 32;
        const size_t rowq = (size_t)b * SEQ + q0 + qi;
        const int pi = (qi & 3) + 4 * (qi >> 3) + 16 * ((qi >> 2) & 1);
        const bf16_t* kbase = PS + ((size_t)b * SEQ + pi) * PS_W + SBW + h * HD + hf * 8;
        const bf16_t* vbase = VT + (size_t)pi * SEQ + hf * 16;
        const unsigned char* kl = klds + pi * AT_KS + hf * 16; const unsigned char* vl = vlds + pi * AT_VS + hf * 32;
        AttFrag FA, FB;
        att_load(FA, kbase, vbase, kl, vl, w0, qblk);
        f32x16 O0, O1;
#pragma unroll
        for (int r = 0; r < 16; ++r) { O0[r] = 0.f; O1[r] = 0.f; }
        float rp = 1.0f;
        for (int kt = qblk; kt >= 0; kt -= 2) {
            att_load(FB, kbase, vbase, kl, vl, w0, kt - 1);
            if (att_tile(FA, Qf, O0, O1, rp, kt == qblk, qi, hf) || kt < 1) break;
            att_load(FA, kbase, vbase, kl, vl, w0, kt - 2);
            if (att_tile(FB, Qf, O0, O1, rp, false, qi, hf)) break;
        }
        bf16_t* op = MIX + rowq * DM + CW + h * HD;
#pragma unroll
        for (int db = 0; db < 2; ++db)
#pragma unroll
            for (int gq = 0; gq < 2; ++gq) {
                const uint4 gw = gwv[db][gq]; const f32x16& O = db ? O1 : O0;
                uint4 w;
                w.x = pk2(O[8 * gq + 0] * siluf_(bf2f((bf16_t)(gw.x & 0xffff))), O[8 * gq + 1] * siluf_(bf2f((bf16_t)(gw.x >> 16)))); w.y = pk2(O[8 * gq + 2] * siluf_(bf2f((bf16_t)(gw.y & 0xffff))), O[8 * gq + 3] * siluf_(bf2f((bf16_t)(gw.y >> 16))));
                w.z = pk2(O[8 * gq + 4] * siluf_(bf2f((bf16_t)(gw.z & 0xffff))), O[8 * gq + 5] * siluf_(bf2f((bf16_t)(gw.z >> 16)))); w.w = pk2(O[8 * gq + 6] * siluf_(bf2f((bf16_t)(gw.w & 0xffff))), O[8 * gq + 7] * siluf_(bf2f((bf16_t)(gw.w >> 16))));
                *(uint4*)(op + db * 32 + hf * 16 + gq * 8) = w;
            }
    }
    __syncthreads();
}

constexpr int TS = 72;
constexpr int TILE_B = 64 * TS * 2;
constexpr int AABS = 68, XTS = 65, CSS = 65;

__device__ __forceinline__ f32x4 mm_tile(const bf16_t* X, int m0, const bf16_t* Yt, int n0, int K, int fr, int fq, f32x4 acc) {
#pragma unroll
    for (int kk = 0; kk < 2; ++kk) {
        if (kk * 32 < K) {
            const bf16x8 a = *(const bf16x8*)(X + (m0 + fr) * TS + kk * 32 + fq * 8);
            const bf16x8 b = *(const bf16x8*)(Yt + (n0 + fr) * TS + kk * 32 + fq * 8);
            acc = __builtin_amdgcn_mfma_f32_16x16x32_bf16(a, b, acc, 0, 0, 0);
        }
    }
    return acc;
}
__device__ __forceinline__ uint2 pk4(const f32x4& v) { uint2 w; w.x = pk2(v[0], v[1]); w.y = pk2(v[2], v[3]); return w; }

struct B1Loads {
    bf16x8 rc, kc, vc, rp, kp, vp;
    f32x4 vf0, vf1;
    bf16x8 cc[2], cp[2];
};
__device__ __forceinline__ void b1_issue_loads(const Params& p, int l, int gi, int h, int tid, B1Loads& L) {
    const int b = gi >> 5, c = gi & 31, t0 = c * 64;
    const bf16_t* PR = (const bf16_t*)(p.ws + WS_PR); const float* VF = (const float*)(p.ws + WS_VF);
    {
        const int tt = tid >> 3, j0 = (tid & 7) * 8, t = t0 + tt, cj0 = h * HD + j0; const size_t row = (size_t)b * SEQ + t;
        const bf16_t* cur = PR + row * PR_W; const bf16_t* prv = cur - (t > 0 ? PR_W : 0);
        L.rc = *(const bf16x8*)(cur + cj0); L.kc = *(const bf16x8*)(cur + 384 + cj0); L.vc = *(const bf16x8*)(cur + 768 + cj0);
        L.rp = *(const bf16x8*)(prv + cj0); L.kp = *(const bf16x8*)(prv + 384 + cj0); L.vp = *(const bf16x8*)(prv + 768 + cj0);
        if (l > 0) { L.vf0 = *(const f32x4*)(VF + row * RWW + cj0); L.vf1 = *(const f32x4*)(VF + row * RWW + cj0 + 4); }
    }
    if (h == 0) {
#pragma unroll
        for (int q = 0; q < 2; ++q) {
            const int item = tid + 512 * q, tt = item >> 4, g = item & 15, t = t0 + tt;
            const bf16_t* cur = PR + ((size_t)b * SEQ + t) * PR_W + 1152; const bf16_t* prv = cur - (t > 0 ? PR_W : 0);
            const int gc = g < 12 ? g : 0, gp = g < 8 ? g : (g < 12 ? g + 4 : 0);
            L.cc[q] = *(const bf16x8*)(cur + 8 * gc); L.cp[q] = *(const bf16x8*)(prv + 8 * gp);
        }
    }
}

__device__ void rwkv_b1_phase(const Params& p, int l, unsigned char* lds) {
    const int G = gridDim.x;
    float* VF = (float*)(p.ws + WS_VF);
    const float* mu = p.in[11] + l * 1216; const float* w0 = p.in[12] + l * RWW;
    const float* a0 = p.in[14] + l * RWW; const float* kks = p.in[16] + l * RWW; const float* ka = p.in[17] + l * RWW;
    const float* rk = p.in[18] + l * RWW; const float* v0 = p.in[21];
    const float* w2 = p.in[13] + l * LORA * RWW; const float* a2 = p.in[15] + l * LORA * RWW; const float* v2 = p.in[23];
    bf16_t* T_At = (bf16_t*)lds; bf16_t* T_Rt = T_At + 64 * TS; bf16_t* T_Bt = T_Rt + 64 * TS; bf16_t* T_Kt = T_Bt + 64 * TS;
    bf16_t* T_VT = T_Kt + 64 * TS; bf16_t* T_bhT = T_VT + 64 * TS; bf16_t* T_khT = T_bhT + 64 * TS;
    bf16_t* T_Aak = T_khT + 64 * TS; bf16_t* T_Arb = T_Aak + 64 * TS; bf16_t* T_Ark = T_Arb + 64 * TS;
    bf16_t* T_WT = T_At; bf16_t* T_U0T = T_Bt;
    float* Aab = (float*)(lds + 10 * TILE_B);
    float* XT = (float*)(lds + 10 * TILE_B + 64 * AABS * 4);
    float* PCv = XT + 128 * XTS;
    float* TI = PCv + 64;
    float* CS = (float*)T_Aak;
    constexpr int LS = 33;
    float* WD = Aab; float* AD = WD + 64 * LS;
    float* VL = XT + 64 * XTS;
    float* WLT = (float*)lds; float* ALT = WLT + 64 * XTS; float* VGT = ALT + 64 * XTS;

    constexpr int NGRP = BATCH * (SEQ / 64);
    int gi = blockIdx.x;
    if (gi >= NGRP) return;
    B1Loads L;
    b1_issue_loads(p, l, gi, 0, tid_(), L);
    float codes[2][8];
#pragma unroll 1
    for (int it = 0; gi < NGRP; ++it) {
        const int h = it % NH;
        const int tid = tid_(), lane = tid & 63, wave = __builtin_amdgcn_readfirstlane(tid >> 6), fr = lane & 15, fq = lane >> 4;
        const int b = gi >> 5, c = gi & 31, bh = b * NH + h, jb = bh * 32 + c, t0 = c * 64;
        float wg[6][8];
#pragma unroll
        for (int q = 0; q < 6; ++q) {
            const int id = wave + 8 * q, Lk = id >> 4, tj = id & 3;
            if (q < 4 || l > 0) {
                const float* Wg = (Lk == 0 ? w2 : (Lk == 1 ? a2 : v2)) + (size_t)fq * RWW + h * HD + tj * 16 + fr;
#pragma unroll
                for (int kk = 0; kk < 8; ++kk) wg[q][kk] = Wg[(size_t)kk * 4 * RWW];
            }
        }
#pragma unroll
        for (int q = 0; q < 2; ++q) {
            const int item = tid + 512 * q, tt = item >> 4, g = item & 15, t = t0 + tt; const bool hp = t > 0;
            if (h == 0) {
#pragma unroll
                for (int e = 0; e < 8; ++e) {
                    const float xc = bf2f((bf16_t)L.cc[q][e]), xp = hp ? bf2f((bf16_t)L.cp[q][e]) : 0.f;
                    const float x_ = xc + (xp - xc) * mu[1152 + 8 * (g & 7) + e];
                    codes[q][e] = g < 4 ? 1.0f - 2.0f * __builtin_amdgcn_rcpf(1.0f + __builtin_amdgcn_exp2f(2.8853900817779268f * x_)) : (g < 8 ? x_ : xc + xp);
                }
            }
            if (g < 8 || (g < 12 && l > 0)) {
                float* dst = (g < 4 ? WD + tt * LS + 8 * g : (g < 8 ? AD + tt * LS + 8 * (g - 4) : VL + tt * LS + 8 * (g - 8)));
#pragma unroll
                for (int e = 0; e < 8; ++e) dst[e] = codes[q][e];
            }
        }
        __syncthreads();
#pragma unroll
        for (int q = 0; q < 6; ++q) {
            if (q < 4 || l > 0) {
                const int id = wave + 8 * q, Lk = id >> 4, ti = (id >> 2) & 3, tj = id & 3;
                const float* Xs = (Lk == 0 ? WD : (Lk == 1 ? AD : VL)) + (ti * 16 + fr) * LS + fq;
                f32x4 acc = (f32x4){0.f, 0.f, 0.f, 0.f};
#pragma unroll
                for (int kk = 0; kk < 8; ++kk) acc = __builtin_amdgcn_mfma_f32_16x16x4f32(Xs[kk * 4], wg[q][kk], acc, 0, 0, 0);
                float* out = (Lk == 0 ? WLT : (Lk == 1 ? ALT : VGT)) + (tj * 16 + fr) * XTS + ti * 16 + fq * 4;
#pragma unroll
                for (int r = 0; r < 4; ++r) out[r] = acc[r];
            }
        }
        __syncthreads();
        const int tt = tid >> 3, j0 = (tid & 7) * 8, t = t0 + tt, cj0 = h * HD + j0;
        const size_t row = (size_t)b * SEQ + t;
        float rr[8], kk_[8], vv[8], aa[8], bb[8], lw[8];
        {
            const bool hp = t > 0;
            float wl[8], al[8], vg[8];
#pragma unroll
            for (int e = 0; e < 8; ++e) {
                const float r_c = bf2f((bf16_t)L.rc[e]), k_c = bf2f((bf16_t)L.kc[e]), v_c = bf2f((bf16_t)L.vc[e]);
                const float r_p = hp ? bf2f((bf16_t)L.rp[e]) : 0.f, k_p = hp ? bf2f((bf16_t)L.kp[e]) : 0.f, v_p = hp ? bf2f((bf16_t)L.vp[e]) : 0.f;
                rr[e] = r_c + (r_p - r_c) * mu[cj0 + e]; kk_[e] = k_c + (k_p - k_c) * mu[384 + cj0 + e]; vv[e] = v_c + (v_p - v_c) * mu[768 + cj0 + e];
                wl[e] = w0[cj0 + e] + WLT[(j0 + e) * XTS + tt]; al[e] = a0[cj0 + e] + ALT[(j0 + e) * XTS + tt]; vg[e] = l > 0 ? v0[cj0 + e] + VGT[(j0 + e) * XTS + tt] : 0.f;
            }
            float ssq = 0.f, bon = 0.f;
#pragma unroll
            for (int e = 0; e < 8; ++e) {
                const float sp2 = fmaxf(-wl[e], 0.f) * 1.4426950408889634f + __builtin_amdgcn_logf(1.0f + __builtin_amdgcn_exp2f(-1.4426950408889634f * fabsf(wl[e])));
                lw[e] = -__builtin_amdgcn_exp2f(-sp2 - 0.7213475204444817f);
                const float alr = __builtin_amdgcn_rcpf(1.0f + __builtin_amdgcn_exp2f(-1.4426950408889634f * al[e]));
                if (l > 0) { const float vf = e < 4 ? L.vf0[e & 3] : L.vf1[e & 3]; vv[e] = vv[e] + (vf - vv[e]) * __builtin_amdgcn_rcpf(1.0f + __builtin_amdgcn_exp2f(-1.4426950408889634f * vg[e])); }
                const float kkr = kk_[e] * kks[cj0 + e];
                kk_[e] = kk_[e] * (1.0f + (alr - 1.0f) * ka[cj0 + e]);
                aa[e] = kkr; bb[e] = alr; ssq += kkr * kkr; bon += rr[e] * kk_[e] * rk[cj0 + e];
            }
            if (l == 0) { __builtin_nontemporal_store((f32x4){vv[0], vv[1], vv[2], vv[3]}, (f32x4*)(VF + row * RWW + cj0)); __builtin_nontemporal_store((f32x4){vv[4], vv[5], vv[6], vv[7]}, (f32x4*)(VF + row * RWW + cj0 + 4)); }
            ssq += __shfl_xor(ssq, 1); ssq += __shfl_xor(ssq, 2); ssq += __shfl_xor(ssq, 4);
            bon += __shfl_xor(bon, 1); bon += __shfl_xor(bon, 2); bon += __shfl_xor(bon, 4);
            const float inv = fminf(__builtin_amdgcn_rsqf(ssq), 1e12f);
            uint4 bvw; float bv[8];
#pragma unroll
            for (int e = 0; e < 8; ++e) { const float kn = aa[e] * inv; aa[e] = -kn; bb[e] = kn * bb[e]; bv[e] = bon * vv[e]; CS[tt * CSS + j0 + e] = lw[e]; }
            bvw.x = pk2(bv[0], bv[1]); bvw.y = pk2(bv[2], bv[3]); bvw.z = pk2(bv[4], bv[5]); bvw.w = pk2(bv[6], bv[7]);
            *(uint4*)((bf16_t*)(p.ws + WS_CH_BV) + (size_t)jb * 4096 + tt * 64 + j0) = bvw;
        }
        __syncthreads();
#pragma unroll
        for (int e = 0; e < 8; ++e) {
            const int j = wave * 8 + e; float x = CS[lane * CSS + j];
#pragma unroll
            for (int o = 1; o < 64; o <<= 1) { const float y = __shfl_up(x, o); if (lane >= o) x += y; }
            CS[lane * CSS + j] = x;
        }
        __syncthreads();
        {
            float at[8], rt[8], bt[8], kt[8];
#pragma unroll
            for (int e = 0; e < 8; ++e) {
                const int j = j0 + e; const float cs = CS[tt * CSS + j] * 1.4426950408889634f, csC = CS[63 * CSS + j] * 1.4426950408889634f, lw2 = lw[e] * 1.4426950408889634f;
                const float e_in = __builtin_amdgcn_exp2f(cs), e_ex = __builtin_amdgcn_exp2f(cs - lw2), e_ng = __builtin_amdgcn_exp2f(-cs), e_ht = __builtin_amdgcn_exp2f(csC - cs);
                at[e] = aa[e] * e_ex; rt[e] = rr[e] * e_in; bt[e] = bb[e] * e_ng; kt[e] = kk_[e] * e_ng;
                T_VT[j * TS + tt] = f2bf(vv[e]); T_bhT[j * TS + tt] = f2bf(bb[e] * e_ht); T_khT[j * TS + tt] = f2bf(kk_[e] * e_ht);
                XT[j * XTS + tt] = at[e];
                if (tt == 63) PCv[j] = __builtin_amdgcn_exp2f(csC);
            }
            uint4 w;
            w.x = pk2(at[0], at[1]); w.y = pk2(at[2], at[3]); w.z = pk2(at[4], at[5]); w.w = pk2(at[6], at[7]); *(uint4*)(T_At + tt * TS + j0) = w;
            w.x = pk2(rt[0], rt[1]); w.y = pk2(rt[2], rt[3]); w.z = pk2(rt[4], rt[5]); w.w = pk2(rt[6], rt[7]); *(uint4*)(T_Rt + tt * TS + j0) = w;
            w.x = pk2(bt[0], bt[1]); w.y = pk2(bt[2], bt[3]); w.z = pk2(bt[4], bt[5]); w.w = pk2(bt[6], bt[7]); *(uint4*)(T_Bt + tt * TS + j0) = w;
            w.x = pk2(kt[0], kt[1]); w.y = pk2(kt[2], kt[3]); w.z = pk2(kt[4], kt[5]); w.w = pk2(kt[6], kt[7]); *(uint4*)(T_Kt + tt * TS + j0) = w;
        }
        __syncthreads();
        { const int hn = h + 1 < NH ? h + 1 : 0, gn = h + 1 < NH ? gi : gi + G; if (gn < NGRP) b1_issue_loads(p, l, gn, hn, tid, L); }
        {
            const int mat = wave >> 1;
            const bf16_t* As = (mat == 0 || mat == 2) ? T_Bt : T_Kt; const bf16_t* Bs = (mat < 2) ? T_At : T_Rt;
            bf16_t* dstb = (mat == 1 ? T_Aak : (mat == 2 ? T_Arb : T_Ark));
#pragma unroll
            for (int q = 0; q < 8; ++q) {
                constexpr int TI0[8] = {0, 0, 0, 0, 3, 1, 2, 3}, TJ0[8] = {0, 1, 2, 3, 3, 0, 0, 0}, TI1[8] = {1, 1, 1, 2, 2, 2, 3, 3}, TJ1[8] = {1, 2, 3, 2, 3, 1, 1, 2};
                const int ti = (wave & 1) ? TI1[q] : TI0[q], tj = (wave & 1) ? TJ1[q] : TJ0[q];
                f32x4 acc = (f32x4){0.f, 0.f, 0.f, 0.f};
                if (ti <= tj) acc = mm_tile(As, ti * 16, Bs, tj * 16, 64, fr, fq, acc);
                const int tcol = tj * 16 + fr, i0 = ti * 16 + fq * 4;
                if (ti == tj) {
#pragma unroll
                    for (int r = 0; r < 4; ++r) { const bool keep = (mat < 2) ? (i0 + r < tcol) : (i0 + r <= tcol); if (!keep) acc[r] = 0.f; }
                }
                if (mat == 0) *(f32x4*)(Aab + tcol * AABS + i0) = acc;
                else *(uint2*)(dstb + tcol * TS + i0) = pk4(acc);
            }
        }
        __syncthreads();
        if (wave == 0) {
            const int blk = lane >> 4, cc = lane & 15; const float* ar = Aab + (16 * blk) * AABS + 16 * blk;
            float x[16];
#pragma unroll
            for (int u = 0; u < 16; ++u) { float v = (u == cc) ? 1.0f : 0.f;
#pragma unroll
                for (int i = 0; i < u; ++i) v += ar[u * AABS + i] * x[i];
                x[u] = v; }
#pragma unroll
            for (int u = 0; u < 16; ++u) TI[(blk * 16 + u) * 17 + cc] = x[u];
        } else {
#pragma unroll 1
            for (int id = wave - 1; id < 16; id += 7) {
                const int ti = id >> 2, tj = id & 3;
                f32x4 acc = mm_tile(T_Aak, ti * 16, T_VT, tj * 16, 64, fr, fq, (f32x4){0.f, 0.f, 0.f, 0.f});
                const int j = tj * 16 + fr, tr = ti * 16 + fq * 4;
#pragma unroll
                for (int r = 0; r < 4; ++r) XT[(64 + j) * XTS + tr + r] = acc[r];
            }
        }
        __syncthreads();
        {
            float* xc = XT + (wave * 16 + fr) * XTS;
#pragma unroll
            for (int I = 0; I < 4; ++I) {
                f32x4 acc;
#pragma unroll
                for (int r = 0; r < 4; ++r) acc[r] = xc[16 * I + 4 * fq + r];
#pragma unroll
                for (int J = 0; J < I; ++J)
#pragma unroll
                    for (int kk = 0; kk < 4; ++kk) acc = __builtin_amdgcn_mfma_f32_16x16x4f32(Aab[(16 * I + fr) * AABS + 16 * J + 4 * kk + fq], xc[16 * J + 4 * kk + fq], acc, 0, 0, 0);
#pragma unroll
                for (int r = 0; r < 4; ++r) xc[16 * I + 4 * fq + r] = acc[r];
                asm volatile("s_waitcnt lgkmcnt(0)" ::: "memory");
                f32x4 xs = (f32x4){0.f, 0.f, 0.f, 0.f};
#pragma unroll
                for (int kk = 0; kk < 4; ++kk) xs = __builtin_amdgcn_mfma_f32_16x16x4f32(TI[(I * 16 + fr) * 17 + 4 * kk + fq], xc[16 * I + 4 * kk + fq], xs, 0, 0, 0);
                asm volatile("s_waitcnt lgkmcnt(0)" ::: "memory");
#pragma unroll
                for (int r = 0; r < 4; ++r) xc[16 * I + 4 * fq + r] = xs[r];
                asm volatile("s_waitcnt lgkmcnt(0)" ::: "memory");
            }
        }
        __syncthreads();
        {
            const int col = tid >> 2, tg = (tid & 3) * 16;
            const float* xr = XT + col * XTS + tg; bf16_t* dst = (col < 64 ? T_WT + col * TS : T_U0T + (col - 64) * TS) + tg;
            uint4 w0_, w1_;
            w0_.x = pk2(xr[0], xr[1]); w0_.y = pk2(xr[2], xr[3]); w0_.z = pk2(xr[4], xr[5]); w0_.w = pk2(xr[6], xr[7]);
            w1_.x = pk2(xr[8], xr[9]); w1_.y = pk2(xr[10], xr[11]); w1_.z = pk2(xr[12], xr[13]); w1_.w = pk2(xr[14], xr[15]);
            *(uint4*)dst = w0_; *(uint4*)(dst + 8) = w1_;
        }
        __syncthreads();
        {
            bf16_t* gM = (bf16_t*)(p.ws + WS_CH_M) + (size_t)jb * 4096; bf16_t* gNT = (bf16_t*)(p.ws + WS_CH_NT) + (size_t)jb * 4096;
            bf16_t* gG = (bf16_t*)(p.ws + WS_CH_G) + (size_t)jb * 4096; bf16_t* gY1T = (bf16_t*)(p.ws + WS_CH_Y1T) + (size_t)jb * 4096;
            const int mat = wave >> 1;
            const bf16_t* A1 = (mat == 0 || mat == 2) ? T_WT : (mat == 1 ? T_U0T : T_bhT);
            const bf16_t* B1 = (mat == 0 || mat == 1) ? T_Arb : (mat == 2 ? T_bhT : T_U0T);
            const bf16_t* A2 = mat == 1 ? T_VT : T_khT; const bf16_t* B2 = mat == 1 ? T_Ark : T_VT;
            bf16_t* gdst = mat == 0 ? gG : (mat == 1 ? gY1T : (mat == 2 ? gM : gNT));
#pragma unroll
            for (int q = 0; q < 8; ++q) {
                const int ti = ((wave & 1) * 8 + q) >> 2, tj = q & 3;
                const int col = tj * 16 + fr, r0 = ti * 16 + fq * 4;
                f32x4 acc = mm_tile(A1, ti * 16, B1, tj * 16, 64, fr, fq, (f32x4){0.f, 0.f, 0.f, 0.f});
                if (mat & 1) acc = mm_tile(A2, ti * 16, B2, tj * 16, 64, fr, fq, acc);
                if (mat == 0) {
                    const uint2 rw = *(const uint2*)(T_Rt + col * TS + r0);
                    acc[0] += bf2f((bf16_t)(rw.x & 0xffff)); acc[1] += bf2f((bf16_t)(rw.x >> 16)); acc[2] += bf2f((bf16_t)(rw.y & 0xffff)); acc[3] += bf2f((bf16_t)(rw.y >> 16));
                } else if (mat == 2 && ti == tj) {
                    const float pc = PCv[col];
#pragma unroll
                    for (int r = 0; r < 4; ++r) if (r0 + r == col) acc[r] += pc;
                }
                *(uint2*)(gdst + col * 64 + r0) = pk4(acc);
            }
        }
        __syncthreads();
        if (h == NH - 1) gi += G;
    }
}

__device__ void rwkv_b2_job(const Params& p, int bh, unsigned char* lds) {
    const int tid = tid_(), lane = tid & 63, wave = __builtin_amdgcn_readfirstlane(tid >> 6), fr = lane & 15, fq = lane >> 4;
    const int mi = wave >> 1, nj0 = (wave & 1) * 2;
    const bf16_t* gM = (const bf16_t*)(p.ws + WS_CH_M); const bf16_t* gNT = (const bf16_t*)(p.ws + WS_CH_NT); bf16_t* gZT = (bf16_t*)(p.ws + WS_ZT);
    bf16_t* zbuf = (bf16_t*)lds;
    f32x4 z[2];
    z[0] = (f32x4){0.f, 0.f, 0.f, 0.f}; z[1] = z[0];
    const int c0 = mi * 16 + fq * 4;
    bf16x8 am[2]; uint2 nw[2];
    {
        const size_t jb = (size_t)bh * 32;
#pragma unroll
        for (int kk = 0; kk < 2; ++kk) am[kk] = *(const bf16x8*)(gM + jb * 4096 + (mi * 16 + fr) * 64 + kk * 32 + fq * 8);
#pragma unroll
        for (int q = 0; q < 2; ++q) nw[q] = *(const uint2*)(gNT + jb * 4096 + ((nj0 + q) * 16 + fr) * 64 + c0);
    }
#pragma unroll 1
    for (int c = 0; c < SEQ / 64; ++c) {
        const size_t jb = (size_t)bh * 32 + c;
        bf16_t* zh = zbuf + (c & 1) * 2 * 64 * TS; bf16_t* zl = zh + 64 * TS;
#pragma unroll
        for (int q = 0; q < 2; ++q) {
            const int j = (nj0 + q) * 16 + fr;
            const uint2 hi = pk4(z[q]);
            f32x4 lo;
            lo[0] = z[q][0] - bf2f((bf16_t)(hi.x & 0xffff)); lo[1] = z[q][1] - bf2f((bf16_t)(hi.x >> 16)); lo[2] = z[q][2] - bf2f((bf16_t)(hi.y & 0xffff)); lo[3] = z[q][3] - bf2f((bf16_t)(hi.y >> 16));
            *(uint2*)(zh + j * TS + c0) = hi; *(uint2*)(zl + j * TS + c0) = pk4(lo);
            *(uint2*)(gZT + jb * 4096 + j * 64 + c0) = hi;
        }
        bf16x8 amn[2]; uint2 nwn[2];
        {
            const size_t jn = (size_t)bh * 32 + (c + 1 < SEQ / 64 ? c + 1 : c);
#pragma unroll
            for (int kk = 0; kk < 2; ++kk) amn[kk] = *(const bf16x8*)(gM + jn * 4096 + (mi * 16 + fr) * 64 + kk * 32 + fq * 8);
#pragma unroll
            for (int q = 0; q < 2; ++q) nwn[q] = *(const uint2*)(gNT + jn * 4096 + ((nj0 + q) * 16 + fr) * 64 + c0);
        }
        __syncthreads();
#pragma unroll
        for (int q = 0; q < 2; ++q) {
            const int j = (nj0 + q) * 16 + fr;
            f32x4 acc; acc[0] = bf2f((bf16_t)(nw[q].x & 0xffff)); acc[1] = bf2f((bf16_t)(nw[q].x >> 16)); acc[2] = bf2f((bf16_t)(nw[q].y & 0xffff)); acc[3] = bf2f((bf16_t)(nw[q].y >> 16));
#pragma unroll
            for (int kk = 0; kk < 2; ++kk) {
                const bf16x8 bh_ = *(const bf16x8*)(zh + j * TS + kk * 32 + fq * 8), bl_ = *(const bf16x8*)(zl + j * TS + kk * 32 + fq * 8);
                acc = __builtin_amdgcn_mfma_f32_16x16x32_bf16(am[kk], bh_, acc, 0, 0, 0);
                acc = __builtin_amdgcn_mfma_f32_16x16x32_bf16(am[kk], bl_, acc, 0, 0, 0);
            }
            z[q] = acc;
        }
        am[0] = amn[0]; am[1] = amn[1]; nw[0] = nwn[0]; nw[1] = nwn[1];
    }
    __syncthreads();
}

struct B3Loads { bf16x8 bg[2], az[4][2]; uint2 yw[4], bw[4], gw[4]; };
__device__ __forceinline__ void b3_issue_loads(const Params& p, int pair, int wave, int fr, int fq, B3Loads& L) {
    const int jb = pair * 2 + (wave >> 2), mi = wave & 3, bh = jb >> 5, c = jb & 31, b = bh / NH, h = bh % NH;
    const bf16_t* gG = (const bf16_t*)(p.ws + WS_CH_G) + (size_t)jb * 4096; const bf16_t* gY1 = (const bf16_t*)(p.ws + WS_CH_Y1T) + (size_t)jb * 4096;
    const bf16_t* gBV = (const bf16_t*)(p.ws + WS_CH_BV) + (size_t)jb * 4096; const bf16_t* gZT = (const bf16_t*)(p.ws + WS_ZT) + (size_t)jb * 4096;
    const bf16_t* PG = (const bf16_t*)(p.ws + WS_PG);
    const int tt = mi * 16 + fr; const size_t row = (size_t)b * SEQ + c * 64 + tt;
#pragma unroll
    for (int kk = 0; kk < 2; ++kk) L.bg[kk] = __builtin_nontemporal_load((const bf16x8*)(gG + tt * 64 + kk * 32 + fq * 8));
#pragma unroll
    for (int nj = 0; nj < 4; ++nj) { const int j0 = nj * 16 + fq * 4;
        L.yw[nj] = ldnt_u2((const void*)(gY1 + tt * 64 + j0)); L.bw[nj] = ldnt_u2((const void*)(gBV + tt * 64 + j0)); L.gw[nj] = ldnt_u2((const void*)(PG + row * PG_W + h * HD + j0));
#pragma unroll
        for (int kk = 0; kk < 2; ++kk) L.az[nj][kk] = *(const bf16x8*)(gZT + (nj * 16 + fr) * 64 + kk * 32 + fq * 8); }
}
__device__ void rwkv_b3_phase(const Params& p, int l) {
    const int G = gridDim.x, NPAIR = BATCH * NH * 16;
    int pair = blockIdx.x;
    if (pair >= NPAIR) return;
    B3Loads L;
    { const int tid = tid_(), lane = tid & 63; b3_issue_loads(p, pair, __builtin_amdgcn_readfirstlane(tid >> 6), lane & 15, lane >> 4, L); }
#pragma unroll 1
    for (; pair < NPAIR; pair += G) {
        const int tid = tid_(), lane = tid & 63, wave = __builtin_amdgcn_readfirstlane(tid >> 6), fr = lane & 15, fq = lane >> 4;
        const int jb = pair * 2 + (wave >> 2), mi = wave & 3;
        const int bh = jb >> 5, c = jb & 31, b = bh / NH, h = bh % NH;
        bf16_t* MIX = (bf16_t*)(p.ws + WS_MIX);
        const float* gng = p.in[19] + l * RWW + h * HD; const float* gnb = p.in[20] + l * RWW + h * HD;
        const int tt = mi * 16 + fr; const size_t row = (size_t)b * SEQ + c * 64 + tt;
        f32x4 acc[4];
#pragma unroll
        for (int nj = 0; nj < 4; ++nj) {
            acc[nj][0] = bf2f((bf16_t)(L.yw[nj].x & 0xffff)); acc[nj][1] = bf2f((bf16_t)(L.yw[nj].x >> 16)); acc[nj][2] = bf2f((bf16_t)(L.yw[nj].y & 0xffff)); acc[nj][3] = bf2f((bf16_t)(L.yw[nj].y >> 16));
#pragma unroll
            for (int kk = 0; kk < 2; ++kk) acc[nj] = __builtin_amdgcn_mfma_f32_16x16x32_bf16(L.az[nj][kk], L.bg[kk], acc[nj], 0, 0, 0);
        }
        uint2 bw[4], gw[4];
#pragma unroll
        for (int nj = 0; nj < 4; ++nj) { bw[nj] = L.bw[nj]; gw[nj] = L.gw[nj]; }
        if (pair + G < NPAIR) b3_issue_loads(p, pair + G, wave, fr, fq, L);
        float s = 0.f;
#pragma unroll
        for (int nj = 0; nj < 4; ++nj) s += (acc[nj][0] + acc[nj][1]) + (acc[nj][2] + acc[nj][3]);
        s += __shfl_xor(s, 16); s += __shfl_xor(s, 32);
        const float mean = s * (1.0f / HD);
        float vs = 0.f;
#pragma unroll
        for (int nj = 0; nj < 4; ++nj) { acc[nj] = acc[nj] - mean; vs += (acc[nj][0] * acc[nj][0] + acc[nj][1] * acc[nj][1]) + (acc[nj][2] * acc[nj][2] + acc[nj][3] * acc[nj][3]); }
        vs += __shfl_xor(vs, 16); vs += __shfl_xor(vs, 32);
        const float rstd = rsqrtf(vs * (1.0f / HD) + GN_EPS);
#pragma unroll
        for (int nj = 0; nj < 4; ++nj) {
            const int j0 = nj * 16 + fq * 4;
            const f32x4 gg = *(const f32x4*)(gng + j0), gb = *(const f32x4*)(gnb + j0);
            const float bv0 = bf2f((bf16_t)(bw[nj].x & 0xffff)), bv1 = bf2f((bf16_t)(bw[nj].x >> 16)), bv2 = bf2f((bf16_t)(bw[nj].y & 0xffff)), bv3 = bf2f((bf16_t)(bw[nj].y >> 16));
            const float g0 = bf2f((bf16_t)(gw[nj].x & 0xffff)), g1 = bf2f((bf16_t)(gw[nj].x >> 16)), g2 = bf2f((bf16_t)(gw[nj].y & 0xffff)), g3 = bf2f((bf16_t)(gw[nj].y >> 16));
            const float o0 = acc[nj][0] * rstd * gg[0] + gb[0] + bv0, o1 = acc[nj][1] * rstd * gg[1] + gb[1] + bv1, o2 = acc[nj][2] * rstd * gg[2] + gb[2] + bv2, o3 = acc[nj][3] * rstd * gg[3] + gb[3] + bv3;
            uint2 w; w.x = pk2(o0 * siluf_(g0), o1 * siluf_(g1)); w.y = pk2(o2 * siluf_(g2), o3 * siluf_(g3));
            *(uint2*)(MIX + row * DM + CW + SBW + h * HD + j0) = w;
        }
    }
}

constexpr int N_ATT_JOBS = BATCH * NH * 8, N_CONV_JOBS = BATCH * (SEQ / 64), N_CHAINS = BATCH * NH;
__device__ __forceinline__ void run_side_job(const Params& p, int l, int id, unsigned char* lds) {
    if (id < N_ATT_JOBS) attn_wg_job(p, id, lds); else conv_job64(p, l, id - N_ATT_JOBS, lds);
}
__device__ void phase_mix1(const Params& p, int l, unsigned char* lds) {
    rwkv_b1_phase(p, l, lds);
    if (!defer_layer1_weights()) for (int id = blockIdx.x; id < N_ATT_JOBS + N_CONV_JOBS; id += gridDim.x) run_side_job(p, l, id, lds);
}
__device__ void phase_mix2(const Params& p, int l, unsigned char* lds) {
    const int G = gridDim.x, w = blockIdx.x, NJ = N_ATT_JOBS + N_CONV_JOBS;
    if (!defer_layer1_weights()) { for (int job = w; job < N_CHAINS; job += G) rwkv_b2_job(p, job, lds); return; }
    const bool prep = l + 1 < DEPTH;
    const int nlow = prep ? 5 : 4;
    if (w < N_CHAINS) {
        rwkv_b2_job(p, w, lds);
        for (int s_ = 0; s_ < nlow; ++s_) { const int id = s_ * N_CHAINS + w; if (id < NJ) run_side_job(p, l, id, lds); }
    } else {
        if (prep) prep_weights(p, l + 1, lds, w - N_CHAINS, G - N_CHAINS);
        for (int id = nlow * N_CHAINS + (w - N_CHAINS); id < NJ; id += G - N_CHAINS) run_side_job(p, l, id, lds);
    }
}
__device__ void phase_mix3(const Params& p, int l, unsigned char* lds) {
    rwkv_b3_phase(p, l);
}

#define LAS __attribute__((address_space(3)))
#define XB_TMO      128
#define XB_XCNT(j)  (256  + 64 * (j))
#define XB_XSUB(j)  (1280 + 64 * (j))
#define XB_XGEN(j)  (2304 + 64 * (j))
#define XB_TOP      3328
#define XB_TOPGEN   3392
#define XCD_BAR_WORDS 3456
#define XB_SPIN_CAP (1u << 18)

__device__ __forceinline__ unsigned xb_ld(unsigned* p)              { return __hip_atomic_load(p, __ATOMIC_RELAXED, __HIP_MEMORY_SCOPE_AGENT); }
__device__ __forceinline__ unsigned xb_add(unsigned* p, unsigned v) { return __hip_atomic_fetch_add(p, v, __ATOMIC_RELAXED, __HIP_MEMORY_SCOPE_AGENT); }
__device__ __forceinline__ unsigned xb_xcc_id() { return (unsigned)__builtin_amdgcn_s_getreg((3 << 11) | 20) & 0xFu; }
#define XB_SPIN(cond, bar) do { unsigned _sp = 0; while (cond) { __builtin_amdgcn_s_sleep(1); \
    if ((++_sp & 255u) == 0u) { if (xb_ld(&(bar)[XB_TMO])) break; if (_sp > XB_SPIN_CAP) { atomicAdd(&(bar)[XB_TMO], 1u); break; } } } } while (0)

struct XcdBarrier {
    unsigned* bar; unsigned x;
    volatile LAS unsigned* st;
};

__device__ __forceinline__ XcdBarrier xcd_barrier_post(unsigned* bar, volatile LAS unsigned* st) {
    XcdBarrier b; b.bar = bar; b.x = xb_xcc_id(); b.st = st;
    if (threadIdx.x == 0) (void)xb_add(&bar[XB_XCNT(b.x)], 1u);
    return b;
}
__device__ __forceinline__ void xcd_barrier_complete(unsigned* bar, unsigned x, unsigned& nloc, unsigned& nx) {
    const unsigned G = gridDim.x * gridDim.y * gridDim.z;
    unsigned sum, cnt, mine, sp = 0u;
    for (;;) {
        sum = 0u; cnt = 0u; mine = 0u;
#pragma unroll
        for (unsigned j = 0; j < 16; ++j) { const unsigned c = xb_ld(&bar[XB_XCNT(j)]); sum += c; cnt += (c > 0u) ? 1u : 0u; mine = (j == x) ? c : mine; }
        if (sum == G) break;
        __builtin_amdgcn_s_sleep(1);
        if ((++sp & 255u) == 0u) { if (xb_ld(&bar[XB_TMO])) break; if (sp > XB_SPIN_CAP) { atomicAdd(&bar[XB_TMO], 1u); break; } }
    }
    nloc = mine > 0u ? mine : 1u; nx = cnt > 0u ? cnt : 1u;
}

__device__ __forceinline__ void xcd_barrier(const XcdBarrier& b) {
    asm volatile("s_waitcnt vmcnt(0)" ::: "memory");
    __syncthreads();
    if (threadIdx.x == 0) {
        unsigned* bar = b.bar;
        __builtin_amdgcn_s_waitcnt(0);
        unsigned nloc = b.st[0], nx = b.st[1];
        if (nloc == 0u) { xcd_barrier_complete(bar, b.x, nloc, nx); b.st[0] = nloc; b.st[1] = nx; }
        const unsigned old = xb_add(&bar[XB_XSUB(b.x)], 1u);
        const unsigned gen = old / nloc;
        if (old + 1u == (gen + 1u) * nloc) {
            __builtin_amdgcn_fence(__ATOMIC_RELEASE, "agent");
            asm volatile("s_waitcnt vmcnt(0)" ::: "memory");
            const unsigned og = xb_add(&bar[XB_TOP], 1u);
            const unsigned tg = og / nx;
            if (og + 1u == (tg + 1u) * nx) xb_add(&bar[XB_TOPGEN], 1u);
            else XB_SPIN(xb_ld(&bar[XB_TOPGEN]) == tg, bar);
            __builtin_amdgcn_fence(__ATOMIC_ACQUIRE, "agent");
            xb_add(&bar[XB_XGEN(b.x)], 1u);
            asm volatile("s_waitcnt vmcnt(0)" ::: "memory");
        } else {
            XB_SPIN(xb_ld(&bar[XB_XGEN(b.x)]) == gen, bar);
            __builtin_amdgcn_fence(__ATOMIC_ACQUIRE, "agent");
            asm volatile("s_waitcnt vmcnt(0)" ::: "memory");
        }
    }
    __syncthreads();
}

constexpr int PH_PER_LAYER = 6;
constexpr int N_PHASES = 1 + PH_PER_LAYER * DEPTH;
__device__ __forceinline__ void run_phase(const Params& p, int ph, unsigned char* lds) {
    unsigned char* ws = p.ws;
    if (ph == 0) { phase_prologue(p, lds); return; }
    const int l = (ph - 1) / PH_PER_LAYER, k = (ph - 1) % PH_PER_LAYER;
    if (k == 0) {
        EpiInProjP E{(bf16_t*)(ws + WS_PC), (bf16_t*)(ws + WS_PS), (bf16_t*)(ws + WS_PR), (bf16_t*)(ws + WS_PG), (bf16_t*)(ws + WS_VT)};
        pg8::Gemm g{(const bf16_t*)(ws + WS_XB), (const bf16_t*)(ws + WS_WIN) + (size_t)l * NINT * DM, M, NINT, DM}; pg8::StaticOrder S; S.init(M, NINT, (int)gridDim.x, (int)blockIdx.x);
        pg8::gemm_phase<EpiInProjP, pg8::StaticOrder, true, true>((PG8_LAS unsigned char*)lds, g, S, E);
    } else if (k == 1) {
        phase_mix1(p, l, lds);
    } else if (k == 2) {
        phase_mix2(p, l, lds);
    } else if (k == 3) {
        phase_mix3(p, l, lds);
    } else if (k == 4) {
        EpiOutBf16P E{(bf16_t*)(ws + WS_Y), DM};
        pg8::Gemm g{(const bf16_t*)(ws + WS_MIX), (const bf16_t*)(ws + WS_WOUT) + (size_t)l * DM * DM, M, DM, DM}; pg8::StaticOrder S; S.init(M, DM, (int)gridDim.x, (int)blockIdx.x);
        pg8::gemm_phase<EpiOutBf16P, pg8::StaticOrder, true, true>((PG8_LAS unsigned char*)lds, g, S, E);
    } else {
        phase_rowpass(l == 0 ? p.in[0] : p.out, (const bf16_t*)(ws + WS_Y), p.in[2] + l * DM, p.out, l + 1 < DEPTH ? (bf16_t*)(ws + WS_XB) : nullptr);
    }
}

static_assert(10 * TILE_B + 64 * AABS * 4 + 128 * XTS * 4 + 64 * 4 + 4 * 16 * 17 * 4 <= 147456, "B1 LDS map");
constexpr int LDS_BYTES = 147456 + 256;

constexpr int MISC_OFF = 147456;
#if MK_COOP == 2
__global__ void __launch_bounds__(512, 2) fwd_kernel(Params p) {
    extern __shared__ __attribute__((aligned(16))) unsigned char lds[];
    volatile LAS unsigned* misc = (volatile LAS unsigned*)((LAS unsigned char*)lds + MISC_OFF);
    if (threadIdx.x < 16) misc[threadIdx.x] = 0u;
    __syncthreads();
    XcdBarrier bar = xcd_barrier_post((unsigned*)(p.ws + WS_CTL), misc);
    for (int ph = p.ph_lo; ph < p.ph_hi; ++ph) {
        run_phase(p, ph, lds);
        if (ph + 1 < p.ph_hi) xcd_barrier(bar);
    }
}
#elif MK_COOP == 1
__global__ void __launch_bounds__(512, 2) fwd_kernel(Params p) {
    extern __shared__ __attribute__((aligned(16))) unsigned char lds[];
    cg::grid_group grid = cg::this_grid();
    for (int ph = p.ph_lo; ph < p.ph_hi; ++ph) {
        run_phase(p, ph, lds);
        if (ph + 1 < p.ph_hi) grid.sync();
    }
}
#else
__global__ void __launch_bounds__(512, 2) fwd_kernel(Params p) {
    extern __shared__ __attribute__((aligned(16))) unsigned char lds[];
    for (int ph = p.ph_lo; ph < p.ph_hi; ++ph) run_phase(p, ph, lds);
}
#endif

extern "C" void kernel_launch(void* const* d_in, const int* in_sizes, int n_in, void* d_out, int out_size, void* d_ws, size_t ws_size, hipStream_t stream) {
    static int grid = 0;
    if (grid == 0) {
        if (n_in != 24 || out_size != M * DM || ws_size < WS_END) { fprintf(stderr, "kernel_launch: unexpected problem (n_in %d out %d ws %zu)\n", n_in, out_size, ws_size); grid = -1; return; }
        int dev = 0, cus = 0, per_cu = 0;
        hipGetDevice(&dev); hipDeviceGetAttribute(&cus, hipDeviceAttributeMultiprocessorCount, dev);
        hipFuncSetAttribute((const void*)fwd_kernel, hipFuncAttributeMaxDynamicSharedMemorySize, LDS_BYTES);
        hipOccupancyMaxActiveBlocksPerMultiprocessor(&per_cu, (const void*)fwd_kernel, 512, LDS_BYTES);
        if (per_cu < 1) { fprintf(stderr, "kernel_launch: occupancy query says %d blocks per CU\n", per_cu); per_cu = 1; }
        grid = cus;
        (void)hipGetLastError();
    }
    if (grid < 0) return;
    Params p{};
    for (int i = 0; i < 24; ++i) p.in[i] = (const float*)d_in[i];
    p.out = (float*)d_out; p.ws = (unsigned char*)d_ws;
#if MK_COOP == 2
    p.ph_lo = 0; p.ph_hi = N_PHASES;
    if (hipMemsetAsync((char*)d_ws + WS_CTL, 0, XCD_BAR_WORDS * 4, stream) != hipSuccess) { fprintf(stderr, "kernel_launch: memset of the barrier words failed\n"); return; }
    hipLaunchKernelGGL(fwd_kernel, dim3(grid), dim3(512), LDS_BYTES, stream, p);
#elif MK_COOP == 1
    p.ph_lo = 0; p.ph_hi = N_PHASES;
    void* args[] = {&p};
    hipError_t e = hipLaunchCooperativeKernel((const void*)fwd_kernel, dim3(grid), dim3(512), args, LDS_BYTES, stream);
    if (e != hipSuccess) fprintf(stderr, "cooperative launch failed: %s (grid %d)\n", hipGetErrorString(e), grid);
#else
    for (int ph = 0; ph < N_PHASES; ++ph) {
        p.ph_lo = ph; p.ph_hi = ph + 1;
        hipLaunchKernelGGL(fwd_kernel, dim3(grid), dim3(512), LDS_BYTES, stream, p);
    }
#endif
}
```

```cpp
#include <hip/hip_runtime.h>
#include <hip/hip_cooperative_groups.h>
#include <cstdio>
#include <cstdint>
namespace cg = cooperative_groups;

#ifndef MK_COOP
#define MK_COOP 2
#endif

constexpr int BATCH = 16, SEQ = 2048, DM = 1024, DEPTH = 2;
constexpr int M = BATCH * SEQ;
constexpr int HD = 64, NH = 6;
constexpr int CW = 256, SBW = 384, RWW = 384, LORA = 32, TAPS = 31;
constexpr int DIN = 3904;
constexpr int NINT = 4096;
constexpr int PC_W = 768, PS_W = 1152, PR_W = 1280, PG_W = 384;
constexpr float RMS_EPS = 1e-6f, LN_EPS = 1e-5f, GN_EPS = 64e-5f;

typedef unsigned short bf16_t;
typedef short bf16x8 __attribute__((ext_vector_type(8)));
typedef float f32x4 __attribute__((ext_vector_type(4)));
typedef unsigned short us4 __attribute__((ext_vector_type(4)));

constexpr size_t MiB = 1u << 20;
constexpr size_t WS_CTL = 0;
constexpr size_t WS_WPW = 512 * 1024;
constexpr size_t WS_WIN = 1 * MiB;
constexpr size_t WS_WOUT = 17 * MiB;
constexpr size_t WS_XB = 21 * MiB;
constexpr size_t WS_MIX = WS_XB;
constexpr size_t WS_PC = 85 * MiB;
constexpr size_t WS_PS = 133 * MiB;
constexpr size_t WS_VT = 205 * MiB;
constexpr size_t WS_Y = WS_PC;
constexpr size_t WS_PR = 229 * MiB;
constexpr size_t WS_PG = 309 * MiB;
constexpr size_t WS_VF = 333 * MiB;
constexpr size_t WS_CH = 381 * MiB;
constexpr size_t CH_SZ = (size_t)3072 * 4096 * 2;
constexpr size_t WS_CH_M = WS_CH, WS_CH_NT = WS_CH + CH_SZ, WS_CH_G = WS_CH + 2 * CH_SZ, WS_CH_Y1T = WS_CH + 3 * CH_SZ, WS_CH_BV = WS_CH + 4 * CH_SZ;
constexpr size_t WS_ZT = WS_PR;
constexpr size_t WS_END = 501 * MiB;

struct Params {
    const float* in[24];
    float* out;
    unsigned char* ws;
    int ph_lo, ph_hi;
};

__device__ __forceinline__ float bf2f(bf16_t v) { return __uint_as_float(((unsigned)v) << 16); }
typedef float f32x2_t __attribute__((ext_vector_type(2)));
typedef __bf16 bf16x2_t __attribute__((ext_vector_type(2)));
__device__ __forceinline__ unsigned pk2(float lo, float hi) { f32x2_t v = {lo, hi}; bf16x2_t b = __builtin_convertvector(v, bf16x2_t); return __builtin_bit_cast(unsigned, b); }
__device__ __forceinline__ bf16_t f2bf(float f) { return (bf16_t)(pk2(f, f) & 0xffffu); }
__device__ __forceinline__ float wave_sum(float v) {
#pragma unroll
    for (int o = 1; o < 64; o <<= 1) v += __shfl_xor(v, o);
    return v;
}
__device__ __forceinline__ float sigmoidf_(float x) { return __builtin_amdgcn_rcpf(1.0f + __builtin_amdgcn_exp2f(-1.4426950408889634f * x)); }
__device__ __forceinline__ float siluf_(float x) { return x * __builtin_amdgcn_rcpf(1.0f + __builtin_amdgcn_exp2f(-1.4426950408889634f * x)); }
__device__ __forceinline__ int tid_() { int t = threadIdx.x; asm volatile("" : "+v"(t)); return t; }
typedef unsigned u32x2_t __attribute__((ext_vector_type(2)));
__device__ __forceinline__ uint2 ldnt_u2(const void* p) { const u32x2_t v = __builtin_nontemporal_load((const u32x2_t*)p); uint2 r; r.x = v[0]; r.y = v[1]; return r; }

__device__ __forceinline__ int orig_col(int n) { return n < 3520 ? n : (n < 3584 ? -1 : (n < 3968 ? n - 64 : -1)); }

__device__ void transpose_tile(const float* W, int ldw, int ncol_src, const float* gain, bf16_t* WT, int K, int n0, int k0, bool permute, float* tile  , bool skip_fold_rows = false) {
    const int tid = tid_();
#pragma unroll
    for (int i = 0; i < 8; ++i) {
        const int kl = (tid >> 6) + 8 * i, nl = tid & 63;
        const int n = n0 + nl, k = k0 + kl;
        const int oc = permute ? orig_col(n) : n;
        float v = 0.f;
        if (oc >= 0 && oc < ncol_src) v = W[(size_t)k * ldw + oc] * (gain ? gain[k] : 1.0f);
        if (permute && n >= 768 && n < 1152) v *= 0.125f * 1.4426950408889634f;
        tile[kl * 65 + nl] = v;
    }
    __syncthreads();
#pragma unroll
    for (int i = 0; i < 8; ++i) {
        const int nl = (tid >> 6) + 8 * i, kl = tid & 63;
        if (!(skip_fold_rows && n0 + nl >= 3520 && n0 + nl < 3584)) WT[(size_t)(n0 + nl) * K + k0 + kl] = f2bf(tile[kl * 65 + nl]);
    }
    __syncthreads();
}
__device__ void fold_v1_rows(const Params& p, int l, bf16_t* WinT_l, float* scr, int worker, int nworkers) {
    const int tid = tid_(), lane = tid & 63, wave = __builtin_amdgcn_readfirstlane(tid >> 6);
    const float* W = p.in[3] + (size_t)l * DM * DIN; const float* gain = p.in[1] + l * DM; const float* v1 = p.in[22] + (size_t)(l - 1) * RWW * LORA; const float* muv = p.in[11] + l * 1216 + 768;
    float* V1c = scr;
    float* Wr = scr + RWW * 64 + wave * RWW;
    for (int idx = tid; idx < RWW * 64; idx += 512) { const int c = idx >> 6, o = idx & 63; const float m = muv[c]; V1c[idx] = (o >= 32 ? m : 1.0f - m) * v1[c * LORA + (o & 31)]; }
    __syncthreads();
    for (int k = worker * 8 + wave; k < DM; k += nworkers * 8) {
        const float* wr = W + (size_t)k * DIN + 3072;
#pragma unroll
        for (int i = 0; i < 6; ++i) Wr[lane + 64 * i] = wr[lane + 64 * i];
        asm volatile("s_waitcnt lgkmcnt(0)" ::: "memory");
        float a0 = 0.f, a1 = 0.f, a2 = 0.f, a3 = 0.f;
#pragma unroll 4
        for (int c4 = 0; c4 < RWW / 4; ++c4) { const f32x4 w = *(const f32x4*)(Wr + 4 * c4);
            a0 += w[0] * V1c[(4 * c4) * 64 + lane]; a1 += w[1] * V1c[(4 * c4 + 1) * 64 + lane]; a2 += w[2] * V1c[(4 * c4 + 2) * 64 + lane]; a3 += w[3] * V1c[(4 * c4 + 3) * 64 + lane]; }
        WinT_l[(size_t)(3520 + lane) * DM + k] = f2bf(((a0 + a1) + (a2 + a3)) * gain[k]);
        asm volatile("s_waitcnt lgkmcnt(0)" ::: "memory");
    }
    __syncthreads();
}
__device__ void prep_weights(const Params& p, int l, unsigned char* lds, int worker, int nworkers) {
    float* tile = (float*)lds;
    bf16_t* WinT = (bf16_t*)(p.ws + WS_WIN) + (size_t)l * NINT * DM; bf16_t* WoutT = (bf16_t*)(p.ws + WS_WOUT) + (size_t)l * DM * DM; bf16_t* WpwT = (bf16_t*)(p.ws + WS_WPW) + (size_t)l * CW * CW;
    const int nt_in = (NINT / 64) * (DM / 64), nt_out = (DM / 64) * (DM / 64), nt_pw = (CW / 64) * (CW / 64);
    for (int j = worker; j < nt_in + nt_out + nt_pw; j += nworkers) {
        if (j < nt_in) transpose_tile(p.in[3] + (size_t)l * DM * DIN, DIN, DIN, p.in[1] + l * DM, WinT, DM, (j / (DM / 64)) * 64, (j % (DM / 64)) * 64, true, tile, l > 0);
        else if (j < nt_in + nt_out) { const int r = j - nt_in; transpose_tile(p.in[4] + (size_t)l * DM * DM, DM, DM, nullptr, WoutT, DM, (r / (DM / 64)) * 64, (r % (DM / 64)) * 64, false, tile); }
        else { const int r = j - nt_in - nt_out; transpose_tile(p.in[9] + (size_t)l * CW * CW, CW, CW, nullptr, WpwT, CW, (r >> 2) * 64, (r & 3) * 64, false, tile); }
    }
    if (l > 0) fold_v1_rows(p, l, WinT, tile, worker, nworkers);
}

__device__ void rows_to_xb(const float* X, bf16_t* XB) {
    const int tid = tid_(), lane = tid & 63, wave = __builtin_amdgcn_readfirstlane(tid >> 6);
    for (int row = blockIdx.x * 8 + wave; row < M; row += gridDim.x * 8) {
        const float* xr = X + (size_t)row * DM;
        f32x4 v[4]; float ss = 0.f;
#pragma unroll
        for (int i = 0; i < 4; ++i) { v[i] = __builtin_nontemporal_load((const f32x4*)(xr + i * 256 + lane * 4)); ss += v[i][0] * v[i][0] + v[i][1] * v[i][1] + v[i][2] * v[i][2] + v[i][3] * v[i][3]; }
        ss = wave_sum(ss);
        const float rstd = rsqrtf(ss * (1.0f / DM) + RMS_EPS);
#pragma unroll
        for (int i = 0; i < 4; ++i) { uint2 w; w.x = pk2(v[i][0] * rstd, v[i][1] * rstd); w.y = pk2(v[i][2] * rstd, v[i][3] * rstd); *(uint2*)(XB + (size_t)row * DM + i * 256 + lane * 4) = w; }
    }
}

__device__ __forceinline__ bool defer_layer1_weights() { return gridDim.x >= BATCH * NH + 32; }
__device__ void phase_prologue(const Params& p, unsigned char* lds) {
    prep_weights(p, 0, lds, blockIdx.x, gridDim.x);
    if (!defer_layer1_weights()) for (int l = 1; l < DEPTH; ++l) prep_weights(p, l, lds, blockIdx.x, gridDim.x);
    rows_to_xb(p.in[0], (bf16_t*)(p.ws + WS_XB));
}

namespace pg8 {
#define PG8_LAS __attribute__((address_space(3)))
typedef unsigned short bf16_t;
typedef short bf16x8 __attribute__((ext_vector_type(8)));
typedef float f32x4 __attribute__((ext_vector_type(4)));
typedef unsigned u32x4 __attribute__((ext_vector_type(4)));
constexpr int BM = 256, BK = 64, HALF = 128, HTB = HALF * BK * 2  , STAGE_BYTES = 8 * HTB, NXCD = 8, WGM = 8;

__host__ __device__ __forceinline__ int lds_byte(int r, int c) { const int st = (r >> 4) * 2 + (c >> 5), rr = r & 15, cc = c & 31, ob = rr * 64 + cc * 2; return st * 1024 + (ob ^ (((ob >> 9) & 1) << 5)); }
__host__ __device__ __forceinline__ void stage_rc(int b, int& R, int& C) { const int st = b / 1024, sb = b % 1024, swz = sb ^ (((sb >> 9) & 1) << 5); R = (st >> 1) * 16 + swz / 64; C = (st & 1) * 32 + (swz % 64) / 2; }
__host__ __device__ __forceinline__ int perm32(int rho) { const int n = rho >> 4, i = rho & 15; return 8 * (i >> 2) + 4 * n + (i & 3); }

struct Unit { int pm, pn; };
struct Gemm { const bf16_t* A; const bf16_t* Bt; int M, N, K; };

struct StaticOrder {
    int nM, nN, nwg, G, c;
    __host__ __device__ void init(int M, int N, int G_, int c_) { nM = M / BM; nN = N / BM; nwg = nM * nN; G = G_; c = c_; }
    __host__ __device__ bool next(int i, Unit& u) const {
        const long L = (long)i * G + c; if (L >= nwg) return false;
        int wgid = (int)L; { const int q = nwg / NXCD, r = nwg % NXCD, xcd = wgid % NXCD, off = wgid / NXCD; wgid = (xcd < r ? xcd * (q + 1) : r * (q + 1) + (xcd - r) * q) + off; }
        const int nig = WGM * nN, gid = wgid / nig, fm = gid * WGM, gsz = (nM - fm) < WGM ? (nM - fm) : WGM;
        u.pm = fm + ((wgid % nig) % gsz); u.pn = (wgid % nig) / gsz; return true;
    }
    __device__ __forceinline__ void a_ready(const Unit&) const {}
    __device__ __forceinline__ void done(const Unit&) const {}
};


__device__ __forceinline__ unsigned cvt_pk_bf16(float lo, float hi) { unsigned r; asm volatile("v_cvt_pk_bf16_f32 %0, %1, %2" : "=v"(r) : "v"(lo), "v"(hi)); return r; }

template <class Epi, class Sched, bool ALIGN_EPI = false, bool SP2 = false>
__device__ __forceinline__ void gemm_phase(PG8_LAS unsigned char* lds, const Gemm g, const Sched& S, const Epi& E) {
    const int tid = tid_(), wid = __builtin_amdgcn_readfirstlane(tid >> 6), lane = tid & 63, wr = wid >> 2, wc = wid & 3, fr = lane & 15, fq = lane >> 4;
    const int K = g.K, nt = K / BK;
    unsigned voffA[2], voffB[2];
#pragma unroll
    for (int i = 0; i < 2; ++i) { int R, C; stage_rc(tid * 16 + i * 8192, R, C); const int Rb = Epi::PERM ? ((R & ~31) + perm32(R & 31)) : R;
        voffA[i] = (unsigned)(R * K + C) * 2u; voffB[i] = (unsigned)(Rb * K + C) * 2u; }
    const size_t kstep = (size_t)(BK * 2);
    const size_t hstep = (size_t)HALF * K * 2;
    const size_t tstep = 2 * hstep;
    const unsigned ldsw = (unsigned)wid * 1024u;
    const int aoff = lds_byte(wr * 64 + fr, fq * 8), boff = lds_byte(wc * 32 + fr, fq * 8);
#define PG8_SA(b, h) (((b) * 2 + (h)) * HTB)
#define PG8_SB(b, h) ((4 + (b) * 2 + (h)) * HTB)
#define PG8_STAGE(bufoff, gbase, voff) do { _Pragma("unroll") for (int _i = 0; _i < 2; ++_i) \
        __builtin_amdgcn_global_load_lds((const unsigned*)((const char*)(gbase) + (voff)[_i]), (PG8_LAS unsigned*)(lds + (bufoff) + ldsw + _i * 8192), 16, 0, 0); } while (0)
#define PG8_LDA(dst, b, h) do { _Pragma("unroll") for (int m = 0; m < 4; ++m) _Pragma("unroll") for (int k = 0; k < 2; ++k) dst[m][k] = *(const PG8_LAS bf16x8*)(lds + PG8_SA(b, h) + aoff + m * 2048 + k * 1024); } while (0)
#define PG8_LDB(dst, b, h) do { _Pragma("unroll") for (int n = 0; n < 2; ++n) _Pragma("unroll") for (int k = 0; k < 2; ++k) dst[n][k] = *(const PG8_LAS bf16x8*)(lds + PG8_SB(b, h) + boff + n * 2048 + k * 1024); } while (0)
#define PG8_MMA(ai, bj, At, Bt) do { __builtin_amdgcn_s_setprio(1); _Pragma("unroll") for (int m = 0; m < 4; ++m) _Pragma("unroll") for (int n = 0; n < 2; ++n) _Pragma("unroll") for (int k = 0; k < 2; ++k) \
        acc[ai][bj][m][n] = __builtin_amdgcn_mfma_f32_16x16x32_bf16(Bt[n][k], At[m][k], acc[ai][bj][m][n], 0, 0, 0); __builtin_amdgcn_s_setprio(0); } while (0)
#define PG8_WAIT_V(n) asm volatile("s_waitcnt vmcnt(" #n ")" ::: "memory")
#define PG8_WAIT_L(n) asm volatile("s_waitcnt lgkmcnt(" #n ")" ::: "memory")
#define PG8_BAR __builtin_amdgcn_s_barrier()
#define PG8_SCHED __builtin_amdgcn_sched_barrier(0)
    Unit cur, nxt; int ui = 0;
    if (!S.next(0, cur)) return;
    f32x4 acc[2][2][4][2];
#pragma unroll
    for (int a = 0; a < 2; ++a)
#pragma unroll
        for (int b = 0; b < 2; ++b)
#pragma unroll
            for (int m = 0; m < 4; ++m)
#pragma unroll
                for (int n = 0; n < 2; ++n) acc[a][b][m][n] = (f32x4){0.f, 0.f, 0.f, 0.f};
    bf16x8 At[4][2], B0[2][2], B1[2][2];
    const char* cA = (const char*)g.A + (size_t)cur.pm * tstep; const char* cB = (const char*)g.Bt + (size_t)cur.pn * tstep;
    S.a_ready(cur);
    if constexpr (SP2) {
        PG8_STAGE(PG8_SB(0, 0), cB, voffB); PG8_STAGE(PG8_SB(0, 1), cB + hstep, voffB); PG8_STAGE(PG8_SA(0, 0), cA, voffA); PG8_STAGE(PG8_SA(0, 1), cA + hstep, voffA);
        if (wr == 1) PG8_BAR;
        PG8_WAIT_V(2); PG8_BAR;
        PG8_STAGE(PG8_SB(1, 0), cB + kstep, voffB); PG8_STAGE(PG8_SA(1, 0), cA + kstep, voffA); PG8_STAGE(PG8_SB(1, 1), cB + hstep + kstep, voffB);
        PG8_WAIT_V(6); PG8_BAR;
    } else {
        PG8_STAGE(PG8_SB(0, 0), cB, voffB); PG8_STAGE(PG8_SA(0, 0), cA, voffA); PG8_STAGE(PG8_SB(0, 1), cB + hstep, voffB); PG8_STAGE(PG8_SA(0, 1), cA + hstep, voffA);
        if (wr == 1) PG8_BAR;
        PG8_WAIT_V(4); PG8_BAR;
        PG8_STAGE(PG8_SB(1, 0), cB + kstep, voffB); PG8_STAGE(PG8_SA(1, 0), cA + kstep, voffA); PG8_STAGE(PG8_SB(1, 1), cB + hstep + kstep, voffB);
        PG8_WAIT_V(6); PG8_BAR;
    }
    for (;;) {
        const bool has_next = S.next(ui + 1, nxt);
        const char* nA = has_next ? (const char*)g.A + (size_t)nxt.pm * tstep : cA; const char* nB = has_next ? (const char*)g.Bt + (size_t)nxt.pn * tstep : cB;
        for (int t = 0; t < nt; t += 2) {
            const bool last = (t == nt - 2);
            const char* a1 = cA + (size_t)(t + 1) * kstep;
            const char* a2 = last ? nA : cA + (size_t)(t + 2) * kstep; const char* b2 = last ? nB : cB + (size_t)(t + 2) * kstep;
            const char* a3 = a2 + kstep; const char* b3 = b2 + kstep;
            if (last && has_next) S.a_ready(nxt);
            if constexpr (SP2) {
            PG8_LDB(B0, 0, 0); PG8_LDB(B1, 0, 1); PG8_SCHED; PG8_LDA(At, 0, 0); PG8_STAGE(PG8_SA(1, 1), a1 + hstep, voffA);
            PG8_WAIT_V(8); PG8_WAIT_L(0); PG8_BAR; PG8_MMA(0, 0, At, B0); PG8_MMA(0, 1, At, B1); PG8_BAR; PG8_SCHED;
            PG8_LDA(At, 0, 1); PG8_STAGE(PG8_SB(0, 0), b2, voffB); PG8_STAGE(PG8_SB(0, 1), b2 + hstep, voffB); PG8_STAGE(PG8_SA(0, 0), a2, voffA);
            PG8_WAIT_V(8); PG8_WAIT_L(0); PG8_BAR; PG8_MMA(1, 0, At, B0); PG8_MMA(1, 1, At, B1); PG8_BAR; PG8_SCHED;
            PG8_LDB(B0, 1, 0); PG8_LDB(B1, 1, 1); PG8_SCHED; PG8_LDA(At, 1, 0); PG8_STAGE(PG8_SA(0, 1), a2 + hstep, voffA);
            PG8_WAIT_V(8); PG8_WAIT_L(0); PG8_BAR; PG8_MMA(0, 0, At, B0); PG8_MMA(0, 1, At, B1); PG8_BAR; PG8_SCHED;
            PG8_LDA(At, 1, 1); PG8_STAGE(PG8_SB(1, 0), b3, voffB); PG8_STAGE(PG8_SB(1, 1), b3 + hstep, voffB); PG8_STAGE(PG8_SA(1, 0), a3, voffA);
            PG8_WAIT_V(8); PG8_WAIT_L(0); PG8_BAR; PG8_MMA(1, 0, At, B0); PG8_MMA(1, 1, At, B1); PG8_BAR; PG8_SCHED;
            } else {
            PG8_LDB(B0, 0, 0); PG8_SCHED; PG8_LDA(At, 0, 0); PG8_STAGE(PG8_SA(1, 1), a1 + hstep, voffA);
            PG8_WAIT_L(8); PG8_BAR; PG8_WAIT_L(0); PG8_MMA(0, 0, At, B0); PG8_BAR; PG8_SCHED;
            PG8_LDB(B1, 0, 1); PG8_STAGE(PG8_SB(0, 0), b2, voffB);
            PG8_BAR; PG8_WAIT_L(0); PG8_MMA(0, 1, At, B1); PG8_BAR;
            PG8_LDA(At, 0, 1); PG8_STAGE(PG8_SA(0, 0), a2, voffA);
            PG8_BAR; PG8_WAIT_L(0); PG8_MMA(1, 0, At, B0); PG8_BAR; PG8_SCHED;
            PG8_STAGE(PG8_SB(0, 1), b2 + hstep, voffB);
            PG8_WAIT_V(6); PG8_BAR; PG8_MMA(1, 1, At, B1); PG8_BAR;
            PG8_LDB(B0, 1, 0); PG8_SCHED; PG8_LDA(At, 1, 0); PG8_STAGE(PG8_SA(0, 1), a2 + hstep, voffA);
            PG8_WAIT_L(8); PG8_BAR; PG8_WAIT_L(0); PG8_MMA(0, 0, At, B0); PG8_BAR; PG8_SCHED;
            PG8_LDB(B1, 1, 1); PG8_STAGE(PG8_SB(1, 0), b3, voffB);
            PG8_BAR; PG8_WAIT_L(0); PG8_MMA(0, 1, At, B1); PG8_BAR;
            PG8_LDA(At, 1, 1); PG8_STAGE(PG8_SA(1, 0), a3, voffA);
            PG8_BAR; PG8_WAIT_L(0); PG8_MMA(1, 0, At, B0); PG8_BAR; PG8_SCHED;
            PG8_STAGE(PG8_SB(1, 1), b3 + hstep, voffB);
            PG8_WAIT_V(6); PG8_BAR; PG8_MMA(1, 1, At, B1); PG8_BAR;
            }
        }
        if constexpr (ALIGN_EPI) { if (wr == 0) PG8_BAR; }
        if constexpr (!Epi::AFTER_DRAIN) { E(acc, cur, wr, wc, fr, fq); S.done(cur); }
        if (!has_next) break;
#pragma unroll
        for (int a = 0; a < 2; ++a)
#pragma unroll
            for (int b = 0; b < 2; ++b)
#pragma unroll
                for (int m = 0; m < 4; ++m)
#pragma unroll
                    for (int n = 0; n < 2; ++n) acc[a][b][m][n] = (f32x4){0.f, 0.f, 0.f, 0.f};
        cur = nxt; cA = nA; cB = nB; ++ui;
        if constexpr (ALIGN_EPI) { if (wr == 1) PG8_BAR; }
    }
    PG8_WAIT_V(0);
    if constexpr (!ALIGN_EPI) { if (wr == 0) PG8_BAR; }
    PG8_BAR;
    if constexpr (Epi::AFTER_DRAIN) { E.fused(acc, cur, wr, wc, fr, fq, lds, wid, lane); S.done(cur); }
#undef PG8_SA
#undef PG8_SB
#undef PG8_STAGE
#undef PG8_LDA
#undef PG8_LDB
#undef PG8_MMA
#undef PG8_WAIT_V
#undef PG8_WAIT_L
#undef PG8_BAR
#undef PG8_SCHED
}
}

struct EpiInProjP {
    static constexpr bool PERM = true, AFTER_DRAIN = false;
    bf16_t *PC, *PS, *PR, *PG, *VT;
    __device__ __forceinline__ void operator()(const pg8::f32x4 (&acc)[2][2][4][2], const pg8::Unit& u, int wr, int wc, int fr, int fq) const {
        const int row0 = u.pm * 256 + wr * 64 + fr;
#pragma unroll
        for (int bj = 0; bj < 2; ++bj) {
            const int blk = 2 * u.pn + bj; bf16_t* base; int ld, c0;
            if (blk >= 12 && blk < 15) {
                const int vc = 128 * (blk - 12) + wc * 32 + 8 * fq;
#pragma unroll
                for (int ai = 0; ai < 2; ++ai)
#pragma unroll
                    for (int m = 0; m < 4; ++m) {
                        const int row = row0 + ai * 128 + m * 16, b = row >> 11, t = row & 2047;
#pragma unroll
                        for (int n = 0; n < 2; ++n)
#pragma unroll
                            for (int e = 0; e < 4; ++e) { const int col = vc + 4 * n + e, hh = col >> 6, d = col & 63;
                                VT[((size_t)(b * NH + hh) * HD + d) * SEQ + t] = f2bf(acc[ai][bj][m][n][e]); }
                    }
                continue;
            }
            if (blk < 6) { base = PC; ld = PC_W; c0 = 128 * blk; }
            else if (blk < 12) { base = PS; ld = PS_W; c0 = 128 * (blk - 6); }
            else if (blk < 18) { base = PS; ld = PS_W; c0 = 768 + 128 * (blk - 15); }
            else if (blk < 28) { base = PR; ld = PR_W; c0 = 128 * (blk - 18); }
            else if (blk < 31) { base = PG; ld = PG_W; c0 = 128 * (blk - 28); }
            else continue;
            const int col = c0 + wc * 32 + 8 * fq;
#pragma unroll
            for (int ai = 0; ai < 2; ++ai)
#pragma unroll
                for (int m = 0; m < 4; ++m) {
                    const pg8::f32x4 v0 = acc[ai][bj][m][0], v1 = acc[ai][bj][m][1]; pg8::u32x4 w;
                    w.x = pg8::cvt_pk_bf16(v0[0], v0[1]); w.y = pg8::cvt_pk_bf16(v0[2], v0[3]); w.z = pg8::cvt_pk_bf16(v1[0], v1[1]); w.w = pg8::cvt_pk_bf16(v1[2], v1[3]);
                    *(pg8::u32x4*)(base + (size_t)(row0 + ai * 128 + m * 16) * ld + col) = w;
                }
        }
    }
};
struct EpiOutBf16P {
    static constexpr bool PERM = true, AFTER_DRAIN = false;
    bf16_t* Y; int ld;
    __device__ __forceinline__ void operator()(const pg8::f32x4 (&acc)[2][2][4][2], const pg8::Unit& u, int wr, int wc, int fr, int fq) const {
        const int row0 = u.pm * 256 + wr * 64 + fr, col0 = u.pn * 256 + wc * 32 + 8 * fq;
#pragma unroll
        for (int ai = 0; ai < 2; ++ai)
#pragma unroll
            for (int m = 0; m < 4; ++m)
#pragma unroll
                for (int bj = 0; bj < 2; ++bj) {
                    const pg8::f32x4 v0 = acc[ai][bj][m][0], v1 = acc[ai][bj][m][1]; pg8::u32x4 w;
                    w.x = pg8::cvt_pk_bf16(v0[0], v0[1]); w.y = pg8::cvt_pk_bf16(v0[2], v0[3]); w.z = pg8::cvt_pk_bf16(v1[0], v1[1]); w.w = pg8::cvt_pk_bf16(v1[2], v1[3]);
                    *(pg8::u32x4*)(Y + (size_t)(row0 + ai * 128 + m * 16) * ld + col0 + bj * 128) = w;
                }
    }
};

__device__ void phase_rowpass(const float* Xin, const bf16_t* Y, const float* gpost, float* Xout, bf16_t* XB) {
    const int tid = tid_(), lane = tid & 63, wave = __builtin_amdgcn_readfirstlane(tid >> 6);
    for (int row = blockIdx.x * 8 + wave; row < M; row += gridDim.x * 8) {
        f32x4 y[4], x[4]; float ss = 0.f;
#pragma unroll
        for (int i = 0; i < 4; ++i) { const uint2 yw = ldnt_u2((const void*)(Y + (size_t)row * DM + i * 256 + lane * 4));
            y[i] = (f32x4){bf2f((bf16_t)(yw.x & 0xffff)), bf2f((bf16_t)(yw.x >> 16)), bf2f((bf16_t)(yw.y & 0xffff)), bf2f((bf16_t)(yw.y >> 16))};
            x[i] = __builtin_nontemporal_load((const f32x4*)(Xin + (size_t)row * DM + i * 256 + lane * 4));
            ss += y[i][0] * y[i][0] + y[i][1] * y[i][1] + y[i][2] * y[i][2] + y[i][3] * y[i][3]; }
        ss = wave_sum(ss);
        const float rstd = rsqrtf(ss * (1.0f / DM) + RMS_EPS);
        float s2 = 0.f;
#pragma unroll
        for (int i = 0; i < 4; ++i) { const f32x4 g = *(const f32x4*)(gpost + i * 256 + lane * 4);
            x[i] = x[i] + y[i] * rstd * g; s2 += x[i][0] * x[i][0] + x[i][1] * x[i][1] + x[i][2] * x[i][2] + x[i][3] * x[i][3];
            __builtin_nontemporal_store(x[i], (f32x4*)(Xout + (size_t)row * DM + i * 256 + lane * 4)); }
        if (XB) {
            s2 = wave_sum(s2);
            const float r2 = rsqrtf(s2 * (1.0f / DM) + RMS_EPS);
#pragma unroll
            for (int i = 0; i < 4; ++i) { uint2 w; w.x = pk2(x[i][0] * r2, x[i][1] * r2); w.y = pk2(x[i][2] * r2, x[i][3] * r2); *(uint2*)(XB + (size_t)row * DM + i * 256 + lane * 4) = w; }
        }
    }
}

constexpr int CV_AS = 264;
constexpr int CV_CS = 264;
__device__ void conv_job64(const Params& p, int l, int job, unsigned char* lds) {
    const int tid = tid_(), lane = tid & 63, wave = __builtin_amdgcn_readfirstlane(tid >> 6), fr = lane & 15, fq = lane >> 4;
    const int b = job >> 5, t0 = (job & 31) * 64;
    const bf16_t* PC = (const bf16_t*)(p.ws + WS_PC); bf16_t* MIX = (bf16_t*)(p.ws + WS_MIX);
    const float* dw = p.in[5] + l * TAPS * CW; const float* dwb = p.in[6] + l * CW; const float* lng = p.in[7] + l * CW; const float* lnb = p.in[8] + l * CW;
    const bf16_t* pwT = (const bf16_t*)(p.ws + WS_WPW) + (size_t)l * CW * CW; const float* pwb = p.in[10] + l * CW;
    float* u = (float*)lds;
    bf16_t* act = (bf16_t*)(lds + 94 * 256 * 4);
    for (int idx = tid; idx < 94 * 32; idx += 512) {
        const int r = idx >> 5, c8 = (idx & 31) * 8, t = t0 - 30 + r;
        float v[8];
        if (t >= 0) { const bf16_t* pr = PC + ((size_t)b * SEQ + t) * PC_W + c8; const bf16x8 a = *(const bf16x8*)pr, g = *(const bf16x8*)(pr + 256);
#pragma unroll
            for (int e = 0; e < 8; ++e) v[e] = bf2f((bf16_t)a[e]) * __builtin_amdgcn_rcpf(1.0f + __builtin_amdgcn_exp2f(-1.4426950408889634f * bf2f((bf16_t)g[e]))); }
        else {
#pragma unroll
            for (int e = 0; e < 8; ++e) v[e] = 0.f; }
        *(f32x4*)(u + r * 256 + c8) = (f32x4){v[0], v[1], v[2], v[3]}; *(f32x4*)(u + r * 256 + c8 + 4) = (f32x4){v[4], v[5], v[6], v[7]};
    }
    __syncthreads();
    const int c = tid & 255, half = tid >> 8;
    float acc[32];
    {
        float w[TAPS];
#pragma unroll
        for (int j = 0; j < TAPS; ++j) w[j] = dw[j * CW + c];
        const float bias = dwb[c];
#pragma unroll
        for (int i = 0; i < 32; ++i) acc[i] = bias;
        const float* up = u + (half * 32) * 256 + c;
#pragma unroll
        for (int rr = 0; rr < 62; ++rr) {
            const float uv = up[rr * 256];
#pragma unroll
            for (int i = 0; i < 32; ++i) { if (rr - i >= 0 && rr - i < TAPS) acc[i] += w[rr - i] * uv; }
        }
    }
    __syncthreads();
    float* cv = u;
#pragma unroll
    for (int i = 0; i < 32; ++i) cv[(half * 32 + i) * CV_CS + c] = acc[i];
    __syncthreads();
    uint4 gcv[4];
#pragma unroll
    for (int j = 0; j < 4; ++j) gcv[j] = *(const uint4*)(PC + ((size_t)b * SEQ + t0 + j * 16 + fr) * PC_W + 512 + wave * 32 + fq * 8);
    {
        const int tt = wave * 8 + (lane >> 3), pp = lane & 7;
        f32x4 x[8]; float s_ = 0.f;
#pragma unroll
        for (int k = 0; k < 8; ++k) { x[k] = *(const f32x4*)(cv + tt * CV_CS + 4 * pp + 32 * k); s_ += (x[k][0] + x[k][1]) + (x[k][2] + x[k][3]); }
        s_ += __shfl_xor(s_, 1); s_ += __shfl_xor(s_, 2); s_ += __shfl_xor(s_, 4);
        const float mean = s_ * (1.0f / CW); float q_ = 0.f;
#pragma unroll
        for (int k = 0; k < 8; ++k) { x[k] = x[k] - mean; q_ += (x[k][0] * x[k][0] + x[k][1] * x[k][1]) + (x[k][2] * x[k][2] + x[k][3] * x[k][3]); }
        q_ += __shfl_xor(q_, 1); q_ += __shfl_xor(q_, 2); q_ += __shfl_xor(q_, 4);
        const float rstd = rsqrtf(q_ * (1.0f / CW) + LN_EPS);
#pragma unroll
        for (int k = 0; k < 8; ++k) {
            const f32x4 g = *(const f32x4*)(lng + 4 * pp + 32 * k), bb = *(const f32x4*)(lnb + 4 * pp + 32 * k);
            float y[4];
#pragma unroll
            for (int e = 0; e < 4; ++e) y[e] = siluf_(x[k][e] * rstd * g[e] + bb[e]);
            uint2 w; w.x = pk2(y[0], y[1]); w.y = pk2(y[2], y[3]); *(uint2*)(act + tt * CV_AS + 4 * pp + 32 * k) = w;
        }
    }
    __syncthreads();
    {
        f32x4 o[2][4];
#pragma unroll
        for (int i = 0; i < 2; ++i)
#pragma unroll
            for (int j = 0; j < 4; ++j) o[i][j] = (f32x4){0.f, 0.f, 0.f, 0.f};
#pragma unroll 2
        for (int kk = 0; kk < 8; ++kk) {
            bf16x8 a[2], bq[4];
#pragma unroll
            for (int i = 0; i < 2; ++i) a[i] = *(const bf16x8*)(pwT + (size_t)(wave * 32 + 8 * (fr >> 2) + 4 * i + (fr & 3)) * CW + kk * 32 + fq * 8);
#pragma unroll
            for (int j = 0; j < 4; ++j) bq[j] = *(const bf16x8*)(act + (j * 16 + fr) * CV_AS + kk * 32 + fq * 8);
#pragma unroll
            for (int i = 0; i < 2; ++i)
#pragma unroll
                for (int j = 0; j < 4; ++j) o[i][j] = __builtin_amdgcn_mfma_f32_16x16x32_bf16(a[i], bq[j], o[i][j], 0, 0, 0);
        }
        {
            const int n0 = wave * 32 + fq * 8; const f32x4 bias0 = *(const f32x4*)(pwb + n0), bias1 = *(const f32x4*)(pwb + n0 + 4);
#pragma unroll
            for (int j = 0; j < 4; ++j) {
                const size_t row = (size_t)b * SEQ + t0 + j * 16 + fr;
                const uint4 gw = gcv[j];
                const f32x4 v0 = o[0][j] + bias0, v1 = o[1][j] + bias1;
                uint4 w;
                w.x = pk2(v0[0] * siluf_(bf2f((bf16_t)(gw.x & 0xffff))), v0[1] * siluf_(bf2f((bf16_t)(gw.x >> 16)))); w.y = pk2(v0[2] * siluf_(bf2f((bf16_t)(gw.y & 0xffff))), v0[3] * siluf_(bf2f((bf16_t)(gw.y >> 16))));
                w.z = pk2(v1[0] * siluf_(bf2f((bf16_t)(gw.z & 0xffff))), v1[1] * siluf_(bf2f((bf16_t)(gw.z >> 16)))); w.w = pk2(v1[2] * siluf_(bf2f((bf16_t)(gw.w & 0xffff))), v1[3] * siluf_(bf2f((bf16_t)(gw.w >> 16))));
                *(uint4*)(MIX + row * DM + n0) = w;
            }
        }
    }
    __syncthreads();
}

typedef float f32x16 __attribute__((ext_vector_type(16)));
struct AttFrag { bf16x8 K[4], V[2][2]; };
constexpr int AT_WIN = 224;
constexpr int AT_KS = 144, AT_VS = 976;
constexpr int AT_VOFF = (AT_WIN + 256) * AT_KS;
static_assert(AT_VOFF + 64 * AT_VS <= 147456, "attention LDS map");
__device__ __forceinline__ void att_load(AttFrag& F, const bf16_t* kbase, const bf16_t* vbase, const unsigned char* klds, const unsigned char* vlds, int w0, int kt) {
    const int s0 = (kt > 0 ? kt : 0) * 32;
    if (s0 >= w0) {
        const unsigned char* kp = klds + (s0 - w0) * AT_KS; const unsigned char* vp = vlds + (s0 - w0) * 2;
#pragma unroll
        for (int ks = 0; ks < 4; ++ks) F.K[ks] = *(const bf16x8*)(kp + ks * 32);
#pragma unroll
        for (int db = 0; db < 2; ++db)
#pragma unroll
            for (int s = 0; s < 2; ++s) F.V[db][s] = *(const bf16x8*)(vp + db * 32 * AT_VS + s * 16);
    } else {
#pragma unroll
        for (int ks = 0; ks < 4; ++ks) F.K[ks] = *(const bf16x8*)(kbase + (size_t)s0 * PS_W + ks * 16);
#pragma unroll
        for (int db = 0; db < 2; ++db)
#pragma unroll
            for (int s = 0; s < 2; ++s) F.V[db][s] = *(const bf16x8*)(vbase + (size_t)db * 32 * SEQ + s0 + s * 8);
    }
}
__device__ __forceinline__ bool att_tile(const AttFrag& F, const bf16x8 (&Qf)[4], f32x16& O0, f32x16& O1, float& rp, bool diag, int qi, int hf) {
    f32x16 S;
#pragma unroll
    for (int r = 0; r < 16; ++r) S[r] = 0.f;
#pragma unroll
    for (int ks = 0; ks < 4; ++ks) S = __builtin_amdgcn_mfma_f32_32x32x16_bf16(F.K[ks], Qf[ks], S, 0, 0, 0);
    float tot = 1.0f;
#pragma unroll
    for (int r = 0; r < 16; ++r) {
        float k_ = __builtin_amdgcn_rcpf(1.0f + __builtin_amdgcn_exp2f(S[r]));
        if (diag && (hf * 16 + r >= qi)) k_ = 1.0f;
        S[r] = k_; tot *= k_;
    }
    const float toto = __shfl_xor(tot, 32);
    float e = hf ? rp : rp * toto;
#pragma unroll
    for (int r = 15; r >= 0; --r) { const float k_ = S[r]; S[r] = (1.0f - k_) * e; e *= k_; }
    rp = rp * tot * toto;
    bf16x8 Pf[2];
#pragma unroll
    for (int s = 0; s < 2; ++s) {
        union { bf16x8 v; unsigned u[4]; } pk;
#pragma unroll
        for (int j = 0; j < 4; ++j) pk.u[j] = pk2(S[8 * s + 2 * j], S[8 * s + 2 * j + 1]);
        Pf[s] = pk.v;
    }
#pragma unroll
    for (int s = 0; s < 2; ++s) { O0 = __builtin_amdgcn_mfma_f32_32x32x16_bf16(F.V[0][s], Pf[s], O0, 0, 0, 0); O1 = __builtin_amdgcn_mfma_f32_32x32x16_bf16(F.V[1][s], Pf[s], O1, 0, 0, 0); }
    return __ballot(rp != 0.0f) == 0ull;
}
__device__ void attn_wg_job(const Params& p, int job, unsigned char* lds) {
    const int tid = tid_(), lane = tid & 63, wave = __builtin_amdgcn_readfirstlane(tid >> 6), qi = lane & 31, hf = lane >> 5;
    const int bh = job >> 3, g = job & 7, b = bh / NH, h = bh % NH;
    const bf16_t* PS = (const bf16_t*)(p.ws + WS_PS); const bf16_t* VT = (const bf16_t*)(p.ws + WS_VT) + (size_t)bh * HD * SEQ; bf16_t* MIX = (bf16_t*)(p.ws + WS_MIX);
    const int w0 = g * 256 > AT_WIN ? g * 256 - AT_WIN : 0, nkeys = g * 256 + 256 - w0;
    unsigned char* klds = lds; unsigned char* vlds = lds + AT_VOFF;
    bf16x8 Qf[4];
#pragma unroll
    for (int ks = 0; ks < 4; ++ks) Qf[ks] = *(const bf16x8*)(PS + ((size_t)b * SEQ + (g * 8 + wave) * 32 + qi) * PS_W + h * HD + ks * 16 + hf * 8);
    uint4 gwv[2][2];
#pragma unroll
    for (int db = 0; db < 2; ++db)
#pragma unroll
        for (int gq = 0; gq < 2; ++gq) gwv[db][gq] = *(const uint4*)(PS + ((size_t)b * SEQ + (g * 8 + wave) * 32 + qi) * PS_W + 768 + h * HD + db * 32 + hf * 16 + gq * 8);
    {
        const bf16_t* ksrc = PS + ((size_t)b * SEQ + w0) * PS_W + SBW + h * HD;
        for (int idx = tid; idx < nkeys * 8; idx += 512) { const int row = idx >> 3, pc = idx & 7; *(uint4*)(klds + row * AT_KS + pc * 16) = *(const uint4*)(ksrc + (size_t)row * PS_W + pc * 8); }
        const int pc = tid & 63, npc = nkeys >> 3;
        if (pc < npc) {
#pragma unroll
            for (int i = 0; i < 8; ++i) { const int d = (tid >> 6) + 8 * i; *(uint4*)(vlds + d * AT_VS + pc * 16) = *(const uint4*)(VT + (size_t)d * SEQ + w0 + pc * 8); }
        }
    }
    __syncthreads();
    {
        const int qblk = g * 8 + wave, q0 = qblk * 32;
        const size_t rowq = (size_t)b * SEQ + q0 + qi;
        const int pi = (qi & 3) + 4 * (qi >> 3) + 16 * ((qi >> 2) & 1);
        const bf16_t* kbase = PS + ((size_t)b * SEQ + pi) * PS_W + SBW + h * HD + hf * 8;
        const bf16_t* vbase = VT + (size_t)pi * SEQ + hf * 16;
        const unsigned char* kl = klds + pi * AT_KS + hf * 16; const unsigned char* vl = vlds + pi * AT_VS + hf * 32;
        AttFrag FA, FB;
        att_load(FA, kbase, vbase, kl, vl, w0, qblk);
        f32x16 O0, O1;
#pragma unroll
        for (int r = 0; r < 16; ++r) { O0[r] = 0.f; O1[r] = 0.f; }
        float rp = 1.0f;
        for (int kt = qblk; kt >= 0; kt -= 2) {
            att_load(FB, kbase, vbase, kl, vl, w0, kt - 1);
            if (att_tile(FA, Qf, O0, O1, rp, kt == qblk, qi, hf) || kt < 1) break;
            att_load(FA, kbase, vbase, kl, vl, w0, kt - 2);
            if (att_tile(FB, Qf, O0, O1, rp, false, qi, hf)) break;
        }
        bf16_t* op = MIX + rowq * DM + CW + h * HD;
#pragma unroll
        for (int db = 0; db < 2; ++db)
#pragma unroll
            for (int gq = 0; gq < 2; ++gq) {
                const uint4 gw = gwv[db][gq]; const f32x16& O = db ? O1 : O0;
                uint4 w;
                w.x = pk2(O[8 * gq + 0] * siluf_(bf2f((bf16_t)(gw.x & 0xffff))), O[8 * gq + 1] * siluf_(bf2f((bf16_t)(gw.x >> 16)))); w.y = pk2(O[8 * gq + 2] * siluf_(bf2f((bf16_t)(gw.y & 0xffff))), O[8 * gq + 3] * siluf_(bf2f((bf16_t)(gw.y >> 16))));
                w.z = pk2(O[8 * gq + 4] * siluf_(bf2f((bf16_t)(gw.z & 0xffff))), O[8 * gq + 5] * siluf_(bf2f((bf16_t)(gw.z >> 16)))); w.w = pk2(O[8 * gq + 6] * siluf_(bf2f((bf16_t)(gw.w & 0xffff))), O[8 * gq + 7] * siluf_(bf2f((bf16_t)(gw.w >> 16))));
                *(uint4*)(op + db * 32 + hf * 16 + gq * 8) = w;
            }
    }
    __syncthreads();
}

constexpr int TS = 72;
constexpr int TILE_B = 64 * TS * 2;
constexpr int AABS = 68, XTS = 65, CSS = 65;

__device__ __forceinline__ f32x4 mm_tile(const bf16_t* X, int m0, const bf16_t* Yt, int n0, int K, int fr, int fq, f32x4 acc) {
#pragma unroll
    for (int kk = 0; kk < 2; ++kk) {
        if (kk * 32 < K) {
            const bf16x8 a = *(const bf16x8*)(X + (m0 + fr) * TS + kk * 32 + fq * 8);
            const bf16x8 b = *(const bf16x8*)(Yt + (n0 + fr) * TS + kk * 32 + fq * 8);
            acc = __builtin_amdgcn_mfma_f32_16x16x32_bf16(a, b, acc, 0, 0, 0);
        }
    }
    return acc;
}
__device__ __forceinline__ uint2 pk4(const f32x4& v) { uint2 w; w.x = pk2(v[0], v[1]); w.y = pk2(v[2], v[3]); return w; }

struct B1Loads {
    bf16x8 rc, kc, vc, rp, kp, vp;
    f32x4 vf0, vf1;
    bf16x8 cc[2], cp[2];
};
__device__ __forceinline__ void b1_issue_loads(const Params& p, int l, int gi, int h, int tid, B1Loads& L) {
    const int b = gi >> 5, c = gi & 31, t0 = c * 64;
    const bf16_t* PR = (const bf16_t*)(p.ws + WS_PR); const float* VF = (const float*)(p.ws + WS_VF);
    {
        const int tt = tid >> 3, j0 = (tid & 7) * 8, t = t0 + tt, cj0 = h * HD + j0; const size_t row = (size_t)b * SEQ + t;
        const bf16_t* cur = PR + row * PR_W; const bf16_t* prv = cur - (t > 0 ? PR_W : 0);
        L.rc = *(const bf16x8*)(cur + cj0); L.kc = *(const bf16x8*)(cur + 384 + cj0); L.vc = *(const bf16x8*)(cur + 768 + cj0);
        L.rp = *(const bf16x8*)(prv + cj0); L.kp = *(const bf16x8*)(prv + 384 + cj0); L.vp = *(const bf16x8*)(prv + 768 + cj0);
        if (l > 0) { L.vf0 = *(const f32x4*)(VF + row * RWW + cj0); L.vf1 = *(const f32x4*)(VF + row * RWW + cj0 + 4); }
    }
    if (h == 0) {
#pragma unroll
        for (int q = 0; q < 2; ++q) {
            const int item = tid + 512 * q, tt = item >> 4, g = item & 15, t = t0 + tt;
            const bf16_t* cur = PR + ((size_t)b * SEQ + t) * PR_W + 1152; const bf16_t* prv = cur - (t > 0 ? PR_W : 0);
            const int gc = g < 12 ? g : 0, gp = g < 8 ? g : (g < 12 ? g + 4 : 0);
            L.cc[q] = *(const bf16x8*)(cur + 8 * gc); L.cp[q] = *(const bf16x8*)(prv + 8 * gp);
        }
    }
}

__device__ void rwkv_b1_phase(const Params& p, int l, unsigned char* lds) {
    const int G = gridDim.x;
    float* VF = (float*)(p.ws + WS_VF);
    const float* mu = p.in[11] + l * 1216; const float* w0 = p.in[12] + l * RWW;
    const float* a0 = p.in[14] + l * RWW; const float* kks = p.in[16] + l * RWW; const float* ka = p.in[17] + l * RWW;
    const float* rk = p.in[18] + l * RWW; const float* v0 = p.in[21];
    const float* w2 = p.in[13] + l * LORA * RWW; const float* a2 = p.in[15] + l * LORA * RWW; const float* v2 = p.in[23];
    bf16_t* T_At = (bf16_t*)lds; bf16_t* T_Rt = T_At + 64 * TS; bf16_t* T_Bt = T_Rt + 64 * TS; bf16_t* T_Kt = T_Bt + 64 * TS;
    bf16_t* T_VT = T_Kt + 64 * TS; bf16_t* T_bhT = T_VT + 64 * TS; bf16_t* T_khT = T_bhT + 64 * TS;
    bf16_t* T_Aak = T_khT + 64 * TS; bf16_t* T_Arb = T_Aak + 64 * TS; bf16_t* T_Ark = T_Arb + 64 * TS;
    bf16_t* T_WT = T_At; bf16_t* T_U0T = T_Bt;
    float* Aab = (float*)(lds + 10 * TILE_B);
    float* XT = (float*)(lds + 10 * TILE_B + 64 * AABS * 4);
    float* PCv = XT + 128 * XTS;
    float* TI = PCv + 64;
    float* CS = (float*)T_Aak;
    constexpr int LS = 33;
    float* WD = Aab; float* AD = WD + 64 * LS;
    float* VL = XT + 64 * XTS;
    float* WLT = (float*)lds; float* ALT = WLT + 64 * XTS; float* VGT = ALT + 64 * XTS;

    constexpr int NGRP = BATCH * (SEQ / 64);
    int gi = blockIdx.x;
    if (gi >= NGRP) return;
    B1Loads L;
    b1_issue_loads(p, l, gi, 0, tid_(), L);
    float codes[2][8];
#pragma unroll 1
    for (int it = 0; gi < NGRP; ++it) {
        const int h = it % NH;
        const int tid = tid_(), lane = tid & 63, wave = __builtin_amdgcn_readfirstlane(tid >> 6), fr = lane & 15, fq = lane >> 4;
        const int b = gi >> 5, c = gi & 31, bh = b * NH + h, jb = bh * 32 + c, t0 = c * 64;
        float wg[6][8];
#pragma unroll
        for (int q = 0; q < 6; ++q) {
            const int id = wave + 8 * q, Lk = id >> 4, tj = id & 3;
            if (q < 4 || l > 0) {
                const float* Wg = (Lk == 0 ? w2 : (Lk == 1 ? a2 : v2)) + (size_t)(8 * fq) * RWW + h * HD + tj * 16 + fr;
#pragma unroll
                for (int kk = 0; kk < 8; ++kk) wg[q][kk] = Wg[(size_t)kk * RWW];
            }
        }
#pragma unroll
        for (int q = 0; q < 2; ++q) {
            const int item = tid + 512 * q, tt = item >> 4, g = item & 15, t = t0 + tt; const bool hp = t > 0;
            if (h == 0) {
#pragma unroll
                for (int e = 0; e < 8; ++e) {
                    const float xc = bf2f((bf16_t)L.cc[q][e]), xp = hp ? bf2f((bf16_t)L.cp[q][e]) : 0.f;
                    const float x_ = xc + (xp - xc) * mu[1152 + 8 * (g & 7) + e];
                    codes[q][e] = g < 4 ? 1.0f - 2.0f * __builtin_amdgcn_rcpf(1.0f + __builtin_amdgcn_exp2f(2.8853900817779268f * x_)) : (g < 8 ? x_ : xc + xp);
                }
            }
            if (g < 8 || (g < 12 && l > 0)) {
                float* dst = (g < 4 ? WD + tt * LS + 8 * g : (g < 8 ? AD + tt * LS + 8 * (g - 4) : VL + tt * LS + 8 * (g - 8)));
#pragma unroll
                for (int e = 0; e < 8; ++e) dst[e] = codes[q][e];
            }
        }
        __syncthreads();
#pragma unroll
        for (int q = 0; q < 6; ++q) {
            if (q < 4 || l > 0) {
                const int id = wave + 8 * q, Lk = id >> 4, ti = (id >> 2) & 3, tj = id & 3;
                const float* Xs = (Lk == 0 ? WD : (Lk == 1 ? AD : VL)) + (ti * 16 + fr) * LS + 8 * fq;
                float xs[8];
#pragma unroll
                for (int jj = 0; jj < 8; ++jj) xs[jj] = Xs[jj];
                union { bf16x8 v; unsigned u[4]; } ah, al, bh, bl;
#pragma unroll
                for (int jj = 0; jj < 4; ++jj) { ah.u[jj] = pk2(xs[2 * jj], xs[2 * jj + 1]); bh.u[jj] = pk2(wg[q][2 * jj], wg[q][2 * jj + 1]); }
                f32x4 acc = __builtin_amdgcn_mfma_f32_16x16x32_bf16(ah.v, bh.v, (f32x4){0.f, 0.f, 0.f, 0.f}, 0, 0, 0);
                if (Lk == 0) {
#pragma unroll
                    for (int jj = 0; jj < 4; ++jj) {
                        al.u[jj] = pk2(xs[2 * jj] - bf2f((bf16_t)(ah.u[jj] & 0xffff)), xs[2 * jj + 1] - bf2f((bf16_t)(ah.u[jj] >> 16)));
                        bl.u[jj] = pk2(wg[q][2 * jj] - bf2f((bf16_t)(bh.u[jj] & 0xffff)), wg[q][2 * jj + 1] - bf2f((bf16_t)(bh.u[jj] >> 16)));
                    }
                    acc = __builtin_amdgcn_mfma_f32_16x16x32_bf16(al.v, bh.v, acc, 0, 0, 0);
                    acc = __builtin_amdgcn_mfma_f32_16x16x32_bf16(ah.v, bl.v, acc, 0, 0, 0);
                }
                float* out = (Lk == 0 ? WLT : (Lk == 1 ? ALT : VGT)) + (tj * 16 + fr) * XTS + ti * 16 + fq * 4;
#pragma unroll
                for (int r = 0; r < 4; ++r) out[r] = acc[r];
            }
        }
        __syncthreads();
        const int tt = tid >> 3, j0 = (tid & 7) * 8, t = t0 + tt, cj0 = h * HD + j0;
        const size_t row = (size_t)b * SEQ + t;
        float rr[8], kk_[8], vv[8], aa[8], bb[8], lw[8];
        {
            const bool hp = t > 0;
            float wl[8], al[8], vg[8];
#pragma unroll
            for (int e = 0; e < 8; ++e) {
                const float r_c = bf2f((bf16_t)L.rc[e]), k_c = bf2f((bf16_t)L.kc[e]), v_c = bf2f((bf16_t)L.vc[e]);
                const float r_p = hp ? bf2f((bf16_t)L.rp[e]) : 0.f, k_p = hp ? bf2f((bf16_t)L.kp[e]) : 0.f, v_p = hp ? bf2f((bf16_t)L.vp[e]) : 0.f;
                rr[e] = r_c + (r_p - r_c) * mu[cj0 + e]; kk_[e] = k_c + (k_p - k_c) * mu[384 + cj0 + e]; vv[e] = v_c + (v_p - v_c) * mu[768 + cj0 + e];
                wl[e] = w0[cj0 + e] + WLT[(j0 + e) * XTS + tt]; al[e] = a0[cj0 + e] + ALT[(j0 + e) * XTS + tt]; vg[e] = l > 0 ? v0[cj0 + e] + VGT[(j0 + e) * XTS + tt] : 0.f;
            }
            float ssq = 0.f, bon = 0.f;
#pragma unroll
            for (int e = 0; e < 8; ++e) {
                const float sp2 = fmaxf(-wl[e], 0.f) * 1.4426950408889634f + __builtin_amdgcn_logf(1.0f + __builtin_amdgcn_exp2f(-1.4426950408889634f * fabsf(wl[e])));
                lw[e] = -__builtin_amdgcn_exp2f(-sp2 - 0.7213475204444817f);
                const float alr = __builtin_amdgcn_rcpf(1.0f + __builtin_amdgcn_exp2f(-1.4426950408889634f * al[e]));
                if (l > 0) { const float vf = e < 4 ? L.vf0[e & 3] : L.vf1[e & 3]; vv[e] = vv[e] + (vf - vv[e]) * __builtin_amdgcn_rcpf(1.0f + __builtin_amdgcn_exp2f(-1.4426950408889634f * vg[e])); }
                const float kkr = kk_[e] * kks[cj0 + e];
                kk_[e] = kk_[e] * (1.0f + (alr - 1.0f) * ka[cj0 + e]);
                aa[e] = kkr; bb[e] = alr; ssq += kkr * kkr; bon += rr[e] * kk_[e] * rk[cj0 + e];
            }
            if (l == 0) { __builtin_nontemporal_store((f32x4){vv[0], vv[1], vv[2], vv[3]}, (f32x4*)(VF + row * RWW + cj0)); __builtin_nontemporal_store((f32x4){vv[4], vv[5], vv[6], vv[7]}, (f32x4*)(VF + row * RWW + cj0 + 4)); }
            ssq += __shfl_xor(ssq, 1); ssq += __shfl_xor(ssq, 2); ssq += __shfl_xor(ssq, 4);
            bon += __shfl_xor(bon, 1); bon += __shfl_xor(bon, 2); bon += __shfl_xor(bon, 4);
            const float inv = fminf(__builtin_amdgcn_rsqf(ssq), 1e12f);
            uint4 bvw; float bv[8];
#pragma unroll
            for (int e = 0; e < 8; ++e) { const float kn = aa[e] * inv; aa[e] = -kn; bb[e] = kn * bb[e]; bv[e] = bon * vv[e]; }
            bvw.x = pk2(bv[0], bv[1]); bvw.y = pk2(bv[2], bv[3]); bvw.z = pk2(bv[4], bv[5]); bvw.w = pk2(bv[6], bv[7]);
            *(uint4*)((bf16_t*)(p.ws + WS_CH_BV) + (size_t)jb * 4096 + tt * 64 + j0) = bvw;
        }
        float csv[8], cst[8];
        {
            const int ts = lane >> 3;
#pragma unroll
            for (int e = 0; e < 8; ++e) { float x = lw[e];
                { const float y = __shfl_up(x, 8); if (ts >= 1) x += y; }
                { const float y = __shfl_up(x, 16); if (ts >= 2) x += y; }
                { const float y = __shfl_up(x, 32); if (ts >= 4) x += y; }
                csv[e] = x; }
            if (ts == 7) {
#pragma unroll
                for (int e = 0; e < 8; ++e) CS[wave * 64 + j0 + e] = csv[e];
            }
        }
        __syncthreads();
        {
#pragma unroll
            for (int e = 0; e < 8; ++e) cst[e] = 0.f;
#pragma unroll
            for (int w_ = 0; w_ < 8; ++w_) {
                const f32x4 t0_ = *(const f32x4*)(CS + w_ * 64 + j0), t1_ = *(const f32x4*)(CS + w_ * 64 + j0 + 4);
#pragma unroll
                for (int e = 0; e < 4; ++e) { cst[e] += t0_[e]; cst[4 + e] += t1_[e]; if (w_ < wave) { csv[e] += t0_[e]; csv[4 + e] += t1_[e]; } }
            }
            float at[8], rt[8], bt[8], kt[8];
#pragma unroll
            for (int e = 0; e < 8; ++e) {
                const int j = j0 + e; const float cs = csv[e] * 1.4426950408889634f, csC = cst[e] * 1.4426950408889634f, lw2 = lw[e] * 1.4426950408889634f;
                const float e_in = __builtin_amdgcn_exp2f(cs), e_ex = __builtin_amdgcn_exp2f(cs - lw2), e_ng = __builtin_amdgcn_exp2f(-cs), e_ht = __builtin_amdgcn_exp2f(csC - cs);
                at[e] = aa[e] * e_ex; rt[e] = rr[e] * e_in; bt[e] = bb[e] * e_ng; kt[e] = kk_[e] * e_ng;
                T_VT[j * TS + tt] = f2bf(vv[e]); T_bhT[j * TS + tt] = f2bf(bb[e] * e_ht); T_khT[j * TS + tt] = f2bf(kk_[e] * e_ht);
                XT[j * XTS + tt] = at[e];
                if (tt == 63) PCv[j] = __builtin_amdgcn_exp2f(csC);
            }
            uint4 w;
            w.x = pk2(at[0], at[1]); w.y = pk2(at[2], at[3]); w.z = pk2(at[4], at[5]); w.w = pk2(at[6], at[7]); *(uint4*)(T_At + tt * TS + j0) = w;
            w.x = pk2(rt[0], rt[1]); w.y = pk2(rt[2], rt[3]); w.z = pk2(rt[4], rt[5]); w.w = pk2(rt[6], rt[7]); *(uint4*)(T_Rt + tt * TS + j0) = w;
            w.x = pk2(bt[0], bt[1]); w.y = pk2(bt[2], bt[3]); w.z = pk2(bt[4], bt[5]); w.w = pk2(bt[6], bt[7]); *(uint4*)(T_Bt + tt * TS + j0) = w;
            w.x = pk2(kt[0], kt[1]); w.y = pk2(kt[2], kt[3]); w.z = pk2(kt[4], kt[5]); w.w = pk2(kt[6], kt[7]); *(uint4*)(T_Kt + tt * TS + j0) = w;
        }
        __syncthreads();
        { const int hn = h + 1 < NH ? h + 1 : 0, gn = h + 1 < NH ? gi : gi + G; if (gn < NGRP) b1_issue_loads(p, l, gn, hn, tid, L); }
        {
            const int mat = wave >> 1;
            const bf16_t* As = (mat == 0 || mat == 2) ? T_Bt : T_Kt; const bf16_t* Bs = (mat < 2) ? T_At : T_Rt;
            bf16_t* dstb = (mat == 1 ? T_Aak : (mat == 2 ? T_Arb : T_Ark));
#pragma unroll
            for (int q = 0; q < 8; ++q) {
                constexpr int TI0[8] = {0, 0, 0, 0, 3, 1, 2, 3}, TJ0[8] = {0, 1, 2, 3, 3, 0, 0, 0}, TI1[8] = {1, 1, 1, 2, 2, 2, 3, 3}, TJ1[8] = {1, 2, 3, 2, 3, 1, 1, 2};
                const int ti = (wave & 1) ? TI1[q] : TI0[q], tj = (wave & 1) ? TJ1[q] : TJ0[q];
                f32x4 acc = (f32x4){0.f, 0.f, 0.f, 0.f};
                if (ti <= tj) acc = mm_tile(As, ti * 16, Bs, tj * 16, 64, fr, fq, acc);
                const int tcol = tj * 16 + fr, i0 = ti * 16 + fq * 4;
                if (ti == tj) {
#pragma unroll
                    for (int r = 0; r < 4; ++r) { const bool keep = (mat < 2) ? (i0 + r < tcol) : (i0 + r <= tcol); if (!keep) acc[r] = 0.f; }
                }
                if (mat == 0) *(f32x4*)(Aab + tcol * AABS + i0) = acc;
                else *(uint2*)(dstb + tcol * TS + i0) = pk4(acc);
            }
        }
        __syncthreads();
        if (wave == 0) {
            const int blk = lane >> 4, cc = lane & 15; const float* ar = Aab + (16 * blk) * AABS + 16 * blk;
            float x[16];
#pragma unroll
            for (int u = 0; u < 16; ++u) { float v = (u == cc) ? 1.0f : 0.f;
#pragma unroll
                for (int i = 0; i < u; ++i) v += ar[u * AABS + i] * x[i];
                x[u] = v; }
#pragma unroll
            for (int u = 0; u < 16; ++u) TI[(blk * 16 + u) * 17 + cc] = x[u];
        } else {
#pragma unroll 1
            for (int id = wave - 1; id < 16; id += 7) {
                const int ti = id >> 2, tj = id & 3;
                f32x4 acc = mm_tile(T_Aak, ti * 16, T_VT, tj * 16, 64, fr, fq, (f32x4){0.f, 0.f, 0.f, 0.f});
                const int j = tj * 16 + fr, tr = ti * 16 + fq * 4;
#pragma unroll
                for (int r = 0; r < 4; ++r) XT[(64 + j) * XTS + tr + r] = acc[r];
            }
        }
        __syncthreads();
        {
            float* xc = XT + (wave * 16 + fr) * XTS;
#pragma unroll
            for (int I = 0; I < 4; ++I) {
                f32x4 acc;
#pragma unroll
                for (int r = 0; r < 4; ++r) acc[r] = xc[16 * I + 4 * fq + r];
#pragma unroll
                for (int J = 0; J < I; ++J)
#pragma unroll
                    for (int kk = 0; kk < 4; ++kk) acc = __builtin_amdgcn_mfma_f32_16x16x4f32(Aab[(16 * I + fr) * AABS + 16 * J + 4 * kk + fq], xc[16 * J + 4 * kk + fq], acc, 0, 0, 0);
#pragma unroll
                for (int r = 0; r < 4; ++r) xc[16 * I + 4 * fq + r] = acc[r];
                asm volatile("s_waitcnt lgkmcnt(0)" ::: "memory");
                f32x4 xs = (f32x4){0.f, 0.f, 0.f, 0.f};
#pragma unroll
                for (int kk = 0; kk < 4; ++kk) xs = __builtin_amdgcn_mfma_f32_16x16x4f32(TI[(I * 16 + fr) * 17 + 4 * kk + fq], xc[16 * I + 4 * kk + fq], xs, 0, 0, 0);
                asm volatile("s_waitcnt lgkmcnt(0)" ::: "memory");
#pragma unroll
                for (int r = 0; r < 4; ++r) xc[16 * I + 4 * fq + r] = xs[r];
                asm volatile("s_waitcnt lgkmcnt(0)" ::: "memory");
            }
        }
        {
            const int col = wave * 16 + (lane >> 2), tg = (lane & 3) * 16;
            const float* xr = XT + col * XTS + tg; bf16_t* dst = (col < 64 ? T_WT + col * TS : T_U0T + (col - 64) * TS) + tg;
            uint4 w0_, w1_;
            w0_.x = pk2(xr[0], xr[1]); w0_.y = pk2(xr[2], xr[3]); w0_.z = pk2(xr[4], xr[5]); w0_.w = pk2(xr[6], xr[7]);
            w1_.x = pk2(xr[8], xr[9]); w1_.y = pk2(xr[10], xr[11]); w1_.z = pk2(xr[12], xr[13]); w1_.w = pk2(xr[14], xr[15]);
            *(uint4*)dst = w0_; *(uint4*)(dst + 8) = w1_;
        }
        __syncthreads();
        {
            bf16_t* gM = (bf16_t*)(p.ws + WS_CH_M) + (size_t)jb * 4096; bf16_t* gNT = (bf16_t*)(p.ws + WS_CH_NT) + (size_t)jb * 4096;
            bf16_t* gG = (bf16_t*)(p.ws + WS_CH_G) + (size_t)jb * 4096; bf16_t* gY1T = (bf16_t*)(p.ws + WS_CH_Y1T) + (size_t)jb * 4096;
            const int mat = wave >> 1;
            const bf16_t* A1 = (mat == 0 || mat == 2) ? T_WT : (mat == 1 ? T_U0T : T_bhT);
            const bf16_t* B1 = (mat == 0 || mat == 1) ? T_Arb : (mat == 2 ? T_bhT : T_U0T);
            const bf16_t* A2 = mat == 1 ? T_VT : T_khT; const bf16_t* B2 = mat == 1 ? T_Ark : T_VT;
            bf16_t* gdst = mat == 0 ? gG : (mat == 1 ? gY1T : (mat == 2 ? gM : gNT));
#pragma unroll
            for (int q = 0; q < 8; ++q) {
                const int ti = ((wave & 1) * 8 + q) >> 2, tj = q & 3;
                const int col = tj * 16 + fr, r0 = ti * 16 + fq * 4;
                f32x4 acc = mm_tile(A1, ti * 16, B1, tj * 16, 64, fr, fq, (f32x4){0.f, 0.f, 0.f, 0.f});
                if (mat & 1) acc = mm_tile(A2, ti * 16, B2, tj * 16, 64, fr, fq, acc);
                if (mat == 0) {
                    const uint2 rw = *(const uint2*)(T_Rt + col * TS + r0);
                    acc[0] += bf2f((bf16_t)(rw.x & 0xffff)); acc[1] += bf2f((bf16_t)(rw.x >> 16)); acc[2] += bf2f((bf16_t)(rw.y & 0xffff)); acc[3] += bf2f((bf16_t)(rw.y >> 16));
                } else if (mat == 2 && ti == tj) {
                    const float pc = PCv[col];
#pragma unroll
                    for (int r = 0; r < 4; ++r) if (r0 + r == col) acc[r] += pc;
                }
                *(uint2*)(gdst + col * 64 + r0) = pk4(acc);
            }
        }
        if (h == NH - 1) gi += G;
    }
    __syncthreads();
}

__device__ void rwkv_b2_job(const Params& p, int bh, unsigned char* lds) {
    const int tid = tid_(), lane = tid & 63, wave = __builtin_amdgcn_readfirstlane(tid >> 6), fr = lane & 15, fq = lane >> 4;
    const int mi = wave >> 1, nj0 = (wave & 1) * 2;
    const bf16_t* gM = (const bf16_t*)(p.ws + WS_CH_M); const bf16_t* gNT = (const bf16_t*)(p.ws + WS_CH_NT); bf16_t* gZT = (bf16_t*)(p.ws + WS_ZT);
    bf16_t* zbuf = (bf16_t*)lds;
    f32x4 z[2];
    z[0] = (f32x4){0.f, 0.f, 0.f, 0.f}; z[1] = z[0];
    const int c0 = mi * 16 + fq * 4;
    bf16x8 am[2]; uint2 nw[2];
    {
        const size_t jb = (size_t)bh * 32;
#pragma unroll
        for (int kk = 0; kk < 2; ++kk) am[kk] = *(const bf16x8*)(gM + jb * 4096 + (mi * 16 + fr) * 64 + kk * 32 + fq * 8);
#pragma unroll
        for (int q = 0; q < 2; ++q) nw[q] = *(const uint2*)(gNT + jb * 4096 + ((nj0 + q) * 16 + fr) * 64 + c0);
    }
#pragma unroll 1
    for (int c = 0; c < SEQ / 64; ++c) {
        const size_t jb = (size_t)bh * 32 + c;
        bf16_t* zh = zbuf + (c & 1) * 2 * 64 * TS; bf16_t* zl = zh + 64 * TS;
#pragma unroll
        for (int q = 0; q < 2; ++q) {
            const int j = (nj0 + q) * 16 + fr;
            const uint2 hi = pk4(z[q]);
            f32x4 lo;
            lo[0] = z[q][0] - bf2f((bf16_t)(hi.x & 0xffff)); lo[1] = z[q][1] - bf2f((bf16_t)(hi.x >> 16)); lo[2] = z[q][2] - bf2f((bf16_t)(hi.y & 0xffff)); lo[3] = z[q][3] - bf2f((bf16_t)(hi.y >> 16));
            *(uint2*)(zh + j * TS + c0) = hi; *(uint2*)(zl + j * TS + c0) = pk4(lo);
            *(uint2*)(gZT + jb * 4096 + j * 64 + c0) = hi;
        }
        bf16x8 amn[2]; uint2 nwn[2];
        {
            const size_t jn = (size_t)bh * 32 + (c + 1 < SEQ / 64 ? c + 1 : c);
#pragma unroll
            for (int kk = 0; kk < 2; ++kk) amn[kk] = *(const bf16x8*)(gM + jn * 4096 + (mi * 16 + fr) * 64 + kk * 32 + fq * 8);
#pragma unroll
            for (int q = 0; q < 2; ++q) nwn[q] = *(const uint2*)(gNT + jn * 4096 + ((nj0 + q) * 16 + fr) * 64 + c0);
        }
        __syncthreads();
#pragma unroll
        for (int q = 0; q < 2; ++q) {
            const int j = (nj0 + q) * 16 + fr;
            f32x4 acc; acc[0] = bf2f((bf16_t)(nw[q].x & 0xffff)); acc[1] = bf2f((bf16_t)(nw[q].x >> 16)); acc[2] = bf2f((bf16_t)(nw[q].y & 0xffff)); acc[3] = bf2f((bf16_t)(nw[q].y >> 16));
#pragma unroll
            for (int kk = 0; kk < 2; ++kk) {
                const bf16x8 bh_ = *(const bf16x8*)(zh + j * TS + kk * 32 + fq * 8), bl_ = *(const bf16x8*)(zl + j * TS + kk * 32 + fq * 8);
                acc = __builtin_amdgcn_mfma_f32_16x16x32_bf16(am[kk], bh_, acc, 0, 0, 0);
                acc = __builtin_amdgcn_mfma_f32_16x16x32_bf16(am[kk], bl_, acc, 0, 0, 0);
            }
            z[q] = acc;
        }
        am[0] = amn[0]; am[1] = amn[1]; nw[0] = nwn[0]; nw[1] = nwn[1];
    }
    __syncthreads();
}

struct B3Loads { bf16x8 bg[2], az[4][2]; uint2 yw[4], bw[4], gw[4]; };
__device__ __forceinline__ void b3_issue_loads(const Params& p, int pair, int wave, int fr, int fq, B3Loads& L) {
    const int jb = pair * 2 + (wave >> 2), mi = wave & 3, bh = jb >> 5, c = jb & 31, b = bh / NH, h = bh % NH;
    const bf16_t* gG = (const bf16_t*)(p.ws + WS_CH_G) + (size_t)jb * 4096; const bf16_t* gY1 = (const bf16_t*)(p.ws + WS_CH_Y1T) + (size_t)jb * 4096;
    const bf16_t* gBV = (const bf16_t*)(p.ws + WS_CH_BV) + (size_t)jb * 4096; const bf16_t* gZT = (const bf16_t*)(p.ws + WS_ZT) + (size_t)jb * 4096;
    const bf16_t* PG = (const bf16_t*)(p.ws + WS_PG);
    const int tt = mi * 16 + fr; const size_t row = (size_t)b * SEQ + c * 64 + tt;
#pragma unroll
    for (int kk = 0; kk < 2; ++kk) L.bg[kk] = __builtin_nontemporal_load((const bf16x8*)(gG + tt * 64 + kk * 32 + fq * 8));
#pragma unroll
    for (int nj = 0; nj < 4; ++nj) { const int j0 = nj * 16 + fq * 4;
        L.yw[nj] = ldnt_u2((const void*)(gY1 + tt * 64 + j0)); L.bw[nj] = ldnt_u2((const void*)(gBV + tt * 64 + j0)); L.gw[nj] = ldnt_u2((const void*)(PG + row * PG_W + h * HD + j0));
#pragma unroll
        for (int kk = 0; kk < 2; ++kk) L.az[nj][kk] = *(const bf16x8*)(gZT + (nj * 16 + fr) * 64 + kk * 32 + fq * 8); }
}
__device__ void rwkv_b3_phase(const Params& p, int l) {
    const int G = gridDim.x, NPAIR = BATCH * NH * 16;
    int pair = blockIdx.x;
    if (pair >= NPAIR) return;
    B3Loads L;
    { const int tid = tid_(), lane = tid & 63; b3_issue_loads(p, pair, __builtin_amdgcn_readfirstlane(tid >> 6), lane & 15, lane >> 4, L); }
#pragma unroll 1
    for (; pair < NPAIR; pair += G) {
        const int tid = tid_(), lane = tid & 63, wave = __builtin_amdgcn_readfirstlane(tid >> 6), fr = lane & 15, fq = lane >> 4;
        const int jb = pair * 2 + (wave >> 2), mi = wave & 3;
        const int bh = jb >> 5, c = jb & 31, b = bh / NH, h = bh % NH;
        bf16_t* MIX = (bf16_t*)(p.ws + WS_MIX);
        const float* gng = p.in[19] + l * RWW + h * HD; const float* gnb = p.in[20] + l * RWW + h * HD;
        const int tt = mi * 16 + fr; const size_t row = (size_t)b * SEQ + c * 64 + tt;
        f32x4 acc[4];
#pragma unroll
        for (int nj = 0; nj < 4; ++nj) {
            acc[nj][0] = bf2f((bf16_t)(L.yw[nj].x & 0xffff)); acc[nj][1] = bf2f((bf16_t)(L.yw[nj].x >> 16)); acc[nj][2] = bf2f((bf16_t)(L.yw[nj].y & 0xffff)); acc[nj][3] = bf2f((bf16_t)(L.yw[nj].y >> 16));
#pragma unroll
            for (int kk = 0; kk < 2; ++kk) acc[nj] = __builtin_amdgcn_mfma_f32_16x16x32_bf16(L.az[nj][kk], L.bg[kk], acc[nj], 0, 0, 0);
        }
        uint2 bw[4], gw[4];
#pragma unroll
        for (int nj = 0; nj < 4; ++nj) { bw[nj] = L.bw[nj]; gw[nj] = L.gw[nj]; }
        if (pair + G < NPAIR) b3_issue_loads(p, pair + G, wave, fr, fq, L);
        float s = 0.f;
#pragma unroll
        for (int nj = 0; nj < 4; ++nj) s += (acc[nj][0] + acc[nj][1]) + (acc[nj][2] + acc[nj][3]);
        s += __shfl_xor(s, 16); s += __shfl_xor(s, 32);
        const float mean = s * (1.0f / HD);
        float vs = 0.f;
#pragma unroll
        for (int nj = 0; nj < 4; ++nj) { acc[nj] = acc[nj] - mean; vs += (acc[nj][0] * acc[nj][0] + acc[nj][1] * acc[nj][1]) + (acc[nj][2] * acc[nj][2] + acc[nj][3] * acc[nj][3]); }
        vs += __shfl_xor(vs, 16); vs += __shfl_xor(vs, 32);
        const float rstd = rsqrtf(vs * (1.0f / HD) + GN_EPS);
#pragma unroll
        for (int nj = 0; nj < 4; ++nj) {
            const int j0 = nj * 16 + fq * 4;
            const f32x4 gg = *(const f32x4*)(gng + j0), gb = *(const f32x4*)(gnb + j0);
            const float bv0 = bf2f((bf16_t)(bw[nj].x & 0xffff)), bv1 = bf2f((bf16_t)(bw[nj].x >> 16)), bv2 = bf2f((bf16_t)(bw[nj].y & 0xffff)), bv3 = bf2f((bf16_t)(bw[nj].y >> 16));
            const float g0 = bf2f((bf16_t)(gw[nj].x & 0xffff)), g1 = bf2f((bf16_t)(gw[nj].x >> 16)), g2 = bf2f((bf16_t)(gw[nj].y & 0xffff)), g3 = bf2f((bf16_t)(gw[nj].y >> 16));
            const float o0 = acc[nj][0] * rstd * gg[0] + gb[0] + bv0, o1 = acc[nj][1] * rstd * gg[1] + gb[1] + bv1, o2 = acc[nj][2] * rstd * gg[2] + gb[2] + bv2, o3 = acc[nj][3] * rstd * gg[3] + gb[3] + bv3;
            uint2 w; w.x = pk2(o0 * siluf_(g0), o1 * siluf_(g1)); w.y = pk2(o2 * siluf_(g2), o3 * siluf_(g3));
            *(uint2*)(MIX + row * DM + CW + SBW + h * HD + j0) = w;
        }
    }
}

constexpr int N_ATT_JOBS = BATCH * NH * 8, N_CONV_JOBS = BATCH * (SEQ / 64), N_CHAINS = BATCH * NH;
__device__ __forceinline__ void run_side_job(const Params& p, int l, int id, unsigned char* lds) {
    if (id < N_ATT_JOBS) attn_wg_job(p, id, lds); else conv_job64(p, l, id - N_ATT_JOBS, lds);
}
__device__ void phase_mix1(const Params& p, int l, unsigned char* lds) {
    rwkv_b1_phase(p, l, lds);
    if (!defer_layer1_weights()) for (int id = blockIdx.x; id < N_ATT_JOBS + N_CONV_JOBS; id += gridDim.x) run_side_job(p, l, id, lds);
}
__device__ void phase_mix2(const Params& p, int l, unsigned char* lds) {
    const int G = gridDim.x, w = blockIdx.x, NJ = N_ATT_JOBS + N_CONV_JOBS;
    if (!defer_layer1_weights()) { for (int job = w; job < N_CHAINS; job += G) rwkv_b2_job(p, job, lds); return; }
    const bool prep = l + 1 < DEPTH;
    const int nlow = prep ? 5 : 4;
    if (w < N_CHAINS) {
        rwkv_b2_job(p, w, lds);
        for (int s_ = 0; s_ < nlow; ++s_) { const int id = s_ * N_CHAINS + w; if (id < NJ) run_side_job(p, l, id, lds); }
    } else {
        if (prep) prep_weights(p, l + 1, lds, w - N_CHAINS, G - N_CHAINS);
        for (int id = nlow * N_CHAINS + (w - N_CHAINS); id < NJ; id += G - N_CHAINS) run_side_job(p, l, id, lds);
    }
}
__device__ void phase_mix3(const Params& p, int l, unsigned char* lds) {
    rwkv_b3_phase(p, l);
}

#define LAS __attribute__((address_space(3)))
#define XB_TMO      128
#define XB_XCNT(j)  (256  + 64 * (j))
#define XB_XSUB(j)  (1280 + 64 * (j))
#define XB_XGEN(j)  (2304 + 64 * (j))
#define XB_TOP      3328
#define XB_TOPGEN   3392
#define XCD_BAR_WORDS 3456
#define XB_SPIN_CAP (1u << 18)

__device__ __forceinline__ unsigned xb_ld(unsigned* p)              { return __hip_atomic_load(p, __ATOMIC_RELAXED, __HIP_MEMORY_SCOPE_AGENT); }
__device__ __forceinline__ unsigned xb_add(unsigned* p, unsigned v) { return __hip_atomic_fetch_add(p, v, __ATOMIC_RELAXED, __HIP_MEMORY_SCOPE_AGENT); }
__device__ __forceinline__ unsigned xb_xcc_id() { return (unsigned)__builtin_amdgcn_s_getreg((3 << 11) | 20) & 0xFu; }
#define XB_SPIN(cond, bar) do { unsigned _sp = 0; while (cond) { __builtin_amdgcn_s_sleep(1); \
    if ((++_sp & 255u) == 0u) { if (xb_ld(&(bar)[XB_TMO])) break; if (_sp > XB_SPIN_CAP) { atomicAdd(&(bar)[XB_TMO], 1u); break; } } } } while (0)

struct XcdBarrier {
    unsigned* bar; unsigned x;
    volatile LAS unsigned* st;
};

__device__ __forceinline__ XcdBarrier xcd_barrier_post(unsigned* bar, volatile LAS unsigned* st) {
    XcdBarrier b; b.bar = bar; b.x = xb_xcc_id(); b.st = st;
    if (threadIdx.x == 0) (void)xb_add(&bar[XB_XCNT(b.x)], 1u);
    return b;
}
__device__ __forceinline__ void xcd_barrier_complete(unsigned* bar, unsigned x, unsigned& nloc, unsigned& nx) {
    const unsigned G = gridDim.x * gridDim.y * gridDim.z;
    unsigned sum, cnt, mine, sp = 0u;
    for (;;) {
        sum = 0u; cnt = 0u; mine = 0u;
#pragma unroll
        for (unsigned j = 0; j < 16; ++j) { const unsigned c = xb_ld(&bar[XB_XCNT(j)]); sum += c; cnt += (c > 0u) ? 1u : 0u; mine = (j == x) ? c : mine; }
        if (sum == G) break;
        __builtin_amdgcn_s_sleep(1);
        if ((++sp & 255u) == 0u) { if (xb_ld(&bar[XB_TMO])) break; if (sp > XB_SPIN_CAP) { atomicAdd(&bar[XB_TMO], 1u); break; } }
    }
    nloc = mine > 0u ? mine : 1u; nx = cnt > 0u ? cnt : 1u;
}

__device__ __forceinline__ void xcd_barrier(const XcdBarrier& b) {
    asm volatile("s_waitcnt vmcnt(0)" ::: "memory");
    __syncthreads();
    if (threadIdx.x == 0) {
        unsigned* bar = b.bar;
        __builtin_amdgcn_s_waitcnt(0);
        unsigned nloc = b.st[0], nx = b.st[1];
        if (nloc == 0u) { xcd_barrier_complete(bar, b.x, nloc, nx); b.st[0] = nloc; b.st[1] = nx; }
        const unsigned old = xb_add(&bar[XB_XSUB(b.x)], 1u);
        const unsigned gen = old / nloc;
        if (old + 1u == (gen + 1u) * nloc) {
            __builtin_amdgcn_fence(__ATOMIC_RELEASE, "agent");
            asm volatile("s_waitcnt vmcnt(0)" ::: "memory");
            const unsigned og = xb_add(&bar[XB_TOP], 1u);
            const unsigned tg = og / nx;
            if (og + 1u == (tg + 1u) * nx) xb_add(&bar[XB_TOPGEN], 1u);
            else XB_SPIN(xb_ld(&bar[XB_TOPGEN]) == tg, bar);
            __builtin_amdgcn_fence(__ATOMIC_ACQUIRE, "agent");
            xb_add(&bar[XB_XGEN(b.x)], 1u);
            asm volatile("s_waitcnt vmcnt(0)" ::: "memory");
        } else {
            XB_SPIN(xb_ld(&bar[XB_XGEN(b.x)]) == gen, bar);
            __builtin_amdgcn_fence(__ATOMIC_ACQUIRE, "agent");
            asm volatile("s_waitcnt vmcnt(0)" ::: "memory");
        }
    }
    __syncthreads();
}

constexpr int PH_PER_LAYER = 6;
constexpr int N_PHASES = 1 + PH_PER_LAYER * DEPTH;
__device__ __forceinline__ void run_phase(const Params& p, int ph, unsigned char* lds) {
    unsigned char* ws = p.ws;
    if (ph == 0) { phase_prologue(p, lds); return; }
    const int l = (ph - 1) / PH_PER_LAYER, k = (ph - 1) % PH_PER_LAYER;
    if (k == 0) {
        EpiInProjP E{(bf16_t*)(ws + WS_PC), (bf16_t*)(ws + WS_PS), (bf16_t*)(ws + WS_PR), (bf16_t*)(ws + WS_PG), (bf16_t*)(ws + WS_VT)};
        pg8::Gemm g{(const bf16_t*)(ws + WS_XB), (const bf16_t*)(ws + WS_WIN) + (size_t)l * NINT * DM, M, NINT, DM}; pg8::StaticOrder S; S.init(M, NINT, (int)gridDim.x, (int)blockIdx.x);
        pg8::gemm_phase<EpiInProjP, pg8::StaticOrder, true, true>((PG8_LAS unsigned char*)lds, g, S, E);
    } else if (k == 1) {
        phase_mix1(p, l, lds);
    } else if (k == 2) {
        phase_mix2(p, l, lds);
    } else if (k == 3) {
        phase_mix3(p, l, lds);
    } else if (k == 4) {
        EpiOutBf16P E{(bf16_t*)(ws + WS_Y), DM};
        pg8::Gemm g{(const bf16_t*)(ws + WS_MIX), (const bf16_t*)(ws + WS_WOUT) + (size_t)l * DM * DM, M, DM, DM}; pg8::StaticOrder S; S.init(M, DM, (int)gridDim.x, (int)blockIdx.x);
        pg8::gemm_phase<EpiOutBf16P, pg8::StaticOrder, true, true>((PG8_LAS unsigned char*)lds, g, S, E);
    } else {
        phase_rowpass(l == 0 ? p.in[0] : p.out, (const bf16_t*)(ws + WS_Y), p.in[2] + l * DM, p.out, l + 1 < DEPTH ? (bf16_t*)(ws + WS_XB) : nullptr);
    }
}

static_assert(10 * TILE_B + 64 * AABS * 4 + 128 * XTS * 4 + 64 * 4 + 4 * 16 * 17 * 4 <= 147456, "B1 LDS map");
constexpr int LDS_BYTES = 147456 + 256;

constexpr int MISC_OFF = 147456;
#if MK_COOP == 2
__global__ void __launch_bounds__(512, 2) fwd_kernel(Params p) {
    extern __shared__ __attribute__((aligned(16))) unsigned char lds[];
    volatile LAS unsigned* misc = (volatile LAS unsigned*)((LAS unsigned char*)lds + MISC_OFF);
    if (threadIdx.x < 16) misc[threadIdx.x] = 0u;
    __syncthreads();
    XcdBarrier bar = xcd_barrier_post((unsigned*)(p.ws + WS_CTL), misc);
    for (int ph = p.ph_lo; ph < p.ph_hi; ++ph) {
        run_phase(p, ph, lds);
        if (ph + 1 < p.ph_hi) xcd_barrier(bar);
    }
}
#elif MK_COOP == 1
__global__ void __launch_bounds__(512, 2) fwd_kernel(Params p) {
    extern __shared__ __attribute__((aligned(16))) unsigned char lds[];
    cg::grid_group grid = cg::this_grid();
    for (int ph = p.ph_lo; ph < p.ph_hi; ++ph) {
        run_phase(p, ph, lds);
        if (ph + 1 < p.ph_hi) grid.sync();
    }
}
#else
__global__ void __launch_bounds__(512, 2) fwd_kernel(Params p) {
    extern __shared__ __attribute__((aligned(16))) unsigned char lds[];
    for (int ph = p.ph_lo; ph < p.ph_hi; ++ph) run_phase(p, ph, lds);
}
#endif

extern "C" void kernel_launch(void* const* d_in, const int* in_sizes, int n_in, void* d_out, int out_size, void* d_ws, size_t ws_size, hipStream_t stream) {
    static int grid = 0;
    if (grid == 0) {
        if (n_in != 24 || out_size != M * DM || ws_size < WS_END) { fprintf(stderr, "kernel_launch: unexpected problem (n_in %d out %d ws %zu)\n", n_in, out_size, ws_size); grid = -1; return; }
        int dev = 0, cus = 0, per_cu = 0;
        hipGetDevice(&dev); hipDeviceGetAttribute(&cus, hipDeviceAttributeMultiprocessorCount, dev);
        hipFuncSetAttribute((const void*)fwd_kernel, hipFuncAttributeMaxDynamicSharedMemorySize, LDS_BYTES);
        hipOccupancyMaxActiveBlocksPerMultiprocessor(&per_cu, (const void*)fwd_kernel, 512, LDS_BYTES);
        if (per_cu < 1) { fprintf(stderr, "kernel_launch: occupancy query says %d blocks per CU\n", per_cu); per_cu = 1; }
        grid = cus;
        (void)hipGetLastError();
    }
    if (grid < 0) return;
    Params p{};
    for (int i = 0; i < 24; ++i) p.in[i] = (const float*)d_in[i];
    p.out = (float*)d_out; p.ws = (unsigned char*)d_ws;
#if MK_COOP == 2
    p.ph_lo = 0; p.ph_hi = N_PHASES;
    if (hipMemsetAsync((char*)d_ws + WS_CTL, 0, XCD_BAR_WORDS * 4, stream) != hipSuccess) { fprintf(stderr, "kernel_launch: memset of the barrier words failed\n"); return; }
    hipLaunchKernelGGL(fwd_kernel, dim3(grid), dim3(512), LDS_BYTES, stream, p);
#elif MK_COOP == 1
    p.ph_lo = 0; p.ph_hi = N_PHASES;
    void* args[] = {&p};
    hipError_t e = hipLaunchCooperativeKernel((const void*)fwd_kernel, dim3(grid), dim3(512), args, LDS_BYTES, stream);
    if (e != hipSuccess) fprintf(stderr, "cooperative launch failed: %s (grid %d)\n", hipGetErrorString(e), grid);
#else
    for (int ph = 0; ph < N_PHASES; ++ph) {
        p.ph_lo = ph; p.ph_hi = ph + 1;
        hipLaunchKernelGGL(fwd_kernel, dim3(grid), dim3(512), LDS_BYTES, stream, p);
    }
#endif
}
```

```cpp
#include <hip/hip_runtime.h>
#include <hip/hip_cooperative_groups.h>
#include <cstdio>
#include <cstdint>
namespace cg = cooperative_groups;

#ifndef MK_COOP
#define MK_COOP 2
#endif

constexpr int BATCH = 16, SEQ = 2048, DM = 1024, DEPTH = 2;
constexpr int M = BATCH * SEQ;
constexpr int HD = 64, NH = 6;
constexpr int CW = 256, SBW = 384, RWW = 384, LORA = 32, TAPS = 31;
constexpr int DIN = 3904;
constexpr int NINT = 4096;
constexpr int PC_W = 768, PS_W = 1152, PR_W = 1280, PG_W = 384;
constexpr float RMS_EPS = 1e-6f, LN_EPS = 1e-5f, GN_EPS = 64e-5f;

typedef unsigned short bf16_t;
typedef short bf16x8 __attribute__((ext_vector_type(8)));
typedef float f32x4 __attribute__((ext_vector_type(4)));
typedef unsigned short us4 __attribute__((ext_vector_type(4)));

constexpr size_t MiB = 1u << 20;
constexpr size_t WS_CTL = 0;
constexpr size_t WS_WPW = 512 * 1024;
constexpr size_t WS_WIN = 1 * MiB;
constexpr size_t WS_WOUT = 17 * MiB;
constexpr size_t WS_XB = 21 * MiB;
constexpr size_t WS_MIX = WS_XB;
constexpr size_t WS_PC = 85 * MiB;
constexpr size_t WS_PS = 133 * MiB;
constexpr size_t WS_VT = 205 * MiB;
constexpr size_t WS_Y = WS_PC;
constexpr size_t WS_PR = 229 * MiB;
constexpr size_t WS_PG = 309 * MiB;
constexpr size_t WS_VF = 333 * MiB;
constexpr size_t WS_CH = 381 * MiB;
constexpr size_t CH_SZ = (size_t)3072 * 4096 * 2;
constexpr size_t WS_CH_M = WS_CH, WS_CH_NT = WS_CH + CH_SZ, WS_CH_G = WS_CH + 2 * CH_SZ, WS_CH_Y1T = WS_CH + 3 * CH_SZ, WS_CH_BV = WS_CH + 4 * CH_SZ;
constexpr size_t WS_ZT = WS_PR;
constexpr size_t WS_LRT = 501 * MiB;
constexpr int LRT_N = DEPTH * 3 * NH * 4 * 64;
constexpr size_t WS_END = 502 * MiB;

struct Params {
    const float* in[24];
    float* out;
    unsigned char* ws;
    int ph_lo, ph_hi;
};

__device__ __forceinline__ float bf2f(bf16_t v) { return __uint_as_float(((unsigned)v) << 16); }
typedef float f32x2_t __attribute__((ext_vector_type(2)));
typedef __bf16 bf16x2_t __attribute__((ext_vector_type(2)));
__device__ __forceinline__ float bfl(unsigned w) { return __uint_as_float(w << 16); }
__device__ __forceinline__ float bfh(unsigned w) { return __uint_as_float(w & 0xffff0000u); }
__device__ __forceinline__ unsigned pk2(float lo, float hi) { f32x2_t v = {lo, hi}; bf16x2_t b = __builtin_convertvector(v, bf16x2_t); return __builtin_bit_cast(unsigned, b); }
__device__ __forceinline__ bf16_t f2bf(float f) { return (bf16_t)(pk2(f, f) & 0xffffu); }
__device__ __forceinline__ float wave_sum(float v) {
#pragma unroll
    for (int o = 1; o < 64; o <<= 1) v += __shfl_xor(v, o);
    return v;
}
__device__ __forceinline__ float sigmoidf_(float x) { return __builtin_amdgcn_rcpf(1.0f + __builtin_amdgcn_exp2f(-1.4426950408889634f * x)); }
__device__ __forceinline__ float siluf_(float x) { return x * __builtin_amdgcn_rcpf(1.0f + __builtin_amdgcn_exp2f(-1.4426950408889634f * x)); }
__device__ __forceinline__ int tid_() { int t = threadIdx.x; asm volatile("" : "+v"(t)); return t; }
typedef unsigned u32x2_t __attribute__((ext_vector_type(2)));
typedef unsigned u32x4_t __attribute__((ext_vector_type(4)));
__device__ __forceinline__ uint4 ldnt_u4(const void* p) { const u32x4_t v = __builtin_nontemporal_load((const u32x4_t*)p); uint4 r; r.x = v[0]; r.y = v[1]; r.z = v[2]; r.w = v[3]; return r; }
__device__ __forceinline__ void stnt_u4(void* p, const uint4& v) { const u32x4_t w = {v.x, v.y, v.z, v.w}; __builtin_nontemporal_store(w, (u32x4_t*)p); }
__device__ __forceinline__ void stnt_u2v(void* p, const uint2& v) { const u32x2_t w = {v.x, v.y}; __builtin_nontemporal_store(w, (u32x2_t*)p); }
__device__ __forceinline__ uint2 ldnt_u2(const void* p) { const u32x2_t v = __builtin_nontemporal_load((const u32x2_t*)p); uint2 r; r.x = v[0]; r.y = v[1]; return r; }

__device__ __forceinline__ int orig_col(int n) { return n < 3520 ? n : (n < 3584 ? -1 : (n < 3968 ? n - 64 : -1)); }

__host__ __device__ __forceinline__ int wide_row(int n) { return (n & ~255) + 128 * ((n >> 5) & 1) + 32 * ((n >> 6) & 3) + (n & 31); }
struct TDesc { const float* W; const float* gain; bf16_t* WT; int ldw, ncol, K, n0, k0; bool permute, skip, wide; };
__device__ __forceinline__ void tt_load(const TDesc& d, int tid, float (&v)[8]) {
#pragma unroll
    for (int i = 0; i < 8; ++i) {
        const int kl = (tid >> 6) + 8 * i, nl = tid & 63, n = d.n0 + nl, k = d.k0 + kl;
        const int oc = d.permute ? orig_col(n) : n;
        v[i] = 0.f;
        if (oc >= 0 && oc < d.ncol) v[i] = d.W[(size_t)k * d.ldw + oc];
    }
}
__device__ __forceinline__ void tt_to_lds(const TDesc& d, int tid, const float (&v)[8], float* tile  ) {
#pragma unroll
    for (int i = 0; i < 8; ++i) {
        const int kl = (tid >> 6) + 8 * i, nl = tid & 63, n = d.n0 + nl;
        float x = v[i] * (d.gain ? d.gain[d.k0 + kl] : 1.0f);
        if (d.permute && n >= 768 && n < 1152) x *= 0.125f * 1.4426950408889634f;
        tile[kl * 65 + nl] = x;
    }
}
__device__ __forceinline__ void tt_store(const TDesc& d, int tid, const float* tile) {
#pragma unroll
    for (int i = 0; i < 4; ++i) {
        const int nl = (tid >> 5) + 16 * i, kp = tid & 31;
        if (!(d.skip && d.n0 + nl >= 3520 && d.n0 + nl < 3584)) *(unsigned*)(d.WT + (size_t)(d.wide ? wide_row(d.n0 + nl) : d.n0 + nl) * d.K + d.k0 + 2 * kp) = pk2(tile[(2 * kp) * 65 + nl], tile[(2 * kp + 1) * 65 + nl]);
    }
}
__device__ void fold_v1_rows(const Params& p, int l, bf16_t* WinT_l, float* scr, int worker, int nworkers) {
    const int tid = tid_(), lane = tid & 63, wave = __builtin_amdgcn_readfirstlane(tid >> 6);
    const float* W = p.in[3] + (size_t)l * DM * DIN; const float* gain = p.in[1] + l * DM; const float* v1 = p.in[22] + (size_t)(l - 1) * RWW * LORA; const float* muv = p.in[11] + l * 1216 + 768;
    float* V1c = scr;
    float* Wr = scr + RWW * 64 + wave * RWW;
    for (int idx = tid; idx < RWW * 64; idx += 512) { const int c = idx >> 6, o = idx & 63; const float m = muv[c]; V1c[idx] = (o >= 32 ? m : 1.0f - m) * v1[c * LORA + (o & 31)]; }
    __syncthreads();
    for (int k = worker * 8 + wave; k < DM; k += nworkers * 8) {
        const float* wr = W + (size_t)k * DIN + 3072;
#pragma unroll
        for (int i = 0; i < 6; ++i) Wr[lane + 64 * i] = wr[lane + 64 * i];
        asm volatile("s_waitcnt lgkmcnt(0)" ::: "memory");
        float a0 = 0.f, a1 = 0.f, a2 = 0.f, a3 = 0.f;
#pragma unroll 4
        for (int c4 = 0; c4 < RWW / 4; ++c4) { const f32x4 w = *(const f32x4*)(Wr + 4 * c4);
            a0 += w[0] * V1c[(4 * c4) * 64 + lane]; a1 += w[1] * V1c[(4 * c4 + 1) * 64 + lane]; a2 += w[2] * V1c[(4 * c4 + 2) * 64 + lane]; a3 += w[3] * V1c[(4 * c4 + 3) * 64 + lane]; }
        WinT_l[(size_t)wide_row(3520 + lane) * DM + k] = f2bf(((a0 + a1) + (a2 + a3)) * gain[k]);
        asm volatile("s_waitcnt lgkmcnt(0)" ::: "memory");
    }
    __syncthreads();
}
__device__ __forceinline__ TDesc tile_desc(const Params& p, int l, int j) {
    constexpr int nt_in = (NINT / 64) * (DM / 64), nt_out = (DM / 64) * (DM / 64);
    TDesc d;
    if (j < nt_in) { d.W = p.in[3] + (size_t)l * DM * DIN; d.gain = p.in[1] + l * DM; d.WT = (bf16_t*)(p.ws + WS_WIN) + (size_t)l * NINT * DM; d.ldw = DIN; d.ncol = DIN; d.K = DM; d.n0 = (j / (DM / 64)) * 64; d.k0 = (j % (DM / 64)) * 64; d.permute = true; d.skip = l > 0; d.wide = true; }
    else if (j < nt_in + nt_out) { const int r = j - nt_in; d.W = p.in[4] + (size_t)l * DM * DM; d.gain = nullptr; d.WT = (bf16_t*)(p.ws + WS_WOUT) + (size_t)l * DM * DM; d.ldw = DM; d.ncol = DM; d.K = DM; d.n0 = (r / (DM / 64)) * 64; d.k0 = (r % (DM / 64)) * 64; d.permute = false; d.skip = false; d.wide = true; }
    else { const int r = j - nt_in - nt_out; d.W = p.in[9] + (size_t)l * CW * CW; d.gain = nullptr; d.WT = (bf16_t*)(p.ws + WS_WPW) + (size_t)l * CW * CW; d.ldw = CW; d.ncol = CW; d.K = CW; d.n0 = (r >> 2) * 64; d.k0 = (r & 3) * 64; d.permute = false; d.skip = false; d.wide = false; }
    return d;
}
__device__ void prep_weights(const Params& p, int l, unsigned char* lds, int worker, int nworkers) {
    float* tile = (float*)lds;
    constexpr int NT = (NINT / 64) * (DM / 64) + (DM / 64) * (DM / 64) + (CW / 64) * (CW / 64), TILE_F = 64 * 65 + 32;
    const int tid = tid_();
    int j = worker, buf = 0;
    TDesc dc; float vc[8];
    if (j < NT) { dc = tile_desc(p, l, j); tt_load(dc, tid, vc); }
#pragma unroll 1
    for (; j < NT; j += nworkers) {
        const bool hn = j + nworkers < NT;
        TDesc dn = dc; float vn[8];
        if (hn) { dn = tile_desc(p, l, j + nworkers); tt_load(dn, tid, vn); }
        tt_to_lds(dc, tid, vc, tile + buf * TILE_F);
        __syncthreads();
        tt_store(dc, tid, tile + buf * TILE_F);
        buf ^= 1;
        if (hn) { dc = dn;
#pragma unroll
            for (int i = 0; i < 8; ++i) vc[i] = vn[i]; }
    }
    __syncthreads();
    if (l > 0) fold_v1_rows(p, l, (bf16_t*)(p.ws + WS_WIN) + (size_t)l * NINT * DM, tile, worker, nworkers);
}

__device__ void rows_to_xb(const float* X, bf16_t* XB) {
    const int tid = tid_(), lane = tid & 63, wave = __builtin_amdgcn_readfirstlane(tid >> 6);
    for (int row = blockIdx.x * 8 + wave; row < M; row += gridDim.x * 8) {
        const float* xr = X + (size_t)row * DM;
        f32x4 v[4]; float ss = 0.f;
#pragma unroll
        for (int i = 0; i < 4; ++i) { v[i] = __builtin_nontemporal_load((const f32x4*)(xr + i * 256 + lane * 4)); ss += v[i][0] * v[i][0] + v[i][1] * v[i][1] + v[i][2] * v[i][2] + v[i][3] * v[i][3]; }
        ss = wave_sum(ss);
        const float rstd = rsqrtf(ss * (1.0f / DM) + RMS_EPS);
#pragma unroll
        for (int i = 0; i < 4; ++i) { uint2 w; w.x = pk2(v[i][0] * rstd, v[i][1] * rstd); w.y = pk2(v[i][2] * rstd, v[i][3] * rstd); *(uint2*)(XB + (size_t)row * DM + i * 256 + lane * 4) = w; }
    }
}

__device__ __forceinline__ bool defer_layer1_weights() { return gridDim.x >= BATCH * NH + 32; }
__device__ void phase_prologue(const Params& p, unsigned char* lds) {
    prep_weights(p, 0, lds, blockIdx.x, gridDim.x);
    if (!defer_layer1_weights()) for (int l = 1; l < DEPTH; ++l) prep_weights(p, l, lds, blockIdx.x, gridDim.x);
    for (int e = blockIdx.x * 512 + tid_(); e < LRT_N; e += gridDim.x * 512) {
        const int ln = e & 63, tj = (e >> 6) & 3, hk = e >> 8, h = hk % NH, lk = hk / NH, Lk = lk % 3, l = lk / 3, fr = ln & 15, fq = ln >> 4;
        uint4 hi = {0u, 0u, 0u, 0u}, lo = hi;
        if (Lk < 2 || l > 0) {
            const float* src = (Lk == 0 ? p.in[13] + (size_t)l * LORA * RWW : (Lk == 1 ? p.in[15] + (size_t)l * LORA * RWW : p.in[23])) + (size_t)(8 * fq) * RWW + h * HD + tj * 16 + fr;
            float v[8]; unsigned uh[4], ul[4];
#pragma unroll
            for (int kk = 0; kk < 8; ++kk) v[kk] = src[(size_t)kk * RWW];
#pragma unroll
            for (int jj = 0; jj < 4; ++jj) { uh[jj] = pk2(v[2 * jj], v[2 * jj + 1]); ul[jj] = pk2(v[2 * jj] - bfl(uh[jj]), v[2 * jj + 1] - bfh(uh[jj])); }
            hi = (uint4){uh[0], uh[1], uh[2], uh[3]}; lo = (uint4){ul[0], ul[1], ul[2], ul[3]};
        }
        ((uint4*)(p.ws + WS_LRT))[e] = hi; ((uint4*)(p.ws + WS_LRT))[LRT_N + e] = lo;
    }
    rows_to_xb(p.in[0], (bf16_t*)(p.ws + WS_XB));
}

namespace pg8 {
#define PG8_LAS __attribute__((address_space(3)))
typedef unsigned short bf16_t;
typedef short bf16x8 __attribute__((ext_vector_type(8)));
typedef float f32x4 __attribute__((ext_vector_type(4)));
typedef unsigned u32x4 __attribute__((ext_vector_type(4)));
constexpr int BM = 256, BK = 64, HALF = 128, HTB = HALF * BK * 2  , STAGE_BYTES = 8 * HTB, NXCD = 8, WGM = 4;

__host__ __device__ __forceinline__ int lds_byte(int r, int c) { const int st = (r >> 4) * 2 + (c >> 5), rr = r & 15, cc = c & 31, ob = rr * 64 + cc * 2; return st * 1024 + (ob ^ (((ob >> 9) & 1) << 5)); }
__host__ __device__ __forceinline__ void stage_rc(int b, int& R, int& C) { const int st = b / 1024, sb = b % 1024, swz = sb ^ (((sb >> 9) & 1) << 5); R = (st >> 1) * 16 + swz / 64; C = (st & 1) * 32 + (swz % 64) / 2; }
__host__ __device__ __forceinline__ int perm32(int rho) { const int n = rho >> 4, i = rho & 15; return 8 * (i >> 2) + 4 * n + (i & 3); }

struct Unit { int pm, pn; };
struct Gemm { const bf16_t* A; const bf16_t* Bt; int M, N, K; };

struct StaticOrder {
    int nM, nN, nwg, G, c;
    __host__ __device__ void init(int M, int N, int G_, int c_) { nM = M / BM; nN = N / BM; nwg = nM * nN; G = G_; c = c_; }
    __host__ __device__ bool next(int i, Unit& u) const {
        const long L = (long)i * G + c; if (L >= nwg) return false;
        int wgid = (int)L; { const int q = nwg / NXCD, r = nwg % NXCD, xcd = wgid % NXCD, off = wgid / NXCD; wgid = (xcd < r ? xcd * (q + 1) : r * (q + 1) + (xcd - r) * q) + off; }
        const int nig = WGM * nN, gid = wgid / nig, fm = gid * WGM, gsz = (nM - fm) < WGM ? (nM - fm) : WGM;
        u.pm = fm + ((wgid % nig) % gsz); u.pn = (wgid % nig) / gsz; return true;
    }
    __device__ __forceinline__ void a_ready(const Unit&) const {}
    __device__ __forceinline__ void done(const Unit&) const {}
};


__device__ __forceinline__ unsigned cvt_pk_bf16(float lo, float hi) { unsigned r; asm volatile("v_cvt_pk_bf16_f32 %0, %1, %2" : "=v"(r) : "v"(lo), "v"(hi)); return r; }

template <class Epi, class Sched, bool ALIGN_EPI = false, bool SP2 = false>
__device__ __forceinline__ void gemm_phase(PG8_LAS unsigned char* lds, const Gemm g, const Sched& S, const Epi& E) {
    const int tid = tid_(), wid = __builtin_amdgcn_readfirstlane(tid >> 6), lane = tid & 63, wr = wid >> 2, wc = wid & 3, fr = lane & 15, fq = lane >> 4;
    const int K = g.K, nt = K / BK;
    unsigned voffA[2], voffB[2];
#pragma unroll
    for (int i = 0; i < 2; ++i) { int R, C; stage_rc(tid * 16 + i * 8192, R, C); const int Rb = Epi::PERM ? ((R & ~31) + perm32(R & 31)) : R;
        voffA[i] = (unsigned)(R * K + C) * 2u; voffB[i] = (unsigned)(Rb * K + C) * 2u; }
    const size_t kstep = (size_t)(BK * 2);
    const size_t hstep = (size_t)HALF * K * 2;
    const size_t tstep = 2 * hstep;
    const unsigned ldsw = (unsigned)wid * 1024u;
    const int aoff = lds_byte(wr * 64 + fr, fq * 8), boff = lds_byte(wc * 32 + fr, fq * 8);
#define PG8_SA(b, h) (((b) * 2 + (h)) * HTB)
#define PG8_SB(b, h) ((4 + (b) * 2 + (h)) * HTB)
#define PG8_STAGE(bufoff, gbase, voff) do { _Pragma("unroll") for (int _i = 0; _i < 2; ++_i) \
        __builtin_amdgcn_global_load_lds((const unsigned*)((const char*)(gbase) + (voff)[_i]), (PG8_LAS unsigned*)(lds + (bufoff) + ldsw + _i * 8192), 16, 0, 0); } while (0)
#define PG8_LDA(dst, b, h) do { _Pragma("unroll") for (int m = 0; m < 4; ++m) _Pragma("unroll") for (int k = 0; k < 2; ++k) dst[m][k] = *(const PG8_LAS bf16x8*)(lds + PG8_SA(b, h) + aoff + m * 2048 + k * 1024); } while (0)
#define PG8_LDB(dst, b, h) do { _Pragma("unroll") for (int n = 0; n < 2; ++n) _Pragma("unroll") for (int k = 0; k < 2; ++k) dst[n][k] = *(const PG8_LAS bf16x8*)(lds + PG8_SB(b, h) + boff + n * 2048 + k * 1024); } while (0)
#define PG8_MMA(ai, bj, At, Bt) do { __builtin_amdgcn_s_setprio(1); _Pragma("unroll") for (int m = 0; m < 4; ++m) _Pragma("unroll") for (int n = 0; n < 2; ++n) _Pragma("unroll") for (int k = 0; k < 2; ++k) \
        acc[ai][bj][m][n] = __builtin_amdgcn_mfma_f32_16x16x32_bf16(Bt[n][k], At[m][k], acc[ai][bj][m][n], 0, 0, 0); __builtin_amdgcn_s_setprio(0); } while (0)
#define PG8_WAIT_V(n) asm volatile("s_waitcnt vmcnt(" #n ")" ::: "memory")
#define PG8_WAIT_L(n) asm volatile("s_waitcnt lgkmcnt(" #n ")" ::: "memory")
#define PG8_BAR __builtin_amdgcn_s_barrier()
#define PG8_SCHED __builtin_amdgcn_sched_barrier(0)
    Unit cur, nxt; int ui = 0;
    if (!S.next(0, cur)) return;
    f32x4 acc[2][2][4][2];
#pragma unroll
    for (int a = 0; a < 2; ++a)
#pragma unroll
        for (int b = 0; b < 2; ++b)
#pragma unroll
            for (int m = 0; m < 4; ++m)
#pragma unroll
                for (int n = 0; n < 2; ++n) acc[a][b][m][n] = (f32x4){0.f, 0.f, 0.f, 0.f};
    bf16x8 At[4][2], B0[2][2], B1[2][2];
    const char* cA = (const char*)g.A + (size_t)cur.pm * tstep; const char* cB = (const char*)g.Bt + (size_t)cur.pn * tstep;
    S.a_ready(cur);
    if constexpr (SP2) {
        PG8_STAGE(PG8_SB(0, 0), cB, voffB); PG8_STAGE(PG8_SB(0, 1), cB + hstep, voffB); PG8_STAGE(PG8_SA(0, 0), cA, voffA); PG8_STAGE(PG8_SA(0, 1), cA + hstep, voffA);
        if (wr == 1) PG8_BAR;
        PG8_WAIT_V(2); PG8_BAR;
        PG8_STAGE(PG8_SB(1, 0), cB + kstep, voffB); PG8_STAGE(PG8_SA(1, 0), cA + kstep, voffA); PG8_STAGE(PG8_SB(1, 1), cB + hstep + kstep, voffB);
        PG8_WAIT_V(6); PG8_BAR;
    } else {
        PG8_STAGE(PG8_SB(0, 0), cB, voffB); PG8_STAGE(PG8_SA(0, 0), cA, voffA); PG8_STAGE(PG8_SB(0, 1), cB + hstep, voffB); PG8_STAGE(PG8_SA(0, 1), cA + hstep, voffA);
        if (wr == 1) PG8_BAR;
        PG8_WAIT_V(4); PG8_BAR;
        PG8_STAGE(PG8_SB(1, 0), cB + kstep, voffB); PG8_STAGE(PG8_SA(1, 0), cA + kstep, voffA); PG8_STAGE(PG8_SB(1, 1), cB + hstep + kstep, voffB);
        PG8_WAIT_V(6); PG8_BAR;
    }
    for (;;) {
        const bool has_next = S.next(ui + 1, nxt);
        const char* nA = has_next ? (const char*)g.A + (size_t)nxt.pm * tstep : cA; const char* nB = has_next ? (const char*)g.Bt + (size_t)nxt.pn * tstep : cB;
        for (int t = 0; t < nt; t += 2) {
            const bool last = (t == nt - 2);
            const char* a1 = cA + (size_t)(t + 1) * kstep;
            const char* a2 = last ? nA : cA + (size_t)(t + 2) * kstep; const char* b2 = last ? nB : cB + (size_t)(t + 2) * kstep;
            const char* a3 = a2 + kstep; const char* b3 = b2 + kstep;
            if (last && has_next) S.a_ready(nxt);
            if constexpr (SP2) {
            PG8_LDB(B0, 0, 0); PG8_LDB(B1, 0, 1); PG8_SCHED; PG8_LDA(At, 0, 0); PG8_STAGE(PG8_SA(1, 1), a1 + hstep, voffA);
            PG8_WAIT_V(8); PG8_WAIT_L(0); PG8_BAR; PG8_MMA(0, 0, At, B0); PG8_MMA(0, 1, At, B1); PG8_BAR; PG8_SCHED;
            PG8_LDA(At, 0, 1); PG8_STAGE(PG8_SB(0, 0), b2, voffB); PG8_STAGE(PG8_SB(0, 1), b2 + hstep, voffB); PG8_STAGE(PG8_SA(0, 0), a2, voffA);
            PG8_WAIT_V(8); PG8_WAIT_L(0); PG8_BAR; PG8_MMA(1, 0, At, B0); PG8_MMA(1, 1, At, B1); PG8_BAR; PG8_SCHED;
            PG8_LDB(B0, 1, 0); PG8_LDB(B1, 1, 1); PG8_SCHED; PG8_LDA(At, 1, 0); PG8_STAGE(PG8_SA(0, 1), a2 + hstep, voffA);
            PG8_WAIT_V(8); PG8_WAIT_L(0); PG8_BAR; PG8_MMA(0, 0, At, B0); PG8_MMA(0, 1, At, B1); PG8_BAR; PG8_SCHED;
            PG8_LDA(At, 1, 1); PG8_STAGE(PG8_SB(1, 0), b3, voffB); PG8_STAGE(PG8_SB(1, 1), b3 + hstep, voffB); PG8_STAGE(PG8_SA(1, 0), a3, voffA);
            PG8_WAIT_V(8); PG8_WAIT_L(0); PG8_BAR; PG8_MMA(1, 0, At, B0); PG8_MMA(1, 1, At, B1); PG8_BAR; PG8_SCHED;
            } else {
            PG8_LDB(B0, 0, 0); PG8_SCHED; PG8_LDA(At, 0, 0); PG8_STAGE(PG8_SA(1, 1), a1 + hstep, voffA);
            PG8_WAIT_L(8); PG8_BAR; PG8_WAIT_L(0); PG8_MMA(0, 0, At, B0); PG8_BAR; PG8_SCHED;
            PG8_LDB(B1, 0, 1); PG8_STAGE(PG8_SB(0, 0), b2, voffB);
            PG8_BAR; PG8_WAIT_L(0); PG8_MMA(0, 1, At, B1); PG8_BAR;
            PG8_LDA(At, 0, 1); PG8_STAGE(PG8_SA(0, 0), a2, voffA);
            PG8_BAR; PG8_WAIT_L(0); PG8_MMA(1, 0, At, B0); PG8_BAR; PG8_SCHED;
            PG8_STAGE(PG8_SB(0, 1), b2 + hstep, voffB);
            PG8_WAIT_V(6); PG8_BAR; PG8_MMA(1, 1, At, B1); PG8_BAR;
            PG8_LDB(B0, 1, 0); PG8_SCHED; PG8_LDA(At, 1, 0); PG8_STAGE(PG8_SA(0, 1), a2 + hstep, voffA);
            PG8_WAIT_L(8); PG8_BAR; PG8_WAIT_L(0); PG8_MMA(0, 0, At, B0); PG8_BAR; PG8_SCHED;
            PG8_LDB(B1, 1, 1); PG8_STAGE(PG8_SB(1, 0), b3, voffB);
            PG8_BAR; PG8_WAIT_L(0); PG8_MMA(0, 1, At, B1); PG8_BAR;
            PG8_LDA(At, 1, 1); PG8_STAGE(PG8_SA(1, 0), a3, voffA);
            PG8_BAR; PG8_WAIT_L(0); PG8_MMA(1, 0, At, B0); PG8_BAR; PG8_SCHED;
            PG8_STAGE(PG8_SB(1, 1), b3 + hstep, voffB);
            PG8_WAIT_V(6); PG8_BAR; PG8_MMA(1, 1, At, B1); PG8_BAR;
            }
        }
        if constexpr (ALIGN_EPI) { if (wr == 0) PG8_BAR; }
        if constexpr (!Epi::AFTER_DRAIN) { E(acc, cur, wr, wc, fr, fq); S.done(cur); }
        if (!has_next) break;
#pragma unroll
        for (int a = 0; a < 2; ++a)
#pragma unroll
            for (int b = 0; b < 2; ++b)
#pragma unroll
                for (int m = 0; m < 4; ++m)
#pragma unroll
                    for (int n = 0; n < 2; ++n) acc[a][b][m][n] = (f32x4){0.f, 0.f, 0.f, 0.f};
        cur = nxt; cA = nA; cB = nB; ++ui;
        if constexpr (ALIGN_EPI) { if (wr == 1) PG8_BAR; }
    }
    PG8_WAIT_V(0);
    if constexpr (!ALIGN_EPI) { if (wr == 0) PG8_BAR; }
    PG8_BAR;
    if constexpr (Epi::AFTER_DRAIN) { E.fused(acc, cur, wr, wc, fr, fq, lds, wid, lane); S.done(cur); }
#undef PG8_SA
#undef PG8_SB
#undef PG8_STAGE
#undef PG8_LDA
#undef PG8_LDB
#undef PG8_MMA
#undef PG8_WAIT_V
#undef PG8_WAIT_L
#undef PG8_BAR
#undef PG8_SCHED
}
}

struct EpiInProjP {
    static constexpr bool PERM = true, AFTER_DRAIN = false;
    bf16_t *PC, *PS, *PR, *PG, *VT; unsigned char* spare;
    __device__ __forceinline__ void operator()(const pg8::f32x4 (&acc)[2][2][4][2], const pg8::Unit& u, int wr, int wc, int fr, int fq) const {
        const int row0 = u.pm * 256 + wr * 64 + fr;
        const int blk = 2 * u.pn + (wc >> 1), cw = 64 * (wc & 1);
        bf16_t* base; int ld, c0;
        if (blk >= 12 && blk < 15) {
#pragma unroll
            for (int bj = 0; bj < 2; ++bj) {
                const int vc = 128 * (blk - 12) + cw + 32 * bj + 8 * fq;
#pragma unroll
                for (int ai = 0; ai < 2; ++ai)
#pragma unroll
                    for (int m = 0; m < 4; ++m) {
                        const int row = row0 + ai * 128 + m * 16, b = row >> 11, t = row & 2047;
#pragma unroll
                        for (int n = 0; n < 2; ++n)
#pragma unroll
                            for (int e = 0; e < 4; ++e) { const int col = vc + 4 * n + e, hh = col >> 6, d = col & 63;
                                VT[((size_t)(b * NH + hh) * HD + d) * SEQ + t] = f2bf(acc[ai][bj][m][n][e]); }
                    }
            }
            return;
        }
        if (blk < 6) { base = PC; ld = PC_W; c0 = 128 * blk; }
        else if (blk < 12) { base = PS; ld = PS_W; c0 = 128 * (blk - 6); }
        else if (blk < 18) { base = PS; ld = PS_W; c0 = 768 + 128 * (blk - 15); }
        else if (blk < 28) { base = PR; ld = PR_W; c0 = 128 * (blk - 18); }
        else if (blk < 31) { base = PG; ld = PG_W; c0 = 128 * (blk - 28); }
        else return;
        bf16_t* slot = (bf16_t*)(spare + (wr * 4 + wc) * 2048);
        const int ln = fq * 16 + fr, r8 = ln >> 3, ch = ln & 7;
        bf16_t* dst = base + (size_t)(u.pm * 256 + wr * 64 + r8) * ld + c0 + cw + ch * 8;
#pragma unroll
        for (int ai = 0; ai < 2; ++ai)
#pragma unroll
            for (int m = 0; m < 4; ++m) {
#pragma unroll
                for (int bj = 0; bj < 2; ++bj) {
                    const pg8::f32x4 v0 = acc[ai][bj][m][0], v1 = acc[ai][bj][m][1]; pg8::u32x4 w;
                    w.x = pg8::cvt_pk_bf16(v0[0], v0[1]); w.y = pg8::cvt_pk_bf16(v0[2], v0[3]); w.z = pg8::cvt_pk_bf16(v1[0], v1[1]); w.w = pg8::cvt_pk_bf16(v1[2], v1[3]);
                    *(pg8::u32x4*)(slot + fr * 64 + (((4 * bj + fq) ^ (fr & 7)) << 3)) = w;
                }
                asm volatile("s_waitcnt lgkmcnt(0)" ::: "memory");
#pragma unroll
                for (int i = 0; i < 2; ++i) {
                    const pg8::u32x4 w = *(const pg8::u32x4*)(slot + (i * 8 + r8) * 64 + ((ch ^ r8) << 3));
                    __builtin_nontemporal_store(w, (pg8::u32x4*)(dst + (size_t)(ai * 128 + m * 16 + i * 8) * ld));
                }
                asm volatile("s_waitcnt lgkmcnt(0)" ::: "memory");
            }
    }
};
struct EpiOutBf16P {
    static constexpr bool PERM = true, AFTER_DRAIN = false;
    bf16_t* Y; int ld; unsigned char* spare;
    __device__ __forceinline__ void operator()(const pg8::f32x4 (&acc)[2][2][4][2], const pg8::Unit& u, int wr, int wc, int fr, int fq) const {
        bf16_t* slot = (bf16_t*)(spare + (wr * 4 + wc) * 2048);
        const int ln = fq * 16 + fr, r8 = ln >> 3, ch = ln & 7;
        bf16_t* dst = Y + (size_t)(u.pm * 256 + wr * 64 + r8) * ld + u.pn * 256 + wc * 64 + ch * 8;
#pragma unroll
        for (int ai = 0; ai < 2; ++ai)
#pragma unroll
            for (int m = 0; m < 4; ++m) {
#pragma unroll
                for (int bj = 0; bj < 2; ++bj) {
                    const pg8::f32x4 v0 = acc[ai][bj][m][0], v1 = acc[ai][bj][m][1]; pg8::u32x4 w;
                    w.x = pg8::cvt_pk_bf16(v0[0], v0[1]); w.y = pg8::cvt_pk_bf16(v0[2], v0[3]); w.z = pg8::cvt_pk_bf16(v1[0], v1[1]); w.w = pg8::cvt_pk_bf16(v1[2], v1[3]);
                    *(pg8::u32x4*)(slot + fr * 64 + (((4 * bj + fq) ^ (fr & 7)) << 3)) = w;
                }
                asm volatile("s_waitcnt lgkmcnt(0)" ::: "memory");
#pragma unroll
                for (int i = 0; i < 2; ++i) {
                    const pg8::u32x4 w = *(const pg8::u32x4*)(slot + (i * 8 + r8) * 64 + ((ch ^ r8) << 3));
                    *(pg8::u32x4*)(dst + (size_t)(ai * 128 + m * 16 + i * 8) * ld) = w;
                }
                asm volatile("s_waitcnt lgkmcnt(0)" ::: "memory");
            }
    }
};

__device__ void phase_rowpass(const float* Xin, const bf16_t* Y, const float* gpost, float* Xout, bf16_t* XB) {
    const int tid = tid_(), lane = tid & 63, wave = __builtin_amdgcn_readfirstlane(tid >> 6);
    const int stride = gridDim.x * 8;
    int row = blockIdx.x * 8 + wave;
    if (row >= M) return;
    f32x4 g[4];
#pragma unroll
    for (int i = 0; i < 4; ++i) g[i] = *(const f32x4*)(gpost + i * 256 + lane * 4);
    uint2 yw[4], ywn[4]; f32x4 x[4], xn[4];
#pragma unroll
    for (int i = 0; i < 4; ++i) { yw[i] = *(const uint2*)(Y + (size_t)row * DM + i * 256 + lane * 4); x[i] = __builtin_nontemporal_load((const f32x4*)(Xin + (size_t)row * DM + i * 256 + lane * 4)); }
#pragma unroll 1
    for (; row < M; row += stride) {
        const int rn = row + stride < M ? row + stride : row;
#pragma unroll
        for (int i = 0; i < 4; ++i) { ywn[i] = *(const uint2*)(Y + (size_t)rn * DM + i * 256 + lane * 4); xn[i] = __builtin_nontemporal_load((const f32x4*)(Xin + (size_t)rn * DM + i * 256 + lane * 4)); }
        f32x4 y[4]; float ss = 0.f;
#pragma unroll
        for (int i = 0; i < 4; ++i) { y[i] = (f32x4){bfl(yw[i].x), bfh(yw[i].x), bfl(yw[i].y), bfh(yw[i].y)};
            ss += y[i][0] * y[i][0] + y[i][1] * y[i][1] + y[i][2] * y[i][2] + y[i][3] * y[i][3]; }
        ss = wave_sum(ss);
        const float rstd = rsqrtf(ss * (1.0f / DM) + RMS_EPS);
        float s2 = 0.f;
#pragma unroll
        for (int i = 0; i < 4; ++i) {
            x[i] = x[i] + y[i] * rstd * g[i]; s2 += x[i][0] * x[i][0] + x[i][1] * x[i][1] + x[i][2] * x[i][2] + x[i][3] * x[i][3];
            __builtin_nontemporal_store(x[i], (f32x4*)(Xout + (size_t)row * DM + i * 256 + lane * 4)); }
        if (XB) {
            s2 = wave_sum(s2);
            const float r2 = rsqrtf(s2 * (1.0f / DM) + RMS_EPS);
#pragma unroll
            for (int i = 0; i < 4; ++i) { uint2 w; w.x = pk2(x[i][0] * r2, x[i][1] * r2); w.y = pk2(x[i][2] * r2, x[i][3] * r2); *(uint2*)(XB + (size_t)row * DM + i * 256 + lane * 4) = w; }
        }
#pragma unroll
        for (int i = 0; i < 4; ++i) { yw[i] = ywn[i]; x[i] = xn[i]; }
    }
}

constexpr int CV_AS = 264;
constexpr int CV_CS = 264;
__device__ void conv_job64(const Params& p, int l, int job, unsigned char* lds) {
    const int tid = tid_(), lane = tid & 63, wave = __builtin_amdgcn_readfirstlane(tid >> 6), fr = lane & 15, fq = lane >> 4;
    const int b = job >> 5, t0 = (job & 31) * 64;
    const bf16_t* PC = (const bf16_t*)(p.ws + WS_PC); bf16_t* MIX = (bf16_t*)(p.ws + WS_MIX);
    const float* dw = p.in[5] + l * TAPS * CW; const float* dwb = p.in[6] + l * CW; const float* lng = p.in[7] + l * CW; const float* lnb = p.in[8] + l * CW;
    const bf16_t* pwT = (const bf16_t*)(p.ws + WS_WPW) + (size_t)l * CW * CW; const float* pwb = p.in[10] + l * CW;
    float* u = (float*)lds;
    bf16_t* act = (bf16_t*)(lds + 94 * 256 * 4);
    const int c = tid & 255, half = tid >> 8;
    float w[TAPS];
#pragma unroll
    for (int j = 0; j < TAPS; ++j) w[j] = dw[j * CW + c];
    const float bias = dwb[c];
    for (int idx = tid; idx < 94 * 32; idx += 512) {
        const int r = idx >> 5, c8 = (idx & 31) * 8, t = t0 - 30 + r;
        float v[8];
        if (t >= 0) { const bf16_t* pr = PC + ((size_t)b * SEQ + t) * PC_W + c8; const bf16x8 a = *(const bf16x8*)pr, g = *(const bf16x8*)(pr + 256);
#pragma unroll
            for (int e = 0; e < 8; ++e) v[e] = bf2f((bf16_t)a[e]) * __builtin_amdgcn_rcpf(1.0f + __builtin_amdgcn_exp2f(-1.4426950408889634f * bf2f((bf16_t)g[e]))); }
        else {
#pragma unroll
            for (int e = 0; e < 8; ++e) v[e] = 0.f; }
        *(f32x4*)(u + r * 256 + c8) = (f32x4){v[0], v[1], v[2], v[3]}; *(f32x4*)(u + r * 256 + c8 + 4) = (f32x4){v[4], v[5], v[6], v[7]};
    }
    __syncthreads();
    float acc[32];
    f32x4 lg[8], lb[8];
#pragma unroll
    for (int k = 0; k < 8; ++k) { lg[k] = *(const f32x4*)(lng + 4 * (lane & 7) + 32 * k); lb[k] = *(const f32x4*)(lnb + 4 * (lane & 7) + 32 * k); }
    const f32x4 pbias0 = *(const f32x4*)(pwb + wave * 32 + fq * 8), pbias1 = *(const f32x4*)(pwb + wave * 32 + fq * 8 + 4);
    {
#pragma unroll
        for (int i = 0; i < 32; ++i) acc[i] = bias;
        const float* up = u + (half * 32) * 256 + c;
#pragma unroll
        for (int rr = 0; rr < 62; ++rr) {
            const float uv = up[rr * 256];
#pragma unroll
            for (int i = 0; i < 32; ++i) { if (rr - i >= 0 && rr - i < TAPS) acc[i] += w[rr - i] * uv; }
        }
    }
    __syncthreads();
    float* cv = u;
#pragma unroll
    for (int i = 0; i < 32; ++i) cv[(half * 32 + i) * CV_CS + c] = acc[i];
    __syncthreads();
    uint4 gcv[4];
#pragma unroll
    for (int j = 0; j < 4; ++j) gcv[j] = *(const uint4*)(PC + ((size_t)b * SEQ + t0 + j * 16 + fr) * PC_W + 512 + wave * 32 + fq * 8);
    bf16x8 pwa[8][2];
#pragma unroll
    for (int kk = 0; kk < 8; ++kk)
#pragma unroll
        for (int i = 0; i < 2; ++i) pwa[kk][i] = *(const bf16x8*)(pwT + (size_t)(wave * 32 + 8 * (fr >> 2) + 4 * i + (fr & 3)) * CW + kk * 32 + fq * 8);
    {
        const int tt = wave * 8 + (lane >> 3), pp = lane & 7;
        f32x4 x[8]; float s_ = 0.f;
#pragma unroll
        for (int k = 0; k < 8; ++k) { x[k] = *(const f32x4*)(cv + tt * CV_CS + 4 * pp + 32 * k); s_ += (x[k][0] + x[k][1]) + (x[k][2] + x[k][3]); }
        s_ += __shfl_xor(s_, 1); s_ += __shfl_xor(s_, 2); s_ += __shfl_xor(s_, 4);
        const float mean = s_ * (1.0f / CW); float q_ = 0.f;
#pragma unroll
        for (int k = 0; k < 8; ++k) { x[k] = x[k] - mean; q_ += (x[k][0] * x[k][0] + x[k][1] * x[k][1]) + (x[k][2] * x[k][2] + x[k][3] * x[k][3]); }
        q_ += __shfl_xor(q_, 1); q_ += __shfl_xor(q_, 2); q_ += __shfl_xor(q_, 4);
        const float rstd = rsqrtf(q_ * (1.0f / CW) + LN_EPS);
#pragma unroll
        for (int k = 0; k < 8; ++k) {
            const f32x4 g = lg[k], bb = lb[k];
            float y[4];
#pragma unroll
            for (int e = 0; e < 4; ++e) y[e] = siluf_(x[k][e] * rstd * g[e] + bb[e]);
            uint2 w; w.x = pk2(y[0], y[1]); w.y = pk2(y[2], y[3]); *(uint2*)(act + tt * CV_AS + 4 * pp + 32 * k) = w;
        }
    }
    __syncthreads();
    {
        f32x4 o[2][4];
#pragma unroll
        for (int i = 0; i < 2; ++i)
#pragma unroll
            for (int j = 0; j < 4; ++j) o[i][j] = (f32x4){0.f, 0.f, 0.f, 0.f};
#pragma unroll
        for (int kk = 0; kk < 8; ++kk) {
            bf16x8 bq[4];
#pragma unroll
            for (int j = 0; j < 4; ++j) bq[j] = *(const bf16x8*)(act + (j * 16 + fr) * CV_AS + kk * 32 + fq * 8);
#pragma unroll
            for (int i = 0; i < 2; ++i)
#pragma unroll
                for (int j = 0; j < 4; ++j) o[i][j] = __builtin_amdgcn_mfma_f32_16x16x32_bf16(pwa[kk][i], bq[j], o[i][j], 0, 0, 0);
        }
        {
            const int n0 = wave * 32 + fq * 8; const f32x4 bias0 = pbias0, bias1 = pbias1;
#pragma unroll
            for (int j = 0; j < 4; ++j) {
                const size_t row = (size_t)b * SEQ + t0 + j * 16 + fr;
                const uint4 gw = gcv[j];
                const f32x4 v0 = o[0][j] + bias0, v1 = o[1][j] + bias1;
                uint4 w;
                w.x = pk2(v0[0] * siluf_(bf2f((bf16_t)(gw.x & 0xffff))), v0[1] * siluf_(bf2f((bf16_t)(gw.x >> 16)))); w.y = pk2(v0[2] * siluf_(bf2f((bf16_t)(gw.y & 0xffff))), v0[3] * siluf_(bf2f((bf16_t)(gw.y >> 16))));
                w.z = pk2(v1[0] * siluf_(bf2f((bf16_t)(gw.z & 0xffff))), v1[1] * siluf_(bf2f((bf16_t)(gw.z >> 16)))); w.w = pk2(v1[2] * siluf_(bf2f((bf16_t)(gw.w & 0xffff))), v1[3] * siluf_(bf2f((bf16_t)(gw.w >> 16))));
                *(uint4*)(MIX + row * DM + n0) = w;
            }
        }
    }
    __syncthreads();
}

typedef float f32x16 __attribute__((ext_vector_type(16)));
struct AttFrag { bf16x8 K[4], V[2][2]; };
constexpr int AT_WIN = 224;
constexpr int AT_KS = 144, AT_VS = 976;
constexpr int AT_VOFF = (AT_WIN + 256) * AT_KS;
static_assert(AT_VOFF + 64 * AT_VS <= 147456, "attention LDS map");
__device__ __forceinline__ void att_load(AttFrag& F, const bf16_t* kbase, const bf16_t* vbase, const unsigned char* klds, const unsigned char* vlds, int w0, int kt) {
    const int s0 = (kt > 0 ? kt : 0) * 32;
    if (s0 >= w0) {
        const unsigned char* kp = klds + (s0 - w0) * AT_KS; const unsigned char* vp = vlds + (s0 - w0) * 2;
#pragma unroll
        for (int ks = 0; ks < 4; ++ks) F.K[ks] = *(const bf16x8*)(kp + ks * 32);
#pragma unroll
        for (int db = 0; db < 2; ++db)
#pragma unroll
            for (int s = 0; s < 2; ++s) F.V[db][s] = *(const bf16x8*)(vp + db * 32 * AT_VS + s * 16);
    } else {
#pragma unroll
        for (int ks = 0; ks < 4; ++ks) F.K[ks] = *(const bf16x8*)(kbase + (size_t)s0 * PS_W + ks * 16);
#pragma unroll
        for (int db = 0; db < 2; ++db)
#pragma unroll
            for (int s = 0; s < 2; ++s) F.V[db][s] = *(const bf16x8*)(vbase + (size_t)db * 32 * SEQ + s0 + s * 8);
    }
}
__device__ __forceinline__ bool att_tile(const AttFrag& F, const bf16x8 (&Qf)[4], f32x16& O0, f32x16& O1, float& rp, bool diag, int qi, int hf) {
    f32x16 S;
#pragma unroll
    for (int r = 0; r < 16; ++r) S[r] = 0.f;
#pragma unroll
    for (int ks = 0; ks < 4; ++ks) S = __builtin_amdgcn_mfma_f32_32x32x16_bf16(F.K[ks], Qf[ks], S, 0, 0, 0);
    float tot = 1.0f;
#pragma unroll
    for (int r = 0; r < 16; ++r) {
        float k_ = __builtin_amdgcn_rcpf(1.0f + __builtin_amdgcn_exp2f(S[r]));
        if (diag && (hf * 16 + r >= qi)) k_ = 1.0f;
        S[r] = k_; tot *= k_;
    }
    const float toto = __shfl_xor(tot, 32);
    float e = hf ? rp : rp * toto;
#pragma unroll
    for (int r = 15; r >= 0; --r) { const float en = e * S[r]; S[r] = e - en; e = en; }
    rp = rp * tot * toto;
    bf16x8 Pf[2];
#pragma unroll
    for (int s = 0; s < 2; ++s) {
        union { bf16x8 v; unsigned u[4]; } pk;
#pragma unroll
        for (int j = 0; j < 4; ++j) pk.u[j] = pk2(S[8 * s + 2 * j], S[8 * s + 2 * j + 1]);
        Pf[s] = pk.v;
    }
#pragma unroll
    for (int s = 0; s < 2; ++s) { O0 = __builtin_amdgcn_mfma_f32_32x32x16_bf16(F.V[0][s], Pf[s], O0, 0, 0, 0); O1 = __builtin_amdgcn_mfma_f32_32x32x16_bf16(F.V[1][s], Pf[s], O1, 0, 0, 0); }
    return __ballot(rp != 0.0f) == 0ull;
}
__device__ void attn_wg_job(const Params& p, int job, unsigned char* lds) {
    const int tid = tid_(), lane = tid & 63, wave = __builtin_amdgcn_readfirstlane(tid >> 6), qi = lane & 31, hf = lane >> 5;
    const int bh = job >> 3, g = job & 7, b = bh / NH, h = bh % NH;
    const bf16_t* PS = (const bf16_t*)(p.ws + WS_PS); const bf16_t* VT = (const bf16_t*)(p.ws + WS_VT) + (size_t)bh * HD * SEQ; bf16_t* MIX = (bf16_t*)(p.ws + WS_MIX);
    const int w0 = g * 256 > AT_WIN ? g * 256 - AT_WIN : 0, nkeys = g * 256 + 256 - w0;
    unsigned char* klds = lds; unsigned char* vlds = lds + AT_VOFF;
    bf16x8 Qf[4];
#pragma unroll
    for (int ks = 0; ks < 4; ++ks) Qf[ks] = *(const bf16x8*)(PS + ((size_t)b * SEQ + (g * 8 + wave) * 32 + qi) * PS_W + h * HD + ks * 16 + hf * 8);
    uint4 gwv[2][2];
#pragma unroll
    for (int db = 0; db < 2; ++db)
#pragma unroll
        for (int gq = 0; gq < 2; ++gq) gwv[db][gq] = *(const uint4*)(PS + ((size_t)b * SEQ + (g * 8 + wave) * 32 + qi) * PS_W + 768 + h * HD + db * 32 + hf * 16 + gq * 8);
    {
        const bf16_t* ksrc = PS + ((size_t)b * SEQ + w0) * PS_W + SBW + h * HD;
        for (int idx = tid; idx < nkeys * 8; idx += 512) { const int row = idx >> 3, pc = idx & 7; *(uint4*)(klds + row * AT_KS + pc * 16) = *(const uint4*)(ksrc + (size_t)row * PS_W + pc * 8); }
        const int pc = tid & 63, npc = nkeys >> 3;
        if (pc < npc) {
#pragma unroll
            for (int i = 0; i < 8; ++i) { const int d = (tid >> 6) + 8 * i; *(uint4*)(vlds + d * AT_VS + pc * 16) = *(const uint4*)(VT + (size_t)d * SEQ + w0 + pc * 8); }
        }
    }
    __syncthreads();
    {
        const int qblk = g * 8 + wave, q0 = qblk * 32;
        const size_t rowq = (size_t)b * SEQ + q0 + qi;
        const int pi = (qi & 3) + 4 * (qi >> 3) + 16 * ((qi >> 2) & 1);
        const bf16_t* kbase = PS + ((size_t)b * SEQ + pi) * PS_W + SBW + h * HD + hf * 8;
        const bf16_t* vbase = VT + (size_t)pi * SEQ + hf * 16;
        const unsigned char* kl = klds + pi * AT_KS + hf * 16; const unsigned char* vl = vlds + pi * AT_VS + hf * 32;
        AttFrag FA, FB;
        att_load(FA, kbase, vbase, kl, vl, w0, qblk);
        f32x16 O0, O1;
#pragma unroll
        for (int r = 0; r < 16; ++r) { O0[r] = 0.f; O1[r] = 0.f; }
        float rp = 1.0f;
        for (int kt = qblk; kt >= 0; kt -= 2) {
            att_load(FB, kbase, vbase, kl, vl, w0, kt - 1);
            if (att_tile(FA, Qf, O0, O1, rp, kt == qblk, qi, hf) || kt < 1) break;
            att_load(FA, kbase, vbase, kl, vl, w0, kt - 2);
            if (att_tile(FB, Qf, O0, O1, rp, false, qi, hf)) break;
        }
        bf16_t* op = MIX + rowq * DM + CW + h * HD;
#pragma unroll
        for (int db = 0; db < 2; ++db)
#pragma unroll
            for (int gq = 0; gq < 2; ++gq) {
                const uint4 gw = gwv[db][gq]; const f32x16& O = db ? O1 : O0;
                uint4 w;
                w.x = pk2(O[8 * gq + 0] * siluf_(bf2f((bf16_t)(gw.x & 0xffff))), O[8 * gq + 1] * siluf_(bf2f((bf16_t)(gw.x >> 16)))); w.y = pk2(O[8 * gq + 2] * siluf_(bf2f((bf16_t)(gw.y & 0xffff))), O[8 * gq + 3] * siluf_(bf2f((bf16_t)(gw.y >> 16))));
                w.z = pk2(O[8 * gq + 4] * siluf_(bf2f((bf16_t)(gw.z & 0xffff))), O[8 * gq + 5] * siluf_(bf2f((bf16_t)(gw.z >> 16)))); w.w = pk2(O[8 * gq + 6] * siluf_(bf2f((bf16_t)(gw.w & 0xffff))), O[8 * gq + 7] * siluf_(bf2f((bf16_t)(gw.w >> 16))));
                *(uint4*)(op + db * 32 + hf * 16 + gq * 8) = w;
            }
    }
    __syncthreads();
}

constexpr int TS = 72;
constexpr int TILE_B = 64 * TS * 2;
constexpr int AABS = 68, XTS = 65, CSS = 65, OTS = 68;

__device__ __forceinline__ int tile_off(int row, int chunk, int swz) { return row * TS + ((chunk ^ ((row >> 3) & swz)) << 3); }
__device__ __forceinline__ f32x4 mm_tile(const bf16_t* X, int m0, const bf16_t* Yt, int n0, int K, int fr, int fq, f32x4 acc, int swx = 0, int swy = 0) {
#pragma unroll
    for (int kk = 0; kk < 2; ++kk) {
        if (kk * 32 < K) {
            const bf16x8 a = *(const bf16x8*)(X + tile_off(m0 + fr, kk * 4 + fq, swx));
            const bf16x8 b = *(const bf16x8*)(Yt + tile_off(n0 + fr, kk * 4 + fq, swy));
            acc = __builtin_amdgcn_mfma_f32_16x16x32_bf16(a, b, acc, 0, 0, 0);
        }
    }
    return acc;
}
__device__ __forceinline__ f32x4 mm_tile_r(const bf16_t* X, int arow, const bf16_t* Yt, int n0, int fr, int fq, f32x4 acc, int swx = 0, int swy = 0) {
#pragma unroll
    for (int kk = 0; kk < 2; ++kk) {
        const bf16x8 a = *(const bf16x8*)(X + tile_off(arow, kk * 4 + fq, swx));
        const bf16x8 b = *(const bf16x8*)(Yt + tile_off(n0 + fr, kk * 4 + fq, swy));
        acc = __builtin_amdgcn_mfma_f32_16x16x32_bf16(a, b, acc, 0, 0, 0);
    }
    return acc;
}
__device__ __forceinline__ uint2 pk4(const f32x4& v) { uint2 w; w.x = pk2(v[0], v[1]); w.y = pk2(v[2], v[3]); return w; }

struct B1Loads {
    bf16x8 rc, kc, vc, rp, kp, vp;
    f32x4 vf0, vf1;
    bf16x8 cc[2], cp[2];
};
__device__ __forceinline__ void b1_issue_loads(const Params& p, int l, int gi, int h, int tid, B1Loads& L) {
    const int b = gi >> 5, c = gi & 31, t0 = c * 64;
    const bf16_t* PR = (const bf16_t*)(p.ws + WS_PR); const float* VF = (const float*)(p.ws + WS_VF);
    {
        const int tt = tid >> 3, j0 = (tid & 7) * 8, t = t0 + tt, cj0 = h * HD + j0; const size_t row = (size_t)b * SEQ + t;
        const bf16_t* cur = PR + row * PR_W; const bf16_t* prv = cur - (t > 0 ? PR_W : 0);
        L.rc = *(const bf16x8*)(cur + cj0); L.kc = *(const bf16x8*)(cur + 384 + cj0); L.vc = *(const bf16x8*)(cur + 768 + cj0);
        L.rp = *(const bf16x8*)(prv + cj0); L.kp = *(const bf16x8*)(prv + 384 + cj0); L.vp = *(const bf16x8*)(prv + 768 + cj0);
        if (l > 0) { L.vf0 = *(const f32x4*)(VF + row * RWW + cj0); L.vf1 = *(const f32x4*)(VF + row * RWW + cj0 + 4); }
    }
    if (h == 0) {
#pragma unroll
        for (int q = 0; q < 2; ++q) {
            const int item = tid + 512 * q, tt = item >> 4, g = item & 15, t = t0 + tt;
            const bf16_t* cur = PR + ((size_t)b * SEQ + t) * PR_W + 1152; const bf16_t* prv = cur - (t > 0 ? PR_W : 0);
            const int gc = g < 12 ? g : 0, gp = g < 8 ? g : (g < 12 ? g + 4 : 0);
            L.cc[q] = *(const bf16x8*)(cur + 8 * gc); L.cp[q] = *(const bf16x8*)(prv + 8 * gp);
        }
    }
}

__device__ void rwkv_b1_phase(const Params& p, int l, unsigned char* lds) {
    const int G = gridDim.x;
    float* VF = (float*)(p.ws + WS_VF);
    const float* mu = p.in[11] + l * 1216; const float* w0 = p.in[12] + l * RWW;
    const float* a0 = p.in[14] + l * RWW; const float* kks = p.in[16] + l * RWW; const float* ka = p.in[17] + l * RWW;
    const float* rk = p.in[18] + l * RWW; const float* v0 = p.in[21];
    const float* w2 = p.in[13] + l * LORA * RWW; const float* a2 = p.in[15] + l * LORA * RWW; const float* v2 = p.in[23];
    bf16_t* T_At = (bf16_t*)lds; bf16_t* T_Rt = T_At + 64 * TS; bf16_t* T_Bt = T_Rt + 64 * TS; bf16_t* T_Kt = T_Bt + 64 * TS;
    bf16_t* T_VT = T_Kt + 64 * TS; bf16_t* T_bhT = T_VT + 64 * TS; bf16_t* T_khT = T_bhT + 64 * TS;
    bf16_t* T_Aak = T_khT + 64 * TS; bf16_t* T_Arb = T_Aak + 64 * TS; bf16_t* T_Ark = T_Arb + 64 * TS;
    bf16_t* T_WT = T_At; bf16_t* T_U0T = T_Bt;
    float* Aab = (float*)(lds + 10 * TILE_B);
    float* XT = (float*)(lds + 10 * TILE_B + 64 * AABS * 4);
    float* PCv = XT + 128 * XTS;
    float* TI = PCv + 64;
    float* CS = (float*)T_Aak;
    constexpr int LS = 33;
    float* WD = Aab; float* AD = WD + 64 * LS;
    float* VL = XT + 64 * XTS;
    float* WLT = (float*)lds; float* ALT = WLT + 64 * OTS; float* VGT = ALT + 64 * OTS;
    static_assert(3 * 64 * OTS * 4 <= 6 * TILE_B, "low-rank outputs");

    constexpr int NGRP = BATCH * (SEQ / 64);
    int gi = blockIdx.x;
    if (gi >= NGRP) return;
    B1Loads L;
    b1_issue_loads(p, l, gi, 0, tid_(), L);
    float codes[2][8];
    bf16x8 wgh[6], wgl[2];
#define B1_LOAD_WG(hh, tid_v) do { const int wv_ = __builtin_amdgcn_readfirstlane((tid_v) >> 6); const bf16x8* lrt_ = (const bf16x8*)(p.ws + WS_LRT); \
        _Pragma("unroll") for (int q = 0; q < 6; ++q) { const int id = wv_ + 8 * q, Lk = id >> 4, tj = id & 3; \
            if (q < 4 || l > 0) { const int e_ = ((((l * 3 + Lk) * NH + (hh)) * 4 + tj) << 6) + ((tid_v) & 63); wgh[q] = lrt_[e_]; if (q < 2) wgl[q] = lrt_[LRT_N + e_]; } } } while (0)
    { const int tid0 = tid_(); B1_LOAD_WG(0, tid0); }
#pragma unroll 1
    for (int it = 0; gi < NGRP; ++it) {
        const int h = it % NH;
        const int tid = tid_(), lane = tid & 63, wave = __builtin_amdgcn_readfirstlane(tid >> 6), fr = lane & 15, fq = lane >> 4;
        const int b = gi >> 5, c = gi & 31, bh = b * NH + h, jb = bh * 32 + c, t0 = c * 64;
        f32x4 pm[9][2];
        {
            const int pc = h * HD + (tid & 7) * 8;
            const float* src[9] = {mu + pc, mu + 384 + pc, mu + 768 + pc, w0 + pc, a0 + pc, v0 + pc, kks + pc, ka + pc, rk + pc};
#pragma unroll
            for (int i = 0; i < 9; ++i) { if (i != 5 || l > 0) { pm[i][0] = *(const f32x4*)src[i]; pm[i][1] = *(const f32x4*)(src[i] + 4); } else { pm[i][0] = (f32x4){0.f, 0.f, 0.f, 0.f}; pm[i][1] = pm[i][0]; } }
        }
#define PM(i, e) pm[i][(e) >> 2][(e) & 3]
#pragma unroll
        for (int q = 0; q < 2; ++q) {
            const int item = tid + 512 * q, tt = item >> 4, g = item & 15, t = t0 + tt; const bool hp = t > 0;
            if (h == 0) {
#pragma unroll
                for (int e = 0; e < 8; ++e) {
                    const float xc = bf2f((bf16_t)L.cc[q][e]), xp = hp ? bf2f((bf16_t)L.cp[q][e]) : 0.f;
                    const float x_ = xc + (xp - xc) * mu[1152 + 8 * (g & 7) + e];
                    codes[q][e] = g < 4 ? 1.0f - 2.0f * __builtin_amdgcn_rcpf(1.0f + __builtin_amdgcn_exp2f(2.8853900817779268f * x_)) : (g < 8 ? x_ : xc + xp);
                }
            }
            if (g < 8 || (g < 12 && l > 0)) {
                float* dst = (g < 4 ? WD + tt * LS + 8 * g : (g < 8 ? AD + tt * LS + 8 * (g - 4) : VL + tt * LS + 8 * (g - 8)));
#pragma unroll
                for (int e = 0; e < 8; ++e) dst[e] = codes[q][e];
            }
        }
        __syncthreads();
#pragma unroll
        for (int q = 0; q < 6; ++q) {
            if (q < 4 || l > 0) {
                const int id = wave + 8 * q, Lk = id >> 4, ti = (id >> 2) & 3, tj = id & 3;
                const float* Xs = (Lk == 0 ? WD : (Lk == 1 ? AD : VL)) + (ti * 16 + fr) * LS + 8 * fq;
                float xs[8];
#pragma unroll
                for (int jj = 0; jj < 8; ++jj) xs[jj] = Xs[jj];
                union { bf16x8 v; unsigned u[4]; } ah, al;
#pragma unroll
                for (int jj = 0; jj < 4; ++jj) ah.u[jj] = pk2(xs[2 * jj], xs[2 * jj + 1]);
                f32x4 acc = __builtin_amdgcn_mfma_f32_16x16x32_bf16(ah.v, wgh[q], (f32x4){0.f, 0.f, 0.f, 0.f}, 0, 0, 0);
                if (Lk == 0) {
#pragma unroll
                    for (int jj = 0; jj < 4; ++jj) al.u[jj] = pk2(xs[2 * jj] - bf2f((bf16_t)(ah.u[jj] & 0xffff)), xs[2 * jj + 1] - bf2f((bf16_t)(ah.u[jj] >> 16)));
                    acc = __builtin_amdgcn_mfma_f32_16x16x32_bf16(al.v, wgh[q], acc, 0, 0, 0);
                    acc = __builtin_amdgcn_mfma_f32_16x16x32_bf16(ah.v, wgl[q < 2 ? q : 0], acc, 0, 0, 0);
                }
                float* out = (Lk == 0 ? WLT : (Lk == 1 ? ALT : VGT)) + (tj * 16 + fr) * OTS + ((ti * 16 + fq * 4) ^ (8 * ((2 * tj + (fr >> 3)) & 7)));
                *(f32x4*)out = acc;
            }
        }
        __syncthreads();
        const int tt = tid >> 3, j0 = (tid & 7) * 8, t = t0 + tt, cj0 = h * HD + j0;
        const size_t row = (size_t)b * SEQ + t;
        float rr[8], kk_[8], vv[8], aa[8], bb[8], lw[8];
        {
            const bool hp = t > 0;
            float wl[8], al[8], vg[8];
            const int ttx = tt ^ (8 * (tid & 7));
#pragma unroll
            for (int e = 0; e < 8; ++e) {
                const float r_c = bf2f((bf16_t)L.rc[e]), k_c = bf2f((bf16_t)L.kc[e]), v_c = bf2f((bf16_t)L.vc[e]);
                const float r_p = hp ? bf2f((bf16_t)L.rp[e]) : 0.f, k_p = hp ? bf2f((bf16_t)L.kp[e]) : 0.f, v_p = hp ? bf2f((bf16_t)L.vp[e]) : 0.f;
                rr[e] = r_c + (r_p - r_c) * PM(0, e); kk_[e] = k_c + (k_p - k_c) * PM(1, e); vv[e] = v_c + (v_p - v_c) * PM(2, e);
                wl[e] = PM(3, e) + WLT[(j0 + e) * OTS + ttx]; al[e] = PM(4, e) + ALT[(j0 + e) * OTS + ttx]; vg[e] = l > 0 ? PM(5, e) + VGT[(j0 + e) * OTS + ttx] : 0.f;
            }
            float ssq = 0.f, bon = 0.f;
#pragma unroll
            for (int e = 0; e < 8; ++e) {
                lw[e] = -0.6065306597126334f * __builtin_amdgcn_rcpf(1.0f + __builtin_amdgcn_exp2f(-1.4426950408889634f * wl[e]));
                const float alr = __builtin_amdgcn_rcpf(1.0f + __builtin_amdgcn_exp2f(-1.4426950408889634f * al[e]));
                if (l > 0) { const float vf = e < 4 ? L.vf0[e & 3] : L.vf1[e & 3]; vv[e] = vv[e] + (vf - vv[e]) * __builtin_amdgcn_rcpf(1.0f + __builtin_amdgcn_exp2f(-1.4426950408889634f * vg[e])); }
                const float kkr = kk_[e] * PM(6, e);
                kk_[e] = kk_[e] * (1.0f + (alr - 1.0f) * PM(7, e));
                aa[e] = kkr; bb[e] = alr; ssq += kkr * kkr; bon += rr[e] * kk_[e] * PM(8, e);
            }
            if (l == 0) { __builtin_nontemporal_store((f32x4){vv[0], vv[1], vv[2], vv[3]}, (f32x4*)(VF + row * RWW + cj0)); __builtin_nontemporal_store((f32x4){vv[4], vv[5], vv[6], vv[7]}, (f32x4*)(VF + row * RWW + cj0 + 4)); }
            ssq += __shfl_xor(ssq, 1); ssq += __shfl_xor(ssq, 2); ssq += __shfl_xor(ssq, 4);
            bon += __shfl_xor(bon, 1); bon += __shfl_xor(bon, 2); bon += __shfl_xor(bon, 4);
            const float inv = fminf(__builtin_amdgcn_rsqf(ssq), 1e12f);
            uint4 bvw; float bv[8];
#pragma unroll
            for (int e = 0; e < 8; ++e) { const float kn = aa[e] * inv; aa[e] = -kn; bb[e] = kn * bb[e]; bv[e] = bon * vv[e]; }
            bvw.x = pk2(bv[0], bv[1]); bvw.y = pk2(bv[2], bv[3]); bvw.z = pk2(bv[4], bv[5]); bvw.w = pk2(bv[6], bv[7]);
            stnt_u4((bf16_t*)(p.ws + WS_CH_BV) + (size_t)jb * 4096 + tt * 64 + j0, bvw);
        }
        float csv[8], cst[8];
        {
            const int ts = lane >> 3;
#pragma unroll
            for (int e = 0; e < 8; ++e) { float x = lw[e];
                { const float y = __shfl_up(x, 8); if (ts >= 1) x += y; }
                { const float y = __shfl_up(x, 16); if (ts >= 2) x += y; }
                { const float y = __shfl_up(x, 32); if (ts >= 4) x += y; }
                csv[e] = x; }
            if (ts == 7) {
#pragma unroll
                for (int e = 0; e < 8; ++e) CS[wave * 64 + j0 + e] = csv[e];
            }
        }
        __syncthreads();
        {
#pragma unroll
            for (int e = 0; e < 8; ++e) cst[e] = 0.f;
            f32x4 tw[8][2];
#pragma unroll
            for (int w_ = 0; w_ < 8; ++w_) { tw[w_][0] = *(const f32x4*)(CS + w_ * 64 + j0); tw[w_][1] = *(const f32x4*)(CS + w_ * 64 + j0 + 4); }
#pragma unroll
            for (int w_ = 0; w_ < 8; ++w_) {
                if (w_ == wave) {
                    asm volatile("" ::: "memory");
#pragma unroll
                    for (int e = 0; e < 8; ++e) csv[e] += cst[e];
                }
#pragma unroll
                for (int e = 0; e < 4; ++e) { cst[e] += tw[w_][0][e]; cst[4 + e] += tw[w_][1][e]; }
            }
            float at[8], rt[8], bt[8], kt[8];
            const int tts = tt ^ (8 * (tid & 7));
#pragma unroll
            for (int e = 0; e < 8; ++e) {
                const int j = j0 + e; const float cs = csv[e] * 1.4426950408889634f, csC = cst[e] * 1.4426950408889634f, lw2 = lw[e] * 1.4426950408889634f;
                const float e_in = __builtin_amdgcn_exp2f(cs), e_ex = __builtin_amdgcn_exp2f(cs - lw2), e_ng = __builtin_amdgcn_exp2f(-cs), e_ht = __builtin_amdgcn_exp2f(csC - cs);
                at[e] = aa[e] * e_ex; rt[e] = rr[e] * e_in; bt[e] = bb[e] * e_ng; kt[e] = kk_[e] * e_ng;
                T_VT[j * TS + tts] = f2bf(vv[e]); T_bhT[j * TS + tts] = f2bf(bb[e] * e_ht); T_khT[j * TS + tts] = f2bf(kk_[e] * e_ht);
                XT[j * XTS + tt] = at[e];
                if (tt == 63) PCv[j] = __builtin_amdgcn_exp2f(csC);
            }
            uint4 w;
            w.x = pk2(at[0], at[1]); w.y = pk2(at[2], at[3]); w.z = pk2(at[4], at[5]); w.w = pk2(at[6], at[7]); *(uint4*)(T_At + tt * TS + j0) = w;
            w.x = pk2(rt[0], rt[1]); w.y = pk2(rt[2], rt[3]); w.z = pk2(rt[4], rt[5]); w.w = pk2(rt[6], rt[7]); *(uint4*)(T_Rt + tt * TS + j0) = w;
            w.x = pk2(bt[0], bt[1]); w.y = pk2(bt[2], bt[3]); w.z = pk2(bt[4], bt[5]); w.w = pk2(bt[6], bt[7]); *(uint4*)(T_Bt + tt * TS + j0) = w;
            w.x = pk2(kt[0], kt[1]); w.y = pk2(kt[2], kt[3]); w.z = pk2(kt[4], kt[5]); w.w = pk2(kt[6], kt[7]); *(uint4*)(T_Kt + tt * TS + j0) = w;
        }
        __syncthreads();
        { const int hn = h + 1 < NH ? h + 1 : 0, gn = h + 1 < NH ? gi : gi + G; if (gn < NGRP) { b1_issue_loads(p, l, gn, hn, tid, L); B1_LOAD_WG(hn, tid); } }
        {
            const int mat = wave >> 1;
            const bf16_t* As = (mat == 0 || mat == 2) ? T_Bt : T_Kt; const bf16_t* Bs = (mat < 2) ? T_At : T_Rt;
            bf16_t* dstb = (mat == 1 ? T_Aak : (mat == 2 ? T_Arb : T_Ark));
#define B1_ST1_TILE(ti, tj) do { \
                float zf_ = 0.f; asm volatile("" : "+v"(zf_));        \
                f32x4 acc = (f32x4){zf_, zf_, zf_, zf_}; \
                if ((ti) <= (tj)) acc = mm_tile(As, (ti) * 16, Bs, (tj) * 16, 64, fr, fq, acc); \
                const int tcol = (tj) * 16 + fr, i0 = (ti) * 16 + fq * 4; \
                if ((ti) == (tj)) { _Pragma("unroll") for (int r = 0; r < 4; ++r) { const bool keep = (mat < 2) ? (i0 + r < tcol) : (i0 + r <= tcol); if (!keep) acc[r] = 0.f; } } \
                if (mat == 0) *(f32x4*)(Aab + tcol * AABS + i0) = acc; \
                else *(uint2*)(dstb + tcol * TS + i0) = pk4(acc); } while (0)
            if (wave & 1) { B1_ST1_TILE(1, 1); B1_ST1_TILE(1, 2); B1_ST1_TILE(1, 3); B1_ST1_TILE(2, 2); B1_ST1_TILE(2, 3); B1_ST1_TILE(2, 1); B1_ST1_TILE(3, 1); B1_ST1_TILE(3, 2); }
            else { B1_ST1_TILE(0, 0); B1_ST1_TILE(0, 1); B1_ST1_TILE(0, 2); B1_ST1_TILE(0, 3); B1_ST1_TILE(3, 3); B1_ST1_TILE(1, 0); B1_ST1_TILE(2, 0); B1_ST1_TILE(3, 0); }
#undef B1_ST1_TILE
        }
        __syncthreads();
        if (wave == 0) {
            const int blk = lane >> 4, cc = lane & 15; const float* ar = Aab + (16 * blk) * AABS + 16 * blk;
            float x[16];
#pragma unroll
            for (int u = 0; u < 16; ++u) { float v = (u == cc) ? 1.0f : 0.f;
#pragma unroll
                for (int i = 0; i < u; ++i) v += ar[u * AABS + i] * x[i];
                x[u] = v; }
#pragma unroll
            for (int u = 0; u < 16; ++u) TI[(blk * 16 + u) * 17 + cc] = x[u];
        } else {
#pragma unroll 1
            for (int id = wave - 1; id < 16; id += 7) {
                const int ti = id >> 2, tj = id & 3;
                f32x4 acc = mm_tile(T_Aak, ti * 16, T_VT, tj * 16, 64, fr, fq, (f32x4){0.f, 0.f, 0.f, 0.f}, 0, 7);
                const int j = tj * 16 + fr, tr = ti * 16 + fq * 4;
#pragma unroll
                for (int r = 0; r < 4; ++r) XT[(64 + j) * XTS + tr + r] = acc[r];
            }
        }
        __syncthreads();
        {
            float* xc = XT + (wave * 16 + fr) * XTS;
#pragma unroll
            for (int I = 0; I < 4; ++I) {
                f32x4 acc;
#pragma unroll
                for (int r = 0; r < 4; ++r) acc[r] = xc[16 * I + 4 * fq + r];
#pragma unroll
                for (int J = 0; J < I; ++J)
#pragma unroll
                    for (int kk = 0; kk < 4; ++kk) acc = __builtin_amdgcn_mfma_f32_16x16x4f32(Aab[(16 * I + fr) * AABS + 16 * J + 4 * kk + fq], xc[16 * J + 4 * kk + fq], acc, 0, 0, 0);
#pragma unroll
                for (int r = 0; r < 4; ++r) xc[16 * I + 4 * fq + r] = acc[r];
                asm volatile("s_waitcnt lgkmcnt(0)" ::: "memory");
                f32x4 xs = (f32x4){0.f, 0.f, 0.f, 0.f};
#pragma unroll
                for (int kk = 0; kk < 4; ++kk) xs = __builtin_amdgcn_mfma_f32_16x16x4f32(TI[(I * 16 + fr) * 17 + 4 * kk + fq], xc[16 * I + 4 * kk + fq], xs, 0, 0, 0);
                asm volatile("s_waitcnt lgkmcnt(0)" ::: "memory");
#pragma unroll
                for (int r = 0; r < 4; ++r) xc[16 * I + 4 * fq + r] = xs[r];
                asm volatile("s_waitcnt lgkmcnt(0)" ::: "memory");
            }
        }
        {
            const int col = wave * 16 + (lane >> 2), tg = (lane & 3) * 16;
            const float* xr = XT + col * XTS + tg; bf16_t* dst = (col < 64 ? T_WT + col * TS : T_U0T + (col - 64) * TS) + tg;
            uint4 w0_, w1_;
            w0_.x = pk2(xr[0], xr[1]); w0_.y = pk2(xr[2], xr[3]); w0_.z = pk2(xr[4], xr[5]); w0_.w = pk2(xr[6], xr[7]);
            w1_.x = pk2(xr[8], xr[9]); w1_.y = pk2(xr[10], xr[11]); w1_.z = pk2(xr[12], xr[13]); w1_.w = pk2(xr[14], xr[15]);
            *(uint4*)dst = w0_; *(uint4*)(dst + 8) = w1_;
        }
        __syncthreads();
        {
            bf16_t* gM = (bf16_t*)(p.ws + WS_CH_M) + (size_t)jb * 4096; bf16_t* gNT = (bf16_t*)(p.ws + WS_CH_NT) + (size_t)jb * 4096;
            bf16_t* gG = (bf16_t*)(p.ws + WS_CH_G) + (size_t)jb * 4096; bf16_t* gY1T = (bf16_t*)(p.ws + WS_CH_Y1T) + (size_t)jb * 4096;
            const int mat = wave >> 1;
            const bf16_t* A1 = (mat == 0 || mat == 2) ? T_WT : (mat == 1 ? T_U0T : T_bhT);
            const bf16_t* B1 = (mat == 0 || mat == 1) ? T_Arb : (mat == 2 ? T_bhT : T_U0T);
            const bf16_t* A2 = mat == 1 ? T_VT : T_khT; const bf16_t* B2 = mat == 1 ? T_Ark : T_VT;
            const int swA1 = mat == 3 ? 7 : 0, swB1 = mat == 2 ? 7 : 0, swB2 = mat == 3 ? 7 : 0;
            bf16_t* gdst = mat == 0 ? gG : (mat == 1 ? gY1T : (mat == 2 ? gM : gNT));
            const int m_ = wave & 1;
#pragma unroll
            for (int tj = 0; tj < 4; ++tj) {
                const int col = tj * 16 + fr, r0 = m_ * 32 + fq * 8;
                f32x4 acc[2];
#pragma unroll
                for (int i = 0; i < 2; ++i) {
                    const int arow = m_ * 32 + 8 * (fr >> 2) + 4 * i + (fr & 3);
                    acc[i] = mm_tile_r(A1, arow, B1, tj * 16, fr, fq, (f32x4){0.f, 0.f, 0.f, 0.f}, swA1, swB1);
                    if (mat & 1) acc[i] = mm_tile_r(A2, arow, B2, tj * 16, fr, fq, acc[i], 7, swB2);
                }
                if (mat == 0) {
                    const uint4 rw = *(const uint4*)(T_Rt + col * TS + r0);
                    acc[0][0] += bfl(rw.x); acc[0][1] += bfh(rw.x); acc[0][2] += bfl(rw.y); acc[0][3] += bfh(rw.y);
                    acc[1][0] += bfl(rw.z); acc[1][1] += bfh(rw.z); acc[1][2] += bfl(rw.w); acc[1][3] += bfh(rw.w);
                } else if (mat == 2 && (tj >> 1) == m_) {
                    const float pc = PCv[col];
#pragma unroll
                    for (int i = 0; i < 2; ++i)
#pragma unroll
                        for (int r = 0; r < 4; ++r) if (r0 + 4 * i + r == col) acc[i][r] += pc;
                }
                uint4 w; w.x = pk2(acc[0][0], acc[0][1]); w.y = pk2(acc[0][2], acc[0][3]); w.z = pk2(acc[1][0], acc[1][1]); w.w = pk2(acc[1][2], acc[1][3]);
                if (mat == 3) {
                    bf16_t* d0 = gdst + (((r0 >> 4) * 2 + (col >> 5)) * 64 + (((r0 & 15) >> 2) * 16 + (col & 15))) * 8 + ((col >> 4) & 1) * 4;
                    stnt_u2v(d0, (uint2){w.x, w.y}); stnt_u2v(d0 + 128, (uint2){w.z, w.w});
                } else stnt_u4(gdst + col * 64 + r0, w);
            }
        }
        if (h == NH - 1) gi += G;
    }
    __syncthreads();
}

struct B2Ops { bf16x8 am[2]; uint2 nw[2]; };
__device__ __forceinline__ void b2_load(const bf16_t* gM, const bf16_t* gNT, size_t jb, int mi, int nj0, int fr, int fq, int c0, B2Ops& o) {
#pragma unroll
    for (int kk = 0; kk < 2; ++kk) o.am[kk] = __builtin_nontemporal_load((const bf16x8*)(gM + jb * 4096 + (mi * 16 + fr) * 64 + kk * 32 + fq * 8));
    { const uint4 w = ldnt_u4((const void*)(gNT + jb * 4096 + ((mi * 2 + (nj0 >> 1)) * 64 + fq * 16 + fr) * 8)); o.nw[0] = (uint2){w.x, w.y}; o.nw[1] = (uint2){w.z, w.w}; }
}
__device__ __forceinline__ void b2_step(bf16_t* zbuf, int c, int nj0, int fr, int fq, int c0, const B2Ops& o, f32x4 (&z)[2]) {
    bf16_t* zh = zbuf + (c & 7) * 64 * TS; bf16_t* zl = zbuf + (8 + (c & 1)) * 64 * TS;
#pragma unroll
    for (int q = 0; q < 2; ++q) {
        const int j = (nj0 + q) * 16 + fr;
        const uint2 hi = pk4(z[q]);
        f32x4 lo;
        lo[0] = z[q][0] - bf2f((bf16_t)(hi.x & 0xffff)); lo[1] = z[q][1] - bf2f((bf16_t)(hi.x >> 16)); lo[2] = z[q][2] - bf2f((bf16_t)(hi.y & 0xffff)); lo[3] = z[q][3] - bf2f((bf16_t)(hi.y >> 16));
        *(uint2*)(zh + j * TS + c0) = hi; *(uint2*)(zl + j * TS + c0) = pk4(lo);
    }
    __syncthreads();
#pragma unroll
    for (int q = 0; q < 2; ++q) {
        const int j = (nj0 + q) * 16 + fr;
        f32x4 acc; acc[0] = bf2f((bf16_t)(o.nw[q].x & 0xffff)); acc[1] = bf2f((bf16_t)(o.nw[q].x >> 16)); acc[2] = bf2f((bf16_t)(o.nw[q].y & 0xffff)); acc[3] = bf2f((bf16_t)(o.nw[q].y >> 16));
#pragma unroll
        for (int kk = 0; kk < 2; ++kk) {
            const bf16x8 bh_ = *(const bf16x8*)(zh + j * TS + kk * 32 + fq * 8), bl_ = *(const bf16x8*)(zl + j * TS + kk * 32 + fq * 8);
            acc = __builtin_amdgcn_mfma_f32_16x16x32_bf16(o.am[kk], bh_, acc, 0, 0, 0);
            acc = __builtin_amdgcn_mfma_f32_16x16x32_bf16(o.am[kk], bl_, acc, 0, 0, 0);
        }
        z[q] = acc;
    }
}
__device__ void rwkv_b2_job(const Params& p, int bh, unsigned char* lds) {
    const int tid = tid_(), lane = tid & 63, wave = __builtin_amdgcn_readfirstlane(tid >> 6), fr = lane & 15, fq = lane >> 4;
    const int mi = wave >> 1, nj0 = (wave & 1) * 2, c0 = mi * 16 + fq * 4;
    const bf16_t* gM = (const bf16_t*)(p.ws + WS_CH_M); const bf16_t* gNT = (const bf16_t*)(p.ws + WS_CH_NT); bf16_t* gZT = (bf16_t*)(p.ws + WS_ZT);
    bf16_t* zbuf = (bf16_t*)lds;
    f32x4 z[2];
    z[0] = (f32x4){0.f, 0.f, 0.f, 0.f}; z[1] = z[0];
    const size_t jb0 = (size_t)bh * 32;
    constexpr int B2_PF = 8;
    B2Ops o[B2_PF];
#pragma unroll
    for (int c = 0; c < B2_PF; ++c) b2_load(gM, gNT, jb0 + c, mi, nj0, fr, fq, c0, o[c]);
#pragma unroll
    for (int c = 0; c < SEQ / 64; ++c) {
        b2_step(zbuf, c, nj0, fr, fq, c0, o[c % B2_PF], z);
        if (c + B2_PF < SEQ / 64) b2_load(gM, gNT, jb0 + c + B2_PF, mi, nj0, fr, fq, c0, o[c % B2_PF]);
        if ((c & 7) == 7) {
#pragma unroll
            for (int i = 0; i < 8; ++i) stnt_u4(gZT + (jb0 + c - 7 + i) * 4096 + (tid >> 3) * 64 + (tid & 7) * 8, *(const uint4*)(zbuf + i * 64 * TS + (tid >> 3) * TS + (tid & 7) * 8));
            __syncthreads();
        }
    }
    __syncthreads();
}

constexpr int B3_GN_OFF = 8 * (4 * 16 * 72) * 2 + 4 * (64 * 72) * 2;
struct B3Loads { uint4 rz[2], rg[2], ry[2], rb[2], rp[2]; };
__device__ __forceinline__ void b3_issue_loads(const Params& p, int l, int pair, int wave, int fr, int fq, B3Loads& L) {
    const int jb = pair * 2 + (wave >> 2), mi = wave & 3, bh = jb >> 5, c = jb & 31, b = bh / NH, h = bh % NH;
    const bf16_t* gG = (const bf16_t*)(p.ws + WS_CH_G) + (size_t)jb * 4096; const bf16_t* gY1 = (const bf16_t*)(p.ws + WS_CH_Y1T) + (size_t)jb * 4096;
    const bf16_t* gBV = (const bf16_t*)(p.ws + WS_CH_BV) + (size_t)jb * 4096; const bf16_t* gZT = (const bf16_t*)(p.ws + WS_ZT) + (size_t)jb * 4096;
    const bf16_t* PG = (const bf16_t*)(p.ws + WS_PG);
    const int tt = mi * 16 + fr; const size_t row = (size_t)b * SEQ + c * 64 + tt;
    {
        const int r8 = (fq * 16 + fr) >> 3, ch = fr & 7;
#pragma unroll
        for (int i = 0; i < 2; ++i) { const int rr = mi * 16 + i * 8 + r8;
            L.rg[i] = ldnt_u4((const void*)(gG + rr * 64 + ch * 8)); L.ry[i] = ldnt_u4((const void*)(gY1 + rr * 64 + ch * 8)); L.rb[i] = ldnt_u4((const void*)(gBV + rr * 64 + ch * 8));
            L.rp[i] = ldnt_u4((const void*)(PG + ((size_t)b * SEQ + c * 64 + rr) * PG_W + h * HD + ch * 8));
            L.rz[i] = ldnt_u4((const void*)(gZT + rr * 64 + ch * 8)); }
    }
}
__device__ __forceinline__ void b3_compute(const Params& p, int l, int pair, int wave, int fr, int fq, const B3Loads& L, unsigned char* lds, int par) {
    const int jb = pair * 2 + (wave >> 2), mi = wave & 3;
    const int bh = jb >> 5, c = jb & 31, b = bh / NH, h = bh % NH;
    bf16_t* MIX = (bf16_t*)(p.ws + WS_MIX);
    const int tt = mi * 16 + fr; const size_t row = (size_t)b * SEQ + c * 64 + tt;
    bf16_t* wb = (bf16_t*)lds + wave * (4 * 16 * 72);
    bf16_t* zb = (bf16_t*)lds + 8 * (4 * 16 * 72) + (par * 2 + (wave >> 2)) * (64 * 72);
    {
        const int r8 = (fq * 16 + fr) >> 3, ch = fr & 7;
#pragma unroll
        for (int i = 0; i < 2; ++i) { bf16_t* d = wb + (i * 8 + r8) * 72 + ch * 8;
            *(uint4*)d = L.rg[i]; *(uint4*)(d + 16 * 72) = L.ry[i]; *(uint4*)(d + 32 * 72) = L.rb[i]; *(uint4*)(d + 48 * 72) = L.rp[i];
            *(uint4*)(zb + (mi * 16 + i * 8 + r8) * 72 + ch * 8) = L.rz[i]; }
        asm volatile("s_waitcnt lgkmcnt(0)" ::: "memory");
    }
    __syncthreads();
    bf16x8 az[4][2];
#pragma unroll
    for (int nj = 0; nj < 4; ++nj)
#pragma unroll
        for (int kk = 0; kk < 2; ++kk) az[nj][kk] = *(const bf16x8*)(zb + ((nj >> 1) * 32 + 8 * (fr >> 2) + 4 * (nj & 1) + (fr & 3)) * 72 + (kk * 4 + fq) * 8);
    bf16x8 Lbg[2]; uint4 Lyw[2], Lbw[2], Lgw[2];
#pragma unroll
    for (int m = 0; m < 2; ++m) { const bf16_t* sr = wb + fr * 72 + (m * 4 + fq) * 8;
        Lbg[m] = *(const bf16x8*)sr; Lyw[m] = *(const uint4*)(sr + 16 * 72); Lbw[m] = *(const uint4*)(sr + 32 * 72); Lgw[m] = *(const uint4*)(sr + 48 * 72); }
    asm volatile("s_waitcnt lgkmcnt(0)" ::: "memory");
    f32x4 acc[4];
#pragma unroll
    for (int m = 0; m < 2; ++m) {
        acc[2 * m][0] = bfl(Lyw[m].x); acc[2 * m][1] = bfh(Lyw[m].x); acc[2 * m][2] = bfl(Lyw[m].y); acc[2 * m][3] = bfh(Lyw[m].y);
        acc[2 * m + 1][0] = bfl(Lyw[m].z); acc[2 * m + 1][1] = bfh(Lyw[m].z); acc[2 * m + 1][2] = bfl(Lyw[m].w); acc[2 * m + 1][3] = bfh(Lyw[m].w);
    }
#pragma unroll
    for (int nj = 0; nj < 4; ++nj)
#pragma unroll
        for (int kk = 0; kk < 2; ++kk) acc[nj] = __builtin_amdgcn_mfma_f32_16x16x32_bf16(az[nj][kk], Lbg[kk], acc[nj], 0, 0, 0);
    float s = 0.f;
#pragma unroll
    for (int nj = 0; nj < 4; ++nj) s += (acc[nj][0] + acc[nj][1]) + (acc[nj][2] + acc[nj][3]);
    s += __shfl_xor(s, 16); s += __shfl_xor(s, 32);
    const float mean = s * (1.0f / HD);
    float vs = 0.f;
#pragma unroll
    for (int nj = 0; nj < 4; ++nj) { acc[nj] = acc[nj] - mean; vs += (acc[nj][0] * acc[nj][0] + acc[nj][1] * acc[nj][1]) + (acc[nj][2] * acc[nj][2] + acc[nj][3] * acc[nj][3]); }
    vs += __shfl_xor(vs, 16); vs += __shfl_xor(vs, 32);
    const float rstd = rsqrtf(vs * (1.0f / HD) + GN_EPS);
#pragma unroll
    for (int m = 0; m < 2; ++m) {
        const int j0 = m * 32 + fq * 8;
        const float* gn_ = (const float*)(lds + B3_GN_OFF) + h * HD + j0;
        const f32x4 gg0 = *(const f32x4*)gn_, gg1 = *(const f32x4*)(gn_ + 4), gb0 = *(const f32x4*)(gn_ + RWW), gb1 = *(const f32x4*)(gn_ + RWW + 4);
        const f32x4 o0 = acc[2 * m] * rstd * gg0 + gb0 + (f32x4){bfl(Lbw[m].x), bfh(Lbw[m].x), bfl(Lbw[m].y), bfh(Lbw[m].y)};
        const f32x4 o1 = acc[2 * m + 1] * rstd * gg1 + gb1 + (f32x4){bfl(Lbw[m].z), bfh(Lbw[m].z), bfl(Lbw[m].w), bfh(Lbw[m].w)};
        uint4 w;
        w.x = pk2(o0[0] * siluf_(bfl(Lgw[m].x)), o0[1] * siluf_(bfh(Lgw[m].x))); w.y = pk2(o0[2] * siluf_(bfl(Lgw[m].y)), o0[3] * siluf_(bfh(Lgw[m].y)));
        w.z = pk2(o1[0] * siluf_(bfl(Lgw[m].z)), o1[1] * siluf_(bfh(Lgw[m].z))); w.w = pk2(o1[2] * siluf_(bfl(Lgw[m].w)), o1[3] * siluf_(bfh(Lgw[m].w)));
        *(uint4*)(wb + fr * 72 + (m * 4 + fq) * 8) = w;
    }
    asm volatile("s_waitcnt lgkmcnt(0)" ::: "memory");
    {
        const int r8 = (fq * 16 + fr) >> 3, ch = fr & 7;
        uint4 ow[2];
#pragma unroll
        for (int i = 0; i < 2; ++i) ow[i] = *(const uint4*)(wb + (i * 8 + r8) * 72 + ch * 8);
#pragma unroll
        for (int i = 0; i < 2; ++i) *(uint4*)(MIX + ((size_t)b * SEQ + c * 64 + mi * 16 + i * 8 + r8) * DM + CW + SBW + h * HD + ch * 8) = ow[i];
        asm volatile("s_waitcnt lgkmcnt(0)" ::: "memory");
    }
}
__device__ void rwkv_b3_phase(const Params& p, int l, unsigned char* lds) {
    const int G = gridDim.x, NPAIR = BATCH * NH * 16;
    int pair = blockIdx.x;
    if (pair >= NPAIR) return;
    { float* GN = (float*)(lds + B3_GN_OFF); const int t_ = tid_(); if (t_ < 2 * (RWW / 4)) { const int a_ = t_ / (RWW / 4), o_ = (t_ % (RWW / 4)) * 4; *(f32x4*)(GN + a_ * RWW + o_) = *(const f32x4*)(p.in[19 + a_] + l * RWW + o_); } }
    __syncthreads();
    B3Loads LA, LB;
    { const int tid = tid_(), lane = tid & 63; b3_issue_loads(p, l, pair, __builtin_amdgcn_readfirstlane(tid >> 6), lane & 15, lane >> 4, LA); }
#pragma unroll 1
    for (; pair < NPAIR; pair += 2 * G) {
        const int tid = tid_(), lane = tid & 63, wave = __builtin_amdgcn_readfirstlane(tid >> 6), fr = lane & 15, fq = lane >> 4;
        if (pair + G < NPAIR) b3_issue_loads(p, l, pair + G, wave, fr, fq, LB);
        b3_compute(p, l, pair, wave, fr, fq, LA, lds, 0);
        if (pair + G >= NPAIR) break;
        if (pair + 2 * G < NPAIR) b3_issue_loads(p, l, pair + 2 * G, wave, fr, fq, LA);
        b3_compute(p, l, pair + G, wave, fr, fq, LB, lds, 1);
    }
}

constexpr int QCTR_WORD = 3584, MISC_OFF_ = 147456;
constexpr int N_ATT_JOBS = BATCH * NH * 8, N_CONV_JOBS = BATCH * (SEQ / 64), N_CHAINS = BATCH * NH;
__device__ __forceinline__ void run_side_job(const Params& p, int l, int id, unsigned char* lds) {
    if (id < N_ATT_JOBS) attn_wg_job(p, id, lds); else conv_job64(p, l, id - N_ATT_JOBS, lds);
}
__device__ void phase_mix1(const Params& p, int l, unsigned char* lds) {
    rwkv_b1_phase(p, l, lds);
    if (!defer_layer1_weights()) for (int id = blockIdx.x; id < N_ATT_JOBS + N_CONV_JOBS; id += gridDim.x) run_side_job(p, l, id, lds);
}
constexpr int N_CHAIN_WGS = N_CHAINS;
__device__ void phase_mix2(const Params& p, int l, unsigned char* lds) {
    const int G = gridDim.x, w = blockIdx.x, NJ = N_ATT_JOBS + N_CONV_JOBS;
    if (!defer_layer1_weights()) { for (int job = w; job < N_CHAINS; job += G) rwkv_b2_job(p, job, lds); return; }
    const bool prep = l + 1 < DEPTH;
    if (w < N_CHAIN_WGS) rwkv_b2_job(p, w, lds);
    else if (prep) prep_weights(p, l + 1, lds, w - N_CHAIN_WGS, G - N_CHAIN_WGS);
    unsigned* ctr = (unsigned*)(p.ws + WS_CTL) + QCTR_WORD + 64 * l;
    volatile unsigned* slot = (volatile unsigned*)(lds + MISC_OFF_) + 24;
    const bool t0 = tid_() == 0;
    if (t0) slot[0] = atomicAdd(ctr, 1u);
    __syncthreads();
    unsigned q = __builtin_amdgcn_readfirstlane(slot[0]);
#pragma unroll 1
    for (int it = 1; q < (unsigned)NJ; ++it) {
        unsigned nq = 0; if (t0) nq = atomicAdd(ctr, 1u);
        int id; if (q < (unsigned)N_CONV_JOBS) id = N_ATT_JOBS + (int)q; else { const int a = (int)q - N_CONV_JOBS; id = (a % (BATCH * NH)) * 8 + (7 - a / (BATCH * NH)); }
        run_side_job(p, l, id, lds);
        if (t0) slot[it & 1] = nq;
        __syncthreads();
        q = __builtin_amdgcn_readfirstlane(slot[it & 1]);
    }
}
__device__ void phase_mix3(const Params& p, int l, unsigned char* lds) {
    rwkv_b3_phase(p, l, lds);
}

#define LAS __attribute__((address_space(3)))
#define XB_TMO      128
#define XB_XCNT(j)  (256  + 64 * (j))
#define XB_XSUB(j)  (1280 + 64 * (j))
#define XB_XGEN(j)  (2304 + 64 * (j))
#define XB_TOP      3328
#define XB_TOPGEN   3392
#define XCD_BAR_WORDS 3456
#define XB_SPIN_CAP (1u << 18)

__device__ __forceinline__ unsigned xb_ld(unsigned* p)              { return __hip_atomic_load(p, __ATOMIC_RELAXED, __HIP_MEMORY_SCOPE_AGENT); }
__device__ __forceinline__ unsigned xb_add(unsigned* p, unsigned v) { return __hip_atomic_fetch_add(p, v, __ATOMIC_RELAXED, __HIP_MEMORY_SCOPE_AGENT); }
__device__ __forceinline__ unsigned xb_xcc_id() { return (unsigned)__builtin_amdgcn_s_getreg((3 << 11) | 20) & 0xFu; }
#define XB_SPIN(cond, bar) do { unsigned _sp = 0; while (cond) { __builtin_amdgcn_s_sleep(1); \
    if ((++_sp & 255u) == 0u) { if (xb_ld(&(bar)[XB_TMO])) break; if (_sp > XB_SPIN_CAP) { atomicAdd(&(bar)[XB_TMO], 1u); break; } } } } while (0)

struct XcdBarrier {
    unsigned* bar; unsigned x;
    volatile LAS unsigned* st;
};

__device__ __forceinline__ XcdBarrier xcd_barrier_post(unsigned* bar, volatile LAS unsigned* st) {
    XcdBarrier b; b.bar = bar; b.x = xb_xcc_id(); b.st = st;
    if (threadIdx.x == 0) (void)xb_add(&bar[XB_XCNT(b.x)], 1u);
    return b;
}
__device__ __forceinline__ void xcd_barrier_complete(unsigned* bar, unsigned x, unsigned& nloc, unsigned& nx) {
    const unsigned G = gridDim.x * gridDim.y * gridDim.z;
    unsigned sum, cnt, mine, sp = 0u;
    for (;;) {
        sum = 0u; cnt = 0u; mine = 0u;
#pragma unroll
        for (unsigned j = 0; j < 16; ++j) { const unsigned c = xb_ld(&bar[XB_XCNT(j)]); sum += c; cnt += (c > 0u) ? 1u : 0u; mine = (j == x) ? c : mine; }
        if (sum == G) break;
        __builtin_amdgcn_s_sleep(1);
        if ((++sp & 255u) == 0u) { if (xb_ld(&bar[XB_TMO])) break; if (sp > XB_SPIN_CAP) { atomicAdd(&bar[XB_TMO], 1u); break; } }
    }
    nloc = mine > 0u ? mine : 1u; nx = cnt > 0u ? cnt : 1u;
}

__device__ __forceinline__ void xcd_barrier(const XcdBarrier& b) {
    asm volatile("s_waitcnt vmcnt(0)" ::: "memory");
    __syncthreads();
    if (threadIdx.x == 0) {
        unsigned* bar = b.bar;
        __builtin_amdgcn_s_waitcnt(0);
        unsigned nloc = b.st[0], nx = b.st[1];
        if (nloc == 0u) { xcd_barrier_complete(bar, b.x, nloc, nx); b.st[0] = nloc; b.st[1] = nx; }
        const unsigned old = xb_add(&bar[XB_XSUB(b.x)], 1u);
        const unsigned gen = old / nloc;
        if (old + 1u == (gen + 1u) * nloc) {
            __builtin_amdgcn_fence(__ATOMIC_RELEASE, "agent");
            asm volatile("s_waitcnt vmcnt(0)" ::: "memory");
            const unsigned og = xb_add(&bar[XB_TOP], 1u);
            const unsigned tg = og / nx;
            if (og + 1u == (tg + 1u) * nx) xb_add(&bar[XB_TOPGEN], 1u);
            else XB_SPIN(xb_ld(&bar[XB_TOPGEN]) == tg, bar);
            __builtin_amdgcn_fence(__ATOMIC_ACQUIRE, "agent");
            xb_add(&bar[XB_XGEN(b.x)], 1u);
            asm volatile("s_waitcnt vmcnt(0)" ::: "memory");
        } else {
            XB_SPIN(xb_ld(&bar[XB_XGEN(b.x)]) == gen, bar);
            __builtin_amdgcn_fence(__ATOMIC_ACQUIRE, "agent");
            asm volatile("s_waitcnt vmcnt(0)" ::: "memory");
        }
    }
    __syncthreads();
}

constexpr int PH_PER_LAYER = 6;
constexpr int N_PHASES = 1 + PH_PER_LAYER * DEPTH;
__device__ __forceinline__ void run_phase(const Params& p, int ph, unsigned char* lds) {
    unsigned char* ws = p.ws;
    if (ph == 0) { phase_prologue(p, lds); return; }
    const int l = (ph - 1) / PH_PER_LAYER, k = (ph - 1) % PH_PER_LAYER;
    if (k == 0) {
        EpiInProjP E{(bf16_t*)(ws + WS_PC), (bf16_t*)(ws + WS_PS), (bf16_t*)(ws + WS_PR), (bf16_t*)(ws + WS_PG), (bf16_t*)(ws + WS_VT), lds + pg8::STAGE_BYTES};
        pg8::Gemm g{(const bf16_t*)(ws + WS_XB), (const bf16_t*)(ws + WS_WIN) + (size_t)l * NINT * DM, M, NINT, DM}; pg8::StaticOrder S; S.init(M, NINT, (int)gridDim.x, (int)blockIdx.x);
        pg8::gemm_phase<EpiInProjP, pg8::StaticOrder, true, true>((PG8_LAS unsigned char*)lds, g, S, E);
    } else if (k == 1) {
        phase_mix1(p, l, lds);
    } else if (k == 2) {
        phase_mix2(p, l, lds);
    } else if (k == 3) {
        phase_mix3(p, l, lds);
    } else if (k == 4) {
        EpiOutBf16P E{(bf16_t*)(ws + WS_Y), DM, lds + pg8::STAGE_BYTES};
        pg8::Gemm g{(const bf16_t*)(ws + WS_MIX), (const bf16_t*)(ws + WS_WOUT) + (size_t)l * DM * DM, M, DM, DM}; pg8::StaticOrder S; S.init(M, DM, (int)gridDim.x, (int)blockIdx.x);
        pg8::gemm_phase<EpiOutBf16P, pg8::StaticOrder, true, true>((PG8_LAS unsigned char*)lds, g, S, E);
    } else {
        phase_rowpass(l == 0 ? p.in[0] : p.out, (const bf16_t*)(ws + WS_Y), p.in[2] + l * DM, p.out, l + 1 < DEPTH ? (bf16_t*)(ws + WS_XB) : nullptr);
    }
}

static_assert(10 * TILE_B + 64 * AABS * 4 + 128 * XTS * 4 + 64 * 4 + 4 * 16 * 17 * 4 <= 147456, "B1 LDS map");
constexpr int LDS_BYTES = 147456 + 256;

constexpr int MISC_OFF = 147456;
#if MK_COOP == 2
__global__ void __launch_bounds__(512, 2) fwd_kernel(Params p) {
    extern __shared__ __attribute__((aligned(16))) unsigned char lds[];
    volatile LAS unsigned* misc = (volatile LAS unsigned*)((LAS unsigned char*)lds + MISC_OFF);
    if (threadIdx.x < 16) misc[threadIdx.x] = 0u;
    __syncthreads();
    XcdBarrier bar = xcd_barrier_post((unsigned*)(p.ws + WS_CTL), misc);
    for (int ph = p.ph_lo; ph < p.ph_hi; ++ph) {
        run_phase(p, ph, lds);
        if (ph + 1 < p.ph_hi) xcd_barrier(bar);
    }
}
#elif MK_COOP == 1
__global__ void __launch_bounds__(512, 2) fwd_kernel(Params p) {
    extern __shared__ __attribute__((aligned(16))) unsigned char lds[];
    cg::grid_group grid = cg::this_grid();
    for (int ph = p.ph_lo; ph < p.ph_hi; ++ph) {
        run_phase(p, ph, lds);
        if (ph + 1 < p.ph_hi) grid.sync();
    }
}
#else
__global__ void __launch_bounds__(512, 2) fwd_kernel(Params p) {
    extern __shared__ __attribute__((aligned(16))) unsigned char lds[];
    for (int ph = p.ph_lo; ph < p.ph_hi; ++ph) run_phase(p, ph, lds);
}
#endif

extern "C" void kernel_launch(void* const* d_in, const int* in_sizes, int n_in, void* d_out, int out_size, void* d_ws, size_t ws_size, hipStream_t stream) {
    static int grid = 0;
    if (grid == 0) {
        if (n_in != 24 || out_size != M * DM || ws_size < WS_END) { fprintf(stderr, "kernel_launch: unexpected problem (n_in %d out %d ws %zu)\n", n_in, out_size, ws_size); grid = -1; return; }
        int dev = 0, cus = 0, per_cu = 0;
        hipGetDevice(&dev); hipDeviceGetAttribute(&cus, hipDeviceAttributeMultiprocessorCount, dev);
        hipFuncSetAttribute((const void*)fwd_kernel, hipFuncAttributeMaxDynamicSharedMemorySize, LDS_BYTES);
        hipOccupancyMaxActiveBlocksPerMultiprocessor(&per_cu, (const void*)fwd_kernel, 512, LDS_BYTES);
        if (per_cu < 1) { fprintf(stderr, "kernel_launch: occupancy query says %d blocks per CU\n", per_cu); per_cu = 1; }
        grid = cus;
        (void)hipGetLastError();
    }
    if (grid < 0) return;
    Params p{};
    for (int i = 0; i < 24; ++i) p.in[i] = (const float*)d_in[i];
    p.out = (float*)d_out; p.ws = (unsigned char*)d_ws;
#if MK_COOP == 2
    p.ph_lo = 0; p.ph_hi = N_PHASES;
    if (hipMemsetAsync((char*)d_ws + WS_CTL, 0, 16384, stream) != hipSuccess) { fprintf(stderr, "kernel_launch: memset of the barrier words failed\n"); return; }
    hipLaunchKernelGGL(fwd_kernel, dim3(grid), dim3(512), LDS_BYTES, stream, p);
#elif MK_COOP == 1
    p.ph_lo = 0; p.ph_hi = N_PHASES;
    void* args[] = {&p};
    hipError_t e = hipLaunchCooperativeKernel((const void*)fwd_kernel, dim3(grid), dim3(512), args, LDS_BYTES, stream);
    if (e != hipSuccess) fprintf(stderr, "cooperative launch failed: %s (grid %d)\n", hipGetErrorString(e), grid);
#else
    for (int ph = 0; ph < N_PHASES; ++ph) {
        p.ph_lo = ph; p.ph_hi = ph + 1;
        hipLaunchKernelGGL(fwd_kernel, dim3(grid), dim3(512), LDS_BYTES, stream, p);
    }
#endif
}
```
